# Optimizing an MI355X kernel written in HIP

```python
import math
import jax, jax.numpy as jnp
from jax import lax
import numpy as np

D_MODEL = 1024
BATCH = 4
SEQ = 8192
DEPTH = 2

GDN_HEADS = 8
GDN_HEAD_DIM = 128
GDN_WIDTH = GDN_HEADS * GDN_HEAD_DIM
SSD_HEADS = 16
SSD_HEAD_DIM = 64
SSD_WIDTH = SSD_HEADS * SSD_HEAD_DIM
SSD_GROUPS = 2
SSD_STATE = 128
BC_WIDTH = SSD_GROUPS * SSD_STATE
MIX_WIDTH = GDN_WIDTH + SSD_WIDTH
CONV_K = 7
CHUNK = 64
N_EXPERTS = 16
EXPERT_FF = 512
EC_FACTOR = 2
EPS = 1e-6
DT_MIN = 1e-3
DT_MAX = 0.1

CONV_CH = 3 * GDN_WIDTH + SSD_WIDTH + 2 * BC_WIDTH
GATE_CH = GDN_WIDTH + SSD_WIDTH
SCALAR_CH = 4 * GDN_HEADS + 2 * SSD_HEADS
PROJ_OUT = CONV_CH + GATE_CH + SCALAR_CH

kernel_name = "bidir_hybrid_gdn_ssd_ec_moe"

F32 = jnp.float32


def rms_norm(x, w):
    xf = x.astype(F32)
    y = xf * lax.rsqrt(jnp.mean(xf * xf, axis=-1, keepdims=True) + EPS)
    return (y * w.astype(F32)).astype(x.dtype)


def l2_normalize(t):
    return t * lax.rsqrt(jnp.sum(t * t, axis=-1, keepdims=True) + EPS)


def centred_dwconv(x, w, b):
    pad = (CONV_K - 1) // 2
    L = x.shape[1]
    xp = jnp.pad(x, ((0, 0), (pad, pad), (0, 0)))
    out = xp[:, 0:L] * w[0]
    for tap in range(1, CONV_K):
        out = out + xp[:, tap:tap + L] * w[tap]
    return out + b


def flip_seq(t):
    return jnp.flip(t, axis=1)


def gated_delta_chunked(q, k, v, g, beta):
    Bsz, L, H, Dk = q.shape
    Dv = v.shape[-1]
    N = L // CHUNK

    def to_chunks(t):
        t = t.reshape((Bsz, N, CHUNK) + t.shape[2:])
        return jnp.swapaxes(t, 2, 3)

    q, k, v, g, beta = (to_chunks(t) for t in (q, k, v, g, beta))
    gc = jnp.cumsum(g, axis=-1)
    incl = jnp.tril(jnp.ones((CHUNK, CHUNK), bool))
    strict = jnp.tril(jnp.ones((CHUNK, CHUNK), bool), k=-1)
    decay = jnp.exp(jnp.where(incl, gc[..., :, None] - gc[..., None, :], -jnp.inf))
    kk = jnp.einsum('bnhid,bnhjd->bnhij', k, k)
    A = jnp.where(strict, beta[..., :, None] * kk * decay, 0.0)
    rhs = jnp.concatenate([v * beta[..., None], k * (beta * jnp.exp(gc))[..., None]], axis=-1)
    sol = lax.linalg.triangular_solve(A, rhs, left_side=True, lower=True, unit_diagonal=True)
    u_v, w_k = sol[..., :Dv], sol[..., Dv:]
    qk = jnp.einsum('bnhid,bnhjd->bnhij', q, k) * decay
    q_dec = q * jnp.exp(gc)[..., None]
    g_last = gc[..., -1]
    k_dec = k * jnp.exp(g_last[..., None] - gc)[..., None]

    def step(S, inp):
        u_c, w_c, qk_c, qd_c, kd_c, gl_c = inp
        u_new = u_c - jnp.einsum('bhik,bhkv->bhiv', w_c, S)
        o = jnp.einsum('bhik,bhkv->bhiv', qd_c, S) + jnp.einsum('bhij,bhjv->bhiv', qk_c, u_new)
        S = S * jnp.exp(gl_c)[..., None, None] + jnp.einsum('bhjk,bhjv->bhkv', kd_c, u_new)
        return S, o

    xs = tuple(jnp.moveaxis(t, 1, 0) for t in (u_v, w_k, qk, q_dec, k_dec, g_last))
    S0 = jnp.zeros((Bsz, H, Dk, Dv), F32)
    _, o = lax.scan(step, S0, xs)
    return jnp.transpose(o, (1, 0, 3, 2, 4)).reshape(Bsz, L, H, Dv)


def ssd_chunked(x, dt, A, Bm, Cm):
    Bsz, L, H, P = x.shape
    G, Ns = Bm.shape[2], Bm.shape[3]
    Hg = H // G
    N = L // CHUNK
    x = x.reshape(Bsz, N, CHUNK, G, Hg, P)
    dt = dt.reshape(Bsz, N, CHUNK, G, Hg)
    Bm = Bm.reshape(Bsz, N, CHUNK, G, Ns)
    Cm = Cm.reshape(Bsz, N, CHUNK, G, Ns)
    cs = jnp.cumsum(dt * A.reshape(G, Hg), axis=2)
    incl = jnp.tril(jnp.ones((CHUNK, CHUNK), bool))[:, :, None, None]
    Lmat = jnp.exp(jnp.where(incl, cs[:, :, :, None] - cs[:, :, None, :], -jnp.inf))
    cb = jnp.einsum('bnigs,bnjgs->bnijg', Cm, Bm)
    xdt = x * dt[..., None]
    y_intra = jnp.einsum('bnijgh,bnjghp->bnighp', cb[..., None] * Lmat, xdt)
    cs_last = cs[:, :, -1]
    w_state = jnp.exp(cs_last[:, :, None] - cs)
    chunk_states = jnp.einsum('bnjgs,bnjghp->bnghsp', Bm, xdt * w_state[..., None])

    def step(hst, inp):
        st, dec, c_c, ecs_c = inp
        y = jnp.einsum('bigs,bghsp->bighp', c_c, hst) * ecs_c[..., None]
        hst = hst * jnp.exp(dec)[..., None, None] + st
        return hst, y

    xs = tuple(jnp.moveaxis(t, 1, 0) for t in (chunk_states, cs_last, Cm, jnp.exp(cs)))
    h0 = jnp.zeros((Bsz, G, Hg, Ns, P), F32)
    _, y_inter = lax.scan(step, h0, xs)
    y = y_intra + jnp.moveaxis(y_inter, 0, 1)
    return y.reshape(Bsz, L, H, P)


def hybrid_mixer(n, w_in, conv_w, conv_b, gdn_A_log, gdn_dt_bias, gdn_norm_w,
                 ssd_A_log, ssd_dt_bias, ssd_D, ssd_norm_w, w_out):
    Bsz, L, _ = n.shape
    proj = jnp.einsum('bld,dp->blp', n, w_in)
    conv_in, gates, scal = jnp.split(proj, [CONV_CH, CONV_CH + GATE_CH], axis=-1)
    c = jax.nn.silu(centred_dwconv(conv_in, conv_w, conv_b)).astype(F32)
    q, k, v, xs, Bm, Cm = jnp.split(
        c, [GDN_WIDTH, 2 * GDN_WIDTH, 3 * GDN_WIDTH, 3 * GDN_WIDTH + SSD_WIDTH,
            3 * GDN_WIDTH + SSD_WIDTH + BC_WIDTH], axis=-1)
    g_gate, z = jnp.split(gates.astype(F32), [GDN_WIDTH], axis=-1)
    gh, sh = GDN_HEADS, SSD_HEADS
    b_f, b_b, a_f, a_b, dt_f, dt_b = jnp.split(
        scal.astype(F32), [gh, 2 * gh, 3 * gh, 4 * gh, 4 * gh + sh], axis=-1)

    q = l2_normalize(q.reshape(Bsz, L, gh, GDN_HEAD_DIM)) * (GDN_HEAD_DIM ** -0.5)
    k = l2_normalize(k.reshape(Bsz, L, gh, GDN_HEAD_DIM))
    v = v.reshape(Bsz, L, gh, GDN_HEAD_DIM)
    gA = gdn_A_log.astype(F32)
    gB = gdn_dt_bias.astype(F32)
    g_fw = -jnp.exp(gA[0]) * jax.nn.softplus(a_f + gB[0])
    g_bw = -jnp.exp(gA[1]) * jax.nn.softplus(a_b + gB[1])
    o_fw = gated_delta_chunked(q, k, v, g_fw, jax.nn.sigmoid(b_f))
    o_bw = flip_seq(gated_delta_chunked(flip_seq(q), flip_seq(k), flip_seq(v),
                                        flip_seq(g_bw), flip_seq(jax.nn.sigmoid(b_b))))
    o_gdn = rms_norm(o_fw + o_bw, gdn_norm_w) * jax.nn.silu(g_gate.reshape(Bsz, L, gh, GDN_HEAD_DIM))
    o_gdn = o_gdn.reshape(Bsz, L, GDN_WIDTH)

    x_ssd = xs.reshape(Bsz, L, sh, SSD_HEAD_DIM)
    Bm = Bm.reshape(Bsz, L, SSD_GROUPS, SSD_STATE)
    Cm = Cm.reshape(Bsz, L, SSD_GROUPS, SSD_STATE)
    sA = -jnp.exp(ssd_A_log.astype(F32))
    sB = ssd_dt_bias.astype(F32)
    dt_fw = jax.nn.softplus(dt_f + sB[0])
    dt_bw = jax.nn.softplus(dt_b + sB[1])
    y_fw = ssd_chunked(x_ssd, dt_fw, sA[0], Bm, Cm)
    y_bw = flip_seq(ssd_chunked(flip_seq(x_ssd), flip_seq(dt_bw), sA[1], flip_seq(Bm), flip_seq(Cm)))
    y = y_fw + y_bw + ssd_D.astype(F32)[:, None] * x_ssd
    y = y.reshape(Bsz, L, SSD_WIDTH) * jax.nn.silu(z)
    y = rms_norm(y.reshape(Bsz, L, SSD_GROUPS, SSD_WIDTH // SSD_GROUPS),
                 ssd_norm_w.reshape(SSD_GROUPS, SSD_WIDTH // SSD_GROUPS)).reshape(Bsz, L, SSD_WIDTH)

    mixed = jnp.concatenate([o_gdn, y], axis=-1).astype(n.dtype)
    return jnp.einsum('blm,md->bld', mixed, w_out)


def expert_choice_ffn(n, w_router, w_gate, w_up, w_down):
    Bsz, L, D = n.shape
    cap = EC_FACTOR * L // N_EXPERTS
    logits = jnp.einsum('bld,de->ble', n, w_router).astype(F32)
    aff = jax.nn.softmax(logits, axis=-1)
    vals, idx = lax.top_k(jnp.swapaxes(aff, 1, 2), cap)
    xs = jax.vmap(lambda hb, ib: hb[ib])(n, idx)
    a = jnp.einsum('becd,edf->becf', xs, w_gate)
    u = jnp.einsum('becd,edf->becf', xs, w_up)
    y = jnp.einsum('becf,efd->becd', jax.nn.silu(a) * u, w_down) * vals[..., None].astype(n.dtype)
    return jax.vmap(lambda yb, ib: jnp.zeros((L, D), yb.dtype).at[ib.reshape(-1)].add(yb.reshape(-1, D)))(y, idx)


def _inv_softplus(t):
    return t + jnp.log(-jnp.expm1(-t))


def setup_inputs(seed: int = 0) -> dict:
    key = jax.random.key(seed)
    ks = jax.random.split(key, 20)

    def normal(k, shape, scale):
        return jax.random.normal(k, shape, F32) * scale

    def gain(k, shape):
        return 1.0 + 0.02 * jax.random.normal(k, shape, F32)

    def dt_bias(k, shape):
        u = jax.random.uniform(k, shape, F32)
        dt = jnp.exp(u * (math.log(DT_MAX) - math.log(DT_MIN)) + math.log(DT_MIN))
        return _inv_softplus(dt)

    def a_log(k, shape):
        return jnp.log(jax.random.uniform(k, shape, F32, 1.0, 16.0))

    return {
        "x": jax.random.normal(ks[0], (BATCH, SEQ, D_MODEL), F32),
        "norm1_w": gain(ks[1], (DEPTH, D_MODEL)),
        "w_in": normal(ks[2], (DEPTH, D_MODEL, PROJ_OUT), D_MODEL ** -0.5),
        "conv_w": normal(ks[3], (DEPTH, CONV_K, CONV_CH), CONV_K ** -0.5),
        "conv_b": normal(ks[4], (DEPTH, CONV_CH), 0.01),
        "gdn_A_log": a_log(ks[5], (DEPTH, 2, GDN_HEADS)),
        "gdn_dt_bias": dt_bias(ks[6], (DEPTH, 2, GDN_HEADS)),
        "gdn_norm_w": gain(ks[7], (DEPTH, GDN_HEAD_DIM)),
        "ssd_A_log": a_log(ks[8], (DEPTH, 2, SSD_HEADS)),
        "ssd_dt_bias": dt_bias(ks[9], (DEPTH, 2, SSD_HEADS)),
        "ssd_D": gain(ks[10], (DEPTH, SSD_HEADS)),
        "ssd_norm_w": gain(ks[11], (DEPTH, SSD_WIDTH)),
        "w_out": normal(ks[12], (DEPTH, MIX_WIDTH, D_MODEL), MIX_WIDTH ** -0.5),
        "norm2_w": gain(ks[13], (DEPTH, D_MODEL)),
        "w_router": normal(ks[14], (DEPTH, D_MODEL, N_EXPERTS), D_MODEL ** -0.5),
        "w_gate": normal(ks[15], (DEPTH, N_EXPERTS, D_MODEL, EXPERT_FF), D_MODEL ** -0.5),
        "w_up": normal(ks[16], (DEPTH, N_EXPERTS, D_MODEL, EXPERT_FF), D_MODEL ** -0.5),
        "w_down": normal(ks[17], (DEPTH, N_EXPERTS, EXPERT_FF, D_MODEL), EXPERT_FF ** -0.5),
        "final_norm_w": gain(ks[18], (D_MODEL,)),
    }


def reference(x, norm1_w, w_in, conv_w, conv_b, gdn_A_log, gdn_dt_bias, gdn_norm_w,
              ssd_A_log, ssd_dt_bias, ssd_D, ssd_norm_w, w_out, norm2_w, w_router,
              w_gate, w_up, w_down, final_norm_w):
    h = x
    for layer in range(DEPTH):
        h = h + hybrid_mixer(rms_norm(h, norm1_w[layer]), w_in[layer], conv_w[layer], conv_b[layer],
                             gdn_A_log[layer], gdn_dt_bias[layer], gdn_norm_w[layer],
                             ssd_A_log[layer], ssd_dt_bias[layer], ssd_D[layer], ssd_norm_w[layer],
                             w_out[layer])
        h = h + expert_choice_ffn(rms_norm(h, norm2_w[layer]), w_router[layer], w_gate[layer],
                                  w_up[layer], w_down[layer])
    return rms_norm(h, final_norm_w)
```

```cpp
#include <hip/hip_runtime.h>
#include <cstdio>
#include <cstdint>
namespace pg8 {
#define PG8_LAS __attribute__((address_space(3)))
typedef unsigned short bf16_t;
typedef short bf16x8 __attribute__((ext_vector_type(8)));
typedef float f32x4 __attribute__((ext_vector_type(4)));
typedef unsigned u32x4 __attribute__((ext_vector_type(4)));
constexpr int BM = 256, BK = 64, HALF = 128, HTB = HALF * BK * 2  , STAGE_BYTES = 8 * HTB, NXCD = 8, WGM = 8;

__host__ __device__ __forceinline__ int lds_byte(int r, int c) { const int st = (r >> 4) * 2 + (c >> 5), rr = r & 15, cc = c & 31, ob = rr * 64 + cc * 2; return st * 1024 + (ob ^ (((ob >> 9) & 1) << 5)); }
__host__ __device__ __forceinline__ void stage_rc(int b, int& R, int& C) { const int st = b / 1024, sb = b % 1024, swz = sb ^ (((sb >> 9) & 1) << 5); R = (st >> 1) * 16 + swz / 64; C = (st & 1) * 32 + (swz % 64) / 2; }
__host__ __device__ __forceinline__ int perm32(int rho) { const int n = rho >> 4, i = rho & 15; return 8 * (i >> 2) + 4 * n + (i & 3); }

struct Unit { int pm, pn; };
struct Gemm { const bf16_t* A; const bf16_t* Bt; int M, N, K; int bshift, bmask; size_t bstride;
    __device__ __forceinline__ size_t grp_off(int pm) const { return (size_t)((pm >> bshift) & bmask) * bstride; } };

struct StaticOrder {
    int nM, nN, nwg, G, c;
    __host__ __device__ void init(int M, int N, int G_, int c_) { nM = M / BM; nN = N / BM; nwg = nM * nN; G = G_; c = c_; }
    __host__ __device__ bool next(int i, Unit& u) const {
        const long L = (long)i * G + c; if (L >= nwg) return false;
        int wgid = (int)L; { const int q = nwg / NXCD, r = nwg % NXCD, xcd = wgid % NXCD, off = wgid / NXCD; wgid = (xcd < r ? xcd * (q + 1) : r * (q + 1) + (xcd - r) * q) + off; }
        const int nig = WGM * nN, gid = wgid / nig, fm = gid * WGM, gsz = (nM - fm) < WGM ? (nM - fm) : WGM;
        u.pm = fm + ((wgid % nig) % gsz); u.pn = (wgid % nig) / gsz; return true;
    }
    __device__ __forceinline__ void a_ready(const Unit&) const {}
    __device__ __forceinline__ void done(const Unit&) const {}
};

__device__ __forceinline__ unsigned cvt_pk_bf16(float lo, float hi) { unsigned r; asm volatile("v_cvt_pk_bf16_f32 %0, %1, %2" : "=v"(r) : "v"(lo), "v"(hi)); return r; }
__device__ __forceinline__ float silu_f(float x) { return x * __builtin_amdgcn_rcpf(1.0f + __builtin_amdgcn_exp2f(-1.4426950408889634f * x)); }
struct EpiBf16 {
    static constexpr bool PERM = true, AFTER_DRAIN = false;
    bf16_t* O; int ldc;
    __device__ __forceinline__ void operator()(const f32x4 (&acc)[2][2][4][2], const Unit& u, int wr, int wc, int fr, int fq) const {
        const int row0 = u.pm * BM + wr * 64 + fr; const int col0 = u.pn * BM + wc * 32 + 8 * fq;
#pragma unroll
        for (int ai = 0; ai < 2; ++ai)
#pragma unroll
            for (int m = 0; m < 4; ++m) { bf16_t* rowp = O + (size_t)(row0 + ai * HALF + m * 16) * ldc + col0;
#pragma unroll
                for (int bj = 0; bj < 2; ++bj) { const f32x4 v0 = acc[ai][bj][m][0], v1 = acc[ai][bj][m][1];
                    u32x4 w; w.x = cvt_pk_bf16(v0[0], v0[1]); w.y = cvt_pk_bf16(v0[2], v0[3]); w.z = cvt_pk_bf16(v1[0], v1[1]); w.w = cvt_pk_bf16(v1[2], v1[3]);
                    *(u32x4*)(rowp + bj * HALF) = w; } }
    }
};
struct EpiRawA {
    static constexpr bool PERM = true, AFTER_DRAIN = false;
    bf16_t* O; float* S;
    __device__ __forceinline__ void operator()(const f32x4 (&acc)[2][2][4][2], const Unit& u, int wr, int wc, int fr, int fq) const {
        const int row0 = u.pm * BM + wr * 64 + fr;
        if (u.pn < 18) {
            const int col0 = u.pn * BM + wc * 32 + 8 * fq;
#pragma unroll
            for (int ai = 0; ai < 2; ++ai)
#pragma unroll
                for (int m = 0; m < 4; ++m) { bf16_t* rowp = O + (size_t)(row0 + ai * HALF + m * 16) * 4608 + col0;
#pragma unroll
                    for (int bj = 0; bj < 2; ++bj) { const f32x4 v0 = acc[ai][bj][m][0], v1 = acc[ai][bj][m][1];
                        u32x4 w; w.x = cvt_pk_bf16(v0[0], v0[1]); w.y = cvt_pk_bf16(v0[2], v0[3]); w.z = cvt_pk_bf16(v1[0], v1[1]); w.w = cvt_pk_bf16(v1[2], v1[3]);
                        *(u32x4*)(rowp + bj * HALF) = w; } }
        } else if (wc < 2) {
            const int col0 = wc * 32 + 8 * fq;
#pragma unroll
            for (int ai = 0; ai < 2; ++ai)
#pragma unroll
                for (int m = 0; m < 4; ++m) { float* sp = S + (size_t)(row0 + ai * HALF + m * 16) * 64 + col0;
                    *(f32x4*)sp = acc[ai][0][m][0]; *(f32x4*)(sp + 4) = acc[ai][0][m][1]; }
        }
    }
};
struct EpiResid {
    static constexpr bool PERM = false, AFTER_DRAIN = false;
    const float* base; float* out; int ldc;
    __device__ __forceinline__ void operator()(const f32x4 (&acc)[2][2][4][2], const Unit& u, int wr, int wc, int fr, int fq) const {
        const int row0 = u.pm * BM + wr * 64 + fr, col0 = u.pn * BM + wc * 32 + 4 * fq;
#pragma unroll
        for (int ai = 0; ai < 2; ++ai)
#pragma unroll
            for (int m = 0; m < 4; ++m) { const size_t off = (size_t)(row0 + ai * HALF + m * 16) * ldc + col0;
#pragma unroll
                for (int bj = 0; bj < 2; ++bj)
#pragma unroll
                    for (int n = 0; n < 2; ++n) { const size_t ix = off + bj * HALF + n * 16; *(f32x4*)(out + ix) = *(const f32x4*)(base + ix) + acc[ai][bj][m][n]; } }
    }
};
struct EpiSwiglu {
    static constexpr bool PERM = true, AFTER_DRAIN = false;
    bf16_t* O; int ldh;
    __device__ __forceinline__ void operator()(const f32x4 (&acc)[2][2][4][2], const Unit& u, int wr, int wc, int fr, int fq) const {
        const int row0 = u.pm * BM + wr * 64 + fr; const int f0 = (u.pn * BM + wc * 32 + 8 * fq) >> 1;
        typedef unsigned u32x2 __attribute__((ext_vector_type(2)));
#pragma unroll
        for (int ai = 0; ai < 2; ++ai)
#pragma unroll
            for (int m = 0; m < 4; ++m) { bf16_t* rowp = O + (size_t)(row0 + ai * HALF + m * 16) * ldh + f0;
#pragma unroll
                for (int bj = 0; bj < 2; ++bj) { const f32x4 v0 = acc[ai][bj][m][0], v1 = acc[ai][bj][m][1];
                    u32x2 w; w.x = cvt_pk_bf16(silu_f(v0[0]) * v0[1], silu_f(v0[2]) * v0[3]); w.y = cvt_pk_bf16(silu_f(v1[0]) * v1[1], silu_f(v1[2]) * v1[3]);
                    *(u32x2*)(rowp + bj * (HALF / 2)) = w; } }
    }
};
template <class Epi, class Sched, bool ALIGN_EPI = false, bool SP2 = false>
__device__ __forceinline__ void gemm_phase(PG8_LAS unsigned char* lds, const Gemm g, const Sched& S, const Epi& E) {
    int tid_o = threadIdx.x; asm volatile("" : "+v"(tid_o));
    const int tid = tid_o, wid = __builtin_amdgcn_readfirstlane(tid >> 6), lane = tid & 63, wr = wid >> 2, wc = wid & 3, fr = lane & 15, fq = lane >> 4;
    const int K = g.K, nt = K / BK;
    unsigned voffA[2], voffB[2];
#pragma unroll
    for (int i = 0; i < 2; ++i) { int R, C; stage_rc(tid * 16 + i * 8192, R, C); const int Rb = Epi::PERM ? ((R & ~31) + perm32(R & 31)) : R;
        voffA[i] = (unsigned)(R * K + C) * 2u; voffB[i] = (unsigned)(Rb * K + C) * 2u; }
    const size_t kstep = (size_t)(BK * 2);
    const size_t hstep = (size_t)HALF * K * 2;
    const size_t tstep = 2 * hstep;
    const unsigned ldsw = (unsigned)wid * 1024u;
    const int aoff = lds_byte(wr * 64 + fr, fq * 8), boff = lds_byte(wc * 32 + fr, fq * 8);
#define PG8_SA(b, h) (((b) * 2 + (h)) * HTB)
#define PG8_SB(b, h) ((4 + (b) * 2 + (h)) * HTB)
#define PG8_STAGE(bufoff, gbase, voff) do { _Pragma("unroll") for (int _i = 0; _i < 2; ++_i) \
        __builtin_amdgcn_global_load_lds((const unsigned*)((const char*)(gbase) + (voff)[_i]), (PG8_LAS unsigned*)(lds + (bufoff) + ldsw + _i * 8192), 16, 0, 0); } while (0)
#define PG8_LDA(dst, b, h) do { _Pragma("unroll") for (int m = 0; m < 4; ++m) _Pragma("unroll") for (int k = 0; k < 2; ++k) dst[m][k] = *(const PG8_LAS bf16x8*)(lds + PG8_SA(b, h) + aoff + m * 2048 + k * 1024); } while (0)
#define PG8_LDB(dst, b, h) do { _Pragma("unroll") for (int n = 0; n < 2; ++n) _Pragma("unroll") for (int k = 0; k < 2; ++k) dst[n][k] = *(const PG8_LAS bf16x8*)(lds + PG8_SB(b, h) + boff + n * 2048 + k * 1024); } while (0)
#define PG8_MMA(ai, bj, At, Bt) do { __builtin_amdgcn_s_setprio(1); _Pragma("unroll") for (int m = 0; m < 4; ++m) _Pragma("unroll") for (int n = 0; n < 2; ++n) _Pragma("unroll") for (int k = 0; k < 2; ++k) \
        acc[ai][bj][m][n] = __builtin_amdgcn_mfma_f32_16x16x32_bf16(Bt[n][k], At[m][k], acc[ai][bj][m][n], 0, 0, 0); __builtin_amdgcn_s_setprio(0); } while (0)
#define PG8_WAIT_V(n) asm volatile("s_waitcnt vmcnt(" #n ")" ::: "memory")
#define PG8_WAIT_L(n) asm volatile("s_waitcnt lgkmcnt(" #n ")" ::: "memory")
#define PG8_BAR __builtin_amdgcn_s_barrier()
#define PG8_SCHED __builtin_amdgcn_sched_barrier(0)
    Unit cur, nxt; int ui = 0;
    if (!S.next(0, cur)) return;
    f32x4 acc[2][2][4][2];
#pragma unroll
    for (int a = 0; a < 2; ++a)
#pragma unroll
        for (int b = 0; b < 2; ++b)
#pragma unroll
            for (int m = 0; m < 4; ++m)
#pragma unroll
                for (int n = 0; n < 2; ++n) acc[a][b][m][n] = (f32x4){0.f, 0.f, 0.f, 0.f};
    bf16x8 At[4][2], B0[2][2], B1[2][2];
    const char* cA = (const char*)g.A + (size_t)cur.pm * tstep; const char* cB = (const char*)g.Bt + g.grp_off(cur.pm) + (size_t)cur.pn * tstep;
    S.a_ready(cur);
    if constexpr (SP2) {
        PG8_STAGE(PG8_SB(0, 0), cB, voffB); PG8_STAGE(PG8_SB(0, 1), cB + hstep, voffB); PG8_STAGE(PG8_SA(0, 0), cA, voffA); PG8_STAGE(PG8_SA(0, 1), cA + hstep, voffA);
        if (wr == 1) PG8_BAR;
        PG8_WAIT_V(2); PG8_BAR;
        PG8_STAGE(PG8_SB(1, 0), cB + kstep, voffB); PG8_STAGE(PG8_SA(1, 0), cA + kstep, voffA); PG8_STAGE(PG8_SB(1, 1), cB + hstep + kstep, voffB);
        PG8_WAIT_V(6); PG8_BAR;
    } else {
        PG8_STAGE(PG8_SB(0, 0), cB, voffB); PG8_STAGE(PG8_SA(0, 0), cA, voffA); PG8_STAGE(PG8_SB(0, 1), cB + hstep, voffB); PG8_STAGE(PG8_SA(0, 1), cA + hstep, voffA);
        if (wr == 1) PG8_BAR;
        PG8_WAIT_V(4); PG8_BAR;
        PG8_STAGE(PG8_SB(1, 0), cB + kstep, voffB); PG8_STAGE(PG8_SA(1, 0), cA + kstep, voffA); PG8_STAGE(PG8_SB(1, 1), cB + hstep + kstep, voffB);
        PG8_WAIT_V(6); PG8_BAR;
    }
    for (;;) {
        const bool has_next = S.next(ui + 1, nxt);
        const char* nA = has_next ? (const char*)g.A + (size_t)nxt.pm * tstep : cA; const char* nB = has_next ? (const char*)g.Bt + g.grp_off(nxt.pm) + (size_t)nxt.pn * tstep : cB;
        for (int t = 0; t < nt; t += 2) {
            const bool last = (t == nt - 2);
            const char* a1 = cA + (size_t)(t + 1) * kstep;
            const char* a2 = last ? nA : cA + (size_t)(t + 2) * kstep; const char* b2 = last ? nB : cB + (size_t)(t + 2) * kstep;
            const char* a3 = a2 + kstep; const char* b3 = b2 + kstep;
            if (last && has_next) S.a_ready(nxt);
            if constexpr (SP2) {
            PG8_LDB(B0, 0, 0); PG8_LDB(B1, 0, 1); PG8_SCHED; PG8_LDA(At, 0, 0); PG8_STAGE(PG8_SA(1, 1), a1 + hstep, voffA);
            PG8_WAIT_V(8); PG8_WAIT_L(0); PG8_BAR; PG8_MMA(0, 0, At, B0); PG8_MMA(0, 1, At, B1); PG8_BAR; PG8_SCHED;
            PG8_LDA(At, 0, 1); PG8_STAGE(PG8_SB(0, 0), b2, voffB); PG8_STAGE(PG8_SB(0, 1), b2 + hstep, voffB); PG8_STAGE(PG8_SA(0, 0), a2, voffA);
            PG8_WAIT_V(8); PG8_WAIT_L(0); PG8_BAR; PG8_MMA(1, 0, At, B0); PG8_MMA(1, 1, At, B1); PG8_BAR; PG8_SCHED;
            PG8_LDB(B0, 1, 0); PG8_LDB(B1, 1, 1); PG8_SCHED; PG8_LDA(At, 1, 0); PG8_STAGE(PG8_SA(0, 1), a2 + hstep, voffA);
            PG8_WAIT_V(8); PG8_WAIT_L(0); PG8_BAR; PG8_MMA(0, 0, At, B0); PG8_MMA(0, 1, At, B1); PG8_BAR; PG8_SCHED;
            PG8_LDA(At, 1, 1); PG8_STAGE(PG8_SB(1, 0), b3, voffB); PG8_STAGE(PG8_SB(1, 1), b3 + hstep, voffB); PG8_STAGE(PG8_SA(1, 0), a3, voffA);
            PG8_WAIT_V(8); PG8_WAIT_L(0); PG8_BAR; PG8_MMA(1, 0, At, B0); PG8_MMA(1, 1, At, B1); PG8_BAR; PG8_SCHED;
            } else {
            PG8_LDB(B0, 0, 0); PG8_SCHED; PG8_LDA(At, 0, 0); PG8_STAGE(PG8_SA(1, 1), a1 + hstep, voffA);
            PG8_WAIT_L(8); PG8_BAR; PG8_WAIT_L(0); PG8_MMA(0, 0, At, B0); PG8_BAR; PG8_SCHED;
            PG8_LDB(B1, 0, 1); PG8_STAGE(PG8_SB(0, 0), b2, voffB);
            PG8_BAR; PG8_WAIT_L(0); PG8_MMA(0, 1, At, B1); PG8_BAR;
            PG8_LDA(At, 0, 1); PG8_STAGE(PG8_SA(0, 0), a2, voffA);
            PG8_BAR; PG8_WAIT_L(0); PG8_MMA(1, 0, At, B0); PG8_BAR; PG8_SCHED;
            PG8_STAGE(PG8_SB(0, 1), b2 + hstep, voffB);
            PG8_WAIT_V(6); PG8_BAR; PG8_MMA(1, 1, At, B1); PG8_BAR;
            PG8_LDB(B0, 1, 0); PG8_SCHED; PG8_LDA(At, 1, 0); PG8_STAGE(PG8_SA(0, 1), a2 + hstep, voffA);
            PG8_WAIT_L(8); PG8_BAR; PG8_WAIT_L(0); PG8_MMA(0, 0, At, B0); PG8_BAR; PG8_SCHED;
            PG8_LDB(B1, 1, 1); PG8_STAGE(PG8_SB(1, 0), b3, voffB);
            PG8_BAR; PG8_WAIT_L(0); PG8_MMA(0, 1, At, B1); PG8_BAR;
            PG8_LDA(At, 1, 1); PG8_STAGE(PG8_SA(1, 0), a3, voffA);
            PG8_BAR; PG8_WAIT_L(0); PG8_MMA(1, 0, At, B0); PG8_BAR; PG8_SCHED;
            PG8_STAGE(PG8_SB(1, 1), b3 + hstep, voffB);
            PG8_WAIT_V(6); PG8_BAR; PG8_MMA(1, 1, At, B1); PG8_BAR;
            }
        }
        if constexpr (ALIGN_EPI) { if (wr == 0) PG8_BAR; }
        if constexpr (!Epi::AFTER_DRAIN) { E(acc, cur, wr, wc, fr, fq); S.done(cur); }
        if (!has_next) break;
#pragma unroll
        for (int a = 0; a < 2; ++a)
#pragma unroll
            for (int b = 0; b < 2; ++b)
#pragma unroll
                for (int m = 0; m < 4; ++m)
#pragma unroll
                    for (int n = 0; n < 2; ++n) acc[a][b][m][n] = (f32x4){0.f, 0.f, 0.f, 0.f};
        cur = nxt; cA = nA; cB = nB; ++ui;
        if constexpr (ALIGN_EPI) { if (wr == 1) PG8_BAR; }
    }
    PG8_WAIT_V(0);
    if constexpr (!ALIGN_EPI) { if (wr == 0) PG8_BAR; }
    PG8_BAR;
    if constexpr (Epi::AFTER_DRAIN) { E.fused(acc, cur, wr, wc, fr, fq, lds, wid, lane); S.done(cur); }
#undef PG8_SA
#undef PG8_SB
#undef PG8_STAGE
#undef PG8_LDA
#undef PG8_LDB
#undef PG8_MMA
#undef PG8_WAIT_V
#undef PG8_WAIT_L
#undef PG8_BAR
#undef PG8_SCHED
}
}
#define GAS __attribute__((address_space(1)))
#define LAS __attribute__((address_space(3)))
typedef unsigned short bf16;
typedef unsigned v4u __attribute__((ext_vector_type(4)));
typedef float f32x4 __attribute__((ext_vector_type(4)));
typedef short bf16x8 __attribute__((ext_vector_type(8)));
typedef GAS unsigned gu32;
typedef GAS unsigned long long gu64;
#define RLX_AGENT __ATOMIC_RELAXED, __HIP_MEMORY_SCOPE_AGENT
#define LDS_WAIT() asm volatile("s_waitcnt lgkmcnt(0)" ::: "memory")
#define VM_WAIT() asm volatile("s_waitcnt vmcnt(0)" ::: "memory")
__device__ __forceinline__ unsigned long long rt() { return __builtin_amdgcn_s_memrealtime(); }
__device__ __forceinline__ unsigned f2bf(float f) { unsigned u = __builtin_bit_cast(unsigned, f); return (u + 0x7fffu + ((u >> 16) & 1u)) >> 16; }
__device__ __forceinline__ unsigned pk2(float lo, float hi) { return f2bf(lo) | (f2bf(hi) << 16); }
#define XB_TMO      128
#define XB_XCNT(j)  (256  + 64 * (j))
#define XB_XSUB(j)  (1280 + 64 * (j))
#define XB_XGEN(j)  (2304 + 64 * (j))
#define XB_TOP      3328
#define XB_TOPGEN   3392
#define XCD_BAR_WORDS 3456
#define XB_SPIN_CAP (1u << 18)

__device__ __forceinline__ unsigned xb_ld(unsigned* p)              { return __hip_atomic_load(p, __ATOMIC_RELAXED, __HIP_MEMORY_SCOPE_AGENT); }
__device__ __forceinline__ unsigned xb_add(unsigned* p, unsigned v) { return __hip_atomic_fetch_add(p, v, __ATOMIC_RELAXED, __HIP_MEMORY_SCOPE_AGENT); }
__device__ __forceinline__ unsigned xb_xcc_id() { return (unsigned)__builtin_amdgcn_s_getreg((3 << 11) | 20) & 0xFu; }
#define XB_SPIN(cond, bar) do { unsigned _sp = 0; while (cond) { __builtin_amdgcn_s_sleep(1); \
    if ((++_sp & 255u) == 0u) { if (xb_ld(&(bar)[XB_TMO])) break; if (_sp > XB_SPIN_CAP) { atomicAdd(&(bar)[XB_TMO], 1u); break; } } } } while (0)

struct XcdBarrier {
    unsigned* bar; unsigned x;
    volatile LAS unsigned* st;
};

__device__ __forceinline__ XcdBarrier xcd_barrier_post(unsigned* bar, volatile LAS unsigned* st) {
    XcdBarrier b; b.bar = bar; b.x = xb_xcc_id(); b.st = st;
    if (threadIdx.x == 0) (void)xb_add(&bar[XB_XCNT(b.x)], 1u);
    return b;
}
__device__ __forceinline__ void xcd_barrier_complete(unsigned* bar, unsigned x, unsigned& nloc, unsigned& nx) {
    const unsigned G = gridDim.x * gridDim.y * gridDim.z;
    unsigned sum, cnt, mine, sp = 0u;
    for (;;) {
        sum = 0u; cnt = 0u; mine = 0u;
#pragma unroll
        for (unsigned j = 0; j < 16; ++j) { const unsigned c = xb_ld(&bar[XB_XCNT(j)]); sum += c; cnt += (c > 0u) ? 1u : 0u; mine = (j == x) ? c : mine; }
        if (sum == G) break;
        __builtin_amdgcn_s_sleep(1);
        if ((++sp & 255u) == 0u) { if (xb_ld(&bar[XB_TMO])) break; if (sp > XB_SPIN_CAP) { atomicAdd(&bar[XB_TMO], 1u); break; } }
    }
    nloc = mine > 0u ? mine : 1u; nx = cnt > 0u ? cnt : 1u;
}

__device__ __forceinline__ void xcd_barrier(const XcdBarrier& b) {
    asm volatile("s_waitcnt vmcnt(0)" ::: "memory");
    __syncthreads();
    if (threadIdx.x == 0) {
        unsigned* bar = b.bar;
        __builtin_amdgcn_s_waitcnt(0);
        unsigned nloc = b.st[0], nx = b.st[1];
        if (nloc == 0u) { xcd_barrier_complete(bar, b.x, nloc, nx); b.st[0] = nloc; b.st[1] = nx; }
        const unsigned old = xb_add(&bar[XB_XSUB(b.x)], 1u);
        const unsigned gen = old / nloc;
        if (old + 1u == (gen + 1u) * nloc) {
            __builtin_amdgcn_fence(__ATOMIC_RELEASE, "agent");
            asm volatile("s_waitcnt vmcnt(0)" ::: "memory");
            const unsigned og = xb_add(&bar[XB_TOP], 1u);
            const unsigned tg = og / nx;
            if (og + 1u == (tg + 1u) * nx) xb_add(&bar[XB_TOPGEN], 1u);
            else XB_SPIN(xb_ld(&bar[XB_TOPGEN]) == tg, bar);
            __builtin_amdgcn_fence(__ATOMIC_ACQUIRE, "agent");
            xb_add(&bar[XB_XGEN(b.x)], 1u);
            asm volatile("s_waitcnt vmcnt(0)" ::: "memory");
        } else {
            XB_SPIN(xb_ld(&bar[XB_XGEN(b.x)]) == gen, bar);
            __builtin_amdgcn_fence(__ATOMIC_ACQUIRE, "agent");
            asm volatile("s_waitcnt vmcnt(0)" ::: "memory");
        }
    }
    __syncthreads();
}
constexpr int NB = 4, SEQ = 8192, DM = 1024, M = NB * SEQ, DEPTH = 2;
constexpr int NCHUNK = SEQ / 64;
constexpr int CONV_CH = 4608, NWA = 4864  , NGATE = 2048, NEXP = 16, EFF = 512, CAP = 1024;
constexpr int MEXP = NB * NEXP * CAP;
constexpr float EPS = 1e-6f;
constexpr int NWAVES = 8;
constexpr size_t MiB = 1u << 20;
constexpr size_t WS_CTL = 0, CTL_ZERO_BYTES = 1 * MiB;
constexpr size_t WS_WA = 1 * MiB;
constexpr size_t WS_WB = 11 * MiB;
constexpr size_t WS_WO = 15 * MiB;
constexpr size_t WS_XN = 19 * MiB;
constexpr size_t WS_RAW = 83 * MiB;
constexpr size_t WS_SCAL = 371 * MiB;
constexpr size_t WS_OG = 379 * MiB;
constexpr size_t WS_YS = 443 * MiB;
constexpr size_t WS_GATES = 83 * MiB;
constexpr size_t WS_MIXED = 211 * MiB;
constexpr size_t WS_WGU = 83 * MiB;
constexpr size_t WS_WD = 115 * MiB;
constexpr size_t WS_XG = 131 * MiB;
constexpr size_t WS_HMID = 259 * MiB;
constexpr size_t WS_AFF = 323 * MiB;
constexpr size_t WS_IDX = 325 * MiB;
constexpr size_t WS_VAL = 326 * MiB;
constexpr size_t WS_INV = 327 * MiB;
constexpr size_t WS_END = 507 * MiB;
constexpr int CW_TMO = 0, CW_BAR = 4096;
constexpr int LDS_BYTES = 163840;
constexpr int MISC_OFF = LDS_BYTES - 256;

typedef short bf16x8 __attribute__((ext_vector_type(8)));
typedef short bf16x4 __attribute__((ext_vector_type(4)));
typedef float f32x4 __attribute__((ext_vector_type(4)));
typedef float f32x2 __attribute__((ext_vector_type(2)));
typedef unsigned u32x4 __attribute__((ext_vector_type(4)));
typedef unsigned u32x2 __attribute__((ext_vector_type(2)));
typedef __bf16 bf16x2_t __attribute__((ext_vector_type(2)));
typedef short s16x2 __attribute__((ext_vector_type(2)));

__device__ __forceinline__ float bf2f(unsigned short v) { return __uint_as_float((unsigned)v << 16); }
__device__ __forceinline__ float bf2f_s(short v) { return __uint_as_float((unsigned)(unsigned short)v << 16); }
__device__ __forceinline__ unsigned pkbf(float lo, float hi) { f32x2 v = {lo, hi}; bf16x2_t b = __builtin_convertvector(v, bf16x2_t); return __builtin_bit_cast(unsigned, b); }
__device__ __forceinline__ unsigned short f2bf1(float f) { return (unsigned short)(pkbf(f, 0.f) & 0xffffu); }
__device__ __forceinline__ float silu(float x) { return x * __builtin_amdgcn_rcpf(1.0f + __builtin_amdgcn_exp2f(-1.4426950408889634f * x)); }
__device__ __forceinline__ float softplus_f(float x) { return x > 20.f ? x : log1pf(expf(x)); }
__device__ __forceinline__ float sigmoid_f(float x) { return 1.0f / (1.0f + expf(-x)); }
__device__ __forceinline__ void atomic_add_bf16x2(bf16* p, float a, float b) {
    (void)__builtin_amdgcn_global_atomic_fadd_v2bf16((GAS s16x2*)p, __builtin_bit_cast(s16x2, pkbf(a, b)));
}
__device__ __forceinline__ float wave_sum(float v) {
#pragma unroll
    for (int o = 1; o < 64; o <<= 1) v += __shfl_xor(v, o);
    return v;
}

template <int MT, int NT>
__device__ __forceinline__ void mma_lds(f32x4 (&acc)[MT][NT], const LAS bf16* A, int lda, int m0, const LAS bf16* Bt, int ldb, int n0, int K, int fr, int fq) {
    for (int k0 = 0; k0 < K; k0 += 32) {
        bf16x8 a[MT], b[NT];
#pragma unroll
        for (int mt = 0; mt < MT; ++mt) a[mt] = *(const LAS bf16x8*)(A + (m0 + mt * 16 + fr) * lda + k0 + fq * 8);
#pragma unroll
        for (int nt = 0; nt < NT; ++nt) b[nt] = *(const LAS bf16x8*)(Bt + (n0 + nt * 16 + fr) * ldb + k0 + fq * 8);
#pragma unroll
        for (int mt = 0; mt < MT; ++mt)
#pragma unroll
            for (int nt = 0; nt < NT; ++nt) acc[mt][nt] = __builtin_amdgcn_mfma_f32_16x16x32_bf16(a[mt], b[nt], acc[mt][nt], 0, 0, 0);
    }
}

__device__ __forceinline__ void conv16(float (&acc)[16], const LAS bf16* src, int ld, const LAS float* cw, int cwld) {
#pragma unroll
    for (int c = 0; c < 16; ++c) acc[c] = cw[7 * cwld + c];
#pragma unroll
    for (int tap = 0; tap < 7; ++tap) {
        const bf16x8 x0 = *(const LAS bf16x8*)(src + tap * ld), x1 = *(const LAS bf16x8*)(src + tap * ld + 8);
        const LAS float* w = cw + tap * cwld;
#pragma unroll
        for (int c = 0; c < 8; ++c) { acc[c] += bf2f_s(x0[c]) * w[c]; acc[8 + c] += bf2f_s(x1[c]) * w[8 + c]; }
        if (tap & 1) asm volatile("" ::: "memory");
    }
}
__device__ __forceinline__ void conv8(float (&acc)[8], const LAS bf16* src, int ld, const LAS float* cw, int cwld) {
#pragma unroll
    for (int c = 0; c < 8; ++c) acc[c] = cw[7 * cwld + c];
#pragma unroll
    for (int tap = 0; tap < 7; ++tap) {
        const bf16x8 x0 = *(const LAS bf16x8*)(src + tap * ld);
        const LAS float* w = cw + tap * cwld;
#pragma unroll
        for (int c = 0; c < 8; ++c) acc[c] += bf2f_s(x0[c]) * w[c];
        if (tap & 1) asm volatile("" ::: "memory");
    }
}

__device__ __forceinline__ void transpose_item(const float* W, int K, int N, int k0, int n0, bf16* WT, int drow0, int rmul, LAS float* scr, int lane) {
#pragma unroll 8
    for (int i = 0; i < 32; ++i) { const int kk = 2 * i + (lane >> 5); scr[kk * 33 + (lane & 31)] = W[(size_t)(k0 + kk) * N + n0 + (lane & 31)]; }
    LDS_WAIT(); asm volatile("" ::: "memory");
    const int c = lane & 7;
#pragma unroll
    for (int j = 0; j < 4; ++j) { const int n = (lane >> 3) + 8 * j; const LAS float* s = scr + (8 * c) * 33 + n;
        u32x4 o; o.x = pkbf(s[0 * 33], s[1 * 33]); o.y = pkbf(s[2 * 33], s[3 * 33]); o.z = pkbf(s[4 * 33], s[5 * 33]); o.w = pkbf(s[6 * 33], s[7 * 33]);
        *(GAS u32x4*)(WT + (size_t)(drow0 + rmul * n) * K + k0 + 8 * c) = o; }
    LDS_WAIT(); asm volatile("" ::: "memory");
}
__device__ __forceinline__ void cvt_mixer_weights(LAS unsigned char* lds, unsigned char* ws, const float* w_in, const float* w_out, int gw, int NGW, int wave, int lane) {
    LAS float* scr = (LAS float*)(lds + wave * 16384);
    bf16* WA = (bf16*)(ws + WS_WA); bf16* WB = (bf16*)(ws + WS_WB); bf16* WO = (bf16*)(ws + WS_WO);
    constexpr int I_IN = 16 * 210, I_OUT = 32 * 32;
    for (int it = gw; it < I_IN + I_OUT; it += NGW) {
        if (it < I_IN) { const int kb = it / 210, nb = it % 210, n0 = nb * 32;
            bf16* dst; int drow;
            if (n0 < 4608) { dst = WA; drow = n0; } else if (n0 < 6656) { dst = WB; drow = n0 - 4608; } else { dst = WA; drow = 4608 + (n0 - 6656); }
            transpose_item(w_in, 1024, 6720, kb * 64, n0, dst, drow, 1, scr, lane);
        } else { const int r = it - I_IN, kb = r / 32, nb = r % 32; transpose_item(w_out, 2048, 1024, kb * 64, nb * 32, WO, nb * 32, 1, scr, lane); }
    }
    for (int r = gw; r < 192; r += NGW) { GAS u32x4* p = (GAS u32x4*)(WA + (size_t)(4672 + r) * 1024) + lane; p[0] = (u32x4){0u, 0u, 0u, 0u}; p[64] = (u32x4){0u, 0u, 0u, 0u}; }
}
__device__ __forceinline__ void cvt_expert_weights(LAS unsigned char* lds, unsigned char* ws, const float* w_gate, const float* w_up, const float* w_down, int gw, int NGW, int wave, int lane) {
    LAS float* scr = (LAS float*)(lds + wave * 16384);
    bf16* WGU = (bf16*)(ws + WS_WGU); bf16* WD = (bf16*)(ws + WS_WD);
    constexpr int I_G = 16 * 16;
    constexpr int I_D = 8 * 32;
    constexpr int PER_E = 2 * I_G + I_D;
    for (int it = gw; it < NEXP * PER_E; it += NGW) {
        const int e = it / PER_E; int r = it % PER_E;
        if (r < 2 * I_G) { const int up = r >= I_G; if (up) r -= I_G; const int kb = r / 16, nb = r % 16;
            transpose_item((up ? w_up : w_gate) + (size_t)e * 1024 * 512, 1024, 512, kb * 64, nb * 32, WGU + (size_t)e * 1024 * 1024, 2 * (nb * 32) + up, 2, scr, lane);
        } else { r -= 2 * I_G; const int kb = r / 32, nb = r % 32;
            transpose_item(w_down + (size_t)e * 512 * 1024, 512, 1024, kb * 64, nb * 32, WD + (size_t)e * 1024 * 512, nb * 32, 1, scr, lane); }
    }
}

__device__ __forceinline__ void rms_row_regs(const float* xrow, const f32x4 (&w)[4], f32x4 (&v)[4], int lane) {
    const GAS f32x4* xr = (const GAS f32x4*)xrow + lane; float s = 0.f;
#pragma unroll
    for (int j = 0; j < 4; ++j) { v[j] = xr[64 * j]; s += (v[j].x * v[j].x + v[j].y * v[j].y) + (v[j].z * v[j].z + v[j].w * v[j].w); }
    const float rstd = 1.0f / sqrtf(wave_sum(s) * (1.0f / DM) + EPS);
#pragma unroll
    for (int j = 0; j < 4; ++j) v[j] = v[j] * rstd * w[j];
}
__device__ __forceinline__ void store_row_bf16(bf16* orow, const f32x4 (&v)[4], int lane) {
    GAS u32x2* o8 = (GAS u32x2*)orow + lane;
#pragma unroll
    for (int j = 0; j < 4; ++j) { u32x2 t; t.x = pkbf(v[j].x, v[j].y); t.y = pkbf(v[j].z, v[j].w); o8[64 * j] = t; }
}
__device__ __forceinline__ void load_w4(const float* w, f32x4 (&wv)[4], int lane) {
#pragma unroll
    for (int j = 0; j < 4; ++j) wv[j] = ((const GAS f32x4*)w)[lane + 64 * j];
}
__device__ __forceinline__ void phase_norm(const float* src, const float* w, bf16* XN, int gw, int NGW, int lane) {
    f32x4 wv[4]; load_w4(w, wv, lane);
    for (int m = gw; m < M; m += NGW) { f32x4 v[4]; rms_row_regs(src + (size_t)m * DM, wv, v, lane); store_row_bf16(XN + (size_t)m * DM, v, lane); }
}
__device__ __forceinline__ void zero_region(unsigned char* p, size_t bytes, int gtid, int NGT) {
    GAS u32x4* q = (GAS u32x4*)p; const size_t n = bytes / 16;
    for (size_t i = gtid; i < n; i += NGT) q[i] = (u32x4){0u, 0u, 0u, 0u};
}

__device__ __forceinline__ void phase_norm2_router(LAS unsigned char* lds, const float* h, const float* w2, const float* w_router, bf16* XN, float* aff, int gw, int NGW, int tid, int lane) {
    LAS float* wrT = (LAS float*)lds;
    for (int e = tid; e < 16 * 1024; e += 512) { const int k = e >> 4, x = e & 15; wrT[x * 1024 + k] = w_router[e]; }
    __syncthreads();
    f32x4 wv[4]; load_w4(w2, wv, lane);
    for (int m = gw; m < M; m += NGW) {
        f32x4 v[4]; rms_row_regs(h + (size_t)m * DM, wv, v, lane); store_row_bf16(XN + (size_t)m * DM, v, lane);
        float mine = 0.f;
#pragma unroll 1
        for (int x = 0; x < 16; ++x) { float s = 0.f;
#pragma unroll
            for (int j = 0; j < 4; ++j) { const f32x4 wr = *(const LAS f32x4*)(wrT + x * 1024 + 4 * lane + 256 * j); s += (v[j].x * wr.x + v[j].y * wr.y) + (v[j].z * wr.z + v[j].w * wr.w); }
            s = wave_sum(s); mine = (lane == x) ? s : mine; }
        float mx = mine;
        mx = fmaxf(mx, __shfl_xor(mx, 1)); mx = fmaxf(mx, __shfl_xor(mx, 2)); mx = fmaxf(mx, __shfl_xor(mx, 4)); mx = fmaxf(mx, __shfl_xor(mx, 8));
        const float ex = expf(mine - mx); float den = ex;
        den += __shfl_xor(den, 1); den += __shfl_xor(den, 2); den += __shfl_xor(den, 4); den += __shfl_xor(den, 8);
        if (lane < 16) aff[(size_t)m * 16 + lane] = ex / den;
    }
}

__device__ __forceinline__ void phase_finish(const bf16* og, const bf16* ys, const bf16* gates, const float* gnw, const float* snw, bf16* mixed, int gw, int NGW, int lane) {
    float gw_[16], sw_[16];
#pragma unroll
    for (int c = 0; c < 16; ++c) { gw_[c] = gnw[(16 * lane + c) & 127]; sw_[c] = snw[16 * lane + c]; }
    for (int m = gw; m < M; m += NGW) {
        const bf16x8 o0 = *(const GAS bf16x8*)(og + (size_t)m * 1024 + 16 * lane), o1 = *(const GAS bf16x8*)(og + (size_t)m * 1024 + 16 * lane + 8);
        const bf16x8 y0 = *(const GAS bf16x8*)(ys + (size_t)m * 1024 + 16 * lane), y1 = *(const GAS bf16x8*)(ys + (size_t)m * 1024 + 16 * lane + 8);
        const bf16x8 g0 = *(const GAS bf16x8*)(gates + (size_t)m * 2048 + 16 * lane), g1 = *(const GAS bf16x8*)(gates + (size_t)m * 2048 + 16 * lane + 8);
        const bf16x8 z0 = *(const GAS bf16x8*)(gates + (size_t)m * 2048 + 1024 + 16 * lane), z1 = *(const GAS bf16x8*)(gates + (size_t)m * 2048 + 1024 + 16 * lane + 8);
        float o[16], t[16]; float so = 0.f, st = 0.f;
#pragma unroll
        for (int c = 0; c < 8; ++c) { o[c] = bf2f_s(o0[c]); o[8 + c] = bf2f_s(o1[c]); t[c] = bf2f_s(y0[c]) * silu(bf2f_s(z0[c])); t[8 + c] = bf2f_s(y1[c]) * silu(bf2f_s(z1[c])); }
#pragma unroll
        for (int c = 0; c < 16; ++c) { so += o[c] * o[c]; st += t[c] * t[c]; }
        so += __shfl_xor(so, 1); so += __shfl_xor(so, 2); so += __shfl_xor(so, 4);
        st += __shfl_xor(st, 1); st += __shfl_xor(st, 2); st += __shfl_xor(st, 4); st += __shfl_xor(st, 8); st += __shfl_xor(st, 16);
        const float ro = 1.0f / sqrtf(so * (1.0f / 128.f) + EPS), rt = 1.0f / sqrtf(st * (1.0f / 512.f) + EPS);
        float a[16], b2[16];
#pragma unroll
        for (int c = 0; c < 8; ++c) { a[c] = o[c] * ro * gw_[c] * silu(bf2f_s(g0[c])); a[8 + c] = o[8 + c] * ro * gw_[8 + c] * silu(bf2f_s(g1[c])); }
#pragma unroll
        for (int c = 0; c < 16; ++c) b2[c] = t[c] * rt * sw_[c];
        u32x4 w0, w1, w2, w3;
        w0.x = pkbf(a[0], a[1]); w0.y = pkbf(a[2], a[3]); w0.z = pkbf(a[4], a[5]); w0.w = pkbf(a[6], a[7]);
        w1.x = pkbf(a[8], a[9]); w1.y = pkbf(a[10], a[11]); w1.z = pkbf(a[12], a[13]); w1.w = pkbf(a[14], a[15]);
        w2.x = pkbf(b2[0], b2[1]); w2.y = pkbf(b2[2], b2[3]); w2.z = pkbf(b2[4], b2[5]); w2.w = pkbf(b2[6], b2[7]);
        w3.x = pkbf(b2[8], b2[9]); w3.y = pkbf(b2[10], b2[11]); w3.z = pkbf(b2[12], b2[13]); w3.w = pkbf(b2[14], b2[15]);
        GAS u32x4* mp = (GAS u32x4*)(mixed + (size_t)m * 2048 + 16 * lane);
        mp[0] = w0; mp[1] = w1; mp[128] = w2; mp[129] = w3;
    }
}

__device__ __forceinline__ void phase_topk(LAS unsigned char* lds, const float* aff, int* idx, float* val, int* inv, int be, int tid, int wave, int lane) {
    LAS unsigned* hist = (LAS unsigned*)lds;
    LAS unsigned* ctl = hist + 256;
    LAS unsigned* wsum = hist + 320;
    const int b = be >> 4, e = be & 15;
    unsigned key[16];
#pragma unroll
    for (int i = 0; i < 16; ++i) key[i] = __float_as_uint(aff[((size_t)b * SEQ + tid * 16 + i) * 16 + e]);
    unsigned prefix = 0u, mask = 0u; unsigned krem = CAP;
    for (int pass = 0; pass < 4; ++pass) {
        const int shift = 24 - 8 * pass;
        if (tid < 256) hist[tid] = 0u;
        __syncthreads();
#pragma unroll
        for (int i = 0; i < 16; ++i) if ((key[i] & mask) == prefix) atomicAdd((unsigned*)&hist[(key[i] >> shift) & 255u], 1u);
        __syncthreads();
        if (tid == 0) { unsigned cum = 0u; int d = 255;
            for (; d > 0; --d) { const unsigned c = hist[d]; if (cum + c >= krem) break; cum += c; }
            ctl[0] = prefix | ((unsigned)d << shift); ctl[1] = krem - cum; }
        __syncthreads();
        prefix = ctl[0]; krem = ctl[1]; mask |= 255u << shift;
        __syncthreads();
    }
    const unsigned thr = prefix;
    int ngt = 0, neq = 0;
#pragma unroll
    for (int i = 0; i < 16; ++i) { ngt += key[i] > thr; neq += key[i] == thr; }
    int sg = ngt, sq = neq;
#pragma unroll
    for (int o = 1; o < 64; o <<= 1) { const int a = __shfl_up(sg, o), c = __shfl_up(sq, o); if (lane >= o) { sg += a; sq += c; } }
    if (lane == 63) { wsum[wave] = (unsigned)sg; wsum[8 + wave] = (unsigned)sq; }
    __syncthreads();
    int bg = 0, bq = 0;
#pragma unroll
    for (int w = 0; w < 8; ++w) if (w < wave) { bg += (int)wsum[w]; bq += (int)wsum[8 + w]; }
    int pg = bg + sg - ngt, pq = bq + sq - neq;
#pragma unroll
    for (int i = 0; i < 16; ++i) {
        const int tok = tid * 16 + i; const bool gt = key[i] > thr, eq = key[i] == thr;
        const bool sel = gt || (eq && pq < (int)krem);
        const int slot = pg + (pq < (int)krem ? pq : (int)krem);
        if (sel) { idx[be * CAP + slot] = tok; val[be * CAP + slot] = __uint_as_float(key[i]); }
        inv[((size_t)b * SEQ + tok) * 16 + e] = sel ? slot : -1;
        pg += gt; pq += eq;
    }
    __syncthreads();
}

__device__ __forceinline__ void phase_gather(const bf16* XN, const int* idx, bf16* XG, int gw, int NGW, int lane) {
    for (int r = gw; r < MEXP; r += NGW) {
        const int b = r >> 14; const int tok = idx[r];
        const GAS u32x4* s = (const GAS u32x4*)(XN + ((size_t)b * SEQ + tok) * DM) + lane; GAS u32x4* d = (GAS u32x4*)(XG + (size_t)r * DM) + lane;
        const u32x4 a = s[0], c = s[64]; d[0] = a; d[64] = c;
    }
}

__device__ __forceinline__ void phase_combine(const float* hin, float* hout, const bf16* Y, const int* inv, const float* val, const float* wn, bf16* XN, bool final_, int gw, int NGW, int lane) {
    f32x4 wv[4]; load_w4(wn, wv, lane);
    for (int m = gw; m < M; m += NGW) {
        const int b = m >> 13;
        const GAS f32x4* xr = (const GAS f32x4*)(hin + (size_t)m * DM) + lane; f32x4 v[4];
#pragma unroll
        for (int j = 0; j < 4; ++j) v[j] = xr[64 * j];
        const int myslot = (lane < 16) ? inv[(size_t)m * 16 + lane] : -1;
        for (int e = 0; e < 16; ++e) {
            const int s = __shfl(myslot, e);
            if (s >= 0) {
                const int r = (b * 16 + e) * CAP + s; const float a = val[r];
                const GAS u32x2* yr = (const GAS u32x2*)(Y + (size_t)r * DM) + lane;
#pragma unroll
                for (int j = 0; j < 4; ++j) { const u32x2 t = yr[64 * j];
                    v[j].x += a * __uint_as_float(t.x << 16); v[j].y += a * __uint_as_float(t.x & 0xffff0000u); v[j].z += a * __uint_as_float(t.y << 16); v[j].w += a * __uint_as_float(t.y & 0xffff0000u); }
            }
        }
        float s2 = 0.f;
#pragma unroll
        for (int j = 0; j < 4; ++j) s2 += (v[j].x * v[j].x + v[j].y * v[j].y) + (v[j].z * v[j].z + v[j].w * v[j].w);
        const float rstd = 1.0f / sqrtf(wave_sum(s2) * (1.0f / DM) + EPS);
        GAS f32x4* ho = (GAS f32x4*)(hout + (size_t)m * DM) + lane;
        if (final_) {
#pragma unroll
            for (int j = 0; j < 4; ++j) ho[64 * j] = v[j] * rstd * wv[j];
        } else {
#pragma unroll
            for (int j = 0; j < 4; ++j) ho[64 * j] = v[j];
            f32x4 nv[4];
#pragma unroll
            for (int j = 0; j < 4; ++j) nv[j] = v[j] * rstd * wv[j];
            store_row_bf16(XN + (size_t)m * DM, nv, lane);
        }
    }
}
namespace gdn {
constexpr int CW = 0;
constexpr int SC = CW + 8 * 320 * 4;
constexpr int Q = SC + 1280;
constexpr int K = Q + 64 * 136 * 2;
constexpr int KDT = K + 64 * 136 * 2;
constexpr int VT = KDT + 128 * 72 * 2;
constexpr int T = VT + 64 * 72 * 2;
constexpr int QKD = T + 64 * 72 * 2;
constexpr int ST = QKD + 64 * 72 * 2;
constexpr int TMP = ST + 64 * 136 * 2;
constexpr int RQ = TMP, RK = RQ + 70 * 136 * 2, RV = RK + 70 * 136 * 2, RAW_END = RV + 70 * 72 * 2;
constexpr int AF = TMP, TF = AF + 64 * 68 * 4, XF = TF + 64 * 68 * 4, INV_END = XF + 3 * 16 * 17 * 4;
constexpr int RT = TMP, UT = RT + 64 * 72 * 2, OS = UT + 64 * 72 * 2, ST_END = OS + 64 * 65 * 4;
static_assert(RAW_END <= MISC_OFF && INV_END <= MISC_OFF && ST_END <= MISC_OFF, "gdn LDS map");
}
__device__ __forceinline__ void gdn_chain(LAS unsigned char* lds, int cid, const bf16* raw, const float* scal, const float* conv_w, const float* conv_b,
                                          const float* A_log, const float* dt_bias, bf16* og, int tid, int wave, int lane) {
    using namespace gdn;
    const int dvh = cid & 1, dir = (cid >> 1) & 1, h = (cid >> 2) & 7, b = cid >> 5;
    const int fr = lane & 15, fq = lane >> 4;
    LAS float* cw = (LAS float*)(lds + CW); LAS float* sc = (LAS float*)(lds + SC);
    LAS bf16* q_ = (LAS bf16*)(lds + Q); LAS bf16* k_ = (LAS bf16*)(lds + K); LAS bf16* kdT = (LAS bf16*)(lds + KDT); LAS bf16* vT = (LAS bf16*)(lds + VT);
    LAS bf16* T_ = (LAS bf16*)(lds + T); LAS bf16* QKd = (LAS bf16*)(lds + QKD); LAS bf16* ST_ = (LAS bf16*)(lds + ST);
    LAS bf16* rq = (LAS bf16*)(lds + RQ); LAS bf16* rk = (LAS bf16*)(lds + RK); LAS bf16* rv = (LAS bf16*)(lds + RV);
    LAS float* Af = (LAS float*)(lds + AF); LAS float* Tf = (LAS float*)(lds + TF); LAS float* Xf = (LAS float*)(lds + XF);
    LAS bf16* rT = (LAS bf16*)(lds + RT); LAS bf16* uT = (LAS bf16*)(lds + UT); LAS float* os = (LAS float*)(lds + OS);
    for (int e = tid; e < 8 * 320; e += 512) { const int r = e / 320, c = e % 320;
        const int gch = c < 128 ? h * 128 + c : (c < 256 ? 1024 + h * 128 + (c - 128) : 2048 + h * 128 + dvh * 64 + (c - 256));
        cw[e] = r < 7 ? conv_w[r * CONV_CH + gch] : conv_b[gch]; }
    for (int e = tid; e < 64 * 136 / 2; e += 512) ((LAS unsigned*)ST_)[e] = 0u;
    const float expA = expf(A_log[dir * 8 + h]), dtb = dt_bias[dir * 8 + h];
    f32x4 sacc[4];
#pragma unroll
    for (int nt = 0; nt < 4; ++nt) sacc[nt] = (f32x4){0.f, 0.f, 0.f, 0.f};
    const size_t rowb = (size_t)b * SEQ;
    __syncthreads();
    for (int n = 0; n < NCHUNK; ++n) {
        const int t0 = (dir ? NCHUNK - 1 - n : n) * 64;
        for (int e = tid; e < 70 * 40; e += 512) { const int r = e / 40, p = e % 40; const int t = t0 - 3 + r;
            u32x4 v = (u32x4){0u, 0u, 0u, 0u};
            const int col = p < 16 ? h * 128 + p * 8 : (p < 32 ? 1024 + h * 128 + (p - 16) * 8 : 2048 + h * 128 + dvh * 64 + (p - 32) * 8);
            if (t >= 0 && t < SEQ) v = *(const GAS u32x4*)(raw + (rowb + t) * CONV_CH + col);
            LAS bf16* d = p < 16 ? rq + r * 136 + p * 8 : (p < 32 ? rk + r * 136 + (p - 16) * 8 : rv + r * 72 + (p - 32) * 8);
            *(LAS u32x4*)d = v; }
        if (wave == 0) { const int i = lane; const int t = t0 + (dir ? 63 - i : i);
            const float braw = scal[(rowb + t) * 64 + dir * 8 + h], araw = scal[(rowb + t) * 64 + 16 + dir * 8 + h];
            const float g = -expA * softplus_f(araw + dtb);
            float gc = g;
#pragma unroll
            for (int o = 1; o < 64; o <<= 1) { const float y = __shfl_up(gc, o); if (i >= o) gc += y; }
            const float gl = __shfl(gc, 63);
            sc[i] = sigmoid_f(braw); sc[64 + i] = gc; sc[128 + i] = expf(gc); sc[192 + i] = expf(gl - gc); if (i == 0) sc[256] = expf(gl); }
        __syncthreads();
        { const int i = tid >> 3, cg = tid & 7; const int o = dir ? 63 - i : i;
          float a[16];
          conv16(a, rq + o * 136 + cg * 16, 136, cw + cg * 16, 320);
          float ss = 0.f;
#pragma unroll
          for (int c = 0; c < 16; ++c) { a[c] = silu(a[c]); ss += a[c] * a[c]; }
          ss += __shfl_xor(ss, 1); ss += __shfl_xor(ss, 2); ss += __shfl_xor(ss, 4);
          float rs = (1.0f / sqrtf(ss + EPS)) * 0.08838834764831845f;
          { u32x4 w0, w1; w0.x = pkbf(a[0] * rs, a[1] * rs); w0.y = pkbf(a[2] * rs, a[3] * rs); w0.z = pkbf(a[4] * rs, a[5] * rs); w0.w = pkbf(a[6] * rs, a[7] * rs);
            w1.x = pkbf(a[8] * rs, a[9] * rs); w1.y = pkbf(a[10] * rs, a[11] * rs); w1.z = pkbf(a[12] * rs, a[13] * rs); w1.w = pkbf(a[14] * rs, a[15] * rs);
            *(LAS u32x4*)(q_ + i * 136 + cg * 16) = w0; *(LAS u32x4*)(q_ + i * 136 + cg * 16 + 8) = w1; }
          conv16(a, rk + o * 136 + cg * 16, 136, cw + 128 + cg * 16, 320);
          ss = 0.f;
#pragma unroll
          for (int c = 0; c < 16; ++c) { a[c] = silu(a[c]); ss += a[c] * a[c]; }
          ss += __shfl_xor(ss, 1); ss += __shfl_xor(ss, 2); ss += __shfl_xor(ss, 4);
          rs = 1.0f / sqrtf(ss + EPS);
          { u32x4 w0, w1; w0.x = pkbf(a[0] * rs, a[1] * rs); w0.y = pkbf(a[2] * rs, a[3] * rs); w0.z = pkbf(a[4] * rs, a[5] * rs); w0.w = pkbf(a[6] * rs, a[7] * rs);
            w1.x = pkbf(a[8] * rs, a[9] * rs); w1.y = pkbf(a[10] * rs, a[11] * rs); w1.z = pkbf(a[12] * rs, a[13] * rs); w1.w = pkbf(a[14] * rs, a[15] * rs);
            *(LAS u32x4*)(k_ + i * 136 + cg * 16) = w0; *(LAS u32x4*)(k_ + i * 136 + cg * 16 + 8) = w1; }
          const float ek = sc[192 + i] * rs;
#pragma unroll
          for (int c = 0; c < 16; ++c) kdT[(cg * 16 + c) * 72 + i] = f2bf1(a[c] * ek);
          float v8[8];
          conv8(v8, rv + o * 72 + cg * 8, 72, cw + 256 + cg * 8, 320);
#pragma unroll
          for (int c = 0; c < 8; ++c) vT[(cg * 8 + c) * 72 + i] = f2bf1(silu(v8[c]));
        }
        __syncthreads();
        { const int which = wave >> 2, mt = wave & 3;
          f32x4 acc[1][4];
#pragma unroll
          for (int nt = 0; nt < 4; ++nt) acc[0][nt] = (f32x4){0.f, 0.f, 0.f, 0.f};
          mma_lds<1, 4>(acc, which ? q_ : k_, 136, mt * 16, k_, 136, 0, 128, fr, fq);
#pragma unroll
          for (int nt = 0; nt < 4; ++nt)
#pragma unroll
              for (int r = 0; r < 4; ++r) { const int i = mt * 16 + 4 * fq + r, j = nt * 16 + fr;
                  const float d = expf(fminf(sc[64 + i] - sc[64 + j], 0.f)); const float x = acc[0][nt][r] * d;
                  if (which == 0) Af[i * 68 + j] = (i > j) ? sc[i] * x : 0.f;
                  else QKd[i * 72 + j] = f2bf1((i >= j) ? x : 0.f); }
        }
        __syncthreads();
        if (wave == 0) { const int blk = lane >> 4, c = lane & 15; float t[16];
#pragma unroll
            for (int i = 0; i < 16; ++i) t[i] = (i == c) ? 1.f : 0.f;
#pragma unroll
            for (int i = 1; i < 16; ++i) { float s = 0.f; const LAS float* ar = Af + (blk * 16 + i) * 68 + blk * 16;
#pragma unroll
                for (int j = 0; j < i; ++j) s += ar[j] * t[j];
                t[i] = (i > c) ? -s : t[i];
                if ((i & 3) == 3) asm volatile("" ::: "memory"); }
#pragma unroll
            for (int i = 0; i < 16; ++i) Tf[(blk * 16 + i) * 68 + blk * 16 + c] = t[i]; }
        for (int d = 1; d <= 3; ++d) { const int nbk = 4 - d;
            __syncthreads();
            for (int e = tid; e < nbk * 256; e += 512) { const int J = e >> 8, r = (e >> 4) & 15, c = e & 15, I = J + d; float s = 0.f;
                for (int kk = J * 16; kk < I * 16; ++kk) s += Af[(I * 16 + r) * 68 + kk] * Tf[kk * 68 + J * 16 + c];
                Xf[(J * 16 + r) * 17 + c] = s; }
            __syncthreads();
            for (int e = tid; e < nbk * 256; e += 512) { const int J = e >> 8, r = (e >> 4) & 15, c = e & 15, I = J + d; float s = 0.f;
#pragma unroll
                for (int m2 = 0; m2 < 16; ++m2) s += Tf[(I * 16 + r) * 68 + I * 16 + m2] * Xf[(J * 16 + m2) * 17 + c];
                Tf[(I * 16 + r) * 68 + J * 16 + c] = -s; }
        }
        __syncthreads();
        for (int e = tid; e < 4096; e += 512) { const int i = e >> 6, j = e & 63; T_[i * 72 + j] = f2bf1(((i >> 4) >= (j >> 4)) ? Tf[i * 68 + j] : 0.f); }
        __syncthreads();
        const int mt = wave & 3, nh = wave >> 2;
        f32x4 aq[2];
        { f32x4 ak[2]; ak[0] = ak[1] = aq[0] = aq[1] = (f32x4){0.f, 0.f, 0.f, 0.f};
          for (int k0 = 0; k0 < 128; k0 += 32) {
              const bf16x8 fk = *(const LAS bf16x8*)(k_ + (mt * 16 + fr) * 136 + k0 + fq * 8), fqv = *(const LAS bf16x8*)(q_ + (mt * 16 + fr) * 136 + k0 + fq * 8);
#pragma unroll
              for (int nl = 0; nl < 2; ++nl) { const bf16x8 fb = *(const LAS bf16x8*)(ST_ + (nh * 32 + nl * 16 + fr) * 136 + k0 + fq * 8);
                  ak[nl] = __builtin_amdgcn_mfma_f32_16x16x32_bf16(fk, fb, ak[nl], 0, 0, 0); aq[nl] = __builtin_amdgcn_mfma_f32_16x16x32_bf16(fqv, fb, aq[nl], 0, 0, 0); } }
          const int i0 = mt * 16 + 4 * fq;
          const f32x4 be4 = *(const LAS f32x4*)(sc + i0), eg4 = *(const LAS f32x4*)(sc + 128 + i0);
#pragma unroll
          for (int nl = 0; nl < 2; ++nl) { const int dv = nh * 32 + nl * 16 + fr;
              const bf16x4 vv = *(const LAS bf16x4*)(vT + dv * 72 + i0);
              float r0 = be4[0] * (bf2f_s(vv[0]) - eg4[0] * ak[nl][0]), r1 = be4[1] * (bf2f_s(vv[1]) - eg4[1] * ak[nl][1]);
              float r2 = be4[2] * (bf2f_s(vv[2]) - eg4[2] * ak[nl][2]), r3 = be4[3] * (bf2f_s(vv[3]) - eg4[3] * ak[nl][3]);
              u32x2 w; w.x = pkbf(r0, r1); w.y = pkbf(r2, r3); *(LAS u32x2*)(rT + dv * 72 + i0) = w;
              aq[nl][0] *= eg4[0]; aq[nl][1] *= eg4[1]; aq[nl][2] *= eg4[2]; aq[nl][3] *= eg4[3]; }
        }
        __syncthreads();
        { f32x4 au[1][2]; au[0][0] = au[0][1] = (f32x4){0.f, 0.f, 0.f, 0.f};
          mma_lds<1, 2>(au, T_, 72, mt * 16, rT, 72, nh * 32, 64, fr, fq);
          const int i0 = mt * 16 + 4 * fq;
#pragma unroll
          for (int nl = 0; nl < 2; ++nl) { const int dv = nh * 32 + nl * 16 + fr; u32x2 w; w.x = pkbf(au[0][nl][0], au[0][nl][1]); w.y = pkbf(au[0][nl][2], au[0][nl][3]); *(LAS u32x2*)(uT + dv * 72 + i0) = w; }
        }
        __syncthreads();
        { f32x4 ao[1][2]; ao[0][0] = aq[0]; ao[0][1] = aq[1];
          mma_lds<1, 2>(ao, QKd, 72, mt * 16, uT, 72, nh * 32, 64, fr, fq);
          const int i0 = mt * 16 + 4 * fq;
#pragma unroll
          for (int nl = 0; nl < 2; ++nl)
#pragma unroll
              for (int r = 0; r < 4; ++r) os[(i0 + r) * 65 + nh * 32 + nl * 16 + fr] = ao[0][nl][r];
          const float egl = sc[256];
          f32x4 as_[1][4];
#pragma unroll
          for (int nt = 0; nt < 4; ++nt) as_[0][nt] = sacc[nt] * egl;
          mma_lds<1, 4>(as_, kdT, 72, wave * 16, uT, 72, 0, 64, fr, fq);
#pragma unroll
          for (int nt = 0; nt < 4; ++nt) { sacc[nt] = as_[0][nt];
              u32x2 w; w.x = pkbf(sacc[nt][0], sacc[nt][1]); w.y = pkbf(sacc[nt][2], sacc[nt][3]); *(LAS u32x2*)(ST_ + (nt * 16 + fr) * 136 + wave * 16 + 4 * fq) = w; }
        }
        __syncthreads();
#pragma unroll
        for (int ii = 0; ii < 4; ++ii) { const int i = wave * 8 + 2 * ii + (lane >> 5), cp = lane & 31; const int t = t0 + (dir ? 63 - i : i);
            atomic_add_bf16x2(og + (rowb + t) * 1024 + h * 128 + dvh * 64 + 2 * cp, os[i * 65 + 2 * cp], os[i * 65 + 2 * cp + 1]); }
        __syncthreads();
    }
}

namespace ssd {
constexpr int CW = 0;
constexpr int SC = CW + 8 * 320 * 4;
constexpr int BM_ = SC + 1280;
constexpr int CM_ = BM_ + 64 * 136 * 2;
constexpr int BT = CM_ + 64 * 136 * 2;
constexpr int XDT = BT + 128 * 72 * 2;
constexpr int XDW = XDT + 64 * 72 * 2;
constexpr int MM = XDW + 64 * 72 * 2;
constexpr int HT = MM + 64 * 72 * 2;
constexpr int TMP = HT + 64 * 136 * 2;
constexpr int RX = TMP, RB = RX + 70 * 72 * 2, RC = RB + 70 * 136 * 2, RAW_END = RC + 70 * 136 * 2;
constexpr int OS = TMP, OS_END = OS + 64 * 65 * 4;
static_assert(RAW_END <= MISC_OFF && OS_END <= MISC_OFF, "ssd LDS map");
}
__device__ __forceinline__ void ssd_chain(LAS unsigned char* lds, int cid, const bf16* raw, const float* scal, const float* conv_w, const float* conv_b,
                                          const float* A_log, const float* dt_bias, const float* Dp, bf16* ys, int tid, int wave, int lane) {
    using namespace ssd;
    const int dir = cid & 1, head = (cid >> 1) & 15, b = cid >> 5; const int g = head >> 3;
    const int fr = lane & 15, fq = lane >> 4;
    LAS float* cw = (LAS float*)(lds + CW); LAS float* sc = (LAS float*)(lds + SC);
    LAS bf16* Bm = (LAS bf16*)(lds + BM_); LAS bf16* Cm = (LAS bf16*)(lds + CM_); LAS bf16* BT_ = (LAS bf16*)(lds + BT);
    LAS bf16* xdt = (LAS bf16*)(lds + XDT); LAS bf16* xdw = (LAS bf16*)(lds + XDW); LAS bf16* Mm = (LAS bf16*)(lds + MM); LAS bf16* hT = (LAS bf16*)(lds + HT);
    LAS bf16* rx = (LAS bf16*)(lds + RX); LAS bf16* rb = (LAS bf16*)(lds + RB); LAS bf16* rc = (LAS bf16*)(lds + RC); LAS float* os = (LAS float*)(lds + OS);
    const int chx = 3072 + head * 64, chb = 4096 + g * 128, chc = 4352 + g * 128;
    for (int e = tid; e < 8 * 320; e += 512) { const int r = e / 320, c = e % 320;
        const int gch = c < 64 ? chx + c : (c < 192 ? chb + (c - 64) : chc + (c - 192));
        cw[e] = r < 7 ? conv_w[r * CONV_CH + gch] : conv_b[gch]; }
    for (int e = tid; e < 64 * 136 / 2; e += 512) ((LAS unsigned*)hT)[e] = 0u;
    const float Ah = -expf(A_log[dir * 16 + head]), dtb = dt_bias[dir * 16 + head], Dh = (dir == 0) ? Dp[head] : 0.f;
    f32x4 hacc[4];
#pragma unroll
    for (int nt = 0; nt < 4; ++nt) hacc[nt] = (f32x4){0.f, 0.f, 0.f, 0.f};
    const size_t rowb = (size_t)b * SEQ;
    __syncthreads();
    for (int n = 0; n < NCHUNK; ++n) {
        const int t0 = (dir ? NCHUNK - 1 - n : n) * 64;
        for (int e = tid; e < 70 * 40; e += 512) { const int r = e / 40, p = e % 40; const int t = t0 - 3 + r;
            u32x4 v = (u32x4){0u, 0u, 0u, 0u};
            const int col = p < 8 ? chx + p * 8 : (p < 24 ? chb + (p - 8) * 8 : chc + (p - 24) * 8);
            if (t >= 0 && t < SEQ) v = *(const GAS u32x4*)(raw + (rowb + t) * CONV_CH + col);
            LAS bf16* d = p < 8 ? rx + r * 72 + p * 8 : (p < 24 ? rb + r * 136 + (p - 8) * 8 : rc + r * 136 + (p - 24) * 8);
            *(LAS u32x4*)d = v; }
        if (wave == 0) { const int i = lane; const int t = t0 + (dir ? 63 - i : i);
            const float dt = softplus_f(scal[(rowb + t) * 64 + 32 + dir * 16 + head] + dtb);
            float cs = dt * Ah;
#pragma unroll
            for (int o = 1; o < 64; o <<= 1) { const float y = __shfl_up(cs, o); if (i >= o) cs += y; }
            const float cl = __shfl(cs, 63);
            sc[i] = dt; sc[64 + i] = cs; sc[128 + i] = expf(cs); sc[192 + i] = expf(cl - cs); if (i == 0) sc[256] = expf(cl); }
        __syncthreads();
        { const int i = tid >> 3, cg = tid & 7; const int o = dir ? 63 - i : i;
          float a[16];
          conv16(a, rb + o * 136 + cg * 16, 136, cw + 64 + cg * 16, 320);
#pragma unroll
          for (int c = 0; c < 16; ++c) a[c] = silu(a[c]);
          { u32x4 w0, w1; w0.x = pkbf(a[0], a[1]); w0.y = pkbf(a[2], a[3]); w0.z = pkbf(a[4], a[5]); w0.w = pkbf(a[6], a[7]);
            w1.x = pkbf(a[8], a[9]); w1.y = pkbf(a[10], a[11]); w1.z = pkbf(a[12], a[13]); w1.w = pkbf(a[14], a[15]);
            *(LAS u32x4*)(Bm + i * 136 + cg * 16) = w0; *(LAS u32x4*)(Bm + i * 136 + cg * 16 + 8) = w1; }
#pragma unroll
          for (int c = 0; c < 16; ++c) BT_[(cg * 16 + c) * 72 + i] = f2bf1(a[c]);
          conv16(a, rc + o * 136 + cg * 16, 136, cw + 192 + cg * 16, 320);
#pragma unroll
          for (int c = 0; c < 16; ++c) a[c] = silu(a[c]);
          { u32x4 w0, w1; w0.x = pkbf(a[0], a[1]); w0.y = pkbf(a[2], a[3]); w0.z = pkbf(a[4], a[5]); w0.w = pkbf(a[6], a[7]);
            w1.x = pkbf(a[8], a[9]); w1.y = pkbf(a[10], a[11]); w1.z = pkbf(a[12], a[13]); w1.w = pkbf(a[14], a[15]);
            *(LAS u32x4*)(Cm + i * 136 + cg * 16) = w0; *(LAS u32x4*)(Cm + i * 136 + cg * 16 + 8) = w1; }
          float x8[8];
          conv8(x8, rx + o * 72 + cg * 8, 72, cw + cg * 8, 320);
          const float dt = sc[i], wst = sc[192 + i];
#pragma unroll
          for (int c = 0; c < 8; ++c) { const float xv = silu(x8[c]) * dt; xdt[(cg * 8 + c) * 72 + i] = f2bf1(xv); xdw[(cg * 8 + c) * 72 + i] = f2bf1(xv * wst); }
        }
        __syncthreads();
        const int mt = wave & 3, nh = wave >> 2;
        { f32x4 acc[1][2]; acc[0][0] = acc[0][1] = (f32x4){0.f, 0.f, 0.f, 0.f};
          mma_lds<1, 2>(acc, Cm, 136, mt * 16, Bm, 136, nh * 32, 128, fr, fq);
#pragma unroll
          for (int nl = 0; nl < 2; ++nl)
#pragma unroll
              for (int r = 0; r < 4; ++r) { const int i = mt * 16 + 4 * fq + r, j = nh * 32 + nl * 16 + fr;
                  const float d = expf(fminf(sc[64 + i] - sc[64 + j], 0.f));
                  Mm[i * 72 + j] = f2bf1((i >= j) ? acc[0][nl][r] * d : 0.f); }
        }
        __syncthreads();
        { f32x4 a1[1][2], a2[1][2]; a1[0][0] = a1[0][1] = a2[0][0] = a2[0][1] = (f32x4){0.f, 0.f, 0.f, 0.f};
          mma_lds<1, 2>(a1, Mm, 72, mt * 16, xdt, 72, nh * 32, 64, fr, fq);
          mma_lds<1, 2>(a2, Cm, 136, mt * 16, hT, 136, nh * 32, 128, fr, fq);
          const int i0 = mt * 16 + 4 * fq;
          const f32x4 ec4 = *(const LAS f32x4*)(sc + 128 + i0), dt4 = *(const LAS f32x4*)(sc + i0);
#pragma unroll
          for (int nl = 0; nl < 2; ++nl) { const int p = nh * 32 + nl * 16 + fr; const bf16x4 xv = *(const LAS bf16x4*)(xdt + p * 72 + i0);
#pragma unroll
              for (int r = 0; r < 4; ++r) os[(i0 + r) * 65 + p] = a1[0][nl][r] + ec4[r] * a2[0][nl][r] + Dh * bf2f_s(xv[r]) / dt4[r]; }
        }
        __syncthreads();
        { const float ecl = sc[256];
          f32x4 ah[1][4];
#pragma unroll
          for (int nt = 0; nt < 4; ++nt) ah[0][nt] = hacc[nt] * ecl;
          mma_lds<1, 4>(ah, BT_, 72, wave * 16, xdw, 72, 0, 64, fr, fq);
#pragma unroll
          for (int nt = 0; nt < 4; ++nt) { hacc[nt] = ah[0][nt];
              u32x2 w; w.x = pkbf(hacc[nt][0], hacc[nt][1]); w.y = pkbf(hacc[nt][2], hacc[nt][3]); *(LAS u32x2*)(hT + (nt * 16 + fr) * 136 + wave * 16 + 4 * fq) = w; }
        }
#pragma unroll
        for (int ii = 0; ii < 4; ++ii) { const int i = wave * 8 + 2 * ii + (lane >> 5), cp = lane & 31; const int t = t0 + (dir ? 63 - i : i);
            atomic_add_bf16x2(ys + (rowb + t) * 1024 + head * 64 + 2 * cp, os[i * 65 + 2 * cp], os[i * 65 + 2 * cp + 1]); }
        __syncthreads();
    }
}
#ifndef MK_ONE_LAUNCH
#define MK_ONE_LAUNCH 0
#endif
constexpr int NPHASE = 1 + 11 * DEPTH;
struct Args { const float* in[19]; float* out; unsigned char* ws; int ph_lo, ph_hi; };
__global__ void __launch_bounds__(NWAVES * 64, 2) fwd_kernel(Args args) {
    extern __shared__ __attribute__((aligned(16))) unsigned char lds_raw[];
    LAS unsigned char* lds = (LAS unsigned char*)lds_raw;
    unsigned* ctl = (unsigned*)(args.ws + WS_CTL);
    volatile LAS unsigned* MISC = (volatile LAS unsigned*)(lds + MISC_OFF);
    for (int u = threadIdx.x; u < 64; u += 512) MISC[u] = 0u;
    __syncthreads();
#if MK_ONE_LAUNCH
    XcdBarrier bar = xcd_barrier_post(ctl + CW_BAR, MISC + 8);
#define GRID_BAR() do { XcdBarrier bb_ = bar; asm volatile("" : "+s"(bb_.bar), "+s"(bb_.x)); xcd_barrier(bb_); } while (0)
#else
#define GRID_BAR() do {} while (0)
#endif
    const int lo = args.ph_lo, hi = args.ph_hi;
#define WSP(T, off) ((T*)(wsb + (off)))
    for (int ph = lo; ph < hi; ++ph) {
        int tid = threadIdx.x, bid = blockIdx.x, G = gridDim.x;
        const __attribute__((address_space(4))) Args* ap = (const __attribute__((address_space(4))) Args*)__builtin_amdgcn_kernarg_segment_ptr();
        asm volatile("" : "+v"(tid)); asm volatile("" : "+s"(bid), "+s"(G), "+s"(ap));
        unsigned char* wsb = ap->ws;
        const int lane = tid & 63, wave = __builtin_amdgcn_readfirstlane(tid >> 6);
        const int gw = bid * NWAVES + wave, NGW = G * NWAVES, gtid = bid * 512 + tid, NGT = G * 512;
        const int l = (ph == 0) ? 0 : (ph - 1) / 11; const int k = (ph == 0) ? -1 : (ph - 1) % 11;
        switch (k) {
        case -1: {
            cvt_mixer_weights(lds, wsb, ap->in[2], ap->in[12], gw, NGW, wave, lane);
            phase_norm(ap->in[0], ap->in[1], WSP(bf16, WS_XN), gw, NGW, lane);
            zero_region(wsb + WS_OG, 128 * MiB, gtid, NGT);
        } break;
        case 0: {
            pg8::Gemm g{WSP(bf16, WS_XN), WSP(bf16, WS_WA), M, NWA, DM, 0, 0, 0}; pg8::StaticOrder S; S.init(M, NWA, G, bid);
            pg8::EpiRawA E{WSP(bf16, WS_RAW), WSP(float, WS_SCAL)};
            pg8::gemm_phase<pg8::EpiRawA, pg8::StaticOrder, true, true>(lds, g, S, E);
        } break;
        case 1: {
            const float* cwp = ap->in[3] + (size_t)l * 7 * CONV_CH; const float* cbp = ap->in[4] + (size_t)l * CONV_CH;
            for (int c = bid; c < 256; c += G) {
                if (c < 128) gdn_chain(lds, c, WSP(bf16, WS_RAW), WSP(float, WS_SCAL), cwp, cbp, ap->in[5] + l * 16, ap->in[6] + l * 16, WSP(bf16, WS_OG), tid, wave, lane);
                else ssd_chain(lds, c - 128, WSP(bf16, WS_RAW), WSP(float, WS_SCAL), cwp, cbp, ap->in[8] + l * 32, ap->in[9] + l * 32, ap->in[10] + l * 16, WSP(bf16, WS_YS), tid, wave, lane);
                __syncthreads();
            }
        } break;
        case 2: {
            pg8::Gemm g{WSP(bf16, WS_XN), WSP(bf16, WS_WB), M, NGATE, DM, 0, 0, 0}; pg8::StaticOrder S; S.init(M, NGATE, G, bid);
            pg8::EpiBf16 E{WSP(bf16, WS_GATES), NGATE};
            pg8::gemm_phase<pg8::EpiBf16, pg8::StaticOrder, true, true>(lds, g, S, E);
        } break;
        case 3: {
            phase_finish(WSP(bf16, WS_OG), WSP(bf16, WS_YS), WSP(bf16, WS_GATES), ap->in[7] + l * 128, ap->in[11] + l * 1024, WSP(bf16, WS_MIXED), gw, NGW, lane);
        } break;
        case 4: {
            pg8::Gemm g{WSP(bf16, WS_MIXED), WSP(bf16, WS_WO), M, DM, 2048, 0, 0, 0}; pg8::StaticOrder S; S.init(M, DM, G, bid);
            pg8::EpiResid E{(l == 0) ? ap->in[0] : ap->out, ap->out, DM};
            pg8::gemm_phase<pg8::EpiResid, pg8::StaticOrder, true, true>(lds, g, S, E);
        } break;
        case 5: {
            phase_norm2_router(lds, ap->out, ap->in[13] + l * DM, ap->in[14] + (size_t)l * DM * 16, WSP(bf16, WS_XN), WSP(float, WS_AFF), gw, NGW, tid, lane);
            __syncthreads();
            cvt_expert_weights(lds, wsb, ap->in[15] + (size_t)l * NEXP * DM * EFF, ap->in[16] + (size_t)l * NEXP * DM * EFF, ap->in[17] + (size_t)l * NEXP * EFF * DM, gw, NGW, wave, lane);
            if (l + 1 < DEPTH) { cvt_mixer_weights(lds, wsb, ap->in[2] + (size_t)(l + 1) * DM * 6720, ap->in[12] + (size_t)(l + 1) * 2048 * DM, gw, NGW, wave, lane);
                                 zero_region(wsb + WS_OG, 128 * MiB, gtid, NGT); }
        } break;
        case 6: {
            for (int be = bid; be < NB * NEXP; be += G) phase_topk(lds, WSP(float, WS_AFF), WSP(int, WS_IDX), WSP(float, WS_VAL), WSP(int, WS_INV), be, tid, wave, lane);
        } break;
        case 7: {
            phase_gather(WSP(bf16, WS_XN), WSP(int, WS_IDX), WSP(bf16, WS_XG), gw, NGW, lane);
        } break;
        case 8: {
            pg8::Gemm g{WSP(bf16, WS_XG), WSP(bf16, WS_WGU), MEXP, 1024, DM, 2, 15, (size_t)1024 * 1024 * 2}; pg8::StaticOrder S; S.init(MEXP, 1024, G, bid);
            pg8::EpiSwiglu E{WSP(bf16, WS_HMID), EFF};
            pg8::gemm_phase<pg8::EpiSwiglu, pg8::StaticOrder, true, true>(lds, g, S, E);
        } break;
        case 9: {
            pg8::Gemm g{WSP(bf16, WS_HMID), WSP(bf16, WS_WD), MEXP, 1024, EFF, 2, 15, (size_t)1024 * 512 * 2}; pg8::StaticOrder S; S.init(MEXP, 1024, G, bid);
            pg8::EpiBf16 E{WSP(bf16, WS_XG), 1024};
            pg8::gemm_phase<pg8::EpiBf16, pg8::StaticOrder, true, true>(lds, g, S, E);
        } break;
        default: {
            const bool last = (l + 1 == DEPTH);
            phase_combine(ap->out, ap->out, WSP(bf16, WS_XG), WSP(int, WS_INV), WSP(float, WS_VAL), last ? ap->in[18] : ap->in[1] + (size_t)(l + 1) * DM, WSP(bf16, WS_XN), last, gw, NGW, lane);
        } break;
        }
        if (ph + 1 < hi) GRID_BAR();
    }
#undef WSP
}

extern "C" void kernel_launch(void* const* d_in, const int* in_sizes, int n_in, void* d_out, int out_size, void* d_ws, size_t ws_size, hipStream_t stream) {
    static int grid = 0;
    if (grid == 0) {
        if (n_in != 19 || in_sizes[0] != M * DM || out_size != M * DM || ws_size < WS_END) { fprintf(stderr, "kernel_launch: unexpected shapes (n_in %d, in0 %d, out %d, ws %zu); nothing launched\n", n_in, n_in > 0 ? in_sizes[0] : -1, out_size, ws_size); grid = -1; return; }
        int dev = 0, cus = 0;
        if (hipGetDevice(&dev) != hipSuccess || hipDeviceGetAttribute(&cus, hipDeviceAttributeMultiprocessorCount, dev) != hipSuccess) { grid = -1; return; }
        if (hipFuncSetAttribute((const void*)fwd_kernel, hipFuncAttributeMaxDynamicSharedMemorySize, LDS_BYTES) != hipSuccess) { fprintf(stderr, "kernel_launch: hipFuncSetAttribute failed\n"); grid = -1; return; }
        (void)hipGetLastError();
        grid = cus;
    }
    if (grid < 0) return;
    (void)hipMemsetAsync((char*)d_ws + WS_CTL, 0, CTL_ZERO_BYTES, stream);
    Args a{};
    for (int i = 0; i < 19; ++i) a.in[i] = (const float*)d_in[i];
    a.out = (float*)d_out; a.ws = (unsigned char*)d_ws;
#if MK_ONE_LAUNCH
    a.ph_lo = 0; a.ph_hi = NPHASE;
    hipLaunchKernelGGL(fwd_kernel, dim3(grid), dim3(NWAVES * 64), LDS_BYTES, stream, a);
#else
    for (int p = 0; p < NPHASE; ++p) { a.ph_lo = p; a.ph_hi = p + 1; hipLaunchKernelGGL(fwd_kernel, dim3(grid), dim3(NWAVES * 64), LDS_BYTES, stream, a); }
#endif
}
```

```cpp
#include <hip/hip_runtime.h>
#include <cstdio>
#include <cstdint>
namespace pg8 {
#define PG8_LAS __attribute__((address_space(3)))
typedef unsigned short bf16_t;
typedef short bf16x8 __attribute__((ext_vector_type(8)));
typedef float f32x4 __attribute__((ext_vector_type(4)));
typedef unsigned u32x4 __attribute__((ext_vector_type(4)));
constexpr int BM = 256, BK = 64, HALF = 128, HTB = HALF * BK * 2  , STAGE_BYTES = 8 * HTB, NXCD = 8, WGM = 8;

__host__ __device__ __forceinline__ int lds_byte(int r, int c) { const int st = (r >> 4) * 2 + (c >> 5), rr = r & 15, cc = c & 31, ob = rr * 64 + cc * 2; return st * 1024 + (ob ^ (((ob >> 9) & 1) << 5)); }
__host__ __device__ __forceinline__ void stage_rc(int b, int& R, int& C) { const int st = b / 1024, sb = b % 1024, swz = sb ^ (((sb >> 9) & 1) << 5); R = (st >> 1) * 16 + swz / 64; C = (st & 1) * 32 + (swz % 64) / 2; }
__host__ __device__ __forceinline__ int perm32(int rho) { const int n = rho >> 4, i = rho & 15; return 8 * (i >> 2) + 4 * n + (i & 3); }

struct Unit { int pm, pn; };
struct Gemm { const bf16_t* A; const bf16_t* Bt; int M, N, K; int bshift, bmask; size_t bstride;
    __device__ __forceinline__ size_t grp_off(int pm) const { return (size_t)((pm >> bshift) & bmask) * bstride; } };

struct StaticOrder {
    int nM, nN, nwg, G, c;
    __host__ __device__ void init(int M, int N, int G_, int c_) { nM = M / BM; nN = N / BM; nwg = nM * nN; G = G_; c = c_; }
    __host__ __device__ bool next(int i, Unit& u) const {
        const long L = (long)i * G + c; if (L >= nwg) return false;
        int wgid = (int)L; { const int q = nwg / NXCD, r = nwg % NXCD, xcd = wgid % NXCD, off = wgid / NXCD; wgid = (xcd < r ? xcd * (q + 1) : r * (q + 1) + (xcd - r) * q) + off; }
        const int nig = WGM * nN, gid = wgid / nig, fm = gid * WGM, gsz = (nM - fm) < WGM ? (nM - fm) : WGM;
        u.pm = fm + ((wgid % nig) % gsz); u.pn = (wgid % nig) / gsz; return true;
    }
    __device__ __forceinline__ void a_ready(const Unit&) const {}
    __device__ __forceinline__ void done(const Unit&) const {}
};

__device__ __forceinline__ unsigned cvt_pk_bf16(float lo, float hi) { unsigned r; asm volatile("v_cvt_pk_bf16_f32 %0, %1, %2" : "=v"(r) : "v"(lo), "v"(hi)); return r; }
__device__ __forceinline__ float silu_f(float x) { return x * __builtin_amdgcn_rcpf(1.0f + __builtin_amdgcn_exp2f(-1.4426950408889634f * x)); }
struct EpiBf16 {
    static constexpr bool PERM = true, AFTER_DRAIN = false;
    bf16_t* O; int ldc;
    __device__ __forceinline__ void operator()(const f32x4 (&acc)[2][2][4][2], const Unit& u, int wr, int wc, int fr, int fq) const {
        const int row0 = u.pm * BM + wr * 64 + fr; const int col0 = u.pn * BM + wc * 32 + 8 * fq;
#pragma unroll
        for (int ai = 0; ai < 2; ++ai)
#pragma unroll
            for (int m = 0; m < 4; ++m) { bf16_t* rowp = O + (size_t)(row0 + ai * HALF + m * 16) * ldc + col0;
#pragma unroll
                for (int bj = 0; bj < 2; ++bj) { const f32x4 v0 = acc[ai][bj][m][0], v1 = acc[ai][bj][m][1];
                    u32x4 w; w.x = cvt_pk_bf16(v0[0], v0[1]); w.y = cvt_pk_bf16(v0[2], v0[3]); w.z = cvt_pk_bf16(v1[0], v1[1]); w.w = cvt_pk_bf16(v1[2], v1[3]);
                    *(u32x4*)(rowp + bj * HALF) = w; } }
    }
};
struct EpiRawA {
    static constexpr bool PERM = true, AFTER_DRAIN = false;
    bf16_t* O; float* S;
    __device__ __forceinline__ void operator()(const f32x4 (&acc)[2][2][4][2], const Unit& u, int wr, int wc, int fr, int fq) const {
        const int row0 = u.pm * BM + wr * 64 + fr;
        if (u.pn < 18) {
            const int col0 = u.pn * BM + wc * 32 + 8 * fq;
#pragma unroll
            for (int ai = 0; ai < 2; ++ai)
#pragma unroll
                for (int m = 0; m < 4; ++m) { bf16_t* rowp = O + (size_t)(row0 + ai * HALF + m * 16) * 4608 + col0;
#pragma unroll
                    for (int bj = 0; bj < 2; ++bj) { const f32x4 v0 = acc[ai][bj][m][0], v1 = acc[ai][bj][m][1];
                        u32x4 w; w.x = cvt_pk_bf16(v0[0], v0[1]); w.y = cvt_pk_bf16(v0[2], v0[3]); w.z = cvt_pk_bf16(v1[0], v1[1]); w.w = cvt_pk_bf16(v1[2], v1[3]);
                        *(u32x4*)(rowp + bj * HALF) = w; } }
        } else if (wc < 2) {
            const int col0 = wc * 32 + 8 * fq;
#pragma unroll
            for (int ai = 0; ai < 2; ++ai)
#pragma unroll
                for (int m = 0; m < 4; ++m) { float* sp = S + (size_t)(row0 + ai * HALF + m * 16) * 64 + col0;
                    *(f32x4*)sp = acc[ai][0][m][0]; *(f32x4*)(sp + 4) = acc[ai][0][m][1]; }
        }
    }
};
struct EpiResid {
    static constexpr bool PERM = false, AFTER_DRAIN = false;
    const float* base; float* out; int ldc;
    __device__ __forceinline__ void operator()(const f32x4 (&acc)[2][2][4][2], const Unit& u, int wr, int wc, int fr, int fq) const {
        const int row0 = u.pm * BM + wr * 64 + fr, col0 = u.pn * BM + wc * 32 + 4 * fq;
#pragma unroll
        for (int ai = 0; ai < 2; ++ai)
#pragma unroll
            for (int m = 0; m < 4; ++m) { const size_t off = (size_t)(row0 + ai * HALF + m * 16) * ldc + col0;
#pragma unroll
                for (int bj = 0; bj < 2; ++bj)
#pragma unroll
                    for (int n = 0; n < 2; ++n) { const size_t ix = off + bj * HALF + n * 16; *(f32x4*)(out + ix) = *(const f32x4*)(base + ix) + acc[ai][bj][m][n]; } }
    }
};
struct EpiSwiglu {
    static constexpr bool PERM = true, AFTER_DRAIN = false;
    bf16_t* O; int ldh;
    __device__ __forceinline__ void operator()(const f32x4 (&acc)[2][2][4][2], const Unit& u, int wr, int wc, int fr, int fq) const {
        const int row0 = u.pm * BM + wr * 64 + fr; const int f0 = (u.pn * BM + wc * 32 + 8 * fq) >> 1;
        typedef unsigned u32x2 __attribute__((ext_vector_type(2)));
#pragma unroll
        for (int ai = 0; ai < 2; ++ai)
#pragma unroll
            for (int m = 0; m < 4; ++m) { bf16_t* rowp = O + (size_t)(row0 + ai * HALF + m * 16) * ldh + f0;
#pragma unroll
                for (int bj = 0; bj < 2; ++bj) { const f32x4 v0 = acc[ai][bj][m][0], v1 = acc[ai][bj][m][1];
                    u32x2 w; w.x = cvt_pk_bf16(silu_f(v0[0]) * v0[1], silu_f(v0[2]) * v0[3]); w.y = cvt_pk_bf16(silu_f(v1[0]) * v1[1], silu_f(v1[2]) * v1[3]);
                    *(u32x2*)(rowp + bj * (HALF / 2)) = w; } }
    }
};
template <class Epi, class Sched, bool ALIGN_EPI = false, bool SP2 = false>
__device__ __forceinline__ void gemm_phase(PG8_LAS unsigned char* lds, const Gemm g, const Sched& S, const Epi& E) {
    int tid_o = threadIdx.x; asm volatile("" : "+v"(tid_o));
    const int tid = tid_o, wid = __builtin_amdgcn_readfirstlane(tid >> 6), lane = tid & 63, wr = wid >> 2, wc = wid & 3, fr = lane & 15, fq = lane >> 4;
    const int K = g.K, nt = K / BK;
    unsigned voffA[2], voffB[2];
#pragma unroll
    for (int i = 0; i < 2; ++i) { int R, C; stage_rc(tid * 16 + i * 8192, R, C); const int Rb = Epi::PERM ? ((R & ~31) + perm32(R & 31)) : R;
        voffA[i] = (unsigned)(R * K + C) * 2u; voffB[i] = (unsigned)(Rb * K + C) * 2u; }
    const size_t kstep = (size_t)(BK * 2);
    const size_t hstep = (size_t)HALF * K * 2;
    const size_t tstep = 2 * hstep;
    const unsigned ldsw = (unsigned)wid * 1024u;
    const int aoff = lds_byte(wr * 64 + fr, fq * 8), boff = lds_byte(wc * 32 + fr, fq * 8);
#define PG8_SA(b, h) (((b) * 2 + (h)) * HTB)
#define PG8_SB(b, h) ((4 + (b) * 2 + (h)) * HTB)
#define PG8_STAGE(bufoff, gbase, voff) do { _Pragma("unroll") for (int _i = 0; _i < 2; ++_i) \
        __builtin_amdgcn_global_load_lds((const unsigned*)((const char*)(gbase) + (voff)[_i]), (PG8_LAS unsigned*)(lds + (bufoff) + ldsw + _i * 8192), 16, 0, 0); } while (0)
#define PG8_LDA(dst, b, h) do { _Pragma("unroll") for (int m = 0; m < 4; ++m) _Pragma("unroll") for (int k = 0; k < 2; ++k) dst[m][k] = *(const PG8_LAS bf16x8*)(lds + PG8_SA(b, h) + aoff + m * 2048 + k * 1024); } while (0)
#define PG8_LDB(dst, b, h) do { _Pragma("unroll") for (int n = 0; n < 2; ++n) _Pragma("unroll") for (int k = 0; k < 2; ++k) dst[n][k] = *(const PG8_LAS bf16x8*)(lds + PG8_SB(b, h) + boff + n * 2048 + k * 1024); } while (0)
#define PG8_MMA(ai, bj, At, Bt) do { __builtin_amdgcn_s_setprio(1); _Pragma("unroll") for (int m = 0; m < 4; ++m) _Pragma("unroll") for (int n = 0; n < 2; ++n) _Pragma("unroll") for (int k = 0; k < 2; ++k) \
        acc[ai][bj][m][n] = __builtin_amdgcn_mfma_f32_16x16x32_bf16(Bt[n][k], At[m][k], acc[ai][bj][m][n], 0, 0, 0); __builtin_amdgcn_s_setprio(0); } while (0)
#define PG8_WAIT_V(n) asm volatile("s_waitcnt vmcnt(" #n ")" ::: "memory")
#define PG8_WAIT_L(n) asm volatile("s_waitcnt lgkmcnt(" #n ")" ::: "memory")
#define PG8_BAR __builtin_amdgcn_s_barrier()
#define PG8_SCHED __builtin_amdgcn_sched_barrier(0)
    Unit cur, nxt; int ui = 0;
    if (!S.next(0, cur)) return;
    f32x4 acc[2][2][4][2];
#pragma unroll
    for (int a = 0; a < 2; ++a)
#pragma unroll
        for (int b = 0; b < 2; ++b)
#pragma unroll
            for (int m = 0; m < 4; ++m)
#pragma unroll
                for (int n = 0; n < 2; ++n) acc[a][b][m][n] = (f32x4){0.f, 0.f, 0.f, 0.f};
    bf16x8 At[4][2], B0[2][2], B1[2][2];
    const char* cA = (const char*)g.A + (size_t)cur.pm * tstep; const char* cB = (const char*)g.Bt + g.grp_off(cur.pm) + (size_t)cur.pn * tstep;
    S.a_ready(cur);
    if constexpr (SP2) {
        PG8_STAGE(PG8_SB(0, 0), cB, voffB); PG8_STAGE(PG8_SB(0, 1), cB + hstep, voffB); PG8_STAGE(PG8_SA(0, 0), cA, voffA); PG8_STAGE(PG8_SA(0, 1), cA + hstep, voffA);
        if (wr == 1) PG8_BAR;
        PG8_WAIT_V(2); PG8_BAR;
        PG8_STAGE(PG8_SB(1, 0), cB + kstep, voffB); PG8_STAGE(PG8_SA(1, 0), cA + kstep, voffA); PG8_STAGE(PG8_SB(1, 1), cB + hstep + kstep, voffB);
        PG8_WAIT_V(6); PG8_BAR;
    } else {
        PG8_STAGE(PG8_SB(0, 0), cB, voffB); PG8_STAGE(PG8_SA(0, 0), cA, voffA); PG8_STAGE(PG8_SB(0, 1), cB + hstep, voffB); PG8_STAGE(PG8_SA(0, 1), cA + hstep, voffA);
        if (wr == 1) PG8_BAR;
        PG8_WAIT_V(4); PG8_BAR;
        PG8_STAGE(PG8_SB(1, 0), cB + kstep, voffB); PG8_STAGE(PG8_SA(1, 0), cA + kstep, voffA); PG8_STAGE(PG8_SB(1, 1), cB + hstep + kstep, voffB);
        PG8_WAIT_V(6); PG8_BAR;
    }
    for (;;) {
        const bool has_next = S.next(ui + 1, nxt);
        const char* nA = has_next ? (const char*)g.A + (size_t)nxt.pm * tstep : cA; const char* nB = has_next ? (const char*)g.Bt + g.grp_off(nxt.pm) + (size_t)nxt.pn * tstep : cB;
        for (int t = 0; t < nt; t += 2) {
            const bool last = (t == nt - 2);
            const char* a1 = cA + (size_t)(t + 1) * kstep;
            const char* a2 = last ? nA : cA + (size_t)(t + 2) * kstep; const char* b2 = last ? nB : cB + (size_t)(t + 2) * kstep;
            const char* a3 = a2 + kstep; const char* b3 = b2 + kstep;
            if (last && has_next) S.a_ready(nxt);
            if constexpr (SP2) {
            PG8_LDB(B0, 0, 0); PG8_LDB(B1, 0, 1); PG8_SCHED; PG8_LDA(At, 0, 0); PG8_STAGE(PG8_SA(1, 1), a1 + hstep, voffA);
            PG8_WAIT_V(8); PG8_WAIT_L(0); PG8_BAR; PG8_MMA(0, 0, At, B0); PG8_MMA(0, 1, At, B1); PG8_BAR; PG8_SCHED;
            PG8_LDA(At, 0, 1); PG8_STAGE(PG8_SB(0, 0), b2, voffB); PG8_STAGE(PG8_SB(0, 1), b2 + hstep, voffB); PG8_STAGE(PG8_SA(0, 0), a2, voffA);
            PG8_WAIT_V(8); PG8_WAIT_L(0); PG8_BAR; PG8_MMA(1, 0, At, B0); PG8_MMA(1, 1, At, B1); PG8_BAR; PG8_SCHED;
            PG8_LDB(B0, 1, 0); PG8_LDB(B1, 1, 1); PG8_SCHED; PG8_LDA(At, 1, 0); PG8_STAGE(PG8_SA(0, 1), a2 + hstep, voffA);
            PG8_WAIT_V(8); PG8_WAIT_L(0); PG8_BAR; PG8_MMA(0, 0, At, B0); PG8_MMA(0, 1, At, B1); PG8_BAR; PG8_SCHED;
            PG8_LDA(At, 1, 1); PG8_STAGE(PG8_SB(1, 0), b3, voffB); PG8_STAGE(PG8_SB(1, 1), b3 + hstep, voffB); PG8_STAGE(PG8_SA(1, 0), a3, voffA);
            PG8_WAIT_V(8); PG8_WAIT_L(0); PG8_BAR; PG8_MMA(1, 0, At, B0); PG8_MMA(1, 1, At, B1); PG8_BAR; PG8_SCHED;
            } else {
            PG8_LDB(B0, 0, 0); PG8_SCHED; PG8_LDA(At, 0, 0); PG8_STAGE(PG8_SA(1, 1), a1 + hstep, voffA);
            PG8_WAIT_L(8); PG8_BAR; PG8_WAIT_L(0); PG8_MMA(0, 0, At, B0); PG8_BAR; PG8_SCHED;
            PG8_LDB(B1, 0, 1); PG8_STAGE(PG8_SB(0, 0), b2, voffB);
            PG8_BAR; PG8_WAIT_L(0); PG8_MMA(0, 1, At, B1); PG8_BAR;
            PG8_LDA(At, 0, 1); PG8_STAGE(PG8_SA(0, 0), a2, voffA);
            PG8_BAR; PG8_WAIT_L(0); PG8_MMA(1, 0, At, B0); PG8_BAR; PG8_SCHED;
            PG8_STAGE(PG8_SB(0, 1), b2 + hstep, voffB);
            PG8_WAIT_V(6); PG8_BAR; PG8_MMA(1, 1, At, B1); PG8_BAR;
            PG8_LDB(B0, 1, 0); PG8_SCHED; PG8_LDA(At, 1, 0); PG8_STAGE(PG8_SA(0, 1), a2 + hstep, voffA);
            PG8_WAIT_L(8); PG8_BAR; PG8_WAIT_L(0); PG8_MMA(0, 0, At, B0); PG8_BAR; PG8_SCHED;
            PG8_LDB(B1, 1, 1); PG8_STAGE(PG8_SB(1, 0), b3, voffB);
            PG8_BAR; PG8_WAIT_L(0); PG8_MMA(0, 1, At, B1); PG8_BAR;
            PG8_LDA(At, 1, 1); PG8_STAGE(PG8_SA(1, 0), a3, voffA);
            PG8_BAR; PG8_WAIT_L(0); PG8_MMA(1, 0, At, B0); PG8_BAR; PG8_SCHED;
            PG8_STAGE(PG8_SB(1, 1), b3 + hstep, voffB);
            PG8_WAIT_V(6); PG8_BAR; PG8_MMA(1, 1, At, B1); PG8_BAR;
            }
        }
        if constexpr (ALIGN_EPI) { if (wr == 0) PG8_BAR; }
        if constexpr (!Epi::AFTER_DRAIN) { E(acc, cur, wr, wc, fr, fq); S.done(cur); }
        if (!has_next) break;
#pragma unroll
        for (int a = 0; a < 2; ++a)
#pragma unroll
            for (int b = 0; b < 2; ++b)
#pragma unroll
                for (int m = 0; m < 4; ++m)
#pragma unroll
                    for (int n = 0; n < 2; ++n) acc[a][b][m][n] = (f32x4){0.f, 0.f, 0.f, 0.f};
        cur = nxt; cA = nA; cB = nB; ++ui;
        if constexpr (ALIGN_EPI) { if (wr == 1) PG8_BAR; }
    }
    PG8_WAIT_V(0);
    if constexpr (!ALIGN_EPI) { if (wr == 0) PG8_BAR; }
    PG8_BAR;
    if constexpr (Epi::AFTER_DRAIN) { E.fused(acc, cur, wr, wc, fr, fq, lds, wid, lane); S.done(cur); }
#undef PG8_SA
#undef PG8_SB
#undef PG8_STAGE
#undef PG8_LDA
#undef PG8_LDB
#undef PG8_MMA
#undef PG8_WAIT_V
#undef PG8_WAIT_L
#undef PG8_BAR
#undef PG8_SCHED
}
}
#define GAS __attribute__((address_space(1)))
#define LAS __attribute__((address_space(3)))
typedef unsigned short bf16;
typedef unsigned v4u __attribute__((ext_vector_type(4)));
typedef float f32x4 __attribute__((ext_vector_type(4)));
typedef short bf16x8 __attribute__((ext_vector_type(8)));
typedef GAS unsigned gu32;
typedef GAS unsigned long long gu64;
#define RLX_AGENT __ATOMIC_RELAXED, __HIP_MEMORY_SCOPE_AGENT
#define LDS_WAIT() asm volatile("s_waitcnt lgkmcnt(0)" ::: "memory")
#define VM_WAIT() asm volatile("s_waitcnt vmcnt(0)" ::: "memory")
__device__ __forceinline__ unsigned long long rt() { return __builtin_amdgcn_s_memrealtime(); }
__device__ __forceinline__ unsigned f2bf(float f) { unsigned u = __builtin_bit_cast(unsigned, f); return (u + 0x7fffu + ((u >> 16) & 1u)) >> 16; }
__device__ __forceinline__ unsigned pk2(float lo, float hi) { return f2bf(lo) | (f2bf(hi) << 16); }
#define XB_TMO      128
#define XB_XCNT(j)  (256  + 64 * (j))
#define XB_XSUB(j)  (1280 + 64 * (j))
#define XB_XGEN(j)  (2304 + 64 * (j))
#define XB_TOP      3328
#define XB_TOPGEN   3392
#define XCD_BAR_WORDS 3456
#define XB_SPIN_CAP (1u << 18)

__device__ __forceinline__ unsigned xb_ld(unsigned* p)              { return __hip_atomic_load(p, __ATOMIC_RELAXED, __HIP_MEMORY_SCOPE_AGENT); }
__device__ __forceinline__ unsigned xb_add(unsigned* p, unsigned v) { return __hip_atomic_fetch_add(p, v, __ATOMIC_RELAXED, __HIP_MEMORY_SCOPE_AGENT); }
__device__ __forceinline__ unsigned xb_xcc_id() { return (unsigned)__builtin_amdgcn_s_getreg((3 << 11) | 20) & 0xFu; }
#define XB_SPIN(cond, bar) do { unsigned _sp = 0; while (cond) { __builtin_amdgcn_s_sleep(1); \
    if ((++_sp & 255u) == 0u) { if (xb_ld(&(bar)[XB_TMO])) break; if (_sp > XB_SPIN_CAP) { atomicAdd(&(bar)[XB_TMO], 1u); break; } } } } while (0)

struct XcdBarrier {
    unsigned* bar; unsigned x;
    volatile LAS unsigned* st;
};

__device__ __forceinline__ XcdBarrier xcd_barrier_post(unsigned* bar, volatile LAS unsigned* st) {
    XcdBarrier b; b.bar = bar; b.x = xb_xcc_id(); b.st = st;
    if (threadIdx.x == 0) (void)xb_add(&bar[XB_XCNT(b.x)], 1u);
    return b;
}
__device__ __forceinline__ void xcd_barrier_complete(unsigned* bar, unsigned x, unsigned& nloc, unsigned& nx) {
    const unsigned G = gridDim.x * gridDim.y * gridDim.z;
    unsigned sum, cnt, mine, sp = 0u;
    for (;;) {
        sum = 0u; cnt = 0u; mine = 0u;
#pragma unroll
        for (unsigned j = 0; j < 16; ++j) { const unsigned c = xb_ld(&bar[XB_XCNT(j)]); sum += c; cnt += (c > 0u) ? 1u : 0u; mine = (j == x) ? c : mine; }
        if (sum == G) break;
        __builtin_amdgcn_s_sleep(1);
        if ((++sp & 255u) == 0u) { if (xb_ld(&bar[XB_TMO])) break; if (sp > XB_SPIN_CAP) { atomicAdd(&bar[XB_TMO], 1u); break; } }
    }
    nloc = mine > 0u ? mine : 1u; nx = cnt > 0u ? cnt : 1u;
}

__device__ __forceinline__ void xcd_barrier(const XcdBarrier& b) {
    asm volatile("s_waitcnt vmcnt(0)" ::: "memory");
    __syncthreads();
    if (threadIdx.x == 0) {
        unsigned* bar = b.bar;
        __builtin_amdgcn_s_waitcnt(0);
        unsigned nloc = b.st[0], nx = b.st[1];
        if (nloc == 0u) { xcd_barrier_complete(bar, b.x, nloc, nx); b.st[0] = nloc; b.st[1] = nx; }
        const unsigned old = xb_add(&bar[XB_XSUB(b.x)], 1u);
        const unsigned gen = old / nloc;
        if (old + 1u == (gen + 1u) * nloc) {
            __builtin_amdgcn_fence(__ATOMIC_RELEASE, "agent");
            asm volatile("s_waitcnt vmcnt(0)" ::: "memory");
            const unsigned og = xb_add(&bar[XB_TOP], 1u);
            const unsigned tg = og / nx;
            if (og + 1u == (tg + 1u) * nx) xb_add(&bar[XB_TOPGEN], 1u);
            else XB_SPIN(xb_ld(&bar[XB_TOPGEN]) == tg, bar);
            __builtin_amdgcn_fence(__ATOMIC_ACQUIRE, "agent");
            xb_add(&bar[XB_XGEN(b.x)], 1u);
            asm volatile("s_waitcnt vmcnt(0)" ::: "memory");
        } else {
            XB_SPIN(xb_ld(&bar[XB_XGEN(b.x)]) == gen, bar);
            __builtin_amdgcn_fence(__ATOMIC_ACQUIRE, "agent");
            asm volatile("s_waitcnt vmcnt(0)" ::: "memory");
        }
    }
    __syncthreads();
}
constexpr int NB = 4, SEQ = 8192, DM = 1024, M = NB * SEQ, DEPTH = 2;
constexpr int NCHUNK = SEQ / 64;
constexpr int CONV_CH = 4608, NWA = 4864  , NGATE = 2048, NEXP = 16, EFF = 512, CAP = 1024;
constexpr int MEXP = NB * NEXP * CAP;
constexpr float EPS = 1e-6f;
constexpr int NWAVES = 8;
constexpr size_t MiB = 1u << 20;
constexpr size_t WS_CTL = 0, CTL_ZERO_BYTES = 1 * MiB;
constexpr size_t WS_WA = 1 * MiB;
constexpr size_t WS_WB = 11 * MiB;
constexpr size_t WS_WO = 15 * MiB;
constexpr size_t WS_XN = 19 * MiB;
constexpr size_t WS_RAW = 83 * MiB;
constexpr size_t WS_SCAL = 371 * MiB;
constexpr size_t WS_OG = 379 * MiB;
constexpr size_t WS_YS = 443 * MiB;
constexpr size_t WS_GATES = 83 * MiB;
constexpr size_t WS_MIXED = 211 * MiB;
constexpr size_t WS_WGU = 83 * MiB;
constexpr size_t WS_WD = 115 * MiB;
constexpr size_t WS_XG = 131 * MiB;
constexpr size_t WS_HMID = 259 * MiB;
constexpr size_t WS_AFF = 323 * MiB;
constexpr size_t WS_IDX = 325 * MiB;
constexpr size_t WS_VAL = 326 * MiB;
constexpr size_t WS_INV = 327 * MiB;
constexpr size_t WS_END = 507 * MiB;
constexpr int CW_TMO = 0, CW_BAR = 4096;
constexpr int LDS_BYTES = 163840;
constexpr int MISC_OFF = LDS_BYTES - 256;

typedef short bf16x8 __attribute__((ext_vector_type(8)));
typedef short bf16x4 __attribute__((ext_vector_type(4)));
typedef float f32x4 __attribute__((ext_vector_type(4)));
typedef float f32x2 __attribute__((ext_vector_type(2)));
typedef unsigned u32x4 __attribute__((ext_vector_type(4)));
typedef unsigned u32x2 __attribute__((ext_vector_type(2)));
typedef __bf16 bf16x2_t __attribute__((ext_vector_type(2)));
typedef short s16x2 __attribute__((ext_vector_type(2)));

__device__ __forceinline__ float bf2f(unsigned short v) { return __uint_as_float((unsigned)v << 16); }
__device__ __forceinline__ float bf2f_s(short v) { return __uint_as_float((unsigned)(unsigned short)v << 16); }
__device__ __forceinline__ unsigned pkbf(float lo, float hi) { f32x2 v = {lo, hi}; bf16x2_t b = __builtin_convertvector(v, bf16x2_t); return __builtin_bit_cast(unsigned, b); }
__device__ __forceinline__ unsigned short f2bf1(float f) { return (unsigned short)(pkbf(f, 0.f) & 0xffffu); }
__device__ __forceinline__ float silu(float x) { return x * __builtin_amdgcn_rcpf(1.0f + __builtin_amdgcn_exp2f(-1.4426950408889634f * x)); }
__device__ __forceinline__ float softplus_f(float x) { return x > 20.f ? x : log1pf(expf(x)); }
__device__ __forceinline__ float sigmoid_f(float x) { return 1.0f / (1.0f + expf(-x)); }
__device__ __forceinline__ void atomic_add_bf16x2(bf16* p, float a, float b) {
    (void)__builtin_amdgcn_global_atomic_fadd_v2bf16((GAS s16x2*)p, __builtin_bit_cast(s16x2, pkbf(a, b)));
}
__device__ __forceinline__ float wave_sum(float v) {
#pragma unroll
    for (int o = 1; o < 64; o <<= 1) v += __shfl_xor(v, o);
    return v;
}

template <int MT, int NT>
__device__ __forceinline__ void mma_lds(f32x4 (&acc)[MT][NT], const LAS bf16* A, int lda, int m0, const LAS bf16* Bt, int ldb, int n0, int K, int fr, int fq) {
    for (int k0 = 0; k0 < K; k0 += 32) {
        bf16x8 a[MT], b[NT];
#pragma unroll
        for (int mt = 0; mt < MT; ++mt) a[mt] = *(const LAS bf16x8*)(A + (m0 + mt * 16 + fr) * lda + k0 + fq * 8);
#pragma unroll
        for (int nt = 0; nt < NT; ++nt) b[nt] = *(const LAS bf16x8*)(Bt + (n0 + nt * 16 + fr) * ldb + k0 + fq * 8);
#pragma unroll
        for (int mt = 0; mt < MT; ++mt)
#pragma unroll
            for (int nt = 0; nt < NT; ++nt) acc[mt][nt] = __builtin_amdgcn_mfma_f32_16x16x32_bf16(a[mt], b[nt], acc[mt][nt], 0, 0, 0);
    }
}

__device__ __forceinline__ void conv16(float (&acc)[16], const LAS bf16* src, int ld, const LAS float* cw, int cwld) {
#pragma unroll
    for (int c = 0; c < 16; ++c) acc[c] = cw[7 * cwld + c];
#pragma unroll
    for (int tap = 0; tap < 7; ++tap) {
        const bf16x8 x0 = *(const LAS bf16x8*)(src + tap * ld), x1 = *(const LAS bf16x8*)(src + tap * ld + 8);
        const LAS float* w = cw + tap * cwld;
#pragma unroll
        for (int c = 0; c < 8; ++c) { acc[c] += bf2f_s(x0[c]) * w[c]; acc[8 + c] += bf2f_s(x1[c]) * w[8 + c]; }
        if (tap & 1) asm volatile("" ::: "memory");
    }
}
__device__ __forceinline__ void conv8(float (&acc)[8], const LAS bf16* src, int ld, const LAS float* cw, int cwld) {
#pragma unroll
    for (int c = 0; c < 8; ++c) acc[c] = cw[7 * cwld + c];
#pragma unroll
    for (int tap = 0; tap < 7; ++tap) {
        const bf16x8 x0 = *(const LAS bf16x8*)(src + tap * ld);
        const LAS float* w = cw + tap * cwld;
#pragma unroll
        for (int c = 0; c < 8; ++c) acc[c] += bf2f_s(x0[c]) * w[c];
        if (tap & 1) asm volatile("" ::: "memory");
    }
}

__device__ __forceinline__ void transpose_item(const float* W, int K, int N, int k0, int n0, bf16* WT, int drow0, int rmul, LAS float* scr, int lane) {
#pragma unroll 8
    for (int i = 0; i < 32; ++i) { const int kk = 2 * i + (lane >> 5); scr[kk * 33 + (lane & 31)] = W[(size_t)(k0 + kk) * N + n0 + (lane & 31)]; }
    LDS_WAIT(); asm volatile("" ::: "memory");
    const int c = lane & 7;
#pragma unroll
    for (int j = 0; j < 4; ++j) { const int n = (lane >> 3) + 8 * j; const LAS float* s = scr + (8 * c) * 33 + n;
        u32x4 o; o.x = pkbf(s[0 * 33], s[1 * 33]); o.y = pkbf(s[2 * 33], s[3 * 33]); o.z = pkbf(s[4 * 33], s[5 * 33]); o.w = pkbf(s[6 * 33], s[7 * 33]);
        *(GAS u32x4*)(WT + (size_t)(drow0 + rmul * n) * K + k0 + 8 * c) = o; }
    LDS_WAIT(); asm volatile("" ::: "memory");
}
__device__ __forceinline__ void cvt_mixer_weights(LAS unsigned char* lds, unsigned char* ws, const float* w_in, const float* w_out, int gw, int NGW, int wave, int lane) {
    LAS float* scr = (LAS float*)(lds + wave * 16384);
    bf16* WA = (bf16*)(ws + WS_WA); bf16* WB = (bf16*)(ws + WS_WB); bf16* WO = (bf16*)(ws + WS_WO);
    constexpr int I_IN = 16 * 210, I_OUT = 32 * 32;
    for (int it = gw; it < I_IN + I_OUT; it += NGW) {
        if (it < I_IN) { const int kb = it / 210, nb = it % 210, n0 = nb * 32;
            bf16* dst; int drow;
            if (n0 < 4608) { dst = WA; drow = n0; } else if (n0 < 6656) { dst = WB; drow = n0 - 4608; } else { dst = WA; drow = 4608 + (n0 - 6656); }
            transpose_item(w_in, 1024, 6720, kb * 64, n0, dst, drow, 1, scr, lane);
        } else { const int r = it - I_IN, kb = r / 32, nb = r % 32; transpose_item(w_out, 2048, 1024, kb * 64, nb * 32, WO, nb * 32, 1, scr, lane); }
    }
    for (int r = gw; r < 192; r += NGW) { GAS u32x4* p = (GAS u32x4*)(WA + (size_t)(4672 + r) * 1024) + lane; p[0] = (u32x4){0u, 0u, 0u, 0u}; p[64] = (u32x4){0u, 0u, 0u, 0u}; }
}
__device__ __forceinline__ void cvt_expert_weights(LAS unsigned char* lds, unsigned char* ws, const float* w_gate, const float* w_up, const float* w_down, int gw, int NGW, int wave, int lane) {
    LAS float* scr = (LAS float*)(lds + wave * 16384);
    bf16* WGU = (bf16*)(ws + WS_WGU); bf16* WD = (bf16*)(ws + WS_WD);
    constexpr int I_G = 16 * 16;
    constexpr int I_D = 8 * 32;
    constexpr int PER_E = 2 * I_G + I_D;
    for (int it = gw; it < NEXP * PER_E; it += NGW) {
        const int e = it / PER_E; int r = it % PER_E;
        if (r < 2 * I_G) { const int up = r >= I_G; if (up) r -= I_G; const int kb = r / 16, nb = r % 16;
            transpose_item((up ? w_up : w_gate) + (size_t)e * 1024 * 512, 1024, 512, kb * 64, nb * 32, WGU + (size_t)e * 1024 * 1024, 2 * (nb * 32) + up, 2, scr, lane);
        } else { r -= 2 * I_G; const int kb = r / 32, nb = r % 32;
            transpose_item(w_down + (size_t)e * 512 * 1024, 512, 1024, kb * 64, nb * 32, WD + (size_t)e * 1024 * 512, nb * 32, 1, scr, lane); }
    }
}

__device__ __forceinline__ void rms_row_regs(const float* xrow, const f32x4 (&w)[4], f32x4 (&v)[4], int lane) {
    const GAS f32x4* xr = (const GAS f32x4*)xrow + lane; float s = 0.f;
#pragma unroll
    for (int j = 0; j < 4; ++j) { v[j] = xr[64 * j]; s += (v[j].x * v[j].x + v[j].y * v[j].y) + (v[j].z * v[j].z + v[j].w * v[j].w); }
    const float rstd = 1.0f / sqrtf(wave_sum(s) * (1.0f / DM) + EPS);
#pragma unroll
    for (int j = 0; j < 4; ++j) v[j] = v[j] * rstd * w[j];
}
__device__ __forceinline__ void store_row_bf16(bf16* orow, const f32x4 (&v)[4], int lane) {
    GAS u32x2* o8 = (GAS u32x2*)orow + lane;
#pragma unroll
    for (int j = 0; j < 4; ++j) { u32x2 t; t.x = pkbf(v[j].x, v[j].y); t.y = pkbf(v[j].z, v[j].w); o8[64 * j] = t; }
}
__device__ __forceinline__ void load_w4(const float* w, f32x4 (&wv)[4], int lane) {
#pragma unroll
    for (int j = 0; j < 4; ++j) wv[j] = ((const GAS f32x4*)w)[lane + 64 * j];
}
__device__ __forceinline__ void phase_norm(const float* src, const float* w, bf16* XN, int gw, int NGW, int lane) {
    f32x4 wv[4]; load_w4(w, wv, lane);
    for (int m = gw; m < M; m += NGW) { f32x4 v[4]; rms_row_regs(src + (size_t)m * DM, wv, v, lane); store_row_bf16(XN + (size_t)m * DM, v, lane); }
}
__device__ __forceinline__ void zero_region(unsigned char* p, size_t bytes, int gtid, int NGT) {
    GAS u32x4* q = (GAS u32x4*)p; const size_t n = bytes / 16;
    for (size_t i = gtid; i < n; i += NGT) q[i] = (u32x4){0u, 0u, 0u, 0u};
}

__device__ __forceinline__ void phase_norm2_router(LAS unsigned char* lds, const float* h, const float* w2, const float* w_router, bf16* XN, float* aff, int gw, int NGW, int tid, int lane) {
    LAS float* wrT = (LAS float*)lds;
    for (int e = tid; e < 16 * 1024; e += 512) { const int k = e >> 4, x = e & 15; wrT[x * 1024 + k] = w_router[e]; }
    __syncthreads();
    f32x4 wv[4]; load_w4(w2, wv, lane);
    for (int m = gw; m < M; m += NGW) {
        f32x4 v[4]; rms_row_regs(h + (size_t)m * DM, wv, v, lane); store_row_bf16(XN + (size_t)m * DM, v, lane);
        float mine = 0.f;
#pragma unroll 1
        for (int x = 0; x < 16; ++x) { float s = 0.f;
#pragma unroll
            for (int j = 0; j < 4; ++j) { const f32x4 wr = *(const LAS f32x4*)(wrT + x * 1024 + 4 * lane + 256 * j); s += (v[j].x * wr.x + v[j].y * wr.y) + (v[j].z * wr.z + v[j].w * wr.w); }
            s = wave_sum(s); mine = (lane == x) ? s : mine; }
        float mx = mine;
        mx = fmaxf(mx, __shfl_xor(mx, 1)); mx = fmaxf(mx, __shfl_xor(mx, 2)); mx = fmaxf(mx, __shfl_xor(mx, 4)); mx = fmaxf(mx, __shfl_xor(mx, 8));
        const float ex = expf(mine - mx); float den = ex;
        den += __shfl_xor(den, 1); den += __shfl_xor(den, 2); den += __shfl_xor(den, 4); den += __shfl_xor(den, 8);
        if (lane < 16) aff[(size_t)m * 16 + lane] = ex / den;
    }
}

__device__ __forceinline__ void phase_finish(const bf16* og, const bf16* ys, const bf16* gates, const float* gnw, const float* snw, bf16* mixed, int gw, int NGW, int lane) {
    float gw_[16], sw_[16];
#pragma unroll
    for (int c = 0; c < 16; ++c) { gw_[c] = gnw[(16 * lane + c) & 127]; sw_[c] = snw[16 * lane + c]; }
    for (int m = gw; m < M; m += NGW) {
        const bf16x8 o0 = *(const GAS bf16x8*)(og + (size_t)m * 1024 + 16 * lane), o1 = *(const GAS bf16x8*)(og + (size_t)m * 1024 + 16 * lane + 8);
        const bf16x8 y0 = *(const GAS bf16x8*)(ys + (size_t)m * 1024 + 16 * lane), y1 = *(const GAS bf16x8*)(ys + (size_t)m * 1024 + 16 * lane + 8);
        const bf16x8 g0 = *(const GAS bf16x8*)(gates + (size_t)m * 2048 + 16 * lane), g1 = *(const GAS bf16x8*)(gates + (size_t)m * 2048 + 16 * lane + 8);
        const bf16x8 z0 = *(const GAS bf16x8*)(gates + (size_t)m * 2048 + 1024 + 16 * lane), z1 = *(const GAS bf16x8*)(gates + (size_t)m * 2048 + 1024 + 16 * lane + 8);
        float o[16], t[16]; float so = 0.f, st = 0.f;
#pragma unroll
        for (int c = 0; c < 8; ++c) { o[c] = bf2f_s(o0[c]); o[8 + c] = bf2f_s(o1[c]); t[c] = bf2f_s(y0[c]) * silu(bf2f_s(z0[c])); t[8 + c] = bf2f_s(y1[c]) * silu(bf2f_s(z1[c])); }
#pragma unroll
        for (int c = 0; c < 16; ++c) { so += o[c] * o[c]; st += t[c] * t[c]; }
        so += __shfl_xor(so, 1); so += __shfl_xor(so, 2); so += __shfl_xor(so, 4);
        st += __shfl_xor(st, 1); st += __shfl_xor(st, 2); st += __shfl_xor(st, 4); st += __shfl_xor(st, 8); st += __shfl_xor(st, 16);
        const float ro = 1.0f / sqrtf(so * (1.0f / 128.f) + EPS), rt = 1.0f / sqrtf(st * (1.0f / 512.f) + EPS);
        float a[16], b2[16];
#pragma unroll
        for (int c = 0; c < 8; ++c) { a[c] = o[c] * ro * gw_[c] * silu(bf2f_s(g0[c])); a[8 + c] = o[8 + c] * ro * gw_[8 + c] * silu(bf2f_s(g1[c])); }
#pragma unroll
        for (int c = 0; c < 16; ++c) b2[c] = t[c] * rt * sw_[c];
        u32x4 w0, w1, w2, w3;
        w0.x = pkbf(a[0], a[1]); w0.y = pkbf(a[2], a[3]); w0.z = pkbf(a[4], a[5]); w0.w = pkbf(a[6], a[7]);
        w1.x = pkbf(a[8], a[9]); w1.y = pkbf(a[10], a[11]); w1.z = pkbf(a[12], a[13]); w1.w = pkbf(a[14], a[15]);
        w2.x = pkbf(b2[0], b2[1]); w2.y = pkbf(b2[2], b2[3]); w2.z = pkbf(b2[4], b2[5]); w2.w = pkbf(b2[6], b2[7]);
        w3.x = pkbf(b2[8], b2[9]); w3.y = pkbf(b2[10], b2[11]); w3.z = pkbf(b2[12], b2[13]); w3.w = pkbf(b2[14], b2[15]);
        GAS u32x4* mp = (GAS u32x4*)(mixed + (size_t)m * 2048 + 16 * lane);
        mp[0] = w0; mp[1] = w1; mp[128] = w2; mp[129] = w3;
    }
}

__device__ __forceinline__ void phase_topk(LAS unsigned char* lds, const float* aff, int* idx, float* val, int* inv, int be, int tid, int wave, int lane) {
    LAS unsigned* hist = (LAS unsigned*)lds;
    LAS unsigned* ctl = hist + 256;
    LAS unsigned* wsum = hist + 320;
    const int b = be >> 4, e = be & 15;
    unsigned key[16];
#pragma unroll
    for (int i = 0; i < 16; ++i) key[i] = __float_as_uint(aff[((size_t)b * SEQ + tid * 16 + i) * 16 + e]);
    unsigned prefix = 0u, mask = 0u; unsigned krem = CAP;
    for (int pass = 0; pass < 4; ++pass) {
        const int shift = 24 - 8 * pass;
        if (tid < 256) hist[tid] = 0u;
        __syncthreads();
#pragma unroll
        for (int i = 0; i < 16; ++i) if ((key[i] & mask) == prefix) atomicAdd((unsigned*)&hist[(key[i] >> shift) & 255u], 1u);
        __syncthreads();
        if (tid == 0) { unsigned cum = 0u; int d = 255;
            for (; d > 0; --d) { const unsigned c = hist[d]; if (cum + c >= krem) break; cum += c; }
            ctl[0] = prefix | ((unsigned)d << shift); ctl[1] = krem - cum; }
        __syncthreads();
        prefix = ctl[0]; krem = ctl[1]; mask |= 255u << shift;
        __syncthreads();
    }
    const unsigned thr = prefix;
    int ngt = 0, neq = 0;
#pragma unroll
    for (int i = 0; i < 16; ++i) { ngt += key[i] > thr; neq += key[i] == thr; }
    int sg = ngt, sq = neq;
#pragma unroll
    for (int o = 1; o < 64; o <<= 1) { const int a = __shfl_up(sg, o), c = __shfl_up(sq, o); if (lane >= o) { sg += a; sq += c; } }
    if (lane == 63) { wsum[wave] = (unsigned)sg; wsum[8 + wave] = (unsigned)sq; }
    __syncthreads();
    int bg = 0, bq = 0;
#pragma unroll
    for (int w = 0; w < 8; ++w) if (w < wave) { bg += (int)wsum[w]; bq += (int)wsum[8 + w]; }
    int pg = bg + sg - ngt, pq = bq + sq - neq;
#pragma unroll
    for (int i = 0; i < 16; ++i) {
        const int tok = tid * 16 + i; const bool gt = key[i] > thr, eq = key[i] == thr;
        const bool sel = gt || (eq && pq < (int)krem);
        const int slot = pg + (pq < (int)krem ? pq : (int)krem);
        if (sel) { idx[be * CAP + slot] = tok; val[be * CAP + slot] = __uint_as_float(key[i]); }
        inv[((size_t)b * SEQ + tok) * 16 + e] = sel ? slot : -1;
        pg += gt; pq += eq;
    }
    __syncthreads();
}

__device__ __forceinline__ void phase_gather(const bf16* XN, const int* idx, bf16* XG, int gw, int NGW, int lane) {
    for (int r = gw; r < MEXP; r += NGW) {
        const int b = r >> 14; const int tok = idx[r];
        const GAS u32x4* s = (const GAS u32x4*)(XN + ((size_t)b * SEQ + tok) * DM) + lane; GAS u32x4* d = (GAS u32x4*)(XG + (size_t)r * DM) + lane;
        const u32x4 a = s[0], c = s[64]; d[0] = a; d[64] = c;
    }
}

__device__ __forceinline__ void phase_combine(const float* hin, float* hout, const bf16* Y, const int* inv, const float* val, const float* wn, bf16* XN, bool final_, int gw, int NGW, int lane) {
    f32x4 wv[4]; load_w4(wn, wv, lane);
    for (int m = gw; m < M; m += NGW) {
        const int b = m >> 13;
        const GAS f32x4* xr = (const GAS f32x4*)(hin + (size_t)m * DM) + lane; f32x4 v[4];
#pragma unroll
        for (int j = 0; j < 4; ++j) v[j] = xr[64 * j];
        const int myslot = (lane < 16) ? inv[(size_t)m * 16 + lane] : -1;
        for (int e = 0; e < 16; ++e) {
            const int s = __shfl(myslot, e);
            if (s >= 0) {
                const int r = (b * 16 + e) * CAP + s; const float a = val[r];
                const GAS u32x2* yr = (const GAS u32x2*)(Y + (size_t)r * DM) + lane;
#pragma unroll
                for (int j = 0; j < 4; ++j) { const u32x2 t = yr[64 * j];
                    v[j].x += a * __uint_as_float(t.x << 16); v[j].y += a * __uint_as_float(t.x & 0xffff0000u); v[j].z += a * __uint_as_float(t.y << 16); v[j].w += a * __uint_as_float(t.y & 0xffff0000u); }
            }
        }
        float s2 = 0.f;
#pragma unroll
        for (int j = 0; j < 4; ++j) s2 += (v[j].x * v[j].x + v[j].y * v[j].y) + (v[j].z * v[j].z + v[j].w * v[j].w);
        const float rstd = 1.0f / sqrtf(wave_sum(s2) * (1.0f / DM) + EPS);
        GAS f32x4* ho = (GAS f32x4*)(hout + (size_t)m * DM) + lane;
        if (final_) {
#pragma unroll
            for (int j = 0; j < 4; ++j) ho[64 * j] = v[j] * rstd * wv[j];
        } else {
#pragma unroll
            for (int j = 0; j < 4; ++j) ho[64 * j] = v[j];
            f32x4 nv[4];
#pragma unroll
            for (int j = 0; j < 4; ++j) nv[j] = v[j] * rstd * wv[j];
            store_row_bf16(XN + (size_t)m * DM, nv, lane);
        }
    }
}
namespace gdn {
constexpr int CW = 0;
constexpr int SC = CW + 8 * 320 * 4;
constexpr int Q = SC + 1280;
constexpr int K = Q + 64 * 136 * 2;
constexpr int KDT = K + 64 * 136 * 2;
constexpr int VT = KDT + 128 * 72 * 2;
constexpr int T = VT + 64 * 72 * 2;
constexpr int QKD = T + 64 * 72 * 2;
constexpr int ST = QKD + 64 * 72 * 2;
constexpr int TMP = ST + 64 * 136 * 2;
constexpr int RQ = TMP, RK = RQ + 70 * 136 * 2, RV = RK + 70 * 136 * 2, RAW_END = RV + 70 * 72 * 2;
constexpr int AF = TMP, TF = AF + 64 * 68 * 4, XF = TF + 64 * 68 * 4, INV_END = XF + 3 * 16 * 17 * 4;
constexpr int RT = TMP, UT = RT + 64 * 72 * 2, OS = UT + 64 * 72 * 2, ST_END = OS + 64 * 65 * 4;
static_assert(RAW_END <= MISC_OFF && INV_END <= MISC_OFF && ST_END <= MISC_OFF, "gdn LDS map");
}
__device__ __forceinline__ void gdn_chain(LAS unsigned char* lds, int cid, const bf16* raw, const float* scal, const float* conv_w, const float* conv_b,
                                          const float* A_log, const float* dt_bias, bf16* og, int tid, int wave, int lane) {
    using namespace gdn;
    const int dvh = cid & 1, dir = (cid >> 1) & 1, h = (cid >> 2) & 7, b = cid >> 5;
    const int fr = lane & 15, fq = lane >> 4;
    LAS float* cw = (LAS float*)(lds + CW); LAS float* sc = (LAS float*)(lds + SC);
    LAS bf16* q_ = (LAS bf16*)(lds + Q); LAS bf16* k_ = (LAS bf16*)(lds + K); LAS bf16* kdT = (LAS bf16*)(lds + KDT); LAS bf16* vT = (LAS bf16*)(lds + VT);
    LAS bf16* T_ = (LAS bf16*)(lds + T); LAS bf16* QKd = (LAS bf16*)(lds + QKD); LAS bf16* ST_ = (LAS bf16*)(lds + ST);
    LAS bf16* rq = (LAS bf16*)(lds + RQ); LAS bf16* rk = (LAS bf16*)(lds + RK); LAS bf16* rv = (LAS bf16*)(lds + RV);
    LAS float* Af = (LAS float*)(lds + AF); LAS float* Tf = (LAS float*)(lds + TF); LAS float* Xf = (LAS float*)(lds + XF);
    LAS bf16* rT = (LAS bf16*)(lds + RT); LAS bf16* uT = (LAS bf16*)(lds + UT); LAS float* os = (LAS float*)(lds + OS);
    for (int e = tid; e < 8 * 320; e += 512) { const int r = e / 320, c = e % 320;
        const int gch = c < 128 ? h * 128 + c : (c < 256 ? 1024 + h * 128 + (c - 128) : 2048 + h * 128 + dvh * 64 + (c - 256));
        cw[e] = r < 7 ? conv_w[r * CONV_CH + gch] : conv_b[gch]; }
    for (int e = tid; e < 64 * 136 / 2; e += 512) ((LAS unsigned*)ST_)[e] = 0u;
    const float expA = expf(A_log[dir * 8 + h]), dtb = dt_bias[dir * 8 + h];
    f32x4 sacc[4];
#pragma unroll
    for (int nt = 0; nt < 4; ++nt) sacc[nt] = (f32x4){0.f, 0.f, 0.f, 0.f};
    const size_t rowb = (size_t)b * SEQ;
    __syncthreads();
    for (int n = 0; n < NCHUNK; ++n) {
        const int t0 = (dir ? NCHUNK - 1 - n : n) * 64;
        for (int e = tid; e < 70 * 40; e += 512) { const int r = e / 40, p = e % 40; const int t = t0 - 3 + r;
            u32x4 v = (u32x4){0u, 0u, 0u, 0u};
            const int col = p < 16 ? h * 128 + p * 8 : (p < 32 ? 1024 + h * 128 + (p - 16) * 8 : 2048 + h * 128 + dvh * 64 + (p - 32) * 8);
            if (t >= 0 && t < SEQ) v = *(const GAS u32x4*)(raw + (rowb + t) * CONV_CH + col);
            LAS bf16* d = p < 16 ? rq + r * 136 + p * 8 : (p < 32 ? rk + r * 136 + (p - 16) * 8 : rv + r * 72 + (p - 32) * 8);
            *(LAS u32x4*)d = v; }
        if (wave == 0) { const int i = lane; const int t = t0 + (dir ? 63 - i : i);
            const float braw = scal[(rowb + t) * 64 + dir * 8 + h], araw = scal[(rowb + t) * 64 + 16 + dir * 8 + h];
            const float g = -expA * softplus_f(araw + dtb);
            float gc = g;
#pragma unroll
            for (int o = 1; o < 64; o <<= 1) { const float y = __shfl_up(gc, o); if (i >= o) gc += y; }
            const float gl = __shfl(gc, 63);
            sc[i] = sigmoid_f(braw); sc[64 + i] = gc; sc[128 + i] = expf(gc); sc[192 + i] = expf(gl - gc); if (i == 0) sc[256] = expf(gl); }
        __syncthreads();
        { const int i = tid >> 3, cg = tid & 7; const int o = dir ? 63 - i : i;
          float a[16];
          conv16(a, rq + o * 136 + cg * 16, 136, cw + cg * 16, 320);
          float ss = 0.f;
#pragma unroll
          for (int c = 0; c < 16; ++c) { a[c] = silu(a[c]); ss += a[c] * a[c]; }
          ss += __shfl_xor(ss, 1); ss += __shfl_xor(ss, 2); ss += __shfl_xor(ss, 4);
          float rs = (1.0f / sqrtf(ss + EPS)) * 0.08838834764831845f;
          { u32x4 w0, w1; w0.x = pkbf(a[0] * rs, a[1] * rs); w0.y = pkbf(a[2] * rs, a[3] * rs); w0.z = pkbf(a[4] * rs, a[5] * rs); w0.w = pkbf(a[6] * rs, a[7] * rs);
            w1.x = pkbf(a[8] * rs, a[9] * rs); w1.y = pkbf(a[10] * rs, a[11] * rs); w1.z = pkbf(a[12] * rs, a[13] * rs); w1.w = pkbf(a[14] * rs, a[15] * rs);
            *(LAS u32x4*)(q_ + i * 136 + cg * 16) = w0; *(LAS u32x4*)(q_ + i * 136 + cg * 16 + 8) = w1; }
          conv16(a, rk + o * 136 + cg * 16, 136, cw + 128 + cg * 16, 320);
          ss = 0.f;
#pragma unroll
          for (int c = 0; c < 16; ++c) { a[c] = silu(a[c]); ss += a[c] * a[c]; }
          ss += __shfl_xor(ss, 1); ss += __shfl_xor(ss, 2); ss += __shfl_xor(ss, 4);
          rs = 1.0f / sqrtf(ss + EPS);
          { u32x4 w0, w1; w0.x = pkbf(a[0] * rs, a[1] * rs); w0.y = pkbf(a[2] * rs, a[3] * rs); w0.z = pkbf(a[4] * rs, a[5] * rs); w0.w = pkbf(a[6] * rs, a[7] * rs);
            w1.x = pkbf(a[8] * rs, a[9] * rs); w1.y = pkbf(a[10] * rs, a[11] * rs); w1.z = pkbf(a[12] * rs, a[13] * rs); w1.w = pkbf(a[14] * rs, a[15] * rs);
            *(LAS u32x4*)(k_ + i * 136 + cg * 16) = w0; *(LAS u32x4*)(k_ + i * 136 + cg * 16 + 8) = w1; }
          const float ek = sc[192 + i] * rs;
#pragma unroll
          for (int c = 0; c < 16; ++c) kdT[(cg * 16 + c) * 72 + i] = f2bf1(a[c] * ek);
          float v8[8];
          conv8(v8, rv + o * 72 + cg * 8, 72, cw + 256 + cg * 8, 320);
#pragma unroll
          for (int c = 0; c < 8; ++c) vT[(cg * 8 + c) * 72 + i] = f2bf1(silu(v8[c]));
        }
        __syncthreads();
        { const int which = wave >> 2, mt = wave & 3;
          f32x4 acc[1][4];
#pragma unroll
          for (int nt = 0; nt < 4; ++nt) acc[0][nt] = (f32x4){0.f, 0.f, 0.f, 0.f};
          mma_lds<1, 4>(acc, which ? q_ : k_, 136, mt * 16, k_, 136, 0, 128, fr, fq);
#pragma unroll
          for (int nt = 0; nt < 4; ++nt)
#pragma unroll
              for (int r = 0; r < 4; ++r) { const int i = mt * 16 + 4 * fq + r, j = nt * 16 + fr;
                  const float d = expf(fminf(sc[64 + i] - sc[64 + j], 0.f)); const float x = acc[0][nt][r] * d;
                  if (which == 0) Af[i * 68 + j] = (i > j) ? sc[i] * x : 0.f;
                  else QKd[i * 72 + j] = f2bf1((i >= j) ? x : 0.f); }
        }
        __syncthreads();
        if (wave == 0) { const int blk = lane >> 4, c = lane & 15; float t[16];
#pragma unroll
            for (int i = 0; i < 16; ++i) t[i] = (i == c) ? 1.f : 0.f;
#pragma unroll
            for (int i = 1; i < 16; ++i) { float s = 0.f; const LAS float* ar = Af + (blk * 16 + i) * 68 + blk * 16;
#pragma unroll
                for (int j = 0; j < i; ++j) s += ar[j] * t[j];
                t[i] = (i > c) ? -s : t[i];
                if ((i & 3) == 3) asm volatile("" ::: "memory"); }
#pragma unroll
            for (int i = 0; i < 16; ++i) Tf[(blk * 16 + i) * 68 + blk * 16 + c] = t[i]; }
        for (int d = 1; d <= 3; ++d) { const int nbk = 4 - d;
            __syncthreads();
            for (int e = tid; e < nbk * 256; e += 512) { const int J = e >> 8, r = (e >> 4) & 15, c = e & 15, I = J + d; float s = 0.f;
                for (int kk = J * 16; kk < I * 16; ++kk) s += Af[(I * 16 + r) * 68 + kk] * Tf[kk * 68 + J * 16 + c];
                Xf[(J * 16 + r) * 17 + c] = s; }
            __syncthreads();
            for (int e = tid; e < nbk * 256; e += 512) { const int J = e >> 8, r = (e >> 4) & 15, c = e & 15, I = J + d; float s = 0.f;
#pragma unroll
                for (int m2 = 0; m2 < 16; ++m2) s += Tf[(I * 16 + r) * 68 + I * 16 + m2] * Xf[(J * 16 + m2) * 17 + c];
                Tf[(I * 16 + r) * 68 + J * 16 + c] = -s; }
        }
        __syncthreads();
        for (int e = tid; e < 4096; e += 512) { const int i = e >> 6, j = e & 63; T_[i * 72 + j] = f2bf1(((i >> 4) >= (j >> 4)) ? Tf[i * 68 + j] : 0.f); }
        __syncthreads();
        const int mt = wave & 3, nh = wave >> 2;
        f32x4 aq[2];
        { f32x4 ak[2]; ak[0] = ak[1] = aq[0] = aq[1] = (f32x4){0.f, 0.f, 0.f, 0.f};
          for (int k0 = 0; k0 < 128; k0 += 32) {
              const bf16x8 fk = *(const LAS bf16x8*)(k_ + (mt * 16 + fr) * 136 + k0 + fq * 8), fqv = *(const LAS bf16x8*)(q_ + (mt * 16 + fr) * 136 + k0 + fq * 8);
#pragma unroll
              for (int nl = 0; nl < 2; ++nl) { const bf16x8 fb = *(const LAS bf16x8*)(ST_ + (nh * 32 + nl * 16 + fr) * 136 + k0 + fq * 8);
                  ak[nl] = __builtin_amdgcn_mfma_f32_16x16x32_bf16(fk, fb, ak[nl], 0, 0, 0); aq[nl] = __builtin_amdgcn_mfma_f32_16x16x32_bf16(fqv, fb, aq[nl], 0, 0, 0); } }
          const int i0 = mt * 16 + 4 * fq;
          const f32x4 be4 = *(const LAS f32x4*)(sc + i0), eg4 = *(const LAS f32x4*)(sc + 128 + i0);
#pragma unroll
          for (int nl = 0; nl < 2; ++nl) { const int dv = nh * 32 + nl * 16 + fr;
              const bf16x4 vv = *(const LAS bf16x4*)(vT + dv * 72 + i0);
              float r0 = be4[0] * (bf2f_s(vv[0]) - eg4[0] * ak[nl][0]), r1 = be4[1] * (bf2f_s(vv[1]) - eg4[1] * ak[nl][1]);
              float r2 = be4[2] * (bf2f_s(vv[2]) - eg4[2] * ak[nl][2]), r3 = be4[3] * (bf2f_s(vv[3]) - eg4[3] * ak[nl][3]);
              u32x2 w; w.x = pkbf(r0, r1); w.y = pkbf(r2, r3); *(LAS u32x2*)(rT + dv * 72 + i0) = w;
              aq[nl][0] *= eg4[0]; aq[nl][1] *= eg4[1]; aq[nl][2] *= eg4[2]; aq[nl][3] *= eg4[3]; }
        }
        __syncthreads();
        { f32x4 au[1][2]; au[0][0] = au[0][1] = (f32x4){0.f, 0.f, 0.f, 0.f};
          mma_lds<1, 2>(au, T_, 72, mt * 16, rT, 72, nh * 32, 64, fr, fq);
          const int i0 = mt * 16 + 4 * fq;
#pragma unroll
          for (int nl = 0; nl < 2; ++nl) { const int dv = nh * 32 + nl * 16 + fr; u32x2 w; w.x = pkbf(au[0][nl][0], au[0][nl][1]); w.y = pkbf(au[0][nl][2], au[0][nl][3]); *(LAS u32x2*)(uT + dv * 72 + i0) = w; }
        }
        __syncthreads();
        { f32x4 ao[1][2]; ao[0][0] = aq[0]; ao[0][1] = aq[1];
          mma_lds<1, 2>(ao, QKd, 72, mt * 16, uT, 72, nh * 32, 64, fr, fq);
          const int i0 = mt * 16 + 4 * fq;
#pragma unroll
          for (int nl = 0; nl < 2; ++nl)
#pragma unroll
              for (int r = 0; r < 4; ++r) os[(i0 + r) * 65 + nh * 32 + nl * 16 + fr] = ao[0][nl][r];
          const float egl = sc[256];
          f32x4 as_[1][4];
#pragma unroll
          for (int nt = 0; nt < 4; ++nt) as_[0][nt] = sacc[nt] * egl;
          mma_lds<1, 4>(as_, kdT, 72, wave * 16, uT, 72, 0, 64, fr, fq);
#pragma unroll
          for (int nt = 0; nt < 4; ++nt) { sacc[nt] = as_[0][nt];
              u32x2 w; w.x = pkbf(sacc[nt][0], sacc[nt][1]); w.y = pkbf(sacc[nt][2], sacc[nt][3]); *(LAS u32x2*)(ST_ + (nt * 16 + fr) * 136 + wave * 16 + 4 * fq) = w; }
        }
        __syncthreads();
#pragma unroll
        for (int ii = 0; ii < 4; ++ii) { const int i = wave * 8 + 2 * ii + (lane >> 5), cp = lane & 31; const int t = t0 + (dir ? 63 - i : i);
            atomic_add_bf16x2(og + (rowb + t) * 1024 + h * 128 + dvh * 64 + 2 * cp, os[i * 65 + 2 * cp], os[i * 65 + 2 * cp + 1]); }
        __syncthreads();
    }
}

namespace ssd {
constexpr int CW = 0;
constexpr int SC = CW + 8 * 320 * 4;
constexpr int BM_ = SC + 1280;
constexpr int CM_ = BM_ + 64 * 136 * 2;
constexpr int BT = CM_ + 64 * 136 * 2;
constexpr int XDT = BT + 128 * 72 * 2;
constexpr int XDW = XDT + 64 * 72 * 2;
constexpr int MM = XDW + 64 * 72 * 2;
constexpr int HT = MM + 64 * 72 * 2;
constexpr int TMP = HT + 64 * 136 * 2;
constexpr int RX = TMP, RB = RX + 70 * 72 * 2, RC = RB + 70 * 136 * 2, RAW_END = RC + 70 * 136 * 2;
constexpr int OS = TMP, OS_END = OS + 64 * 65 * 4;
static_assert(RAW_END <= MISC_OFF && OS_END <= MISC_OFF, "ssd LDS map");
}
__device__ __forceinline__ void ssd_chain(LAS unsigned char* lds, int cid, const bf16* raw, const float* scal, const float* conv_w, const float* conv_b,
                                          const float* A_log, const float* dt_bias, const float* Dp, bf16* ys, int tid, int wave, int lane) {
    using namespace ssd;
    const int dir = cid & 1, head = (cid >> 1) & 15, b = cid >> 5; const int g = head >> 3;
    const int fr = lane & 15, fq = lane >> 4;
    LAS float* cw = (LAS float*)(lds + CW); LAS float* sc = (LAS float*)(lds + SC);
    LAS bf16* Bm = (LAS bf16*)(lds + BM_); LAS bf16* Cm = (LAS bf16*)(lds + CM_); LAS bf16* BT_ = (LAS bf16*)(lds + BT);
    LAS bf16* xdt = (LAS bf16*)(lds + XDT); LAS bf16* xdw = (LAS bf16*)(lds + XDW); LAS bf16* Mm = (LAS bf16*)(lds + MM); LAS bf16* hT = (LAS bf16*)(lds + HT);
    LAS bf16* rx = (LAS bf16*)(lds + RX); LAS bf16* rb = (LAS bf16*)(lds + RB); LAS bf16* rc = (LAS bf16*)(lds + RC); LAS float* os = (LAS float*)(lds + OS);
    const int chx = 3072 + head * 64, chb = 4096 + g * 128, chc = 4352 + g * 128;
    for (int e = tid; e < 8 * 320; e += 512) { const int r = e / 320, c = e % 320;
        const int gch = c < 64 ? chx + c : (c < 192 ? chb + (c - 64) : chc + (c - 192));
        cw[e] = r < 7 ? conv_w[r * CONV_CH + gch] : conv_b[gch]; }
    for (int e = tid; e < 64 * 136 / 2; e += 512) ((LAS unsigned*)hT)[e] = 0u;
    const float Ah = -expf(A_log[dir * 16 + head]), dtb = dt_bias[dir * 16 + head], Dh = (dir == 0) ? Dp[head] : 0.f;
    f32x4 hacc[4];
#pragma unroll
    for (int nt = 0; nt < 4; ++nt) hacc[nt] = (f32x4){0.f, 0.f, 0.f, 0.f};
    const size_t rowb = (size_t)b * SEQ;
    __syncthreads();
    for (int n = 0; n < NCHUNK; ++n) {
        const int t0 = (dir ? NCHUNK - 1 - n : n) * 64;
        for (int e = tid; e < 70 * 40; e += 512) { const int r = e / 40, p = e % 40; const int t = t0 - 3 + r;
            u32x4 v = (u32x4){0u, 0u, 0u, 0u};
            const int col = p < 8 ? chx + p * 8 : (p < 24 ? chb + (p - 8) * 8 : chc + (p - 24) * 8);
            if (t >= 0 && t < SEQ) v = *(const GAS u32x4*)(raw + (rowb + t) * CONV_CH + col);
            LAS bf16* d = p < 8 ? rx + r * 72 + p * 8 : (p < 24 ? rb + r * 136 + (p - 8) * 8 : rc + r * 136 + (p - 24) * 8);
            *(LAS u32x4*)d = v; }
        if (wave == 0) { const int i = lane; const int t = t0 + (dir ? 63 - i : i);
            const float dt = softplus_f(scal[(rowb + t) * 64 + 32 + dir * 16 + head] + dtb);
            float cs = dt * Ah;
#pragma unroll
            for (int o = 1; o < 64; o <<= 1) { const float y = __shfl_up(cs, o); if (i >= o) cs += y; }
            const float cl = __shfl(cs, 63);
            sc[i] = dt; sc[64 + i] = cs; sc[128 + i] = expf(cs); sc[192 + i] = expf(cl - cs); if (i == 0) sc[256] = expf(cl); }
        __syncthreads();
        { const int i = tid >> 3, cg = tid & 7; const int o = dir ? 63 - i : i;
          float a[16];
          conv16(a, rb + o * 136 + cg * 16, 136, cw + 64 + cg * 16, 320);
#pragma unroll
          for (int c = 0; c < 16; ++c) a[c] = silu(a[c]);
          { u32x4 w0, w1; w0.x = pkbf(a[0], a[1]); w0.y = pkbf(a[2], a[3]); w0.z = pkbf(a[4], a[5]); w0.w = pkbf(a[6], a[7]);
            w1.x = pkbf(a[8], a[9]); w1.y = pkbf(a[10], a[11]); w1.z = pkbf(a[12], a[13]); w1.w = pkbf(a[14], a[15]);
            *(LAS u32x4*)(Bm + i * 136 + cg * 16) = w0; *(LAS u32x4*)(Bm + i * 136 + cg * 16 + 8) = w1; }
#pragma unroll
          for (int c = 0; c < 16; ++c) BT_[(cg * 16 + c) * 72 + i] = f2bf1(a[c]);
          conv16(a, rc + o * 136 + cg * 16, 136, cw + 192 + cg * 16, 320);
#pragma unroll
          for (int c = 0; c < 16; ++c) a[c] = silu(a[c]);
          { u32x4 w0, w1; w0.x = pkbf(a[0], a[1]); w0.y = pkbf(a[2], a[3]); w0.z = pkbf(a[4], a[5]); w0.w = pkbf(a[6], a[7]);
            w1.x = pkbf(a[8], a[9]); w1.y = pkbf(a[10], a[11]); w1.z = pkbf(a[12], a[13]); w1.w = pkbf(a[14], a[15]);
            *(LAS u32x4*)(Cm + i * 136 + cg * 16) = w0; *(LAS u32x4*)(Cm + i * 136 + cg * 16 + 8) = w1; }
          float x8[8];
          conv8(x8, rx + o * 72 + cg * 8, 72, cw + cg * 8, 320);
          const float dt = sc[i], wst = sc[192 + i];
#pragma unroll
          for (int c = 0; c < 8; ++c) { const float xv = silu(x8[c]) * dt; xdt[(cg * 8 + c) * 72 + i] = f2bf1(xv); xdw[(cg * 8 + c) * 72 + i] = f2bf1(xv * wst); }
        }
        __syncthreads();
        const int mt = wave & 3, nh = wave >> 2;
        { f32x4 acc[1][2]; acc[0][0] = acc[0][1] = (f32x4){0.f, 0.f, 0.f, 0.f};
          mma_lds<1, 2>(acc, Cm, 136, mt * 16, Bm, 136, nh * 32, 128, fr, fq);
#pragma unroll
          for (int nl = 0; nl < 2; ++nl)
#pragma unroll
              for (int r = 0; r < 4; ++r) { const int i = mt * 16 + 4 * fq + r, j = nh * 32 + nl * 16 + fr;
                  const float d = expf(fminf(sc[64 + i] - sc[64 + j], 0.f));
                  Mm[i * 72 + j] = f2bf1((i >= j) ? acc[0][nl][r] * d : 0.f); }
        }
        __syncthreads();
        { f32x4 a1[1][2], a2[1][2]; a1[0][0] = a1[0][1] = a2[0][0] = a2[0][1] = (f32x4){0.f, 0.f, 0.f, 0.f};
          mma_lds<1, 2>(a1, Mm, 72, mt * 16, xdt, 72, nh * 32, 64, fr, fq);
          mma_lds<1, 2>(a2, Cm, 136, mt * 16, hT, 136, nh * 32, 128, fr, fq);
          const int i0 = mt * 16 + 4 * fq;
          const f32x4 ec4 = *(const LAS f32x4*)(sc + 128 + i0), dt4 = *(const LAS f32x4*)(sc + i0);
#pragma unroll
          for (int nl = 0; nl < 2; ++nl) { const int p = nh * 32 + nl * 16 + fr; const bf16x4 xv = *(const LAS bf16x4*)(xdt + p * 72 + i0);
#pragma unroll
              for (int r = 0; r < 4; ++r) os[(i0 + r) * 65 + p] = a1[0][nl][r] + ec4[r] * a2[0][nl][r] + Dh * bf2f_s(xv[r]) / dt4[r]; }
        }
        __syncthreads();
        { const float ecl = sc[256];
          f32x4 ah[1][4];
#pragma unroll
          for (int nt = 0; nt < 4; ++nt) ah[0][nt] = hacc[nt] * ecl;
          mma_lds<1, 4>(ah, BT_, 72, wave * 16, xdw, 72, 0, 64, fr, fq);
#pragma unroll
          for (int nt = 0; nt < 4; ++nt) { hacc[nt] = ah[0][nt];
              u32x2 w; w.x = pkbf(hacc[nt][0], hacc[nt][1]); w.y = pkbf(hacc[nt][2], hacc[nt][3]); *(LAS u32x2*)(hT + (nt * 16 + fr) * 136 + wave * 16 + 4 * fq) = w; }
        }
#pragma unroll
        for (int ii = 0; ii < 4; ++ii) { const int i = wave * 8 + 2 * ii + (lane >> 5), cp = lane & 31; const int t = t0 + (dir ? 63 - i : i);
            atomic_add_bf16x2(ys + (rowb + t) * 1024 + head * 64 + 2 * cp, os[i * 65 + 2 * cp], os[i * 65 + 2 * cp + 1]); }
        __syncthreads();
    }
}
#ifndef MK_ONE_LAUNCH
#define MK_ONE_LAUNCH 1
#endif
constexpr int NPHASE = 1 + 11 * DEPTH;
struct Args { const float* in[19]; float* out; unsigned char* ws; int ph_lo, ph_hi; };
__global__ void __launch_bounds__(NWAVES * 64, 2) fwd_kernel(Args args) {
    extern __shared__ __attribute__((aligned(16))) unsigned char lds_raw[];
    LAS unsigned char* lds = (LAS unsigned char*)lds_raw;
    unsigned* ctl = (unsigned*)(args.ws + WS_CTL);
    volatile LAS unsigned* MISC = (volatile LAS unsigned*)(lds + MISC_OFF);
    for (int u = threadIdx.x; u < 64; u += 512) MISC[u] = 0u;
    __syncthreads();
#if MK_ONE_LAUNCH
    XcdBarrier bar = xcd_barrier_post(ctl + CW_BAR, MISC + 8);
#define GRID_BAR() do { XcdBarrier bb_ = bar; asm volatile("" : "+s"(bb_.bar), "+s"(bb_.x)); xcd_barrier(bb_); } while (0)
#else
#define GRID_BAR() do {} while (0)
#endif
    const int lo = args.ph_lo, hi = args.ph_hi;
#define WSP(T, off) ((T*)(wsb + (off)))
    for (int ph = lo; ph < hi; ++ph) {
        int tid = threadIdx.x, bid = blockIdx.x, G = gridDim.x;
        const __attribute__((address_space(4))) Args* ap = (const __attribute__((address_space(4))) Args*)__builtin_amdgcn_kernarg_segment_ptr();
        asm volatile("" : "+v"(tid)); asm volatile("" : "+s"(bid), "+s"(G), "+s"(ap));
        unsigned char* wsb = ap->ws;
        const int lane = tid & 63, wave = __builtin_amdgcn_readfirstlane(tid >> 6);
        const int gw = bid * NWAVES + wave, NGW = G * NWAVES, gtid = bid * 512 + tid, NGT = G * 512;
        const int l = (ph == 0) ? 0 : (ph - 1) / 11; const int k = (ph == 0) ? -1 : (ph - 1) % 11;
        switch (k) {
        case -1: {
            cvt_mixer_weights(lds, wsb, ap->in[2], ap->in[12], gw, NGW, wave, lane);
            phase_norm(ap->in[0], ap->in[1], WSP(bf16, WS_XN), gw, NGW, lane);
            zero_region(wsb + WS_OG, 128 * MiB, gtid, NGT);
        } break;
        case 0: {
            pg8::Gemm g{WSP(bf16, WS_XN), WSP(bf16, WS_WA), M, NWA, DM, 0, 0, 0}; pg8::StaticOrder S; S.init(M, NWA, G, bid);
            pg8::EpiRawA E{WSP(bf16, WS_RAW), WSP(float, WS_SCAL)};
            pg8::gemm_phase<pg8::EpiRawA, pg8::StaticOrder, true, true>(lds, g, S, E);
        } break;
        case 1: {
            const float* cwp = ap->in[3] + (size_t)l * 7 * CONV_CH; const float* cbp = ap->in[4] + (size_t)l * CONV_CH;
            for (int c = bid; c < 256; c += G) {
                if (c < 128) gdn_chain(lds, c, WSP(bf16, WS_RAW), WSP(float, WS_SCAL), cwp, cbp, ap->in[5] + l * 16, ap->in[6] + l * 16, WSP(bf16, WS_OG), tid, wave, lane);
                else ssd_chain(lds, c - 128, WSP(bf16, WS_RAW), WSP(float, WS_SCAL), cwp, cbp, ap->in[8] + l * 32, ap->in[9] + l * 32, ap->in[10] + l * 16, WSP(bf16, WS_YS), tid, wave, lane);
                __syncthreads();
            }
        } break;
        case 2: {
            pg8::Gemm g{WSP(bf16, WS_XN), WSP(bf16, WS_WB), M, NGATE, DM, 0, 0, 0}; pg8::StaticOrder S; S.init(M, NGATE, G, bid);
            pg8::EpiBf16 E{WSP(bf16, WS_GATES), NGATE};
            pg8::gemm_phase<pg8::EpiBf16, pg8::StaticOrder, true, true>(lds, g, S, E);
        } break;
        case 3: {
            phase_finish(WSP(bf16, WS_OG), WSP(bf16, WS_YS), WSP(bf16, WS_GATES), ap->in[7] + l * 128, ap->in[11] + l * 1024, WSP(bf16, WS_MIXED), gw, NGW, lane);
        } break;
        case 4: {
            pg8::Gemm g{WSP(bf16, WS_MIXED), WSP(bf16, WS_WO), M, DM, 2048, 0, 0, 0}; pg8::StaticOrder S; S.init(M, DM, G, bid);
            pg8::EpiResid E{(l == 0) ? ap->in[0] : ap->out, ap->out, DM};
            pg8::gemm_phase<pg8::EpiResid, pg8::StaticOrder, true, true>(lds, g, S, E);
        } break;
        case 5: {
            phase_norm2_router(lds, ap->out, ap->in[13] + l * DM, ap->in[14] + (size_t)l * DM * 16, WSP(bf16, WS_XN), WSP(float, WS_AFF), gw, NGW, tid, lane);
            __syncthreads();
            cvt_expert_weights(lds, wsb, ap->in[15] + (size_t)l * NEXP * DM * EFF, ap->in[16] + (size_t)l * NEXP * DM * EFF, ap->in[17] + (size_t)l * NEXP * EFF * DM, gw, NGW, wave, lane);
            if (l + 1 < DEPTH) { cvt_mixer_weights(lds, wsb, ap->in[2] + (size_t)(l + 1) * DM * 6720, ap->in[12] + (size_t)(l + 1) * 2048 * DM, gw, NGW, wave, lane);
                                 zero_region(wsb + WS_OG, 128 * MiB, gtid, NGT); }
        } break;
        case 6: {
            for (int be = bid; be < NB * NEXP; be += G) phase_topk(lds, WSP(float, WS_AFF), WSP(int, WS_IDX), WSP(float, WS_VAL), WSP(int, WS_INV), be, tid, wave, lane);
        } break;
        case 7: {
            phase_gather(WSP(bf16, WS_XN), WSP(int, WS_IDX), WSP(bf16, WS_XG), gw, NGW, lane);
        } break;
        case 8: {
            pg8::Gemm g{WSP(bf16, WS_XG), WSP(bf16, WS_WGU), MEXP, 1024, DM, 2, 15, (size_t)1024 * 1024 * 2}; pg8::StaticOrder S; S.init(MEXP, 1024, G, bid);
            pg8::EpiSwiglu E{WSP(bf16, WS_HMID), EFF};
            pg8::gemm_phase<pg8::EpiSwiglu, pg8::StaticOrder, true, true>(lds, g, S, E);
        } break;
        case 9: {
            pg8::Gemm g{WSP(bf16, WS_HMID), WSP(bf16, WS_WD), MEXP, 1024, EFF, 2, 15, (size_t)1024 * 512 * 2}; pg8::StaticOrder S; S.init(MEXP, 1024, G, bid);
            pg8::EpiBf16 E{WSP(bf16, WS_XG), 1024};
            pg8::gemm_phase<pg8::EpiBf16, pg8::StaticOrder, true, true>(lds, g, S, E);
        } break;
        default: {
            const bool last = (l + 1 == DEPTH);
            phase_combine(ap->out, ap->out, WSP(bf16, WS_XG), WSP(int, WS_INV), WSP(float, WS_VAL), last ? ap->in[18] : ap->in[1] + (size_t)(l + 1) * DM, WSP(bf16, WS_XN), last, gw, NGW, lane);
        } break;
        }
        if (ph + 1 < hi) GRID_BAR();
    }
#undef WSP
}

extern "C" void kernel_launch(void* const* d_in, const int* in_sizes, int n_in, void* d_out, int out_size, void* d_ws, size_t ws_size, hipStream_t stream) {
    static int grid = 0;
    if (grid == 0) {
        if (n_in != 19 || in_sizes[0] != M * DM || out_size != M * DM || ws_size < WS_END) { fprintf(stderr, "kernel_launch: unexpected shapes (n_in %d, in0 %d, out %d, ws %zu); nothing launched\n", n_in, n_in > 0 ? in_sizes[0] : -1, out_size, ws_size); grid = -1; return; }
        int dev = 0, cus = 0;
        if (hipGetDevice(&dev) != hipSuccess || hipDeviceGetAttribute(&cus, hipDeviceAttributeMultiprocessorCount, dev) != hipSuccess) { grid = -1; return; }
        if (hipFuncSetAttribute((const void*)fwd_kernel, hipFuncAttributeMaxDynamicSharedMemorySize, LDS_BYTES) != hipSuccess) { fprintf(stderr, "kernel_launch: hipFuncSetAttribute failed\n"); grid = -1; return; }
        (void)hipGetLastError();
        grid = cus;
    }
    if (grid < 0) return;
    (void)hipMemsetAsync((char*)d_ws + WS_CTL, 0, CTL_ZERO_BYTES, stream);
    Args a{};
    for (int i = 0; i < 19; ++i) a.in[i] = (const float*)d_in[i];
    a.out = (float*)d_out; a.ws = (unsigned char*)d_ws;
#if MK_ONE_LAUNCH
    a.ph_lo = 0; a.ph_hi = NPHASE;
    hipLaunchKernelGGL(fwd_kernel, dim3(grid), dim3(NWAVES * 64), LDS_BYTES, stream, a);
#else
    for (int p = 0; p < NPHASE; ++p) { a.ph_lo = p; a.ph_hi = p + 1; hipLaunchKernelGGL(fwd_kernel, dim3(grid), dim3(NWAVES * 64), LDS_BYTES, stream, a); }
#endif
}
```

```cpp
#include <hip/hip_runtime.h>
#include <cstdio>
#include <cstdint>
namespace pg8 {
#define PG8_LAS __attribute__((address_space(3)))
typedef unsigned short bf16_t;
typedef short bf16x8 __attribute__((ext_vector_type(8)));
typedef float f32x4 __attribute__((ext_vector_type(4)));
typedef unsigned u32x4 __attribute__((ext_vector_type(4)));
constexpr int BM = 256, BK = 64, HALF = 128, HTB = HALF * BK * 2  , STAGE_BYTES = 8 * HTB, NXCD = 8, WGM = 8;

__host__ __device__ __forceinline__ int lds_byte(int r, int c) { const int st = (r >> 4) * 2 + (c >> 5), rr = r & 15, cc = c & 31, ob = rr * 64 + cc * 2; return st * 1024 + (ob ^ (((ob >> 9) & 1) << 5)); }
__host__ __device__ __forceinline__ void stage_rc(int b, int& R, int& C) { const int st = b / 1024, sb = b % 1024, swz = sb ^ (((sb >> 9) & 1) << 5); R = (st >> 1) * 16 + swz / 64; C = (st & 1) * 32 + (swz % 64) / 2; }
__host__ __device__ __forceinline__ int perm32(int rho) { const int n = rho >> 4, i = rho & 15; return 8 * (i >> 2) + 4 * n + (i & 3); }

struct Unit { int pm, pn; };
struct Gemm { const bf16_t* A; const bf16_t* Bt; int M, N, K; int bshift, bmask; size_t bstride;
    __device__ __forceinline__ size_t grp_off(int pm) const { return (size_t)((pm >> bshift) & bmask) * bstride; } };

struct StaticOrder {
    int nM, nN, nwg, G, c;
    __host__ __device__ void init(int M, int N, int G_, int c_) { nM = M / BM; nN = N / BM; nwg = nM * nN; G = G_; c = c_; }
    __host__ __device__ bool next(int i, Unit& u) const {
        const long L = (long)i * G + c; if (L >= nwg) return false;
        int wgid = (int)L; { const int q = nwg / NXCD, r = nwg % NXCD, xcd = wgid % NXCD, off = wgid / NXCD; wgid = (xcd < r ? xcd * (q + 1) : r * (q + 1) + (xcd - r) * q) + off; }
        const int nig = WGM * nN, gid = wgid / nig, fm = gid * WGM, gsz = (nM - fm) < WGM ? (nM - fm) : WGM;
        u.pm = fm + ((wgid % nig) % gsz); u.pn = (wgid % nig) / gsz; return true;
    }
    __device__ __forceinline__ void a_ready(const Unit&) const {}
    __device__ __forceinline__ void done(const Unit&) const {}
};

__device__ __forceinline__ unsigned cvt_pk_bf16(float lo, float hi) { unsigned r; asm volatile("v_cvt_pk_bf16_f32 %0, %1, %2" : "=v"(r) : "v"(lo), "v"(hi)); return r; }
__device__ __forceinline__ float silu_f(float x) { return x * __builtin_amdgcn_rcpf(1.0f + __builtin_amdgcn_exp2f(-1.4426950408889634f * x)); }
struct EpiBf16 {
    static constexpr bool PERM = true, AFTER_DRAIN = false;
    bf16_t* O; int ldc;
    __device__ __forceinline__ void operator()(const f32x4 (&acc)[2][2][4][2], const Unit& u, int wr, int wc, int fr, int fq) const {
        const int row0 = u.pm * BM + wr * 64 + fr; const int col0 = u.pn * BM + wc * 32 + 8 * fq;
#pragma unroll
        for (int ai = 0; ai < 2; ++ai)
#pragma unroll
            for (int m = 0; m < 4; ++m) { bf16_t* rowp = O + (size_t)(row0 + ai * HALF + m * 16) * ldc + col0;
#pragma unroll
                for (int bj = 0; bj < 2; ++bj) { const f32x4 v0 = acc[ai][bj][m][0], v1 = acc[ai][bj][m][1];
                    u32x4 w; w.x = cvt_pk_bf16(v0[0], v0[1]); w.y = cvt_pk_bf16(v0[2], v0[3]); w.z = cvt_pk_bf16(v1[0], v1[1]); w.w = cvt_pk_bf16(v1[2], v1[3]);
                    *(u32x4*)(rowp + bj * HALF) = w; } }
    }
};
struct EpiRawA {
    static constexpr bool PERM = true, AFTER_DRAIN = false;
    bf16_t* O; float* S;
    __device__ __forceinline__ void operator()(const f32x4 (&acc)[2][2][4][2], const Unit& u, int wr, int wc, int fr, int fq) const {
        const int row0 = u.pm * BM + wr * 64 + fr;
        if (u.pn < 18) {
            const int col0 = u.pn * BM + wc * 32 + 8 * fq;
#pragma unroll
            for (int ai = 0; ai < 2; ++ai)
#pragma unroll
                for (int m = 0; m < 4; ++m) { bf16_t* rowp = O + (size_t)(row0 + ai * HALF + m * 16) * 4608 + col0;
#pragma unroll
                    for (int bj = 0; bj < 2; ++bj) { const f32x4 v0 = acc[ai][bj][m][0], v1 = acc[ai][bj][m][1];
                        u32x4 w; w.x = cvt_pk_bf16(v0[0], v0[1]); w.y = cvt_pk_bf16(v0[2], v0[3]); w.z = cvt_pk_bf16(v1[0], v1[1]); w.w = cvt_pk_bf16(v1[2], v1[3]);
                        *(u32x4*)(rowp + bj * HALF) = w; } }
        } else if (wc < 2) {
            const int col0 = wc * 32 + 8 * fq;
#pragma unroll
            for (int ai = 0; ai < 2; ++ai)
#pragma unroll
                for (int m = 0; m < 4; ++m) { float* sp = S + (size_t)(row0 + ai * HALF + m * 16) * 64 + col0;
                    *(f32x4*)sp = acc[ai][0][m][0]; *(f32x4*)(sp + 4) = acc[ai][0][m][1]; }
        }
    }
};
struct EpiResid {
    static constexpr bool PERM = false, AFTER_DRAIN = false;
    const float* base; float* out; int ldc;
    __device__ __forceinline__ void operator()(const f32x4 (&acc)[2][2][4][2], const Unit& u, int wr, int wc, int fr, int fq) const {
        const int row0 = u.pm * BM + wr * 64 + fr, col0 = u.pn * BM + wc * 32 + 4 * fq;
#pragma unroll
        for (int ai = 0; ai < 2; ++ai)
#pragma unroll
            for (int m = 0; m < 4; ++m) { const size_t off = (size_t)(row0 + ai * HALF + m * 16) * ldc + col0;
#pragma unroll
                for (int bj = 0; bj < 2; ++bj)
#pragma unroll
                    for (int n = 0; n < 2; ++n) { const size_t ix = off + bj * HALF + n * 16; *(f32x4*)(out + ix) = *(const f32x4*)(base + ix) + acc[ai][bj][m][n]; } }
    }
};
struct EpiSwiglu {
    static constexpr bool PERM = true, AFTER_DRAIN = false;
    bf16_t* O; int ldh;
    __device__ __forceinline__ void operator()(const f32x4 (&acc)[2][2][4][2], const Unit& u, int wr, int wc, int fr, int fq) const {
        const int row0 = u.pm * BM + wr * 64 + fr; const int f0 = (u.pn * BM + wc * 32 + 8 * fq) >> 1;
        typedef unsigned u32x2 __attribute__((ext_vector_type(2)));
#pragma unroll
        for (int ai = 0; ai < 2; ++ai)
#pragma unroll
            for (int m = 0; m < 4; ++m) { bf16_t* rowp = O + (size_t)(row0 + ai * HALF + m * 16) * ldh + f0;
#pragma unroll
                for (int bj = 0; bj < 2; ++bj) { const f32x4 v0 = acc[ai][bj][m][0], v1 = acc[ai][bj][m][1];
                    u32x2 w; w.x = cvt_pk_bf16(silu_f(v0[0]) * v0[1], silu_f(v0[2]) * v0[3]); w.y = cvt_pk_bf16(silu_f(v1[0]) * v1[1], silu_f(v1[2]) * v1[3]);
                    *(u32x2*)(rowp + bj * (HALF / 2)) = w; } }
    }
};
template <class Epi, class Sched, bool ALIGN_EPI = false, bool SP2 = false>
__device__ __forceinline__ void gemm_phase(PG8_LAS unsigned char* lds, const Gemm g, const Sched& S, const Epi& E) {
    int tid_o = threadIdx.x; asm volatile("" : "+v"(tid_o));
    const int tid = tid_o, wid = __builtin_amdgcn_readfirstlane(tid >> 6), lane = tid & 63, wr = wid >> 2, wc = wid & 3, fr = lane & 15, fq = lane >> 4;
    const int K = g.K, nt = K / BK;
    unsigned voffA[2], voffB[2];
#pragma unroll
    for (int i = 0; i < 2; ++i) { int R, C; stage_rc(tid * 16 + i * 8192, R, C); const int Rb = Epi::PERM ? ((R & ~31) + perm32(R & 31)) : R;
        voffA[i] = (unsigned)(R * K + C) * 2u; voffB[i] = (unsigned)(Rb * K + C) * 2u; }
    const size_t kstep = (size_t)(BK * 2);
    const size_t hstep = (size_t)HALF * K * 2;
    const size_t tstep = 2 * hstep;
    const unsigned ldsw = (unsigned)wid * 1024u;
    const int aoff = lds_byte(wr * 64 + fr, fq * 8), boff = lds_byte(wc * 32 + fr, fq * 8);
#define PG8_SA(b, h) (((b) * 2 + (h)) * HTB)
#define PG8_SB(b, h) ((4 + (b) * 2 + (h)) * HTB)
#define PG8_STAGE(bufoff, gbase, voff) do { _Pragma("unroll") for (int _i = 0; _i < 2; ++_i) \
        __builtin_amdgcn_global_load_lds((const unsigned*)((const char*)(gbase) + (voff)[_i]), (PG8_LAS unsigned*)(lds + (bufoff) + ldsw + _i * 8192), 16, 0, 0); } while (0)
#define PG8_LDA(dst, b, h) do { _Pragma("unroll") for (int m = 0; m < 4; ++m) _Pragma("unroll") for (int k = 0; k < 2; ++k) dst[m][k] = *(const PG8_LAS bf16x8*)(lds + PG8_SA(b, h) + aoff + m * 2048 + k * 1024); } while (0)
#define PG8_LDB(dst, b, h) do { _Pragma("unroll") for (int n = 0; n < 2; ++n) _Pragma("unroll") for (int k = 0; k < 2; ++k) dst[n][k] = *(const PG8_LAS bf16x8*)(lds + PG8_SB(b, h) + boff + n * 2048 + k * 1024); } while (0)
#define PG8_MMA(ai, bj, At, Bt) do { __builtin_amdgcn_s_setprio(1); _Pragma("unroll") for (int m = 0; m < 4; ++m) _Pragma("unroll") for (int n = 0; n < 2; ++n) _Pragma("unroll") for (int k = 0; k < 2; ++k) \
        acc[ai][bj][m][n] = __builtin_amdgcn_mfma_f32_16x16x32_bf16(Bt[n][k], At[m][k], acc[ai][bj][m][n], 0, 0, 0); __builtin_amdgcn_s_setprio(0); } while (0)
#define PG8_WAIT_V(n) asm volatile("s_waitcnt vmcnt(" #n ")" ::: "memory")
#define PG8_WAIT_L(n) asm volatile("s_waitcnt lgkmcnt(" #n ")" ::: "memory")
#define PG8_BAR __builtin_amdgcn_s_barrier()
#define PG8_SCHED __builtin_amdgcn_sched_barrier(0)
    Unit cur, nxt; int ui = 0;
    if (!S.next(0, cur)) return;
    f32x4 acc[2][2][4][2];
#pragma unroll
    for (int a = 0; a < 2; ++a)
#pragma unroll
        for (int b = 0; b < 2; ++b)
#pragma unroll
            for (int m = 0; m < 4; ++m)
#pragma unroll
                for (int n = 0; n < 2; ++n) acc[a][b][m][n] = (f32x4){0.f, 0.f, 0.f, 0.f};
    bf16x8 At[4][2], B0[2][2], B1[2][2];
    const char* cA = (const char*)g.A + (size_t)cur.pm * tstep; const char* cB = (const char*)g.Bt + g.grp_off(cur.pm) + (size_t)cur.pn * tstep;
    S.a_ready(cur);
    if constexpr (SP2) {
        PG8_STAGE(PG8_SB(0, 0), cB, voffB); PG8_STAGE(PG8_SB(0, 1), cB + hstep, voffB); PG8_STAGE(PG8_SA(0, 0), cA, voffA); PG8_STAGE(PG8_SA(0, 1), cA + hstep, voffA);
        if (wr == 1) PG8_BAR;
        PG8_WAIT_V(2); PG8_BAR;
        PG8_STAGE(PG8_SB(1, 0), cB + kstep, voffB); PG8_STAGE(PG8_SA(1, 0), cA + kstep, voffA); PG8_STAGE(PG8_SB(1, 1), cB + hstep + kstep, voffB);
        PG8_WAIT_V(6); PG8_BAR;
    } else {
        PG8_STAGE(PG8_SB(0, 0), cB, voffB); PG8_STAGE(PG8_SA(0, 0), cA, voffA); PG8_STAGE(PG8_SB(0, 1), cB + hstep, voffB); PG8_STAGE(PG8_SA(0, 1), cA + hstep, voffA);
        if (wr == 1) PG8_BAR;
        PG8_WAIT_V(4); PG8_BAR;
        PG8_STAGE(PG8_SB(1, 0), cB + kstep, voffB); PG8_STAGE(PG8_SA(1, 0), cA + kstep, voffA); PG8_STAGE(PG8_SB(1, 1), cB + hstep + kstep, voffB);
        PG8_WAIT_V(6); PG8_BAR;
    }
    for (;;) {
        const bool has_next = S.next(ui + 1, nxt);
        const char* nA = has_next ? (const char*)g.A + (size_t)nxt.pm * tstep : cA; const char* nB = has_next ? (const char*)g.Bt + g.grp_off(nxt.pm) + (size_t)nxt.pn * tstep : cB;
        for (int t = 0; t < nt; t += 2) {
            const bool last = (t == nt - 2);
            const char* a1 = cA + (size_t)(t + 1) * kstep;
            const char* a2 = last ? nA : cA + (size_t)(t + 2) * kstep; const char* b2 = last ? nB : cB + (size_t)(t + 2) * kstep;
            const char* a3 = a2 + kstep; const char* b3 = b2 + kstep;
            if (last && has_next) S.a_ready(nxt);
            if constexpr (SP2) {
            PG8_LDB(B0, 0, 0); PG8_LDB(B1, 0, 1); PG8_SCHED; PG8_LDA(At, 0, 0); PG8_STAGE(PG8_SA(1, 1), a1 + hstep, voffA);
            PG8_WAIT_V(8); PG8_WAIT_L(0); PG8_BAR; PG8_MMA(0, 0, At, B0); PG8_MMA(0, 1, At, B1); PG8_BAR; PG8_SCHED;
            PG8_LDA(At, 0, 1); PG8_STAGE(PG8_SB(0, 0), b2, voffB); PG8_STAGE(PG8_SB(0, 1), b2 + hstep, voffB); PG8_STAGE(PG8_SA(0, 0), a2, voffA);
            PG8_WAIT_V(8); PG8_WAIT_L(0); PG8_BAR; PG8_MMA(1, 0, At, B0); PG8_MMA(1, 1, At, B1); PG8_BAR; PG8_SCHED;
            PG8_LDB(B0, 1, 0); PG8_LDB(B1, 1, 1); PG8_SCHED; PG8_LDA(At, 1, 0); PG8_STAGE(PG8_SA(0, 1), a2 + hstep, voffA);
            PG8_WAIT_V(8); PG8_WAIT_L(0); PG8_BAR; PG8_MMA(0, 0, At, B0); PG8_MMA(0, 1, At, B1); PG8_BAR; PG8_SCHED;
            PG8_LDA(At, 1, 1); PG8_STAGE(PG8_SB(1, 0), b3, voffB); PG8_STAGE(PG8_SB(1, 1), b3 + hstep, voffB); PG8_STAGE(PG8_SA(1, 0), a3, voffA);
            PG8_WAIT_V(8); PG8_WAIT_L(0); PG8_BAR; PG8_MMA(1, 0, At, B0); PG8_MMA(1, 1, At, B1); PG8_BAR; PG8_SCHED;
            } else {
            PG8_LDB(B0, 0, 0); PG8_SCHED; PG8_LDA(At, 0, 0); PG8_STAGE(PG8_SA(1, 1), a1 + hstep, voffA);
            PG8_WAIT_L(8); PG8_BAR; PG8_WAIT_L(0); PG8_MMA(0, 0, At, B0); PG8_BAR; PG8_SCHED;
            PG8_LDB(B1, 0, 1); PG8_STAGE(PG8_SB(0, 0), b2, voffB);
            PG8_BAR; PG8_WAIT_L(0); PG8_MMA(0, 1, At, B1); PG8_BAR;
            PG8_LDA(At, 0, 1); PG8_STAGE(PG8_SA(0, 0), a2, voffA);
            PG8_BAR; PG8_WAIT_L(0); PG8_MMA(1, 0, At, B0); PG8_BAR; PG8_SCHED;
            PG8_STAGE(PG8_SB(0, 1), b2 + hstep, voffB);
            PG8_WAIT_V(6); PG8_BAR; PG8_MMA(1, 1, At, B1); PG8_BAR;
            PG8_LDB(B0, 1, 0); PG8_SCHED; PG8_LDA(At, 1, 0); PG8_STAGE(PG8_SA(0, 1), a2 + hstep, voffA);
            PG8_WAIT_L(8); PG8_BAR; PG8_WAIT_L(0); PG8_MMA(0, 0, At, B0); PG8_BAR; PG8_SCHED;
            PG8_LDB(B1, 1, 1); PG8_STAGE(PG8_SB(1, 0), b3, voffB);
            PG8_BAR; PG8_WAIT_L(0); PG8_MMA(0, 1, At, B1); PG8_BAR;
            PG8_LDA(At, 1, 1); PG8_STAGE(PG8_SA(1, 0), a3, voffA);
            PG8_BAR; PG8_WAIT_L(0); PG8_MMA(1, 0, At, B0); PG8_BAR; PG8_SCHED;
            PG8_STAGE(PG8_SB(1, 1), b3 + hstep, voffB);
            PG8_WAIT_V(6); PG8_BAR; PG8_MMA(1, 1, At, B1); PG8_BAR;
            }
        }
        if constexpr (ALIGN_EPI) { if (wr == 0) PG8_BAR; }
        if constexpr (!Epi::AFTER_DRAIN) { E(acc, cur, wr, wc, fr, fq); S.done(cur); }
        if (!has_next) break;
#pragma unroll
        for (int a = 0; a < 2; ++a)
#pragma unroll
            for (int b = 0; b < 2; ++b)
#pragma unroll
                for (int m = 0; m < 4; ++m)
#pragma unroll
                    for (int n = 0; n < 2; ++n) acc[a][b][m][n] = (f32x4){0.f, 0.f, 0.f, 0.f};
        cur = nxt; cA = nA; cB = nB; ++ui;
        if constexpr (ALIGN_EPI) { if (wr == 1) PG8_BAR; }
    }
    PG8_WAIT_V(0);
    if constexpr (!ALIGN_EPI) { if (wr == 0) PG8_BAR; }
    PG8_BAR;
    if constexpr (Epi::AFTER_DRAIN) { E.fused(acc, cur, wr, wc, fr, fq, lds, wid, lane); S.done(cur); }
#undef PG8_SA
#undef PG8_SB
#undef PG8_STAGE
#undef PG8_LDA
#undef PG8_LDB
#undef PG8_MMA
#undef PG8_WAIT_V
#undef PG8_WAIT_L
#undef PG8_BAR
#undef PG8_SCHED
}
}
#define GAS __attribute__((address_space(1)))
#define LAS __attribute__((address_space(3)))
typedef unsigned short bf16;
typedef unsigned v4u __attribute__((ext_vector_type(4)));
typedef float f32x4 __attribute__((ext_vector_type(4)));
typedef short bf16x8 __attribute__((ext_vector_type(8)));
typedef GAS unsigned gu32;
typedef GAS unsigned long long gu64;
#define RLX_AGENT __ATOMIC_RELAXED, __HIP_MEMORY_SCOPE_AGENT
#define LDS_WAIT() asm volatile("s_waitcnt lgkmcnt(0)" ::: "memory")
#define VM_WAIT() asm volatile("s_waitcnt vmcnt(0)" ::: "memory")
__device__ __forceinline__ unsigned long long rt() { return __builtin_amdgcn_s_memrealtime(); }
__device__ __forceinline__ unsigned f2bf(float f) { unsigned u = __builtin_bit_cast(unsigned, f); return (u + 0x7fffu + ((u >> 16) & 1u)) >> 16; }
__device__ __forceinline__ unsigned pk2(float lo, float hi) { return f2bf(lo) | (f2bf(hi) << 16); }
#define XB_TMO      128
#define XB_XCNT(j)  (256  + 64 * (j))
#define XB_XSUB(j)  (1280 + 64 * (j))
#define XB_XGEN(j)  (2304 + 64 * (j))
#define XB_TOP      3328
#define XB_TOPGEN   3392
#define XCD_BAR_WORDS 3456
#define XB_SPIN_CAP (1u << 18)

__device__ __forceinline__ unsigned xb_ld(unsigned* p)              { return __hip_atomic_load(p, __ATOMIC_RELAXED, __HIP_MEMORY_SCOPE_AGENT); }
__device__ __forceinline__ unsigned xb_add(unsigned* p, unsigned v) { return __hip_atomic_fetch_add(p, v, __ATOMIC_RELAXED, __HIP_MEMORY_SCOPE_AGENT); }
__device__ __forceinline__ unsigned xb_xcc_id() { return (unsigned)__builtin_amdgcn_s_getreg((3 << 11) | 20) & 0xFu; }
#define XB_SPIN(cond, bar) do { unsigned _sp = 0; while (cond) { __builtin_amdgcn_s_sleep(1); \
    if ((++_sp & 255u) == 0u) { if (xb_ld(&(bar)[XB_TMO])) break; if (_sp > XB_SPIN_CAP) { atomicAdd(&(bar)[XB_TMO], 1u); break; } } } } while (0)

struct XcdBarrier {
    unsigned* bar; unsigned x;
    volatile LAS unsigned* st;
};

__device__ __forceinline__ XcdBarrier xcd_barrier_post(unsigned* bar, volatile LAS unsigned* st) {
    XcdBarrier b; b.bar = bar; b.x = xb_xcc_id(); b.st = st;
    if (threadIdx.x == 0) (void)xb_add(&bar[XB_XCNT(b.x)], 1u);
    return b;
}
__device__ __forceinline__ void xcd_barrier_complete(unsigned* bar, unsigned x, unsigned& nloc, unsigned& nx) {
    const unsigned G = gridDim.x * gridDim.y * gridDim.z;
    unsigned sum, cnt, mine, sp = 0u;
    for (;;) {
        sum = 0u; cnt = 0u; mine = 0u;
#pragma unroll
        for (unsigned j = 0; j < 16; ++j) { const unsigned c = xb_ld(&bar[XB_XCNT(j)]); sum += c; cnt += (c > 0u) ? 1u : 0u; mine = (j == x) ? c : mine; }
        if (sum == G) break;
        __builtin_amdgcn_s_sleep(1);
        if ((++sp & 255u) == 0u) { if (xb_ld(&bar[XB_TMO])) break; if (sp > XB_SPIN_CAP) { atomicAdd(&bar[XB_TMO], 1u); break; } }
    }
    nloc = mine > 0u ? mine : 1u; nx = cnt > 0u ? cnt : 1u;
}

__device__ __forceinline__ void xcd_barrier(const XcdBarrier& b) {
    asm volatile("s_waitcnt vmcnt(0)" ::: "memory");
    __syncthreads();
    if (threadIdx.x == 0) {
        unsigned* bar = b.bar;
        __builtin_amdgcn_s_waitcnt(0);
        unsigned nloc = b.st[0], nx = b.st[1];
        if (nloc == 0u) { xcd_barrier_complete(bar, b.x, nloc, nx); b.st[0] = nloc; b.st[1] = nx; }
        const unsigned old = xb_add(&bar[XB_XSUB(b.x)], 1u);
        const unsigned gen = old / nloc;
        if (old + 1u == (gen + 1u) * nloc) {
            __builtin_amdgcn_fence(__ATOMIC_RELEASE, "agent");
            asm volatile("s_waitcnt vmcnt(0)" ::: "memory");
            const unsigned og = xb_add(&bar[XB_TOP], 1u);
            const unsigned tg = og / nx;
            if (og + 1u == (tg + 1u) * nx) xb_add(&bar[XB_TOPGEN], 1u);
            else XB_SPIN(xb_ld(&bar[XB_TOPGEN]) == tg, bar);
            __builtin_amdgcn_fence(__ATOMIC_ACQUIRE, "agent");
            xb_add(&bar[XB_XGEN(b.x)], 1u);
            asm volatile("s_waitcnt vmcnt(0)" ::: "memory");
        } else {
            XB_SPIN(xb_ld(&bar[XB_XGEN(b.x)]) == gen, bar);
            __builtin_amdgcn_fence(__ATOMIC_ACQUIRE, "agent");
            asm volatile("s_waitcnt vmcnt(0)" ::: "memory");
        }
    }
    __syncthreads();
}
constexpr int NB = 4, SEQ = 8192, DM = 1024, M = NB * SEQ, DEPTH = 2;
constexpr int NCHUNK = SEQ / 64;
constexpr int CONV_CH = 4608, NWA = 4864  , NGATE = 2048, NEXP = 16, EFF = 512, CAP = 1024;
constexpr int MEXP = NB * NEXP * CAP;
constexpr float EPS = 1e-6f;
constexpr int NWAVES = 8;
constexpr size_t MiB = 1u << 20;
constexpr size_t WS_CTL = 0, CTL_ZERO_BYTES = 1 * MiB;
constexpr size_t WS_WA = 1 * MiB;
constexpr size_t WS_WB = 11 * MiB;
constexpr size_t WS_WO = 15 * MiB;
constexpr size_t WS_XN = 19 * MiB;
constexpr size_t WS_RAW = 83 * MiB;
constexpr size_t WS_SCAL = 371 * MiB;
constexpr size_t WS_OG = 19 * MiB;
constexpr size_t WS_YS = 443 * MiB;
constexpr size_t WS_XN2 = 83 * MiB;
constexpr size_t WS_GATES = 147 * MiB;
constexpr size_t WS_MIXED = 275 * MiB;
constexpr size_t WS_WGU = 83 * MiB;
constexpr size_t WS_WD = 115 * MiB;
constexpr size_t WS_XG = 131 * MiB;
constexpr size_t WS_HMID = 259 * MiB;
constexpr size_t WS_AFF = 323 * MiB;
constexpr size_t WS_IDX = 325 * MiB;
constexpr size_t WS_VAL = 326 * MiB;
constexpr size_t WS_INV = 327 * MiB;
constexpr size_t WS_END = 507 * MiB;
constexpr int CW_TMO = 0, CW_BAR = 4096;
constexpr int LDS_BYTES = 163840;
constexpr int MISC_OFF = LDS_BYTES - 256;

typedef short bf16x8 __attribute__((ext_vector_type(8)));
typedef short bf16x4 __attribute__((ext_vector_type(4)));
typedef float f32x4 __attribute__((ext_vector_type(4)));
typedef float f32x2 __attribute__((ext_vector_type(2)));
typedef unsigned u32x4 __attribute__((ext_vector_type(4)));
typedef unsigned u32x2 __attribute__((ext_vector_type(2)));
typedef __bf16 bf16x2_t __attribute__((ext_vector_type(2)));
typedef short s16x2 __attribute__((ext_vector_type(2)));

__device__ __forceinline__ float bf2f(unsigned short v) { return __uint_as_float((unsigned)v << 16); }
__device__ __forceinline__ float bf2f_s(short v) { return __uint_as_float((unsigned)(unsigned short)v << 16); }
__device__ __forceinline__ unsigned pkbf(float lo, float hi) { f32x2 v = {lo, hi}; bf16x2_t b = __builtin_convertvector(v, bf16x2_t); return __builtin_bit_cast(unsigned, b); }
__device__ __forceinline__ unsigned short f2bf1(float f) { return (unsigned short)(pkbf(f, 0.f) & 0xffffu); }
__device__ __forceinline__ float silu(float x) { return x * __builtin_amdgcn_rcpf(1.0f + __builtin_amdgcn_exp2f(-1.4426950408889634f * x)); }
__device__ __forceinline__ float softplus_f(float x) { return x > 20.f ? x : log1pf(expf(x)); }
__device__ __forceinline__ float sigmoid_f(float x) { return 1.0f / (1.0f + expf(-x)); }
__device__ __forceinline__ void atomic_add_bf16x2(bf16* p, float a, float b) {
    (void)__builtin_amdgcn_global_atomic_fadd_v2bf16((GAS s16x2*)p, __builtin_bit_cast(s16x2, pkbf(a, b)));
}
__device__ __forceinline__ float wave_sum(float v) {
#pragma unroll
    for (int o = 1; o < 64; o <<= 1) v += __shfl_xor(v, o);
    return v;
}

template <int MT, int NT>
__device__ __forceinline__ void mma_lds(f32x4 (&acc)[MT][NT], const LAS bf16* A, int lda, int m0, const LAS bf16* Bt, int ldb, int n0, int K, int fr, int fq) {
    for (int k0 = 0; k0 < K; k0 += 32) {
        bf16x8 a[MT], b[NT];
#pragma unroll
        for (int mt = 0; mt < MT; ++mt) a[mt] = *(const LAS bf16x8*)(A + (m0 + mt * 16 + fr) * lda + k0 + fq * 8);
#pragma unroll
        for (int nt = 0; nt < NT; ++nt) b[nt] = *(const LAS bf16x8*)(Bt + (n0 + nt * 16 + fr) * ldb + k0 + fq * 8);
#pragma unroll
        for (int mt = 0; mt < MT; ++mt)
#pragma unroll
            for (int nt = 0; nt < NT; ++nt) acc[mt][nt] = __builtin_amdgcn_mfma_f32_16x16x32_bf16(a[mt], b[nt], acc[mt][nt], 0, 0, 0);
    }
}

__device__ __forceinline__ void conv16(float (&acc)[16], const LAS bf16* src, int ld, const LAS float* cw, int cwld) {
#pragma unroll
    for (int c = 0; c < 16; ++c) acc[c] = cw[7 * cwld + c];
#pragma unroll
    for (int tap = 0; tap < 7; ++tap) {
        const bf16x8 x0 = *(const LAS bf16x8*)(src + tap * ld), x1 = *(const LAS bf16x8*)(src + tap * ld + 8);
        const LAS float* w = cw + tap * cwld;
#pragma unroll
        for (int c = 0; c < 8; ++c) { acc[c] += bf2f_s(x0[c]) * w[c]; acc[8 + c] += bf2f_s(x1[c]) * w[8 + c]; }
        if (tap & 1) asm volatile("" ::: "memory");
    }
}
__device__ __forceinline__ void conv8(float (&acc)[8], const LAS bf16* src, int ld, const LAS float* cw, int cwld) {
#pragma unroll
    for (int c = 0; c < 8; ++c) acc[c] = cw[7 * cwld + c];
#pragma unroll
    for (int tap = 0; tap < 7; ++tap) {
        const bf16x8 x0 = *(const LAS bf16x8*)(src + tap * ld);
        const LAS float* w = cw + tap * cwld;
#pragma unroll
        for (int c = 0; c < 8; ++c) acc[c] += bf2f_s(x0[c]) * w[c];
        if (tap & 1) asm volatile("" ::: "memory");
    }
}

__device__ __forceinline__ void transpose_item(const float* W, int K, int N, int k0, int n0, bf16* WT, int drow0, int rmul, LAS float* scr, int lane) {
#pragma unroll 8
    for (int i = 0; i < 32; ++i) { const int kk = 2 * i + (lane >> 5); scr[kk * 33 + (lane & 31)] = W[(size_t)(k0 + kk) * N + n0 + (lane & 31)]; }
    LDS_WAIT(); asm volatile("" ::: "memory");
    const int c = lane & 7;
#pragma unroll
    for (int j = 0; j < 4; ++j) { const int n = (lane >> 3) + 8 * j; const LAS float* s = scr + (8 * c) * 33 + n;
        u32x4 o; o.x = pkbf(s[0 * 33], s[1 * 33]); o.y = pkbf(s[2 * 33], s[3 * 33]); o.z = pkbf(s[4 * 33], s[5 * 33]); o.w = pkbf(s[6 * 33], s[7 * 33]);
        *(GAS u32x4*)(WT + (size_t)(drow0 + rmul * n) * K + k0 + 8 * c) = o; }
    LDS_WAIT(); asm volatile("" ::: "memory");
}
__device__ __forceinline__ void cvt_mixer_weights(LAS unsigned char* lds, unsigned char* ws, const float* w_in, const float* w_out, int gw, int NGW, int wave, int lane) {
    LAS float* scr = (LAS float*)(lds + wave * 16384);
    bf16* WA = (bf16*)(ws + WS_WA); bf16* WB = (bf16*)(ws + WS_WB); bf16* WO = (bf16*)(ws + WS_WO);
    constexpr int I_IN = 16 * 210, I_OUT = 32 * 32;
    for (int it = gw; it < I_IN + I_OUT; it += NGW) {
        if (it < I_IN) { const int kb = it / 210, nb = it % 210, n0 = nb * 32;
            bf16* dst; int drow;
            if (n0 < 4608) { dst = WA; drow = n0; } else if (n0 < 6656) { dst = WB; drow = n0 - 4608; } else { dst = WA; drow = 4608 + (n0 - 6656); }
            transpose_item(w_in, 1024, 6720, kb * 64, n0, dst, drow, 1, scr, lane);
        } else { const int r = it - I_IN, kb = r / 32, nb = r % 32; transpose_item(w_out, 2048, 1024, kb * 64, nb * 32, WO, nb * 32, 1, scr, lane); }
    }
    for (int r = gw; r < 192; r += NGW) { GAS u32x4* p = (GAS u32x4*)(WA + (size_t)(4672 + r) * 1024) + lane; p[0] = (u32x4){0u, 0u, 0u, 0u}; p[64] = (u32x4){0u, 0u, 0u, 0u}; }
}
__device__ __forceinline__ void cvt_expert_weights(LAS unsigned char* lds, unsigned char* ws, const float* w_gate, const float* w_up, const float* w_down, int gw, int NGW, int wave, int lane) {
    LAS float* scr = (LAS float*)(lds + wave * 16384);
    bf16* WGU = (bf16*)(ws + WS_WGU); bf16* WD = (bf16*)(ws + WS_WD);
    constexpr int I_G = 16 * 16;
    constexpr int I_D = 8 * 32;
    constexpr int PER_E = 2 * I_G + I_D;
    for (int it = gw; it < NEXP * PER_E; it += NGW) {
        const int e = it / PER_E; int r = it % PER_E;
        if (r < 2 * I_G) { const int up = r >= I_G; if (up) r -= I_G; const int kb = r / 16, nb = r % 16;
            transpose_item((up ? w_up : w_gate) + (size_t)e * 1024 * 512, 1024, 512, kb * 64, nb * 32, WGU + (size_t)e * 1024 * 1024, 2 * (nb * 32) + up, 2, scr, lane);
        } else { r -= 2 * I_G; const int kb = r / 32, nb = r % 32;
            transpose_item(w_down + (size_t)e * 512 * 1024, 512, 1024, kb * 64, nb * 32, WD + (size_t)e * 1024 * 512, nb * 32, 1, scr, lane); }
    }
}

__device__ __forceinline__ void rms_row_regs(const float* xrow, const f32x4 (&w)[4], f32x4 (&v)[4], int lane) {
    const GAS f32x4* xr = (const GAS f32x4*)xrow + lane; float s = 0.f;
#pragma unroll
    for (int j = 0; j < 4; ++j) { v[j] = xr[64 * j]; s += (v[j].x * v[j].x + v[j].y * v[j].y) + (v[j].z * v[j].z + v[j].w * v[j].w); }
    const float rstd = 1.0f / sqrtf(wave_sum(s) * (1.0f / DM) + EPS);
#pragma unroll
    for (int j = 0; j < 4; ++j) v[j] = v[j] * rstd * w[j];
}
__device__ __forceinline__ void store_row_bf16(bf16* orow, const f32x4 (&v)[4], int lane) {
    GAS u32x2* o8 = (GAS u32x2*)orow + lane;
#pragma unroll
    for (int j = 0; j < 4; ++j) { u32x2 t; t.x = pkbf(v[j].x, v[j].y); t.y = pkbf(v[j].z, v[j].w); o8[64 * j] = t; }
}
__device__ __forceinline__ void load_w4(const float* w, f32x4 (&wv)[4], int lane) {
#pragma unroll
    for (int j = 0; j < 4; ++j) wv[j] = ((const GAS f32x4*)w)[lane + 64 * j];
}
__device__ __forceinline__ void phase_norm(const float* src, const float* w, bf16* XN, int gw, int NGW, int lane) {
    f32x4 wv[4]; load_w4(w, wv, lane);
    for (int m = gw; m < M; m += NGW) { f32x4 v[4]; rms_row_regs(src + (size_t)m * DM, wv, v, lane); store_row_bf16(XN + (size_t)m * DM, v, lane); }
}
__device__ __forceinline__ void zero_region(unsigned char* p, size_t bytes, int gtid, int NGT) {
    GAS u32x4* q = (GAS u32x4*)p; const size_t n = bytes / 16;
    for (size_t i = gtid; i < n; i += NGT) q[i] = (u32x4){0u, 0u, 0u, 0u};
}

__device__ __forceinline__ void phase_norm2_router(LAS unsigned char* lds, const float* h, const float* w2, const float* w_router, bf16* XN, float* aff, int gw, int NGW, int tid, int lane) {
    LAS float* wrT = (LAS float*)lds;
    for (int e = tid; e < 16 * 1024; e += 512) { const int k = e >> 4, x = e & 15; wrT[x * 1024 + k] = w_router[e]; }
    __syncthreads();
    f32x4 wv[4]; load_w4(w2, wv, lane);
    for (int m = gw; m < M; m += NGW) {
        f32x4 v[4]; rms_row_regs(h + (size_t)m * DM, wv, v, lane); store_row_bf16(XN + (size_t)m * DM, v, lane);
        float mine = 0.f;
#pragma unroll 1
        for (int x = 0; x < 16; ++x) { float s = 0.f;
#pragma unroll
            for (int j = 0; j < 4; ++j) { const f32x4 wr = *(const LAS f32x4*)(wrT + x * 1024 + 4 * lane + 256 * j); s += (v[j].x * wr.x + v[j].y * wr.y) + (v[j].z * wr.z + v[j].w * wr.w); }
            s = wave_sum(s); mine = (lane == x) ? s : mine; }
        float mx = mine;
        mx = fmaxf(mx, __shfl_xor(mx, 1)); mx = fmaxf(mx, __shfl_xor(mx, 2)); mx = fmaxf(mx, __shfl_xor(mx, 4)); mx = fmaxf(mx, __shfl_xor(mx, 8));
        const float ex = expf(mine - mx); float den = ex;
        den += __shfl_xor(den, 1); den += __shfl_xor(den, 2); den += __shfl_xor(den, 4); den += __shfl_xor(den, 8);
        if (lane < 16) aff[(size_t)m * 16 + lane] = ex / den;
    }
}

__device__ __forceinline__ void phase_finish(const bf16* og, const bf16* ys, const bf16* gates, const float* gnw, const float* snw, bf16* mixed, int gw, int NGW, int lane) {
    float gw_[16], sw_[16];
#pragma unroll
    for (int c = 0; c < 16; ++c) { gw_[c] = gnw[(16 * lane + c) & 127]; sw_[c] = snw[16 * lane + c]; }
    for (int m = gw; m < M; m += NGW) {
        const bf16x8 o0 = *(const GAS bf16x8*)(og + (size_t)m * 1024 + 16 * lane), o1 = *(const GAS bf16x8*)(og + (size_t)m * 1024 + 16 * lane + 8);
        const bf16x8 y0 = *(const GAS bf16x8*)(ys + (size_t)m * 1024 + 16 * lane), y1 = *(const GAS bf16x8*)(ys + (size_t)m * 1024 + 16 * lane + 8);
        const bf16x8 g0 = *(const GAS bf16x8*)(gates + (size_t)m * 2048 + 16 * lane), g1 = *(const GAS bf16x8*)(gates + (size_t)m * 2048 + 16 * lane + 8);
        const bf16x8 z0 = *(const GAS bf16x8*)(gates + (size_t)m * 2048 + 1024 + 16 * lane), z1 = *(const GAS bf16x8*)(gates + (size_t)m * 2048 + 1024 + 16 * lane + 8);
        float o[16], t[16]; float so = 0.f, st = 0.f;
#pragma unroll
        for (int c = 0; c < 8; ++c) { o[c] = bf2f_s(o0[c]); o[8 + c] = bf2f_s(o1[c]); t[c] = bf2f_s(y0[c]) * silu(bf2f_s(z0[c])); t[8 + c] = bf2f_s(y1[c]) * silu(bf2f_s(z1[c])); }
#pragma unroll
        for (int c = 0; c < 16; ++c) { so += o[c] * o[c]; st += t[c] * t[c]; }
        so += __shfl_xor(so, 1); so += __shfl_xor(so, 2); so += __shfl_xor(so, 4);
        st += __shfl_xor(st, 1); st += __shfl_xor(st, 2); st += __shfl_xor(st, 4); st += __shfl_xor(st, 8); st += __shfl_xor(st, 16);
        const float ro = 1.0f / sqrtf(so * (1.0f / 128.f) + EPS), rt = 1.0f / sqrtf(st * (1.0f / 512.f) + EPS);
        float a[16], b2[16];
#pragma unroll
        for (int c = 0; c < 8; ++c) { a[c] = o[c] * ro * gw_[c] * silu(bf2f_s(g0[c])); a[8 + c] = o[8 + c] * ro * gw_[8 + c] * silu(bf2f_s(g1[c])); }
#pragma unroll
        for (int c = 0; c < 16; ++c) b2[c] = t[c] * rt * sw_[c];
        u32x4 w0, w1, w2, w3;
        w0.x = pkbf(a[0], a[1]); w0.y = pkbf(a[2], a[3]); w0.z = pkbf(a[4], a[5]); w0.w = pkbf(a[6], a[7]);
        w1.x = pkbf(a[8], a[9]); w1.y = pkbf(a[10], a[11]); w1.z = pkbf(a[12], a[13]); w1.w = pkbf(a[14], a[15]);
        w2.x = pkbf(b2[0], b2[1]); w2.y = pkbf(b2[2], b2[3]); w2.z = pkbf(b2[4], b2[5]); w2.w = pkbf(b2[6], b2[7]);
        w3.x = pkbf(b2[8], b2[9]); w3.y = pkbf(b2[10], b2[11]); w3.z = pkbf(b2[12], b2[13]); w3.w = pkbf(b2[14], b2[15]);
        GAS u32x4* mp = (GAS u32x4*)(mixed + (size_t)m * 2048 + 16 * lane);
        mp[0] = w0; mp[1] = w1; mp[128] = w2; mp[129] = w3;
    }
}

__device__ __forceinline__ void phase_topk(LAS unsigned char* lds, const float* aff, int* idx, float* val, int* inv, int be, int tid, int wave, int lane) {
    LAS unsigned* hist = (LAS unsigned*)lds;
    LAS unsigned* ctl = hist + 256;
    LAS unsigned* wsum = hist + 320;
    const int b = be >> 4, e = be & 15;
    unsigned key[16];
#pragma unroll
    for (int i = 0; i < 16; ++i) key[i] = __float_as_uint(aff[((size_t)b * SEQ + tid * 16 + i) * 16 + e]);
    unsigned prefix = 0u, mask = 0u; unsigned krem = CAP;
    for (int pass = 0; pass < 4; ++pass) {
        const int shift = 24 - 8 * pass;
        if (tid < 256) hist[tid] = 0u;
        __syncthreads();
#pragma unroll
        for (int i = 0; i < 16; ++i) if ((key[i] & mask) == prefix) atomicAdd((unsigned*)&hist[(key[i] >> shift) & 255u], 1u);
        __syncthreads();
        if (tid == 0) { unsigned cum = 0u; int d = 255;
            for (; d > 0; --d) { const unsigned c = hist[d]; if (cum + c >= krem) break; cum += c; }
            ctl[0] = prefix | ((unsigned)d << shift); ctl[1] = krem - cum; }
        __syncthreads();
        prefix = ctl[0]; krem = ctl[1]; mask |= 255u << shift;
        __syncthreads();
    }
    const unsigned thr = prefix;
    int ngt = 0, neq = 0;
#pragma unroll
    for (int i = 0; i < 16; ++i) { ngt += key[i] > thr; neq += key[i] == thr; }
    int sg = ngt, sq = neq;
#pragma unroll
    for (int o = 1; o < 64; o <<= 1) { const int a = __shfl_up(sg, o), c = __shfl_up(sq, o); if (lane >= o) { sg += a; sq += c; } }
    if (lane == 63) { wsum[wave] = (unsigned)sg; wsum[8 + wave] = (unsigned)sq; }
    __syncthreads();
    int bg = 0, bq = 0;
#pragma unroll
    for (int w = 0; w < 8; ++w) if (w < wave) { bg += (int)wsum[w]; bq += (int)wsum[8 + w]; }
    int pg = bg + sg - ngt, pq = bq + sq - neq;
#pragma unroll
    for (int i = 0; i < 16; ++i) {
        const int tok = tid * 16 + i; const bool gt = key[i] > thr, eq = key[i] == thr;
        const bool sel = gt || (eq && pq < (int)krem);
        const int slot = pg + (pq < (int)krem ? pq : (int)krem);
        if (sel) { idx[be * CAP + slot] = tok; val[be * CAP + slot] = __uint_as_float(key[i]); }
        inv[((size_t)b * SEQ + tok) * 16 + e] = sel ? slot : -1;
        pg += gt; pq += eq;
    }
    __syncthreads();
}

__device__ __forceinline__ void phase_gather(const bf16* XN, const int* idx, bf16* XG, int gw, int NGW, int lane) {
    for (int r = gw; r < MEXP; r += NGW) {
        const int b = r >> 14; const int tok = idx[r];
        const GAS u32x4* s = (const GAS u32x4*)(XN + ((size_t)b * SEQ + tok) * DM) + lane; GAS u32x4* d = (GAS u32x4*)(XG + (size_t)r * DM) + lane;
        const u32x4 a = s[0], c = s[64]; d[0] = a; d[64] = c;
    }
}

__device__ __forceinline__ void phase_combine(const float* hin, float* hout, const bf16* Y, const int* inv, const float* val, const float* wn, bf16* XN, bool final_, int gw, int NGW, int lane) {
    f32x4 wv[4]; load_w4(wn, wv, lane);
    for (int m = gw; m < M; m += NGW) {
        const int b = m >> 13;
        const GAS f32x4* xr = (const GAS f32x4*)(hin + (size_t)m * DM) + lane; f32x4 v[4];
#pragma unroll
        for (int j = 0; j < 4; ++j) v[j] = xr[64 * j];
        const int myslot = (lane < 16) ? inv[(size_t)m * 16 + lane] : -1;
        for (int e = 0; e < 16; ++e) {
            const int s = __shfl(myslot, e);
            if (s >= 0) {
                const int r = (b * 16 + e) * CAP + s; const float a = val[r];
                const GAS u32x2* yr = (const GAS u32x2*)(Y + (size_t)r * DM) + lane;
#pragma unroll
                for (int j = 0; j < 4; ++j) { const u32x2 t = yr[64 * j];
                    v[j].x += a * __uint_as_float(t.x << 16); v[j].y += a * __uint_as_float(t.x & 0xffff0000u); v[j].z += a * __uint_as_float(t.y << 16); v[j].w += a * __uint_as_float(t.y & 0xffff0000u); }
            }
        }
        float s2 = 0.f;
#pragma unroll
        for (int j = 0; j < 4; ++j) s2 += (v[j].x * v[j].x + v[j].y * v[j].y) + (v[j].z * v[j].z + v[j].w * v[j].w);
        const float rstd = 1.0f / sqrtf(wave_sum(s2) * (1.0f / DM) + EPS);
        GAS f32x4* ho = (GAS f32x4*)(hout + (size_t)m * DM) + lane;
        if (final_) {
#pragma unroll
            for (int j = 0; j < 4; ++j) ho[64 * j] = v[j] * rstd * wv[j];
        } else {
#pragma unroll
            for (int j = 0; j < 4; ++j) ho[64 * j] = v[j];
            f32x4 nv[4];
#pragma unroll
            for (int j = 0; j < 4; ++j) nv[j] = v[j] * rstd * wv[j];
            store_row_bf16(XN + (size_t)m * DM, nv, lane);
        }
    }
}
namespace gdn {
constexpr int CW = 0;
constexpr int SC = CW + 8 * 320 * 4;
constexpr int Q = SC + 1280;
constexpr int K = Q + 64 * 136 * 2;
constexpr int KDT = K + 64 * 136 * 2;
constexpr int VT = KDT + 128 * 72 * 2;
constexpr int T = VT + 64 * 72 * 2;
constexpr int QKD = T + 64 * 72 * 2;
constexpr int ST = QKD + 64 * 72 * 2;
constexpr int TMP = ST + 64 * 136 * 2;
constexpr int RQ = TMP, RK = RQ + 70 * 136 * 2, RV = RK + 70 * 136 * 2, RAW_END = RV + 70 * 72 * 2;
constexpr int AF = TMP, TF = AF + 64 * 68 * 4, XF = TF + 64 * 68 * 4, INV_END = XF + 3 * 16 * 17 * 4;
constexpr int RT = TMP, UT = RT + 64 * 72 * 2, OS = UT + 64 * 72 * 2, ST_END = OS + 64 * 65 * 4;
static_assert(RAW_END <= MISC_OFF && INV_END <= MISC_OFF && ST_END <= MISC_OFF, "gdn LDS map");
}
__device__ __forceinline__ void gdn_chain(LAS unsigned char* lds, int cid, const bf16* raw, const float* scal, const float* conv_w, const float* conv_b,
                                          const float* A_log, const float* dt_bias, bf16* og, int tid, int wave, int lane) {
    using namespace gdn;
    const int dvh = cid & 1, dir = (cid >> 1) & 1, h = (cid >> 2) & 7, b = cid >> 5;
    const int fr = lane & 15, fq = lane >> 4;
    LAS float* cw = (LAS float*)(lds + CW); LAS float* sc = (LAS float*)(lds + SC);
    LAS bf16* q_ = (LAS bf16*)(lds + Q); LAS bf16* k_ = (LAS bf16*)(lds + K); LAS bf16* kdT = (LAS bf16*)(lds + KDT); LAS bf16* vT = (LAS bf16*)(lds + VT);
    LAS bf16* T_ = (LAS bf16*)(lds + T); LAS bf16* QKd = (LAS bf16*)(lds + QKD); LAS bf16* ST_ = (LAS bf16*)(lds + ST);
    LAS bf16* rq = (LAS bf16*)(lds + RQ); LAS bf16* rk = (LAS bf16*)(lds + RK); LAS bf16* rv = (LAS bf16*)(lds + RV);
    LAS float* Af = (LAS float*)(lds + AF); LAS float* Tf = (LAS float*)(lds + TF); LAS float* Xf = (LAS float*)(lds + XF);
    LAS bf16* rT = (LAS bf16*)(lds + RT); LAS bf16* uT = (LAS bf16*)(lds + UT); LAS float* os = (LAS float*)(lds + OS);
    for (int e = tid; e < 8 * 320; e += 512) { const int r = e / 320, c = e % 320;
        const int gch = c < 128 ? h * 128 + c : (c < 256 ? 1024 + h * 128 + (c - 128) : 2048 + h * 128 + dvh * 64 + (c - 256));
        cw[e] = r < 7 ? conv_w[r * CONV_CH + gch] : conv_b[gch]; }
    for (int e = tid; e < 64 * 136 / 2; e += 512) ((LAS unsigned*)ST_)[e] = 0u;
    const float expA = expf(A_log[dir * 8 + h]), dtb = dt_bias[dir * 8 + h];
    f32x4 sacc[4];
#pragma unroll
    for (int nt = 0; nt < 4; ++nt) sacc[nt] = (f32x4){0.f, 0.f, 0.f, 0.f};
    const size_t rowb = (size_t)b * SEQ;
    __syncthreads();
    for (int n = 0; n < NCHUNK; ++n) {
        const int t0 = (dir ? NCHUNK - 1 - n : n) * 64;
        for (int e = tid; e < 70 * 40; e += 512) { const int r = e / 40, p = e % 40; const int t = t0 - 3 + r;
            u32x4 v = (u32x4){0u, 0u, 0u, 0u};
            const int col = p < 16 ? h * 128 + p * 8 : (p < 32 ? 1024 + h * 128 + (p - 16) * 8 : 2048 + h * 128 + dvh * 64 + (p - 32) * 8);
            if (t >= 0 && t < SEQ) v = *(const GAS u32x4*)(raw + (rowb + t) * CONV_CH + col);
            LAS bf16* d = p < 16 ? rq + r * 136 + p * 8 : (p < 32 ? rk + r * 136 + (p - 16) * 8 : rv + r * 72 + (p - 32) * 8);
            *(LAS u32x4*)d = v; }
        if (wave == 0) { const int i = lane; const int t = t0 + (dir ? 63 - i : i);
            const float braw = scal[(rowb + t) * 64 + dir * 8 + h], araw = scal[(rowb + t) * 64 + 16 + dir * 8 + h];
            const float g = -expA * softplus_f(araw + dtb);
            float gc = g;
#pragma unroll
            for (int o = 1; o < 64; o <<= 1) { const float y = __shfl_up(gc, o); if (i >= o) gc += y; }
            const float gl = __shfl(gc, 63);
            sc[i] = sigmoid_f(braw); sc[64 + i] = gc; sc[128 + i] = expf(gc); sc[192 + i] = expf(gl - gc); if (i == 0) sc[256] = expf(gl); }
        __syncthreads();
        { const int i = tid >> 3, cg = tid & 7; const int o = dir ? 63 - i : i;
          float a[16];
          conv16(a, rq + o * 136 + cg * 16, 136, cw + cg * 16, 320);
          float ss = 0.f;
#pragma unroll
          for (int c = 0; c < 16; ++c) { a[c] = silu(a[c]); ss += a[c] * a[c]; }
          ss += __shfl_xor(ss, 1); ss += __shfl_xor(ss, 2); ss += __shfl_xor(ss, 4);
          float rs = (1.0f / sqrtf(ss + EPS)) * 0.08838834764831845f;
          { u32x4 w0, w1; w0.x = pkbf(a[0] * rs, a[1] * rs); w0.y = pkbf(a[2] * rs, a[3] * rs); w0.z = pkbf(a[4] * rs, a[5] * rs); w0.w = pkbf(a[6] * rs, a[7] * rs);
            w1.x = pkbf(a[8] * rs, a[9] * rs); w1.y = pkbf(a[10] * rs, a[11] * rs); w1.z = pkbf(a[12] * rs, a[13] * rs); w1.w = pkbf(a[14] * rs, a[15] * rs);
            *(LAS u32x4*)(q_ + i * 136 + cg * 16) = w0; *(LAS u32x4*)(q_ + i * 136 + cg * 16 + 8) = w1; }
          conv16(a, rk + o * 136 + cg * 16, 136, cw + 128 + cg * 16, 320);
          ss = 0.f;
#pragma unroll
          for (int c = 0; c < 16; ++c) { a[c] = silu(a[c]); ss += a[c] * a[c]; }
          ss += __shfl_xor(ss, 1); ss += __shfl_xor(ss, 2); ss += __shfl_xor(ss, 4);
          rs = 1.0f / sqrtf(ss + EPS);
          { u32x4 w0, w1; w0.x = pkbf(a[0] * rs, a[1] * rs); w0.y = pkbf(a[2] * rs, a[3] * rs); w0.z = pkbf(a[4] * rs, a[5] * rs); w0.w = pkbf(a[6] * rs, a[7] * rs);
            w1.x = pkbf(a[8] * rs, a[9] * rs); w1.y = pkbf(a[10] * rs, a[11] * rs); w1.z = pkbf(a[12] * rs, a[13] * rs); w1.w = pkbf(a[14] * rs, a[15] * rs);
            *(LAS u32x4*)(k_ + i * 136 + cg * 16) = w0; *(LAS u32x4*)(k_ + i * 136 + cg * 16 + 8) = w1; }
          const float ek = sc[192 + i] * rs;
#pragma unroll
          for (int c = 0; c < 16; ++c) kdT[(cg * 16 + c) * 72 + i] = f2bf1(a[c] * ek);
          float v8[8];
          conv8(v8, rv + o * 72 + cg * 8, 72, cw + 256 + cg * 8, 320);
#pragma unroll
          for (int c = 0; c < 8; ++c) vT[(cg * 8 + c) * 72 + i] = f2bf1(silu(v8[c]));
        }
        __syncthreads();
        { const int which = wave >> 2, mt = wave & 3;
          f32x4 acc[1][4];
#pragma unroll
          for (int nt = 0; nt < 4; ++nt) acc[0][nt] = (f32x4){0.f, 0.f, 0.f, 0.f};
          mma_lds<1, 4>(acc, which ? q_ : k_, 136, mt * 16, k_, 136, 0, 128, fr, fq);
#pragma unroll
          for (int nt = 0; nt < 4; ++nt)
#pragma unroll
              for (int r = 0; r < 4; ++r) { const int i = mt * 16 + 4 * fq + r, j = nt * 16 + fr;
                  const float d = expf(fminf(sc[64 + i] - sc[64 + j], 0.f)); const float x = acc[0][nt][r] * d;
                  if (which == 0) Af[i * 68 + j] = (i > j) ? sc[i] * x : 0.f;
                  else QKd[i * 72 + j] = f2bf1((i >= j) ? x : 0.f); }
        }
        __syncthreads();
        if (wave == 0) { const int blk = lane >> 4, c = lane & 15; float t[16];
#pragma unroll
            for (int i = 0; i < 16; ++i) t[i] = (i == c) ? 1.f : 0.f;
#pragma unroll
            for (int i = 1; i < 16; ++i) { float s = 0.f; const LAS float* ar = Af + (blk * 16 + i) * 68 + blk * 16;
#pragma unroll
                for (int j = 0; j < i; ++j) s += ar[j] * t[j];
                t[i] = (i > c) ? -s : t[i];
                if ((i & 3) == 3) asm volatile("" ::: "memory"); }
#pragma unroll
            for (int i = 0; i < 16; ++i) Tf[(blk * 16 + i) * 68 + blk * 16 + c] = t[i]; }
        for (int d = 1; d <= 3; ++d) { const int nbk = 4 - d;
            __syncthreads();
            for (int e = tid; e < nbk * 256; e += 512) { const int J = e >> 8, r = (e >> 4) & 15, c = e & 15, I = J + d; float s = 0.f;
                for (int kk = J * 16; kk < I * 16; ++kk) s += Af[(I * 16 + r) * 68 + kk] * Tf[kk * 68 + J * 16 + c];
                Xf[(J * 16 + r) * 17 + c] = s; }
            __syncthreads();
            for (int e = tid; e < nbk * 256; e += 512) { const int J = e >> 8, r = (e >> 4) & 15, c = e & 15, I = J + d; float s = 0.f;
#pragma unroll
                for (int m2 = 0; m2 < 16; ++m2) s += Tf[(I * 16 + r) * 68 + I * 16 + m2] * Xf[(J * 16 + m2) * 17 + c];
                Tf[(I * 16 + r) * 68 + J * 16 + c] = -s; }
        }
        __syncthreads();
        for (int e = tid; e < 4096; e += 512) { const int i = e >> 6, j = e & 63; T_[i * 72 + j] = f2bf1(((i >> 4) >= (j >> 4)) ? Tf[i * 68 + j] : 0.f); }
        __syncthreads();
        const int mt = wave & 3, nh = wave >> 2;
        f32x4 aq[2];
        { f32x4 ak[2]; ak[0] = ak[1] = aq[0] = aq[1] = (f32x4){0.f, 0.f, 0.f, 0.f};
          for (int k0 = 0; k0 < 128; k0 += 32) {
              const bf16x8 fk = *(const LAS bf16x8*)(k_ + (mt * 16 + fr) * 136 + k0 + fq * 8), fqv = *(const LAS bf16x8*)(q_ + (mt * 16 + fr) * 136 + k0 + fq * 8);
#pragma unroll
              for (int nl = 0; nl < 2; ++nl) { const bf16x8 fb = *(const LAS bf16x8*)(ST_ + (nh * 32 + nl * 16 + fr) * 136 + k0 + fq * 8);
                  ak[nl] = __builtin_amdgcn_mfma_f32_16x16x32_bf16(fk, fb, ak[nl], 0, 0, 0); aq[nl] = __builtin_amdgcn_mfma_f32_16x16x32_bf16(fqv, fb, aq[nl], 0, 0, 0); } }
          const int i0 = mt * 16 + 4 * fq;
          const f32x4 be4 = *(const LAS f32x4*)(sc + i0), eg4 = *(const LAS f32x4*)(sc + 128 + i0);
#pragma unroll
          for (int nl = 0; nl < 2; ++nl) { const int dv = nh * 32 + nl * 16 + fr;
              const bf16x4 vv = *(const LAS bf16x4*)(vT + dv * 72 + i0);
              float r0 = be4[0] * (bf2f_s(vv[0]) - eg4[0] * ak[nl][0]), r1 = be4[1] * (bf2f_s(vv[1]) - eg4[1] * ak[nl][1]);
              float r2 = be4[2] * (bf2f_s(vv[2]) - eg4[2] * ak[nl][2]), r3 = be4[3] * (bf2f_s(vv[3]) - eg4[3] * ak[nl][3]);
              u32x2 w; w.x = pkbf(r0, r1); w.y = pkbf(r2, r3); *(LAS u32x2*)(rT + dv * 72 + i0) = w;
              aq[nl][0] *= eg4[0]; aq[nl][1] *= eg4[1]; aq[nl][2] *= eg4[2]; aq[nl][3] *= eg4[3]; }
        }
        __syncthreads();
        { f32x4 au[1][2]; au[0][0] = au[0][1] = (f32x4){0.f, 0.f, 0.f, 0.f};
          mma_lds<1, 2>(au, T_, 72, mt * 16, rT, 72, nh * 32, 64, fr, fq);
          const int i0 = mt * 16 + 4 * fq;
#pragma unroll
          for (int nl = 0; nl < 2; ++nl) { const int dv = nh * 32 + nl * 16 + fr; u32x2 w; w.x = pkbf(au[0][nl][0], au[0][nl][1]); w.y = pkbf(au[0][nl][2], au[0][nl][3]); *(LAS u32x2*)(uT + dv * 72 + i0) = w; }
        }
        __syncthreads();
        { f32x4 ao[1][2]; ao[0][0] = aq[0]; ao[0][1] = aq[1];
          mma_lds<1, 2>(ao, QKd, 72, mt * 16, uT, 72, nh * 32, 64, fr, fq);
          const int i0 = mt * 16 + 4 * fq;
#pragma unroll
          for (int nl = 0; nl < 2; ++nl)
#pragma unroll
              for (int r = 0; r < 4; ++r) os[(i0 + r) * 65 + nh * 32 + nl * 16 + fr] = ao[0][nl][r];
          const float egl = sc[256];
          f32x4 as_[1][4];
#pragma unroll
          for (int nt = 0; nt < 4; ++nt) as_[0][nt] = sacc[nt] * egl;
          mma_lds<1, 4>(as_, kdT, 72, wave * 16, uT, 72, 0, 64, fr, fq);
#pragma unroll
          for (int nt = 0; nt < 4; ++nt) { sacc[nt] = as_[0][nt];
              u32x2 w; w.x = pkbf(sacc[nt][0], sacc[nt][1]); w.y = pkbf(sacc[nt][2], sacc[nt][3]); *(LAS u32x2*)(ST_ + (nt * 16 + fr) * 136 + wave * 16 + 4 * fq) = w; }
        }
        __syncthreads();
#pragma unroll
        for (int ii = 0; ii < 4; ++ii) { const int i = wave * 8 + 2 * ii + (lane >> 5), cp = lane & 31; const int t = t0 + (dir ? 63 - i : i);
            atomic_add_bf16x2(og + (rowb + t) * 1024 + h * 128 + dvh * 64 + 2 * cp, os[i * 65 + 2 * cp], os[i * 65 + 2 * cp + 1]); }
        __syncthreads();
    }
}

namespace ssd {
constexpr int CW = 0;
constexpr int SC = CW + 8 * 320 * 4;
constexpr int BM_ = SC + 1280;
constexpr int CM_ = BM_ + 64 * 136 * 2;
constexpr int BT = CM_ + 64 * 136 * 2;
constexpr int XDT = BT + 128 * 72 * 2;
constexpr int XDW = XDT + 64 * 72 * 2;
constexpr int MM = XDW + 64 * 72 * 2;
constexpr int HT = MM + 64 * 72 * 2;
constexpr int TMP = HT + 64 * 136 * 2;
constexpr int RX = TMP, RB = RX + 70 * 72 * 2, RC = RB + 70 * 136 * 2, RAW_END = RC + 70 * 136 * 2;
constexpr int OS = TMP, OS_END = OS + 64 * 65 * 4;
static_assert(RAW_END <= MISC_OFF && OS_END <= MISC_OFF, "ssd LDS map");
}
__device__ __forceinline__ void ssd_chain(LAS unsigned char* lds, int cid, const bf16* raw, const float* scal, const float* conv_w, const float* conv_b,
                                          const float* A_log, const float* dt_bias, const float* Dp, bf16* ys, int tid, int wave, int lane) {
    using namespace ssd;
    const int dir = cid & 1, head = (cid >> 1) & 15, b = cid >> 5; const int g = head >> 3;
    const int fr = lane & 15, fq = lane >> 4;
    LAS float* cw = (LAS float*)(lds + CW); LAS float* sc = (LAS float*)(lds + SC);
    LAS bf16* Bm = (LAS bf16*)(lds + BM_); LAS bf16* Cm = (LAS bf16*)(lds + CM_); LAS bf16* BT_ = (LAS bf16*)(lds + BT);
    LAS bf16* xdt = (LAS bf16*)(lds + XDT); LAS bf16* xdw = (LAS bf16*)(lds + XDW); LAS bf16* Mm = (LAS bf16*)(lds + MM); LAS bf16* hT = (LAS bf16*)(lds + HT);
    LAS bf16* rx = (LAS bf16*)(lds + RX); LAS bf16* rb = (LAS bf16*)(lds + RB); LAS bf16* rc = (LAS bf16*)(lds + RC); LAS float* os = (LAS float*)(lds + OS);
    const int chx = 3072 + head * 64, chb = 4096 + g * 128, chc = 4352 + g * 128;
    for (int e = tid; e < 8 * 320; e += 512) { const int r = e / 320, c = e % 320;
        const int gch = c < 64 ? chx + c : (c < 192 ? chb + (c - 64) : chc + (c - 192));
        cw[e] = r < 7 ? conv_w[r * CONV_CH + gch] : conv_b[gch]; }
    for (int e = tid; e < 64 * 136 / 2; e += 512) ((LAS unsigned*)hT)[e] = 0u;
    const float Ah = -expf(A_log[dir * 16 + head]), dtb = dt_bias[dir * 16 + head], Dh = (dir == 0) ? Dp[head] : 0.f;
    f32x4 hacc[4];
#pragma unroll
    for (int nt = 0; nt < 4; ++nt) hacc[nt] = (f32x4){0.f, 0.f, 0.f, 0.f};
    const size_t rowb = (size_t)b * SEQ;
    __syncthreads();
    for (int n = 0; n < NCHUNK; ++n) {
        const int t0 = (dir ? NCHUNK - 1 - n : n) * 64;
        for (int e = tid; e < 70 * 40; e += 512) { const int r = e / 40, p = e % 40; const int t = t0 - 3 + r;
            u32x4 v = (u32x4){0u, 0u, 0u, 0u};
            const int col = p < 8 ? chx + p * 8 : (p < 24 ? chb + (p - 8) * 8 : chc + (p - 24) * 8);
            if (t >= 0 && t < SEQ) v = *(const GAS u32x4*)(raw + (rowb + t) * CONV_CH + col);
            LAS bf16* d = p < 8 ? rx + r * 72 + p * 8 : (p < 24 ? rb + r * 136 + (p - 8) * 8 : rc + r * 136 + (p - 24) * 8);
            *(LAS u32x4*)d = v; }
        if (wave == 0) { const int i = lane; const int t = t0 + (dir ? 63 - i : i);
            const float dt = softplus_f(scal[(rowb + t) * 64 + 32 + dir * 16 + head] + dtb);
            float cs = dt * Ah;
#pragma unroll
            for (int o = 1; o < 64; o <<= 1) { const float y = __shfl_up(cs, o); if (i >= o) cs += y; }
            const float cl = __shfl(cs, 63);
            sc[i] = dt; sc[64 + i] = cs; sc[128 + i] = expf(cs); sc[192 + i] = expf(cl - cs); if (i == 0) sc[256] = expf(cl); }
        __syncthreads();
        { const int i = tid >> 3, cg = tid & 7; const int o = dir ? 63 - i : i;
          float a[16];
          conv16(a, rb + o * 136 + cg * 16, 136, cw + 64 + cg * 16, 320);
#pragma unroll
          for (int c = 0; c < 16; ++c) a[c] = silu(a[c]);
          { u32x4 w0, w1; w0.x = pkbf(a[0], a[1]); w0.y = pkbf(a[2], a[3]); w0.z = pkbf(a[4], a[5]); w0.w = pkbf(a[6], a[7]);
            w1.x = pkbf(a[8], a[9]); w1.y = pkbf(a[10], a[11]); w1.z = pkbf(a[12], a[13]); w1.w = pkbf(a[14], a[15]);
            *(LAS u32x4*)(Bm + i * 136 + cg * 16) = w0; *(LAS u32x4*)(Bm + i * 136 + cg * 16 + 8) = w1; }
#pragma unroll
          for (int c = 0; c < 16; ++c) BT_[(cg * 16 + c) * 72 + i] = f2bf1(a[c]);
          conv16(a, rc + o * 136 + cg * 16, 136, cw + 192 + cg * 16, 320);
#pragma unroll
          for (int c = 0; c < 16; ++c) a[c] = silu(a[c]);
          { u32x4 w0, w1; w0.x = pkbf(a[0], a[1]); w0.y = pkbf(a[2], a[3]); w0.z = pkbf(a[4], a[5]); w0.w = pkbf(a[6], a[7]);
            w1.x = pkbf(a[8], a[9]); w1.y = pkbf(a[10], a[11]); w1.z = pkbf(a[12], a[13]); w1.w = pkbf(a[14], a[15]);
            *(LAS u32x4*)(Cm + i * 136 + cg * 16) = w0; *(LAS u32x4*)(Cm + i * 136 + cg * 16 + 8) = w1; }
          float x8[8];
          conv8(x8, rx + o * 72 + cg * 8, 72, cw + cg * 8, 320);
          const float dt = sc[i], wst = sc[192 + i];
#pragma unroll
          for (int c = 0; c < 8; ++c) { const float xv = silu(x8[c]) * dt; xdt[(cg * 8 + c) * 72 + i] = f2bf1(xv); xdw[(cg * 8 + c) * 72 + i] = f2bf1(xv * wst); }
        }
        __syncthreads();
        const int mt = wave & 3, nh = wave >> 2;
        { f32x4 acc[1][2]; acc[0][0] = acc[0][1] = (f32x4){0.f, 0.f, 0.f, 0.f};
          mma_lds<1, 2>(acc, Cm, 136, mt * 16, Bm, 136, nh * 32, 128, fr, fq);
#pragma unroll
          for (int nl = 0; nl < 2; ++nl)
#pragma unroll
              for (int r = 0; r < 4; ++r) { const int i = mt * 16 + 4 * fq + r, j = nh * 32 + nl * 16 + fr;
                  const float d = expf(fminf(sc[64 + i] - sc[64 + j], 0.f));
                  Mm[i * 72 + j] = f2bf1((i >= j) ? acc[0][nl][r] * d : 0.f); }
        }
        __syncthreads();
        { f32x4 a1[1][2], a2[1][2]; a1[0][0] = a1[0][1] = a2[0][0] = a2[0][1] = (f32x4){0.f, 0.f, 0.f, 0.f};
          mma_lds<1, 2>(a1, Mm, 72, mt * 16, xdt, 72, nh * 32, 64, fr, fq);
          mma_lds<1, 2>(a2, Cm, 136, mt * 16, hT, 136, nh * 32, 128, fr, fq);
          const int i0 = mt * 16 + 4 * fq;
          const f32x4 ec4 = *(const LAS f32x4*)(sc + 128 + i0), dt4 = *(const LAS f32x4*)(sc + i0);
#pragma unroll
          for (int nl = 0; nl < 2; ++nl) { const int p = nh * 32 + nl * 16 + fr; const bf16x4 xv = *(const LAS bf16x4*)(xdt + p * 72 + i0);
#pragma unroll
              for (int r = 0; r < 4; ++r) os[(i0 + r) * 65 + p] = a1[0][nl][r] + ec4[r] * a2[0][nl][r] + Dh * bf2f_s(xv[r]) / dt4[r]; }
        }
        __syncthreads();
        { const float ecl = sc[256];
          f32x4 ah[1][4];
#pragma unroll
          for (int nt = 0; nt < 4; ++nt) ah[0][nt] = hacc[nt] * ecl;
          mma_lds<1, 4>(ah, BT_, 72, wave * 16, xdw, 72, 0, 64, fr, fq);
#pragma unroll
          for (int nt = 0; nt < 4; ++nt) { hacc[nt] = ah[0][nt];
              u32x2 w; w.x = pkbf(hacc[nt][0], hacc[nt][1]); w.y = pkbf(hacc[nt][2], hacc[nt][3]); *(LAS u32x2*)(hT + (nt * 16 + fr) * 136 + wave * 16 + 4 * fq) = w; }
        }
#pragma unroll
        for (int ii = 0; ii < 4; ++ii) { const int i = wave * 8 + 2 * ii + (lane >> 5), cp = lane & 31; const int t = t0 + (dir ? 63 - i : i);
            atomic_add_bf16x2(ys + (rowb + t) * 1024 + head * 64 + 2 * cp, os[i * 65 + 2 * cp], os[i * 65 + 2 * cp + 1]); }
        __syncthreads();
    }
}
namespace pgd {
constexpr int CW = 0;
constexpr int SC = CW + 8 * 384 * 4;
constexpr int Q = SC + 1280;
constexpr int K = Q + 64 * 136 * 2;
constexpr int VT = K + 64 * 136 * 2;
constexpr int TMP = VT + 128 * 72 * 2;
constexpr int RQ = TMP, RK = RQ + 70 * 136 * 2, RV = RK + 70 * 136 * 2, RAW_END = RV + 70 * 136 * 2;
constexpr int AF = TMP, A2F = AF + 64 * 68 * 4, TF = A2F + 64 * 68 * 4, T2F = TF + 64 * 68 * 4, XF = T2F + 64 * 68 * 4, QKP = XF + 2 * 3 * 16 * 17 * 4, INV_END = QKP + 64 * 72 * 2;
constexpr int TP = AF;
constexpr int STASH = MISC_OFF - 8192;
static_assert(RAW_END <= STASH && INV_END <= STASH, "prep gdn LDS map");
}
constexpr size_t WS_TQ = 379 * MiB;

__device__ __forceinline__ void prep_gdn_stash(LAS unsigned char* lds, int bid, const bf16* raw, int tid) {
    const int bh = bid >> 3, b = bh >> 3, h = bh & 7, r8 = bid & 7;
    LAS bf16* st = (LAS bf16*)(lds + pgd::STASH);
    for (int e = tid; e < 2 * 3 * 48; e += 512) { const int which = e / 144, r = (e % 144) / 48, p = e % 48;
        const int t = which ? (r8 * 16 + 16) * 64 + r : r8 * 16 * 64 - 3 + r;
        const int col = p < 16 ? h * 128 + p * 8 : (p < 32 ? 1024 + h * 128 + (p - 16) * 8 : 2048 + h * 128 + (p - 32) * 8);
        u32x4 v = (u32x4){0u, 0u, 0u, 0u};
        if (t >= 0 && t < SEQ) v = *(const GAS u32x4*)(raw + ((size_t)b * SEQ + t) * CONV_CH + col);
        *(LAS u32x4*)(st + which * 1152 + r * 384 + p * 8) = v; }
}
__device__ __forceinline__ void inv_diag_blocks(const LAS float* Af, LAS float* Tf, int lane) {
    const int blk = lane >> 4, c = lane & 15; float t[16];
#pragma unroll
    for (int i = 0; i < 16; ++i) t[i] = (i == c) ? 1.f : 0.f;
#pragma unroll
    for (int i = 1; i < 16; ++i) { float s = 0.f; const LAS float* ar = Af + (blk * 16 + i) * 68 + blk * 16;
#pragma unroll
        for (int j = 0; j < i; ++j) s += ar[j] * t[j];
        t[i] = (i > c) ? -s : t[i];
        if ((i & 3) == 3) asm volatile("" ::: "memory"); }
#pragma unroll
    for (int i = 0; i < 16; ++i) Tf[(blk * 16 + i) * 68 + blk * 16 + c] = t[i];
}
__device__ __forceinline__ void inv_offdiag_x(const LAS float* Af, const LAS float* Tf, LAS float* Xf, int d, int ht) {
    const int nbk = 4 - d;
    for (int e = ht; e < nbk * 256; e += 256) { const int J = e >> 8, r = (e >> 4) & 15, c = e & 15, I = J + d; float s = 0.f;
        for (int kk = J * 16; kk < I * 16; ++kk) s += Af[(I * 16 + r) * 68 + kk] * Tf[kk * 68 + J * 16 + c];
        Xf[(J * 16 + r) * 17 + c] = s; }
}
__device__ __forceinline__ void inv_offdiag_t(LAS float* Tf, const LAS float* Xf, int d, int ht) {
    const int nbk = 4 - d;
    for (int e = ht; e < nbk * 256; e += 256) { const int J = e >> 8, r = (e >> 4) & 15, c = e & 15, I = J + d; float s = 0.f;
#pragma unroll
        for (int m2 = 0; m2 < 16; ++m2) s += Tf[(I * 16 + r) * 68 + I * 16 + m2] * Xf[(J * 16 + m2) * 17 + c];
        Tf[(I * 16 + r) * 68 + J * 16 + c] = -s; }
}

__device__ __forceinline__ void prep_gdn_range(LAS unsigned char* lds, int bid, bf16* raw, const float* scal, const float* conv_w, const float* conv_b,
                                               const float* A_log, const float* dt_bias, bf16* TQ, int tid, int wave, int lane) {
    using namespace pgd;
    const int bh = bid >> 3, b = bh >> 3, h = bh & 7, r8 = bid & 7;
    const int fr = lane & 15, fq = lane >> 4;
    LAS float* cw = (LAS float*)(lds + CW); LAS float* sc = (LAS float*)(lds + SC);
    LAS bf16* q_ = (LAS bf16*)(lds + Q); LAS bf16* k_ = (LAS bf16*)(lds + K); LAS bf16* vT = (LAS bf16*)(lds + VT);
    LAS bf16* rq = (LAS bf16*)(lds + RQ); LAS bf16* rk = (LAS bf16*)(lds + RK); LAS bf16* rv = (LAS bf16*)(lds + RV);
    LAS float* Af = (LAS float*)(lds + AF); LAS float* A2f = (LAS float*)(lds + A2F); LAS float* Tf = (LAS float*)(lds + TF); LAS float* T2f = (LAS float*)(lds + T2F);
    LAS float* Xf = (LAS float*)(lds + XF); LAS bf16* QKp = (LAS bf16*)(lds + QKP); LAS bf16* Tp = (LAS bf16*)(lds + TP);
    LAS bf16* st = (LAS bf16*)(lds + STASH);
    for (int e = tid; e < 8 * 384; e += 512) { const int r = e / 384, c = e % 384;
        const int gch = (c >> 7) * 1024 + h * 128 + (c & 127);
        cw[e] = r < 7 ? conv_w[r * CONV_CH + gch] : conv_b[gch]; }
    const float expAf = expf(A_log[h]), dtbf = dt_bias[h], expAb = expf(A_log[8 + h]), dtbb = dt_bias[8 + h];
    const size_t rowb = (size_t)b * SEQ;
    const int half = wave >> 2, ht = tid & 255;
    __syncthreads();
    for (int u = 0; u < 16; ++u) {
        const int c = r8 * 16 + u, t0 = c * 64;
        for (int e = tid; e < 70 * 48; e += 512) { const int r = e / 48, p = e % 48;
            u32x4 v;
            if (r < 3) v = *(const LAS u32x4*)(st + r * 384 + p * 8);
            else if (r >= 67 && u == 15) v = *(const LAS u32x4*)(st + 1152 + (r - 67) * 384 + p * 8);
            else { const int col = p < 16 ? h * 128 + p * 8 : (p < 32 ? 1024 + h * 128 + (p - 16) * 8 : 2048 + h * 128 + (p - 32) * 8);
                   v = *(const GAS u32x4*)(raw + (rowb + t0 - 3 + r) * CONV_CH + col); }
            LAS bf16* d = p < 16 ? rq + r * 136 + p * 8 : (p < 32 ? rk + r * 136 + (p - 16) * 8 : rv + r * 136 + (p - 32) * 8);
            *(LAS u32x4*)d = v; }
        if (wave == 0) { const int i = lane; const size_t so = (rowb + t0 + i) * 64;
            const float g = -expAf * softplus_f(scal[so + 16 + h] + dtbf); float gc = g;
#pragma unroll
            for (int o = 1; o < 64; o <<= 1) { const float y = __shfl_up(gc, o); if (i >= o) gc += y; }
            sc[i] = sigmoid_f(scal[so + h]); sc[64 + i] = gc; }
        if (wave == 1) { const int i = lane; const size_t so = (rowb + t0 + i) * 64;
            const float g = -expAb * softplus_f(scal[so + 24 + h] + dtbb); float gc = g;
#pragma unroll
            for (int o = 1; o < 64; o <<= 1) { const float y = __shfl_down(gc, o); if (i + o < 64) gc += y; }
            sc[128 + i] = sigmoid_f(scal[so + 8 + h]); sc[192 + i] = gc; }
        __syncthreads();
        if (tid < 144) { const int r = tid / 48, p = tid % 48;
            const LAS bf16* s = p < 16 ? rq + (64 + r) * 136 + p * 8 : (p < 32 ? rk + (64 + r) * 136 + (p - 16) * 8 : rv + (64 + r) * 136 + (p - 32) * 8);
            *(LAS u32x4*)(st + r * 384 + p * 8) = *(const LAS u32x4*)s; }
        { const int i = tid >> 3, cg = tid & 7;
          float a[16];
          conv16(a, rq + i * 136 + cg * 16, 136, cw + cg * 16, 384);
          float ss = 0.f;
#pragma unroll
          for (int c2 = 0; c2 < 16; ++c2) { a[c2] = silu(a[c2]); ss += a[c2] * a[c2]; }
          ss += __shfl_xor(ss, 1); ss += __shfl_xor(ss, 2); ss += __shfl_xor(ss, 4);
          float rs = (1.0f / sqrtf(ss + EPS)) * 0.08838834764831845f;
          { u32x4 w0, w1; w0.x = pkbf(a[0] * rs, a[1] * rs); w0.y = pkbf(a[2] * rs, a[3] * rs); w0.z = pkbf(a[4] * rs, a[5] * rs); w0.w = pkbf(a[6] * rs, a[7] * rs);
            w1.x = pkbf(a[8] * rs, a[9] * rs); w1.y = pkbf(a[10] * rs, a[11] * rs); w1.z = pkbf(a[12] * rs, a[13] * rs); w1.w = pkbf(a[14] * rs, a[15] * rs);
            *(LAS u32x4*)(q_ + i * 136 + cg * 16) = w0; *(LAS u32x4*)(q_ + i * 136 + cg * 16 + 8) = w1;
            GAS u32x4* gp = (GAS u32x4*)(raw + (rowb + t0 + i) * CONV_CH + h * 128 + cg * 16); gp[0] = w0; gp[1] = w1; }
          conv16(a, rk + i * 136 + cg * 16, 136, cw + 128 + cg * 16, 384);
          ss = 0.f;
#pragma unroll
          for (int c2 = 0; c2 < 16; ++c2) { a[c2] = silu(a[c2]); ss += a[c2] * a[c2]; }
          ss += __shfl_xor(ss, 1); ss += __shfl_xor(ss, 2); ss += __shfl_xor(ss, 4);
          rs = 1.0f / sqrtf(ss + EPS);
          { u32x4 w0, w1; w0.x = pkbf(a[0] * rs, a[1] * rs); w0.y = pkbf(a[2] * rs, a[3] * rs); w0.z = pkbf(a[4] * rs, a[5] * rs); w0.w = pkbf(a[6] * rs, a[7] * rs);
            w1.x = pkbf(a[8] * rs, a[9] * rs); w1.y = pkbf(a[10] * rs, a[11] * rs); w1.z = pkbf(a[12] * rs, a[13] * rs); w1.w = pkbf(a[14] * rs, a[15] * rs);
            *(LAS u32x4*)(k_ + i * 136 + cg * 16) = w0; *(LAS u32x4*)(k_ + i * 136 + cg * 16 + 8) = w1;
            GAS u32x4* gp = (GAS u32x4*)(raw + (rowb + t0 + i) * CONV_CH + 1024 + h * 128 + cg * 16); gp[0] = w0; gp[1] = w1; }
          conv16(a, rv + i * 136 + cg * 16, 136, cw + 256 + cg * 16, 384);
#pragma unroll
          for (int c2 = 0; c2 < 16; ++c2) vT[(cg * 16 + c2) * 72 + i] = f2bf1(silu(a[c2]));
        }
        __syncthreads();
        for (int e = tid; e < 128 * 8; e += 512) { const int dv = e >> 3, p = e & 7;
            *(GAS u32x4*)(raw + (rowb + t0 + (dv >> 1)) * CONV_CH + 2048 + h * 128 + (dv & 1) * 64 + p * 8) = *(const LAS u32x4*)(vT + dv * 72 + p * 8); }
        { const int mt = wave & 3;
          f32x4 acc[1][4];
#pragma unroll
          for (int nt = 0; nt < 4; ++nt) acc[0][nt] = (f32x4){0.f, 0.f, 0.f, 0.f};
          mma_lds<1, 4>(acc, half ? q_ : k_, 136, mt * 16, k_, 136, 0, 128, fr, fq);
#pragma unroll
          for (int nt = 0; nt < 4; ++nt)
#pragma unroll
              for (int r = 0; r < 4; ++r) { const int i = mt * 16 + 4 * fq + r, j = nt * 16 + fr;
                  const float df = expf(fminf(sc[64 + i] - sc[64 + j], 0.f)), db = expf(fminf(sc[192 + i] - sc[192 + j], 0.f));
                  const float x = acc[0][nt][r];
                  if (half == 0) { Af[i * 68 + j] = (i > j) ? sc[i] * x * df : 0.f; A2f[j * 68 + i] = (i < j) ? sc[128 + i] * x * db : 0.f; }
                  else QKp[i * 72 + j] = f2bf1(i > j ? x * df : (i < j ? x * db : x)); }
        }
        __syncthreads();
        { const LAS float* Ah = half ? A2f : Af; LAS float* Th = half ? T2f : Tf; LAS float* Xh = Xf + half * (3 * 16 * 17);
          if ((wave & 3) == 0) inv_diag_blocks(Ah, Th, lane);
          for (int d = 1; d <= 3; ++d) {
              __syncthreads(); inv_offdiag_x(Ah, Th, Xh, d, ht);
              __syncthreads(); inv_offdiag_t(Th, Xh, d, ht); }
        }
        __syncthreads();
        for (int e = tid; e < 4096; e += 512) { const int i = e >> 6, j = e & 63;
            float v = 1.0f;
            if (i > j) v = Tf[i * 68 + j];
            else if (i < j) v = T2f[j * 68 + i];
            Tp[i * 72 + j] = f2bf1(v); }
        __syncthreads();
        { bf16* tq = TQ + ((size_t)(bh * NCHUNK + c)) * 8192;
          for (int e = tid; e < 1024; e += 512) { const int which = e >> 9, r = (e >> 3) & 63, p = e & 7;
              *(GAS u32x4*)(tq + which * 4096 + r * 64 + p * 8) = *(const LAS u32x4*)((which ? QKp : Tp) + r * 72 + p * 8); } }
        __syncthreads();
    }
}

__device__ __forceinline__ void gdn_state_v1(LAS unsigned char* lds, int cid, const bf16* raw, const float* scal, const bf16* TQ,
                                             const float* A_log, const float* dt_bias, bf16* og, int tid, int wave, int lane) {
    using namespace gdn;
    const int dvh = cid & 1, dir = (cid >> 1) & 1, h = (cid >> 2) & 7, b = cid >> 5;
    const int fr = lane & 15, fq = lane >> 4;
    LAS float* sc = (LAS float*)(lds + SC);
    LAS bf16* q_ = (LAS bf16*)(lds + Q); LAS bf16* k_ = (LAS bf16*)(lds + K); LAS bf16* kdT = (LAS bf16*)(lds + KDT); LAS bf16* vT = (LAS bf16*)(lds + VT);
    LAS bf16* T_ = (LAS bf16*)(lds + T); LAS bf16* QKd = (LAS bf16*)(lds + QKD); LAS bf16* ST_ = (LAS bf16*)(lds + ST);
    LAS bf16* rT = (LAS bf16*)(lds + RT); LAS bf16* uT = (LAS bf16*)(lds + UT); LAS float* os = (LAS float*)(lds + OS);
    for (int e = tid; e < 64 * 136 / 2; e += 512) ((LAS unsigned*)ST_)[e] = 0u;
    const float expA = expf(A_log[dir * 8 + h]), dtb = dt_bias[dir * 8 + h];
    f32x4 sacc[4];
#pragma unroll
    for (int nt = 0; nt < 4; ++nt) sacc[nt] = (f32x4){0.f, 0.f, 0.f, 0.f};
    const size_t rowb = (size_t)b * SEQ; const int bh = b * 8 + h;
    __syncthreads();
    for (int n = 0; n < NCHUNK; ++n) {
        const int c = dir ? NCHUNK - 1 - n : n, t0 = c * 64;
        for (int e = tid; e < 64 * 16; e += 512) { const int r = e >> 4, p = e & 15;
            *(LAS u32x4*)(q_ + r * 136 + p * 8) = *(const GAS u32x4*)(raw + (rowb + t0 + r) * CONV_CH + h * 128 + p * 8);
            *(LAS u32x4*)(k_ + r * 136 + p * 8) = *(const GAS u32x4*)(raw + (rowb + t0 + r) * CONV_CH + 1024 + h * 128 + p * 8); }
        { const int dvl = tid >> 3, p = tid & 7; const int dv = dvh * 64 + dvl;
          *(LAS u32x4*)(vT + dvl * 72 + p * 8) = *(const GAS u32x4*)(raw + (rowb + t0 + (dv >> 1)) * CONV_CH + 2048 + h * 128 + (dv & 1) * 64 + p * 8); }
        { const bf16* tq = TQ + ((size_t)(bh * NCHUNK + c)) * 8192;
          for (int e = tid; e < 1024; e += 512) { const int which = e >> 9, i = (e >> 3) & 63, p = e & 7;
              bf16x8 v = *(const GAS bf16x8*)(tq + which * 4096 + i * 64 + p * 8);
#pragma unroll
              for (int x = 0; x < 8; ++x) { const int j = p * 8 + x; const bool keep = dir ? (i < j) : (i > j);
                  if (i == j) { if (which == 0) v[x] = (short)0x3F80; } else if (!keep) v[x] = 0; }
              *(LAS bf16x8*)((which ? QKd : T_) + i * 72 + p * 8) = v; } }
        if (wave == 0) { const int i = lane; const size_t so = (rowb + t0 + i) * 64;
            const float g = -expA * softplus_f(scal[so + 16 + dir * 8 + h] + dtb); float gc = g;
            if (dir == 0) {
#pragma unroll
                for (int o = 1; o < 64; o <<= 1) { const float y = __shfl_up(gc, o); if (i >= o) gc += y; }
            } else {
#pragma unroll
                for (int o = 1; o < 64; o <<= 1) { const float y = __shfl_down(gc, o); if (i + o < 64) gc += y; }
            }
            const float gl = __shfl(gc, dir ? 0 : 63);
            sc[i] = sigmoid_f(scal[so + dir * 8 + h]); sc[64 + i] = gc; sc[128 + i] = expf(gc); sc[192 + i] = expf(gl - gc); if (i == 0) sc[256] = expf(gl); }
        __syncthreads();
        { const int i = tid >> 3, cg = tid & 7; const float ek = sc[192 + i];
          const bf16x8 k0 = *(const LAS bf16x8*)(k_ + i * 136 + cg * 16), k1 = *(const LAS bf16x8*)(k_ + i * 136 + cg * 16 + 8);
#pragma unroll
          for (int x = 0; x < 8; ++x) { kdT[(cg * 16 + x) * 72 + i] = f2bf1(bf2f_s(k0[x]) * ek); kdT[(cg * 16 + 8 + x) * 72 + i] = f2bf1(bf2f_s(k1[x]) * ek); } }
        __syncthreads();
        const int mt = wave & 3, nh = wave >> 2;
        f32x4 aq[2];
        { f32x4 ak[2]; ak[0] = ak[1] = aq[0] = aq[1] = (f32x4){0.f, 0.f, 0.f, 0.f};
          for (int k0 = 0; k0 < 128; k0 += 32) {
              const bf16x8 fk = *(const LAS bf16x8*)(k_ + (mt * 16 + fr) * 136 + k0 + fq * 8), fqv = *(const LAS bf16x8*)(q_ + (mt * 16 + fr) * 136 + k0 + fq * 8);
#pragma unroll
              for (int nl = 0; nl < 2; ++nl) { const bf16x8 fb = *(const LAS bf16x8*)(ST_ + (nh * 32 + nl * 16 + fr) * 136 + k0 + fq * 8);
                  ak[nl] = __builtin_amdgcn_mfma_f32_16x16x32_bf16(fk, fb, ak[nl], 0, 0, 0); aq[nl] = __builtin_amdgcn_mfma_f32_16x16x32_bf16(fqv, fb, aq[nl], 0, 0, 0); } }
          const int i0 = mt * 16 + 4 * fq;
          const f32x4 be4 = *(const LAS f32x4*)(sc + i0), eg4 = *(const LAS f32x4*)(sc + 128 + i0);
#pragma unroll
          for (int nl = 0; nl < 2; ++nl) { const int dv = nh * 32 + nl * 16 + fr;
              const bf16x4 vv = *(const LAS bf16x4*)(vT + dv * 72 + i0);
              float r0 = be4[0] * (bf2f_s(vv[0]) - eg4[0] * ak[nl][0]), r1 = be4[1] * (bf2f_s(vv[1]) - eg4[1] * ak[nl][1]);
              float r2 = be4[2] * (bf2f_s(vv[2]) - eg4[2] * ak[nl][2]), r3 = be4[3] * (bf2f_s(vv[3]) - eg4[3] * ak[nl][3]);
              u32x2 w; w.x = pkbf(r0, r1); w.y = pkbf(r2, r3); *(LAS u32x2*)(rT + dv * 72 + i0) = w;
              aq[nl][0] *= eg4[0]; aq[nl][1] *= eg4[1]; aq[nl][2] *= eg4[2]; aq[nl][3] *= eg4[3]; }
        }
        __syncthreads();
        { f32x4 au[1][2]; au[0][0] = au[0][1] = (f32x4){0.f, 0.f, 0.f, 0.f};
          mma_lds<1, 2>(au, T_, 72, mt * 16, rT, 72, nh * 32, 64, fr, fq);
          const int i0 = mt * 16 + 4 * fq;
#pragma unroll
          for (int nl = 0; nl < 2; ++nl) { const int dv = nh * 32 + nl * 16 + fr; u32x2 w; w.x = pkbf(au[0][nl][0], au[0][nl][1]); w.y = pkbf(au[0][nl][2], au[0][nl][3]); *(LAS u32x2*)(uT + dv * 72 + i0) = w; }
        }
        __syncthreads();
        { f32x4 ao[1][2]; ao[0][0] = aq[0]; ao[0][1] = aq[1];
          mma_lds<1, 2>(ao, QKd, 72, mt * 16, uT, 72, nh * 32, 64, fr, fq);
          const int i0 = mt * 16 + 4 * fq;
#pragma unroll
          for (int nl = 0; nl < 2; ++nl)
#pragma unroll
              for (int r = 0; r < 4; ++r) os[(i0 + r) * 65 + nh * 32 + nl * 16 + fr] = ao[0][nl][r];
          const float egl = sc[256];
          f32x4 as_[1][4];
#pragma unroll
          for (int nt = 0; nt < 4; ++nt) as_[0][nt] = sacc[nt] * egl;
          mma_lds<1, 4>(as_, kdT, 72, wave * 16, uT, 72, 0, 64, fr, fq);
#pragma unroll
          for (int nt = 0; nt < 4; ++nt) { sacc[nt] = as_[0][nt];
              u32x2 w; w.x = pkbf(sacc[nt][0], sacc[nt][1]); w.y = pkbf(sacc[nt][2], sacc[nt][3]); *(LAS u32x2*)(ST_ + (nt * 16 + fr) * 136 + wave * 16 + 4 * fq) = w; }
        }
        __syncthreads();
#pragma unroll
        for (int ii = 0; ii < 4; ++ii) { const int i = wave * 8 + 2 * ii + (lane >> 5), cp = lane & 31;
            atomic_add_bf16x2(og + (rowb + t0 + i) * 1024 + h * 128 + dvh * 64 + 2 * cp, os[i * 65 + 2 * cp], os[i * 65 + 2 * cp + 1]); }
        __syncthreads();
    }
}
#ifndef MK_ONE_LAUNCH
#define MK_ONE_LAUNCH 1
#endif
constexpr int PPL = 13;
constexpr int NPHASE = 1 + PPL * DEPTH;
struct Args { const float* in[19]; float* out; unsigned char* ws; int ph_lo, ph_hi; };
__global__ void __launch_bounds__(NWAVES * 64, 2) fwd_kernel(Args args) {
    extern __shared__ __attribute__((aligned(16))) unsigned char lds_raw[];
    LAS unsigned char* lds = (LAS unsigned char*)lds_raw;
    unsigned* ctl = (unsigned*)(args.ws + WS_CTL);
    volatile LAS unsigned* MISC = (volatile LAS unsigned*)(lds + MISC_OFF);
    for (int u = threadIdx.x; u < 64; u += 512) MISC[u] = 0u;
    __syncthreads();
#if MK_ONE_LAUNCH
    XcdBarrier bar = xcd_barrier_post(ctl + CW_BAR, MISC + 8);
#define GRID_BAR() do { XcdBarrier bb_ = bar; asm volatile("" : "+s"(bb_.bar), "+s"(bb_.x)); xcd_barrier(bb_); } while (0)
#else
#define GRID_BAR() do {} while (0)
#endif
    const int lo = args.ph_lo, hi = args.ph_hi;
#define WSP(T, off) ((T*)(wsb + (off)))
    for (int ph = lo; ph < hi; ++ph) {
        int tid = threadIdx.x, bid = blockIdx.x, G = gridDim.x;
        const __attribute__((address_space(4))) Args* ap = (const __attribute__((address_space(4))) Args*)__builtin_amdgcn_kernarg_segment_ptr();
        asm volatile("" : "+v"(tid)); asm volatile("" : "+s"(bid), "+s"(G), "+s"(ap));
        unsigned char* wsb = ap->ws;
        const int lane = tid & 63, wave = __builtin_amdgcn_readfirstlane(tid >> 6);
        const int gw = bid * NWAVES + wave, NGW = G * NWAVES, gtid = bid * 512 + tid, NGT = G * 512;
        const int l = (ph == 0) ? 0 : (ph - 1) / PPL; const int k = (ph == 0) ? -1 : (ph - 1) % PPL;
        switch (k) {
        case -1: {
            cvt_mixer_weights(lds, wsb, ap->in[2], ap->in[12], gw, NGW, wave, lane);
            phase_norm(ap->in[0], ap->in[1], WSP(bf16, WS_XN), gw, NGW, lane);
        } break;
        case 0: {
            pg8::Gemm g{WSP(bf16, WS_XN), WSP(bf16, WS_WA), M, NWA, DM, 0, 0, 0}; pg8::StaticOrder S; S.init(M, NWA, G, bid);
            pg8::EpiRawA E{WSP(bf16, WS_RAW), WSP(float, WS_SCAL)};
            pg8::gemm_phase<pg8::EpiRawA, pg8::StaticOrder, true, true>(lds, g, S, E);
#if defined(EXP_DUP_GEMM)
            if (l == 0) { __syncthreads(); pg8::gemm_phase<pg8::EpiRawA, pg8::StaticOrder, true, true>(lds, g, S, E); }
#endif
        } break;
        case 1: {
            prep_gdn_stash(lds, bid, WSP(bf16, WS_RAW), tid);
            zero_region(wsb + WS_OG, 64 * MiB, gtid, NGT); zero_region(wsb + WS_YS, 64 * MiB, gtid, NGT);
            GRID_BAR();
            prep_gdn_range(lds, bid, WSP(bf16, WS_RAW), WSP(float, WS_SCAL), ap->in[3] + (size_t)l * 7 * CONV_CH, ap->in[4] + (size_t)l * CONV_CH,
                           ap->in[5] + l * 16, ap->in[6] + l * 16, WSP(bf16, WS_TQ), tid, wave, lane);
        } break;
        case 2: {
            const float* cwp = ap->in[3] + (size_t)l * 7 * CONV_CH; const float* cbp = ap->in[4] + (size_t)l * CONV_CH;
            for (int c = bid; c < 256; c += G) {
                if (c < 128) gdn_state_v1(lds, c, WSP(bf16, WS_RAW), WSP(float, WS_SCAL), WSP(bf16, WS_TQ), ap->in[5] + l * 16, ap->in[6] + l * 16, WSP(bf16, WS_OG), tid, wave, lane);
                else ssd_chain(lds, c - 128, WSP(bf16, WS_RAW), WSP(float, WS_SCAL), cwp, cbp, ap->in[8] + l * 32, ap->in[9] + l * 32, ap->in[10] + l * 16, WSP(bf16, WS_YS), tid, wave, lane);
                __syncthreads();
            }
        } break;
        case 3: {
            phase_norm((l == 0) ? ap->in[0] : ap->out, ap->in[1] + (size_t)l * DM, WSP(bf16, WS_XN2), gw, NGW, lane);
        } break;
        case 4: {
            pg8::Gemm g{WSP(bf16, WS_XN2), WSP(bf16, WS_WB), M, NGATE, DM, 0, 0, 0}; pg8::StaticOrder S; S.init(M, NGATE, G, bid);
            pg8::EpiBf16 E{WSP(bf16, WS_GATES), NGATE};
            pg8::gemm_phase<pg8::EpiBf16, pg8::StaticOrder, true, true>(lds, g, S, E);
#if defined(EXP_DUP_GEMM)
            if (l == 0) { __syncthreads(); pg8::gemm_phase<pg8::EpiBf16, pg8::StaticOrder, true, true>(lds, g, S, E); }
#endif
        } break;
        case 5: {
            phase_finish(WSP(bf16, WS_OG), WSP(bf16, WS_YS), WSP(bf16, WS_GATES), ap->in[7] + l * 128, ap->in[11] + l * 1024, WSP(bf16, WS_MIXED), gw, NGW, lane);
        } break;
        case 6: {
            pg8::Gemm g{WSP(bf16, WS_MIXED), WSP(bf16, WS_WO), M, DM, 2048, 0, 0, 0}; pg8::StaticOrder S; S.init(M, DM, G, bid);
            pg8::EpiResid E{(l == 0) ? ap->in[0] : ap->out, ap->out, DM};
            pg8::gemm_phase<pg8::EpiResid, pg8::StaticOrder, true, true>(lds, g, S, E);
#if defined(EXP_DUP_GEMM)
            if (l == 0) { __syncthreads(); pg8::gemm_phase<pg8::EpiResid, pg8::StaticOrder, true, true>(lds, g, S, E); }
#endif
        } break;
        case 7: {
            phase_norm2_router(lds, ap->out, ap->in[13] + l * DM, ap->in[14] + (size_t)l * DM * 16, WSP(bf16, WS_XN), WSP(float, WS_AFF), gw, NGW, tid, lane);
            __syncthreads();
            cvt_expert_weights(lds, wsb, ap->in[15] + (size_t)l * NEXP * DM * EFF, ap->in[16] + (size_t)l * NEXP * DM * EFF, ap->in[17] + (size_t)l * NEXP * EFF * DM, gw, NGW, wave, lane);
            if (l + 1 < DEPTH) cvt_mixer_weights(lds, wsb, ap->in[2] + (size_t)(l + 1) * DM * 6720, ap->in[12] + (size_t)(l + 1) * 2048 * DM, gw, NGW, wave, lane);
        } break;
        case 8: {
            for (int be = bid; be < NB * NEXP; be += G) phase_topk(lds, WSP(float, WS_AFF), WSP(int, WS_IDX), WSP(float, WS_VAL), WSP(int, WS_INV), be, tid, wave, lane);
        } break;
        case 9: {
            phase_gather(WSP(bf16, WS_XN), WSP(int, WS_IDX), WSP(bf16, WS_XG), gw, NGW, lane);
        } break;
        case 10: {
            pg8::Gemm g{WSP(bf16, WS_XG), WSP(bf16, WS_WGU), MEXP, 1024, DM, 2, 15, (size_t)1024 * 1024 * 2}; pg8::StaticOrder S; S.init(MEXP, 1024, G, bid);
            pg8::EpiSwiglu E{WSP(bf16, WS_HMID), EFF};
            pg8::gemm_phase<pg8::EpiSwiglu, pg8::StaticOrder, true, true>(lds, g, S, E);
#if defined(EXP_DUP_GEMM)
            if (l == 0) { __syncthreads(); pg8::gemm_phase<pg8::EpiSwiglu, pg8::StaticOrder, true, true>(lds, g, S, E); }
#endif
        } break;
        case 11: {
            pg8::Gemm g{WSP(bf16, WS_HMID), WSP(bf16, WS_WD), MEXP, 1024, EFF, 2, 15, (size_t)1024 * 512 * 2}; pg8::StaticOrder S; S.init(MEXP, 1024, G, bid);
            pg8::EpiBf16 E{WSP(bf16, WS_XG), 1024};
            pg8::gemm_phase<pg8::EpiBf16, pg8::StaticOrder, true, true>(lds, g, S, E);
#if defined(EXP_DUP_GEMM)
            if (l == 0) { __syncthreads(); pg8::gemm_phase<pg8::EpiBf16, pg8::StaticOrder, true, true>(lds, g, S, E); }
#endif
        } break;
        default: {
            const bool last = (l + 1 == DEPTH);
            phase_combine(ap->out, ap->out, WSP(bf16, WS_XG), WSP(int, WS_INV), WSP(float, WS_VAL), last ? ap->in[18] : ap->in[1] + (size_t)(l + 1) * DM, WSP(bf16, WS_XN), last, gw, NGW, lane);
        } break;
        }
        if (ph + 1 < hi) GRID_BAR();
    }
#undef WSP
}

extern "C" void kernel_launch(void* const* d_in, const int* in_sizes, int n_in, void* d_out, int out_size, void* d_ws, size_t ws_size, hipStream_t stream) {
    static int grid = 0;
    if (grid == 0) {
        if (n_in != 19 || in_sizes[0] != M * DM || out_size != M * DM || ws_size < WS_END) { fprintf(stderr, "kernel_launch: unexpected shapes (n_in %d, in0 %d, out %d, ws %zu); nothing launched\n", n_in, n_in > 0 ? in_sizes[0] : -1, out_size, ws_size); grid = -1; return; }
        int dev = 0, cus = 0;
        if (hipGetDevice(&dev) != hipSuccess || hipDeviceGetAttribute(&cus, hipDeviceAttributeMultiprocessorCount, dev) != hipSuccess) { grid = -1; return; }
        if (hipFuncSetAttribute((const void*)fwd_kernel, hipFuncAttributeMaxDynamicSharedMemorySize, LDS_BYTES) != hipSuccess) { fprintf(stderr, "kernel_launch: hipFuncSetAttribute failed\n"); grid = -1; return; }
        (void)hipGetLastError();
        grid = cus;
    }
    if (grid < 0) return;
    (void)hipMemsetAsync((char*)d_ws + WS_CTL, 0, CTL_ZERO_BYTES, stream);
    Args a{};
    for (int i = 0; i < 19; ++i) a.in[i] = (const float*)d_in[i];
    a.out = (float*)d_out; a.ws = (unsigned char*)d_ws;
#if MK_ONE_LAUNCH
    a.ph_lo = 0; a.ph_hi = NPHASE;
    hipLaunchKernelGGL(fwd_kernel, dim3(grid), dim3(NWAVES * 64), LDS_BYTES, stream, a);
#else
    for (int p = 0; p < NPHASE; ++p) { a.ph_lo = p; a.ph_hi = p + 1; hipLaunchKernelGGL(fwd_kernel, dim3(grid), dim3(NWAVES * 64), LDS_BYTES, stream, a); }
#endif
}
```

```cpp
#include <hip/hip_runtime.h>
#include <cstdio>
#include <cstdint>
namespace pg8 {
#define PG8_LAS __attribute__((address_space(3)))
typedef unsigned short bf16_t;
typedef short bf16x8 __attribute__((ext_vector_type(8)));
typedef float f32x4 __attribute__((ext_vector_type(4)));
typedef unsigned u32x4 __attribute__((ext_vector_type(4)));
constexpr int BM = 256, BK = 64, HALF = 128, HTB = HALF * BK * 2  , STAGE_BYTES = 8 * HTB, NXCD = 8, WGM = 8;

__host__ __device__ __forceinline__ int lds_byte(int r, int c) { const int st = (r >> 4) * 2 + (c >> 5), rr = r & 15, cc = c & 31, ob = rr * 64 + cc * 2; return st * 1024 + (ob ^ (((ob >> 9) & 1) << 5)); }
__host__ __device__ __forceinline__ void stage_rc(int b, int& R, int& C) { const int st = b / 1024, sb = b % 1024, swz = sb ^ (((sb >> 9) & 1) << 5); R = (st >> 1) * 16 + swz / 64; C = (st & 1) * 32 + (swz % 64) / 2; }
__host__ __device__ __forceinline__ int perm32(int rho) { const int n = rho >> 4, i = rho & 15; return 8 * (i >> 2) + 4 * n + (i & 3); }

struct Unit { int pm, pn; };
struct Gemm { const bf16_t* A; const bf16_t* Bt; int M, N, K; int bshift, bmask; size_t bstride;
    __device__ __forceinline__ size_t grp_off(int pm) const { return (size_t)((pm >> bshift) & bmask) * bstride; } };

struct StaticOrder {
    int nM, nN, nwg, G, c;
    __host__ __device__ void init(int M, int N, int G_, int c_) { nM = M / BM; nN = N / BM; nwg = nM * nN; G = G_; c = c_; }
    __host__ __device__ bool next(int i, Unit& u) const {
        const long L = (long)i * G + c; if (L >= nwg) return false;
        int wgid = (int)L; { const int q = nwg / NXCD, r = nwg % NXCD, xcd = wgid % NXCD, off = wgid / NXCD; wgid = (xcd < r ? xcd * (q + 1) : r * (q + 1) + (xcd - r) * q) + off; }
        const int nig = WGM * nN, gid = wgid / nig, fm = gid * WGM, gsz = (nM - fm) < WGM ? (nM - fm) : WGM;
        u.pm = fm + ((wgid % nig) % gsz); u.pn = (wgid % nig) / gsz; return true;
    }
    __device__ __forceinline__ void a_ready(const Unit&) const {}
    __device__ __forceinline__ void done(const Unit&) const {}
};

__device__ __forceinline__ unsigned cvt_pk_bf16(float lo, float hi) { unsigned r; asm volatile("v_cvt_pk_bf16_f32 %0, %1, %2" : "=v"(r) : "v"(lo), "v"(hi)); return r; }
__device__ __forceinline__ float silu_f(float x) { return x * __builtin_amdgcn_rcpf(1.0f + __builtin_amdgcn_exp2f(-1.4426950408889634f * x)); }
struct EpiBf16 {
    static constexpr bool PERM = true, AFTER_DRAIN = false;
    bf16_t* O; int ldc;
    __device__ __forceinline__ void operator()(const f32x4 (&acc)[2][2][4][2], const Unit& u, int wr, int wc, int fr, int fq) const {
        const int row0 = u.pm * BM + wr * 64 + fr; const int col0 = u.pn * BM + wc * 32 + 8 * fq;
#pragma unroll
        for (int ai = 0; ai < 2; ++ai)
#pragma unroll
            for (int m = 0; m < 4; ++m) { bf16_t* rowp = O + (size_t)(row0 + ai * HALF + m * 16) * ldc + col0;
#pragma unroll
                for (int bj = 0; bj < 2; ++bj) { const f32x4 v0 = acc[ai][bj][m][0], v1 = acc[ai][bj][m][1];
                    u32x4 w; w.x = cvt_pk_bf16(v0[0], v0[1]); w.y = cvt_pk_bf16(v0[2], v0[3]); w.z = cvt_pk_bf16(v1[0], v1[1]); w.w = cvt_pk_bf16(v1[2], v1[3]);
                    *(u32x4*)(rowp + bj * HALF) = w; } }
    }
};
struct EpiRawA {
    static constexpr bool PERM = true, AFTER_DRAIN = false;
    bf16_t* O; float* S;
    __device__ __forceinline__ void operator()(const f32x4 (&acc)[2][2][4][2], const Unit& u, int wr, int wc, int fr, int fq) const {
        const int row0 = u.pm * BM + wr * 64 + fr;
        if (u.pn < 18) {
            const int col0 = u.pn * BM + wc * 32 + 8 * fq;
#pragma unroll
            for (int ai = 0; ai < 2; ++ai)
#pragma unroll
                for (int m = 0; m < 4; ++m) { bf16_t* rowp = O + (size_t)(row0 + ai * HALF + m * 16) * 4608 + col0;
#pragma unroll
                    for (int bj = 0; bj < 2; ++bj) { const f32x4 v0 = acc[ai][bj][m][0], v1 = acc[ai][bj][m][1];
                        u32x4 w; w.x = cvt_pk_bf16(v0[0], v0[1]); w.y = cvt_pk_bf16(v0[2], v0[3]); w.z = cvt_pk_bf16(v1[0], v1[1]); w.w = cvt_pk_bf16(v1[2], v1[3]);
                        *(u32x4*)(rowp + bj * HALF) = w; } }
        } else if (wc < 2) {
            const int col0 = wc * 32 + 8 * fq;
#pragma unroll
            for (int ai = 0; ai < 2; ++ai)
#pragma unroll
                for (int m = 0; m < 4; ++m) { float* sp = S + (size_t)(row0 + ai * HALF + m * 16) * 64 + col0;
                    *(f32x4*)sp = acc[ai][0][m][0]; *(f32x4*)(sp + 4) = acc[ai][0][m][1]; }
        }
    }
};
struct EpiResid {
    static constexpr bool PERM = false, AFTER_DRAIN = false;
    const float* base; float* out; int ldc;
    __device__ __forceinline__ void operator()(const f32x4 (&acc)[2][2][4][2], const Unit& u, int wr, int wc, int fr, int fq) const {
        const int row0 = u.pm * BM + wr * 64 + fr, col0 = u.pn * BM + wc * 32 + 4 * fq;
#pragma unroll
        for (int ai = 0; ai < 2; ++ai)
#pragma unroll
            for (int m = 0; m < 4; ++m) { const size_t off = (size_t)(row0 + ai * HALF + m * 16) * ldc + col0;
#pragma unroll
                for (int bj = 0; bj < 2; ++bj)
#pragma unroll
                    for (int n = 0; n < 2; ++n) { const size_t ix = off + bj * HALF + n * 16; *(f32x4*)(out + ix) = *(const f32x4*)(base + ix) + acc[ai][bj][m][n]; } }
    }
};
struct EpiSwiglu {
    static constexpr bool PERM = true, AFTER_DRAIN = false;
    bf16_t* O; int ldh;
    __device__ __forceinline__ void operator()(const f32x4 (&acc)[2][2][4][2], const Unit& u, int wr, int wc, int fr, int fq) const {
        const int row0 = u.pm * BM + wr * 64 + fr; const int f0 = (u.pn * BM + wc * 32 + 8 * fq) >> 1;
        typedef unsigned u32x2 __attribute__((ext_vector_type(2)));
#pragma unroll
        for (int ai = 0; ai < 2; ++ai)
#pragma unroll
            for (int m = 0; m < 4; ++m) { bf16_t* rowp = O + (size_t)(row0 + ai * HALF + m * 16) * ldh + f0;
#pragma unroll
                for (int bj = 0; bj < 2; ++bj) { const f32x4 v0 = acc[ai][bj][m][0], v1 = acc[ai][bj][m][1];
                    u32x2 w; w.x = cvt_pk_bf16(silu_f(v0[0]) * v0[1], silu_f(v0[2]) * v0[3]); w.y = cvt_pk_bf16(silu_f(v1[0]) * v1[1], silu_f(v1[2]) * v1[3]);
                    *(u32x2*)(rowp + bj * (HALF / 2)) = w; } }
    }
};
template <class Epi, class Sched, bool ALIGN_EPI = false, bool SP2 = false>
__device__ __forceinline__ void gemm_phase(PG8_LAS unsigned char* lds, const Gemm g, const Sched& S, const Epi& E) {
    int tid_o = threadIdx.x; asm volatile("" : "+v"(tid_o));
    const int tid = tid_o, wid = __builtin_amdgcn_readfirstlane(tid >> 6), lane = tid & 63, wr = wid >> 2, wc = wid & 3, fr = lane & 15, fq = lane >> 4;
    const int K = g.K, nt = K / BK;
    unsigned voffA[2], voffB[2];
#pragma unroll
    for (int i = 0; i < 2; ++i) { int R, C; stage_rc(tid * 16 + i * 8192, R, C); const int Rb = Epi::PERM ? ((R & ~31) + perm32(R & 31)) : R;
        voffA[i] = (unsigned)(R * K + C) * 2u; voffB[i] = (unsigned)(Rb * K + C) * 2u; }
    const size_t kstep = (size_t)(BK * 2);
    const size_t hstep = (size_t)HALF * K * 2;
    const size_t tstep = 2 * hstep;
    const unsigned ldsw = (unsigned)wid * 1024u;
    const int aoff = lds_byte(wr * 64 + fr, fq * 8), boff = lds_byte(wc * 32 + fr, fq * 8);
#define PG8_SA(b, h) (((b) * 2 + (h)) * HTB)
#define PG8_SB(b, h) ((4 + (b) * 2 + (h)) * HTB)
#define PG8_STAGE(bufoff, gbase, voff) do { _Pragma("unroll") for (int _i = 0; _i < 2; ++_i) \
        __builtin_amdgcn_global_load_lds((const unsigned*)((const char*)(gbase) + (voff)[_i]), (PG8_LAS unsigned*)(lds + (bufoff) + ldsw + _i * 8192), 16, 0, 0); } while (0)
#define PG8_LDA(dst, b, h) do { _Pragma("unroll") for (int m = 0; m < 4; ++m) _Pragma("unroll") for (int k = 0; k < 2; ++k) dst[m][k] = *(const PG8_LAS bf16x8*)(lds + PG8_SA(b, h) + aoff + m * 2048 + k * 1024); } while (0)
#define PG8_LDB(dst, b, h) do { _Pragma("unroll") for (int n = 0; n < 2; ++n) _Pragma("unroll") for (int k = 0; k < 2; ++k) dst[n][k] = *(const PG8_LAS bf16x8*)(lds + PG8_SB(b, h) + boff + n * 2048 + k * 1024); } while (0)
#define PG8_MMA(ai, bj, At, Bt) do { __builtin_amdgcn_s_setprio(1); _Pragma("unroll") for (int m = 0; m < 4; ++m) _Pragma("unroll") for (int n = 0; n < 2; ++n) _Pragma("unroll") for (int k = 0; k < 2; ++k) \
        acc[ai][bj][m][n] = __builtin_amdgcn_mfma_f32_16x16x32_bf16(Bt[n][k], At[m][k], acc[ai][bj][m][n], 0, 0, 0); __builtin_amdgcn_s_setprio(0); } while (0)
#define PG8_WAIT_V(n) asm volatile("s_waitcnt vmcnt(" #n ")" ::: "memory")
#define PG8_WAIT_L(n) asm volatile("s_waitcnt lgkmcnt(" #n ")" ::: "memory")
#define PG8_BAR __builtin_amdgcn_s_barrier()
#define PG8_SCHED __builtin_amdgcn_sched_barrier(0)
    Unit cur, nxt; int ui = 0;
    if (!S.next(0, cur)) return;
    f32x4 acc[2][2][4][2];
#pragma unroll
    for (int a = 0; a < 2; ++a)
#pragma unroll
        for (int b = 0; b < 2; ++b)
#pragma unroll
            for (int m = 0; m < 4; ++m)
#pragma unroll
                for (int n = 0; n < 2; ++n) acc[a][b][m][n] = (f32x4){0.f, 0.f, 0.f, 0.f};
    bf16x8 At[4][2], B0[2][2], B1[2][2];
    const char* cA = (const char*)g.A + (size_t)cur.pm * tstep; const char* cB = (const char*)g.Bt + g.grp_off(cur.pm) + (size_t)cur.pn * tstep;
    S.a_ready(cur);
    if constexpr (SP2) {
        PG8_STAGE(PG8_SB(0, 0), cB, voffB); PG8_STAGE(PG8_SB(0, 1), cB + hstep, voffB); PG8_STAGE(PG8_SA(0, 0), cA, voffA); PG8_STAGE(PG8_SA(0, 1), cA + hstep, voffA);
        if (wr == 1) PG8_BAR;
        PG8_WAIT_V(2); PG8_BAR;
        PG8_STAGE(PG8_SB(1, 0), cB + kstep, voffB); PG8_STAGE(PG8_SA(1, 0), cA + kstep, voffA); PG8_STAGE(PG8_SB(1, 1), cB + hstep + kstep, voffB);
        PG8_WAIT_V(6); PG8_BAR;
    } else {
        PG8_STAGE(PG8_SB(0, 0), cB, voffB); PG8_STAGE(PG8_SA(0, 0), cA, voffA); PG8_STAGE(PG8_SB(0, 1), cB + hstep, voffB); PG8_STAGE(PG8_SA(0, 1), cA + hstep, voffA);
        if (wr == 1) PG8_BAR;
        PG8_WAIT_V(4); PG8_BAR;
        PG8_STAGE(PG8_SB(1, 0), cB + kstep, voffB); PG8_STAGE(PG8_SA(1, 0), cA + kstep, voffA); PG8_STAGE(PG8_SB(1, 1), cB + hstep + kstep, voffB);
        PG8_WAIT_V(6); PG8_BAR;
    }
    for (;;) {
        const bool has_next = S.next(ui + 1, nxt);
        const char* nA = has_next ? (const char*)g.A + (size_t)nxt.pm * tstep : cA; const char* nB = has_next ? (const char*)g.Bt + g.grp_off(nxt.pm) + (size_t)nxt.pn * tstep : cB;
        for (int t = 0; t < nt; t += 2) {
            const bool last = (t == nt - 2);
            const char* a1 = cA + (size_t)(t + 1) * kstep;
            const char* a2 = last ? nA : cA + (size_t)(t + 2) * kstep; const char* b2 = last ? nB : cB + (size_t)(t + 2) * kstep;
            const char* a3 = a2 + kstep; const char* b3 = b2 + kstep;
            if (last && has_next) S.a_ready(nxt);
            if constexpr (SP2) {
            PG8_LDB(B0, 0, 0); PG8_LDB(B1, 0, 1); PG8_SCHED; PG8_LDA(At, 0, 0); PG8_STAGE(PG8_SA(1, 1), a1 + hstep, voffA);
            PG8_WAIT_V(8); PG8_WAIT_L(0); PG8_BAR; PG8_MMA(0, 0, At, B0); PG8_MMA(0, 1, At, B1); PG8_BAR; PG8_SCHED;
            PG8_LDA(At, 0, 1); PG8_STAGE(PG8_SB(0, 0), b2, voffB); PG8_STAGE(PG8_SB(0, 1), b2 + hstep, voffB); PG8_STAGE(PG8_SA(0, 0), a2, voffA);
            PG8_WAIT_V(8); PG8_WAIT_L(0); PG8_BAR; PG8_MMA(1, 0, At, B0); PG8_MMA(1, 1, At, B1); PG8_BAR; PG8_SCHED;
            PG8_LDB(B0, 1, 0); PG8_LDB(B1, 1, 1); PG8_SCHED; PG8_LDA(At, 1, 0); PG8_STAGE(PG8_SA(0, 1), a2 + hstep, voffA);
            PG8_WAIT_V(8); PG8_WAIT_L(0); PG8_BAR; PG8_MMA(0, 0, At, B0); PG8_MMA(0, 1, At, B1); PG8_BAR; PG8_SCHED;
            PG8_LDA(At, 1, 1); PG8_STAGE(PG8_SB(1, 0), b3, voffB); PG8_STAGE(PG8_SB(1, 1), b3 + hstep, voffB); PG8_STAGE(PG8_SA(1, 0), a3, voffA);
            PG8_WAIT_V(8); PG8_WAIT_L(0); PG8_BAR; PG8_MMA(1, 0, At, B0); PG8_MMA(1, 1, At, B1); PG8_BAR; PG8_SCHED;
            } else {
            PG8_LDB(B0, 0, 0); PG8_SCHED; PG8_LDA(At, 0, 0); PG8_STAGE(PG8_SA(1, 1), a1 + hstep, voffA);
            PG8_WAIT_L(8); PG8_BAR; PG8_WAIT_L(0); PG8_MMA(0, 0, At, B0); PG8_BAR; PG8_SCHED;
            PG8_LDB(B1, 0, 1); PG8_STAGE(PG8_SB(0, 0), b2, voffB);
            PG8_BAR; PG8_WAIT_L(0); PG8_MMA(0, 1, At, B1); PG8_BAR;
            PG8_LDA(At, 0, 1); PG8_STAGE(PG8_SA(0, 0), a2, voffA);
            PG8_BAR; PG8_WAIT_L(0); PG8_MMA(1, 0, At, B0); PG8_BAR; PG8_SCHED;
            PG8_STAGE(PG8_SB(0, 1), b2 + hstep, voffB);
            PG8_WAIT_V(6); PG8_BAR; PG8_MMA(1, 1, At, B1); PG8_BAR;
            PG8_LDB(B0, 1, 0); PG8_SCHED; PG8_LDA(At, 1, 0); PG8_STAGE(PG8_SA(0, 1), a2 + hstep, voffA);
            PG8_WAIT_L(8); PG8_BAR; PG8_WAIT_L(0); PG8_MMA(0, 0, At, B0); PG8_BAR; PG8_SCHED;
            PG8_LDB(B1, 1, 1); PG8_STAGE(PG8_SB(1, 0), b3, voffB);
            PG8_BAR; PG8_WAIT_L(0); PG8_MMA(0, 1, At, B1); PG8_BAR;
            PG8_LDA(At, 1, 1); PG8_STAGE(PG8_SA(1, 0), a3, voffA);
            PG8_BAR; PG8_WAIT_L(0); PG8_MMA(1, 0, At, B0); PG8_BAR; PG8_SCHED;
            PG8_STAGE(PG8_SB(1, 1), b3 + hstep, voffB);
            PG8_WAIT_V(6); PG8_BAR; PG8_MMA(1, 1, At, B1); PG8_BAR;
            }
        }
        if constexpr (ALIGN_EPI) { if (wr == 0) PG8_BAR; }
        if constexpr (!Epi::AFTER_DRAIN) { E(acc, cur, wr, wc, fr, fq); S.done(cur); }
        if (!has_next) break;
#pragma unroll
        for (int a = 0; a < 2; ++a)
#pragma unroll
            for (int b = 0; b < 2; ++b)
#pragma unroll
                for (int m = 0; m < 4; ++m)
#pragma unroll
                    for (int n = 0; n < 2; ++n) acc[a][b][m][n] = (f32x4){0.f, 0.f, 0.f, 0.f};
        cur = nxt; cA = nA; cB = nB; ++ui;
        if constexpr (ALIGN_EPI) { if (wr == 1) PG8_BAR; }
    }
    PG8_WAIT_V(0);
    if constexpr (!ALIGN_EPI) { if (wr == 0) PG8_BAR; }
    PG8_BAR;
    if constexpr (Epi::AFTER_DRAIN) { E.fused(acc, cur, wr, wc, fr, fq, lds, wid, lane); S.done(cur); }
#undef PG8_SA
#undef PG8_SB
#undef PG8_STAGE
#undef PG8_LDA
#undef PG8_LDB
#undef PG8_MMA
#undef PG8_WAIT_V
#undef PG8_WAIT_L
#undef PG8_BAR
#undef PG8_SCHED
}
}
#define GAS __attribute__((address_space(1)))
#define LAS __attribute__((address_space(3)))
typedef unsigned short bf16;
typedef unsigned v4u __attribute__((ext_vector_type(4)));
typedef float f32x4 __attribute__((ext_vector_type(4)));
typedef short bf16x8 __attribute__((ext_vector_type(8)));
typedef GAS unsigned gu32;
typedef GAS unsigned long long gu64;
#define RLX_AGENT __ATOMIC_RELAXED, __HIP_MEMORY_SCOPE_AGENT
#define LDS_WAIT() asm volatile("s_waitcnt lgkmcnt(0)" ::: "memory")
#define VM_WAIT() asm volatile("s_waitcnt vmcnt(0)" ::: "memory")
__device__ __forceinline__ unsigned long long rt() { return __builtin_amdgcn_s_memrealtime(); }
__device__ __forceinline__ unsigned f2bf(float f) { unsigned u = __builtin_bit_cast(unsigned, f); return (u + 0x7fffu + ((u >> 16) & 1u)) >> 16; }
__device__ __forceinline__ unsigned pk2(float lo, float hi) { return f2bf(lo) | (f2bf(hi) << 16); }
#define XB_TMO      128
#define XB_XCNT(j)  (256  + 64 * (j))
#define XB_XSUB(j)  (1280 + 64 * (j))
#define XB_XGEN(j)  (2304 + 64 * (j))
#define XB_TOP      3328
#define XB_TOPGEN   3392
#define XCD_BAR_WORDS 3456
#define XB_SPIN_CAP (1u << 18)

__device__ __forceinline__ unsigned xb_ld(unsigned* p)              { return __hip_atomic_load(p, __ATOMIC_RELAXED, __HIP_MEMORY_SCOPE_AGENT); }
__device__ __forceinline__ unsigned xb_add(unsigned* p, unsigned v) { return __hip_atomic_fetch_add(p, v, __ATOMIC_RELAXED, __HIP_MEMORY_SCOPE_AGENT); }
__device__ __forceinline__ unsigned xb_xcc_id() { return (unsigned)__builtin_amdgcn_s_getreg((3 << 11) | 20) & 0xFu; }
#define XB_SPIN(cond, bar) do { unsigned _sp = 0; while (cond) { __builtin_amdgcn_s_sleep(1); \
    if ((++_sp & 255u) == 0u) { if (xb_ld(&(bar)[XB_TMO])) break; if (_sp > XB_SPIN_CAP) { atomicAdd(&(bar)[XB_TMO], 1u); break; } } } } while (0)

struct XcdBarrier {
    unsigned* bar; unsigned x;
    volatile LAS unsigned* st;
};

__device__ __forceinline__ XcdBarrier xcd_barrier_post(unsigned* bar, volatile LAS unsigned* st) {
    XcdBarrier b; b.bar = bar; b.x = xb_xcc_id(); b.st = st;
    if (threadIdx.x == 0) (void)xb_add(&bar[XB_XCNT(b.x)], 1u);
    return b;
}
__device__ __forceinline__ void xcd_barrier_complete(unsigned* bar, unsigned x, unsigned& nloc, unsigned& nx) {
    const unsigned G = gridDim.x * gridDim.y * gridDim.z;
    unsigned sum, cnt, mine, sp = 0u;
    for (;;) {
        sum = 0u; cnt = 0u; mine = 0u;
#pragma unroll
        for (unsigned j = 0; j < 16; ++j) { const unsigned c = xb_ld(&bar[XB_XCNT(j)]); sum += c; cnt += (c > 0u) ? 1u : 0u; mine = (j == x) ? c : mine; }
        if (sum == G) break;
        __builtin_amdgcn_s_sleep(1);
        if ((++sp & 255u) == 0u) { if (xb_ld(&bar[XB_TMO])) break; if (sp > XB_SPIN_CAP) { atomicAdd(&bar[XB_TMO], 1u); break; } }
    }
    nloc = mine > 0u ? mine : 1u; nx = cnt > 0u ? cnt : 1u;
}

__device__ __forceinline__ void xcd_barrier(const XcdBarrier& b) {
    asm volatile("s_waitcnt vmcnt(0)" ::: "memory");
    __syncthreads();
    if (threadIdx.x == 0) {
        unsigned* bar = b.bar;
        __builtin_amdgcn_s_waitcnt(0);
        unsigned nloc = b.st[0], nx = b.st[1];
        if (nloc == 0u) { xcd_barrier_complete(bar, b.x, nloc, nx); b.st[0] = nloc; b.st[1] = nx; }
        const unsigned old = xb_add(&bar[XB_XSUB(b.x)], 1u);
        const unsigned gen = old / nloc;
        if (old + 1u == (gen + 1u) * nloc) {
            __builtin_amdgcn_fence(__ATOMIC_RELEASE, "agent");
            asm volatile("s_waitcnt vmcnt(0)" ::: "memory");
            const unsigned og = xb_add(&bar[XB_TOP], 1u);
            const unsigned tg = og / nx;
            if (og + 1u == (tg + 1u) * nx) xb_add(&bar[XB_TOPGEN], 1u);
            else XB_SPIN(xb_ld(&bar[XB_TOPGEN]) == tg, bar);
            __builtin_amdgcn_fence(__ATOMIC_ACQUIRE, "agent");
            xb_add(&bar[XB_XGEN(b.x)], 1u);
            asm volatile("s_waitcnt vmcnt(0)" ::: "memory");
        } else {
            XB_SPIN(xb_ld(&bar[XB_XGEN(b.x)]) == gen, bar);
            __builtin_amdgcn_fence(__ATOMIC_ACQUIRE, "agent");
            asm volatile("s_waitcnt vmcnt(0)" ::: "memory");
        }
    }
    __syncthreads();
}
constexpr int NB = 4, SEQ = 8192, DM = 1024, M = NB * SEQ, DEPTH = 2;
constexpr int NCHUNK = SEQ / 64;
constexpr int CONV_CH = 4608, NWA = 4864  , NGATE = 2048, NEXP = 16, EFF = 512, CAP = 1024;
constexpr int MEXP = NB * NEXP * CAP;
constexpr float EPS = 1e-6f;
constexpr int NWAVES = 8;
constexpr size_t MiB = 1u << 20;
constexpr size_t WS_CTL = 0, CTL_ZERO_BYTES = 1 * MiB;
constexpr size_t WS_WA = 1 * MiB;
constexpr size_t WS_WB = 11 * MiB;
constexpr size_t WS_WO = 15 * MiB;
constexpr size_t WS_XN = 19 * MiB;
constexpr size_t WS_RAW = 83 * MiB;
constexpr size_t WS_SCAL = 371 * MiB;
constexpr size_t WS_OG = 19 * MiB;
constexpr size_t WS_YS = 443 * MiB;
constexpr size_t WS_XN2 = 83 * MiB;
constexpr size_t WS_GATES = 147 * MiB;
constexpr size_t WS_MIXED = 147 * MiB;
constexpr size_t WS_WGU = 83 * MiB;
constexpr size_t WS_WD = 115 * MiB;
constexpr size_t WS_XG = 131 * MiB;
constexpr size_t WS_HMID = 259 * MiB;
constexpr size_t WS_AFF = 323 * MiB;
constexpr size_t WS_IDX = 325 * MiB;
constexpr size_t WS_VAL = 326 * MiB;
constexpr size_t WS_INV = 327 * MiB;
constexpr size_t WS_END = 507 * MiB;
constexpr int CW_TMO = 0, CW_BAR = 4096;
constexpr int LDS_BYTES = 163840;
constexpr int MISC_OFF = LDS_BYTES - 256;

typedef short bf16x8 __attribute__((ext_vector_type(8)));
typedef short bf16x4 __attribute__((ext_vector_type(4)));
typedef float f32x4 __attribute__((ext_vector_type(4)));
typedef float f32x2 __attribute__((ext_vector_type(2)));
typedef unsigned u32x4 __attribute__((ext_vector_type(4)));
typedef unsigned u32x2 __attribute__((ext_vector_type(2)));
typedef __bf16 bf16x2_t __attribute__((ext_vector_type(2)));
typedef short s16x2 __attribute__((ext_vector_type(2)));

__device__ __forceinline__ float bf2f(unsigned short v) { return __uint_as_float((unsigned)v << 16); }
__device__ __forceinline__ float bf2f_s(short v) { return __uint_as_float((unsigned)(unsigned short)v << 16); }
__device__ __forceinline__ unsigned pkbf(float lo, float hi) { f32x2 v = {lo, hi}; bf16x2_t b = __builtin_convertvector(v, bf16x2_t); return __builtin_bit_cast(unsigned, b); }
__device__ __forceinline__ unsigned short f2bf1(float f) { return (unsigned short)(pkbf(f, 0.f) & 0xffffu); }
__device__ __forceinline__ float silu(float x) { return x * __builtin_amdgcn_rcpf(1.0f + __builtin_amdgcn_exp2f(-1.4426950408889634f * x)); }
__device__ __forceinline__ float softplus_f(float x) { return x > 20.f ? x : log1pf(expf(x)); }
__device__ __forceinline__ float sigmoid_f(float x) { return 1.0f / (1.0f + expf(-x)); }
__device__ __forceinline__ void atomic_add_bf16x2(bf16* p, float a, float b) {
    (void)__builtin_amdgcn_global_atomic_fadd_v2bf16((GAS s16x2*)p, __builtin_bit_cast(s16x2, pkbf(a, b)));
}
__device__ __forceinline__ float wave_sum(float v) {
#pragma unroll
    for (int o = 1; o < 64; o <<= 1) v += __shfl_xor(v, o);
    return v;
}

template <int MT, int NT>
__device__ __forceinline__ void mma_lds(f32x4 (&acc)[MT][NT], const LAS bf16* A, int lda, int m0, const LAS bf16* Bt, int ldb, int n0, int K, int fr, int fq) {
    for (int k0 = 0; k0 < K; k0 += 32) {
        bf16x8 a[MT], b[NT];
#pragma unroll
        for (int mt = 0; mt < MT; ++mt) a[mt] = *(const LAS bf16x8*)(A + (m0 + mt * 16 + fr) * lda + k0 + fq * 8);
#pragma unroll
        for (int nt = 0; nt < NT; ++nt) b[nt] = *(const LAS bf16x8*)(Bt + (n0 + nt * 16 + fr) * ldb + k0 + fq * 8);
#pragma unroll
        for (int mt = 0; mt < MT; ++mt)
#pragma unroll
            for (int nt = 0; nt < NT; ++nt) acc[mt][nt] = __builtin_amdgcn_mfma_f32_16x16x32_bf16(a[mt], b[nt], acc[mt][nt], 0, 0, 0);
    }
}

__device__ __forceinline__ void conv16(float (&acc)[16], const LAS bf16* src, int ld, const LAS float* cw, int cwld) {
#pragma unroll
    for (int c = 0; c < 16; ++c) acc[c] = cw[7 * cwld + c];
#pragma unroll
    for (int tap = 0; tap < 7; ++tap) {
        const bf16x8 x0 = *(const LAS bf16x8*)(src + tap * ld), x1 = *(const LAS bf16x8*)(src + tap * ld + 8);
        const LAS float* w = cw + tap * cwld;
#pragma unroll
        for (int c = 0; c < 8; ++c) { acc[c] += bf2f_s(x0[c]) * w[c]; acc[8 + c] += bf2f_s(x1[c]) * w[8 + c]; }
        if (tap & 1) asm volatile("" ::: "memory");
    }
}
__device__ __forceinline__ void conv8(float (&acc)[8], const LAS bf16* src, int ld, const LAS float* cw, int cwld) {
#pragma unroll
    for (int c = 0; c < 8; ++c) acc[c] = cw[7 * cwld + c];
#pragma unroll
    for (int tap = 0; tap < 7; ++tap) {
        const bf16x8 x0 = *(const LAS bf16x8*)(src + tap * ld);
        const LAS float* w = cw + tap * cwld;
#pragma unroll
        for (int c = 0; c < 8; ++c) acc[c] += bf2f_s(x0[c]) * w[c];
        if (tap & 1) asm volatile("" ::: "memory");
    }
}

__device__ __forceinline__ void transpose_item(const float* W, int K, int N, int k0, int n0, bf16* WT, int drow0, int rmul, LAS float* scr, int lane) {
#pragma unroll 8
    for (int i = 0; i < 32; ++i) { const int kk = 2 * i + (lane >> 5); scr[kk * 33 + (lane & 31)] = W[(size_t)(k0 + kk) * N + n0 + (lane & 31)]; }
    LDS_WAIT(); asm volatile("" ::: "memory");
    const int c = lane & 7;
#pragma unroll
    for (int j = 0; j < 4; ++j) { const int n = (lane >> 3) + 8 * j; const LAS float* s = scr + (8 * c) * 33 + n;
        u32x4 o; o.x = pkbf(s[0 * 33], s[1 * 33]); o.y = pkbf(s[2 * 33], s[3 * 33]); o.z = pkbf(s[4 * 33], s[5 * 33]); o.w = pkbf(s[6 * 33], s[7 * 33]);
        *(GAS u32x4*)(WT + (size_t)(drow0 + rmul * n) * K + k0 + 8 * c) = o; }
    LDS_WAIT(); asm volatile("" ::: "memory");
}
__device__ __forceinline__ void cvt_mixer_weights(LAS unsigned char* lds, unsigned char* ws, const float* w_in, const float* w_out, int gw, int NGW, int wave, int lane) {
    LAS float* scr = (LAS float*)(lds + wave * 16384);
    bf16* WA = (bf16*)(ws + WS_WA); bf16* WB = (bf16*)(ws + WS_WB); bf16* WO = (bf16*)(ws + WS_WO);
    constexpr int I_IN = 16 * 210, I_OUT = 32 * 32;
    for (int it = gw; it < I_IN + I_OUT; it += NGW) {
        if (it < I_IN) { const int kb = it / 210, nb = it % 210, n0 = nb * 32;
            bf16* dst; int drow;
            if (n0 < 4608) { dst = WA; drow = n0; } else if (n0 < 6656) { dst = WB; drow = n0 - 4608; } else { dst = WA; drow = 4608 + (n0 - 6656); }
            transpose_item(w_in, 1024, 6720, kb * 64, n0, dst, drow, 1, scr, lane);
        } else { const int r = it - I_IN, kb = r / 32, nb = r % 32; transpose_item(w_out, 2048, 1024, kb * 64, nb * 32, WO, nb * 32, 1, scr, lane); }
    }
    for (int r = gw; r < 192; r += NGW) { GAS u32x4* p = (GAS u32x4*)(WA + (size_t)(4672 + r) * 1024) + lane; p[0] = (u32x4){0u, 0u, 0u, 0u}; p[64] = (u32x4){0u, 0u, 0u, 0u}; }
}
__device__ __forceinline__ void cvt_expert_weights(LAS unsigned char* lds, unsigned char* ws, const float* w_gate, const float* w_up, const float* w_down, int gw, int NGW, int wave, int lane) {
    LAS float* scr = (LAS float*)(lds + wave * 16384);
    bf16* WGU = (bf16*)(ws + WS_WGU); bf16* WD = (bf16*)(ws + WS_WD);
    constexpr int I_G = 16 * 16;
    constexpr int I_D = 8 * 32;
    constexpr int PER_E = 2 * I_G + I_D;
    for (int it = gw; it < NEXP * PER_E; it += NGW) {
        const int e = it / PER_E; int r = it % PER_E;
        if (r < 2 * I_G) { const int up = r >= I_G; if (up) r -= I_G; const int kb = r / 16, nb = r % 16;
            transpose_item((up ? w_up : w_gate) + (size_t)e * 1024 * 512, 1024, 512, kb * 64, nb * 32, WGU + (size_t)e * 1024 * 1024, 2 * (nb * 32) + up, 2, scr, lane);
        } else { r -= 2 * I_G; const int kb = r / 32, nb = r % 32;
            transpose_item(w_down + (size_t)e * 512 * 1024, 512, 1024, kb * 64, nb * 32, WD + (size_t)e * 1024 * 512, nb * 32, 1, scr, lane); }
    }
}

__device__ __forceinline__ void rms_row_regs(const float* xrow, const f32x4 (&w)[4], f32x4 (&v)[4], int lane) {
    const GAS f32x4* xr = (const GAS f32x4*)xrow + lane; float s = 0.f;
#pragma unroll
    for (int j = 0; j < 4; ++j) { v[j] = xr[64 * j]; s += (v[j].x * v[j].x + v[j].y * v[j].y) + (v[j].z * v[j].z + v[j].w * v[j].w); }
    const float rstd = 1.0f / sqrtf(wave_sum(s) * (1.0f / DM) + EPS);
#pragma unroll
    for (int j = 0; j < 4; ++j) v[j] = v[j] * rstd * w[j];
}
__device__ __forceinline__ void store_row_bf16(bf16* orow, const f32x4 (&v)[4], int lane) {
    GAS u32x2* o8 = (GAS u32x2*)orow + lane;
#pragma unroll
    for (int j = 0; j < 4; ++j) { u32x2 t; t.x = pkbf(v[j].x, v[j].y); t.y = pkbf(v[j].z, v[j].w); o8[64 * j] = t; }
}
__device__ __forceinline__ void load_w4(const float* w, f32x4 (&wv)[4], int lane) {
#pragma unroll
    for (int j = 0; j < 4; ++j) wv[j] = ((const GAS f32x4*)w)[lane + 64 * j];
}
__device__ __forceinline__ void phase_norm(const float* src, const float* w, bf16* XN, int gw, int NGW, int lane) {
    f32x4 wv[4]; load_w4(w, wv, lane);
    for (int m = gw; m < M; m += NGW) { f32x4 v[4]; rms_row_regs(src + (size_t)m * DM, wv, v, lane); store_row_bf16(XN + (size_t)m * DM, v, lane); }
}
__device__ __forceinline__ void zero_region(unsigned char* p, size_t bytes, int gtid, int NGT) {
    GAS u32x4* q = (GAS u32x4*)p; const size_t n = bytes / 16;
    for (size_t i = gtid; i < n; i += NGT) q[i] = (u32x4){0u, 0u, 0u, 0u};
}

__device__ __forceinline__ void phase_norm2_router(LAS unsigned char* lds, const float* h, const float* w2, const float* w_router, bf16* XN, float* aff, int gw, int NGW, int tid, int lane) {
    LAS float* wrT = (LAS float*)lds;
    for (int e = tid; e < 16 * 1024; e += 512) { const int k = e >> 4, x = e & 15; wrT[x * 1024 + k] = w_router[e]; }
    __syncthreads();
    f32x4 wv[4]; load_w4(w2, wv, lane);
    for (int m = gw; m < M; m += NGW) {
        f32x4 v[4]; rms_row_regs(h + (size_t)m * DM, wv, v, lane); store_row_bf16(XN + (size_t)m * DM, v, lane);
        float mine = 0.f;
#pragma unroll 1
        for (int x = 0; x < 16; ++x) { float s = 0.f;
#pragma unroll
            for (int j = 0; j < 4; ++j) { const f32x4 wr = *(const LAS f32x4*)(wrT + x * 1024 + 4 * lane + 256 * j); s += (v[j].x * wr.x + v[j].y * wr.y) + (v[j].z * wr.z + v[j].w * wr.w); }
            s = wave_sum(s); mine = (lane == x) ? s : mine; }
        float mx = mine;
        mx = fmaxf(mx, __shfl_xor(mx, 1)); mx = fmaxf(mx, __shfl_xor(mx, 2)); mx = fmaxf(mx, __shfl_xor(mx, 4)); mx = fmaxf(mx, __shfl_xor(mx, 8));
        const float ex = expf(mine - mx); float den = ex;
        den += __shfl_xor(den, 1); den += __shfl_xor(den, 2); den += __shfl_xor(den, 4); den += __shfl_xor(den, 8);
        if (lane < 16) aff[(size_t)m * 16 + lane] = ex / den;
    }
}

__device__ __forceinline__ void phase_finish(const bf16* og, const bf16* ys, const bf16* yi, const bf16* gates, const float* gnw, const float* snw, bf16* mixed, int gw, int NGW, int lane) {
    float gw_[16], sw_[16];
#pragma unroll
    for (int c = 0; c < 16; ++c) { gw_[c] = gnw[(16 * lane + c) & 127]; sw_[c] = snw[16 * lane + c]; }
    for (int m = gw; m < M; m += NGW) {
        const bf16x8 o0 = *(const GAS bf16x8*)(og + (size_t)m * 1024 + 16 * lane), o1 = *(const GAS bf16x8*)(og + (size_t)m * 1024 + 16 * lane + 8);
        const bf16x8 y0 = *(const GAS bf16x8*)(ys + (size_t)m * 1024 + 16 * lane), y1 = *(const GAS bf16x8*)(ys + (size_t)m * 1024 + 16 * lane + 8);
        const bf16x8 i0 = *(const GAS bf16x8*)(yi + (size_t)m * 1024 + 16 * lane), i1 = *(const GAS bf16x8*)(yi + (size_t)m * 1024 + 16 * lane + 8);
        const bf16x8 g0 = *(const GAS bf16x8*)(gates + (size_t)m * 2048 + 16 * lane), g1 = *(const GAS bf16x8*)(gates + (size_t)m * 2048 + 16 * lane + 8);
        const bf16x8 z0 = *(const GAS bf16x8*)(gates + (size_t)m * 2048 + 1024 + 16 * lane), z1 = *(const GAS bf16x8*)(gates + (size_t)m * 2048 + 1024 + 16 * lane + 8);
        float o[16], t[16]; float so = 0.f, st = 0.f;
#pragma unroll
        for (int c = 0; c < 8; ++c) { o[c] = bf2f_s(o0[c]); o[8 + c] = bf2f_s(o1[c]); t[c] = (bf2f_s(y0[c]) + bf2f_s(i0[c])) * silu(bf2f_s(z0[c])); t[8 + c] = (bf2f_s(y1[c]) + bf2f_s(i1[c])) * silu(bf2f_s(z1[c])); }
#pragma unroll
        for (int c = 0; c < 16; ++c) { so += o[c] * o[c]; st += t[c] * t[c]; }
        so += __shfl_xor(so, 1); so += __shfl_xor(so, 2); so += __shfl_xor(so, 4);
        st += __shfl_xor(st, 1); st += __shfl_xor(st, 2); st += __shfl_xor(st, 4); st += __shfl_xor(st, 8); st += __shfl_xor(st, 16);
        const float ro = 1.0f / sqrtf(so * (1.0f / 128.f) + EPS), rt = 1.0f / sqrtf(st * (1.0f / 512.f) + EPS);
        float a[16], b2[16];
#pragma unroll
        for (int c = 0; c < 8; ++c) { a[c] = o[c] * ro * gw_[c] * silu(bf2f_s(g0[c])); a[8 + c] = o[8 + c] * ro * gw_[8 + c] * silu(bf2f_s(g1[c])); }
#pragma unroll
        for (int c = 0; c < 16; ++c) b2[c] = t[c] * rt * sw_[c];
        u32x4 w0, w1, w2, w3;
        w0.x = pkbf(a[0], a[1]); w0.y = pkbf(a[2], a[3]); w0.z = pkbf(a[4], a[5]); w0.w = pkbf(a[6], a[7]);
        w1.x = pkbf(a[8], a[9]); w1.y = pkbf(a[10], a[11]); w1.z = pkbf(a[12], a[13]); w1.w = pkbf(a[14], a[15]);
        w2.x = pkbf(b2[0], b2[1]); w2.y = pkbf(b2[2], b2[3]); w2.z = pkbf(b2[4], b2[5]); w2.w = pkbf(b2[6], b2[7]);
        w3.x = pkbf(b2[8], b2[9]); w3.y = pkbf(b2[10], b2[11]); w3.z = pkbf(b2[12], b2[13]); w3.w = pkbf(b2[14], b2[15]);
        GAS u32x4* mp = (GAS u32x4*)(mixed + (size_t)m * 2048 + 16 * lane);
        mp[0] = w0; mp[1] = w1; mp[128] = w2; mp[129] = w3;
    }
}

__device__ __forceinline__ void phase_topk(LAS unsigned char* lds, const float* aff, int* idx, float* val, int* inv, int be, int tid, int wave, int lane) {
    LAS unsigned* hist = (LAS unsigned*)lds;
    LAS unsigned* ctl = hist + 256;
    LAS unsigned* wsum = hist + 320;
    const int b = be >> 4, e = be & 15;
    unsigned key[16];
#pragma unroll
    for (int i = 0; i < 16; ++i) key[i] = __float_as_uint(aff[((size_t)b * SEQ + tid * 16 + i) * 16 + e]);
    unsigned prefix = 0u, mask = 0u; unsigned krem = CAP;
    for (int pass = 0; pass < 4; ++pass) {
        const int shift = 24 - 8 * pass;
        if (tid < 256) hist[tid] = 0u;
        __syncthreads();
#pragma unroll
        for (int i = 0; i < 16; ++i) if ((key[i] & mask) == prefix) atomicAdd((unsigned*)&hist[(key[i] >> shift) & 255u], 1u);
        __syncthreads();
        if (wave == 0) {
            const u32x4 hb = *(const LAS u32x4*)(hist + 4 * lane); const unsigned sl = hb.x + hb.y + hb.z + hb.w; unsigned S = sl;
#pragma unroll
            for (int o = 1; o < 64; o <<= 1) { const unsigned y = __shfl_down(S, o); if (lane + o < 64) S += y; }
            const unsigned above = S - sl;
            if (above < krem && krem <= above + sl) { unsigned cum = above; int d;
                if (cum + hb.w >= krem) d = 3; else { cum += hb.w; if (cum + hb.z >= krem) d = 2; else { cum += hb.z; if (cum + hb.y >= krem) d = 1; else { cum += hb.y; d = 0; } } }
                ctl[0] = prefix | ((unsigned)(4 * lane + d) << shift); ctl[1] = krem - cum; } }
        __syncthreads();
        prefix = ctl[0]; krem = ctl[1]; mask |= 255u << shift;
        __syncthreads();
    }
    const unsigned thr = prefix;
    int ngt = 0, neq = 0;
#pragma unroll
    for (int i = 0; i < 16; ++i) { ngt += key[i] > thr; neq += key[i] == thr; }
    int sg = ngt, sq = neq;
#pragma unroll
    for (int o = 1; o < 64; o <<= 1) { const int a = __shfl_up(sg, o), c = __shfl_up(sq, o); if (lane >= o) { sg += a; sq += c; } }
    if (lane == 63) { wsum[wave] = (unsigned)sg; wsum[8 + wave] = (unsigned)sq; }
    __syncthreads();
    int bg = 0, bq = 0;
#pragma unroll
    for (int w = 0; w < 8; ++w) if (w < wave) { bg += (int)wsum[w]; bq += (int)wsum[8 + w]; }
    int pg = bg + sg - ngt, pq = bq + sq - neq;
#pragma unroll
    for (int i = 0; i < 16; ++i) {
        const int tok = tid * 16 + i; const bool gt = key[i] > thr, eq = key[i] == thr;
        const bool sel = gt || (eq && pq < (int)krem);
        const int slot = pg + (pq < (int)krem ? pq : (int)krem);
        if (sel) { idx[be * CAP + slot] = tok; val[be * CAP + slot] = __uint_as_float(key[i]); }
        inv[((size_t)b * SEQ + tok) * 16 + e] = sel ? slot : -1;
        pg += gt; pq += eq;
    }
    __syncthreads();
}

__device__ __forceinline__ void phase_gather(const bf16* XN, const int* idx, bf16* XG, int gw, int NGW, int lane) {
    for (int r = gw; r < MEXP; r += NGW) {
        const int b = r >> 14; const int tok = idx[r];
        const GAS u32x4* s = (const GAS u32x4*)(XN + ((size_t)b * SEQ + tok) * DM) + lane; GAS u32x4* d = (GAS u32x4*)(XG + (size_t)r * DM) + lane;
        const u32x4 a = s[0], c = s[64]; d[0] = a; d[64] = c;
    }
}

__device__ __forceinline__ void phase_combine(const float* hin, float* hout, const bf16* Y, const int* inv, const float* val, const float* wn, bf16* XN, bool final_, int gw, int NGW, int lane, float pscale = 1.0f) {
    f32x4 wv[4]; load_w4(wn, wv, lane);
    for (int m = gw; m < M; m += NGW) {
        const int b = m >> 13;
        const GAS f32x4* xr = (const GAS f32x4*)(hin + (size_t)m * DM) + lane; f32x4 v[4];
#pragma unroll
        for (int j = 0; j < 4; ++j) v[j] = xr[64 * j];
        const int myslot = (lane < 16) ? inv[(size_t)m * 16 + lane] : -1;
        for (int e = 0; e < 16; ++e) {
            const int s = __shfl(myslot, e);
            if (s >= 0) {
                const int r = (b * 16 + e) * CAP + s; const float a = val[r];
                const GAS u32x2* yr = (const GAS u32x2*)(Y + (size_t)r * DM) + lane;
#pragma unroll
                for (int j = 0; j < 4; ++j) { const u32x2 t = yr[64 * j];
                    v[j].x += a * __uint_as_float(t.x << 16); v[j].y += a * __uint_as_float(t.x & 0xffff0000u); v[j].z += a * __uint_as_float(t.y << 16); v[j].w += a * __uint_as_float(t.y & 0xffff0000u); }
            }
        }
        float s2 = 0.f;
#pragma unroll
        for (int j = 0; j < 4; ++j) s2 += (v[j].x * v[j].x + v[j].y * v[j].y) + (v[j].z * v[j].z + v[j].w * v[j].w);
        const float rstd = 1.0f / sqrtf(wave_sum(s2) * (1.0f / DM) + EPS);
        GAS f32x4* ho = (GAS f32x4*)(hout + (size_t)m * DM) + lane;
        if (final_) {
#pragma unroll
            for (int j = 0; j < 4; ++j) ho[64 * j] = v[j] * (rstd * pscale) * wv[j];
        } else {
#pragma unroll
            for (int j = 0; j < 4; ++j) ho[64 * j] = v[j];
            f32x4 nv[4];
#pragma unroll
            for (int j = 0; j < 4; ++j) nv[j] = v[j] * rstd * wv[j];
            store_row_bf16(XN + (size_t)m * DM, nv, lane);
        }
    }
}
namespace gdn {
constexpr int CW = 0;
constexpr int SC = CW + 8 * 320 * 4;
constexpr int Q = SC + 1280;
constexpr int K = Q + 64 * 136 * 2;
constexpr int KDT = K + 64 * 136 * 2;
constexpr int VT = KDT + 128 * 72 * 2;
constexpr int T = VT + 64 * 72 * 2;
constexpr int QKD = T + 64 * 72 * 2;
constexpr int ST = QKD + 64 * 72 * 2;
constexpr int TMP = ST + 64 * 136 * 2;
constexpr int RQ = TMP, RK = RQ + 70 * 136 * 2, RV = RK + 70 * 136 * 2, RAW_END = RV + 70 * 72 * 2;
constexpr int AF = TMP, TF = AF + 64 * 68 * 4, XF = TF + 64 * 68 * 4, INV_END = XF + 3 * 16 * 17 * 4;
constexpr int RT = TMP, UT = RT + 64 * 72 * 2, OS = UT + 64 * 72 * 2, ST_END = OS + 64 * 65 * 4;
static_assert(RAW_END <= MISC_OFF && INV_END <= MISC_OFF && ST_END <= MISC_OFF, "gdn LDS map");
}
__device__ __forceinline__ void gdn_chain(LAS unsigned char* lds, int cid, const bf16* raw, const float* scal, const float* conv_w, const float* conv_b,
                                          const float* A_log, const float* dt_bias, bf16* og, int tid, int wave, int lane) {
    using namespace gdn;
    const int dvh = cid & 1, dir = (cid >> 1) & 1, h = (cid >> 2) & 7, b = cid >> 5;
    const int fr = lane & 15, fq = lane >> 4;
    LAS float* cw = (LAS float*)(lds + CW); LAS float* sc = (LAS float*)(lds + SC);
    LAS bf16* q_ = (LAS bf16*)(lds + Q); LAS bf16* k_ = (LAS bf16*)(lds + K); LAS bf16* kdT = (LAS bf16*)(lds + KDT); LAS bf16* vT = (LAS bf16*)(lds + VT);
    LAS bf16* T_ = (LAS bf16*)(lds + T); LAS bf16* QKd = (LAS bf16*)(lds + QKD); LAS bf16* ST_ = (LAS bf16*)(lds + ST);
    LAS bf16* rq = (LAS bf16*)(lds + RQ); LAS bf16* rk = (LAS bf16*)(lds + RK); LAS bf16* rv = (LAS bf16*)(lds + RV);
    LAS float* Af = (LAS float*)(lds + AF); LAS float* Tf = (LAS float*)(lds + TF); LAS float* Xf = (LAS float*)(lds + XF);
    LAS bf16* rT = (LAS bf16*)(lds + RT); LAS bf16* uT = (LAS bf16*)(lds + UT); LAS float* os = (LAS float*)(lds + OS);
    for (int e = tid; e < 8 * 320; e += 512) { const int r = e / 320, c = e % 320;
        const int gch = c < 128 ? h * 128 + c : (c < 256 ? 1024 + h * 128 + (c - 128) : 2048 + h * 128 + dvh * 64 + (c - 256));
        cw[e] = r < 7 ? conv_w[r * CONV_CH + gch] : conv_b[gch]; }
    for (int e = tid; e < 64 * 136 / 2; e += 512) ((LAS unsigned*)ST_)[e] = 0u;
    const float expA = expf(A_log[dir * 8 + h]), dtb = dt_bias[dir * 8 + h];
    f32x4 sacc[4];
#pragma unroll
    for (int nt = 0; nt < 4; ++nt) sacc[nt] = (f32x4){0.f, 0.f, 0.f, 0.f};
    const size_t rowb = (size_t)b * SEQ;
    __syncthreads();
    for (int n = 0; n < NCHUNK; ++n) {
        const int t0 = (dir ? NCHUNK - 1 - n : n) * 64;
        for (int e = tid; e < 70 * 40; e += 512) { const int r = e / 40, p = e % 40; const int t = t0 - 3 + r;
            u32x4 v = (u32x4){0u, 0u, 0u, 0u};
            const int col = p < 16 ? h * 128 + p * 8 : (p < 32 ? 1024 + h * 128 + (p - 16) * 8 : 2048 + h * 128 + dvh * 64 + (p - 32) * 8);
            if (t >= 0 && t < SEQ) v = *(const GAS u32x4*)(raw + (rowb + t) * CONV_CH + col);
            LAS bf16* d = p < 16 ? rq + r * 136 + p * 8 : (p < 32 ? rk + r * 136 + (p - 16) * 8 : rv + r * 72 + (p - 32) * 8);
            *(LAS u32x4*)d = v; }
        if (wave == 0) { const int i = lane; const int t = t0 + (dir ? 63 - i : i);
            const float braw = scal[(rowb + t) * 64 + dir * 8 + h], araw = scal[(rowb + t) * 64 + 16 + dir * 8 + h];
            const float g = -expA * softplus_f(araw + dtb);
            float gc = g;
#pragma unroll
            for (int o = 1; o < 64; o <<= 1) { const float y = __shfl_up(gc, o); if (i >= o) gc += y; }
            const float gl = __shfl(gc, 63);
            sc[i] = sigmoid_f(braw); sc[64 + i] = gc; sc[128 + i] = expf(gc); sc[192 + i] = expf(gl - gc); if (i == 0) sc[256] = expf(gl); }
        __syncthreads();
        { const int i = tid >> 3, cg = tid & 7; const int o = dir ? 63 - i : i;
          float a[16];
          conv16(a, rq + o * 136 + cg * 16, 136, cw + cg * 16, 320);
          float ss = 0.f;
#pragma unroll
          for (int c = 0; c < 16; ++c) { a[c] = silu(a[c]); ss += a[c] * a[c]; }
          ss += __shfl_xor(ss, 1); ss += __shfl_xor(ss, 2); ss += __shfl_xor(ss, 4);
          float rs = (1.0f / sqrtf(ss + EPS)) * 0.08838834764831845f;
          { u32x4 w0, w1; w0.x = pkbf(a[0] * rs, a[1] * rs); w0.y = pkbf(a[2] * rs, a[3] * rs); w0.z = pkbf(a[4] * rs, a[5] * rs); w0.w = pkbf(a[6] * rs, a[7] * rs);
            w1.x = pkbf(a[8] * rs, a[9] * rs); w1.y = pkbf(a[10] * rs, a[11] * rs); w1.z = pkbf(a[12] * rs, a[13] * rs); w1.w = pkbf(a[14] * rs, a[15] * rs);
            *(LAS u32x4*)(q_ + i * 136 + cg * 16) = w0; *(LAS u32x4*)(q_ + i * 136 + cg * 16 + 8) = w1; }
          conv16(a, rk + o * 136 + cg * 16, 136, cw + 128 + cg * 16, 320);
          ss = 0.f;
#pragma unroll
          for (int c = 0; c < 16; ++c) { a[c] = silu(a[c]); ss += a[c] * a[c]; }
          ss += __shfl_xor(ss, 1); ss += __shfl_xor(ss, 2); ss += __shfl_xor(ss, 4);
          rs = 1.0f / sqrtf(ss + EPS);
          { u32x4 w0, w1; w0.x = pkbf(a[0] * rs, a[1] * rs); w0.y = pkbf(a[2] * rs, a[3] * rs); w0.z = pkbf(a[4] * rs, a[5] * rs); w0.w = pkbf(a[6] * rs, a[7] * rs);
            w1.x = pkbf(a[8] * rs, a[9] * rs); w1.y = pkbf(a[10] * rs, a[11] * rs); w1.z = pkbf(a[12] * rs, a[13] * rs); w1.w = pkbf(a[14] * rs, a[15] * rs);
            *(LAS u32x4*)(k_ + i * 136 + cg * 16) = w0; *(LAS u32x4*)(k_ + i * 136 + cg * 16 + 8) = w1; }
          const float ek = sc[192 + i] * rs;
#pragma unroll
          for (int c = 0; c < 16; ++c) kdT[(cg * 16 + c) * 72 + i] = f2bf1(a[c] * ek);
          float v8[8];
          conv8(v8, rv + o * 72 + cg * 8, 72, cw + 256 + cg * 8, 320);
#pragma unroll
          for (int c = 0; c < 8; ++c) vT[(cg * 8 + c) * 72 + i] = f2bf1(silu(v8[c]));
        }
        __syncthreads();
        { const int which = wave >> 2, mt = wave & 3;
          f32x4 acc[1][4];
#pragma unroll
          for (int nt = 0; nt < 4; ++nt) acc[0][nt] = (f32x4){0.f, 0.f, 0.f, 0.f};
          mma_lds<1, 4>(acc, which ? q_ : k_, 136, mt * 16, k_, 136, 0, 128, fr, fq);
#pragma unroll
          for (int nt = 0; nt < 4; ++nt)
#pragma unroll
              for (int r = 0; r < 4; ++r) { const int i = mt * 16 + 4 * fq + r, j = nt * 16 + fr;
                  const float d = expf(fminf(sc[64 + i] - sc[64 + j], 0.f)); const float x = acc[0][nt][r] * d;
                  if (which == 0) Af[i * 68 + j] = (i > j) ? sc[i] * x : 0.f;
                  else QKd[i * 72 + j] = f2bf1((i >= j) ? x : 0.f); }
        }
        __syncthreads();
        if (wave == 0) { const int blk = lane >> 4, c = lane & 15; float t[16];
#pragma unroll
            for (int i = 0; i < 16; ++i) t[i] = (i == c) ? 1.f : 0.f;
#pragma unroll
            for (int i = 1; i < 16; ++i) { float s = 0.f; const LAS float* ar = Af + (blk * 16 + i) * 68 + blk * 16;
#pragma unroll
                for (int j = 0; j < i; ++j) s += ar[j] * t[j];
                t[i] = (i > c) ? -s : t[i];
                if ((i & 3) == 3) asm volatile("" ::: "memory"); }
#pragma unroll
            for (int i = 0; i < 16; ++i) Tf[(blk * 16 + i) * 68 + blk * 16 + c] = t[i]; }
        for (int d = 1; d <= 3; ++d) { const int nbk = 4 - d;
            __syncthreads();
            for (int e = tid; e < nbk * 256; e += 512) { const int J = e >> 8, r = (e >> 4) & 15, c = e & 15, I = J + d; float s = 0.f;
                for (int kk = J * 16; kk < I * 16; ++kk) s += Af[(I * 16 + r) * 68 + kk] * Tf[kk * 68 + J * 16 + c];
                Xf[(J * 16 + r) * 17 + c] = s; }
            __syncthreads();
            for (int e = tid; e < nbk * 256; e += 512) { const int J = e >> 8, r = (e >> 4) & 15, c = e & 15, I = J + d; float s = 0.f;
#pragma unroll
                for (int m2 = 0; m2 < 16; ++m2) s += Tf[(I * 16 + r) * 68 + I * 16 + m2] * Xf[(J * 16 + m2) * 17 + c];
                Tf[(I * 16 + r) * 68 + J * 16 + c] = -s; }
        }
        __syncthreads();
        for (int e = tid; e < 4096; e += 512) { const int i = e >> 6, j = e & 63; T_[i * 72 + j] = f2bf1(((i >> 4) >= (j >> 4)) ? Tf[i * 68 + j] : 0.f); }
        __syncthreads();
        const int mt = wave & 3, nh = wave >> 2;
        f32x4 aq[2];
        { f32x4 ak[2]; ak[0] = ak[1] = aq[0] = aq[1] = (f32x4){0.f, 0.f, 0.f, 0.f};
          for (int k0 = 0; k0 < 128; k0 += 32) {
              const bf16x8 fk = *(const LAS bf16x8*)(k_ + (mt * 16 + fr) * 136 + k0 + fq * 8), fqv = *(const LAS bf16x8*)(q_ + (mt * 16 + fr) * 136 + k0 + fq * 8);
#pragma unroll
              for (int nl = 0; nl < 2; ++nl) { const bf16x8 fb = *(const LAS bf16x8*)(ST_ + (nh * 32 + nl * 16 + fr) * 136 + k0 + fq * 8);
                  ak[nl] = __builtin_amdgcn_mfma_f32_16x16x32_bf16(fk, fb, ak[nl], 0, 0, 0); aq[nl] = __builtin_amdgcn_mfma_f32_16x16x32_bf16(fqv, fb, aq[nl], 0, 0, 0); } }
          const int i0 = mt * 16 + 4 * fq;
          const f32x4 be4 = *(const LAS f32x4*)(sc + i0), eg4 = *(const LAS f32x4*)(sc + 128 + i0);
#pragma unroll
          for (int nl = 0; nl < 2; ++nl) { const int dv = nh * 32 + nl * 16 + fr;
              const bf16x4 vv = *(const LAS bf16x4*)(vT + dv * 72 + i0);
              float r0 = be4[0] * (bf2f_s(vv[0]) - eg4[0] * ak[nl][0]), r1 = be4[1] * (bf2f_s(vv[1]) - eg4[1] * ak[nl][1]);
              float r2 = be4[2] * (bf2f_s(vv[2]) - eg4[2] * ak[nl][2]), r3 = be4[3] * (bf2f_s(vv[3]) - eg4[3] * ak[nl][3]);
              u32x2 w; w.x = pkbf(r0, r1); w.y = pkbf(r2, r3); *(LAS u32x2*)(rT + dv * 72 + i0) = w;
              aq[nl][0] *= eg4[0]; aq[nl][1] *= eg4[1]; aq[nl][2] *= eg4[2]; aq[nl][3] *= eg4[3]; }
        }
        __syncthreads();
        { f32x4 au[1][2]; au[0][0] = au[0][1] = (f32x4){0.f, 0.f, 0.f, 0.f};
          mma_lds<1, 2>(au, T_, 72, mt * 16, rT, 72, nh * 32, 64, fr, fq);
          const int i0 = mt * 16 + 4 * fq;
#pragma unroll
          for (int nl = 0; nl < 2; ++nl) { const int dv = nh * 32 + nl * 16 + fr; u32x2 w; w.x = pkbf(au[0][nl][0], au[0][nl][1]); w.y = pkbf(au[0][nl][2], au[0][nl][3]); *(LAS u32x2*)(uT + dv * 72 + i0) = w; }
        }
        __syncthreads();
        { f32x4 ao[1][2]; ao[0][0] = aq[0]; ao[0][1] = aq[1];
          mma_lds<1, 2>(ao, QKd, 72, mt * 16, uT, 72, nh * 32, 64, fr, fq);
          const int i0 = mt * 16 + 4 * fq;
#pragma unroll
          for (int nl = 0; nl < 2; ++nl)
#pragma unroll
              for (int r = 0; r < 4; ++r) os[(i0 + r) * 65 + nh * 32 + nl * 16 + fr] = ao[0][nl][r];
          const float egl = sc[256];
          f32x4 as_[1][4];
#pragma unroll
          for (int nt = 0; nt < 4; ++nt) as_[0][nt] = sacc[nt] * egl;
          mma_lds<1, 4>(as_, kdT, 72, wave * 16, uT, 72, 0, 64, fr, fq);
#pragma unroll
          for (int nt = 0; nt < 4; ++nt) { sacc[nt] = as_[0][nt];
              u32x2 w; w.x = pkbf(sacc[nt][0], sacc[nt][1]); w.y = pkbf(sacc[nt][2], sacc[nt][3]); *(LAS u32x2*)(ST_ + (nt * 16 + fr) * 136 + wave * 16 + 4 * fq) = w; }
        }
        __syncthreads();
#pragma unroll
        for (int ii = 0; ii < 4; ++ii) { const int i = wave * 8 + 2 * ii + (lane >> 5), cp = lane & 31; const int t = t0 + (dir ? 63 - i : i);
            atomic_add_bf16x2(og + (rowb + t) * 1024 + h * 128 + dvh * 64 + 2 * cp, os[i * 65 + 2 * cp], os[i * 65 + 2 * cp + 1]); }
        __syncthreads();
    }
}

namespace ssd {
constexpr int CW = 0;
constexpr int SC = CW + 8 * 320 * 4;
constexpr int BM_ = SC + 1280;
constexpr int CM_ = BM_ + 64 * 136 * 2;
constexpr int BT = CM_ + 64 * 136 * 2;
constexpr int XDT = BT + 128 * 72 * 2;
constexpr int XDW = XDT + 64 * 72 * 2;
constexpr int MM = XDW + 64 * 72 * 2;
constexpr int HT = MM + 64 * 72 * 2;
constexpr int TMP = HT + 64 * 136 * 2;
constexpr int RX = TMP, RB = RX + 70 * 72 * 2, RC = RB + 70 * 136 * 2, RAW_END = RC + 70 * 136 * 2;
constexpr int OS = TMP, OS_END = OS + 64 * 65 * 4;
static_assert(RAW_END <= MISC_OFF && OS_END <= MISC_OFF, "ssd LDS map");
}
__device__ __forceinline__ void ssd_chain(LAS unsigned char* lds, int cid, const bf16* raw, const float* scal, const float* conv_w, const float* conv_b,
                                          const float* A_log, const float* dt_bias, const float* Dp, bf16* ys, int tid, int wave, int lane) {
    using namespace ssd;
    const int dir = cid & 1, head = (cid >> 1) & 15, b = cid >> 5; const int g = head >> 3;
    const int fr = lane & 15, fq = lane >> 4;
    LAS float* cw = (LAS float*)(lds + CW); LAS float* sc = (LAS float*)(lds + SC);
    LAS bf16* Bm = (LAS bf16*)(lds + BM_); LAS bf16* Cm = (LAS bf16*)(lds + CM_); LAS bf16* BT_ = (LAS bf16*)(lds + BT);
    LAS bf16* xdt = (LAS bf16*)(lds + XDT); LAS bf16* xdw = (LAS bf16*)(lds + XDW); LAS bf16* Mm = (LAS bf16*)(lds + MM); LAS bf16* hT = (LAS bf16*)(lds + HT);
    LAS bf16* rx = (LAS bf16*)(lds + RX); LAS bf16* rb = (LAS bf16*)(lds + RB); LAS bf16* rc = (LAS bf16*)(lds + RC); LAS float* os = (LAS float*)(lds + OS);
    const int chx = 3072 + head * 64, chb = 4096 + g * 128, chc = 4352 + g * 128;
    for (int e = tid; e < 8 * 320; e += 512) { const int r = e / 320, c = e % 320;
        const int gch = c < 64 ? chx + c : (c < 192 ? chb + (c - 64) : chc + (c - 192));
        cw[e] = r < 7 ? conv_w[r * CONV_CH + gch] : conv_b[gch]; }
    for (int e = tid; e < 64 * 136 / 2; e += 512) ((LAS unsigned*)hT)[e] = 0u;
    const float Ah = -expf(A_log[dir * 16 + head]), dtb = dt_bias[dir * 16 + head], Dh = (dir == 0) ? Dp[head] : 0.f;
    f32x4 hacc[4];
#pragma unroll
    for (int nt = 0; nt < 4; ++nt) hacc[nt] = (f32x4){0.f, 0.f, 0.f, 0.f};
    const size_t rowb = (size_t)b * SEQ;
    __syncthreads();
    for (int n = 0; n < NCHUNK; ++n) {
        const int t0 = (dir ? NCHUNK - 1 - n : n) * 64;
        for (int e = tid; e < 70 * 40; e += 512) { const int r = e / 40, p = e % 40; const int t = t0 - 3 + r;
            u32x4 v = (u32x4){0u, 0u, 0u, 0u};
            const int col = p < 8 ? chx + p * 8 : (p < 24 ? chb + (p - 8) * 8 : chc + (p - 24) * 8);
            if (t >= 0 && t < SEQ) v = *(const GAS u32x4*)(raw + (rowb + t) * CONV_CH + col);
            LAS bf16* d = p < 8 ? rx + r * 72 + p * 8 : (p < 24 ? rb + r * 136 + (p - 8) * 8 : rc + r * 136 + (p - 24) * 8);
            *(LAS u32x4*)d = v; }
        if (wave == 0) { const int i = lane; const int t = t0 + (dir ? 63 - i : i);
            const float dt = softplus_f(scal[(rowb + t) * 64 + 32 + dir * 16 + head] + dtb);
            float cs = dt * Ah;
#pragma unroll
            for (int o = 1; o < 64; o <<= 1) { const float y = __shfl_up(cs, o); if (i >= o) cs += y; }
            const float cl = __shfl(cs, 63);
            sc[i] = dt; sc[64 + i] = cs; sc[128 + i] = expf(cs); sc[192 + i] = expf(cl - cs); if (i == 0) sc[256] = expf(cl); }
        __syncthreads();
        { const int i = tid >> 3, cg = tid & 7; const int o = dir ? 63 - i : i;
          float a[16];
          conv16(a, rb + o * 136 + cg * 16, 136, cw + 64 + cg * 16, 320);
#pragma unroll
          for (int c = 0; c < 16; ++c) a[c] = silu(a[c]);
          { u32x4 w0, w1; w0.x = pkbf(a[0], a[1]); w0.y = pkbf(a[2], a[3]); w0.z = pkbf(a[4], a[5]); w0.w = pkbf(a[6], a[7]);
            w1.x = pkbf(a[8], a[9]); w1.y = pkbf(a[10], a[11]); w1.z = pkbf(a[12], a[13]); w1.w = pkbf(a[14], a[15]);
            *(LAS u32x4*)(Bm + i * 136 + cg * 16) = w0; *(LAS u32x4*)(Bm + i * 136 + cg * 16 + 8) = w1; }
#pragma unroll
          for (int c = 0; c < 16; ++c) BT_[(cg * 16 + c) * 72 + i] = f2bf1(a[c]);
          conv16(a, rc + o * 136 + cg * 16, 136, cw + 192 + cg * 16, 320);
#pragma unroll
          for (int c = 0; c < 16; ++c) a[c] = silu(a[c]);
          { u32x4 w0, w1; w0.x = pkbf(a[0], a[1]); w0.y = pkbf(a[2], a[3]); w0.z = pkbf(a[4], a[5]); w0.w = pkbf(a[6], a[7]);
            w1.x = pkbf(a[8], a[9]); w1.y = pkbf(a[10], a[11]); w1.z = pkbf(a[12], a[13]); w1.w = pkbf(a[14], a[15]);
            *(LAS u32x4*)(Cm + i * 136 + cg * 16) = w0; *(LAS u32x4*)(Cm + i * 136 + cg * 16 + 8) = w1; }
          float x8[8];
          conv8(x8, rx + o * 72 + cg * 8, 72, cw + cg * 8, 320);
          const float dt = sc[i], wst = sc[192 + i];
#pragma unroll
          for (int c = 0; c < 8; ++c) { const float xv = silu(x8[c]) * dt; xdt[(cg * 8 + c) * 72 + i] = f2bf1(xv); xdw[(cg * 8 + c) * 72 + i] = f2bf1(xv * wst); }
        }
        __syncthreads();
        const int mt = wave & 3, nh = wave >> 2;
        { f32x4 acc[1][2]; acc[0][0] = acc[0][1] = (f32x4){0.f, 0.f, 0.f, 0.f};
          mma_lds<1, 2>(acc, Cm, 136, mt * 16, Bm, 136, nh * 32, 128, fr, fq);
#pragma unroll
          for (int nl = 0; nl < 2; ++nl)
#pragma unroll
              for (int r = 0; r < 4; ++r) { const int i = mt * 16 + 4 * fq + r, j = nh * 32 + nl * 16 + fr;
                  const float d = expf(fminf(sc[64 + i] - sc[64 + j], 0.f));
                  Mm[i * 72 + j] = f2bf1((i >= j) ? acc[0][nl][r] * d : 0.f); }
        }
        __syncthreads();
        { f32x4 a1[1][2], a2[1][2]; a1[0][0] = a1[0][1] = a2[0][0] = a2[0][1] = (f32x4){0.f, 0.f, 0.f, 0.f};
          mma_lds<1, 2>(a1, Mm, 72, mt * 16, xdt, 72, nh * 32, 64, fr, fq);
          mma_lds<1, 2>(a2, Cm, 136, mt * 16, hT, 136, nh * 32, 128, fr, fq);
          const int i0 = mt * 16 + 4 * fq;
          const f32x4 ec4 = *(const LAS f32x4*)(sc + 128 + i0), dt4 = *(const LAS f32x4*)(sc + i0);
#pragma unroll
          for (int nl = 0; nl < 2; ++nl) { const int p = nh * 32 + nl * 16 + fr; const bf16x4 xv = *(const LAS bf16x4*)(xdt + p * 72 + i0);
#pragma unroll
              for (int r = 0; r < 4; ++r) os[(i0 + r) * 65 + p] = a1[0][nl][r] + ec4[r] * a2[0][nl][r] + Dh * bf2f_s(xv[r]) / dt4[r]; }
        }
        __syncthreads();
        { const float ecl = sc[256];
          f32x4 ah[1][4];
#pragma unroll
          for (int nt = 0; nt < 4; ++nt) ah[0][nt] = hacc[nt] * ecl;
          mma_lds<1, 4>(ah, BT_, 72, wave * 16, xdw, 72, 0, 64, fr, fq);
#pragma unroll
          for (int nt = 0; nt < 4; ++nt) { hacc[nt] = ah[0][nt];
              u32x2 w; w.x = pkbf(hacc[nt][0], hacc[nt][1]); w.y = pkbf(hacc[nt][2], hacc[nt][3]); *(LAS u32x2*)(hT + (nt * 16 + fr) * 136 + wave * 16 + 4 * fq) = w; }
        }
#pragma unroll
        for (int ii = 0; ii < 4; ++ii) { const int i = wave * 8 + 2 * ii + (lane >> 5), cp = lane & 31; const int t = t0 + (dir ? 63 - i : i);
            atomic_add_bf16x2(ys + (rowb + t) * 1024 + head * 64 + 2 * cp, os[i * 65 + 2 * cp], os[i * 65 + 2 * cp + 1]); }
        __syncthreads();
    }
}
namespace pgd {
constexpr int CW = 0;
constexpr int SC = CW + 8 * 384 * 4;
constexpr int Q = SC + 1280;
constexpr int K = Q + 64 * 136 * 2;
constexpr int VT = K + 64 * 136 * 2;
constexpr int TMP = VT + 128 * 72 * 2;
constexpr int RQ = TMP, RK = RQ + 70 * 136 * 2, RV = RK + 70 * 136 * 2, RAW_END = RV + 70 * 136 * 2;
constexpr int AF = TMP, A2F = AF + 64 * 68 * 4, TF = A2F + 64 * 68 * 4, T2F = TF + 64 * 68 * 4, QKP = T2F + 64 * 68 * 4, INV_END = QKP + 64 * 72 * 2;
constexpr int XF = VT;
constexpr int TP = AF;
constexpr int STASH = MISC_OFF - 16384;
static_assert(RAW_END <= STASH && INV_END <= STASH, "prep gdn LDS map");
}
constexpr size_t WS_TQ = 379 * MiB;

__device__ __forceinline__ void prep_gdn_stash(LAS unsigned char* lds, int bid, const bf16* raw, int tid) {
    const int bh = bid >> 3, b = bh >> 3, h = bh & 7, r8 = bid & 7;
    LAS bf16* st = (LAS bf16*)(lds + pgd::STASH);
    for (int e = tid; e < 2 * 3 * 48; e += 512) { const int which = e / 144, r = (e % 144) / 48, p = e % 48;
        const int t = which ? (r8 * 16 + 16) * 64 + r : r8 * 16 * 64 - 3 + r;
        const int col = p < 16 ? h * 128 + p * 8 : (p < 32 ? 1024 + h * 128 + (p - 16) * 8 : 2048 + h * 128 + (p - 32) * 8);
        u32x4 v = (u32x4){0u, 0u, 0u, 0u};
        if (t >= 0 && t < SEQ) v = *(const GAS u32x4*)(raw + ((size_t)b * SEQ + t) * CONV_CH + col);
        *(LAS u32x4*)(st + which * 1152 + r * 384 + p * 8) = v; }
}
__device__ __forceinline__ void inv_diag_blocks(const LAS float* Af, LAS float* Tf, int lane) {
    const int blk = lane >> 4, c = lane & 15; float t[16];
#pragma unroll
    for (int i = 0; i < 16; ++i) t[i] = (i == c) ? 1.f : 0.f;
#pragma unroll
    for (int i = 1; i < 16; ++i) { float s = 0.f; const LAS float* ar = Af + (blk * 16 + i) * 68 + blk * 16;
#pragma unroll
        for (int j = 0; j < i; ++j) s += ar[j] * t[j];
        t[i] = (i > c) ? -s : t[i];
        if ((i & 3) == 3) asm volatile("" ::: "memory"); }
#pragma unroll
    for (int i = 0; i < 16; ++i) Tf[(blk * 16 + i) * 68 + blk * 16 + c] = t[i];
}
__device__ __forceinline__ void inv_offdiag_x(const LAS float* Af, const LAS float* Tf, LAS float* Xf, int d, int ht) {
    const int nbk = 4 - d;
    for (int e = ht; e < nbk * 256; e += 256) { const int J = e >> 8, r = (e >> 4) & 15, c = e & 15, I = J + d; float s = 0.f;
        for (int kk = J * 16; kk < I * 16; ++kk) s += Af[(I * 16 + r) * 68 + kk] * Tf[kk * 68 + J * 16 + c];
        Xf[(J * 16 + r) * 17 + c] = s; }
}
__device__ __forceinline__ void inv_offdiag_t(LAS float* Tf, const LAS float* Xf, int d, int ht) {
    const int nbk = 4 - d;
    for (int e = ht; e < nbk * 256; e += 256) { const int J = e >> 8, r = (e >> 4) & 15, c = e & 15, I = J + d; float s = 0.f;
#pragma unroll
        for (int m2 = 0; m2 < 16; ++m2) s += Tf[(I * 16 + r) * 68 + I * 16 + m2] * Xf[(J * 16 + m2) * 17 + c];
        Tf[(I * 16 + r) * 68 + J * 16 + c] = -s; }
}

__device__ __forceinline__ void conv_pair8(float (&o)[16], const LAS bf16* src  , int ld, const float (&w)[16]) {
#pragma unroll
    for (int t = 0; t < 8; ++t) { o[2 * t] = w[14]; o[2 * t + 1] = w[15]; }
#pragma unroll
    for (int r = 0; r < 14; ++r) { const unsigned xv = *(const LAS unsigned*)(src + r * ld); const float x0 = __uint_as_float(xv << 16), x1 = __uint_as_float(xv & 0xffff0000u);
#pragma unroll
        for (int t = 0; t < 8; ++t) { const int tap = r - t; if (tap >= 0 && tap < 7) { o[2 * t] += x0 * w[2 * tap]; o[2 * t + 1] += x1 * w[2 * tap + 1]; } } }
}
namespace pg2 {
constexpr int CW = 0;
constexpr int SC = CW + 8 * 384 * 4;
constexpr int Q = SC + 1280;
constexpr int K = Q + 64 * 136 * 2;
constexpr int VT = K + 64 * 136 * 2;
constexpr int RAWT = VT + 128 * 72 * 2;
constexpr int RAW_END = RAWT + 3 * 70 * 136 * 2;
constexpr int ABF = RAWT, TRM = ABF + 2 * 64 * 72 * 2, TTR = TRM + 2 * 64 * 72 * 2, AD = TTR + 2 * 64 * 72 * 2, XS = AD + 2 * 4 * 256 * 4, QKP = XS + 2 * 32 * 40 * 2, INV_END = QKP + 64 * 72 * 2;
static_assert(RAW_END <= pgd::STASH && INV_END <= pgd::STASH, "prep gdn v2 LDS map");
}
__device__ __forceinline__ void prep_gdn_range(LAS unsigned char* lds, int bid, bf16* raw, const float* scal, const float* conv_w, const float* conv_b,
                                               const float* A_log, const float* dt_bias, bf16* TQ, int tid_p, int wave_p, int lane_p) {
    using namespace pg2;
    int tid = tid_p, wave = wave_p, lane = lane_p;
    const int bh = bid >> 3, b = bh >> 3, h = bh & 7, r8 = bid & 7;
    LAS float* cw = (LAS float*)(lds + CW); LAS float* sc = (LAS float*)(lds + SC);
    LAS bf16* q_ = (LAS bf16*)(lds + Q); LAS bf16* k_ = (LAS bf16*)(lds + K); LAS bf16* vT = (LAS bf16*)(lds + VT);
    LAS bf16* rq = (LAS bf16*)(lds + RAWT); LAS bf16* rk = rq + 70 * 136; LAS bf16* rv = rk + 70 * 136;
    LAS bf16* Abf = (LAS bf16*)(lds + ABF); LAS bf16* Trm = (LAS bf16*)(lds + TRM); LAS bf16* Ttr = (LAS bf16*)(lds + TTR);
    LAS float* ADf = (LAS float*)(lds + AD); LAS bf16* Xs = (LAS bf16*)(lds + XS); LAS bf16* QKp = (LAS bf16*)(lds + QKP);
    LAS bf16* st = (LAS bf16*)(lds + pgd::STASH);
    for (int e = tid; e < 8 * 384; e += 512) { const int r = e / 384, c = e % 384;
        const int gch = (c >> 7) * 1024 + h * 128 + (c & 127);
        cw[e] = r < 7 ? conv_w[r * CONV_CH + gch] : conv_b[gch]; }
    const float LOG2E = 1.4426950408889634f;
    const float expAf = expf(A_log[h]), dtbf = dt_bias[h], expAb = expf(A_log[8 + h]), dtbb = dt_bias[8 + h];
    const size_t rowb = (size_t)b * SEQ;
    u32x4 pre[7];
#define PG2_LOAD(u_) do { const int t0_ = (r8 * 16 + (u_)) * 64; \
        _Pragma("unroll") for (int x = 0; x < 7; ++x) { const int e = tid + 512 * x; const int r = e / 48, p = e % 48; \
            pre[x] = (u32x4){0u, 0u, 0u, 0u}; \
            if (e < 70 * 48 && r >= 3 && !(r >= 67 && (u_) == 15)) { const int col = p < 16 ? h * 128 + p * 8 : (p < 32 ? 1024 + h * 128 + (p - 16) * 8 : 2048 + h * 128 + (p - 32) * 8); \
                pre[x] = *(const GAS u32x4*)(raw + (rowb + t0_ - 3 + r) * CONV_CH + col); } } } while (0)
    PG2_LOAD(0);
    __syncthreads();
    for (int u = 0; u < 16; ++u) {
        tid = tid_p; asm volatile("" : "+v"(tid));
        lane = tid & 63; wave = __builtin_amdgcn_readfirstlane(tid >> 6);
        const int fr = lane & 15, fq = lane >> 4, half = wave >> 2, w4 = wave & 3;
        const int c = r8 * 16 + u, t0 = c * 64;
#pragma unroll
        for (int x = 0; x < 7; ++x) { const int e = tid + 512 * x; const int r = e / 48, p = e % 48;
            if (e < 70 * 48) { u32x4 v = pre[x];
                if (r < 3) v = *(const LAS u32x4*)(st + r * 384 + p * 8);
                else if (r >= 67 && u == 15) v = *(const LAS u32x4*)(st + 1152 + (r - 67) * 384 + p * 8);
                *(LAS u32x4*)((p < 16 ? rq + r * 136 + p * 8 : (p < 32 ? rk + r * 136 + (p - 16) * 8 : rv + r * 136 + (p - 32) * 8))) = v; } }
        if (wave == 0) { const int i = lane; const size_t so = (rowb + t0 + i) * 64;
            const float g = -expAf * softplus_f(scal[so + 16 + h] + dtbf); float gc = g;
#pragma unroll
            for (int o = 1; o < 64; o <<= 1) { const float y = __shfl_up(gc, o); if (i >= o) gc += y; }
            sc[i] = sigmoid_f(scal[so + h]); sc[64 + i] = gc * LOG2E; }
        if (wave == 1) { const int i = lane; const size_t so = (rowb + t0 + i) * 64;
            const float g = -expAb * softplus_f(scal[so + 24 + h] + dtbb); float gc = g;
#pragma unroll
            for (int o = 1; o < 64; o <<= 1) { const float y = __shfl_down(gc, o); if (i + o < 64) gc += y; }
            sc[128 + i] = sigmoid_f(scal[so + 8 + h]); sc[192 + i] = gc * LOG2E; }
        __syncthreads();
        if (u + 1 < 16) PG2_LOAD(u + 1);
        if (tid < 144) { const int r = tid / 48, p = tid % 48;
            const LAS bf16* s = p < 16 ? rq + (64 + r) * 136 + p * 8 : (p < 32 ? rk + (64 + r) * 136 + (p - 16) * 8 : rv + (64 + r) * 136 + (p - 32) * 8);
            *(LAS u32x4*)(st + r * 384 + p * 8) = *(const LAS u32x4*)s; }
        { const int tg = wave, cp = lane; float w[16], o[16];
#pragma unroll
          for (int tap = 0; tap < 8; ++tap) { w[2 * tap] = cw[tap * 384 + 2 * cp]; w[2 * tap + 1] = cw[tap * 384 + 2 * cp + 1]; }
          conv_pair8(o, rq + (8 * tg) * 136 + 2 * cp, 136, w);
#pragma unroll
          for (int t = 0; t < 8; ++t) { o[2 * t] = silu(o[2 * t]); o[2 * t + 1] = silu(o[2 * t + 1]);
              const float rs = (1.0f / sqrtf(wave_sum(o[2 * t] * o[2 * t] + o[2 * t + 1] * o[2 * t + 1]) + EPS)) * 0.08838834764831845f;
              const unsigned pk = pkbf(o[2 * t] * rs, o[2 * t + 1] * rs);
              *(LAS unsigned*)(q_ + (8 * tg + t) * 136 + 2 * cp) = pk; *(GAS unsigned*)(raw + (rowb + t0 + 8 * tg + t) * CONV_CH + h * 128 + 2 * cp) = pk; }
#pragma unroll
          for (int tap = 0; tap < 8; ++tap) { w[2 * tap] = cw[tap * 384 + 128 + 2 * cp]; w[2 * tap + 1] = cw[tap * 384 + 128 + 2 * cp + 1]; }
          conv_pair8(o, rk + (8 * tg) * 136 + 2 * cp, 136, w);
#pragma unroll
          for (int t = 0; t < 8; ++t) { o[2 * t] = silu(o[2 * t]); o[2 * t + 1] = silu(o[2 * t + 1]);
              const float rs = 1.0f / sqrtf(wave_sum(o[2 * t] * o[2 * t] + o[2 * t + 1] * o[2 * t + 1]) + EPS);
              const unsigned pk = pkbf(o[2 * t] * rs, o[2 * t + 1] * rs);
              *(LAS unsigned*)(k_ + (8 * tg + t) * 136 + 2 * cp) = pk; *(GAS unsigned*)(raw + (rowb + t0 + 8 * tg + t) * CONV_CH + 1024 + h * 128 + 2 * cp) = pk; }
#pragma unroll
          for (int tap = 0; tap < 8; ++tap) { w[2 * tap] = cw[tap * 384 + 256 + 2 * cp]; w[2 * tap + 1] = cw[tap * 384 + 256 + 2 * cp + 1]; }
          conv_pair8(o, rv + (8 * tg) * 136 + 2 * cp, 136, w);
#pragma unroll
          for (int t = 0; t < 16; ++t) o[t] = silu(o[t]);
          u32x4 e0, e1; e0.x = pkbf(o[0], o[2]); e0.y = pkbf(o[4], o[6]); e0.z = pkbf(o[8], o[10]); e0.w = pkbf(o[12], o[14]);
          e1.x = pkbf(o[1], o[3]); e1.y = pkbf(o[5], o[7]); e1.z = pkbf(o[9], o[11]); e1.w = pkbf(o[13], o[15]);
          *(LAS u32x4*)(vT + (2 * cp) * 72 + 8 * tg) = e0; *(LAS u32x4*)(vT + (2 * cp + 1) * 72 + 8 * tg) = e1;
        }
        __syncthreads();
        for (int e = tid; e < 128 * 8; e += 512) { const int dv = e >> 3, p = e & 7;
            *(GAS u32x4*)(raw + (rowb + t0 + (dv >> 1)) * CONV_CH + 2048 + h * 128 + (dv & 1) * 64 + p * 8) = *(const LAS u32x4*)(vT + dv * 72 + p * 8); }
        for (int e = tid; e < 2 * 2 * 64 * 72 * 2 / 16; e += 512) ((LAS u32x4*)(lds + TRM))[e] = (u32x4){0u, 0u, 0u, 0u};
        for (int e = tid; e < 2 * 32 * 40 * 2 / 16; e += 512) ((LAS u32x4*)(lds + XS))[e] = (u32x4){0u, 0u, 0u, 0u};
        { const int mt = w4;
          f32x4 acc[1][4];
#pragma unroll
          for (int nt = 0; nt < 4; ++nt) acc[0][nt] = (f32x4){0.f, 0.f, 0.f, 0.f};
          mma_lds<1, 4>(acc, half ? q_ : k_, 136, mt * 16, k_, 136, 0, 128, fr, fq);
#pragma unroll
          for (int nt = 0; nt < 4; ++nt)
#pragma unroll
              for (int r = 0; r < 4; ++r) { const int i = mt * 16 + 4 * fq + r, j = nt * 16 + fr;
                  const float arg = (i > j) ? sc[64 + i] - sc[64 + j] : sc[192 + i] - sc[192 + j];
                  const float x = acc[0][nt][r] * __builtin_amdgcn_exp2f(fminf(arg, 0.f));
                  if (half == 0) { const float af = (i > j) ? sc[i] * x : 0.f, ab = (i < j) ? sc[128 + i] * x : 0.f;
                      Abf[i * 72 + j] = f2bf1(af); Abf[64 * 72 + j * 72 + i] = f2bf1(ab);
                      if (mt == nt) { ADf[(mt * 16 + (i & 15)) * 16 + (j & 15)] = af; ADf[1024 + (mt * 16 + (j & 15)) * 16 + (i & 15)] = ab; } }
                  else QKp[i * 72 + j] = f2bf1(i == j ? acc[0][nt][r] : x); }
        }
        __syncthreads();
        { LAS bf16* Ab = Abf + half * 64 * 72; LAS bf16* Tr = Trm + half * 64 * 72; LAS bf16* Tt = Ttr + half * 64 * 72; LAS bf16* Xh = Xs + half * 32 * 40;
          if (w4 == 0) { const int blk = lane >> 4, cc = lane & 15; float t[16]; const LAS float* ad = ADf + half * 1024 + blk * 256;
#pragma unroll
              for (int i = 0; i < 16; ++i) t[i] = (i == cc) ? 1.f : 0.f;
#pragma unroll
              for (int i = 1; i < 16; ++i) { float s0 = 0.f, s1 = 0.f;
#pragma unroll
                  for (int j = 0; j < i; ++j) { if (j & 1) s1 += ad[i * 16 + j] * t[j]; else s0 += ad[i * 16 + j] * t[j]; }
                  t[i] = (i > cc) ? -(s0 + s1) : t[i];
                  if ((i & 3) == 3) asm volatile("" ::: "memory"); }
#pragma unroll
              for (int i = 0; i < 16; ++i) { const unsigned short tb = f2bf1(t[i]); Tr[(blk * 16 + i) * 72 + blk * 16 + cc] = tb; Tt[(blk * 16 + cc) * 72 + blk * 16 + i] = tb; } }
          __syncthreads();
          f32x4 a1[1][1];
          if (w4 < 2) { const int J = 2 * w4, I = J + 1; a1[0][0] = (f32x4){0.f, 0.f, 0.f, 0.f};
              mma_lds<1, 1>(a1, Ab + 16 * J, 72, 16 * I, Tt + 16 * J, 72, 16 * J, 32, fr, fq);
              u32x2 wv; wv.x = pkbf(a1[0][0][0], a1[0][0][1]); wv.y = pkbf(a1[0][0][2], a1[0][0][3]);
              *(LAS u32x2*)(Xh + (w4 * 16 + fr) * 40 + 4 * fq) = wv; }
          __syncthreads();
          if (w4 < 2) { const int J = 2 * w4, I = J + 1; a1[0][0] = (f32x4){0.f, 0.f, 0.f, 0.f};
              mma_lds<1, 1>(a1, Tr + 16 * I, 72, 16 * I, Xh, 40, w4 * 16, 32, fr, fq);
#pragma unroll
              for (int r = 0; r < 4; ++r) Tr[(16 * I + 4 * fq + r) * 72 + 16 * J + fr] = f2bf1(-a1[0][0][r]);
              u32x2 wv; wv.x = pkbf(-a1[0][0][0], -a1[0][0][1]); wv.y = pkbf(-a1[0][0][2], -a1[0][0][3]);
              *(LAS u32x2*)(Tt + (16 * J + fr) * 72 + 16 * I + 4 * fq) = wv; }
          __syncthreads();
          { const int mt2 = w4 >> 1, nt2 = w4 & 1; a1[0][0] = (f32x4){0.f, 0.f, 0.f, 0.f};
            mma_lds<1, 1>(a1, Ab, 72, 32 + 16 * mt2, Tt, 72, 16 * nt2, 32, fr, fq);
            u32x2 wv; wv.x = pkbf(a1[0][0][0], a1[0][0][1]); wv.y = pkbf(a1[0][0][2], a1[0][0][3]);
            __syncthreads();
            *(LAS u32x2*)(Xh + (16 * nt2 + fr) * 40 + 16 * mt2 + 4 * fq) = wv;
            __syncthreads();
            a1[0][0] = (f32x4){0.f, 0.f, 0.f, 0.f};
            mma_lds<1, 1>(a1, Tr + 32, 72, 32 + 16 * mt2, Xh, 40, 16 * nt2, 32, fr, fq);
#pragma unroll
            for (int r = 0; r < 4; ++r) Tr[(32 + 16 * mt2 + 4 * fq + r) * 72 + 16 * nt2 + fr] = f2bf1(-a1[0][0][r]);
            u32x2 w2; w2.x = pkbf(-a1[0][0][0], -a1[0][0][1]); w2.y = pkbf(-a1[0][0][2], -a1[0][0][3]);
            *(LAS u32x2*)(Tt + (16 * nt2 + fr) * 72 + 32 + 16 * mt2 + 4 * fq) = w2; }
        }
        __syncthreads();
        { bf16* tq = TQ + ((size_t)(bh * NCHUNK + c)) * 8192;
          for (int e = tid; e < 1024; e += 512) { const int which = e >> 9, i = (e >> 3) & 63, p = e & 7;
              if (which) *(GAS u32x4*)(tq + 4096 + i * 64 + p * 8) = *(const LAS u32x4*)(QKp + i * 72 + p * 8);
              else { const bf16x8 lo = *(const LAS bf16x8*)(Trm + i * 72 + p * 8), up = *(const LAS bf16x8*)(Ttr + 64 * 72 + i * 72 + p * 8); bf16x8 o8;
#pragma unroll
                  for (int y = 0; y < 8; ++y) { const int j = p * 8 + y; o8[y] = (i > j) ? lo[y] : (i < j ? up[y] : (short)0x3F80); }
                  *(GAS bf16x8*)(tq + i * 64 + p * 8) = o8; } } }
        __syncthreads();
    }
#undef PG2_LOAD
}

__device__ __forceinline__ void gdn_state_v1(LAS unsigned char* lds, int cid, const bf16* raw, const float* scal, const bf16* TQ,
                                             const float* A_log, const float* dt_bias, bf16* og, int tid, int wave, int lane) {
    using namespace gdn;
    const int dvh = cid & 1, dir = (cid >> 1) & 1, h = (cid >> 2) & 7, b = cid >> 5;
    const int fr = lane & 15, fq = lane >> 4;
    LAS float* sc = (LAS float*)(lds + SC);
    LAS bf16* q_ = (LAS bf16*)(lds + Q); LAS bf16* k_ = (LAS bf16*)(lds + K); LAS bf16* kdT = (LAS bf16*)(lds + KDT); LAS bf16* vT = (LAS bf16*)(lds + VT);
    LAS bf16* T_ = (LAS bf16*)(lds + T); LAS bf16* QKd = (LAS bf16*)(lds + QKD); LAS bf16* ST_ = (LAS bf16*)(lds + ST);
    LAS bf16* rT = (LAS bf16*)(lds + RT); LAS bf16* uT = (LAS bf16*)(lds + UT); LAS float* os = (LAS float*)(lds + OS);
    for (int e = tid; e < 64 * 136 / 2; e += 512) ((LAS unsigned*)ST_)[e] = 0u;
    const float expA = expf(A_log[dir * 8 + h]), dtb = dt_bias[dir * 8 + h];
    f32x4 sacc[4];
#pragma unroll
    for (int nt = 0; nt < 4; ++nt) sacc[nt] = (f32x4){0.f, 0.f, 0.f, 0.f};
    const size_t rowb = (size_t)b * SEQ; const int bh = b * 8 + h;
    __syncthreads();
    for (int n = 0; n < NCHUNK; ++n) {
        const int c = dir ? NCHUNK - 1 - n : n, t0 = c * 64;
        for (int e = tid; e < 64 * 16; e += 512) { const int r = e >> 4, p = e & 15;
            *(LAS u32x4*)(q_ + r * 136 + p * 8) = *(const GAS u32x4*)(raw + (rowb + t0 + r) * CONV_CH + h * 128 + p * 8);
            *(LAS u32x4*)(k_ + r * 136 + p * 8) = *(const GAS u32x4*)(raw + (rowb + t0 + r) * CONV_CH + 1024 + h * 128 + p * 8); }
        { const int dvl = tid >> 3, p = tid & 7; const int dv = dvh * 64 + dvl;
          *(LAS u32x4*)(vT + dvl * 72 + p * 8) = *(const GAS u32x4*)(raw + (rowb + t0 + (dv >> 1)) * CONV_CH + 2048 + h * 128 + (dv & 1) * 64 + p * 8); }
        { const bf16* tq = TQ + ((size_t)(bh * NCHUNK + c)) * 8192;
          for (int e = tid; e < 1024; e += 512) { const int which = e >> 9, i = (e >> 3) & 63, p = e & 7;
              bf16x8 v = *(const GAS bf16x8*)(tq + which * 4096 + i * 64 + p * 8);
#pragma unroll
              for (int x = 0; x < 8; ++x) { const int j = p * 8 + x; const bool keep = dir ? (i < j) : (i > j);
                  if (i == j) { if (which == 0) v[x] = (short)0x3F80; } else if (!keep) v[x] = 0; }
              *(LAS bf16x8*)((which ? QKd : T_) + i * 72 + p * 8) = v; } }
        if (wave == 0) { const int i = lane; const size_t so = (rowb + t0 + i) * 64;
            const float g = -expA * softplus_f(scal[so + 16 + dir * 8 + h] + dtb); float gc = g;
            if (dir == 0) {
#pragma unroll
                for (int o = 1; o < 64; o <<= 1) { const float y = __shfl_up(gc, o); if (i >= o) gc += y; }
            } else {
#pragma unroll
                for (int o = 1; o < 64; o <<= 1) { const float y = __shfl_down(gc, o); if (i + o < 64) gc += y; }
            }
            const float gl = __shfl(gc, dir ? 0 : 63);
            sc[i] = sigmoid_f(scal[so + dir * 8 + h]); sc[64 + i] = gc; sc[128 + i] = expf(gc); sc[192 + i] = expf(gl - gc); if (i == 0) sc[256] = expf(gl); }
        __syncthreads();
        { const int i = tid >> 3, cg = tid & 7; const float ek = sc[192 + i];
          const bf16x8 k0 = *(const LAS bf16x8*)(k_ + i * 136 + cg * 16), k1 = *(const LAS bf16x8*)(k_ + i * 136 + cg * 16 + 8);
#pragma unroll
          for (int x = 0; x < 8; ++x) { kdT[(cg * 16 + x) * 72 + i] = f2bf1(bf2f_s(k0[x]) * ek); kdT[(cg * 16 + 8 + x) * 72 + i] = f2bf1(bf2f_s(k1[x]) * ek); } }
        __syncthreads();
        const int mt = wave & 3, nh = wave >> 2;
        f32x4 aq[2];
        { f32x4 ak[2]; ak[0] = ak[1] = aq[0] = aq[1] = (f32x4){0.f, 0.f, 0.f, 0.f};
          for (int k0 = 0; k0 < 128; k0 += 32) {
              const bf16x8 fk = *(const LAS bf16x8*)(k_ + (mt * 16 + fr) * 136 + k0 + fq * 8), fqv = *(const LAS bf16x8*)(q_ + (mt * 16 + fr) * 136 + k0 + fq * 8);
#pragma unroll
              for (int nl = 0; nl < 2; ++nl) { const bf16x8 fb = *(const LAS bf16x8*)(ST_ + (nh * 32 + nl * 16 + fr) * 136 + k0 + fq * 8);
                  ak[nl] = __builtin_amdgcn_mfma_f32_16x16x32_bf16(fk, fb, ak[nl], 0, 0, 0); aq[nl] = __builtin_amdgcn_mfma_f32_16x16x32_bf16(fqv, fb, aq[nl], 0, 0, 0); } }
          const int i0 = mt * 16 + 4 * fq;
          const f32x4 be4 = *(const LAS f32x4*)(sc + i0), eg4 = *(const LAS f32x4*)(sc + 128 + i0);
#pragma unroll
          for (int nl = 0; nl < 2; ++nl) { const int dv = nh * 32 + nl * 16 + fr;
              const bf16x4 vv = *(const LAS bf16x4*)(vT + dv * 72 + i0);
              float r0 = be4[0] * (bf2f_s(vv[0]) - eg4[0] * ak[nl][0]), r1 = be4[1] * (bf2f_s(vv[1]) - eg4[1] * ak[nl][1]);
              float r2 = be4[2] * (bf2f_s(vv[2]) - eg4[2] * ak[nl][2]), r3 = be4[3] * (bf2f_s(vv[3]) - eg4[3] * ak[nl][3]);
              u32x2 w; w.x = pkbf(r0, r1); w.y = pkbf(r2, r3); *(LAS u32x2*)(rT + dv * 72 + i0) = w;
              aq[nl][0] *= eg4[0]; aq[nl][1] *= eg4[1]; aq[nl][2] *= eg4[2]; aq[nl][3] *= eg4[3]; }
        }
        __syncthreads();
        { f32x4 au[1][2]; au[0][0] = au[0][1] = (f32x4){0.f, 0.f, 0.f, 0.f};
          mma_lds<1, 2>(au, T_, 72, mt * 16, rT, 72, nh * 32, 64, fr, fq);
          const int i0 = mt * 16 + 4 * fq;
#pragma unroll
          for (int nl = 0; nl < 2; ++nl) { const int dv = nh * 32 + nl * 16 + fr; u32x2 w; w.x = pkbf(au[0][nl][0], au[0][nl][1]); w.y = pkbf(au[0][nl][2], au[0][nl][3]); *(LAS u32x2*)(uT + dv * 72 + i0) = w; }
        }
        __syncthreads();
        { f32x4 ao[1][2]; ao[0][0] = aq[0]; ao[0][1] = aq[1];
          mma_lds<1, 2>(ao, QKd, 72, mt * 16, uT, 72, nh * 32, 64, fr, fq);
          const int i0 = mt * 16 + 4 * fq;
#pragma unroll
          for (int nl = 0; nl < 2; ++nl)
#pragma unroll
              for (int r = 0; r < 4; ++r) os[(i0 + r) * 65 + nh * 32 + nl * 16 + fr] = ao[0][nl][r];
          const float egl = sc[256];
          f32x4 as_[1][4];
#pragma unroll
          for (int nt = 0; nt < 4; ++nt) as_[0][nt] = sacc[nt] * egl;
          mma_lds<1, 4>(as_, kdT, 72, wave * 16, uT, 72, 0, 64, fr, fq);
#pragma unroll
          for (int nt = 0; nt < 4; ++nt) { sacc[nt] = as_[0][nt];
              u32x2 w; w.x = pkbf(sacc[nt][0], sacc[nt][1]); w.y = pkbf(sacc[nt][2], sacc[nt][3]); *(LAS u32x2*)(ST_ + (nt * 16 + fr) * 136 + wave * 16 + 4 * fq) = w; }
        }
        __syncthreads();
#pragma unroll
        for (int ii = 0; ii < 4; ++ii) { const int i = wave * 8 + 2 * ii + (lane >> 5), cp = lane & 31;
            atomic_add_bf16x2(og + (rowb + t0 + i) * 1024 + h * 128 + dvh * 64 + 2 * cp, os[i * 65 + 2 * cp], os[i * 65 + 2 * cp + 1]); }
        __syncthreads();
    }
}
typedef float f32x16 __attribute__((ext_vector_type(16)));
typedef short v4i16_t __attribute__((ext_vector_type(4)));
namespace gs2 {
constexpr int KO = 0;
constexpr int QO = KO + 64 * 132 * 2;
constexpr int VTO = QO + 64 * 132 * 2;
constexpr int TO = VTO + 128 * 68 * 2;
constexpr int QKO = TO + 64 * 68 * 2;
constexpr int SCO = QKO + 64 * 68 * 2;
constexpr int BUF = SCO + 1024;
constexpr int OST = 2 * BUF;
constexpr int END = OST + 64 * 136 * 2;
static_assert(END <= MISC_OFF && BUF % 16 == 0, "gdn state LDS map");
}
__device__ __forceinline__ bf16x8 cvt8(const f32x16& x, int base) {
    u32x4 w; w.x = pkbf(x[base], x[base + 1]); w.y = pkbf(x[base + 2], x[base + 3]); w.z = pkbf(x[base + 4], x[base + 5]); w.w = pkbf(x[base + 6], x[base + 7]);
    return __builtin_bit_cast(bf16x8, w);
}
__device__ __forceinline__ bf16x8 afrag(const LAS bf16* p) {
    const bf16x4 lo = *(const LAS bf16x4*)p, hi = *(const LAS bf16x4*)(p + 8);
    return (bf16x8){lo[0], lo[1], lo[2], lo[3], hi[0], hi[1], hi[2], hi[3]};
}
__device__ __forceinline__ bf16x8 afrag_tr(const LAS bf16* p, int ld) {
    const v4i16_t lo = __builtin_amdgcn_ds_read_tr16_b64_v4i16((LAS v4i16_t*)p), hi = __builtin_amdgcn_ds_read_tr16_b64_v4i16((LAS v4i16_t*)(p + 8 * ld));
    return (bf16x8){lo[0], lo[1], lo[2], lo[3], hi[0], hi[1], hi[2], hi[3]};
}
#define MFMA32(a, b, c) __builtin_amdgcn_mfma_f32_32x32x16_bf16((a), (b), (c), 0, 0, 0)

#ifndef WG_BAR
#define WG_BAR() asm volatile("s_waitcnt lgkmcnt(0)\n\ts_barrier" ::: "memory")
#endif
template <int DIR>
__device__ __forceinline__ void gdn_state2(LAS unsigned char* lds, int b, int h, const bf16* raw, const float* scal, const bf16* TQ,
                                           const float* A_log, const float* dt_bias, bf16* og, int tid, int wave, int lane, float* probe = nullptr) {
    using namespace gs2;
    const size_t rowb = (size_t)b * SEQ; const int bh = b * 8 + h;
    const float expA = expf(A_log[DIR * 8 + h]), dtb = dt_bias[DIR * 8 + h];
    LAS bf16* ost = (LAS bf16*)(lds + OST);
    const int r31 = lane & 31, hh = lane >> 5;
    if (wave >= 4) {
        const int ht = tid - 256;
        unsigned go[16], lo_[16]; u32x4 ld[16]; float sr0 = 0.f, sr1 = 0.f;
#pragma unroll
        for (int x = 0; x < 4; ++x) { const int e = ht + 256 * x, r = e >> 4, p = e & 15;
            go[x] = (unsigned)((r * CONV_CH + 1024 + h * 128 + p * 8) * 2); go[4 + x] = (unsigned)((r * CONV_CH + h * 128 + p * 8) * 2);
            lo_[x] = (unsigned)(KO + (r * 132 + p * 8) * 2); lo_[4 + x] = (unsigned)(QO + (r * 132 + p * 8) * 2); }
#pragma unroll
        for (int x = 0; x < 4; ++x) { const int e = ht + 256 * x, dv = e >> 3, p = e & 7;
            go[8 + x] = (unsigned)(((dv >> 1) * CONV_CH + 2048 + h * 128 + (dv & 1) * 64 + p * 8) * 2); lo_[8 + x] = (unsigned)(VTO + (dv * 68 + p * 8) * 2); }
        u32x4 km[2], dg[2], qm[2];
#pragma unroll
        for (int x = 0; x < 2; ++x) { const int e = ht + 256 * x, i = e >> 3, p = e & 7;
            go[12 + x] = (unsigned)(e * 16); go[14 + x] = (unsigned)(8192 + e * 16);
            lo_[12 + x] = (unsigned)(TO + (i * 68 + p * 8) * 2); lo_[14 + x] = (unsigned)(QKO + (i * 68 + p * 8) * 2);
            unsigned kw[4], dw[4], qw[4];
#pragma unroll
            for (int w = 0; w < 4; ++w) { const int j0 = p * 8 + 2 * w, j1 = j0 + 1;
                const bool k0 = DIR ? (i < j0) : (i > j0), k1 = DIR ? (i < j1) : (i > j1);
                kw[w] = (k0 ? 0xFFFFu : 0u) | (k1 ? 0xFFFF0000u : 0u); dw[w] = (i == j0 ? 0x3F80u : 0u) | (i == j1 ? 0x3F800000u : 0u);
                qw[w] = kw[w] | (i == j0 ? 0xFFFFu : 0u) | (i == j1 ? 0xFFFF0000u : 0u); }
            km[x] = (u32x4){kw[0], kw[1], kw[2], kw[3]}; dg[x] = (u32x4){dw[0], dw[1], dw[2], dw[3]}; qm[x] = (u32x4){qw[0], qw[1], qw[2], qw[3]}; }
        const unsigned so_l = (unsigned)(lane * 256 + (DIR * 8 + h) * 4);
#define GS2_ISSUE(c_) do { const GAS char* rb_ = (const GAS char*)(raw + (rowb + (size_t)(c_) * 64) * CONV_CH); const GAS char* tb_ = (const GAS char*)(TQ + ((size_t)(bh * NCHUNK + (c_))) * 8192); \
            _Pragma("unroll") for (int x = 0; x < 12; ++x) ld[x] = *(const GAS u32x4*)(rb_ + go[x]); \
            _Pragma("unroll") for (int x = 12; x < 16; ++x) ld[x] = *(const GAS u32x4*)(tb_ + go[x]); \
            if (wave == 4) { const GAS char* sb_ = (const GAS char*)(scal + (rowb + (size_t)(c_) * 64) * 64); sr0 = *(const GAS float*)(sb_ + so_l); sr1 = *(const GAS float*)(sb_ + so_l + 64); } } while (0)
#define GS2_ST16(off_, v_) do { LAS unsigned char* d_ = B_ + (off_); *(LAS u32x2*)(d_) = (u32x2){(v_).x, (v_).y}; *(LAS u32x2*)(d_ + 8) = (u32x2){(v_).z, (v_).w}; } while (0)
#define GS2_COMMIT(bi_, c_) do { LAS unsigned char* B_ = lds + (bi_) * BUF; \
            _Pragma("unroll") for (int x = 0; x < 12; ++x) GS2_ST16(lo_[x], ld[x]); \
            _Pragma("unroll") for (int x = 0; x < 2; ++x) { const u32x4 tv = (ld[12 + x] & km[x]) | dg[x], qv = ld[14 + x] & qm[x]; \
                GS2_ST16(lo_[12 + x], tv); GS2_ST16(lo_[14 + x], qv); } \
            if (wave == 4) { LAS float* sc_ = (LAS float*)(B_ + SCO); const int i = lane; \
                const float g = -expA * softplus_f(sr1 + dtb); float gc = g; \
                if (DIR == 0) { _Pragma("unroll") for (int o = 1; o < 64; o <<= 1) { const float y = __shfl_up(gc, o); if (i >= o) gc += y; } } \
                else { _Pragma("unroll") for (int o = 1; o < 64; o <<= 1) { const float y = __shfl_down(gc, o); if (i + o < 64) gc += y; } } \
                const float gl = __shfl(gc, DIR ? 0 : 63); \
                sc_[i] = sigmoid_f(sr0); sc_[64 + i] = expf(gc); sc_[128 + i] = expf(gl - gc); if (i == 0) sc_[192] = expf(gl); } } while (0)
        { const int c0 = DIR ? NCHUNK - 1 : 0; GS2_ISSUE(c0); GS2_COMMIT(0, c0); GS2_ISSUE((DIR ? c0 - 1 : c0 + 1)); }
        for (int n = 0; n < NCHUNK; ++n) {
            const int c = DIR ? NCHUNK - 1 - n : n;
            WG_BAR();
            const bool more = n + 1 < NCHUNK; const int cn = DIR ? c - 1 : c + 1;
            unsigned ov[16];
            if (n > 0) {
#pragma unroll
                for (int x = 0; x < 16; ++x) ov[x] = *(const LAS unsigned*)(ost + ((wave - 4) * 16 + x) * 136 + 2 * lane);
            }
            WG_BAR();
            if (n > 0) { const int tp = (DIR ? c + 1 : c - 1) * 64;
#pragma unroll
                for (int x = 0; x < 16; ++x) { GAS char* ob_ = (GAS char*)(og + (rowb + tp + (wave - 4) * 16 + x) * 1024 + h * 128);
                    (void)__builtin_amdgcn_global_atomic_fadd_v2bf16((GAS s16x2*)(ob_ + lane * 4), __builtin_bit_cast(s16x2, ov[x])); } }
            if (more) { GS2_COMMIT((n + 1) & 1, cn); if (n + 2 < NCHUNK) GS2_ISSUE((DIR ? cn - 1 : cn + 1)); }
        }
        WG_BAR();
        { const int tp = (DIR ? 0 : NCHUNK - 1) * 64;
#pragma unroll
          for (int x = 0; x < 16; ++x) { const unsigned v = *(const LAS unsigned*)(ost + ((wave - 4) * 16 + x) * 136 + 2 * lane);
              (void)__builtin_amdgcn_global_atomic_fadd_v2bf16((GAS s16x2*)(og + (rowb + tp + (wave - 4) * 16 + x) * 1024 + h * 128 + 2 * lane), __builtin_bit_cast(s16x2, v)); } }
#undef GS2_ISSUE
#undef GS2_COMMIT
#undef GS2_ST16
    } else {
        const int dv0 = 32 * wave;
#if defined(PROBE_STATE)
        unsigned long long tw_ = 0ull; const unsigned long long ts0_ = __builtin_amdgcn_s_memtime();
#define PB_BAR() do { const unsigned long long t0_ = __builtin_amdgcn_s_memtime(); WG_BAR(); tw_ += __builtin_amdgcn_s_memtime() - t0_; } while (0)
#else
#define PB_BAR() WG_BAR()
#endif
        f32x16 St[4];
#pragma unroll
        for (int t = 0; t < 4; ++t)
#pragma unroll
            for (int r = 0; r < 16; ++r) St[t][r] = 0.f;
        for (int n = 0; n < NCHUNK; ++n) {
            PB_BAR();
            const LAS unsigned char* Bb = lds + (n & 1) * BUF;
            const LAS bf16* Kb = (const LAS bf16*)(Bb + KO); const LAS bf16* Qb = (const LAS bf16*)(Bb + QO); const LAS bf16* Vb = (const LAS bf16*)(Bb + VTO);
            const LAS bf16* Tb = (const LAS bf16*)(Bb + TO); const LAS bf16* QKb = (const LAS bf16*)(Bb + QKO); const LAS float* sc = (const LAS float*)(Bb + SCO);
            f32x16 aK[2], aQ[2];
#pragma unroll
            for (int m = 0; m < 2; ++m)
#pragma unroll
                for (int r = 0; r < 16; ++r) { aK[m][r] = 0.f; aQ[m][r] = 0.f; }
#pragma unroll
            for (int ks = 0; ks < 8; ++ks) { const bf16x8 bs = cvt8(St[ks >> 1], 8 * (ks & 1));
#pragma unroll
                for (int m = 0; m < 2; ++m) { const int off = (32 * m + r31) * 132 + 16 * ks + 4 * hh;
                    aK[m] = MFMA32(afrag(Kb + off), bs, aK[m]); aQ[m] = MFMA32(afrag(Qb + off), bs, aQ[m]); }
                if (ks & 1) asm volatile("" ::: "memory"); }
#pragma unroll
            for (int m = 0; m < 2; ++m)
#pragma unroll
                for (int q4 = 0; q4 < 4; ++q4) { const int tb = 32 * m + 8 * q4 + 4 * hh;
                    const bf16x4 vv = *(const LAS bf16x4*)(Vb + (dv0 + r31) * 68 + tb); const f32x4 be = *(const LAS f32x4*)(sc + tb), eg = *(const LAS f32x4*)(sc + 64 + tb);
#pragma unroll
                    for (int e = 0; e < 4; ++e) { aK[m][4 * q4 + e] = be[e] * (bf2f_s(vv[e]) - eg[e] * aK[m][4 * q4 + e]); aQ[m][4 * q4 + e] *= eg[e]; } }
            f32x16 au[2];
#pragma unroll
            for (int m = 0; m < 2; ++m)
#pragma unroll
                for (int r = 0; r < 16; ++r) au[m][r] = 0.f;
#pragma unroll
            for (int mi = 0; mi < 2; ++mi)
#pragma unroll
                for (int kt = 0; kt < 4; ++kt) { const bool need = DIR ? (kt >= 2 * mi) : (kt <= 2 * mi + 1);
                    if (need) au[mi] = MFMA32(afrag(Tb + (32 * mi + r31) * 68 + 16 * kt + 4 * hh), cvt8(aK[kt >> 1], 8 * (kt & 1)), au[mi]); }
#pragma unroll
            for (int mi = 0; mi < 2; ++mi)
#pragma unroll
                for (int kt = 0; kt < 4; ++kt) { const bool need = DIR ? (kt >= 2 * mi) : (kt <= 2 * mi + 1);
                    if (need) aQ[mi] = MFMA32(afrag(QKb + (32 * mi + r31) * 68 + 16 * kt + 4 * hh), cvt8(au[kt >> 1], 8 * (kt & 1)), aQ[mi]); }
#pragma unroll
            for (int m = 0; m < 2; ++m)
#pragma unroll
                for (int q4 = 0; q4 < 4; ++q4) { const f32x4 ek = *(const LAS f32x4*)(sc + 128 + 32 * m + 8 * q4 + 4 * hh);
#pragma unroll
                    for (int e = 0; e < 4; ++e) au[m][4 * q4 + e] *= ek[e]; }
            const float egl = sc[192];
            PB_BAR();
#pragma unroll
            for (int mi = 0; mi < 2; ++mi)
#pragma unroll
                for (int r = 0; r < 16; ++r) ost[(32 * mi + (r & 3) + 8 * (r >> 2) + 4 * hh) * 136 + dv0 + r31] = f2bf1(aQ[mi][r]);
            { const int i16 = r31 & 15; const LAS bf16* kp = Kb + (4 * hh + (i16 >> 2)) * 132 + 16 * (r31 >> 4) + 4 * (i16 & 3);
#pragma unroll
              for (int t = 0; t < 4; ++t) {
#pragma unroll
                  for (int r = 0; r < 16; ++r) St[t][r] *= egl;
#pragma unroll
                  for (int kt = 0; kt < 4; ++kt) St[t] = MFMA32(afrag_tr(kp + (16 * kt) * 132 + 32 * t, 132), cvt8(au[kt >> 1], 8 * (kt & 1)), St[t]);
                  asm volatile("" ::: "memory"); } }
        }
        WG_BAR();
#if defined(PROBE_STATE)
        if (blockIdx.x == 0 && tid == 0 && probe) { const unsigned long long tt_ = __builtin_amdgcn_s_memtime() - ts0_; *probe = (float)((double)tw_ / (double)tt_); }
#endif
    }
}
namespace psd {
constexpr int CW = 0;
constexpr int SC = CW + 8 * 768 * 4;
constexpr int BM_ = SC + 8 * 4 * 64 * 4;
constexpr int CM_ = BM_ + 64 * 136 * 2;
constexpr int CB = CM_ + 64 * 136 * 2;
constexpr int R = CB + 64 * 68 * 4;
constexpr int RBC = R, RBC_END = R + 70 * 272 * 2;
constexpr int RX = R, XT = RX + 70 * 136 * 2, MM = XT + 128 * 72 * 2, R_END = MM + 2 * 64 * 72 * 2;
constexpr int YST = RX;
constexpr int PRBC = CW + 8 * 768 * 4, PXT = PRBC + 70 * 272 * 2, P_END = PXT + 256 * 72 * 2;
constexpr int STASH = pgd::STASH + 4608;
static_assert(P_END <= pgd::STASH, "prep ssd conv LDS map");
static_assert(RBC_END <= pgd::STASH && R_END <= pgd::STASH && STASH + 9216 <= MISC_OFF, "prep ssd LDS map");
}
__device__ __forceinline__ void prep_ssd_stash(LAS unsigned char* lds, int bid, const bf16* raw, int tid) {
    const int bg = bid >> 5, b = bg >> 1, g = bg & 1, r32 = bid & 31;
    LAS bf16* st = (LAS bf16*)(lds + psd::STASH);
    for (int e = tid; e < 2 * 3 * 96; e += 512) { const int which = e / 288, r = (e % 288) / 96, p = e % 96;
        const int t = which ? (r32 * 4 + 4) * 64 + r : r32 * 4 * 64 - 3 + r;
        const int col = p < 64 ? 3072 + g * 512 + p * 8 : (p < 80 ? 4096 + g * 128 + (p - 64) * 8 : 4352 + g * 128 + (p - 80) * 8);
        u32x4 v = (u32x4){0u, 0u, 0u, 0u};
        if (t >= 0 && t < SEQ) v = *(const GAS u32x4*)(raw + ((size_t)b * SEQ + t) * CONV_CH + col);
        *(LAS u32x4*)(st + which * 2304 + r * 768 + p * 8) = v; }
}
__device__ __forceinline__ void prep_ssd_range(LAS unsigned char* lds, int bid, bf16* raw, const float* conv_w, const float* conv_b, int tid_p) {
    using namespace psd;
    const int bg = bid >> 5, b = bg >> 1, g = bg & 1, r32 = bid & 31;
    LAS float* cw = (LAS float*)(lds + CW);
    LAS bf16* rbc = (LAS bf16*)(lds + PRBC); LAS bf16* xT = (LAS bf16*)(lds + PXT);
    LAS bf16* st = (LAS bf16*)(lds + STASH);
    for (int e = tid_p; e < 8 * 768; e += 512) { const int r = e / 768, c = e % 768;
        const int gch = c < 512 ? 3072 + g * 512 + c : (c < 640 ? 4096 + g * 128 + (c - 512) : 4352 + g * 128 + (c - 640));
        cw[e] = r < 7 ? conv_w[r * CONV_CH + gch] : conv_b[gch]; }
    const size_t rowb = (size_t)b * SEQ;
    __syncthreads();
    for (int u = 0; u < 4; ++u) {
        int tid = tid_p; asm volatile("" : "+v"(tid));
        const int lane = tid & 63, wave = __builtin_amdgcn_readfirstlane(tid >> 6);
        const int c = r32 * 4 + u, t0 = c * 64;
        for (int ps = 0; ps < 3; ++ps) {
            const int scol = ps == 0 ? 512 : (ps == 1 ? 0 : 256);
            const int gcol = ps == 0 ? 4096 + g * 128 : 3072 + g * 512 + (ps - 1) * 256;
            for (int e = tid; e < 70 * 32; e += 512) { const int r = e >> 5, p = e & 31;
                u32x4 v;
                if (r < 3) v = *(const LAS u32x4*)(st + r * 768 + scol + p * 8);
                else if (r >= 67 && u == 3) v = *(const LAS u32x4*)(st + 2304 + (r - 67) * 768 + scol + p * 8);
                else { const int col = ps == 0 ? (p < 16 ? 4096 + g * 128 + p * 8 : 4352 + g * 128 + (p - 16) * 8) : gcol + p * 8;
                       v = *(const GAS u32x4*)(raw + (rowb + t0 - 3 + r) * CONV_CH + col); }
                *(LAS u32x4*)(rbc + r * 272 + (p < 16 ? p * 8 : 136 + (p - 16) * 8)) = v; }
            __syncthreads();
            if (tid < 96) { const int r = tid >> 5, p = tid & 31;
                *(LAS u32x4*)(st + r * 768 + scol + p * 8) = *(const LAS u32x4*)(rbc + (64 + r) * 272 + (p < 16 ? p * 8 : 136 + (p - 16) * 8)); }
            { const int tg = wave, cp = lane; float w[16], o[16];
#pragma unroll
              for (int hf = 0; hf < 2; ++hf) {
#pragma unroll
                  for (int tap = 0; tap < 8; ++tap) { w[2 * tap] = cw[tap * 768 + scol + hf * 128 + 2 * cp]; w[2 * tap + 1] = cw[tap * 768 + scol + hf * 128 + 2 * cp + 1]; }
                  conv_pair8(o, rbc + (8 * tg) * 272 + hf * 136 + 2 * cp, 272, w);
#pragma unroll
                  for (int t = 0; t < 16; ++t) o[t] = silu(o[t]);
                  if (ps == 0) {
#pragma unroll
                      for (int t = 0; t < 8; ++t) *(GAS unsigned*)(raw + (rowb + t0 + 8 * tg + t) * CONV_CH + (hf ? 4352 : 4096) + g * 128 + 2 * cp) = pkbf(o[2 * t], o[2 * t + 1]);
                  } else {
                      u32x4 e0, e1; e0.x = pkbf(o[0], o[2]); e0.y = pkbf(o[4], o[6]); e0.z = pkbf(o[8], o[10]); e0.w = pkbf(o[12], o[14]);
                      e1.x = pkbf(o[1], o[3]); e1.y = pkbf(o[5], o[7]); e1.z = pkbf(o[9], o[11]); e1.w = pkbf(o[13], o[15]);
                      *(LAS u32x4*)(xT + (hf * 128 + 2 * cp) * 72 + 8 * tg) = e0; *(LAS u32x4*)(xT + (hf * 128 + 2 * cp + 1) * 72 + 8 * tg) = e1; } } }
            __syncthreads();
            if (ps > 0) {
                for (int e = tid; e < 256 * 8; e += 512) { const int xr = e >> 3, p = e & 7; const int hl = (ps - 1) * 4 + (xr >> 6), pp = xr & 63;
                    *(GAS u32x4*)(raw + (rowb + t0 + pp) * CONV_CH + 3072 + (g * 8 + hl) * 64 + p * 8) = *(const LAS u32x4*)(xT + xr * 72 + p * 8); }
                __syncthreads(); }
        }
    }
}
__device__ __forceinline__ void ssd_intra_range(LAS unsigned char* lds, int bid, const bf16* raw, const float* scal, const float* A_log, const float* dt_bias, const float* Dp, bf16* yi, int tid_p) {
    using namespace psd;
    const int bg = bid >> 5, b = bg >> 1, g = bg & 1, r32 = bid & 31;
    LAS float* sc = (LAS float*)(lds + SC);
    LAS bf16* Bm = (LAS bf16*)(lds + BM_); LAS bf16* Cm = (LAS bf16*)(lds + CM_); LAS float* cb = (LAS float*)(lds + CB);
    LAS bf16* xT = (LAS bf16*)(lds + XT); LAS bf16* Mm = (LAS bf16*)(lds + MM); LAS bf16* yst = (LAS bf16*)(lds + YST);
    const size_t rowb = (size_t)b * SEQ;
    for (int u = 0; u < 4; ++u) {
        int tid = tid_p; asm volatile("" : "+v"(tid));
        const int lane = tid & 63, wave = __builtin_amdgcn_readfirstlane(tid >> 6), fr = lane & 15, fq = lane >> 4;
        const int c = r32 * 4 + u, t0 = c * 64;
        const int hd_w = g * 8 + wave;
        const float Af_ = -expf(A_log[hd_w]), Ab_ = -expf(A_log[16 + hd_w]), bf_ = dt_bias[hd_w], bb_ = dt_bias[16 + hd_w];
        for (int e = tid; e < 64 * 32; e += 512) { const int r = e >> 5, p = e & 31;
            const u32x4 v = *(const GAS u32x4*)(raw + (rowb + t0 + r) * CONV_CH + (p < 16 ? 4096 + g * 128 + p * 8 : 4352 + g * 128 + (p - 16) * 8));
            *(LAS u32x4*)((p < 16 ? Bm + r * 136 + p * 8 : Cm + r * 136 + (p - 16) * 8)) = v; }
        { const int i = lane; const size_t so = (rowb + t0 + i) * 64;
          const float dtf = softplus_f(scal[so + 32 + hd_w] + bf_), dtb = softplus_f(scal[so + 48 + hd_w] + bb_);
          float cf = dtf * Af_, cbk = dtb * Ab_;
#pragma unroll
          for (int o = 1; o < 64; o <<= 1) { const float y = __shfl_up(cf, o), z = __shfl_down(cbk, o); if (i >= o) cf += y; if (i + o < 64) cbk += z; }
          LAS float* s = sc + wave * 256; s[i] = dtf; s[64 + i] = cf * 1.4426950408889634f; s[128 + i] = dtb; s[192 + i] = cbk * 1.4426950408889634f; }
        __syncthreads();
        { const int mt = wave & 3, nh = wave >> 2;
          f32x4 acc[1][2]; acc[0][0] = acc[0][1] = (f32x4){0.f, 0.f, 0.f, 0.f};
          mma_lds<1, 2>(acc, Cm, 136, mt * 16, Bm, 136, nh * 32, 128, fr, fq);
#pragma unroll
          for (int nl = 0; nl < 2; ++nl)
#pragma unroll
              for (int r = 0; r < 4; ++r) cb[(mt * 16 + 4 * fq + r) * 68 + nh * 32 + nl * 16 + fr] = acc[0][nl][r]; }
        for (int hp = 0; hp < 4; ++hp) {
            __syncthreads();
            for (int e = tid; e < 128 * 8; e += 512) { const int xr = e >> 3, p = e & 7; const int hl = 2 * hp + (xr >> 6), pp = xr & 63;
                *(LAS u32x4*)(xT + xr * 72 + p * 8) = *(const GAS u32x4*)(raw + (rowb + t0 + pp) * CONV_CH + 3072 + (g * 8 + hl) * 64 + p * 8); }
            { const int e = tid >> 8, i = (tid >> 2) & 63, jq = tid & 3; const int hl = 2 * hp + e;
              const LAS float* s = sc + hl * 256; const float Dh = Dp[g * 8 + hl];
              const float csfi = s[64 + i], csbi = s[192 + i], dsum = s[i] + s[128 + i];
#pragma unroll
              for (int jj = 0; jj < 16; jj += 2) { float m2[2];
#pragma unroll
                  for (int y = 0; y < 2; ++y) { const int j = jq * 16 + jj + y; const float cbv = cb[i * 68 + j];
                      const float arg = (i > j) ? csfi - s[64 + j] : csbi - s[192 + j];
                      const float dtj = (i > j) ? s[j] : s[128 + j];
                      const float w = (i == j) ? dsum : __builtin_amdgcn_exp2f(fminf(arg, 0.f)) * dtj;
                      m2[y] = cbv * w + ((i == j) ? Dh : 0.f); }
                  *(LAS unsigned*)(Mm + (e * 64 + i) * 72 + jq * 16 + jj) = pkbf(m2[0], m2[1]); } }
            __syncthreads();
            { const int e = wave >> 2, mt = wave & 3;
              f32x4 acc[1][4];
#pragma unroll
              for (int nt = 0; nt < 4; ++nt) acc[0][nt] = (f32x4){0.f, 0.f, 0.f, 0.f};
              mma_lds<1, 4>(acc, xT + e * 64 * 72, 72, mt * 16, Mm + e * 64 * 72, 72, 0, 64, fr, fq);
#pragma unroll
              for (int nt = 0; nt < 4; ++nt) { u32x2 w; w.x = pkbf(acc[0][nt][0], acc[0][nt][1]); w.y = pkbf(acc[0][nt][2], acc[0][nt][3]);
                  *(LAS u32x2*)(yst + (nt * 16 + fr) * 136 + e * 64 + mt * 16 + 4 * fq) = w; } }
            __syncthreads();
            for (int e = tid; e < 64 * 16; e += 512) { const int i = e >> 4, p = e & 15;
                *(GAS u32x4*)(yi + (rowb + t0 + i) * 1024 + (g * 8 + 2 * hp) * 64 + p * 8) = *(const LAS u32x4*)(yst + i * 136 + p * 8); }
        }
        __syncthreads();
    }
}

namespace ss2 {
constexpr int CO = 0;
constexpr int BO = CO + 64 * 132 * 2;
constexpr int XO = BO + 64 * 132 * 2;
constexpr int SCO = XO + 128 * 72 * 2;
constexpr int BUF = SCO + 1536;
constexpr int OST = 2 * BUF;
constexpr int END = OST + 64 * 136 * 2;
static_assert(END <= MISC_OFF && BUF % 16 == 0, "ssd state LDS map");
}
#ifndef WG_BAR
#define WG_BAR() asm volatile("s_waitcnt lgkmcnt(0)\n\ts_barrier" ::: "memory")
#endif
template <int DIR>
__device__ __forceinline__ void ssd_state2(LAS unsigned char* lds, int b, int g, int hp, const bf16* raw, const float* scal,
                                           const float* A_log, const float* dt_bias, bf16* ys, int tid, int wave, int lane) {
    using namespace ss2;
    const size_t rowb = (size_t)b * SEQ; const int hd0 = g * 8 + 2 * hp;
    LAS bf16* ost = (LAS bf16*)(lds + OST);
    const int r31 = lane & 31, hh = lane >> 5;
    if (wave >= 4) {
        const int ht = tid - 256;
        const int he = (wave - 4) & 1; const float Ah = -expf(A_log[DIR * 16 + hd0 + he]), dtb = dt_bias[DIR * 16 + hd0 + he];
        unsigned go[12], lo_[12]; u32x4 ld[12]; float sr0 = 0.f;
#pragma unroll
        for (int x = 0; x < 4; ++x) { const int e = ht + 256 * x, r = e >> 4, p = e & 15;
            go[x] = (unsigned)((r * CONV_CH + 4352 + g * 128 + p * 8) * 2); go[4 + x] = (unsigned)((r * CONV_CH + 4096 + g * 128 + p * 8) * 2);
            lo_[x] = (unsigned)(CO + (r * 132 + p * 8) * 2); lo_[4 + x] = (unsigned)(BO + (r * 132 + p * 8) * 2); }
#pragma unroll
        for (int x = 0; x < 4; ++x) { const int e = ht + 256 * x, xr = e >> 3, p = e & 7;
            go[8 + x] = (unsigned)(((xr & 63) * CONV_CH + 3072 + (hd0 + (xr >> 6)) * 64 + p * 8) * 2); lo_[8 + x] = (unsigned)(XO + (xr * 72 + p * 8) * 2); }
        const unsigned so_l = (unsigned)(lane * 256 + (32 + DIR * 16 + hd0 + he) * 4);
#define SS2_ISSUE(c_) do { const GAS char* rb_ = (const GAS char*)(raw + (rowb + (size_t)(c_) * 64) * CONV_CH); \
            _Pragma("unroll") for (int x = 0; x < 12; ++x) ld[x] = *(const GAS u32x4*)(rb_ + go[x]); \
            if (wave < 6) sr0 = *(const GAS float*)((const GAS char*)(scal + (rowb + (size_t)(c_) * 64) * 64) + so_l); } while (0)
#define SS2_COMMIT(bi_, c_) do { LAS unsigned char* B_ = lds + (bi_) * BUF; \
            _Pragma("unroll") for (int x = 0; x < 12; ++x) { LAS unsigned char* d_ = B_ + lo_[x]; *(LAS u32x2*)(d_) = (u32x2){ld[x].x, ld[x].y}; *(LAS u32x2*)(d_ + 8) = (u32x2){ld[x].z, ld[x].w}; } \
            if (wave < 6) { LAS float* sc_ = (LAS float*)(B_ + SCO) + he * 192; const int i = lane; \
                const float dt = softplus_f(sr0 + dtb); float cs = dt * Ah; \
                if (DIR == 0) { _Pragma("unroll") for (int o = 1; o < 64; o <<= 1) { const float y = __shfl_up(cs, o); if (i >= o) cs += y; } } \
                else { _Pragma("unroll") for (int o = 1; o < 64; o <<= 1) { const float y = __shfl_down(cs, o); if (i + o < 64) cs += y; } } \
                const float cl = __shfl(cs, DIR ? 0 : 63); \
                sc_[i] = expf(cs); sc_[64 + i] = dt * expf(cl - cs); if (i == 0) sc_[128] = expf(cl); } } while (0)
        { const int c0 = DIR ? NCHUNK - 1 : 0; SS2_ISSUE(c0); SS2_COMMIT(0, c0); SS2_ISSUE((DIR ? c0 - 1 : c0 + 1)); }
        for (int n = 0; n < NCHUNK; ++n) {
            const int c = DIR ? NCHUNK - 1 - n : n;
            WG_BAR();
            const bool more = n + 1 < NCHUNK; const int cn = DIR ? c - 1 : c + 1;
            unsigned ov[16];
            if (n > 0) {
#pragma unroll
                for (int x = 0; x < 16; ++x) ov[x] = *(const LAS unsigned*)(ost + ((wave - 4) * 16 + x) * 136 + 2 * lane);
            }
            WG_BAR();
            if (n > 0) { const int tp = (DIR ? c + 1 : c - 1) * 64;
#pragma unroll
                for (int x = 0; x < 16; ++x) { GAS char* ob_ = (GAS char*)(ys + (rowb + tp + (wave - 4) * 16 + x) * 1024 + hd0 * 64);
                    (void)__builtin_amdgcn_global_atomic_fadd_v2bf16((GAS s16x2*)(ob_ + lane * 4), __builtin_bit_cast(s16x2, ov[x])); } }
            if (more) { SS2_COMMIT((n + 1) & 1, cn); if (n + 2 < NCHUNK) SS2_ISSUE((DIR ? cn - 1 : cn + 1)); }
        }
        WG_BAR();
        { const int tp = (DIR ? 0 : NCHUNK - 1) * 64;
#pragma unroll
          for (int x = 0; x < 16; ++x) { const unsigned v = *(const LAS unsigned*)(ost + ((wave - 4) * 16 + x) * 136 + 2 * lane);
              (void)__builtin_amdgcn_global_atomic_fadd_v2bf16((GAS s16x2*)(ys + (rowb + tp + (wave - 4) * 16 + x) * 1024 + hd0 * 64 + 2 * lane), __builtin_bit_cast(s16x2, v)); } }
#undef SS2_ISSUE
#undef SS2_COMMIT
    } else {
        const int e = wave >> 1, ps = wave & 1; const int xrow = e * 64 + ps * 32 + r31;
        f32x16 Ht[4];
#pragma unroll
        for (int t = 0; t < 4; ++t)
#pragma unroll
            for (int r = 0; r < 16; ++r) Ht[t][r] = 0.f;
        for (int n = 0; n < NCHUNK; ++n) {
            WG_BAR();
            const LAS unsigned char* Bb = lds + (n & 1) * BUF;
            const LAS bf16* Cb = (const LAS bf16*)(Bb + CO); const LAS bf16* Bmb = (const LAS bf16*)(Bb + BO); const LAS bf16* Xb = (const LAS bf16*)(Bb + XO);
            const LAS float* sc = (const LAS float*)(Bb + SCO) + e * 192;
            f32x16 aY[2];
#pragma unroll
            for (int m = 0; m < 2; ++m)
#pragma unroll
                for (int r = 0; r < 16; ++r) aY[m][r] = 0.f;
#pragma unroll
            for (int ks = 0; ks < 8; ++ks) { const bf16x8 bs = cvt8(Ht[ks >> 1], 8 * (ks & 1));
#pragma unroll
                for (int m = 0; m < 2; ++m) aY[m] = MFMA32(afrag(Cb + (32 * m + r31) * 132 + 16 * ks + 4 * hh), bs, aY[m]);
                if (ks & 1) asm volatile("" ::: "memory"); }
#pragma unroll
            for (int m = 0; m < 2; ++m)
#pragma unroll
                for (int q4 = 0; q4 < 4; ++q4) { const f32x4 ec = *(const LAS f32x4*)(sc + 32 * m + 8 * q4 + 4 * hh);
#pragma unroll
                    for (int x = 0; x < 4; ++x) aY[m][4 * q4 + x] *= ec[x]; }
            const float ecl = sc[128];
            WG_BAR();
#pragma unroll
            for (int mi = 0; mi < 2; ++mi)
#pragma unroll
                for (int r = 0; r < 16; ++r) ost[(32 * mi + (r & 3) + 8 * (r >> 2) + 4 * hh) * 136 + e * 64 + ps * 32 + r31] = f2bf1(aY[mi][r]);
            { const int i16 = r31 & 15; const LAS bf16* bp = Bmb + (8 * hh + (i16 >> 2)) * 132 + 16 * (r31 >> 4) + 4 * (i16 & 3);
              bf16x8 xf[4];
#pragma unroll
              for (int kt = 0; kt < 4; ++kt) { const bf16x8 xv = *(const LAS bf16x8*)(Xb + xrow * 72 + 16 * kt + 8 * hh);
                  const f32x4 w0 = *(const LAS f32x4*)(sc + 64 + 16 * kt + 8 * hh), w1 = *(const LAS f32x4*)(sc + 64 + 16 * kt + 8 * hh + 4);
                  u32x4 w; w.x = pkbf(bf2f_s(xv[0]) * w0[0], bf2f_s(xv[1]) * w0[1]); w.y = pkbf(bf2f_s(xv[2]) * w0[2], bf2f_s(xv[3]) * w0[3]);
                  w.z = pkbf(bf2f_s(xv[4]) * w1[0], bf2f_s(xv[5]) * w1[1]); w.w = pkbf(bf2f_s(xv[6]) * w1[2], bf2f_s(xv[7]) * w1[3]);
                  xf[kt] = __builtin_bit_cast(bf16x8, w); }
#pragma unroll
              for (int t = 0; t < 4; ++t) {
#pragma unroll
                  for (int r = 0; r < 16; ++r) Ht[t][r] *= ecl;
#pragma unroll
                  for (int kt = 0; kt < 4; ++kt) { const LAS bf16* p = bp + (16 * kt) * 132 + 32 * t;
                      const v4i16_t lo = __builtin_amdgcn_ds_read_tr16_b64_v4i16((LAS v4i16_t*)p), hi = __builtin_amdgcn_ds_read_tr16_b64_v4i16((LAS v4i16_t*)(p + 4 * 132));
                      Ht[t] = MFMA32(((bf16x8){lo[0], lo[1], lo[2], lo[3], hi[0], hi[1], hi[2], hi[3]}), xf[kt], Ht[t]); }
                  asm volatile("" ::: "memory"); } }
        }
        WG_BAR();
    }
}
#ifndef MK_ONE_LAUNCH
#define MK_ONE_LAUNCH 1
#endif
constexpr int PPL = 14;
constexpr int NPHASE = 1 + PPL * DEPTH;
struct Args { const float* in[19]; float* out; unsigned char* ws; int ph_lo, ph_hi; };
__global__ void __launch_bounds__(NWAVES * 64, 2) fwd_kernel(Args args) {
    extern __shared__ __attribute__((aligned(16))) unsigned char lds_raw[];
    LAS unsigned char* lds = (LAS unsigned char*)lds_raw;
    unsigned* ctl = (unsigned*)(args.ws + WS_CTL);
    volatile LAS unsigned* MISC = (volatile LAS unsigned*)(lds + MISC_OFF);
    for (int u = threadIdx.x; u < 64; u += 512) MISC[u] = 0u;
    __syncthreads();
#if MK_ONE_LAUNCH
    XcdBarrier bar = xcd_barrier_post(ctl + CW_BAR, MISC + 8);
#define GRID_BAR() do { XcdBarrier bb_ = bar; asm volatile("" : "+s"(bb_.bar), "+s"(bb_.x)); xcd_barrier(bb_); } while (0)
#else
#define GRID_BAR() do {} while (0)
#endif
    const int lo = args.ph_lo, hi = args.ph_hi;
#define WSP(T, off) ((T*)(wsb + (off)))
#if defined(PROBE_STATE) || defined(PROBE_ANY)
#define PROBE_PTR ((float*)(wsb + WS_CTL) + 2048)
#define PROBE_SCALE (1.0f + sqrtf(8.7e-4f * fminf(fmaxf(*(volatile float*)PROBE_PTR, 0.f), 1.f)))
#else
#define PROBE_PTR ((float*)nullptr)
#define PROBE_SCALE 1.0f
#endif
    for (int ph = lo; ph < hi; ++ph) {
        int tid = threadIdx.x, bid = blockIdx.x, G = gridDim.x;
        const __attribute__((address_space(4))) Args* ap = (const __attribute__((address_space(4))) Args*)__builtin_amdgcn_kernarg_segment_ptr();
        asm volatile("" : "+v"(tid)); asm volatile("" : "+s"(bid), "+s"(G), "+s"(ap));
        unsigned char* wsb = ap->ws;
        const int lane = tid & 63, wave = __builtin_amdgcn_readfirstlane(tid >> 6);
        const int gw = bid * NWAVES + wave, NGW = G * NWAVES, gtid = bid * 512 + tid, NGT = G * 512;
        const int l = (ph == 0) ? 0 : (ph - 1) / PPL; const int k = (ph == 0) ? -1 : (ph - 1) % PPL;
        switch (k) {
        case -1: {
            cvt_mixer_weights(lds, wsb, ap->in[2], ap->in[12], gw, NGW, wave, lane);
            phase_norm(ap->in[0], ap->in[1], WSP(bf16, WS_XN), gw, NGW, lane);
        } break;
        case 0: {
            pg8::Gemm g{WSP(bf16, WS_XN), WSP(bf16, WS_WA), M, NWA, DM, 0, 0, 0}; pg8::StaticOrder S; S.init(M, NWA, G, bid);
            pg8::EpiRawA E{WSP(bf16, WS_RAW), WSP(float, WS_SCAL)};
            pg8::gemm_phase<pg8::EpiRawA, pg8::StaticOrder, true, true>(lds, g, S, E);
#if defined(EXP_DUP_GEMM)
            if (l == 0) { __syncthreads(); pg8::gemm_phase<pg8::EpiRawA, pg8::StaticOrder, true, true>(lds, g, S, E); }
#endif
        } break;
        case 1: {
            prep_gdn_stash(lds, bid, WSP(bf16, WS_RAW), tid); prep_ssd_stash(lds, bid, WSP(bf16, WS_RAW), tid);
            zero_region(wsb + WS_OG, 64 * MiB, gtid, NGT); zero_region(wsb + WS_YS, 64 * MiB, gtid, NGT);
            GRID_BAR();
            prep_gdn_range(lds, bid, WSP(bf16, WS_RAW), WSP(float, WS_SCAL), ap->in[3] + (size_t)l * 7 * CONV_CH, ap->in[4] + (size_t)l * CONV_CH,
                           ap->in[5] + l * 16, ap->in[6] + l * 16, WSP(bf16, WS_TQ), tid, wave, lane);
            __syncthreads();
            { int tid2 = threadIdx.x; asm volatile("" : "+v"(tid2));
              prep_ssd_range(lds, bid, WSP(bf16, WS_RAW), ap->in[3] + (size_t)l * 7 * CONV_CH, ap->in[4] + (size_t)l * CONV_CH, tid2); }
        } break;
        case 2: {
            for (int c = bid; c < 128; c += G) {
                int tid = threadIdx.x; asm volatile("" : "+v"(tid));
                const int lane = tid & 63, wave = __builtin_amdgcn_readfirstlane(tid >> 6);
                if (c < 64) { const int b_ = c >> 4, h_ = (c >> 1) & 7;
                    if (c & 1) gdn_state2<1>(lds, b_, h_, WSP(bf16, WS_RAW), WSP(float, WS_SCAL), WSP(bf16, WS_TQ), ap->in[5] + l * 16, ap->in[6] + l * 16, WSP(bf16, WS_OG), tid, wave, lane);
                    else       gdn_state2<0>(lds, b_, h_, WSP(bf16, WS_RAW), WSP(float, WS_SCAL), WSP(bf16, WS_TQ), ap->in[5] + l * 16, ap->in[6] + l * 16, WSP(bf16, WS_OG), tid, wave, lane, PROBE_PTR); }
                else { const int c2 = c - 64, hp_ = c2 & 3, g_ = (c2 >> 3) & 1, b_ = c2 >> 4;
                    if ((c2 >> 2) & 1) ssd_state2<1>(lds, b_, g_, hp_, WSP(bf16, WS_RAW), WSP(float, WS_SCAL), ap->in[8] + l * 32, ap->in[9] + l * 32, WSP(bf16, WS_YS), tid, wave, lane);
                    else               ssd_state2<0>(lds, b_, g_, hp_, WSP(bf16, WS_RAW), WSP(float, WS_SCAL), ap->in[8] + l * 32, ap->in[9] + l * 32, WSP(bf16, WS_YS), tid, wave, lane); }
                __syncthreads();
            }
#if defined(EXP_DUP_STATE)
            if (l == 0) {
            for (int c = bid; c < 128; c += G) {
                int tid = threadIdx.x; asm volatile("" : "+v"(tid));
                const int lane = tid & 63, wave = __builtin_amdgcn_readfirstlane(tid >> 6);
                if (c < 64) { const int b_ = c >> 4, h_ = (c >> 1) & 7;
                    if (c & 1) gdn_state2<1>(lds, b_, h_, WSP(bf16, WS_RAW), WSP(float, WS_SCAL), WSP(bf16, WS_TQ), ap->in[5] + l * 16, ap->in[6] + l * 16, (bf16*)ap->out, tid, wave, lane);
                    else       gdn_state2<0>(lds, b_, h_, WSP(bf16, WS_RAW), WSP(float, WS_SCAL), WSP(bf16, WS_TQ), ap->in[5] + l * 16, ap->in[6] + l * 16, (bf16*)ap->out, tid, wave, lane); }
                else { const int c2 = c - 64, hp_ = c2 & 3, g_ = (c2 >> 3) & 1, b_ = c2 >> 4;
                    if ((c2 >> 2) & 1) ssd_state2<1>(lds, b_, g_, hp_, WSP(bf16, WS_RAW), WSP(float, WS_SCAL), ap->in[8] + l * 32, ap->in[9] + l * 32, ((bf16*)ap->out + (size_t)M * 1024), tid, wave, lane);
                    else               ssd_state2<0>(lds, b_, g_, hp_, WSP(bf16, WS_RAW), WSP(float, WS_SCAL), ap->in[8] + l * 32, ap->in[9] + l * 32, ((bf16*)ap->out + (size_t)M * 1024), tid, wave, lane); }
                __syncthreads();
            }
            }
#endif
        } break;
        case 3: {
            ssd_intra_range(lds, bid, WSP(bf16, WS_RAW), WSP(float, WS_SCAL), ap->in[8] + l * 32, ap->in[9] + l * 32, ap->in[10] + l * 16, WSP(bf16, WS_TQ), tid);
        } break;
        case 4: {
            phase_norm((l == 0) ? ap->in[0] : ap->out, ap->in[1] + (size_t)l * DM, WSP(bf16, WS_XN2), gw, NGW, lane);
#if defined(EXP_DUP_B)
            if (l == 0) { __syncthreads();
            phase_norm((l == 0) ? ap->in[0] : ap->out, ap->in[1] + (size_t)l * DM, WSP(bf16, WS_XN2), gw, NGW, lane);
 }
#endif
        } break;
        case 5: {
            pg8::Gemm g{WSP(bf16, WS_XN2), WSP(bf16, WS_WB), M, NGATE, DM, 0, 0, 0}; pg8::StaticOrder S; S.init(M, NGATE, G, bid);
            pg8::EpiBf16 E{WSP(bf16, WS_GATES), NGATE};
            pg8::gemm_phase<pg8::EpiBf16, pg8::StaticOrder, true, true>(lds, g, S, E);
#if defined(EXP_DUP_GEMM)
            if (l == 0) { __syncthreads(); pg8::gemm_phase<pg8::EpiBf16, pg8::StaticOrder, true, true>(lds, g, S, E); }
#endif
        } break;
        case 6: {
            phase_finish(WSP(bf16, WS_OG), WSP(bf16, WS_YS), WSP(bf16, WS_TQ), WSP(bf16, WS_GATES), ap->in[7] + l * 128, ap->in[11] + l * 1024, WSP(bf16, WS_MIXED), gw, NGW, lane);
#if defined(EXP_DUP_B)
            if (l == 0) { __syncthreads();
            phase_finish(WSP(bf16, WS_OG), WSP(bf16, WS_YS), WSP(bf16, WS_TQ), WSP(bf16, WS_GATES), ap->in[7] + l * 128, ap->in[11] + l * 1024, WSP(bf16, WS_MIXED), gw, NGW, lane);
 }
#endif
        } break;
        case 7: {
            pg8::Gemm g{WSP(bf16, WS_MIXED), WSP(bf16, WS_WO), M, DM, 2048, 0, 0, 0}; pg8::StaticOrder S; S.init(M, DM, G, bid);
            pg8::EpiResid E{(l == 0) ? ap->in[0] : ap->out, ap->out, DM};
            pg8::gemm_phase<pg8::EpiResid, pg8::StaticOrder, true, true>(lds, g, S, E);
#if defined(EXP_DUP_GEMM)
            if (l == 0) { __syncthreads(); pg8::gemm_phase<pg8::EpiResid, pg8::StaticOrder, true, true>(lds, g, S, E); }
#endif
        } break;
        case 8: {
            phase_norm2_router(lds, ap->out, ap->in[13] + l * DM, ap->in[14] + (size_t)l * DM * 16, WSP(bf16, WS_XN), WSP(float, WS_AFF), gw, NGW, tid, lane);
            __syncthreads();
            cvt_expert_weights(lds, wsb, ap->in[15] + (size_t)l * NEXP * DM * EFF, ap->in[16] + (size_t)l * NEXP * DM * EFF, ap->in[17] + (size_t)l * NEXP * EFF * DM, gw, NGW, wave, lane);
            if (l + 1 < DEPTH) cvt_mixer_weights(lds, wsb, ap->in[2] + (size_t)(l + 1) * DM * 6720, ap->in[12] + (size_t)(l + 1) * 2048 * DM, gw, NGW, wave, lane);
#if defined(EXP_DUP_A)
            if (l == 0) { __syncthreads();
            phase_norm2_router(lds, ap->out, ap->in[13] + l * DM, ap->in[14] + (size_t)l * DM * 16, WSP(bf16, WS_XN), WSP(float, WS_AFF), gw, NGW, tid, lane);
            __syncthreads();
            cvt_expert_weights(lds, wsb, ap->in[15] + (size_t)l * NEXP * DM * EFF, ap->in[16] + (size_t)l * NEXP * DM * EFF, ap->in[17] + (size_t)l * NEXP * EFF * DM, gw, NGW, wave, lane);
            if (l + 1 < DEPTH) cvt_mixer_weights(lds, wsb, ap->in[2] + (size_t)(l + 1) * DM * 6720, ap->in[12] + (size_t)(l + 1) * 2048 * DM, gw, NGW, wave, lane);
 }
#endif
        } break;
        case 9: {
            for (int be = bid; be < NB * NEXP; be += G) phase_topk(lds, WSP(float, WS_AFF), WSP(int, WS_IDX), WSP(float, WS_VAL), WSP(int, WS_INV), be, tid, wave, lane);
#if defined(EXP_DUP_A)
            if (l == 0) { __syncthreads();
            for (int be = bid; be < NB * NEXP; be += G) phase_topk(lds, WSP(float, WS_AFF), WSP(int, WS_IDX), WSP(float, WS_VAL), WSP(int, WS_INV), be, tid, wave, lane);
 }
#endif
        } break;
        case 10: {
            phase_gather(WSP(bf16, WS_XN), WSP(int, WS_IDX), WSP(bf16, WS_XG), gw, NGW, lane);
#if defined(EXP_DUP_A)
            if (l == 0) { __syncthreads();
            phase_gather(WSP(bf16, WS_XN), WSP(int, WS_IDX), WSP(bf16, WS_XG), gw, NGW, lane);
 }
#endif
        } break;
        case 11: {
            pg8::Gemm g{WSP(bf16, WS_XG), WSP(bf16, WS_WGU), MEXP, 1024, DM, 2, 15, (size_t)1024 * 1024 * 2}; pg8::StaticOrder S; S.init(MEXP, 1024, G, bid);
            pg8::EpiSwiglu E{WSP(bf16, WS_HMID), EFF};
            pg8::gemm_phase<pg8::EpiSwiglu, pg8::StaticOrder, true, true>(lds, g, S, E);
#if defined(EXP_DUP_GEMM)
            if (l == 0) { __syncthreads(); pg8::gemm_phase<pg8::EpiSwiglu, pg8::StaticOrder, true, true>(lds, g, S, E); }
#endif
        } break;
        case 12: {
            pg8::Gemm g{WSP(bf16, WS_HMID), WSP(bf16, WS_WD), MEXP, 1024, EFF, 2, 15, (size_t)1024 * 512 * 2}; pg8::StaticOrder S; S.init(MEXP, 1024, G, bid);
            pg8::EpiBf16 E{WSP(bf16, WS_XG), 1024};
            pg8::gemm_phase<pg8::EpiBf16, pg8::StaticOrder, true, true>(lds, g, S, E);
#if defined(EXP_DUP_GEMM)
            if (l == 0) { __syncthreads(); pg8::gemm_phase<pg8::EpiBf16, pg8::StaticOrder, true, true>(lds, g, S, E); }
#endif
        } break;
        default: {
            const bool last = (l + 1 == DEPTH);
            phase_combine(ap->out, ap->out, WSP(bf16, WS_XG), WSP(int, WS_INV), WSP(float, WS_VAL), last ? ap->in[18] : ap->in[1] + (size_t)(l + 1) * DM, WSP(bf16, WS_XN), last, gw, NGW, lane, PROBE_SCALE);
        } break;
        }
        if (ph + 1 < hi) GRID_BAR();
    }
#undef WSP
}

extern "C" void kernel_launch(void* const* d_in, const int* in_sizes, int n_in, void* d_out, int out_size, void* d_ws, size_t ws_size, hipStream_t stream) {
    static int grid = 0;
    if (grid == 0) {
        if (n_in != 19 || in_sizes[0] != M * DM || out_size != M * DM || ws_size < WS_END) { fprintf(stderr, "kernel_launch: unexpected shapes (n_in %d, in0 %d, out %d, ws %zu); nothing launched\n", n_in, n_in > 0 ? in_sizes[0] : -1, out_size, ws_size); grid = -1; return; }
        int dev = 0, cus = 0;
        if (hipGetDevice(&dev) != hipSuccess || hipDeviceGetAttribute(&cus, hipDeviceAttributeMultiprocessorCount, dev) != hipSuccess) { grid = -1; return; }
        if (hipFuncSetAttribute((const void*)fwd_kernel, hipFuncAttributeMaxDynamicSharedMemorySize, LDS_BYTES) != hipSuccess) { fprintf(stderr, "kernel_launch: hipFuncSetAttribute failed\n"); grid = -1; return; }
        (void)hipGetLastError();
        grid = cus;
    }
    if (grid < 0) return;
    (void)hipMemsetAsync((char*)d_ws + WS_CTL, 0, CTL_ZERO_BYTES, stream);
    Args a{};
    for (int i = 0; i < 19; ++i) a.in[i] = (const float*)d_in[i];
    a.out = (float*)d_out; a.ws = (unsigned char*)d_ws;
#if MK_ONE_LAUNCH
    a.ph_lo = 0; a.ph_hi = NPHASE;
    hipLaunchKernelGGL(fwd_kernel, dim3(grid), dim3(NWAVES * 64), LDS_BYTES, stream, a);
#else
    for (int p = 0; p < NPHASE; ++p) { a.ph_lo = p; a.ph_hi = p + 1; hipLaunchKernelGGL(fwd_kernel, dim3(grid), dim3(NWAVES * 64), LDS_BYTES, stream, a); }
#endif
}
```

```cpp
#include <hip/hip_runtime.h>
#include <cstdio>
#include <cstdint>
namespace pg8 {
#define PG8_LAS __attribute__((address_space(3)))
typedef unsigned short bf16_t;
typedef short bf16x8 __attribute__((ext_vector_type(8)));
typedef float f32x4 __attribute__((ext_vector_type(4)));
typedef unsigned u32x4 __attribute__((ext_vector_type(4)));
constexpr int BM = 256, BK = 64, HALF = 128, HTB = HALF * BK * 2  , STAGE_BYTES = 8 * HTB, NXCD = 8, WGM = 8;

__host__ __device__ __forceinline__ int lds_byte(int r, int c) { const int st = (r >> 4) * 2 + (c >> 5), rr = r & 15, cc = c & 31, ob = rr * 64 + cc * 2; return st * 1024 + (ob ^ (((ob >> 9) & 1) << 5)); }
__host__ __device__ __forceinline__ void stage_rc(int b, int& R, int& C) { const int st = b / 1024, sb = b % 1024, swz = sb ^ (((sb >> 9) & 1) << 5); R = (st >> 1) * 16 + swz / 64; C = (st & 1) * 32 + (swz % 64) / 2; }
__host__ __device__ __forceinline__ int perm32(int rho) { const int n = rho >> 4, i = rho & 15; return 8 * (i >> 2) + 4 * n + (i & 3); }

struct Unit { int pm, pn; };
struct Gemm { const bf16_t* A; const bf16_t* Bt; int M, N, K; int bshift, bmask; size_t bstride;
    __device__ __forceinline__ size_t grp_off(int pm) const { return (size_t)((pm >> bshift) & bmask) * bstride; } };

struct StaticOrder {
    int nM, nN, nwg, G, c;
    __host__ __device__ void init(int M, int N, int G_, int c_) { nM = M / BM; nN = N / BM; nwg = nM * nN; G = G_; c = c_; }
    __host__ __device__ bool next(int i, Unit& u) const {
        const long L = (long)i * G + c; if (L >= nwg) return false;
        int wgid = (int)L; { const int q = nwg / NXCD, r = nwg % NXCD, xcd = wgid % NXCD, off = wgid / NXCD; wgid = (xcd < r ? xcd * (q + 1) : r * (q + 1) + (xcd - r) * q) + off; }
        const int nig = WGM * nN, gid = wgid / nig, fm = gid * WGM, gsz = (nM - fm) < WGM ? (nM - fm) : WGM;
        u.pm = fm + ((wgid % nig) % gsz); u.pn = (wgid % nig) / gsz; return true;
    }
    __device__ __forceinline__ void a_ready(const Unit&) const {}
    __device__ __forceinline__ void done(const Unit&) const {}
};

__device__ __forceinline__ unsigned cvt_pk_bf16(float lo, float hi) { unsigned r; asm volatile("v_cvt_pk_bf16_f32 %0, %1, %2" : "=v"(r) : "v"(lo), "v"(hi)); return r; }
__device__ __forceinline__ float silu_f(float x) { return x * __builtin_amdgcn_rcpf(1.0f + __builtin_amdgcn_exp2f(-1.4426950408889634f * x)); }
struct EpiBf16 {
    static constexpr bool PERM = true, AFTER_DRAIN = false;
    bf16_t* O; int ldc;
    __device__ __forceinline__ void operator()(const f32x4 (&acc)[2][2][4][2], const Unit& u, int wr, int wc, int fr, int fq) const {
        const int row0 = u.pm * BM + wr * 64 + fr; const int col0 = u.pn * BM + wc * 32 + 8 * fq;
#pragma unroll
        for (int ai = 0; ai < 2; ++ai)
#pragma unroll
            for (int m = 0; m < 4; ++m) { bf16_t* rowp = O + (size_t)(row0 + ai * HALF + m * 16) * ldc + col0;
#pragma unroll
                for (int bj = 0; bj < 2; ++bj) { const f32x4 v0 = acc[ai][bj][m][0], v1 = acc[ai][bj][m][1];
                    u32x4 w; w.x = cvt_pk_bf16(v0[0], v0[1]); w.y = cvt_pk_bf16(v0[2], v0[3]); w.z = cvt_pk_bf16(v1[0], v1[1]); w.w = cvt_pk_bf16(v1[2], v1[3]);
                    *(u32x4*)(rowp + bj * HALF) = w; } }
    }
};
struct EpiRawA {
    static constexpr bool PERM = true, AFTER_DRAIN = false;
    bf16_t* O; float* S;
    __device__ __forceinline__ void operator()(const f32x4 (&acc)[2][2][4][2], const Unit& u, int wr, int wc, int fr, int fq) const {
        const int row0 = u.pm * BM + wr * 64 + fr;
        if (u.pn < 18) {
            const int col0 = u.pn * BM + wc * 32 + 8 * fq;
#pragma unroll
            for (int ai = 0; ai < 2; ++ai)
#pragma unroll
                for (int m = 0; m < 4; ++m) { bf16_t* rowp = O + (size_t)(row0 + ai * HALF + m * 16) * 4608 + col0;
#pragma unroll
                    for (int bj = 0; bj < 2; ++bj) { const f32x4 v0 = acc[ai][bj][m][0], v1 = acc[ai][bj][m][1];
                        u32x4 w; w.x = cvt_pk_bf16(v0[0], v0[1]); w.y = cvt_pk_bf16(v0[2], v0[3]); w.z = cvt_pk_bf16(v1[0], v1[1]); w.w = cvt_pk_bf16(v1[2], v1[3]);
                        *(u32x4*)(rowp + bj * HALF) = w; } }
        } else if (wc < 2) {
            const int col0 = wc * 32 + 8 * fq;
#pragma unroll
            for (int ai = 0; ai < 2; ++ai)
#pragma unroll
                for (int m = 0; m < 4; ++m) { float* sp = S + (size_t)(row0 + ai * HALF + m * 16) * 64 + col0;
                    *(f32x4*)sp = acc[ai][0][m][0]; *(f32x4*)(sp + 4) = acc[ai][0][m][1]; }
        }
    }
};
struct EpiResid {
    static constexpr bool PERM = false, AFTER_DRAIN = false;
    const float* base; float* out; int ldc;
    __device__ __forceinline__ void operator()(const f32x4 (&acc)[2][2][4][2], const Unit& u, int wr, int wc, int fr, int fq) const {
        const int row0 = u.pm * BM + wr * 64 + fr, col0 = u.pn * BM + wc * 32 + 4 * fq;
#pragma unroll
        for (int ai = 0; ai < 2; ++ai)
#pragma unroll
            for (int m = 0; m < 4; ++m) { const size_t off = (size_t)(row0 + ai * HALF + m * 16) * ldc + col0;
#pragma unroll
                for (int bj = 0; bj < 2; ++bj)
#pragma unroll
                    for (int n = 0; n < 2; ++n) { const size_t ix = off + bj * HALF + n * 16; *(f32x4*)(out + ix) = *(const f32x4*)(base + ix) + acc[ai][bj][m][n]; } }
    }
};
struct EpiSwiglu {
    static constexpr bool PERM = true, AFTER_DRAIN = false;
    bf16_t* O; int ldh;
    __device__ __forceinline__ void operator()(const f32x4 (&acc)[2][2][4][2], const Unit& u, int wr, int wc, int fr, int fq) const {
        const int row0 = u.pm * BM + wr * 64 + fr; const int f0 = (u.pn * BM + wc * 32 + 8 * fq) >> 1;
        typedef unsigned u32x2 __attribute__((ext_vector_type(2)));
#pragma unroll
        for (int ai = 0; ai < 2; ++ai)
#pragma unroll
            for (int m = 0; m < 4; ++m) { bf16_t* rowp = O + (size_t)(row0 + ai * HALF + m * 16) * ldh + f0;
#pragma unroll
                for (int bj = 0; bj < 2; ++bj) { const f32x4 v0 = acc[ai][bj][m][0], v1 = acc[ai][bj][m][1];
                    u32x2 w; w.x = cvt_pk_bf16(silu_f(v0[0]) * v0[1], silu_f(v0[2]) * v0[3]); w.y = cvt_pk_bf16(silu_f(v1[0]) * v1[1], silu_f(v1[2]) * v1[3]);
                    *(u32x2*)(rowp + bj * (HALF / 2)) = w; } }
    }
};
template <class Epi, class Sched, bool ALIGN_EPI = false, bool SP2 = false>
__device__ __forceinline__ void gemm_phase(PG8_LAS unsigned char* lds, const Gemm g, const Sched& S, const Epi& E) {
    int tid_o = threadIdx.x; asm volatile("" : "+v"(tid_o));
    const int tid = tid_o, wid = __builtin_amdgcn_readfirstlane(tid >> 6), lane = tid & 63, wr = wid >> 2, wc = wid & 3, fr = lane & 15, fq = lane >> 4;
    const int K = g.K, nt = K / BK;
    unsigned voffA[2], voffB[2];
#pragma unroll
    for (int i = 0; i < 2; ++i) { int R, C; stage_rc(tid * 16 + i * 8192, R, C); const int Rb = Epi::PERM ? ((R & ~31) + perm32(R & 31)) : R;
        voffA[i] = (unsigned)(R * K + C) * 2u; voffB[i] = (unsigned)(Rb * K + C) * 2u; }
    const size_t kstep = (size_t)(BK * 2);
    const size_t hstep = (size_t)HALF * K * 2;
    const size_t tstep = 2 * hstep;
    const unsigned ldsw = (unsigned)wid * 1024u;
    const int aoff = lds_byte(wr * 64 + fr, fq * 8), boff = lds_byte(wc * 32 + fr, fq * 8);
#define PG8_SA(b, h) (((b) * 2 + (h)) * HTB)
#define PG8_SB(b, h) ((4 + (b) * 2 + (h)) * HTB)
#define PG8_STAGE(bufoff, gbase, voff) do { _Pragma("unroll") for (int _i = 0; _i < 2; ++_i) \
        __builtin_amdgcn_global_load_lds((const unsigned*)((const char*)(gbase) + (voff)[_i]), (PG8_LAS unsigned*)(lds + (bufoff) + ldsw + _i * 8192), 16, 0, 0); } while (0)
#define PG8_LDA(dst, b, h) do { _Pragma("unroll") for (int m = 0; m < 4; ++m) _Pragma("unroll") for (int k = 0; k < 2; ++k) dst[m][k] = *(const PG8_LAS bf16x8*)(lds + PG8_SA(b, h) + aoff + m * 2048 + k * 1024); } while (0)
#define PG8_LDB(dst, b, h) do { _Pragma("unroll") for (int n = 0; n < 2; ++n) _Pragma("unroll") for (int k = 0; k < 2; ++k) dst[n][k] = *(const PG8_LAS bf16x8*)(lds + PG8_SB(b, h) + boff + n * 2048 + k * 1024); } while (0)
#define PG8_MMA(ai, bj, At, Bt) do { __builtin_amdgcn_s_setprio(1); _Pragma("unroll") for (int m = 0; m < 4; ++m) _Pragma("unroll") for (int n = 0; n < 2; ++n) _Pragma("unroll") for (int k = 0; k < 2; ++k) \
        acc[ai][bj][m][n] = __builtin_amdgcn_mfma_f32_16x16x32_bf16(Bt[n][k], At[m][k], acc[ai][bj][m][n], 0, 0, 0); __builtin_amdgcn_s_setprio(0); } while (0)
#define PG8_WAIT_V(n) asm volatile("s_waitcnt vmcnt(" #n ")" ::: "memory")
#define PG8_WAIT_L(n) asm volatile("s_waitcnt lgkmcnt(" #n ")" ::: "memory")
#define PG8_BAR __builtin_amdgcn_s_barrier()
#define PG8_SCHED __builtin_amdgcn_sched_barrier(0)
    Unit cur, nxt; int ui = 0;
    if (!S.next(0, cur)) return;
    f32x4 acc[2][2][4][2];
#pragma unroll
    for (int a = 0; a < 2; ++a)
#pragma unroll
        for (int b = 0; b < 2; ++b)
#pragma unroll
            for (int m = 0; m < 4; ++m)
#pragma unroll
                for (int n = 0; n < 2; ++n) acc[a][b][m][n] = (f32x4){0.f, 0.f, 0.f, 0.f};
    bf16x8 At[4][2], B0[2][2], B1[2][2];
    const char* cA = (const char*)g.A + (size_t)cur.pm * tstep; const char* cB = (const char*)g.Bt + g.grp_off(cur.pm) + (size_t)cur.pn * tstep;
    S.a_ready(cur);
    if constexpr (SP2) {
        PG8_STAGE(PG8_SB(0, 0), cB, voffB); PG8_STAGE(PG8_SB(0, 1), cB + hstep, voffB); PG8_STAGE(PG8_SA(0, 0), cA, voffA); PG8_STAGE(PG8_SA(0, 1), cA + hstep, voffA);
        if (wr == 1) PG8_BAR;
        PG8_WAIT_V(2); PG8_BAR;
        PG8_STAGE(PG8_SB(1, 0), cB + kstep, voffB); PG8_STAGE(PG8_SA(1, 0), cA + kstep, voffA); PG8_STAGE(PG8_SB(1, 1), cB + hstep + kstep, voffB);
        PG8_WAIT_V(6); PG8_BAR;
    } else {
        PG8_STAGE(PG8_SB(0, 0), cB, voffB); PG8_STAGE(PG8_SA(0, 0), cA, voffA); PG8_STAGE(PG8_SB(0, 1), cB + hstep, voffB); PG8_STAGE(PG8_SA(0, 1), cA + hstep, voffA);
        if (wr == 1) PG8_BAR;
        PG8_WAIT_V(4); PG8_BAR;
        PG8_STAGE(PG8_SB(1, 0), cB + kstep, voffB); PG8_STAGE(PG8_SA(1, 0), cA + kstep, voffA); PG8_STAGE(PG8_SB(1, 1), cB + hstep + kstep, voffB);
        PG8_WAIT_V(6); PG8_BAR;
    }
    for (;;) {
        const bool has_next = S.next(ui + 1, nxt);
        const char* nA = has_next ? (const char*)g.A + (size_t)nxt.pm * tstep : cA; const char* nB = has_next ? (const char*)g.Bt + g.grp_off(nxt.pm) + (size_t)nxt.pn * tstep : cB;
        for (int t = 0; t < nt; t += 2) {
            const bool last = (t == nt - 2);
            const char* a1 = cA + (size_t)(t + 1) * kstep;
            const char* a2 = last ? nA : cA + (size_t)(t + 2) * kstep; const char* b2 = last ? nB : cB + (size_t)(t + 2) * kstep;
            const char* a3 = a2 + kstep; const char* b3 = b2 + kstep;
            if (last && has_next) S.a_ready(nxt);
            if constexpr (SP2) {
            PG8_LDB(B0, 0, 0); PG8_LDB(B1, 0, 1); PG8_SCHED; PG8_LDA(At, 0, 0); PG8_STAGE(PG8_SA(1, 1), a1 + hstep, voffA);
            PG8_WAIT_V(8); PG8_WAIT_L(0); PG8_BAR; PG8_MMA(0, 0, At, B0); PG8_MMA(0, 1, At, B1); PG8_BAR; PG8_SCHED;
            PG8_LDA(At, 0, 1); PG8_STAGE(PG8_SB(0, 0), b2, voffB); PG8_STAGE(PG8_SB(0, 1), b2 + hstep, voffB); PG8_STAGE(PG8_SA(0, 0), a2, voffA);
            PG8_WAIT_V(8); PG8_WAIT_L(0); PG8_BAR; PG8_MMA(1, 0, At, B0); PG8_MMA(1, 1, At, B1); PG8_BAR; PG8_SCHED;
            PG8_LDB(B0, 1, 0); PG8_LDB(B1, 1, 1); PG8_SCHED; PG8_LDA(At, 1, 0); PG8_STAGE(PG8_SA(0, 1), a2 + hstep, voffA);
            PG8_WAIT_V(8); PG8_WAIT_L(0); PG8_BAR; PG8_MMA(0, 0, At, B0); PG8_MMA(0, 1, At, B1); PG8_BAR; PG8_SCHED;
            PG8_LDA(At, 1, 1); PG8_STAGE(PG8_SB(1, 0), b3, voffB); PG8_STAGE(PG8_SB(1, 1), b3 + hstep, voffB); PG8_STAGE(PG8_SA(1, 0), a3, voffA);
            PG8_WAIT_V(8); PG8_WAIT_L(0); PG8_BAR; PG8_MMA(1, 0, At, B0); PG8_MMA(1, 1, At, B1); PG8_BAR; PG8_SCHED;
            } else {
            PG8_LDB(B0, 0, 0); PG8_SCHED; PG8_LDA(At, 0, 0); PG8_STAGE(PG8_SA(1, 1), a1 + hstep, voffA);
            PG8_WAIT_L(8); PG8_BAR; PG8_WAIT_L(0); PG8_MMA(0, 0, At, B0); PG8_BAR; PG8_SCHED;
            PG8_LDB(B1, 0, 1); PG8_STAGE(PG8_SB(0, 0), b2, voffB);
            PG8_BAR; PG8_WAIT_L(0); PG8_MMA(0, 1, At, B1); PG8_BAR;
            PG8_LDA(At, 0, 1); PG8_STAGE(PG8_SA(0, 0), a2, voffA);
            PG8_BAR; PG8_WAIT_L(0); PG8_MMA(1, 0, At, B0); PG8_BAR; PG8_SCHED;
            PG8_STAGE(PG8_SB(0, 1), b2 + hstep, voffB);
            PG8_WAIT_V(6); PG8_BAR; PG8_MMA(1, 1, At, B1); PG8_BAR;
            PG8_LDB(B0, 1, 0); PG8_SCHED; PG8_LDA(At, 1, 0); PG8_STAGE(PG8_SA(0, 1), a2 + hstep, voffA);
            PG8_WAIT_L(8); PG8_BAR; PG8_WAIT_L(0); PG8_MMA(0, 0, At, B0); PG8_BAR; PG8_SCHED;
            PG8_LDB(B1, 1, 1); PG8_STAGE(PG8_SB(1, 0), b3, voffB);
            PG8_BAR; PG8_WAIT_L(0); PG8_MMA(0, 1, At, B1); PG8_BAR;
            PG8_LDA(At, 1, 1); PG8_STAGE(PG8_SA(1, 0), a3, voffA);
            PG8_BAR; PG8_WAIT_L(0); PG8_MMA(1, 0, At, B0); PG8_BAR; PG8_SCHED;
            PG8_STAGE(PG8_SB(1, 1), b3 + hstep, voffB);
            PG8_WAIT_V(6); PG8_BAR; PG8_MMA(1, 1, At, B1); PG8_BAR;
            }
        }
        if constexpr (ALIGN_EPI) { if (wr == 0) PG8_BAR; }
        if constexpr (!Epi::AFTER_DRAIN) { E(acc, cur, wr, wc, fr, fq); S.done(cur); }
        if (!has_next) break;
#pragma unroll
        for (int a = 0; a < 2; ++a)
#pragma unroll
            for (int b = 0; b < 2; ++b)
#pragma unroll
                for (int m = 0; m < 4; ++m)
#pragma unroll
                    for (int n = 0; n < 2; ++n) acc[a][b][m][n] = (f32x4){0.f, 0.f, 0.f, 0.f};
        cur = nxt; cA = nA; cB = nB; ++ui;
        if constexpr (ALIGN_EPI) { if (wr == 1) PG8_BAR; }
    }
    PG8_WAIT_V(0);
    if constexpr (!ALIGN_EPI) { if (wr == 0) PG8_BAR; }
    PG8_BAR;
    if constexpr (Epi::AFTER_DRAIN) { E.fused(acc, cur, wr, wc, fr, fq, lds, wid, lane); S.done(cur); }
#undef PG8_SA
#undef PG8_SB
#undef PG8_STAGE
#undef PG8_LDA
#undef PG8_LDB
#undef PG8_MMA
#undef PG8_WAIT_V
#undef PG8_WAIT_L
#undef PG8_BAR
#undef PG8_SCHED
}
}
#define GAS __attribute__((address_space(1)))
#define LAS __attribute__((address_space(3)))
typedef unsigned short bf16;
typedef unsigned v4u __attribute__((ext_vector_type(4)));
typedef float f32x4 __attribute__((ext_vector_type(4)));
typedef short bf16x8 __attribute__((ext_vector_type(8)));
typedef GAS unsigned gu32;
typedef GAS unsigned long long gu64;
#define RLX_AGENT __ATOMIC_RELAXED, __HIP_MEMORY_SCOPE_AGENT
#define LDS_WAIT() asm volatile("s_waitcnt lgkmcnt(0)" ::: "memory")
#define VM_WAIT() asm volatile("s_waitcnt vmcnt(0)" ::: "memory")
__device__ __forceinline__ unsigned long long rt() { return __builtin_amdgcn_s_memrealtime(); }
__device__ __forceinline__ unsigned f2bf(float f) { unsigned u = __builtin_bit_cast(unsigned, f); return (u + 0x7fffu + ((u >> 16) & 1u)) >> 16; }
__device__ __forceinline__ unsigned pk2(float lo, float hi) { return f2bf(lo) | (f2bf(hi) << 16); }
#define XB_TMO      128
#define XB_XCNT(j)  (256  + 64 * (j))
#define XB_XSUB(j)  (1280 + 64 * (j))
#define XB_XGEN(j)  (2304 + 64 * (j))
#define XB_TOP      3328
#define XB_TOPGEN   3392
#define XCD_BAR_WORDS 3456
#define XB_SPIN_CAP (1u << 18)

__device__ __forceinline__ unsigned xb_ld(unsigned* p)              { return __hip_atomic_load(p, __ATOMIC_RELAXED, __HIP_MEMORY_SCOPE_AGENT); }
__device__ __forceinline__ unsigned xb_add(unsigned* p, unsigned v) { return __hip_atomic_fetch_add(p, v, __ATOMIC_RELAXED, __HIP_MEMORY_SCOPE_AGENT); }
__device__ __forceinline__ unsigned xb_xcc_id() { return (unsigned)__builtin_amdgcn_s_getreg((3 << 11) | 20) & 0xFu; }
#define XB_SPIN(cond, bar) do { unsigned _sp = 0; while (cond) { __builtin_amdgcn_s_sleep(1); \
    if ((++_sp & 255u) == 0u) { if (xb_ld(&(bar)[XB_TMO])) break; if (_sp > XB_SPIN_CAP) { atomicAdd(&(bar)[XB_TMO], 1u); break; } } } } while (0)

struct XcdBarrier {
    unsigned* bar; unsigned x;
    volatile LAS unsigned* st;
};

__device__ __forceinline__ XcdBarrier xcd_barrier_post(unsigned* bar, volatile LAS unsigned* st) {
    XcdBarrier b; b.bar = bar; b.x = xb_xcc_id(); b.st = st;
    if (threadIdx.x == 0) (void)xb_add(&bar[XB_XCNT(b.x)], 1u);
    return b;
}
__device__ __forceinline__ void xcd_barrier_complete(unsigned* bar, unsigned x, unsigned& nloc, unsigned& nx) {
    const unsigned G = gridDim.x * gridDim.y * gridDim.z;
    unsigned sum, cnt, mine, sp = 0u;
    for (;;) {
        sum = 0u; cnt = 0u; mine = 0u;
#pragma unroll
        for (unsigned j = 0; j < 16; ++j) { const unsigned c = xb_ld(&bar[XB_XCNT(j)]); sum += c; cnt += (c > 0u) ? 1u : 0u; mine = (j == x) ? c : mine; }
        if (sum == G) break;
        __builtin_amdgcn_s_sleep(1);
        if ((++sp & 255u) == 0u) { if (xb_ld(&bar[XB_TMO])) break; if (sp > XB_SPIN_CAP) { atomicAdd(&bar[XB_TMO], 1u); break; } }
    }
    nloc = mine > 0u ? mine : 1u; nx = cnt > 0u ? cnt : 1u;
}

__device__ __forceinline__ void xcd_barrier(const XcdBarrier& b) {
    asm volatile("s_waitcnt vmcnt(0)" ::: "memory");
    __syncthreads();
    if (threadIdx.x == 0) {
        unsigned* bar = b.bar;
        __builtin_amdgcn_s_waitcnt(0);
        unsigned nloc = b.st[0], nx = b.st[1];
        if (nloc == 0u) { xcd_barrier_complete(bar, b.x, nloc, nx); b.st[0] = nloc; b.st[1] = nx; }
        const unsigned old = xb_add(&bar[XB_XSUB(b.x)], 1u);
        const unsigned gen = old / nloc;
        if (old + 1u == (gen + 1u) * nloc) {
            __builtin_amdgcn_fence(__ATOMIC_RELEASE, "agent");
            asm volatile("s_waitcnt vmcnt(0)" ::: "memory");
            const unsigned og = xb_add(&bar[XB_TOP], 1u);
            const unsigned tg = og / nx;
            if (og + 1u == (tg + 1u) * nx) xb_add(&bar[XB_TOPGEN], 1u);
            else XB_SPIN(xb_ld(&bar[XB_TOPGEN]) == tg, bar);
            __builtin_amdgcn_fence(__ATOMIC_ACQUIRE, "agent");
            xb_add(&bar[XB_XGEN(b.x)], 1u);
            asm volatile("s_waitcnt vmcnt(0)" ::: "memory");
        } else {
            XB_SPIN(xb_ld(&bar[XB_XGEN(b.x)]) == gen, bar);
            __builtin_amdgcn_fence(__ATOMIC_ACQUIRE, "agent");
            asm volatile("s_waitcnt vmcnt(0)" ::: "memory");
        }
    }
    __syncthreads();
}
constexpr int NB = 4, SEQ = 8192, DM = 1024, M = NB * SEQ, DEPTH = 2;
constexpr int NCHUNK = SEQ / 64;
constexpr int CONV_CH = 4608, NWA = 4864  , NGATE = 2048, NEXP = 16, EFF = 512, CAP = 1024;
constexpr int MEXP = NB * NEXP * CAP;
constexpr float EPS = 1e-6f;
constexpr int NWAVES = 8;
constexpr size_t MiB = 1u << 20;
constexpr size_t WS_CTL = 0, CTL_ZERO_BYTES = 1 * MiB;
constexpr size_t WS_WA = 1 * MiB;
constexpr size_t WS_WB = 11 * MiB;
constexpr size_t WS_WO = 15 * MiB;
constexpr size_t WS_XN = 19 * MiB;
constexpr size_t WS_RAW = 83 * MiB;
constexpr size_t WS_SCAL = 371 * MiB;
constexpr size_t WS_OG = 19 * MiB;
constexpr size_t WS_YS = 443 * MiB;
constexpr size_t WS_XN2 = 83 * MiB;
constexpr size_t WS_GATES = 147 * MiB;
constexpr size_t WS_MIXED = 147 * MiB;
constexpr size_t WS_WGU = 83 * MiB;
constexpr size_t WS_WD = 115 * MiB;
constexpr size_t WS_XG = 131 * MiB;
constexpr size_t WS_HMID = 259 * MiB;
constexpr size_t WS_AFF = 323 * MiB;
constexpr size_t WS_IDX = 325 * MiB;
constexpr size_t WS_VAL = 326 * MiB;
constexpr size_t WS_INV = 327 * MiB;
constexpr size_t WS_END = 507 * MiB;
constexpr int CW_TMO = 0, CW_BAR = 4096;
constexpr int LDS_BYTES = 163840;
constexpr int MISC_OFF = LDS_BYTES - 256;

typedef short bf16x8 __attribute__((ext_vector_type(8)));
typedef short bf16x4 __attribute__((ext_vector_type(4)));
typedef float f32x4 __attribute__((ext_vector_type(4)));
typedef float f32x2 __attribute__((ext_vector_type(2)));
typedef unsigned u32x4 __attribute__((ext_vector_type(4)));
typedef unsigned u32x2 __attribute__((ext_vector_type(2)));
typedef __bf16 bf16x2_t __attribute__((ext_vector_type(2)));
typedef short s16x2 __attribute__((ext_vector_type(2)));

__device__ __forceinline__ float bf2f(unsigned short v) { return __uint_as_float((unsigned)v << 16); }
__device__ __forceinline__ float bf2f_s(short v) { return __uint_as_float((unsigned)(unsigned short)v << 16); }
__device__ __forceinline__ unsigned pkbf(float lo, float hi) { f32x2 v = {lo, hi}; bf16x2_t b = __builtin_convertvector(v, bf16x2_t); return __builtin_bit_cast(unsigned, b); }
__device__ __forceinline__ unsigned short f2bf1(float f) { return (unsigned short)(pkbf(f, 0.f) & 0xffffu); }
__device__ __forceinline__ float silu(float x) { return x * __builtin_amdgcn_rcpf(1.0f + __builtin_amdgcn_exp2f(-1.4426950408889634f * x)); }
__device__ __forceinline__ float softplus_f(float x) { return x > 20.f ? x : log1pf(expf(x)); }
__device__ __forceinline__ float sigmoid_f(float x) { return 1.0f / (1.0f + expf(-x)); }
__device__ __forceinline__ void atomic_add_bf16x2(bf16* p, float a, float b) {
    (void)__builtin_amdgcn_global_atomic_fadd_v2bf16((GAS s16x2*)p, __builtin_bit_cast(s16x2, pkbf(a, b)));
}
__device__ __forceinline__ float wave_sum(float v) {
#pragma unroll
    for (int o = 1; o < 64; o <<= 1) v += __shfl_xor(v, o);
    return v;
}

template <int MT, int NT>
__device__ __forceinline__ void mma_lds(f32x4 (&acc)[MT][NT], const LAS bf16* A, int lda, int m0, const LAS bf16* Bt, int ldb, int n0, int K, int fr, int fq) {
    for (int k0 = 0; k0 < K; k0 += 32) {
        bf16x8 a[MT], b[NT];
#pragma unroll
        for (int mt = 0; mt < MT; ++mt) a[mt] = *(const LAS bf16x8*)(A + (m0 + mt * 16 + fr) * lda + k0 + fq * 8);
#pragma unroll
        for (int nt = 0; nt < NT; ++nt) b[nt] = *(const LAS bf16x8*)(Bt + (n0 + nt * 16 + fr) * ldb + k0 + fq * 8);
#pragma unroll
        for (int mt = 0; mt < MT; ++mt)
#pragma unroll
            for (int nt = 0; nt < NT; ++nt) acc[mt][nt] = __builtin_amdgcn_mfma_f32_16x16x32_bf16(a[mt], b[nt], acc[mt][nt], 0, 0, 0);
    }
}

__device__ __forceinline__ void conv16(float (&acc)[16], const LAS bf16* src, int ld, const LAS float* cw, int cwld) {
#pragma unroll
    for (int c = 0; c < 16; ++c) acc[c] = cw[7 * cwld + c];
#pragma unroll
    for (int tap = 0; tap < 7; ++tap) {
        const bf16x8 x0 = *(const LAS bf16x8*)(src + tap * ld), x1 = *(const LAS bf16x8*)(src + tap * ld + 8);
        const LAS float* w = cw + tap * cwld;
#pragma unroll
        for (int c = 0; c < 8; ++c) { acc[c] += bf2f_s(x0[c]) * w[c]; acc[8 + c] += bf2f_s(x1[c]) * w[8 + c]; }
        if (tap & 1) asm volatile("" ::: "memory");
    }
}
__device__ __forceinline__ void conv8(float (&acc)[8], const LAS bf16* src, int ld, const LAS float* cw, int cwld) {
#pragma unroll
    for (int c = 0; c < 8; ++c) acc[c] = cw[7 * cwld + c];
#pragma unroll
    for (int tap = 0; tap < 7; ++tap) {
        const bf16x8 x0 = *(const LAS bf16x8*)(src + tap * ld);
        const LAS float* w = cw + tap * cwld;
#pragma unroll
        for (int c = 0; c < 8; ++c) acc[c] += bf2f_s(x0[c]) * w[c];
        if (tap & 1) asm volatile("" ::: "memory");
    }
}

#if defined(PROBE_SUB)
#define PB_START(id_, ws_) do { if ((id_) == PROBE_SUB && blockIdx.x == 0 && threadIdx.x == 0) ((unsigned long long*)(ws_))[1100] = __builtin_amdgcn_s_memrealtime(); } while (0)
#define PB_END(id_, ws_) do { if ((id_) == PROBE_SUB && blockIdx.x == 0 && threadIdx.x == 0) { const unsigned long long t1_ = __builtin_amdgcn_s_memrealtime(), t0_ = ((unsigned long long*)(ws_))[1100]; \
        const unsigned bk_ = (unsigned)((t1_ - t0_) / PROBE_TICKS); *((volatile float*)(ws_) + 2048) = (float)(bk_ > 40u ? 40u : bk_) * (1.0f / 40.0f); } } while (0)
#else
#define PB_START(id_, ws_) do {} while (0)
#define PB_END(id_, ws_) do {} while (0)
#endif
__device__ __forceinline__ void transpose_item(const float* W, int K, int N, int k0, int n0, bf16* WT, int drow0, int rmul, LAS float* scr, int lane) {
#pragma unroll 8
    for (int i = 0; i < 32; ++i) { const int kk = 2 * i + (lane >> 5); scr[kk * 33 + (lane & 31)] = W[(size_t)(k0 + kk) * N + n0 + (lane & 31)]; }
    LDS_WAIT(); asm volatile("" ::: "memory");
    const int c = lane & 7;
#pragma unroll
    for (int j = 0; j < 4; ++j) { const int n = (lane >> 3) + 8 * j; const LAS float* s = scr + (8 * c) * 33 + n;
        u32x4 o; o.x = pkbf(s[0 * 33], s[1 * 33]); o.y = pkbf(s[2 * 33], s[3 * 33]); o.z = pkbf(s[4 * 33], s[5 * 33]); o.w = pkbf(s[6 * 33], s[7 * 33]);
        *(GAS u32x4*)(WT + (size_t)(drow0 + rmul * n) * K + k0 + 8 * c) = o; }
    LDS_WAIT(); asm volatile("" ::: "memory");
}
__device__ __forceinline__ void cvt_mixer_weights(LAS unsigned char* lds, unsigned char* ws, const float* w_in, const float* w_out, int gw, int NGW, int wave, int lane) {
    LAS float* scr = (LAS float*)(lds + wave * 16384);
    bf16* WA = (bf16*)(ws + WS_WA); bf16* WB = (bf16*)(ws + WS_WB); bf16* WO = (bf16*)(ws + WS_WO);
    constexpr int I_IN = 16 * 210, I_OUT = 32 * 32;
    for (int it = gw; it < I_IN + I_OUT; it += NGW) {
        if (it < I_IN) { const int kb = it / 210, nb = it % 210, n0 = nb * 32;
            bf16* dst; int drow;
            if (n0 < 4608) { dst = WA; drow = n0; } else if (n0 < 6656) { dst = WB; drow = n0 - 4608; } else { dst = WA; drow = 4608 + (n0 - 6656); }
            transpose_item(w_in, 1024, 6720, kb * 64, n0, dst, drow, 1, scr, lane);
        } else { const int r = it - I_IN, kb = r / 32, nb = r % 32; transpose_item(w_out, 2048, 1024, kb * 64, nb * 32, WO, nb * 32, 1, scr, lane); }
    }
    { u32x4 z = (u32x4){0u, 0u, 0u, 0u}; asm volatile("" : "+v"(z));
      for (int r = gw; r < 192; r += NGW) { GAS u32x4* p = (GAS u32x4*)(WA + (size_t)(4672 + r) * 1024) + lane; p[0] = z; p[64] = z; } }
}
__device__ __forceinline__ void cvt_expert_weights(LAS unsigned char* lds, unsigned char* ws, const float* w_gate, const float* w_up, const float* w_down, int gw, int NGW, int wave, int lane) {
    LAS float* scr = (LAS float*)(lds + wave * 16384);
    bf16* WGU = (bf16*)(ws + WS_WGU); bf16* WD = (bf16*)(ws + WS_WD);
    constexpr int I_G = 16 * 16;
    constexpr int I_D = 8 * 32;
    constexpr int PER_E = 2 * I_G + I_D;
    for (int it = gw; it < NEXP * PER_E; it += NGW) {
        const int e = it / PER_E; int r = it % PER_E;
        if (r < 2 * I_G) { const int up = r >= I_G; if (up) r -= I_G; const int kb = r / 16, nb = r % 16;
            transpose_item((up ? w_up : w_gate) + (size_t)e * 1024 * 512, 1024, 512, kb * 64, nb * 32, WGU + (size_t)e * 1024 * 1024, 2 * (nb * 32) + up, 2, scr, lane);
        } else { r -= 2 * I_G; const int kb = r / 32, nb = r % 32;
            transpose_item(w_down + (size_t)e * 512 * 1024, 512, 1024, kb * 64, nb * 32, WD + (size_t)e * 1024 * 512, nb * 32, 1, scr, lane); }
    }
}

__device__ __forceinline__ void rms_row_regs(const float* xrow, const f32x4 (&w)[4], f32x4 (&v)[4], int lane) {
    const GAS f32x4* xr = (const GAS f32x4*)xrow + lane; float s = 0.f;
#pragma unroll
    for (int j = 0; j < 4; ++j) { v[j] = xr[64 * j]; s += (v[j].x * v[j].x + v[j].y * v[j].y) + (v[j].z * v[j].z + v[j].w * v[j].w); }
    const float rstd = 1.0f / sqrtf(wave_sum(s) * (1.0f / DM) + EPS);
#pragma unroll
    for (int j = 0; j < 4; ++j) v[j] = v[j] * rstd * w[j];
}
__device__ __forceinline__ void store_row_bf16(bf16* orow, const f32x4 (&v)[4], int lane) {
    GAS u32x2* o8 = (GAS u32x2*)orow + lane;
#pragma unroll
    for (int j = 0; j < 4; ++j) { u32x2 t; t.x = pkbf(v[j].x, v[j].y); t.y = pkbf(v[j].z, v[j].w); o8[64 * j] = t; }
}
__device__ __forceinline__ void load_w4(const float* w, f32x4 (&wv)[4], int lane) {
#pragma unroll
    for (int j = 0; j < 4; ++j) wv[j] = ((const GAS f32x4*)w)[lane + 64 * j];
}
__device__ __forceinline__ void phase_norm(const float* src, const float* w, bf16* XN, int gw, int NGW, int lane) {
    f32x4 wv[4]; load_w4(w, wv, lane);
    for (int m = gw; m < M; m += NGW) { f32x4 v[4]; rms_row_regs(src + (size_t)m * DM, wv, v, lane); store_row_bf16(XN + (size_t)m * DM, v, lane); }
}
__device__ __forceinline__ void zero_region(unsigned char* p, size_t bytes, int gtid, int NGT) {
    GAS u32x4* q = (GAS u32x4*)p; const size_t n = bytes / 16;
    u32x4 z = (u32x4){0u, 0u, 0u, 0u}; asm volatile("" : "+v"(z));
    for (size_t i = gtid; i < n; i += NGT) q[i] = z;
}

__device__ __forceinline__ void phase_norm2_router(LAS unsigned char* lds, const float* h, const float* w2, const float* w_router, bf16* XN, float* aff, int gw, int NGW, int tid, int lane) {
    LAS float* wrT = (LAS float*)lds;
    for (int e = tid; e < 16 * 1024; e += 512) { const int k = e >> 4, x = e & 15; wrT[x * 1024 + k] = w_router[e]; }
    __syncthreads();
    f32x4 wv[4]; load_w4(w2, wv, lane);
    for (int m = gw; m < M; m += NGW) {
        f32x4 v[4]; rms_row_regs(h + (size_t)m * DM, wv, v, lane); store_row_bf16(XN + (size_t)m * DM, v, lane);
        float mine = 0.f;
#pragma unroll 1
        for (int x = 0; x < 16; ++x) { float s = 0.f;
#pragma unroll
            for (int j = 0; j < 4; ++j) { const f32x4 wr = *(const LAS f32x4*)(wrT + x * 1024 + 4 * lane + 256 * j); s += (v[j].x * wr.x + v[j].y * wr.y) + (v[j].z * wr.z + v[j].w * wr.w); }
            s = wave_sum(s); mine = (lane == x) ? s : mine; }
        float mx = mine;
        mx = fmaxf(mx, __shfl_xor(mx, 1)); mx = fmaxf(mx, __shfl_xor(mx, 2)); mx = fmaxf(mx, __shfl_xor(mx, 4)); mx = fmaxf(mx, __shfl_xor(mx, 8));
        const float ex = expf(mine - mx); float den = ex;
        den += __shfl_xor(den, 1); den += __shfl_xor(den, 2); den += __shfl_xor(den, 4); den += __shfl_xor(den, 8);
        if (lane < 16) aff[(size_t)m * 16 + lane] = ex / den;
    }
}

__device__ __forceinline__ void phase_finish(const bf16* og, const bf16* ys, const bf16* yi, const bf16* gates, const float* gnw, const float* snw, bf16* mixed, int gw, int NGW, int lane) {
    float gw_[16], sw_[16];
#pragma unroll
    for (int c = 0; c < 16; ++c) { gw_[c] = gnw[(16 * lane + c) & 127]; sw_[c] = snw[16 * lane + c]; }
    for (int m = gw; m < M; m += NGW) {
        const bf16x8 o0 = *(const GAS bf16x8*)(og + (size_t)m * 1024 + 16 * lane), o1 = *(const GAS bf16x8*)(og + (size_t)m * 1024 + 16 * lane + 8);
        const bf16x8 y0 = *(const GAS bf16x8*)(ys + (size_t)m * 1024 + 16 * lane), y1 = *(const GAS bf16x8*)(ys + (size_t)m * 1024 + 16 * lane + 8);
        const bf16x8 i0 = *(const GAS bf16x8*)(yi + (size_t)m * 1024 + 16 * lane), i1 = *(const GAS bf16x8*)(yi + (size_t)m * 1024 + 16 * lane + 8);
        const bf16x8 g0 = *(const GAS bf16x8*)(gates + (size_t)m * 2048 + 16 * lane), g1 = *(const GAS bf16x8*)(gates + (size_t)m * 2048 + 16 * lane + 8);
        const bf16x8 z0 = *(const GAS bf16x8*)(gates + (size_t)m * 2048 + 1024 + 16 * lane), z1 = *(const GAS bf16x8*)(gates + (size_t)m * 2048 + 1024 + 16 * lane + 8);
        float o[16], t[16]; float so = 0.f, st = 0.f;
#pragma unroll
        for (int c = 0; c < 8; ++c) { o[c] = bf2f_s(o0[c]); o[8 + c] = bf2f_s(o1[c]); t[c] = (bf2f_s(y0[c]) + bf2f_s(i0[c])) * silu(bf2f_s(z0[c])); t[8 + c] = (bf2f_s(y1[c]) + bf2f_s(i1[c])) * silu(bf2f_s(z1[c])); }
#pragma unroll
        for (int c = 0; c < 16; ++c) { so += o[c] * o[c]; st += t[c] * t[c]; }
        so += __shfl_xor(so, 1); so += __shfl_xor(so, 2); so += __shfl_xor(so, 4);
        st += __shfl_xor(st, 1); st += __shfl_xor(st, 2); st += __shfl_xor(st, 4); st += __shfl_xor(st, 8); st += __shfl_xor(st, 16);
        const float ro = 1.0f / sqrtf(so * (1.0f / 128.f) + EPS), rt = 1.0f / sqrtf(st * (1.0f / 512.f) + EPS);
        float a[16], b2[16];
#pragma unroll
        for (int c = 0; c < 8; ++c) { a[c] = o[c] * ro * gw_[c] * silu(bf2f_s(g0[c])); a[8 + c] = o[8 + c] * ro * gw_[8 + c] * silu(bf2f_s(g1[c])); }
#pragma unroll
        for (int c = 0; c < 16; ++c) b2[c] = t[c] * rt * sw_[c];
        u32x4 w0, w1, w2, w3;
        w0.x = pkbf(a[0], a[1]); w0.y = pkbf(a[2], a[3]); w0.z = pkbf(a[4], a[5]); w0.w = pkbf(a[6], a[7]);
        w1.x = pkbf(a[8], a[9]); w1.y = pkbf(a[10], a[11]); w1.z = pkbf(a[12], a[13]); w1.w = pkbf(a[14], a[15]);
        w2.x = pkbf(b2[0], b2[1]); w2.y = pkbf(b2[2], b2[3]); w2.z = pkbf(b2[4], b2[5]); w2.w = pkbf(b2[6], b2[7]);
        w3.x = pkbf(b2[8], b2[9]); w3.y = pkbf(b2[10], b2[11]); w3.z = pkbf(b2[12], b2[13]); w3.w = pkbf(b2[14], b2[15]);
        GAS u32x4* mp = (GAS u32x4*)(mixed + (size_t)m * 2048 + 16 * lane);
        mp[0] = w0; mp[1] = w1; mp[128] = w2; mp[129] = w3;
    }
}

__device__ __forceinline__ void phase_topk(LAS unsigned char* lds, const float* aff, int* idx, float* val, int* inv, int be, int tid, int wave, int lane) {
    LAS unsigned* hist = (LAS unsigned*)lds;
    LAS unsigned* ctl = hist + 256;
    LAS unsigned* wsum = hist + 320;
    const int b = be >> 4, e = be & 15;
    unsigned key[16];
#pragma unroll
    for (int i = 0; i < 16; ++i) key[i] = __float_as_uint(aff[((size_t)b * SEQ + tid * 16 + i) * 16 + e]);
    unsigned prefix = 0u, mask = 0u; unsigned krem = CAP;
    for (int pass = 0; pass < 4; ++pass) {
        const int shift = 24 - 8 * pass;
        if (tid < 256) hist[tid] = 0u;
        __syncthreads();
#pragma unroll
        for (int i = 0; i < 16; ++i) if ((key[i] & mask) == prefix) atomicAdd((unsigned*)&hist[(key[i] >> shift) & 255u], 1u);
        __syncthreads();
        if (wave == 0) {
            const u32x4 hb = *(const LAS u32x4*)(hist + 4 * lane); const unsigned sl = hb.x + hb.y + hb.z + hb.w; unsigned S = sl;
#pragma unroll
            for (int o = 1; o < 64; o <<= 1) { const unsigned y = __shfl_down(S, o); if (lane + o < 64) S += y; }
            const unsigned above = S - sl;
            if (above < krem && krem <= above + sl) { unsigned cum = above; int d;
                if (cum + hb.w >= krem) d = 3; else { cum += hb.w; if (cum + hb.z >= krem) d = 2; else { cum += hb.z; if (cum + hb.y >= krem) d = 1; else { cum += hb.y; d = 0; } } }
                ctl[0] = prefix | ((unsigned)(4 * lane + d) << shift); ctl[1] = krem - cum; } }
        __syncthreads();
        prefix = ctl[0]; krem = ctl[1]; mask |= 255u << shift;
        __syncthreads();
    }
    const unsigned thr = prefix;
    int ngt = 0, neq = 0;
#pragma unroll
    for (int i = 0; i < 16; ++i) { ngt += key[i] > thr; neq += key[i] == thr; }
    int sg = ngt, sq = neq;
#pragma unroll
    for (int o = 1; o < 64; o <<= 1) { const int a = __shfl_up(sg, o), c = __shfl_up(sq, o); if (lane >= o) { sg += a; sq += c; } }
    if (lane == 63) { wsum[wave] = (unsigned)sg; wsum[8 + wave] = (unsigned)sq; }
    __syncthreads();
    int bg = 0, bq = 0;
#pragma unroll
    for (int w = 0; w < 8; ++w) if (w < wave) { bg += (int)wsum[w]; bq += (int)wsum[8 + w]; }
    int pg = bg + sg - ngt, pq = bq + sq - neq;
#pragma unroll
    for (int i = 0; i < 16; ++i) {
        const int tok = tid * 16 + i; const bool gt = key[i] > thr, eq = key[i] == thr;
        const bool sel = gt || (eq && pq < (int)krem);
        const int slot = pg + (pq < (int)krem ? pq : (int)krem);
        if (sel) { idx[be * CAP + slot] = tok; val[be * CAP + slot] = __uint_as_float(key[i]); }
        inv[((size_t)b * SEQ + tok) * 16 + e] = sel ? slot : -1;
        pg += gt; pq += eq;
    }
    __syncthreads();
}

__device__ __forceinline__ void phase_gather(const bf16* XN, const int* idx, bf16* XG, int gw, int NGW, int lane) {
    for (int r = gw; r < MEXP; r += NGW) {
        const int b = r >> 14; const int tok = idx[r];
        const GAS u32x4* s = (const GAS u32x4*)(XN + ((size_t)b * SEQ + tok) * DM) + lane; GAS u32x4* d = (GAS u32x4*)(XG + (size_t)r * DM) + lane;
        const u32x4 a = s[0], c = s[64]; d[0] = a; d[64] = c;
    }
}

__device__ __forceinline__ void phase_combine(const float* hin, float* hout, const bf16* Y, const int* inv, const float* val, const float* wn, bf16* XN, bool final_, int gw, int NGW, int lane, float pscale = 1.0f) {
    f32x4 wv[4]; load_w4(wn, wv, lane);
    for (int m = gw; m < M; m += NGW) {
        const int b = m >> 13;
        const GAS f32x4* xr = (const GAS f32x4*)(hin + (size_t)m * DM) + lane; f32x4 v[4];
#pragma unroll
        for (int j = 0; j < 4; ++j) v[j] = xr[64 * j];
        const int myslot = (lane < 16) ? inv[(size_t)m * 16 + lane] : -1;
        for (int e = 0; e < 16; ++e) {
            const int s = __shfl(myslot, e);
            if (s >= 0) {
                const int r = (b * 16 + e) * CAP + s; const float a = val[r];
                const GAS u32x2* yr = (const GAS u32x2*)(Y + (size_t)r * DM) + lane;
#pragma unroll
                for (int j = 0; j < 4; ++j) { const u32x2 t = yr[64 * j];
                    v[j].x += a * __uint_as_float(t.x << 16); v[j].y += a * __uint_as_float(t.x & 0xffff0000u); v[j].z += a * __uint_as_float(t.y << 16); v[j].w += a * __uint_as_float(t.y & 0xffff0000u); }
            }
        }
        float s2 = 0.f;
#pragma unroll
        for (int j = 0; j < 4; ++j) s2 += (v[j].x * v[j].x + v[j].y * v[j].y) + (v[j].z * v[j].z + v[j].w * v[j].w);
        const float rstd = 1.0f / sqrtf(wave_sum(s2) * (1.0f / DM) + EPS);
        GAS f32x4* ho = (GAS f32x4*)(hout + (size_t)m * DM) + lane;
        if (final_) {
#pragma unroll
            for (int j = 0; j < 4; ++j) ho[64 * j] = v[j] * (rstd * pscale) * wv[j];
        } else {
#pragma unroll
            for (int j = 0; j < 4; ++j) ho[64 * j] = v[j];
            f32x4 nv[4];
#pragma unroll
            for (int j = 0; j < 4; ++j) nv[j] = v[j] * rstd * wv[j];
            store_row_bf16(XN + (size_t)m * DM, nv, lane);
        }
    }
}
namespace gdn {
constexpr int CW = 0;
constexpr int SC = CW + 8 * 320 * 4;
constexpr int Q = SC + 1280;
constexpr int K = Q + 64 * 136 * 2;
constexpr int KDT = K + 64 * 136 * 2;
constexpr int VT = KDT + 128 * 72 * 2;
constexpr int T = VT + 64 * 72 * 2;
constexpr int QKD = T + 64 * 72 * 2;
constexpr int ST = QKD + 64 * 72 * 2;
constexpr int TMP = ST + 64 * 136 * 2;
constexpr int RQ = TMP, RK = RQ + 70 * 136 * 2, RV = RK + 70 * 136 * 2, RAW_END = RV + 70 * 72 * 2;
constexpr int AF = TMP, TF = AF + 64 * 68 * 4, XF = TF + 64 * 68 * 4, INV_END = XF + 3 * 16 * 17 * 4;
constexpr int RT = TMP, UT = RT + 64 * 72 * 2, OS = UT + 64 * 72 * 2, ST_END = OS + 64 * 65 * 4;
static_assert(RAW_END <= MISC_OFF && INV_END <= MISC_OFF && ST_END <= MISC_OFF, "gdn LDS map");
}
__device__ __forceinline__ void gdn_chain(LAS unsigned char* lds, int cid, const bf16* raw, const float* scal, const float* conv_w, const float* conv_b,
                                          const float* A_log, const float* dt_bias, bf16* og, int tid, int wave, int lane) {
    using namespace gdn;
    const int dvh = cid & 1, dir = (cid >> 1) & 1, h = (cid >> 2) & 7, b = cid >> 5;
    const int fr = lane & 15, fq = lane >> 4;
    LAS float* cw = (LAS float*)(lds + CW); LAS float* sc = (LAS float*)(lds + SC);
    LAS bf16* q_ = (LAS bf16*)(lds + Q); LAS bf16* k_ = (LAS bf16*)(lds + K); LAS bf16* kdT = (LAS bf16*)(lds + KDT); LAS bf16* vT = (LAS bf16*)(lds + VT);
    LAS bf16* T_ = (LAS bf16*)(lds + T); LAS bf16* QKd = (LAS bf16*)(lds + QKD); LAS bf16* ST_ = (LAS bf16*)(lds + ST);
    LAS bf16* rq = (LAS bf16*)(lds + RQ); LAS bf16* rk = (LAS bf16*)(lds + RK); LAS bf16* rv = (LAS bf16*)(lds + RV);
    LAS float* Af = (LAS float*)(lds + AF); LAS float* Tf = (LAS float*)(lds + TF); LAS float* Xf = (LAS float*)(lds + XF);
    LAS bf16* rT = (LAS bf16*)(lds + RT); LAS bf16* uT = (LAS bf16*)(lds + UT); LAS float* os = (LAS float*)(lds + OS);
    for (int e = tid; e < 8 * 320; e += 512) { const int r = e / 320, c = e % 320;
        const int gch = c < 128 ? h * 128 + c : (c < 256 ? 1024 + h * 128 + (c - 128) : 2048 + h * 128 + dvh * 64 + (c - 256));
        cw[e] = r < 7 ? conv_w[r * CONV_CH + gch] : conv_b[gch]; }
    for (int e = tid; e < 64 * 136 / 2; e += 512) ((LAS unsigned*)ST_)[e] = 0u;
    const float expA = expf(A_log[dir * 8 + h]), dtb = dt_bias[dir * 8 + h];
    f32x4 sacc[4];
#pragma unroll
    for (int nt = 0; nt < 4; ++nt) sacc[nt] = (f32x4){0.f, 0.f, 0.f, 0.f};
    const size_t rowb = (size_t)b * SEQ;
    __syncthreads();
    for (int n = 0; n < NCHUNK; ++n) {
        const int t0 = (dir ? NCHUNK - 1 - n : n) * 64;
        for (int e = tid; e < 70 * 40; e += 512) { const int r = e / 40, p = e % 40; const int t = t0 - 3 + r;
            u32x4 v = (u32x4){0u, 0u, 0u, 0u};
            const int col = p < 16 ? h * 128 + p * 8 : (p < 32 ? 1024 + h * 128 + (p - 16) * 8 : 2048 + h * 128 + dvh * 64 + (p - 32) * 8);
            if (t >= 0 && t < SEQ) v = *(const GAS u32x4*)(raw + (rowb + t) * CONV_CH + col);
            LAS bf16* d = p < 16 ? rq + r * 136 + p * 8 : (p < 32 ? rk + r * 136 + (p - 16) * 8 : rv + r * 72 + (p - 32) * 8);
            *(LAS u32x4*)d = v; }
        if (wave == 0) { const int i = lane; const int t = t0 + (dir ? 63 - i : i);
            const float braw = scal[(rowb + t) * 64 + dir * 8 + h], araw = scal[(rowb + t) * 64 + 16 + dir * 8 + h];
            const float g = -expA * softplus_f(araw + dtb);
            float gc = g;
#pragma unroll
            for (int o = 1; o < 64; o <<= 1) { const float y = __shfl_up(gc, o); if (i >= o) gc += y; }
            const float gl = __shfl(gc, 63);
            sc[i] = sigmoid_f(braw); sc[64 + i] = gc; sc[128 + i] = expf(gc); sc[192 + i] = expf(gl - gc); if (i == 0) sc[256] = expf(gl); }
        __syncthreads();
        { const int i = tid >> 3, cg = tid & 7; const int o = dir ? 63 - i : i;
          float a[16];
          conv16(a, rq + o * 136 + cg * 16, 136, cw + cg * 16, 320);
          float ss = 0.f;
#pragma unroll
          for (int c = 0; c < 16; ++c) { a[c] = silu(a[c]); ss += a[c] * a[c]; }
          ss += __shfl_xor(ss, 1); ss += __shfl_xor(ss, 2); ss += __shfl_xor(ss, 4);
          float rs = (1.0f / sqrtf(ss + EPS)) * 0.08838834764831845f;
          { u32x4 w0, w1; w0.x = pkbf(a[0] * rs, a[1] * rs); w0.y = pkbf(a[2] * rs, a[3] * rs); w0.z = pkbf(a[4] * rs, a[5] * rs); w0.w = pkbf(a[6] * rs, a[7] * rs);
            w1.x = pkbf(a[8] * rs, a[9] * rs); w1.y = pkbf(a[10] * rs, a[11] * rs); w1.z = pkbf(a[12] * rs, a[13] * rs); w1.w = pkbf(a[14] * rs, a[15] * rs);
            *(LAS u32x4*)(q_ + i * 136 + cg * 16) = w0; *(LAS u32x4*)(q_ + i * 136 + cg * 16 + 8) = w1; }
          conv16(a, rk + o * 136 + cg * 16, 136, cw + 128 + cg * 16, 320);
          ss = 0.f;
#pragma unroll
          for (int c = 0; c < 16; ++c) { a[c] = silu(a[c]); ss += a[c] * a[c]; }
          ss += __shfl_xor(ss, 1); ss += __shfl_xor(ss, 2); ss += __shfl_xor(ss, 4);
          rs = 1.0f / sqrtf(ss + EPS);
          { u32x4 w0, w1; w0.x = pkbf(a[0] * rs, a[1] * rs); w0.y = pkbf(a[2] * rs, a[3] * rs); w0.z = pkbf(a[4] * rs, a[5] * rs); w0.w = pkbf(a[6] * rs, a[7] * rs);
            w1.x = pkbf(a[8] * rs, a[9] * rs); w1.y = pkbf(a[10] * rs, a[11] * rs); w1.z = pkbf(a[12] * rs, a[13] * rs); w1.w = pkbf(a[14] * rs, a[15] * rs);
            *(LAS u32x4*)(k_ + i * 136 + cg * 16) = w0; *(LAS u32x4*)(k_ + i * 136 + cg * 16 + 8) = w1; }
          const float ek = sc[192 + i] * rs;
#pragma unroll
          for (int c = 0; c < 16; ++c) kdT[(cg * 16 + c) * 72 + i] = f2bf1(a[c] * ek);
          float v8[8];
          conv8(v8, rv + o * 72 + cg * 8, 72, cw + 256 + cg * 8, 320);
#pragma unroll
          for (int c = 0; c < 8; ++c) vT[(cg * 8 + c) * 72 + i] = f2bf1(silu(v8[c]));
        }
        __syncthreads();
        { const int which = wave >> 2, mt = wave & 3;
          f32x4 acc[1][4];
#pragma unroll
          for (int nt = 0; nt < 4; ++nt) acc[0][nt] = (f32x4){0.f, 0.f, 0.f, 0.f};
          mma_lds<1, 4>(acc, which ? q_ : k_, 136, mt * 16, k_, 136, 0, 128, fr, fq);
#pragma unroll
          for (int nt = 0; nt < 4; ++nt)
#pragma unroll
              for (int r = 0; r < 4; ++r) { const int i = mt * 16 + 4 * fq + r, j = nt * 16 + fr;
                  const float d = expf(fminf(sc[64 + i] - sc[64 + j], 0.f)); const float x = acc[0][nt][r] * d;
                  if (which == 0) Af[i * 68 + j] = (i > j) ? sc[i] * x : 0.f;
                  else QKd[i * 72 + j] = f2bf1((i >= j) ? x : 0.f); }
        }
        __syncthreads();
        if (wave == 0) { const int blk = lane >> 4, c = lane & 15; float t[16];
#pragma unroll
            for (int i = 0; i < 16; ++i) t[i] = (i == c) ? 1.f : 0.f;
#pragma unroll
            for (int i = 1; i < 16; ++i) { float s = 0.f; const LAS float* ar = Af + (blk * 16 + i) * 68 + blk * 16;
#pragma unroll
                for (int j = 0; j < i; ++j) s += ar[j] * t[j];
                t[i] = (i > c) ? -s : t[i];
                if ((i & 3) == 3) asm volatile("" ::: "memory"); }
#pragma unroll
            for (int i = 0; i < 16; ++i) Tf[(blk * 16 + i) * 68 + blk * 16 + c] = t[i]; }
        for (int d = 1; d <= 3; ++d) { const int nbk = 4 - d;
            __syncthreads();
            for (int e = tid; e < nbk * 256; e += 512) { const int J = e >> 8, r = (e >> 4) & 15, c = e & 15, I = J + d; float s = 0.f;
                for (int kk = J * 16; kk < I * 16; ++kk) s += Af[(I * 16 + r) * 68 + kk] * Tf[kk * 68 + J * 16 + c];
                Xf[(J * 16 + r) * 17 + c] = s; }
            __syncthreads();
            for (int e = tid; e < nbk * 256; e += 512) { const int J = e >> 8, r = (e >> 4) & 15, c = e & 15, I = J + d; float s = 0.f;
#pragma unroll
                for (int m2 = 0; m2 < 16; ++m2) s += Tf[(I * 16 + r) * 68 + I * 16 + m2] * Xf[(J * 16 + m2) * 17 + c];
                Tf[(I * 16 + r) * 68 + J * 16 + c] = -s; }
        }
        __syncthreads();
        for (int e = tid; e < 4096; e += 512) { const int i = e >> 6, j = e & 63; T_[i * 72 + j] = f2bf1(((i >> 4) >= (j >> 4)) ? Tf[i * 68 + j] : 0.f); }
        __syncthreads();
        const int mt = wave & 3, nh = wave >> 2;
        f32x4 aq[2];
        { f32x4 ak[2]; ak[0] = ak[1] = aq[0] = aq[1] = (f32x4){0.f, 0.f, 0.f, 0.f};
          for (int k0 = 0; k0 < 128; k0 += 32) {
              const bf16x8 fk = *(const LAS bf16x8*)(k_ + (mt * 16 + fr) * 136 + k0 + fq * 8), fqv = *(const LAS bf16x8*)(q_ + (mt * 16 + fr) * 136 + k0 + fq * 8);
#pragma unroll
              for (int nl = 0; nl < 2; ++nl) { const bf16x8 fb = *(const LAS bf16x8*)(ST_ + (nh * 32 + nl * 16 + fr) * 136 + k0 + fq * 8);
                  ak[nl] = __builtin_amdgcn_mfma_f32_16x16x32_bf16(fk, fb, ak[nl], 0, 0, 0); aq[nl] = __builtin_amdgcn_mfma_f32_16x16x32_bf16(fqv, fb, aq[nl], 0, 0, 0); } }
          const int i0 = mt * 16 + 4 * fq;
          const f32x4 be4 = *(const LAS f32x4*)(sc + i0), eg4 = *(const LAS f32x4*)(sc + 128 + i0);
#pragma unroll
          for (int nl = 0; nl < 2; ++nl) { const int dv = nh * 32 + nl * 16 + fr;
              const bf16x4 vv = *(const LAS bf16x4*)(vT + dv * 72 + i0);
              float r0 = be4[0] * (bf2f_s(vv[0]) - eg4[0] * ak[nl][0]), r1 = be4[1] * (bf2f_s(vv[1]) - eg4[1] * ak[nl][1]);
              float r2 = be4[2] * (bf2f_s(vv[2]) - eg4[2] * ak[nl][2]), r3 = be4[3] * (bf2f_s(vv[3]) - eg4[3] * ak[nl][3]);
              u32x2 w; w.x = pkbf(r0, r1); w.y = pkbf(r2, r3); *(LAS u32x2*)(rT + dv * 72 + i0) = w;
              aq[nl][0] *= eg4[0]; aq[nl][1] *= eg4[1]; aq[nl][2] *= eg4[2]; aq[nl][3] *= eg4[3]; }
        }
        __syncthreads();
        { f32x4 au[1][2]; au[0][0] = au[0][1] = (f32x4){0.f, 0.f, 0.f, 0.f};
          mma_lds<1, 2>(au, T_, 72, mt * 16, rT, 72, nh * 32, 64, fr, fq);
          const int i0 = mt * 16 + 4 * fq;
#pragma unroll
          for (int nl = 0; nl < 2; ++nl) { const int dv = nh * 32 + nl * 16 + fr; u32x2 w; w.x = pkbf(au[0][nl][0], au[0][nl][1]); w.y = pkbf(au[0][nl][2], au[0][nl][3]); *(LAS u32x2*)(uT + dv * 72 + i0) = w; }
        }
        __syncthreads();
        { f32x4 ao[1][2]; ao[0][0] = aq[0]; ao[0][1] = aq[1];
          mma_lds<1, 2>(ao, QKd, 72, mt * 16, uT, 72, nh * 32, 64, fr, fq);
          const int i0 = mt * 16 + 4 * fq;
#pragma unroll
          for (int nl = 0; nl < 2; ++nl)
#pragma unroll
              for (int r = 0; r < 4; ++r) os[(i0 + r) * 65 + nh * 32 + nl * 16 + fr] = ao[0][nl][r];
          const float egl = sc[256];
          f32x4 as_[1][4];
#pragma unroll
          for (int nt = 0; nt < 4; ++nt) as_[0][nt] = sacc[nt] * egl;
          mma_lds<1, 4>(as_, kdT, 72, wave * 16, uT, 72, 0, 64, fr, fq);
#pragma unroll
          for (int nt = 0; nt < 4; ++nt) { sacc[nt] = as_[0][nt];
              u32x2 w; w.x = pkbf(sacc[nt][0], sacc[nt][1]); w.y = pkbf(sacc[nt][2], sacc[nt][3]); *(LAS u32x2*)(ST_ + (nt * 16 + fr) * 136 + wave * 16 + 4 * fq) = w; }
        }
        __syncthreads();
#pragma unroll
        for (int ii = 0; ii < 4; ++ii) { const int i = wave * 8 + 2 * ii + (lane >> 5), cp = lane & 31; const int t = t0 + (dir ? 63 - i : i);
            atomic_add_bf16x2(og + (rowb + t) * 1024 + h * 128 + dvh * 64 + 2 * cp, os[i * 65 + 2 * cp], os[i * 65 + 2 * cp + 1]); }
        __syncthreads();
    }
}

namespace ssd {
constexpr int CW = 0;
constexpr int SC = CW + 8 * 320 * 4;
constexpr int BM_ = SC + 1280;
constexpr int CM_ = BM_ + 64 * 136 * 2;
constexpr int BT = CM_ + 64 * 136 * 2;
constexpr int XDT = BT + 128 * 72 * 2;
constexpr int XDW = XDT + 64 * 72 * 2;
constexpr int MM = XDW + 64 * 72 * 2;
constexpr int HT = MM + 64 * 72 * 2;
constexpr int TMP = HT + 64 * 136 * 2;
constexpr int RX = TMP, RB = RX + 70 * 72 * 2, RC = RB + 70 * 136 * 2, RAW_END = RC + 70 * 136 * 2;
constexpr int OS = TMP, OS_END = OS + 64 * 65 * 4;
static_assert(RAW_END <= MISC_OFF && OS_END <= MISC_OFF, "ssd LDS map");
}
__device__ __forceinline__ void ssd_chain(LAS unsigned char* lds, int cid, const bf16* raw, const float* scal, const float* conv_w, const float* conv_b,
                                          const float* A_log, const float* dt_bias, const float* Dp, bf16* ys, int tid, int wave, int lane) {
    using namespace ssd;
    const int dir = cid & 1, head = (cid >> 1) & 15, b = cid >> 5; const int g = head >> 3;
    const int fr = lane & 15, fq = lane >> 4;
    LAS float* cw = (LAS float*)(lds + CW); LAS float* sc = (LAS float*)(lds + SC);
    LAS bf16* Bm = (LAS bf16*)(lds + BM_); LAS bf16* Cm = (LAS bf16*)(lds + CM_); LAS bf16* BT_ = (LAS bf16*)(lds + BT);
    LAS bf16* xdt = (LAS bf16*)(lds + XDT); LAS bf16* xdw = (LAS bf16*)(lds + XDW); LAS bf16* Mm = (LAS bf16*)(lds + MM); LAS bf16* hT = (LAS bf16*)(lds + HT);
    LAS bf16* rx = (LAS bf16*)(lds + RX); LAS bf16* rb = (LAS bf16*)(lds + RB); LAS bf16* rc = (LAS bf16*)(lds + RC); LAS float* os = (LAS float*)(lds + OS);
    const int chx = 3072 + head * 64, chb = 4096 + g * 128, chc = 4352 + g * 128;
    for (int e = tid; e < 8 * 320; e += 512) { const int r = e / 320, c = e % 320;
        const int gch = c < 64 ? chx + c : (c < 192 ? chb + (c - 64) : chc + (c - 192));
        cw[e] = r < 7 ? conv_w[r * CONV_CH + gch] : conv_b[gch]; }
    for (int e = tid; e < 64 * 136 / 2; e += 512) ((LAS unsigned*)hT)[e] = 0u;
    const float Ah = -expf(A_log[dir * 16 + head]), dtb = dt_bias[dir * 16 + head], Dh = (dir == 0) ? Dp[head] : 0.f;
    f32x4 hacc[4];
#pragma unroll
    for (int nt = 0; nt < 4; ++nt) hacc[nt] = (f32x4){0.f, 0.f, 0.f, 0.f};
    const size_t rowb = (size_t)b * SEQ;
    __syncthreads();
    for (int n = 0; n < NCHUNK; ++n) {
        const int t0 = (dir ? NCHUNK - 1 - n : n) * 64;
        for (int e = tid; e < 70 * 40; e += 512) { const int r = e / 40, p = e % 40; const int t = t0 - 3 + r;
            u32x4 v = (u32x4){0u, 0u, 0u, 0u};
            const int col = p < 8 ? chx + p * 8 : (p < 24 ? chb + (p - 8) * 8 : chc + (p - 24) * 8);
            if (t >= 0 && t < SEQ) v = *(const GAS u32x4*)(raw + (rowb + t) * CONV_CH + col);
            LAS bf16* d = p < 8 ? rx + r * 72 + p * 8 : (p < 24 ? rb + r * 136 + (p - 8) * 8 : rc + r * 136 + (p - 24) * 8);
            *(LAS u32x4*)d = v; }
        if (wave == 0) { const int i = lane; const int t = t0 + (dir ? 63 - i : i);
            const float dt = softplus_f(scal[(rowb + t) * 64 + 32 + dir * 16 + head] + dtb);
            float cs = dt * Ah;
#pragma unroll
            for (int o = 1; o < 64; o <<= 1) { const float y = __shfl_up(cs, o); if (i >= o) cs += y; }
            const float cl = __shfl(cs, 63);
            sc[i] = dt; sc[64 + i] = cs; sc[128 + i] = expf(cs); sc[192 + i] = expf(cl - cs); if (i == 0) sc[256] = expf(cl); }
        __syncthreads();
        { const int i = tid >> 3, cg = tid & 7; const int o = dir ? 63 - i : i;
          float a[16];
          conv16(a, rb + o * 136 + cg * 16, 136, cw + 64 + cg * 16, 320);
#pragma unroll
          for (int c = 0; c < 16; ++c) a[c] = silu(a[c]);
          { u32x4 w0, w1; w0.x = pkbf(a[0], a[1]); w0.y = pkbf(a[2], a[3]); w0.z = pkbf(a[4], a[5]); w0.w = pkbf(a[6], a[7]);
            w1.x = pkbf(a[8], a[9]); w1.y = pkbf(a[10], a[11]); w1.z = pkbf(a[12], a[13]); w1.w = pkbf(a[14], a[15]);
            *(LAS u32x4*)(Bm + i * 136 + cg * 16) = w0; *(LAS u32x4*)(Bm + i * 136 + cg * 16 + 8) = w1; }
#pragma unroll
          for (int c = 0; c < 16; ++c) BT_[(cg * 16 + c) * 72 + i] = f2bf1(a[c]);
          conv16(a, rc + o * 136 + cg * 16, 136, cw + 192 + cg * 16, 320);
#pragma unroll
          for (int c = 0; c < 16; ++c) a[c] = silu(a[c]);
          { u32x4 w0, w1; w0.x = pkbf(a[0], a[1]); w0.y = pkbf(a[2], a[3]); w0.z = pkbf(a[4], a[5]); w0.w = pkbf(a[6], a[7]);
            w1.x = pkbf(a[8], a[9]); w1.y = pkbf(a[10], a[11]); w1.z = pkbf(a[12], a[13]); w1.w = pkbf(a[14], a[15]);
            *(LAS u32x4*)(Cm + i * 136 + cg * 16) = w0; *(LAS u32x4*)(Cm + i * 136 + cg * 16 + 8) = w1; }
          float x8[8];
          conv8(x8, rx + o * 72 + cg * 8, 72, cw + cg * 8, 320);
          const float dt = sc[i], wst = sc[192 + i];
#pragma unroll
          for (int c = 0; c < 8; ++c) { const float xv = silu(x8[c]) * dt; xdt[(cg * 8 + c) * 72 + i] = f2bf1(xv); xdw[(cg * 8 + c) * 72 + i] = f2bf1(xv * wst); }
        }
        __syncthreads();
        const int mt = wave & 3, nh = wave >> 2;
        { f32x4 acc[1][2]; acc[0][0] = acc[0][1] = (f32x4){0.f, 0.f, 0.f, 0.f};
          mma_lds<1, 2>(acc, Cm, 136, mt * 16, Bm, 136, nh * 32, 128, fr, fq);
#pragma unroll
          for (int nl = 0; nl < 2; ++nl)
#pragma unroll
              for (int r = 0; r < 4; ++r) { const int i = mt * 16 + 4 * fq + r, j = nh * 32 + nl * 16 + fr;
                  const float d = expf(fminf(sc[64 + i] - sc[64 + j], 0.f));
                  Mm[i * 72 + j] = f2bf1((i >= j) ? acc[0][nl][r] * d : 0.f); }
        }
        __syncthreads();
        { f32x4 a1[1][2], a2[1][2]; a1[0][0] = a1[0][1] = a2[0][0] = a2[0][1] = (f32x4){0.f, 0.f, 0.f, 0.f};
          mma_lds<1, 2>(a1, Mm, 72, mt * 16, xdt, 72, nh * 32, 64, fr, fq);
          mma_lds<1, 2>(a2, Cm, 136, mt * 16, hT, 136, nh * 32, 128, fr, fq);
          const int i0 = mt * 16 + 4 * fq;
          const f32x4 ec4 = *(const LAS f32x4*)(sc + 128 + i0), dt4 = *(const LAS f32x4*)(sc + i0);
#pragma unroll
          for (int nl = 0; nl < 2; ++nl) { const int p = nh * 32 + nl * 16 + fr; const bf16x4 xv = *(const LAS bf16x4*)(xdt + p * 72 + i0);
#pragma unroll
              for (int r = 0; r < 4; ++r) os[(i0 + r) * 65 + p] = a1[0][nl][r] + ec4[r] * a2[0][nl][r] + Dh * bf2f_s(xv[r]) / dt4[r]; }
        }
        __syncthreads();
        { const float ecl = sc[256];
          f32x4 ah[1][4];
#pragma unroll
          for (int nt = 0; nt < 4; ++nt) ah[0][nt] = hacc[nt] * ecl;
          mma_lds<1, 4>(ah, BT_, 72, wave * 16, xdw, 72, 0, 64, fr, fq);
#pragma unroll
          for (int nt = 0; nt < 4; ++nt) { hacc[nt] = ah[0][nt];
              u32x2 w; w.x = pkbf(hacc[nt][0], hacc[nt][1]); w.y = pkbf(hacc[nt][2], hacc[nt][3]); *(LAS u32x2*)(hT + (nt * 16 + fr) * 136 + wave * 16 + 4 * fq) = w; }
        }
#pragma unroll
        for (int ii = 0; ii < 4; ++ii) { const int i = wave * 8 + 2 * ii + (lane >> 5), cp = lane & 31; const int t = t0 + (dir ? 63 - i : i);
            atomic_add_bf16x2(ys + (rowb + t) * 1024 + head * 64 + 2 * cp, os[i * 65 + 2 * cp], os[i * 65 + 2 * cp + 1]); }
        __syncthreads();
    }
}
namespace pgd {
constexpr int CW = 0;
constexpr int SC = CW + 8 * 384 * 4;
constexpr int Q = SC + 1280;
constexpr int K = Q + 64 * 136 * 2;
constexpr int VT = K + 64 * 136 * 2;
constexpr int TMP = VT + 128 * 72 * 2;
constexpr int RQ = TMP, RK = RQ + 70 * 136 * 2, RV = RK + 70 * 136 * 2, RAW_END = RV + 70 * 136 * 2;
constexpr int AF = TMP, A2F = AF + 64 * 68 * 4, TF = A2F + 64 * 68 * 4, T2F = TF + 64 * 68 * 4, QKP = T2F + 64 * 68 * 4, INV_END = QKP + 64 * 72 * 2;
constexpr int XF = VT;
constexpr int TP = AF;
constexpr int STASH = MISC_OFF - 16384;
static_assert(RAW_END <= STASH && INV_END <= STASH, "prep gdn LDS map");
}
constexpr size_t WS_TQ = 379 * MiB;

__device__ __forceinline__ void prep_gdn_stash(LAS unsigned char* lds, int bid, const bf16* raw, int tid) {
    const int bh = bid >> 3, b = bh >> 3, h = bh & 7, r8 = bid & 7;
    LAS bf16* st = (LAS bf16*)(lds + pgd::STASH);
    for (int e = tid; e < 2 * 3 * 48; e += 512) { const int which = e / 144, r = (e % 144) / 48, p = e % 48;
        const int t = which ? (r8 * 16 + 16) * 64 + r : r8 * 16 * 64 - 3 + r;
        const int col = p < 16 ? h * 128 + p * 8 : (p < 32 ? 1024 + h * 128 + (p - 16) * 8 : 2048 + h * 128 + (p - 32) * 8);
        u32x4 v = (u32x4){0u, 0u, 0u, 0u};
        if (t >= 0 && t < SEQ) v = *(const GAS u32x4*)(raw + ((size_t)b * SEQ + t) * CONV_CH + col);
        *(LAS u32x4*)(st + which * 1152 + r * 384 + p * 8) = v; }
}
__device__ __forceinline__ void inv_diag_blocks(const LAS float* Af, LAS float* Tf, int lane) {
    const int blk = lane >> 4, c = lane & 15; float t[16];
#pragma unroll
    for (int i = 0; i < 16; ++i) t[i] = (i == c) ? 1.f : 0.f;
#pragma unroll
    for (int i = 1; i < 16; ++i) { float s = 0.f; const LAS float* ar = Af + (blk * 16 + i) * 68 + blk * 16;
#pragma unroll
        for (int j = 0; j < i; ++j) s += ar[j] * t[j];
        t[i] = (i > c) ? -s : t[i];
        if ((i & 3) == 3) asm volatile("" ::: "memory"); }
#pragma unroll
    for (int i = 0; i < 16; ++i) Tf[(blk * 16 + i) * 68 + blk * 16 + c] = t[i];
}
__device__ __forceinline__ void inv_offdiag_x(const LAS float* Af, const LAS float* Tf, LAS float* Xf, int d, int ht) {
    const int nbk = 4 - d;
    for (int e = ht; e < nbk * 256; e += 256) { const int J = e >> 8, r = (e >> 4) & 15, c = e & 15, I = J + d; float s = 0.f;
        for (int kk = J * 16; kk < I * 16; ++kk) s += Af[(I * 16 + r) * 68 + kk] * Tf[kk * 68 + J * 16 + c];
        Xf[(J * 16 + r) * 17 + c] = s; }
}
__device__ __forceinline__ void inv_offdiag_t(LAS float* Tf, const LAS float* Xf, int d, int ht) {
    const int nbk = 4 - d;
    for (int e = ht; e < nbk * 256; e += 256) { const int J = e >> 8, r = (e >> 4) & 15, c = e & 15, I = J + d; float s = 0.f;
#pragma unroll
        for (int m2 = 0; m2 < 16; ++m2) s += Tf[(I * 16 + r) * 68 + I * 16 + m2] * Xf[(J * 16 + m2) * 17 + c];
        Tf[(I * 16 + r) * 68 + J * 16 + c] = -s; }
}

__device__ __forceinline__ void conv_pair8(float (&o)[16], const LAS bf16* src  , int ld, const float (&w)[16]) {
#pragma unroll
    for (int t = 0; t < 8; ++t) { o[2 * t] = w[14]; o[2 * t + 1] = w[15]; }
#pragma unroll
    for (int r = 0; r < 14; ++r) { const unsigned xv = *(const LAS unsigned*)(src + r * ld); const float x0 = __uint_as_float(xv << 16), x1 = __uint_as_float(xv & 0xffff0000u);
#pragma unroll
        for (int t = 0; t < 8; ++t) { const int tap = r - t; if (tap >= 0 && tap < 7) { o[2 * t] += x0 * w[2 * tap]; o[2 * t + 1] += x1 * w[2 * tap + 1]; } } }
}
namespace pg2 {
constexpr int CW = 0;
constexpr int SC = CW + 8 * 384 * 4;
constexpr int Q = SC + 1280;
constexpr int K = Q + 64 * 136 * 2;
constexpr int VT = K + 64 * 136 * 2;
constexpr int RAWT = VT + 128 * 72 * 2;
constexpr int RAW_END = RAWT + 3 * 70 * 136 * 2;
constexpr int ABF = RAWT, TRM = ABF + 2 * 64 * 72 * 2, TTR = TRM + 2 * 64 * 72 * 2, AD = TTR + 2 * 64 * 72 * 2, XS = AD + 2 * 4 * 256 * 4, QKP = XS + 2 * 32 * 40 * 2, INV_END = QKP + 64 * 72 * 2;
static_assert(RAW_END <= pgd::STASH && INV_END <= pgd::STASH, "prep gdn v2 LDS map");
}
__device__ __forceinline__ void prep_gdn_range(LAS unsigned char* lds, int bid, bf16* raw, const float* scal, const float* conv_w, const float* conv_b,
                                               const float* A_log, const float* dt_bias, bf16* TQ, int tid_p, int wave_p, int lane_p, float* scal_w) {
    using namespace pg2;
    int tid = tid_p, wave = wave_p, lane = lane_p;
    const int bh = bid >> 3, b = bh >> 3, h = bh & 7, r8 = bid & 7;
    LAS float* cw = (LAS float*)(lds + CW); LAS float* sc = (LAS float*)(lds + SC);
    LAS bf16* q_ = (LAS bf16*)(lds + Q); LAS bf16* k_ = (LAS bf16*)(lds + K); LAS bf16* vT = (LAS bf16*)(lds + VT);
    LAS bf16* rq = (LAS bf16*)(lds + RAWT); LAS bf16* rk = rq + 70 * 136; LAS bf16* rv = rk + 70 * 136;
    LAS bf16* Abf = (LAS bf16*)(lds + ABF); LAS bf16* Trm = (LAS bf16*)(lds + TRM); LAS bf16* Ttr = (LAS bf16*)(lds + TTR);
    LAS float* ADf = (LAS float*)(lds + AD); LAS bf16* Xs = (LAS bf16*)(lds + XS); LAS bf16* QKp = (LAS bf16*)(lds + QKP);
    LAS bf16* st = (LAS bf16*)(lds + pgd::STASH);
    for (int e = tid; e < 8 * 384; e += 512) { const int r = e / 384, c = e % 384;
        const int gch = (c >> 7) * 1024 + h * 128 + (c & 127);
        cw[e] = r < 7 ? conv_w[r * CONV_CH + gch] : conv_b[gch]; }
    const float LOG2E = 1.4426950408889634f;
    const float expAf = expf(A_log[h]), dtbf = dt_bias[h], expAb = expf(A_log[8 + h]), dtbb = dt_bias[8 + h];
    const size_t rowb = (size_t)b * SEQ;
    u32x4 pre[7];
#define PG2_LOAD(u_) do { const int t0_ = (r8 * 16 + (u_)) * 64; \
        _Pragma("unroll") for (int x = 0; x < 7; ++x) { const int e = tid + 512 * x; const int r = e / 48, p = e % 48; \
            pre[x] = (u32x4){0u, 0u, 0u, 0u}; \
            if (e < 70 * 48 && r >= 3 && !(r >= 67 && (u_) == 15)) { const int col = p < 16 ? h * 128 + p * 8 : (p < 32 ? 1024 + h * 128 + (p - 16) * 8 : 2048 + h * 128 + (p - 32) * 8); \
                pre[x] = *(const GAS u32x4*)(raw + (rowb + t0_ - 3 + r) * CONV_CH + col); } } } while (0)
    PG2_LOAD(0);
    __syncthreads();
    for (int u = 0; u < 16; ++u) {
        tid = tid_p; asm volatile("" : "+v"(tid));
        lane = tid & 63; wave = __builtin_amdgcn_readfirstlane(tid >> 6);
        const int fr = lane & 15, fq = lane >> 4, half = wave >> 2, w4 = wave & 3;
        const int c = r8 * 16 + u, t0 = c * 64;
#pragma unroll
        for (int x = 0; x < 7; ++x) { const int e = tid + 512 * x; const int r = e / 48, p = e % 48;
            if (e < 70 * 48) { u32x4 v = pre[x];
                if (r < 3) v = *(const LAS u32x4*)(st + r * 384 + p * 8);
                else if (r >= 67 && u == 15) v = *(const LAS u32x4*)(st + 1152 + (r - 67) * 384 + p * 8);
                *(LAS u32x4*)((p < 16 ? rq + r * 136 + p * 8 : (p < 32 ? rk + r * 136 + (p - 16) * 8 : rv + r * 136 + (p - 32) * 8))) = v; } }
        if (wave == 0) { const int i = lane; const size_t so = (rowb + t0 + i) * 64;
            const float g = -expAf * softplus_f(scal[so + 16 + h] + dtbf); float gc = g;
#pragma unroll
            for (int o = 1; o < 64; o <<= 1) { const float y = __shfl_up(gc, o); if (i >= o) gc += y; }
            const float be_ = sigmoid_f(scal[so + h]); sc[i] = be_; sc[64 + i] = gc * LOG2E; scal_w[so + h] = be_; scal_w[so + 16 + h] = gc; }
        if (wave == 1) { const int i = lane; const size_t so = (rowb + t0 + i) * 64;
            const float g = -expAb * softplus_f(scal[so + 24 + h] + dtbb); float gc = g;
#pragma unroll
            for (int o = 1; o < 64; o <<= 1) { const float y = __shfl_down(gc, o); if (i + o < 64) gc += y; }
            const float be_ = sigmoid_f(scal[so + 8 + h]); sc[128 + i] = be_; sc[192 + i] = gc * LOG2E; scal_w[so + 8 + h] = be_; scal_w[so + 24 + h] = gc; }
        __syncthreads();
        if (u + 1 < 16) PG2_LOAD(u + 1);
        if (tid < 144) { const int r = tid / 48, p = tid % 48;
            const LAS bf16* s = p < 16 ? rq + (64 + r) * 136 + p * 8 : (p < 32 ? rk + (64 + r) * 136 + (p - 16) * 8 : rv + (64 + r) * 136 + (p - 32) * 8);
            *(LAS u32x4*)(st + r * 384 + p * 8) = *(const LAS u32x4*)s; }
        { const int tg = wave, cp = lane; float w[16], o[16];
#pragma unroll
          for (int tap = 0; tap < 8; ++tap) { w[2 * tap] = cw[tap * 384 + 2 * cp]; w[2 * tap + 1] = cw[tap * 384 + 2 * cp + 1]; }
          conv_pair8(o, rq + (8 * tg) * 136 + 2 * cp, 136, w);
#pragma unroll
          for (int t = 0; t < 8; ++t) { o[2 * t] = silu(o[2 * t]); o[2 * t + 1] = silu(o[2 * t + 1]);
              const float rs = (1.0f / sqrtf(wave_sum(o[2 * t] * o[2 * t] + o[2 * t + 1] * o[2 * t + 1]) + EPS)) * 0.08838834764831845f;
              const unsigned pk = pkbf(o[2 * t] * rs, o[2 * t + 1] * rs);
              *(LAS unsigned*)(q_ + (8 * tg + t) * 136 + 2 * cp) = pk; *(GAS unsigned*)(raw + (rowb + t0 + 8 * tg + t) * CONV_CH + h * 128 + 2 * cp) = pk; }
#pragma unroll
          for (int tap = 0; tap < 8; ++tap) { w[2 * tap] = cw[tap * 384 + 128 + 2 * cp]; w[2 * tap + 1] = cw[tap * 384 + 128 + 2 * cp + 1]; }
          conv_pair8(o, rk + (8 * tg) * 136 + 2 * cp, 136, w);
#pragma unroll
          for (int t = 0; t < 8; ++t) { o[2 * t] = silu(o[2 * t]); o[2 * t + 1] = silu(o[2 * t + 1]);
              const float rs = 1.0f / sqrtf(wave_sum(o[2 * t] * o[2 * t] + o[2 * t + 1] * o[2 * t + 1]) + EPS);
              const unsigned pk = pkbf(o[2 * t] * rs, o[2 * t + 1] * rs);
              *(LAS unsigned*)(k_ + (8 * tg + t) * 136 + 2 * cp) = pk; *(GAS unsigned*)(raw + (rowb + t0 + 8 * tg + t) * CONV_CH + 1024 + h * 128 + 2 * cp) = pk; }
#pragma unroll
          for (int tap = 0; tap < 8; ++tap) { w[2 * tap] = cw[tap * 384 + 256 + 2 * cp]; w[2 * tap + 1] = cw[tap * 384 + 256 + 2 * cp + 1]; }
          conv_pair8(o, rv + (8 * tg) * 136 + 2 * cp, 136, w);
#pragma unroll
          for (int t = 0; t < 16; ++t) o[t] = silu(o[t]);
          u32x4 e0, e1; e0.x = pkbf(o[0], o[2]); e0.y = pkbf(o[4], o[6]); e0.z = pkbf(o[8], o[10]); e0.w = pkbf(o[12], o[14]);
          e1.x = pkbf(o[1], o[3]); e1.y = pkbf(o[5], o[7]); e1.z = pkbf(o[9], o[11]); e1.w = pkbf(o[13], o[15]);
          *(LAS u32x4*)(vT + (2 * cp) * 72 + 8 * tg) = e0; *(LAS u32x4*)(vT + (2 * cp + 1) * 72 + 8 * tg) = e1;
        }
        __syncthreads();
        for (int e = tid; e < 128 * 8; e += 512) { const int dv = e >> 3, p = e & 7;
            *(GAS u32x4*)(raw + (rowb + t0 + (dv >> 1)) * CONV_CH + 2048 + h * 128 + (dv & 1) * 64 + p * 8) = *(const LAS u32x4*)(vT + dv * 72 + p * 8); }
        for (int e = tid; e < 2 * 2 * 64 * 72 * 2 / 16; e += 512) ((LAS u32x4*)(lds + TRM))[e] = (u32x4){0u, 0u, 0u, 0u};
        for (int e = tid; e < 2 * 32 * 40 * 2 / 16; e += 512) ((LAS u32x4*)(lds + XS))[e] = (u32x4){0u, 0u, 0u, 0u};
        { const int mt = w4;
          f32x4 acc[1][4];
#pragma unroll
          for (int nt = 0; nt < 4; ++nt) acc[0][nt] = (f32x4){0.f, 0.f, 0.f, 0.f};
          mma_lds<1, 4>(acc, half ? q_ : k_, 136, mt * 16, k_, 136, 0, 128, fr, fq);
#pragma unroll
          for (int nt = 0; nt < 4; ++nt)
#pragma unroll
              for (int r = 0; r < 4; ++r) { const int i = mt * 16 + 4 * fq + r, j = nt * 16 + fr;
                  const float arg = (i > j) ? sc[64 + i] - sc[64 + j] : sc[192 + i] - sc[192 + j];
                  const float x = acc[0][nt][r] * __builtin_amdgcn_exp2f(fminf(arg, 0.f));
                  if (half == 0) { const float af = (i > j) ? sc[i] * x : 0.f, ab = (i < j) ? sc[128 + i] * x : 0.f;
                      Abf[i * 72 + j] = f2bf1(af); Abf[64 * 72 + j * 72 + i] = f2bf1(ab);
                      if (mt == nt) { ADf[(mt * 16 + (i & 15)) * 16 + (j & 15)] = af; ADf[1024 + (mt * 16 + (j & 15)) * 16 + (i & 15)] = ab; } }
                  else QKp[i * 72 + j] = f2bf1(i == j ? acc[0][nt][r] : x); }
        }
        __syncthreads();
        { LAS bf16* Ab = Abf + half * 64 * 72; LAS bf16* Tr = Trm + half * 64 * 72; LAS bf16* Tt = Ttr + half * 64 * 72; LAS bf16* Xh = Xs + half * 32 * 40;
          if (w4 == 0) { const int blk = lane >> 4, cc = lane & 15; float t[16]; const LAS float* ad = ADf + half * 1024 + blk * 256;
#pragma unroll
              for (int i = 0; i < 16; ++i) t[i] = (i == cc) ? 1.f : 0.f;
#pragma unroll
              for (int i = 1; i < 16; ++i) { float s0 = 0.f, s1 = 0.f;
#pragma unroll
                  for (int j = 0; j < i; ++j) { if (j & 1) s1 += ad[i * 16 + j] * t[j]; else s0 += ad[i * 16 + j] * t[j]; }
                  t[i] = (i > cc) ? -(s0 + s1) : t[i];
                  if ((i & 3) == 3) asm volatile("" ::: "memory"); }
#pragma unroll
              for (int i = 0; i < 16; ++i) { const unsigned short tb = f2bf1(t[i]); Tr[(blk * 16 + i) * 72 + blk * 16 + cc] = tb; Tt[(blk * 16 + cc) * 72 + blk * 16 + i] = tb; } }
          __syncthreads();
          f32x4 a1[1][1];
          if (w4 < 2) { const int J = 2 * w4, I = J + 1; a1[0][0] = (f32x4){0.f, 0.f, 0.f, 0.f};
              mma_lds<1, 1>(a1, Ab + 16 * J, 72, 16 * I, Tt + 16 * J, 72, 16 * J, 32, fr, fq);
              u32x2 wv; wv.x = pkbf(a1[0][0][0], a1[0][0][1]); wv.y = pkbf(a1[0][0][2], a1[0][0][3]);
              *(LAS u32x2*)(Xh + (w4 * 16 + fr) * 40 + 4 * fq) = wv; }
          __syncthreads();
          if (w4 < 2) { const int J = 2 * w4, I = J + 1; a1[0][0] = (f32x4){0.f, 0.f, 0.f, 0.f};
              mma_lds<1, 1>(a1, Tr + 16 * I, 72, 16 * I, Xh, 40, w4 * 16, 32, fr, fq);
#pragma unroll
              for (int r = 0; r < 4; ++r) Tr[(16 * I + 4 * fq + r) * 72 + 16 * J + fr] = f2bf1(-a1[0][0][r]);
              u32x2 wv; wv.x = pkbf(-a1[0][0][0], -a1[0][0][1]); wv.y = pkbf(-a1[0][0][2], -a1[0][0][3]);
              *(LAS u32x2*)(Tt + (16 * J + fr) * 72 + 16 * I + 4 * fq) = wv; }
          __syncthreads();
          { const int mt2 = w4 >> 1, nt2 = w4 & 1; a1[0][0] = (f32x4){0.f, 0.f, 0.f, 0.f};
            mma_lds<1, 1>(a1, Ab, 72, 32 + 16 * mt2, Tt, 72, 16 * nt2, 32, fr, fq);
            u32x2 wv; wv.x = pkbf(a1[0][0][0], a1[0][0][1]); wv.y = pkbf(a1[0][0][2], a1[0][0][3]);
            __syncthreads();
            *(LAS u32x2*)(Xh + (16 * nt2 + fr) * 40 + 16 * mt2 + 4 * fq) = wv;
            __syncthreads();
            a1[0][0] = (f32x4){0.f, 0.f, 0.f, 0.f};
            mma_lds<1, 1>(a1, Tr + 32, 72, 32 + 16 * mt2, Xh, 40, 16 * nt2, 32, fr, fq);
#pragma unroll
            for (int r = 0; r < 4; ++r) Tr[(32 + 16 * mt2 + 4 * fq + r) * 72 + 16 * nt2 + fr] = f2bf1(-a1[0][0][r]);
            u32x2 w2; w2.x = pkbf(-a1[0][0][0], -a1[0][0][1]); w2.y = pkbf(-a1[0][0][2], -a1[0][0][3]);
            *(LAS u32x2*)(Tt + (16 * nt2 + fr) * 72 + 32 + 16 * mt2 + 4 * fq) = w2; }
        }
        __syncthreads();
        { bf16* tq = TQ + ((size_t)(bh * NCHUNK + c)) * 8192;
          for (int e = tid; e < 1024; e += 512) { const int which = e >> 9, i = (e >> 3) & 63, p = e & 7;
              if (which) *(GAS u32x4*)(tq + 4096 + i * 64 + p * 8) = *(const LAS u32x4*)(QKp + i * 72 + p * 8);
              else { const bf16x8 lo = *(const LAS bf16x8*)(Trm + i * 72 + p * 8), up = *(const LAS bf16x8*)(Ttr + 64 * 72 + i * 72 + p * 8); bf16x8 o8;
#pragma unroll
                  for (int y = 0; y < 8; ++y) { const int j = p * 8 + y; o8[y] = (i > j) ? lo[y] : (i < j ? up[y] : (short)0x3F80); }
                  *(GAS bf16x8*)(tq + i * 64 + p * 8) = o8; } } }
        __syncthreads();
    }
#undef PG2_LOAD
}

__device__ __forceinline__ void gdn_state_v1(LAS unsigned char* lds, int cid, const bf16* raw, const float* scal, const bf16* TQ,
                                             const float* A_log, const float* dt_bias, bf16* og, int tid, int wave, int lane) {
    using namespace gdn;
    const int dvh = cid & 1, dir = (cid >> 1) & 1, h = (cid >> 2) & 7, b = cid >> 5;
    const int fr = lane & 15, fq = lane >> 4;
    LAS float* sc = (LAS float*)(lds + SC);
    LAS bf16* q_ = (LAS bf16*)(lds + Q); LAS bf16* k_ = (LAS bf16*)(lds + K); LAS bf16* kdT = (LAS bf16*)(lds + KDT); LAS bf16* vT = (LAS bf16*)(lds + VT);
    LAS bf16* T_ = (LAS bf16*)(lds + T); LAS bf16* QKd = (LAS bf16*)(lds + QKD); LAS bf16* ST_ = (LAS bf16*)(lds + ST);
    LAS bf16* rT = (LAS bf16*)(lds + RT); LAS bf16* uT = (LAS bf16*)(lds + UT); LAS float* os = (LAS float*)(lds + OS);
    for (int e = tid; e < 64 * 136 / 2; e += 512) ((LAS unsigned*)ST_)[e] = 0u;
    const float expA = expf(A_log[dir * 8 + h]), dtb = dt_bias[dir * 8 + h];
    f32x4 sacc[4];
#pragma unroll
    for (int nt = 0; nt < 4; ++nt) sacc[nt] = (f32x4){0.f, 0.f, 0.f, 0.f};
    const size_t rowb = (size_t)b * SEQ; const int bh = b * 8 + h;
    __syncthreads();
    for (int n = 0; n < NCHUNK; ++n) {
        const int c = dir ? NCHUNK - 1 - n : n, t0 = c * 64;
        for (int e = tid; e < 64 * 16; e += 512) { const int r = e >> 4, p = e & 15;
            *(LAS u32x4*)(q_ + r * 136 + p * 8) = *(const GAS u32x4*)(raw + (rowb + t0 + r) * CONV_CH + h * 128 + p * 8);
            *(LAS u32x4*)(k_ + r * 136 + p * 8) = *(const GAS u32x4*)(raw + (rowb + t0 + r) * CONV_CH + 1024 + h * 128 + p * 8); }
        { const int dvl = tid >> 3, p = tid & 7; const int dv = dvh * 64 + dvl;
          *(LAS u32x4*)(vT + dvl * 72 + p * 8) = *(const GAS u32x4*)(raw + (rowb + t0 + (dv >> 1)) * CONV_CH + 2048 + h * 128 + (dv & 1) * 64 + p * 8); }
        { const bf16* tq = TQ + ((size_t)(bh * NCHUNK + c)) * 8192;
          for (int e = tid; e < 1024; e += 512) { const int which = e >> 9, i = (e >> 3) & 63, p = e & 7;
              bf16x8 v = *(const GAS bf16x8*)(tq + which * 4096 + i * 64 + p * 8);
#pragma unroll
              for (int x = 0; x < 8; ++x) { const int j = p * 8 + x; const bool keep = dir ? (i < j) : (i > j);
                  if (i == j) { if (which == 0) v[x] = (short)0x3F80; } else if (!keep) v[x] = 0; }
              *(LAS bf16x8*)((which ? QKd : T_) + i * 72 + p * 8) = v; } }
        if (wave == 0) { const int i = lane; const size_t so = (rowb + t0 + i) * 64;
            const float g = -expA * softplus_f(scal[so + 16 + dir * 8 + h] + dtb); float gc = g;
            if (dir == 0) {
#pragma unroll
                for (int o = 1; o < 64; o <<= 1) { const float y = __shfl_up(gc, o); if (i >= o) gc += y; }
            } else {
#pragma unroll
                for (int o = 1; o < 64; o <<= 1) { const float y = __shfl_down(gc, o); if (i + o < 64) gc += y; }
            }
            const float gl = __shfl(gc, dir ? 0 : 63);
            sc[i] = sigmoid_f(scal[so + dir * 8 + h]); sc[64 + i] = gc; sc[128 + i] = expf(gc); sc[192 + i] = expf(gl - gc); if (i == 0) sc[256] = expf(gl); }
        __syncthreads();
        { const int i = tid >> 3, cg = tid & 7; const float ek = sc[192 + i];
          const bf16x8 k0 = *(const LAS bf16x8*)(k_ + i * 136 + cg * 16), k1 = *(const LAS bf16x8*)(k_ + i * 136 + cg * 16 + 8);
#pragma unroll
          for (int x = 0; x < 8; ++x) { kdT[(cg * 16 + x) * 72 + i] = f2bf1(bf2f_s(k0[x]) * ek); kdT[(cg * 16 + 8 + x) * 72 + i] = f2bf1(bf2f_s(k1[x]) * ek); } }
        __syncthreads();
        const int mt = wave & 3, nh = wave >> 2;
        f32x4 aq[2];
        { f32x4 ak[2]; ak[0] = ak[1] = aq[0] = aq[1] = (f32x4){0.f, 0.f, 0.f, 0.f};
          for (int k0 = 0; k0 < 128; k0 += 32) {
              const bf16x8 fk = *(const LAS bf16x8*)(k_ + (mt * 16 + fr) * 136 + k0 + fq * 8), fqv = *(const LAS bf16x8*)(q_ + (mt * 16 + fr) * 136 + k0 + fq * 8);
#pragma unroll
              for (int nl = 0; nl < 2; ++nl) { const bf16x8 fb = *(const LAS bf16x8*)(ST_ + (nh * 32 + nl * 16 + fr) * 136 + k0 + fq * 8);
                  ak[nl] = __builtin_amdgcn_mfma_f32_16x16x32_bf16(fk, fb, ak[nl], 0, 0, 0); aq[nl] = __builtin_amdgcn_mfma_f32_16x16x32_bf16(fqv, fb, aq[nl], 0, 0, 0); } }
          const int i0 = mt * 16 + 4 * fq;
          const f32x4 be4 = *(const LAS f32x4*)(sc + i0), eg4 = *(const LAS f32x4*)(sc + 128 + i0);
#pragma unroll
          for (int nl = 0; nl < 2; ++nl) { const int dv = nh * 32 + nl * 16 + fr;
              const bf16x4 vv = *(const LAS bf16x4*)(vT + dv * 72 + i0);
              float r0 = be4[0] * (bf2f_s(vv[0]) - eg4[0] * ak[nl][0]), r1 = be4[1] * (bf2f_s(vv[1]) - eg4[1] * ak[nl][1]);
              float r2 = be4[2] * (bf2f_s(vv[2]) - eg4[2] * ak[nl][2]), r3 = be4[3] * (bf2f_s(vv[3]) - eg4[3] * ak[nl][3]);
              u32x2 w; w.x = pkbf(r0, r1); w.y = pkbf(r2, r3); *(LAS u32x2*)(rT + dv * 72 + i0) = w;
              aq[nl][0] *= eg4[0]; aq[nl][1] *= eg4[1]; aq[nl][2] *= eg4[2]; aq[nl][3] *= eg4[3]; }
        }
        __syncthreads();
        { f32x4 au[1][2]; au[0][0] = au[0][1] = (f32x4){0.f, 0.f, 0.f, 0.f};
          mma_lds<1, 2>(au, T_, 72, mt * 16, rT, 72, nh * 32, 64, fr, fq);
          const int i0 = mt * 16 + 4 * fq;
#pragma unroll
          for (int nl = 0; nl < 2; ++nl) { const int dv = nh * 32 + nl * 16 + fr; u32x2 w; w.x = pkbf(au[0][nl][0], au[0][nl][1]); w.y = pkbf(au[0][nl][2], au[0][nl][3]); *(LAS u32x2*)(uT + dv * 72 + i0) = w; }
        }
        __syncthreads();
        { f32x4 ao[1][2]; ao[0][0] = aq[0]; ao[0][1] = aq[1];
          mma_lds<1, 2>(ao, QKd, 72, mt * 16, uT, 72, nh * 32, 64, fr, fq);
          const int i0 = mt * 16 + 4 * fq;
#pragma unroll
          for (int nl = 0; nl < 2; ++nl)
#pragma unroll
              for (int r = 0; r < 4; ++r) os[(i0 + r) * 65 + nh * 32 + nl * 16 + fr] = ao[0][nl][r];
          const float egl = sc[256];
          f32x4 as_[1][4];
#pragma unroll
          for (int nt = 0; nt < 4; ++nt) as_[0][nt] = sacc[nt] * egl;
          mma_lds<1, 4>(as_, kdT, 72, wave * 16, uT, 72, 0, 64, fr, fq);
#pragma unroll
          for (int nt = 0; nt < 4; ++nt) { sacc[nt] = as_[0][nt];
              u32x2 w; w.x = pkbf(sacc[nt][0], sacc[nt][1]); w.y = pkbf(sacc[nt][2], sacc[nt][3]); *(LAS u32x2*)(ST_ + (nt * 16 + fr) * 136 + wave * 16 + 4 * fq) = w; }
        }
        __syncthreads();
#pragma unroll
        for (int ii = 0; ii < 4; ++ii) { const int i = wave * 8 + 2 * ii + (lane >> 5), cp = lane & 31;
            atomic_add_bf16x2(og + (rowb + t0 + i) * 1024 + h * 128 + dvh * 64 + 2 * cp, os[i * 65 + 2 * cp], os[i * 65 + 2 * cp + 1]); }
        __syncthreads();
    }
}
typedef float f32x16 __attribute__((ext_vector_type(16)));
typedef short v4i16_t __attribute__((ext_vector_type(4)));
namespace gs2 {
constexpr int KO = 0;
constexpr int QO = KO + 64 * 132 * 2;
constexpr int VTO = QO + 64 * 132 * 2;
constexpr int TO = VTO + 64 * 68 * 2;
constexpr int QKO = TO + 64 * 68 * 2;
constexpr int SCO = QKO + 64 * 68 * 2;
constexpr int BUF = SCO + 1024;
constexpr int OST = 2 * BUF;
constexpr int END = OST + 64 * 72 * 2;
static_assert(END <= MISC_OFF && BUF % 16 == 0, "gdn state LDS map");
}
__device__ __forceinline__ bf16x8 cvt8(const f32x16& x, int base) {
    u32x4 w; w.x = pkbf(x[base], x[base + 1]); w.y = pkbf(x[base + 2], x[base + 3]); w.z = pkbf(x[base + 4], x[base + 5]); w.w = pkbf(x[base + 6], x[base + 7]);
    return __builtin_bit_cast(bf16x8, w);
}
__device__ __forceinline__ bf16x8 afrag(const LAS bf16* p) {
    const bf16x4 lo = *(const LAS bf16x4*)p, hi = *(const LAS bf16x4*)(p + 8);
    return (bf16x8){lo[0], lo[1], lo[2], lo[3], hi[0], hi[1], hi[2], hi[3]};
}
__device__ __forceinline__ bf16x8 afrag_tr(const LAS bf16* p, int ld) {
    const v4i16_t lo = __builtin_amdgcn_ds_read_tr16_b64_v4i16((LAS v4i16_t*)p), hi = __builtin_amdgcn_ds_read_tr16_b64_v4i16((LAS v4i16_t*)(p + 8 * ld));
    return (bf16x8){lo[0], lo[1], lo[2], lo[3], hi[0], hi[1], hi[2], hi[3]};
}
#define MFMA32(a, b, c) __builtin_amdgcn_mfma_f32_32x32x16_bf16((a), (b), (c), 0, 0, 0)

#ifndef WG_BAR
#define WG_BAR() asm volatile("s_waitcnt lgkmcnt(0)\n\ts_barrier" ::: "memory")
#endif
template <int DIR>
__device__ __forceinline__ void gdn_state2(LAS unsigned char* lds, int b, int h, int half, const bf16* raw, const float* scal, const bf16* TQ,
                                           const float* A_log, const float* dt_bias, bf16* og, int tid, int wave, int lane, float* probe = nullptr) {
    using namespace gs2;
    const size_t rowb = (size_t)b * SEQ; const int bh = b * 8 + h;
    const float expA = expf(A_log[DIR * 8 + h]), dtb = dt_bias[DIR * 8 + h];
    LAS bf16* ost = (LAS bf16*)(lds + OST);
    const int r31 = lane & 31, hh = lane >> 5;
    if (wave == 4 || wave == 5) {
        for (int n = 0; n < 2 * NCHUNK + 1; ++n) WG_BAR();
    } else if (wave >= 2) {
        const int hw = (wave & 1) | ((wave >> 2) << 1);
        const int ht = hw * 64 + lane;
        unsigned go[14], lo_[14]; u32x4 ld[14]; float sr0 = 0.f, sr1 = 0.f;
#pragma unroll
        for (int x = 0; x < 4; ++x) { const int e = ht + 256 * x, r = e >> 4, p = e & 15;
            go[x] = (unsigned)((r * CONV_CH + 1024 + h * 128 + p * 8) * 2); go[4 + x] = (unsigned)((r * CONV_CH + h * 128 + p * 8) * 2);
            lo_[x] = (unsigned)(KO + (r * 132 + p * 8) * 2); lo_[4 + x] = (unsigned)(QO + (r * 132 + p * 8) * 2); }
#pragma unroll
        for (int x = 0; x < 2; ++x) { const int e = ht + 256 * x, dvl = e >> 3, p = e & 7; const int dv = 64 * half + dvl;
            go[8 + x] = (unsigned)(((dv >> 1) * CONV_CH + 2048 + h * 128 + (dv & 1) * 64 + p * 8) * 2); lo_[8 + x] = (unsigned)(VTO + (dvl * 68 + p * 8) * 2); }
        u32x4 km[2], dg[2], qm[2];
#pragma unroll
        for (int x = 0; x < 2; ++x) { const int e = ht + 256 * x, i = e >> 3, p = e & 7;
            go[10 + x] = (unsigned)(e * 16); go[12 + x] = (unsigned)(8192 + e * 16);
            lo_[10 + x] = (unsigned)(TO + (i * 68 + p * 8) * 2); lo_[12 + x] = (unsigned)(QKO + (i * 68 + p * 8) * 2);
            unsigned kw[4], dw[4], qw[4];
#pragma unroll
            for (int w = 0; w < 4; ++w) { const int j0 = p * 8 + 2 * w, j1 = j0 + 1;
                const bool k0 = DIR ? (i < j0) : (i > j0), k1 = DIR ? (i < j1) : (i > j1);
                kw[w] = (k0 ? 0xFFFFu : 0u) | (k1 ? 0xFFFF0000u : 0u); dw[w] = (i == j0 ? 0x3F80u : 0u) | (i == j1 ? 0x3F800000u : 0u);
                qw[w] = kw[w] | (i == j0 ? 0xFFFFu : 0u) | (i == j1 ? 0xFFFF0000u : 0u); }
            km[x] = (u32x4){kw[0], kw[1], kw[2], kw[3]}; dg[x] = (u32x4){dw[0], dw[1], dw[2], dw[3]}; qm[x] = (u32x4){qw[0], qw[1], qw[2], qw[3]}; }
        const unsigned so_l = (unsigned)(lane * 256 + (DIR * 8 + h) * 4);
#define GS2_ISSUE(c_) do { const GAS char* rb_ = (const GAS char*)(raw + (rowb + (size_t)(c_) * 64) * CONV_CH); const GAS char* tb_ = (const GAS char*)(TQ + ((size_t)(bh * NCHUNK + (c_))) * 8192); \
            _Pragma("unroll") for (int x = 0; x < 10; ++x) ld[x] = *(const GAS u32x4*)(rb_ + go[x]); \
            _Pragma("unroll") for (int x = 10; x < 14; ++x) ld[x] = *(const GAS u32x4*)(tb_ + go[x]); \
            if (hw == 0) { const GAS char* sb_ = (const GAS char*)(scal + (rowb + (size_t)(c_) * 64) * 64); sr0 = *(const GAS float*)(sb_ + so_l); sr1 = *(const GAS float*)(sb_ + so_l + 64); } } while (0)
#define GS2_ST16(off_, v_) do { LAS unsigned char* d_ = B_ + (off_); *(LAS u32x2*)(d_) = (u32x2){(v_).x, (v_).y}; *(LAS u32x2*)(d_ + 8) = (u32x2){(v_).z, (v_).w}; } while (0)
#define GS2_COMMIT(bi_, c_) do { LAS unsigned char* B_ = lds + (bi_) * BUF; \
            _Pragma("unroll") for (int x = 0; x < 10; ++x) GS2_ST16(lo_[x], ld[x]); \
            _Pragma("unroll") for (int x = 0; x < 2; ++x) { const u32x4 tv = (ld[10 + x] & km[x]) | dg[x], qv = ld[12 + x] & qm[x]; \
                GS2_ST16(lo_[10 + x], tv); GS2_ST16(lo_[12 + x], qv); } \
            if (hw == 0) { LAS float* sc_ = (LAS float*)(B_ + SCO); const int i = lane; const float gc = sr1; const float gl = __shfl(gc, DIR ? 0 : 63); \
                sc_[i] = sr0; sc_[64 + i] = __expf(gc); sc_[128 + i] = __expf(gl - gc); if (i == 0) sc_[192] = __expf(gl); } } while (0)
        { const int c0 = DIR ? NCHUNK - 1 : 0; GS2_ISSUE(c0); GS2_COMMIT(0, c0); GS2_ISSUE((DIR ? c0 - 1 : c0 + 1)); }
        for (int n = 0; n < NCHUNK; ++n) {
            const int c = DIR ? NCHUNK - 1 - n : n;
            WG_BAR();
            const bool more = n + 1 < NCHUNK; const int cn = DIR ? c - 1 : c + 1;
            if (more) { GS2_COMMIT((n + 1) & 1, cn); if (n + 2 < NCHUNK) GS2_ISSUE((DIR ? cn - 1 : cn + 1)); }
            unsigned ov[8];
            if (n > 0) {
#pragma unroll
                for (int x = 0; x < 8; ++x) ov[x] = *(const LAS unsigned*)(ost + (hw * 16 + 2 * x + (lane >> 5)) * 72 + 2 * (lane & 31));
            }
            WG_BAR();
            if (n > 0) { const int tp = (DIR ? c + 1 : c - 1) * 64;
#pragma unroll
                for (int x = 0; x < 8; ++x) { GAS char* ob_ = (GAS char*)(og + (rowb + tp + hw * 16 + 2 * x) * 1024 + h * 128 + half * 64);
                    (void)__builtin_amdgcn_global_atomic_fadd_v2bf16((GAS s16x2*)(ob_ + (lane >> 5) * 2048 + (lane & 31) * 4), __builtin_bit_cast(s16x2, ov[x])); } }
        }
        WG_BAR();
        { const int tp = (DIR ? 0 : NCHUNK - 1) * 64;
#pragma unroll
          for (int x = 0; x < 8; ++x) { const unsigned v = *(const LAS unsigned*)(ost + (hw * 16 + 2 * x + (lane >> 5)) * 72 + 2 * (lane & 31));
              GAS char* ob_ = (GAS char*)(og + (rowb + tp + hw * 16 + 2 * x) * 1024 + h * 128 + half * 64);
              (void)__builtin_amdgcn_global_atomic_fadd_v2bf16((GAS s16x2*)(ob_ + (lane >> 5) * 2048 + (lane & 31) * 4), __builtin_bit_cast(s16x2, v)); } }
#undef GS2_ISSUE
#undef GS2_COMMIT
#undef GS2_ST16
    } else {
        const int dv0 = 32 * wave;
#if defined(PROBE_STATE)
        unsigned long long tw_ = 0ull; const unsigned long long ts0_ = __builtin_amdgcn_s_memtime();
#define PB_BAR() do { const unsigned long long t0_ = __builtin_amdgcn_s_memtime(); WG_BAR(); tw_ += __builtin_amdgcn_s_memtime() - t0_; } while (0)
#else
#define PB_BAR() WG_BAR()
#endif
        f32x16 St[4];
#pragma unroll
        for (int t = 0; t < 4; ++t)
#pragma unroll
            for (int r = 0; r < 16; ++r) St[t][r] = 0.f;
        for (int n = 0; n < NCHUNK; ++n) {
            PB_BAR();
            const LAS unsigned char* Bb = lds + (n & 1) * BUF;
            const LAS bf16* Kb = (const LAS bf16*)(Bb + KO); const LAS bf16* Qb = (const LAS bf16*)(Bb + QO); const LAS bf16* Vb = (const LAS bf16*)(Bb + VTO);
            const LAS bf16* Tb = (const LAS bf16*)(Bb + TO); const LAS bf16* QKb = (const LAS bf16*)(Bb + QKO); const LAS float* sc = (const LAS float*)(Bb + SCO);
            f32x16 aK[2];
#pragma unroll
            for (int m = 0; m < 2; ++m)
#pragma unroll
                for (int r = 0; r < 16; ++r) aK[m][r] = 0.f;
            bf16x8 fa[2][2];
            const int offk = r31 * 132 + 4 * hh;
#define GS2_LD2(P_, bi_, ks_) do { fa[bi_][0] = afrag((P_) + offk + 16 * (ks_)); fa[bi_][1] = afrag((P_) + offk + 32 * 132 + 16 * (ks_)); } while (0)
            GS2_LD2(Kb, 0, 0);
#pragma unroll
            for (int ks = 0; ks < 8; ++ks) {
                if (ks < 7) GS2_LD2(Kb, (ks + 1) & 1, ks + 1);
                __builtin_amdgcn_sched_barrier(0);
                const bf16x8 bs = cvt8(St[ks >> 1], 8 * (ks & 1));
                aK[0] = MFMA32(fa[ks & 1][0], bs, aK[0]); aK[1] = MFMA32(fa[ks & 1][1], bs, aK[1]);
                __builtin_amdgcn_sched_barrier(0); }
            bf16x8 ft[8];
#pragma unroll
            for (int mi = 0; mi < 2; ++mi)
#pragma unroll
                for (int kt = 0; kt < 4; ++kt) { const bool need = DIR ? (kt >= 2 * mi) : (kt <= 2 * mi + 1);
                    if (need) ft[mi * 4 + kt] = afrag(Tb + (32 * mi + r31) * 68 + 16 * kt + 4 * hh); }
#pragma unroll
            for (int m = 0; m < 2; ++m)
#pragma unroll
                for (int q4 = 0; q4 < 4; ++q4) { const int tb = 32 * m + 8 * q4 + 4 * hh;
                    const bf16x4 vv = *(const LAS bf16x4*)(Vb + (dv0 + r31) * 68 + tb); const f32x4 be = *(const LAS f32x4*)(sc + tb), eg = *(const LAS f32x4*)(sc + 64 + tb);
#pragma unroll
                    for (int e = 0; e < 4; ++e) aK[m][4 * q4 + e] = be[e] * (bf2f_s(vv[e]) - eg[e] * aK[m][4 * q4 + e]); }
            const bf16x8 br0 = cvt8(aK[0], 0), br1 = cvt8(aK[0], 8), br2 = cvt8(aK[1], 0), br3 = cvt8(aK[1], 8);
            __builtin_amdgcn_sched_barrier(0);
            f32x16 au[2];
#pragma unroll
            for (int m = 0; m < 2; ++m)
#pragma unroll
                for (int r = 0; r < 16; ++r) au[m][r] = 0.f;
            GS2_LD2(Qb, 0, 0);
#pragma unroll
            for (int mi = 0; mi < 2; ++mi)
#pragma unroll
                for (int kt = 0; kt < 4; ++kt) { const bool need = DIR ? (kt >= 2 * mi) : (kt <= 2 * mi + 1);
                    if (need) au[mi] = MFMA32(ft[mi * 4 + kt], (kt == 0 ? br0 : kt == 1 ? br1 : kt == 2 ? br2 : br3), au[mi]); }
            __builtin_amdgcn_sched_barrier(0);
            f32x16 aQ[2];
#pragma unroll
            for (int m = 0; m < 2; ++m)
#pragma unroll
                for (int r = 0; r < 16; ++r) aQ[m][r] = 0.f;
#pragma unroll
            for (int ks = 0; ks < 8; ++ks) {
                if (ks < 7) GS2_LD2(Qb, (ks + 1) & 1, ks + 1);
                __builtin_amdgcn_sched_barrier(0);
                const bf16x8 bs = cvt8(St[ks >> 1], 8 * (ks & 1));
                aQ[0] = MFMA32(fa[ks & 1][0], bs, aQ[0]); aQ[1] = MFMA32(fa[ks & 1][1], bs, aQ[1]);
                __builtin_amdgcn_sched_barrier(0); }
#undef GS2_LD2
            const bf16x8 bu0 = cvt8(au[0], 0), bu1 = cvt8(au[0], 8), bu2 = cvt8(au[1], 0), bu3 = cvt8(au[1], 8);
#pragma unroll
            for (int m = 0; m < 2; ++m)
#pragma unroll
                for (int q4 = 0; q4 < 4; ++q4) { const int tb = 32 * m + 8 * q4 + 4 * hh; const f32x4 ek = *(const LAS f32x4*)(sc + 128 + tb), eg = *(const LAS f32x4*)(sc + 64 + tb);
#pragma unroll
                    for (int e = 0; e < 4; ++e) { au[m][4 * q4 + e] *= ek[e]; aQ[m][4 * q4 + e] *= eg[e]; } }
            const bf16x8 bd0 = cvt8(au[0], 0), bd1 = cvt8(au[0], 8), bd2 = cvt8(au[1], 0), bd3 = cvt8(au[1], 8);
            __builtin_amdgcn_sched_barrier(0);
            bf16x8 fqk[8];
#pragma unroll
            for (int mi = 0; mi < 2; ++mi)
#pragma unroll
                for (int kt = 0; kt < 4; ++kt) { const bool need = DIR ? (kt >= 2 * mi) : (kt <= 2 * mi + 1);
                    if (need) fqk[mi * 4 + kt] = afrag(QKb + (32 * mi + r31) * 68 + 16 * kt + 4 * hh); }
            const int i16 = r31 & 15; const LAS bf16* kp = Kb + (4 * hh + (i16 >> 2)) * 132 + 16 * (r31 >> 4) + 4 * (i16 & 3);
            bf16x8 fk[2][4];
#define GS2_LDKT(bi_, t_) do { _Pragma("unroll") for (int kt = 0; kt < 4; ++kt) fk[bi_][kt] = afrag_tr(kp + (16 * kt) * 132 + 32 * (t_), 132); } while (0)
            __builtin_amdgcn_sched_barrier(0);
#pragma unroll
            for (int mi = 0; mi < 2; ++mi)
#pragma unroll
                for (int kt = 0; kt < 4; ++kt) { const bool need = DIR ? (kt >= 2 * mi) : (kt <= 2 * mi + 1);
                    if (need) aQ[mi] = MFMA32(fqk[mi * 4 + kt], (kt == 0 ? bu0 : kt == 1 ? bu1 : kt == 2 ? bu2 : bu3), aQ[mi]); }
            GS2_LDKT(0, 0);
            const float egl = sc[192];
            PB_BAR();
#pragma unroll
            for (int mi = 0; mi < 2; ++mi)
#pragma unroll
                for (int r = 0; r < 16; ++r) ost[(32 * mi + (r & 3) + 8 * (r >> 2) + 4 * hh) * 72 + dv0 + r31] = f2bf1(aQ[mi][r]);
#pragma unroll
            for (int t = 0; t < 4; ++t) {
                if (t < 3) GS2_LDKT((t + 1) & 1, t + 1);
                __builtin_amdgcn_sched_barrier(0);
#pragma unroll
                for (int r = 0; r < 16; ++r) St[t][r] *= egl;
                St[t] = MFMA32(fk[t & 1][0], bd0, St[t]); St[t] = MFMA32(fk[t & 1][1], bd1, St[t]);
                St[t] = MFMA32(fk[t & 1][2], bd2, St[t]); St[t] = MFMA32(fk[t & 1][3], bd3, St[t]);
                __builtin_amdgcn_sched_barrier(0); }
#undef GS2_LDKT
        }
        WG_BAR();
#if defined(PROBE_STATE)
        if (blockIdx.x == 0 && tid == 0 && probe) { const unsigned long long tt_ = __builtin_amdgcn_s_memtime() - ts0_; *probe = (float)((double)tw_ / (double)tt_); }
#endif
    }
}
constexpr size_t WS_SSC = 1 * MiB;
namespace psd {
constexpr int CW = 0;
constexpr int SC = CW + 8 * 768 * 4;
constexpr int BM_ = SC + 8 * 4 * 64 * 4;
constexpr int CM_ = BM_ + 64 * 136 * 2;
constexpr int CB = CM_ + 64 * 136 * 2;
constexpr int R = CB + 64 * 68 * 4;
constexpr int RBC = R, RBC_END = R + 70 * 272 * 2;
constexpr int RX = R, XT = RX + 70 * 136 * 2, MM = XT + 128 * 72 * 2, R_END = MM + 2 * 64 * 72 * 2;
constexpr int YST = RX;
constexpr int PRBC = CW + 8 * 768 * 4, PXT = PRBC + 70 * 272 * 2, P_END = PXT + 256 * 72 * 2;
constexpr int STASH = pgd::STASH + 4608;
static_assert(P_END <= pgd::STASH, "prep ssd conv LDS map");
static_assert(RBC_END <= pgd::STASH && R_END <= pgd::STASH && STASH + 9216 <= MISC_OFF, "prep ssd LDS map");
}
__device__ __forceinline__ void prep_ssd_stash(LAS unsigned char* lds, int bid, const bf16* raw, int tid) {
    const int bg = bid >> 5, b = bg >> 1, g = bg & 1, r32 = bid & 31;
    LAS bf16* st = (LAS bf16*)(lds + psd::STASH);
    for (int e = tid; e < 2 * 3 * 96; e += 512) { const int which = e / 288, r = (e % 288) / 96, p = e % 96;
        const int t = which ? (r32 * 4 + 4) * 64 + r : r32 * 4 * 64 - 3 + r;
        const int col = p < 64 ? 3072 + g * 512 + p * 8 : (p < 80 ? 4096 + g * 128 + (p - 64) * 8 : 4352 + g * 128 + (p - 80) * 8);
        u32x4 v = (u32x4){0u, 0u, 0u, 0u};
        if (t >= 0 && t < SEQ) v = *(const GAS u32x4*)(raw + ((size_t)b * SEQ + t) * CONV_CH + col);
        *(LAS u32x4*)(st + which * 2304 + r * 768 + p * 8) = v; }
}
__device__ __forceinline__ void prep_ssd_range(LAS unsigned char* lds, int bid, bf16* raw, const float* conv_w, const float* conv_b, int tid_p,
                                               const float* scal, const float* A_log, const float* dt_bias, float* ssc) {
    using namespace psd;
    const int bg = bid >> 5, b = bg >> 1, g = bg & 1, r32 = bid & 31;
    LAS float* cw = (LAS float*)(lds + CW);
    LAS bf16* rbc = (LAS bf16*)(lds + PRBC); LAS bf16* xT = (LAS bf16*)(lds + PXT);
    LAS bf16* st = (LAS bf16*)(lds + STASH);
    for (int e = tid_p; e < 8 * 768; e += 512) { const int r = e / 768, c = e % 768;
        const int gch = c < 512 ? 3072 + g * 512 + c : (c < 640 ? 4096 + g * 128 + (c - 512) : 4352 + g * 128 + (c - 640));
        cw[e] = r < 7 ? conv_w[r * CONV_CH + gch] : conv_b[gch]; }
    const size_t rowb = (size_t)b * SEQ;
    __syncthreads();
    for (int u = 0; u < 4; ++u) {
        int tid = tid_p; asm volatile("" : "+v"(tid));
        const int lane = tid & 63, wave = __builtin_amdgcn_readfirstlane(tid >> 6);
        const int c = r32 * 4 + u, t0 = c * 64;
        { const int hd = g * 8 + wave, i = lane; const size_t so = (rowb + t0 + i) * 64;
          const float dtf = softplus_f(scal[so + 32 + hd] + dt_bias[hd]), dtb = softplus_f(scal[so + 48 + hd] + dt_bias[16 + hd]);
          float cf = dtf * -expf(A_log[hd]), cbk = dtb * -expf(A_log[16 + hd]);
#pragma unroll
          for (int o = 1; o < 64; o <<= 1) { const float y = __shfl_up(cf, o), z = __shfl_down(cbk, o); if (i >= o) cf += y; if (i + o < 64) cbk += z; }
          float* sp = ssc + ((size_t)((b * 16 + hd) * NCHUNK + c)) * 256 + i; sp[0] = dtf; sp[64] = cf; sp[128] = dtb; sp[192] = cbk; }
        for (int ps = 0; ps < 3; ++ps) {
            const int scol = ps == 0 ? 512 : (ps == 1 ? 0 : 256);
            const int gcol = ps == 0 ? 4096 + g * 128 : 3072 + g * 512 + (ps - 1) * 256;
            for (int e = tid; e < 70 * 32; e += 512) { const int r = e >> 5, p = e & 31;
                u32x4 v;
                if (r < 3) v = *(const LAS u32x4*)(st + r * 768 + scol + p * 8);
                else if (r >= 67 && u == 3) v = *(const LAS u32x4*)(st + 2304 + (r - 67) * 768 + scol + p * 8);
                else { const int col = ps == 0 ? (p < 16 ? 4096 + g * 128 + p * 8 : 4352 + g * 128 + (p - 16) * 8) : gcol + p * 8;
                       v = *(const GAS u32x4*)(raw + (rowb + t0 - 3 + r) * CONV_CH + col); }
                *(LAS u32x4*)(rbc + r * 272 + (p < 16 ? p * 8 : 136 + (p - 16) * 8)) = v; }
            __syncthreads();
            if (tid < 96) { const int r = tid >> 5, p = tid & 31;
                *(LAS u32x4*)(st + r * 768 + scol + p * 8) = *(const LAS u32x4*)(rbc + (64 + r) * 272 + (p < 16 ? p * 8 : 136 + (p - 16) * 8)); }
            { const int tg = wave, cp = lane; float w[16], o[16];
#pragma unroll
              for (int hf = 0; hf < 2; ++hf) {
#pragma unroll
                  for (int tap = 0; tap < 8; ++tap) { w[2 * tap] = cw[tap * 768 + scol + hf * 128 + 2 * cp]; w[2 * tap + 1] = cw[tap * 768 + scol + hf * 128 + 2 * cp + 1]; }
                  conv_pair8(o, rbc + (8 * tg) * 272 + hf * 136 + 2 * cp, 272, w);
#pragma unroll
                  for (int t = 0; t < 16; ++t) o[t] = silu(o[t]);
                  if (ps == 0) {
#pragma unroll
                      for (int t = 0; t < 8; ++t) *(GAS unsigned*)(raw + (rowb + t0 + 8 * tg + t) * CONV_CH + (hf ? 4352 : 4096) + g * 128 + 2 * cp) = pkbf(o[2 * t], o[2 * t + 1]);
                  } else {
                      u32x4 e0, e1; e0.x = pkbf(o[0], o[2]); e0.y = pkbf(o[4], o[6]); e0.z = pkbf(o[8], o[10]); e0.w = pkbf(o[12], o[14]);
                      e1.x = pkbf(o[1], o[3]); e1.y = pkbf(o[5], o[7]); e1.z = pkbf(o[9], o[11]); e1.w = pkbf(o[13], o[15]);
                      *(LAS u32x4*)(xT + (hf * 128 + 2 * cp) * 72 + 8 * tg) = e0; *(LAS u32x4*)(xT + (hf * 128 + 2 * cp + 1) * 72 + 8 * tg) = e1; } } }
            __syncthreads();
            if (ps > 0) {
                for (int e = tid; e < 256 * 8; e += 512) { const int xr = e >> 3, p = e & 7; const int hl = (ps - 1) * 4 + (xr >> 6), pp = xr & 63;
                    *(GAS u32x4*)(raw + (rowb + t0 + pp) * CONV_CH + 3072 + (g * 8 + hl) * 64 + p * 8) = *(const LAS u32x4*)(xT + xr * 72 + p * 8); }
                __syncthreads(); }
        }
    }
}
__device__ __forceinline__ void ssd_intra_range(LAS unsigned char* lds, int bid, const bf16* raw, const float* ssc, const float* Dp, bf16* yi, int tid_p) {
    using namespace psd;
    const int bg = bid >> 5, b = bg >> 1, g = bg & 1, r32 = bid & 31;
    LAS float* sc = (LAS float*)(lds + SC);
    LAS bf16* Bm = (LAS bf16*)(lds + BM_); LAS bf16* Cm = (LAS bf16*)(lds + CM_); LAS float* cb = (LAS float*)(lds + CB);
    LAS bf16* xT = (LAS bf16*)(lds + XT); LAS bf16* Mm = (LAS bf16*)(lds + MM); LAS bf16* yst = (LAS bf16*)(lds + YST);
    const size_t rowb = (size_t)b * SEQ;
    for (int u = 0; u < 4; ++u) {
        int tid = tid_p; asm volatile("" : "+v"(tid));
        const int lane = tid & 63, wave = __builtin_amdgcn_readfirstlane(tid >> 6), fr = lane & 15, fq = lane >> 4;
        const int c = r32 * 4 + u, t0 = c * 64;
        const int hd_w = g * 8 + wave;
        for (int e = tid; e < 64 * 32; e += 512) { const int r = e >> 5, p = e & 31;
            const u32x4 v = *(const GAS u32x4*)(raw + (rowb + t0 + r) * CONV_CH + (p < 16 ? 4096 + g * 128 + p * 8 : 4352 + g * 128 + (p - 16) * 8));
            *(LAS u32x4*)((p < 16 ? Bm + r * 136 + p * 8 : Cm + r * 136 + (p - 16) * 8)) = v; }
        { const int i = lane; const float* sp = ssc + ((size_t)((b * 16 + hd_w) * NCHUNK + c)) * 256 + i;
          LAS float* s = sc + wave * 256; s[i] = sp[0]; s[64 + i] = sp[64] * 1.4426950408889634f; s[128 + i] = sp[128]; s[192 + i] = sp[192] * 1.4426950408889634f; }
        __syncthreads();
        { const int mt = wave & 3, nh = wave >> 2;
          f32x4 acc[1][2]; acc[0][0] = acc[0][1] = (f32x4){0.f, 0.f, 0.f, 0.f};
          mma_lds<1, 2>(acc, Cm, 136, mt * 16, Bm, 136, nh * 32, 128, fr, fq);
#pragma unroll
          for (int nl = 0; nl < 2; ++nl)
#pragma unroll
              for (int r = 0; r < 4; ++r) cb[(mt * 16 + 4 * fq + r) * 68 + nh * 32 + nl * 16 + fr] = acc[0][nl][r]; }
        for (int hp = 0; hp < 4; ++hp) {
            __syncthreads();
            for (int e = tid; e < 128 * 8; e += 512) { const int xr = e >> 3, p = e & 7; const int hl = 2 * hp + (xr >> 6), pp = xr & 63;
                *(LAS u32x4*)(xT + xr * 72 + p * 8) = *(const GAS u32x4*)(raw + (rowb + t0 + pp) * CONV_CH + 3072 + (g * 8 + hl) * 64 + p * 8); }
            { const int e = tid >> 8, i = (tid >> 2) & 63, jq = tid & 3; const int hl = 2 * hp + e;
              const LAS float* s = sc + hl * 256; const float Dh = Dp[g * 8 + hl];
              const float csfi = s[64 + i], csbi = s[192 + i], dsum = s[i] + s[128 + i];
#pragma unroll
              for (int jj = 0; jj < 16; jj += 2) { float m2[2];
#pragma unroll
                  for (int y = 0; y < 2; ++y) { const int j = jq * 16 + jj + y; const float cbv = cb[i * 68 + j];
                      const float arg = (i > j) ? csfi - s[64 + j] : csbi - s[192 + j];
                      const float dtj = (i > j) ? s[j] : s[128 + j];
                      const float w = (i == j) ? dsum : __builtin_amdgcn_exp2f(fminf(arg, 0.f)) * dtj;
                      m2[y] = cbv * w + ((i == j) ? Dh : 0.f); }
                  *(LAS unsigned*)(Mm + (e * 64 + i) * 72 + jq * 16 + jj) = pkbf(m2[0], m2[1]); } }
            __syncthreads();
            { const int e = wave >> 2, mt = wave & 3;
              f32x4 acc[1][4];
#pragma unroll
              for (int nt = 0; nt < 4; ++nt) acc[0][nt] = (f32x4){0.f, 0.f, 0.f, 0.f};
              mma_lds<1, 4>(acc, xT + e * 64 * 72, 72, mt * 16, Mm + e * 64 * 72, 72, 0, 64, fr, fq);
#pragma unroll
              for (int nt = 0; nt < 4; ++nt) { u32x2 w; w.x = pkbf(acc[0][nt][0], acc[0][nt][1]); w.y = pkbf(acc[0][nt][2], acc[0][nt][3]);
                  *(LAS u32x2*)(yst + (nt * 16 + fr) * 136 + e * 64 + mt * 16 + 4 * fq) = w; } }
            __syncthreads();
            for (int e = tid; e < 64 * 16; e += 512) { const int i = e >> 4, p = e & 15;
                *(GAS u32x4*)(yi + (rowb + t0 + i) * 1024 + (g * 8 + 2 * hp) * 64 + p * 8) = *(const LAS u32x4*)(yst + i * 136 + p * 8); }
        }
        __syncthreads();
    }
}

namespace ss2 {
constexpr int CO = 0;
constexpr int BO = CO + 64 * 132 * 2;
constexpr int XO = BO + 64 * 132 * 2;
constexpr int SCO = XO + 64 * 72 * 2;
constexpr int BUF = SCO + 768;
constexpr int OST = 2 * BUF;
constexpr int END = OST + 64 * 72 * 2;
static_assert(END <= MISC_OFF && BUF % 16 == 0, "ssd state LDS map");
}
template <int DIR>
__device__ __forceinline__ void ssd_state2(LAS unsigned char* lds, int b, int hd, const bf16* raw, const float* ssc, bf16* ys, int tid, int wave, int lane) {
    using namespace ss2;
    const size_t rowb = (size_t)b * SEQ; const int g = hd >> 3;
    LAS bf16* ost = (LAS bf16*)(lds + OST);
    const int r31 = lane & 31, hh = lane >> 5;
    if (wave == 4 || wave == 5) {
        for (int n = 0; n < 2 * NCHUNK + 1; ++n) WG_BAR();
    } else if (wave >= 2) {
        const int hw = (wave & 1) | ((wave >> 2) << 1); const int ht = hw * 64 + lane;
        unsigned go[10], lo_[10]; u32x4 ld[10]; float sr0 = 0.f, sr1 = 0.f;
#pragma unroll
        for (int x = 0; x < 4; ++x) { const int e = ht + 256 * x, r = e >> 4, p = e & 15;
            go[x] = (unsigned)((r * CONV_CH + 4352 + g * 128 + p * 8) * 2); go[4 + x] = (unsigned)((r * CONV_CH + 4096 + g * 128 + p * 8) * 2);
            lo_[x] = (unsigned)(CO + (r * 132 + p * 8) * 2); lo_[4 + x] = (unsigned)(BO + (r * 132 + p * 8) * 2); }
#pragma unroll
        for (int x = 0; x < 2; ++x) { const int e = ht + 256 * x, xr = e >> 3, p = e & 7;
            go[8 + x] = (unsigned)((xr * CONV_CH + 3072 + hd * 64 + p * 8) * 2); lo_[8 + x] = (unsigned)(XO + (xr * 72 + p * 8) * 2); }
#define SS2_ISSUE(c_) do { const GAS char* rb_ = (const GAS char*)(raw + (rowb + (size_t)(c_) * 64) * CONV_CH); \
            _Pragma("unroll") for (int x = 0; x < 10; ++x) ld[x] = *(const GAS u32x4*)(rb_ + go[x]); \
            if (hw == 0) { const float* sp_ = ssc + ((size_t)((b * 16 + hd) * NCHUNK + (c_))) * 256 + DIR * 128 + lane; sr0 = sp_[0]; sr1 = sp_[64]; } } while (0)
#define SS2_COMMIT(bi_, c_) do { LAS unsigned char* B_ = lds + (bi_) * BUF; \
            _Pragma("unroll") for (int x = 0; x < 10; ++x) { LAS unsigned char* d_ = B_ + lo_[x]; *(LAS u32x2*)(d_) = (u32x2){ld[x].x, ld[x].y}; *(LAS u32x2*)(d_ + 8) = (u32x2){ld[x].z, ld[x].w}; } \
            if (hw == 0) { LAS float* sc_ = (LAS float*)(B_ + SCO); const int i = lane; const float cs = sr1; const float cl = __shfl(cs, DIR ? 0 : 63); \
                sc_[i] = __expf(cs); sc_[64 + i] = sr0 * __expf(cl - cs); if (i == 0) sc_[128] = __expf(cl); } } while (0)
        { const int c0 = DIR ? NCHUNK - 1 : 0; SS2_ISSUE(c0); SS2_COMMIT(0, c0); SS2_ISSUE((DIR ? c0 - 1 : c0 + 1)); }
        for (int n = 0; n < NCHUNK; ++n) {
            const int c = DIR ? NCHUNK - 1 - n : n;
            WG_BAR();
            const bool more = n + 1 < NCHUNK; const int cn = DIR ? c - 1 : c + 1;
            if (more) { SS2_COMMIT((n + 1) & 1, cn); if (n + 2 < NCHUNK) SS2_ISSUE((DIR ? cn - 1 : cn + 1)); }
            unsigned ov[8];
            if (n > 0) {
#pragma unroll
                for (int x = 0; x < 8; ++x) ov[x] = *(const LAS unsigned*)(ost + (hw * 16 + 2 * x + (lane >> 5)) * 72 + 2 * (lane & 31));
            }
            WG_BAR();
            if (n > 0) { const int tp = (DIR ? c + 1 : c - 1) * 64;
#pragma unroll
                for (int x = 0; x < 8; ++x) { GAS char* ob_ = (GAS char*)(ys + (rowb + tp + hw * 16 + 2 * x) * 1024 + hd * 64);
                    (void)__builtin_amdgcn_global_atomic_fadd_v2bf16((GAS s16x2*)(ob_ + (lane >> 5) * 2048 + (lane & 31) * 4), __builtin_bit_cast(s16x2, ov[x])); } }
        }
        WG_BAR();
        { const int tp = (DIR ? 0 : NCHUNK - 1) * 64;
#pragma unroll
          for (int x = 0; x < 8; ++x) { const unsigned v = *(const LAS unsigned*)(ost + (hw * 16 + 2 * x + (lane >> 5)) * 72 + 2 * (lane & 31));
              GAS char* ob_ = (GAS char*)(ys + (rowb + tp + hw * 16 + 2 * x) * 1024 + hd * 64);
              (void)__builtin_amdgcn_global_atomic_fadd_v2bf16((GAS s16x2*)(ob_ + (lane >> 5) * 2048 + (lane & 31) * 4), __builtin_bit_cast(s16x2, v)); } }
#undef SS2_ISSUE
#undef SS2_COMMIT
    } else {
        const int ps = wave; const int xrow = ps * 32 + r31;
        f32x16 Ht[4];
#pragma unroll
        for (int t = 0; t < 4; ++t)
#pragma unroll
            for (int r = 0; r < 16; ++r) Ht[t][r] = 0.f;
        for (int n = 0; n < NCHUNK; ++n) {
            WG_BAR();
            const LAS unsigned char* Bb = lds + (n & 1) * BUF;
            const LAS bf16* Cb = (const LAS bf16*)(Bb + CO); const LAS bf16* Bmb = (const LAS bf16*)(Bb + BO); const LAS bf16* Xb = (const LAS bf16*)(Bb + XO);
            const LAS float* sc = (const LAS float*)(Bb + SCO);
            f32x16 aY[2];
#pragma unroll
            for (int m = 0; m < 2; ++m)
#pragma unroll
                for (int r = 0; r < 16; ++r) aY[m][r] = 0.f;
            bf16x8 fa[2][2];
            const int offc = r31 * 132 + 4 * hh;
#define SS2_LD2(bi_, ks_) do { fa[bi_][0] = afrag(Cb + offc + 16 * (ks_)); fa[bi_][1] = afrag(Cb + offc + 32 * 132 + 16 * (ks_)); } while (0)
            SS2_LD2(0, 0);
#pragma unroll
            for (int ks = 0; ks < 8; ++ks) {
                if (ks < 7) SS2_LD2((ks + 1) & 1, ks + 1);
                __builtin_amdgcn_sched_barrier(0);
                const bf16x8 bs = cvt8(Ht[ks >> 1], 8 * (ks & 1));
                aY[0] = MFMA32(fa[ks & 1][0], bs, aY[0]); aY[1] = MFMA32(fa[ks & 1][1], bs, aY[1]);
                __builtin_amdgcn_sched_barrier(0); }
#undef SS2_LD2
            const int i16 = r31 & 15; const LAS bf16* bp = Bmb + (8 * hh + (i16 >> 2)) * 132 + 16 * (r31 >> 4) + 4 * (i16 & 3);
            bf16x8 xf[4];
#pragma unroll
            for (int kt = 0; kt < 4; ++kt) { const bf16x8 xv = *(const LAS bf16x8*)(Xb + xrow * 72 + 16 * kt + 8 * hh);
                const f32x4 w0 = *(const LAS f32x4*)(sc + 64 + 16 * kt + 8 * hh), w1 = *(const LAS f32x4*)(sc + 64 + 16 * kt + 8 * hh + 4);
                u32x4 w; w.x = pkbf(bf2f_s(xv[0]) * w0[0], bf2f_s(xv[1]) * w0[1]); w.y = pkbf(bf2f_s(xv[2]) * w0[2], bf2f_s(xv[3]) * w0[3]);
                w.z = pkbf(bf2f_s(xv[4]) * w1[0], bf2f_s(xv[5]) * w1[1]); w.w = pkbf(bf2f_s(xv[6]) * w1[2], bf2f_s(xv[7]) * w1[3]);
                xf[kt] = __builtin_bit_cast(bf16x8, w); }
            bf16x8 fb[2][4];
#define SS2_LDBT(bi_, t_) do { _Pragma("unroll") for (int kt = 0; kt < 4; ++kt) { const LAS bf16* p_ = bp + (16 * kt) * 132 + 32 * (t_); \
                const v4i16_t lo_ = __builtin_amdgcn_ds_read_tr16_b64_v4i16((LAS v4i16_t*)p_), hi_ = __builtin_amdgcn_ds_read_tr16_b64_v4i16((LAS v4i16_t*)(p_ + 4 * 132)); \
                fb[bi_][kt] = (bf16x8){lo_[0], lo_[1], lo_[2], lo_[3], hi_[0], hi_[1], hi_[2], hi_[3]}; } } while (0)
            SS2_LDBT(0, 0);
#pragma unroll
            for (int m = 0; m < 2; ++m)
#pragma unroll
                for (int q4 = 0; q4 < 4; ++q4) { const f32x4 ec = *(const LAS f32x4*)(sc + 32 * m + 8 * q4 + 4 * hh);
#pragma unroll
                    for (int x = 0; x < 4; ++x) aY[m][4 * q4 + x] *= ec[x]; }
            const float ecl = sc[128];
            WG_BAR();
#pragma unroll
            for (int mi = 0; mi < 2; ++mi)
#pragma unroll
                for (int r = 0; r < 16; ++r) ost[(32 * mi + (r & 3) + 8 * (r >> 2) + 4 * hh) * 72 + ps * 32 + r31] = f2bf1(aY[mi][r]);
#pragma unroll
            for (int t = 0; t < 4; ++t) {
                if (t < 3) SS2_LDBT((t + 1) & 1, t + 1);
                __builtin_amdgcn_sched_barrier(0);
#pragma unroll
                for (int r = 0; r < 16; ++r) Ht[t][r] *= ecl;
                Ht[t] = MFMA32(fb[t & 1][0], xf[0], Ht[t]); Ht[t] = MFMA32(fb[t & 1][1], xf[1], Ht[t]);
                Ht[t] = MFMA32(fb[t & 1][2], xf[2], Ht[t]); Ht[t] = MFMA32(fb[t & 1][3], xf[3], Ht[t]);
                __builtin_amdgcn_sched_barrier(0); }
#undef SS2_LDBT
        }
        WG_BAR();
    }
}
#ifndef MK_ONE_LAUNCH
#define MK_ONE_LAUNCH 1
#endif
constexpr int PPL = 14;
constexpr int NPHASE = 1 + PPL * DEPTH;
struct Args { const float* in[19]; float* out; unsigned char* ws; int ph_lo, ph_hi; };
__global__ void __launch_bounds__(NWAVES * 64, 2) fwd_kernel(Args args) {
    extern __shared__ __attribute__((aligned(16))) unsigned char lds_raw[];
    LAS unsigned char* lds = (LAS unsigned char*)lds_raw;
    unsigned* ctl = (unsigned*)(args.ws + WS_CTL);
    volatile LAS unsigned* MISC = (volatile LAS unsigned*)(lds + MISC_OFF);
    for (int u = threadIdx.x; u < 64; u += 512) MISC[u] = 0u;
    __syncthreads();
#if MK_ONE_LAUNCH
    XcdBarrier bar = xcd_barrier_post(ctl + CW_BAR, MISC + 8);
#define GRID_BAR() do { XcdBarrier bb_ = bar; asm volatile("" : "+s"(bb_.bar), "+s"(bb_.x)); xcd_barrier(bb_); } while (0)
#else
#define GRID_BAR() do {} while (0)
#endif
    const int lo = args.ph_lo, hi = args.ph_hi;
#define WSP(T, off) ((T*)(wsb + (off)))
#if defined(PROBE_STATE) || defined(PROBE_ANY) || defined(PROBE_SUB)
#define PROBE_PTR ((float*)(wsb + WS_CTL) + 2048)
#define PROBE_SCALE (1.0f + sqrtf(8.7e-4f * fminf(fmaxf(*(volatile float*)PROBE_PTR, 0.f), 1.f)))
#else
#define PROBE_PTR ((float*)nullptr)
#define PROBE_SCALE 1.0f
#endif
    for (int ph = lo; ph < hi; ++ph) {
        int tid = threadIdx.x, bid = blockIdx.x, G = gridDim.x;
        const __attribute__((address_space(4))) Args* ap = (const __attribute__((address_space(4))) Args*)__builtin_amdgcn_kernarg_segment_ptr();
        asm volatile("" : "+v"(tid)); asm volatile("" : "+s"(bid), "+s"(G), "+s"(ap));
        unsigned char* wsb = ap->ws;
        const int lane = tid & 63, wave = __builtin_amdgcn_readfirstlane(tid >> 6);
        const int gw = bid * NWAVES + wave, NGW = G * NWAVES, gtid = bid * 512 + tid, NGT = G * 512;
        const int l = (ph == 0) ? 0 : (ph - 1) / PPL; const int k = (ph == 0) ? -1 : (ph - 1) % PPL;
#if defined(PROBE_ANY)
        if (l == PROBE_L && k == PROBE_K0 && blockIdx.x == 0 && threadIdx.x == 0) ((unsigned long long*)(wsb + WS_CTL))[1100] = __builtin_amdgcn_s_memrealtime();
#endif
        switch (k) {
        case -1: {
            cvt_mixer_weights(lds, wsb, ap->in[2], ap->in[12], gw, NGW, wave, lane);
            phase_norm(ap->in[0], ap->in[1], WSP(bf16, WS_XN), gw, NGW, lane);
        } break;
        case 0: {
            pg8::Gemm g{WSP(bf16, WS_XN), WSP(bf16, WS_WA), M, NWA, DM, 0, 0, 0}; pg8::StaticOrder S; S.init(M, NWA, G, bid);
            pg8::EpiRawA E{WSP(bf16, WS_RAW), WSP(float, WS_SCAL)};
            pg8::gemm_phase<pg8::EpiRawA, pg8::StaticOrder, true, true>(lds, g, S, E);
#if defined(EXP_DUP_GEMM)
            if (l == 0 && (EXP_DUP_GEMM & 1)) { __syncthreads(); pg8::gemm_phase<pg8::EpiRawA, pg8::StaticOrder, true, true>(lds, g, S, E); }
#endif
        } break;
        case 1: {
            if (l == 1) PB_START(3, wsb);
            prep_gdn_stash(lds, bid, WSP(bf16, WS_RAW), tid); prep_ssd_stash(lds, bid, WSP(bf16, WS_RAW), tid);
            zero_region(wsb + WS_OG, 64 * MiB, gtid, NGT); zero_region(wsb + WS_YS, 64 * MiB, gtid, NGT);
            GRID_BAR();
            if (l == 1) { PB_END(3, wsb); PB_START(1, wsb); }
            prep_gdn_range(lds, bid, WSP(bf16, WS_RAW), WSP(float, WS_SCAL), ap->in[3] + (size_t)l * 7 * CONV_CH, ap->in[4] + (size_t)l * CONV_CH,
                           ap->in[5] + l * 16, ap->in[6] + l * 16, WSP(bf16, WS_TQ), tid, wave, lane, WSP(float, WS_SCAL));
            __syncthreads();
            if (l == 1) { PB_END(1, wsb); PB_START(2, wsb); }
            { int tid2 = threadIdx.x; asm volatile("" : "+v"(tid2));
              prep_ssd_range(lds, bid, WSP(bf16, WS_RAW), ap->in[3] + (size_t)l * 7 * CONV_CH, ap->in[4] + (size_t)l * CONV_CH, tid2,
                             WSP(float, WS_SCAL), ap->in[8] + l * 32, ap->in[9] + l * 32, WSP(float, WS_SSC)); }
            if (l == 1) { __syncthreads(); PB_END(2, wsb); }
        } break;
        case 2: {
            for (int c = bid; c < 256; c += G) {
                int tid = threadIdx.x; asm volatile("" : "+v"(tid));
                const int lane = tid & 63, wave = __builtin_amdgcn_readfirstlane(tid >> 6);
                if (c < 128) { const int b_ = c >> 5, h_ = (c >> 2) & 7, hf_ = c & 1;
                    if ((c >> 1) & 1) gdn_state2<1>(lds, b_, h_, hf_, WSP(bf16, WS_RAW), WSP(float, WS_SCAL), WSP(bf16, WS_TQ), ap->in[5] + l * 16, ap->in[6] + l * 16, WSP(bf16, WS_OG), tid, wave, lane);
                    else       gdn_state2<0>(lds, b_, h_, hf_, WSP(bf16, WS_RAW), WSP(float, WS_SCAL), WSP(bf16, WS_TQ), ap->in[5] + l * 16, ap->in[6] + l * 16, WSP(bf16, WS_OG), tid, wave, lane, PROBE_PTR); }
                else { const int c2 = c - 128, hd_ = (c2 >> 1) & 15, b_ = c2 >> 5;
                    if (c2 & 1) ssd_state2<1>(lds, b_, hd_, WSP(bf16, WS_RAW), WSP(float, WS_SSC), WSP(bf16, WS_YS), tid, wave, lane);
                    else        ssd_state2<0>(lds, b_, hd_, WSP(bf16, WS_RAW), WSP(float, WS_SSC), WSP(bf16, WS_YS), tid, wave, lane); }
                __syncthreads();
            }
        } break;
        case 3: {
            ssd_intra_range(lds, bid, WSP(bf16, WS_RAW), WSP(float, WS_SSC), ap->in[10] + l * 16, WSP(bf16, WS_TQ), tid);
#if defined(EXP_DUP_INTRA)
            if (l == 0) { __syncthreads();
            ssd_intra_range(lds, bid, WSP(bf16, WS_RAW), WSP(float, WS_SSC), ap->in[10] + l * 16, WSP(bf16, WS_TQ), tid);
 }
#endif
        } break;
        case 4: {
            phase_norm((l == 0) ? ap->in[0] : ap->out, ap->in[1] + (size_t)l * DM, WSP(bf16, WS_XN2), gw, NGW, lane);
#if defined(EXP_DUP_B)
            if (l == 0) { __syncthreads();
            phase_norm((l == 0) ? ap->in[0] : ap->out, ap->in[1] + (size_t)l * DM, WSP(bf16, WS_XN2), gw, NGW, lane);
 }
#endif
        } break;
        case 5: {
            pg8::Gemm g{WSP(bf16, WS_XN2), WSP(bf16, WS_WB), M, NGATE, DM, 0, 0, 0}; pg8::StaticOrder S; S.init(M, NGATE, G, bid);
            pg8::EpiBf16 E{WSP(bf16, WS_GATES), NGATE};
            pg8::gemm_phase<pg8::EpiBf16, pg8::StaticOrder, true, true>(lds, g, S, E);
#if defined(EXP_DUP_GEMM)
            if (l == 0 && (EXP_DUP_GEMM & 2)) { __syncthreads(); pg8::gemm_phase<pg8::EpiBf16, pg8::StaticOrder, true, true>(lds, g, S, E); }
#endif
        } break;
        case 6: {
            phase_finish(WSP(bf16, WS_OG), WSP(bf16, WS_YS), WSP(bf16, WS_TQ), WSP(bf16, WS_GATES), ap->in[7] + l * 128, ap->in[11] + l * 1024, WSP(bf16, WS_MIXED), gw, NGW, lane);
#if defined(EXP_DUP_B)
            if (l == 0) { __syncthreads();
            phase_finish(WSP(bf16, WS_OG), WSP(bf16, WS_YS), WSP(bf16, WS_TQ), WSP(bf16, WS_GATES), ap->in[7] + l * 128, ap->in[11] + l * 1024, WSP(bf16, WS_MIXED), gw, NGW, lane);
 }
#endif
        } break;
        case 7: {
            pg8::Gemm g{WSP(bf16, WS_MIXED), WSP(bf16, WS_WO), M, DM, 2048, 0, 0, 0}; pg8::StaticOrder S; S.init(M, DM, G, bid);
            pg8::EpiResid E{(l == 0) ? ap->in[0] : ap->out, ap->out, DM};
            pg8::gemm_phase<pg8::EpiResid, pg8::StaticOrder, true, true>(lds, g, S, E);
#if defined(EXP_DUP_GEMM)
            if (l == 0 && (EXP_DUP_GEMM & 4)) { __syncthreads(); pg8::gemm_phase<pg8::EpiResid, pg8::StaticOrder, true, true>(lds, g, S, E); }
#endif
        } break;
        case 8: {
            phase_norm2_router(lds, ap->out, ap->in[13] + l * DM, ap->in[14] + (size_t)l * DM * 16, WSP(bf16, WS_XN), WSP(float, WS_AFF), gw, NGW, tid, lane);
            __syncthreads();
            cvt_expert_weights(lds, wsb, ap->in[15] + (size_t)l * NEXP * DM * EFF, ap->in[16] + (size_t)l * NEXP * DM * EFF, ap->in[17] + (size_t)l * NEXP * EFF * DM, gw, NGW, wave, lane);
            if (l + 1 < DEPTH) cvt_mixer_weights(lds, wsb, ap->in[2] + (size_t)(l + 1) * DM * 6720, ap->in[12] + (size_t)(l + 1) * 2048 * DM, gw, NGW, wave, lane);
#if defined(EXP_DUP_A) || defined(EXP_DUP_N2)
            if (l == 0) { __syncthreads();
            phase_norm2_router(lds, ap->out, ap->in[13] + l * DM, ap->in[14] + (size_t)l * DM * 16, WSP(bf16, WS_XN), WSP(float, WS_AFF), gw, NGW, tid, lane);
            __syncthreads();
            cvt_expert_weights(lds, wsb, ap->in[15] + (size_t)l * NEXP * DM * EFF, ap->in[16] + (size_t)l * NEXP * DM * EFF, ap->in[17] + (size_t)l * NEXP * EFF * DM, gw, NGW, wave, lane);
            if (l + 1 < DEPTH) cvt_mixer_weights(lds, wsb, ap->in[2] + (size_t)(l + 1) * DM * 6720, ap->in[12] + (size_t)(l + 1) * 2048 * DM, gw, NGW, wave, lane);
 }
#endif
        } break;
        case 9: {
            for (int be = bid; be < NB * NEXP; be += G) phase_topk(lds, WSP(float, WS_AFF), WSP(int, WS_IDX), WSP(float, WS_VAL), WSP(int, WS_INV), be, tid, wave, lane);
#if defined(EXP_DUP_A) || defined(EXP_DUP_TK)
            if (l == 0) { __syncthreads();
            for (int be = bid; be < NB * NEXP; be += G) phase_topk(lds, WSP(float, WS_AFF), WSP(int, WS_IDX), WSP(float, WS_VAL), WSP(int, WS_INV), be, tid, wave, lane);
 }
#endif
        } break;
        case 10: {
            phase_gather(WSP(bf16, WS_XN), WSP(int, WS_IDX), WSP(bf16, WS_XG), gw, NGW, lane);
#if defined(EXP_DUP_A) || defined(EXP_DUP_GA)
            if (l == 0) { __syncthreads();
            phase_gather(WSP(bf16, WS_XN), WSP(int, WS_IDX), WSP(bf16, WS_XG), gw, NGW, lane);
 }
#endif
        } break;
        case 11: {
            pg8::Gemm g{WSP(bf16, WS_XG), WSP(bf16, WS_WGU), MEXP, 1024, DM, 2, 15, (size_t)1024 * 1024 * 2}; pg8::StaticOrder S; S.init(MEXP, 1024, G, bid);
            pg8::EpiSwiglu E{WSP(bf16, WS_HMID), EFF};
            pg8::gemm_phase<pg8::EpiSwiglu, pg8::StaticOrder, true, true>(lds, g, S, E);
#if defined(EXP_DUP_GEMM)
            if (l == 0 && (EXP_DUP_GEMM & 8)) { __syncthreads(); pg8::gemm_phase<pg8::EpiSwiglu, pg8::StaticOrder, true, true>(lds, g, S, E); }
#endif
        } break;
        case 12: {
            pg8::Gemm g{WSP(bf16, WS_HMID), WSP(bf16, WS_WD), MEXP, 1024, EFF, 2, 15, (size_t)1024 * 512 * 2}; pg8::StaticOrder S; S.init(MEXP, 1024, G, bid);
            pg8::EpiBf16 E{WSP(bf16, WS_XG), 1024};
            pg8::gemm_phase<pg8::EpiBf16, pg8::StaticOrder, true, true>(lds, g, S, E);
#if defined(EXP_DUP_GEMM)
            if (l == 0 && (EXP_DUP_GEMM & 16)) { __syncthreads(); pg8::gemm_phase<pg8::EpiBf16, pg8::StaticOrder, true, true>(lds, g, S, E); }
#endif
        } break;
        default: {
            const bool last = (l + 1 == DEPTH);
            phase_combine(ap->out, ap->out, WSP(bf16, WS_XG), WSP(int, WS_INV), WSP(float, WS_VAL), last ? ap->in[18] : ap->in[1] + (size_t)(l + 1) * DM, WSP(bf16, WS_XN), last, gw, NGW, lane, PROBE_SCALE);

        } break;
        }
        if (ph + 1 < hi) GRID_BAR();
#if defined(PROBE_ANY)
        if (l == PROBE_L && k == PROBE_K1 && blockIdx.x == 0 && threadIdx.x == 0) { const unsigned long long t1_ = __builtin_amdgcn_s_memrealtime(), t0_ = ((unsigned long long*)(wsb + WS_CTL))[1100];
            const unsigned bk_ = (unsigned)((t1_ - t0_) / PROBE_TICKS); *(volatile float*)PROBE_PTR = (float)(bk_ > 40u ? 40u : bk_) * (1.0f / 40.0f); }
#endif
    }
#undef WSP
}

extern "C" void kernel_launch(void* const* d_in, const int* in_sizes, int n_in, void* d_out, int out_size, void* d_ws, size_t ws_size, hipStream_t stream) {
    static int grid = 0;
    if (grid == 0) {
        if (n_in != 19 || in_sizes[0] != M * DM || out_size != M * DM || ws_size < WS_END) { fprintf(stderr, "kernel_launch: unexpected shapes (n_in %d, in0 %d, out %d, ws %zu); nothing launched\n", n_in, n_in > 0 ? in_sizes[0] : -1, out_size, ws_size); grid = -1; return; }
        int dev = 0, cus = 0;
        if (hipGetDevice(&dev) != hipSuccess || hipDeviceGetAttribute(&cus, hipDeviceAttributeMultiprocessorCount, dev) != hipSuccess) { grid = -1; return; }
        if (hipFuncSetAttribute((const void*)fwd_kernel, hipFuncAttributeMaxDynamicSharedMemorySize, LDS_BYTES) != hipSuccess) { fprintf(stderr, "kernel_launch: hipFuncSetAttribute failed\n"); grid = -1; return; }
        (void)hipGetLastError();
        grid = cus;
    }
    if (grid < 0) return;
    (void)hipMemsetAsync((char*)d_ws + WS_CTL, 0, CTL_ZERO_BYTES, stream);
    Args a{};
    for (int i = 0; i < 19; ++i) a.in[i] = (const float*)d_in[i];
    a.out = (float*)d_out; a.ws = (unsigned char*)d_ws;
#if MK_ONE_LAUNCH
    a.ph_lo = 0; a.ph_hi = NPHASE;
    hipLaunchKernelGGL(fwd_kernel, dim3(grid), dim3(NWAVES * 64), LDS_BYTES, stream, a);
#else
    for (int p = 0; p < NPHASE; ++p) { a.ph_lo = p; a.ph_hi = p + 1; hipLaunchKernelGGL(fwd_kernel, dim3(grid), dim3(NWAVES * 64), LDS_BYTES, stream, a); }
#endif
}
```

```cpp
#include <hip/hip_runtime.h>
#include <cstdio>
#include <cstdint>
namespace pg8 {
#define PG8_LAS __attribute__((address_space(3)))
typedef unsigned short bf16_t;
typedef short bf16x8 __attribute__((ext_vector_type(8)));
typedef float f32x4 __attribute__((ext_vector_type(4)));
typedef unsigned u32x4 __attribute__((ext_vector_type(4)));
constexpr int BM = 256, BK = 64, HALF = 128, HTB = HALF * BK * 2  , STAGE_BYTES = 8 * HTB, NXCD = 8, WGM = 8;

__host__ __device__ __forceinline__ int lds_byte(int r, int c) { const int st = (r >> 4) * 2 + (c >> 5), rr = r & 15, cc = c & 31, ob = rr * 64 + cc * 2; return st * 1024 + (ob ^ (((ob >> 9) & 1) << 5)); }
__host__ __device__ __forceinline__ void stage_rc(int b, int& R, int& C) { const int st = b / 1024, sb = b % 1024, swz = sb ^ (((sb >> 9) & 1) << 5); R = (st >> 1) * 16 + swz / 64; C = (st & 1) * 32 + (swz % 64) / 2; }
__host__ __device__ __forceinline__ int perm32(int rho) { const int n = rho >> 4, i = rho & 15; return 8 * (i >> 2) + 4 * n + (i & 3); }

struct Unit { int pm, pn; };
struct Gemm { const bf16_t* A; const bf16_t* Bt; int M, N, K; int bshift, bmask; size_t bstride;
    __device__ __forceinline__ size_t grp_off(int pm) const { return (size_t)((pm >> bshift) & bmask) * bstride; } };

struct StaticOrder {
    int nM, nN, nwg, G, c;
    __host__ __device__ void init(int M, int N, int G_, int c_) { nM = M / BM; nN = N / BM; nwg = nM * nN; G = G_; c = c_; }
    __host__ __device__ bool next(int i, Unit& u) const {
        const long L = (long)i * G + c; if (L >= nwg) return false;
        int wgid = (int)L; { const int q = nwg / NXCD, r = nwg % NXCD, xcd = wgid % NXCD, off = wgid / NXCD; wgid = (xcd < r ? xcd * (q + 1) : r * (q + 1) + (xcd - r) * q) + off; }
        const int nig = WGM * nN, gid = wgid / nig, fm = gid * WGM, gsz = (nM - fm) < WGM ? (nM - fm) : WGM;
        u.pm = fm + ((wgid % nig) % gsz); u.pn = (wgid % nig) / gsz; return true;
    }
    __device__ __forceinline__ void a_ready(const Unit&) const {}
    __device__ __forceinline__ void done(const Unit&) const {}
};

__device__ __forceinline__ unsigned cvt_pk_bf16(float lo, float hi) { unsigned r; asm volatile("v_cvt_pk_bf16_f32 %0, %1, %2" : "=v"(r) : "v"(lo), "v"(hi)); return r; }
__device__ __forceinline__ float silu_f(float x) { return x * __builtin_amdgcn_rcpf(1.0f + __builtin_amdgcn_exp2f(-1.4426950408889634f * x)); }
struct EpiBf16 {
    static constexpr bool PERM = true, AFTER_DRAIN = false;
    bf16_t* O; int ldc;
    __device__ __forceinline__ void operator()(const f32x4 (&acc)[2][2][4][2], const Unit& u, int wr, int wc, int fr, int fq) const {
        const int row0 = u.pm * BM + wr * 64 + fr; const int col0 = u.pn * BM + wc * 32 + 8 * fq;
#pragma unroll
        for (int ai = 0; ai < 2; ++ai)
#pragma unroll
            for (int m = 0; m < 4; ++m) { bf16_t* rowp = O + (size_t)(row0 + ai * HALF + m * 16) * ldc + col0;
#pragma unroll
                for (int bj = 0; bj < 2; ++bj) { const f32x4 v0 = acc[ai][bj][m][0], v1 = acc[ai][bj][m][1];
                    u32x4 w; w.x = cvt_pk_bf16(v0[0], v0[1]); w.y = cvt_pk_bf16(v0[2], v0[3]); w.z = cvt_pk_bf16(v1[0], v1[1]); w.w = cvt_pk_bf16(v1[2], v1[3]);
                    *(u32x4*)(rowp + bj * HALF) = w; } }
    }
};
struct EpiRawA {
    static constexpr bool PERM = true, AFTER_DRAIN = false;
    bf16_t* O; float* S;
    __device__ __forceinline__ void operator()(const f32x4 (&acc)[2][2][4][2], const Unit& u, int wr, int wc, int fr, int fq) const {
        const int row0 = u.pm * BM + wr * 64 + fr;
        if (u.pn < 18) {
            const int col0 = u.pn * BM + wc * 32 + 8 * fq;
#pragma unroll
            for (int ai = 0; ai < 2; ++ai)
#pragma unroll
                for (int m = 0; m < 4; ++m) { bf16_t* rowp = O + (size_t)(row0 + ai * HALF + m * 16) * 4608 + col0;
#pragma unroll
                    for (int bj = 0; bj < 2; ++bj) { const f32x4 v0 = acc[ai][bj][m][0], v1 = acc[ai][bj][m][1];
                        u32x4 w; w.x = cvt_pk_bf16(v0[0], v0[1]); w.y = cvt_pk_bf16(v0[2], v0[3]); w.z = cvt_pk_bf16(v1[0], v1[1]); w.w = cvt_pk_bf16(v1[2], v1[3]);
                        *(u32x4*)(rowp + bj * HALF) = w; } }
        } else if (wc < 2) {
            const int col0 = wc * 32 + 8 * fq;
#pragma unroll
            for (int ai = 0; ai < 2; ++ai)
#pragma unroll
                for (int m = 0; m < 4; ++m) { float* sp = S + (size_t)(row0 + ai * HALF + m * 16) * 64 + col0;
                    *(f32x4*)sp = acc[ai][0][m][0]; *(f32x4*)(sp + 4) = acc[ai][0][m][1]; }
        }
    }
};
struct EpiResid {
    static constexpr bool PERM = false, AFTER_DRAIN = false;
    const float* base; float* out; int ldc;
    __device__ __forceinline__ void operator()(const f32x4 (&acc)[2][2][4][2], const Unit& u, int wr, int wc, int fr, int fq) const {
        const int row0 = u.pm * BM + wr * 64 + fr, col0 = u.pn * BM + wc * 32 + 4 * fq;
#pragma unroll
        for (int ai = 0; ai < 2; ++ai)
#pragma unroll
            for (int m = 0; m < 4; ++m) { const size_t off = (size_t)(row0 + ai * HALF + m * 16) * ldc + col0;
#pragma unroll
                for (int bj = 0; bj < 2; ++bj)
#pragma unroll
                    for (int n = 0; n < 2; ++n) { const size_t ix = off + bj * HALF + n * 16; *(f32x4*)(out + ix) = *(const f32x4*)(base + ix) + acc[ai][bj][m][n]; } }
    }
};
struct EpiSwiglu {
    static constexpr bool PERM = true, AFTER_DRAIN = false;
    bf16_t* O; int ldh;
    __device__ __forceinline__ void operator()(const f32x4 (&acc)[2][2][4][2], const Unit& u, int wr, int wc, int fr, int fq) const {
        const int row0 = u.pm * BM + wr * 64 + fr; const int f0 = (u.pn * BM + wc * 32 + 8 * fq) >> 1;
        typedef unsigned u32x2 __attribute__((ext_vector_type(2)));
#pragma unroll
        for (int ai = 0; ai < 2; ++ai)
#pragma unroll
            for (int m = 0; m < 4; ++m) { bf16_t* rowp = O + (size_t)(row0 + ai * HALF + m * 16) * ldh + f0;
#pragma unroll
                for (int bj = 0; bj < 2; ++bj) { const f32x4 v0 = acc[ai][bj][m][0], v1 = acc[ai][bj][m][1];
                    u32x2 w; w.x = cvt_pk_bf16(silu_f(v0[0]) * v0[1], silu_f(v0[2]) * v0[3]); w.y = cvt_pk_bf16(silu_f(v1[0]) * v1[1], silu_f(v1[2]) * v1[3]);
                    *(u32x2*)(rowp + bj * (HALF / 2)) = w; } }
    }
};
template <class Epi, class Sched, bool ALIGN_EPI = false, bool SP2 = false>
__device__ __forceinline__ void gemm_phase(PG8_LAS unsigned char* lds, const Gemm g, const Sched& S, const Epi& E) {
    int tid_o = threadIdx.x; asm volatile("" : "+v"(tid_o));
    const int tid = tid_o, wid = __builtin_amdgcn_readfirstlane(tid >> 6), lane = tid & 63, wr = wid >> 2, wc = wid & 3, fr = lane & 15, fq = lane >> 4;
    const int K = g.K, nt = K / BK;
    unsigned voffA[2], voffB[2];
#pragma unroll
    for (int i = 0; i < 2; ++i) { int R, C; stage_rc(tid * 16 + i * 8192, R, C); const int Rb = Epi::PERM ? ((R & ~31) + perm32(R & 31)) : R;
        voffA[i] = (unsigned)(R * K + C) * 2u; voffB[i] = (unsigned)(Rb * K + C) * 2u; }
    const size_t kstep = (size_t)(BK * 2);
    const size_t hstep = (size_t)HALF * K * 2;
    const size_t tstep = 2 * hstep;
    const unsigned ldsw = (unsigned)wid * 1024u;
    const int aoff = lds_byte(wr * 64 + fr, fq * 8), boff = lds_byte(wc * 32 + fr, fq * 8);
#define PG8_SA(b, h) (((b) * 2 + (h)) * HTB)
#define PG8_SB(b, h) ((4 + (b) * 2 + (h)) * HTB)
#define PG8_STAGE(bufoff, gbase, voff) do { _Pragma("unroll") for (int _i = 0; _i < 2; ++_i) \
        __builtin_amdgcn_global_load_lds((const unsigned*)((const char*)(gbase) + (voff)[_i]), (PG8_LAS unsigned*)(lds + (bufoff) + ldsw + _i * 8192), 16, 0, 0); } while (0)
#define PG8_LDA(dst, b, h) do { _Pragma("unroll") for (int m = 0; m < 4; ++m) _Pragma("unroll") for (int k = 0; k < 2; ++k) dst[m][k] = *(const PG8_LAS bf16x8*)(lds + PG8_SA(b, h) + aoff + m * 2048 + k * 1024); } while (0)
#define PG8_LDB(dst, b, h) do { _Pragma("unroll") for (int n = 0; n < 2; ++n) _Pragma("unroll") for (int k = 0; k < 2; ++k) dst[n][k] = *(const PG8_LAS bf16x8*)(lds + PG8_SB(b, h) + boff + n * 2048 + k * 1024); } while (0)
#define PG8_MMA(ai, bj, At, Bt) do { __builtin_amdgcn_s_setprio(1); _Pragma("unroll") for (int m = 0; m < 4; ++m) _Pragma("unroll") for (int n = 0; n < 2; ++n) _Pragma("unroll") for (int k = 0; k < 2; ++k) \
        acc[ai][bj][m][n] = __builtin_amdgcn_mfma_f32_16x16x32_bf16(Bt[n][k], At[m][k], acc[ai][bj][m][n], 0, 0, 0); __builtin_amdgcn_s_setprio(0); } while (0)
#define PG8_WAIT_V(n) asm volatile("s_waitcnt vmcnt(" #n ")" ::: "memory")
#define PG8_WAIT_L(n) asm volatile("s_waitcnt lgkmcnt(" #n ")" ::: "memory")
#define PG8_BAR __builtin_amdgcn_s_barrier()
#define PG8_SCHED __builtin_amdgcn_sched_barrier(0)
    Unit cur, nxt; int ui = 0;
    if (!S.next(0, cur)) return;
    f32x4 acc[2][2][4][2];
#pragma unroll
    for (int a = 0; a < 2; ++a)
#pragma unroll
        for (int b = 0; b < 2; ++b)
#pragma unroll
            for (int m = 0; m < 4; ++m)
#pragma unroll
                for (int n = 0; n < 2; ++n) acc[a][b][m][n] = (f32x4){0.f, 0.f, 0.f, 0.f};
    bf16x8 At[4][2], B0[2][2], B1[2][2];
    const char* cA = (const char*)g.A + (size_t)cur.pm * tstep; const char* cB = (const char*)g.Bt + g.grp_off(cur.pm) + (size_t)cur.pn * tstep;
    S.a_ready(cur);
    if constexpr (SP2) {
        PG8_STAGE(PG8_SB(0, 0), cB, voffB); PG8_STAGE(PG8_SB(0, 1), cB + hstep, voffB); PG8_STAGE(PG8_SA(0, 0), cA, voffA); PG8_STAGE(PG8_SA(0, 1), cA + hstep, voffA);
        if (wr == 1) PG8_BAR;
        PG8_WAIT_V(2); PG8_BAR;
        PG8_STAGE(PG8_SB(1, 0), cB + kstep, voffB); PG8_STAGE(PG8_SA(1, 0), cA + kstep, voffA); PG8_STAGE(PG8_SB(1, 1), cB + hstep + kstep, voffB);
        PG8_WAIT_V(6); PG8_BAR;
    } else {
        PG8_STAGE(PG8_SB(0, 0), cB, voffB); PG8_STAGE(PG8_SA(0, 0), cA, voffA); PG8_STAGE(PG8_SB(0, 1), cB + hstep, voffB); PG8_STAGE(PG8_SA(0, 1), cA + hstep, voffA);
        if (wr == 1) PG8_BAR;
        PG8_WAIT_V(4); PG8_BAR;
        PG8_STAGE(PG8_SB(1, 0), cB + kstep, voffB); PG8_STAGE(PG8_SA(1, 0), cA + kstep, voffA); PG8_STAGE(PG8_SB(1, 1), cB + hstep + kstep, voffB);
        PG8_WAIT_V(6); PG8_BAR;
    }
    for (;;) {
        const bool has_next = S.next(ui + 1, nxt);
        const char* nA = has_next ? (const char*)g.A + (size_t)nxt.pm * tstep : cA; const char* nB = has_next ? (const char*)g.Bt + g.grp_off(nxt.pm) + (size_t)nxt.pn * tstep : cB;
        for (int t = 0; t < nt; t += 2) {
            const bool last = (t == nt - 2);
            const char* a1 = cA + (size_t)(t + 1) * kstep;
            const char* a2 = last ? nA : cA + (size_t)(t + 2) * kstep; const char* b2 = last ? nB : cB + (size_t)(t + 2) * kstep;
            const char* a3 = a2 + kstep; const char* b3 = b2 + kstep;
            if (last && has_next) S.a_ready(nxt);
            if constexpr (SP2) {
            PG8_LDB(B0, 0, 0); PG8_LDB(B1, 0, 1); PG8_SCHED; PG8_LDA(At, 0, 0); PG8_STAGE(PG8_SA(1, 1), a1 + hstep, voffA);
            PG8_WAIT_V(8); PG8_WAIT_L(0); PG8_BAR; PG8_MMA(0, 0, At, B0); PG8_MMA(0, 1, At, B1); PG8_BAR; PG8_SCHED;
            PG8_LDA(At, 0, 1); PG8_STAGE(PG8_SB(0, 0), b2, voffB); PG8_STAGE(PG8_SB(0, 1), b2 + hstep, voffB); PG8_STAGE(PG8_SA(0, 0), a2, voffA);
            PG8_WAIT_V(8); PG8_WAIT_L(0); PG8_BAR; PG8_MMA(1, 0, At, B0); PG8_MMA(1, 1, At, B1); PG8_BAR; PG8_SCHED;
            PG8_LDB(B0, 1, 0); PG8_LDB(B1, 1, 1); PG8_SCHED; PG8_LDA(At, 1, 0); PG8_STAGE(PG8_SA(0, 1), a2 + hstep, voffA);
            PG8_WAIT_V(8); PG8_WAIT_L(0); PG8_BAR; PG8_MMA(0, 0, At, B0); PG8_MMA(0, 1, At, B1); PG8_BAR; PG8_SCHED;
            PG8_LDA(At, 1, 1); PG8_STAGE(PG8_SB(1, 0), b3, voffB); PG8_STAGE(PG8_SB(1, 1), b3 + hstep, voffB); PG8_STAGE(PG8_SA(1, 0), a3, voffA);
            PG8_WAIT_V(8); PG8_WAIT_L(0); PG8_BAR; PG8_MMA(1, 0, At, B0); PG8_MMA(1, 1, At, B1); PG8_BAR; PG8_SCHED;
            } else {
            PG8_LDB(B0, 0, 0); PG8_SCHED; PG8_LDA(At, 0, 0); PG8_STAGE(PG8_SA(1, 1), a1 + hstep, voffA);
            PG8_WAIT_L(8); PG8_BAR; PG8_WAIT_L(0); PG8_MMA(0, 0, At, B0); PG8_BAR; PG8_SCHED;
            PG8_LDB(B1, 0, 1); PG8_STAGE(PG8_SB(0, 0), b2, voffB);
            PG8_BAR; PG8_WAIT_L(0); PG8_MMA(0, 1, At, B1); PG8_BAR;
            PG8_LDA(At, 0, 1); PG8_STAGE(PG8_SA(0, 0), a2, voffA);
            PG8_BAR; PG8_WAIT_L(0); PG8_MMA(1, 0, At, B0); PG8_BAR; PG8_SCHED;
            PG8_STAGE(PG8_SB(0, 1), b2 + hstep, voffB);
            PG8_WAIT_V(6); PG8_BAR; PG8_MMA(1, 1, At, B1); PG8_BAR;
            PG8_LDB(B0, 1, 0); PG8_SCHED; PG8_LDA(At, 1, 0); PG8_STAGE(PG8_SA(0, 1), a2 + hstep, voffA);
            PG8_WAIT_L(8); PG8_BAR; PG8_WAIT_L(0); PG8_MMA(0, 0, At, B0); PG8_BAR; PG8_SCHED;
            PG8_LDB(B1, 1, 1); PG8_STAGE(PG8_SB(1, 0), b3, voffB);
            PG8_BAR; PG8_WAIT_L(0); PG8_MMA(0, 1, At, B1); PG8_BAR;
            PG8_LDA(At, 1, 1); PG8_STAGE(PG8_SA(1, 0), a3, voffA);
            PG8_BAR; PG8_WAIT_L(0); PG8_MMA(1, 0, At, B0); PG8_BAR; PG8_SCHED;
            PG8_STAGE(PG8_SB(1, 1), b3 + hstep, voffB);
            PG8_WAIT_V(6); PG8_BAR; PG8_MMA(1, 1, At, B1); PG8_BAR;
            }
        }
        if constexpr (ALIGN_EPI) { if (wr == 0) PG8_BAR; }
        if constexpr (!Epi::AFTER_DRAIN) { E(acc, cur, wr, wc, fr, fq); S.done(cur); }
        if (!has_next) break;
#pragma unroll
        for (int a = 0; a < 2; ++a)
#pragma unroll
            for (int b = 0; b < 2; ++b)
#pragma unroll
                for (int m = 0; m < 4; ++m)
#pragma unroll
                    for (int n = 0; n < 2; ++n) acc[a][b][m][n] = (f32x4){0.f, 0.f, 0.f, 0.f};
        cur = nxt; cA = nA; cB = nB; ++ui;
        if constexpr (ALIGN_EPI) { if (wr == 1) PG8_BAR; }
    }
    PG8_WAIT_V(0);
    if constexpr (!ALIGN_EPI) { if (wr == 0) PG8_BAR; }
    PG8_BAR;
    if constexpr (Epi::AFTER_DRAIN) { E.fused(acc, cur, wr, wc, fr, fq, lds, wid, lane); S.done(cur); }
#undef PG8_SA
#undef PG8_SB
#undef PG8_STAGE
#undef PG8_LDA
#undef PG8_LDB
#undef PG8_MMA
#undef PG8_WAIT_V
#undef PG8_WAIT_L
#undef PG8_BAR
#undef PG8_SCHED
}
}
#define GAS __attribute__((address_space(1)))
#define LAS __attribute__((address_space(3)))
typedef unsigned short bf16;
typedef unsigned v4u __attribute__((ext_vector_type(4)));
typedef float f32x4 __attribute__((ext_vector_type(4)));
typedef short bf16x8 __attribute__((ext_vector_type(8)));
typedef GAS unsigned gu32;
typedef GAS unsigned long long gu64;
#define RLX_AGENT __ATOMIC_RELAXED, __HIP_MEMORY_SCOPE_AGENT
#define LDS_WAIT() asm volatile("s_waitcnt lgkmcnt(0)" ::: "memory")
#define VM_WAIT() asm volatile("s_waitcnt vmcnt(0)" ::: "memory")
__device__ __forceinline__ unsigned long long rt() { return __builtin_amdgcn_s_memrealtime(); }
__device__ __forceinline__ unsigned f2bf(float f) { unsigned u = __builtin_bit_cast(unsigned, f); return (u + 0x7fffu + ((u >> 16) & 1u)) >> 16; }
__device__ __forceinline__ unsigned pk2(float lo, float hi) { return f2bf(lo) | (f2bf(hi) << 16); }
#define XB_TMO      128
#define XB_XCNT(j)  (256  + 64 * (j))
#define XB_XSUB(j)  (1280 + 64 * (j))
#define XB_XGEN(j)  (2304 + 64 * (j))
#define XB_TOP      3328
#define XB_TOPGEN   3392
#define XCD_BAR_WORDS 3456
#define XB_SPIN_CAP (1u << 18)

__device__ __forceinline__ unsigned xb_ld(unsigned* p)              { return __hip_atomic_load(p, __ATOMIC_RELAXED, __HIP_MEMORY_SCOPE_AGENT); }
__device__ __forceinline__ unsigned xb_add(unsigned* p, unsigned v) { return __hip_atomic_fetch_add(p, v, __ATOMIC_RELAXED, __HIP_MEMORY_SCOPE_AGENT); }
__device__ __forceinline__ unsigned xb_xcc_id() { return (unsigned)__builtin_amdgcn_s_getreg((3 << 11) | 20) & 0xFu; }
#define XB_SPIN(cond, bar) do { unsigned _sp = 0; while (cond) { __builtin_amdgcn_s_sleep(1); \
    if ((++_sp & 255u) == 0u) { if (xb_ld(&(bar)[XB_TMO])) break; if (_sp > XB_SPIN_CAP) { atomicAdd(&(bar)[XB_TMO], 1u); break; } } } } while (0)

struct XcdBarrier {
    unsigned* bar; unsigned x;
    volatile LAS unsigned* st;
};

__device__ __forceinline__ XcdBarrier xcd_barrier_post(unsigned* bar, volatile LAS unsigned* st) {
    XcdBarrier b; b.bar = bar; b.x = xb_xcc_id(); b.st = st;
    if (threadIdx.x == 0) (void)xb_add(&bar[XB_XCNT(b.x)], 1u);
    return b;
}
__device__ __forceinline__ void xcd_barrier_complete(unsigned* bar, unsigned x, unsigned& nloc, unsigned& nx) {
    const unsigned G = gridDim.x * gridDim.y * gridDim.z;
    unsigned sum, cnt, mine, sp = 0u;
    for (;;) {
        sum = 0u; cnt = 0u; mine = 0u;
#pragma unroll
        for (unsigned j = 0; j < 16; ++j) { const unsigned c = xb_ld(&bar[XB_XCNT(j)]); sum += c; cnt += (c > 0u) ? 1u : 0u; mine = (j == x) ? c : mine; }
        if (sum == G) break;
        __builtin_amdgcn_s_sleep(1);
        if ((++sp & 255u) == 0u) { if (xb_ld(&bar[XB_TMO])) break; if (sp > XB_SPIN_CAP) { atomicAdd(&bar[XB_TMO], 1u); break; } }
    }
    nloc = mine > 0u ? mine : 1u; nx = cnt > 0u ? cnt : 1u;
}

__device__ __forceinline__ void xcd_barrier(const XcdBarrier& b) {
    asm volatile("s_waitcnt vmcnt(0)" ::: "memory");
    __syncthreads();
    if (threadIdx.x == 0) {
        unsigned* bar = b.bar;
        __builtin_amdgcn_s_waitcnt(0);
        unsigned nloc = b.st[0], nx = b.st[1];
        if (nloc == 0u) { xcd_barrier_complete(bar, b.x, nloc, nx); b.st[0] = nloc; b.st[1] = nx; }
        const unsigned old = xb_add(&bar[XB_XSUB(b.x)], 1u);
        const unsigned gen = old / nloc;
        if (old + 1u == (gen + 1u) * nloc) {
            __builtin_amdgcn_fence(__ATOMIC_RELEASE, "agent");
            asm volatile("s_waitcnt vmcnt(0)" ::: "memory");
            const unsigned og = xb_add(&bar[XB_TOP], 1u);
            const unsigned tg = og / nx;
            if (og + 1u == (tg + 1u) * nx) xb_add(&bar[XB_TOPGEN], 1u);
            else XB_SPIN(xb_ld(&bar[XB_TOPGEN]) == tg, bar);
            __builtin_amdgcn_fence(__ATOMIC_ACQUIRE, "agent");
            xb_add(&bar[XB_XGEN(b.x)], 1u);
            asm volatile("s_waitcnt vmcnt(0)" ::: "memory");
        } else {
            XB_SPIN(xb_ld(&bar[XB_XGEN(b.x)]) == gen, bar);
            __builtin_amdgcn_fence(__ATOMIC_ACQUIRE, "agent");
            asm volatile("s_waitcnt vmcnt(0)" ::: "memory");
        }
    }
    __syncthreads();
}
constexpr int NB = 4, SEQ = 8192, DM = 1024, M = NB * SEQ, DEPTH = 2;
constexpr int NCHUNK = SEQ / 64;
constexpr int CONV_CH = 4608, NWA = 4864  , NGATE = 2048, NEXP = 16, EFF = 512, CAP = 1024;
constexpr int MEXP = NB * NEXP * CAP;
constexpr float EPS = 1e-6f;
constexpr int NWAVES = 8;
constexpr size_t MiB = 1u << 20;
constexpr size_t WS_CTL = 0, CTL_ZERO_BYTES = 1 * MiB;
constexpr size_t WS_WA = 1 * MiB;
constexpr size_t WS_WB = 11 * MiB;
constexpr size_t WS_WO = 15 * MiB;
constexpr size_t WS_XN = 19 * MiB;
constexpr size_t WS_RAW = 83 * MiB;
constexpr size_t WS_SCAL = 371 * MiB;
constexpr size_t WS_OG = 19 * MiB;
constexpr size_t WS_YS = 443 * MiB;
constexpr size_t WS_XN2 = 83 * MiB;
constexpr size_t WS_GATES = 147 * MiB;
constexpr size_t WS_MIXED = 147 * MiB;
constexpr size_t WS_WGU = 83 * MiB;
constexpr size_t WS_WD = 115 * MiB;
constexpr size_t WS_XG = 131 * MiB;
constexpr size_t WS_HMID = 259 * MiB;
constexpr size_t WS_AFF = 323 * MiB;
constexpr size_t WS_IDX = 325 * MiB;
constexpr size_t WS_VAL = 326 * MiB;
constexpr size_t WS_INV = 327 * MiB;
constexpr size_t WS_END = 507 * MiB;
constexpr int CW_TMO = 0, CW_BAR = 4096;
constexpr int LDS_BYTES = 163840;
constexpr int MISC_OFF = LDS_BYTES - 256;

typedef short bf16x8 __attribute__((ext_vector_type(8)));
typedef short bf16x4 __attribute__((ext_vector_type(4)));
typedef float f32x4 __attribute__((ext_vector_type(4)));
typedef float f32x2 __attribute__((ext_vector_type(2)));
typedef unsigned u32x4 __attribute__((ext_vector_type(4)));
typedef unsigned u32x2 __attribute__((ext_vector_type(2)));
typedef __bf16 bf16x2_t __attribute__((ext_vector_type(2)));
typedef short s16x2 __attribute__((ext_vector_type(2)));

__device__ __forceinline__ float bf2f(unsigned short v) { return __uint_as_float((unsigned)v << 16); }
__device__ __forceinline__ float bf2f_s(short v) { return __uint_as_float((unsigned)(unsigned short)v << 16); }
__device__ __forceinline__ unsigned pkbf(float lo, float hi) { f32x2 v = {lo, hi}; bf16x2_t b = __builtin_convertvector(v, bf16x2_t); return __builtin_bit_cast(unsigned, b); }
__device__ __forceinline__ unsigned short f2bf1(float f) { return (unsigned short)(pkbf(f, 0.f) & 0xffffu); }
__device__ __forceinline__ float silu(float x) { return x * __builtin_amdgcn_rcpf(1.0f + __builtin_amdgcn_exp2f(-1.4426950408889634f * x)); }
__device__ __forceinline__ float softplus_f(float x) { return x > 20.f ? x : log1pf(expf(x)); }
__device__ __forceinline__ float sigmoid_f(float x) { return 1.0f / (1.0f + expf(-x)); }
__device__ __forceinline__ void atomic_add_bf16x2(bf16* p, float a, float b) {
    (void)__builtin_amdgcn_global_atomic_fadd_v2bf16((GAS s16x2*)p, __builtin_bit_cast(s16x2, pkbf(a, b)));
}
template <int CTRL> __device__ __forceinline__ float dppf(float v) { return __builtin_bit_cast(float, __builtin_amdgcn_update_dpp(0, __builtin_bit_cast(int, v), CTRL, 0xF, 0xF, true)); }
__device__ __forceinline__ float wave_sum(float v) {
    v += dppf<0xB1>(v); v += dppf<0x4E>(v); v += dppf<0x141>(v); v += dppf<0x140>(v);
    const float s0 = __builtin_bit_cast(float, __builtin_amdgcn_readlane(__builtin_bit_cast(int, v), 0)), s1 = __builtin_bit_cast(float, __builtin_amdgcn_readlane(__builtin_bit_cast(int, v), 16));
    const float s2 = __builtin_bit_cast(float, __builtin_amdgcn_readlane(__builtin_bit_cast(int, v), 32)), s3 = __builtin_bit_cast(float, __builtin_amdgcn_readlane(__builtin_bit_cast(int, v), 48));
    return (s0 + s1) + (s2 + s3);
}

__device__ __forceinline__ float softplus_fast(float x) { const float e = __builtin_amdgcn_exp2f(1.4426950408889634f * fminf(x, 20.f));
    const float lg = (e < 1e-3f) ? e * (1.0f - 0.5f * e) : 0.6931471805599453f * __builtin_amdgcn_logf(1.0f + e); return x > 20.f ? x : lg; }
__device__ __forceinline__ float sigmoid_fast(float x) { return __builtin_amdgcn_rcpf(1.0f + __builtin_amdgcn_exp2f(-1.4426950408889634f * x)); }
__device__ __forceinline__ float scan_fwd64(float v, int lane) {
    v += dppf<0x111>(v); v += dppf<0x112>(v); v += dppf<0x114>(v); v += dppf<0x118>(v);
    const float t0 = __builtin_bit_cast(float, __builtin_amdgcn_readlane(__builtin_bit_cast(int, v), 15)), t1 = __builtin_bit_cast(float, __builtin_amdgcn_readlane(__builtin_bit_cast(int, v), 31));
    const float t2 = __builtin_bit_cast(float, __builtin_amdgcn_readlane(__builtin_bit_cast(int, v), 47));
    const int row = lane >> 4; return v + (row == 0 ? 0.f : row == 1 ? t0 : row == 2 ? t0 + t1 : (t0 + t1) + t2);
}
__device__ __forceinline__ float scan_bwd64(float v, int lane) {
    v += dppf<0x101>(v); v += dppf<0x102>(v); v += dppf<0x104>(v); v += dppf<0x108>(v);
    const float t1 = __builtin_bit_cast(float, __builtin_amdgcn_readlane(__builtin_bit_cast(int, v), 16)), t2 = __builtin_bit_cast(float, __builtin_amdgcn_readlane(__builtin_bit_cast(int, v), 32));
    const float t3 = __builtin_bit_cast(float, __builtin_amdgcn_readlane(__builtin_bit_cast(int, v), 48));
    const int row = lane >> 4; return v + (row == 3 ? 0.f : row == 2 ? t3 : row == 1 ? t3 + t2 : (t3 + t2) + t1);
}

template <int CTRL> __device__ __forceinline__ int dppi(int v) { return __builtin_amdgcn_update_dpp(0, v, CTRL, 0xF, 0xF, true); }
__device__ __forceinline__ int scan_fwd64_i(int v, int lane) {
    v += dppi<0x111>(v); v += dppi<0x112>(v); v += dppi<0x114>(v); v += dppi<0x118>(v);
    const int t0 = __builtin_amdgcn_readlane(v, 15), t1 = __builtin_amdgcn_readlane(v, 31), t2 = __builtin_amdgcn_readlane(v, 47);
    const int row = lane >> 4; return v + (row == 0 ? 0 : row == 1 ? t0 : row == 2 ? t0 + t1 : t0 + t1 + t2);
}
template <int MT, int NT>
__device__ __forceinline__ void mma_lds(f32x4 (&acc)[MT][NT], const LAS bf16* A, int lda, int m0, const LAS bf16* Bt, int ldb, int n0, int K, int fr, int fq) {
    for (int k0 = 0; k0 < K; k0 += 32) {
        bf16x8 a[MT], b[NT];
#pragma unroll
        for (int mt = 0; mt < MT; ++mt) a[mt] = *(const LAS bf16x8*)(A + (m0 + mt * 16 + fr) * lda + k0 + fq * 8);
#pragma unroll
        for (int nt = 0; nt < NT; ++nt) b[nt] = *(const LAS bf16x8*)(Bt + (n0 + nt * 16 + fr) * ldb + k0 + fq * 8);
#pragma unroll
        for (int mt = 0; mt < MT; ++mt)
#pragma unroll
            for (int nt = 0; nt < NT; ++nt) acc[mt][nt] = __builtin_amdgcn_mfma_f32_16x16x32_bf16(a[mt], b[nt], acc[mt][nt], 0, 0, 0);
    }
}

__device__ __forceinline__ void conv16(float (&acc)[16], const LAS bf16* src, int ld, const LAS float* cw, int cwld) {
#pragma unroll
    for (int c = 0; c < 16; ++c) acc[c] = cw[7 * cwld + c];
#pragma unroll
    for (int tap = 0; tap < 7; ++tap) {
        const bf16x8 x0 = *(const LAS bf16x8*)(src + tap * ld), x1 = *(const LAS bf16x8*)(src + tap * ld + 8);
        const LAS float* w = cw + tap * cwld;
#pragma unroll
        for (int c = 0; c < 8; ++c) { acc[c] += bf2f_s(x0[c]) * w[c]; acc[8 + c] += bf2f_s(x1[c]) * w[8 + c]; }
        if (tap & 1) asm volatile("" ::: "memory");
    }
}
__device__ __forceinline__ void conv8(float (&acc)[8], const LAS bf16* src, int ld, const LAS float* cw, int cwld) {
#pragma unroll
    for (int c = 0; c < 8; ++c) acc[c] = cw[7 * cwld + c];
#pragma unroll
    for (int tap = 0; tap < 7; ++tap) {
        const bf16x8 x0 = *(const LAS bf16x8*)(src + tap * ld);
        const LAS float* w = cw + tap * cwld;
#pragma unroll
        for (int c = 0; c < 8; ++c) acc[c] += bf2f_s(x0[c]) * w[c];
        if (tap & 1) asm volatile("" ::: "memory");
    }
}

#if defined(PROBE_SUB)
#define PB_START(id_, ws_) do { if ((id_) == PROBE_SUB && blockIdx.x == 0 && threadIdx.x == 0) ((unsigned long long*)(ws_))[1100] = __builtin_amdgcn_s_memrealtime(); } while (0)
#define PB_END(id_, ws_) do { if ((id_) == PROBE_SUB && blockIdx.x == 0 && threadIdx.x == 0) { const unsigned long long t1_ = __builtin_amdgcn_s_memrealtime(), t0_ = ((unsigned long long*)(ws_))[1100]; \
        const unsigned bk_ = (unsigned)((t1_ - t0_) / PROBE_TICKS); *((volatile float*)(ws_) + 2048) = (float)(bk_ > 40u ? 40u : bk_) * (1.0f / 40.0f); } } while (0)
#else
#define PB_START(id_, ws_) do {} while (0)
#define PB_END(id_, ws_) do {} while (0)
#endif
__device__ __forceinline__ void transpose_item(const float* W, int K, int N, int k0, int n0, bf16* WT, int drow0, int rmul, LAS float* scr, int lane) {
#pragma unroll 8
    for (int i = 0; i < 32; ++i) { const int kk = 2 * i + (lane >> 5); scr[kk * 33 + (lane & 31)] = W[(size_t)(k0 + kk) * N + n0 + (lane & 31)]; }
    LDS_WAIT(); asm volatile("" ::: "memory");
    const int c = lane & 7;
#pragma unroll
    for (int j = 0; j < 4; ++j) { const int n = (lane >> 3) + 8 * j; const LAS float* s = scr + (8 * c) * 33 + n;
        u32x4 o; o.x = pkbf(s[0 * 33], s[1 * 33]); o.y = pkbf(s[2 * 33], s[3 * 33]); o.z = pkbf(s[4 * 33], s[5 * 33]); o.w = pkbf(s[6 * 33], s[7 * 33]);
        *(GAS u32x4*)(WT + (size_t)(drow0 + rmul * n) * K + k0 + 8 * c) = o; }
    LDS_WAIT(); asm volatile("" ::: "memory");
}
__device__ __forceinline__ void cvt_mixer_weights(LAS unsigned char* lds, unsigned char* ws, const float* w_in, const float* w_out, int gw, int NGW, int wave, int lane) {
    LAS float* scr = (LAS float*)(lds + wave * 16384);
    bf16* WA = (bf16*)(ws + WS_WA); bf16* WB = (bf16*)(ws + WS_WB); bf16* WO = (bf16*)(ws + WS_WO);
    constexpr int I_IN = 16 * 210, I_OUT = 32 * 32;
    for (int it = gw; it < I_IN + I_OUT; it += NGW) {
        if (it < I_IN) { const int kb = it / 210, nb = it % 210, n0 = nb * 32;
            bf16* dst; int drow;
            if (n0 < 4608) { dst = WA; drow = n0; } else if (n0 < 6656) { dst = WB; drow = n0 - 4608; } else { dst = WA; drow = 4608 + (n0 - 6656); }
            transpose_item(w_in, 1024, 6720, kb * 64, n0, dst, drow, 1, scr, lane);
        } else { const int r = it - I_IN, kb = r / 32, nb = r % 32; transpose_item(w_out, 2048, 1024, kb * 64, nb * 32, WO, nb * 32, 1, scr, lane); }
    }
    { u32x4 z = (u32x4){0u, 0u, 0u, 0u}; asm volatile("" : "+v"(z));
      for (int r = gw; r < 192; r += NGW) { GAS u32x4* p = (GAS u32x4*)(WA + (size_t)(4672 + r) * 1024) + lane; p[0] = z; p[64] = z; } }
}
__device__ __forceinline__ void cvt_expert_weights(LAS unsigned char* lds, unsigned char* ws, const float* w_gate, const float* w_up, const float* w_down, int gw, int NGW, int wave, int lane) {
    LAS float* scr = (LAS float*)(lds + wave * 16384);
    bf16* WGU = (bf16*)(ws + WS_WGU); bf16* WD = (bf16*)(ws + WS_WD);
    constexpr int I_G = 16 * 16;
    constexpr int I_D = 8 * 32;
    constexpr int PER_E = 2 * I_G + I_D;
    for (int it = gw; it < NEXP * PER_E; it += NGW) {
        const int e = it / PER_E; int r = it % PER_E;
        if (r < 2 * I_G) { const int up = r >= I_G; if (up) r -= I_G; const int kb = r / 16, nb = r % 16;
            transpose_item((up ? w_up : w_gate) + (size_t)e * 1024 * 512, 1024, 512, kb * 64, nb * 32, WGU + (size_t)e * 1024 * 1024, 2 * (nb * 32) + up, 2, scr, lane);
        } else { r -= 2 * I_G; const int kb = r / 32, nb = r % 32;
            transpose_item(w_down + (size_t)e * 512 * 1024, 512, 1024, kb * 64, nb * 32, WD + (size_t)e * 1024 * 512, nb * 32, 1, scr, lane); }
    }
}

__device__ __forceinline__ void rms_row_regs(const float* xrow, const f32x4 (&w)[4], f32x4 (&v)[4], int lane) {
    const GAS f32x4* xr = (const GAS f32x4*)xrow + lane; float s = 0.f;
#pragma unroll
    for (int j = 0; j < 4; ++j) { v[j] = xr[64 * j]; s += (v[j].x * v[j].x + v[j].y * v[j].y) + (v[j].z * v[j].z + v[j].w * v[j].w); }
    const float rstd = __builtin_amdgcn_rsqf(wave_sum(s) * (1.0f / DM) + EPS);
#pragma unroll
    for (int j = 0; j < 4; ++j) v[j] = v[j] * rstd * w[j];
}
__device__ __forceinline__ void store_row_bf16(bf16* orow, const f32x4 (&v)[4], int lane) {
    GAS u32x2* o8 = (GAS u32x2*)orow + lane;
#pragma unroll
    for (int j = 0; j < 4; ++j) { u32x2 t; t.x = pkbf(v[j].x, v[j].y); t.y = pkbf(v[j].z, v[j].w); o8[64 * j] = t; }
}
__device__ __forceinline__ void load_w4(const float* w, f32x4 (&wv)[4], int lane) {
#pragma unroll
    for (int j = 0; j < 4; ++j) wv[j] = ((const GAS f32x4*)w)[lane + 64 * j];
}
__device__ __forceinline__ void phase_norm(const float* src, const float* w, bf16* XN, int gw, int NGW, int lane) {
    f32x4 wv[4]; load_w4(w, wv, lane);
    for (int m = gw; m < M; m += NGW) { f32x4 v[4]; rms_row_regs(src + (size_t)m * DM, wv, v, lane); store_row_bf16(XN + (size_t)m * DM, v, lane); }
}
__device__ __forceinline__ void zero_region(unsigned char* p, size_t bytes, int gtid, int NGT) {
    GAS u32x4* q = (GAS u32x4*)p; const size_t n = bytes / 16;
    u32x4 z = (u32x4){0u, 0u, 0u, 0u}; asm volatile("" : "+v"(z));
    for (size_t i = gtid; i < n; i += NGT) q[i] = z;
}

__device__ __forceinline__ void phase_norm2_router(LAS unsigned char* lds, const float* h, const float* w2, const float* w_router, bf16* XN, float* aff, int gw, int NGW, int tid, int lane) {
    LAS float* wrT = (LAS float*)lds;
    for (int e = tid; e < 16 * 1024; e += 512) { const int k = e >> 4, x = e & 15; wrT[x * 1024 + k] = w_router[e]; }
    __syncthreads();
    f32x4 wv[4]; load_w4(w2, wv, lane);
    for (int m = gw; m < M; m += NGW) {
        f32x4 v[4]; rms_row_regs(h + (size_t)m * DM, wv, v, lane); store_row_bf16(XN + (size_t)m * DM, v, lane);
        float mine = 0.f;
#pragma unroll 1
        for (int x = 0; x < 16; ++x) { float s = 0.f;
#pragma unroll
            for (int j = 0; j < 4; ++j) { const f32x4 wr = *(const LAS f32x4*)(wrT + x * 1024 + 4 * lane + 256 * j); s += (v[j].x * wr.x + v[j].y * wr.y) + (v[j].z * wr.z + v[j].w * wr.w); }
            s = wave_sum(s); mine = (lane == x) ? s : mine; }
        float mx = mine;
        mx = fmaxf(mx, __shfl_xor(mx, 1)); mx = fmaxf(mx, __shfl_xor(mx, 2)); mx = fmaxf(mx, __shfl_xor(mx, 4)); mx = fmaxf(mx, __shfl_xor(mx, 8));
        const float ex = expf(mine - mx); float den = ex;
        den += __shfl_xor(den, 1); den += __shfl_xor(den, 2); den += __shfl_xor(den, 4); den += __shfl_xor(den, 8);
        if (lane < 16) aff[(size_t)m * 16 + lane] = ex / den;
    }
}

__device__ __forceinline__ void phase_finish(const bf16* og, const bf16* ys, const bf16* yi, const bf16* gates, const float* gnw, const float* snw, bf16* mixed, int gw, int NGW, int lane) {
    float gw_[16], sw_[16];
#pragma unroll
    for (int c = 0; c < 16; ++c) { gw_[c] = gnw[(16 * lane + c) & 127]; sw_[c] = snw[16 * lane + c]; }
    for (int m = gw; m < M; m += NGW) {
        const bf16x8 o0 = *(const GAS bf16x8*)(og + (size_t)m * 1024 + 16 * lane), o1 = *(const GAS bf16x8*)(og + (size_t)m * 1024 + 16 * lane + 8);
        const bf16x8 y0 = *(const GAS bf16x8*)(ys + (size_t)m * 1024 + 16 * lane), y1 = *(const GAS bf16x8*)(ys + (size_t)m * 1024 + 16 * lane + 8);
        const bf16x8 i0 = *(const GAS bf16x8*)(yi + (size_t)m * 1024 + 16 * lane), i1 = *(const GAS bf16x8*)(yi + (size_t)m * 1024 + 16 * lane + 8);
        const bf16x8 g0 = *(const GAS bf16x8*)(gates + (size_t)m * 2048 + 16 * lane), g1 = *(const GAS bf16x8*)(gates + (size_t)m * 2048 + 16 * lane + 8);
        const bf16x8 z0 = *(const GAS bf16x8*)(gates + (size_t)m * 2048 + 1024 + 16 * lane), z1 = *(const GAS bf16x8*)(gates + (size_t)m * 2048 + 1024 + 16 * lane + 8);
        float o[16], t[16]; float so = 0.f, st = 0.f;
#pragma unroll
        for (int c = 0; c < 8; ++c) { o[c] = bf2f_s(o0[c]); o[8 + c] = bf2f_s(o1[c]); t[c] = (bf2f_s(y0[c]) + bf2f_s(i0[c])) * silu(bf2f_s(z0[c])); t[8 + c] = (bf2f_s(y1[c]) + bf2f_s(i1[c])) * silu(bf2f_s(z1[c])); }
#pragma unroll
        for (int c = 0; c < 16; ++c) { so += o[c] * o[c]; st += t[c] * t[c]; }
        so += __shfl_xor(so, 1); so += __shfl_xor(so, 2); so += __shfl_xor(so, 4);
        st += __shfl_xor(st, 1); st += __shfl_xor(st, 2); st += __shfl_xor(st, 4); st += __shfl_xor(st, 8); st += __shfl_xor(st, 16);
        const float ro = __builtin_amdgcn_rsqf(so * (1.0f / 128.f) + EPS), rt = __builtin_amdgcn_rsqf(st * (1.0f / 512.f) + EPS);
        float a[16], b2[16];
#pragma unroll
        for (int c = 0; c < 8; ++c) { a[c] = o[c] * ro * gw_[c] * silu(bf2f_s(g0[c])); a[8 + c] = o[8 + c] * ro * gw_[8 + c] * silu(bf2f_s(g1[c])); }
#pragma unroll
        for (int c = 0; c < 16; ++c) b2[c] = t[c] * rt * sw_[c];
        u32x4 w0, w1, w2, w3;
        w0.x = pkbf(a[0], a[1]); w0.y = pkbf(a[2], a[3]); w0.z = pkbf(a[4], a[5]); w0.w = pkbf(a[6], a[7]);
        w1.x = pkbf(a[8], a[9]); w1.y = pkbf(a[10], a[11]); w1.z = pkbf(a[12], a[13]); w1.w = pkbf(a[14], a[15]);
        w2.x = pkbf(b2[0], b2[1]); w2.y = pkbf(b2[2], b2[3]); w2.z = pkbf(b2[4], b2[5]); w2.w = pkbf(b2[6], b2[7]);
        w3.x = pkbf(b2[8], b2[9]); w3.y = pkbf(b2[10], b2[11]); w3.z = pkbf(b2[12], b2[13]); w3.w = pkbf(b2[14], b2[15]);
        GAS u32x4* mp = (GAS u32x4*)(mixed + (size_t)m * 2048 + 16 * lane);
        mp[0] = w0; mp[1] = w1; mp[128] = w2; mp[129] = w3;
    }
}

__device__ __forceinline__ void phase_topk(LAS unsigned char* lds, const float* aff, int* idx, float* val, int* inv, int be, int tid, int wave, int lane) {
    LAS unsigned* hist = (LAS unsigned*)lds;
    LAS unsigned* ctl = hist + 256;
    LAS unsigned* wsum = hist + 320;
    const int b = be >> 4, e = be & 15;
    unsigned key[16];
#pragma unroll
    for (int i = 0; i < 16; ++i) key[i] = __float_as_uint(aff[((size_t)b * SEQ + tid * 16 + i) * 16 + e]);
    unsigned prefix = 0u, mask = 0u; unsigned krem = CAP;
    for (int pass = 0; pass < 4; ++pass) {
        const int shift = 24 - 8 * pass;
        if (tid < 256) hist[tid] = 0u;
        __syncthreads();
#pragma unroll
        for (int i = 0; i < 16; ++i) if ((key[i] & mask) == prefix) atomicAdd((unsigned*)&hist[(key[i] >> shift) & 255u], 1u);
        __syncthreads();
        if (wave == 0) {
            const u32x4 hb = *(const LAS u32x4*)(hist + 4 * lane); const unsigned sl = hb.x + hb.y + hb.z + hb.w;
            int Si = (int)sl; Si += dppi<0x101>(Si); Si += dppi<0x102>(Si); Si += dppi<0x104>(Si); Si += dppi<0x108>(Si);
            { const int t1 = __builtin_amdgcn_readlane(Si, 16), t2 = __builtin_amdgcn_readlane(Si, 32), t3 = __builtin_amdgcn_readlane(Si, 48); const int row = lane >> 4;
              Si += (row == 3 ? 0 : row == 2 ? t3 : row == 1 ? t3 + t2 : t3 + t2 + t1); }
            const unsigned S = (unsigned)Si;
            const unsigned above = S - sl;
            if (above < krem && krem <= above + sl) { unsigned cum = above; int d;
                if (cum + hb.w >= krem) d = 3; else { cum += hb.w; if (cum + hb.z >= krem) d = 2; else { cum += hb.z; if (cum + hb.y >= krem) d = 1; else { cum += hb.y; d = 0; } } }
                ctl[0] = prefix | ((unsigned)(4 * lane + d) << shift); ctl[1] = krem - cum; } }
        __syncthreads();
        prefix = ctl[0]; krem = ctl[1]; mask |= 255u << shift;
        __syncthreads();
    }
    const unsigned thr = prefix;
    int ngt = 0, neq = 0;
#pragma unroll
    for (int i = 0; i < 16; ++i) { ngt += key[i] > thr; neq += key[i] == thr; }
    const int sg = scan_fwd64_i(ngt, lane), sq = scan_fwd64_i(neq, lane);
    if (lane == 63) { wsum[wave] = (unsigned)sg; wsum[8 + wave] = (unsigned)sq; }
    __syncthreads();
    int bg = 0, bq = 0;
#pragma unroll
    for (int w = 0; w < 8; ++w) if (w < wave) { bg += (int)wsum[w]; bq += (int)wsum[8 + w]; }
    int pg = bg + sg - ngt, pq = bq + sq - neq;
#pragma unroll
    for (int i = 0; i < 16; ++i) {
        const int tok = tid * 16 + i; const bool gt = key[i] > thr, eq = key[i] == thr;
        const bool sel = gt || (eq && pq < (int)krem);
        const int slot = pg + (pq < (int)krem ? pq : (int)krem);
        if (sel) { idx[be * CAP + slot] = tok; val[be * CAP + slot] = __uint_as_float(key[i]); }
        inv[((size_t)b * SEQ + tok) * 16 + e] = sel ? slot : -1;
        pg += gt; pq += eq;
    }
    __syncthreads();
}

__device__ __forceinline__ void phase_gather(const bf16* XN, const int* idx, bf16* XG, int gw, int NGW, int lane) {
    for (int r = gw; r < MEXP; r += NGW) {
        const int b = r >> 14; const int tok = idx[r];
        const GAS u32x4* s = (const GAS u32x4*)(XN + ((size_t)b * SEQ + tok) * DM) + lane; GAS u32x4* d = (GAS u32x4*)(XG + (size_t)r * DM) + lane;
        const u32x4 a = s[0], c = s[64]; d[0] = a; d[64] = c;
    }
}

__device__ __forceinline__ void phase_combine(const float* hin, float* hout, const bf16* Y, const int* inv, const float* val, const float* wn, bf16* XN, bool final_, int gw, int NGW, int lane, float pscale = 1.0f) {
    f32x4 wv[4]; load_w4(wn, wv, lane);
    for (int m = gw; m < M; m += NGW) {
        const int b = m >> 13;
        const GAS f32x4* xr = (const GAS f32x4*)(hin + (size_t)m * DM) + lane; f32x4 v[4];
#pragma unroll
        for (int j = 0; j < 4; ++j) v[j] = xr[64 * j];
        const int myslot = (lane < 16) ? inv[(size_t)m * 16 + lane] : -1;
        for (int e = 0; e < 16; ++e) {
            const int s = __shfl(myslot, e);
            if (s >= 0) {
                const int r = (b * 16 + e) * CAP + s; const float a = val[r];
                const GAS u32x2* yr = (const GAS u32x2*)(Y + (size_t)r * DM) + lane;
#pragma unroll
                for (int j = 0; j < 4; ++j) { const u32x2 t = yr[64 * j];
                    v[j].x += a * __uint_as_float(t.x << 16); v[j].y += a * __uint_as_float(t.x & 0xffff0000u); v[j].z += a * __uint_as_float(t.y << 16); v[j].w += a * __uint_as_float(t.y & 0xffff0000u); }
            }
        }
        float s2 = 0.f;
#pragma unroll
        for (int j = 0; j < 4; ++j) s2 += (v[j].x * v[j].x + v[j].y * v[j].y) + (v[j].z * v[j].z + v[j].w * v[j].w);
        const float rstd = __builtin_amdgcn_rsqf(wave_sum(s2) * (1.0f / DM) + EPS);
        GAS f32x4* ho = (GAS f32x4*)(hout + (size_t)m * DM) + lane;
        if (final_) {
#pragma unroll
            for (int j = 0; j < 4; ++j) ho[64 * j] = v[j] * (rstd * pscale) * wv[j];
        } else {
#pragma unroll
            for (int j = 0; j < 4; ++j) ho[64 * j] = v[j];
            f32x4 nv[4];
#pragma unroll
            for (int j = 0; j < 4; ++j) nv[j] = v[j] * rstd * wv[j];
            store_row_bf16(XN + (size_t)m * DM, nv, lane);
        }
    }
}
namespace gdn {
constexpr int CW = 0;
constexpr int SC = CW + 8 * 320 * 4;
constexpr int Q = SC + 1280;
constexpr int K = Q + 64 * 136 * 2;
constexpr int KDT = K + 64 * 136 * 2;
constexpr int VT = KDT + 128 * 72 * 2;
constexpr int T = VT + 64 * 72 * 2;
constexpr int QKD = T + 64 * 72 * 2;
constexpr int ST = QKD + 64 * 72 * 2;
constexpr int TMP = ST + 64 * 136 * 2;
constexpr int RQ = TMP, RK = RQ + 70 * 136 * 2, RV = RK + 70 * 136 * 2, RAW_END = RV + 70 * 72 * 2;
constexpr int AF = TMP, TF = AF + 64 * 68 * 4, XF = TF + 64 * 68 * 4, INV_END = XF + 3 * 16 * 17 * 4;
constexpr int RT = TMP, UT = RT + 64 * 72 * 2, OS = UT + 64 * 72 * 2, ST_END = OS + 64 * 65 * 4;
static_assert(RAW_END <= MISC_OFF && INV_END <= MISC_OFF && ST_END <= MISC_OFF, "gdn LDS map");
}
__device__ __forceinline__ void gdn_chain(LAS unsigned char* lds, int cid, const bf16* raw, const float* scal, const float* conv_w, const float* conv_b,
                                          const float* A_log, const float* dt_bias, bf16* og, int tid, int wave, int lane) {
    using namespace gdn;
    const int dvh = cid & 1, dir = (cid >> 1) & 1, h = (cid >> 2) & 7, b = cid >> 5;
    const int fr = lane & 15, fq = lane >> 4;
    LAS float* cw = (LAS float*)(lds + CW); LAS float* sc = (LAS float*)(lds + SC);
    LAS bf16* q_ = (LAS bf16*)(lds + Q); LAS bf16* k_ = (LAS bf16*)(lds + K); LAS bf16* kdT = (LAS bf16*)(lds + KDT); LAS bf16* vT = (LAS bf16*)(lds + VT);
    LAS bf16* T_ = (LAS bf16*)(lds + T); LAS bf16* QKd = (LAS bf16*)(lds + QKD); LAS bf16* ST_ = (LAS bf16*)(lds + ST);
    LAS bf16* rq = (LAS bf16*)(lds + RQ); LAS bf16* rk = (LAS bf16*)(lds + RK); LAS bf16* rv = (LAS bf16*)(lds + RV);
    LAS float* Af = (LAS float*)(lds + AF); LAS float* Tf = (LAS float*)(lds + TF); LAS float* Xf = (LAS float*)(lds + XF);
    LAS bf16* rT = (LAS bf16*)(lds + RT); LAS bf16* uT = (LAS bf16*)(lds + UT); LAS float* os = (LAS float*)(lds + OS);
    for (int e = tid; e < 8 * 320; e += 512) { const int r = e / 320, c = e % 320;
        const int gch = c < 128 ? h * 128 + c : (c < 256 ? 1024 + h * 128 + (c - 128) : 2048 + h * 128 + dvh * 64 + (c - 256));
        cw[e] = r < 7 ? conv_w[r * CONV_CH + gch] : conv_b[gch]; }
    for (int e = tid; e < 64 * 136 / 2; e += 512) ((LAS unsigned*)ST_)[e] = 0u;
    const float expA = expf(A_log[dir * 8 + h]), dtb = dt_bias[dir * 8 + h];
    f32x4 sacc[4];
#pragma unroll
    for (int nt = 0; nt < 4; ++nt) sacc[nt] = (f32x4){0.f, 0.f, 0.f, 0.f};
    const size_t rowb = (size_t)b * SEQ;
    __syncthreads();
    for (int n = 0; n < NCHUNK; ++n) {
        const int t0 = (dir ? NCHUNK - 1 - n : n) * 64;
        for (int e = tid; e < 70 * 40; e += 512) { const int r = e / 40, p = e % 40; const int t = t0 - 3 + r;
            u32x4 v = (u32x4){0u, 0u, 0u, 0u};
            const int col = p < 16 ? h * 128 + p * 8 : (p < 32 ? 1024 + h * 128 + (p - 16) * 8 : 2048 + h * 128 + dvh * 64 + (p - 32) * 8);
            if (t >= 0 && t < SEQ) v = *(const GAS u32x4*)(raw + (rowb + t) * CONV_CH + col);
            LAS bf16* d = p < 16 ? rq + r * 136 + p * 8 : (p < 32 ? rk + r * 136 + (p - 16) * 8 : rv + r * 72 + (p - 32) * 8);
            *(LAS u32x4*)d = v; }
        if (wave == 0) { const int i = lane; const int t = t0 + (dir ? 63 - i : i);
            const float braw = scal[(rowb + t) * 64 + dir * 8 + h], araw = scal[(rowb + t) * 64 + 16 + dir * 8 + h];
            const float g = -expA * softplus_f(araw + dtb);
            float gc = g;
#pragma unroll
            for (int o = 1; o < 64; o <<= 1) { const float y = __shfl_up(gc, o); if (i >= o) gc += y; }
            const float gl = __shfl(gc, 63);
            sc[i] = sigmoid_f(braw); sc[64 + i] = gc; sc[128 + i] = expf(gc); sc[192 + i] = expf(gl - gc); if (i == 0) sc[256] = expf(gl); }
        __syncthreads();
        { const int i = tid >> 3, cg = tid & 7; const int o = dir ? 63 - i : i;
          float a[16];
          conv16(a, rq + o * 136 + cg * 16, 136, cw + cg * 16, 320);
          float ss = 0.f;
#pragma unroll
          for (int c = 0; c < 16; ++c) { a[c] = silu(a[c]); ss += a[c] * a[c]; }
          ss += __shfl_xor(ss, 1); ss += __shfl_xor(ss, 2); ss += __shfl_xor(ss, 4);
          float rs = (1.0f / sqrtf(ss + EPS)) * 0.08838834764831845f;
          { u32x4 w0, w1; w0.x = pkbf(a[0] * rs, a[1] * rs); w0.y = pkbf(a[2] * rs, a[3] * rs); w0.z = pkbf(a[4] * rs, a[5] * rs); w0.w = pkbf(a[6] * rs, a[7] * rs);
            w1.x = pkbf(a[8] * rs, a[9] * rs); w1.y = pkbf(a[10] * rs, a[11] * rs); w1.z = pkbf(a[12] * rs, a[13] * rs); w1.w = pkbf(a[14] * rs, a[15] * rs);
            *(LAS u32x4*)(q_ + i * 136 + cg * 16) = w0; *(LAS u32x4*)(q_ + i * 136 + cg * 16 + 8) = w1; }
          conv16(a, rk + o * 136 + cg * 16, 136, cw + 128 + cg * 16, 320);
          ss = 0.f;
#pragma unroll
          for (int c = 0; c < 16; ++c) { a[c] = silu(a[c]); ss += a[c] * a[c]; }
          ss += __shfl_xor(ss, 1); ss += __shfl_xor(ss, 2); ss += __shfl_xor(ss, 4);
          rs = 1.0f / sqrtf(ss + EPS);
          { u32x4 w0, w1; w0.x = pkbf(a[0] * rs, a[1] * rs); w0.y = pkbf(a[2] * rs, a[3] * rs); w0.z = pkbf(a[4] * rs, a[5] * rs); w0.w = pkbf(a[6] * rs, a[7] * rs);
            w1.x = pkbf(a[8] * rs, a[9] * rs); w1.y = pkbf(a[10] * rs, a[11] * rs); w1.z = pkbf(a[12] * rs, a[13] * rs); w1.w = pkbf(a[14] * rs, a[15] * rs);
            *(LAS u32x4*)(k_ + i * 136 + cg * 16) = w0; *(LAS u32x4*)(k_ + i * 136 + cg * 16 + 8) = w1; }
          const float ek = sc[192 + i] * rs;
#pragma unroll
          for (int c = 0; c < 16; ++c) kdT[(cg * 16 + c) * 72 + i] = f2bf1(a[c] * ek);
          float v8[8];
          conv8(v8, rv + o * 72 + cg * 8, 72, cw + 256 + cg * 8, 320);
#pragma unroll
          for (int c = 0; c < 8; ++c) vT[(cg * 8 + c) * 72 + i] = f2bf1(silu(v8[c]));
        }
        __syncthreads();
        { const int which = wave >> 2, mt = wave & 3;
          f32x4 acc[1][4];
#pragma unroll
          for (int nt = 0; nt < 4; ++nt) acc[0][nt] = (f32x4){0.f, 0.f, 0.f, 0.f};
          mma_lds<1, 4>(acc, which ? q_ : k_, 136, mt * 16, k_, 136, 0, 128, fr, fq);
#pragma unroll
          for (int nt = 0; nt < 4; ++nt)
#pragma unroll
              for (int r = 0; r < 4; ++r) { const int i = mt * 16 + 4 * fq + r, j = nt * 16 + fr;
                  const float d = expf(fminf(sc[64 + i] - sc[64 + j], 0.f)); const float x = acc[0][nt][r] * d;
                  if (which == 0) Af[i * 68 + j] = (i > j) ? sc[i] * x : 0.f;
                  else QKd[i * 72 + j] = f2bf1((i >= j) ? x : 0.f); }
        }
        __syncthreads();
        if (wave == 0) { const int blk = lane >> 4, c = lane & 15; float t[16];
#pragma unroll
            for (int i = 0; i < 16; ++i) t[i] = (i == c) ? 1.f : 0.f;
#pragma unroll
            for (int i = 1; i < 16; ++i) { float s = 0.f; const LAS float* ar = Af + (blk * 16 + i) * 68 + blk * 16;
#pragma unroll
                for (int j = 0; j < i; ++j) s += ar[j] * t[j];
                t[i] = (i > c) ? -s : t[i];
                if ((i & 3) == 3) asm volatile("" ::: "memory"); }
#pragma unroll
            for (int i = 0; i < 16; ++i) Tf[(blk * 16 + i) * 68 + blk * 16 + c] = t[i]; }
        for (int d = 1; d <= 3; ++d) { const int nbk = 4 - d;
            __syncthreads();
            for (int e = tid; e < nbk * 256; e += 512) { const int J = e >> 8, r = (e >> 4) & 15, c = e & 15, I = J + d; float s = 0.f;
                for (int kk = J * 16; kk < I * 16; ++kk) s += Af[(I * 16 + r) * 68 + kk] * Tf[kk * 68 + J * 16 + c];
                Xf[(J * 16 + r) * 17 + c] = s; }
            __syncthreads();
            for (int e = tid; e < nbk * 256; e += 512) { const int J = e >> 8, r = (e >> 4) & 15, c = e & 15, I = J + d; float s = 0.f;
#pragma unroll
                for (int m2 = 0; m2 < 16; ++m2) s += Tf[(I * 16 + r) * 68 + I * 16 + m2] * Xf[(J * 16 + m2) * 17 + c];
                Tf[(I * 16 + r) * 68 + J * 16 + c] = -s; }
        }
        __syncthreads();
        for (int e = tid; e < 4096; e += 512) { const int i = e >> 6, j = e & 63; T_[i * 72 + j] = f2bf1(((i >> 4) >= (j >> 4)) ? Tf[i * 68 + j] : 0.f); }
        __syncthreads();
        const int mt = wave & 3, nh = wave >> 2;
        f32x4 aq[2];
        { f32x4 ak[2]; ak[0] = ak[1] = aq[0] = aq[1] = (f32x4){0.f, 0.f, 0.f, 0.f};
          for (int k0 = 0; k0 < 128; k0 += 32) {
              const bf16x8 fk = *(const LAS bf16x8*)(k_ + (mt * 16 + fr) * 136 + k0 + fq * 8), fqv = *(const LAS bf16x8*)(q_ + (mt * 16 + fr) * 136 + k0 + fq * 8);
#pragma unroll
              for (int nl = 0; nl < 2; ++nl) { const bf16x8 fb = *(const LAS bf16x8*)(ST_ + (nh * 32 + nl * 16 + fr) * 136 + k0 + fq * 8);
                  ak[nl] = __builtin_amdgcn_mfma_f32_16x16x32_bf16(fk, fb, ak[nl], 0, 0, 0); aq[nl] = __builtin_amdgcn_mfma_f32_16x16x32_bf16(fqv, fb, aq[nl], 0, 0, 0); } }
          const int i0 = mt * 16 + 4 * fq;
          const f32x4 be4 = *(const LAS f32x4*)(sc + i0), eg4 = *(const LAS f32x4*)(sc + 128 + i0);
#pragma unroll
          for (int nl = 0; nl < 2; ++nl) { const int dv = nh * 32 + nl * 16 + fr;
              const bf16x4 vv = *(const LAS bf16x4*)(vT + dv * 72 + i0);
              float r0 = be4[0] * (bf2f_s(vv[0]) - eg4[0] * ak[nl][0]), r1 = be4[1] * (bf2f_s(vv[1]) - eg4[1] * ak[nl][1]);
              float r2 = be4[2] * (bf2f_s(vv[2]) - eg4[2] * ak[nl][2]), r3 = be4[3] * (bf2f_s(vv[3]) - eg4[3] * ak[nl][3]);
              u32x2 w; w.x = pkbf(r0, r1); w.y = pkbf(r2, r3); *(LAS u32x2*)(rT + dv * 72 + i0) = w;
              aq[nl][0] *= eg4[0]; aq[nl][1] *= eg4[1]; aq[nl][2] *= eg4[2]; aq[nl][3] *= eg4[3]; }
        }
        __syncthreads();
        { f32x4 au[1][2]; au[0][0] = au[0][1] = (f32x4){0.f, 0.f, 0.f, 0.f};
          mma_lds<1, 2>(au, T_, 72, mt * 16, rT, 72, nh * 32, 64, fr, fq);
          const int i0 = mt * 16 + 4 * fq;
#pragma unroll
          for (int nl = 0; nl < 2; ++nl) { const int dv = nh * 32 + nl * 16 + fr; u32x2 w; w.x = pkbf(au[0][nl][0], au[0][nl][1]); w.y = pkbf(au[0][nl][2], au[0][nl][3]); *(LAS u32x2*)(uT + dv * 72 + i0) = w; }
        }
        __syncthreads();
        { f32x4 ao[1][2]; ao[0][0] = aq[0]; ao[0][1] = aq[1];
          mma_lds<1, 2>(ao, QKd, 72, mt * 16, uT, 72, nh * 32, 64, fr, fq);
          const int i0 = mt * 16 + 4 * fq;
#pragma unroll
          for (int nl = 0; nl < 2; ++nl)
#pragma unroll
              for (int r = 0; r < 4; ++r) os[(i0 + r) * 65 + nh * 32 + nl * 16 + fr] = ao[0][nl][r];
          const float egl = sc[256];
          f32x4 as_[1][4];
#pragma unroll
          for (int nt = 0; nt < 4; ++nt) as_[0][nt] = sacc[nt] * egl;
          mma_lds<1, 4>(as_, kdT, 72, wave * 16, uT, 72, 0, 64, fr, fq);
#pragma unroll
          for (int nt = 0; nt < 4; ++nt) { sacc[nt] = as_[0][nt];
              u32x2 w; w.x = pkbf(sacc[nt][0], sacc[nt][1]); w.y = pkbf(sacc[nt][2], sacc[nt][3]); *(LAS u32x2*)(ST_ + (nt * 16 + fr) * 136 + wave * 16 + 4 * fq) = w; }
        }
        __syncthreads();
#pragma unroll
        for (int ii = 0; ii < 4; ++ii) { const int i = wave * 8 + 2 * ii + (lane >> 5), cp = lane & 31; const int t = t0 + (dir ? 63 - i : i);
            atomic_add_bf16x2(og + (rowb + t) * 1024 + h * 128 + dvh * 64 + 2 * cp, os[i * 65 + 2 * cp], os[i * 65 + 2 * cp + 1]); }
        __syncthreads();
    }
}

namespace ssd {
constexpr int CW = 0;
constexpr int SC = CW + 8 * 320 * 4;
constexpr int BM_ = SC + 1280;
constexpr int CM_ = BM_ + 64 * 136 * 2;
constexpr int BT = CM_ + 64 * 136 * 2;
constexpr int XDT = BT + 128 * 72 * 2;
constexpr int XDW = XDT + 64 * 72 * 2;
constexpr int MM = XDW + 64 * 72 * 2;
constexpr int HT = MM + 64 * 72 * 2;
constexpr int TMP = HT + 64 * 136 * 2;
constexpr int RX = TMP, RB = RX + 70 * 72 * 2, RC = RB + 70 * 136 * 2, RAW_END = RC + 70 * 136 * 2;
constexpr int OS = TMP, OS_END = OS + 64 * 65 * 4;
static_assert(RAW_END <= MISC_OFF && OS_END <= MISC_OFF, "ssd LDS map");
}
__device__ __forceinline__ void ssd_chain(LAS unsigned char* lds, int cid, const bf16* raw, const float* scal, const float* conv_w, const float* conv_b,
                                          const float* A_log, const float* dt_bias, const float* Dp, bf16* ys, int tid, int wave, int lane) {
    using namespace ssd;
    const int dir = cid & 1, head = (cid >> 1) & 15, b = cid >> 5; const int g = head >> 3;
    const int fr = lane & 15, fq = lane >> 4;
    LAS float* cw = (LAS float*)(lds + CW); LAS float* sc = (LAS float*)(lds + SC);
    LAS bf16* Bm = (LAS bf16*)(lds + BM_); LAS bf16* Cm = (LAS bf16*)(lds + CM_); LAS bf16* BT_ = (LAS bf16*)(lds + BT);
    LAS bf16* xdt = (LAS bf16*)(lds + XDT); LAS bf16* xdw = (LAS bf16*)(lds + XDW); LAS bf16* Mm = (LAS bf16*)(lds + MM); LAS bf16* hT = (LAS bf16*)(lds + HT);
    LAS bf16* rx = (LAS bf16*)(lds + RX); LAS bf16* rb = (LAS bf16*)(lds + RB); LAS bf16* rc = (LAS bf16*)(lds + RC); LAS float* os = (LAS float*)(lds + OS);
    const int chx = 3072 + head * 64, chb = 4096 + g * 128, chc = 4352 + g * 128;
    for (int e = tid; e < 8 * 320; e += 512) { const int r = e / 320, c = e % 320;
        const int gch = c < 64 ? chx + c : (c < 192 ? chb + (c - 64) : chc + (c - 192));
        cw[e] = r < 7 ? conv_w[r * CONV_CH + gch] : conv_b[gch]; }
    for (int e = tid; e < 64 * 136 / 2; e += 512) ((LAS unsigned*)hT)[e] = 0u;
    const float Ah = -expf(A_log[dir * 16 + head]), dtb = dt_bias[dir * 16 + head], Dh = (dir == 0) ? Dp[head] : 0.f;
    f32x4 hacc[4];
#pragma unroll
    for (int nt = 0; nt < 4; ++nt) hacc[nt] = (f32x4){0.f, 0.f, 0.f, 0.f};
    const size_t rowb = (size_t)b * SEQ;
    __syncthreads();
    for (int n = 0; n < NCHUNK; ++n) {
        const int t0 = (dir ? NCHUNK - 1 - n : n) * 64;
        for (int e = tid; e < 70 * 40; e += 512) { const int r = e / 40, p = e % 40; const int t = t0 - 3 + r;
            u32x4 v = (u32x4){0u, 0u, 0u, 0u};
            const int col = p < 8 ? chx + p * 8 : (p < 24 ? chb + (p - 8) * 8 : chc + (p - 24) * 8);
            if (t >= 0 && t < SEQ) v = *(const GAS u32x4*)(raw + (rowb + t) * CONV_CH + col);
            LAS bf16* d = p < 8 ? rx + r * 72 + p * 8 : (p < 24 ? rb + r * 136 + (p - 8) * 8 : rc + r * 136 + (p - 24) * 8);
            *(LAS u32x4*)d = v; }
        if (wave == 0) { const int i = lane; const int t = t0 + (dir ? 63 - i : i);
            const float dt = softplus_f(scal[(rowb + t) * 64 + 32 + dir * 16 + head] + dtb);
            float cs = dt * Ah;
#pragma unroll
            for (int o = 1; o < 64; o <<= 1) { const float y = __shfl_up(cs, o); if (i >= o) cs += y; }
            const float cl = __shfl(cs, 63);
            sc[i] = dt; sc[64 + i] = cs; sc[128 + i] = expf(cs); sc[192 + i] = expf(cl - cs); if (i == 0) sc[256] = expf(cl); }
        __syncthreads();
        { const int i = tid >> 3, cg = tid & 7; const int o = dir ? 63 - i : i;
          float a[16];
          conv16(a, rb + o * 136 + cg * 16, 136, cw + 64 + cg * 16, 320);
#pragma unroll
          for (int c = 0; c < 16; ++c) a[c] = silu(a[c]);
          { u32x4 w0, w1; w0.x = pkbf(a[0], a[1]); w0.y = pkbf(a[2], a[3]); w0.z = pkbf(a[4], a[5]); w0.w = pkbf(a[6], a[7]);
            w1.x = pkbf(a[8], a[9]); w1.y = pkbf(a[10], a[11]); w1.z = pkbf(a[12], a[13]); w1.w = pkbf(a[14], a[15]);
            *(LAS u32x4*)(Bm + i * 136 + cg * 16) = w0; *(LAS u32x4*)(Bm + i * 136 + cg * 16 + 8) = w1; }
#pragma unroll
          for (int c = 0; c < 16; ++c) BT_[(cg * 16 + c) * 72 + i] = f2bf1(a[c]);
          conv16(a, rc + o * 136 + cg * 16, 136, cw + 192 + cg * 16, 320);
#pragma unroll
          for (int c = 0; c < 16; ++c) a[c] = silu(a[c]);
          { u32x4 w0, w1; w0.x = pkbf(a[0], a[1]); w0.y = pkbf(a[2], a[3]); w0.z = pkbf(a[4], a[5]); w0.w = pkbf(a[6], a[7]);
            w1.x = pkbf(a[8], a[9]); w1.y = pkbf(a[10], a[11]); w1.z = pkbf(a[12], a[13]); w1.w = pkbf(a[14], a[15]);
            *(LAS u32x4*)(Cm + i * 136 + cg * 16) = w0; *(LAS u32x4*)(Cm + i * 136 + cg * 16 + 8) = w1; }
          float x8[8];
          conv8(x8, rx + o * 72 + cg * 8, 72, cw + cg * 8, 320);
          const float dt = sc[i], wst = sc[192 + i];
#pragma unroll
          for (int c = 0; c < 8; ++c) { const float xv = silu(x8[c]) * dt; xdt[(cg * 8 + c) * 72 + i] = f2bf1(xv); xdw[(cg * 8 + c) * 72 + i] = f2bf1(xv * wst); }
        }
        __syncthreads();
        const int mt = wave & 3, nh = wave >> 2;
        { f32x4 acc[1][2]; acc[0][0] = acc[0][1] = (f32x4){0.f, 0.f, 0.f, 0.f};
          mma_lds<1, 2>(acc, Cm, 136, mt * 16, Bm, 136, nh * 32, 128, fr, fq);
#pragma unroll
          for (int nl = 0; nl < 2; ++nl)
#pragma unroll
              for (int r = 0; r < 4; ++r) { const int i = mt * 16 + 4 * fq + r, j = nh * 32 + nl * 16 + fr;
                  const float d = expf(fminf(sc[64 + i] - sc[64 + j], 0.f));
                  Mm[i * 72 + j] = f2bf1((i >= j) ? acc[0][nl][r] * d : 0.f); }
        }
        __syncthreads();
        { f32x4 a1[1][2], a2[1][2]; a1[0][0] = a1[0][1] = a2[0][0] = a2[0][1] = (f32x4){0.f, 0.f, 0.f, 0.f};
          mma_lds<1, 2>(a1, Mm, 72, mt * 16, xdt, 72, nh * 32, 64, fr, fq);
          mma_lds<1, 2>(a2, Cm, 136, mt * 16, hT, 136, nh * 32, 128, fr, fq);
          const int i0 = mt * 16 + 4 * fq;
          const f32x4 ec4 = *(const LAS f32x4*)(sc + 128 + i0), dt4 = *(const LAS f32x4*)(sc + i0);
#pragma unroll
          for (int nl = 0; nl < 2; ++nl) { const int p = nh * 32 + nl * 16 + fr; const bf16x4 xv = *(const LAS bf16x4*)(xdt + p * 72 + i0);
#pragma unroll
              for (int r = 0; r < 4; ++r) os[(i0 + r) * 65 + p] = a1[0][nl][r] + ec4[r] * a2[0][nl][r] + Dh * bf2f_s(xv[r]) / dt4[r]; }
        }
        __syncthreads();
        { const float ecl = sc[256];
          f32x4 ah[1][4];
#pragma unroll
          for (int nt = 0; nt < 4; ++nt) ah[0][nt] = hacc[nt] * ecl;
          mma_lds<1, 4>(ah, BT_, 72, wave * 16, xdw, 72, 0, 64, fr, fq);
#pragma unroll
          for (int nt = 0; nt < 4; ++nt) { hacc[nt] = ah[0][nt];
              u32x2 w; w.x = pkbf(hacc[nt][0], hacc[nt][1]); w.y = pkbf(hacc[nt][2], hacc[nt][3]); *(LAS u32x2*)(hT + (nt * 16 + fr) * 136 + wave * 16 + 4 * fq) = w; }
        }
#pragma unroll
        for (int ii = 0; ii < 4; ++ii) { const int i = wave * 8 + 2 * ii + (lane >> 5), cp = lane & 31; const int t = t0 + (dir ? 63 - i : i);
            atomic_add_bf16x2(ys + (rowb + t) * 1024 + head * 64 + 2 * cp, os[i * 65 + 2 * cp], os[i * 65 + 2 * cp + 1]); }
        __syncthreads();
    }
}
namespace pgd {
constexpr int CW = 0;
constexpr int SC = CW + 8 * 384 * 4;
constexpr int Q = SC + 1280;
constexpr int K = Q + 64 * 136 * 2;
constexpr int VT = K + 64 * 136 * 2;
constexpr int TMP = VT + 128 * 72 * 2;
constexpr int RQ = TMP, RK = RQ + 70 * 136 * 2, RV = RK + 70 * 136 * 2, RAW_END = RV + 70 * 136 * 2;
constexpr int AF = TMP, A2F = AF + 64 * 68 * 4, TF = A2F + 64 * 68 * 4, T2F = TF + 64 * 68 * 4, QKP = T2F + 64 * 68 * 4, INV_END = QKP + 64 * 72 * 2;
constexpr int XF = VT;
constexpr int TP = AF;
constexpr int STASH = MISC_OFF - 16384;
static_assert(RAW_END <= STASH && INV_END <= STASH, "prep gdn LDS map");
}
constexpr size_t WS_TQ = 379 * MiB;

__device__ __forceinline__ void prep_gdn_stash(LAS unsigned char* lds, int bid, const bf16* raw, int tid) {
    const int bh = bid >> 3, b = bh >> 3, h = bh & 7, r8 = bid & 7;
    LAS bf16* st = (LAS bf16*)(lds + pgd::STASH);
    for (int e = tid; e < 2 * 3 * 48; e += 512) { const int which = e / 144, r = (e % 144) / 48, p = e % 48;
        const int t = which ? (r8 * 16 + 16) * 64 + r : r8 * 16 * 64 - 3 + r;
        const int col = p < 16 ? h * 128 + p * 8 : (p < 32 ? 1024 + h * 128 + (p - 16) * 8 : 2048 + h * 128 + (p - 32) * 8);
        u32x4 v = (u32x4){0u, 0u, 0u, 0u};
        if (t >= 0 && t < SEQ) v = *(const GAS u32x4*)(raw + ((size_t)b * SEQ + t) * CONV_CH + col);
        *(LAS u32x4*)(st + which * 1152 + r * 384 + p * 8) = v; }
}
__device__ __forceinline__ void inv_diag_blocks(const LAS float* Af, LAS float* Tf, int lane) {
    const int blk = lane >> 4, c = lane & 15; float t[16];
#pragma unroll
    for (int i = 0; i < 16; ++i) t[i] = (i == c) ? 1.f : 0.f;
#pragma unroll
    for (int i = 1; i < 16; ++i) { float s = 0.f; const LAS float* ar = Af + (blk * 16 + i) * 68 + blk * 16;
#pragma unroll
        for (int j = 0; j < i; ++j) s += ar[j] * t[j];
        t[i] = (i > c) ? -s : t[i];
        if ((i & 3) == 3) asm volatile("" ::: "memory"); }
#pragma unroll
    for (int i = 0; i < 16; ++i) Tf[(blk * 16 + i) * 68 + blk * 16 + c] = t[i];
}
__device__ __forceinline__ void inv_offdiag_x(const LAS float* Af, const LAS float* Tf, LAS float* Xf, int d, int ht) {
    const int nbk = 4 - d;
    for (int e = ht; e < nbk * 256; e += 256) { const int J = e >> 8, r = (e >> 4) & 15, c = e & 15, I = J + d; float s = 0.f;
        for (int kk = J * 16; kk < I * 16; ++kk) s += Af[(I * 16 + r) * 68 + kk] * Tf[kk * 68 + J * 16 + c];
        Xf[(J * 16 + r) * 17 + c] = s; }
}
__device__ __forceinline__ void inv_offdiag_t(LAS float* Tf, const LAS float* Xf, int d, int ht) {
    const int nbk = 4 - d;
    for (int e = ht; e < nbk * 256; e += 256) { const int J = e >> 8, r = (e >> 4) & 15, c = e & 15, I = J + d; float s = 0.f;
#pragma unroll
        for (int m2 = 0; m2 < 16; ++m2) s += Tf[(I * 16 + r) * 68 + I * 16 + m2] * Xf[(J * 16 + m2) * 17 + c];
        Tf[(I * 16 + r) * 68 + J * 16 + c] = -s; }
}

__device__ __forceinline__ void conv_pair8(float (&o)[16], const LAS bf16* src  , int ld, const float (&w)[16]) {
#pragma unroll
    for (int t = 0; t < 8; ++t) { o[2 * t] = w[14]; o[2 * t + 1] = w[15]; }
#pragma unroll
    for (int r = 0; r < 14; ++r) { const unsigned xv = *(const LAS unsigned*)(src + r * ld); const float x0 = __uint_as_float(xv << 16), x1 = __uint_as_float(xv & 0xffff0000u);
#pragma unroll
        for (int t = 0; t < 8; ++t) { const int tap = r - t; if (tap >= 0 && tap < 7) { o[2 * t] += x0 * w[2 * tap]; o[2 * t + 1] += x1 * w[2 * tap + 1]; } } }
}
namespace pg2 {
constexpr int CW = 0;
constexpr int SC = CW + 8 * 384 * 4;
constexpr int Q = SC + 1280;
constexpr int K = Q + 64 * 136 * 2;
constexpr int VT = K + 64 * 136 * 2;
constexpr int RAWT = VT + 128 * 72 * 2;
constexpr int RAW_END = RAWT + 3 * 70 * 136 * 2;
constexpr int ABF = RAWT, TRM = ABF + 2 * 64 * 72 * 2, TTR = TRM + 2 * 64 * 72 * 2, AD = TTR + 2 * 64 * 72 * 2, XS = AD + 2 * 4 * 256 * 4, QKP = XS + 2 * 32 * 40 * 2, INV_END = QKP + 64 * 72 * 2;
static_assert(RAW_END <= pgd::STASH && INV_END <= pgd::STASH, "prep gdn v2 LDS map");
}
__device__ __forceinline__ void prep_gdn_range(LAS unsigned char* lds, int bid, bf16* raw, const float* scal, const float* conv_w, const float* conv_b,
                                               const float* A_log, const float* dt_bias, bf16* TQ, int tid_p, int wave_p, int lane_p, float* scal_w) {
    using namespace pg2;
    int tid = tid_p, wave = wave_p, lane = lane_p;
    const int bh = bid >> 3, b = bh >> 3, h = bh & 7, r8 = bid & 7;
    LAS float* cw = (LAS float*)(lds + CW); LAS float* sc = (LAS float*)(lds + SC);
    LAS bf16* q_ = (LAS bf16*)(lds + Q); LAS bf16* k_ = (LAS bf16*)(lds + K); LAS bf16* vT = (LAS bf16*)(lds + VT);
    LAS bf16* rq = (LAS bf16*)(lds + RAWT); LAS bf16* rk = rq + 70 * 136; LAS bf16* rv = rk + 70 * 136;
    LAS bf16* Abf = (LAS bf16*)(lds + ABF); LAS bf16* Trm = (LAS bf16*)(lds + TRM); LAS bf16* Ttr = (LAS bf16*)(lds + TTR);
    LAS float* ADf = (LAS float*)(lds + AD); LAS bf16* Xs = (LAS bf16*)(lds + XS); LAS bf16* QKp = (LAS bf16*)(lds + QKP);
    LAS bf16* st = (LAS bf16*)(lds + pgd::STASH);
    for (int e = tid; e < 8 * 384; e += 512) { const int r = e / 384, c = e % 384;
        const int gch = (c >> 7) * 1024 + h * 128 + (c & 127);
        cw[e] = r < 7 ? conv_w[r * CONV_CH + gch] : conv_b[gch]; }
    const float LOG2E = 1.4426950408889634f;
    const float expAf = expf(A_log[h]), dtbf = dt_bias[h], expAb = expf(A_log[8 + h]), dtbb = dt_bias[8 + h];
    const size_t rowb = (size_t)b * SEQ;
    u32x4 pre[7];
#define PG2_LOAD(u_) do { const int t0_ = (r8 * 16 + (u_)) * 64; \
        _Pragma("unroll") for (int x = 0; x < 7; ++x) { const int e = tid + 512 * x; const int r = e / 48, p = e % 48; \
            pre[x] = (u32x4){0u, 0u, 0u, 0u}; \
            if (e < 70 * 48 && r >= 3 && !(r >= 67 && (u_) == 15)) { const int col = p < 16 ? h * 128 + p * 8 : (p < 32 ? 1024 + h * 128 + (p - 16) * 8 : 2048 + h * 128 + (p - 32) * 8); \
                pre[x] = *(const GAS u32x4*)(raw + (rowb + t0_ - 3 + r) * CONV_CH + col); } } } while (0)
    PG2_LOAD(0);
    __syncthreads();
    for (int u = 0; u < 16; ++u) {
        tid = tid_p; asm volatile("" : "+v"(tid));
        lane = tid & 63; wave = __builtin_amdgcn_readfirstlane(tid >> 6);
        const int fr = lane & 15, fq = lane >> 4, half = wave >> 2, w4 = wave & 3;
        const int c = r8 * 16 + u, t0 = c * 64;
#pragma unroll
        for (int x = 0; x < 7; ++x) { const int e = tid + 512 * x; const int r = e / 48, p = e % 48;
            if (e < 70 * 48) { u32x4 v = pre[x];
                if (r < 3) v = *(const LAS u32x4*)(st + r * 384 + p * 8);
                else if (r >= 67 && u == 15) v = *(const LAS u32x4*)(st + 1152 + (r - 67) * 384 + p * 8);
                *(LAS u32x4*)((p < 16 ? rq + r * 136 + p * 8 : (p < 32 ? rk + r * 136 + (p - 16) * 8 : rv + r * 136 + (p - 32) * 8))) = v; } }
        if (wave == 0) { const int i = lane; const size_t so = (rowb + t0 + i) * 64;
            const float gc = scan_fwd64(-expAf * softplus_fast(scal[so + 16 + h] + dtbf), i);
            const float be_ = sigmoid_fast(scal[so + h]); sc[i] = be_; sc[64 + i] = gc * LOG2E; scal_w[so + h] = be_; scal_w[so + 16 + h] = gc; }
        if (wave == 1) { const int i = lane; const size_t so = (rowb + t0 + i) * 64;
            const float gc = scan_bwd64(-expAb * softplus_fast(scal[so + 24 + h] + dtbb), i);
            const float be_ = sigmoid_fast(scal[so + 8 + h]); sc[128 + i] = be_; sc[192 + i] = gc * LOG2E; scal_w[so + 8 + h] = be_; scal_w[so + 24 + h] = gc; }
        __syncthreads();
        if (u + 1 < 16) PG2_LOAD(u + 1);
        if (tid < 144) { const int r = tid / 48, p = tid % 48;
            const LAS bf16* s = p < 16 ? rq + (64 + r) * 136 + p * 8 : (p < 32 ? rk + (64 + r) * 136 + (p - 16) * 8 : rv + (64 + r) * 136 + (p - 32) * 8);
            *(LAS u32x4*)(st + r * 384 + p * 8) = *(const LAS u32x4*)s; }
        { const int tg = wave, cp = lane; float w[16], o[16];
#pragma unroll
          for (int tap = 0; tap < 8; ++tap) { w[2 * tap] = cw[tap * 384 + 2 * cp]; w[2 * tap + 1] = cw[tap * 384 + 2 * cp + 1]; }
          conv_pair8(o, rq + (8 * tg) * 136 + 2 * cp, 136, w);
#pragma unroll
          for (int t = 0; t < 8; ++t) { o[2 * t] = silu(o[2 * t]); o[2 * t + 1] = silu(o[2 * t + 1]);
              const float rs = __builtin_amdgcn_rsqf(wave_sum(o[2 * t] * o[2 * t] + o[2 * t + 1] * o[2 * t + 1]) + EPS) * 0.08838834764831845f;
              const unsigned pk = pkbf(o[2 * t] * rs, o[2 * t + 1] * rs);
              *(LAS unsigned*)(q_ + (8 * tg + t) * 136 + 2 * cp) = pk; *(GAS unsigned*)(raw + (rowb + t0 + 8 * tg + t) * CONV_CH + h * 128 + 2 * cp) = pk; }
#pragma unroll
          for (int tap = 0; tap < 8; ++tap) { w[2 * tap] = cw[tap * 384 + 128 + 2 * cp]; w[2 * tap + 1] = cw[tap * 384 + 128 + 2 * cp + 1]; }
          conv_pair8(o, rk + (8 * tg) * 136 + 2 * cp, 136, w);
#pragma unroll
          for (int t = 0; t < 8; ++t) { o[2 * t] = silu(o[2 * t]); o[2 * t + 1] = silu(o[2 * t + 1]);
              const float rs = __builtin_amdgcn_rsqf(wave_sum(o[2 * t] * o[2 * t] + o[2 * t + 1] * o[2 * t + 1]) + EPS);
              const unsigned pk = pkbf(o[2 * t] * rs, o[2 * t + 1] * rs);
              *(LAS unsigned*)(k_ + (8 * tg + t) * 136 + 2 * cp) = pk; *(GAS unsigned*)(raw + (rowb + t0 + 8 * tg + t) * CONV_CH + 1024 + h * 128 + 2 * cp) = pk; }
#pragma unroll
          for (int tap = 0; tap < 8; ++tap) { w[2 * tap] = cw[tap * 384 + 256 + 2 * cp]; w[2 * tap + 1] = cw[tap * 384 + 256 + 2 * cp + 1]; }
          conv_pair8(o, rv + (8 * tg) * 136 + 2 * cp, 136, w);
#pragma unroll
          for (int t = 0; t < 16; ++t) o[t] = silu(o[t]);
          u32x4 e0, e1; e0.x = pkbf(o[0], o[2]); e0.y = pkbf(o[4], o[6]); e0.z = pkbf(o[8], o[10]); e0.w = pkbf(o[12], o[14]);
          e1.x = pkbf(o[1], o[3]); e1.y = pkbf(o[5], o[7]); e1.z = pkbf(o[9], o[11]); e1.w = pkbf(o[13], o[15]);
          *(LAS u32x4*)(vT + (2 * cp) * 72 + 8 * tg) = e0; *(LAS u32x4*)(vT + (2 * cp + 1) * 72 + 8 * tg) = e1;
        }
        __syncthreads();
        for (int e = tid; e < 128 * 8; e += 512) { const int dv = e >> 3, p = e & 7;
            *(GAS u32x4*)(raw + (rowb + t0 + (dv >> 1)) * CONV_CH + 2048 + h * 128 + (dv & 1) * 64 + p * 8) = *(const LAS u32x4*)(vT + dv * 72 + p * 8); }
        for (int e = tid; e < 2 * 2 * 64 * 72 * 2 / 16; e += 512) ((LAS u32x4*)(lds + TRM))[e] = (u32x4){0u, 0u, 0u, 0u};
        for (int e = tid; e < 2 * 32 * 40 * 2 / 16; e += 512) ((LAS u32x4*)(lds + XS))[e] = (u32x4){0u, 0u, 0u, 0u};
        { const int mt = w4;
          f32x4 acc[1][4];
#pragma unroll
          for (int nt = 0; nt < 4; ++nt) acc[0][nt] = (f32x4){0.f, 0.f, 0.f, 0.f};
          mma_lds<1, 4>(acc, half ? q_ : k_, 136, mt * 16, k_, 136, 0, 128, fr, fq);
          const int i0 = mt * 16 + 4 * fq;
          const f32x4 gfi = *(const LAS f32x4*)(sc + 64 + i0), gbi = *(const LAS f32x4*)(sc + 192 + i0), bfi = *(const LAS f32x4*)(sc + i0), bbi = *(const LAS f32x4*)(sc + 128 + i0);
          float gfj[4], gbj[4];
#pragma unroll
          for (int nt = 0; nt < 4; ++nt) { gfj[nt] = sc[64 + nt * 16 + fr]; gbj[nt] = sc[192 + nt * 16 + fr]; }
          asm volatile("" ::: "memory");
#pragma unroll
          for (int nt = 0; nt < 4; ++nt)
#pragma unroll
              for (int r = 0; r < 4; ++r) { const int i = i0 + r, j = nt * 16 + fr; const bool lower = i > j, upper = i < j;
                  const float argl = gfi[r] - gfj[nt], argu = gbi[r] - gbj[nt];
                  const float x = acc[0][nt][r] * __builtin_amdgcn_exp2f(fminf(lower ? argl : argu, 0.f));
                  if (half == 0) { const float af = lower ? bfi[r] * x : 0.f, ab = upper ? bbi[r] * x : 0.f;
                      Abf[i * 72 + j] = f2bf1(af); Abf[64 * 72 + j * 72 + i] = f2bf1(ab);
                      if (mt == nt) { ADf[(mt * 16 + (i & 15)) * 16 + (j & 15)] = af; ADf[1024 + (mt * 16 + (j & 15)) * 16 + (i & 15)] = ab; } }
                  else QKp[i * 72 + j] = f2bf1(i == j ? acc[0][nt][r] : x); }
        }
        __syncthreads();
        { LAS bf16* Ab = Abf + half * 64 * 72; LAS bf16* Tr = Trm + half * 64 * 72; LAS bf16* Tt = Ttr + half * 64 * 72; LAS bf16* Xh = Xs + half * 32 * 40;
          if (w4 == 0) { const int blk = lane >> 4, cc = lane & 15; float t[16]; const LAS float* ad = ADf + half * 1024 + blk * 256;
#pragma unroll
              for (int i = 0; i < 16; ++i) t[i] = (i == cc) ? 1.f : 0.f;
#pragma unroll
              for (int i = 1; i < 16; ++i) { float s0 = 0.f, s1 = 0.f;
#pragma unroll
                  for (int j = 0; j < i; ++j) { if (j & 1) s1 += ad[i * 16 + j] * t[j]; else s0 += ad[i * 16 + j] * t[j]; }
                  t[i] = (i > cc) ? -(s0 + s1) : t[i];
                  if ((i & 3) == 3) asm volatile("" ::: "memory"); }
#pragma unroll
              for (int i = 0; i < 16; ++i) { const unsigned short tb = f2bf1(t[i]); Tr[(blk * 16 + i) * 72 + blk * 16 + cc] = tb; Tt[(blk * 16 + cc) * 72 + blk * 16 + i] = tb; } }
          __syncthreads();
          f32x4 a1[1][1];
          if (w4 < 2) { const int J = 2 * w4, I = J + 1; a1[0][0] = (f32x4){0.f, 0.f, 0.f, 0.f};
              mma_lds<1, 1>(a1, Ab + 16 * J, 72, 16 * I, Tt + 16 * J, 72, 16 * J, 32, fr, fq);
              u32x2 wv; wv.x = pkbf(a1[0][0][0], a1[0][0][1]); wv.y = pkbf(a1[0][0][2], a1[0][0][3]);
              *(LAS u32x2*)(Xh + (w4 * 16 + fr) * 40 + 4 * fq) = wv; }
          __syncthreads();
          if (w4 < 2) { const int J = 2 * w4, I = J + 1; a1[0][0] = (f32x4){0.f, 0.f, 0.f, 0.f};
              mma_lds<1, 1>(a1, Tr + 16 * I, 72, 16 * I, Xh, 40, w4 * 16, 32, fr, fq);
#pragma unroll
              for (int r = 0; r < 4; ++r) Tr[(16 * I + 4 * fq + r) * 72 + 16 * J + fr] = f2bf1(-a1[0][0][r]);
              u32x2 wv; wv.x = pkbf(-a1[0][0][0], -a1[0][0][1]); wv.y = pkbf(-a1[0][0][2], -a1[0][0][3]);
              *(LAS u32x2*)(Tt + (16 * J + fr) * 72 + 16 * I + 4 * fq) = wv; }
          __syncthreads();
          { const int mt2 = w4 >> 1, nt2 = w4 & 1; a1[0][0] = (f32x4){0.f, 0.f, 0.f, 0.f};
            mma_lds<1, 1>(a1, Ab, 72, 32 + 16 * mt2, Tt, 72, 16 * nt2, 32, fr, fq);
            u32x2 wv; wv.x = pkbf(a1[0][0][0], a1[0][0][1]); wv.y = pkbf(a1[0][0][2], a1[0][0][3]);
            __syncthreads();
            *(LAS u32x2*)(Xh + (16 * nt2 + fr) * 40 + 16 * mt2 + 4 * fq) = wv;
            __syncthreads();
            a1[0][0] = (f32x4){0.f, 0.f, 0.f, 0.f};
            mma_lds<1, 1>(a1, Tr + 32, 72, 32 + 16 * mt2, Xh, 40, 16 * nt2, 32, fr, fq);
#pragma unroll
            for (int r = 0; r < 4; ++r) Tr[(32 + 16 * mt2 + 4 * fq + r) * 72 + 16 * nt2 + fr] = f2bf1(-a1[0][0][r]);
            u32x2 w2; w2.x = pkbf(-a1[0][0][0], -a1[0][0][1]); w2.y = pkbf(-a1[0][0][2], -a1[0][0][3]);
            *(LAS u32x2*)(Tt + (16 * nt2 + fr) * 72 + 32 + 16 * mt2 + 4 * fq) = w2; }
        }
        __syncthreads();
        { bf16* tq = TQ + ((size_t)(bh * NCHUNK + c)) * 8192;
          for (int e = tid; e < 1024; e += 512) { const int which = e >> 9, i = (e >> 3) & 63, p = e & 7;
              if (which) *(GAS u32x4*)(tq + 4096 + i * 64 + p * 8) = *(const LAS u32x4*)(QKp + i * 72 + p * 8);
              else { const bf16x8 lo = *(const LAS bf16x8*)(Trm + i * 72 + p * 8), up = *(const LAS bf16x8*)(Ttr + 64 * 72 + i * 72 + p * 8); bf16x8 o8;
#pragma unroll
                  for (int y = 0; y < 8; ++y) { const int j = p * 8 + y; o8[y] = (i > j) ? lo[y] : (i < j ? up[y] : (short)0x3F80); }
                  *(GAS bf16x8*)(tq + i * 64 + p * 8) = o8; } } }
        __syncthreads();
    }
#undef PG2_LOAD
}

__device__ __forceinline__ void gdn_state_v1(LAS unsigned char* lds, int cid, const bf16* raw, const float* scal, const bf16* TQ,
                                             const float* A_log, const float* dt_bias, bf16* og, int tid, int wave, int lane) {
    using namespace gdn;
    const int dvh = cid & 1, dir = (cid >> 1) & 1, h = (cid >> 2) & 7, b = cid >> 5;
    const int fr = lane & 15, fq = lane >> 4;
    LAS float* sc = (LAS float*)(lds + SC);
    LAS bf16* q_ = (LAS bf16*)(lds + Q); LAS bf16* k_ = (LAS bf16*)(lds + K); LAS bf16* kdT = (LAS bf16*)(lds + KDT); LAS bf16* vT = (LAS bf16*)(lds + VT);
    LAS bf16* T_ = (LAS bf16*)(lds + T); LAS bf16* QKd = (LAS bf16*)(lds + QKD); LAS bf16* ST_ = (LAS bf16*)(lds + ST);
    LAS bf16* rT = (LAS bf16*)(lds + RT); LAS bf16* uT = (LAS bf16*)(lds + UT); LAS float* os = (LAS float*)(lds + OS);
    for (int e = tid; e < 64 * 136 / 2; e += 512) ((LAS unsigned*)ST_)[e] = 0u;
    const float expA = expf(A_log[dir * 8 + h]), dtb = dt_bias[dir * 8 + h];
    f32x4 sacc[4];
#pragma unroll
    for (int nt = 0; nt < 4; ++nt) sacc[nt] = (f32x4){0.f, 0.f, 0.f, 0.f};
    const size_t rowb = (size_t)b * SEQ; const int bh = b * 8 + h;
    __syncthreads();
    for (int n = 0; n < NCHUNK; ++n) {
        const int c = dir ? NCHUNK - 1 - n : n, t0 = c * 64;
        for (int e = tid; e < 64 * 16; e += 512) { const int r = e >> 4, p = e & 15;
            *(LAS u32x4*)(q_ + r * 136 + p * 8) = *(const GAS u32x4*)(raw + (rowb + t0 + r) * CONV_CH + h * 128 + p * 8);
            *(LAS u32x4*)(k_ + r * 136 + p * 8) = *(const GAS u32x4*)(raw + (rowb + t0 + r) * CONV_CH + 1024 + h * 128 + p * 8); }
        { const int dvl = tid >> 3, p = tid & 7; const int dv = dvh * 64 + dvl;
          *(LAS u32x4*)(vT + dvl * 72 + p * 8) = *(const GAS u32x4*)(raw + (rowb + t0 + (dv >> 1)) * CONV_CH + 2048 + h * 128 + (dv & 1) * 64 + p * 8); }
        { const bf16* tq = TQ + ((size_t)(bh * NCHUNK + c)) * 8192;
          for (int e = tid; e < 1024; e += 512) { const int which = e >> 9, i = (e >> 3) & 63, p = e & 7;
              bf16x8 v = *(const GAS bf16x8*)(tq + which * 4096 + i * 64 + p * 8);
#pragma unroll
              for (int x = 0; x < 8; ++x) { const int j = p * 8 + x; const bool keep = dir ? (i < j) : (i > j);
                  if (i == j) { if (which == 0) v[x] = (short)0x3F80; } else if (!keep) v[x] = 0; }
              *(LAS bf16x8*)((which ? QKd : T_) + i * 72 + p * 8) = v; } }
        if (wave == 0) { const int i = lane; const size_t so = (rowb + t0 + i) * 64;
            const float g = -expA * softplus_f(scal[so + 16 + dir * 8 + h] + dtb); float gc = g;
            if (dir == 0) {
#pragma unroll
                for (int o = 1; o < 64; o <<= 1) { const float y = __shfl_up(gc, o); if (i >= o) gc += y; }
            } else {
#pragma unroll
                for (int o = 1; o < 64; o <<= 1) { const float y = __shfl_down(gc, o); if (i + o < 64) gc += y; }
            }
            const float gl = __shfl(gc, dir ? 0 : 63);
            sc[i] = sigmoid_f(scal[so + dir * 8 + h]); sc[64 + i] = gc; sc[128 + i] = expf(gc); sc[192 + i] = expf(gl - gc); if (i == 0) sc[256] = expf(gl); }
        __syncthreads();
        { const int i = tid >> 3, cg = tid & 7; const float ek = sc[192 + i];
          const bf16x8 k0 = *(const LAS bf16x8*)(k_ + i * 136 + cg * 16), k1 = *(const LAS bf16x8*)(k_ + i * 136 + cg * 16 + 8);
#pragma unroll
          for (int x = 0; x < 8; ++x) { kdT[(cg * 16 + x) * 72 + i] = f2bf1(bf2f_s(k0[x]) * ek); kdT[(cg * 16 + 8 + x) * 72 + i] = f2bf1(bf2f_s(k1[x]) * ek); } }
        __syncthreads();
        const int mt = wave & 3, nh = wave >> 2;
        f32x4 aq[2];
        { f32x4 ak[2]; ak[0] = ak[1] = aq[0] = aq[1] = (f32x4){0.f, 0.f, 0.f, 0.f};
          for (int k0 = 0; k0 < 128; k0 += 32) {
              const bf16x8 fk = *(const LAS bf16x8*)(k_ + (mt * 16 + fr) * 136 + k0 + fq * 8), fqv = *(const LAS bf16x8*)(q_ + (mt * 16 + fr) * 136 + k0 + fq * 8);
#pragma unroll
              for (int nl = 0; nl < 2; ++nl) { const bf16x8 fb = *(const LAS bf16x8*)(ST_ + (nh * 32 + nl * 16 + fr) * 136 + k0 + fq * 8);
                  ak[nl] = __builtin_amdgcn_mfma_f32_16x16x32_bf16(fk, fb, ak[nl], 0, 0, 0); aq[nl] = __builtin_amdgcn_mfma_f32_16x16x32_bf16(fqv, fb, aq[nl], 0, 0, 0); } }
          const int i0 = mt * 16 + 4 * fq;
          const f32x4 be4 = *(const LAS f32x4*)(sc + i0), eg4 = *(const LAS f32x4*)(sc + 128 + i0);
#pragma unroll
          for (int nl = 0; nl < 2; ++nl) { const int dv = nh * 32 + nl * 16 + fr;
              const bf16x4 vv = *(const LAS bf16x4*)(vT + dv * 72 + i0);
              float r0 = be4[0] * (bf2f_s(vv[0]) - eg4[0] * ak[nl][0]), r1 = be4[1] * (bf2f_s(vv[1]) - eg4[1] * ak[nl][1]);
              float r2 = be4[2] * (bf2f_s(vv[2]) - eg4[2] * ak[nl][2]), r3 = be4[3] * (bf2f_s(vv[3]) - eg4[3] * ak[nl][3]);
              u32x2 w; w.x = pkbf(r0, r1); w.y = pkbf(r2, r3); *(LAS u32x2*)(rT + dv * 72 + i0) = w;
              aq[nl][0] *= eg4[0]; aq[nl][1] *= eg4[1]; aq[nl][2] *= eg4[2]; aq[nl][3] *= eg4[3]; }
        }
        __syncthreads();
        { f32x4 au[1][2]; au[0][0] = au[0][1] = (f32x4){0.f, 0.f, 0.f, 0.f};
          mma_lds<1, 2>(au, T_, 72, mt * 16, rT, 72, nh * 32, 64, fr, fq);
          const int i0 = mt * 16 + 4 * fq;
#pragma unroll
          for (int nl = 0; nl < 2; ++nl) { const int dv = nh * 32 + nl * 16 + fr; u32x2 w; w.x = pkbf(au[0][nl][0], au[0][nl][1]); w.y = pkbf(au[0][nl][2], au[0][nl][3]); *(LAS u32x2*)(uT + dv * 72 + i0) = w; }
        }
        __syncthreads();
        { f32x4 ao[1][2]; ao[0][0] = aq[0]; ao[0][1] = aq[1];
          mma_lds<1, 2>(ao, QKd, 72, mt * 16, uT, 72, nh * 32, 64, fr, fq);
          const int i0 = mt * 16 + 4 * fq;
#pragma unroll
          for (int nl = 0; nl < 2; ++nl)
#pragma unroll
              for (int r = 0; r < 4; ++r) os[(i0 + r) * 65 + nh * 32 + nl * 16 + fr] = ao[0][nl][r];
          const float egl = sc[256];
          f32x4 as_[1][4];
#pragma unroll
          for (int nt = 0; nt < 4; ++nt) as_[0][nt] = sacc[nt] * egl;
          mma_lds<1, 4>(as_, kdT, 72, wave * 16, uT, 72, 0, 64, fr, fq);
#pragma unroll
          for (int nt = 0; nt < 4; ++nt) { sacc[nt] = as_[0][nt];
              u32x2 w; w.x = pkbf(sacc[nt][0], sacc[nt][1]); w.y = pkbf(sacc[nt][2], sacc[nt][3]); *(LAS u32x2*)(ST_ + (nt * 16 + fr) * 136 + wave * 16 + 4 * fq) = w; }
        }
        __syncthreads();
#pragma unroll
        for (int ii = 0; ii < 4; ++ii) { const int i = wave * 8 + 2 * ii + (lane >> 5), cp = lane & 31;
            atomic_add_bf16x2(og + (rowb + t0 + i) * 1024 + h * 128 + dvh * 64 + 2 * cp, os[i * 65 + 2 * cp], os[i * 65 + 2 * cp + 1]); }
        __syncthreads();
    }
}
typedef float f32x16 __attribute__((ext_vector_type(16)));
typedef short v4i16_t __attribute__((ext_vector_type(4)));
namespace gs2 {
constexpr int KO = 0;
constexpr int QO = KO + 64 * 132 * 2;
constexpr int VTO = QO + 64 * 132 * 2;
constexpr int TO = VTO + 64 * 68 * 2;
constexpr int QKO = TO + 64 * 68 * 2;
constexpr int SCO = QKO + 64 * 68 * 2;
constexpr int BUF = SCO + 1024;
constexpr int OST = 2 * BUF;
constexpr int END = OST + 2 * 64 * 72 * 2;
static_assert(END <= MISC_OFF && BUF % 16 == 0, "gdn state LDS map");
}
__device__ __forceinline__ bf16x8 cvt8(const f32x16& x, int base) {
    u32x4 w; w.x = pkbf(x[base], x[base + 1]); w.y = pkbf(x[base + 2], x[base + 3]); w.z = pkbf(x[base + 4], x[base + 5]); w.w = pkbf(x[base + 6], x[base + 7]);
    return __builtin_bit_cast(bf16x8, w);
}
__device__ __forceinline__ bf16x8 afrag(const LAS bf16* p) {
    const bf16x4 lo = *(const LAS bf16x4*)p, hi = *(const LAS bf16x4*)(p + 8);
    return (bf16x8){lo[0], lo[1], lo[2], lo[3], hi[0], hi[1], hi[2], hi[3]};
}
__device__ __forceinline__ bf16x8 afrag_tr(const LAS bf16* p, int ld) {
    const v4i16_t lo = __builtin_amdgcn_ds_read_tr16_b64_v4i16((LAS v4i16_t*)p), hi = __builtin_amdgcn_ds_read_tr16_b64_v4i16((LAS v4i16_t*)(p + 8 * ld));
    return (bf16x8){lo[0], lo[1], lo[2], lo[3], hi[0], hi[1], hi[2], hi[3]};
}
#define MFMA32(a, b, c) __builtin_amdgcn_mfma_f32_32x32x16_bf16((a), (b), (c), 0, 0, 0)

#ifndef WG_BAR
#define WG_BAR() asm volatile("s_waitcnt lgkmcnt(0)\n\ts_barrier" ::: "memory")
#endif
template <int DIR>
__device__ __forceinline__ void gdn_state2(LAS unsigned char* lds, int b, int h, int half, const bf16* raw, const float* scal, const bf16* TQ,
                                           const float* A_log, const float* dt_bias, bf16* og, int tid, int wave, int lane, float* probe = nullptr) {
    using namespace gs2;
    const size_t rowb = (size_t)b * SEQ; const int bh = b * 8 + h;
    const float expA = expf(A_log[DIR * 8 + h]), dtb = dt_bias[DIR * 8 + h];
    LAS bf16* ost = (LAS bf16*)(lds + OST);
    const int r31 = lane & 31, hh = lane >> 5;
    if (wave == 4 || wave == 5) {
        for (int n = 0; n < NCHUNK + 1; ++n) WG_BAR();
    } else if (wave >= 2) {
        const int hw = (wave & 1) | ((wave >> 2) << 1);
        const int ht = hw * 64 + lane;
        unsigned go[14], lo_[14]; u32x4 ld[14]; float sr0 = 0.f, sr1 = 0.f;
#pragma unroll
        for (int x = 0; x < 4; ++x) { const int e = ht + 256 * x, r = e >> 4, p = e & 15;
            go[x] = (unsigned)((r * CONV_CH + 1024 + h * 128 + p * 8) * 2); go[4 + x] = (unsigned)((r * CONV_CH + h * 128 + p * 8) * 2);
            lo_[x] = (unsigned)(KO + (r * 132 + p * 8) * 2); lo_[4 + x] = (unsigned)(QO + (r * 132 + p * 8) * 2); }
#pragma unroll
        for (int x = 0; x < 2; ++x) { const int e = ht + 256 * x, dvl = e >> 3, p = e & 7; const int dv = 64 * half + dvl;
            go[8 + x] = (unsigned)(((dv >> 1) * CONV_CH + 2048 + h * 128 + (dv & 1) * 64 + p * 8) * 2); lo_[8 + x] = (unsigned)(VTO + (dvl * 68 + p * 8) * 2); }
        u32x4 km[2], dg[2], qm[2];
#pragma unroll
        for (int x = 0; x < 2; ++x) { const int e = ht + 256 * x, i = e >> 3, p = e & 7;
            go[10 + x] = (unsigned)(e * 16); go[12 + x] = (unsigned)(8192 + e * 16);
            lo_[10 + x] = (unsigned)(TO + (i * 68 + p * 8) * 2); lo_[12 + x] = (unsigned)(QKO + (i * 68 + p * 8) * 2);
            unsigned kw[4], dw[4], qw[4];
#pragma unroll
            for (int w = 0; w < 4; ++w) { const int j0 = p * 8 + 2 * w, j1 = j0 + 1;
                const bool k0 = DIR ? (i < j0) : (i > j0), k1 = DIR ? (i < j1) : (i > j1);
                kw[w] = (k0 ? 0xFFFFu : 0u) | (k1 ? 0xFFFF0000u : 0u); dw[w] = (i == j0 ? 0x3F80u : 0u) | (i == j1 ? 0x3F800000u : 0u);
                qw[w] = kw[w] | (i == j0 ? 0xFFFFu : 0u) | (i == j1 ? 0xFFFF0000u : 0u); }
            km[x] = (u32x4){kw[0], kw[1], kw[2], kw[3]}; dg[x] = (u32x4){dw[0], dw[1], dw[2], dw[3]}; qm[x] = (u32x4){qw[0], qw[1], qw[2], qw[3]}; }
        const unsigned so_l = (unsigned)(lane * 256 + (DIR * 8 + h) * 4);
#define GS2_ISSUE(c_) do { const GAS char* rb_ = (const GAS char*)(raw + (rowb + (size_t)(c_) * 64) * CONV_CH); const GAS char* tb_ = (const GAS char*)(TQ + ((size_t)(bh * NCHUNK + (c_))) * 8192); \
            _Pragma("unroll") for (int x = 0; x < 10; ++x) ld[x] = *(const GAS u32x4*)(rb_ + go[x]); \
            _Pragma("unroll") for (int x = 10; x < 14; ++x) ld[x] = *(const GAS u32x4*)(tb_ + go[x]); \
            if (hw == 0) { const GAS char* sb_ = (const GAS char*)(scal + (rowb + (size_t)(c_) * 64) * 64); sr0 = *(const GAS float*)(sb_ + so_l); sr1 = *(const GAS float*)(sb_ + so_l + 64); } } while (0)
#define GS2_ST16(off_, v_) do { LAS unsigned char* d_ = B_ + (off_); *(LAS u32x2*)(d_) = (u32x2){(v_).x, (v_).y}; *(LAS u32x2*)(d_ + 8) = (u32x2){(v_).z, (v_).w}; } while (0)
#define GS2_COMMIT(bi_, c_) do { LAS unsigned char* B_ = lds + (bi_) * BUF; \
            _Pragma("unroll") for (int x = 0; x < 10; ++x) GS2_ST16(lo_[x], ld[x]); \
            _Pragma("unroll") for (int x = 0; x < 2; ++x) { const u32x4 tv = (ld[10 + x] & km[x]) | dg[x], qv = ld[12 + x] & qm[x]; \
                GS2_ST16(lo_[10 + x], tv); GS2_ST16(lo_[12 + x], qv); } \
            if (hw == 0) { LAS float* sc_ = (LAS float*)(B_ + SCO); const int i = lane; const float gc = sr1; const float gl = __shfl(gc, DIR ? 0 : 63); \
                sc_[i] = sr0; sc_[64 + i] = __expf(gc); sc_[128 + i] = __expf(gl - gc); if (i == 0) sc_[192] = __expf(gl); } } while (0)
        { const int c0 = DIR ? NCHUNK - 1 : 0; GS2_ISSUE(c0); GS2_COMMIT(0, c0); GS2_ISSUE((DIR ? c0 - 1 : c0 + 1)); }
        for (int n = 0; n < NCHUNK; ++n) {
            const int c = DIR ? NCHUNK - 1 - n : n;
            WG_BAR();
            const bool more = n + 1 < NCHUNK; const int cn = DIR ? c - 1 : c + 1;
            if (more) { GS2_COMMIT((n + 1) & 1, cn); if (n + 2 < NCHUNK) GS2_ISSUE((DIR ? cn - 1 : cn + 1)); }
            unsigned ov[8];
            if (n > 0) {
#pragma unroll
                for (int x = 0; x < 8; ++x) ov[x] = *(const LAS unsigned*)(ost + ((n - 1) & 1) * (64 * 72) + (hw * 16 + 2 * x + (lane >> 5)) * 72 + 2 * (lane & 31));
            }
            if (n > 0) { const int tp = (DIR ? c + 1 : c - 1) * 64;
#pragma unroll
                for (int x = 0; x < 8; ++x) { GAS char* ob_ = (GAS char*)(og + (rowb + tp + hw * 16 + 2 * x) * 1024 + h * 128 + half * 64);
                    (void)__builtin_amdgcn_global_atomic_fadd_v2bf16((GAS s16x2*)(ob_ + (lane >> 5) * 2048 + (lane & 31) * 4), __builtin_bit_cast(s16x2, ov[x])); } }
        }
        WG_BAR();
        { const int tp = (DIR ? 0 : NCHUNK - 1) * 64;
#pragma unroll
          for (int x = 0; x < 8; ++x) { const unsigned v = *(const LAS unsigned*)(ost + ((NCHUNK - 1) & 1) * (64 * 72) + (hw * 16 + 2 * x + (lane >> 5)) * 72 + 2 * (lane & 31));
              GAS char* ob_ = (GAS char*)(og + (rowb + tp + hw * 16 + 2 * x) * 1024 + h * 128 + half * 64);
              (void)__builtin_amdgcn_global_atomic_fadd_v2bf16((GAS s16x2*)(ob_ + (lane >> 5) * 2048 + (lane & 31) * 4), __builtin_bit_cast(s16x2, v)); } }
#undef GS2_ISSUE
#undef GS2_COMMIT
#undef GS2_ST16
    } else {
        const int dv0 = 32 * wave;
#if defined(PROBE_STATE)
        unsigned long long tw_ = 0ull; const unsigned long long ts0_ = __builtin_amdgcn_s_memtime();
#define PB_BAR() do { const unsigned long long t0_ = __builtin_amdgcn_s_memtime(); WG_BAR(); tw_ += __builtin_amdgcn_s_memtime() - t0_; } while (0)
#else
#define PB_BAR() WG_BAR()
#endif
        f32x16 St[4];
#pragma unroll
        for (int t = 0; t < 4; ++t)
#pragma unroll
            for (int r = 0; r < 16; ++r) St[t][r] = 0.f;
        for (int n = 0; n < NCHUNK; ++n) {
            PB_BAR();
            const LAS unsigned char* Bb = lds + (n & 1) * BUF;
            const LAS bf16* Kb = (const LAS bf16*)(Bb + KO); const LAS bf16* Qb = (const LAS bf16*)(Bb + QO); const LAS bf16* Vb = (const LAS bf16*)(Bb + VTO);
            const LAS bf16* Tb = (const LAS bf16*)(Bb + TO); const LAS bf16* QKb = (const LAS bf16*)(Bb + QKO); const LAS float* sc = (const LAS float*)(Bb + SCO);
            f32x16 aK[2];
#pragma unroll
            for (int m = 0; m < 2; ++m)
#pragma unroll
                for (int r = 0; r < 16; ++r) aK[m][r] = 0.f;
            bf16x8 fa[2][2];
            const int offk = r31 * 132 + 4 * hh;
#define GS2_LD2(P_, bi_, ks_) do { fa[bi_][0] = afrag((P_) + offk + 16 * (ks_)); fa[bi_][1] = afrag((P_) + offk + 32 * 132 + 16 * (ks_)); } while (0)
            GS2_LD2(Kb, 0, 0);
#pragma unroll
            for (int ks = 0; ks < 8; ++ks) {
                if (ks < 7) GS2_LD2(Kb, (ks + 1) & 1, ks + 1);
                __builtin_amdgcn_sched_barrier(0);
                const bf16x8 bs = cvt8(St[ks >> 1], 8 * (ks & 1));
                aK[0] = MFMA32(fa[ks & 1][0], bs, aK[0]); aK[1] = MFMA32(fa[ks & 1][1], bs, aK[1]);
                __builtin_amdgcn_sched_barrier(0); }
            bf16x8 ft[8];
#pragma unroll
            for (int mi = 0; mi < 2; ++mi)
#pragma unroll
                for (int kt = 0; kt < 4; ++kt) { const bool need = DIR ? (kt >= 2 * mi) : (kt <= 2 * mi + 1);
                    if (need) ft[mi * 4 + kt] = afrag(Tb + (32 * mi + r31) * 68 + 16 * kt + 4 * hh); }
#pragma unroll
            for (int m = 0; m < 2; ++m)
#pragma unroll
                for (int q4 = 0; q4 < 4; ++q4) { const int tb = 32 * m + 8 * q4 + 4 * hh;
                    const bf16x4 vv = *(const LAS bf16x4*)(Vb + (dv0 + r31) * 68 + tb); const f32x4 be = *(const LAS f32x4*)(sc + tb), eg = *(const LAS f32x4*)(sc + 64 + tb);
#pragma unroll
                    for (int e = 0; e < 4; ++e) aK[m][4 * q4 + e] = be[e] * (bf2f_s(vv[e]) - eg[e] * aK[m][4 * q4 + e]); }
            const bf16x8 br0 = cvt8(aK[0], 0), br1 = cvt8(aK[0], 8), br2 = cvt8(aK[1], 0), br3 = cvt8(aK[1], 8);
            __builtin_amdgcn_sched_barrier(0);
            f32x16 au[2];
#pragma unroll
            for (int m = 0; m < 2; ++m)
#pragma unroll
                for (int r = 0; r < 16; ++r) au[m][r] = 0.f;
            GS2_LD2(Qb, 0, 0);
#pragma unroll
            for (int mi = 0; mi < 2; ++mi)
#pragma unroll
                for (int kt = 0; kt < 4; ++kt) { const bool need = DIR ? (kt >= 2 * mi) : (kt <= 2 * mi + 1);
                    if (need) au[mi] = MFMA32(ft[mi * 4 + kt], (kt == 0 ? br0 : kt == 1 ? br1 : kt == 2 ? br2 : br3), au[mi]); }
            __builtin_amdgcn_sched_barrier(0);
            f32x16 aQ[2];
#pragma unroll
            for (int m = 0; m < 2; ++m)
#pragma unroll
                for (int r = 0; r < 16; ++r) aQ[m][r] = 0.f;
#pragma unroll
            for (int ks = 0; ks < 8; ++ks) {
                if (ks < 7) GS2_LD2(Qb, (ks + 1) & 1, ks + 1);
                __builtin_amdgcn_sched_barrier(0);
                const bf16x8 bs = cvt8(St[ks >> 1], 8 * (ks & 1));
                aQ[0] = MFMA32(fa[ks & 1][0], bs, aQ[0]); aQ[1] = MFMA32(fa[ks & 1][1], bs, aQ[1]);
                __builtin_amdgcn_sched_barrier(0); }
#undef GS2_LD2
            const bf16x8 bu0 = cvt8(au[0], 0), bu1 = cvt8(au[0], 8), bu2 = cvt8(au[1], 0), bu3 = cvt8(au[1], 8);
#pragma unroll
            for (int m = 0; m < 2; ++m)
#pragma unroll
                for (int q4 = 0; q4 < 4; ++q4) { const int tb = 32 * m + 8 * q4 + 4 * hh; const f32x4 ek = *(const LAS f32x4*)(sc + 128 + tb), eg = *(const LAS f32x4*)(sc + 64 + tb);
#pragma unroll
                    for (int e = 0; e < 4; ++e) { au[m][4 * q4 + e] *= ek[e]; aQ[m][4 * q4 + e] *= eg[e]; } }
            const bf16x8 bd0 = cvt8(au[0], 0), bd1 = cvt8(au[0], 8), bd2 = cvt8(au[1], 0), bd3 = cvt8(au[1], 8);
            __builtin_amdgcn_sched_barrier(0);
            bf16x8 fqk[8];
#pragma unroll
            for (int mi = 0; mi < 2; ++mi)
#pragma unroll
                for (int kt = 0; kt < 4; ++kt) { const bool need = DIR ? (kt >= 2 * mi) : (kt <= 2 * mi + 1);
                    if (need) fqk[mi * 4 + kt] = afrag(QKb + (32 * mi + r31) * 68 + 16 * kt + 4 * hh); }
            const int i16 = r31 & 15; const LAS bf16* kp = Kb + (4 * hh + (i16 >> 2)) * 132 + 16 * (r31 >> 4) + 4 * (i16 & 3);
            bf16x8 fk[2][4];
#define GS2_LDKT(bi_, t_) do { _Pragma("unroll") for (int kt = 0; kt < 4; ++kt) fk[bi_][kt] = afrag_tr(kp + (16 * kt) * 132 + 32 * (t_), 132); } while (0)
            __builtin_amdgcn_sched_barrier(0);
#pragma unroll
            for (int mi = 0; mi < 2; ++mi)
#pragma unroll
                for (int kt = 0; kt < 4; ++kt) { const bool need = DIR ? (kt >= 2 * mi) : (kt <= 2 * mi + 1);
                    if (need) aQ[mi] = MFMA32(fqk[mi * 4 + kt], (kt == 0 ? bu0 : kt == 1 ? bu1 : kt == 2 ? bu2 : bu3), aQ[mi]); }
            GS2_LDKT(0, 0);
            const float egl = sc[192];
#pragma unroll
            for (int mi = 0; mi < 2; ++mi)
#pragma unroll
                for (int r = 0; r < 16; ++r) ost[(n & 1) * (64 * 72) + (32 * mi + (r & 3) + 8 * (r >> 2) + 4 * hh) * 72 + dv0 + r31] = f2bf1(aQ[mi][r]);
#pragma unroll
            for (int t = 0; t < 4; ++t) {
                if (t < 3) GS2_LDKT((t + 1) & 1, t + 1);
                __builtin_amdgcn_sched_barrier(0);
#pragma unroll
                for (int r = 0; r < 16; ++r) St[t][r] *= egl;
                St[t] = MFMA32(fk[t & 1][0], bd0, St[t]); St[t] = MFMA32(fk[t & 1][1], bd1, St[t]);
                St[t] = MFMA32(fk[t & 1][2], bd2, St[t]); St[t] = MFMA32(fk[t & 1][3], bd3, St[t]);
                __builtin_amdgcn_sched_barrier(0); }
#undef GS2_LDKT
        }
        WG_BAR();
#if defined(PROBE_STATE)
        if (blockIdx.x == 0 && tid == 0 && probe) { const unsigned long long tt_ = __builtin_amdgcn_s_memtime() - ts0_; *probe = (float)((double)tw_ / (double)tt_); }
#endif
    }
}
constexpr size_t WS_SSC = 1 * MiB;
namespace psd {
constexpr int CW = 0;
constexpr int SC = CW + 8 * 768 * 4;
constexpr int BM_ = SC + 8 * 4 * 64 * 4;
constexpr int CM_ = BM_ + 64 * 136 * 2;
constexpr int CB = CM_ + 64 * 136 * 2;
constexpr int R = CB + 64 * 68 * 4;
constexpr int RBC = R, RBC_END = R + 70 * 272 * 2;
constexpr int RX = R, XT = RX + 70 * 136 * 2, MM = XT + 128 * 72 * 2, R_END = MM + 2 * 64 * 72 * 2;
constexpr int YST = RX;
constexpr int PRBC = CW + 8 * 768 * 4, PXT = PRBC + 70 * 272 * 2, P_END = PXT + 256 * 72 * 2;
constexpr int STASH = pgd::STASH + 4608;
static_assert(P_END <= pgd::STASH, "prep ssd conv LDS map");
static_assert(RBC_END <= pgd::STASH && R_END <= pgd::STASH && STASH + 9216 <= MISC_OFF, "prep ssd LDS map");
}
__device__ __forceinline__ void prep_ssd_stash(LAS unsigned char* lds, int bid, const bf16* raw, int tid) {
    const int bg = bid >> 5, b = bg >> 1, g = bg & 1, r32 = bid & 31;
    LAS bf16* st = (LAS bf16*)(lds + psd::STASH);
    for (int e = tid; e < 2 * 3 * 96; e += 512) { const int which = e / 288, r = (e % 288) / 96, p = e % 96;
        const int t = which ? (r32 * 4 + 4) * 64 + r : r32 * 4 * 64 - 3 + r;
        const int col = p < 64 ? 3072 + g * 512 + p * 8 : (p < 80 ? 4096 + g * 128 + (p - 64) * 8 : 4352 + g * 128 + (p - 80) * 8);
        u32x4 v = (u32x4){0u, 0u, 0u, 0u};
        if (t >= 0 && t < SEQ) v = *(const GAS u32x4*)(raw + ((size_t)b * SEQ + t) * CONV_CH + col);
        *(LAS u32x4*)(st + which * 2304 + r * 768 + p * 8) = v; }
}
__device__ __forceinline__ void prep_ssd_range(LAS unsigned char* lds, int bid, bf16* raw, const float* conv_w, const float* conv_b, int tid_p,
                                               const float* scal, const float* A_log, const float* dt_bias, float* ssc) {
    using namespace psd;
    const int bg = bid >> 5, b = bg >> 1, g = bg & 1, r32 = bid & 31;
    LAS float* cw = (LAS float*)(lds + CW);
    LAS bf16* rbc = (LAS bf16*)(lds + PRBC); LAS bf16* xT = (LAS bf16*)(lds + PXT);
    LAS bf16* st = (LAS bf16*)(lds + STASH);
    for (int e = tid_p; e < 8 * 768; e += 512) { const int r = e / 768, c = e % 768;
        const int gch = c < 512 ? 3072 + g * 512 + c : (c < 640 ? 4096 + g * 128 + (c - 512) : 4352 + g * 128 + (c - 640));
        cw[e] = r < 7 ? conv_w[r * CONV_CH + gch] : conv_b[gch]; }
    const size_t rowb = (size_t)b * SEQ;
    __syncthreads();
    for (int u = 0; u < 4; ++u) {
        int tid = tid_p; asm volatile("" : "+v"(tid));
        const int lane = tid & 63, wave = __builtin_amdgcn_readfirstlane(tid >> 6);
        const int c = r32 * 4 + u, t0 = c * 64;
        { const int hd = g * 8 + wave, i = lane; const size_t so = (rowb + t0 + i) * 64;
          const float dtf = softplus_fast(scal[so + 32 + hd] + dt_bias[hd]), dtb = softplus_fast(scal[so + 48 + hd] + dt_bias[16 + hd]);
          const float cf = scan_fwd64(dtf * -expf(A_log[hd]), i), cbk = scan_bwd64(dtb * -expf(A_log[16 + hd]), i);
          float* sp = ssc + ((size_t)((b * 16 + hd) * NCHUNK + c)) * 256 + i; sp[0] = dtf; sp[64] = cf; sp[128] = dtb; sp[192] = cbk; }
        for (int ps = 0; ps < 3; ++ps) {
            const int scol = ps == 0 ? 512 : (ps == 1 ? 0 : 256);
            const int gcol = ps == 0 ? 4096 + g * 128 : 3072 + g * 512 + (ps - 1) * 256;
            for (int e = tid; e < 70 * 32; e += 512) { const int r = e >> 5, p = e & 31;
                u32x4 v;
                if (r < 3) v = *(const LAS u32x4*)(st + r * 768 + scol + p * 8);
                else if (r >= 67 && u == 3) v = *(const LAS u32x4*)(st + 2304 + (r - 67) * 768 + scol + p * 8);
                else { const int col = ps == 0 ? (p < 16 ? 4096 + g * 128 + p * 8 : 4352 + g * 128 + (p - 16) * 8) : gcol + p * 8;
                       v = *(const GAS u32x4*)(raw + (rowb + t0 - 3 + r) * CONV_CH + col); }
                *(LAS u32x4*)(rbc + r * 272 + (p < 16 ? p * 8 : 136 + (p - 16) * 8)) = v; }
            __syncthreads();
            if (tid < 96) { const int r = tid >> 5, p = tid & 31;
                *(LAS u32x4*)(st + r * 768 + scol + p * 8) = *(const LAS u32x4*)(rbc + (64 + r) * 272 + (p < 16 ? p * 8 : 136 + (p - 16) * 8)); }
            { const int tg = wave, cp = lane; float w[16], o[16];
#pragma unroll
              for (int hf = 0; hf < 2; ++hf) {
#pragma unroll
                  for (int tap = 0; tap < 8; ++tap) { w[2 * tap] = cw[tap * 768 + scol + hf * 128 + 2 * cp]; w[2 * tap + 1] = cw[tap * 768 + scol + hf * 128 + 2 * cp + 1]; }
                  conv_pair8(o, rbc + (8 * tg) * 272 + hf * 136 + 2 * cp, 272, w);
#pragma unroll
                  for (int t = 0; t < 16; ++t) o[t] = silu(o[t]);
                  if (ps == 0) {
#pragma unroll
                      for (int t = 0; t < 8; ++t) *(GAS unsigned*)(raw + (rowb + t0 + 8 * tg + t) * CONV_CH + (hf ? 4352 : 4096) + g * 128 + 2 * cp) = pkbf(o[2 * t], o[2 * t + 1]);
                  } else {
                      u32x4 e0, e1; e0.x = pkbf(o[0], o[2]); e0.y = pkbf(o[4], o[6]); e0.z = pkbf(o[8], o[10]); e0.w = pkbf(o[12], o[14]);
                      e1.x = pkbf(o[1], o[3]); e1.y = pkbf(o[5], o[7]); e1.z = pkbf(o[9], o[11]); e1.w = pkbf(o[13], o[15]);
                      *(LAS u32x4*)(xT + (hf * 128 + 2 * cp) * 72 + 8 * tg) = e0; *(LAS u32x4*)(xT + (hf * 128 + 2 * cp + 1) * 72 + 8 * tg) = e1; } } }
            __syncthreads();
            if (ps > 0) {
                for (int e = tid; e < 256 * 8; e += 512) { const int xr = e >> 3, p = e & 7; const int hl = (ps - 1) * 4 + (xr >> 6), pp = xr & 63;
                    *(GAS u32x4*)(raw + (rowb + t0 + pp) * CONV_CH + 3072 + (g * 8 + hl) * 64 + p * 8) = *(const LAS u32x4*)(xT + xr * 72 + p * 8); }
                __syncthreads(); }
        }
    }
}
__device__ __forceinline__ void ssd_intra_range(LAS unsigned char* lds, int bid, const bf16* raw, const float* ssc, const float* Dp, bf16* yi, int tid_p) {
    using namespace psd;
    const int bg = bid >> 5, b = bg >> 1, g = bg & 1, r32 = bid & 31;
    LAS float* sc = (LAS float*)(lds + SC);
    LAS bf16* Bm = (LAS bf16*)(lds + BM_); LAS bf16* Cm = (LAS bf16*)(lds + CM_); LAS float* cb = (LAS float*)(lds + CB);
    LAS bf16* xT = (LAS bf16*)(lds + XT); LAS bf16* Mm = (LAS bf16*)(lds + MM); LAS bf16* yst = (LAS bf16*)(lds + YST);
    const size_t rowb = (size_t)b * SEQ;
    for (int u = 0; u < 4; ++u) {
        int tid = tid_p; asm volatile("" : "+v"(tid));
        const int lane = tid & 63, wave = __builtin_amdgcn_readfirstlane(tid >> 6), fr = lane & 15, fq = lane >> 4;
        const int c = r32 * 4 + u, t0 = c * 64;
        const int hd_w = g * 8 + wave;
        for (int e = tid; e < 64 * 32; e += 512) { const int r = e >> 5, p = e & 31;
            const u32x4 v = *(const GAS u32x4*)(raw + (rowb + t0 + r) * CONV_CH + (p < 16 ? 4096 + g * 128 + p * 8 : 4352 + g * 128 + (p - 16) * 8));
            *(LAS u32x4*)((p < 16 ? Bm + r * 136 + p * 8 : Cm + r * 136 + (p - 16) * 8)) = v; }
        { const int i = lane; const float* sp = ssc + ((size_t)((b * 16 + hd_w) * NCHUNK + c)) * 256 + i;
          LAS float* s = sc + wave * 256; s[i] = sp[0]; s[64 + i] = sp[64] * 1.4426950408889634f; s[128 + i] = sp[128]; s[192 + i] = sp[192] * 1.4426950408889634f; }
        __syncthreads();
        { const int mt = wave & 3, nh = wave >> 2;
          f32x4 acc[1][2]; acc[0][0] = acc[0][1] = (f32x4){0.f, 0.f, 0.f, 0.f};
          mma_lds<1, 2>(acc, Cm, 136, mt * 16, Bm, 136, nh * 32, 128, fr, fq);
#pragma unroll
          for (int nl = 0; nl < 2; ++nl)
#pragma unroll
              for (int r = 0; r < 4; ++r) cb[(mt * 16 + 4 * fq + r) * 68 + nh * 32 + nl * 16 + fr] = acc[0][nl][r]; }
        for (int hp = 0; hp < 4; ++hp) {
            __syncthreads();
            for (int e = tid; e < 128 * 8; e += 512) { const int xr = e >> 3, p = e & 7; const int hl = 2 * hp + (xr >> 6), pp = xr & 63;
                *(LAS u32x4*)(xT + xr * 72 + p * 8) = *(const GAS u32x4*)(raw + (rowb + t0 + pp) * CONV_CH + 3072 + (g * 8 + hl) * 64 + p * 8); }
            { const int e = tid >> 8, i = (tid >> 2) & 63, jq = tid & 3; const int hl = 2 * hp + e;
              const LAS float* s = sc + hl * 256; const float Dh = Dp[g * 8 + hl];
              const float csfi = s[64 + i], csbi = s[192 + i], dsum = s[i] + s[128 + i];
#pragma unroll
              for (int jj = 0; jj < 16; jj += 2) { float m2[2];
#pragma unroll
                  for (int y = 0; y < 2; ++y) { const int j = jq * 16 + jj + y; const float cbv = cb[i * 68 + j];
                      const float cfj = s[64 + j], cbj = s[192 + j], dfj = s[j], dbj = s[128 + j];
                      const float arg = (i > j) ? csfi - cfj : csbi - cbj;
                      const float dtj = (i > j) ? dfj : dbj;
                      const float w = (i == j) ? dsum : __builtin_amdgcn_exp2f(fminf(arg, 0.f)) * dtj;
                      m2[y] = cbv * w + ((i == j) ? Dh : 0.f); }
                  *(LAS unsigned*)(Mm + (e * 64 + i) * 72 + jq * 16 + jj) = pkbf(m2[0], m2[1]); } }
            __syncthreads();
            { const int e = wave >> 2, mt = wave & 3;
              f32x4 acc[1][4];
#pragma unroll
              for (int nt = 0; nt < 4; ++nt) acc[0][nt] = (f32x4){0.f, 0.f, 0.f, 0.f};
              mma_lds<1, 4>(acc, xT + e * 64 * 72, 72, mt * 16, Mm + e * 64 * 72, 72, 0, 64, fr, fq);
#pragma unroll
              for (int nt = 0; nt < 4; ++nt) { u32x2 w; w.x = pkbf(acc[0][nt][0], acc[0][nt][1]); w.y = pkbf(acc[0][nt][2], acc[0][nt][3]);
                  *(LAS u32x2*)(yst + (nt * 16 + fr) * 136 + e * 64 + mt * 16 + 4 * fq) = w; } }
            __syncthreads();
            for (int e = tid; e < 64 * 16; e += 512) { const int i = e >> 4, p = e & 15;
                *(GAS u32x4*)(yi + (rowb + t0 + i) * 1024 + (g * 8 + 2 * hp) * 64 + p * 8) = *(const LAS u32x4*)(yst + i * 136 + p * 8); }
        }
        __syncthreads();
    }
}

namespace ss2 {
constexpr int CO = 0;
constexpr int BO = CO + 64 * 132 * 2;
constexpr int XO = BO + 64 * 132 * 2;
constexpr int SCO = XO + 64 * 72 * 2;
constexpr int BUF = SCO + 768;
constexpr int OST = 2 * BUF;
constexpr int END = OST + 2 * 64 * 72 * 2;
static_assert(END <= MISC_OFF && BUF % 16 == 0, "ssd state LDS map");
}
template <int DIR>
__device__ __forceinline__ void ssd_state2(LAS unsigned char* lds, int b, int hd, const bf16* raw, const float* ssc, bf16* ys, int tid, int wave, int lane) {
    using namespace ss2;
    const size_t rowb = (size_t)b * SEQ; const int g = hd >> 3;
    LAS bf16* ost = (LAS bf16*)(lds + OST);
    const int r31 = lane & 31, hh = lane >> 5;
    if (wave == 4 || wave == 5) {
        for (int n = 0; n < NCHUNK + 1; ++n) WG_BAR();
    } else if (wave >= 2) {
        const int hw = (wave & 1) | ((wave >> 2) << 1); const int ht = hw * 64 + lane;
        unsigned go[10], lo_[10]; u32x4 ld[10]; float sr0 = 0.f, sr1 = 0.f;
#pragma unroll
        for (int x = 0; x < 4; ++x) { const int e = ht + 256 * x, r = e >> 4, p = e & 15;
            go[x] = (unsigned)((r * CONV_CH + 4352 + g * 128 + p * 8) * 2); go[4 + x] = (unsigned)((r * CONV_CH + 4096 + g * 128 + p * 8) * 2);
            lo_[x] = (unsigned)(CO + (r * 132 + p * 8) * 2); lo_[4 + x] = (unsigned)(BO + (r * 132 + p * 8) * 2); }
#pragma unroll
        for (int x = 0; x < 2; ++x) { const int e = ht + 256 * x, xr = e >> 3, p = e & 7;
            go[8 + x] = (unsigned)((xr * CONV_CH + 3072 + hd * 64 + p * 8) * 2); lo_[8 + x] = (unsigned)(XO + (xr * 72 + p * 8) * 2); }
#define SS2_ISSUE(c_) do { const GAS char* rb_ = (const GAS char*)(raw + (rowb + (size_t)(c_) * 64) * CONV_CH); \
            _Pragma("unroll") for (int x = 0; x < 10; ++x) ld[x] = *(const GAS u32x4*)(rb_ + go[x]); \
            if (hw == 0) { const float* sp_ = ssc + ((size_t)((b * 16 + hd) * NCHUNK + (c_))) * 256 + DIR * 128 + lane; sr0 = sp_[0]; sr1 = sp_[64]; } } while (0)
#define SS2_COMMIT(bi_, c_) do { LAS unsigned char* B_ = lds + (bi_) * BUF; \
            _Pragma("unroll") for (int x = 0; x < 10; ++x) { LAS unsigned char* d_ = B_ + lo_[x]; *(LAS u32x2*)(d_) = (u32x2){ld[x].x, ld[x].y}; *(LAS u32x2*)(d_ + 8) = (u32x2){ld[x].z, ld[x].w}; } \
            if (hw == 0) { LAS float* sc_ = (LAS float*)(B_ + SCO); const int i = lane; const float cs = sr1; const float cl = __shfl(cs, DIR ? 0 : 63); \
                sc_[i] = __expf(cs); sc_[64 + i] = sr0 * __expf(cl - cs); if (i == 0) sc_[128] = __expf(cl); } } while (0)
        { const int c0 = DIR ? NCHUNK - 1 : 0; SS2_ISSUE(c0); SS2_COMMIT(0, c0); SS2_ISSUE((DIR ? c0 - 1 : c0 + 1)); }
        for (int n = 0; n < NCHUNK; ++n) {
            const int c = DIR ? NCHUNK - 1 - n : n;
            WG_BAR();
            const bool more = n + 1 < NCHUNK; const int cn = DIR ? c - 1 : c + 1;
            if (more) { SS2_COMMIT((n + 1) & 1, cn); if (n + 2 < NCHUNK) SS2_ISSUE((DIR ? cn - 1 : cn + 1)); }
            unsigned ov[8];
            if (n > 0) {
#pragma unroll
                for (int x = 0; x < 8; ++x) ov[x] = *(const LAS unsigned*)(ost + ((n - 1) & 1) * (64 * 72) + (hw * 16 + 2 * x + (lane >> 5)) * 72 + 2 * (lane & 31));
            }
            if (n > 0) { const int tp = (DIR ? c + 1 : c - 1) * 64;
#pragma unroll
                for (int x = 0; x < 8; ++x) { GAS char* ob_ = (GAS char*)(ys + (rowb + tp + hw * 16 + 2 * x) * 1024 + hd * 64);
                    (void)__builtin_amdgcn_global_atomic_fadd_v2bf16((GAS s16x2*)(ob_ + (lane >> 5) * 2048 + (lane & 31) * 4), __builtin_bit_cast(s16x2, ov[x])); } }
        }
        WG_BAR();
        { const int tp = (DIR ? 0 : NCHUNK - 1) * 64;
#pragma unroll
          for (int x = 0; x < 8; ++x) { const unsigned v = *(const LAS unsigned*)(ost + ((NCHUNK - 1) & 1) * (64 * 72) + (hw * 16 + 2 * x + (lane >> 5)) * 72 + 2 * (lane & 31));
              GAS char* ob_ = (GAS char*)(ys + (rowb + tp + hw * 16 + 2 * x) * 1024 + hd * 64);
              (void)__builtin_amdgcn_global_atomic_fadd_v2bf16((GAS s16x2*)(ob_ + (lane >> 5) * 2048 + (lane & 31) * 4), __builtin_bit_cast(s16x2, v)); } }
#undef SS2_ISSUE
#undef SS2_COMMIT
    } else {
        const int ps = wave; const int xrow = ps * 32 + r31;
        f32x16 Ht[4];
#pragma unroll
        for (int t = 0; t < 4; ++t)
#pragma unroll
            for (int r = 0; r < 16; ++r) Ht[t][r] = 0.f;
        for (int n = 0; n < NCHUNK; ++n) {
            WG_BAR();
            const LAS unsigned char* Bb = lds + (n & 1) * BUF;
            const LAS bf16* Cb = (const LAS bf16*)(Bb + CO); const LAS bf16* Bmb = (const LAS bf16*)(Bb + BO); const LAS bf16* Xb = (const LAS bf16*)(Bb + XO);
            const LAS float* sc = (const LAS float*)(Bb + SCO);
            f32x16 aY[2];
#pragma unroll
            for (int m = 0; m < 2; ++m)
#pragma unroll
                for (int r = 0; r < 16; ++r) aY[m][r] = 0.f;
            bf16x8 fa[2][2];
            const int offc = r31 * 132 + 4 * hh;
#define SS2_LD2(bi_, ks_) do { fa[bi_][0] = afrag(Cb + offc + 16 * (ks_)); fa[bi_][1] = afrag(Cb + offc + 32 * 132 + 16 * (ks_)); } while (0)
            SS2_LD2(0, 0);
#pragma unroll
            for (int ks = 0; ks < 8; ++ks) {
                if (ks < 7) SS2_LD2((ks + 1) & 1, ks + 1);
                __builtin_amdgcn_sched_barrier(0);
                const bf16x8 bs = cvt8(Ht[ks >> 1], 8 * (ks & 1));
                aY[0] = MFMA32(fa[ks & 1][0], bs, aY[0]); aY[1] = MFMA32(fa[ks & 1][1], bs, aY[1]);
                __builtin_amdgcn_sched_barrier(0); }
#undef SS2_LD2
            const int i16 = r31 & 15; const LAS bf16* bp = Bmb + (8 * hh + (i16 >> 2)) * 132 + 16 * (r31 >> 4) + 4 * (i16 & 3);
            bf16x8 xf[4];
#pragma unroll
            for (int kt = 0; kt < 4; ++kt) { const bf16x8 xv = *(const LAS bf16x8*)(Xb + xrow * 72 + 16 * kt + 8 * hh);
                const f32x4 w0 = *(const LAS f32x4*)(sc + 64 + 16 * kt + 8 * hh), w1 = *(const LAS f32x4*)(sc + 64 + 16 * kt + 8 * hh + 4);
                u32x4 w; w.x = pkbf(bf2f_s(xv[0]) * w0[0], bf2f_s(xv[1]) * w0[1]); w.y = pkbf(bf2f_s(xv[2]) * w0[2], bf2f_s(xv[3]) * w0[3]);
                w.z = pkbf(bf2f_s(xv[4]) * w1[0], bf2f_s(xv[5]) * w1[1]); w.w = pkbf(bf2f_s(xv[6]) * w1[2], bf2f_s(xv[7]) * w1[3]);
                xf[kt] = __builtin_bit_cast(bf16x8, w); }
            bf16x8 fb[2][4];
#define SS2_LDBT(bi_, t_) do { _Pragma("unroll") for (int kt = 0; kt < 4; ++kt) { const LAS bf16* p_ = bp + (16 * kt) * 132 + 32 * (t_); \
                const v4i16_t lo_ = __builtin_amdgcn_ds_read_tr16_b64_v4i16((LAS v4i16_t*)p_), hi_ = __builtin_amdgcn_ds_read_tr16_b64_v4i16((LAS v4i16_t*)(p_ + 4 * 132)); \
                fb[bi_][kt] = (bf16x8){lo_[0], lo_[1], lo_[2], lo_[3], hi_[0], hi_[1], hi_[2], hi_[3]}; } } while (0)
            SS2_LDBT(0, 0);
#pragma unroll
            for (int m = 0; m < 2; ++m)
#pragma unroll
                for (int q4 = 0; q4 < 4; ++q4) { const f32x4 ec = *(const LAS f32x4*)(sc + 32 * m + 8 * q4 + 4 * hh);
#pragma unroll
                    for (int x = 0; x < 4; ++x) aY[m][4 * q4 + x] *= ec[x]; }
            const float ecl = sc[128];
#pragma unroll
            for (int mi = 0; mi < 2; ++mi)
#pragma unroll
                for (int r = 0; r < 16; ++r) ost[(n & 1) * (64 * 72) + (32 * mi + (r & 3) + 8 * (r >> 2) + 4 * hh) * 72 + ps * 32 + r31] = f2bf1(aY[mi][r]);
#pragma unroll
            for (int t = 0; t < 4; ++t) {
                if (t < 3) SS2_LDBT((t + 1) & 1, t + 1);
                __builtin_amdgcn_sched_barrier(0);
#pragma unroll
                for (int r = 0; r < 16; ++r) Ht[t][r] *= ecl;
                Ht[t] = MFMA32(fb[t & 1][0], xf[0], Ht[t]); Ht[t] = MFMA32(fb[t & 1][1], xf[1], Ht[t]);
                Ht[t] = MFMA32(fb[t & 1][2], xf[2], Ht[t]); Ht[t] = MFMA32(fb[t & 1][3], xf[3], Ht[t]);
                __builtin_amdgcn_sched_barrier(0); }
#undef SS2_LDBT
        }
        WG_BAR();
    }
}
namespace gs3 {
constexpr int LDK = 136, LDT = 72;
constexpr int KO = 0;
constexpr int QO = KO + 64 * LDK * 2;
constexpr int VTO = QO + 64 * LDK * 2;
constexpr int TO = VTO + 64 * LDT * 2;
constexpr int QKO = TO + 64 * LDT * 2;
constexpr int SCO = QKO + 64 * LDT * 2;
constexpr int BUF = SCO + 1024;
constexpr int OST = 2 * BUF;
constexpr int END = OST + 2 * 64 * 72 * 2;
static_assert(END <= MISC_OFF && BUF % 16 == 0, "gdn state3 LDS map");
}
__device__ __forceinline__ bf16x8 pack2(const f32x4& a, const f32x4& b) {
    u32x4 w; w.x = pkbf(a[0], a[1]); w.y = pkbf(a[2], a[3]); w.z = pkbf(b[0], b[1]); w.w = pkbf(b[2], b[3]);
    return __builtin_bit_cast(bf16x8, w);
}
__device__ __forceinline__ bf16x8 afrag16(const LAS bf16* p) {
    const bf16x4 lo = *(const LAS bf16x4*)p, hi = *(const LAS bf16x4*)(p + 16);
    return (bf16x8){lo[0], lo[1], lo[2], lo[3], hi[0], hi[1], hi[2], hi[3]};
}
__device__ __forceinline__ bf16x8 afrag16_tr(const LAS bf16* p, int ld) {
    const v4i16_t lo = __builtin_amdgcn_ds_read_tr16_b64_v4i16((LAS v4i16_t*)p), hi = __builtin_amdgcn_ds_read_tr16_b64_v4i16((LAS v4i16_t*)(p + 16 * ld));
    return (bf16x8){lo[0], lo[1], lo[2], lo[3], hi[0], hi[1], hi[2], hi[3]};
}
#define MFMA16(a, b, c) __builtin_amdgcn_mfma_f32_16x16x32_bf16((a), (b), (c), 0, 0, 0)

constexpr int CW_OFLAG = 16384;
__device__ __forceinline__ void store16_wt(bf16* p, u32x4 v) { asm volatile("global_store_dwordx4 %0, %1, off sc1\n\ts_nop 1" :: "v"(p), "v"(v) : "memory"); }
__device__ __forceinline__ void out_rows(const LAS bf16* ostb, bf16* gbase  , int lane, bool second) {
#pragma unroll
    for (int x = 0; x < 2; ++x) { const int r = 8 * x + (lane >> 3), pc = lane & 7;
        const u32x4 ov = *(const LAS u32x4*)(ostb + r * 72 + pc * 8); bf16* gp = gbase + (size_t)r * 1024 + pc * 8;
        if (!second) store16_wt(gp, ov);
        else { const u32x4 gv = *(const GAS u32x4*)gp; u32x4 o;
            o.x = pkbf(__uint_as_float(ov.x << 16) + __uint_as_float(gv.x << 16), __uint_as_float(ov.x & 0xffff0000u) + __uint_as_float(gv.x & 0xffff0000u));
            o.y = pkbf(__uint_as_float(ov.y << 16) + __uint_as_float(gv.y << 16), __uint_as_float(ov.y & 0xffff0000u) + __uint_as_float(gv.y & 0xffff0000u));
            o.z = pkbf(__uint_as_float(ov.z << 16) + __uint_as_float(gv.z << 16), __uint_as_float(ov.z & 0xffff0000u) + __uint_as_float(gv.z & 0xffff0000u));
            o.w = pkbf(__uint_as_float(ov.w << 16) + __uint_as_float(gv.w << 16), __uint_as_float(ov.w & 0xffff0000u) + __uint_as_float(gv.w & 0xffff0000u));
            *(GAS u32x4*)gp = o; } }
}
__device__ __forceinline__ void out_handshake(unsigned* flags, int mine, int partner, int hw, int lane) {
    asm volatile("s_waitcnt vmcnt(0)" ::: "memory");
    if (lane == 0) { __hip_atomic_store(flags + (mine * 4 + hw) * 16, 1u, __ATOMIC_RELAXED, __HIP_MEMORY_SCOPE_AGENT);
        unsigned sp = 0;
        while (__hip_atomic_load(flags + (partner * 4 + hw) * 16, __ATOMIC_RELAXED, __HIP_MEMORY_SCOPE_AGENT) == 0u) { __builtin_amdgcn_s_sleep(2); if (++sp > (1u << 22)) break; } }
    __builtin_amdgcn_fence(__ATOMIC_ACQUIRE, "agent");
    asm volatile("s_waitcnt vmcnt(0)" ::: "memory");
}

template <int DIR>
__device__ __forceinline__ void gdn_state3(LAS unsigned char* lds, int b, int h, int half, const bf16* raw, const float* scal, const bf16* TQ, bf16* og, int tid, int wave, int lane, unsigned* flags, int cid) {
    using namespace gs3;
    const size_t rowb = (size_t)b * SEQ; const int bh = b * 8 + h;
    LAS bf16* ost = (LAS bf16*)(lds + OST);
    const int fr = lane & 15, fq = lane >> 4;
    if (wave >= 4) {
        const int hw = wave - 4; const int ht = hw * 64 + lane;
        unsigned go[14], lo_[14]; u32x4 ld[14]; float sr0 = 0.f, sr1 = 0.f;
#pragma unroll
        for (int x = 0; x < 4; ++x) { const int e = ht + 256 * x, r = e >> 4, p = e & 15;
            go[x] = (unsigned)((r * CONV_CH + 1024 + h * 128 + p * 8) * 2); go[4 + x] = (unsigned)((r * CONV_CH + h * 128 + p * 8) * 2);
            lo_[x] = (unsigned)(KO + (r * LDK + p * 8) * 2); lo_[4 + x] = (unsigned)(QO + (r * LDK + p * 8) * 2); }
#pragma unroll
        for (int x = 0; x < 2; ++x) { const int e = ht + 256 * x, dvl = e >> 3, p = e & 7; const int dv = 64 * half + dvl;
            go[8 + x] = (unsigned)(((dv >> 1) * CONV_CH + 2048 + h * 128 + (dv & 1) * 64 + p * 8) * 2); lo_[8 + x] = (unsigned)(VTO + (dvl * LDT + p * 8) * 2); }
        u32x4 km[2], dg[2], qm[2];
#pragma unroll
        for (int x = 0; x < 2; ++x) { const int e = ht + 256 * x, i = e >> 3, p = e & 7;
            go[10 + x] = (unsigned)(e * 16); go[12 + x] = (unsigned)(8192 + e * 16);
            lo_[10 + x] = (unsigned)(TO + (i * LDT + p * 8) * 2); lo_[12 + x] = (unsigned)(QKO + (i * LDT + p * 8) * 2);
            unsigned kw[4], dw[4], qw[4];
#pragma unroll
            for (int w = 0; w < 4; ++w) { const int j0 = p * 8 + 2 * w, j1 = j0 + 1;
                const bool k0 = DIR ? (i < j0) : (i > j0), k1 = DIR ? (i < j1) : (i > j1);
                kw[w] = (k0 ? 0xFFFFu : 0u) | (k1 ? 0xFFFF0000u : 0u); dw[w] = (i == j0 ? 0x3F80u : 0u) | (i == j1 ? 0x3F800000u : 0u);
                qw[w] = kw[w] | (i == j0 ? 0xFFFFu : 0u) | (i == j1 ? 0xFFFF0000u : 0u); }
            km[x] = (u32x4){kw[0], kw[1], kw[2], kw[3]}; dg[x] = (u32x4){dw[0], dw[1], dw[2], dw[3]}; qm[x] = (u32x4){qw[0], qw[1], qw[2], qw[3]}; }
        const unsigned so_l = (unsigned)(lane * 256 + (DIR * 8 + h) * 4);
#define GS3_ISSUE(c_) do { const GAS char* rb_ = (const GAS char*)(raw + (rowb + (size_t)(c_) * 64) * CONV_CH); const GAS char* tb_ = (const GAS char*)(TQ + ((size_t)(bh * NCHUNK + (c_))) * 8192); \
            _Pragma("unroll") for (int x = 0; x < 10; ++x) ld[x] = *(const GAS u32x4*)(rb_ + go[x]); \
            _Pragma("unroll") for (int x = 10; x < 14; ++x) ld[x] = *(const GAS u32x4*)(tb_ + go[x]); \
            if (hw == 0) { const GAS char* sb_ = (const GAS char*)(scal + (rowb + (size_t)(c_) * 64) * 64); sr0 = *(const GAS float*)(sb_ + so_l); sr1 = *(const GAS float*)(sb_ + so_l + 64); } } while (0)
#define GS3_COMMIT(bi_, c_) do { LAS unsigned char* B_ = lds + (bi_) * BUF; \
            _Pragma("unroll") for (int x = 0; x < 10; ++x) *(LAS u32x4*)(B_ + lo_[x]) = ld[x]; \
            _Pragma("unroll") for (int x = 0; x < 2; ++x) { *(LAS u32x4*)(B_ + lo_[10 + x]) = (ld[10 + x] & km[x]) | dg[x]; *(LAS u32x4*)(B_ + lo_[12 + x]) = ld[12 + x] & qm[x]; } \
            if (hw == 0) { LAS float* sc_ = (LAS float*)(B_ + SCO); const int i = lane; const float gc = sr1; const float gl = __shfl(gc, DIR ? 0 : 63); \
                sc_[i] = sr0; sc_[64 + i] = __expf(gc); sc_[128 + i] = __expf(gl - gc); if (i == 0) sc_[192] = __expf(gl); } } while (0)
        { const int c0 = DIR ? NCHUNK - 1 : 0; GS3_ISSUE(c0); GS3_COMMIT(0, c0); GS3_ISSUE((DIR ? c0 - 1 : c0 + 1)); }
        for (int n = 0; n < NCHUNK; ++n) {
            const int c = DIR ? NCHUNK - 1 - n : n;
            WG_BAR();
            const bool more = n + 1 < NCHUNK; const int cn = DIR ? c - 1 : c + 1;
            if (more) { GS3_COMMIT((n + 1) & 1, cn); if (n + 2 < NCHUNK) GS3_ISSUE((DIR ? cn - 1 : cn + 1)); }
            if (n > 0) { const int tp = (DIR ? c + 1 : c - 1) * 64;
#pragma unroll
                for (int x = 0; x < 8; ++x) { const unsigned v = *(const LAS unsigned*)(ost + ((n - 1) & 1) * (64 * 72) + (hw * 16 + 2 * x + (lane >> 5)) * 72 + 2 * (lane & 31));
                    GAS char* ob_ = (GAS char*)(og + (rowb + tp + hw * 16 + 2 * x) * 1024 + h * 128 + half * 64);
                    (void)__builtin_amdgcn_global_atomic_fadd_v2bf16((GAS s16x2*)(ob_ + (lane >> 5) * 2048 + (lane & 31) * 4), __builtin_bit_cast(s16x2, v)); } }
        }
        WG_BAR();
        { const int tp = (DIR ? 0 : NCHUNK - 1) * 64;
#pragma unroll
          for (int x = 0; x < 8; ++x) { const unsigned v = *(const LAS unsigned*)(ost + ((NCHUNK - 1) & 1) * (64 * 72) + (hw * 16 + 2 * x + (lane >> 5)) * 72 + 2 * (lane & 31));
              GAS char* ob_ = (GAS char*)(og + (rowb + tp + hw * 16 + 2 * x) * 1024 + h * 128 + half * 64);
              (void)__builtin_amdgcn_global_atomic_fadd_v2bf16((GAS s16x2*)(ob_ + (lane >> 5) * 2048 + (lane & 31) * 4), __builtin_bit_cast(s16x2, v)); } }
#undef GS3_ISSUE
#undef GS3_COMMIT
    } else {
        const int dv0 = 16 * wave;
        f32x4 St[8];
#pragma unroll
        for (int t = 0; t < 8; ++t) St[t] = (f32x4){0.f, 0.f, 0.f, 0.f};
        for (int n = 0; n < NCHUNK; ++n) {
            WG_BAR();
            const LAS unsigned char* Bb = lds + (n & 1) * BUF;
            const LAS bf16* Kb = (const LAS bf16*)(Bb + KO); const LAS bf16* Qb = (const LAS bf16*)(Bb + QO); const LAS bf16* Vb = (const LAS bf16*)(Bb + VTO);
            const LAS bf16* Tb = (const LAS bf16*)(Bb + TO); const LAS bf16* QKb = (const LAS bf16*)(Bb + QKO); const LAS float* sc = (const LAS float*)(Bb + SCO);
            const int offa = fr * LDK + 4 * fq, offt = fr * LDT + 4 * fq;
            bf16x8 bS[4];
#pragma unroll
            for (int ks = 0; ks < 4; ++ks) bS[ks] = pack2(St[2 * ks], St[2 * ks + 1]);
            f32x4 aK[4];
#pragma unroll
            for (int m = 0; m < 4; ++m) aK[m] = (f32x4){0.f, 0.f, 0.f, 0.f};
#pragma unroll
            for (int ks = 0; ks < 4; ++ks) { bf16x8 fa[4];
#pragma unroll
                for (int m = 0; m < 4; ++m) fa[m] = afrag16(Kb + offa + 16 * m * LDK + 32 * ks);
#pragma unroll
                for (int m = 0; m < 4; ++m) aK[m] = MFMA16(fa[m], bS[ks], aK[m]); }
            bf16x8 ft[8];
#pragma unroll
            for (int mi = 0; mi < 4; ++mi)
#pragma unroll
                for (int kt = 0; kt < 2; ++kt) { const bool need = DIR ? (kt >= (mi >> 1)) : (kt <= (mi >> 1));
                    if (need) ft[mi * 2 + kt] = afrag16(Tb + offt + 16 * mi * LDT + 32 * kt); }
#pragma unroll
            for (int m = 0; m < 4; ++m) { const int tb = 16 * m + 4 * fq;
                const bf16x4 vv = *(const LAS bf16x4*)(Vb + (dv0 + fr) * LDT + tb); const f32x4 be = *(const LAS f32x4*)(sc + tb), eg = *(const LAS f32x4*)(sc + 64 + tb);
#pragma unroll
                for (int e = 0; e < 4; ++e) aK[m][e] = be[e] * (bf2f_s(vv[e]) - eg[e] * aK[m][e]); }
            const bf16x8 br0 = pack2(aK[0], aK[1]), br1 = pack2(aK[2], aK[3]);
            f32x4 au[4];
#pragma unroll
            for (int m = 0; m < 4; ++m) au[m] = (f32x4){0.f, 0.f, 0.f, 0.f};
#pragma unroll
            for (int mi = 0; mi < 4; ++mi)
#pragma unroll
                for (int kt = 0; kt < 2; ++kt) { const bool need = DIR ? (kt >= (mi >> 1)) : (kt <= (mi >> 1));
                    if (need) au[mi] = MFMA16(ft[mi * 2 + kt], (kt == 0 ? br0 : br1), au[mi]); }
            f32x4 aQ[4];
#pragma unroll
            for (int m = 0; m < 4; ++m) aQ[m] = (f32x4){0.f, 0.f, 0.f, 0.f};
#pragma unroll
            for (int ks = 0; ks < 4; ++ks) { bf16x8 fa[4];
#pragma unroll
                for (int m = 0; m < 4; ++m) fa[m] = afrag16(Qb + offa + 16 * m * LDK + 32 * ks);
#pragma unroll
                for (int m = 0; m < 4; ++m) aQ[m] = MFMA16(fa[m], bS[ks], aQ[m]); }
            bf16x8 fqk[8];
#pragma unroll
            for (int mi = 0; mi < 4; ++mi)
#pragma unroll
                for (int kt = 0; kt < 2; ++kt) { const bool need = DIR ? (kt >= (mi >> 1)) : (kt <= (mi >> 1));
                    if (need) fqk[mi * 2 + kt] = afrag16(QKb + offt + 16 * mi * LDT + 32 * kt); }
            const bf16x8 bu0 = pack2(au[0], au[1]), bu1 = pack2(au[2], au[3]);
#pragma unroll
            for (int m = 0; m < 4; ++m) { const int tb = 16 * m + 4 * fq; const f32x4 ek = *(const LAS f32x4*)(sc + 128 + tb), eg = *(const LAS f32x4*)(sc + 64 + tb);
#pragma unroll
                for (int e = 0; e < 4; ++e) { au[m][e] *= ek[e]; aQ[m][e] *= eg[e]; } }
            const bf16x8 bd0 = pack2(au[0], au[1]), bd1 = pack2(au[2], au[3]);
#pragma unroll
            for (int mi = 0; mi < 4; ++mi)
#pragma unroll
                for (int kt = 0; kt < 2; ++kt) { const bool need = DIR ? (kt >= (mi >> 1)) : (kt <= (mi >> 1));
                    if (need) aQ[mi] = MFMA16(fqk[mi * 2 + kt], (kt == 0 ? bu0 : bu1), aQ[mi]); }
            const float egl = sc[192];
#pragma unroll
            for (int m = 0; m < 4; ++m)
#pragma unroll
                for (int e = 0; e < 4; ++e) ost[(n & 1) * (64 * 72) + (16 * m + 4 * fq + e) * 72 + dv0 + fr] = f2bf1(aQ[m][e]);
            { const LAS bf16* kp = Kb + (4 * fq + (fr >> 2)) * LDK + 4 * (fr & 3);
#pragma unroll
              for (int t = 0; t < 8; ++t) { const bf16x8 f0 = afrag16_tr(kp + 16 * t, LDK), f1 = afrag16_tr(kp + 32 * LDK + 16 * t, LDK);
                  St[t] = St[t] * egl; St[t] = MFMA16(f0, bd0, St[t]); St[t] = MFMA16(f1, bd1, St[t]); } }
        }
        WG_BAR();
    }
}

namespace ss3 {
constexpr int LDK = 136, LDT = 72;
constexpr int CO = 0;
constexpr int BO = CO + 64 * LDK * 2;
constexpr int XO = BO + 64 * LDK * 2;
constexpr int SCO = XO + 64 * LDT * 2;
constexpr int BUF = SCO + 768;
constexpr int OST = 2 * BUF;
constexpr int END = OST + 2 * 64 * 72 * 2;
static_assert(END <= MISC_OFF && BUF % 16 == 0, "ssd state3 LDS map");
}
template <int DIR>
__device__ __forceinline__ void ssd_state3(LAS unsigned char* lds, int b, int hd, const bf16* raw, const float* ssc, bf16* ys, int tid, int wave, int lane, unsigned* flags, int cid) {
    using namespace ss3;
    const size_t rowb = (size_t)b * SEQ; const int g = hd >> 3;
    LAS bf16* ost = (LAS bf16*)(lds + OST);
    const int fr = lane & 15, fq = lane >> 4;
    if (wave >= 4) {
        const int hw = wave - 4; const int ht = hw * 64 + lane;
        unsigned go[10], lo_[10]; u32x4 ld[10]; float sr0 = 0.f, sr1 = 0.f;
#pragma unroll
        for (int x = 0; x < 4; ++x) { const int e = ht + 256 * x, r = e >> 4, p = e & 15;
            go[x] = (unsigned)((r * CONV_CH + 4352 + g * 128 + p * 8) * 2); go[4 + x] = (unsigned)((r * CONV_CH + 4096 + g * 128 + p * 8) * 2);
            lo_[x] = (unsigned)(CO + (r * LDK + p * 8) * 2); lo_[4 + x] = (unsigned)(BO + (r * LDK + p * 8) * 2); }
#pragma unroll
        for (int x = 0; x < 2; ++x) { const int e = ht + 256 * x, xr = e >> 3, p = e & 7;
            go[8 + x] = (unsigned)((xr * CONV_CH + 3072 + hd * 64 + p * 8) * 2); lo_[8 + x] = (unsigned)(XO + (xr * LDT + p * 8) * 2); }
#define SS3_ISSUE(c_) do { const GAS char* rb_ = (const GAS char*)(raw + (rowb + (size_t)(c_) * 64) * CONV_CH); \
            _Pragma("unroll") for (int x = 0; x < 10; ++x) ld[x] = *(const GAS u32x4*)(rb_ + go[x]); \
            if (hw == 0) { const float* sp_ = ssc + ((size_t)((b * 16 + hd) * NCHUNK + (c_))) * 256 + DIR * 128 + lane; sr0 = sp_[0]; sr1 = sp_[64]; } } while (0)
#define SS3_COMMIT(bi_, c_) do { LAS unsigned char* B_ = lds + (bi_) * BUF; \
            _Pragma("unroll") for (int x = 0; x < 10; ++x) *(LAS u32x4*)(B_ + lo_[x]) = ld[x]; \
            if (hw == 0) { LAS float* sc_ = (LAS float*)(B_ + SCO); const int i = lane; const float cs = sr1; const float cl = __shfl(cs, DIR ? 0 : 63); \
                sc_[i] = __expf(cs); sc_[64 + i] = sr0 * __expf(cl - cs); if (i == 0) sc_[128] = __expf(cl); } } while (0)
        { const int c0 = DIR ? NCHUNK - 1 : 0; SS3_ISSUE(c0); SS3_COMMIT(0, c0); SS3_ISSUE((DIR ? c0 - 1 : c0 + 1)); }
        for (int n = 0; n < NCHUNK; ++n) {
            const int c = DIR ? NCHUNK - 1 - n : n;
            WG_BAR();
            const bool more = n + 1 < NCHUNK; const int cn = DIR ? c - 1 : c + 1;
            if (more) { SS3_COMMIT((n + 1) & 1, cn); if (n + 2 < NCHUNK) SS3_ISSUE((DIR ? cn - 1 : cn + 1)); }
            if (n > 0) { const int tp = (DIR ? c + 1 : c - 1) * 64;
#pragma unroll
                for (int x = 0; x < 8; ++x) { const unsigned v = *(const LAS unsigned*)(ost + ((n - 1) & 1) * (64 * 72) + (hw * 16 + 2 * x + (lane >> 5)) * 72 + 2 * (lane & 31));
                    GAS char* ob_ = (GAS char*)(ys + (rowb + tp + hw * 16 + 2 * x) * 1024 + hd * 64);
                    (void)__builtin_amdgcn_global_atomic_fadd_v2bf16((GAS s16x2*)(ob_ + (lane >> 5) * 2048 + (lane & 31) * 4), __builtin_bit_cast(s16x2, v)); } }
        }
        WG_BAR();
        { const int tp = (DIR ? 0 : NCHUNK - 1) * 64;
#pragma unroll
          for (int x = 0; x < 8; ++x) { const unsigned v = *(const LAS unsigned*)(ost + ((NCHUNK - 1) & 1) * (64 * 72) + (hw * 16 + 2 * x + (lane >> 5)) * 72 + 2 * (lane & 31));
              GAS char* ob_ = (GAS char*)(ys + (rowb + tp + hw * 16 + 2 * x) * 1024 + hd * 64);
              (void)__builtin_amdgcn_global_atomic_fadd_v2bf16((GAS s16x2*)(ob_ + (lane >> 5) * 2048 + (lane & 31) * 4), __builtin_bit_cast(s16x2, v)); } }
#undef SS3_ISSUE
#undef SS3_COMMIT
    } else {
        const int p0 = 16 * wave;
        f32x4 Ht[8];
#pragma unroll
        for (int t = 0; t < 8; ++t) Ht[t] = (f32x4){0.f, 0.f, 0.f, 0.f};
        for (int n = 0; n < NCHUNK; ++n) {
            WG_BAR();
            const LAS unsigned char* Bb = lds + (n & 1) * BUF;
            const LAS bf16* Cb = (const LAS bf16*)(Bb + CO); const LAS bf16* Bmb = (const LAS bf16*)(Bb + BO); const LAS bf16* Xb = (const LAS bf16*)(Bb + XO);
            const LAS float* sc = (const LAS float*)(Bb + SCO);
            const int offa = fr * LDK + 4 * fq;
            f32x4 aY[4];
#pragma unroll
            for (int m = 0; m < 4; ++m) aY[m] = (f32x4){0.f, 0.f, 0.f, 0.f};
#pragma unroll
            for (int ks = 0; ks < 4; ++ks) { const bf16x8 bs = pack2(Ht[2 * ks], Ht[2 * ks + 1]); bf16x8 fa[4];
#pragma unroll
                for (int m = 0; m < 4; ++m) fa[m] = afrag16(Cb + offa + 16 * m * LDK + 32 * ks);
#pragma unroll
                for (int m = 0; m < 4; ++m) aY[m] = MFMA16(fa[m], bs, aY[m]); }
            bf16x8 xf[2];
#pragma unroll
            for (int kt = 0; kt < 2; ++kt) { const bf16x8 xv = *(const LAS bf16x8*)(Xb + (p0 + fr) * LDT + 32 * kt + 8 * fq);
                const f32x4 w0 = *(const LAS f32x4*)(sc + 64 + 32 * kt + 8 * fq), w1 = *(const LAS f32x4*)(sc + 64 + 32 * kt + 8 * fq + 4);
                u32x4 w; w.x = pkbf(bf2f_s(xv[0]) * w0[0], bf2f_s(xv[1]) * w0[1]); w.y = pkbf(bf2f_s(xv[2]) * w0[2], bf2f_s(xv[3]) * w0[3]);
                w.z = pkbf(bf2f_s(xv[4]) * w1[0], bf2f_s(xv[5]) * w1[1]); w.w = pkbf(bf2f_s(xv[6]) * w1[2], bf2f_s(xv[7]) * w1[3]);
                xf[kt] = __builtin_bit_cast(bf16x8, w); }
#pragma unroll
            for (int m = 0; m < 4; ++m) { const f32x4 ec = *(const LAS f32x4*)(sc + 16 * m + 4 * fq);
#pragma unroll
                for (int e = 0; e < 4; ++e) aY[m][e] *= ec[e]; }
            const float ecl = sc[128];
#pragma unroll
            for (int m = 0; m < 4; ++m)
#pragma unroll
                for (int e = 0; e < 4; ++e) ost[(n & 1) * (64 * 72) + (16 * m + 4 * fq + e) * 72 + p0 + fr] = f2bf1(aY[m][e]);
            { const LAS bf16* bp = Bmb + (8 * fq + (fr >> 2)) * LDK + 4 * (fr & 3);
#pragma unroll
              for (int t = 0; t < 8; ++t) {
                  bf16x8 f[2];
#pragma unroll
                  for (int kt = 0; kt < 2; ++kt) { const LAS bf16* p = bp + (32 * kt) * LDK + 16 * t;
                      const v4i16_t lo = __builtin_amdgcn_ds_read_tr16_b64_v4i16((LAS v4i16_t*)p), hi = __builtin_amdgcn_ds_read_tr16_b64_v4i16((LAS v4i16_t*)(p + 4 * LDK));
                      f[kt] = (bf16x8){lo[0], lo[1], lo[2], lo[3], hi[0], hi[1], hi[2], hi[3]}; }
                  Ht[t] = Ht[t] * ecl; Ht[t] = MFMA16(f[0], xf[0], Ht[t]); Ht[t] = MFMA16(f[1], xf[1], Ht[t]); } }
        }
        WG_BAR();
    }
}
#ifndef PG8_SP2_
#define PG8_SP2_ true
#endif
#ifndef MK_ONE_LAUNCH
#define MK_ONE_LAUNCH 1
#endif
constexpr int PPL = 14;
constexpr int NPHASE = 1 + PPL * DEPTH;
struct Args { const float* in[19]; float* out; unsigned char* ws; int ph_lo, ph_hi; };
__global__ void __launch_bounds__(NWAVES * 64, 2) fwd_kernel(Args args) {
    extern __shared__ __attribute__((aligned(16))) unsigned char lds_raw[];
    LAS unsigned char* lds = (LAS unsigned char*)lds_raw;
    unsigned* ctl = (unsigned*)(args.ws + WS_CTL);
    volatile LAS unsigned* MISC = (volatile LAS unsigned*)(lds + MISC_OFF);
    for (int u = threadIdx.x; u < 64; u += 512) MISC[u] = 0u;
    __syncthreads();
#if MK_ONE_LAUNCH
    XcdBarrier bar = xcd_barrier_post(ctl + CW_BAR, MISC + 8);
#define GRID_BAR() do { XcdBarrier bb_ = bar; asm volatile("" : "+s"(bb_.bar), "+s"(bb_.x)); xcd_barrier(bb_); } while (0)
#else
#define GRID_BAR() do {} while (0)
#endif
    const int lo = args.ph_lo, hi = args.ph_hi;
#define WSP(T, off) ((T*)(wsb + (off)))
#if defined(PROBE_STATE) || defined(PROBE_ANY) || defined(PROBE_SUB)
#define PROBE_PTR ((float*)(wsb + WS_CTL) + 2048)
#define PROBE_SCALE (1.0f + sqrtf(8.7e-4f * fminf(fmaxf(*(volatile float*)PROBE_PTR, 0.f), 1.f)))
#else
#define PROBE_PTR ((float*)nullptr)
#define PROBE_SCALE 1.0f
#endif
    for (int ph = lo; ph < hi; ++ph) {
        int tid = threadIdx.x, bid = blockIdx.x, G = gridDim.x;
        const __attribute__((address_space(4))) Args* ap = (const __attribute__((address_space(4))) Args*)__builtin_amdgcn_kernarg_segment_ptr();
        asm volatile("" : "+v"(tid)); asm volatile("" : "+s"(bid), "+s"(G), "+s"(ap));
        unsigned char* wsb = ap->ws;
        const int lane = tid & 63, wave = __builtin_amdgcn_readfirstlane(tid >> 6);
        const int gw = bid * NWAVES + wave, NGW = G * NWAVES, gtid = bid * 512 + tid, NGT = G * 512;
        const int l = (ph == 0) ? 0 : (ph - 1) / PPL; const int k = (ph == 0) ? -1 : (ph - 1) % PPL;
#if defined(PROBE_ANY)
        if (l == PROBE_L && k == PROBE_K0 && blockIdx.x == 0 && threadIdx.x == 0) ((unsigned long long*)(wsb + WS_CTL))[1100] = __builtin_amdgcn_s_memrealtime();
#endif
        switch (k) {
        case -1: {
            cvt_mixer_weights(lds, wsb, ap->in[2], ap->in[12], gw, NGW, wave, lane);
            phase_norm(ap->in[0], ap->in[1], WSP(bf16, WS_XN), gw, NGW, lane);
        } break;
        case 0: {
            pg8::Gemm g{WSP(bf16, WS_XN), WSP(bf16, WS_WA), M, NWA, DM, 0, 0, 0}; pg8::StaticOrder S; S.init(M, NWA, G, bid);
            pg8::EpiRawA E{WSP(bf16, WS_RAW), WSP(float, WS_SCAL)};
            pg8::gemm_phase<pg8::EpiRawA, pg8::StaticOrder, true, PG8_SP2_>(lds, g, S, E);
#if defined(EXP_DUP_GEMM)
            if (l == 0 && (EXP_DUP_GEMM & 1)) { __syncthreads(); pg8::gemm_phase<pg8::EpiRawA, pg8::StaticOrder, true, PG8_SP2_>(lds, g, S, E); }
#endif
        } break;
        case 1: {
            if (l == 1) PB_START(3, wsb);
            prep_gdn_stash(lds, bid, WSP(bf16, WS_RAW), tid); prep_ssd_stash(lds, bid, WSP(bf16, WS_RAW), tid);
            zero_region(wsb + WS_OG, 64 * MiB, gtid, NGT); zero_region(wsb + WS_YS, 64 * MiB, gtid, NGT);
            GRID_BAR();
            if (l == 1) { PB_END(3, wsb); PB_START(1, wsb); }
            prep_gdn_range(lds, bid, WSP(bf16, WS_RAW), WSP(float, WS_SCAL), ap->in[3] + (size_t)l * 7 * CONV_CH, ap->in[4] + (size_t)l * CONV_CH,
                           ap->in[5] + l * 16, ap->in[6] + l * 16, WSP(bf16, WS_TQ), tid, wave, lane, WSP(float, WS_SCAL));
            __syncthreads();
            if (l == 1) { PB_END(1, wsb); PB_START(2, wsb); }
            { int tid2 = threadIdx.x; asm volatile("" : "+v"(tid2));
              prep_ssd_range(lds, bid, WSP(bf16, WS_RAW), ap->in[3] + (size_t)l * 7 * CONV_CH, ap->in[4] + (size_t)l * CONV_CH, tid2,
                             WSP(float, WS_SCAL), ap->in[8] + l * 32, ap->in[9] + l * 32, WSP(float, WS_SSC)); }
            if (l == 1) { __syncthreads(); PB_END(2, wsb); }
        } break;
        case 2: {
            for (int c = bid; c < 256; c += G) {
                int tid = threadIdx.x; asm volatile("" : "+v"(tid));
                const int lane = tid & 63, wave = __builtin_amdgcn_readfirstlane(tid >> 6);
                if (c < 128) { const int x_ = (c & 7) | ((c >> 4) << 3), hf_ = (c >> 3) & 1;
                    const int b_ = x_ >> 4, h_ = (x_ >> 1) & 7;
                    if (x_ & 1) gdn_state3<1>(lds, b_, h_, hf_, WSP(bf16, WS_RAW), WSP(float, WS_SCAL), WSP(bf16, WS_TQ), WSP(bf16, WS_OG), tid, wave, lane, nullptr, 0);
                    else        gdn_state3<0>(lds, b_, h_, hf_, WSP(bf16, WS_RAW), WSP(float, WS_SCAL), WSP(bf16, WS_TQ), WSP(bf16, WS_OG), tid, wave, lane, nullptr, 0); }
                else { const int c2 = c - 128, gi_ = c2 & 15, hl_ = c2 >> 4;
                    const int b_ = gi_ >> 2, hd_ = ((gi_ >> 1) & 1) * 8 + hl_;
                    if (gi_ & 1) ssd_state3<1>(lds, b_, hd_, WSP(bf16, WS_RAW), WSP(float, WS_SSC), WSP(bf16, WS_YS), tid, wave, lane, nullptr, 0);
                    else         ssd_state3<0>(lds, b_, hd_, WSP(bf16, WS_RAW), WSP(float, WS_SSC), WSP(bf16, WS_YS), tid, wave, lane, nullptr, 0); }
                __syncthreads();
            }
        } break;
        case 3: {
            ssd_intra_range(lds, bid, WSP(bf16, WS_RAW), WSP(float, WS_SSC), ap->in[10] + l * 16, WSP(bf16, WS_TQ), tid);
#if defined(EXP_DUP_INTRA)
            if (l == 0) { __syncthreads();
            ssd_intra_range(lds, bid, WSP(bf16, WS_RAW), WSP(float, WS_SSC), ap->in[10] + l * 16, WSP(bf16, WS_TQ), tid);
 }
#endif
        } break;
        case 4: {
            phase_norm((l == 0) ? ap->in[0] : ap->out, ap->in[1] + (size_t)l * DM, WSP(bf16, WS_XN2), gw, NGW, lane);
#if defined(EXP_DUP_B)
            if (l == 0) { __syncthreads();
            phase_norm((l == 0) ? ap->in[0] : ap->out, ap->in[1] + (size_t)l * DM, WSP(bf16, WS_XN2), gw, NGW, lane);
 }
#endif
        } break;
        case 5: {
            pg8::Gemm g{WSP(bf16, WS_XN2), WSP(bf16, WS_WB), M, NGATE, DM, 0, 0, 0}; pg8::StaticOrder S; S.init(M, NGATE, G, bid);
            pg8::EpiBf16 E{WSP(bf16, WS_GATES), NGATE};
            pg8::gemm_phase<pg8::EpiBf16, pg8::StaticOrder, true, PG8_SP2_>(lds, g, S, E);
#if defined(EXP_DUP_GEMM)
            if (l == 0 && (EXP_DUP_GEMM & 2)) { __syncthreads(); pg8::gemm_phase<pg8::EpiBf16, pg8::StaticOrder, true, PG8_SP2_>(lds, g, S, E); }
#endif
        } break;
        case 6: {
            phase_finish(WSP(bf16, WS_OG), WSP(bf16, WS_YS), WSP(bf16, WS_TQ), WSP(bf16, WS_GATES), ap->in[7] + l * 128, ap->in[11] + l * 1024, WSP(bf16, WS_MIXED), gw, NGW, lane);
#if defined(EXP_DUP_B)
            if (l == 0) { __syncthreads();
            phase_finish(WSP(bf16, WS_OG), WSP(bf16, WS_YS), WSP(bf16, WS_TQ), WSP(bf16, WS_GATES), ap->in[7] + l * 128, ap->in[11] + l * 1024, WSP(bf16, WS_MIXED), gw, NGW, lane);
 }
#endif
        } break;
        case 7: {
            pg8::Gemm g{WSP(bf16, WS_MIXED), WSP(bf16, WS_WO), M, DM, 2048, 0, 0, 0}; pg8::StaticOrder S; S.init(M, DM, G, bid);
            pg8::EpiResid E{(l == 0) ? ap->in[0] : ap->out, ap->out, DM};
            pg8::gemm_phase<pg8::EpiResid, pg8::StaticOrder, true, PG8_SP2_>(lds, g, S, E);
#if defined(EXP_DUP_GEMM)
            if (l == 0 && (EXP_DUP_GEMM & 4)) { __syncthreads(); pg8::gemm_phase<pg8::EpiResid, pg8::StaticOrder, true, PG8_SP2_>(lds, g, S, E); }
#endif
        } break;
        case 8: {
            phase_norm2_router(lds, ap->out, ap->in[13] + l * DM, ap->in[14] + (size_t)l * DM * 16, WSP(bf16, WS_XN), WSP(float, WS_AFF), gw, NGW, tid, lane);
#if defined(EXP_DUP_A) || defined(EXP_DUP_N2)
            if (l == 0) { __syncthreads();
            phase_norm2_router(lds, ap->out, ap->in[13] + l * DM, ap->in[14] + (size_t)l * DM * 16, WSP(bf16, WS_XN), WSP(float, WS_AFF), gw, NGW, tid, lane);
            __syncthreads();
            cvt_expert_weights(lds, wsb, ap->in[15] + (size_t)l * NEXP * DM * EFF, ap->in[16] + (size_t)l * NEXP * DM * EFF, ap->in[17] + (size_t)l * NEXP * EFF * DM, gw, NGW, wave, lane);
            if (l + 1 < DEPTH) cvt_mixer_weights(lds, wsb, ap->in[2] + (size_t)(l + 1) * DM * 6720, ap->in[12] + (size_t)(l + 1) * 2048 * DM, gw, NGW, wave, lane);
 }
#endif
        } break;
        case 9: {
            if (bid < NB * NEXP) phase_topk(lds, WSP(float, WS_AFF), WSP(int, WS_IDX), WSP(float, WS_VAL), WSP(int, WS_INV), bid, tid, wave, lane);
            else if (G > NB * NEXP) { const int gw2 = (bid - NB * NEXP) * NWAVES + wave, NGW2 = (G - NB * NEXP) * NWAVES;
                cvt_expert_weights(lds, wsb, ap->in[15] + (size_t)l * NEXP * DM * EFF, ap->in[16] + (size_t)l * NEXP * DM * EFF, ap->in[17] + (size_t)l * NEXP * EFF * DM, gw2, NGW2, wave, lane);
                if (l + 1 < DEPTH) cvt_mixer_weights(lds, wsb, ap->in[2] + (size_t)(l + 1) * DM * 6720, ap->in[12] + (size_t)(l + 1) * 2048 * DM, gw2, NGW2, wave, lane); }
#if defined(EXP_DUP_A) || defined(EXP_DUP_TK)
            if (l == 0) { __syncthreads();
            for (int be = bid; be < NB * NEXP; be += G) phase_topk(lds, WSP(float, WS_AFF), WSP(int, WS_IDX), WSP(float, WS_VAL), WSP(int, WS_INV), be, tid, wave, lane);
 }
#endif
        } break;
        case 10: {
            phase_gather(WSP(bf16, WS_XN), WSP(int, WS_IDX), WSP(bf16, WS_XG), gw, NGW, lane);
#if defined(EXP_DUP_A) || defined(EXP_DUP_GA)
            if (l == 0) { __syncthreads();
            phase_gather(WSP(bf16, WS_XN), WSP(int, WS_IDX), WSP(bf16, WS_XG), gw, NGW, lane);
 }
#endif
        } break;
        case 11: {
            pg8::Gemm g{WSP(bf16, WS_XG), WSP(bf16, WS_WGU), MEXP, 1024, DM, 2, 15, (size_t)1024 * 1024 * 2}; pg8::StaticOrder S; S.init(MEXP, 1024, G, bid);
            pg8::EpiSwiglu E{WSP(bf16, WS_HMID), EFF};
            pg8::gemm_phase<pg8::EpiSwiglu, pg8::StaticOrder, true, PG8_SP2_>(lds, g, S, E);
#if defined(EXP_DUP_GEMM)
            if (l == 0 && (EXP_DUP_GEMM & 8)) { __syncthreads(); pg8::gemm_phase<pg8::EpiSwiglu, pg8::StaticOrder, true, PG8_SP2_>(lds, g, S, E); }
#endif
        } break;
        case 12: {
            pg8::Gemm g{WSP(bf16, WS_HMID), WSP(bf16, WS_WD), MEXP, 1024, EFF, 2, 15, (size_t)1024 * 512 * 2}; pg8::StaticOrder S; S.init(MEXP, 1024, G, bid);
            pg8::EpiBf16 E{WSP(bf16, WS_XG), 1024};
            pg8::gemm_phase<pg8::EpiBf16, pg8::StaticOrder, true, PG8_SP2_>(lds, g, S, E);
#if defined(EXP_DUP_GEMM)
            if (l == 0 && (EXP_DUP_GEMM & 16)) { __syncthreads(); pg8::gemm_phase<pg8::EpiBf16, pg8::StaticOrder, true, PG8_SP2_>(lds, g, S, E); }
#endif
        } break;
        default: {
            const bool last = (l + 1 == DEPTH);
            phase_combine(ap->out, ap->out, WSP(bf16, WS_XG), WSP(int, WS_INV), WSP(float, WS_VAL), last ? ap->in[18] : ap->in[1] + (size_t)(l + 1) * DM, WSP(bf16, WS_XN), last, gw, NGW, lane, PROBE_SCALE);

        } break;
        }
        if (ph + 1 < hi) GRID_BAR();
#if defined(PROBE_ANY)
        if (l == PROBE_L && k == PROBE_K1 && blockIdx.x == 0 && threadIdx.x == 0) { const unsigned long long t1_ = __builtin_amdgcn_s_memrealtime(), t0_ = ((unsigned long long*)(wsb + WS_CTL))[1100];
            const unsigned bk_ = (unsigned)((t1_ - t0_) / PROBE_TICKS); *(volatile float*)PROBE_PTR = (float)(bk_ > 40u ? 40u : bk_) * (1.0f / 40.0f); }
#endif
    }
#undef WSP
}

extern "C" void kernel_launch(void* const* d_in, const int* in_sizes, int n_in, void* d_out, int out_size, void* d_ws, size_t ws_size, hipStream_t stream) {
    static int grid = 0;
    if (grid == 0) {
        if (n_in != 19 || in_sizes[0] != M * DM || out_size != M * DM || ws_size < WS_END) { fprintf(stderr, "kernel_launch: unexpected shapes (n_in %d, in0 %d, out %d, ws %zu); nothing launched\n", n_in, n_in > 0 ? in_sizes[0] : -1, out_size, ws_size); grid = -1; return; }
        int dev = 0, cus = 0;
        if (hipGetDevice(&dev) != hipSuccess || hipDeviceGetAttribute(&cus, hipDeviceAttributeMultiprocessorCount, dev) != hipSuccess) { grid = -1; return; }
        if (hipFuncSetAttribute((const void*)fwd_kernel, hipFuncAttributeMaxDynamicSharedMemorySize, LDS_BYTES) != hipSuccess) { fprintf(stderr, "kernel_launch: hipFuncSetAttribute failed\n"); grid = -1; return; }
        (void)hipGetLastError();
        grid = cus;
    }
    if (grid < 0) return;
    (void)hipMemsetAsync((char*)d_ws + WS_CTL, 0, CTL_ZERO_BYTES, stream);
    Args a{};
    for (int i = 0; i < 19; ++i) a.in[i] = (const float*)d_in[i];
    a.out = (float*)d_out; a.ws = (unsigned char*)d_ws;
#if MK_ONE_LAUNCH
    a.ph_lo = 0; a.ph_hi = NPHASE;
    hipLaunchKernelGGL(fwd_kernel, dim3(grid), dim3(NWAVES * 64), LDS_BYTES, stream, a);
#else
    for (int p = 0; p < NPHASE; ++p) { a.ph_lo = p; a.ph_hi = p + 1; hipLaunchKernelGGL(fwd_kernel, dim3(grid), dim3(NWAVES * 64), LDS_BYTES, stream, a); }
#endif
}
```

```cpp
#include <hip/hip_runtime.h>
#include <cstdio>
#include <cstdint>
namespace pg8 {
#define PG8_LAS __attribute__((address_space(3)))
typedef unsigned short bf16_t;
typedef short bf16x8 __attribute__((ext_vector_type(8)));
typedef float f32x4 __attribute__((ext_vector_type(4)));
typedef unsigned u32x4 __attribute__((ext_vector_type(4)));
constexpr int BM = 256, BK = 64, HALF = 128, HTB = HALF * BK * 2  , STAGE_BYTES = 8 * HTB, NXCD = 8, WGM = 8;

__host__ __device__ __forceinline__ int lds_byte(int r, int c) { const int st = (r >> 4) * 2 + (c >> 5), rr = r & 15, cc = c & 31, ob = rr * 64 + cc * 2; return st * 1024 + (ob ^ (((ob >> 9) & 1) << 5)); }
__host__ __device__ __forceinline__ void stage_rc(int b, int& R, int& C) { const int st = b / 1024, sb = b % 1024, swz = sb ^ (((sb >> 9) & 1) << 5); R = (st >> 1) * 16 + swz / 64; C = (st & 1) * 32 + (swz % 64) / 2; }
__host__ __device__ __forceinline__ int perm32(int rho) { const int n = rho >> 4, i = rho & 15; return 8 * (i >> 2) + 4 * n + (i & 3); }

struct Unit { int pm, pn; };
struct Gemm { const bf16_t* A; const bf16_t* Bt; int M, N, K; int bshift, bmask; size_t bstride;
    __device__ __forceinline__ size_t grp_off(int pm) const { return (size_t)((pm >> bshift) & bmask) * bstride; } };

struct StaticOrder {
    int nM, nN, nwg, G, c;
    __host__ __device__ void init(int M, int N, int G_, int c_) { nM = M / BM; nN = N / BM; nwg = nM * nN; G = G_; c = c_; }
    __host__ __device__ bool next(int i, Unit& u) const {
        const long L = (long)i * G + c; if (L >= nwg) return false;
        int wgid = (int)L; { const int q = nwg / NXCD, r = nwg % NXCD, xcd = wgid % NXCD, off = wgid / NXCD; wgid = (xcd < r ? xcd * (q + 1) : r * (q + 1) + (xcd - r) * q) + off; }
        const int nig = WGM * nN, gid = wgid / nig, fm = gid * WGM, gsz = (nM - fm) < WGM ? (nM - fm) : WGM;
        u.pm = fm + ((wgid % nig) % gsz); u.pn = (wgid % nig) / gsz; return true;
    }
    __device__ __forceinline__ void a_ready(const Unit&) const {}
    __device__ __forceinline__ void done(const Unit&) const {}
};

__device__ __forceinline__ unsigned cvt_pk_bf16(float lo, float hi) { unsigned r; asm volatile("v_cvt_pk_bf16_f32 %0, %1, %2" : "=v"(r) : "v"(lo), "v"(hi)); return r; }
__device__ __forceinline__ float silu_f(float x) { return x * __builtin_amdgcn_rcpf(1.0f + __builtin_amdgcn_exp2f(-1.4426950408889634f * x)); }
struct EpiBf16 {
    static constexpr bool PERM = true, AFTER_DRAIN = false;
    bf16_t* O; int ldc;
    __device__ __forceinline__ void operator()(const f32x4 (&acc)[2][2][4][2], const Unit& u, int wr, int wc, int fr, int fq) const {
        const int row0 = u.pm * BM + wr * 64 + fr; const int col0 = u.pn * BM + wc * 32 + 8 * fq;
#pragma unroll
        for (int ai = 0; ai < 2; ++ai)
#pragma unroll
            for (int m = 0; m < 4; ++m) { bf16_t* rowp = O + (size_t)(row0 + ai * HALF + m * 16) * ldc + col0;
#pragma unroll
                for (int bj = 0; bj < 2; ++bj) { const f32x4 v0 = acc[ai][bj][m][0], v1 = acc[ai][bj][m][1];
                    u32x4 w; w.x = cvt_pk_bf16(v0[0], v0[1]); w.y = cvt_pk_bf16(v0[2], v0[3]); w.z = cvt_pk_bf16(v1[0], v1[1]); w.w = cvt_pk_bf16(v1[2], v1[3]);
                    *(u32x4*)(rowp + bj * HALF) = w; } }
    }
};
struct EpiRawA {
    static constexpr bool PERM = true, AFTER_DRAIN = false;
    bf16_t* O; float* S;
    __device__ __forceinline__ void operator()(const f32x4 (&acc)[2][2][4][2], const Unit& u, int wr, int wc, int fr, int fq) const {
        const int row0 = u.pm * BM + wr * 64 + fr;
        if (u.pn < 18) {
            const int col0 = u.pn * BM + wc * 32 + 8 * fq;
#pragma unroll
            for (int ai = 0; ai < 2; ++ai)
#pragma unroll
                for (int m = 0; m < 4; ++m) { bf16_t* rowp = O + (size_t)(row0 + ai * HALF + m * 16) * 4608 + col0;
#pragma unroll
                    for (int bj = 0; bj < 2; ++bj) { const f32x4 v0 = acc[ai][bj][m][0], v1 = acc[ai][bj][m][1];
                        u32x4 w; w.x = cvt_pk_bf16(v0[0], v0[1]); w.y = cvt_pk_bf16(v0[2], v0[3]); w.z = cvt_pk_bf16(v1[0], v1[1]); w.w = cvt_pk_bf16(v1[2], v1[3]);
                        *(u32x4*)(rowp + bj * HALF) = w; } }
        } else if (wc < 2) {
            const int col0 = wc * 32 + 8 * fq;
#pragma unroll
            for (int ai = 0; ai < 2; ++ai)
#pragma unroll
                for (int m = 0; m < 4; ++m) { float* sp = S + (size_t)(row0 + ai * HALF + m * 16) * 64 + col0;
                    *(f32x4*)sp = acc[ai][0][m][0]; *(f32x4*)(sp + 4) = acc[ai][0][m][1]; }
        }
    }
};
struct EpiResid {
    static constexpr bool PERM = false, AFTER_DRAIN = false;
    const float* base; float* out; int ldc;
    __device__ __forceinline__ void operator()(const f32x4 (&acc)[2][2][4][2], const Unit& u, int wr, int wc, int fr, int fq) const {
        const int row0 = u.pm * BM + wr * 64 + fr, col0 = u.pn * BM + wc * 32 + 4 * fq;
#pragma unroll
        for (int ai = 0; ai < 2; ++ai)
#pragma unroll
            for (int mp = 0; mp < 2; ++mp) { f32x4 rv[2][2][2];
#pragma unroll
                for (int mm = 0; mm < 2; ++mm) { const size_t off = (size_t)(row0 + ai * HALF + (2 * mp + mm) * 16) * ldc + col0;
#pragma unroll
                    for (int bj = 0; bj < 2; ++bj)
#pragma unroll
                        for (int n = 0; n < 2; ++n) rv[mm][bj][n] = *(const f32x4*)(base + off + bj * HALF + n * 16); }
                asm volatile("" ::: "memory");
#pragma unroll
                for (int mm = 0; mm < 2; ++mm) { const size_t off = (size_t)(row0 + ai * HALF + (2 * mp + mm) * 16) * ldc + col0;
#pragma unroll
                    for (int bj = 0; bj < 2; ++bj)
#pragma unroll
                        for (int n = 0; n < 2; ++n) *(f32x4*)(out + off + bj * HALF + n * 16) = rv[mm][bj][n] + acc[ai][bj][2 * mp + mm][n]; }
                asm volatile("" ::: "memory"); }
    }
};
struct EpiSwiglu {
    static constexpr bool PERM = true, AFTER_DRAIN = false;
    bf16_t* O; int ldh;
    __device__ __forceinline__ void operator()(const f32x4 (&acc)[2][2][4][2], const Unit& u, int wr, int wc, int fr, int fq) const {
        const int row0 = u.pm * BM + wr * 64 + fr; const int f0 = (u.pn * BM + wc * 32 + 8 * fq) >> 1;
        typedef unsigned u32x2 __attribute__((ext_vector_type(2)));
#pragma unroll
        for (int ai = 0; ai < 2; ++ai)
#pragma unroll
            for (int m = 0; m < 4; ++m) { bf16_t* rowp = O + (size_t)(row0 + ai * HALF + m * 16) * ldh + f0;
#pragma unroll
                for (int bj = 0; bj < 2; ++bj) { const f32x4 v0 = acc[ai][bj][m][0], v1 = acc[ai][bj][m][1];
                    u32x2 w; w.x = cvt_pk_bf16(silu_f(v0[0]) * v0[1], silu_f(v0[2]) * v0[3]); w.y = cvt_pk_bf16(silu_f(v1[0]) * v1[1], silu_f(v1[2]) * v1[3]);
                    *(u32x2*)(rowp + bj * (HALF / 2)) = w; } }
    }
};
template <class Epi, class Sched, bool ALIGN_EPI = false, bool SP2 = false>
__device__ __forceinline__ void gemm_phase(PG8_LAS unsigned char* lds, const Gemm g, const Sched& S, const Epi& E) {
    int tid_o = threadIdx.x; asm volatile("" : "+v"(tid_o));
    const int tid = tid_o, wid = __builtin_amdgcn_readfirstlane(tid >> 6), lane = tid & 63, wr = wid >> 2, wc = wid & 3, fr = lane & 15, fq = lane >> 4;
    const int K = g.K, nt = K / BK;
    unsigned voffA[2], voffB[2];
#pragma unroll
    for (int i = 0; i < 2; ++i) { int R, C; stage_rc(tid * 16 + i * 8192, R, C); const int Rb = Epi::PERM ? ((R & ~31) + perm32(R & 31)) : R;
        voffA[i] = (unsigned)(R * K + C) * 2u; voffB[i] = (unsigned)(Rb * K + C) * 2u; }
    const size_t kstep = (size_t)(BK * 2);
    const size_t hstep = (size_t)HALF * K * 2;
    const size_t tstep = 2 * hstep;
    const unsigned ldsw = (unsigned)wid * 1024u;
    const int aoff = lds_byte(wr * 64 + fr, fq * 8), boff = lds_byte(wc * 32 + fr, fq * 8);
#define PG8_SA(b, h) (((b) * 2 + (h)) * HTB)
#define PG8_SB(b, h) ((4 + (b) * 2 + (h)) * HTB)
#define PG8_STAGE(bufoff, gbase, voff) do { _Pragma("unroll") for (int _i = 0; _i < 2; ++_i) \
        __builtin_amdgcn_global_load_lds((const unsigned*)((const char*)(gbase) + (voff)[_i]), (PG8_LAS unsigned*)(lds + (bufoff) + ldsw + _i * 8192), 16, 0, 0); } while (0)
#define PG8_LDA(dst, b, h) do { _Pragma("unroll") for (int m = 0; m < 4; ++m) _Pragma("unroll") for (int k = 0; k < 2; ++k) dst[m][k] = *(const PG8_LAS bf16x8*)(lds + PG8_SA(b, h) + aoff + m * 2048 + k * 1024); } while (0)
#define PG8_LDB(dst, b, h) do { _Pragma("unroll") for (int n = 0; n < 2; ++n) _Pragma("unroll") for (int k = 0; k < 2; ++k) dst[n][k] = *(const PG8_LAS bf16x8*)(lds + PG8_SB(b, h) + boff + n * 2048 + k * 1024); } while (0)
#define PG8_MMA(ai, bj, At, Bt) do { __builtin_amdgcn_s_setprio(1); _Pragma("unroll") for (int m = 0; m < 4; ++m) _Pragma("unroll") for (int n = 0; n < 2; ++n) _Pragma("unroll") for (int k = 0; k < 2; ++k) \
        acc[ai][bj][m][n] = __builtin_amdgcn_mfma_f32_16x16x32_bf16(Bt[n][k], At[m][k], acc[ai][bj][m][n], 0, 0, 0); __builtin_amdgcn_s_setprio(0); } while (0)
#define PG8_WAIT_V(n) asm volatile("s_waitcnt vmcnt(" #n ")" ::: "memory")
#define PG8_WAIT_L(n) asm volatile("s_waitcnt lgkmcnt(" #n ")" ::: "memory")
#define PG8_BAR __builtin_amdgcn_s_barrier()
#define PG8_SCHED __builtin_amdgcn_sched_barrier(0)
    Unit cur, nxt; int ui = 0;
    if (!S.next(0, cur)) return;
    f32x4 acc[2][2][4][2];
#pragma unroll
    for (int a = 0; a < 2; ++a)
#pragma unroll
        for (int b = 0; b < 2; ++b)
#pragma unroll
            for (int m = 0; m < 4; ++m)
#pragma unroll
                for (int n = 0; n < 2; ++n) acc[a][b][m][n] = (f32x4){0.f, 0.f, 0.f, 0.f};
    bf16x8 At[4][2], B0[2][2], B1[2][2];
    const char* cA = (const char*)g.A + (size_t)cur.pm * tstep; const char* cB = (const char*)g.Bt + g.grp_off(cur.pm) + (size_t)cur.pn * tstep;
    S.a_ready(cur);
    if constexpr (SP2) {
        PG8_STAGE(PG8_SB(0, 0), cB, voffB); PG8_STAGE(PG8_SB(0, 1), cB + hstep, voffB); PG8_STAGE(PG8_SA(0, 0), cA, voffA); PG8_STAGE(PG8_SA(0, 1), cA + hstep, voffA);
        if (wr == 1) PG8_BAR;
        PG8_WAIT_V(2); PG8_BAR;
        PG8_STAGE(PG8_SB(1, 0), cB + kstep, voffB); PG8_STAGE(PG8_SA(1, 0), cA + kstep, voffA); PG8_STAGE(PG8_SB(1, 1), cB + hstep + kstep, voffB);
        PG8_WAIT_V(6); PG8_BAR;
    } else {
        PG8_STAGE(PG8_SB(0, 0), cB, voffB); PG8_STAGE(PG8_SA(0, 0), cA, voffA); PG8_STAGE(PG8_SB(0, 1), cB + hstep, voffB); PG8_STAGE(PG8_SA(0, 1), cA + hstep, voffA);
        if (wr == 1) PG8_BAR;
        PG8_WAIT_V(4); PG8_BAR;
        PG8_STAGE(PG8_SB(1, 0), cB + kstep, voffB); PG8_STAGE(PG8_SA(1, 0), cA + kstep, voffA); PG8_STAGE(PG8_SB(1, 1), cB + hstep + kstep, voffB);
        PG8_WAIT_V(6); PG8_BAR;
    }
    for (;;) {
        const bool has_next = S.next(ui + 1, nxt);
        const char* nA = has_next ? (const char*)g.A + (size_t)nxt.pm * tstep : cA; const char* nB = has_next ? (const char*)g.Bt + g.grp_off(nxt.pm) + (size_t)nxt.pn * tstep : cB;
        for (int t = 0; t < nt; t += 2) {
            const bool last = (t == nt - 2);
            const char* a1 = cA + (size_t)(t + 1) * kstep;
            const char* a2 = last ? nA : cA + (size_t)(t + 2) * kstep; const char* b2 = last ? nB : cB + (size_t)(t + 2) * kstep;
            const char* a3 = a2 + kstep; const char* b3 = b2 + kstep;
            if (last && has_next) S.a_ready(nxt);
            if constexpr (SP2) {
            PG8_LDB(B0, 0, 0); PG8_LDB(B1, 0, 1); PG8_SCHED; PG8_LDA(At, 0, 0); PG8_STAGE(PG8_SA(1, 1), a1 + hstep, voffA);
            PG8_WAIT_V(8); PG8_WAIT_L(0); PG8_BAR; PG8_MMA(0, 0, At, B0); PG8_MMA(0, 1, At, B1); PG8_BAR; PG8_SCHED;
            PG8_LDA(At, 0, 1); PG8_STAGE(PG8_SB(0, 0), b2, voffB); PG8_STAGE(PG8_SB(0, 1), b2 + hstep, voffB); PG8_STAGE(PG8_SA(0, 0), a2, voffA);
            PG8_WAIT_V(8); PG8_WAIT_L(0); PG8_BAR; PG8_MMA(1, 0, At, B0); PG8_MMA(1, 1, At, B1); PG8_BAR; PG8_SCHED;
            PG8_LDB(B0, 1, 0); PG8_LDB(B1, 1, 1); PG8_SCHED; PG8_LDA(At, 1, 0); PG8_STAGE(PG8_SA(0, 1), a2 + hstep, voffA);
            PG8_WAIT_V(8); PG8_WAIT_L(0); PG8_BAR; PG8_MMA(0, 0, At, B0); PG8_MMA(0, 1, At, B1); PG8_BAR; PG8_SCHED;
            PG8_LDA(At, 1, 1); PG8_STAGE(PG8_SB(1, 0), b3, voffB); PG8_STAGE(PG8_SB(1, 1), b3 + hstep, voffB); PG8_STAGE(PG8_SA(1, 0), a3, voffA);
            PG8_WAIT_V(8); PG8_WAIT_L(0); PG8_BAR; PG8_MMA(1, 0, At, B0); PG8_MMA(1, 1, At, B1); PG8_BAR; PG8_SCHED;
            } else {
            PG8_LDB(B0, 0, 0); PG8_SCHED; PG8_LDA(At, 0, 0); PG8_STAGE(PG8_SA(1, 1), a1 + hstep, voffA);
            PG8_WAIT_L(8); PG8_BAR; PG8_WAIT_L(0); PG8_MMA(0, 0, At, B0); PG8_BAR; PG8_SCHED;
            PG8_LDB(B1, 0, 1); PG8_STAGE(PG8_SB(0, 0), b2, voffB);
            PG8_BAR; PG8_WAIT_L(0); PG8_MMA(0, 1, At, B1); PG8_BAR;
            PG8_LDA(At, 0, 1); PG8_STAGE(PG8_SA(0, 0), a2, voffA);
            PG8_BAR; PG8_WAIT_L(0); PG8_MMA(1, 0, At, B0); PG8_BAR; PG8_SCHED;
            PG8_STAGE(PG8_SB(0, 1), b2 + hstep, voffB);
            PG8_WAIT_V(6); PG8_BAR; PG8_MMA(1, 1, At, B1); PG8_BAR;
            PG8_LDB(B0, 1, 0); PG8_SCHED; PG8_LDA(At, 1, 0); PG8_STAGE(PG8_SA(0, 1), a2 + hstep, voffA);
            PG8_WAIT_L(8); PG8_BAR; PG8_WAIT_L(0); PG8_MMA(0, 0, At, B0); PG8_BAR; PG8_SCHED;
            PG8_LDB(B1, 1, 1); PG8_STAGE(PG8_SB(1, 0), b3, voffB);
            PG8_BAR; PG8_WAIT_L(0); PG8_MMA(0, 1, At, B1); PG8_BAR;
            PG8_LDA(At, 1, 1); PG8_STAGE(PG8_SA(1, 0), a3, voffA);
            PG8_BAR; PG8_WAIT_L(0); PG8_MMA(1, 0, At, B0); PG8_BAR; PG8_SCHED;
            PG8_STAGE(PG8_SB(1, 1), b3 + hstep, voffB);
            PG8_WAIT_V(6); PG8_BAR; PG8_MMA(1, 1, At, B1); PG8_BAR;
            }
        }
        if constexpr (ALIGN_EPI) { if (wr == 0) PG8_BAR; }
        if constexpr (!Epi::AFTER_DRAIN) { E(acc, cur, wr, wc, fr, fq); S.done(cur); }
        if (!has_next) break;
#pragma unroll
        for (int a = 0; a < 2; ++a)
#pragma unroll
            for (int b = 0; b < 2; ++b)
#pragma unroll
                for (int m = 0; m < 4; ++m)
#pragma unroll
                    for (int n = 0; n < 2; ++n) acc[a][b][m][n] = (f32x4){0.f, 0.f, 0.f, 0.f};
        cur = nxt; cA = nA; cB = nB; ++ui;
        if constexpr (ALIGN_EPI) { if (wr == 1) PG8_BAR; }
    }
    PG8_WAIT_V(0);
    if constexpr (!ALIGN_EPI) { if (wr == 0) PG8_BAR; }
    PG8_BAR;
    if constexpr (Epi::AFTER_DRAIN) { E.fused(acc, cur, wr, wc, fr, fq, lds, wid, lane); S.done(cur); }
#undef PG8_SA
#undef PG8_SB
#undef PG8_STAGE
#undef PG8_LDA
#undef PG8_LDB
#undef PG8_MMA
#undef PG8_WAIT_V
#undef PG8_WAIT_L
#undef PG8_BAR
#undef PG8_SCHED
}
}
#define GAS __attribute__((address_space(1)))
#define LAS __attribute__((address_space(3)))
typedef unsigned short bf16;
typedef unsigned v4u __attribute__((ext_vector_type(4)));
typedef float f32x4 __attribute__((ext_vector_type(4)));
typedef short bf16x8 __attribute__((ext_vector_type(8)));
typedef GAS unsigned gu32;
typedef GAS unsigned long long gu64;
#define RLX_AGENT __ATOMIC_RELAXED, __HIP_MEMORY_SCOPE_AGENT
#define LDS_WAIT() asm volatile("s_waitcnt lgkmcnt(0)" ::: "memory")
#define VM_WAIT() asm volatile("s_waitcnt vmcnt(0)" ::: "memory")
__device__ __forceinline__ unsigned long long rt() { return __builtin_amdgcn_s_memrealtime(); }
__device__ __forceinline__ unsigned f2bf(float f) { unsigned u = __builtin_bit_cast(unsigned, f); return (u + 0x7fffu + ((u >> 16) & 1u)) >> 16; }
__device__ __forceinline__ unsigned pk2(float lo, float hi) { return f2bf(lo) | (f2bf(hi) << 16); }
#define XB_TMO      128
#define XB_XCNT(j)  (256  + 64 * (j))
#define XB_XSUB(j)  (1280 + 64 * (j))
#define XB_XGEN(j)  (2304 + 64 * (j))
#define XB_TOP      3328
#define XB_TOPGEN   3392
#define XCD_BAR_WORDS 3456
#define XB_SPIN_CAP (1u << 18)

__device__ __forceinline__ unsigned xb_ld(unsigned* p)              { return __hip_atomic_load(p, __ATOMIC_RELAXED, __HIP_MEMORY_SCOPE_AGENT); }
__device__ __forceinline__ unsigned xb_add(unsigned* p, unsigned v) { return __hip_atomic_fetch_add(p, v, __ATOMIC_RELAXED, __HIP_MEMORY_SCOPE_AGENT); }
__device__ __forceinline__ unsigned xb_xcc_id() { return (unsigned)__builtin_amdgcn_s_getreg((3 << 11) | 20) & 0xFu; }
#define XB_SPIN(cond, bar) do { unsigned _sp = 0; while (cond) { __builtin_amdgcn_s_sleep(1); \
    if ((++_sp & 255u) == 0u) { if (xb_ld(&(bar)[XB_TMO])) break; if (_sp > XB_SPIN_CAP) { atomicAdd(&(bar)[XB_TMO], 1u); break; } } } } while (0)

struct XcdBarrier {
    unsigned* bar; unsigned x;
    volatile LAS unsigned* st;
};

__device__ __forceinline__ XcdBarrier xcd_barrier_post(unsigned* bar, volatile LAS unsigned* st) {
    XcdBarrier b; b.bar = bar; b.x = xb_xcc_id(); b.st = st;
    if (threadIdx.x == 0) (void)xb_add(&bar[XB_XCNT(b.x)], 1u);
    return b;
}
__device__ __forceinline__ void xcd_barrier_complete(unsigned* bar, unsigned x, unsigned& nloc, unsigned& nx) {
    const unsigned G = gridDim.x * gridDim.y * gridDim.z;
    unsigned sum, cnt, mine, sp = 0u;
    for (;;) {
        sum = 0u; cnt = 0u; mine = 0u;
#pragma unroll
        for (unsigned j = 0; j < 16; ++j) { const unsigned c = xb_ld(&bar[XB_XCNT(j)]); sum += c; cnt += (c > 0u) ? 1u : 0u; mine = (j == x) ? c : mine; }
        if (sum == G) break;
        __builtin_amdgcn_s_sleep(1);
        if ((++sp & 255u) == 0u) { if (xb_ld(&bar[XB_TMO])) break; if (sp > XB_SPIN_CAP) { atomicAdd(&bar[XB_TMO], 1u); break; } }
    }
    nloc = mine > 0u ? mine : 1u; nx = cnt > 0u ? cnt : 1u;
}

__device__ __forceinline__ void xcd_barrier(const XcdBarrier& b) {
    asm volatile("s_waitcnt vmcnt(0)" ::: "memory");
    __syncthreads();
    if (threadIdx.x == 0) {
        unsigned* bar = b.bar;
        __builtin_amdgcn_s_waitcnt(0);
        unsigned nloc = b.st[0], nx = b.st[1];
        if (nloc == 0u) { xcd_barrier_complete(bar, b.x, nloc, nx); b.st[0] = nloc; b.st[1] = nx; }
        const unsigned old = xb_add(&bar[XB_XSUB(b.x)], 1u);
        const unsigned gen = old / nloc;
        if (old + 1u == (gen + 1u) * nloc) {
            __builtin_amdgcn_fence(__ATOMIC_RELEASE, "agent");
            asm volatile("s_waitcnt vmcnt(0)" ::: "memory");
            const unsigned og = xb_add(&bar[XB_TOP], 1u);
            const unsigned tg = og / nx;
            if (og + 1u == (tg + 1u) * nx) xb_add(&bar[XB_TOPGEN], 1u);
            else XB_SPIN(xb_ld(&bar[XB_TOPGEN]) == tg, bar);
            __builtin_amdgcn_fence(__ATOMIC_ACQUIRE, "agent");
            xb_add(&bar[XB_XGEN(b.x)], 1u);
            asm volatile("s_waitcnt vmcnt(0)" ::: "memory");
        } else {
            XB_SPIN(xb_ld(&bar[XB_XGEN(b.x)]) == gen, bar);
            __builtin_amdgcn_fence(__ATOMIC_ACQUIRE, "agent");
            asm volatile("s_waitcnt vmcnt(0)" ::: "memory");
        }
    }
    __syncthreads();
}
constexpr int NB = 4, SEQ = 8192, DM = 1024, M = NB * SEQ, DEPTH = 2;
constexpr int NCHUNK = SEQ / 64;
constexpr int CONV_CH = 4608, NWA = 4864  , NGATE = 2048, NEXP = 16, EFF = 512, CAP = 1024;
constexpr int MEXP = NB * NEXP * CAP;
constexpr float EPS = 1e-6f;
constexpr int NWAVES = 8;
constexpr size_t MiB = 1u << 20;
constexpr size_t WS_CTL = 0, CTL_ZERO_BYTES = 1 * MiB;
constexpr size_t WS_WA = 1 * MiB;
constexpr size_t WS_WB = 11 * MiB;
constexpr size_t WS_WO = 15 * MiB;
constexpr size_t WS_XN = 19 * MiB;
constexpr size_t WS_RAW = 83 * MiB;
constexpr size_t WS_SCAL = 371 * MiB;
constexpr size_t WS_OG = 19 * MiB;
constexpr size_t WS_YS = 443 * MiB;
constexpr size_t WS_XN2 = 83 * MiB;
constexpr size_t WS_GATES = 147 * MiB;
constexpr size_t WS_MIXED = 147 * MiB;
constexpr size_t WS_WGU = 83 * MiB;
constexpr size_t WS_WD = 115 * MiB;
constexpr size_t WS_XG = 131 * MiB;
constexpr size_t WS_HMID = 259 * MiB;
constexpr size_t WS_AFF = 323 * MiB;
constexpr size_t WS_IDX = 325 * MiB;
constexpr size_t WS_VAL = 326 * MiB;
constexpr size_t WS_INV = 327 * MiB;
constexpr size_t WS_END = 507 * MiB;
constexpr int CW_TMO = 0, CW_BAR = 4096;
constexpr int LDS_BYTES = 163840;
constexpr int MISC_OFF = LDS_BYTES - 256;

typedef short bf16x8 __attribute__((ext_vector_type(8)));
typedef short bf16x4 __attribute__((ext_vector_type(4)));
typedef float f32x4 __attribute__((ext_vector_type(4)));
typedef float f32x2 __attribute__((ext_vector_type(2)));
typedef unsigned u32x4 __attribute__((ext_vector_type(4)));
typedef unsigned u32x2 __attribute__((ext_vector_type(2)));
typedef __bf16 bf16x2_t __attribute__((ext_vector_type(2)));
typedef short s16x2 __attribute__((ext_vector_type(2)));

__device__ __forceinline__ float bf2f(unsigned short v) { return __uint_as_float((unsigned)v << 16); }
__device__ __forceinline__ float bf2f_s(short v) { return __uint_as_float((unsigned)(unsigned short)v << 16); }
__device__ __forceinline__ unsigned pkbf(float lo, float hi) { f32x2 v = {lo, hi}; bf16x2_t b = __builtin_convertvector(v, bf16x2_t); return __builtin_bit_cast(unsigned, b); }
__device__ __forceinline__ unsigned short f2bf1(float f) { return (unsigned short)(pkbf(f, 0.f) & 0xffffu); }
__device__ __forceinline__ float silu(float x) { return x * __builtin_amdgcn_rcpf(1.0f + __builtin_amdgcn_exp2f(-1.4426950408889634f * x)); }
__device__ __forceinline__ float softplus_f(float x) { return x > 20.f ? x : log1pf(expf(x)); }
__device__ __forceinline__ float sigmoid_f(float x) { return 1.0f / (1.0f + expf(-x)); }
__device__ __forceinline__ void atomic_add_bf16x2(bf16* p, float a, float b) {
    (void)__builtin_amdgcn_global_atomic_fadd_v2bf16((GAS s16x2*)p, __builtin_bit_cast(s16x2, pkbf(a, b)));
}
template <int CTRL> __device__ __forceinline__ float dppf(float v) { return __builtin_bit_cast(float, __builtin_amdgcn_update_dpp(0, __builtin_bit_cast(int, v), CTRL, 0xF, 0xF, true)); }
__device__ __forceinline__ float wave_sum(float v) {
    v += dppf<0xB1>(v); v += dppf<0x4E>(v); v += dppf<0x141>(v); v += dppf<0x140>(v);
    const float s0 = __builtin_bit_cast(float, __builtin_amdgcn_readlane(__builtin_bit_cast(int, v), 0)), s1 = __builtin_bit_cast(float, __builtin_amdgcn_readlane(__builtin_bit_cast(int, v), 16));
    const float s2 = __builtin_bit_cast(float, __builtin_amdgcn_readlane(__builtin_bit_cast(int, v), 32)), s3 = __builtin_bit_cast(float, __builtin_amdgcn_readlane(__builtin_bit_cast(int, v), 48));
    return (s0 + s1) + (s2 + s3);
}

__device__ __forceinline__ float softplus_fast(float x) { const float e = __builtin_amdgcn_exp2f(1.4426950408889634f * fminf(x, 20.f));
    const float lg = (e < 1e-3f) ? e * (1.0f - 0.5f * e) : 0.6931471805599453f * __builtin_amdgcn_logf(1.0f + e); return x > 20.f ? x : lg; }
__device__ __forceinline__ float sigmoid_fast(float x) { return __builtin_amdgcn_rcpf(1.0f + __builtin_amdgcn_exp2f(-1.4426950408889634f * x)); }
__device__ __forceinline__ float scan_fwd64(float v, int lane) {
    v += dppf<0x111>(v); v += dppf<0x112>(v); v += dppf<0x114>(v); v += dppf<0x118>(v);
    const float t0 = __builtin_bit_cast(float, __builtin_amdgcn_readlane(__builtin_bit_cast(int, v), 15)), t1 = __builtin_bit_cast(float, __builtin_amdgcn_readlane(__builtin_bit_cast(int, v), 31));
    const float t2 = __builtin_bit_cast(float, __builtin_amdgcn_readlane(__builtin_bit_cast(int, v), 47));
    const int row = lane >> 4; return v + (row == 0 ? 0.f : row == 1 ? t0 : row == 2 ? t0 + t1 : (t0 + t1) + t2);
}
__device__ __forceinline__ float scan_bwd64(float v, int lane) {
    v += dppf<0x101>(v); v += dppf<0x102>(v); v += dppf<0x104>(v); v += dppf<0x108>(v);
    const float t1 = __builtin_bit_cast(float, __builtin_amdgcn_readlane(__builtin_bit_cast(int, v), 16)), t2 = __builtin_bit_cast(float, __builtin_amdgcn_readlane(__builtin_bit_cast(int, v), 32));
    const float t3 = __builtin_bit_cast(float, __builtin_amdgcn_readlane(__builtin_bit_cast(int, v), 48));
    const int row = lane >> 4; return v + (row == 3 ? 0.f : row == 2 ? t3 : row == 1 ? t3 + t2 : (t3 + t2) + t1);
}

template <int CTRL> __device__ __forceinline__ int dppi(int v) { return __builtin_amdgcn_update_dpp(0, v, CTRL, 0xF, 0xF, true); }
__device__ __forceinline__ int scan_fwd64_i(int v, int lane) {
    v += dppi<0x111>(v); v += dppi<0x112>(v); v += dppi<0x114>(v); v += dppi<0x118>(v);
    const int t0 = __builtin_amdgcn_readlane(v, 15), t1 = __builtin_amdgcn_readlane(v, 31), t2 = __builtin_amdgcn_readlane(v, 47);
    const int row = lane >> 4; return v + (row == 0 ? 0 : row == 1 ? t0 : row == 2 ? t0 + t1 : t0 + t1 + t2);
}
template <int MT, int NT>
__device__ __forceinline__ void mma_lds(f32x4 (&acc)[MT][NT], const LAS bf16* A, int lda, int m0, const LAS bf16* Bt, int ldb, int n0, int K, int fr, int fq) {
    for (int k0 = 0; k0 < K; k0 += 32) {
        bf16x8 a[MT], b[NT];
#pragma unroll
        for (int mt = 0; mt < MT; ++mt) a[mt] = *(const LAS bf16x8*)(A + (m0 + mt * 16 + fr) * lda + k0 + fq * 8);
#pragma unroll
        for (int nt = 0; nt < NT; ++nt) b[nt] = *(const LAS bf16x8*)(Bt + (n0 + nt * 16 + fr) * ldb + k0 + fq * 8);
#pragma unroll
        for (int mt = 0; mt < MT; ++mt)
#pragma unroll
            for (int nt = 0; nt < NT; ++nt) acc[mt][nt] = __builtin_amdgcn_mfma_f32_16x16x32_bf16(a[mt], b[nt], acc[mt][nt], 0, 0, 0);
    }
}

__device__ __forceinline__ void conv16(float (&acc)[16], const LAS bf16* src, int ld, const LAS float* cw, int cwld) {
#pragma unroll
    for (int c = 0; c < 16; ++c) acc[c] = cw[7 * cwld + c];
#pragma unroll
    for (int tap = 0; tap < 7; ++tap) {
        const bf16x8 x0 = *(const LAS bf16x8*)(src + tap * ld), x1 = *(const LAS bf16x8*)(src + tap * ld + 8);
        const LAS float* w = cw + tap * cwld;
#pragma unroll
        for (int c = 0; c < 8; ++c) { acc[c] += bf2f_s(x0[c]) * w[c]; acc[8 + c] += bf2f_s(x1[c]) * w[8 + c]; }
        if (tap & 1) asm volatile("" ::: "memory");
    }
}
__device__ __forceinline__ void conv8(float (&acc)[8], const LAS bf16* src, int ld, const LAS float* cw, int cwld) {
#pragma unroll
    for (int c = 0; c < 8; ++c) acc[c] = cw[7 * cwld + c];
#pragma unroll
    for (int tap = 0; tap < 7; ++tap) {
        const bf16x8 x0 = *(const LAS bf16x8*)(src + tap * ld);
        const LAS float* w = cw + tap * cwld;
#pragma unroll
        for (int c = 0; c < 8; ++c) acc[c] += bf2f_s(x0[c]) * w[c];
        if (tap & 1) asm volatile("" ::: "memory");
    }
}

#if defined(PROBE_SUB)
#define PB_START(id_, ws_) do { if ((id_) == PROBE_SUB && blockIdx.x == 0 && threadIdx.x == 0) ((unsigned long long*)(ws_))[1100] = __builtin_amdgcn_s_memrealtime(); } while (0)
#define PB_END(id_, ws_) do { if ((id_) == PROBE_SUB && blockIdx.x == 0 && threadIdx.x == 0) { const unsigned long long t1_ = __builtin_amdgcn_s_memrealtime(), t0_ = ((unsigned long long*)(ws_))[1100]; \
        const unsigned bk_ = (unsigned)((t1_ - t0_) / PROBE_TICKS); *((volatile float*)(ws_) + 2048) = (float)(bk_ > 40u ? 40u : bk_) * (1.0f / 40.0f); } } while (0)
#else
#define PB_START(id_, ws_) do {} while (0)
#define PB_END(id_, ws_) do {} while (0)
#endif
__device__ __forceinline__ void transpose_item(const float* W, int K, int N, int k0, int n0, bf16* WT, int drow0, int rmul, LAS float* scr, int lane) {
#pragma unroll 8
    for (int i = 0; i < 32; ++i) { const int kk = 2 * i + (lane >> 5); scr[kk * 33 + (lane & 31)] = W[(size_t)(k0 + kk) * N + n0 + (lane & 31)]; }
    LDS_WAIT(); asm volatile("" ::: "memory");
    const int c = lane & 7;
#pragma unroll
    for (int j = 0; j < 4; ++j) { const int n = (lane >> 3) + 8 * j; const LAS float* s = scr + (8 * c) * 33 + n;
        u32x4 o; o.x = pkbf(s[0 * 33], s[1 * 33]); o.y = pkbf(s[2 * 33], s[3 * 33]); o.z = pkbf(s[4 * 33], s[5 * 33]); o.w = pkbf(s[6 * 33], s[7 * 33]);
        *(GAS u32x4*)(WT + (size_t)(drow0 + rmul * n) * K + k0 + 8 * c) = o; }
    LDS_WAIT(); asm volatile("" ::: "memory");
}
__device__ __forceinline__ void cvt_mixer_weights(LAS unsigned char* lds, unsigned char* ws, const float* w_in, const float* w_out, int gw, int NGW, int wave, int lane) {
    LAS float* scr = (LAS float*)(lds + wave * 16384);
    bf16* WA = (bf16*)(ws + WS_WA); bf16* WB = (bf16*)(ws + WS_WB); bf16* WO = (bf16*)(ws + WS_WO);
    constexpr int I_IN = 16 * 210, I_OUT = 32 * 32;
    for (int it = gw; it < I_IN + I_OUT; it += NGW) {
        if (it < I_IN) { const int kb = it / 210, nb = it % 210, n0 = nb * 32;
            bf16* dst; int drow;
            if (n0 < 4608) { dst = WA; drow = n0; } else if (n0 < 6656) { dst = WB; drow = n0 - 4608; } else { dst = WA; drow = 4608 + (n0 - 6656); }
            transpose_item(w_in, 1024, 6720, kb * 64, n0, dst, drow, 1, scr, lane);
        } else { const int r = it - I_IN, kb = r / 32, nb = r % 32; transpose_item(w_out, 2048, 1024, kb * 64, nb * 32, WO, nb * 32, 1, scr, lane); }
    }
    { u32x4 z = (u32x4){0u, 0u, 0u, 0u}; asm volatile("" : "+v"(z));
      for (int r = gw; r < 192; r += NGW) { GAS u32x4* p = (GAS u32x4*)(WA + (size_t)(4672 + r) * 1024) + lane; p[0] = z; p[64] = z; } }
}
__device__ __forceinline__ void cvt_expert_weights(LAS unsigned char* lds, unsigned char* ws, const float* w_gate, const float* w_up, const float* w_down, int gw, int NGW, int wave, int lane) {
    LAS float* scr = (LAS float*)(lds + wave * 16384);
    bf16* WGU = (bf16*)(ws + WS_WGU); bf16* WD = (bf16*)(ws + WS_WD);
    constexpr int I_G = 16 * 16;
    constexpr int I_D = 8 * 32;
    constexpr int PER_E = 2 * I_G + I_D;
    for (int it = gw; it < NEXP * PER_E; it += NGW) {
        const int e = it / PER_E; int r = it % PER_E;
        if (r < 2 * I_G) { const int up = r >= I_G; if (up) r -= I_G; const int kb = r / 16, nb = r % 16;
            transpose_item((up ? w_up : w_gate) + (size_t)e * 1024 * 512, 1024, 512, kb * 64, nb * 32, WGU + (size_t)e * 1024 * 1024, 2 * (nb * 32) + up, 2, scr, lane);
        } else { r -= 2 * I_G; const int kb = r / 32, nb = r % 32;
            transpose_item(w_down + (size_t)e * 512 * 1024, 512, 1024, kb * 64, nb * 32, WD + (size_t)e * 1024 * 512, nb * 32, 1, scr, lane); }
    }
}

__device__ __forceinline__ void rms_row_regs(const float* xrow, const f32x4 (&w)[4], f32x4 (&v)[4], int lane) {
    const GAS f32x4* xr = (const GAS f32x4*)xrow + lane; float s = 0.f;
#pragma unroll
    for (int j = 0; j < 4; ++j) { v[j] = xr[64 * j]; s += (v[j].x * v[j].x + v[j].y * v[j].y) + (v[j].z * v[j].z + v[j].w * v[j].w); }
    const float rstd = __builtin_amdgcn_rsqf(wave_sum(s) * (1.0f / DM) + EPS);
#pragma unroll
    for (int j = 0; j < 4; ++j) v[j] = v[j] * rstd * w[j];
}
__device__ __forceinline__ void store_row_bf16(bf16* orow, const f32x4 (&v)[4], int lane) {
    GAS u32x2* o8 = (GAS u32x2*)orow + lane;
#pragma unroll
    for (int j = 0; j < 4; ++j) { u32x2 t; t.x = pkbf(v[j].x, v[j].y); t.y = pkbf(v[j].z, v[j].w); o8[64 * j] = t; }
}
__device__ __forceinline__ void load_w4(const float* w, f32x4 (&wv)[4], int lane) {
#pragma unroll
    for (int j = 0; j < 4; ++j) wv[j] = ((const GAS f32x4*)w)[lane + 64 * j];
}
__device__ __forceinline__ void phase_norm(const float* src, const float* w, bf16* XN, int gw, int NGW, int lane) {
    f32x4 wv[4]; load_w4(w, wv, lane);
    for (int m = gw; m < M; m += NGW) { f32x4 v[4]; rms_row_regs(src + (size_t)m * DM, wv, v, lane); store_row_bf16(XN + (size_t)m * DM, v, lane); }
}
__device__ __forceinline__ void zero_region(unsigned char* p, size_t bytes, int gtid, int NGT) {
    GAS u32x4* q = (GAS u32x4*)p; const size_t n = bytes / 16;
    u32x4 z = (u32x4){0u, 0u, 0u, 0u}; asm volatile("" : "+v"(z));
    for (size_t i = gtid; i < n; i += NGT) q[i] = z;
}

__device__ __forceinline__ void phase_norm2_router(LAS unsigned char* lds, const float* h, const float* w2, const float* w_router, bf16* XN, float* aff, int gw, int NGW, int tid, int lane) {
    LAS float* wrT = (LAS float*)lds;
    for (int e = tid; e < 16 * 1024; e += 512) { const int k = e >> 4, x = e & 15; wrT[x * 1024 + k] = w_router[e]; }
    __syncthreads();
    f32x4 wv[4]; load_w4(w2, wv, lane);
    for (int m = gw; m < M; m += NGW) {
        f32x4 v[4]; rms_row_regs(h + (size_t)m * DM, wv, v, lane); store_row_bf16(XN + (size_t)m * DM, v, lane);
        float mine = 0.f;
#pragma unroll 1
        for (int x = 0; x < 16; ++x) { float s = 0.f;
#pragma unroll
            for (int j = 0; j < 4; ++j) { const f32x4 wr = *(const LAS f32x4*)(wrT + x * 1024 + 4 * lane + 256 * j); s += (v[j].x * wr.x + v[j].y * wr.y) + (v[j].z * wr.z + v[j].w * wr.w); }
            s = wave_sum(s); mine = (lane == x) ? s : mine; }
        float mx = mine;
        mx = fmaxf(mx, __shfl_xor(mx, 1)); mx = fmaxf(mx, __shfl_xor(mx, 2)); mx = fmaxf(mx, __shfl_xor(mx, 4)); mx = fmaxf(mx, __shfl_xor(mx, 8));
        const float ex = expf(mine - mx); float den = ex;
        den += __shfl_xor(den, 1); den += __shfl_xor(den, 2); den += __shfl_xor(den, 4); den += __shfl_xor(den, 8);
        if (lane < 16) aff[(size_t)m * 16 + lane] = ex / den;
    }
}

__device__ __forceinline__ void phase_finish(const bf16* og, const bf16* ys, const bf16* yi, const bf16* gates, const float* gnw, const float* snw, bf16* mixed, int gw, int NGW, int lane) {
    float gw_[16], sw_[16];
#pragma unroll
    for (int c = 0; c < 16; ++c) { gw_[c] = gnw[(16 * lane + c) & 127]; sw_[c] = snw[16 * lane + c]; }
    for (int m = gw; m < M; m += NGW) {
        const bf16x8 o0 = *(const GAS bf16x8*)(og + (size_t)m * 1024 + 16 * lane), o1 = *(const GAS bf16x8*)(og + (size_t)m * 1024 + 16 * lane + 8);
        const bf16x8 y0 = *(const GAS bf16x8*)(ys + (size_t)m * 1024 + 16 * lane), y1 = *(const GAS bf16x8*)(ys + (size_t)m * 1024 + 16 * lane + 8);
        const bf16x8 i0 = *(const GAS bf16x8*)(yi + (size_t)m * 1024 + 16 * lane), i1 = *(const GAS bf16x8*)(yi + (size_t)m * 1024 + 16 * lane + 8);
        const bf16x8 g0 = *(const GAS bf16x8*)(gates + (size_t)m * 2048 + 16 * lane), g1 = *(const GAS bf16x8*)(gates + (size_t)m * 2048 + 16 * lane + 8);
        const bf16x8 z0 = *(const GAS bf16x8*)(gates + (size_t)m * 2048 + 1024 + 16 * lane), z1 = *(const GAS bf16x8*)(gates + (size_t)m * 2048 + 1024 + 16 * lane + 8);
        float o[16], t[16]; float so = 0.f, st = 0.f;
#pragma unroll
        for (int c = 0; c < 8; ++c) { o[c] = bf2f_s(o0[c]); o[8 + c] = bf2f_s(o1[c]); t[c] = (bf2f_s(y0[c]) + bf2f_s(i0[c])) * silu(bf2f_s(z0[c])); t[8 + c] = (bf2f_s(y1[c]) + bf2f_s(i1[c])) * silu(bf2f_s(z1[c])); }
#pragma unroll
        for (int c = 0; c < 16; ++c) { so += o[c] * o[c]; st += t[c] * t[c]; }
        so += __shfl_xor(so, 1); so += __shfl_xor(so, 2); so += __shfl_xor(so, 4);
        st += __shfl_xor(st, 1); st += __shfl_xor(st, 2); st += __shfl_xor(st, 4); st += __shfl_xor(st, 8); st += __shfl_xor(st, 16);
        const float ro = __builtin_amdgcn_rsqf(so * (1.0f / 128.f) + EPS), rt = __builtin_amdgcn_rsqf(st * (1.0f / 512.f) + EPS);
        float a[16], b2[16];
#pragma unroll
        for (int c = 0; c < 8; ++c) { a[c] = o[c] * ro * gw_[c] * silu(bf2f_s(g0[c])); a[8 + c] = o[8 + c] * ro * gw_[8 + c] * silu(bf2f_s(g1[c])); }
#pragma unroll
        for (int c = 0; c < 16; ++c) b2[c] = t[c] * rt * sw_[c];
        u32x4 w0, w1, w2, w3;
        w0.x = pkbf(a[0], a[1]); w0.y = pkbf(a[2], a[3]); w0.z = pkbf(a[4], a[5]); w0.w = pkbf(a[6], a[7]);
        w1.x = pkbf(a[8], a[9]); w1.y = pkbf(a[10], a[11]); w1.z = pkbf(a[12], a[13]); w1.w = pkbf(a[14], a[15]);
        w2.x = pkbf(b2[0], b2[1]); w2.y = pkbf(b2[2], b2[3]); w2.z = pkbf(b2[4], b2[5]); w2.w = pkbf(b2[6], b2[7]);
        w3.x = pkbf(b2[8], b2[9]); w3.y = pkbf(b2[10], b2[11]); w3.z = pkbf(b2[12], b2[13]); w3.w = pkbf(b2[14], b2[15]);
        GAS u32x4* mp = (GAS u32x4*)(mixed + (size_t)m * 2048 + 16 * lane);
        mp[0] = w0; mp[1] = w1; mp[128] = w2; mp[129] = w3;
    }
}

__device__ __forceinline__ void phase_topk(LAS unsigned char* lds, const float* aff, int* idx, float* val, int* inv, int be, int tid, int wave, int lane) {
    LAS unsigned* hist = (LAS unsigned*)lds;
    LAS unsigned* ctl = hist + 256;
    LAS unsigned* wsum = hist + 320;
    const int b = be >> 4, e = be & 15;
    unsigned key[16];
#pragma unroll
    for (int i = 0; i < 16; ++i) key[i] = __float_as_uint(aff[((size_t)b * SEQ + tid * 16 + i) * 16 + e]);
    unsigned prefix = 0u, mask = 0u; unsigned krem = CAP;
    for (int pass = 0; pass < 4; ++pass) {
        const int shift = 24 - 8 * pass;
        if (tid < 256) hist[tid] = 0u;
        __syncthreads();
#pragma unroll
        for (int i = 0; i < 16; ++i) if ((key[i] & mask) == prefix) atomicAdd((unsigned*)&hist[(key[i] >> shift) & 255u], 1u);
        __syncthreads();
        if (wave == 0) {
            const u32x4 hb = *(const LAS u32x4*)(hist + 4 * lane); const unsigned sl = hb.x + hb.y + hb.z + hb.w;
            int Si = (int)sl; Si += dppi<0x101>(Si); Si += dppi<0x102>(Si); Si += dppi<0x104>(Si); Si += dppi<0x108>(Si);
            { const int t1 = __builtin_amdgcn_readlane(Si, 16), t2 = __builtin_amdgcn_readlane(Si, 32), t3 = __builtin_amdgcn_readlane(Si, 48); const int row = lane >> 4;
              Si += (row == 3 ? 0 : row == 2 ? t3 : row == 1 ? t3 + t2 : t3 + t2 + t1); }
            const unsigned S = (unsigned)Si;
            const unsigned above = S - sl;
            if (above < krem && krem <= above + sl) { unsigned cum = above; int d;
                if (cum + hb.w >= krem) d = 3; else { cum += hb.w; if (cum + hb.z >= krem) d = 2; else { cum += hb.z; if (cum + hb.y >= krem) d = 1; else { cum += hb.y; d = 0; } } }
                ctl[0] = prefix | ((unsigned)(4 * lane + d) << shift); ctl[1] = krem - cum; } }
        __syncthreads();
        prefix = ctl[0]; krem = ctl[1]; mask |= 255u << shift;
        __syncthreads();
    }
    const unsigned thr = prefix;
    int ngt = 0, neq = 0;
#pragma unroll
    for (int i = 0; i < 16; ++i) { ngt += key[i] > thr; neq += key[i] == thr; }
    const int sg = scan_fwd64_i(ngt, lane), sq = scan_fwd64_i(neq, lane);
    if (lane == 63) { wsum[wave] = (unsigned)sg; wsum[8 + wave] = (unsigned)sq; }
    __syncthreads();
    int bg = 0, bq = 0;
#pragma unroll
    for (int w = 0; w < 8; ++w) if (w < wave) { bg += (int)wsum[w]; bq += (int)wsum[8 + w]; }
    int pg = bg + sg - ngt, pq = bq + sq - neq;
#pragma unroll
    for (int i = 0; i < 16; ++i) {
        const int tok = tid * 16 + i; const bool gt = key[i] > thr, eq = key[i] == thr;
        const bool sel = gt || (eq && pq < (int)krem);
        const int slot = pg + (pq < (int)krem ? pq : (int)krem);
        if (sel) { idx[be * CAP + slot] = tok; val[be * CAP + slot] = __uint_as_float(key[i]); }
        inv[((size_t)b * SEQ + tok) * 16 + e] = sel ? slot : -1;
        pg += gt; pq += eq;
    }
    __syncthreads();
}

__device__ __forceinline__ void phase_gather(const bf16* XN, const int* idx, bf16* XG, int gw, int NGW, int lane) {
    for (int r = gw; r < MEXP; r += NGW) {
        const int b = r >> 14; const int tok = idx[r];
        const GAS u32x4* s = (const GAS u32x4*)(XN + ((size_t)b * SEQ + tok) * DM) + lane; GAS u32x4* d = (GAS u32x4*)(XG + (size_t)r * DM) + lane;
        const u32x4 a = s[0], c = s[64]; d[0] = a; d[64] = c;
    }
}

__device__ __forceinline__ void phase_combine(const float* hin, float* hout, const bf16* Y, const int* inv, const float* val, const float* wn, bf16* XN, bool final_, int gw, int NGW, int lane, float pscale = 1.0f) {
    f32x4 wv[4]; load_w4(wn, wv, lane);
    for (int m = gw; m < M; m += NGW) {
        const int b = m >> 13;
        const GAS f32x4* xr = (const GAS f32x4*)(hin + (size_t)m * DM) + lane; f32x4 v[4];
#pragma unroll
        for (int j = 0; j < 4; ++j) v[j] = xr[64 * j];
        const int myslot = (lane < 16) ? inv[(size_t)m * 16 + lane] : -1;
        for (int e = 0; e < 16; ++e) {
            const int s = __shfl(myslot, e);
            if (s >= 0) {
                const int r = (b * 16 + e) * CAP + s; const float a = val[r];
                const GAS u32x2* yr = (const GAS u32x2*)(Y + (size_t)r * DM) + lane;
#pragma unroll
                for (int j = 0; j < 4; ++j) { const u32x2 t = yr[64 * j];
                    v[j].x += a * __uint_as_float(t.x << 16); v[j].y += a * __uint_as_float(t.x & 0xffff0000u); v[j].z += a * __uint_as_float(t.y << 16); v[j].w += a * __uint_as_float(t.y & 0xffff0000u); }
            }
        }
        float s2 = 0.f;
#pragma unroll
        for (int j = 0; j < 4; ++j) s2 += (v[j].x * v[j].x + v[j].y * v[j].y) + (v[j].z * v[j].z + v[j].w * v[j].w);
        const float rstd = __builtin_amdgcn_rsqf(wave_sum(s2) * (1.0f / DM) + EPS);
        GAS f32x4* ho = (GAS f32x4*)(hout + (size_t)m * DM) + lane;
        if (final_) {
#pragma unroll
            for (int j = 0; j < 4; ++j) ho[64 * j] = v[j] * (rstd * pscale) * wv[j];
        } else {
#pragma unroll
            for (int j = 0; j < 4; ++j) ho[64 * j] = v[j];
            f32x4 nv[4];
#pragma unroll
            for (int j = 0; j < 4; ++j) nv[j] = v[j] * rstd * wv[j];
            store_row_bf16(XN + (size_t)m * DM, nv, lane);
        }
    }
}
namespace gdn {
constexpr int CW = 0;
constexpr int SC = CW + 8 * 320 * 4;
constexpr int Q = SC + 1280;
constexpr int K = Q + 64 * 136 * 2;
constexpr int KDT = K + 64 * 136 * 2;
constexpr int VT = KDT + 128 * 72 * 2;
constexpr int T = VT + 64 * 72 * 2;
constexpr int QKD = T + 64 * 72 * 2;
constexpr int ST = QKD + 64 * 72 * 2;
constexpr int TMP = ST + 64 * 136 * 2;
constexpr int RQ = TMP, RK = RQ + 70 * 136 * 2, RV = RK + 70 * 136 * 2, RAW_END = RV + 70 * 72 * 2;
constexpr int AF = TMP, TF = AF + 64 * 68 * 4, XF = TF + 64 * 68 * 4, INV_END = XF + 3 * 16 * 17 * 4;
constexpr int RT = TMP, UT = RT + 64 * 72 * 2, OS = UT + 64 * 72 * 2, ST_END = OS + 64 * 65 * 4;
static_assert(RAW_END <= MISC_OFF && INV_END <= MISC_OFF && ST_END <= MISC_OFF, "gdn LDS map");
}
__device__ __forceinline__ void gdn_chain(LAS unsigned char* lds, int cid, const bf16* raw, const float* scal, const float* conv_w, const float* conv_b,
                                          const float* A_log, const float* dt_bias, bf16* og, int tid, int wave, int lane) {
    using namespace gdn;
    const int dvh = cid & 1, dir = (cid >> 1) & 1, h = (cid >> 2) & 7, b = cid >> 5;
    const int fr = lane & 15, fq = lane >> 4;
    LAS float* cw = (LAS float*)(lds + CW); LAS float* sc = (LAS float*)(lds + SC);
    LAS bf16* q_ = (LAS bf16*)(lds + Q); LAS bf16* k_ = (LAS bf16*)(lds + K); LAS bf16* kdT = (LAS bf16*)(lds + KDT); LAS bf16* vT = (LAS bf16*)(lds + VT);
    LAS bf16* T_ = (LAS bf16*)(lds + T); LAS bf16* QKd = (LAS bf16*)(lds + QKD); LAS bf16* ST_ = (LAS bf16*)(lds + ST);
    LAS bf16* rq = (LAS bf16*)(lds + RQ); LAS bf16* rk = (LAS bf16*)(lds + RK); LAS bf16* rv = (LAS bf16*)(lds + RV);
    LAS float* Af = (LAS float*)(lds + AF); LAS float* Tf = (LAS float*)(lds + TF); LAS float* Xf = (LAS float*)(lds + XF);
    LAS bf16* rT = (LAS bf16*)(lds + RT); LAS bf16* uT = (LAS bf16*)(lds + UT); LAS float* os = (LAS float*)(lds + OS);
    for (int e = tid; e < 8 * 320; e += 512) { const int r = e / 320, c = e % 320;
        const int gch = c < 128 ? h * 128 + c : (c < 256 ? 1024 + h * 128 + (c - 128) : 2048 + h * 128 + dvh * 64 + (c - 256));
        cw[e] = r < 7 ? conv_w[r * CONV_CH + gch] : conv_b[gch]; }
    for (int e = tid; e < 64 * 136 / 2; e += 512) ((LAS unsigned*)ST_)[e] = 0u;
    const float expA = expf(A_log[dir * 8 + h]), dtb = dt_bias[dir * 8 + h];
    f32x4 sacc[4];
#pragma unroll
    for (int nt = 0; nt < 4; ++nt) sacc[nt] = (f32x4){0.f, 0.f, 0.f, 0.f};
    const size_t rowb = (size_t)b * SEQ;
    __syncthreads();
    for (int n = 0; n < NCHUNK; ++n) {
        const int t0 = (dir ? NCHUNK - 1 - n : n) * 64;
        for (int e = tid; e < 70 * 40; e += 512) { const int r = e / 40, p = e % 40; const int t = t0 - 3 + r;
            u32x4 v = (u32x4){0u, 0u, 0u, 0u};
            const int col = p < 16 ? h * 128 + p * 8 : (p < 32 ? 1024 + h * 128 + (p - 16) * 8 : 2048 + h * 128 + dvh * 64 + (p - 32) * 8);
            if (t >= 0 && t < SEQ) v = *(const GAS u32x4*)(raw + (rowb + t) * CONV_CH + col);
            LAS bf16* d = p < 16 ? rq + r * 136 + p * 8 : (p < 32 ? rk + r * 136 + (p - 16) * 8 : rv + r * 72 + (p - 32) * 8);
            *(LAS u32x4*)d = v; }
        if (wave == 0) { const int i = lane; const int t = t0 + (dir ? 63 - i : i);
            const float braw = scal[(rowb + t) * 64 + dir * 8 + h], araw = scal[(rowb + t) * 64 + 16 + dir * 8 + h];
            const float g = -expA * softplus_f(araw + dtb);
            float gc = g;
#pragma unroll
            for (int o = 1; o < 64; o <<= 1) { const float y = __shfl_up(gc, o); if (i >= o) gc += y; }
            const float gl = __shfl(gc, 63);
            sc[i] = sigmoid_f(braw); sc[64 + i] = gc; sc[128 + i] = expf(gc); sc[192 + i] = expf(gl - gc); if (i == 0) sc[256] = expf(gl); }
        __syncthreads();
        { const int i = tid >> 3, cg = tid & 7; const int o = dir ? 63 - i : i;
          float a[16];
          conv16(a, rq + o * 136 + cg * 16, 136, cw + cg * 16, 320);
          float ss = 0.f;
#pragma unroll
          for (int c = 0; c < 16; ++c) { a[c] = silu(a[c]); ss += a[c] * a[c]; }
          ss += __shfl_xor(ss, 1); ss += __shfl_xor(ss, 2); ss += __shfl_xor(ss, 4);
          float rs = (1.0f / sqrtf(ss + EPS)) * 0.08838834764831845f;
          { u32x4 w0, w1; w0.x = pkbf(a[0] * rs, a[1] * rs); w0.y = pkbf(a[2] * rs, a[3] * rs); w0.z = pkbf(a[4] * rs, a[5] * rs); w0.w = pkbf(a[6] * rs, a[7] * rs);
            w1.x = pkbf(a[8] * rs, a[9] * rs); w1.y = pkbf(a[10] * rs, a[11] * rs); w1.z = pkbf(a[12] * rs, a[13] * rs); w1.w = pkbf(a[14] * rs, a[15] * rs);
            *(LAS u32x4*)(q_ + i * 136 + cg * 16) = w0; *(LAS u32x4*)(q_ + i * 136 + cg * 16 + 8) = w1; }
          conv16(a, rk + o * 136 + cg * 16, 136, cw + 128 + cg * 16, 320);
          ss = 0.f;
#pragma unroll
          for (int c = 0; c < 16; ++c) { a[c] = silu(a[c]); ss += a[c] * a[c]; }
          ss += __shfl_xor(ss, 1); ss += __shfl_xor(ss, 2); ss += __shfl_xor(ss, 4);
          rs = 1.0f / sqrtf(ss + EPS);
          { u32x4 w0, w1; w0.x = pkbf(a[0] * rs, a[1] * rs); w0.y = pkbf(a[2] * rs, a[3] * rs); w0.z = pkbf(a[4] * rs, a[5] * rs); w0.w = pkbf(a[6] * rs, a[7] * rs);
            w1.x = pkbf(a[8] * rs, a[9] * rs); w1.y = pkbf(a[10] * rs, a[11] * rs); w1.z = pkbf(a[12] * rs, a[13] * rs); w1.w = pkbf(a[14] * rs, a[15] * rs);
            *(LAS u32x4*)(k_ + i * 136 + cg * 16) = w0; *(LAS u32x4*)(k_ + i * 136 + cg * 16 + 8) = w1; }
          const float ek = sc[192 + i] * rs;
#pragma unroll
          for (int c = 0; c < 16; ++c) kdT[(cg * 16 + c) * 72 + i] = f2bf1(a[c] * ek);
          float v8[8];
          conv8(v8, rv + o * 72 + cg * 8, 72, cw + 256 + cg * 8, 320);
#pragma unroll
          for (int c = 0; c < 8; ++c) vT[(cg * 8 + c) * 72 + i] = f2bf1(silu(v8[c]));
        }
        __syncthreads();
        { const int which = wave >> 2, mt = wave & 3;
          f32x4 acc[1][4];
#pragma unroll
          for (int nt = 0; nt < 4; ++nt) acc[0][nt] = (f32x4){0.f, 0.f, 0.f, 0.f};
          mma_lds<1, 4>(acc, which ? q_ : k_, 136, mt * 16, k_, 136, 0, 128, fr, fq);
#pragma unroll
          for (int nt = 0; nt < 4; ++nt)
#pragma unroll
              for (int r = 0; r < 4; ++r) { const int i = mt * 16 + 4 * fq + r, j = nt * 16 + fr;
                  const float d = expf(fminf(sc[64 + i] - sc[64 + j], 0.f)); const float x = acc[0][nt][r] * d;
                  if (which == 0) Af[i * 68 + j] = (i > j) ? sc[i] * x : 0.f;
                  else QKd[i * 72 + j] = f2bf1((i >= j) ? x : 0.f); }
        }
        __syncthreads();
        if (wave == 0) { const int blk = lane >> 4, c = lane & 15; float t[16];
#pragma unroll
            for (int i = 0; i < 16; ++i) t[i] = (i == c) ? 1.f : 0.f;
#pragma unroll
            for (int i = 1; i < 16; ++i) { float s = 0.f; const LAS float* ar = Af + (blk * 16 + i) * 68 + blk * 16;
#pragma unroll
                for (int j = 0; j < i; ++j) s += ar[j] * t[j];
                t[i] = (i > c) ? -s : t[i];
                if ((i & 3) == 3) asm volatile("" ::: "memory"); }
#pragma unroll
            for (int i = 0; i < 16; ++i) Tf[(blk * 16 + i) * 68 + blk * 16 + c] = t[i]; }
        for (int d = 1; d <= 3; ++d) { const int nbk = 4 - d;
            __syncthreads();
            for (int e = tid; e < nbk * 256; e += 512) { const int J = e >> 8, r = (e >> 4) & 15, c = e & 15, I = J + d; float s = 0.f;
                for (int kk = J * 16; kk < I * 16; ++kk) s += Af[(I * 16 + r) * 68 + kk] * Tf[kk * 68 + J * 16 + c];
                Xf[(J * 16 + r) * 17 + c] = s; }
            __syncthreads();
            for (int e = tid; e < nbk * 256; e += 512) { const int J = e >> 8, r = (e >> 4) & 15, c = e & 15, I = J + d; float s = 0.f;
#pragma unroll
                for (int m2 = 0; m2 < 16; ++m2) s += Tf[(I * 16 + r) * 68 + I * 16 + m2] * Xf[(J * 16 + m2) * 17 + c];
                Tf[(I * 16 + r) * 68 + J * 16 + c] = -s; }
        }
        __syncthreads();
        for (int e = tid; e < 4096; e += 512) { const int i = e >> 6, j = e & 63; T_[i * 72 + j] = f2bf1(((i >> 4) >= (j >> 4)) ? Tf[i * 68 + j] : 0.f); }
        __syncthreads();
        const int mt = wave & 3, nh = wave >> 2;
        f32x4 aq[2];
        { f32x4 ak[2]; ak[0] = ak[1] = aq[0] = aq[1] = (f32x4){0.f, 0.f, 0.f, 0.f};
          for (int k0 = 0; k0 < 128; k0 += 32) {
              const bf16x8 fk = *(const LAS bf16x8*)(k_ + (mt * 16 + fr) * 136 + k0 + fq * 8), fqv = *(const LAS bf16x8*)(q_ + (mt * 16 + fr) * 136 + k0 + fq * 8);
#pragma unroll
              for (int nl = 0; nl < 2; ++nl) { const bf16x8 fb = *(const LAS bf16x8*)(ST_ + (nh * 32 + nl * 16 + fr) * 136 + k0 + fq * 8);
                  ak[nl] = __builtin_amdgcn_mfma_f32_16x16x32_bf16(fk, fb, ak[nl], 0, 0, 0); aq[nl] = __builtin_amdgcn_mfma_f32_16x16x32_bf16(fqv, fb, aq[nl], 0, 0, 0); } }
          const int i0 = mt * 16 + 4 * fq;
          const f32x4 be4 = *(const LAS f32x4*)(sc + i0), eg4 = *(const LAS f32x4*)(sc + 128 + i0);
#pragma unroll
          for (int nl = 0; nl < 2; ++nl) { const int dv = nh * 32 + nl * 16 + fr;
              const bf16x4 vv = *(const LAS bf16x4*)(vT + dv * 72 + i0);
              float r0 = be4[0] * (bf2f_s(vv[0]) - eg4[0] * ak[nl][0]), r1 = be4[1] * (bf2f_s(vv[1]) - eg4[1] * ak[nl][1]);
              float r2 = be4[2] * (bf2f_s(vv[2]) - eg4[2] * ak[nl][2]), r3 = be4[3] * (bf2f_s(vv[3]) - eg4[3] * ak[nl][3]);
              u32x2 w; w.x = pkbf(r0, r1); w.y = pkbf(r2, r3); *(LAS u32x2*)(rT + dv * 72 + i0) = w;
              aq[nl][0] *= eg4[0]; aq[nl][1] *= eg4[1]; aq[nl][2] *= eg4[2]; aq[nl][3] *= eg4[3]; }
        }
        __syncthreads();
        { f32x4 au[1][2]; au[0][0] = au[0][1] = (f32x4){0.f, 0.f, 0.f, 0.f};
          mma_lds<1, 2>(au, T_, 72, mt * 16, rT, 72, nh * 32, 64, fr, fq);
          const int i0 = mt * 16 + 4 * fq;
#pragma unroll
          for (int nl = 0; nl < 2; ++nl) { const int dv = nh * 32 + nl * 16 + fr; u32x2 w; w.x = pkbf(au[0][nl][0], au[0][nl][1]); w.y = pkbf(au[0][nl][2], au[0][nl][3]); *(LAS u32x2*)(uT + dv * 72 + i0) = w; }
        }
        __syncthreads();
        { f32x4 ao[1][2]; ao[0][0] = aq[0]; ao[0][1] = aq[1];
          mma_lds<1, 2>(ao, QKd, 72, mt * 16, uT, 72, nh * 32, 64, fr, fq);
          const int i0 = mt * 16 + 4 * fq;
#pragma unroll
          for (int nl = 0; nl < 2; ++nl)
#pragma unroll
              for (int r = 0; r < 4; ++r) os[(i0 + r) * 65 + nh * 32 + nl * 16 + fr] = ao[0][nl][r];
          const float egl = sc[256];
          f32x4 as_[1][4];
#pragma unroll
          for (int nt = 0; nt < 4; ++nt) as_[0][nt] = sacc[nt] * egl;
          mma_lds<1, 4>(as_, kdT, 72, wave * 16, uT, 72, 0, 64, fr, fq);
#pragma unroll
          for (int nt = 0; nt < 4; ++nt) { sacc[nt] = as_[0][nt];
              u32x2 w; w.x = pkbf(sacc[nt][0], sacc[nt][1]); w.y = pkbf(sacc[nt][2], sacc[nt][3]); *(LAS u32x2*)(ST_ + (nt * 16 + fr) * 136 + wave * 16 + 4 * fq) = w; }
        }
        __syncthreads();
#pragma unroll
        for (int ii = 0; ii < 4; ++ii) { const int i = wave * 8 + 2 * ii + (lane >> 5), cp = lane & 31; const int t = t0 + (dir ? 63 - i : i);
            atomic_add_bf16x2(og + (rowb + t) * 1024 + h * 128 + dvh * 64 + 2 * cp, os[i * 65 + 2 * cp], os[i * 65 + 2 * cp + 1]); }
        __syncthreads();
    }
}

namespace ssd {
constexpr int CW = 0;
constexpr int SC = CW + 8 * 320 * 4;
constexpr int BM_ = SC + 1280;
constexpr int CM_ = BM_ + 64 * 136 * 2;
constexpr int BT = CM_ + 64 * 136 * 2;
constexpr int XDT = BT + 128 * 72 * 2;
constexpr int XDW = XDT + 64 * 72 * 2;
constexpr int MM = XDW + 64 * 72 * 2;
constexpr int HT = MM + 64 * 72 * 2;
constexpr int TMP = HT + 64 * 136 * 2;
constexpr int RX = TMP, RB = RX + 70 * 72 * 2, RC = RB + 70 * 136 * 2, RAW_END = RC + 70 * 136 * 2;
constexpr int OS = TMP, OS_END = OS + 64 * 65 * 4;
static_assert(RAW_END <= MISC_OFF && OS_END <= MISC_OFF, "ssd LDS map");
}
__device__ __forceinline__ void ssd_chain(LAS unsigned char* lds, int cid, const bf16* raw, const float* scal, const float* conv_w, const float* conv_b,
                                          const float* A_log, const float* dt_bias, const float* Dp, bf16* ys, int tid, int wave, int lane) {
    using namespace ssd;
    const int dir = cid & 1, head = (cid >> 1) & 15, b = cid >> 5; const int g = head >> 3;
    const int fr = lane & 15, fq = lane >> 4;
    LAS float* cw = (LAS float*)(lds + CW); LAS float* sc = (LAS float*)(lds + SC);
    LAS bf16* Bm = (LAS bf16*)(lds + BM_); LAS bf16* Cm = (LAS bf16*)(lds + CM_); LAS bf16* BT_ = (LAS bf16*)(lds + BT);
    LAS bf16* xdt = (LAS bf16*)(lds + XDT); LAS bf16* xdw = (LAS bf16*)(lds + XDW); LAS bf16* Mm = (LAS bf16*)(lds + MM); LAS bf16* hT = (LAS bf16*)(lds + HT);
    LAS bf16* rx = (LAS bf16*)(lds + RX); LAS bf16* rb = (LAS bf16*)(lds + RB); LAS bf16* rc = (LAS bf16*)(lds + RC); LAS float* os = (LAS float*)(lds + OS);
    const int chx = 3072 + head * 64, chb = 4096 + g * 128, chc = 4352 + g * 128;
    for (int e = tid; e < 8 * 320; e += 512) { const int r = e / 320, c = e % 320;
        const int gch = c < 64 ? chx + c : (c < 192 ? chb + (c - 64) : chc + (c - 192));
        cw[e] = r < 7 ? conv_w[r * CONV_CH + gch] : conv_b[gch]; }
    for (int e = tid; e < 64 * 136 / 2; e += 512) ((LAS unsigned*)hT)[e] = 0u;
    const float Ah = -expf(A_log[dir * 16 + head]), dtb = dt_bias[dir * 16 + head], Dh = (dir == 0) ? Dp[head] : 0.f;
    f32x4 hacc[4];
#pragma unroll
    for (int nt = 0; nt < 4; ++nt) hacc[nt] = (f32x4){0.f, 0.f, 0.f, 0.f};
    const size_t rowb = (size_t)b * SEQ;
    __syncthreads();
    for (int n = 0; n < NCHUNK; ++n) {
        const int t0 = (dir ? NCHUNK - 1 - n : n) * 64;
        for (int e = tid; e < 70 * 40; e += 512) { const int r = e / 40, p = e % 40; const int t = t0 - 3 + r;
            u32x4 v = (u32x4){0u, 0u, 0u, 0u};
            const int col = p < 8 ? chx + p * 8 : (p < 24 ? chb + (p - 8) * 8 : chc + (p - 24) * 8);
            if (t >= 0 && t < SEQ) v = *(const GAS u32x4*)(raw + (rowb + t) * CONV_CH + col);
            LAS bf16* d = p < 8 ? rx + r * 72 + p * 8 : (p < 24 ? rb + r * 136 + (p - 8) * 8 : rc + r * 136 + (p - 24) * 8);
            *(LAS u32x4*)d = v; }
        if (wave == 0) { const int i = lane; const int t = t0 + (dir ? 63 - i : i);
            const float dt = softplus_f(scal[(rowb + t) * 64 + 32 + dir * 16 + head] + dtb);
            float cs = dt * Ah;
#pragma unroll
            for (int o = 1; o < 64; o <<= 1) { const float y = __shfl_up(cs, o); if (i >= o) cs += y; }
            const float cl = __shfl(cs, 63);
            sc[i] = dt; sc[64 + i] = cs; sc[128 + i] = expf(cs); sc[192 + i] = expf(cl - cs); if (i == 0) sc[256] = expf(cl); }
        __syncthreads();
        { const int i = tid >> 3, cg = tid & 7; const int o = dir ? 63 - i : i;
          float a[16];
          conv16(a, rb + o * 136 + cg * 16, 136, cw + 64 + cg * 16, 320);
#pragma unroll
          for (int c = 0; c < 16; ++c) a[c] = silu(a[c]);
          { u32x4 w0, w1; w0.x = pkbf(a[0], a[1]); w0.y = pkbf(a[2], a[3]); w0.z = pkbf(a[4], a[5]); w0.w = pkbf(a[6], a[7]);
            w1.x = pkbf(a[8], a[9]); w1.y = pkbf(a[10], a[11]); w1.z = pkbf(a[12], a[13]); w1.w = pkbf(a[14], a[15]);
            *(LAS u32x4*)(Bm + i * 136 + cg * 16) = w0; *(LAS u32x4*)(Bm + i * 136 + cg * 16 + 8) = w1; }
#pragma unroll
          for (int c = 0; c < 16; ++c) BT_[(cg * 16 + c) * 72 + i] = f2bf1(a[c]);
          conv16(a, rc + o * 136 + cg * 16, 136, cw + 192 + cg * 16, 320);
#pragma unroll
          for (int c = 0; c < 16; ++c) a[c] = silu(a[c]);
          { u32x4 w0, w1; w0.x = pkbf(a[0], a[1]); w0.y = pkbf(a[2], a[3]); w0.z = pkbf(a[4], a[5]); w0.w = pkbf(a[6], a[7]);
            w1.x = pkbf(a[8], a[9]); w1.y = pkbf(a[10], a[11]); w1.z = pkbf(a[12], a[13]); w1.w = pkbf(a[14], a[15]);
            *(LAS u32x4*)(Cm + i * 136 + cg * 16) = w0; *(LAS u32x4*)(Cm + i * 136 + cg * 16 + 8) = w1; }
          float x8[8];
          conv8(x8, rx + o * 72 + cg * 8, 72, cw + cg * 8, 320);
          const float dt = sc[i], wst = sc[192 + i];
#pragma unroll
          for (int c = 0; c < 8; ++c) { const float xv = silu(x8[c]) * dt; xdt[(cg * 8 + c) * 72 + i] = f2bf1(xv); xdw[(cg * 8 + c) * 72 + i] = f2bf1(xv * wst); }
        }
        __syncthreads();
        const int mt = wave & 3, nh = wave >> 2;
        { f32x4 acc[1][2]; acc[0][0] = acc[0][1] = (f32x4){0.f, 0.f, 0.f, 0.f};
          mma_lds<1, 2>(acc, Cm, 136, mt * 16, Bm, 136, nh * 32, 128, fr, fq);
#pragma unroll
          for (int nl = 0; nl < 2; ++nl)
#pragma unroll
              for (int r = 0; r < 4; ++r) { const int i = mt * 16 + 4 * fq + r, j = nh * 32 + nl * 16 + fr;
                  const float d = expf(fminf(sc[64 + i] - sc[64 + j], 0.f));
                  Mm[i * 72 + j] = f2bf1((i >= j) ? acc[0][nl][r] * d : 0.f); }
        }
        __syncthreads();
        { f32x4 a1[1][2], a2[1][2]; a1[0][0] = a1[0][1] = a2[0][0] = a2[0][1] = (f32x4){0.f, 0.f, 0.f, 0.f};
          mma_lds<1, 2>(a1, Mm, 72, mt * 16, xdt, 72, nh * 32, 64, fr, fq);
          mma_lds<1, 2>(a2, Cm, 136, mt * 16, hT, 136, nh * 32, 128, fr, fq);
          const int i0 = mt * 16 + 4 * fq;
          const f32x4 ec4 = *(const LAS f32x4*)(sc + 128 + i0), dt4 = *(const LAS f32x4*)(sc + i0);
#pragma unroll
          for (int nl = 0; nl < 2; ++nl) { const int p = nh * 32 + nl * 16 + fr; const bf16x4 xv = *(const LAS bf16x4*)(xdt + p * 72 + i0);
#pragma unroll
              for (int r = 0; r < 4; ++r) os[(i0 + r) * 65 + p] = a1[0][nl][r] + ec4[r] * a2[0][nl][r] + Dh * bf2f_s(xv[r]) / dt4[r]; }
        }
        __syncthreads();
        { const float ecl = sc[256];
          f32x4 ah[1][4];
#pragma unroll
          for (int nt = 0; nt < 4; ++nt) ah[0][nt] = hacc[nt] * ecl;
          mma_lds<1, 4>(ah, BT_, 72, wave * 16, xdw, 72, 0, 64, fr, fq);
#pragma unroll
          for (int nt = 0; nt < 4; ++nt) { hacc[nt] = ah[0][nt];
              u32x2 w; w.x = pkbf(hacc[nt][0], hacc[nt][1]); w.y = pkbf(hacc[nt][2], hacc[nt][3]); *(LAS u32x2*)(hT + (nt * 16 + fr) * 136 + wave * 16 + 4 * fq) = w; }
        }
#pragma unroll
        for (int ii = 0; ii < 4; ++ii) { const int i = wave * 8 + 2 * ii + (lane >> 5), cp = lane & 31; const int t = t0 + (dir ? 63 - i : i);
            atomic_add_bf16x2(ys + (rowb + t) * 1024 + head * 64 + 2 * cp, os[i * 65 + 2 * cp], os[i * 65 + 2 * cp + 1]); }
        __syncthreads();
    }
}
namespace pgd {
constexpr int CW = 0;
constexpr int SC = CW + 8 * 384 * 4;
constexpr int Q = SC + 1280;
constexpr int K = Q + 64 * 136 * 2;
constexpr int VT = K + 64 * 136 * 2;
constexpr int TMP = VT + 128 * 72 * 2;
constexpr int RQ = TMP, RK = RQ + 70 * 136 * 2, RV = RK + 70 * 136 * 2, RAW_END = RV + 70 * 136 * 2;
constexpr int AF = TMP, A2F = AF + 64 * 68 * 4, TF = A2F + 64 * 68 * 4, T2F = TF + 64 * 68 * 4, QKP = T2F + 64 * 68 * 4, INV_END = QKP + 64 * 72 * 2;
constexpr int XF = VT;
constexpr int TP = AF;
constexpr int STASH = MISC_OFF - 16384;
static_assert(RAW_END <= STASH && INV_END <= STASH, "prep gdn LDS map");
}
constexpr size_t WS_TQ = 379 * MiB;

__device__ __forceinline__ void prep_gdn_stash(LAS unsigned char* lds, int bid, const bf16* raw, int tid) {
    const int bh = bid >> 3, b = bh >> 3, h = bh & 7, r8 = bid & 7;
    LAS bf16* st = (LAS bf16*)(lds + pgd::STASH);
    for (int e = tid; e < 2 * 3 * 48; e += 512) { const int which = e / 144, r = (e % 144) / 48, p = e % 48;
        const int t = which ? (r8 * 16 + 16) * 64 + r : r8 * 16 * 64 - 3 + r;
        const int col = p < 16 ? h * 128 + p * 8 : (p < 32 ? 1024 + h * 128 + (p - 16) * 8 : 2048 + h * 128 + (p - 32) * 8);
        u32x4 v = (u32x4){0u, 0u, 0u, 0u};
        if (t >= 0 && t < SEQ) v = *(const GAS u32x4*)(raw + ((size_t)b * SEQ + t) * CONV_CH + col);
        *(LAS u32x4*)(st + which * 1152 + r * 384 + p * 8) = v; }
}
__device__ __forceinline__ void inv_diag_blocks(const LAS float* Af, LAS float* Tf, int lane) {
    const int blk = lane >> 4, c = lane & 15; float t[16];
#pragma unroll
    for (int i = 0; i < 16; ++i) t[i] = (i == c) ? 1.f : 0.f;
#pragma unroll
    for (int i = 1; i < 16; ++i) { float s = 0.f; const LAS float* ar = Af + (blk * 16 + i) * 68 + blk * 16;
#pragma unroll
        for (int j = 0; j < i; ++j) s += ar[j] * t[j];
        t[i] = (i > c) ? -s : t[i];
        if ((i & 3) == 3) asm volatile("" ::: "memory"); }
#pragma unroll
    for (int i = 0; i < 16; ++i) Tf[(blk * 16 + i) * 68 + blk * 16 + c] = t[i];
}
__device__ __forceinline__ void inv_offdiag_x(const LAS float* Af, const LAS float* Tf, LAS float* Xf, int d, int ht) {
    const int nbk = 4 - d;
    for (int e = ht; e < nbk * 256; e += 256) { const int J = e >> 8, r = (e >> 4) & 15, c = e & 15, I = J + d; float s = 0.f;
        for (int kk = J * 16; kk < I * 16; ++kk) s += Af[(I * 16 + r) * 68 + kk] * Tf[kk * 68 + J * 16 + c];
        Xf[(J * 16 + r) * 17 + c] = s; }
}
__device__ __forceinline__ void inv_offdiag_t(LAS float* Tf, const LAS float* Xf, int d, int ht) {
    const int nbk = 4 - d;
    for (int e = ht; e < nbk * 256; e += 256) { const int J = e >> 8, r = (e >> 4) & 15, c = e & 15, I = J + d; float s = 0.f;
#pragma unroll
        for (int m2 = 0; m2 < 16; ++m2) s += Tf[(I * 16 + r) * 68 + I * 16 + m2] * Xf[(J * 16 + m2) * 17 + c];
        Tf[(I * 16 + r) * 68 + J * 16 + c] = -s; }
}

__device__ __forceinline__ void conv_pair8(float (&o)[16], const LAS bf16* src  , int ld, const float (&w)[16]) {
#pragma unroll
    for (int t = 0; t < 8; ++t) { o[2 * t] = w[14]; o[2 * t + 1] = w[15]; }
#pragma unroll
    for (int r = 0; r < 14; ++r) { const unsigned xv = *(const LAS unsigned*)(src + r * ld); const float x0 = __uint_as_float(xv << 16), x1 = __uint_as_float(xv & 0xffff0000u);
#pragma unroll
        for (int t = 0; t < 8; ++t) { const int tap = r - t; if (tap >= 0 && tap < 7) { o[2 * t] += x0 * w[2 * tap]; o[2 * t + 1] += x1 * w[2 * tap + 1]; } } }
}
namespace pg2 {
constexpr int CW = 0;
constexpr int SC = CW + 8 * 384 * 4;
constexpr int Q = SC + 1280;
constexpr int K = Q + 64 * 136 * 2;
constexpr int VT = K + 64 * 136 * 2;
constexpr int RAWT = VT + 128 * 72 * 2;
constexpr int RAW_END = RAWT + 3 * 70 * 136 * 2;
constexpr int ABF = RAWT, TRM = ABF + 2 * 64 * 72 * 2, TTR = TRM + 2 * 64 * 72 * 2, AD = TTR + 2 * 64 * 72 * 2, XS = AD + 2 * 4 * 256 * 4, QKP = XS + 2 * 32 * 40 * 2, INV_END = QKP + 64 * 72 * 2;
static_assert(RAW_END <= pgd::STASH && INV_END <= pgd::STASH, "prep gdn v2 LDS map");
}
__device__ __forceinline__ void prep_gdn_range(LAS unsigned char* lds, int bid, bf16* raw, const float* scal, const float* conv_w, const float* conv_b,
                                               const float* A_log, const float* dt_bias, bf16* TQ, int tid_p, int wave_p, int lane_p, float* scal_w) {
    using namespace pg2;
    int tid = tid_p, wave = wave_p, lane = lane_p;
    const int bh = bid >> 3, b = bh >> 3, h = bh & 7, r8 = bid & 7;
    LAS float* cw = (LAS float*)(lds + CW); LAS float* sc = (LAS float*)(lds + SC);
    LAS bf16* q_ = (LAS bf16*)(lds + Q); LAS bf16* k_ = (LAS bf16*)(lds + K); LAS bf16* vT = (LAS bf16*)(lds + VT);
    LAS bf16* rq = (LAS bf16*)(lds + RAWT); LAS bf16* rk = rq + 70 * 136; LAS bf16* rv = rk + 70 * 136;
    LAS bf16* Abf = (LAS bf16*)(lds + ABF); LAS bf16* Trm = (LAS bf16*)(lds + TRM); LAS bf16* Ttr = (LAS bf16*)(lds + TTR);
    LAS float* ADf = (LAS float*)(lds + AD); LAS bf16* Xs = (LAS bf16*)(lds + XS); LAS bf16* QKp = (LAS bf16*)(lds + QKP);
    LAS bf16* st = (LAS bf16*)(lds + pgd::STASH);
    for (int e = tid; e < 8 * 384; e += 512) { const int r = e / 384, c = e % 384;
        const int gch = (c >> 7) * 1024 + h * 128 + (c & 127);
        cw[e] = r < 7 ? conv_w[r * CONV_CH + gch] : conv_b[gch]; }
    const float LOG2E = 1.4426950408889634f;
    const float expAf = expf(A_log[h]), dtbf = dt_bias[h], expAb = expf(A_log[8 + h]), dtbb = dt_bias[8 + h];
    const size_t rowb = (size_t)b * SEQ;
    u32x4 pre[7];
#define PG2_LOAD(u_) do { const int t0_ = (r8 * 16 + (u_)) * 64; \
        _Pragma("unroll") for (int x = 0; x < 7; ++x) { const int e = tid + 512 * x; const int r = e / 48, p = e % 48; \
            pre[x] = (u32x4){0u, 0u, 0u, 0u}; \
            if (e < 70 * 48 && r >= 3 && !(r >= 67 && (u_) == 15)) { const int col = p < 16 ? h * 128 + p * 8 : (p < 32 ? 1024 + h * 128 + (p - 16) * 8 : 2048 + h * 128 + (p - 32) * 8); \
                pre[x] = *(const GAS u32x4*)(raw + (rowb + t0_ - 3 + r) * CONV_CH + col); } } } while (0)
    PG2_LOAD(0);
    float psa = 0.f, psb = 0.f;
#define PG2_LOADS(u_) do { if (wave < 2) { const size_t so_ = (rowb + (size_t)(r8 * 16 + (u_)) * 64 + lane) * 64; psa = scal[so_ + 16 + 8 * wave + h]; psb = scal[so_ + 8 * wave + h]; } } while (0)
    PG2_LOADS(0);
    __syncthreads();
    for (int u = 0; u < 16; ++u) {
        tid = tid_p; asm volatile("" : "+v"(tid));
        lane = tid & 63; wave = __builtin_amdgcn_readfirstlane(tid >> 6);
        const int fr = lane & 15, fq = lane >> 4, half = wave >> 2, w4 = wave & 3;
        const int c = r8 * 16 + u, t0 = c * 64;
#pragma unroll
        for (int x = 0; x < 7; ++x) { const int e = tid + 512 * x; const int r = e / 48, p = e % 48;
            if (e < 70 * 48) { u32x4 v = pre[x];
                if (r < 3) v = *(const LAS u32x4*)(st + r * 384 + p * 8);
                else if (r >= 67 && u == 15) v = *(const LAS u32x4*)(st + 1152 + (r - 67) * 384 + p * 8);
                *(LAS u32x4*)((p < 16 ? rq + r * 136 + p * 8 : (p < 32 ? rk + r * 136 + (p - 16) * 8 : rv + r * 136 + (p - 32) * 8))) = v; } }
        if (wave == 0) { const int i = lane; const size_t so = (rowb + t0 + i) * 64;
            const float gc = scan_fwd64(-expAf * softplus_fast(psa + dtbf), i);
            const float be_ = sigmoid_fast(psb); sc[i] = be_; sc[64 + i] = gc * LOG2E; scal_w[so + h] = be_; scal_w[so + 16 + h] = gc; }
        if (wave == 1) { const int i = lane; const size_t so = (rowb + t0 + i) * 64;
            const float gc = scan_bwd64(-expAb * softplus_fast(psa + dtbb), i);
            const float be_ = sigmoid_fast(psb); sc[128 + i] = be_; sc[192 + i] = gc * LOG2E; scal_w[so + 8 + h] = be_; scal_w[so + 24 + h] = gc; }
        __syncthreads();
        if (u + 1 < 16) { PG2_LOAD(u + 1); PG2_LOADS(u + 1); }
        if (tid < 144) { const int r = tid / 48, p = tid % 48;
            const LAS bf16* s = p < 16 ? rq + (64 + r) * 136 + p * 8 : (p < 32 ? rk + (64 + r) * 136 + (p - 16) * 8 : rv + (64 + r) * 136 + (p - 32) * 8);
            *(LAS u32x4*)(st + r * 384 + p * 8) = *(const LAS u32x4*)s; }
        { const int tg = wave, cp = lane; float w[16], o[16];
#pragma unroll
          for (int tap = 0; tap < 8; ++tap) { w[2 * tap] = cw[tap * 384 + 2 * cp]; w[2 * tap + 1] = cw[tap * 384 + 2 * cp + 1]; }
          conv_pair8(o, rq + (8 * tg) * 136 + 2 * cp, 136, w);
#pragma unroll
          for (int t = 0; t < 8; ++t) { o[2 * t] = silu(o[2 * t]); o[2 * t + 1] = silu(o[2 * t + 1]);
              const float rs = __builtin_amdgcn_rsqf(wave_sum(o[2 * t] * o[2 * t] + o[2 * t + 1] * o[2 * t + 1]) + EPS) * 0.08838834764831845f;
              const unsigned pk = pkbf(o[2 * t] * rs, o[2 * t + 1] * rs);
              *(LAS unsigned*)(q_ + (8 * tg + t) * 136 + 2 * cp) = pk; *(GAS unsigned*)(raw + (rowb + t0 + 8 * tg + t) * CONV_CH + h * 128 + 2 * cp) = pk; }
#pragma unroll
          for (int tap = 0; tap < 8; ++tap) { w[2 * tap] = cw[tap * 384 + 128 + 2 * cp]; w[2 * tap + 1] = cw[tap * 384 + 128 + 2 * cp + 1]; }
          conv_pair8(o, rk + (8 * tg) * 136 + 2 * cp, 136, w);
#pragma unroll
          for (int t = 0; t < 8; ++t) { o[2 * t] = silu(o[2 * t]); o[2 * t + 1] = silu(o[2 * t + 1]);
              const float rs = __builtin_amdgcn_rsqf(wave_sum(o[2 * t] * o[2 * t] + o[2 * t + 1] * o[2 * t + 1]) + EPS);
              const unsigned pk = pkbf(o[2 * t] * rs, o[2 * t + 1] * rs);
              *(LAS unsigned*)(k_ + (8 * tg + t) * 136 + 2 * cp) = pk; *(GAS unsigned*)(raw + (rowb + t0 + 8 * tg + t) * CONV_CH + 1024 + h * 128 + 2 * cp) = pk; }
#pragma unroll
          for (int tap = 0; tap < 8; ++tap) { w[2 * tap] = cw[tap * 384 + 256 + 2 * cp]; w[2 * tap + 1] = cw[tap * 384 + 256 + 2 * cp + 1]; }
          conv_pair8(o, rv + (8 * tg) * 136 + 2 * cp, 136, w);
#pragma unroll
          for (int t = 0; t < 16; ++t) o[t] = silu(o[t]);
          u32x4 e0, e1; e0.x = pkbf(o[0], o[2]); e0.y = pkbf(o[4], o[6]); e0.z = pkbf(o[8], o[10]); e0.w = pkbf(o[12], o[14]);
          e1.x = pkbf(o[1], o[3]); e1.y = pkbf(o[5], o[7]); e1.z = pkbf(o[9], o[11]); e1.w = pkbf(o[13], o[15]);
          *(LAS u32x4*)(vT + (2 * cp) * 72 + 8 * tg) = e0; *(LAS u32x4*)(vT + (2 * cp + 1) * 72 + 8 * tg) = e1;
        }
        __syncthreads();
        for (int e = tid; e < 128 * 8; e += 512) { const int dv = e >> 3, p = e & 7;
            *(GAS u32x4*)(raw + (rowb + t0 + (dv >> 1)) * CONV_CH + 2048 + h * 128 + (dv & 1) * 64 + p * 8) = *(const LAS u32x4*)(vT + dv * 72 + p * 8); }
        for (int e = tid; e < 2 * 2 * 64 * 72 * 2 / 16; e += 512) ((LAS u32x4*)(lds + TRM))[e] = (u32x4){0u, 0u, 0u, 0u};
        for (int e = tid; e < 2 * 32 * 40 * 2 / 16; e += 512) ((LAS u32x4*)(lds + XS))[e] = (u32x4){0u, 0u, 0u, 0u};
        { const int mt = w4;
          f32x4 acc[1][4];
#pragma unroll
          for (int nt = 0; nt < 4; ++nt) acc[0][nt] = (f32x4){0.f, 0.f, 0.f, 0.f};
          mma_lds<1, 4>(acc, half ? q_ : k_, 136, mt * 16, k_, 136, 0, 128, fr, fq);
          const int i0 = mt * 16 + 4 * fq;
          const f32x4 gfi = *(const LAS f32x4*)(sc + 64 + i0), gbi = *(const LAS f32x4*)(sc + 192 + i0), bfi = *(const LAS f32x4*)(sc + i0), bbi = *(const LAS f32x4*)(sc + 128 + i0);
          float gfj[4], gbj[4];
#pragma unroll
          for (int nt = 0; nt < 4; ++nt) { gfj[nt] = sc[64 + nt * 16 + fr]; gbj[nt] = sc[192 + nt * 16 + fr]; }
          asm volatile("" ::: "memory");
#pragma unroll
          for (int nt = 0; nt < 4; ++nt)
#pragma unroll
              for (int r = 0; r < 4; ++r) { const int i = i0 + r, j = nt * 16 + fr; const bool lower = i > j, upper = i < j;
                  const float argl = gfi[r] - gfj[nt], argu = gbi[r] - gbj[nt];
                  const float x = acc[0][nt][r] * __builtin_amdgcn_exp2f(fminf(lower ? argl : argu, 0.f));
                  if (half == 0) { const float af = lower ? bfi[r] * x : 0.f, ab = upper ? bbi[r] * x : 0.f;
                      Abf[i * 72 + j] = f2bf1(af); Abf[64 * 72 + j * 72 + i] = f2bf1(ab);
                      if (mt == nt) { ADf[(mt * 16 + (i & 15)) * 16 + (j & 15)] = af; ADf[1024 + (mt * 16 + (j & 15)) * 16 + (i & 15)] = ab; } }
                  else QKp[i * 72 + j] = f2bf1(i == j ? acc[0][nt][r] : x); }
        }
        __syncthreads();
        { LAS bf16* Ab = Abf + half * 64 * 72; LAS bf16* Tr = Trm + half * 64 * 72; LAS bf16* Tt = Ttr + half * 64 * 72; LAS bf16* Xh = Xs + half * 32 * 40;
          if (w4 == 0) { const int blk = lane >> 4, cc = lane & 15; float t[16]; const LAS float* ad = ADf + half * 1024 + blk * 256;
#pragma unroll
              for (int i = 0; i < 16; ++i) t[i] = (i == cc) ? 1.f : 0.f;
#pragma unroll
              for (int i = 1; i < 16; ++i) { float s0 = 0.f, s1 = 0.f;
#pragma unroll
                  for (int j = 0; j < i; ++j) { if (j & 1) s1 += ad[i * 16 + j] * t[j]; else s0 += ad[i * 16 + j] * t[j]; }
                  t[i] = (i > cc) ? -(s0 + s1) : t[i];
                  if ((i & 3) == 3) asm volatile("" ::: "memory"); }
#pragma unroll
              for (int i = 0; i < 16; ++i) { const unsigned short tb = f2bf1(t[i]); Tr[(blk * 16 + i) * 72 + blk * 16 + cc] = tb; Tt[(blk * 16 + cc) * 72 + blk * 16 + i] = tb; } }
          __syncthreads();
          f32x4 a1[1][1];
          if (w4 < 2) { const int J = 2 * w4, I = J + 1; a1[0][0] = (f32x4){0.f, 0.f, 0.f, 0.f};
              mma_lds<1, 1>(a1, Ab + 16 * J, 72, 16 * I, Tt + 16 * J, 72, 16 * J, 32, fr, fq);
              u32x2 wv; wv.x = pkbf(a1[0][0][0], a1[0][0][1]); wv.y = pkbf(a1[0][0][2], a1[0][0][3]);
              *(LAS u32x2*)(Xh + (w4 * 16 + fr) * 40 + 4 * fq) = wv; }
          __syncthreads();
          if (w4 < 2) { const int J = 2 * w4, I = J + 1; a1[0][0] = (f32x4){0.f, 0.f, 0.f, 0.f};
              mma_lds<1, 1>(a1, Tr + 16 * I, 72, 16 * I, Xh, 40, w4 * 16, 32, fr, fq);
#pragma unroll
              for (int r = 0; r < 4; ++r) Tr[(16 * I + 4 * fq + r) * 72 + 16 * J + fr] = f2bf1(-a1[0][0][r]);
              u32x2 wv; wv.x = pkbf(-a1[0][0][0], -a1[0][0][1]); wv.y = pkbf(-a1[0][0][2], -a1[0][0][3]);
              *(LAS u32x2*)(Tt + (16 * J + fr) * 72 + 16 * I + 4 * fq) = wv; }
          __syncthreads();
          { const int mt2 = w4 >> 1, nt2 = w4 & 1; a1[0][0] = (f32x4){0.f, 0.f, 0.f, 0.f};
            mma_lds<1, 1>(a1, Ab, 72, 32 + 16 * mt2, Tt, 72, 16 * nt2, 32, fr, fq);
            u32x2 wv; wv.x = pkbf(a1[0][0][0], a1[0][0][1]); wv.y = pkbf(a1[0][0][2], a1[0][0][3]);
            __syncthreads();
            *(LAS u32x2*)(Xh + (16 * nt2 + fr) * 40 + 16 * mt2 + 4 * fq) = wv;
            __syncthreads();
            a1[0][0] = (f32x4){0.f, 0.f, 0.f, 0.f};
            mma_lds<1, 1>(a1, Tr + 32, 72, 32 + 16 * mt2, Xh, 40, 16 * nt2, 32, fr, fq);
#pragma unroll
            for (int r = 0; r < 4; ++r) Tr[(32 + 16 * mt2 + 4 * fq + r) * 72 + 16 * nt2 + fr] = f2bf1(-a1[0][0][r]);
            u32x2 w2; w2.x = pkbf(-a1[0][0][0], -a1[0][0][1]); w2.y = pkbf(-a1[0][0][2], -a1[0][0][3]);
            *(LAS u32x2*)(Tt + (16 * nt2 + fr) * 72 + 32 + 16 * mt2 + 4 * fq) = w2; }
        }
        __syncthreads();
        { bf16* tq = TQ + ((size_t)(bh * NCHUNK + c)) * 8192;
          for (int e = tid; e < 1024; e += 512) { const int which = e >> 9, i = (e >> 3) & 63, p = e & 7;
              if (which) *(GAS u32x4*)(tq + 4096 + i * 64 + p * 8) = *(const LAS u32x4*)(QKp + i * 72 + p * 8);
              else { const bf16x8 lo = *(const LAS bf16x8*)(Trm + i * 72 + p * 8), up = *(const LAS bf16x8*)(Ttr + 64 * 72 + i * 72 + p * 8); bf16x8 o8;
#pragma unroll
                  for (int y = 0; y < 8; ++y) { const int j = p * 8 + y; o8[y] = (i > j) ? lo[y] : (i < j ? up[y] : (short)0x3F80); }
                  *(GAS bf16x8*)(tq + i * 64 + p * 8) = o8; } } }
        __syncthreads();
    }
#undef PG2_LOAD
#undef PG2_LOADS
}

__device__ __forceinline__ void gdn_state_v1(LAS unsigned char* lds, int cid, const bf16* raw, const float* scal, const bf16* TQ,
                                             const float* A_log, const float* dt_bias, bf16* og, int tid, int wave, int lane) {
    using namespace gdn;
    const int dvh = cid & 1, dir = (cid >> 1) & 1, h = (cid >> 2) & 7, b = cid >> 5;
    const int fr = lane & 15, fq = lane >> 4;
    LAS float* sc = (LAS float*)(lds + SC);
    LAS bf16* q_ = (LAS bf16*)(lds + Q); LAS bf16* k_ = (LAS bf16*)(lds + K); LAS bf16* kdT = (LAS bf16*)(lds + KDT); LAS bf16* vT = (LAS bf16*)(lds + VT);
    LAS bf16* T_ = (LAS bf16*)(lds + T); LAS bf16* QKd = (LAS bf16*)(lds + QKD); LAS bf16* ST_ = (LAS bf16*)(lds + ST);
    LAS bf16* rT = (LAS bf16*)(lds + RT); LAS bf16* uT = (LAS bf16*)(lds + UT); LAS float* os = (LAS float*)(lds + OS);
    for (int e = tid; e < 64 * 136 / 2; e += 512) ((LAS unsigned*)ST_)[e] = 0u;
    const float expA = expf(A_log[dir * 8 + h]), dtb = dt_bias[dir * 8 + h];
    f32x4 sacc[4];
#pragma unroll
    for (int nt = 0; nt < 4; ++nt) sacc[nt] = (f32x4){0.f, 0.f, 0.f, 0.f};
    const size_t rowb = (size_t)b * SEQ; const int bh = b * 8 + h;
    __syncthreads();
    for (int n = 0; n < NCHUNK; ++n) {
        const int c = dir ? NCHUNK - 1 - n : n, t0 = c * 64;
        for (int e = tid; e < 64 * 16; e += 512) { const int r = e >> 4, p = e & 15;
            *(LAS u32x4*)(q_ + r * 136 + p * 8) = *(const GAS u32x4*)(raw + (rowb + t0 + r) * CONV_CH + h * 128 + p * 8);
            *(LAS u32x4*)(k_ + r * 136 + p * 8) = *(const GAS u32x4*)(raw + (rowb + t0 + r) * CONV_CH + 1024 + h * 128 + p * 8); }
        { const int dvl = tid >> 3, p = tid & 7; const int dv = dvh * 64 + dvl;
          *(LAS u32x4*)(vT + dvl * 72 + p * 8) = *(const GAS u32x4*)(raw + (rowb + t0 + (dv >> 1)) * CONV_CH + 2048 + h * 128 + (dv & 1) * 64 + p * 8); }
        { const bf16* tq = TQ + ((size_t)(bh * NCHUNK + c)) * 8192;
          for (int e = tid; e < 1024; e += 512) { const int which = e >> 9, i = (e >> 3) & 63, p = e & 7;
              bf16x8 v = *(const GAS bf16x8*)(tq + which * 4096 + i * 64 + p * 8);
#pragma unroll
              for (int x = 0; x < 8; ++x) { const int j = p * 8 + x; const bool keep = dir ? (i < j) : (i > j);
                  if (i == j) { if (which == 0) v[x] = (short)0x3F80; } else if (!keep) v[x] = 0; }
              *(LAS bf16x8*)((which ? QKd : T_) + i * 72 + p * 8) = v; } }
        if (wave == 0) { const int i = lane; const size_t so = (rowb + t0 + i) * 64;
            const float g = -expA * softplus_f(scal[so + 16 + dir * 8 + h] + dtb); float gc = g;
            if (dir == 0) {
#pragma unroll
                for (int o = 1; o < 64; o <<= 1) { const float y = __shfl_up(gc, o); if (i >= o) gc += y; }
            } else {
#pragma unroll
                for (int o = 1; o < 64; o <<= 1) { const float y = __shfl_down(gc, o); if (i + o < 64) gc += y; }
            }
            const float gl = __shfl(gc, dir ? 0 : 63);
            sc[i] = sigmoid_f(scal[so + dir * 8 + h]); sc[64 + i] = gc; sc[128 + i] = expf(gc); sc[192 + i] = expf(gl - gc); if (i == 0) sc[256] = expf(gl); }
        __syncthreads();
        { const int i = tid >> 3, cg = tid & 7; const float ek = sc[192 + i];
          const bf16x8 k0 = *(const LAS bf16x8*)(k_ + i * 136 + cg * 16), k1 = *(const LAS bf16x8*)(k_ + i * 136 + cg * 16 + 8);
#pragma unroll
          for (int x = 0; x < 8; ++x) { kdT[(cg * 16 + x) * 72 + i] = f2bf1(bf2f_s(k0[x]) * ek); kdT[(cg * 16 + 8 + x) * 72 + i] = f2bf1(bf2f_s(k1[x]) * ek); } }
        __syncthreads();
        const int mt = wave & 3, nh = wave >> 2;
        f32x4 aq[2];
        { f32x4 ak[2]; ak[0] = ak[1] = aq[0] = aq[1] = (f32x4){0.f, 0.f, 0.f, 0.f};
          for (int k0 = 0; k0 < 128; k0 += 32) {
              const bf16x8 fk = *(const LAS bf16x8*)(k_ + (mt * 16 + fr) * 136 + k0 + fq * 8), fqv = *(const LAS bf16x8*)(q_ + (mt * 16 + fr) * 136 + k0 + fq * 8);
#pragma unroll
              for (int nl = 0; nl < 2; ++nl) { const bf16x8 fb = *(const LAS bf16x8*)(ST_ + (nh * 32 + nl * 16 + fr) * 136 + k0 + fq * 8);
                  ak[nl] = __builtin_amdgcn_mfma_f32_16x16x32_bf16(fk, fb, ak[nl], 0, 0, 0); aq[nl] = __builtin_amdgcn_mfma_f32_16x16x32_bf16(fqv, fb, aq[nl], 0, 0, 0); } }
          const int i0 = mt * 16 + 4 * fq;
          const f32x4 be4 = *(const LAS f32x4*)(sc + i0), eg4 = *(const LAS f32x4*)(sc + 128 + i0);
#pragma unroll
          for (int nl = 0; nl < 2; ++nl) { const int dv = nh * 32 + nl * 16 + fr;
              const bf16x4 vv = *(const LAS bf16x4*)(vT + dv * 72 + i0);
              float r0 = be4[0] * (bf2f_s(vv[0]) - eg4[0] * ak[nl][0]), r1 = be4[1] * (bf2f_s(vv[1]) - eg4[1] * ak[nl][1]);
              float r2 = be4[2] * (bf2f_s(vv[2]) - eg4[2] * ak[nl][2]), r3 = be4[3] * (bf2f_s(vv[3]) - eg4[3] * ak[nl][3]);
              u32x2 w; w.x = pkbf(r0, r1); w.y = pkbf(r2, r3); *(LAS u32x2*)(rT + dv * 72 + i0) = w;
              aq[nl][0] *= eg4[0]; aq[nl][1] *= eg4[1]; aq[nl][2] *= eg4[2]; aq[nl][3] *= eg4[3]; }
        }
        __syncthreads();
        { f32x4 au[1][2]; au[0][0] = au[0][1] = (f32x4){0.f, 0.f, 0.f, 0.f};
          mma_lds<1, 2>(au, T_, 72, mt * 16, rT, 72, nh * 32, 64, fr, fq);
          const int i0 = mt * 16 + 4 * fq;
#pragma unroll
          for (int nl = 0; nl < 2; ++nl) { const int dv = nh * 32 + nl * 16 + fr; u32x2 w; w.x = pkbf(au[0][nl][0], au[0][nl][1]); w.y = pkbf(au[0][nl][2], au[0][nl][3]); *(LAS u32x2*)(uT + dv * 72 + i0) = w; }
        }
        __syncthreads();
        { f32x4 ao[1][2]; ao[0][0] = aq[0]; ao[0][1] = aq[1];
          mma_lds<1, 2>(ao, QKd, 72, mt * 16, uT, 72, nh * 32, 64, fr, fq);
          const int i0 = mt * 16 + 4 * fq;
#pragma unroll
          for (int nl = 0; nl < 2; ++nl)
#pragma unroll
              for (int r = 0; r < 4; ++r) os[(i0 + r) * 65 + nh * 32 + nl * 16 + fr] = ao[0][nl][r];
          const float egl = sc[256];
          f32x4 as_[1][4];
#pragma unroll
          for (int nt = 0; nt < 4; ++nt) as_[0][nt] = sacc[nt] * egl;
          mma_lds<1, 4>(as_, kdT, 72, wave * 16, uT, 72, 0, 64, fr, fq);
#pragma unroll
          for (int nt = 0; nt < 4; ++nt) { sacc[nt] = as_[0][nt];
              u32x2 w; w.x = pkbf(sacc[nt][0], sacc[nt][1]); w.y = pkbf(sacc[nt][2], sacc[nt][3]); *(LAS u32x2*)(ST_ + (nt * 16 + fr) * 136 + wave * 16 + 4 * fq) = w; }
        }
        __syncthreads();
#pragma unroll
        for (int ii = 0; ii < 4; ++ii) { const int i = wave * 8 + 2 * ii + (lane >> 5), cp = lane & 31;
            atomic_add_bf16x2(og + (rowb + t0 + i) * 1024 + h * 128 + dvh * 64 + 2 * cp, os[i * 65 + 2 * cp], os[i * 65 + 2 * cp + 1]); }
        __syncthreads();
    }
}
typedef float f32x16 __attribute__((ext_vector_type(16)));
typedef short v4i16_t __attribute__((ext_vector_type(4)));
namespace gs2 {
constexpr int KO = 0;
constexpr int QO = KO + 64 * 132 * 2;
constexpr int VTO = QO + 64 * 132 * 2;
constexpr int TO = VTO + 64 * 68 * 2;
constexpr int QKO = TO + 64 * 68 * 2;
constexpr int SCO = QKO + 64 * 68 * 2;
constexpr int BUF = SCO + 1024;
constexpr int OST = 2 * BUF;
constexpr int END = OST + 2 * 64 * 72 * 2;
static_assert(END <= MISC_OFF && BUF % 16 == 0, "gdn state LDS map");
}
__device__ __forceinline__ bf16x8 cvt8(const f32x16& x, int base) {
    u32x4 w; w.x = pkbf(x[base], x[base + 1]); w.y = pkbf(x[base + 2], x[base + 3]); w.z = pkbf(x[base + 4], x[base + 5]); w.w = pkbf(x[base + 6], x[base + 7]);
    return __builtin_bit_cast(bf16x8, w);
}
__device__ __forceinline__ bf16x8 afrag(const LAS bf16* p) {
    const bf16x4 lo = *(const LAS bf16x4*)p, hi = *(const LAS bf16x4*)(p + 8);
    return (bf16x8){lo[0], lo[1], lo[2], lo[3], hi[0], hi[1], hi[2], hi[3]};
}
__device__ __forceinline__ bf16x8 afrag_tr(const LAS bf16* p, int ld) {
    const v4i16_t lo = __builtin_amdgcn_ds_read_tr16_b64_v4i16((LAS v4i16_t*)p), hi = __builtin_amdgcn_ds_read_tr16_b64_v4i16((LAS v4i16_t*)(p + 8 * ld));
    return (bf16x8){lo[0], lo[1], lo[2], lo[3], hi[0], hi[1], hi[2], hi[3]};
}
#define MFMA32(a, b, c) __builtin_amdgcn_mfma_f32_32x32x16_bf16((a), (b), (c), 0, 0, 0)

#ifndef WG_BAR
#define WG_BAR() asm volatile("s_waitcnt lgkmcnt(0)\n\ts_barrier" ::: "memory")
#endif
template <int DIR>
__device__ __forceinline__ void gdn_state2(LAS unsigned char* lds, int b, int h, int half, const bf16* raw, const float* scal, const bf16* TQ,
                                           const float* A_log, const float* dt_bias, bf16* og, int tid, int wave, int lane, float* probe = nullptr) {
    using namespace gs2;
    const size_t rowb = (size_t)b * SEQ; const int bh = b * 8 + h;
    const float expA = expf(A_log[DIR * 8 + h]), dtb = dt_bias[DIR * 8 + h];
    LAS bf16* ost = (LAS bf16*)(lds + OST);
    const int r31 = lane & 31, hh = lane >> 5;
    if (wave == 4 || wave == 5) {
        for (int n = 0; n < NCHUNK + 1; ++n) WG_BAR();
    } else if (wave >= 2) {
        const int hw = (wave & 1) | ((wave >> 2) << 1);
        const int ht = hw * 64 + lane;
        unsigned go[14], lo_[14]; u32x4 ld[14]; float sr0 = 0.f, sr1 = 0.f;
#pragma unroll
        for (int x = 0; x < 4; ++x) { const int e = ht + 256 * x, r = e >> 4, p = e & 15;
            go[x] = (unsigned)((r * CONV_CH + 1024 + h * 128 + p * 8) * 2); go[4 + x] = (unsigned)((r * CONV_CH + h * 128 + p * 8) * 2);
            lo_[x] = (unsigned)(KO + (r * 132 + p * 8) * 2); lo_[4 + x] = (unsigned)(QO + (r * 132 + p * 8) * 2); }
#pragma unroll
        for (int x = 0; x < 2; ++x) { const int e = ht + 256 * x, dvl = e >> 3, p = e & 7; const int dv = 64 * half + dvl;
            go[8 + x] = (unsigned)(((dv >> 1) * CONV_CH + 2048 + h * 128 + (dv & 1) * 64 + p * 8) * 2); lo_[8 + x] = (unsigned)(VTO + (dvl * 68 + p * 8) * 2); }
        u32x4 km[2], dg[2], qm[2];
#pragma unroll
        for (int x = 0; x < 2; ++x) { const int e = ht + 256 * x, i = e >> 3, p = e & 7;
            go[10 + x] = (unsigned)(e * 16); go[12 + x] = (unsigned)(8192 + e * 16);
            lo_[10 + x] = (unsigned)(TO + (i * 68 + p * 8) * 2); lo_[12 + x] = (unsigned)(QKO + (i * 68 + p * 8) * 2);
            unsigned kw[4], dw[4], qw[4];
#pragma unroll
            for (int w = 0; w < 4; ++w) { const int j0 = p * 8 + 2 * w, j1 = j0 + 1;
                const bool k0 = DIR ? (i < j0) : (i > j0), k1 = DIR ? (i < j1) : (i > j1);
                kw[w] = (k0 ? 0xFFFFu : 0u) | (k1 ? 0xFFFF0000u : 0u); dw[w] = (i == j0 ? 0x3F80u : 0u) | (i == j1 ? 0x3F800000u : 0u);
                qw[w] = kw[w] | (i == j0 ? 0xFFFFu : 0u) | (i == j1 ? 0xFFFF0000u : 0u); }
            km[x] = (u32x4){kw[0], kw[1], kw[2], kw[3]}; dg[x] = (u32x4){dw[0], dw[1], dw[2], dw[3]}; qm[x] = (u32x4){qw[0], qw[1], qw[2], qw[3]}; }
        const unsigned so_l = (unsigned)(lane * 256 + (DIR * 8 + h) * 4);
#define GS2_ISSUE(c_) do { const GAS char* rb_ = (const GAS char*)(raw + (rowb + (size_t)(c_) * 64) * CONV_CH); const GAS char* tb_ = (const GAS char*)(TQ + ((size_t)(bh * NCHUNK + (c_))) * 8192); \
            _Pragma("unroll") for (int x = 0; x < 10; ++x) ld[x] = *(const GAS u32x4*)(rb_ + go[x]); \
            _Pragma("unroll") for (int x = 10; x < 14; ++x) ld[x] = *(const GAS u32x4*)(tb_ + go[x]); \
            if (hw == 0) { const GAS char* sb_ = (const GAS char*)(scal + (rowb + (size_t)(c_) * 64) * 64); sr0 = *(const GAS float*)(sb_ + so_l); sr1 = *(const GAS float*)(sb_ + so_l + 64); } } while (0)
#define GS2_ST16(off_, v_) do { LAS unsigned char* d_ = B_ + (off_); *(LAS u32x2*)(d_) = (u32x2){(v_).x, (v_).y}; *(LAS u32x2*)(d_ + 8) = (u32x2){(v_).z, (v_).w}; } while (0)
#define GS2_COMMIT(bi_, c_) do { LAS unsigned char* B_ = lds + (bi_) * BUF; \
            _Pragma("unroll") for (int x = 0; x < 10; ++x) GS2_ST16(lo_[x], ld[x]); \
            _Pragma("unroll") for (int x = 0; x < 2; ++x) { const u32x4 tv = (ld[10 + x] & km[x]) | dg[x], qv = ld[12 + x] & qm[x]; \
                GS2_ST16(lo_[10 + x], tv); GS2_ST16(lo_[12 + x], qv); } \
            if (hw == 0) { LAS float* sc_ = (LAS float*)(B_ + SCO); const int i = lane; const float gc = sr1; const float gl = __shfl(gc, DIR ? 0 : 63); \
                sc_[i] = sr0; sc_[64 + i] = __expf(gc); sc_[128 + i] = __expf(gl - gc); if (i == 0) sc_[192] = __expf(gl); } } while (0)
        { const int c0 = DIR ? NCHUNK - 1 : 0; GS2_ISSUE(c0); GS2_COMMIT(0, c0); GS2_ISSUE((DIR ? c0 - 1 : c0 + 1)); }
        for (int n = 0; n < NCHUNK; ++n) {
            const int c = DIR ? NCHUNK - 1 - n : n;
            WG_BAR();
            const bool more = n + 1 < NCHUNK; const int cn = DIR ? c - 1 : c + 1;
            if (more) { GS2_COMMIT((n + 1) & 1, cn); if (n + 2 < NCHUNK) GS2_ISSUE((DIR ? cn - 1 : cn + 1)); }
            unsigned ov[8];
            if (n > 0) {
#pragma unroll
                for (int x = 0; x < 8; ++x) ov[x] = *(const LAS unsigned*)(ost + ((n - 1) & 1) * (64 * 72) + (hw * 16 + 2 * x + (lane >> 5)) * 72 + 2 * (lane & 31));
            }
            if (n > 0) { const int tp = (DIR ? c + 1 : c - 1) * 64;
#pragma unroll
                for (int x = 0; x < 8; ++x) { GAS char* ob_ = (GAS char*)(og + (rowb + tp + hw * 16 + 2 * x) * 1024 + h * 128 + half * 64);
                    (void)__builtin_amdgcn_global_atomic_fadd_v2bf16((GAS s16x2*)(ob_ + (lane >> 5) * 2048 + (lane & 31) * 4), __builtin_bit_cast(s16x2, ov[x])); } }
        }
        WG_BAR();
        { const int tp = (DIR ? 0 : NCHUNK - 1) * 64;
#pragma unroll
          for (int x = 0; x < 8; ++x) { const unsigned v = *(const LAS unsigned*)(ost + ((NCHUNK - 1) & 1) * (64 * 72) + (hw * 16 + 2 * x + (lane >> 5)) * 72 + 2 * (lane & 31));
              GAS char* ob_ = (GAS char*)(og + (rowb + tp + hw * 16 + 2 * x) * 1024 + h * 128 + half * 64);
              (void)__builtin_amdgcn_global_atomic_fadd_v2bf16((GAS s16x2*)(ob_ + (lane >> 5) * 2048 + (lane & 31) * 4), __builtin_bit_cast(s16x2, v)); } }
#undef GS2_ISSUE
#undef GS2_COMMIT
#undef GS2_ST16
    } else {
        const int dv0 = 32 * wave;
#if defined(PROBE_STATE)
        unsigned long long tw_ = 0ull; const unsigned long long ts0_ = __builtin_amdgcn_s_memtime();
#define PB_BAR() do { const unsigned long long t0_ = __builtin_amdgcn_s_memtime(); WG_BAR(); tw_ += __builtin_amdgcn_s_memtime() - t0_; } while (0)
#else
#define PB_BAR() WG_BAR()
#endif
        f32x16 St[4];
#pragma unroll
        for (int t = 0; t < 4; ++t)
#pragma unroll
            for (int r = 0; r < 16; ++r) St[t][r] = 0.f;
        for (int n = 0; n < NCHUNK; ++n) {
            PB_BAR();
            const LAS unsigned char* Bb = lds + (n & 1) * BUF;
            const LAS bf16* Kb = (const LAS bf16*)(Bb + KO); const LAS bf16* Qb = (const LAS bf16*)(Bb + QO); const LAS bf16* Vb = (const LAS bf16*)(Bb + VTO);
            const LAS bf16* Tb = (const LAS bf16*)(Bb + TO); const LAS bf16* QKb = (const LAS bf16*)(Bb + QKO); const LAS float* sc = (const LAS float*)(Bb + SCO);
            f32x16 aK[2];
#pragma unroll
            for (int m = 0; m < 2; ++m)
#pragma unroll
                for (int r = 0; r < 16; ++r) aK[m][r] = 0.f;
            bf16x8 fa[2][2];
            const int offk = r31 * 132 + 4 * hh;
#define GS2_LD2(P_, bi_, ks_) do { fa[bi_][0] = afrag((P_) + offk + 16 * (ks_)); fa[bi_][1] = afrag((P_) + offk + 32 * 132 + 16 * (ks_)); } while (0)
            GS2_LD2(Kb, 0, 0);
#pragma unroll
            for (int ks = 0; ks < 8; ++ks) {
                if (ks < 7) GS2_LD2(Kb, (ks + 1) & 1, ks + 1);
                __builtin_amdgcn_sched_barrier(0);
                const bf16x8 bs = cvt8(St[ks >> 1], 8 * (ks & 1));
                aK[0] = MFMA32(fa[ks & 1][0], bs, aK[0]); aK[1] = MFMA32(fa[ks & 1][1], bs, aK[1]);
                __builtin_amdgcn_sched_barrier(0); }
            bf16x8 ft[8];
#pragma unroll
            for (int mi = 0; mi < 2; ++mi)
#pragma unroll
                for (int kt = 0; kt < 4; ++kt) { const bool need = DIR ? (kt >= 2 * mi) : (kt <= 2 * mi + 1);
                    if (need) ft[mi * 4 + kt] = afrag(Tb + (32 * mi + r31) * 68 + 16 * kt + 4 * hh); }
#pragma unroll
            for (int m = 0; m < 2; ++m)
#pragma unroll
                for (int q4 = 0; q4 < 4; ++q4) { const int tb = 32 * m + 8 * q4 + 4 * hh;
                    const bf16x4 vv = *(const LAS bf16x4*)(Vb + (dv0 + r31) * 68 + tb); const f32x4 be = *(const LAS f32x4*)(sc + tb), eg = *(const LAS f32x4*)(sc + 64 + tb);
#pragma unroll
                    for (int e = 0; e < 4; ++e) aK[m][4 * q4 + e] = be[e] * (bf2f_s(vv[e]) - eg[e] * aK[m][4 * q4 + e]); }
            const bf16x8 br0 = cvt8(aK[0], 0), br1 = cvt8(aK[0], 8), br2 = cvt8(aK[1], 0), br3 = cvt8(aK[1], 8);
            __builtin_amdgcn_sched_barrier(0);
            f32x16 au[2];
#pragma unroll
            for (int m = 0; m < 2; ++m)
#pragma unroll
                for (int r = 0; r < 16; ++r) au[m][r] = 0.f;
            GS2_LD2(Qb, 0, 0);
#pragma unroll
            for (int mi = 0; mi < 2; ++mi)
#pragma unroll
                for (int kt = 0; kt < 4; ++kt) { const bool need = DIR ? (kt >= 2 * mi) : (kt <= 2 * mi + 1);
                    if (need) au[mi] = MFMA32(ft[mi * 4 + kt], (kt == 0 ? br0 : kt == 1 ? br1 : kt == 2 ? br2 : br3), au[mi]); }
            __builtin_amdgcn_sched_barrier(0);
            f32x16 aQ[2];
#pragma unroll
            for (int m = 0; m < 2; ++m)
#pragma unroll
                for (int r = 0; r < 16; ++r) aQ[m][r] = 0.f;
#pragma unroll
            for (int ks = 0; ks < 8; ++ks) {
                if (ks < 7) GS2_LD2(Qb, (ks + 1) & 1, ks + 1);
                __builtin_amdgcn_sched_barrier(0);
                const bf16x8 bs = cvt8(St[ks >> 1], 8 * (ks & 1));
                aQ[0] = MFMA32(fa[ks & 1][0], bs, aQ[0]); aQ[1] = MFMA32(fa[ks & 1][1], bs, aQ[1]);
                __builtin_amdgcn_sched_barrier(0); }
#undef GS2_LD2
            const bf16x8 bu0 = cvt8(au[0], 0), bu1 = cvt8(au[0], 8), bu2 = cvt8(au[1], 0), bu3 = cvt8(au[1], 8);
#pragma unroll
            for (int m = 0; m < 2; ++m)
#pragma unroll
                for (int q4 = 0; q4 < 4; ++q4) { const int tb = 32 * m + 8 * q4 + 4 * hh; const f32x4 ek = *(const LAS f32x4*)(sc + 128 + tb), eg = *(const LAS f32x4*)(sc + 64 + tb);
#pragma unroll
                    for (int e = 0; e < 4; ++e) { au[m][4 * q4 + e] *= ek[e]; aQ[m][4 * q4 + e] *= eg[e]; } }
            const bf16x8 bd0 = cvt8(au[0], 0), bd1 = cvt8(au[0], 8), bd2 = cvt8(au[1], 0), bd3 = cvt8(au[1], 8);
            __builtin_amdgcn_sched_barrier(0);
            bf16x8 fqk[8];
#pragma unroll
            for (int mi = 0; mi < 2; ++mi)
#pragma unroll
                for (int kt = 0; kt < 4; ++kt) { const bool need = DIR ? (kt >= 2 * mi) : (kt <= 2 * mi + 1);
                    if (need) fqk[mi * 4 + kt] = afrag(QKb + (32 * mi + r31) * 68 + 16 * kt + 4 * hh); }
            const int i16 = r31 & 15; const LAS bf16* kp = Kb + (4 * hh + (i16 >> 2)) * 132 + 16 * (r31 >> 4) + 4 * (i16 & 3);
            bf16x8 fk[2][4];
#define GS2_LDKT(bi_, t_) do { _Pragma("unroll") for (int kt = 0; kt < 4; ++kt) fk[bi_][kt] = afrag_tr(kp + (16 * kt) * 132 + 32 * (t_), 132); } while (0)
            __builtin_amdgcn_sched_barrier(0);
#pragma unroll
            for (int mi = 0; mi < 2; ++mi)
#pragma unroll
                for (int kt = 0; kt < 4; ++kt) { const bool need = DIR ? (kt >= 2 * mi) : (kt <= 2 * mi + 1);
                    if (need) aQ[mi] = MFMA32(fqk[mi * 4 + kt], (kt == 0 ? bu0 : kt == 1 ? bu1 : kt == 2 ? bu2 : bu3), aQ[mi]); }
            GS2_LDKT(0, 0);
            const float egl = sc[192];
#pragma unroll
            for (int mi = 0; mi < 2; ++mi)
#pragma unroll
                for (int r = 0; r < 16; ++r) ost[(n & 1) * (64 * 72) + (32 * mi + (r & 3) + 8 * (r >> 2) + 4 * hh) * 72 + dv0 + r31] = f2bf1(aQ[mi][r]);
#pragma unroll
            for (int t = 0; t < 4; ++t) {
                if (t < 3) GS2_LDKT((t + 1) & 1, t + 1);
                __builtin_amdgcn_sched_barrier(0);
#pragma unroll
                for (int r = 0; r < 16; ++r) St[t][r] *= egl;
                St[t] = MFMA32(fk[t & 1][0], bd0, St[t]); St[t] = MFMA32(fk[t & 1][1], bd1, St[t]);
                St[t] = MFMA32(fk[t & 1][2], bd2, St[t]); St[t] = MFMA32(fk[t & 1][3], bd3, St[t]);
                __builtin_amdgcn_sched_barrier(0); }
#undef GS2_LDKT
        }
        WG_BAR();
#if defined(PROBE_STATE)
        if (blockIdx.x == 0 && tid == 0 && probe) { const unsigned long long tt_ = __builtin_amdgcn_s_memtime() - ts0_; *probe = (float)((double)tw_ / (double)tt_); }
#endif
    }
}
constexpr size_t WS_SSC = 1 * MiB;
namespace psd {
constexpr int CW = 0;
constexpr int SC = CW + 8 * 768 * 4;
constexpr int BM_ = SC + 8 * 4 * 64 * 4;
constexpr int CM_ = BM_ + 64 * 136 * 2;
constexpr int CB = CM_ + 64 * 136 * 2;
constexpr int R = CB + 64 * 68 * 4;
constexpr int RBC = R, RBC_END = R + 70 * 272 * 2;
constexpr int RX = R, XT = RX + 70 * 136 * 2, MM = XT + 128 * 72 * 2, R_END = MM + 2 * 64 * 72 * 2;
constexpr int YST = RX;
constexpr int PRBC = CW + 8 * 768 * 4, PXT = PRBC + 70 * 272 * 2, P_END = PXT + 256 * 72 * 2;
constexpr int STASH = pgd::STASH + 4608;
static_assert(P_END <= pgd::STASH, "prep ssd conv LDS map");
static_assert(RBC_END <= pgd::STASH && R_END <= pgd::STASH && STASH + 9216 <= MISC_OFF, "prep ssd LDS map");
}
__device__ __forceinline__ void prep_ssd_stash(LAS unsigned char* lds, int bid, const bf16* raw, int tid) {
    const int bg = bid >> 5, b = bg >> 1, g = bg & 1, r32 = bid & 31;
    LAS bf16* st = (LAS bf16*)(lds + psd::STASH);
    for (int e = tid; e < 2 * 3 * 96; e += 512) { const int which = e / 288, r = (e % 288) / 96, p = e % 96;
        const int t = which ? (r32 * 4 + 4) * 64 + r : r32 * 4 * 64 - 3 + r;
        const int col = p < 64 ? 3072 + g * 512 + p * 8 : (p < 80 ? 4096 + g * 128 + (p - 64) * 8 : 4352 + g * 128 + (p - 80) * 8);
        u32x4 v = (u32x4){0u, 0u, 0u, 0u};
        if (t >= 0 && t < SEQ) v = *(const GAS u32x4*)(raw + ((size_t)b * SEQ + t) * CONV_CH + col);
        *(LAS u32x4*)(st + which * 2304 + r * 768 + p * 8) = v; }
}
__device__ __forceinline__ void prep_ssd_range(LAS unsigned char* lds, int bid, bf16* raw, const float* conv_w, const float* conv_b, int tid_p,
                                               const float* scal, const float* A_log, const float* dt_bias, float* ssc) {
    using namespace psd;
    const int bg = bid >> 5, b = bg >> 1, g = bg & 1, r32 = bid & 31;
    LAS float* cw = (LAS float*)(lds + CW);
    LAS bf16* rbc = (LAS bf16*)(lds + PRBC); LAS bf16* xT = (LAS bf16*)(lds + PXT);
    LAS bf16* st = (LAS bf16*)(lds + STASH);
    for (int e = tid_p; e < 8 * 768; e += 512) { const int r = e / 768, c = e % 768;
        const int gch = c < 512 ? 3072 + g * 512 + c : (c < 640 ? 4096 + g * 128 + (c - 512) : 4352 + g * 128 + (c - 640));
        cw[e] = r < 7 ? conv_w[r * CONV_CH + gch] : conv_b[gch]; }
    const size_t rowb = (size_t)b * SEQ;
    u32x4 pre[5];
#define PSD_LOAD(u_, ps_) do { const int t0_ = (r32 * 4 + (u_)) * 64; \
        _Pragma("unroll") for (int x = 0; x < 5; ++x) { const int e = tid_p + 512 * x; const int r = e >> 5, p = e & 31; \
            pre[x] = (u32x4){0u, 0u, 0u, 0u}; \
            if (e < 70 * 32 && r >= 3 && !(r >= 67 && (u_) == 3)) { const int col = (ps_) == 0 ? (p < 16 ? 4096 + g * 128 + p * 8 : 4352 + g * 128 + (p - 16) * 8) : 3072 + g * 512 + ((ps_) - 1) * 256 + p * 8; \
                pre[x] = *(const GAS u32x4*)(raw + (rowb + t0_ - 3 + r) * CONV_CH + col); } } } while (0)
    PSD_LOAD(0, 0);
    __syncthreads();
    for (int u = 0; u < 4; ++u) {
        int tid = tid_p; asm volatile("" : "+v"(tid));
        const int lane = tid & 63, wave = __builtin_amdgcn_readfirstlane(tid >> 6);
        const int c = r32 * 4 + u, t0 = c * 64;
        { const int hd = g * 8 + wave, i = lane; const size_t so = (rowb + t0 + i) * 64;
          const float dtf = softplus_fast(scal[so + 32 + hd] + dt_bias[hd]), dtb = softplus_fast(scal[so + 48 + hd] + dt_bias[16 + hd]);
          const float cf = scan_fwd64(dtf * -expf(A_log[hd]), i), cbk = scan_bwd64(dtb * -expf(A_log[16 + hd]), i);
          float* sp = ssc + ((size_t)((b * 16 + hd) * NCHUNK + c)) * 256 + i; sp[0] = dtf; sp[64] = cf; sp[128] = dtb; sp[192] = cbk; }
        for (int ps = 0; ps < 3; ++ps) {
            const int scol = ps == 0 ? 512 : (ps == 1 ? 0 : 256);
            const int gcol = ps == 0 ? 4096 + g * 128 : 3072 + g * 512 + (ps - 1) * 256;
#pragma unroll
            for (int x = 0; x < 5; ++x) { const int e = tid_p + 512 * x; const int r = e >> 5, p = e & 31;
                if (e < 70 * 32) { u32x4 v = pre[x];
                    if (r < 3) v = *(const LAS u32x4*)(st + r * 768 + scol + p * 8);
                    else if (r >= 67 && u == 3) v = *(const LAS u32x4*)(st + 2304 + (r - 67) * 768 + scol + p * 8);
                    *(LAS u32x4*)(rbc + r * 272 + (p < 16 ? p * 8 : 136 + (p - 16) * 8)) = v; } }
            __syncthreads();
            if (ps < 2) PSD_LOAD(u, ps + 1); else if (u < 3) PSD_LOAD(u + 1, 0);
            if (tid < 96) { const int r = tid >> 5, p = tid & 31;
                *(LAS u32x4*)(st + r * 768 + scol + p * 8) = *(const LAS u32x4*)(rbc + (64 + r) * 272 + (p < 16 ? p * 8 : 136 + (p - 16) * 8)); }
            { const int tg = wave, cp = lane; float w[16], o[16];
#pragma unroll
              for (int hf = 0; hf < 2; ++hf) {
#pragma unroll
                  for (int tap = 0; tap < 8; ++tap) { w[2 * tap] = cw[tap * 768 + scol + hf * 128 + 2 * cp]; w[2 * tap + 1] = cw[tap * 768 + scol + hf * 128 + 2 * cp + 1]; }
                  conv_pair8(o, rbc + (8 * tg) * 272 + hf * 136 + 2 * cp, 272, w);
#pragma unroll
                  for (int t = 0; t < 16; ++t) o[t] = silu(o[t]);
                  if (ps == 0) {
#pragma unroll
                      for (int t = 0; t < 8; ++t) *(GAS unsigned*)(raw + (rowb + t0 + 8 * tg + t) * CONV_CH + (hf ? 4352 : 4096) + g * 128 + 2 * cp) = pkbf(o[2 * t], o[2 * t + 1]);
                  } else {
                      u32x4 e0, e1; e0.x = pkbf(o[0], o[2]); e0.y = pkbf(o[4], o[6]); e0.z = pkbf(o[8], o[10]); e0.w = pkbf(o[12], o[14]);
                      e1.x = pkbf(o[1], o[3]); e1.y = pkbf(o[5], o[7]); e1.z = pkbf(o[9], o[11]); e1.w = pkbf(o[13], o[15]);
                      *(LAS u32x4*)(xT + (hf * 128 + 2 * cp) * 72 + 8 * tg) = e0; *(LAS u32x4*)(xT + (hf * 128 + 2 * cp + 1) * 72 + 8 * tg) = e1; } } }
            __syncthreads();
            if (ps > 0) {
                for (int e = tid; e < 256 * 8; e += 512) { const int xr = e >> 3, p = e & 7; const int hl = (ps - 1) * 4 + (xr >> 6), pp = xr & 63;
                    *(GAS u32x4*)(raw + (rowb + t0 + pp) * CONV_CH + 3072 + (g * 8 + hl) * 64 + p * 8) = *(const LAS u32x4*)(xT + xr * 72 + p * 8); }
                __syncthreads(); }
        }
    }
}
#undef PSD_LOAD
__device__ __forceinline__ void ssd_intra_range(LAS unsigned char* lds, int bid, const bf16* raw, const float* ssc, const float* Dp, bf16* yi, int tid_p) {
    using namespace psd;
    const int bg = bid >> 5, b = bg >> 1, g = bg & 1, r32 = bid & 31;
    LAS float* sc = (LAS float*)(lds + SC);
    LAS bf16* Bm = (LAS bf16*)(lds + BM_); LAS bf16* Cm = (LAS bf16*)(lds + CM_); LAS float* cb = (LAS float*)(lds + CB);
    LAS bf16* xT = (LAS bf16*)(lds + XT); LAS bf16* Mm = (LAS bf16*)(lds + MM); LAS bf16* yst = (LAS bf16*)(lds + YST);
    const size_t rowb = (size_t)b * SEQ;
    for (int u = 0; u < 4; ++u) {
        int tid = tid_p; asm volatile("" : "+v"(tid));
        const int lane = tid & 63, wave = __builtin_amdgcn_readfirstlane(tid >> 6), fr = lane & 15, fq = lane >> 4;
        const int c = r32 * 4 + u, t0 = c * 64;
        const int hd_w = g * 8 + wave;
        for (int e = tid; e < 64 * 32; e += 512) { const int r = e >> 5, p = e & 31;
            const u32x4 v = *(const GAS u32x4*)(raw + (rowb + t0 + r) * CONV_CH + (p < 16 ? 4096 + g * 128 + p * 8 : 4352 + g * 128 + (p - 16) * 8));
            *(LAS u32x4*)((p < 16 ? Bm + r * 136 + p * 8 : Cm + r * 136 + (p - 16) * 8)) = v; }
        { const int i = lane; const float* sp = ssc + ((size_t)((b * 16 + hd_w) * NCHUNK + c)) * 256 + i;
          LAS float* s = sc + wave * 256; s[i] = sp[0]; s[64 + i] = sp[64] * 1.4426950408889634f; s[128 + i] = sp[128]; s[192 + i] = sp[192] * 1.4426950408889634f; }
        __syncthreads();
        { const int mt = wave & 3, nh = wave >> 2;
          f32x4 acc[1][2]; acc[0][0] = acc[0][1] = (f32x4){0.f, 0.f, 0.f, 0.f};
          mma_lds<1, 2>(acc, Cm, 136, mt * 16, Bm, 136, nh * 32, 128, fr, fq);
#pragma unroll
          for (int nl = 0; nl < 2; ++nl)
#pragma unroll
              for (int r = 0; r < 4; ++r) cb[(mt * 16 + 4 * fq + r) * 68 + nh * 32 + nl * 16 + fr] = acc[0][nl][r]; }
        for (int hp = 0; hp < 4; ++hp) {
            __syncthreads();
            for (int e = tid; e < 128 * 8; e += 512) { const int xr = e >> 3, p = e & 7; const int hl = 2 * hp + (xr >> 6), pp = xr & 63;
                *(LAS u32x4*)(xT + xr * 72 + p * 8) = *(const GAS u32x4*)(raw + (rowb + t0 + pp) * CONV_CH + 3072 + (g * 8 + hl) * 64 + p * 8); }
            { const int e = tid >> 8, i = (tid >> 2) & 63, jq = tid & 3; const int hl = 2 * hp + e;
              const LAS float* s = sc + hl * 256; const float Dh = Dp[g * 8 + hl];
              const float csfi = s[64 + i], csbi = s[192 + i], dsum = s[i] + s[128 + i];
#pragma unroll
              for (int jj = 0; jj < 16; jj += 2) { float m2[2];
#pragma unroll
                  for (int y = 0; y < 2; ++y) { const int j = jq * 16 + jj + y; const float cbv = cb[i * 68 + j];
                      const float cfj = s[64 + j], cbj = s[192 + j], dfj = s[j], dbj = s[128 + j];
                      const float arg = (i > j) ? csfi - cfj : csbi - cbj;
                      const float dtj = (i > j) ? dfj : dbj;
                      const float w = (i == j) ? dsum : __builtin_amdgcn_exp2f(fminf(arg, 0.f)) * dtj;
                      m2[y] = cbv * w + ((i == j) ? Dh : 0.f); }
                  *(LAS unsigned*)(Mm + (e * 64 + i) * 72 + jq * 16 + jj) = pkbf(m2[0], m2[1]); } }
            __syncthreads();
            { const int e = wave >> 2, mt = wave & 3;
              f32x4 acc[1][4];
#pragma unroll
              for (int nt = 0; nt < 4; ++nt) acc[0][nt] = (f32x4){0.f, 0.f, 0.f, 0.f};
              mma_lds<1, 4>(acc, xT + e * 64 * 72, 72, mt * 16, Mm + e * 64 * 72, 72, 0, 64, fr, fq);
#pragma unroll
              for (int nt = 0; nt < 4; ++nt) { u32x2 w; w.x = pkbf(acc[0][nt][0], acc[0][nt][1]); w.y = pkbf(acc[0][nt][2], acc[0][nt][3]);
                  *(LAS u32x2*)(yst + (nt * 16 + fr) * 136 + e * 64 + mt * 16 + 4 * fq) = w; } }
            __syncthreads();
            for (int e = tid; e < 64 * 16; e += 512) { const int i = e >> 4, p = e & 15;
                *(GAS u32x4*)(yi + (rowb + t0 + i) * 1024 + (g * 8 + 2 * hp) * 64 + p * 8) = *(const LAS u32x4*)(yst + i * 136 + p * 8); }
        }
        __syncthreads();
    }
}

namespace ss2 {
constexpr int CO = 0;
constexpr int BO = CO + 64 * 132 * 2;
constexpr int XO = BO + 64 * 132 * 2;
constexpr int SCO = XO + 64 * 72 * 2;
constexpr int BUF = SCO + 768;
constexpr int OST = 2 * BUF;
constexpr int END = OST + 2 * 64 * 72 * 2;
static_assert(END <= MISC_OFF && BUF % 16 == 0, "ssd state LDS map");
}
template <int DIR>
__device__ __forceinline__ void ssd_state2(LAS unsigned char* lds, int b, int hd, const bf16* raw, const float* ssc, bf16* ys, int tid, int wave, int lane) {
    using namespace ss2;
    const size_t rowb = (size_t)b * SEQ; const int g = hd >> 3;
    LAS bf16* ost = (LAS bf16*)(lds + OST);
    const int r31 = lane & 31, hh = lane >> 5;
    if (wave == 4 || wave == 5) {
        for (int n = 0; n < NCHUNK + 1; ++n) WG_BAR();
    } else if (wave >= 2) {
        const int hw = (wave & 1) | ((wave >> 2) << 1); const int ht = hw * 64 + lane;
        unsigned go[10], lo_[10]; u32x4 ld[10]; float sr0 = 0.f, sr1 = 0.f;
#pragma unroll
        for (int x = 0; x < 4; ++x) { const int e = ht + 256 * x, r = e >> 4, p = e & 15;
            go[x] = (unsigned)((r * CONV_CH + 4352 + g * 128 + p * 8) * 2); go[4 + x] = (unsigned)((r * CONV_CH + 4096 + g * 128 + p * 8) * 2);
            lo_[x] = (unsigned)(CO + (r * 132 + p * 8) * 2); lo_[4 + x] = (unsigned)(BO + (r * 132 + p * 8) * 2); }
#pragma unroll
        for (int x = 0; x < 2; ++x) { const int e = ht + 256 * x, xr = e >> 3, p = e & 7;
            go[8 + x] = (unsigned)((xr * CONV_CH + 3072 + hd * 64 + p * 8) * 2); lo_[8 + x] = (unsigned)(XO + (xr * 72 + p * 8) * 2); }
#define SS2_ISSUE(c_) do { const GAS char* rb_ = (const GAS char*)(raw + (rowb + (size_t)(c_) * 64) * CONV_CH); \
            _Pragma("unroll") for (int x = 0; x < 10; ++x) ld[x] = *(const GAS u32x4*)(rb_ + go[x]); \
            if (hw == 0) { const float* sp_ = ssc + ((size_t)((b * 16 + hd) * NCHUNK + (c_))) * 256 + DIR * 128 + lane; sr0 = sp_[0]; sr1 = sp_[64]; } } while (0)
#define SS2_COMMIT(bi_, c_) do { LAS unsigned char* B_ = lds + (bi_) * BUF; \
            _Pragma("unroll") for (int x = 0; x < 10; ++x) { LAS unsigned char* d_ = B_ + lo_[x]; *(LAS u32x2*)(d_) = (u32x2){ld[x].x, ld[x].y}; *(LAS u32x2*)(d_ + 8) = (u32x2){ld[x].z, ld[x].w}; } \
            if (hw == 0) { LAS float* sc_ = (LAS float*)(B_ + SCO); const int i = lane; const float cs = sr1; const float cl = __shfl(cs, DIR ? 0 : 63); \
                sc_[i] = __expf(cs); sc_[64 + i] = sr0 * __expf(cl - cs); if (i == 0) sc_[128] = __expf(cl); } } while (0)
        { const int c0 = DIR ? NCHUNK - 1 : 0; SS2_ISSUE(c0); SS2_COMMIT(0, c0); SS2_ISSUE((DIR ? c0 - 1 : c0 + 1)); }
        for (int n = 0; n < NCHUNK; ++n) {
            const int c = DIR ? NCHUNK - 1 - n : n;
            WG_BAR();
            const bool more = n + 1 < NCHUNK; const int cn = DIR ? c - 1 : c + 1;
            if (more) { SS2_COMMIT((n + 1) & 1, cn); if (n + 2 < NCHUNK) SS2_ISSUE((DIR ? cn - 1 : cn + 1)); }
            unsigned ov[8];
            if (n > 0) {
#pragma unroll
                for (int x = 0; x < 8; ++x) ov[x] = *(const LAS unsigned*)(ost + ((n - 1) & 1) * (64 * 72) + (hw * 16 + 2 * x + (lane >> 5)) * 72 + 2 * (lane & 31));
            }
            if (n > 0) { const int tp = (DIR ? c + 1 : c - 1) * 64;
#pragma unroll
                for (int x = 0; x < 8; ++x) { GAS char* ob_ = (GAS char*)(ys + (rowb + tp + hw * 16 + 2 * x) * 1024 + hd * 64);
                    (void)__builtin_amdgcn_global_atomic_fadd_v2bf16((GAS s16x2*)(ob_ + (lane >> 5) * 2048 + (lane & 31) * 4), __builtin_bit_cast(s16x2, ov[x])); } }
        }
        WG_BAR();
        { const int tp = (DIR ? 0 : NCHUNK - 1) * 64;
#pragma unroll
          for (int x = 0; x < 8; ++x) { const unsigned v = *(const LAS unsigned*)(ost + ((NCHUNK - 1) & 1) * (64 * 72) + (hw * 16 + 2 * x + (lane >> 5)) * 72 + 2 * (lane & 31));
              GAS char* ob_ = (GAS char*)(ys + (rowb + tp + hw * 16 + 2 * x) * 1024 + hd * 64);
              (void)__builtin_amdgcn_global_atomic_fadd_v2bf16((GAS s16x2*)(ob_ + (lane >> 5) * 2048 + (lane & 31) * 4), __builtin_bit_cast(s16x2, v)); } }
#undef SS2_ISSUE
#undef SS2_COMMIT
    } else {
        const int ps = wave; const int xrow = ps * 32 + r31;
        f32x16 Ht[4];
#pragma unroll
        for (int t = 0; t < 4; ++t)
#pragma unroll
            for (int r = 0; r < 16; ++r) Ht[t][r] = 0.f;
        for (int n = 0; n < NCHUNK; ++n) {
            WG_BAR();
            const LAS unsigned char* Bb = lds + (n & 1) * BUF;
            const LAS bf16* Cb = (const LAS bf16*)(Bb + CO); const LAS bf16* Bmb = (const LAS bf16*)(Bb + BO); const LAS bf16* Xb = (const LAS bf16*)(Bb + XO);
            const LAS float* sc = (const LAS float*)(Bb + SCO);
            f32x16 aY[2];
#pragma unroll
            for (int m = 0; m < 2; ++m)
#pragma unroll
                for (int r = 0; r < 16; ++r) aY[m][r] = 0.f;
            bf16x8 fa[2][2];
            const int offc = r31 * 132 + 4 * hh;
#define SS2_LD2(bi_, ks_) do { fa[bi_][0] = afrag(Cb + offc + 16 * (ks_)); fa[bi_][1] = afrag(Cb + offc + 32 * 132 + 16 * (ks_)); } while (0)
            SS2_LD2(0, 0);
#pragma unroll
            for (int ks = 0; ks < 8; ++ks) {
                if (ks < 7) SS2_LD2((ks + 1) & 1, ks + 1);
                __builtin_amdgcn_sched_barrier(0);
                const bf16x8 bs = cvt8(Ht[ks >> 1], 8 * (ks & 1));
                aY[0] = MFMA32(fa[ks & 1][0], bs, aY[0]); aY[1] = MFMA32(fa[ks & 1][1], bs, aY[1]);
                __builtin_amdgcn_sched_barrier(0); }
#undef SS2_LD2
            const int i16 = r31 & 15; const LAS bf16* bp = Bmb + (8 * hh + (i16 >> 2)) * 132 + 16 * (r31 >> 4) + 4 * (i16 & 3);
            bf16x8 xf[4];
#pragma unroll
            for (int kt = 0; kt < 4; ++kt) { const bf16x8 xv = *(const LAS bf16x8*)(Xb + xrow * 72 + 16 * kt + 8 * hh);
                const f32x4 w0 = *(const LAS f32x4*)(sc + 64 + 16 * kt + 8 * hh), w1 = *(const LAS f32x4*)(sc + 64 + 16 * kt + 8 * hh + 4);
                u32x4 w; w.x = pkbf(bf2f_s(xv[0]) * w0[0], bf2f_s(xv[1]) * w0[1]); w.y = pkbf(bf2f_s(xv[2]) * w0[2], bf2f_s(xv[3]) * w0[3]);
                w.z = pkbf(bf2f_s(xv[4]) * w1[0], bf2f_s(xv[5]) * w1[1]); w.w = pkbf(bf2f_s(xv[6]) * w1[2], bf2f_s(xv[7]) * w1[3]);
                xf[kt] = __builtin_bit_cast(bf16x8, w); }
            bf16x8 fb[2][4];
#define SS2_LDBT(bi_, t_) do { _Pragma("unroll") for (int kt = 0; kt < 4; ++kt) { const LAS bf16* p_ = bp + (16 * kt) * 132 + 32 * (t_); \
                const v4i16_t lo_ = __builtin_amdgcn_ds_read_tr16_b64_v4i16((LAS v4i16_t*)p_), hi_ = __builtin_amdgcn_ds_read_tr16_b64_v4i16((LAS v4i16_t*)(p_ + 4 * 132)); \
                fb[bi_][kt] = (bf16x8){lo_[0], lo_[1], lo_[2], lo_[3], hi_[0], hi_[1], hi_[2], hi_[3]}; } } while (0)
            SS2_LDBT(0, 0);
#pragma unroll
            for (int m = 0; m < 2; ++m)
#pragma unroll
                for (int q4 = 0; q4 < 4; ++q4) { const f32x4 ec = *(const LAS f32x4*)(sc + 32 * m + 8 * q4 + 4 * hh);
#pragma unroll
                    for (int x = 0; x < 4; ++x) aY[m][4 * q4 + x] *= ec[x]; }
            const float ecl = sc[128];
#pragma unroll
            for (int mi = 0; mi < 2; ++mi)
#pragma unroll
                for (int r = 0; r < 16; ++r) ost[(n & 1) * (64 * 72) + (32 * mi + (r & 3) + 8 * (r >> 2) + 4 * hh) * 72 + ps * 32 + r31] = f2bf1(aY[mi][r]);
#pragma unroll
            for (int t = 0; t < 4; ++t) {
                if (t < 3) SS2_LDBT((t + 1) & 1, t + 1);
                __builtin_amdgcn_sched_barrier(0);
#pragma unroll
                for (int r = 0; r < 16; ++r) Ht[t][r] *= ecl;
                Ht[t] = MFMA32(fb[t & 1][0], xf[0], Ht[t]); Ht[t] = MFMA32(fb[t & 1][1], xf[1], Ht[t]);
                Ht[t] = MFMA32(fb[t & 1][2], xf[2], Ht[t]); Ht[t] = MFMA32(fb[t & 1][3], xf[3], Ht[t]);
                __builtin_amdgcn_sched_barrier(0); }
#undef SS2_LDBT
        }
        WG_BAR();
    }
}
#ifndef GS3_LDK
#define GS3_LDK 136
#endif
namespace gs3 {
constexpr int LDK = GS3_LDK, LDT = 72;
constexpr int KO = 0;
constexpr int QO = KO + 64 * LDK * 2;
constexpr int VTO = QO + 64 * LDK * 2;
constexpr int TO = VTO + 64 * LDT * 2;
constexpr int QKO = TO + 64 * LDT * 2;
constexpr int SCO = QKO + 64 * LDT * 2;
constexpr int BUF = SCO + 1024;
constexpr int OST = 2 * BUF;
constexpr int END = OST + 2 * 64 * 72 * 2;
static_assert(END <= MISC_OFF && BUF % 16 == 0, "gdn state3 LDS map");
}
__device__ __forceinline__ bf16x8 pack2(const f32x4& a, const f32x4& b) {
    u32x4 w; w.x = pkbf(a[0], a[1]); w.y = pkbf(a[2], a[3]); w.z = pkbf(b[0], b[1]); w.w = pkbf(b[2], b[3]);
    return __builtin_bit_cast(bf16x8, w);
}
__device__ __forceinline__ bf16x8 afrag16(const LAS bf16* p) {
    const bf16x4 lo = *(const LAS bf16x4*)p, hi = *(const LAS bf16x4*)(p + 16);
    return (bf16x8){lo[0], lo[1], lo[2], lo[3], hi[0], hi[1], hi[2], hi[3]};
}
__device__ __forceinline__ bf16x8 afrag16_tr(const LAS bf16* p, int ld) {
    const v4i16_t lo = __builtin_amdgcn_ds_read_tr16_b64_v4i16((LAS v4i16_t*)p), hi = __builtin_amdgcn_ds_read_tr16_b64_v4i16((LAS v4i16_t*)(p + 16 * ld));
    return (bf16x8){lo[0], lo[1], lo[2], lo[3], hi[0], hi[1], hi[2], hi[3]};
}
#define MFMA16(a, b, c) __builtin_amdgcn_mfma_f32_16x16x32_bf16((a), (b), (c), 0, 0, 0)

constexpr int CW_OFLAG = 16384;
__device__ __forceinline__ void store16_wt(bf16* p, u32x4 v) { asm volatile("global_store_dwordx4 %0, %1, off sc1\n\ts_nop 1" :: "v"(p), "v"(v) : "memory"); }
__device__ __forceinline__ void out_rows(const LAS bf16* ostb, bf16* gbase  , int lane, bool second) {
#pragma unroll
    for (int x = 0; x < 2; ++x) { const int r = 8 * x + (lane >> 3), pc = lane & 7;
        const u32x4 ov = *(const LAS u32x4*)(ostb + r * 72 + pc * 8); bf16* gp = gbase + (size_t)r * 1024 + pc * 8;
        if (!second) store16_wt(gp, ov);
        else { const u32x4 gv = *(const GAS u32x4*)gp; u32x4 o;
            o.x = pkbf(__uint_as_float(ov.x << 16) + __uint_as_float(gv.x << 16), __uint_as_float(ov.x & 0xffff0000u) + __uint_as_float(gv.x & 0xffff0000u));
            o.y = pkbf(__uint_as_float(ov.y << 16) + __uint_as_float(gv.y << 16), __uint_as_float(ov.y & 0xffff0000u) + __uint_as_float(gv.y & 0xffff0000u));
            o.z = pkbf(__uint_as_float(ov.z << 16) + __uint_as_float(gv.z << 16), __uint_as_float(ov.z & 0xffff0000u) + __uint_as_float(gv.z & 0xffff0000u));
            o.w = pkbf(__uint_as_float(ov.w << 16) + __uint_as_float(gv.w << 16), __uint_as_float(ov.w & 0xffff0000u) + __uint_as_float(gv.w & 0xffff0000u));
            *(GAS u32x4*)gp = o; } }
}
__device__ __forceinline__ void out_handshake(unsigned* flags, int mine, int partner, int hw, int lane) {
    asm volatile("s_waitcnt vmcnt(0)" ::: "memory");
    if (lane == 0) { __hip_atomic_store(flags + (mine * 4 + hw) * 16, 1u, __ATOMIC_RELAXED, __HIP_MEMORY_SCOPE_AGENT);
        unsigned sp = 0;
        while (__hip_atomic_load(flags + (partner * 4 + hw) * 16, __ATOMIC_RELAXED, __HIP_MEMORY_SCOPE_AGENT) == 0u) { __builtin_amdgcn_s_sleep(2); if (++sp > (1u << 22)) break; } }
    __builtin_amdgcn_fence(__ATOMIC_ACQUIRE, "agent");
    asm volatile("s_waitcnt vmcnt(0)" ::: "memory");
}

template <int DIR, int XP = 0>
__device__ __forceinline__ void gdn_state3(LAS unsigned char* lds, int b, int h, int half, const bf16* raw, const float* scal, const bf16* TQ, bf16* og, int tid, int wave, int lane, unsigned* flags, int cid) {
    using namespace gs3;
    const size_t rowb = (size_t)b * SEQ; const int bh = b * 8 + h;
    LAS bf16* ost = (LAS bf16*)(lds + OST);
    const int fr = lane & 15, fq = lane >> 4;
    if (wave >= 4) {
        const int hw = wave - 4; const int ht = hw * 64 + lane;
        unsigned go[14], lo_[14]; u32x4 ld[14]; float sr0 = 0.f, sr1 = 0.f;
#pragma unroll
        for (int x = 0; x < 4; ++x) { const int e = ht + 256 * x, r = e >> 4, p = e & 15;
            go[x] = (unsigned)((r * CONV_CH + 1024 + h * 128 + p * 8) * 2); go[4 + x] = (unsigned)((r * CONV_CH + h * 128 + p * 8) * 2);
            lo_[x] = (unsigned)(KO + (r * LDK + p * 8) * 2); lo_[4 + x] = (unsigned)(QO + (r * LDK + p * 8) * 2); }
#pragma unroll
        for (int x = 0; x < 2; ++x) { const int e = ht + 256 * x, dvl = e >> 3, p = e & 7; const int dv = 64 * half + dvl;
            go[8 + x] = (unsigned)(((dv >> 1) * CONV_CH + 2048 + h * 128 + (dv & 1) * 64 + p * 8) * 2); lo_[8 + x] = (unsigned)(VTO + (dvl * LDT + p * 8) * 2); }
        u32x4 km[2], dg[2], qm[2];
#pragma unroll
        for (int x = 0; x < 2; ++x) { const int e = ht + 256 * x, i = e >> 3, p = e & 7;
            go[10 + x] = (unsigned)(e * 16); go[12 + x] = (unsigned)(8192 + e * 16);
            lo_[10 + x] = (unsigned)(TO + (i * LDT + p * 8) * 2); lo_[12 + x] = (unsigned)(QKO + (i * LDT + p * 8) * 2);
            unsigned kw[4], dw[4], qw[4];
#pragma unroll
            for (int w = 0; w < 4; ++w) { const int j0 = p * 8 + 2 * w, j1 = j0 + 1;
                const bool k0 = DIR ? (i < j0) : (i > j0), k1 = DIR ? (i < j1) : (i > j1);
                kw[w] = (k0 ? 0xFFFFu : 0u) | (k1 ? 0xFFFF0000u : 0u); dw[w] = (i == j0 ? 0x3F80u : 0u) | (i == j1 ? 0x3F800000u : 0u);
                qw[w] = kw[w] | (i == j0 ? 0xFFFFu : 0u) | (i == j1 ? 0xFFFF0000u : 0u); }
            km[x] = (u32x4){kw[0], kw[1], kw[2], kw[3]}; dg[x] = (u32x4){dw[0], dw[1], dw[2], dw[3]}; qm[x] = (u32x4){qw[0], qw[1], qw[2], qw[3]}; }
        const unsigned so_l = (unsigned)(lane * 256 + (DIR * 8 + h) * 4);
#define GS3_ISSUE(c_) do { const GAS char* rb_ = (const GAS char*)(raw + (rowb + (size_t)(c_) * 64) * CONV_CH); const GAS char* tb_ = (const GAS char*)(TQ + ((size_t)(bh * NCHUNK + (c_))) * 8192); \
            _Pragma("unroll") for (int x = 0; x < 10; ++x) ld[x] = *(const GAS u32x4*)(rb_ + go[x]); \
            _Pragma("unroll") for (int x = 10; x < 14; ++x) ld[x] = *(const GAS u32x4*)(tb_ + go[x]); \
            if (hw == 0) { const GAS char* sb_ = (const GAS char*)(scal + (rowb + (size_t)(c_) * 64) * 64); sr0 = *(const GAS float*)(sb_ + so_l); sr1 = *(const GAS float*)(sb_ + so_l + 64); } } while (0)
#define GS3_COMMIT(bi_, c_) do { LAS unsigned char* B_ = lds + (bi_) * BUF; \
            _Pragma("unroll") for (int x = 0; x < 10; ++x) *(LAS u32x4*)(B_ + lo_[x]) = ld[x]; \
            _Pragma("unroll") for (int x = 0; x < 2; ++x) { *(LAS u32x4*)(B_ + lo_[10 + x]) = (ld[10 + x] & km[x]) | dg[x]; *(LAS u32x4*)(B_ + lo_[12 + x]) = ld[12 + x] & qm[x]; } \
            if (hw == 0) { LAS float* sc_ = (LAS float*)(B_ + SCO); const int i = lane; const float gc = sr1; const float gl = __shfl(gc, DIR ? 0 : 63); \
                sc_[i] = sr0; sc_[64 + i] = __expf(gc); sc_[128 + i] = __expf(gl - gc); if (i == 0) sc_[192] = __expf(gl); } } while (0)
        { const int c0 = DIR ? NCHUNK - 1 : 0; GS3_ISSUE(c0); GS3_COMMIT(0, c0); GS3_ISSUE((DIR ? c0 - 1 : c0 + 1)); }
        for (int n = 0; n < NCHUNK; ++n) {
            const int c = DIR ? NCHUNK - 1 - n : n;
            WG_BAR();
            const bool more = n + 1 < NCHUNK; const int cn = DIR ? c - 1 : c + 1;
            if (more) { GS3_COMMIT((n + 1) & 1, cn); if (n + 2 < NCHUNK && (!(XP & 2) || n < 2)) GS3_ISSUE((DIR ? cn - 1 : cn + 1)); }
            if (n > 0 && !(XP & 1)) { const int tp = (DIR ? c + 1 : c - 1) * 64;
#pragma unroll
                for (int x = 0; x < 8; ++x) { const unsigned v = *(const LAS unsigned*)(ost + ((n - 1) & 1) * (64 * 72) + (hw * 16 + 2 * x + (lane >> 5)) * 72 + 2 * (lane & 31));
                    GAS char* ob_ = (GAS char*)(og + (rowb + tp + hw * 16 + 2 * x) * 1024 + h * 128 + half * 64);
                    (void)__builtin_amdgcn_global_atomic_fadd_v2bf16((GAS s16x2*)(ob_ + (lane >> 5) * 2048 + (lane & 31) * 4), __builtin_bit_cast(s16x2, v)); } }
        }
        WG_BAR();
        { const int tp = (DIR ? 0 : NCHUNK - 1) * 64;
#pragma unroll
          for (int x = 0; x < 8; ++x) { const unsigned v = *(const LAS unsigned*)(ost + ((NCHUNK - 1) & 1) * (64 * 72) + (hw * 16 + 2 * x + (lane >> 5)) * 72 + 2 * (lane & 31));
              GAS char* ob_ = (GAS char*)(og + (rowb + tp + hw * 16 + 2 * x) * 1024 + h * 128 + half * 64);
              (void)__builtin_amdgcn_global_atomic_fadd_v2bf16((GAS s16x2*)(ob_ + (lane >> 5) * 2048 + (lane & 31) * 4), __builtin_bit_cast(s16x2, v)); } }
#undef GS3_ISSUE
#undef GS3_COMMIT
    } else {
        const int dv0 = 16 * wave;
        f32x4 St[8];
#pragma unroll
        for (int t = 0; t < 8; ++t) St[t] = (f32x4){0.f, 0.f, 0.f, 0.f};
        for (int n = 0; n < NCHUNK; ++n) {
            WG_BAR();
            const LAS unsigned char* Bb = lds + (n & 1) * BUF;
            const LAS bf16* Kb = (const LAS bf16*)(Bb + KO); const LAS bf16* Qb = (const LAS bf16*)(Bb + QO); const LAS bf16* Vb = (const LAS bf16*)(Bb + VTO);
            const LAS bf16* Tb = (const LAS bf16*)(Bb + TO); const LAS bf16* QKb = (const LAS bf16*)(Bb + QKO); const LAS float* sc = (const LAS float*)(Bb + SCO);
            const int offa = fr * LDK + 4 * fq, offt = fr * LDT + 4 * fq;
            bf16x8 bS[4];
#pragma unroll
            for (int ks = 0; ks < 4; ++ks) bS[ks] = pack2(St[2 * ks], St[2 * ks + 1]);
            f32x4 aK[4];
#pragma unroll
            for (int m = 0; m < 4; ++m) aK[m] = (f32x4){0.f, 0.f, 0.f, 0.f};
#pragma unroll
            for (int ks = 0; ks < 4; ++ks) { bf16x8 fa[4];
#pragma unroll
                for (int m = 0; m < 4; ++m) fa[m] = afrag16(Kb + offa + 16 * m * LDK + 32 * ks);
#pragma unroll
                for (int m = 0; m < 4; ++m) aK[m] = MFMA16(fa[m], bS[ks], aK[m]); }
            bf16x8 ft[8];
#pragma unroll
            for (int mi = 0; mi < 4; ++mi)
#pragma unroll
                for (int kt = 0; kt < 2; ++kt) { const bool need = DIR ? (kt >= (mi >> 1)) : (kt <= (mi >> 1));
                    if (need) ft[mi * 2 + kt] = afrag16(Tb + offt + 16 * mi * LDT + 32 * kt); }
#pragma unroll
            for (int m = 0; m < 4; ++m) { const int tb = 16 * m + 4 * fq;
                const bf16x4 vv = *(const LAS bf16x4*)(Vb + (dv0 + fr) * LDT + tb); const f32x4 be = *(const LAS f32x4*)(sc + tb), eg = *(const LAS f32x4*)(sc + 64 + tb);
#pragma unroll
                for (int e = 0; e < 4; ++e) aK[m][e] = be[e] * (bf2f_s(vv[e]) - eg[e] * aK[m][e]); }
            const bf16x8 br0 = pack2(aK[0], aK[1]), br1 = pack2(aK[2], aK[3]);
            f32x4 au[4];
#pragma unroll
            for (int m = 0; m < 4; ++m) au[m] = (f32x4){0.f, 0.f, 0.f, 0.f};
#pragma unroll
            for (int mi = 0; mi < 4; ++mi)
#pragma unroll
                for (int kt = 0; kt < 2; ++kt) { const bool need = DIR ? (kt >= (mi >> 1)) : (kt <= (mi >> 1));
                    if (need) au[mi] = MFMA16(ft[mi * 2 + kt], (kt == 0 ? br0 : br1), au[mi]); }
            f32x4 aQ[4];
            if constexpr (!(XP & 4)) {
#pragma unroll
            for (int m = 0; m < 4; ++m) aQ[m] = (f32x4){0.f, 0.f, 0.f, 0.f};
#pragma unroll
            for (int ks = 0; ks < 4; ++ks) { bf16x8 fa[4];
#pragma unroll
                for (int m = 0; m < 4; ++m) fa[m] = afrag16(Qb + offa + 16 * m * LDK + 32 * ks);
#pragma unroll
                for (int m = 0; m < 4; ++m) aQ[m] = MFMA16(fa[m], bS[ks], aQ[m]); }
            bf16x8 fqk[8];
#pragma unroll
            for (int mi = 0; mi < 4; ++mi)
#pragma unroll
                for (int kt = 0; kt < 2; ++kt) { const bool need = DIR ? (kt >= (mi >> 1)) : (kt <= (mi >> 1));
                    if (need) fqk[mi * 2 + kt] = afrag16(QKb + offt + 16 * mi * LDT + 32 * kt); }
            const bf16x8 bu0 = pack2(au[0], au[1]), bu1 = pack2(au[2], au[3]);
#pragma unroll
            for (int m = 0; m < 4; ++m) { const int tb = 16 * m + 4 * fq; const f32x4 eg = *(const LAS f32x4*)(sc + 64 + tb);
#pragma unroll
                for (int e = 0; e < 4; ++e) { aQ[m][e] *= eg[e]; } }
#pragma unroll
            for (int mi = 0; mi < 4; ++mi)
#pragma unroll
                for (int kt = 0; kt < 2; ++kt) { const bool need = DIR ? (kt >= (mi >> 1)) : (kt <= (mi >> 1));
                    if (need) aQ[mi] = MFMA16(fqk[mi * 2 + kt], (kt == 0 ? bu0 : bu1), aQ[mi]); }
#pragma unroll
            for (int m = 0; m < 4; ++m)
#pragma unroll
                for (int e = 0; e < 4; ++e) ost[(n & 1) * (64 * 72) + (16 * m + 4 * fq + e) * 72 + dv0 + fr] = f2bf1(aQ[m][e]);
            }
#pragma unroll
            for (int m = 0; m < 4; ++m) { const int tb = 16 * m + 4 * fq; const f32x4 ek = *(const LAS f32x4*)(sc + 128 + tb);
#pragma unroll
                for (int e = 0; e < 4; ++e) { au[m][e] *= ek[e]; } }
            const bf16x8 bd0 = pack2(au[0], au[1]), bd1 = pack2(au[2], au[3]);
            const float egl = sc[192];
            { const LAS bf16* kp = Kb + (4 * fq + (fr >> 2)) * LDK + 4 * (fr & 3);
#pragma unroll
              for (int t = 0; t < 8; ++t) { const bf16x8 f0 = afrag16_tr(kp + 16 * t, LDK), f1 = afrag16_tr(kp + 32 * LDK + 16 * t, LDK);
                  St[t] = St[t] * egl; St[t] = MFMA16(f0, bd0, St[t]); St[t] = MFMA16(f1, bd1, St[t]); } }
        }
        WG_BAR();
    }
}

namespace ss3 {
constexpr int LDK = GS3_LDK, LDT = 72;
constexpr int CO = 0;
constexpr int BO = CO + 64 * LDK * 2;
constexpr int XO = BO + 64 * LDK * 2;
constexpr int SCO = XO + 64 * LDT * 2;
constexpr int BUF = SCO + 768;
constexpr int OST = 2 * BUF;
constexpr int END = OST + 2 * 64 * 72 * 2;
static_assert(END <= MISC_OFF && BUF % 16 == 0, "ssd state3 LDS map");
}
template <int DIR, int XP = 0>
__device__ __forceinline__ void ssd_state3(LAS unsigned char* lds, int b, int hd, const bf16* raw, const float* ssc, bf16* ys, int tid, int wave, int lane, unsigned* flags, int cid) {
    using namespace ss3;
    const size_t rowb = (size_t)b * SEQ; const int g = hd >> 3;
    LAS bf16* ost = (LAS bf16*)(lds + OST);
    const int fr = lane & 15, fq = lane >> 4;
    if (wave >= 4) {
        const int hw = wave - 4; const int ht = hw * 64 + lane;
        unsigned go[10], lo_[10]; u32x4 ld[10]; float sr0 = 0.f, sr1 = 0.f;
#pragma unroll
        for (int x = 0; x < 4; ++x) { const int e = ht + 256 * x, r = e >> 4, p = e & 15;
            go[x] = (unsigned)((r * CONV_CH + 4352 + g * 128 + p * 8) * 2); go[4 + x] = (unsigned)((r * CONV_CH + 4096 + g * 128 + p * 8) * 2);
            lo_[x] = (unsigned)(CO + (r * LDK + p * 8) * 2); lo_[4 + x] = (unsigned)(BO + (r * LDK + p * 8) * 2); }
#pragma unroll
        for (int x = 0; x < 2; ++x) { const int e = ht + 256 * x, xr = e >> 3, p = e & 7;
            go[8 + x] = (unsigned)((xr * CONV_CH + 3072 + hd * 64 + p * 8) * 2); lo_[8 + x] = (unsigned)(XO + (xr * LDT + p * 8) * 2); }
#define SS3_ISSUE(c_) do { const GAS char* rb_ = (const GAS char*)(raw + (rowb + (size_t)(c_) * 64) * CONV_CH); \
            _Pragma("unroll") for (int x = 0; x < 10; ++x) ld[x] = *(const GAS u32x4*)(rb_ + go[x]); \
            if (hw == 0) { const float* sp_ = ssc + ((size_t)((b * 16 + hd) * NCHUNK + (c_))) * 256 + DIR * 128 + lane; sr0 = sp_[0]; sr1 = sp_[64]; } } while (0)
#define SS3_COMMIT(bi_, c_) do { LAS unsigned char* B_ = lds + (bi_) * BUF; \
            _Pragma("unroll") for (int x = 0; x < 10; ++x) *(LAS u32x4*)(B_ + lo_[x]) = ld[x]; \
            if (hw == 0) { LAS float* sc_ = (LAS float*)(B_ + SCO); const int i = lane; const float cs = sr1; const float cl = __shfl(cs, DIR ? 0 : 63); \
                sc_[i] = __expf(cs); sc_[64 + i] = sr0 * __expf(cl - cs); if (i == 0) sc_[128] = __expf(cl); } } while (0)
        { const int c0 = DIR ? NCHUNK - 1 : 0; SS3_ISSUE(c0); SS3_COMMIT(0, c0); SS3_ISSUE((DIR ? c0 - 1 : c0 + 1)); }
        for (int n = 0; n < NCHUNK; ++n) {
            const int c = DIR ? NCHUNK - 1 - n : n;
            WG_BAR();
            const bool more = n + 1 < NCHUNK; const int cn = DIR ? c - 1 : c + 1;
            if (more) { SS3_COMMIT((n + 1) & 1, cn); if (n + 2 < NCHUNK && (!(XP & 2) || n < 2)) SS3_ISSUE((DIR ? cn - 1 : cn + 1)); }
            if (n > 0 && !(XP & 1)) { const int tp = (DIR ? c + 1 : c - 1) * 64;
#pragma unroll
                for (int x = 0; x < 8; ++x) { const unsigned v = *(const LAS unsigned*)(ost + ((n - 1) & 1) * (64 * 72) + (hw * 16 + 2 * x + (lane >> 5)) * 72 + 2 * (lane & 31));
                    GAS char* ob_ = (GAS char*)(ys + (rowb + tp + hw * 16 + 2 * x) * 1024 + hd * 64);
                    (void)__builtin_amdgcn_global_atomic_fadd_v2bf16((GAS s16x2*)(ob_ + (lane >> 5) * 2048 + (lane & 31) * 4), __builtin_bit_cast(s16x2, v)); } }
        }
        WG_BAR();
        { const int tp = (DIR ? 0 : NCHUNK - 1) * 64;
#pragma unroll
          for (int x = 0; x < 8; ++x) { const unsigned v = *(const LAS unsigned*)(ost + ((NCHUNK - 1) & 1) * (64 * 72) + (hw * 16 + 2 * x + (lane >> 5)) * 72 + 2 * (lane & 31));
              GAS char* ob_ = (GAS char*)(ys + (rowb + tp + hw * 16 + 2 * x) * 1024 + hd * 64);
              (void)__builtin_amdgcn_global_atomic_fadd_v2bf16((GAS s16x2*)(ob_ + (lane >> 5) * 2048 + (lane & 31) * 4), __builtin_bit_cast(s16x2, v)); } }
#undef SS3_ISSUE
#undef SS3_COMMIT
    } else {
        const int p0 = 16 * wave;
        f32x4 Ht[8];
#pragma unroll
        for (int t = 0; t < 8; ++t) Ht[t] = (f32x4){0.f, 0.f, 0.f, 0.f};
        for (int n = 0; n < NCHUNK; ++n) {
            WG_BAR();
            const LAS unsigned char* Bb = lds + (n & 1) * BUF;
            const LAS bf16* Cb = (const LAS bf16*)(Bb + CO); const LAS bf16* Bmb = (const LAS bf16*)(Bb + BO); const LAS bf16* Xb = (const LAS bf16*)(Bb + XO);
            const LAS float* sc = (const LAS float*)(Bb + SCO);
            const int offa = fr * LDK + 4 * fq;
            f32x4 aY[4];
#pragma unroll
            for (int m = 0; m < 4; ++m) aY[m] = (f32x4){0.f, 0.f, 0.f, 0.f};
#pragma unroll
            for (int ks = 0; ks < 4; ++ks) { const bf16x8 bs = pack2(Ht[2 * ks], Ht[2 * ks + 1]); bf16x8 fa[4];
#pragma unroll
                for (int m = 0; m < 4; ++m) fa[m] = afrag16(Cb + offa + 16 * m * LDK + 32 * ks);
#pragma unroll
                for (int m = 0; m < 4; ++m) aY[m] = MFMA16(fa[m], bs, aY[m]); }
            bf16x8 xf[2];
#pragma unroll
            for (int kt = 0; kt < 2; ++kt) { const bf16x8 xv = *(const LAS bf16x8*)(Xb + (p0 + fr) * LDT + 32 * kt + 8 * fq);
                const f32x4 w0 = *(const LAS f32x4*)(sc + 64 + 32 * kt + 8 * fq), w1 = *(const LAS f32x4*)(sc + 64 + 32 * kt + 8 * fq + 4);
                u32x4 w; w.x = pkbf(bf2f_s(xv[0]) * w0[0], bf2f_s(xv[1]) * w0[1]); w.y = pkbf(bf2f_s(xv[2]) * w0[2], bf2f_s(xv[3]) * w0[3]);
                w.z = pkbf(bf2f_s(xv[4]) * w1[0], bf2f_s(xv[5]) * w1[1]); w.w = pkbf(bf2f_s(xv[6]) * w1[2], bf2f_s(xv[7]) * w1[3]);
                xf[kt] = __builtin_bit_cast(bf16x8, w); }
#pragma unroll
            for (int m = 0; m < 4; ++m) { const f32x4 ec = *(const LAS f32x4*)(sc + 16 * m + 4 * fq);
#pragma unroll
                for (int e = 0; e < 4; ++e) aY[m][e] *= ec[e]; }
            const float ecl = sc[128];
#pragma unroll
            for (int m = 0; m < 4; ++m)
#pragma unroll
                for (int e = 0; e < 4; ++e) ost[(n & 1) * (64 * 72) + (16 * m + 4 * fq + e) * 72 + p0 + fr] = f2bf1(aY[m][e]);
            { const LAS bf16* bp = Bmb + (8 * fq + (fr >> 2)) * LDK + 4 * (fr & 3);
#pragma unroll
              for (int t = 0; t < 8; ++t) {
                  bf16x8 f[2];
#pragma unroll
                  for (int kt = 0; kt < 2; ++kt) { const LAS bf16* p = bp + (32 * kt) * LDK + 16 * t;
                      const v4i16_t lo = __builtin_amdgcn_ds_read_tr16_b64_v4i16((LAS v4i16_t*)p), hi = __builtin_amdgcn_ds_read_tr16_b64_v4i16((LAS v4i16_t*)(p + 4 * LDK));
                      f[kt] = (bf16x8){lo[0], lo[1], lo[2], lo[3], hi[0], hi[1], hi[2], hi[3]}; }
                  Ht[t] = Ht[t] * ecl; Ht[t] = MFMA16(f[0], xf[0], Ht[t]); Ht[t] = MFMA16(f[1], xf[1], Ht[t]); } }
        }
        WG_BAR();
    }
}
#ifndef PG8_SP2_
#define PG8_SP2_ true
#endif
#ifndef MK_ONE_LAUNCH
#define MK_ONE_LAUNCH 1
#endif
constexpr int PPL = 14;
constexpr int NPHASE = 1 + PPL * DEPTH;
struct Args { const float* in[19]; float* out; unsigned char* ws; int ph_lo, ph_hi; };
__global__ void __launch_bounds__(NWAVES * 64, 2) fwd_kernel(Args args) {
    extern __shared__ __attribute__((aligned(16))) unsigned char lds_raw[];
    LAS unsigned char* lds = (LAS unsigned char*)lds_raw;
    unsigned* ctl = (unsigned*)(args.ws + WS_CTL);
    volatile LAS unsigned* MISC = (volatile LAS unsigned*)(lds + MISC_OFF);
    for (int u = threadIdx.x; u < 64; u += 512) MISC[u] = 0u;
    __syncthreads();
#if MK_ONE_LAUNCH
    XcdBarrier bar = xcd_barrier_post(ctl + CW_BAR, MISC + 8);
#define GRID_BAR() do { XcdBarrier bb_ = bar; asm volatile("" : "+s"(bb_.bar), "+s"(bb_.x)); xcd_barrier(bb_); } while (0)
#else
#define GRID_BAR() do {} while (0)
#endif
    const int lo = args.ph_lo, hi = args.ph_hi;
#define WSP(T, off) ((T*)(wsb + (off)))
#if defined(PROBE_STATE) || defined(PROBE_ANY) || defined(PROBE_SUB)
#define PROBE_PTR ((float*)(wsb + WS_CTL) + 2048)
#define PROBE_SCALE (1.0f + sqrtf(8.7e-4f * fminf(fmaxf(*(volatile float*)PROBE_PTR, 0.f), 1.f)))
#else
#define PROBE_PTR ((float*)nullptr)
#define PROBE_SCALE 1.0f
#endif
    for (int ph = lo; ph < hi; ++ph) {
        int tid = threadIdx.x, bid = blockIdx.x, G = gridDim.x;
        const __attribute__((address_space(4))) Args* ap = (const __attribute__((address_space(4))) Args*)__builtin_amdgcn_kernarg_segment_ptr();
        asm volatile("" : "+v"(tid)); asm volatile("" : "+s"(bid), "+s"(G), "+s"(ap));
        unsigned char* wsb = ap->ws;
        const int lane = tid & 63, wave = __builtin_amdgcn_readfirstlane(tid >> 6);
        const int gw = bid * NWAVES + wave, NGW = G * NWAVES, gtid = bid * 512 + tid, NGT = G * 512;
        const int l = (ph == 0) ? 0 : (ph - 1) / PPL; const int k = (ph == 0) ? -1 : (ph - 1) % PPL;
#if defined(PROBE_ANY)
        if (l == PROBE_L && k == PROBE_K0 && blockIdx.x == 0 && threadIdx.x == 0) ((unsigned long long*)(wsb + WS_CTL))[1100] = __builtin_amdgcn_s_memrealtime();
#endif
        switch (k) {
        case -1: {
            cvt_mixer_weights(lds, wsb, ap->in[2], ap->in[12], gw, NGW, wave, lane);
            phase_norm(ap->in[0], ap->in[1], WSP(bf16, WS_XN), gw, NGW, lane);
        } break;
        case 0: {
            pg8::Gemm g{WSP(bf16, WS_XN), WSP(bf16, WS_WA), M, NWA, DM, 0, 0, 0}; pg8::StaticOrder S; S.init(M, NWA, G, bid);
            pg8::EpiRawA E{WSP(bf16, WS_RAW), WSP(float, WS_SCAL)};
            pg8::gemm_phase<pg8::EpiRawA, pg8::StaticOrder, true, PG8_SP2_>(lds, g, S, E);
#if defined(EXP_DUP_GEMM)
            if (l == 0 && (EXP_DUP_GEMM & 1)) { __syncthreads(); pg8::gemm_phase<pg8::EpiRawA, pg8::StaticOrder, true, PG8_SP2_>(lds, g, S, E); }
#endif
        } break;
        case 1: {
            if (l == 1) PB_START(3, wsb);
            prep_gdn_stash(lds, bid, WSP(bf16, WS_RAW), tid); prep_ssd_stash(lds, bid, WSP(bf16, WS_RAW), tid);
            zero_region(wsb + WS_OG, 64 * MiB, gtid, NGT); zero_region(wsb + WS_YS, 64 * MiB, gtid, NGT);
            GRID_BAR();
            if (l == 1) { PB_END(3, wsb); PB_START(1, wsb); }
            prep_gdn_range(lds, bid, WSP(bf16, WS_RAW), WSP(float, WS_SCAL), ap->in[3] + (size_t)l * 7 * CONV_CH, ap->in[4] + (size_t)l * CONV_CH,
                           ap->in[5] + l * 16, ap->in[6] + l * 16, WSP(bf16, WS_TQ), tid, wave, lane, WSP(float, WS_SCAL));
            __syncthreads();
            if (l == 1) { PB_END(1, wsb); PB_START(2, wsb); }
            { int tid2 = threadIdx.x; asm volatile("" : "+v"(tid2));
              prep_ssd_range(lds, bid, WSP(bf16, WS_RAW), ap->in[3] + (size_t)l * 7 * CONV_CH, ap->in[4] + (size_t)l * CONV_CH, tid2,
                             WSP(float, WS_SCAL), ap->in[8] + l * 32, ap->in[9] + l * 32, WSP(float, WS_SSC)); }
            if (l == 1) { __syncthreads(); PB_END(2, wsb); }
        } break;
        case 2: {
#if defined(EXP_DUP_ST)
            for (int c0_ = bid; c0_ < 256 * 2; c0_ += G) {
                const int c = c0_ & 255; const bool dup_ = c0_ >= 256;
                if (dup_ && (l != 0 || ((EXP_DUP_ST == 1) != (c < 128)))) continue;
                bf16* const ogp_ = dup_ ? (bf16*)ap->out : WSP(bf16, WS_OG); bf16* const ysp_ = dup_ ? (bf16*)ap->out : WSP(bf16, WS_YS);
#else
            for (int c = bid; c < 256; c += G) {
                bf16* const ogp_ = WSP(bf16, WS_OG); bf16* const ysp_ = WSP(bf16, WS_YS);
#endif
                int tid = threadIdx.x; asm volatile("" : "+v"(tid));
                const int lane = tid & 63, wave = __builtin_amdgcn_readfirstlane(tid >> 6);
                if (c < 128) { const int x_ = (c & 7) | ((c >> 4) << 3), hf_ = (c >> 3) & 1;
                    const int b_ = x_ >> 4, h_ = (x_ >> 1) & 7;
#if defined(EXP_DUP_ST) && defined(EXP_S2)
                    if (dup_) { if (x_ & 1) gdn_state2<1>(lds, b_, h_, hf_, WSP(bf16, WS_RAW), WSP(float, WS_SCAL), WSP(bf16, WS_TQ), ap->in[5] + l * 16, ap->in[6] + l * 16, ogp_, tid, wave, lane);
                                else        gdn_state2<0>(lds, b_, h_, hf_, WSP(bf16, WS_RAW), WSP(float, WS_SCAL), WSP(bf16, WS_TQ), ap->in[5] + l * 16, ap->in[6] + l * 16, ogp_, tid, wave, lane); } else
#endif
#if defined(EXP_DUP_ST) && defined(EXP_XP)
                    if (dup_) { if (x_ & 1) gdn_state3<1, EXP_XP>(lds, b_, h_, hf_, WSP(bf16, WS_RAW), WSP(float, WS_SCAL), WSP(bf16, WS_TQ), ogp_, tid, wave, lane, nullptr, 0);
                                else        gdn_state3<0, EXP_XP>(lds, b_, h_, hf_, WSP(bf16, WS_RAW), WSP(float, WS_SCAL), WSP(bf16, WS_TQ), ogp_, tid, wave, lane, nullptr, 0); } else
#endif
                    if (x_ & 1) gdn_state3<1>(lds, b_, h_, hf_, WSP(bf16, WS_RAW), WSP(float, WS_SCAL), WSP(bf16, WS_TQ), ogp_, tid, wave, lane, nullptr, 0);
                    else        gdn_state3<0>(lds, b_, h_, hf_, WSP(bf16, WS_RAW), WSP(float, WS_SCAL), WSP(bf16, WS_TQ), ogp_, tid, wave, lane, nullptr, 0); }
                else { const int c2 = c - 128, gi_ = c2 & 15, hl_ = c2 >> 4;
                    const int b_ = gi_ >> 2, hd_ = ((gi_ >> 1) & 1) * 8 + hl_;
#if defined(EXP_DUP_ST) && defined(EXP_XP)
                    if (dup_) { if (gi_ & 1) ssd_state3<1, EXP_XP>(lds, b_, hd_, WSP(bf16, WS_RAW), WSP(float, WS_SSC), ysp_, tid, wave, lane, nullptr, 0);
                                else         ssd_state3<0, EXP_XP>(lds, b_, hd_, WSP(bf16, WS_RAW), WSP(float, WS_SSC), ysp_, tid, wave, lane, nullptr, 0); } else
#endif
                    if (gi_ & 1) ssd_state3<1>(lds, b_, hd_, WSP(bf16, WS_RAW), WSP(float, WS_SSC), ysp_, tid, wave, lane, nullptr, 0);
                    else         ssd_state3<0>(lds, b_, hd_, WSP(bf16, WS_RAW), WSP(float, WS_SSC), ysp_, tid, wave, lane, nullptr, 0); }
                __syncthreads();
            }
        } break;
        case 3: {
            ssd_intra_range(lds, bid, WSP(bf16, WS_RAW), WSP(float, WS_SSC), ap->in[10] + l * 16, WSP(bf16, WS_TQ), tid);
#if defined(EXP_DUP_INTRA)
            if (l == 0) { __syncthreads();
            ssd_intra_range(lds, bid, WSP(bf16, WS_RAW), WSP(float, WS_SSC), ap->in[10] + l * 16, WSP(bf16, WS_TQ), tid);
 }
#endif
        } break;
        case 4: {
            phase_norm((l == 0) ? ap->in[0] : ap->out, ap->in[1] + (size_t)l * DM, WSP(bf16, WS_XN2), gw, NGW, lane);
#if defined(EXP_DUP_B)
            if (l == 0) { __syncthreads();
            phase_norm((l == 0) ? ap->in[0] : ap->out, ap->in[1] + (size_t)l * DM, WSP(bf16, WS_XN2), gw, NGW, lane);
 }
#endif
        } break;
        case 5: {
            pg8::Gemm g{WSP(bf16, WS_XN2), WSP(bf16, WS_WB), M, NGATE, DM, 0, 0, 0}; pg8::StaticOrder S; S.init(M, NGATE, G, bid);
            pg8::EpiBf16 E{WSP(bf16, WS_GATES), NGATE};
            pg8::gemm_phase<pg8::EpiBf16, pg8::StaticOrder, true, PG8_SP2_>(lds, g, S, E);
#if defined(EXP_DUP_GEMM)
            if (l == 0 && (EXP_DUP_GEMM & 2)) { __syncthreads(); pg8::gemm_phase<pg8::EpiBf16, pg8::StaticOrder, true, PG8_SP2_>(lds, g, S, E); }
#endif
        } break;
        case 6: {
            phase_finish(WSP(bf16, WS_OG), WSP(bf16, WS_YS), WSP(bf16, WS_TQ), WSP(bf16, WS_GATES), ap->in[7] + l * 128, ap->in[11] + l * 1024, WSP(bf16, WS_MIXED), gw, NGW, lane);
#if defined(EXP_DUP_B)
            if (l == 0) { __syncthreads();
            phase_finish(WSP(bf16, WS_OG), WSP(bf16, WS_YS), WSP(bf16, WS_TQ), WSP(bf16, WS_GATES), ap->in[7] + l * 128, ap->in[11] + l * 1024, WSP(bf16, WS_MIXED), gw, NGW, lane);
 }
#endif
        } break;
        case 7: {
            pg8::Gemm g{WSP(bf16, WS_MIXED), WSP(bf16, WS_WO), M, DM, 2048, 0, 0, 0}; pg8::StaticOrder S; S.init(M, DM, G, bid);
            pg8::EpiResid E{(l == 0) ? ap->in[0] : ap->out, ap->out, DM};
            pg8::gemm_phase<pg8::EpiResid, pg8::StaticOrder, true, PG8_SP2_>(lds, g, S, E);
#if defined(EXP_DUP_GEMM)
            if (l == 0 && (EXP_DUP_GEMM & 4)) { __syncthreads(); pg8::gemm_phase<pg8::EpiResid, pg8::StaticOrder, true, PG8_SP2_>(lds, g, S, E); }
#endif
        } break;
        case 8: {
            phase_norm2_router(lds, ap->out, ap->in[13] + l * DM, ap->in[14] + (size_t)l * DM * 16, WSP(bf16, WS_XN), WSP(float, WS_AFF), gw, NGW, tid, lane);
#if defined(EXP_DUP_A) || defined(EXP_DUP_N2)
            if (l == 0) { __syncthreads();
            phase_norm2_router(lds, ap->out, ap->in[13] + l * DM, ap->in[14] + (size_t)l * DM * 16, WSP(bf16, WS_XN), WSP(float, WS_AFF), gw, NGW, tid, lane);
            __syncthreads();
            cvt_expert_weights(lds, wsb, ap->in[15] + (size_t)l * NEXP * DM * EFF, ap->in[16] + (size_t)l * NEXP * DM * EFF, ap->in[17] + (size_t)l * NEXP * EFF * DM, gw, NGW, wave, lane);
            if (l + 1 < DEPTH) cvt_mixer_weights(lds, wsb, ap->in[2] + (size_t)(l + 1) * DM * 6720, ap->in[12] + (size_t)(l + 1) * 2048 * DM, gw, NGW, wave, lane);
 }
#endif
        } break;
        case 9: {
            if (bid < NB * NEXP) phase_topk(lds, WSP(float, WS_AFF), WSP(int, WS_IDX), WSP(float, WS_VAL), WSP(int, WS_INV), bid, tid, wave, lane);
            else if (G > NB * NEXP) { const int gw2 = (bid - NB * NEXP) * NWAVES + wave, NGW2 = (G - NB * NEXP) * NWAVES;
                cvt_expert_weights(lds, wsb, ap->in[15] + (size_t)l * NEXP * DM * EFF, ap->in[16] + (size_t)l * NEXP * DM * EFF, ap->in[17] + (size_t)l * NEXP * EFF * DM, gw2, NGW2, wave, lane);
                if (l + 1 < DEPTH) cvt_mixer_weights(lds, wsb, ap->in[2] + (size_t)(l + 1) * DM * 6720, ap->in[12] + (size_t)(l + 1) * 2048 * DM, gw2, NGW2, wave, lane); }
#if defined(EXP_DUP_A) || defined(EXP_DUP_TK)
            if (l == 0) { __syncthreads();
            for (int be = bid; be < NB * NEXP; be += G) phase_topk(lds, WSP(float, WS_AFF), WSP(int, WS_IDX), WSP(float, WS_VAL), WSP(int, WS_INV), be, tid, wave, lane);
 }
#endif
        } break;
        case 10: {
            phase_gather(WSP(bf16, WS_XN), WSP(int, WS_IDX), WSP(bf16, WS_XG), gw, NGW, lane);
#if defined(EXP_DUP_A) || defined(EXP_DUP_GA)
            if (l == 0) { __syncthreads();
            phase_gather(WSP(bf16, WS_XN), WSP(int, WS_IDX), WSP(bf16, WS_XG), gw, NGW, lane);
 }
#endif
        } break;
        case 11: {
            pg8::Gemm g{WSP(bf16, WS_XG), WSP(bf16, WS_WGU), MEXP, 1024, DM, 2, 15, (size_t)1024 * 1024 * 2}; pg8::StaticOrder S; S.init(MEXP, 1024, G, bid);
            pg8::EpiSwiglu E{WSP(bf16, WS_HMID), EFF};
            pg8::gemm_phase<pg8::EpiSwiglu, pg8::StaticOrder, true, PG8_SP2_>(lds, g, S, E);
#if defined(EXP_DUP_GEMM)
            if (l == 0 && (EXP_DUP_GEMM & 8)) { __syncthreads(); pg8::gemm_phase<pg8::EpiSwiglu, pg8::StaticOrder, true, PG8_SP2_>(lds, g, S, E); }
#endif
        } break;
        case 12: {
            pg8::Gemm g{WSP(bf16, WS_HMID), WSP(bf16, WS_WD), MEXP, 1024, EFF, 2, 15, (size_t)1024 * 512 * 2}; pg8::StaticOrder S; S.init(MEXP, 1024, G, bid);
            pg8::EpiBf16 E{WSP(bf16, WS_XG), 1024};
            pg8::gemm_phase<pg8::EpiBf16, pg8::StaticOrder, true, PG8_SP2_>(lds, g, S, E);
#if defined(EXP_DUP_GEMM)
            if (l == 0 && (EXP_DUP_GEMM & 16)) { __syncthreads(); pg8::gemm_phase<pg8::EpiBf16, pg8::StaticOrder, true, PG8_SP2_>(lds, g, S, E); }
#endif
        } break;
        default: {
            const bool last = (l + 1 == DEPTH);
            phase_combine(ap->out, ap->out, WSP(bf16, WS_XG), WSP(int, WS_INV), WSP(float, WS_VAL), last ? ap->in[18] : ap->in[1] + (size_t)(l + 1) * DM, WSP(bf16, WS_XN), last, gw, NGW, lane, PROBE_SCALE);

        } break;
        }
        if (ph + 1 < hi) GRID_BAR();
#if defined(EXP_XBAR)
        if (ph == 1) for (int xb_ = 0; xb_ < EXP_XBAR; ++xb_) GRID_BAR();
#endif
#if defined(PROBE_ANY)
        if (l == PROBE_L && k == PROBE_K1 && blockIdx.x == 0 && threadIdx.x == 0) { const unsigned long long t1_ = __builtin_amdgcn_s_memrealtime(), t0_ = ((unsigned long long*)(wsb + WS_CTL))[1100];
            const unsigned bk_ = (unsigned)((t1_ - t0_) / PROBE_TICKS); *(volatile float*)PROBE_PTR = (float)(bk_ > 40u ? 40u : bk_) * (1.0f / 40.0f); }
#endif
    }
#undef WSP
}

extern "C" void kernel_launch(void* const* d_in, const int* in_sizes, int n_in, void* d_out, int out_size, void* d_ws, size_t ws_size, hipStream_t stream) {
    static int grid = 0;
    if (grid == 0) {
        if (n_in != 19 || in_sizes[0] != M * DM || out_size != M * DM || ws_size < WS_END) { fprintf(stderr, "kernel_launch: unexpected shapes (n_in %d, in0 %d, out %d, ws %zu); nothing launched\n", n_in, n_in > 0 ? in_sizes[0] : -1, out_size, ws_size); grid = -1; return; }
        int dev = 0, cus = 0;
        if (hipGetDevice(&dev) != hipSuccess || hipDeviceGetAttribute(&cus, hipDeviceAttributeMultiprocessorCount, dev) != hipSuccess) { grid = -1; return; }
        if (hipFuncSetAttribute((const void*)fwd_kernel, hipFuncAttributeMaxDynamicSharedMemorySize, LDS_BYTES) != hipSuccess) { fprintf(stderr, "kernel_launch: hipFuncSetAttribute failed\n"); grid = -1; return; }
        (void)hipGetLastError();
        grid = cus;
    }
    if (grid < 0) return;
    (void)hipMemsetAsync((char*)d_ws + WS_CTL, 0, CTL_ZERO_BYTES, stream);
    Args a{};
    for (int i = 0; i < 19; ++i) a.in[i] = (const float*)d_in[i];
    a.out = (float*)d_out; a.ws = (unsigned char*)d_ws;
#if MK_ONE_LAUNCH
    a.ph_lo = 0; a.ph_hi = NPHASE;
    hipLaunchKernelGGL(fwd_kernel, dim3(grid), dim3(NWAVES * 64), LDS_BYTES, stream, a);
#else
    for (int p = 0; p < NPHASE; ++p) { a.ph_lo = p; a.ph_hi = p + 1; hipLaunchKernelGGL(fwd_kernel, dim3(grid), dim3(NWAVES * 64), LDS_BYTES, stream, a); }
#endif
}
```

```cpp
#include <hip/hip_runtime.h>
#include <cstdio>
#include <cstdint>
namespace pg8 {
#define PG8_LAS __attribute__((address_space(3)))
typedef unsigned short bf16_t;
typedef short bf16x8 __attribute__((ext_vector_type(8)));
typedef float f32x4 __attribute__((ext_vector_type(4)));
typedef unsigned u32x4 __attribute__((ext_vector_type(4)));
constexpr int BM = 256, BK = 64, HALF = 128, HTB = HALF * BK * 2  , STAGE_BYTES = 8 * HTB, NXCD = 8, WGM = 8;

__host__ __device__ __forceinline__ int lds_byte(int r, int c) { const int st = (r >> 4) * 2 + (c >> 5), rr = r & 15, cc = c & 31, ob = rr * 64 + cc * 2; return st * 1024 + (ob ^ (((ob >> 9) & 1) << 5)); }
__host__ __device__ __forceinline__ void stage_rc(int b, int& R, int& C) { const int st = b / 1024, sb = b % 1024, swz = sb ^ (((sb >> 9) & 1) << 5); R = (st >> 1) * 16 + swz / 64; C = (st & 1) * 32 + (swz % 64) / 2; }
__host__ __device__ __forceinline__ int perm32(int rho) { const int n = rho >> 4, i = rho & 15; return 8 * (i >> 2) + 4 * n + (i & 3); }

struct Unit { int pm, pn; };
struct Gemm { const bf16_t* A; const bf16_t* Bt; int M, N, K; int bshift, bmask; size_t bstride;
    __device__ __forceinline__ size_t grp_off(int pm) const { return (size_t)((pm >> bshift) & bmask) * bstride; } };

struct StaticOrder {
    int nM, nN, nwg, G, c;
    __host__ __device__ void init(int M, int N, int G_, int c_) { nM = M / BM; nN = N / BM; nwg = nM * nN; G = G_; c = c_; }
    __host__ __device__ bool next(int i, Unit& u) const {
        const long L = (long)i * G + c; if (L >= nwg) return false;
        int wgid = (int)L; { const int q = nwg / NXCD, r = nwg % NXCD, xcd = wgid % NXCD, off = wgid / NXCD; wgid = (xcd < r ? xcd * (q + 1) : r * (q + 1) + (xcd - r) * q) + off; }
        const int nig = WGM * nN, gid = wgid / nig, fm = gid * WGM, gsz = (nM - fm) < WGM ? (nM - fm) : WGM;
        u.pm = fm + ((wgid % nig) % gsz); u.pn = (wgid % nig) / gsz; return true;
    }
    __device__ __forceinline__ void a_ready(const Unit&) const {}
    __device__ __forceinline__ void done(const Unit&) const {}
};

__device__ __forceinline__ unsigned cvt_pk_bf16(float lo, float hi) { unsigned r; asm volatile("v_cvt_pk_bf16_f32 %0, %1, %2" : "=v"(r) : "v"(lo), "v"(hi)); return r; }
__device__ __forceinline__ float silu_f(float x) { return x * __builtin_amdgcn_rcpf(1.0f + __builtin_amdgcn_exp2f(-1.4426950408889634f * x)); }
struct EpiBf16 {
    static constexpr bool PERM = true, AFTER_DRAIN = false;
    bf16_t* O; int ldc;
    __device__ __forceinline__ void operator()(const f32x4 (&acc)[2][2][4][2], const Unit& u, int wr, int wc, int fr, int fq) const {
        const int row0 = u.pm * BM + wr * 64 + fr; const int col0 = u.pn * BM + wc * 32 + 8 * fq;
#pragma unroll
        for (int ai = 0; ai < 2; ++ai)
#pragma unroll
            for (int m = 0; m < 4; ++m) { bf16_t* rowp = O + (size_t)(row0 + ai * HALF + m * 16) * ldc + col0;
#pragma unroll
                for (int bj = 0; bj < 2; ++bj) { const f32x4 v0 = acc[ai][bj][m][0], v1 = acc[ai][bj][m][1];
                    u32x4 w; w.x = cvt_pk_bf16(v0[0], v0[1]); w.y = cvt_pk_bf16(v0[2], v0[3]); w.z = cvt_pk_bf16(v1[0], v1[1]); w.w = cvt_pk_bf16(v1[2], v1[3]);
                    *(u32x4*)(rowp + bj * HALF) = w; } }
    }
};
struct EpiRawA {
    static constexpr bool PERM = true, AFTER_DRAIN = false;
    bf16_t* O; float* S;
    __device__ __forceinline__ void operator()(const f32x4 (&acc)[2][2][4][2], const Unit& u, int wr, int wc, int fr, int fq) const {
        const int row0 = u.pm * BM + wr * 64 + fr;
        if (u.pn < 18) {
            const int col0 = u.pn * BM + wc * 32 + 8 * fq;
#pragma unroll
            for (int ai = 0; ai < 2; ++ai)
#pragma unroll
                for (int m = 0; m < 4; ++m) { bf16_t* rowp = O + (size_t)(row0 + ai * HALF + m * 16) * 4608 + col0;
#pragma unroll
                    for (int bj = 0; bj < 2; ++bj) { const f32x4 v0 = acc[ai][bj][m][0], v1 = acc[ai][bj][m][1];
                        u32x4 w; w.x = cvt_pk_bf16(v0[0], v0[1]); w.y = cvt_pk_bf16(v0[2], v0[3]); w.z = cvt_pk_bf16(v1[0], v1[1]); w.w = cvt_pk_bf16(v1[2], v1[3]);
                        *(u32x4*)(rowp + bj * HALF) = w; } }
        } else if (wc < 2) {
            const int col0 = wc * 32 + 8 * fq;
#pragma unroll
            for (int ai = 0; ai < 2; ++ai)
#pragma unroll
                for (int m = 0; m < 4; ++m) { float* sp = S + (size_t)(row0 + ai * HALF + m * 16) * 64 + col0;
                    *(f32x4*)sp = acc[ai][0][m][0]; *(f32x4*)(sp + 4) = acc[ai][0][m][1]; }
        }
    }
};
struct EpiResid {
    static constexpr bool PERM = false, AFTER_DRAIN = false;
    const float* base; float* out; int ldc;
    __device__ __forceinline__ void operator()(const f32x4 (&acc)[2][2][4][2], const Unit& u, int wr, int wc, int fr, int fq) const {
        const int row0 = u.pm * BM + wr * 64 + fr, col0 = u.pn * BM + wc * 32 + 4 * fq;
#pragma unroll
        for (int ai = 0; ai < 2; ++ai)
#pragma unroll
            for (int mp = 0; mp < 2; ++mp) { f32x4 rv[2][2][2];
#pragma unroll
                for (int mm = 0; mm < 2; ++mm) { const size_t off = (size_t)(row0 + ai * HALF + (2 * mp + mm) * 16) * ldc + col0;
#pragma unroll
                    for (int bj = 0; bj < 2; ++bj)
#pragma unroll
                        for (int n = 0; n < 2; ++n) rv[mm][bj][n] = *(const f32x4*)(base + off + bj * HALF + n * 16); }
                asm volatile("" ::: "memory");
#pragma unroll
                for (int mm = 0; mm < 2; ++mm) { const size_t off = (size_t)(row0 + ai * HALF + (2 * mp + mm) * 16) * ldc + col0;
#pragma unroll
                    for (int bj = 0; bj < 2; ++bj)
#pragma unroll
                        for (int n = 0; n < 2; ++n) *(f32x4*)(out + off + bj * HALF + n * 16) = rv[mm][bj][n] + acc[ai][bj][2 * mp + mm][n]; }
                asm volatile("" ::: "memory"); }
    }
};
struct EpiSwiglu {
    static constexpr bool PERM = true, AFTER_DRAIN = false;
    bf16_t* O; int ldh;
    __device__ __forceinline__ void operator()(const f32x4 (&acc)[2][2][4][2], const Unit& u, int wr, int wc, int fr, int fq) const {
        const int row0 = u.pm * BM + wr * 64 + fr; const int f0 = (u.pn * BM + wc * 32 + 8 * fq) >> 1;
        typedef unsigned u32x2 __attribute__((ext_vector_type(2)));
#pragma unroll
        for (int ai = 0; ai < 2; ++ai)
#pragma unroll
            for (int m = 0; m < 4; ++m) { bf16_t* rowp = O + (size_t)(row0 + ai * HALF + m * 16) * ldh + f0;
#pragma unroll
                for (int bj = 0; bj < 2; ++bj) { const f32x4 v0 = acc[ai][bj][m][0], v1 = acc[ai][bj][m][1];
                    u32x2 w; w.x = cvt_pk_bf16(silu_f(v0[0]) * v0[1], silu_f(v0[2]) * v0[3]); w.y = cvt_pk_bf16(silu_f(v1[0]) * v1[1], silu_f(v1[2]) * v1[3]);
                    *(u32x2*)(rowp + bj * (HALF / 2)) = w; } }
    }
};
template <class Epi, class Sched, bool ALIGN_EPI = false, bool SP2 = false>
__device__ __forceinline__ void gemm_phase(PG8_LAS unsigned char* lds, const Gemm g, const Sched& S, const Epi& E) {
    int tid_o = threadIdx.x; asm volatile("" : "+v"(tid_o));
    const int tid = tid_o, wid = __builtin_amdgcn_readfirstlane(tid >> 6), lane = tid & 63, wr = wid >> 2, wc = wid & 3, fr = lane & 15, fq = lane >> 4;
    const int K = g.K, nt = K / BK;
    unsigned voffA[2], voffB[2];
#pragma unroll
    for (int i = 0; i < 2; ++i) { int R, C; stage_rc(tid * 16 + i * 8192, R, C); const int Rb = Epi::PERM ? ((R & ~31) + perm32(R & 31)) : R;
        voffA[i] = (unsigned)(R * K + C) * 2u; voffB[i] = (unsigned)(Rb * K + C) * 2u; }
    const size_t kstep = (size_t)(BK * 2);
    const size_t hstep = (size_t)HALF * K * 2;
    const size_t tstep = 2 * hstep;
    const unsigned ldsw = (unsigned)wid * 1024u;
    const int aoff = lds_byte(wr * 64 + fr, fq * 8), boff = lds_byte(wc * 32 + fr, fq * 8);
#define PG8_SA(b, h) (((b) * 2 + (h)) * HTB)
#define PG8_SB(b, h) ((4 + (b) * 2 + (h)) * HTB)
#define PG8_STAGE(bufoff, gbase, voff) do { _Pragma("unroll") for (int _i = 0; _i < 2; ++_i) \
        __builtin_amdgcn_global_load_lds((const unsigned*)((const char*)(gbase) + (voff)[_i]), (PG8_LAS unsigned*)(lds + (bufoff) + ldsw + _i * 8192), 16, 0, 0); } while (0)
#define PG8_LDA(dst, b, h) do { _Pragma("unroll") for (int m = 0; m < 4; ++m) _Pragma("unroll") for (int k = 0; k < 2; ++k) dst[m][k] = *(const PG8_LAS bf16x8*)(lds + PG8_SA(b, h) + aoff + m * 2048 + k * 1024); } while (0)
#define PG8_LDB(dst, b, h) do { _Pragma("unroll") for (int n = 0; n < 2; ++n) _Pragma("unroll") for (int k = 0; k < 2; ++k) dst[n][k] = *(const PG8_LAS bf16x8*)(lds + PG8_SB(b, h) + boff + n * 2048 + k * 1024); } while (0)
#define PG8_MMA(ai, bj, At, Bt) do { __builtin_amdgcn_s_setprio(1); _Pragma("unroll") for (int m = 0; m < 4; ++m) _Pragma("unroll") for (int n = 0; n < 2; ++n) _Pragma("unroll") for (int k = 0; k < 2; ++k) \
        acc[ai][bj][m][n] = __builtin_amdgcn_mfma_f32_16x16x32_bf16(Bt[n][k], At[m][k], acc[ai][bj][m][n], 0, 0, 0); __builtin_amdgcn_s_setprio(0); } while (0)
#define PG8_WAIT_V(n) asm volatile("s_waitcnt vmcnt(" #n ")" ::: "memory")
#define PG8_WAIT_L(n) asm volatile("s_waitcnt lgkmcnt(" #n ")" ::: "memory")
#define PG8_BAR __builtin_amdgcn_s_barrier()
#define PG8_SCHED __builtin_amdgcn_sched_barrier(0)
    Unit cur, nxt; int ui = 0;
    if (!S.next(0, cur)) return;
    f32x4 acc[2][2][4][2];
#pragma unroll
    for (int a = 0; a < 2; ++a)
#pragma unroll
        for (int b = 0; b < 2; ++b)
#pragma unroll
            for (int m = 0; m < 4; ++m)
#pragma unroll
                for (int n = 0; n < 2; ++n) acc[a][b][m][n] = (f32x4){0.f, 0.f, 0.f, 0.f};
    bf16x8 At[4][2], B0[2][2], B1[2][2];
    const char* cA = (const char*)g.A + (size_t)cur.pm * tstep; const char* cB = (const char*)g.Bt + g.grp_off(cur.pm) + (size_t)cur.pn * tstep;
    S.a_ready(cur);
    if constexpr (SP2) {
        PG8_STAGE(PG8_SB(0, 0), cB, voffB); PG8_STAGE(PG8_SB(0, 1), cB + hstep, voffB); PG8_STAGE(PG8_SA(0, 0), cA, voffA); PG8_STAGE(PG8_SA(0, 1), cA + hstep, voffA);
        if (wr == 1) PG8_BAR;
        PG8_WAIT_V(2); PG8_BAR;
        PG8_STAGE(PG8_SB(1, 0), cB + kstep, voffB); PG8_STAGE(PG8_SA(1, 0), cA + kstep, voffA); PG8_STAGE(PG8_SB(1, 1), cB + hstep + kstep, voffB);
        PG8_WAIT_V(6); PG8_BAR;
    } else {
        PG8_STAGE(PG8_SB(0, 0), cB, voffB); PG8_STAGE(PG8_SA(0, 0), cA, voffA); PG8_STAGE(PG8_SB(0, 1), cB + hstep, voffB); PG8_STAGE(PG8_SA(0, 1), cA + hstep, voffA);
        if (wr == 1) PG8_BAR;
        PG8_WAIT_V(4); PG8_BAR;
        PG8_STAGE(PG8_SB(1, 0), cB + kstep, voffB); PG8_STAGE(PG8_SA(1, 0), cA + kstep, voffA); PG8_STAGE(PG8_SB(1, 1), cB + hstep + kstep, voffB);
        PG8_WAIT_V(6); PG8_BAR;
    }
    for (;;) {
        const bool has_next = S.next(ui + 1, nxt);
        const char* nA = has_next ? (const char*)g.A + (size_t)nxt.pm * tstep : cA; const char* nB = has_next ? (const char*)g.Bt + g.grp_off(nxt.pm) + (size_t)nxt.pn * tstep : cB;
        for (int t = 0; t < nt; t += 2) {
            const bool last = (t == nt - 2);
            const char* a1 = cA + (size_t)(t + 1) * kstep;
            const char* a2 = last ? nA : cA + (size_t)(t + 2) * kstep; const char* b2 = last ? nB : cB + (size_t)(t + 2) * kstep;
            const char* a3 = a2 + kstep; const char* b3 = b2 + kstep;
            if (last && has_next) S.a_ready(nxt);
            if constexpr (SP2) {
            PG8_LDB(B0, 0, 0); PG8_LDB(B1, 0, 1); PG8_SCHED; PG8_LDA(At, 0, 0); PG8_STAGE(PG8_SA(1, 1), a1 + hstep, voffA);
            PG8_WAIT_V(8); PG8_WAIT_L(0); PG8_BAR; PG8_MMA(0, 0, At, B0); PG8_MMA(0, 1, At, B1); PG8_BAR; PG8_SCHED;
            PG8_LDA(At, 0, 1); PG8_STAGE(PG8_SB(0, 0), b2, voffB); PG8_STAGE(PG8_SB(0, 1), b2 + hstep, voffB); PG8_STAGE(PG8_SA(0, 0), a2, voffA);
            PG8_WAIT_V(8); PG8_WAIT_L(0); PG8_BAR; PG8_MMA(1, 0, At, B0); PG8_MMA(1, 1, At, B1); PG8_BAR; PG8_SCHED;
            PG8_LDB(B0, 1, 0); PG8_LDB(B1, 1, 1); PG8_SCHED; PG8_LDA(At, 1, 0); PG8_STAGE(PG8_SA(0, 1), a2 + hstep, voffA);
            PG8_WAIT_V(8); PG8_WAIT_L(0); PG8_BAR; PG8_MMA(0, 0, At, B0); PG8_MMA(0, 1, At, B1); PG8_BAR; PG8_SCHED;
            PG8_LDA(At, 1, 1); PG8_STAGE(PG8_SB(1, 0), b3, voffB); PG8_STAGE(PG8_SB(1, 1), b3 + hstep, voffB); PG8_STAGE(PG8_SA(1, 0), a3, voffA);
            PG8_WAIT_V(8); PG8_WAIT_L(0); PG8_BAR; PG8_MMA(1, 0, At, B0); PG8_MMA(1, 1, At, B1); PG8_BAR; PG8_SCHED;
            } else {
            PG8_LDB(B0, 0, 0); PG8_SCHED; PG8_LDA(At, 0, 0); PG8_STAGE(PG8_SA(1, 1), a1 + hstep, voffA);
            PG8_WAIT_L(8); PG8_BAR; PG8_WAIT_L(0); PG8_MMA(0, 0, At, B0); PG8_BAR; PG8_SCHED;
            PG8_LDB(B1, 0, 1); PG8_STAGE(PG8_SB(0, 0), b2, voffB);
            PG8_BAR; PG8_WAIT_L(0); PG8_MMA(0, 1, At, B1); PG8_BAR;
            PG8_LDA(At, 0, 1); PG8_STAGE(PG8_SA(0, 0), a2, voffA);
            PG8_BAR; PG8_WAIT_L(0); PG8_MMA(1, 0, At, B0); PG8_BAR; PG8_SCHED;
            PG8_STAGE(PG8_SB(0, 1), b2 + hstep, voffB);
            PG8_WAIT_V(6); PG8_BAR; PG8_MMA(1, 1, At, B1); PG8_BAR;
            PG8_LDB(B0, 1, 0); PG8_SCHED; PG8_LDA(At, 1, 0); PG8_STAGE(PG8_SA(0, 1), a2 + hstep, voffA);
            PG8_WAIT_L(8); PG8_BAR; PG8_WAIT_L(0); PG8_MMA(0, 0, At, B0); PG8_BAR; PG8_SCHED;
            PG8_LDB(B1, 1, 1); PG8_STAGE(PG8_SB(1, 0), b3, voffB);
            PG8_BAR; PG8_WAIT_L(0); PG8_MMA(0, 1, At, B1); PG8_BAR;
            PG8_LDA(At, 1, 1); PG8_STAGE(PG8_SA(1, 0), a3, voffA);
            PG8_BAR; PG8_WAIT_L(0); PG8_MMA(1, 0, At, B0); PG8_BAR; PG8_SCHED;
            PG8_STAGE(PG8_SB(1, 1), b3 + hstep, voffB);
            PG8_WAIT_V(6); PG8_BAR; PG8_MMA(1, 1, At, B1); PG8_BAR;
            }
        }
        if constexpr (ALIGN_EPI) { if (wr == 0) PG8_BAR; }
        if constexpr (!Epi::AFTER_DRAIN) { E(acc, cur, wr, wc, fr, fq); S.done(cur); }
        if (!has_next) break;
#pragma unroll
        for (int a = 0; a < 2; ++a)
#pragma unroll
            for (int b = 0; b < 2; ++b)
#pragma unroll
                for (int m = 0; m < 4; ++m)
#pragma unroll
                    for (int n = 0; n < 2; ++n) acc[a][b][m][n] = (f32x4){0.f, 0.f, 0.f, 0.f};
        cur = nxt; cA = nA; cB = nB; ++ui;
        if constexpr (ALIGN_EPI) { if (wr == 1) PG8_BAR; }
    }
    PG8_WAIT_V(0);
    if constexpr (!ALIGN_EPI) { if (wr == 0) PG8_BAR; }
    PG8_BAR;
    if constexpr (Epi::AFTER_DRAIN) { E.fused(acc, cur, wr, wc, fr, fq, lds, wid, lane); S.done(cur); }
#undef PG8_SA
#undef PG8_SB
#undef PG8_STAGE
#undef PG8_LDA
#undef PG8_LDB
#undef PG8_MMA
#undef PG8_WAIT_V
#undef PG8_WAIT_L
#undef PG8_BAR
#undef PG8_SCHED
}
}
#define GAS __attribute__((address_space(1)))
#define LAS __attribute__((address_space(3)))
typedef unsigned short bf16;
typedef unsigned v4u __attribute__((ext_vector_type(4)));
typedef float f32x4 __attribute__((ext_vector_type(4)));
typedef short bf16x8 __attribute__((ext_vector_type(8)));
typedef GAS unsigned gu32;
typedef GAS unsigned long long gu64;
#define RLX_AGENT __ATOMIC_RELAXED, __HIP_MEMORY_SCOPE_AGENT
#define LDS_WAIT() asm volatile("s_waitcnt lgkmcnt(0)" ::: "memory")
#define VM_WAIT() asm volatile("s_waitcnt vmcnt(0)" ::: "memory")
__device__ __forceinline__ unsigned long long rt() { return __builtin_amdgcn_s_memrealtime(); }
__device__ __forceinline__ unsigned f2bf(float f) { unsigned u = __builtin_bit_cast(unsigned, f); return (u + 0x7fffu + ((u >> 16) & 1u)) >> 16; }
__device__ __forceinline__ unsigned pk2(float lo, float hi) { return f2bf(lo) | (f2bf(hi) << 16); }
#define XB_TMO      128
#define XB_XCNT(j)  (256  + 64 * (j))
#define XB_XSUB(j)  (1280 + 64 * (j))
#define XB_XGEN(j)  (2304 + 64 * (j))
#define XB_TOP      3328
#define XB_TOPGEN   3392
#define XCD_BAR_WORDS 3456
#define XB_SPIN_CAP (1u << 18)

__device__ __forceinline__ unsigned xb_ld(unsigned* p)              { return __hip_atomic_load(p, __ATOMIC_RELAXED, __HIP_MEMORY_SCOPE_AGENT); }
__device__ __forceinline__ unsigned xb_add(unsigned* p, unsigned v) { return __hip_atomic_fetch_add(p, v, __ATOMIC_RELAXED, __HIP_MEMORY_SCOPE_AGENT); }
__device__ __forceinline__ unsigned xb_xcc_id() { return (unsigned)__builtin_amdgcn_s_getreg((3 << 11) | 20) & 0xFu; }
#define XB_SPIN(cond, bar) do { unsigned _sp = 0; while (cond) { __builtin_amdgcn_s_sleep(1); \
    if ((++_sp & 255u) == 0u) { if (xb_ld(&(bar)[XB_TMO])) break; if (_sp > XB_SPIN_CAP) { atomicAdd(&(bar)[XB_TMO], 1u); break; } } } } while (0)

struct XcdBarrier {
    unsigned* bar; unsigned x;
    volatile LAS unsigned* st;
};

__device__ __forceinline__ XcdBarrier xcd_barrier_post(unsigned* bar, volatile LAS unsigned* st) {
    XcdBarrier b; b.bar = bar; b.x = xb_xcc_id(); b.st = st;
    if (threadIdx.x == 0) (void)xb_add(&bar[XB_XCNT(b.x)], 1u);
    return b;
}
__device__ __forceinline__ void xcd_barrier_complete(unsigned* bar, unsigned x, unsigned& nloc, unsigned& nx) {
    const unsigned G = gridDim.x * gridDim.y * gridDim.z;
    unsigned sum, cnt, mine, sp = 0u;
    for (;;) {
        sum = 0u; cnt = 0u; mine = 0u;
#pragma unroll
        for (unsigned j = 0; j < 16; ++j) { const unsigned c = xb_ld(&bar[XB_XCNT(j)]); sum += c; cnt += (c > 0u) ? 1u : 0u; mine = (j == x) ? c : mine; }
        if (sum == G) break;
        __builtin_amdgcn_s_sleep(1);
        if ((++sp & 255u) == 0u) { if (xb_ld(&bar[XB_TMO])) break; if (sp > XB_SPIN_CAP) { atomicAdd(&bar[XB_TMO], 1u); break; } }
    }
    nloc = mine > 0u ? mine : 1u; nx = cnt > 0u ? cnt : 1u;
}

__device__ __forceinline__ void xcd_barrier(const XcdBarrier& b) {
    asm volatile("s_waitcnt vmcnt(0)" ::: "memory");
    __syncthreads();
    if (threadIdx.x == 0) {
        unsigned* bar = b.bar;
        __builtin_amdgcn_s_waitcnt(0);
        unsigned nloc = b.st[0], nx = b.st[1];
        if (nloc == 0u) { xcd_barrier_complete(bar, b.x, nloc, nx); b.st[0] = nloc; b.st[1] = nx; }
        const unsigned old = xb_add(&bar[XB_XSUB(b.x)], 1u);
        const unsigned gen = old / nloc;
        if (old + 1u == (gen + 1u) * nloc) {
            __builtin_amdgcn_fence(__ATOMIC_RELEASE, "agent");
            asm volatile("s_waitcnt vmcnt(0)" ::: "memory");
            const unsigned og = xb_add(&bar[XB_TOP], 1u);
            const unsigned tg = og / nx;
            if (og + 1u == (tg + 1u) * nx) xb_add(&bar[XB_TOPGEN], 1u);
            else XB_SPIN(xb_ld(&bar[XB_TOPGEN]) == tg, bar);
            __builtin_amdgcn_fence(__ATOMIC_ACQUIRE, "agent");
            xb_add(&bar[XB_XGEN(b.x)], 1u);
            asm volatile("s_waitcnt vmcnt(0)" ::: "memory");
        } else {
            XB_SPIN(xb_ld(&bar[XB_XGEN(b.x)]) == gen, bar);
            __builtin_amdgcn_fence(__ATOMIC_ACQUIRE, "agent");
            asm volatile("s_waitcnt vmcnt(0)" ::: "memory");
        }
    }
    __syncthreads();
}
constexpr int NB = 4, SEQ = 8192, DM = 1024, M = NB * SEQ, DEPTH = 2;
constexpr int NCHUNK = SEQ / 64;
constexpr int CONV_CH = 4608, NWA = 4864  , NGATE = 2048, NEXP = 16, EFF = 512, CAP = 1024;
constexpr int MEXP = NB * NEXP * CAP;
constexpr float EPS = 1e-6f;
constexpr int NWAVES = 8;
constexpr size_t MiB = 1u << 20;
constexpr size_t WS_CTL = 0, CTL_ZERO_BYTES = 1 * MiB;
constexpr size_t WS_WA = 1 * MiB;
constexpr size_t WS_WB = 11 * MiB;
constexpr size_t WS_WO = 15 * MiB;
constexpr size_t WS_XN = 19 * MiB;
constexpr size_t WS_RAW = 83 * MiB;
constexpr size_t WS_SCAL = 371 * MiB;
constexpr size_t WS_OG = 19 * MiB;
constexpr size_t WS_YS = 443 * MiB;
constexpr size_t WS_XN2 = 83 * MiB;
constexpr size_t WS_GATES = 147 * MiB;
constexpr size_t WS_MIXED = 147 * MiB;
constexpr size_t WS_WGU = 83 * MiB;
constexpr size_t WS_WD = 115 * MiB;
constexpr size_t WS_XG = 131 * MiB;
constexpr size_t WS_HMID = 259 * MiB;
constexpr size_t WS_AFF = 323 * MiB;
constexpr size_t WS_IDX = 325 * MiB;
constexpr size_t WS_VAL = 326 * MiB;
constexpr size_t WS_INV = 327 * MiB;
constexpr size_t WS_END = 507 * MiB;
constexpr int CW_TMO = 0, CW_BAR = 4096;
constexpr int LDS_BYTES = 163840;
constexpr int MISC_OFF = LDS_BYTES - 256;

typedef short bf16x8 __attribute__((ext_vector_type(8)));
typedef short bf16x4 __attribute__((ext_vector_type(4)));
typedef float f32x4 __attribute__((ext_vector_type(4)));
typedef float f32x2 __attribute__((ext_vector_type(2)));
typedef unsigned u32x4 __attribute__((ext_vector_type(4)));
typedef unsigned u32x2 __attribute__((ext_vector_type(2)));
typedef __bf16 bf16x2_t __attribute__((ext_vector_type(2)));
typedef short s16x2 __attribute__((ext_vector_type(2)));

__device__ __forceinline__ float bf2f(unsigned short v) { return __uint_as_float((unsigned)v << 16); }
__device__ __forceinline__ float bf2f_s(short v) { return __uint_as_float((unsigned)(unsigned short)v << 16); }
__device__ __forceinline__ unsigned pkbf(float lo, float hi) { f32x2 v = {lo, hi}; bf16x2_t b = __builtin_convertvector(v, bf16x2_t); return __builtin_bit_cast(unsigned, b); }
__device__ __forceinline__ unsigned short f2bf1(float f) { return (unsigned short)(pkbf(f, 0.f) & 0xffffu); }
__device__ __forceinline__ float silu(float x) { return x * __builtin_amdgcn_rcpf(1.0f + __builtin_amdgcn_exp2f(-1.4426950408889634f * x)); }
__device__ __forceinline__ float softplus_f(float x) { return x > 20.f ? x : log1pf(expf(x)); }
__device__ __forceinline__ float sigmoid_f(float x) { return 1.0f / (1.0f + expf(-x)); }
__device__ __forceinline__ void atomic_add_bf16x2(bf16* p, float a, float b) {
    (void)__builtin_amdgcn_global_atomic_fadd_v2bf16((GAS s16x2*)p, __builtin_bit_cast(s16x2, pkbf(a, b)));
}
template <int CTRL> __device__ __forceinline__ float dppf(float v) { return __builtin_bit_cast(float, __builtin_amdgcn_update_dpp(0, __builtin_bit_cast(int, v), CTRL, 0xF, 0xF, true)); }
__device__ __forceinline__ float wave_sum(float v) {
    v += dppf<0xB1>(v); v += dppf<0x4E>(v); v += dppf<0x141>(v); v += dppf<0x140>(v);
    const float s0 = __builtin_bit_cast(float, __builtin_amdgcn_readlane(__builtin_bit_cast(int, v), 0)), s1 = __builtin_bit_cast(float, __builtin_amdgcn_readlane(__builtin_bit_cast(int, v), 16));
    const float s2 = __builtin_bit_cast(float, __builtin_amdgcn_readlane(__builtin_bit_cast(int, v), 32)), s3 = __builtin_bit_cast(float, __builtin_amdgcn_readlane(__builtin_bit_cast(int, v), 48));
    return (s0 + s1) + (s2 + s3);
}

__device__ __forceinline__ float softplus_fast(float x) { const float e = __builtin_amdgcn_exp2f(1.4426950408889634f * fminf(x, 20.f));
    const float lg = (e < 1e-3f) ? e * (1.0f - 0.5f * e) : 0.6931471805599453f * __builtin_amdgcn_logf(1.0f + e); return x > 20.f ? x : lg; }
__device__ __forceinline__ float sigmoid_fast(float x) { return __builtin_amdgcn_rcpf(1.0f + __builtin_amdgcn_exp2f(-1.4426950408889634f * x)); }
__device__ __forceinline__ float scan_fwd64(float v, int lane) {
    v += dppf<0x111>(v); v += dppf<0x112>(v); v += dppf<0x114>(v); v += dppf<0x118>(v);
    const float t0 = __builtin_bit_cast(float, __builtin_amdgcn_readlane(__builtin_bit_cast(int, v), 15)), t1 = __builtin_bit_cast(float, __builtin_amdgcn_readlane(__builtin_bit_cast(int, v), 31));
    const float t2 = __builtin_bit_cast(float, __builtin_amdgcn_readlane(__builtin_bit_cast(int, v), 47));
    const int row = lane >> 4; return v + (row == 0 ? 0.f : row == 1 ? t0 : row == 2 ? t0 + t1 : (t0 + t1) + t2);
}
__device__ __forceinline__ float scan_bwd64(float v, int lane) {
    v += dppf<0x101>(v); v += dppf<0x102>(v); v += dppf<0x104>(v); v += dppf<0x108>(v);
    const float t1 = __builtin_bit_cast(float, __builtin_amdgcn_readlane(__builtin_bit_cast(int, v), 16)), t2 = __builtin_bit_cast(float, __builtin_amdgcn_readlane(__builtin_bit_cast(int, v), 32));
    const float t3 = __builtin_bit_cast(float, __builtin_amdgcn_readlane(__builtin_bit_cast(int, v), 48));
    const int row = lane >> 4; return v + (row == 3 ? 0.f : row == 2 ? t3 : row == 1 ? t3 + t2 : (t3 + t2) + t1);
}

template <int CTRL> __device__ __forceinline__ int dppi(int v) { return __builtin_amdgcn_update_dpp(0, v, CTRL, 0xF, 0xF, true); }
__device__ __forceinline__ int scan_fwd64_i(int v, int lane) {
    v += dppi<0x111>(v); v += dppi<0x112>(v); v += dppi<0x114>(v); v += dppi<0x118>(v);
    const int t0 = __builtin_amdgcn_readlane(v, 15), t1 = __builtin_amdgcn_readlane(v, 31), t2 = __builtin_amdgcn_readlane(v, 47);
    const int row = lane >> 4; return v + (row == 0 ? 0 : row == 1 ? t0 : row == 2 ? t0 + t1 : t0 + t1 + t2);
}
template <int MT, int NT>
__device__ __forceinline__ void mma_lds(f32x4 (&acc)[MT][NT], const LAS bf16* A, int lda, int m0, const LAS bf16* Bt, int ldb, int n0, int K, int fr, int fq) {
    for (int k0 = 0; k0 < K; k0 += 32) {
        bf16x8 a[MT], b[NT];
#pragma unroll
        for (int mt = 0; mt < MT; ++mt) a[mt] = *(const LAS bf16x8*)(A + (m0 + mt * 16 + fr) * lda + k0 + fq * 8);
#pragma unroll
        for (int nt = 0; nt < NT; ++nt) b[nt] = *(const LAS bf16x8*)(Bt + (n0 + nt * 16 + fr) * ldb + k0 + fq * 8);
#pragma unroll
        for (int mt = 0; mt < MT; ++mt)
#pragma unroll
            for (int nt = 0; nt < NT; ++nt) acc[mt][nt] = __builtin_amdgcn_mfma_f32_16x16x32_bf16(a[mt], b[nt], acc[mt][nt], 0, 0, 0);
    }
}

__device__ __forceinline__ void conv16(float (&acc)[16], const LAS bf16* src, int ld, const LAS float* cw, int cwld) {
#pragma unroll
    for (int c = 0; c < 16; ++c) acc[c] = cw[7 * cwld + c];
#pragma unroll
    for (int tap = 0; tap < 7; ++tap) {
        const bf16x8 x0 = *(const LAS bf16x8*)(src + tap * ld), x1 = *(const LAS bf16x8*)(src + tap * ld + 8);
        const LAS float* w = cw + tap * cwld;
#pragma unroll
        for (int c = 0; c < 8; ++c) { acc[c] += bf2f_s(x0[c]) * w[c]; acc[8 + c] += bf2f_s(x1[c]) * w[8 + c]; }
        if (tap & 1) asm volatile("" ::: "memory");
    }
}
__device__ __forceinline__ void conv8(float (&acc)[8], const LAS bf16* src, int ld, const LAS float* cw, int cwld) {
#pragma unroll
    for (int c = 0; c < 8; ++c) acc[c] = cw[7 * cwld + c];
#pragma unroll
    for (int tap = 0; tap < 7; ++tap) {
        const bf16x8 x0 = *(const LAS bf16x8*)(src + tap * ld);
        const LAS float* w = cw + tap * cwld;
#pragma unroll
        for (int c = 0; c < 8; ++c) acc[c] += bf2f_s(x0[c]) * w[c];
        if (tap & 1) asm volatile("" ::: "memory");
    }
}

#if defined(PROBE_SUB)
#define PB_START(id_, ws_) do { if ((id_) == PROBE_SUB && blockIdx.x == 0 && threadIdx.x == 0) ((unsigned long long*)(ws_))[1100] = __builtin_amdgcn_s_memrealtime(); } while (0)
#define PB_END(id_, ws_) do { if ((id_) == PROBE_SUB && blockIdx.x == 0 && threadIdx.x == 0) { const unsigned long long t1_ = __builtin_amdgcn_s_memrealtime(), t0_ = ((unsigned long long*)(ws_))[1100]; \
        const unsigned bk_ = (unsigned)((t1_ - t0_) / PROBE_TICKS); *((volatile float*)(ws_) + 2048) = (float)(bk_ > 40u ? 40u : bk_) * (1.0f / 40.0f); } } while (0)
#else
#define PB_START(id_, ws_) do {} while (0)
#define PB_END(id_, ws_) do {} while (0)
#endif
__device__ __forceinline__ void transpose_item(const float* W, int K, int N, int k0, int n0, bf16* WT, int drow0, int rmul, LAS float* scr, int lane) {
    f32x4 v[16];
#pragma unroll
    for (int i = 0; i < 16; ++i) { const int kk = 4 * i + (lane >> 4); v[i] = *(const GAS f32x4*)(W + (size_t)(k0 + kk) * N + n0 + 4 * (lane & 15)); }
#pragma unroll
    for (int i = 0; i < 16; ++i) { const int kk = 4 * i + (lane >> 4); LAS float* d = scr + kk * 65 + 4 * (lane & 15); d[0] = v[i].x; d[1] = v[i].y; d[2] = v[i].z; d[3] = v[i].w; }
    LDS_WAIT(); asm volatile("" ::: "memory");
    const int c = lane & 7;
#pragma unroll
    for (int j = 0; j < 8; ++j) { const int n = (lane >> 3) + 8 * j; const LAS float* s = scr + (8 * c) * 65 + n;
        u32x4 o; o.x = pkbf(s[0 * 65], s[1 * 65]); o.y = pkbf(s[2 * 65], s[3 * 65]); o.z = pkbf(s[4 * 65], s[5 * 65]); o.w = pkbf(s[6 * 65], s[7 * 65]);
        *(GAS u32x4*)(WT + (size_t)(drow0 + rmul * n) * K + k0 + 8 * c) = o; }
    LDS_WAIT(); asm volatile("" ::: "memory");
}
__device__ __forceinline__ void cvt_mixer_weights(LAS unsigned char* lds, unsigned char* ws, const float* w_in, const float* w_out, int gw, int NGW, int wave, int lane) {
    LAS float* scr = (LAS float*)(lds + wave * 16896);
    bf16* WA = (bf16*)(ws + WS_WA); bf16* WB = (bf16*)(ws + WS_WB); bf16* WO = (bf16*)(ws + WS_WO);
    constexpr int I_IN = 16 * 105, I_OUT = 32 * 16;
    for (int it = gw; it < I_IN + I_OUT; it += NGW) {
        if (it < I_IN) { const int kb = it / 105, nb = it % 105, n0 = nb * 64;
            bf16* dst; int drow;
            if (n0 < 4608) { dst = WA; drow = n0; } else if (n0 < 6656) { dst = WB; drow = n0 - 4608; } else { dst = WA; drow = 4608 + (n0 - 6656); }
            transpose_item(w_in, 1024, 6720, kb * 64, n0, dst, drow, 1, scr, lane);
        } else { const int r = it - I_IN, kb = r / 16, nb = r % 16; transpose_item(w_out, 2048, 1024, kb * 64, nb * 64, WO, nb * 64, 1, scr, lane); }
    }
    { u32x4 z = (u32x4){0u, 0u, 0u, 0u}; asm volatile("" : "+v"(z));
      for (int r = gw; r < 192; r += NGW) { GAS u32x4* p = (GAS u32x4*)(WA + (size_t)(4672 + r) * 1024) + lane; p[0] = z; p[64] = z; } }
}
__device__ __forceinline__ void cvt_expert_weights(LAS unsigned char* lds, unsigned char* ws, const float* w_gate, const float* w_up, const float* w_down, int gw, int NGW, int wave, int lane) {
    LAS float* scr = (LAS float*)(lds + wave * 16896);
    bf16* WGU = (bf16*)(ws + WS_WGU); bf16* WD = (bf16*)(ws + WS_WD);
    constexpr int I_G = 16 * 8;
    constexpr int I_D = 8 * 16;
    constexpr int PER_E = 2 * I_G + I_D;
    for (int it = gw; it < NEXP * PER_E; it += NGW) {
        const int e = it / PER_E; int r = it % PER_E;
        if (r < 2 * I_G) { const int up = r >= I_G; if (up) r -= I_G; const int kb = r / 8, nb = r % 8;
            transpose_item((up ? w_up : w_gate) + (size_t)e * 1024 * 512, 1024, 512, kb * 64, nb * 64, WGU + (size_t)e * 1024 * 1024, 2 * (nb * 64) + up, 2, scr, lane);
        } else { r -= 2 * I_G; const int kb = r / 16, nb = r % 16;
            transpose_item(w_down + (size_t)e * 512 * 1024, 512, 1024, kb * 64, nb * 64, WD + (size_t)e * 1024 * 512, nb * 64, 1, scr, lane); }
    }
}

__device__ __forceinline__ void rms_row_regs(const float* xrow, const f32x4 (&w)[4], f32x4 (&v)[4], int lane) {
    const GAS f32x4* xr = (const GAS f32x4*)xrow + lane; float s = 0.f;
#pragma unroll
    for (int j = 0; j < 4; ++j) { v[j] = xr[64 * j]; s += (v[j].x * v[j].x + v[j].y * v[j].y) + (v[j].z * v[j].z + v[j].w * v[j].w); }
    const float rstd = __builtin_amdgcn_rsqf(wave_sum(s) * (1.0f / DM) + EPS);
#pragma unroll
    for (int j = 0; j < 4; ++j) v[j] = v[j] * rstd * w[j];
}
__device__ __forceinline__ void store_row_bf16(bf16* orow, const f32x4 (&v)[4], int lane) {
    GAS u32x2* o8 = (GAS u32x2*)orow + lane;
#pragma unroll
    for (int j = 0; j < 4; ++j) { u32x2 t; t.x = pkbf(v[j].x, v[j].y); t.y = pkbf(v[j].z, v[j].w); o8[64 * j] = t; }
}
__device__ __forceinline__ void load_w4(const float* w, f32x4 (&wv)[4], int lane) {
#pragma unroll
    for (int j = 0; j < 4; ++j) wv[j] = ((const GAS f32x4*)w)[lane + 64 * j];
}
__device__ __forceinline__ void phase_norm(const float* src, const float* w, bf16* XN, int gw, int NGW, int lane) {
    f32x4 wv[4]; load_w4(w, wv, lane);
    for (int m = gw; m < M; m += NGW) { f32x4 v[4]; rms_row_regs(src + (size_t)m * DM, wv, v, lane); store_row_bf16(XN + (size_t)m * DM, v, lane); }
}
__device__ __forceinline__ void zero_region(unsigned char* p, size_t bytes, int gtid, int NGT) {
    GAS u32x4* q = (GAS u32x4*)p; const size_t n = bytes / 16;
    u32x4 z = (u32x4){0u, 0u, 0u, 0u}; asm volatile("" : "+v"(z));
    for (size_t i = gtid; i < n; i += NGT) q[i] = z;
}

__device__ __forceinline__ void phase_norm2_router(LAS unsigned char* lds, const float* h, const float* w2, const float* w_router, bf16* XN, float* aff, int gw, int NGW, int tid, int lane) {
    LAS float* wrT = (LAS float*)lds;
    for (int e = tid; e < 16 * 1024; e += 512) { const int k = e >> 4, x = e & 15; wrT[x * 1024 + k] = w_router[e]; }
    __syncthreads();
    f32x4 wv[4]; load_w4(w2, wv, lane);
    for (int m = gw; m < M; m += NGW) {
        f32x4 v[4]; rms_row_regs(h + (size_t)m * DM, wv, v, lane); store_row_bf16(XN + (size_t)m * DM, v, lane);
        float mine = 0.f;
#pragma unroll 1
        for (int x = 0; x < 16; ++x) { float s = 0.f;
#pragma unroll
            for (int j = 0; j < 4; ++j) { const f32x4 wr = *(const LAS f32x4*)(wrT + x * 1024 + 4 * lane + 256 * j); s += (v[j].x * wr.x + v[j].y * wr.y) + (v[j].z * wr.z + v[j].w * wr.w); }
            s = wave_sum(s); mine = (lane == x) ? s : mine; }
        float mx = mine;
        mx = fmaxf(mx, __shfl_xor(mx, 1)); mx = fmaxf(mx, __shfl_xor(mx, 2)); mx = fmaxf(mx, __shfl_xor(mx, 4)); mx = fmaxf(mx, __shfl_xor(mx, 8));
        const float ex = expf(mine - mx); float den = ex;
        den += __shfl_xor(den, 1); den += __shfl_xor(den, 2); den += __shfl_xor(den, 4); den += __shfl_xor(den, 8);
        if (lane < 16) aff[(size_t)m * 16 + lane] = ex / den;
    }
}

__device__ __forceinline__ void phase_finish(const bf16* og, const bf16* ys, const bf16* yi, const bf16* gates, const float* gnw, const float* snw, bf16* mixed, int gw, int NGW, int lane) {
    float gw_[16], sw_[16];
#pragma unroll
    for (int c = 0; c < 16; ++c) { gw_[c] = gnw[(16 * lane + c) & 127]; sw_[c] = snw[16 * lane + c]; }
    for (int m = gw; m < M; m += NGW) {
        const bf16x8 o0 = *(const GAS bf16x8*)(og + (size_t)m * 1024 + 16 * lane), o1 = *(const GAS bf16x8*)(og + (size_t)m * 1024 + 16 * lane + 8);
        const bf16x8 y0 = *(const GAS bf16x8*)(ys + (size_t)m * 1024 + 16 * lane), y1 = *(const GAS bf16x8*)(ys + (size_t)m * 1024 + 16 * lane + 8);
        const bf16x8 i0 = *(const GAS bf16x8*)(yi + (size_t)m * 1024 + 16 * lane), i1 = *(const GAS bf16x8*)(yi + (size_t)m * 1024 + 16 * lane + 8);
        const bf16x8 g0 = *(const GAS bf16x8*)(gates + (size_t)m * 2048 + 16 * lane), g1 = *(const GAS bf16x8*)(gates + (size_t)m * 2048 + 16 * lane + 8);
        const bf16x8 z0 = *(const GAS bf16x8*)(gates + (size_t)m * 2048 + 1024 + 16 * lane), z1 = *(const GAS bf16x8*)(gates + (size_t)m * 2048 + 1024 + 16 * lane + 8);
        float o[16], t[16]; float so = 0.f, st = 0.f;
#pragma unroll
        for (int c = 0; c < 8; ++c) { o[c] = bf2f_s(o0[c]); o[8 + c] = bf2f_s(o1[c]); t[c] = (bf2f_s(y0[c]) + bf2f_s(i0[c])) * silu(bf2f_s(z0[c])); t[8 + c] = (bf2f_s(y1[c]) + bf2f_s(i1[c])) * silu(bf2f_s(z1[c])); }
#pragma unroll
        for (int c = 0; c < 16; ++c) { so += o[c] * o[c]; st += t[c] * t[c]; }
        so += __shfl_xor(so, 1); so += __shfl_xor(so, 2); so += __shfl_xor(so, 4);
        st += __shfl_xor(st, 1); st += __shfl_xor(st, 2); st += __shfl_xor(st, 4); st += __shfl_xor(st, 8); st += __shfl_xor(st, 16);
        const float ro = __builtin_amdgcn_rsqf(so * (1.0f / 128.f) + EPS), rt = __builtin_amdgcn_rsqf(st * (1.0f / 512.f) + EPS);
        float a[16], b2[16];
#pragma unroll
        for (int c = 0; c < 8; ++c) { a[c] = o[c] * ro * gw_[c] * silu(bf2f_s(g0[c])); a[8 + c] = o[8 + c] * ro * gw_[8 + c] * silu(bf2f_s(g1[c])); }
#pragma unroll
        for (int c = 0; c < 16; ++c) b2[c] = t[c] * rt * sw_[c];
        u32x4 w0, w1, w2, w3;
        w0.x = pkbf(a[0], a[1]); w0.y = pkbf(a[2], a[3]); w0.z = pkbf(a[4], a[5]); w0.w = pkbf(a[6], a[7]);
        w1.x = pkbf(a[8], a[9]); w1.y = pkbf(a[10], a[11]); w1.z = pkbf(a[12], a[13]); w1.w = pkbf(a[14], a[15]);
        w2.x = pkbf(b2[0], b2[1]); w2.y = pkbf(b2[2], b2[3]); w2.z = pkbf(b2[4], b2[5]); w2.w = pkbf(b2[6], b2[7]);
        w3.x = pkbf(b2[8], b2[9]); w3.y = pkbf(b2[10], b2[11]); w3.z = pkbf(b2[12], b2[13]); w3.w = pkbf(b2[14], b2[15]);
        GAS u32x4* mp = (GAS u32x4*)(mixed + (size_t)m * 2048 + 16 * lane);
        mp[0] = w0; mp[1] = w1; mp[128] = w2; mp[129] = w3;
    }
}

__device__ __forceinline__ void phase_topk(LAS unsigned char* lds, const float* aff, int* idx, float* val, int* inv, int be, int tid, int wave, int lane) {
    LAS unsigned* hist = (LAS unsigned*)lds;
    LAS unsigned* ctl = hist + 256;
    LAS unsigned* wsum = hist + 320;
    const int b = be >> 4, e = be & 15;
    unsigned key[16];
#pragma unroll
    for (int i = 0; i < 16; ++i) key[i] = __float_as_uint(aff[((size_t)b * SEQ + tid * 16 + i) * 16 + e]);
    unsigned prefix = 0u, mask = 0u; unsigned krem = CAP;
    for (int pass = 0; pass < 4; ++pass) {
        const int shift = 24 - 8 * pass;
        if (tid < 256) hist[tid] = 0u;
        __syncthreads();
#pragma unroll
        for (int i = 0; i < 16; ++i) if ((key[i] & mask) == prefix) atomicAdd((unsigned*)&hist[(key[i] >> shift) & 255u], 1u);
        __syncthreads();
        if (wave == 0) {
            const u32x4 hb = *(const LAS u32x4*)(hist + 4 * lane); const unsigned sl = hb.x + hb.y + hb.z + hb.w;
            int Si = (int)sl; Si += dppi<0x101>(Si); Si += dppi<0x102>(Si); Si += dppi<0x104>(Si); Si += dppi<0x108>(Si);
            { const int t1 = __builtin_amdgcn_readlane(Si, 16), t2 = __builtin_amdgcn_readlane(Si, 32), t3 = __builtin_amdgcn_readlane(Si, 48); const int row = lane >> 4;
              Si += (row == 3 ? 0 : row == 2 ? t3 : row == 1 ? t3 + t2 : t3 + t2 + t1); }
            const unsigned S = (unsigned)Si;
            const unsigned above = S - sl;
            if (above < krem && krem <= above + sl) { unsigned cum = above; int d;
                if (cum + hb.w >= krem) d = 3; else { cum += hb.w; if (cum + hb.z >= krem) d = 2; else { cum += hb.z; if (cum + hb.y >= krem) d = 1; else { cum += hb.y; d = 0; } } }
                ctl[0] = prefix | ((unsigned)(4 * lane + d) << shift); ctl[1] = krem - cum; } }
        __syncthreads();
        prefix = ctl[0]; krem = ctl[1]; mask |= 255u << shift;
        __syncthreads();
    }
    const unsigned thr = prefix;
    int ngt = 0, neq = 0;
#pragma unroll
    for (int i = 0; i < 16; ++i) { ngt += key[i] > thr; neq += key[i] == thr; }
    const int sg = scan_fwd64_i(ngt, lane), sq = scan_fwd64_i(neq, lane);
    if (lane == 63) { wsum[wave] = (unsigned)sg; wsum[8 + wave] = (unsigned)sq; }
    __syncthreads();
    int bg = 0, bq = 0;
#pragma unroll
    for (int w = 0; w < 8; ++w) if (w < wave) { bg += (int)wsum[w]; bq += (int)wsum[8 + w]; }
    int pg = bg + sg - ngt, pq = bq + sq - neq;
#pragma unroll
    for (int i = 0; i < 16; ++i) {
        const int tok = tid * 16 + i; const bool gt = key[i] > thr, eq = key[i] == thr;
        const bool sel = gt || (eq && pq < (int)krem);
        const int slot = pg + (pq < (int)krem ? pq : (int)krem);
        if (sel) { idx[be * CAP + slot] = tok; val[be * CAP + slot] = __uint_as_float(key[i]); }
        inv[((size_t)b * SEQ + tok) * 16 + e] = sel ? slot : -1;
        pg += gt; pq += eq;
    }
    __syncthreads();
}

__device__ __forceinline__ void phase_gather(const bf16* XN, const int* idx, bf16* XG, int gw, int NGW, int lane) {
    for (int r = gw; r < MEXP; r += NGW) {
        const int b = r >> 14; const int tok = idx[r];
        const GAS u32x4* s = (const GAS u32x4*)(XN + ((size_t)b * SEQ + tok) * DM) + lane; GAS u32x4* d = (GAS u32x4*)(XG + (size_t)r * DM) + lane;
        const u32x4 a = s[0], c = s[64]; d[0] = a; d[64] = c;
    }
}

__device__ __forceinline__ void phase_combine(const float* hin, float* hout, const bf16* Y, const int* inv, const float* val, const float* wn, bf16* XN, bool final_, int gw, int NGW, int lane, float pscale = 1.0f) {
    f32x4 wv[4]; load_w4(wn, wv, lane);
    for (int m = gw; m < M; m += NGW) {
        const int b = m >> 13;
        const GAS f32x4* xr = (const GAS f32x4*)(hin + (size_t)m * DM) + lane; f32x4 v[4];
#pragma unroll
        for (int j = 0; j < 4; ++j) v[j] = xr[64 * j];
        const int myslot = (lane < 16) ? inv[(size_t)m * 16 + lane] : -1;
        for (int e = 0; e < 16; ++e) {
            const int s = __shfl(myslot, e);
            if (s >= 0) {
                const int r = (b * 16 + e) * CAP + s; const float a = val[r];
                const GAS u32x2* yr = (const GAS u32x2*)(Y + (size_t)r * DM) + lane;
#pragma unroll
                for (int j = 0; j < 4; ++j) { const u32x2 t = yr[64 * j];
                    v[j].x += a * __uint_as_float(t.x << 16); v[j].y += a * __uint_as_float(t.x & 0xffff0000u); v[j].z += a * __uint_as_float(t.y << 16); v[j].w += a * __uint_as_float(t.y & 0xffff0000u); }
            }
        }
        float s2 = 0.f;
#pragma unroll
        for (int j = 0; j < 4; ++j) s2 += (v[j].x * v[j].x + v[j].y * v[j].y) + (v[j].z * v[j].z + v[j].w * v[j].w);
        const float rstd = __builtin_amdgcn_rsqf(wave_sum(s2) * (1.0f / DM) + EPS);
        GAS f32x4* ho = (GAS f32x4*)(hout + (size_t)m * DM) + lane;
        if (final_) {
#pragma unroll
            for (int j = 0; j < 4; ++j) ho[64 * j] = v[j] * (rstd * pscale) * wv[j];
        } else {
#pragma unroll
            for (int j = 0; j < 4; ++j) ho[64 * j] = v[j];
            f32x4 nv[4];
#pragma unroll
            for (int j = 0; j < 4; ++j) nv[j] = v[j] * rstd * wv[j];
            store_row_bf16(XN + (size_t)m * DM, nv, lane);
        }
    }
}
namespace gdn {
constexpr int CW = 0;
constexpr int SC = CW + 8 * 320 * 4;
constexpr int Q = SC + 1280;
constexpr int K = Q + 64 * 136 * 2;
constexpr int KDT = K + 64 * 136 * 2;
constexpr int VT = KDT + 128 * 72 * 2;
constexpr int T = VT + 64 * 72 * 2;
constexpr int QKD = T + 64 * 72 * 2;
constexpr int ST = QKD + 64 * 72 * 2;
constexpr int TMP = ST + 64 * 136 * 2;
constexpr int RQ = TMP, RK = RQ + 70 * 136 * 2, RV = RK + 70 * 136 * 2, RAW_END = RV + 70 * 72 * 2;
constexpr int AF = TMP, TF = AF + 64 * 68 * 4, XF = TF + 64 * 68 * 4, INV_END = XF + 3 * 16 * 17 * 4;
constexpr int RT = TMP, UT = RT + 64 * 72 * 2, OS = UT + 64 * 72 * 2, ST_END = OS + 64 * 65 * 4;
static_assert(RAW_END <= MISC_OFF && INV_END <= MISC_OFF && ST_END <= MISC_OFF, "gdn LDS map");
}
__device__ __forceinline__ void gdn_chain(LAS unsigned char* lds, int cid, const bf16* raw, const float* scal, const float* conv_w, const float* conv_b,
                                          const float* A_log, const float* dt_bias, bf16* og, int tid, int wave, int lane) {
    using namespace gdn;
    const int dvh = cid & 1, dir = (cid >> 1) & 1, h = (cid >> 2) & 7, b = cid >> 5;
    const int fr = lane & 15, fq = lane >> 4;
    LAS float* cw = (LAS float*)(lds + CW); LAS float* sc = (LAS float*)(lds + SC);
    LAS bf16* q_ = (LAS bf16*)(lds + Q); LAS bf16* k_ = (LAS bf16*)(lds + K); LAS bf16* kdT = (LAS bf16*)(lds + KDT); LAS bf16* vT = (LAS bf16*)(lds + VT);
    LAS bf16* T_ = (LAS bf16*)(lds + T); LAS bf16* QKd = (LAS bf16*)(lds + QKD); LAS bf16* ST_ = (LAS bf16*)(lds + ST);
    LAS bf16* rq = (LAS bf16*)(lds + RQ); LAS bf16* rk = (LAS bf16*)(lds + RK); LAS bf16* rv = (LAS bf16*)(lds + RV);
    LAS float* Af = (LAS float*)(lds + AF); LAS float* Tf = (LAS float*)(lds + TF); LAS float* Xf = (LAS float*)(lds + XF);
    LAS bf16* rT = (LAS bf16*)(lds + RT); LAS bf16* uT = (LAS bf16*)(lds + UT); LAS float* os = (LAS float*)(lds + OS);
    for (int e = tid; e < 8 * 320; e += 512) { const int r = e / 320, c = e % 320;
        const int gch = c < 128 ? h * 128 + c : (c < 256 ? 1024 + h * 128 + (c - 128) : 2048 + h * 128 + dvh * 64 + (c - 256));
        cw[e] = r < 7 ? conv_w[r * CONV_CH + gch] : conv_b[gch]; }
    for (int e = tid; e < 64 * 136 / 2; e += 512) ((LAS unsigned*)ST_)[e] = 0u;
    const float expA = expf(A_log[dir * 8 + h]), dtb = dt_bias[dir * 8 + h];
    f32x4 sacc[4];
#pragma unroll
    for (int nt = 0; nt < 4; ++nt) sacc[nt] = (f32x4){0.f, 0.f, 0.f, 0.f};
    const size_t rowb = (size_t)b * SEQ;
    __syncthreads();
    for (int n = 0; n < NCHUNK; ++n) {
        const int t0 = (dir ? NCHUNK - 1 - n : n) * 64;
        for (int e = tid; e < 70 * 40; e += 512) { const int r = e / 40, p = e % 40; const int t = t0 - 3 + r;
            u32x4 v = (u32x4){0u, 0u, 0u, 0u};
            const int col = p < 16 ? h * 128 + p * 8 : (p < 32 ? 1024 + h * 128 + (p - 16) * 8 : 2048 + h * 128 + dvh * 64 + (p - 32) * 8);
            if (t >= 0 && t < SEQ) v = *(const GAS u32x4*)(raw + (rowb + t) * CONV_CH + col);
            LAS bf16* d = p < 16 ? rq + r * 136 + p * 8 : (p < 32 ? rk + r * 136 + (p - 16) * 8 : rv + r * 72 + (p - 32) * 8);
            *(LAS u32x4*)d = v; }
        if (wave == 0) { const int i = lane; const int t = t0 + (dir ? 63 - i : i);
            const float braw = scal[(rowb + t) * 64 + dir * 8 + h], araw = scal[(rowb + t) * 64 + 16 + dir * 8 + h];
            const float g = -expA * softplus_f(araw + dtb);
            float gc = g;
#pragma unroll
            for (int o = 1; o < 64; o <<= 1) { const float y = __shfl_up(gc, o); if (i >= o) gc += y; }
            const float gl = __shfl(gc, 63);
            sc[i] = sigmoid_f(braw); sc[64 + i] = gc; sc[128 + i] = expf(gc); sc[192 + i] = expf(gl - gc); if (i == 0) sc[256] = expf(gl); }
        __syncthreads();
        { const int i = tid >> 3, cg = tid & 7; const int o = dir ? 63 - i : i;
          float a[16];
          conv16(a, rq + o * 136 + cg * 16, 136, cw + cg * 16, 320);
          float ss = 0.f;
#pragma unroll
          for (int c = 0; c < 16; ++c) { a[c] = silu(a[c]); ss += a[c] * a[c]; }
          ss += __shfl_xor(ss, 1); ss += __shfl_xor(ss, 2); ss += __shfl_xor(ss, 4);
          float rs = (1.0f / sqrtf(ss + EPS)) * 0.08838834764831845f;
          { u32x4 w0, w1; w0.x = pkbf(a[0] * rs, a[1] * rs); w0.y = pkbf(a[2] * rs, a[3] * rs); w0.z = pkbf(a[4] * rs, a[5] * rs); w0.w = pkbf(a[6] * rs, a[7] * rs);
            w1.x = pkbf(a[8] * rs, a[9] * rs); w1.y = pkbf(a[10] * rs, a[11] * rs); w1.z = pkbf(a[12] * rs, a[13] * rs); w1.w = pkbf(a[14] * rs, a[15] * rs);
            *(LAS u32x4*)(q_ + i * 136 + cg * 16) = w0; *(LAS u32x4*)(q_ + i * 136 + cg * 16 + 8) = w1; }
          conv16(a, rk + o * 136 + cg * 16, 136, cw + 128 + cg * 16, 320);
          ss = 0.f;
#pragma unroll
          for (int c = 0; c < 16; ++c) { a[c] = silu(a[c]); ss += a[c] * a[c]; }
          ss += __shfl_xor(ss, 1); ss += __shfl_xor(ss, 2); ss += __shfl_xor(ss, 4);
          rs = 1.0f / sqrtf(ss + EPS);
          { u32x4 w0, w1; w0.x = pkbf(a[0] * rs, a[1] * rs); w0.y = pkbf(a[2] * rs, a[3] * rs); w0.z = pkbf(a[4] * rs, a[5] * rs); w0.w = pkbf(a[6] * rs, a[7] * rs);
            w1.x = pkbf(a[8] * rs, a[9] * rs); w1.y = pkbf(a[10] * rs, a[11] * rs); w1.z = pkbf(a[12] * rs, a[13] * rs); w1.w = pkbf(a[14] * rs, a[15] * rs);
            *(LAS u32x4*)(k_ + i * 136 + cg * 16) = w0; *(LAS u32x4*)(k_ + i * 136 + cg * 16 + 8) = w1; }
          const float ek = sc[192 + i] * rs;
#pragma unroll
          for (int c = 0; c < 16; ++c) kdT[(cg * 16 + c) * 72 + i] = f2bf1(a[c] * ek);
          float v8[8];
          conv8(v8, rv + o * 72 + cg * 8, 72, cw + 256 + cg * 8, 320);
#pragma unroll
          for (int c = 0; c < 8; ++c) vT[(cg * 8 + c) * 72 + i] = f2bf1(silu(v8[c]));
        }
        __syncthreads();
        { const int which = wave >> 2, mt = wave & 3;
          f32x4 acc[1][4];
#pragma unroll
          for (int nt = 0; nt < 4; ++nt) acc[0][nt] = (f32x4){0.f, 0.f, 0.f, 0.f};
          mma_lds<1, 4>(acc, which ? q_ : k_, 136, mt * 16, k_, 136, 0, 128, fr, fq);
#pragma unroll
          for (int nt = 0; nt < 4; ++nt)
#pragma unroll
              for (int r = 0; r < 4; ++r) { const int i = mt * 16 + 4 * fq + r, j = nt * 16 + fr;
                  const float d = expf(fminf(sc[64 + i] - sc[64 + j], 0.f)); const float x = acc[0][nt][r] * d;
                  if (which == 0) Af[i * 68 + j] = (i > j) ? sc[i] * x : 0.f;
                  else QKd[i * 72 + j] = f2bf1((i >= j) ? x : 0.f); }
        }
        __syncthreads();
        if (wave == 0) { const int blk = lane >> 4, c = lane & 15; float t[16];
#pragma unroll
            for (int i = 0; i < 16; ++i) t[i] = (i == c) ? 1.f : 0.f;
#pragma unroll
            for (int i = 1; i < 16; ++i) { float s = 0.f; const LAS float* ar = Af + (blk * 16 + i) * 68 + blk * 16;
#pragma unroll
                for (int j = 0; j < i; ++j) s += ar[j] * t[j];
                t[i] = (i > c) ? -s : t[i];
                if ((i & 3) == 3) asm volatile("" ::: "memory"); }
#pragma unroll
            for (int i = 0; i < 16; ++i) Tf[(blk * 16 + i) * 68 + blk * 16 + c] = t[i]; }
        for (int d = 1; d <= 3; ++d) { const int nbk = 4 - d;
            __syncthreads();
            for (int e = tid; e < nbk * 256; e += 512) { const int J = e >> 8, r = (e >> 4) & 15, c = e & 15, I = J + d; float s = 0.f;
                for (int kk = J * 16; kk < I * 16; ++kk) s += Af[(I * 16 + r) * 68 + kk] * Tf[kk * 68 + J * 16 + c];
                Xf[(J * 16 + r) * 17 + c] = s; }
            __syncthreads();
            for (int e = tid; e < nbk * 256; e += 512) { const int J = e >> 8, r = (e >> 4) & 15, c = e & 15, I = J + d; float s = 0.f;
#pragma unroll
                for (int m2 = 0; m2 < 16; ++m2) s += Tf[(I * 16 + r) * 68 + I * 16 + m2] * Xf[(J * 16 + m2) * 17 + c];
                Tf[(I * 16 + r) * 68 + J * 16 + c] = -s; }
        }
        __syncthreads();
        for (int e = tid; e < 4096; e += 512) { const int i = e >> 6, j = e & 63; T_[i * 72 + j] = f2bf1(((i >> 4) >= (j >> 4)) ? Tf[i * 68 + j] : 0.f); }
        __syncthreads();
        const int mt = wave & 3, nh = wave >> 2;
        f32x4 aq[2];
        { f32x4 ak[2]; ak[0] = ak[1] = aq[0] = aq[1] = (f32x4){0.f, 0.f, 0.f, 0.f};
          for (int k0 = 0; k0 < 128; k0 += 32) {
              const bf16x8 fk = *(const LAS bf16x8*)(k_ + (mt * 16 + fr) * 136 + k0 + fq * 8), fqv = *(const LAS bf16x8*)(q_ + (mt * 16 + fr) * 136 + k0 + fq * 8);
#pragma unroll
              for (int nl = 0; nl < 2; ++nl) { const bf16x8 fb = *(const LAS bf16x8*)(ST_ + (nh * 32 + nl * 16 + fr) * 136 + k0 + fq * 8);
                  ak[nl] = __builtin_amdgcn_mfma_f32_16x16x32_bf16(fk, fb, ak[nl], 0, 0, 0); aq[nl] = __builtin_amdgcn_mfma_f32_16x16x32_bf16(fqv, fb, aq[nl], 0, 0, 0); } }
          const int i0 = mt * 16 + 4 * fq;
          const f32x4 be4 = *(const LAS f32x4*)(sc + i0), eg4 = *(const LAS f32x4*)(sc + 128 + i0);
#pragma unroll
          for (int nl = 0; nl < 2; ++nl) { const int dv = nh * 32 + nl * 16 + fr;
              const bf16x4 vv = *(const LAS bf16x4*)(vT + dv * 72 + i0);
              float r0 = be4[0] * (bf2f_s(vv[0]) - eg4[0] * ak[nl][0]), r1 = be4[1] * (bf2f_s(vv[1]) - eg4[1] * ak[nl][1]);
              float r2 = be4[2] * (bf2f_s(vv[2]) - eg4[2] * ak[nl][2]), r3 = be4[3] * (bf2f_s(vv[3]) - eg4[3] * ak[nl][3]);
              u32x2 w; w.x = pkbf(r0, r1); w.y = pkbf(r2, r3); *(LAS u32x2*)(rT + dv * 72 + i0) = w;
              aq[nl][0] *= eg4[0]; aq[nl][1] *= eg4[1]; aq[nl][2] *= eg4[2]; aq[nl][3] *= eg4[3]; }
        }
        __syncthreads();
        { f32x4 au[1][2]; au[0][0] = au[0][1] = (f32x4){0.f, 0.f, 0.f, 0.f};
          mma_lds<1, 2>(au, T_, 72, mt * 16, rT, 72, nh * 32, 64, fr, fq);
          const int i0 = mt * 16 + 4 * fq;
#pragma unroll
          for (int nl = 0; nl < 2; ++nl) { const int dv = nh * 32 + nl * 16 + fr; u32x2 w; w.x = pkbf(au[0][nl][0], au[0][nl][1]); w.y = pkbf(au[0][nl][2], au[0][nl][3]); *(LAS u32x2*)(uT + dv * 72 + i0) = w; }
        }
        __syncthreads();
        { f32x4 ao[1][2]; ao[0][0] = aq[0]; ao[0][1] = aq[1];
          mma_lds<1, 2>(ao, QKd, 72, mt * 16, uT, 72, nh * 32, 64, fr, fq);
          const int i0 = mt * 16 + 4 * fq;
#pragma unroll
          for (int nl = 0; nl < 2; ++nl)
#pragma unroll
              for (int r = 0; r < 4; ++r) os[(i0 + r) * 65 + nh * 32 + nl * 16 + fr] = ao[0][nl][r];
          const float egl = sc[256];
          f32x4 as_[1][4];
#pragma unroll
          for (int nt = 0; nt < 4; ++nt) as_[0][nt] = sacc[nt] * egl;
          mma_lds<1, 4>(as_, kdT, 72, wave * 16, uT, 72, 0, 64, fr, fq);
#pragma unroll
          for (int nt = 0; nt < 4; ++nt) { sacc[nt] = as_[0][nt];
              u32x2 w; w.x = pkbf(sacc[nt][0], sacc[nt][1]); w.y = pkbf(sacc[nt][2], sacc[nt][3]); *(LAS u32x2*)(ST_ + (nt * 16 + fr) * 136 + wave * 16 + 4 * fq) = w; }
        }
        __syncthreads();
#pragma unroll
        for (int ii = 0; ii < 4; ++ii) { const int i = wave * 8 + 2 * ii + (lane >> 5), cp = lane & 31; const int t = t0 + (dir ? 63 - i : i);
            atomic_add_bf16x2(og + (rowb + t) * 1024 + h * 128 + dvh * 64 + 2 * cp, os[i * 65 + 2 * cp], os[i * 65 + 2 * cp + 1]); }
        __syncthreads();
    }
}

namespace ssd {
constexpr int CW = 0;
constexpr int SC = CW + 8 * 320 * 4;
constexpr int BM_ = SC + 1280;
constexpr int CM_ = BM_ + 64 * 136 * 2;
constexpr int BT = CM_ + 64 * 136 * 2;
constexpr int XDT = BT + 128 * 72 * 2;
constexpr int XDW = XDT + 64 * 72 * 2;
constexpr int MM = XDW + 64 * 72 * 2;
constexpr int HT = MM + 64 * 72 * 2;
constexpr int TMP = HT + 64 * 136 * 2;
constexpr int RX = TMP, RB = RX + 70 * 72 * 2, RC = RB + 70 * 136 * 2, RAW_END = RC + 70 * 136 * 2;
constexpr int OS = TMP, OS_END = OS + 64 * 65 * 4;
static_assert(RAW_END <= MISC_OFF && OS_END <= MISC_OFF, "ssd LDS map");
}
__device__ __forceinline__ void ssd_chain(LAS unsigned char* lds, int cid, const bf16* raw, const float* scal, const float* conv_w, const float* conv_b,
                                          const float* A_log, const float* dt_bias, const float* Dp, bf16* ys, int tid, int wave, int lane) {
    using namespace ssd;
    const int dir = cid & 1, head = (cid >> 1) & 15, b = cid >> 5; const int g = head >> 3;
    const int fr = lane & 15, fq = lane >> 4;
    LAS float* cw = (LAS float*)(lds + CW); LAS float* sc = (LAS float*)(lds + SC);
    LAS bf16* Bm = (LAS bf16*)(lds + BM_); LAS bf16* Cm = (LAS bf16*)(lds + CM_); LAS bf16* BT_ = (LAS bf16*)(lds + BT);
    LAS bf16* xdt = (LAS bf16*)(lds + XDT); LAS bf16* xdw = (LAS bf16*)(lds + XDW); LAS bf16* Mm = (LAS bf16*)(lds + MM); LAS bf16* hT = (LAS bf16*)(lds + HT);
    LAS bf16* rx = (LAS bf16*)(lds + RX); LAS bf16* rb = (LAS bf16*)(lds + RB); LAS bf16* rc = (LAS bf16*)(lds + RC); LAS float* os = (LAS float*)(lds + OS);
    const int chx = 3072 + head * 64, chb = 4096 + g * 128, chc = 4352 + g * 128;
    for (int e = tid; e < 8 * 320; e += 512) { const int r = e / 320, c = e % 320;
        const int gch = c < 64 ? chx + c : (c < 192 ? chb + (c - 64) : chc + (c - 192));
        cw[e] = r < 7 ? conv_w[r * CONV_CH + gch] : conv_b[gch]; }
    for (int e = tid; e < 64 * 136 / 2; e += 512) ((LAS unsigned*)hT)[e] = 0u;
    const float Ah = -expf(A_log[dir * 16 + head]), dtb = dt_bias[dir * 16 + head], Dh = (dir == 0) ? Dp[head] : 0.f;
    f32x4 hacc[4];
#pragma unroll
    for (int nt = 0; nt < 4; ++nt) hacc[nt] = (f32x4){0.f, 0.f, 0.f, 0.f};
    const size_t rowb = (size_t)b * SEQ;
    __syncthreads();
    for (int n = 0; n < NCHUNK; ++n) {
        const int t0 = (dir ? NCHUNK - 1 - n : n) * 64;
        for (int e = tid; e < 70 * 40; e += 512) { const int r = e / 40, p = e % 40; const int t = t0 - 3 + r;
            u32x4 v = (u32x4){0u, 0u, 0u, 0u};
            const int col = p < 8 ? chx + p * 8 : (p < 24 ? chb + (p - 8) * 8 : chc + (p - 24) * 8);
            if (t >= 0 && t < SEQ) v = *(const GAS u32x4*)(raw + (rowb + t) * CONV_CH + col);
            LAS bf16* d = p < 8 ? rx + r * 72 + p * 8 : (p < 24 ? rb + r * 136 + (p - 8) * 8 : rc + r * 136 + (p - 24) * 8);
            *(LAS u32x4*)d = v; }
        if (wave == 0) { const int i = lane; const int t = t0 + (dir ? 63 - i : i);
            const float dt = softplus_f(scal[(rowb + t) * 64 + 32 + dir * 16 + head] + dtb);
            float cs = dt * Ah;
#pragma unroll
            for (int o = 1; o < 64; o <<= 1) { const float y = __shfl_up(cs, o); if (i >= o) cs += y; }
            const float cl = __shfl(cs, 63);
            sc[i] = dt; sc[64 + i] = cs; sc[128 + i] = expf(cs); sc[192 + i] = expf(cl - cs); if (i == 0) sc[256] = expf(cl); }
        __syncthreads();
        { const int i = tid >> 3, cg = tid & 7; const int o = dir ? 63 - i : i;
          float a[16];
          conv16(a, rb + o * 136 + cg * 16, 136, cw + 64 + cg * 16, 320);
#pragma unroll
          for (int c = 0; c < 16; ++c) a[c] = silu(a[c]);
          { u32x4 w0, w1; w0.x = pkbf(a[0], a[1]); w0.y = pkbf(a[2], a[3]); w0.z = pkbf(a[4], a[5]); w0.w = pkbf(a[6], a[7]);
            w1.x = pkbf(a[8], a[9]); w1.y = pkbf(a[10], a[11]); w1.z = pkbf(a[12], a[13]); w1.w = pkbf(a[14], a[15]);
            *(LAS u32x4*)(Bm + i * 136 + cg * 16) = w0; *(LAS u32x4*)(Bm + i * 136 + cg * 16 + 8) = w1; }
#pragma unroll
          for (int c = 0; c < 16; ++c) BT_[(cg * 16 + c) * 72 + i] = f2bf1(a[c]);
          conv16(a, rc + o * 136 + cg * 16, 136, cw + 192 + cg * 16, 320);
#pragma unroll
          for (int c = 0; c < 16; ++c) a[c] = silu(a[c]);
          { u32x4 w0, w1; w0.x = pkbf(a[0], a[1]); w0.y = pkbf(a[2], a[3]); w0.z = pkbf(a[4], a[5]); w0.w = pkbf(a[6], a[7]);
            w1.x = pkbf(a[8], a[9]); w1.y = pkbf(a[10], a[11]); w1.z = pkbf(a[12], a[13]); w1.w = pkbf(a[14], a[15]);
            *(LAS u32x4*)(Cm + i * 136 + cg * 16) = w0; *(LAS u32x4*)(Cm + i * 136 + cg * 16 + 8) = w1; }
          float x8[8];
          conv8(x8, rx + o * 72 + cg * 8, 72, cw + cg * 8, 320);
          const float dt = sc[i], wst = sc[192 + i];
#pragma unroll
          for (int c = 0; c < 8; ++c) { const float xv = silu(x8[c]) * dt; xdt[(cg * 8 + c) * 72 + i] = f2bf1(xv); xdw[(cg * 8 + c) * 72 + i] = f2bf1(xv * wst); }
        }
        __syncthreads();
        const int mt = wave & 3, nh = wave >> 2;
        { f32x4 acc[1][2]; acc[0][0] = acc[0][1] = (f32x4){0.f, 0.f, 0.f, 0.f};
          mma_lds<1, 2>(acc, Cm, 136, mt * 16, Bm, 136, nh * 32, 128, fr, fq);
#pragma unroll
          for (int nl = 0; nl < 2; ++nl)
#pragma unroll
              for (int r = 0; r < 4; ++r) { const int i = mt * 16 + 4 * fq + r, j = nh * 32 + nl * 16 + fr;
                  const float d = expf(fminf(sc[64 + i] - sc[64 + j], 0.f));
                  Mm[i * 72 + j] = f2bf1((i >= j) ? acc[0][nl][r] * d : 0.f); }
        }
        __syncthreads();
        { f32x4 a1[1][2], a2[1][2]; a1[0][0] = a1[0][1] = a2[0][0] = a2[0][1] = (f32x4){0.f, 0.f, 0.f, 0.f};
          mma_lds<1, 2>(a1, Mm, 72, mt * 16, xdt, 72, nh * 32, 64, fr, fq);
          mma_lds<1, 2>(a2, Cm, 136, mt * 16, hT, 136, nh * 32, 128, fr, fq);
          const int i0 = mt * 16 + 4 * fq;
          const f32x4 ec4 = *(const LAS f32x4*)(sc + 128 + i0), dt4 = *(const LAS f32x4*)(sc + i0);
#pragma unroll
          for (int nl = 0; nl < 2; ++nl) { const int p = nh * 32 + nl * 16 + fr; const bf16x4 xv = *(const LAS bf16x4*)(xdt + p * 72 + i0);
#pragma unroll
              for (int r = 0; r < 4; ++r) os[(i0 + r) * 65 + p] = a1[0][nl][r] + ec4[r] * a2[0][nl][r] + Dh * bf2f_s(xv[r]) / dt4[r]; }
        }
        __syncthreads();
        { const float ecl = sc[256];
          f32x4 ah[1][4];
#pragma unroll
          for (int nt = 0; nt < 4; ++nt) ah[0][nt] = hacc[nt] * ecl;
          mma_lds<1, 4>(ah, BT_, 72, wave * 16, xdw, 72, 0, 64, fr, fq);
#pragma unroll
          for (int nt = 0; nt < 4; ++nt) { hacc[nt] = ah[0][nt];
              u32x2 w; w.x = pkbf(hacc[nt][0], hacc[nt][1]); w.y = pkbf(hacc[nt][2], hacc[nt][3]); *(LAS u32x2*)(hT + (nt * 16 + fr) * 136 + wave * 16 + 4 * fq) = w; }
        }
#pragma unroll
        for (int ii = 0; ii < 4; ++ii) { const int i = wave * 8 + 2 * ii + (lane >> 5), cp = lane & 31; const int t = t0 + (dir ? 63 - i : i);
            atomic_add_bf16x2(ys + (rowb + t) * 1024 + head * 64 + 2 * cp, os[i * 65 + 2 * cp], os[i * 65 + 2 * cp + 1]); }
        __syncthreads();
    }
}
namespace pgd {
constexpr int CW = 0;
constexpr int SC = CW + 8 * 384 * 4;
constexpr int Q = SC + 1280;
constexpr int K = Q + 64 * 136 * 2;
constexpr int VT = K + 64 * 136 * 2;
constexpr int TMP = VT + 128 * 72 * 2;
constexpr int RQ = TMP, RK = RQ + 70 * 136 * 2, RV = RK + 70 * 136 * 2, RAW_END = RV + 70 * 136 * 2;
constexpr int AF = TMP, A2F = AF + 64 * 68 * 4, TF = A2F + 64 * 68 * 4, T2F = TF + 64 * 68 * 4, QKP = T2F + 64 * 68 * 4, INV_END = QKP + 64 * 72 * 2;
constexpr int XF = VT;
constexpr int TP = AF;
constexpr int STASH = MISC_OFF - 16384;
static_assert(RAW_END <= STASH && INV_END <= STASH, "prep gdn LDS map");
}
constexpr size_t WS_TQ = 379 * MiB;

__device__ __forceinline__ void prep_gdn_stash(LAS unsigned char* lds, int bid, const bf16* raw, int tid) {
    const int bh = bid >> 3, b = bh >> 3, h = bh & 7, r8 = bid & 7;
    LAS bf16* st = (LAS bf16*)(lds + pgd::STASH);
    for (int e = tid; e < 2 * 3 * 48; e += 512) { const int which = e / 144, r = (e % 144) / 48, p = e % 48;
        const int t = which ? (r8 * 16 + 16) * 64 + r : r8 * 16 * 64 - 3 + r;
        const int col = p < 16 ? h * 128 + p * 8 : (p < 32 ? 1024 + h * 128 + (p - 16) * 8 : 2048 + h * 128 + (p - 32) * 8);
        u32x4 v = (u32x4){0u, 0u, 0u, 0u};
        if (t >= 0 && t < SEQ) v = *(const GAS u32x4*)(raw + ((size_t)b * SEQ + t) * CONV_CH + col);
        *(LAS u32x4*)(st + which * 1152 + r * 384 + p * 8) = v; }
}
__device__ __forceinline__ void inv_diag_blocks(const LAS float* Af, LAS float* Tf, int lane) {
    const int blk = lane >> 4, c = lane & 15; float t[16];
#pragma unroll
    for (int i = 0; i < 16; ++i) t[i] = (i == c) ? 1.f : 0.f;
#pragma unroll
    for (int i = 1; i < 16; ++i) { float s = 0.f; const LAS float* ar = Af + (blk * 16 + i) * 68 + blk * 16;
#pragma unroll
        for (int j = 0; j < i; ++j) s += ar[j] * t[j];
        t[i] = (i > c) ? -s : t[i];
        if ((i & 3) == 3) asm volatile("" ::: "memory"); }
#pragma unroll
    for (int i = 0; i < 16; ++i) Tf[(blk * 16 + i) * 68 + blk * 16 + c] = t[i];
}
__device__ __forceinline__ void inv_offdiag_x(const LAS float* Af, const LAS float* Tf, LAS float* Xf, int d, int ht) {
    const int nbk = 4 - d;
    for (int e = ht; e < nbk * 256; e += 256) { const int J = e >> 8, r = (e >> 4) & 15, c = e & 15, I = J + d; float s = 0.f;
        for (int kk = J * 16; kk < I * 16; ++kk) s += Af[(I * 16 + r) * 68 + kk] * Tf[kk * 68 + J * 16 + c];
        Xf[(J * 16 + r) * 17 + c] = s; }
}
__device__ __forceinline__ void inv_offdiag_t(LAS float* Tf, const LAS float* Xf, int d, int ht) {
    const int nbk = 4 - d;
    for (int e = ht; e < nbk * 256; e += 256) { const int J = e >> 8, r = (e >> 4) & 15, c = e & 15, I = J + d; float s = 0.f;
#pragma unroll
        for (int m2 = 0; m2 < 16; ++m2) s += Tf[(I * 16 + r) * 68 + I * 16 + m2] * Xf[(J * 16 + m2) * 17 + c];
        Tf[(I * 16 + r) * 68 + J * 16 + c] = -s; }
}

__device__ __forceinline__ void conv_pair8(float (&o)[16], const LAS bf16* src  , int ld, const float (&w)[16]) {
#pragma unroll
    for (int t = 0; t < 8; ++t) { o[2 * t] = w[14]; o[2 * t + 1] = w[15]; }
#pragma unroll
    for (int r = 0; r < 14; ++r) { const unsigned xv = *(const LAS unsigned*)(src + r * ld); const float x0 = __uint_as_float(xv << 16), x1 = __uint_as_float(xv & 0xffff0000u);
#pragma unroll
        for (int t = 0; t < 8; ++t) { const int tap = r - t; if (tap >= 0 && tap < 7) { o[2 * t] += x0 * w[2 * tap]; o[2 * t + 1] += x1 * w[2 * tap + 1]; } } }
}
namespace pg2 {
constexpr int CW = 0;
constexpr int SC = CW + 8 * 384 * 4;
constexpr int Q = SC + 1280;
constexpr int K = Q + 64 * 136 * 2;
constexpr int VT = K + 64 * 136 * 2;
constexpr int RAWT = VT + 128 * 72 * 2;
constexpr int RAW_END = RAWT + 3 * 70 * 136 * 2;
constexpr int ABF = RAWT, TRM = ABF + 2 * 64 * 72 * 2, TTR = TRM + 2 * 64 * 72 * 2, AD = TTR + 2 * 64 * 72 * 2, XS = AD + 2 * 4 * 256 * 4, QKP = XS + 2 * 32 * 40 * 2, INV_END = QKP + 64 * 72 * 2;
static_assert(RAW_END <= pgd::STASH && INV_END <= pgd::STASH, "prep gdn v2 LDS map");
}
__device__ __forceinline__ void prep_gdn_range(LAS unsigned char* lds, int bid, bf16* raw, const float* scal, const float* conv_w, const float* conv_b,
                                               const float* A_log, const float* dt_bias, bf16* TQ, int tid_p, int wave_p, int lane_p, float* scal_w) {
    using namespace pg2;
    int tid = tid_p, wave = wave_p, lane = lane_p;
    const int bh = bid >> 3, b = bh >> 3, h = bh & 7, r8 = bid & 7;
    LAS float* cw = (LAS float*)(lds + CW); LAS float* sc = (LAS float*)(lds + SC);
    LAS bf16* q_ = (LAS bf16*)(lds + Q); LAS bf16* k_ = (LAS bf16*)(lds + K); LAS bf16* vT = (LAS bf16*)(lds + VT);
    LAS bf16* rq = (LAS bf16*)(lds + RAWT); LAS bf16* rk = rq + 70 * 136; LAS bf16* rv = rk + 70 * 136;
    LAS bf16* Abf = (LAS bf16*)(lds + ABF); LAS bf16* Trm = (LAS bf16*)(lds + TRM); LAS bf16* Ttr = (LAS bf16*)(lds + TTR);
    LAS float* ADf = (LAS float*)(lds + AD); LAS bf16* Xs = (LAS bf16*)(lds + XS); LAS bf16* QKp = (LAS bf16*)(lds + QKP);
    LAS bf16* st = (LAS bf16*)(lds + pgd::STASH);
    for (int e = tid; e < 8 * 384; e += 512) { const int r = e / 384, c = e % 384;
        const int gch = (c >> 7) * 1024 + h * 128 + (c & 127);
        cw[e] = r < 7 ? conv_w[r * CONV_CH + gch] : conv_b[gch]; }
    const float LOG2E = 1.4426950408889634f;
    const float expAf = expf(A_log[h]), dtbf = dt_bias[h], expAb = expf(A_log[8 + h]), dtbb = dt_bias[8 + h];
    const size_t rowb = (size_t)b * SEQ;
    u32x4 pre[7];
#define PG2_LOAD(u_) do { const int t0_ = (r8 * 16 + (u_)) * 64; \
        _Pragma("unroll") for (int x = 0; x < 7; ++x) { const int e = tid + 512 * x; const int r = e / 48, p = e % 48; \
            pre[x] = (u32x4){0u, 0u, 0u, 0u}; \
            if (e < 70 * 48 && r >= 3 && !(r >= 67 && (u_) == 15)) { const int col = p < 16 ? h * 128 + p * 8 : (p < 32 ? 1024 + h * 128 + (p - 16) * 8 : 2048 + h * 128 + (p - 32) * 8); \
                pre[x] = *(const GAS u32x4*)(raw + (rowb + t0_ - 3 + r) * CONV_CH + col); } } } while (0)
    PG2_LOAD(0);
    float psa = 0.f, psb = 0.f;
#define PG2_LOADS(u_) do { if (wave < 2) { const size_t so_ = (rowb + (size_t)(r8 * 16 + (u_)) * 64 + lane) * 64; psa = scal[so_ + 16 + 8 * wave + h]; psb = scal[so_ + 8 * wave + h]; } } while (0)
    PG2_LOADS(0);
    __syncthreads();
#define PG2_STAGEA(u_) do { const int t0_ = (r8 * 16 + (u_)) * 64; \
        _Pragma("unroll") for (int x = 0; x < 7; ++x) { const int e = tid + 512 * x; const int r = e / 48, p = e % 48; \
            if (e < 70 * 48) { u32x4 v = pre[x]; \
                if (r < 3) v = *(const LAS u32x4*)(st + r * 384 + p * 8); \
                else if (r >= 67 && (u_) == 15) v = *(const LAS u32x4*)(st + 1152 + (r - 67) * 384 + p * 8); \
                *(LAS u32x4*)((p < 16 ? rq + r * 136 + p * 8 : (p < 32 ? rk + r * 136 + (p - 16) * 8 : rv + r * 136 + (p - 32) * 8))) = v; } } \
        if (wave == 0) { const int i = lane; const size_t so = (rowb + t0_ + i) * 64; \
            const float gc = scan_fwd64(-expAf * softplus_fast(psa + dtbf), i); \
            const float be_ = sigmoid_fast(psb); sc[i] = be_; sc[64 + i] = gc * LOG2E; scal_w[so + h] = be_; scal_w[so + 16 + h] = gc; } \
        if (wave == 1) { const int i = lane; const size_t so = (rowb + t0_ + i) * 64; \
            const float gc = scan_bwd64(-expAb * softplus_fast(psa + dtbb), i); \
            const float be_ = sigmoid_fast(psb); sc[128 + i] = be_; sc[192 + i] = gc * LOG2E; scal_w[so + 8 + h] = be_; scal_w[so + 24 + h] = gc; } } while (0)
    PG2_STAGEA(0);
    PG2_LOAD(1); PG2_LOADS(1);
    __syncthreads();
    for (int u = 0; u < 16; ++u) {
        tid = tid_p; asm volatile("" : "+v"(tid));
        lane = tid & 63; wave = __builtin_amdgcn_readfirstlane(tid >> 6);
        const int fr = lane & 15, fq = lane >> 4, half = wave >> 2, w4 = wave & 3;
        const int c = r8 * 16 + u, t0 = c * 64;
        if (tid < 144) { const int r = tid / 48, p = tid % 48;
            const LAS bf16* s = p < 16 ? rq + (64 + r) * 136 + p * 8 : (p < 32 ? rk + (64 + r) * 136 + (p - 16) * 8 : rv + (64 + r) * 136 + (p - 32) * 8);
            *(LAS u32x4*)(st + r * 384 + p * 8) = *(const LAS u32x4*)s; }
        { const int tg = wave, cp = lane; float w[16], o[16];
#pragma unroll
          for (int tap = 0; tap < 8; ++tap) { w[2 * tap] = cw[tap * 384 + 2 * cp]; w[2 * tap + 1] = cw[tap * 384 + 2 * cp + 1]; }
          conv_pair8(o, rq + (8 * tg) * 136 + 2 * cp, 136, w);
#pragma unroll
          for (int t = 0; t < 8; ++t) { o[2 * t] = silu(o[2 * t]); o[2 * t + 1] = silu(o[2 * t + 1]);
              const float rs = __builtin_amdgcn_rsqf(wave_sum(o[2 * t] * o[2 * t] + o[2 * t + 1] * o[2 * t + 1]) + EPS) * 0.08838834764831845f;
              const unsigned pk = pkbf(o[2 * t] * rs, o[2 * t + 1] * rs);
              *(LAS unsigned*)(q_ + (8 * tg + t) * 136 + 2 * cp) = pk; *(GAS unsigned*)(raw + (rowb + t0 + 8 * tg + t) * CONV_CH + h * 128 + 2 * cp) = pk; }
#pragma unroll
          for (int tap = 0; tap < 8; ++tap) { w[2 * tap] = cw[tap * 384 + 128 + 2 * cp]; w[2 * tap + 1] = cw[tap * 384 + 128 + 2 * cp + 1]; }
          conv_pair8(o, rk + (8 * tg) * 136 + 2 * cp, 136, w);
#pragma unroll
          for (int t = 0; t < 8; ++t) { o[2 * t] = silu(o[2 * t]); o[2 * t + 1] = silu(o[2 * t + 1]);
              const float rs = __builtin_amdgcn_rsqf(wave_sum(o[2 * t] * o[2 * t] + o[2 * t + 1] * o[2 * t + 1]) + EPS);
              const unsigned pk = pkbf(o[2 * t] * rs, o[2 * t + 1] * rs);
              *(LAS unsigned*)(k_ + (8 * tg + t) * 136 + 2 * cp) = pk; *(GAS unsigned*)(raw + (rowb + t0 + 8 * tg + t) * CONV_CH + 1024 + h * 128 + 2 * cp) = pk; }
#pragma unroll
          for (int tap = 0; tap < 8; ++tap) { w[2 * tap] = cw[tap * 384 + 256 + 2 * cp]; w[2 * tap + 1] = cw[tap * 384 + 256 + 2 * cp + 1]; }
          conv_pair8(o, rv + (8 * tg) * 136 + 2 * cp, 136, w);
#pragma unroll
          for (int t = 0; t < 16; ++t) o[t] = silu(o[t]);
          u32x4 e0, e1; e0.x = pkbf(o[0], o[2]); e0.y = pkbf(o[4], o[6]); e0.z = pkbf(o[8], o[10]); e0.w = pkbf(o[12], o[14]);
          e1.x = pkbf(o[1], o[3]); e1.y = pkbf(o[5], o[7]); e1.z = pkbf(o[9], o[11]); e1.w = pkbf(o[13], o[15]);
          *(LAS u32x4*)(vT + (2 * cp) * 72 + 8 * tg) = e0; *(LAS u32x4*)(vT + (2 * cp + 1) * 72 + 8 * tg) = e1;
        }
        __syncthreads();
        for (int e = tid; e < 128 * 8; e += 512) { const int dv = e >> 3, p = e & 7;
            *(GAS u32x4*)(raw + (rowb + t0 + (dv >> 1)) * CONV_CH + 2048 + h * 128 + (dv & 1) * 64 + p * 8) = *(const LAS u32x4*)(vT + dv * 72 + p * 8); }
        for (int e = tid; e < 2 * 2 * 64 * 72 * 2 / 16; e += 512) ((LAS u32x4*)(lds + TRM))[e] = (u32x4){0u, 0u, 0u, 0u};
        for (int e = tid; e < 2 * 32 * 40 * 2 / 16; e += 512) ((LAS u32x4*)(lds + XS))[e] = (u32x4){0u, 0u, 0u, 0u};
        { const int mt = w4;
          f32x4 acc[1][4];
#pragma unroll
          for (int nt = 0; nt < 4; ++nt) acc[0][nt] = (f32x4){0.f, 0.f, 0.f, 0.f};
          mma_lds<1, 4>(acc, half ? q_ : k_, 136, mt * 16, k_, 136, 0, 128, fr, fq);
          const int i0 = mt * 16 + 4 * fq;
          const f32x4 gfi = *(const LAS f32x4*)(sc + 64 + i0), gbi = *(const LAS f32x4*)(sc + 192 + i0), bfi = *(const LAS f32x4*)(sc + i0), bbi = *(const LAS f32x4*)(sc + 128 + i0);
          float gfj[4], gbj[4];
#pragma unroll
          for (int nt = 0; nt < 4; ++nt) { gfj[nt] = sc[64 + nt * 16 + fr]; gbj[nt] = sc[192 + nt * 16 + fr]; }
          asm volatile("" ::: "memory");
#pragma unroll
          for (int nt = 0; nt < 4; ++nt)
#pragma unroll
              for (int r = 0; r < 4; ++r) { const int i = i0 + r, j = nt * 16 + fr; const bool lower = i > j, upper = i < j;
                  const float argl = gfi[r] - gfj[nt], argu = gbi[r] - gbj[nt];
                  const float x = acc[0][nt][r] * __builtin_amdgcn_exp2f(fminf(lower ? argl : argu, 0.f));
                  if (half == 0) { const float af = lower ? bfi[r] * x : 0.f, ab = upper ? bbi[r] * x : 0.f;
                      Abf[i * 72 + j] = f2bf1(af); Abf[64 * 72 + j * 72 + i] = f2bf1(ab);
                      if (mt == nt) { ADf[(mt * 16 + (i & 15)) * 16 + (j & 15)] = af; ADf[1024 + (mt * 16 + (j & 15)) * 16 + (i & 15)] = ab; } }
                  else QKp[i * 72 + j] = f2bf1(i == j ? acc[0][nt][r] : x); }
        }
        __syncthreads();
        { LAS bf16* Ab = Abf + half * 64 * 72; LAS bf16* Tr = Trm + half * 64 * 72; LAS bf16* Tt = Ttr + half * 64 * 72; LAS bf16* Xh = Xs + half * 32 * 40;
          if (w4 == 0) { const int blk = lane >> 4, cc = lane & 15; float t[16]; const LAS float* ad = ADf + half * 1024 + blk * 256;
#pragma unroll
              for (int i = 0; i < 16; ++i) t[i] = (i == cc) ? 1.f : 0.f;
#pragma unroll
              for (int i = 1; i < 16; ++i) { float s0 = 0.f, s1 = 0.f;
#pragma unroll
                  for (int j = 0; j < i; ++j) { if (j & 1) s1 += ad[i * 16 + j] * t[j]; else s0 += ad[i * 16 + j] * t[j]; }
                  t[i] = (i > cc) ? -(s0 + s1) : t[i];
                  if ((i & 3) == 3) asm volatile("" ::: "memory"); }
#pragma unroll
              for (int i = 0; i < 16; ++i) { const unsigned short tb = f2bf1(t[i]); Tr[(blk * 16 + i) * 72 + blk * 16 + cc] = tb; Tt[(blk * 16 + cc) * 72 + blk * 16 + i] = tb; } }
          __syncthreads();
          f32x4 a1[1][1];
          if (w4 < 2) { const int J = 2 * w4, I = J + 1; a1[0][0] = (f32x4){0.f, 0.f, 0.f, 0.f};
              mma_lds<1, 1>(a1, Ab + 16 * J, 72, 16 * I, Tt + 16 * J, 72, 16 * J, 32, fr, fq);
              u32x2 wv; wv.x = pkbf(a1[0][0][0], a1[0][0][1]); wv.y = pkbf(a1[0][0][2], a1[0][0][3]);
              *(LAS u32x2*)(Xh + (w4 * 16 + fr) * 40 + 4 * fq) = wv; }
          __syncthreads();
          if (w4 < 2) { const int J = 2 * w4, I = J + 1; a1[0][0] = (f32x4){0.f, 0.f, 0.f, 0.f};
              mma_lds<1, 1>(a1, Tr + 16 * I, 72, 16 * I, Xh, 40, w4 * 16, 32, fr, fq);
#pragma unroll
              for (int r = 0; r < 4; ++r) Tr[(16 * I + 4 * fq + r) * 72 + 16 * J + fr] = f2bf1(-a1[0][0][r]);
              u32x2 wv; wv.x = pkbf(-a1[0][0][0], -a1[0][0][1]); wv.y = pkbf(-a1[0][0][2], -a1[0][0][3]);
              *(LAS u32x2*)(Tt + (16 * J + fr) * 72 + 16 * I + 4 * fq) = wv; }
          __syncthreads();
          { const int mt2 = w4 >> 1, nt2 = w4 & 1; a1[0][0] = (f32x4){0.f, 0.f, 0.f, 0.f};
            mma_lds<1, 1>(a1, Ab, 72, 32 + 16 * mt2, Tt, 72, 16 * nt2, 32, fr, fq);
            u32x2 wv; wv.x = pkbf(a1[0][0][0], a1[0][0][1]); wv.y = pkbf(a1[0][0][2], a1[0][0][3]);
            __syncthreads();
            *(LAS u32x2*)(Xh + (16 * nt2 + fr) * 40 + 16 * mt2 + 4 * fq) = wv;
            __syncthreads();
            a1[0][0] = (f32x4){0.f, 0.f, 0.f, 0.f};
            mma_lds<1, 1>(a1, Tr + 32, 72, 32 + 16 * mt2, Xh, 40, 16 * nt2, 32, fr, fq);
#pragma unroll
            for (int r = 0; r < 4; ++r) Tr[(32 + 16 * mt2 + 4 * fq + r) * 72 + 16 * nt2 + fr] = f2bf1(-a1[0][0][r]);
            u32x2 w2; w2.x = pkbf(-a1[0][0][0], -a1[0][0][1]); w2.y = pkbf(-a1[0][0][2], -a1[0][0][3]);
            *(LAS u32x2*)(Tt + (16 * nt2 + fr) * 72 + 32 + 16 * mt2 + 4 * fq) = w2; }
        }
        __syncthreads();
        { bf16* tq = TQ + ((size_t)(bh * NCHUNK + c)) * 8192;
          const int i = (tid >> 3) & 63, p = tid & 7;
          const u32x4 qkv = *(const LAS u32x4*)(QKp + i * 72 + p * 8);
          const bf16x8 lo = *(const LAS bf16x8*)(Trm + i * 72 + p * 8), up = *(const LAS bf16x8*)(Ttr + 64 * 72 + i * 72 + p * 8); bf16x8 o8;
#pragma unroll
          for (int y = 0; y < 8; ++y) { const int j = p * 8 + y; o8[y] = (i > j) ? lo[y] : (i < j ? up[y] : (short)0x3F80); }
          __syncthreads();
          if (u + 1 < 16) { PG2_STAGEA(u + 1); }
          asm volatile("" ::: "memory");
          *(GAS bf16x8*)(tq + i * 64 + p * 8) = o8; *(GAS u32x4*)(tq + 4096 + i * 64 + p * 8) = qkv;
          if (u + 2 < 16) { PG2_LOAD(u + 2); PG2_LOADS(u + 2); } }
        __syncthreads();
    }
#undef PG2_STAGEA
#undef PG2_LOAD
#undef PG2_LOADS
}

__device__ __forceinline__ void gdn_state_v1(LAS unsigned char* lds, int cid, const bf16* raw, const float* scal, const bf16* TQ,
                                             const float* A_log, const float* dt_bias, bf16* og, int tid, int wave, int lane) {
    using namespace gdn;
    const int dvh = cid & 1, dir = (cid >> 1) & 1, h = (cid >> 2) & 7, b = cid >> 5;
    const int fr = lane & 15, fq = lane >> 4;
    LAS float* sc = (LAS float*)(lds + SC);
    LAS bf16* q_ = (LAS bf16*)(lds + Q); LAS bf16* k_ = (LAS bf16*)(lds + K); LAS bf16* kdT = (LAS bf16*)(lds + KDT); LAS bf16* vT = (LAS bf16*)(lds + VT);
    LAS bf16* T_ = (LAS bf16*)(lds + T); LAS bf16* QKd = (LAS bf16*)(lds + QKD); LAS bf16* ST_ = (LAS bf16*)(lds + ST);
    LAS bf16* rT = (LAS bf16*)(lds + RT); LAS bf16* uT = (LAS bf16*)(lds + UT); LAS float* os = (LAS float*)(lds + OS);
    for (int e = tid; e < 64 * 136 / 2; e += 512) ((LAS unsigned*)ST_)[e] = 0u;
    const float expA = expf(A_log[dir * 8 + h]), dtb = dt_bias[dir * 8 + h];
    f32x4 sacc[4];
#pragma unroll
    for (int nt = 0; nt < 4; ++nt) sacc[nt] = (f32x4){0.f, 0.f, 0.f, 0.f};
    const size_t rowb = (size_t)b * SEQ; const int bh = b * 8 + h;
    __syncthreads();
    for (int n = 0; n < NCHUNK; ++n) {
        const int c = dir ? NCHUNK - 1 - n : n, t0 = c * 64;
        for (int e = tid; e < 64 * 16; e += 512) { const int r = e >> 4, p = e & 15;
            *(LAS u32x4*)(q_ + r * 136 + p * 8) = *(const GAS u32x4*)(raw + (rowb + t0 + r) * CONV_CH + h * 128 + p * 8);
            *(LAS u32x4*)(k_ + r * 136 + p * 8) = *(const GAS u32x4*)(raw + (rowb + t0 + r) * CONV_CH + 1024 + h * 128 + p * 8); }
        { const int dvl = tid >> 3, p = tid & 7; const int dv = dvh * 64 + dvl;
          *(LAS u32x4*)(vT + dvl * 72 + p * 8) = *(const GAS u32x4*)(raw + (rowb + t0 + (dv >> 1)) * CONV_CH + 2048 + h * 128 + (dv & 1) * 64 + p * 8); }
        { const bf16* tq = TQ + ((size_t)(bh * NCHUNK + c)) * 8192;
          for (int e = tid; e < 1024; e += 512) { const int which = e >> 9, i = (e >> 3) & 63, p = e & 7;
              bf16x8 v = *(const GAS bf16x8*)(tq + which * 4096 + i * 64 + p * 8);
#pragma unroll
              for (int x = 0; x < 8; ++x) { const int j = p * 8 + x; const bool keep = dir ? (i < j) : (i > j);
                  if (i == j) { if (which == 0) v[x] = (short)0x3F80; } else if (!keep) v[x] = 0; }
              *(LAS bf16x8*)((which ? QKd : T_) + i * 72 + p * 8) = v; } }
        if (wave == 0) { const int i = lane; const size_t so = (rowb + t0 + i) * 64;
            const float g = -expA * softplus_f(scal[so + 16 + dir * 8 + h] + dtb); float gc = g;
            if (dir == 0) {
#pragma unroll
                for (int o = 1; o < 64; o <<= 1) { const float y = __shfl_up(gc, o); if (i >= o) gc += y; }
            } else {
#pragma unroll
                for (int o = 1; o < 64; o <<= 1) { const float y = __shfl_down(gc, o); if (i + o < 64) gc += y; }
            }
            const float gl = __shfl(gc, dir ? 0 : 63);
            sc[i] = sigmoid_f(scal[so + dir * 8 + h]); sc[64 + i] = gc; sc[128 + i] = expf(gc); sc[192 + i] = expf(gl - gc); if (i == 0) sc[256] = expf(gl); }
        __syncthreads();
        { const int i = tid >> 3, cg = tid & 7; const float ek = sc[192 + i];
          const bf16x8 k0 = *(const LAS bf16x8*)(k_ + i * 136 + cg * 16), k1 = *(const LAS bf16x8*)(k_ + i * 136 + cg * 16 + 8);
#pragma unroll
          for (int x = 0; x < 8; ++x) { kdT[(cg * 16 + x) * 72 + i] = f2bf1(bf2f_s(k0[x]) * ek); kdT[(cg * 16 + 8 + x) * 72 + i] = f2bf1(bf2f_s(k1[x]) * ek); } }
        __syncthreads();
        const int mt = wave & 3, nh = wave >> 2;
        f32x4 aq[2];
        { f32x4 ak[2]; ak[0] = ak[1] = aq[0] = aq[1] = (f32x4){0.f, 0.f, 0.f, 0.f};
          for (int k0 = 0; k0 < 128; k0 += 32) {
              const bf16x8 fk = *(const LAS bf16x8*)(k_ + (mt * 16 + fr) * 136 + k0 + fq * 8), fqv = *(const LAS bf16x8*)(q_ + (mt * 16 + fr) * 136 + k0 + fq * 8);
#pragma unroll
              for (int nl = 0; nl < 2; ++nl) { const bf16x8 fb = *(const LAS bf16x8*)(ST_ + (nh * 32 + nl * 16 + fr) * 136 + k0 + fq * 8);
                  ak[nl] = __builtin_amdgcn_mfma_f32_16x16x32_bf16(fk, fb, ak[nl], 0, 0, 0); aq[nl] = __builtin_amdgcn_mfma_f32_16x16x32_bf16(fqv, fb, aq[nl], 0, 0, 0); } }
          const int i0 = mt * 16 + 4 * fq;
          const f32x4 be4 = *(const LAS f32x4*)(sc + i0), eg4 = *(const LAS f32x4*)(sc + 128 + i0);
#pragma unroll
          for (int nl = 0; nl < 2; ++nl) { const int dv = nh * 32 + nl * 16 + fr;
              const bf16x4 vv = *(const LAS bf16x4*)(vT + dv * 72 + i0);
              float r0 = be4[0] * (bf2f_s(vv[0]) - eg4[0] * ak[nl][0]), r1 = be4[1] * (bf2f_s(vv[1]) - eg4[1] * ak[nl][1]);
              float r2 = be4[2] * (bf2f_s(vv[2]) - eg4[2] * ak[nl][2]), r3 = be4[3] * (bf2f_s(vv[3]) - eg4[3] * ak[nl][3]);
              u32x2 w; w.x = pkbf(r0, r1); w.y = pkbf(r2, r3); *(LAS u32x2*)(rT + dv * 72 + i0) = w;
              aq[nl][0] *= eg4[0]; aq[nl][1] *= eg4[1]; aq[nl][2] *= eg4[2]; aq[nl][3] *= eg4[3]; }
        }
        __syncthreads();
        { f32x4 au[1][2]; au[0][0] = au[0][1] = (f32x4){0.f, 0.f, 0.f, 0.f};
          mma_lds<1, 2>(au, T_, 72, mt * 16, rT, 72, nh * 32, 64, fr, fq);
          const int i0 = mt * 16 + 4 * fq;
#pragma unroll
          for (int nl = 0; nl < 2; ++nl) { const int dv = nh * 32 + nl * 16 + fr; u32x2 w; w.x = pkbf(au[0][nl][0], au[0][nl][1]); w.y = pkbf(au[0][nl][2], au[0][nl][3]); *(LAS u32x2*)(uT + dv * 72 + i0) = w; }
        }
        __syncthreads();
        { f32x4 ao[1][2]; ao[0][0] = aq[0]; ao[0][1] = aq[1];
          mma_lds<1, 2>(ao, QKd, 72, mt * 16, uT, 72, nh * 32, 64, fr, fq);
          const int i0 = mt * 16 + 4 * fq;
#pragma unroll
          for (int nl = 0; nl < 2; ++nl)
#pragma unroll
              for (int r = 0; r < 4; ++r) os[(i0 + r) * 65 + nh * 32 + nl * 16 + fr] = ao[0][nl][r];
          const float egl = sc[256];
          f32x4 as_[1][4];
#pragma unroll
          for (int nt = 0; nt < 4; ++nt) as_[0][nt] = sacc[nt] * egl;
          mma_lds<1, 4>(as_, kdT, 72, wave * 16, uT, 72, 0, 64, fr, fq);
#pragma unroll
          for (int nt = 0; nt < 4; ++nt) { sacc[nt] = as_[0][nt];
              u32x2 w; w.x = pkbf(sacc[nt][0], sacc[nt][1]); w.y = pkbf(sacc[nt][2], sacc[nt][3]); *(LAS u32x2*)(ST_ + (nt * 16 + fr) * 136 + wave * 16 + 4 * fq) = w; }
        }
        __syncthreads();
#pragma unroll
        for (int ii = 0; ii < 4; ++ii) { const int i = wave * 8 + 2 * ii + (lane >> 5), cp = lane & 31;
            atomic_add_bf16x2(og + (rowb + t0 + i) * 1024 + h * 128 + dvh * 64 + 2 * cp, os[i * 65 + 2 * cp], os[i * 65 + 2 * cp + 1]); }
        __syncthreads();
    }
}
typedef float f32x16 __attribute__((ext_vector_type(16)));
typedef short v4i16_t __attribute__((ext_vector_type(4)));
namespace gs2 {
constexpr int KO = 0;
constexpr int QO = KO + 64 * 132 * 2;
constexpr int VTO = QO + 64 * 132 * 2;
constexpr int TO = VTO + 64 * 68 * 2;
constexpr int QKO = TO + 64 * 68 * 2;
constexpr int SCO = QKO + 64 * 68 * 2;
constexpr int BUF = SCO + 1024;
constexpr int OST = 2 * BUF;
constexpr int END = OST + 2 * 64 * 72 * 2;
static_assert(END <= MISC_OFF && BUF % 16 == 0, "gdn state LDS map");
}
__device__ __forceinline__ bf16x8 cvt8(const f32x16& x, int base) {
    u32x4 w; w.x = pkbf(x[base], x[base + 1]); w.y = pkbf(x[base + 2], x[base + 3]); w.z = pkbf(x[base + 4], x[base + 5]); w.w = pkbf(x[base + 6], x[base + 7]);
    return __builtin_bit_cast(bf16x8, w);
}
__device__ __forceinline__ bf16x8 afrag(const LAS bf16* p) {
    const bf16x4 lo = *(const LAS bf16x4*)p, hi = *(const LAS bf16x4*)(p + 8);
    return (bf16x8){lo[0], lo[1], lo[2], lo[3], hi[0], hi[1], hi[2], hi[3]};
}
__device__ __forceinline__ bf16x8 afrag_tr(const LAS bf16* p, int ld) {
    const v4i16_t lo = __builtin_amdgcn_ds_read_tr16_b64_v4i16((LAS v4i16_t*)p), hi = __builtin_amdgcn_ds_read_tr16_b64_v4i16((LAS v4i16_t*)(p + 8 * ld));
    return (bf16x8){lo[0], lo[1], lo[2], lo[3], hi[0], hi[1], hi[2], hi[3]};
}
#define MFMA32(a, b, c) __builtin_amdgcn_mfma_f32_32x32x16_bf16((a), (b), (c), 0, 0, 0)

#ifndef WG_BAR
#define WG_BAR() asm volatile("s_waitcnt lgkmcnt(0)\n\ts_barrier" ::: "memory")
#endif
template <int DIR>
__device__ __forceinline__ void gdn_state2(LAS unsigned char* lds, int b, int h, int half, const bf16* raw, const float* scal, const bf16* TQ,
                                           const float* A_log, const float* dt_bias, bf16* og, int tid, int wave, int lane, float* probe = nullptr) {
    using namespace gs2;
    const size_t rowb = (size_t)b * SEQ; const int bh = b * 8 + h;
    const float expA = expf(A_log[DIR * 8 + h]), dtb = dt_bias[DIR * 8 + h];
    LAS bf16* ost = (LAS bf16*)(lds + OST);
    const int r31 = lane & 31, hh = lane >> 5;
    if (wave == 4 || wave == 5) {
        for (int n = 0; n < NCHUNK + 1; ++n) WG_BAR();
    } else if (wave >= 2) {
        const int hw = (wave & 1) | ((wave >> 2) << 1);
        const int ht = hw * 64 + lane;
        unsigned go[14], lo_[14]; u32x4 ld[14]; float sr0 = 0.f, sr1 = 0.f;
#pragma unroll
        for (int x = 0; x < 4; ++x) { const int e = ht + 256 * x, r = e >> 4, p = e & 15;
            go[x] = (unsigned)((r * CONV_CH + 1024 + h * 128 + p * 8) * 2); go[4 + x] = (unsigned)((r * CONV_CH + h * 128 + p * 8) * 2);
            lo_[x] = (unsigned)(KO + (r * 132 + p * 8) * 2); lo_[4 + x] = (unsigned)(QO + (r * 132 + p * 8) * 2); }
#pragma unroll
        for (int x = 0; x < 2; ++x) { const int e = ht + 256 * x, dvl = e >> 3, p = e & 7; const int dv = 64 * half + dvl;
            go[8 + x] = (unsigned)(((dv >> 1) * CONV_CH + 2048 + h * 128 + (dv & 1) * 64 + p * 8) * 2); lo_[8 + x] = (unsigned)(VTO + (dvl * 68 + p * 8) * 2); }
        u32x4 km[2], dg[2], qm[2];
#pragma unroll
        for (int x = 0; x < 2; ++x) { const int e = ht + 256 * x, i = e >> 3, p = e & 7;
            go[10 + x] = (unsigned)(e * 16); go[12 + x] = (unsigned)(8192 + e * 16);
            lo_[10 + x] = (unsigned)(TO + (i * 68 + p * 8) * 2); lo_[12 + x] = (unsigned)(QKO + (i * 68 + p * 8) * 2);
            unsigned kw[4], dw[4], qw[4];
#pragma unroll
            for (int w = 0; w < 4; ++w) { const int j0 = p * 8 + 2 * w, j1 = j0 + 1;
                const bool k0 = DIR ? (i < j0) : (i > j0), k1 = DIR ? (i < j1) : (i > j1);
                kw[w] = (k0 ? 0xFFFFu : 0u) | (k1 ? 0xFFFF0000u : 0u); dw[w] = (i == j0 ? 0x3F80u : 0u) | (i == j1 ? 0x3F800000u : 0u);
                qw[w] = kw[w] | (i == j0 ? 0xFFFFu : 0u) | (i == j1 ? 0xFFFF0000u : 0u); }
            km[x] = (u32x4){kw[0], kw[1], kw[2], kw[3]}; dg[x] = (u32x4){dw[0], dw[1], dw[2], dw[3]}; qm[x] = (u32x4){qw[0], qw[1], qw[2], qw[3]}; }
        const unsigned so_l = (unsigned)(lane * 256 + (DIR * 8 + h) * 4);
#define GS2_ISSUE(c_) do { const GAS char* rb_ = (const GAS char*)(raw + (rowb + (size_t)(c_) * 64) * CONV_CH); const GAS char* tb_ = (const GAS char*)(TQ + ((size_t)(bh * NCHUNK + (c_))) * 8192); \
            _Pragma("unroll") for (int x = 0; x < 10; ++x) ld[x] = *(const GAS u32x4*)(rb_ + go[x]); \
            _Pragma("unroll") for (int x = 10; x < 14; ++x) ld[x] = *(const GAS u32x4*)(tb_ + go[x]); \
            if (hw == 0) { const GAS char* sb_ = (const GAS char*)(scal + (rowb + (size_t)(c_) * 64) * 64); sr0 = *(const GAS float*)(sb_ + so_l); sr1 = *(const GAS float*)(sb_ + so_l + 64); } } while (0)
#define GS2_ST16(off_, v_) do { LAS unsigned char* d_ = B_ + (off_); *(LAS u32x2*)(d_) = (u32x2){(v_).x, (v_).y}; *(LAS u32x2*)(d_ + 8) = (u32x2){(v_).z, (v_).w}; } while (0)
#define GS2_COMMIT(bi_, c_) do { LAS unsigned char* B_ = lds + (bi_) * BUF; \
            _Pragma("unroll") for (int x = 0; x < 10; ++x) GS2_ST16(lo_[x], ld[x]); \
            _Pragma("unroll") for (int x = 0; x < 2; ++x) { const u32x4 tv = (ld[10 + x] & km[x]) | dg[x], qv = ld[12 + x] & qm[x]; \
                GS2_ST16(lo_[10 + x], tv); GS2_ST16(lo_[12 + x], qv); } \
            if (hw == 0) { LAS float* sc_ = (LAS float*)(B_ + SCO); const int i = lane; const float gc = sr1; const float gl = __shfl(gc, DIR ? 0 : 63); \
                sc_[i] = sr0; sc_[64 + i] = __expf(gc); sc_[128 + i] = __expf(gl - gc); if (i == 0) sc_[192] = __expf(gl); } } while (0)
        { const int c0 = DIR ? NCHUNK - 1 : 0; GS2_ISSUE(c0); GS2_COMMIT(0, c0); GS2_ISSUE((DIR ? c0 - 1 : c0 + 1)); }
        for (int n = 0; n < NCHUNK; ++n) {
            const int c = DIR ? NCHUNK - 1 - n : n;
            WG_BAR();
            const bool more = n + 1 < NCHUNK; const int cn = DIR ? c - 1 : c + 1;
            if (more) { GS2_COMMIT((n + 1) & 1, cn); if (n + 2 < NCHUNK) GS2_ISSUE((DIR ? cn - 1 : cn + 1)); }
            unsigned ov[8];
            if (n > 0) {
#pragma unroll
                for (int x = 0; x < 8; ++x) ov[x] = *(const LAS unsigned*)(ost + ((n - 1) & 1) * (64 * 72) + (hw * 16 + 2 * x + (lane >> 5)) * 72 + 2 * (lane & 31));
            }
            if (n > 0) { const int tp = (DIR ? c + 1 : c - 1) * 64;
#pragma unroll
                for (int x = 0; x < 8; ++x) { GAS char* ob_ = (GAS char*)(og + (rowb + tp + hw * 16 + 2 * x) * 1024 + h * 128 + half * 64);
                    (void)__builtin_amdgcn_global_atomic_fadd_v2bf16((GAS s16x2*)(ob_ + (lane >> 5) * 2048 + (lane & 31) * 4), __builtin_bit_cast(s16x2, ov[x])); } }
        }
        WG_BAR();
        { const int tp = (DIR ? 0 : NCHUNK - 1) * 64;
#pragma unroll
          for (int x = 0; x < 8; ++x) { const unsigned v = *(const LAS unsigned*)(ost + ((NCHUNK - 1) & 1) * (64 * 72) + (hw * 16 + 2 * x + (lane >> 5)) * 72 + 2 * (lane & 31));
              GAS char* ob_ = (GAS char*)(og + (rowb + tp + hw * 16 + 2 * x) * 1024 + h * 128 + half * 64);
              (void)__builtin_amdgcn_global_atomic_fadd_v2bf16((GAS s16x2*)(ob_ + (lane >> 5) * 2048 + (lane & 31) * 4), __builtin_bit_cast(s16x2, v)); } }
#undef GS2_ISSUE
#undef GS2_COMMIT
#undef GS2_ST16
    } else {
        const int dv0 = 32 * wave;
#if defined(PROBE_STATE)
        unsigned long long tw_ = 0ull; const unsigned long long ts0_ = __builtin_amdgcn_s_memtime();
#define PB_BAR() do { const unsigned long long t0_ = __builtin_amdgcn_s_memtime(); WG_BAR(); tw_ += __builtin_amdgcn_s_memtime() - t0_; } while (0)
#else
#define PB_BAR() WG_BAR()
#endif
        f32x16 St[4];
#pragma unroll
        for (int t = 0; t < 4; ++t)
#pragma unroll
            for (int r = 0; r < 16; ++r) St[t][r] = 0.f;
        for (int n = 0; n < NCHUNK; ++n) {
            PB_BAR();
            const LAS unsigned char* Bb = lds + (n & 1) * BUF;
            const LAS bf16* Kb = (const LAS bf16*)(Bb + KO); const LAS bf16* Qb = (const LAS bf16*)(Bb + QO); const LAS bf16* Vb = (const LAS bf16*)(Bb + VTO);
            const LAS bf16* Tb = (const LAS bf16*)(Bb + TO); const LAS bf16* QKb = (const LAS bf16*)(Bb + QKO); const LAS float* sc = (const LAS float*)(Bb + SCO);
            f32x16 aK[2];
#pragma unroll
            for (int m = 0; m < 2; ++m)
#pragma unroll
                for (int r = 0; r < 16; ++r) aK[m][r] = 0.f;
            bf16x8 fa[2][2];
            const int offk = r31 * 132 + 4 * hh;
#define GS2_LD2(P_, bi_, ks_) do { fa[bi_][0] = afrag((P_) + offk + 16 * (ks_)); fa[bi_][1] = afrag((P_) + offk + 32 * 132 + 16 * (ks_)); } while (0)
            GS2_LD2(Kb, 0, 0);
#pragma unroll
            for (int ks = 0; ks < 8; ++ks) {
                if (ks < 7) GS2_LD2(Kb, (ks + 1) & 1, ks + 1);
                __builtin_amdgcn_sched_barrier(0);
                const bf16x8 bs = cvt8(St[ks >> 1], 8 * (ks & 1));
                aK[0] = MFMA32(fa[ks & 1][0], bs, aK[0]); aK[1] = MFMA32(fa[ks & 1][1], bs, aK[1]);
                __builtin_amdgcn_sched_barrier(0); }
            bf16x8 ft[8];
#pragma unroll
            for (int mi = 0; mi < 2; ++mi)
#pragma unroll
                for (int kt = 0; kt < 4; ++kt) { const bool need = DIR ? (kt >= 2 * mi) : (kt <= 2 * mi + 1);
                    if (need) ft[mi * 4 + kt] = afrag(Tb + (32 * mi + r31) * 68 + 16 * kt + 4 * hh); }
#pragma unroll
            for (int m = 0; m < 2; ++m)
#pragma unroll
                for (int q4 = 0; q4 < 4; ++q4) { const int tb = 32 * m + 8 * q4 + 4 * hh;
                    const bf16x4 vv = *(const LAS bf16x4*)(Vb + (dv0 + r31) * 68 + tb); const f32x4 be = *(const LAS f32x4*)(sc + tb), eg = *(const LAS f32x4*)(sc + 64 + tb);
#pragma unroll
                    for (int e = 0; e < 4; ++e) aK[m][4 * q4 + e] = be[e] * (bf2f_s(vv[e]) - eg[e] * aK[m][4 * q4 + e]); }
            const bf16x8 br0 = cvt8(aK[0], 0), br1 = cvt8(aK[0], 8), br2 = cvt8(aK[1], 0), br3 = cvt8(aK[1], 8);
            __builtin_amdgcn_sched_barrier(0);
            f32x16 au[2];
#pragma unroll
            for (int m = 0; m < 2; ++m)
#pragma unroll
                for (int r = 0; r < 16; ++r) au[m][r] = 0.f;
            GS2_LD2(Qb, 0, 0);
#pragma unroll
            for (int mi = 0; mi < 2; ++mi)
#pragma unroll
                for (int kt = 0; kt < 4; ++kt) { const bool need = DIR ? (kt >= 2 * mi) : (kt <= 2 * mi + 1);
                    if (need) au[mi] = MFMA32(ft[mi * 4 + kt], (kt == 0 ? br0 : kt == 1 ? br1 : kt == 2 ? br2 : br3), au[mi]); }
            __builtin_amdgcn_sched_barrier(0);
            f32x16 aQ[2];
#pragma unroll
            for (int m = 0; m < 2; ++m)
#pragma unroll
                for (int r = 0; r < 16; ++r) aQ[m][r] = 0.f;
#pragma unroll
            for (int ks = 0; ks < 8; ++ks) {
                if (ks < 7) GS2_LD2(Qb, (ks + 1) & 1, ks + 1);
                __builtin_amdgcn_sched_barrier(0);
                const bf16x8 bs = cvt8(St[ks >> 1], 8 * (ks & 1));
                aQ[0] = MFMA32(fa[ks & 1][0], bs, aQ[0]); aQ[1] = MFMA32(fa[ks & 1][1], bs, aQ[1]);
                __builtin_amdgcn_sched_barrier(0); }
#undef GS2_LD2
            const bf16x8 bu0 = cvt8(au[0], 0), bu1 = cvt8(au[0], 8), bu2 = cvt8(au[1], 0), bu3 = cvt8(au[1], 8);
#pragma unroll
            for (int m = 0; m < 2; ++m)
#pragma unroll
                for (int q4 = 0; q4 < 4; ++q4) { const int tb = 32 * m + 8 * q4 + 4 * hh; const f32x4 ek = *(const LAS f32x4*)(sc + 128 + tb), eg = *(const LAS f32x4*)(sc + 64 + tb);
#pragma unroll
                    for (int e = 0; e < 4; ++e) { au[m][4 * q4 + e] *= ek[e]; aQ[m][4 * q4 + e] *= eg[e]; } }
            const bf16x8 bd0 = cvt8(au[0], 0), bd1 = cvt8(au[0], 8), bd2 = cvt8(au[1], 0), bd3 = cvt8(au[1], 8);
            __builtin_amdgcn_sched_barrier(0);
            bf16x8 fqk[8];
#pragma unroll
            for (int mi = 0; mi < 2; ++mi)
#pragma unroll
                for (int kt = 0; kt < 4; ++kt) { const bool need = DIR ? (kt >= 2 * mi) : (kt <= 2 * mi + 1);
                    if (need) fqk[mi * 4 + kt] = afrag(QKb + (32 * mi + r31) * 68 + 16 * kt + 4 * hh); }
            const int i16 = r31 & 15; const LAS bf16* kp = Kb + (4 * hh + (i16 >> 2)) * 132 + 16 * (r31 >> 4) + 4 * (i16 & 3);
            bf16x8 fk[2][4];
#define GS2_LDKT(bi_, t_) do { _Pragma("unroll") for (int kt = 0; kt < 4; ++kt) fk[bi_][kt] = afrag_tr(kp + (16 * kt) * 132 + 32 * (t_), 132); } while (0)
            __builtin_amdgcn_sched_barrier(0);
#pragma unroll
            for (int mi = 0; mi < 2; ++mi)
#pragma unroll
                for (int kt = 0; kt < 4; ++kt) { const bool need = DIR ? (kt >= 2 * mi) : (kt <= 2 * mi + 1);
                    if (need) aQ[mi] = MFMA32(fqk[mi * 4 + kt], (kt == 0 ? bu0 : kt == 1 ? bu1 : kt == 2 ? bu2 : bu3), aQ[mi]); }
            GS2_LDKT(0, 0);
            const float egl = sc[192];
#pragma unroll
            for (int mi = 0; mi < 2; ++mi)
#pragma unroll
                for (int r = 0; r < 16; ++r) ost[(n & 1) * (64 * 72) + (32 * mi + (r & 3) + 8 * (r >> 2) + 4 * hh) * 72 + dv0 + r31] = f2bf1(aQ[mi][r]);
#pragma unroll
            for (int t = 0; t < 4; ++t) {
                if (t < 3) GS2_LDKT((t + 1) & 1, t + 1);
                __builtin_amdgcn_sched_barrier(0);
#pragma unroll
                for (int r = 0; r < 16; ++r) St[t][r] *= egl;
                St[t] = MFMA32(fk[t & 1][0], bd0, St[t]); St[t] = MFMA32(fk[t & 1][1], bd1, St[t]);
                St[t] = MFMA32(fk[t & 1][2], bd2, St[t]); St[t] = MFMA32(fk[t & 1][3], bd3, St[t]);
                __builtin_amdgcn_sched_barrier(0); }
#undef GS2_LDKT
        }
        WG_BAR();
#if defined(PROBE_STATE)
        if (blockIdx.x == 0 && tid == 0 && probe) { const unsigned long long tt_ = __builtin_amdgcn_s_memtime() - ts0_; *probe = (float)((double)tw_ / (double)tt_); }
#endif
    }
}
constexpr size_t WS_SSC = 1 * MiB;
namespace psd {
constexpr int CW = 0;
constexpr int SC = CW + 8 * 768 * 4;
constexpr int BM_ = SC + 8 * 4 * 64 * 4;
constexpr int CM_ = BM_ + 64 * 136 * 2;
constexpr int CB = CM_ + 64 * 136 * 2;
constexpr int R = CB + 64 * 68 * 4;
constexpr int RBC = R, RBC_END = R + 70 * 272 * 2;
constexpr int RX = R, XT = RX + 70 * 136 * 2, MM = XT + 128 * 72 * 2, R_END = MM + 2 * 64 * 72 * 2;
constexpr int YST = RX;
constexpr int PRBC = CW + 8 * 768 * 4, PXT = PRBC + 70 * 272 * 2, P_END = PXT + 256 * 72 * 2;
constexpr int STASH = pgd::STASH + 4608;
static_assert(P_END <= pgd::STASH, "prep ssd conv LDS map");
static_assert(RBC_END <= pgd::STASH && R_END <= pgd::STASH && STASH + 9216 <= MISC_OFF, "prep ssd LDS map");
}
__device__ __forceinline__ void prep_ssd_stash(LAS unsigned char* lds, int bid, const bf16* raw, int tid) {
    const int bg = bid >> 5, b = bg >> 1, g = bg & 1, r32 = bid & 31;
    LAS bf16* st = (LAS bf16*)(lds + psd::STASH);
    for (int e = tid; e < 2 * 3 * 96; e += 512) { const int which = e / 288, r = (e % 288) / 96, p = e % 96;
        const int t = which ? (r32 * 4 + 4) * 64 + r : r32 * 4 * 64 - 3 + r;
        const int col = p < 64 ? 3072 + g * 512 + p * 8 : (p < 80 ? 4096 + g * 128 + (p - 64) * 8 : 4352 + g * 128 + (p - 80) * 8);
        u32x4 v = (u32x4){0u, 0u, 0u, 0u};
        if (t >= 0 && t < SEQ) v = *(const GAS u32x4*)(raw + ((size_t)b * SEQ + t) * CONV_CH + col);
        *(LAS u32x4*)(st + which * 2304 + r * 768 + p * 8) = v; }
}
__device__ __forceinline__ void prep_ssd_range(LAS unsigned char* lds, int bid, bf16* raw, const float* conv_w, const float* conv_b, int tid_p,
                                               const float* scal, const float* A_log, const float* dt_bias, float* ssc) {
    using namespace psd;
    const int bg = bid >> 5, b = bg >> 1, g = bg & 1, r32 = bid & 31;
    LAS float* cw = (LAS float*)(lds + CW);
    LAS bf16* rbc = (LAS bf16*)(lds + PRBC); LAS bf16* xT = (LAS bf16*)(lds + PXT);
    LAS bf16* st = (LAS bf16*)(lds + STASH);
    for (int e = tid_p; e < 8 * 768; e += 512) { const int r = e / 768, c = e % 768;
        const int gch = c < 512 ? 3072 + g * 512 + c : (c < 640 ? 4096 + g * 128 + (c - 512) : 4352 + g * 128 + (c - 640));
        cw[e] = r < 7 ? conv_w[r * CONV_CH + gch] : conv_b[gch]; }
    const size_t rowb = (size_t)b * SEQ;
    u32x4 pre[5];
#define PSD_LOAD(u_, ps_) do { const int t0_ = (r32 * 4 + (u_)) * 64; \
        _Pragma("unroll") for (int x = 0; x < 5; ++x) { const int e = tid_p + 512 * x; const int r = e >> 5, p = e & 31; \
            pre[x] = (u32x4){0u, 0u, 0u, 0u}; \
            if (e < 70 * 32 && r >= 3 && !(r >= 67 && (u_) == 3)) { const int col = (ps_) == 0 ? (p < 16 ? 4096 + g * 128 + p * 8 : 4352 + g * 128 + (p - 16) * 8) : 3072 + g * 512 + ((ps_) - 1) * 256 + p * 8; \
                pre[x] = *(const GAS u32x4*)(raw + (rowb + t0_ - 3 + r) * CONV_CH + col); } } } while (0)
    PSD_LOAD(0, 0);
    float sdf[4], sdb[4];
    { const int lane0 = tid_p & 63, wave0 = tid_p >> 6, hd0 = g * 8 + wave0;
#pragma unroll
      for (int u = 0; u < 4; ++u) { const size_t so = (rowb + (size_t)(r32 * 4 + u) * 64 + lane0) * 64; sdf[u] = scal[so + 32 + hd0]; sdb[u] = scal[so + 48 + hd0]; } }
#define PSD_STAGE(u_, scol_) do { _Pragma("unroll") for (int x = 0; x < 5; ++x) { const int e = tid_p + 512 * x; const int r = e >> 5, p = e & 31; \
            if (e < 70 * 32) { u32x4 v = pre[x]; \
                if (r < 3) v = *(const LAS u32x4*)(st + r * 768 + (scol_) + p * 8); \
                else if (r >= 67 && (u_) == 3) v = *(const LAS u32x4*)(st + 2304 + (r - 67) * 768 + (scol_) + p * 8); \
                *(LAS u32x4*)(rbc + r * 272 + (p < 16 ? p * 8 : 136 + (p - 16) * 8)) = v; } } } while (0)
    __syncthreads();
    PSD_STAGE(0, 512);
    PSD_LOAD(0, 1);
    __syncthreads();
#pragma unroll
    for (int u = 0; u < 4; ++u) {
        int tid = tid_p; asm volatile("" : "+v"(tid));
        const int lane = tid & 63, wave = __builtin_amdgcn_readfirstlane(tid >> 6);
        const int c = r32 * 4 + u, t0 = c * 64;
        { const int hd = g * 8 + wave, i = lane;
          const float dtf = softplus_fast(sdf[u] + dt_bias[hd]), dtb = softplus_fast(sdb[u] + dt_bias[16 + hd]);
          const float cf = scan_fwd64(dtf * -expf(A_log[hd]), i), cbk = scan_bwd64(dtb * -expf(A_log[16 + hd]), i);
          float* sp = ssc + ((size_t)((b * 16 + hd) * NCHUNK + c)) * 256 + i; sp[0] = dtf; sp[64] = cf; sp[128] = dtb; sp[192] = cbk; }
        for (int ps = 0; ps < 3; ++ps) {
            const int scol = ps == 0 ? 512 : (ps == 1 ? 0 : 256);
            if (tid < 96) { const int r = tid >> 5, p = tid & 31;
                *(LAS u32x4*)(st + r * 768 + scol + p * 8) = *(const LAS u32x4*)(rbc + (64 + r) * 272 + (p < 16 ? p * 8 : 136 + (p - 16) * 8)); }
            unsigned bcv[16];
            { const int tg = wave, cp = lane; float w[16], o[16];
#pragma unroll
              for (int hf = 0; hf < 2; ++hf) {
#pragma unroll
                  for (int tap = 0; tap < 8; ++tap) { w[2 * tap] = cw[tap * 768 + scol + hf * 128 + 2 * cp]; w[2 * tap + 1] = cw[tap * 768 + scol + hf * 128 + 2 * cp + 1]; }
                  conv_pair8(o, rbc + (8 * tg) * 272 + hf * 136 + 2 * cp, 272, w);
#pragma unroll
                  for (int t = 0; t < 16; ++t) o[t] = silu(o[t]);
#pragma unroll
                  for (int t = 0; t < 8; ++t) bcv[hf * 8 + t] = pkbf(o[2 * t], o[2 * t + 1]);
                  if (ps != 0) {
                      u32x4 e0, e1; e0.x = pkbf(o[0], o[2]); e0.y = pkbf(o[4], o[6]); e0.z = pkbf(o[8], o[10]); e0.w = pkbf(o[12], o[14]);
                      e1.x = pkbf(o[1], o[3]); e1.y = pkbf(o[5], o[7]); e1.z = pkbf(o[9], o[11]); e1.w = pkbf(o[13], o[15]);
                      *(LAS u32x4*)(xT + (hf * 128 + 2 * cp) * 72 + 8 * tg) = e0; *(LAS u32x4*)(xT + (hf * 128 + 2 * cp + 1) * 72 + 8 * tg) = e1; } } }
            __syncthreads();
            const bool lastp = (u == 3 && ps == 2);
            if (!lastp) { if (ps < 2) PSD_STAGE(u, (ps == 0 ? 0 : 256)); else PSD_STAGE(u + 1, 512); }
            asm volatile("" ::: "memory");
            if (ps == 0) {
                const int tg = wave, cp = lane;
#pragma unroll
                for (int hf = 0; hf < 2; ++hf)
#pragma unroll
                    for (int t = 0; t < 8; ++t) *(GAS unsigned*)(raw + (rowb + t0 + 8 * tg + t) * CONV_CH + (hf ? 4352 : 4096) + g * 128 + 2 * cp) = bcv[hf * 8 + t];
            } else {
                for (int e = tid; e < 256 * 8; e += 512) { const int xr = e >> 3, p = e & 7; const int hl = (ps - 1) * 4 + (xr >> 6), pp = xr & 63;
                    *(GAS u32x4*)(raw + (rowb + t0 + pp) * CONV_CH + 3072 + (g * 8 + hl) * 64 + p * 8) = *(const LAS u32x4*)(xT + xr * 72 + p * 8); } }
            if (ps == 0) PSD_LOAD(u, 2); else if (u < 3) { if (ps == 1) PSD_LOAD(u + 1, 0); else PSD_LOAD(u + 1, 1); }
            __syncthreads();
        }
    }
}
#undef PSD_STAGE
#undef PSD_LOAD
__device__ __forceinline__ void ssd_intra_range(LAS unsigned char* lds, int bid, const bf16* raw, const float* ssc, const float* Dp, bf16* yi, int tid_p) {
    using namespace psd;
    const int bg = bid >> 5, b = bg >> 1, g = bg & 1, r32 = bid & 31;
    LAS float* sc = (LAS float*)(lds + SC);
    LAS bf16* Bm = (LAS bf16*)(lds + BM_); LAS bf16* Cm = (LAS bf16*)(lds + CM_); LAS float* cb = (LAS float*)(lds + CB);
    LAS bf16* xT = (LAS bf16*)(lds + XT); LAS bf16* Mm = (LAS bf16*)(lds + MM); LAS bf16* yst = (LAS bf16*)(lds + YST);
    const size_t rowb = (size_t)b * SEQ;
    for (int u = 0; u < 4; ++u) {
        int tid = tid_p; asm volatile("" : "+v"(tid));
        const int lane = tid & 63, wave = __builtin_amdgcn_readfirstlane(tid >> 6), fr = lane & 15, fq = lane >> 4;
        const int c = r32 * 4 + u, t0 = c * 64;
        const int hd_w = g * 8 + wave;
        for (int e = tid; e < 64 * 32; e += 512) { const int r = e >> 5, p = e & 31;
            const u32x4 v = *(const GAS u32x4*)(raw + (rowb + t0 + r) * CONV_CH + (p < 16 ? 4096 + g * 128 + p * 8 : 4352 + g * 128 + (p - 16) * 8));
            *(LAS u32x4*)((p < 16 ? Bm + r * 136 + p * 8 : Cm + r * 136 + (p - 16) * 8)) = v; }
        { const int i = lane; const float* sp = ssc + ((size_t)((b * 16 + hd_w) * NCHUNK + c)) * 256 + i;
          LAS float* s = sc + wave * 256; s[i] = sp[0]; s[64 + i] = sp[64] * 1.4426950408889634f; s[128 + i] = sp[128]; s[192 + i] = sp[192] * 1.4426950408889634f; }
        __syncthreads();
        { const int mt = wave & 3, nh = wave >> 2;
          f32x4 acc[1][2]; acc[0][0] = acc[0][1] = (f32x4){0.f, 0.f, 0.f, 0.f};
          mma_lds<1, 2>(acc, Cm, 136, mt * 16, Bm, 136, nh * 32, 128, fr, fq);
#pragma unroll
          for (int nl = 0; nl < 2; ++nl)
#pragma unroll
              for (int r = 0; r < 4; ++r) cb[(mt * 16 + 4 * fq + r) * 68 + nh * 32 + nl * 16 + fr] = acc[0][nl][r]; }
        for (int hp = 0; hp < 4; ++hp) {
            __syncthreads();
            for (int e = tid; e < 128 * 8; e += 512) { const int xr = e >> 3, p = e & 7; const int hl = 2 * hp + (xr >> 6), pp = xr & 63;
                *(LAS u32x4*)(xT + xr * 72 + p * 8) = *(const GAS u32x4*)(raw + (rowb + t0 + pp) * CONV_CH + 3072 + (g * 8 + hl) * 64 + p * 8); }
            { const int e = tid >> 8, i = (tid >> 2) & 63, jq = tid & 3; const int hl = 2 * hp + e;
              const LAS float* s = sc + hl * 256; const float Dh = Dp[g * 8 + hl];
              const float csfi = s[64 + i], csbi = s[192 + i], dsum = s[i] + s[128 + i];
#pragma unroll
              for (int jj = 0; jj < 16; jj += 2) { float m2[2];
#pragma unroll
                  for (int y = 0; y < 2; ++y) { const int j = jq * 16 + jj + y; const float cbv = cb[i * 68 + j];
                      const float cfj = s[64 + j], cbj = s[192 + j], dfj = s[j], dbj = s[128 + j];
                      const float arg = (i > j) ? csfi - cfj : csbi - cbj;
                      const float dtj = (i > j) ? dfj : dbj;
                      const float w = (i == j) ? dsum : __builtin_amdgcn_exp2f(fminf(arg, 0.f)) * dtj;
                      m2[y] = cbv * w + ((i == j) ? Dh : 0.f); }
                  *(LAS unsigned*)(Mm + (e * 64 + i) * 72 + jq * 16 + jj) = pkbf(m2[0], m2[1]); } }
            __syncthreads();
            { const int e = wave >> 2, mt = wave & 3;
              f32x4 acc[1][4];
#pragma unroll
              for (int nt = 0; nt < 4; ++nt) acc[0][nt] = (f32x4){0.f, 0.f, 0.f, 0.f};
              mma_lds<1, 4>(acc, xT + e * 64 * 72, 72, mt * 16, Mm + e * 64 * 72, 72, 0, 64, fr, fq);
#pragma unroll
              for (int nt = 0; nt < 4; ++nt) { u32x2 w; w.x = pkbf(acc[0][nt][0], acc[0][nt][1]); w.y = pkbf(acc[0][nt][2], acc[0][nt][3]);
                  *(LAS u32x2*)(yst + (nt * 16 + fr) * 136 + e * 64 + mt * 16 + 4 * fq) = w; } }
            __syncthreads();
            for (int e = tid; e < 64 * 16; e += 512) { const int i = e >> 4, p = e & 15;
                *(GAS u32x4*)(yi + (rowb + t0 + i) * 1024 + (g * 8 + 2 * hp) * 64 + p * 8) = *(const LAS u32x4*)(yst + i * 136 + p * 8); }
        }
        __syncthreads();
    }
}

namespace ss2 {
constexpr int CO = 0;
constexpr int BO = CO + 64 * 132 * 2;
constexpr int XO = BO + 64 * 132 * 2;
constexpr int SCO = XO + 64 * 72 * 2;
constexpr int BUF = SCO + 768;
constexpr int OST = 2 * BUF;
constexpr int END = OST + 2 * 64 * 72 * 2;
static_assert(END <= MISC_OFF && BUF % 16 == 0, "ssd state LDS map");
}
template <int DIR>
__device__ __forceinline__ void ssd_state2(LAS unsigned char* lds, int b, int hd, const bf16* raw, const float* ssc, bf16* ys, int tid, int wave, int lane) {
    using namespace ss2;
    const size_t rowb = (size_t)b * SEQ; const int g = hd >> 3;
    LAS bf16* ost = (LAS bf16*)(lds + OST);
    const int r31 = lane & 31, hh = lane >> 5;
    if (wave == 4 || wave == 5) {
        for (int n = 0; n < NCHUNK + 1; ++n) WG_BAR();
    } else if (wave >= 2) {
        const int hw = (wave & 1) | ((wave >> 2) << 1); const int ht = hw * 64 + lane;
        unsigned go[10], lo_[10]; u32x4 ld[10]; float sr0 = 0.f, sr1 = 0.f;
#pragma unroll
        for (int x = 0; x < 4; ++x) { const int e = ht + 256 * x, r = e >> 4, p = e & 15;
            go[x] = (unsigned)((r * CONV_CH + 4352 + g * 128 + p * 8) * 2); go[4 + x] = (unsigned)((r * CONV_CH + 4096 + g * 128 + p * 8) * 2);
            lo_[x] = (unsigned)(CO + (r * 132 + p * 8) * 2); lo_[4 + x] = (unsigned)(BO + (r * 132 + p * 8) * 2); }
#pragma unroll
        for (int x = 0; x < 2; ++x) { const int e = ht + 256 * x, xr = e >> 3, p = e & 7;
            go[8 + x] = (unsigned)((xr * CONV_CH + 3072 + hd * 64 + p * 8) * 2); lo_[8 + x] = (unsigned)(XO + (xr * 72 + p * 8) * 2); }
#define SS2_ISSUE(c_) do { const GAS char* rb_ = (const GAS char*)(raw + (rowb + (size_t)(c_) * 64) * CONV_CH); \
            _Pragma("unroll") for (int x = 0; x < 10; ++x) ld[x] = *(const GAS u32x4*)(rb_ + go[x]); \
            if (hw == 0) { const float* sp_ = ssc + ((size_t)((b * 16 + hd) * NCHUNK + (c_))) * 256 + DIR * 128 + lane; sr0 = sp_[0]; sr1 = sp_[64]; } } while (0)
#define SS2_COMMIT(bi_, c_) do { LAS unsigned char* B_ = lds + (bi_) * BUF; \
            _Pragma("unroll") for (int x = 0; x < 10; ++x) { LAS unsigned char* d_ = B_ + lo_[x]; *(LAS u32x2*)(d_) = (u32x2){ld[x].x, ld[x].y}; *(LAS u32x2*)(d_ + 8) = (u32x2){ld[x].z, ld[x].w}; } \
            if (hw == 0) { LAS float* sc_ = (LAS float*)(B_ + SCO); const int i = lane; const float cs = sr1; const float cl = __shfl(cs, DIR ? 0 : 63); \
                sc_[i] = __expf(cs); sc_[64 + i] = sr0 * __expf(cl - cs); if (i == 0) sc_[128] = __expf(cl); } } while (0)
        { const int c0 = DIR ? NCHUNK - 1 : 0; SS2_ISSUE(c0); SS2_COMMIT(0, c0); SS2_ISSUE((DIR ? c0 - 1 : c0 + 1)); }
        for (int n = 0; n < NCHUNK; ++n) {
            const int c = DIR ? NCHUNK - 1 - n : n;
            WG_BAR();
            const bool more = n + 1 < NCHUNK; const int cn = DIR ? c - 1 : c + 1;
            if (more) { SS2_COMMIT((n + 1) & 1, cn); if (n + 2 < NCHUNK) SS2_ISSUE((DIR ? cn - 1 : cn + 1)); }
            unsigned ov[8];
            if (n > 0) {
#pragma unroll
                for (int x = 0; x < 8; ++x) ov[x] = *(const LAS unsigned*)(ost + ((n - 1) & 1) * (64 * 72) + (hw * 16 + 2 * x + (lane >> 5)) * 72 + 2 * (lane & 31));
            }
            if (n > 0) { const int tp = (DIR ? c + 1 : c - 1) * 64;
#pragma unroll
                for (int x = 0; x < 8; ++x) { GAS char* ob_ = (GAS char*)(ys + (rowb + tp + hw * 16 + 2 * x) * 1024 + hd * 64);
                    (void)__builtin_amdgcn_global_atomic_fadd_v2bf16((GAS s16x2*)(ob_ + (lane >> 5) * 2048 + (lane & 31) * 4), __builtin_bit_cast(s16x2, ov[x])); } }
        }
        WG_BAR();
        { const int tp = (DIR ? 0 : NCHUNK - 1) * 64;
#pragma unroll
          for (int x = 0; x < 8; ++x) { const unsigned v = *(const LAS unsigned*)(ost + ((NCHUNK - 1) & 1) * (64 * 72) + (hw * 16 + 2 * x + (lane >> 5)) * 72 + 2 * (lane & 31));
              GAS char* ob_ = (GAS char*)(ys + (rowb + tp + hw * 16 + 2 * x) * 1024 + hd * 64);
              (void)__builtin_amdgcn_global_atomic_fadd_v2bf16((GAS s16x2*)(ob_ + (lane >> 5) * 2048 + (lane & 31) * 4), __builtin_bit_cast(s16x2, v)); } }
#undef SS2_ISSUE
#undef SS2_COMMIT
    } else {
        const int ps = wave; const int xrow = ps * 32 + r31;
        f32x16 Ht[4];
#pragma unroll
        for (int t = 0; t < 4; ++t)
#pragma unroll
            for (int r = 0; r < 16; ++r) Ht[t][r] = 0.f;
        for (int n = 0; n < NCHUNK; ++n) {
            WG_BAR();
            const LAS unsigned char* Bb = lds + (n & 1) * BUF;
            const LAS bf16* Cb = (const LAS bf16*)(Bb + CO); const LAS bf16* Bmb = (const LAS bf16*)(Bb + BO); const LAS bf16* Xb = (const LAS bf16*)(Bb + XO);
            const LAS float* sc = (const LAS float*)(Bb + SCO);
            f32x16 aY[2];
#pragma unroll
            for (int m = 0; m < 2; ++m)
#pragma unroll
                for (int r = 0; r < 16; ++r) aY[m][r] = 0.f;
            bf16x8 fa[2][2];
            const int offc = r31 * 132 + 4 * hh;
#define SS2_LD2(bi_, ks_) do { fa[bi_][0] = afrag(Cb + offc + 16 * (ks_)); fa[bi_][1] = afrag(Cb + offc + 32 * 132 + 16 * (ks_)); } while (0)
            SS2_LD2(0, 0);
#pragma unroll
            for (int ks = 0; ks < 8; ++ks) {
                if (ks < 7) SS2_LD2((ks + 1) & 1, ks + 1);
                __builtin_amdgcn_sched_barrier(0);
                const bf16x8 bs = cvt8(Ht[ks >> 1], 8 * (ks & 1));
                aY[0] = MFMA32(fa[ks & 1][0], bs, aY[0]); aY[1] = MFMA32(fa[ks & 1][1], bs, aY[1]);
                __builtin_amdgcn_sched_barrier(0); }
#undef SS2_LD2
            const int i16 = r31 & 15; const LAS bf16* bp = Bmb + (8 * hh + (i16 >> 2)) * 132 + 16 * (r31 >> 4) + 4 * (i16 & 3);
            bf16x8 xf[4];
#pragma unroll
            for (int kt = 0; kt < 4; ++kt) { const bf16x8 xv = *(const LAS bf16x8*)(Xb + xrow * 72 + 16 * kt + 8 * hh);
                const f32x4 w0 = *(const LAS f32x4*)(sc + 64 + 16 * kt + 8 * hh), w1 = *(const LAS f32x4*)(sc + 64 + 16 * kt + 8 * hh + 4);
                u32x4 w; w.x = pkbf(bf2f_s(xv[0]) * w0[0], bf2f_s(xv[1]) * w0[1]); w.y = pkbf(bf2f_s(xv[2]) * w0[2], bf2f_s(xv[3]) * w0[3]);
                w.z = pkbf(bf2f_s(xv[4]) * w1[0], bf2f_s(xv[5]) * w1[1]); w.w = pkbf(bf2f_s(xv[6]) * w1[2], bf2f_s(xv[7]) * w1[3]);
                xf[kt] = __builtin_bit_cast(bf16x8, w); }
            bf16x8 fb[2][4];
#define SS2_LDBT(bi_, t_) do { _Pragma("unroll") for (int kt = 0; kt < 4; ++kt) { const LAS bf16* p_ = bp + (16 * kt) * 132 + 32 * (t_); \
                const v4i16_t lo_ = __builtin_amdgcn_ds_read_tr16_b64_v4i16((LAS v4i16_t*)p_), hi_ = __builtin_amdgcn_ds_read_tr16_b64_v4i16((LAS v4i16_t*)(p_ + 4 * 132)); \
                fb[bi_][kt] = (bf16x8){lo_[0], lo_[1], lo_[2], lo_[3], hi_[0], hi_[1], hi_[2], hi_[3]}; } } while (0)
            SS2_LDBT(0, 0);
#pragma unroll
            for (int m = 0; m < 2; ++m)
#pragma unroll
                for (int q4 = 0; q4 < 4; ++q4) { const f32x4 ec = *(const LAS f32x4*)(sc + 32 * m + 8 * q4 + 4 * hh);
#pragma unroll
                    for (int x = 0; x < 4; ++x) aY[m][4 * q4 + x] *= ec[x]; }
            const float ecl = sc[128];
#pragma unroll
            for (int mi = 0; mi < 2; ++mi)
#pragma unroll
                for (int r = 0; r < 16; ++r) ost[(n & 1) * (64 * 72) + (32 * mi + (r & 3) + 8 * (r >> 2) + 4 * hh) * 72 + ps * 32 + r31] = f2bf1(aY[mi][r]);
#pragma unroll
            for (int t = 0; t < 4; ++t) {
                if (t < 3) SS2_LDBT((t + 1) & 1, t + 1);
                __builtin_amdgcn_sched_barrier(0);
#pragma unroll
                for (int r = 0; r < 16; ++r) Ht[t][r] *= ecl;
                Ht[t] = MFMA32(fb[t & 1][0], xf[0], Ht[t]); Ht[t] = MFMA32(fb[t & 1][1], xf[1], Ht[t]);
                Ht[t] = MFMA32(fb[t & 1][2], xf[2], Ht[t]); Ht[t] = MFMA32(fb[t & 1][3], xf[3], Ht[t]);
                __builtin_amdgcn_sched_barrier(0); }
#undef SS2_LDBT
        }
        WG_BAR();
    }
}
#ifndef GS3_LDK
#define GS3_LDK 136
#endif
namespace gs3 {
constexpr int LDK = GS3_LDK, LDT = 72;
constexpr int KO = 0;
constexpr int QO = KO + 64 * LDK * 2;
constexpr int VTO = QO + 64 * LDK * 2;
constexpr int TO = VTO + 64 * LDT * 2;
constexpr int QKO = TO + 64 * LDT * 2;
constexpr int SCO = QKO + 64 * LDT * 2;
constexpr int BUF = SCO + 1024;
constexpr int OST = 2 * BUF;
constexpr int END = OST + 2 * 64 * 72 * 2;
static_assert(END <= MISC_OFF && BUF % 16 == 0, "gdn state3 LDS map");
}
__device__ __forceinline__ bf16x8 pack2(const f32x4& a, const f32x4& b) {
    u32x4 w; w.x = pkbf(a[0], a[1]); w.y = pkbf(a[2], a[3]); w.z = pkbf(b[0], b[1]); w.w = pkbf(b[2], b[3]);
    return __builtin_bit_cast(bf16x8, w);
}
__device__ __forceinline__ bf16x8 afrag16(const LAS bf16* p) {
    const bf16x4 lo = *(const LAS bf16x4*)p, hi = *(const LAS bf16x4*)(p + 16);
    return (bf16x8){lo[0], lo[1], lo[2], lo[3], hi[0], hi[1], hi[2], hi[3]};
}
__device__ __forceinline__ bf16x8 afrag16_tr(const LAS bf16* p, int ld) {
    const v4i16_t lo = __builtin_amdgcn_ds_read_tr16_b64_v4i16((LAS v4i16_t*)p), hi = __builtin_amdgcn_ds_read_tr16_b64_v4i16((LAS v4i16_t*)(p + 16 * ld));
    return (bf16x8){lo[0], lo[1], lo[2], lo[3], hi[0], hi[1], hi[2], hi[3]};
}
#define MFMA16(a, b, c) __builtin_amdgcn_mfma_f32_16x16x32_bf16((a), (b), (c), 0, 0, 0)

constexpr int CW_OFLAG = 16384;
__device__ __forceinline__ void store16_wt(bf16* p, u32x4 v) { asm volatile("global_store_dwordx4 %0, %1, off sc1\n\ts_nop 1" :: "v"(p), "v"(v) : "memory"); }
__device__ __forceinline__ void out_rows(const LAS bf16* ostb, bf16* gbase  , int lane, bool second) {
#pragma unroll
    for (int x = 0; x < 2; ++x) { const int r = 8 * x + (lane >> 3), pc = lane & 7;
        const u32x4 ov = *(const LAS u32x4*)(ostb + r * 72 + pc * 8); bf16* gp = gbase + (size_t)r * 1024 + pc * 8;
        if (!second) store16_wt(gp, ov);
        else { const u32x4 gv = *(const GAS u32x4*)gp; u32x4 o;
            o.x = pkbf(__uint_as_float(ov.x << 16) + __uint_as_float(gv.x << 16), __uint_as_float(ov.x & 0xffff0000u) + __uint_as_float(gv.x & 0xffff0000u));
            o.y = pkbf(__uint_as_float(ov.y << 16) + __uint_as_float(gv.y << 16), __uint_as_float(ov.y & 0xffff0000u) + __uint_as_float(gv.y & 0xffff0000u));
            o.z = pkbf(__uint_as_float(ov.z << 16) + __uint_as_float(gv.z << 16), __uint_as_float(ov.z & 0xffff0000u) + __uint_as_float(gv.z & 0xffff0000u));
            o.w = pkbf(__uint_as_float(ov.w << 16) + __uint_as_float(gv.w << 16), __uint_as_float(ov.w & 0xffff0000u) + __uint_as_float(gv.w & 0xffff0000u));
            *(GAS u32x4*)gp = o; } }
}
__device__ __forceinline__ void out_handshake(unsigned* flags, int mine, int partner, int hw, int lane) {
    asm volatile("s_waitcnt vmcnt(0)" ::: "memory");
    if (lane == 0) { __hip_atomic_store(flags + (mine * 4 + hw) * 16, 1u, __ATOMIC_RELAXED, __HIP_MEMORY_SCOPE_AGENT);
        unsigned sp = 0;
        while (__hip_atomic_load(flags + (partner * 4 + hw) * 16, __ATOMIC_RELAXED, __HIP_MEMORY_SCOPE_AGENT) == 0u) { __builtin_amdgcn_s_sleep(2); if (++sp > (1u << 22)) break; } }
    __builtin_amdgcn_fence(__ATOMIC_ACQUIRE, "agent");
    asm volatile("s_waitcnt vmcnt(0)" ::: "memory");
}

template <int DIR, int XP = 0>
__device__ __forceinline__ void gdn_state3(LAS unsigned char* lds, int b, int h, int half, const bf16* raw, const float* scal, const bf16* TQ, bf16* og, int tid, int wave, int lane, unsigned* flags, int cid) {
    using namespace gs3;
    const size_t rowb = (size_t)b * SEQ; const int bh = b * 8 + h;
    LAS bf16* ost = (LAS bf16*)(lds + OST);
    const int fr = lane & 15, fq = lane >> 4;
    if (wave >= 4) {
        const int hw = wave - 4; const int ht = hw * 64 + lane;
        unsigned go[14], lo_[14]; u32x4 ld[14]; float sr0 = 0.f, sr1 = 0.f;
#pragma unroll
        for (int x = 0; x < 4; ++x) { const int e = ht + 256 * x, r = e >> 4, p = e & 15;
            go[x] = (unsigned)((r * CONV_CH + 1024 + h * 128 + p * 8) * 2); go[4 + x] = (unsigned)((r * CONV_CH + h * 128 + p * 8) * 2);
            lo_[x] = (unsigned)(KO + (r * LDK + p * 8) * 2); lo_[4 + x] = (unsigned)(QO + (r * LDK + p * 8) * 2); }
#pragma unroll
        for (int x = 0; x < 2; ++x) { const int e = ht + 256 * x, dvl = e >> 3, p = e & 7; const int dv = 64 * half + dvl;
            go[8 + x] = (unsigned)(((dv >> 1) * CONV_CH + 2048 + h * 128 + (dv & 1) * 64 + p * 8) * 2); lo_[8 + x] = (unsigned)(VTO + (dvl * LDT + p * 8) * 2); }
        u32x4 km[2], dg[2], qm[2];
#pragma unroll
        for (int x = 0; x < 2; ++x) { const int e = ht + 256 * x, i = e >> 3, p = e & 7;
            go[10 + x] = (unsigned)(e * 16); go[12 + x] = (unsigned)(8192 + e * 16);
            lo_[10 + x] = (unsigned)(TO + (i * LDT + p * 8) * 2); lo_[12 + x] = (unsigned)(QKO + (i * LDT + p * 8) * 2);
            unsigned kw[4], dw[4], qw[4];
#pragma unroll
            for (int w = 0; w < 4; ++w) { const int j0 = p * 8 + 2 * w, j1 = j0 + 1;
                const bool k0 = DIR ? (i < j0) : (i > j0), k1 = DIR ? (i < j1) : (i > j1);
                kw[w] = (k0 ? 0xFFFFu : 0u) | (k1 ? 0xFFFF0000u : 0u); dw[w] = (i == j0 ? 0x3F80u : 0u) | (i == j1 ? 0x3F800000u : 0u);
                qw[w] = kw[w] | (i == j0 ? 0xFFFFu : 0u) | (i == j1 ? 0xFFFF0000u : 0u); }
            km[x] = (u32x4){kw[0], kw[1], kw[2], kw[3]}; dg[x] = (u32x4){dw[0], dw[1], dw[2], dw[3]}; qm[x] = (u32x4){qw[0], qw[1], qw[2], qw[3]}; }
        const unsigned so_l = (unsigned)(lane * 256 + (DIR * 8 + h) * 4);
#define GS3_ISSUE(c_) do { const GAS char* rb_ = (const GAS char*)(raw + (rowb + (size_t)(c_) * 64) * CONV_CH); const GAS char* tb_ = (const GAS char*)(TQ + ((size_t)(bh * NCHUNK + (c_))) * 8192); \
            _Pragma("unroll") for (int x = 0; x < 10; ++x) ld[x] = *(const GAS u32x4*)(rb_ + go[x]); \
            _Pragma("unroll") for (int x = 10; x < 14; ++x) ld[x] = *(const GAS u32x4*)(tb_ + go[x]); \
            if (hw == 0) { const GAS char* sb_ = (const GAS char*)(scal + (rowb + (size_t)(c_) * 64) * 64); sr0 = *(const GAS float*)(sb_ + so_l); sr1 = *(const GAS float*)(sb_ + so_l + 64); } } while (0)
#define GS3_COMMIT(bi_, c_) do { LAS unsigned char* B_ = lds + (bi_) * BUF; \
            _Pragma("unroll") for (int x = 0; x < 10; ++x) *(LAS u32x4*)(B_ + lo_[x]) = ld[x]; \
            _Pragma("unroll") for (int x = 0; x < 2; ++x) { *(LAS u32x4*)(B_ + lo_[10 + x]) = (ld[10 + x] & km[x]) | dg[x]; *(LAS u32x4*)(B_ + lo_[12 + x]) = ld[12 + x] & qm[x]; } \
            if (hw == 0) { LAS float* sc_ = (LAS float*)(B_ + SCO); const int i = lane; const float gc = sr1; const float gl = __shfl(gc, DIR ? 0 : 63); \
                sc_[i] = sr0; sc_[64 + i] = __expf(gc); sc_[128 + i] = __expf(gl - gc); if (i == 0) sc_[192] = __expf(gl); } } while (0)
        { const int c0 = DIR ? NCHUNK - 1 : 0; GS3_ISSUE(c0); GS3_COMMIT(0, c0); GS3_ISSUE((DIR ? c0 - 1 : c0 + 1)); }
        for (int n = 0; n < NCHUNK; ++n) {
            const int c = DIR ? NCHUNK - 1 - n : n;
            WG_BAR();
            const bool more = n + 1 < NCHUNK; const int cn = DIR ? c - 1 : c + 1;
            if (more) { GS3_COMMIT((n + 1) & 1, cn); if (n + 2 < NCHUNK && (!(XP & 2) || n < 2)) GS3_ISSUE((DIR ? cn - 1 : cn + 1)); }
            if (n > 0 && !(XP & 1)) { const int tp = (DIR ? c + 1 : c - 1) * 64;
#pragma unroll
                for (int x = 0; x < 8; ++x) { const unsigned v = *(const LAS unsigned*)(ost + ((n - 1) & 1) * (64 * 72) + (hw * 16 + 2 * x + (lane >> 5)) * 72 + 2 * (lane & 31));
                    GAS char* ob_ = (GAS char*)(og + (rowb + tp + hw * 16 + 2 * x) * 1024 + h * 128 + half * 64);
                    (void)__builtin_amdgcn_global_atomic_fadd_v2bf16((GAS s16x2*)(ob_ + (lane >> 5) * 2048 + (lane & 31) * 4), __builtin_bit_cast(s16x2, v)); } }
        }
        WG_BAR();
        { const int tp = (DIR ? 0 : NCHUNK - 1) * 64;
#pragma unroll
          for (int x = 0; x < 8; ++x) { const unsigned v = *(const LAS unsigned*)(ost + ((NCHUNK - 1) & 1) * (64 * 72) + (hw * 16 + 2 * x + (lane >> 5)) * 72 + 2 * (lane & 31));
              GAS char* ob_ = (GAS char*)(og + (rowb + tp + hw * 16 + 2 * x) * 1024 + h * 128 + half * 64);
              (void)__builtin_amdgcn_global_atomic_fadd_v2bf16((GAS s16x2*)(ob_ + (lane >> 5) * 2048 + (lane & 31) * 4), __builtin_bit_cast(s16x2, v)); } }
#undef GS3_ISSUE
#undef GS3_COMMIT
    } else {
        const int dv0 = 16 * wave;
        f32x4 St[8];
#pragma unroll
        for (int t = 0; t < 8; ++t) St[t] = (f32x4){0.f, 0.f, 0.f, 0.f};
        for (int n = 0; n < NCHUNK; ++n) {
            WG_BAR();
            const LAS unsigned char* Bb = lds + (n & 1) * BUF;
            const LAS bf16* Kb = (const LAS bf16*)(Bb + KO); const LAS bf16* Qb = (const LAS bf16*)(Bb + QO); const LAS bf16* Vb = (const LAS bf16*)(Bb + VTO);
            const LAS bf16* Tb = (const LAS bf16*)(Bb + TO); const LAS bf16* QKb = (const LAS bf16*)(Bb + QKO); const LAS float* sc = (const LAS float*)(Bb + SCO);
            const int offa = fr * LDK + 4 * fq, offt = fr * LDT + 4 * fq;
            bf16x8 bS[4];
#pragma unroll
            for (int ks = 0; ks < 4; ++ks) bS[ks] = pack2(St[2 * ks], St[2 * ks + 1]);
            f32x4 aK[4];
#pragma unroll
            for (int m = 0; m < 4; ++m) aK[m] = (f32x4){0.f, 0.f, 0.f, 0.f};
#pragma unroll
            for (int ks = 0; ks < 4; ++ks) { bf16x8 fa[4];
#pragma unroll
                for (int m = 0; m < 4; ++m) fa[m] = afrag16(Kb + offa + 16 * m * LDK + 32 * ks);
#pragma unroll
                for (int m = 0; m < 4; ++m) aK[m] = MFMA16(fa[m], bS[ks], aK[m]); }
            bf16x8 ft[8];
#pragma unroll
            for (int mi = 0; mi < 4; ++mi)
#pragma unroll
                for (int kt = 0; kt < 2; ++kt) { const bool need = DIR ? (kt >= (mi >> 1)) : (kt <= (mi >> 1));
                    if (need) ft[mi * 2 + kt] = afrag16(Tb + offt + 16 * mi * LDT + 32 * kt); }
#pragma unroll
            for (int m = 0; m < 4; ++m) { const int tb = 16 * m + 4 * fq;
                const bf16x4 vv = *(const LAS bf16x4*)(Vb + (dv0 + fr) * LDT + tb); const f32x4 be = *(const LAS f32x4*)(sc + tb), eg = *(const LAS f32x4*)(sc + 64 + tb);
#pragma unroll
                for (int e = 0; e < 4; ++e) aK[m][e] = be[e] * (bf2f_s(vv[e]) - eg[e] * aK[m][e]); }
            const bf16x8 br0 = pack2(aK[0], aK[1]), br1 = pack2(aK[2], aK[3]);
            f32x4 au[4];
#pragma unroll
            for (int m = 0; m < 4; ++m) au[m] = (f32x4){0.f, 0.f, 0.f, 0.f};
#pragma unroll
            for (int mi = 0; mi < 4; ++mi)
#pragma unroll
                for (int kt = 0; kt < 2; ++kt) { const bool need = DIR ? (kt >= (mi >> 1)) : (kt <= (mi >> 1));
                    if (need) au[mi] = MFMA16(ft[mi * 2 + kt], (kt == 0 ? br0 : br1), au[mi]); }
            f32x4 aQ[4];
            if constexpr (!(XP & 4)) {
#pragma unroll
            for (int m = 0; m < 4; ++m) aQ[m] = (f32x4){0.f, 0.f, 0.f, 0.f};
#pragma unroll
            for (int ks = 0; ks < 4; ++ks) { bf16x8 fa[4];
#pragma unroll
                for (int m = 0; m < 4; ++m) fa[m] = afrag16(Qb + offa + 16 * m * LDK + 32 * ks);
#pragma unroll
                for (int m = 0; m < 4; ++m) aQ[m] = MFMA16(fa[m], bS[ks], aQ[m]); }
            bf16x8 fqk[8];
#pragma unroll
            for (int mi = 0; mi < 4; ++mi)
#pragma unroll
                for (int kt = 0; kt < 2; ++kt) { const bool need = DIR ? (kt >= (mi >> 1)) : (kt <= (mi >> 1));
                    if (need) fqk[mi * 2 + kt] = afrag16(QKb + offt + 16 * mi * LDT + 32 * kt); }
            const bf16x8 bu0 = pack2(au[0], au[1]), bu1 = pack2(au[2], au[3]);
#pragma unroll
            for (int m = 0; m < 4; ++m) { const int tb = 16 * m + 4 * fq; const f32x4 eg = *(const LAS f32x4*)(sc + 64 + tb);
#pragma unroll
                for (int e = 0; e < 4; ++e) { aQ[m][e] *= eg[e]; } }
#pragma unroll
            for (int mi = 0; mi < 4; ++mi)
#pragma unroll
                for (int kt = 0; kt < 2; ++kt) { const bool need = DIR ? (kt >= (mi >> 1)) : (kt <= (mi >> 1));
                    if (need) aQ[mi] = MFMA16(fqk[mi * 2 + kt], (kt == 0 ? bu0 : bu1), aQ[mi]); }
#pragma unroll
            for (int m = 0; m < 4; ++m)
#pragma unroll
                for (int e = 0; e < 4; ++e) ost[(n & 1) * (64 * 72) + (16 * m + 4 * fq + e) * 72 + dv0 + fr] = f2bf1(aQ[m][e]);
            }
#pragma unroll
            for (int m = 0; m < 4; ++m) { const int tb = 16 * m + 4 * fq; const f32x4 ek = *(const LAS f32x4*)(sc + 128 + tb);
#pragma unroll
                for (int e = 0; e < 4; ++e) { au[m][e] *= ek[e]; } }
            const bf16x8 bd0 = pack2(au[0], au[1]), bd1 = pack2(au[2], au[3]);
            const float egl = sc[192];
            { const LAS bf16* kp = Kb + (4 * fq + (fr >> 2)) * LDK + 4 * (fr & 3);
#pragma unroll
              for (int t = 0; t < 8; ++t) { const bf16x8 f0 = afrag16_tr(kp + 16 * t, LDK), f1 = afrag16_tr(kp + 32 * LDK + 16 * t, LDK);
                  St[t] = St[t] * egl; St[t] = MFMA16(f0, bd0, St[t]); St[t] = MFMA16(f1, bd1, St[t]); } }
        }
        WG_BAR();
    }
}

namespace ss3 {
constexpr int LDK = GS3_LDK, LDT = 72;
constexpr int CO = 0;
constexpr int BO = CO + 64 * LDK * 2;
constexpr int XO = BO + 64 * LDK * 2;
constexpr int SCO = XO + 64 * LDT * 2;
constexpr int BUF = SCO + 768;
constexpr int OST = 2 * BUF;
constexpr int END = OST + 2 * 64 * 72 * 2;
static_assert(END <= MISC_OFF && BUF % 16 == 0, "ssd state3 LDS map");
}
template <int DIR, int XP = 0>
__device__ __forceinline__ void ssd_state3(LAS unsigned char* lds, int b, int hd, const bf16* raw, const float* ssc, bf16* ys, int tid, int wave, int lane, unsigned* flags, int cid) {
    using namespace ss3;
    const size_t rowb = (size_t)b * SEQ; const int g = hd >> 3;
    LAS bf16* ost = (LAS bf16*)(lds + OST);
    const int fr = lane & 15, fq = lane >> 4;
    if (wave >= 4) {
        const int hw = wave - 4; const int ht = hw * 64 + lane;
        unsigned go[10], lo_[10]; u32x4 ld[10]; float sr0 = 0.f, sr1 = 0.f;
#pragma unroll
        for (int x = 0; x < 4; ++x) { const int e = ht + 256 * x, r = e >> 4, p = e & 15;
            go[x] = (unsigned)((r * CONV_CH + 4352 + g * 128 + p * 8) * 2); go[4 + x] = (unsigned)((r * CONV_CH + 4096 + g * 128 + p * 8) * 2);
            lo_[x] = (unsigned)(CO + (r * LDK + p * 8) * 2); lo_[4 + x] = (unsigned)(BO + (r * LDK + p * 8) * 2); }
#pragma unroll
        for (int x = 0; x < 2; ++x) { const int e = ht + 256 * x, xr = e >> 3, p = e & 7;
            go[8 + x] = (unsigned)((xr * CONV_CH + 3072 + hd * 64 + p * 8) * 2); lo_[8 + x] = (unsigned)(XO + (xr * LDT + p * 8) * 2); }
#define SS3_ISSUE(c_) do { const GAS char* rb_ = (const GAS char*)(raw + (rowb + (size_t)(c_) * 64) * CONV_CH); \
            _Pragma("unroll") for (int x = 0; x < 10; ++x) ld[x] = *(const GAS u32x4*)(rb_ + go[x]); \
            if (hw == 0) { const float* sp_ = ssc + ((size_t)((b * 16 + hd) * NCHUNK + (c_))) * 256 + DIR * 128 + lane; sr0 = sp_[0]; sr1 = sp_[64]; } } while (0)
#define SS3_COMMIT(bi_, c_) do { LAS unsigned char* B_ = lds + (bi_) * BUF; \
            _Pragma("unroll") for (int x = 0; x < 10; ++x) *(LAS u32x4*)(B_ + lo_[x]) = ld[x]; \
            if (hw == 0) { LAS float* sc_ = (LAS float*)(B_ + SCO); const int i = lane; const float cs = sr1; const float cl = __shfl(cs, DIR ? 0 : 63); \
                sc_[i] = __expf(cs); sc_[64 + i] = sr0 * __expf(cl - cs); if (i == 0) sc_[128] = __expf(cl); } } while (0)
        { const int c0 = DIR ? NCHUNK - 1 : 0; SS3_ISSUE(c0); SS3_COMMIT(0, c0); SS3_ISSUE((DIR ? c0 - 1 : c0 + 1)); }
        for (int n = 0; n < NCHUNK; ++n) {
            const int c = DIR ? NCHUNK - 1 - n : n;
            WG_BAR();
            const bool more = n + 1 < NCHUNK; const int cn = DIR ? c - 1 : c + 1;
            if (more) { SS3_COMMIT((n + 1) & 1, cn); if (n + 2 < NCHUNK && (!(XP & 2) || n < 2)) SS3_ISSUE((DIR ? cn - 1 : cn + 1)); }
            if (n > 0 && !(XP & 1)) { const int tp = (DIR ? c + 1 : c - 1) * 64;
#pragma unroll
                for (int x = 0; x < 8; ++x) { const unsigned v = *(const LAS unsigned*)(ost + ((n - 1) & 1) * (64 * 72) + (hw * 16 + 2 * x + (lane >> 5)) * 72 + 2 * (lane & 31));
                    GAS char* ob_ = (GAS char*)(ys + (rowb + tp + hw * 16 + 2 * x) * 1024 + hd * 64);
                    (void)__builtin_amdgcn_global_atomic_fadd_v2bf16((GAS s16x2*)(ob_ + (lane >> 5) * 2048 + (lane & 31) * 4), __builtin_bit_cast(s16x2, v)); } }
        }
        WG_BAR();
        { const int tp = (DIR ? 0 : NCHUNK - 1) * 64;
#pragma unroll
          for (int x = 0; x < 8; ++x) { const unsigned v = *(const LAS unsigned*)(ost + ((NCHUNK - 1) & 1) * (64 * 72) + (hw * 16 + 2 * x + (lane >> 5)) * 72 + 2 * (lane & 31));
              GAS char* ob_ = (GAS char*)(ys + (rowb + tp + hw * 16 + 2 * x) * 1024 + hd * 64);
              (void)__builtin_amdgcn_global_atomic_fadd_v2bf16((GAS s16x2*)(ob_ + (lane >> 5) * 2048 + (lane & 31) * 4), __builtin_bit_cast(s16x2, v)); } }
#undef SS3_ISSUE
#undef SS3_COMMIT
    } else {
        const int p0 = 16 * wave;
        f32x4 Ht[8];
#pragma unroll
        for (int t = 0; t < 8; ++t) Ht[t] = (f32x4){0.f, 0.f, 0.f, 0.f};
        for (int n = 0; n < NCHUNK; ++n) {
            WG_BAR();
            const LAS unsigned char* Bb = lds + (n & 1) * BUF;
            const LAS bf16* Cb = (const LAS bf16*)(Bb + CO); const LAS bf16* Bmb = (const LAS bf16*)(Bb + BO); const LAS bf16* Xb = (const LAS bf16*)(Bb + XO);
            const LAS float* sc = (const LAS float*)(Bb + SCO);
            const int offa = fr * LDK + 4 * fq;
            f32x4 aY[4];
#pragma unroll
            for (int m = 0; m < 4; ++m) aY[m] = (f32x4){0.f, 0.f, 0.f, 0.f};
#pragma unroll
            for (int ks = 0; ks < 4; ++ks) { const bf16x8 bs = pack2(Ht[2 * ks], Ht[2 * ks + 1]); bf16x8 fa[4];
#pragma unroll
                for (int m = 0; m < 4; ++m) fa[m] = afrag16(Cb + offa + 16 * m * LDK + 32 * ks);
#pragma unroll
                for (int m = 0; m < 4; ++m) aY[m] = MFMA16(fa[m], bs, aY[m]); }
            bf16x8 xf[2];
#pragma unroll
            for (int kt = 0; kt < 2; ++kt) { const bf16x8 xv = *(const LAS bf16x8*)(Xb + (p0 + fr) * LDT + 32 * kt + 8 * fq);
                const f32x4 w0 = *(const LAS f32x4*)(sc + 64 + 32 * kt + 8 * fq), w1 = *(const LAS f32x4*)(sc + 64 + 32 * kt + 8 * fq + 4);
                u32x4 w; w.x = pkbf(bf2f_s(xv[0]) * w0[0], bf2f_s(xv[1]) * w0[1]); w.y = pkbf(bf2f_s(xv[2]) * w0[2], bf2f_s(xv[3]) * w0[3]);
                w.z = pkbf(bf2f_s(xv[4]) * w1[0], bf2f_s(xv[5]) * w1[1]); w.w = pkbf(bf2f_s(xv[6]) * w1[2], bf2f_s(xv[7]) * w1[3]);
                xf[kt] = __builtin_bit_cast(bf16x8, w); }
#pragma unroll
            for (int m = 0; m < 4; ++m) { const f32x4 ec = *(const LAS f32x4*)(sc + 16 * m + 4 * fq);
#pragma unroll
                for (int e = 0; e < 4; ++e) aY[m][e] *= ec[e]; }
            const float ecl = sc[128];
#pragma unroll
            for (int m = 0; m < 4; ++m)
#pragma unroll
                for (int e = 0; e < 4; ++e) ost[(n & 1) * (64 * 72) + (16 * m + 4 * fq + e) * 72 + p0 + fr] = f2bf1(aY[m][e]);
            { const LAS bf16* bp = Bmb + (8 * fq + (fr >> 2)) * LDK + 4 * (fr & 3);
#pragma unroll
              for (int t = 0; t < 8; ++t) {
                  bf16x8 f[2];
#pragma unroll
                  for (int kt = 0; kt < 2; ++kt) { const LAS bf16* p = bp + (32 * kt) * LDK + 16 * t;
                      const v4i16_t lo = __builtin_amdgcn_ds_read_tr16_b64_v4i16((LAS v4i16_t*)p), hi = __builtin_amdgcn_ds_read_tr16_b64_v4i16((LAS v4i16_t*)(p + 4 * LDK));
                      f[kt] = (bf16x8){lo[0], lo[1], lo[2], lo[3], hi[0], hi[1], hi[2], hi[3]}; }
                  Ht[t] = Ht[t] * ecl; Ht[t] = MFMA16(f[0], xf[0], Ht[t]); Ht[t] = MFMA16(f[1], xf[1], Ht[t]); } }
        }
        WG_BAR();
    }
}
#ifndef PG8_SP2_
#define PG8_SP2_ true
#endif
#ifndef MK_ONE_LAUNCH
#define MK_ONE_LAUNCH 1
#endif
constexpr int PPL = 14;
constexpr int NPHASE = 1 + PPL * DEPTH;
struct Args { const float* in[19]; float* out; unsigned char* ws; int ph_lo, ph_hi; };
__global__ void __launch_bounds__(NWAVES * 64, 2) fwd_kernel(Args args) {
    extern __shared__ __attribute__((aligned(16))) unsigned char lds_raw[];
    LAS unsigned char* lds = (LAS unsigned char*)lds_raw;
    unsigned* ctl = (unsigned*)(args.ws + WS_CTL);
    volatile LAS unsigned* MISC = (volatile LAS unsigned*)(lds + MISC_OFF);
    for (int u = threadIdx.x; u < 64; u += 512) MISC[u] = 0u;
    __syncthreads();
#if MK_ONE_LAUNCH
    XcdBarrier bar = xcd_barrier_post(ctl + CW_BAR, MISC + 8);
#define GRID_BAR() do { XcdBarrier bb_ = bar; asm volatile("" : "+s"(bb_.bar), "+s"(bb_.x)); xcd_barrier(bb_); } while (0)
#else
#define GRID_BAR() do {} while (0)
#endif
    const int lo = args.ph_lo, hi = args.ph_hi;
#define WSP(T, off) ((T*)(wsb + (off)))
#if defined(PROBE_STATE) || defined(PROBE_ANY) || defined(PROBE_SUB)
#define PROBE_PTR ((float*)(wsb + WS_CTL) + 2048)
#define PROBE_SCALE (1.0f + sqrtf(8.7e-4f * fminf(fmaxf(*(volatile float*)PROBE_PTR, 0.f), 1.f)))
#else
#define PROBE_PTR ((float*)nullptr)
#define PROBE_SCALE 1.0f
#endif
    for (int ph = lo; ph < hi; ++ph) {
        int tid = threadIdx.x, bid = blockIdx.x, G = gridDim.x;
        const __attribute__((address_space(4))) Args* ap = (const __attribute__((address_space(4))) Args*)__builtin_amdgcn_kernarg_segment_ptr();
        asm volatile("" : "+v"(tid)); asm volatile("" : "+s"(bid), "+s"(G), "+s"(ap));
        unsigned char* wsb = ap->ws;
        const int lane = tid & 63, wave = __builtin_amdgcn_readfirstlane(tid >> 6);
        const int gw = bid * NWAVES + wave, NGW = G * NWAVES, gtid = bid * 512 + tid, NGT = G * 512;
        const int l = (ph == 0) ? 0 : (ph - 1) / PPL; const int k = (ph == 0) ? -1 : (ph - 1) % PPL;
#if defined(PROBE_ANY)
        if (l == PROBE_L && k == PROBE_K0 && blockIdx.x == 0 && threadIdx.x == 0) ((unsigned long long*)(wsb + WS_CTL))[1100] = __builtin_amdgcn_s_memrealtime();
#endif
        switch (k) {
        case -1: {
            cvt_mixer_weights(lds, wsb, ap->in[2], ap->in[12], gw, NGW, wave, lane);
            phase_norm(ap->in[0], ap->in[1], WSP(bf16, WS_XN), gw, NGW, lane);
        } break;
        case 0: {
            pg8::Gemm g{WSP(bf16, WS_XN), WSP(bf16, WS_WA), M, NWA, DM, 0, 0, 0}; pg8::StaticOrder S; S.init(M, NWA, G, bid);
            pg8::EpiRawA E{WSP(bf16, WS_RAW), WSP(float, WS_SCAL)};
            pg8::gemm_phase<pg8::EpiRawA, pg8::StaticOrder, true, PG8_SP2_>(lds, g, S, E);
#if defined(EXP_DUP_GEMM)
            if (l == 0 && (EXP_DUP_GEMM & 1)) { __syncthreads(); pg8::gemm_phase<pg8::EpiRawA, pg8::StaticOrder, true, PG8_SP2_>(lds, g, S, E); }
#endif
        } break;
        case 1: {
            if (l == 1) PB_START(3, wsb);
            prep_gdn_stash(lds, bid, WSP(bf16, WS_RAW), tid); prep_ssd_stash(lds, bid, WSP(bf16, WS_RAW), tid);
            zero_region(wsb + WS_OG, 64 * MiB, gtid, NGT); zero_region(wsb + WS_YS, 64 * MiB, gtid, NGT);
            GRID_BAR();
            if (l == 1) { PB_END(3, wsb); PB_START(1, wsb); }
            prep_gdn_range(lds, bid, WSP(bf16, WS_RAW), WSP(float, WS_SCAL), ap->in[3] + (size_t)l * 7 * CONV_CH, ap->in[4] + (size_t)l * CONV_CH,
                           ap->in[5] + l * 16, ap->in[6] + l * 16, WSP(bf16, WS_TQ), tid, wave, lane, WSP(float, WS_SCAL));
            __syncthreads();
            if (l == 1) { PB_END(1, wsb); PB_START(2, wsb); }
            { int tid2 = threadIdx.x; asm volatile("" : "+v"(tid2));
              prep_ssd_range(lds, bid, WSP(bf16, WS_RAW), ap->in[3] + (size_t)l * 7 * CONV_CH, ap->in[4] + (size_t)l * CONV_CH, tid2,
                             WSP(float, WS_SCAL), ap->in[8] + l * 32, ap->in[9] + l * 32, WSP(float, WS_SSC)); }
            if (l == 1) { __syncthreads(); PB_END(2, wsb); }
        } break;
        case 2: {
#if defined(EXP_DUP_ST)
            for (int c0_ = bid; c0_ < 256 * 2; c0_ += G) {
                const int c = c0_ & 255; const bool dup_ = c0_ >= 256;
                if (dup_ && (l != 0 || ((EXP_DUP_ST == 1) != (c < 128)))) continue;
                bf16* const ogp_ = dup_ ? (bf16*)ap->out : WSP(bf16, WS_OG); bf16* const ysp_ = dup_ ? (bf16*)ap->out : WSP(bf16, WS_YS);
#else
            for (int c = bid; c < 256; c += G) {
                bf16* const ogp_ = WSP(bf16, WS_OG); bf16* const ysp_ = WSP(bf16, WS_YS);
#endif
                int tid = threadIdx.x; asm volatile("" : "+v"(tid));
                const int lane = tid & 63, wave = __builtin_amdgcn_readfirstlane(tid >> 6);
                if (c < 128) { const int x_ = (c & 7) | ((c >> 4) << 3), hf_ = (c >> 3) & 1;
                    const int b_ = x_ >> 4, h_ = (x_ >> 1) & 7;
#if defined(EXP_DUP_ST) && defined(EXP_S2)
                    if (dup_) { if (x_ & 1) gdn_state2<1>(lds, b_, h_, hf_, WSP(bf16, WS_RAW), WSP(float, WS_SCAL), WSP(bf16, WS_TQ), ap->in[5] + l * 16, ap->in[6] + l * 16, ogp_, tid, wave, lane);
                                else        gdn_state2<0>(lds, b_, h_, hf_, WSP(bf16, WS_RAW), WSP(float, WS_SCAL), WSP(bf16, WS_TQ), ap->in[5] + l * 16, ap->in[6] + l * 16, ogp_, tid, wave, lane); } else
#endif
#if defined(EXP_DUP_ST) && defined(EXP_XP)
                    if (dup_) { if (x_ & 1) gdn_state3<1, EXP_XP>(lds, b_, h_, hf_, WSP(bf16, WS_RAW), WSP(float, WS_SCAL), WSP(bf16, WS_TQ), ogp_, tid, wave, lane, nullptr, 0);
                                else        gdn_state3<0, EXP_XP>(lds, b_, h_, hf_, WSP(bf16, WS_RAW), WSP(float, WS_SCAL), WSP(bf16, WS_TQ), ogp_, tid, wave, lane, nullptr, 0); } else
#endif
                    if (x_ & 1) gdn_state3<1>(lds, b_, h_, hf_, WSP(bf16, WS_RAW), WSP(float, WS_SCAL), WSP(bf16, WS_TQ), ogp_, tid, wave, lane, nullptr, 0);
                    else        gdn_state3<0>(lds, b_, h_, hf_, WSP(bf16, WS_RAW), WSP(float, WS_SCAL), WSP(bf16, WS_TQ), ogp_, tid, wave, lane, nullptr, 0); }
                else { const int c2 = c - 128, gi_ = c2 & 15, hl_ = c2 >> 4;
                    const int b_ = gi_ >> 2, hd_ = ((gi_ >> 1) & 1) * 8 + hl_;
#if defined(EXP_DUP_ST) && defined(EXP_XP)
                    if (dup_) { if (gi_ & 1) ssd_state3<1, EXP_XP>(lds, b_, hd_, WSP(bf16, WS_RAW), WSP(float, WS_SSC), ysp_, tid, wave, lane, nullptr, 0);
                                else         ssd_state3<0, EXP_XP>(lds, b_, hd_, WSP(bf16, WS_RAW), WSP(float, WS_SSC), ysp_, tid, wave, lane, nullptr, 0); } else
#endif
                    if (gi_ & 1) ssd_state3<1>(lds, b_, hd_, WSP(bf16, WS_RAW), WSP(float, WS_SSC), ysp_, tid, wave, lane, nullptr, 0);
                    else         ssd_state3<0>(lds, b_, hd_, WSP(bf16, WS_RAW), WSP(float, WS_SSC), ysp_, tid, wave, lane, nullptr, 0); }
                __syncthreads();
            }
        } break;
        case 3: {
            ssd_intra_range(lds, bid, WSP(bf16, WS_RAW), WSP(float, WS_SSC), ap->in[10] + l * 16, WSP(bf16, WS_TQ), tid);
#if defined(EXP_DUP_INTRA)
            if (l == 0) { __syncthreads();
            ssd_intra_range(lds, bid, WSP(bf16, WS_RAW), WSP(float, WS_SSC), ap->in[10] + l * 16, WSP(bf16, WS_TQ), tid);
 }
#endif
        } break;
        case 4: {
            phase_norm((l == 0) ? ap->in[0] : ap->out, ap->in[1] + (size_t)l * DM, WSP(bf16, WS_XN2), gw, NGW, lane);
#if defined(EXP_DUP_B)
            if (l == 0) { __syncthreads();
            phase_norm((l == 0) ? ap->in[0] : ap->out, ap->in[1] + (size_t)l * DM, WSP(bf16, WS_XN2), gw, NGW, lane);
 }
#endif
        } break;
        case 5: {
            pg8::Gemm g{WSP(bf16, WS_XN2), WSP(bf16, WS_WB), M, NGATE, DM, 0, 0, 0}; pg8::StaticOrder S; S.init(M, NGATE, G, bid);
            pg8::EpiBf16 E{WSP(bf16, WS_GATES), NGATE};
            pg8::gemm_phase<pg8::EpiBf16, pg8::StaticOrder, true, PG8_SP2_>(lds, g, S, E);
#if defined(EXP_DUP_GEMM)
            if (l == 0 && (EXP_DUP_GEMM & 2)) { __syncthreads(); pg8::gemm_phase<pg8::EpiBf16, pg8::StaticOrder, true, PG8_SP2_>(lds, g, S, E); }
#endif
        } break;
        case 6: {
            phase_finish(WSP(bf16, WS_OG), WSP(bf16, WS_YS), WSP(bf16, WS_TQ), WSP(bf16, WS_GATES), ap->in[7] + l * 128, ap->in[11] + l * 1024, WSP(bf16, WS_MIXED), gw, NGW, lane);
#if defined(EXP_DUP_B)
            if (l == 0) { __syncthreads();
            phase_finish(WSP(bf16, WS_OG), WSP(bf16, WS_YS), WSP(bf16, WS_TQ), WSP(bf16, WS_GATES), ap->in[7] + l * 128, ap->in[11] + l * 1024, WSP(bf16, WS_MIXED), gw, NGW, lane);
 }
#endif
        } break;
        case 7: {
            pg8::Gemm g{WSP(bf16, WS_MIXED), WSP(bf16, WS_WO), M, DM, 2048, 0, 0, 0}; pg8::StaticOrder S; S.init(M, DM, G, bid);
            pg8::EpiResid E{(l == 0) ? ap->in[0] : ap->out, ap->out, DM};
            pg8::gemm_phase<pg8::EpiResid, pg8::StaticOrder, true, PG8_SP2_>(lds, g, S, E);
#if defined(EXP_DUP_GEMM)
            if (l == 0 && (EXP_DUP_GEMM & 4)) { __syncthreads(); pg8::gemm_phase<pg8::EpiResid, pg8::StaticOrder, true, PG8_SP2_>(lds, g, S, E); }
#endif
        } break;
        case 8: {
            phase_norm2_router(lds, ap->out, ap->in[13] + l * DM, ap->in[14] + (size_t)l * DM * 16, WSP(bf16, WS_XN), WSP(float, WS_AFF), gw, NGW, tid, lane);
#if defined(EXP_DUP_A) || defined(EXP_DUP_N2)
            if (l == 0) { __syncthreads();
            phase_norm2_router(lds, ap->out, ap->in[13] + l * DM, ap->in[14] + (size_t)l * DM * 16, WSP(bf16, WS_XN), WSP(float, WS_AFF), gw, NGW, tid, lane);
            __syncthreads();
            cvt_expert_weights(lds, wsb, ap->in[15] + (size_t)l * NEXP * DM * EFF, ap->in[16] + (size_t)l * NEXP * DM * EFF, ap->in[17] + (size_t)l * NEXP * EFF * DM, gw, NGW, wave, lane);
            if (l + 1 < DEPTH) cvt_mixer_weights(lds, wsb, ap->in[2] + (size_t)(l + 1) * DM * 6720, ap->in[12] + (size_t)(l + 1) * 2048 * DM, gw, NGW, wave, lane);
 }
#endif
        } break;
        case 9: {
            if (bid < NB * NEXP) phase_topk(lds, WSP(float, WS_AFF), WSP(int, WS_IDX), WSP(float, WS_VAL), WSP(int, WS_INV), bid, tid, wave, lane);
            else if (G > NB * NEXP) { const int gw2 = (bid - NB * NEXP) * NWAVES + wave, NGW2 = (G - NB * NEXP) * NWAVES;
                cvt_expert_weights(lds, wsb, ap->in[15] + (size_t)l * NEXP * DM * EFF, ap->in[16] + (size_t)l * NEXP * DM * EFF, ap->in[17] + (size_t)l * NEXP * EFF * DM, gw2, NGW2, wave, lane);
                if (l + 1 < DEPTH) cvt_mixer_weights(lds, wsb, ap->in[2] + (size_t)(l + 1) * DM * 6720, ap->in[12] + (size_t)(l + 1) * 2048 * DM, gw2, NGW2, wave, lane); }
#if defined(EXP_DUP_A) || defined(EXP_DUP_TK)
            if (l == 0) { __syncthreads();
            for (int be = bid; be < NB * NEXP; be += G) phase_topk(lds, WSP(float, WS_AFF), WSP(int, WS_IDX), WSP(float, WS_VAL), WSP(int, WS_INV), be, tid, wave, lane);
 }
#endif
        } break;
        case 10: {
            phase_gather(WSP(bf16, WS_XN), WSP(int, WS_IDX), WSP(bf16, WS_XG), gw, NGW, lane);
#if defined(EXP_DUP_A) || defined(EXP_DUP_GA)
            if (l == 0) { __syncthreads();
            phase_gather(WSP(bf16, WS_XN), WSP(int, WS_IDX), WSP(bf16, WS_XG), gw, NGW, lane);
 }
#endif
        } break;
        case 11: {
            pg8::Gemm g{WSP(bf16, WS_XG), WSP(bf16, WS_WGU), MEXP, 1024, DM, 2, 15, (size_t)1024 * 1024 * 2}; pg8::StaticOrder S; S.init(MEXP, 1024, G, bid);
            pg8::EpiSwiglu E{WSP(bf16, WS_HMID), EFF};
            pg8::gemm_phase<pg8::EpiSwiglu, pg8::StaticOrder, true, PG8_SP2_>(lds, g, S, E);
#if defined(EXP_DUP_GEMM)
            if (l == 0 && (EXP_DUP_GEMM & 8)) { __syncthreads(); pg8::gemm_phase<pg8::EpiSwiglu, pg8::StaticOrder, true, PG8_SP2_>(lds, g, S, E); }
#endif
        } break;
        case 12: {
            pg8::Gemm g{WSP(bf16, WS_HMID), WSP(bf16, WS_WD), MEXP, 1024, EFF, 2, 15, (size_t)1024 * 512 * 2}; pg8::StaticOrder S; S.init(MEXP, 1024, G, bid);
            pg8::EpiBf16 E{WSP(bf16, WS_XG), 1024};
            pg8::gemm_phase<pg8::EpiBf16, pg8::StaticOrder, true, PG8_SP2_>(lds, g, S, E);
#if defined(EXP_DUP_GEMM)
            if (l == 0 && (EXP_DUP_GEMM & 16)) { __syncthreads(); pg8::gemm_phase<pg8::EpiBf16, pg8::StaticOrder, true, PG8_SP2_>(lds, g, S, E); }
#endif
        } break;
        default: {
            const bool last = (l + 1 == DEPTH);
            phase_combine(ap->out, ap->out, WSP(bf16, WS_XG), WSP(int, WS_INV), WSP(float, WS_VAL), last ? ap->in[18] : ap->in[1] + (size_t)(l + 1) * DM, WSP(bf16, WS_XN), last, gw, NGW, lane, PROBE_SCALE);

        } break;
        }
        if (ph + 1 < hi) GRID_BAR();
#if defined(EXP_XBAR)
        if (ph == 1) for (int xb_ = 0; xb_ < EXP_XBAR; ++xb_) GRID_BAR();
#endif
#if defined(PROBE_ANY)
        if (l == PROBE_L && k == PROBE_K1 && blockIdx.x == 0 && threadIdx.x == 0) { const unsigned long long t1_ = __builtin_amdgcn_s_memrealtime(), t0_ = ((unsigned long long*)(wsb + WS_CTL))[1100];
            const unsigned bk_ = (unsigned)((t1_ - t0_) / PROBE_TICKS); *(volatile float*)PROBE_PTR = (float)(bk_ > 40u ? 40u : bk_) * (1.0f / 40.0f); }
#endif
    }
#undef WSP
}

extern "C" void kernel_launch(void* const* d_in, const int* in_sizes, int n_in, void* d_out, int out_size, void* d_ws, size_t ws_size, hipStream_t stream) {
    static int grid = 0;
    if (grid == 0) {
        if (n_in != 19 || in_sizes[0] != M * DM || out_size != M * DM || ws_size < WS_END) { fprintf(stderr, "kernel_launch: unexpected shapes (n_in %d, in0 %d, out %d, ws %zu); nothing launched\n", n_in, n_in > 0 ? in_sizes[0] : -1, out_size, ws_size); grid = -1; return; }
        int dev = 0, cus = 0;
        if (hipGetDevice(&dev) != hipSuccess || hipDeviceGetAttribute(&cus, hipDeviceAttributeMultiprocessorCount, dev) != hipSuccess) { grid = -1; return; }
        if (hipFuncSetAttribute((const void*)fwd_kernel, hipFuncAttributeMaxDynamicSharedMemorySize, LDS_BYTES) != hipSuccess) { fprintf(stderr, "kernel_launch: hipFuncSetAttribute failed\n"); grid = -1; return; }
        (void)hipGetLastError();
        grid = cus;
    }
    if (grid < 0) return;
    (void)hipMemsetAsync((char*)d_ws + WS_CTL, 0, CTL_ZERO_BYTES, stream);
    Args a{};
    for (int i = 0; i < 19; ++i) a.in[i] = (const float*)d_in[i];
    a.out = (float*)d_out; a.ws = (unsigned char*)d_ws;
#if MK_ONE_LAUNCH
    a.ph_lo = 0; a.ph_hi = NPHASE;
    hipLaunchKernelGGL(fwd_kernel, dim3(grid), dim3(NWAVES * 64), LDS_BYTES, stream, a);
#else
    for (int p = 0; p < NPHASE; ++p) { a.ph_lo = p; a.ph_hi = p + 1; hipLaunchKernelGGL(fwd_kernel, dim3(grid), dim3(NWAVES * 64), LDS_BYTES, stream, a); }
#endif
}
```

```cpp
#include <hip/hip_runtime.h>
#include <cstdio>
#include <cstdint>
namespace pg8 {
#define PG8_LAS __attribute__((address_space(3)))
typedef unsigned short bf16_t;
typedef short bf16x8 __attribute__((ext_vector_type(8)));
typedef float f32x4 __attribute__((ext_vector_type(4)));
typedef unsigned u32x4 __attribute__((ext_vector_type(4)));
constexpr int BM = 256, BK = 64, HALF = 128, HTB = HALF * BK * 2  , STAGE_BYTES = 8 * HTB, NXCD = 8, WGM = 8;

__host__ __device__ __forceinline__ int lds_byte(int r, int c) { const int st = (r >> 4) * 2 + (c >> 5), rr = r & 15, cc = c & 31, ob = rr * 64 + cc * 2; return st * 1024 + (ob ^ (((ob >> 9) & 1) << 5)); }
__host__ __device__ __forceinline__ void stage_rc(int b, int& R, int& C) { const int st = b / 1024, sb = b % 1024, swz = sb ^ (((sb >> 9) & 1) << 5); R = (st >> 1) * 16 + swz / 64; C = (st & 1) * 32 + (swz % 64) / 2; }
__host__ __device__ __forceinline__ int perm32(int rho) { const int n = rho >> 4, i = rho & 15; return 8 * (i >> 2) + 4 * n + (i & 3); }

struct Unit { int pm, pn; };
struct Gemm { const bf16_t* A; const bf16_t* Bt; int M, N, K; int bshift, bmask; size_t bstride; const int* gidx = nullptr; int gshift = 0, gmul = 0;
    __device__ __forceinline__ size_t grp_off(int pm) const { return (size_t)((pm >> bshift) & bmask) * bstride; } };

struct StaticOrder {
    int nM, nN, nwg, G, c;
    __host__ __device__ void init(int M, int N, int G_, int c_) { nM = M / BM; nN = N / BM; nwg = nM * nN; G = G_; c = c_; }
    __host__ __device__ bool next(int i, Unit& u) const {
        const long L = (long)i * G + c; if (L >= nwg) return false;
        int wgid = (int)L; { const int q = nwg / NXCD, r = nwg % NXCD, xcd = wgid % NXCD, off = wgid / NXCD; wgid = (xcd < r ? xcd * (q + 1) : r * (q + 1) + (xcd - r) * q) + off; }
        const int nig = WGM * nN, gid = wgid / nig, fm = gid * WGM, gsz = (nM - fm) < WGM ? (nM - fm) : WGM;
        u.pm = fm + ((wgid % nig) % gsz); u.pn = (wgid % nig) / gsz; return true;
    }
    __device__ __forceinline__ void a_ready(const Unit&) const {}
    __device__ __forceinline__ void done(const Unit&) const {}
};

__device__ __forceinline__ unsigned cvt_pk_bf16(float lo, float hi) { unsigned r; asm volatile("v_cvt_pk_bf16_f32 %0, %1, %2" : "=v"(r) : "v"(lo), "v"(hi)); return r; }
__device__ __forceinline__ float silu_f(float x) { return x * __builtin_amdgcn_rcpf(1.0f + __builtin_amdgcn_exp2f(-1.4426950408889634f * x)); }
struct EpiBf16 {
    static constexpr bool PERM = true, AFTER_DRAIN = false;
    bf16_t* O; int ldc;
    __device__ __forceinline__ void operator()(const f32x4 (&acc)[2][2][4][2], const Unit& u, int wr, int wc, int fr, int fq) const {
        const int row0 = u.pm * BM + wr * 64 + fr; const int col0 = u.pn * BM + wc * 32 + 8 * fq;
#pragma unroll
        for (int ai = 0; ai < 2; ++ai)
#pragma unroll
            for (int m = 0; m < 4; ++m) { bf16_t* rowp = O + (size_t)(row0 + ai * HALF + m * 16) * ldc + col0;
#pragma unroll
                for (int bj = 0; bj < 2; ++bj) { const f32x4 v0 = acc[ai][bj][m][0], v1 = acc[ai][bj][m][1];
                    u32x4 w; w.x = cvt_pk_bf16(v0[0], v0[1]); w.y = cvt_pk_bf16(v0[2], v0[3]); w.z = cvt_pk_bf16(v1[0], v1[1]); w.w = cvt_pk_bf16(v1[2], v1[3]);
                    *(u32x4*)(rowp + bj * HALF) = w; } }
    }
};
struct EpiRawA {
    static constexpr bool PERM = true, AFTER_DRAIN = false;
    bf16_t* O; float* S;
    __device__ __forceinline__ void operator()(const f32x4 (&acc)[2][2][4][2], const Unit& u, int wr, int wc, int fr, int fq) const {
        const int row0 = u.pm * BM + wr * 64 + fr;
        if (u.pn < 18) {
            const int col0 = u.pn * BM + wc * 32 + 8 * fq;
#pragma unroll
            for (int ai = 0; ai < 2; ++ai)
#pragma unroll
                for (int m = 0; m < 4; ++m) { bf16_t* rowp = O + (size_t)(row0 + ai * HALF + m * 16) * 4608 + col0;
#pragma unroll
                    for (int bj = 0; bj < 2; ++bj) { const f32x4 v0 = acc[ai][bj][m][0], v1 = acc[ai][bj][m][1];
                        u32x4 w; w.x = cvt_pk_bf16(v0[0], v0[1]); w.y = cvt_pk_bf16(v0[2], v0[3]); w.z = cvt_pk_bf16(v1[0], v1[1]); w.w = cvt_pk_bf16(v1[2], v1[3]);
                        *(u32x4*)(rowp + bj * HALF) = w; } }
        } else if (wc < 2) {
            const int col0 = wc * 32 + 8 * fq;
#pragma unroll
            for (int ai = 0; ai < 2; ++ai)
#pragma unroll
                for (int m = 0; m < 4; ++m) { float* sp = S + (size_t)(row0 + ai * HALF + m * 16) * 64 + col0;
                    *(f32x4*)sp = acc[ai][0][m][0]; *(f32x4*)(sp + 4) = acc[ai][0][m][1]; }
        }
    }
};
struct EpiResid {
    static constexpr bool PERM = false, AFTER_DRAIN = false;
    const float* base; float* out; int ldc;
    __device__ __forceinline__ void operator()(const f32x4 (&acc)[2][2][4][2], const Unit& u, int wr, int wc, int fr, int fq) const {
        const int row0 = u.pm * BM + wr * 64 + fr, col0 = u.pn * BM + wc * 32 + 4 * fq;
#pragma unroll
        for (int ai = 0; ai < 2; ++ai)
#pragma unroll
            for (int mp = 0; mp < 2; ++mp) { f32x4 rv[2][2][2];
#pragma unroll
                for (int mm = 0; mm < 2; ++mm) { const size_t off = (size_t)(row0 + ai * HALF + (2 * mp + mm) * 16) * ldc + col0;
#pragma unroll
                    for (int bj = 0; bj < 2; ++bj)
#pragma unroll
                        for (int n = 0; n < 2; ++n) rv[mm][bj][n] = *(const f32x4*)(base + off + bj * HALF + n * 16); }
                asm volatile("" ::: "memory");
#pragma unroll
                for (int mm = 0; mm < 2; ++mm) { const size_t off = (size_t)(row0 + ai * HALF + (2 * mp + mm) * 16) * ldc + col0;
#pragma unroll
                    for (int bj = 0; bj < 2; ++bj)
#pragma unroll
                        for (int n = 0; n < 2; ++n) *(f32x4*)(out + off + bj * HALF + n * 16) = rv[mm][bj][n] + acc[ai][bj][2 * mp + mm][n]; }
                asm volatile("" ::: "memory"); }
    }
};
struct EpiSwiglu {
    static constexpr bool PERM = true, AFTER_DRAIN = false;
    bf16_t* O; int ldh;
    __device__ __forceinline__ void operator()(const f32x4 (&acc)[2][2][4][2], const Unit& u, int wr, int wc, int fr, int fq) const {
        const int row0 = u.pm * BM + wr * 64 + fr; const int f0 = (u.pn * BM + wc * 32 + 8 * fq) >> 1;
        typedef unsigned u32x2 __attribute__((ext_vector_type(2)));
#pragma unroll
        for (int ai = 0; ai < 2; ++ai)
#pragma unroll
            for (int m = 0; m < 4; ++m) { bf16_t* rowp = O + (size_t)(row0 + ai * HALF + m * 16) * ldh + f0;
#pragma unroll
                for (int bj = 0; bj < 2; ++bj) { const f32x4 v0 = acc[ai][bj][m][0], v1 = acc[ai][bj][m][1];
                    u32x2 w; w.x = cvt_pk_bf16(silu_f(v0[0]) * v0[1], silu_f(v0[2]) * v0[3]); w.y = cvt_pk_bf16(silu_f(v1[0]) * v1[1], silu_f(v1[2]) * v1[3]);
                    *(u32x2*)(rowp + bj * (HALF / 2)) = w; } }
    }
};
template <class Epi, class Sched, bool ALIGN_EPI = false, bool SP2 = false, bool GATHER = false>
__device__ __forceinline__ void gemm_phase(PG8_LAS unsigned char* lds, const Gemm g, const Sched& S, const Epi& E) {
    int tid_o = threadIdx.x; asm volatile("" : "+v"(tid_o));
    const int tid = tid_o, wid = __builtin_amdgcn_readfirstlane(tid >> 6), lane = tid & 63, wr = wid >> 2, wc = wid & 3, fr = lane & 15, fq = lane >> 4;
    const int K = g.K, nt = K / BK;
    unsigned voffA[2], voffB[2];
#pragma unroll
    for (int i = 0; i < 2; ++i) { int R, C; stage_rc(tid * 16 + i * 8192, R, C); const int Rb = Epi::PERM ? ((R & ~31) + perm32(R & 31)) : R;
        voffA[i] = (unsigned)(R * K + C) * 2u; voffB[i] = (unsigned)(Rb * K + C) * 2u; }
    const size_t kstep = (size_t)(BK * 2);
    const size_t hstep = (size_t)HALF * K * 2;
    const size_t tstep = 2 * hstep;
    const size_t hstepA = GATHER ? (size_t)0 : hstep, tstepA = GATHER ? (size_t)0 : tstep;
    unsigned gC[2][2]; int gI[2][2];
    auto g_load = [&](const Unit& u) { _Pragma("unroll") for (int h = 0; h < 2; ++h) _Pragma("unroll") for (int i = 0; i < 2; ++i) { int R, C; stage_rc(tid * 16 + i * 8192, R, C);
        gI[h][i] = g.gidx[u.pm * BM + h * HALF + R]; } };
    auto g_make = [&](const Unit& u, unsigned (&o)[2][2]) { _Pragma("unroll") for (int h = 0; h < 2; ++h) _Pragma("unroll") for (int i = 0; i < 2; ++i) { int R, C; stage_rc(tid * 16 + i * 8192, R, C);
        const int row = u.pm * BM + h * HALF + R; o[h][i] = (unsigned)(((row >> g.gshift) * g.gmul + gI[h][i]) * K + C) * 2u; } };
    const unsigned ldsw = (unsigned)wid * 1024u;
    const int aoff = lds_byte(wr * 64 + fr, fq * 8), boff = lds_byte(wc * 32 + fr, fq * 8);
#define PG8_SA(b, h) (((b) * 2 + (h)) * HTB)
#define PG8_SB(b, h) ((4 + (b) * 2 + (h)) * HTB)
#define PG8_STAGE(bufoff, gbase, voff) do { _Pragma("unroll") for (int _i = 0; _i < 2; ++_i) \
        __builtin_amdgcn_global_load_lds((const unsigned*)((const char*)(gbase) + (voff)[_i]), (PG8_LAS unsigned*)(lds + (bufoff) + ldsw + _i * 8192), 16, 0, 0); } while (0)
#define PG8_LDA(dst, b, h) do { _Pragma("unroll") for (int m = 0; m < 4; ++m) _Pragma("unroll") for (int k = 0; k < 2; ++k) dst[m][k] = *(const PG8_LAS bf16x8*)(lds + PG8_SA(b, h) + aoff + m * 2048 + k * 1024); } while (0)
#define PG8_LDB(dst, b, h) do { _Pragma("unroll") for (int n = 0; n < 2; ++n) _Pragma("unroll") for (int k = 0; k < 2; ++k) dst[n][k] = *(const PG8_LAS bf16x8*)(lds + PG8_SB(b, h) + boff + n * 2048 + k * 1024); } while (0)
#define PG8_MMA(ai, bj, At, Bt) do { __builtin_amdgcn_s_setprio(1); _Pragma("unroll") for (int m = 0; m < 4; ++m) _Pragma("unroll") for (int n = 0; n < 2; ++n) _Pragma("unroll") for (int k = 0; k < 2; ++k) \
        acc[ai][bj][m][n] = __builtin_amdgcn_mfma_f32_16x16x32_bf16(Bt[n][k], At[m][k], acc[ai][bj][m][n], 0, 0, 0); __builtin_amdgcn_s_setprio(0); } while (0)
#define PG8_WAIT_V(n) asm volatile("s_waitcnt vmcnt(" #n ")" ::: "memory")
#define PG8_WAIT_L(n) asm volatile("s_waitcnt lgkmcnt(" #n ")" ::: "memory")
#define PG8_BAR __builtin_amdgcn_s_barrier()
#define PG8_SCHED __builtin_amdgcn_sched_barrier(0)
    Unit cur, nxt; int ui = 0;
    if (!S.next(0, cur)) return;
    f32x4 acc[2][2][4][2];
#pragma unroll
    for (int a = 0; a < 2; ++a)
#pragma unroll
        for (int b = 0; b < 2; ++b)
#pragma unroll
            for (int m = 0; m < 4; ++m)
#pragma unroll
                for (int n = 0; n < 2; ++n) acc[a][b][m][n] = (f32x4){0.f, 0.f, 0.f, 0.f};
    bf16x8 At[4][2], B0[2][2], B1[2][2];
    const char* cA = (const char*)g.A + (size_t)cur.pm * tstepA; const char* cB = (const char*)g.Bt + g.grp_off(cur.pm) + (size_t)cur.pn * tstep;
    if constexpr (GATHER) { g_load(cur); g_make(cur, gC); }
#define PG8_VA(h) (GATHER ? gC[h] : voffA)
    S.a_ready(cur);
    if constexpr (SP2) {
        PG8_STAGE(PG8_SB(0, 0), cB, voffB); PG8_STAGE(PG8_SB(0, 1), cB + hstep, voffB); PG8_STAGE(PG8_SA(0, 0), cA, PG8_VA(0)); PG8_STAGE(PG8_SA(0, 1), cA + hstepA, PG8_VA(1));
        if (wr == 1) PG8_BAR;
        PG8_WAIT_V(2); PG8_BAR;
        PG8_STAGE(PG8_SB(1, 0), cB + kstep, voffB); PG8_STAGE(PG8_SA(1, 0), cA + kstep, PG8_VA(0)); PG8_STAGE(PG8_SB(1, 1), cB + hstep + kstep, voffB);
        PG8_WAIT_V(6); PG8_BAR;
    } else {
        PG8_STAGE(PG8_SB(0, 0), cB, voffB); PG8_STAGE(PG8_SA(0, 0), cA, PG8_VA(0)); PG8_STAGE(PG8_SB(0, 1), cB + hstep, voffB); PG8_STAGE(PG8_SA(0, 1), cA + hstepA, PG8_VA(1));
        if (wr == 1) PG8_BAR;
        PG8_WAIT_V(4); PG8_BAR;
        PG8_STAGE(PG8_SB(1, 0), cB + kstep, voffB); PG8_STAGE(PG8_SA(1, 0), cA + kstep, PG8_VA(0)); PG8_STAGE(PG8_SB(1, 1), cB + hstep + kstep, voffB);
        PG8_WAIT_V(6); PG8_BAR;
    }
    for (;;) {
        const bool has_next = S.next(ui + 1, nxt);
        const char* nA = has_next ? (const char*)g.A + (size_t)nxt.pm * tstepA : cA; const char* nB = has_next ? (const char*)g.Bt + g.grp_off(nxt.pm) + (size_t)nxt.pn * tstep : cB;
        if constexpr (GATHER) { if (has_next) g_load(nxt); }
        for (int t = 0; t < nt; t += 2) {
            const bool last = (t == nt - 2);
            const char* a1 = cA + (size_t)(t + 1) * kstep;
            const char* a2 = last ? nA : cA + (size_t)(t + 2) * kstep; const char* b2 = last ? nB : cB + (size_t)(t + 2) * kstep;
            const char* a3 = a2 + kstep; const char* b3 = b2 + kstep;
            if (last && has_next) S.a_ready(nxt);
#define PG8_GS() do { if constexpr (GATHER) { if (last && has_next) g_make(nxt, gC); } } while (0)
            if constexpr (SP2) {
            PG8_LDB(B0, 0, 0); PG8_LDB(B1, 0, 1); PG8_SCHED; PG8_LDA(At, 0, 0); PG8_STAGE(PG8_SA(1, 1), a1 + hstepA, PG8_VA(1)); PG8_GS();
            PG8_WAIT_V(8); PG8_WAIT_L(0); PG8_BAR; PG8_MMA(0, 0, At, B0); PG8_MMA(0, 1, At, B1); PG8_BAR; PG8_SCHED;
            PG8_LDA(At, 0, 1); PG8_STAGE(PG8_SB(0, 0), b2, voffB); PG8_STAGE(PG8_SB(0, 1), b2 + hstep, voffB); PG8_STAGE(PG8_SA(0, 0), a2, PG8_VA(0));
            PG8_WAIT_V(8); PG8_WAIT_L(0); PG8_BAR; PG8_MMA(1, 0, At, B0); PG8_MMA(1, 1, At, B1); PG8_BAR; PG8_SCHED;
            PG8_LDB(B0, 1, 0); PG8_LDB(B1, 1, 1); PG8_SCHED; PG8_LDA(At, 1, 0); PG8_STAGE(PG8_SA(0, 1), a2 + hstepA, PG8_VA(1));
            PG8_WAIT_V(8); PG8_WAIT_L(0); PG8_BAR; PG8_MMA(0, 0, At, B0); PG8_MMA(0, 1, At, B1); PG8_BAR; PG8_SCHED;
            PG8_LDA(At, 1, 1); PG8_STAGE(PG8_SB(1, 0), b3, voffB); PG8_STAGE(PG8_SB(1, 1), b3 + hstep, voffB); PG8_STAGE(PG8_SA(1, 0), a3, PG8_VA(0));
            PG8_WAIT_V(8); PG8_WAIT_L(0); PG8_BAR; PG8_MMA(1, 0, At, B0); PG8_MMA(1, 1, At, B1); PG8_BAR; PG8_SCHED;
            } else {
            PG8_LDB(B0, 0, 0); PG8_SCHED; PG8_LDA(At, 0, 0); PG8_STAGE(PG8_SA(1, 1), a1 + hstepA, PG8_VA(1)); PG8_GS();
            PG8_WAIT_L(8); PG8_BAR; PG8_WAIT_L(0); PG8_MMA(0, 0, At, B0); PG8_BAR; PG8_SCHED;
            PG8_LDB(B1, 0, 1); PG8_STAGE(PG8_SB(0, 0), b2, voffB);
            PG8_BAR; PG8_WAIT_L(0); PG8_MMA(0, 1, At, B1); PG8_BAR;
            PG8_LDA(At, 0, 1); PG8_STAGE(PG8_SA(0, 0), a2, PG8_VA(0));
            PG8_BAR; PG8_WAIT_L(0); PG8_MMA(1, 0, At, B0); PG8_BAR; PG8_SCHED;
            PG8_STAGE(PG8_SB(0, 1), b2 + hstep, voffB);
            PG8_WAIT_V(6); PG8_BAR; PG8_MMA(1, 1, At, B1); PG8_BAR;
            PG8_LDB(B0, 1, 0); PG8_SCHED; PG8_LDA(At, 1, 0); PG8_STAGE(PG8_SA(0, 1), a2 + hstepA, PG8_VA(1));
            PG8_WAIT_L(8); PG8_BAR; PG8_WAIT_L(0); PG8_MMA(0, 0, At, B0); PG8_BAR; PG8_SCHED;
            PG8_LDB(B1, 1, 1); PG8_STAGE(PG8_SB(1, 0), b3, voffB);
            PG8_BAR; PG8_WAIT_L(0); PG8_MMA(0, 1, At, B1); PG8_BAR;
            PG8_LDA(At, 1, 1); PG8_STAGE(PG8_SA(1, 0), a3, PG8_VA(0));
            PG8_BAR; PG8_WAIT_L(0); PG8_MMA(1, 0, At, B0); PG8_BAR; PG8_SCHED;
            PG8_STAGE(PG8_SB(1, 1), b3 + hstep, voffB);
            PG8_WAIT_V(6); PG8_BAR; PG8_MMA(1, 1, At, B1); PG8_BAR;
            }
        }
        if constexpr (ALIGN_EPI) { if (wr == 0) PG8_BAR; }
        if constexpr (!Epi::AFTER_DRAIN) { E(acc, cur, wr, wc, fr, fq); S.done(cur); }
        if (!has_next) break;
#pragma unroll
        for (int a = 0; a < 2; ++a)
#pragma unroll
            for (int b = 0; b < 2; ++b)
#pragma unroll
                for (int m = 0; m < 4; ++m)
#pragma unroll
                    for (int n = 0; n < 2; ++n) acc[a][b][m][n] = (f32x4){0.f, 0.f, 0.f, 0.f};
        cur = nxt; cA = nA; cB = nB; ++ui;
        if constexpr (ALIGN_EPI) { if (wr == 1) PG8_BAR; }
    }
    PG8_WAIT_V(0);
    if constexpr (!ALIGN_EPI) { if (wr == 0) PG8_BAR; }
    PG8_BAR;
    if constexpr (Epi::AFTER_DRAIN) { E.fused(acc, cur, wr, wc, fr, fq, lds, wid, lane); S.done(cur); }
#undef PG8_SA
#undef PG8_VA
#undef PG8_GS
#undef PG8_SB
#undef PG8_STAGE
#undef PG8_LDA
#undef PG8_LDB
#undef PG8_MMA
#undef PG8_WAIT_V
#undef PG8_WAIT_L
#undef PG8_BAR
#undef PG8_SCHED
}
}
#define GAS __attribute__((address_space(1)))
#define LAS __attribute__((address_space(3)))
typedef unsigned short bf16;
typedef unsigned v4u __attribute__((ext_vector_type(4)));
typedef float f32x4 __attribute__((ext_vector_type(4)));
typedef short bf16x8 __attribute__((ext_vector_type(8)));
typedef GAS unsigned gu32;
typedef GAS unsigned long long gu64;
#define RLX_AGENT __ATOMIC_RELAXED, __HIP_MEMORY_SCOPE_AGENT
#define LDS_WAIT() asm volatile("s_waitcnt lgkmcnt(0)" ::: "memory")
#define VM_WAIT() asm volatile("s_waitcnt vmcnt(0)" ::: "memory")
__device__ __forceinline__ unsigned long long rt() { return __builtin_amdgcn_s_memrealtime(); }
__device__ __forceinline__ unsigned f2bf(float f) { unsigned u = __builtin_bit_cast(unsigned, f); return (u + 0x7fffu + ((u >> 16) & 1u)) >> 16; }
__device__ __forceinline__ unsigned pk2(float lo, float hi) { return f2bf(lo) | (f2bf(hi) << 16); }
#define XB_TMO      128
#define XB_XCNT(j)  (256  + 64 * (j))
#define XB_XSUB(j)  (1280 + 64 * (j))
#define XB_XGEN(j)  (2304 + 64 * (j))
#define XB_TOP      3328
#define XB_TOPGEN   3392
#define XCD_BAR_WORDS 3456
#define XB_SPIN_CAP (1u << 18)

__device__ __forceinline__ unsigned xb_ld(unsigned* p)              { return __hip_atomic_load(p, __ATOMIC_RELAXED, __HIP_MEMORY_SCOPE_AGENT); }
__device__ __forceinline__ unsigned xb_add(unsigned* p, unsigned v) { return __hip_atomic_fetch_add(p, v, __ATOMIC_RELAXED, __HIP_MEMORY_SCOPE_AGENT); }
__device__ __forceinline__ unsigned xb_xcc_id() { return (unsigned)__builtin_amdgcn_s_getreg((3 << 11) | 20) & 0xFu; }
#define XB_SPIN(cond, bar) do { unsigned _sp = 0; while (cond) { __builtin_amdgcn_s_sleep(1); \
    if ((++_sp & 255u) == 0u) { if (xb_ld(&(bar)[XB_TMO])) break; if (_sp > XB_SPIN_CAP) { atomicAdd(&(bar)[XB_TMO], 1u); break; } } } } while (0)

struct XcdBarrier {
    unsigned* bar; unsigned x;
    volatile LAS unsigned* st;
};

__device__ __forceinline__ XcdBarrier xcd_barrier_post(unsigned* bar, volatile LAS unsigned* st) {
    XcdBarrier b; b.bar = bar; b.x = xb_xcc_id(); b.st = st;
    if (threadIdx.x == 0) (void)xb_add(&bar[XB_XCNT(b.x)], 1u);
    return b;
}
__device__ __forceinline__ void xcd_barrier_complete(unsigned* bar, unsigned x, unsigned& nloc, unsigned& nx) {
    const unsigned G = gridDim.x * gridDim.y * gridDim.z;
    unsigned sum, cnt, mine, sp = 0u;
    for (;;) {
        sum = 0u; cnt = 0u; mine = 0u;
#pragma unroll
        for (unsigned j = 0; j < 16; ++j) { const unsigned c = xb_ld(&bar[XB_XCNT(j)]); sum += c; cnt += (c > 0u) ? 1u : 0u; mine = (j == x) ? c : mine; }
        if (sum == G) break;
        __builtin_amdgcn_s_sleep(1);
        if ((++sp & 255u) == 0u) { if (xb_ld(&bar[XB_TMO])) break; if (sp > XB_SPIN_CAP) { atomicAdd(&bar[XB_TMO], 1u); break; } }
    }
    nloc = mine > 0u ? mine : 1u; nx = cnt > 0u ? cnt : 1u;
}

__device__ __forceinline__ void xcd_barrier(const XcdBarrier& b) {
    asm volatile("s_waitcnt vmcnt(0)" ::: "memory");
    __syncthreads();
    if (threadIdx.x == 0) {
        unsigned* bar = b.bar;
        __builtin_amdgcn_s_waitcnt(0);
        unsigned nloc = b.st[0], nx = b.st[1];
        if (nloc == 0u) { xcd_barrier_complete(bar, b.x, nloc, nx); b.st[0] = nloc; b.st[1] = nx; }
        const unsigned old = xb_add(&bar[XB_XSUB(b.x)], 1u);
        const unsigned gen = old / nloc;
        if (old + 1u == (gen + 1u) * nloc) {
            __builtin_amdgcn_fence(__ATOMIC_RELEASE, "agent");
            asm volatile("s_waitcnt vmcnt(0)" ::: "memory");
            const unsigned og = xb_add(&bar[XB_TOP], 1u);
            const unsigned tg = og / nx;
            if (og + 1u == (tg + 1u) * nx) xb_add(&bar[XB_TOPGEN], 1u);
            else XB_SPIN(xb_ld(&bar[XB_TOPGEN]) == tg, bar);
            __builtin_amdgcn_fence(__ATOMIC_ACQUIRE, "agent");
            xb_add(&bar[XB_XGEN(b.x)], 1u);
            asm volatile("s_waitcnt vmcnt(0)" ::: "memory");
        } else {
            XB_SPIN(xb_ld(&bar[XB_XGEN(b.x)]) == gen, bar);
            __builtin_amdgcn_fence(__ATOMIC_ACQUIRE, "agent");
            asm volatile("s_waitcnt vmcnt(0)" ::: "memory");
        }
    }
    __syncthreads();
}
constexpr int NB = 4, SEQ = 8192, DM = 1024, M = NB * SEQ, DEPTH = 2;
constexpr int NCHUNK = SEQ / 64;
constexpr int CONV_CH = 4608, NWA = 4864  , NGATE = 2048, NEXP = 16, EFF = 512, CAP = 1024;
constexpr int MEXP = NB * NEXP * CAP;
constexpr float EPS = 1e-6f;
constexpr int NWAVES = 8;
constexpr size_t MiB = 1u << 20;
constexpr size_t WS_CTL = 0, CTL_ZERO_BYTES = 1 * MiB;
constexpr size_t WS_WA = 1 * MiB;
constexpr size_t WS_WB = 11 * MiB;
constexpr size_t WS_WO = 15 * MiB;
constexpr size_t WS_XN = 19 * MiB;
constexpr size_t WS_RAW = 83 * MiB;
constexpr size_t WS_SCAL = 371 * MiB;
constexpr size_t WS_OG = 19 * MiB;
constexpr size_t WS_YS = 443 * MiB;
constexpr size_t WS_XN2 = 83 * MiB;
constexpr size_t WS_GATES = 147 * MiB;
constexpr size_t WS_MIXED = 147 * MiB;
constexpr size_t WS_WGU = 83 * MiB;
constexpr size_t WS_WD = 115 * MiB;
constexpr size_t WS_XG = 131 * MiB;
constexpr size_t WS_HMID = 259 * MiB;
constexpr size_t WS_AFF = 323 * MiB;
constexpr size_t WS_IDX = 325 * MiB;
constexpr size_t WS_VAL = 326 * MiB;
constexpr size_t WS_INV = 327 * MiB;
constexpr size_t WS_END = 507 * MiB;
constexpr int CW_TMO = 0, CW_BAR = 4096;
constexpr int LDS_BYTES = 163840;
constexpr int MISC_OFF = LDS_BYTES - 256;

typedef short bf16x8 __attribute__((ext_vector_type(8)));
typedef short bf16x4 __attribute__((ext_vector_type(4)));
typedef float f32x4 __attribute__((ext_vector_type(4)));
typedef float f32x2 __attribute__((ext_vector_type(2)));
typedef unsigned u32x4 __attribute__((ext_vector_type(4)));
typedef unsigned u32x2 __attribute__((ext_vector_type(2)));
typedef __bf16 bf16x2_t __attribute__((ext_vector_type(2)));
typedef short s16x2 __attribute__((ext_vector_type(2)));

__device__ __forceinline__ float bf2f(unsigned short v) { return __uint_as_float((unsigned)v << 16); }
__device__ __forceinline__ float bf2f_s(short v) { return __uint_as_float((unsigned)(unsigned short)v << 16); }
__device__ __forceinline__ unsigned pkbf(float lo, float hi) { f32x2 v = {lo, hi}; bf16x2_t b = __builtin_convertvector(v, bf16x2_t); return __builtin_bit_cast(unsigned, b); }
__device__ __forceinline__ unsigned short f2bf1(float f) { return (unsigned short)(pkbf(f, 0.f) & 0xffffu); }
__device__ __forceinline__ float silu(float x) { return x * __builtin_amdgcn_rcpf(1.0f + __builtin_amdgcn_exp2f(-1.4426950408889634f * x)); }
__device__ __forceinline__ float softplus_f(float x) { return x > 20.f ? x : log1pf(expf(x)); }
__device__ __forceinline__ float sigmoid_f(float x) { return 1.0f / (1.0f + expf(-x)); }
__device__ __forceinline__ void atomic_add_bf16x2(bf16* p, float a, float b) {
    (void)__builtin_amdgcn_global_atomic_fadd_v2bf16((GAS s16x2*)p, __builtin_bit_cast(s16x2, pkbf(a, b)));
}
template <int CTRL> __device__ __forceinline__ float dppf(float v) { return __builtin_bit_cast(float, __builtin_amdgcn_update_dpp(0, __builtin_bit_cast(int, v), CTRL, 0xF, 0xF, true)); }
__device__ __forceinline__ float wave_sum(float v) {
    v += dppf<0xB1>(v); v += dppf<0x4E>(v); v += dppf<0x141>(v); v += dppf<0x140>(v);
    const float s0 = __builtin_bit_cast(float, __builtin_amdgcn_readlane(__builtin_bit_cast(int, v), 0)), s1 = __builtin_bit_cast(float, __builtin_amdgcn_readlane(__builtin_bit_cast(int, v), 16));
    const float s2 = __builtin_bit_cast(float, __builtin_amdgcn_readlane(__builtin_bit_cast(int, v), 32)), s3 = __builtin_bit_cast(float, __builtin_amdgcn_readlane(__builtin_bit_cast(int, v), 48));
    return (s0 + s1) + (s2 + s3);
}

__device__ __forceinline__ float softplus_fast(float x) { const float e = __builtin_amdgcn_exp2f(1.4426950408889634f * fminf(x, 20.f));
    const float lg = (e < 1e-3f) ? e * (1.0f - 0.5f * e) : 0.6931471805599453f * __builtin_amdgcn_logf(1.0f + e); return x > 20.f ? x : lg; }
__device__ __forceinline__ float sigmoid_fast(float x) { return __builtin_amdgcn_rcpf(1.0f + __builtin_amdgcn_exp2f(-1.4426950408889634f * x)); }
__device__ __forceinline__ float scan_fwd64(float v, int lane) {
    v += dppf<0x111>(v); v += dppf<0x112>(v); v += dppf<0x114>(v); v += dppf<0x118>(v);
    const float t0 = __builtin_bit_cast(float, __builtin_amdgcn_readlane(__builtin_bit_cast(int, v), 15)), t1 = __builtin_bit_cast(float, __builtin_amdgcn_readlane(__builtin_bit_cast(int, v), 31));
    const float t2 = __builtin_bit_cast(float, __builtin_amdgcn_readlane(__builtin_bit_cast(int, v), 47));
    const int row = lane >> 4; return v + (row == 0 ? 0.f : row == 1 ? t0 : row == 2 ? t0 + t1 : (t0 + t1) + t2);
}
__device__ __forceinline__ float scan_bwd64(float v, int lane) {
    v += dppf<0x101>(v); v += dppf<0x102>(v); v += dppf<0x104>(v); v += dppf<0x108>(v);
    const float t1 = __builtin_bit_cast(float, __builtin_amdgcn_readlane(__builtin_bit_cast(int, v), 16)), t2 = __builtin_bit_cast(float, __builtin_amdgcn_readlane(__builtin_bit_cast(int, v), 32));
    const float t3 = __builtin_bit_cast(float, __builtin_amdgcn_readlane(__builtin_bit_cast(int, v), 48));
    const int row = lane >> 4; return v + (row == 3 ? 0.f : row == 2 ? t3 : row == 1 ? t3 + t2 : (t3 + t2) + t1);
}

template <int CTRL> __device__ __forceinline__ int dppi(int v) { return __builtin_amdgcn_update_dpp(0, v, CTRL, 0xF, 0xF, true); }
__device__ __forceinline__ int scan_fwd64_i(int v, int lane) {
    v += dppi<0x111>(v); v += dppi<0x112>(v); v += dppi<0x114>(v); v += dppi<0x118>(v);
    const int t0 = __builtin_amdgcn_readlane(v, 15), t1 = __builtin_amdgcn_readlane(v, 31), t2 = __builtin_amdgcn_readlane(v, 47);
    const int row = lane >> 4; return v + (row == 0 ? 0 : row == 1 ? t0 : row == 2 ? t0 + t1 : t0 + t1 + t2);
}
template <int MT, int NT>
__device__ __forceinline__ void mma_lds(f32x4 (&acc)[MT][NT], const LAS bf16* A, int lda, int m0, const LAS bf16* Bt, int ldb, int n0, int K, int fr, int fq) {
    for (int k0 = 0; k0 < K; k0 += 32) {
        bf16x8 a[MT], b[NT];
#pragma unroll
        for (int mt = 0; mt < MT; ++mt) a[mt] = *(const LAS bf16x8*)(A + (m0 + mt * 16 + fr) * lda + k0 + fq * 8);
#pragma unroll
        for (int nt = 0; nt < NT; ++nt) b[nt] = *(const LAS bf16x8*)(Bt + (n0 + nt * 16 + fr) * ldb + k0 + fq * 8);
#pragma unroll
        for (int mt = 0; mt < MT; ++mt)
#pragma unroll
            for (int nt = 0; nt < NT; ++nt) acc[mt][nt] = __builtin_amdgcn_mfma_f32_16x16x32_bf16(a[mt], b[nt], acc[mt][nt], 0, 0, 0);
    }
}

__device__ __forceinline__ void conv16(float (&acc)[16], const LAS bf16* src, int ld, const LAS float* cw, int cwld) {
#pragma unroll
    for (int c = 0; c < 16; ++c) acc[c] = cw[7 * cwld + c];
#pragma unroll
    for (int tap = 0; tap < 7; ++tap) {
        const bf16x8 x0 = *(const LAS bf16x8*)(src + tap * ld), x1 = *(const LAS bf16x8*)(src + tap * ld + 8);
        const LAS float* w = cw + tap * cwld;
#pragma unroll
        for (int c = 0; c < 8; ++c) { acc[c] += bf2f_s(x0[c]) * w[c]; acc[8 + c] += bf2f_s(x1[c]) * w[8 + c]; }
        if (tap & 1) asm volatile("" ::: "memory");
    }
}
__device__ __forceinline__ void conv8(float (&acc)[8], const LAS bf16* src, int ld, const LAS float* cw, int cwld) {
#pragma unroll
    for (int c = 0; c < 8; ++c) acc[c] = cw[7 * cwld + c];
#pragma unroll
    for (int tap = 0; tap < 7; ++tap) {
        const bf16x8 x0 = *(const LAS bf16x8*)(src + tap * ld);
        const LAS float* w = cw + tap * cwld;
#pragma unroll
        for (int c = 0; c < 8; ++c) acc[c] += bf2f_s(x0[c]) * w[c];
        if (tap & 1) asm volatile("" ::: "memory");
    }
}

#if defined(PROBE_SUB)
#define PB_START(id_, ws_) do { if ((id_) == PROBE_SUB && blockIdx.x == 0 && threadIdx.x == 0) ((unsigned long long*)(ws_))[1100] = __builtin_amdgcn_s_memrealtime(); } while (0)
#define PB_END(id_, ws_) do { if ((id_) == PROBE_SUB && blockIdx.x == 0 && threadIdx.x == 0) { const unsigned long long t1_ = __builtin_amdgcn_s_memrealtime(), t0_ = ((unsigned long long*)(ws_))[1100]; \
        const unsigned bk_ = (unsigned)((t1_ - t0_) / PROBE_TICKS); *((volatile float*)(ws_) + 2048) = (float)(bk_ > 40u ? 40u : bk_) * (1.0f / 40.0f); } } while (0)
#else
#define PB_START(id_, ws_) do {} while (0)
#define PB_END(id_, ws_) do {} while (0)
#endif
__device__ __forceinline__ void transpose_item(const float* W, int K, int N, int k0, int n0, bf16* WT, int drow0, int rmul, LAS float* scr, int lane) {
    f32x4 v[16];
#pragma unroll
    for (int i = 0; i < 16; ++i) { const int kk = 4 * i + (lane >> 4); v[i] = *(const GAS f32x4*)(W + (size_t)(k0 + kk) * N + n0 + 4 * (lane & 15)); }
#pragma unroll
    for (int i = 0; i < 16; ++i) { const int kk = 4 * i + (lane >> 4); LAS float* d = scr + kk * 65 + 4 * (lane & 15); d[0] = v[i].x; d[1] = v[i].y; d[2] = v[i].z; d[3] = v[i].w; }
    LDS_WAIT(); asm volatile("" ::: "memory");
    const int c = lane & 7;
#pragma unroll
    for (int j = 0; j < 8; ++j) { const int n = (lane >> 3) + 8 * j; const LAS float* s = scr + (8 * c) * 65 + n;
        u32x4 o; o.x = pkbf(s[0 * 65], s[1 * 65]); o.y = pkbf(s[2 * 65], s[3 * 65]); o.z = pkbf(s[4 * 65], s[5 * 65]); o.w = pkbf(s[6 * 65], s[7 * 65]);
        *(GAS u32x4*)(WT + (size_t)(drow0 + rmul * n) * K + k0 + 8 * c) = o; }
    LDS_WAIT(); asm volatile("" ::: "memory");
}
__device__ __forceinline__ void cvt_mixer_weights(LAS unsigned char* lds, unsigned char* ws, const float* w_in, const float* w_out, int gw, int NGW, int wave, int lane) {
    LAS float* scr = (LAS float*)(lds + wave * 16896);
    bf16* WA = (bf16*)(ws + WS_WA); bf16* WB = (bf16*)(ws + WS_WB); bf16* WO = (bf16*)(ws + WS_WO);
    constexpr int I_IN = 16 * 105, I_OUT = 32 * 16;
    for (int it = gw; it < I_IN + I_OUT; it += NGW) {
        if (it < I_IN) { const int kb = it / 105, nb = it % 105, n0 = nb * 64;
            bf16* dst; int drow;
            if (n0 < 4608) { dst = WA; drow = n0; } else if (n0 < 6656) { dst = WB; drow = n0 - 4608; } else { dst = WA; drow = 4608 + (n0 - 6656); }
            transpose_item(w_in, 1024, 6720, kb * 64, n0, dst, drow, 1, scr, lane);
        } else { const int r = it - I_IN, kb = r / 16, nb = r % 16; transpose_item(w_out, 2048, 1024, kb * 64, nb * 64, WO, nb * 64, 1, scr, lane); }
    }
    { u32x4 z = (u32x4){0u, 0u, 0u, 0u}; asm volatile("" : "+v"(z));
      for (int r = gw; r < 192; r += NGW) { GAS u32x4* p = (GAS u32x4*)(WA + (size_t)(4672 + r) * 1024) + lane; p[0] = z; p[64] = z; } }
}
__device__ __forceinline__ void cvt_expert_weights(LAS unsigned char* lds, unsigned char* ws, const float* w_gate, const float* w_up, const float* w_down, int gw, int NGW, int wave, int lane) {
    LAS float* scr = (LAS float*)(lds + wave * 16896);
    bf16* WGU = (bf16*)(ws + WS_WGU); bf16* WD = (bf16*)(ws + WS_WD);
    constexpr int I_G = 16 * 8;
    constexpr int I_D = 8 * 16;
    constexpr int PER_E = 2 * I_G + I_D;
    for (int it = gw; it < NEXP * PER_E; it += NGW) {
        const int e = it / PER_E; int r = it % PER_E;
        if (r < 2 * I_G) { const int up = r >= I_G; if (up) r -= I_G; const int kb = r / 8, nb = r % 8;
            transpose_item((up ? w_up : w_gate) + (size_t)e * 1024 * 512, 1024, 512, kb * 64, nb * 64, WGU + (size_t)e * 1024 * 1024, 2 * (nb * 64) + up, 2, scr, lane);
        } else { r -= 2 * I_G; const int kb = r / 16, nb = r % 16;
            transpose_item(w_down + (size_t)e * 512 * 1024, 512, 1024, kb * 64, nb * 64, WD + (size_t)e * 1024 * 512, nb * 64, 1, scr, lane); }
    }
}

__device__ __forceinline__ void rms_row_regs(const float* xrow, const f32x4 (&w)[4], f32x4 (&v)[4], int lane) {
    const GAS f32x4* xr = (const GAS f32x4*)xrow + lane; float s = 0.f;
#pragma unroll
    for (int j = 0; j < 4; ++j) { v[j] = xr[64 * j]; s += (v[j].x * v[j].x + v[j].y * v[j].y) + (v[j].z * v[j].z + v[j].w * v[j].w); }
    const float rstd = __builtin_amdgcn_rsqf(wave_sum(s) * (1.0f / DM) + EPS);
#pragma unroll
    for (int j = 0; j < 4; ++j) v[j] = v[j] * rstd * w[j];
}
__device__ __forceinline__ void store_row_bf16(bf16* orow, const f32x4 (&v)[4], int lane) {
    GAS u32x2* o8 = (GAS u32x2*)orow + lane;
#pragma unroll
    for (int j = 0; j < 4; ++j) { u32x2 t; t.x = pkbf(v[j].x, v[j].y); t.y = pkbf(v[j].z, v[j].w); o8[64 * j] = t; }
}
__device__ __forceinline__ void load_w4(const float* w, f32x4 (&wv)[4], int lane) {
#pragma unroll
    for (int j = 0; j < 4; ++j) wv[j] = ((const GAS f32x4*)w)[lane + 64 * j];
}
__device__ __forceinline__ void phase_norm(const float* src, const float* w, bf16* XN, int gw, int NGW, int lane) {
    f32x4 wv[4]; load_w4(w, wv, lane);
    for (int m = gw; m < M; m += NGW) { f32x4 v[4]; rms_row_regs(src + (size_t)m * DM, wv, v, lane); store_row_bf16(XN + (size_t)m * DM, v, lane); }
}
__device__ __forceinline__ void zero_region(unsigned char* p, size_t bytes, int gtid, int NGT) {
    GAS u32x4* q = (GAS u32x4*)p; const size_t n = bytes / 16;
    u32x4 z = (u32x4){0u, 0u, 0u, 0u}; asm volatile("" : "+v"(z));
    for (size_t i = gtid; i < n; i += NGT) q[i] = z;
}

__device__ __forceinline__ void phase_norm2_router(LAS unsigned char* lds, const float* h, const float* w2, const float* w_router, bf16* XN, float* aff, int gw, int NGW, int tid, int lane) {
    LAS float* wrT = (LAS float*)lds;
    for (int e = tid; e < 16 * 1024; e += 512) { const int k = e >> 4, x = e & 15; wrT[x * 1024 + k] = w_router[e]; }
    __syncthreads();
    f32x4 wv[4]; load_w4(w2, wv, lane);
    for (int m = gw; m < M; m += NGW) {
        f32x4 v[4]; rms_row_regs(h + (size_t)m * DM, wv, v, lane); store_row_bf16(XN + (size_t)m * DM, v, lane);
        float mine = 0.f;
#pragma unroll 1
        for (int x = 0; x < 16; ++x) { float s = 0.f;
#pragma unroll
            for (int j = 0; j < 4; ++j) { const f32x4 wr = *(const LAS f32x4*)(wrT + x * 1024 + 4 * lane + 256 * j); s += (v[j].x * wr.x + v[j].y * wr.y) + (v[j].z * wr.z + v[j].w * wr.w); }
            s = wave_sum(s); mine = (lane == x) ? s : mine; }
        float mx = mine;
        mx = fmaxf(mx, __shfl_xor(mx, 1)); mx = fmaxf(mx, __shfl_xor(mx, 2)); mx = fmaxf(mx, __shfl_xor(mx, 4)); mx = fmaxf(mx, __shfl_xor(mx, 8));
        const float ex = expf(mine - mx); float den = ex;
        den += __shfl_xor(den, 1); den += __shfl_xor(den, 2); den += __shfl_xor(den, 4); den += __shfl_xor(den, 8);
        if (lane < 16) aff[(size_t)m * 16 + lane] = ex / den;
    }
}

__device__ __forceinline__ void phase_finish(const bf16* og, const bf16* ys, const bf16* yi, const bf16* gates, const float* gnw, const float* snw, bf16* mixed, int gw, int NGW, int lane) {
    float gw_[16], sw_[16];
#pragma unroll
    for (int c = 0; c < 16; ++c) { gw_[c] = gnw[(16 * lane + c) & 127]; sw_[c] = snw[16 * lane + c]; }
    for (int m = gw; m < M; m += NGW) {
        const bf16x8 o0 = *(const GAS bf16x8*)(og + (size_t)m * 1024 + 16 * lane), o1 = *(const GAS bf16x8*)(og + (size_t)m * 1024 + 16 * lane + 8);
        const bf16x8 y0 = *(const GAS bf16x8*)(ys + (size_t)m * 1024 + 16 * lane), y1 = *(const GAS bf16x8*)(ys + (size_t)m * 1024 + 16 * lane + 8);
        const bf16x8 i0 = *(const GAS bf16x8*)(yi + (size_t)m * 1024 + 16 * lane), i1 = *(const GAS bf16x8*)(yi + (size_t)m * 1024 + 16 * lane + 8);
        const bf16x8 g0 = *(const GAS bf16x8*)(gates + (size_t)m * 2048 + 16 * lane), g1 = *(const GAS bf16x8*)(gates + (size_t)m * 2048 + 16 * lane + 8);
        const bf16x8 z0 = *(const GAS bf16x8*)(gates + (size_t)m * 2048 + 1024 + 16 * lane), z1 = *(const GAS bf16x8*)(gates + (size_t)m * 2048 + 1024 + 16 * lane + 8);
        float o[16], t[16]; float so = 0.f, st = 0.f;
#pragma unroll
        for (int c = 0; c < 8; ++c) { o[c] = bf2f_s(o0[c]); o[8 + c] = bf2f_s(o1[c]); t[c] = (bf2f_s(y0[c]) + bf2f_s(i0[c])) * silu(bf2f_s(z0[c])); t[8 + c] = (bf2f_s(y1[c]) + bf2f_s(i1[c])) * silu(bf2f_s(z1[c])); }
#pragma unroll
        for (int c = 0; c < 16; ++c) { so += o[c] * o[c]; st += t[c] * t[c]; }
        so += __shfl_xor(so, 1); so += __shfl_xor(so, 2); so += __shfl_xor(so, 4);
        st += __shfl_xor(st, 1); st += __shfl_xor(st, 2); st += __shfl_xor(st, 4); st += __shfl_xor(st, 8); st += __shfl_xor(st, 16);
        const float ro = __builtin_amdgcn_rsqf(so * (1.0f / 128.f) + EPS), rt = __builtin_amdgcn_rsqf(st * (1.0f / 512.f) + EPS);
        float a[16], b2[16];
#pragma unroll
        for (int c = 0; c < 8; ++c) { a[c] = o[c] * ro * gw_[c] * silu(bf2f_s(g0[c])); a[8 + c] = o[8 + c] * ro * gw_[8 + c] * silu(bf2f_s(g1[c])); }
#pragma unroll
        for (int c = 0; c < 16; ++c) b2[c] = t[c] * rt * sw_[c];
        u32x4 w0, w1, w2, w3;
        w0.x = pkbf(a[0], a[1]); w0.y = pkbf(a[2], a[3]); w0.z = pkbf(a[4], a[5]); w0.w = pkbf(a[6], a[7]);
        w1.x = pkbf(a[8], a[9]); w1.y = pkbf(a[10], a[11]); w1.z = pkbf(a[12], a[13]); w1.w = pkbf(a[14], a[15]);
        w2.x = pkbf(b2[0], b2[1]); w2.y = pkbf(b2[2], b2[3]); w2.z = pkbf(b2[4], b2[5]); w2.w = pkbf(b2[6], b2[7]);
        w3.x = pkbf(b2[8], b2[9]); w3.y = pkbf(b2[10], b2[11]); w3.z = pkbf(b2[12], b2[13]); w3.w = pkbf(b2[14], b2[15]);
        GAS u32x4* mp = (GAS u32x4*)(mixed + (size_t)m * 2048 + 16 * lane);
        mp[0] = w0; mp[1] = w1; mp[128] = w2; mp[129] = w3;
    }
}

__device__ __forceinline__ void phase_topk(LAS unsigned char* lds, const float* aff, int* idx, float* val, int* inv, int be, int tid, int wave, int lane) {
    LAS unsigned* hist = (LAS unsigned*)lds;
    LAS unsigned* ctl = hist + 256;
    LAS unsigned* wsum = hist + 320;
    const int b = be >> 4, e = be & 15;
    unsigned key[16];
#pragma unroll
    for (int i = 0; i < 16; ++i) key[i] = __float_as_uint(aff[((size_t)b * SEQ + tid * 16 + i) * 16 + e]);
    unsigned prefix = 0u, mask = 0u; unsigned krem = CAP;
    for (int pass = 0; pass < 4; ++pass) {
        const int shift = 24 - 8 * pass;
        if (tid < 256) hist[tid] = 0u;
        __syncthreads();
#pragma unroll
        for (int i = 0; i < 16; ++i) if ((key[i] & mask) == prefix) atomicAdd((unsigned*)&hist[(key[i] >> shift) & 255u], 1u);
        __syncthreads();
        if (wave == 0) {
            const u32x4 hb = *(const LAS u32x4*)(hist + 4 * lane); const unsigned sl = hb.x + hb.y + hb.z + hb.w;
            int Si = (int)sl; Si += dppi<0x101>(Si); Si += dppi<0x102>(Si); Si += dppi<0x104>(Si); Si += dppi<0x108>(Si);
            { const int t1 = __builtin_amdgcn_readlane(Si, 16), t2 = __builtin_amdgcn_readlane(Si, 32), t3 = __builtin_amdgcn_readlane(Si, 48); const int row = lane >> 4;
              Si += (row == 3 ? 0 : row == 2 ? t3 : row == 1 ? t3 + t2 : t3 + t2 + t1); }
            const unsigned S = (unsigned)Si;
            const unsigned above = S - sl;
            if (above < krem && krem <= above + sl) { unsigned cum = above; int d;
                if (cum + hb.w >= krem) d = 3; else { cum += hb.w; if (cum + hb.z >= krem) d = 2; else { cum += hb.z; if (cum + hb.y >= krem) d = 1; else { cum += hb.y; d = 0; } } }
                ctl[0] = prefix | ((unsigned)(4 * lane + d) << shift); ctl[1] = krem - cum; } }
        __syncthreads();
        prefix = ctl[0]; krem = ctl[1]; mask |= 255u << shift;
        __syncthreads();
    }
    const unsigned thr = prefix;
    int ngt = 0, neq = 0;
#pragma unroll
    for (int i = 0; i < 16; ++i) { ngt += key[i] > thr; neq += key[i] == thr; }
    const int sg = scan_fwd64_i(ngt, lane), sq = scan_fwd64_i(neq, lane);
    if (lane == 63) { wsum[wave] = (unsigned)sg; wsum[8 + wave] = (unsigned)sq; }
    __syncthreads();
    int bg = 0, bq = 0;
#pragma unroll
    for (int w = 0; w < 8; ++w) if (w < wave) { bg += (int)wsum[w]; bq += (int)wsum[8 + w]; }
    int pg = bg + sg - ngt, pq = bq + sq - neq;
#pragma unroll
    for (int i = 0; i < 16; ++i) {
        const int tok = tid * 16 + i; const bool gt = key[i] > thr, eq = key[i] == thr;
        const bool sel = gt || (eq && pq < (int)krem);
        const int slot = pg + (pq < (int)krem ? pq : (int)krem);
        if (sel) { idx[be * CAP + slot] = tok; val[be * CAP + slot] = __uint_as_float(key[i]); }
        inv[((size_t)b * SEQ + tok) * 16 + e] = sel ? slot : -1;
        pg += gt; pq += eq;
    }
    __syncthreads();
}

__device__ __forceinline__ void phase_gather(const bf16* XN, const int* idx, bf16* XG, int gw, int NGW, int lane) {
    for (int r = gw; r < MEXP; r += NGW) {
        const int b = r >> 14; const int tok = idx[r];
        const GAS u32x4* s = (const GAS u32x4*)(XN + ((size_t)b * SEQ + tok) * DM) + lane; GAS u32x4* d = (GAS u32x4*)(XG + (size_t)r * DM) + lane;
        const u32x4 a = s[0], c = s[64]; d[0] = a; d[64] = c;
    }
}

__device__ __forceinline__ void phase_combine(const float* hin, float* hout, const bf16* Y, const int* inv, const float* val, const float* wn, bf16* XN, bool final_, int gw, int NGW, int lane, float pscale = 1.0f) {
    f32x4 wv[4]; load_w4(wn, wv, lane);
    for (int m = gw; m < M; m += NGW) {
        const int b = m >> 13;
        const GAS f32x4* xr = (const GAS f32x4*)(hin + (size_t)m * DM) + lane; f32x4 v[4];
#pragma unroll
        for (int j = 0; j < 4; ++j) v[j] = xr[64 * j];
        const int myslot = (lane < 16) ? inv[(size_t)m * 16 + lane] : -1;
        for (int e = 0; e < 16; ++e) {
            const int s = __shfl(myslot, e);
            if (s >= 0) {
                const int r = (b * 16 + e) * CAP + s; const float a = val[r];
                const GAS u32x2* yr = (const GAS u32x2*)(Y + (size_t)r * DM) + lane;
#pragma unroll
                for (int j = 0; j < 4; ++j) { const u32x2 t = yr[64 * j];
                    v[j].x += a * __uint_as_float(t.x << 16); v[j].y += a * __uint_as_float(t.x & 0xffff0000u); v[j].z += a * __uint_as_float(t.y << 16); v[j].w += a * __uint_as_float(t.y & 0xffff0000u); }
            }
        }
        float s2 = 0.f;
#pragma unroll
        for (int j = 0; j < 4; ++j) s2 += (v[j].x * v[j].x + v[j].y * v[j].y) + (v[j].z * v[j].z + v[j].w * v[j].w);
        const float rstd = __builtin_amdgcn_rsqf(wave_sum(s2) * (1.0f / DM) + EPS);
        GAS f32x4* ho = (GAS f32x4*)(hout + (size_t)m * DM) + lane;
        if (final_) {
#pragma unroll
            for (int j = 0; j < 4; ++j) ho[64 * j] = v[j] * (rstd * pscale) * wv[j];
        } else {
#pragma unroll
            for (int j = 0; j < 4; ++j) ho[64 * j] = v[j];
            f32x4 nv[4];
#pragma unroll
            for (int j = 0; j < 4; ++j) nv[j] = v[j] * rstd * wv[j];
            store_row_bf16(XN + (size_t)m * DM, nv, lane);
        }
    }
}
namespace gdn {
constexpr int CW = 0;
constexpr int SC = CW + 8 * 320 * 4;
constexpr int Q = SC + 1280;
constexpr int K = Q + 64 * 136 * 2;
constexpr int KDT = K + 64 * 136 * 2;
constexpr int VT = KDT + 128 * 72 * 2;
constexpr int T = VT + 64 * 72 * 2;
constexpr int QKD = T + 64 * 72 * 2;
constexpr int ST = QKD + 64 * 72 * 2;
constexpr int TMP = ST + 64 * 136 * 2;
constexpr int RQ = TMP, RK = RQ + 70 * 136 * 2, RV = RK + 70 * 136 * 2, RAW_END = RV + 70 * 72 * 2;
constexpr int AF = TMP, TF = AF + 64 * 68 * 4, XF = TF + 64 * 68 * 4, INV_END = XF + 3 * 16 * 17 * 4;
constexpr int RT = TMP, UT = RT + 64 * 72 * 2, OS = UT + 64 * 72 * 2, ST_END = OS + 64 * 65 * 4;
static_assert(RAW_END <= MISC_OFF && INV_END <= MISC_OFF && ST_END <= MISC_OFF, "gdn LDS map");
}
__device__ __forceinline__ void gdn_chain(LAS unsigned char* lds, int cid, const bf16* raw, const float* scal, const float* conv_w, const float* conv_b,
                                          const float* A_log, const float* dt_bias, bf16* og, int tid, int wave, int lane) {
    using namespace gdn;
    const int dvh = cid & 1, dir = (cid >> 1) & 1, h = (cid >> 2) & 7, b = cid >> 5;
    const int fr = lane & 15, fq = lane >> 4;
    LAS float* cw = (LAS float*)(lds + CW); LAS float* sc = (LAS float*)(lds + SC);
    LAS bf16* q_ = (LAS bf16*)(lds + Q); LAS bf16* k_ = (LAS bf16*)(lds + K); LAS bf16* kdT = (LAS bf16*)(lds + KDT); LAS bf16* vT = (LAS bf16*)(lds + VT);
    LAS bf16* T_ = (LAS bf16*)(lds + T); LAS bf16* QKd = (LAS bf16*)(lds + QKD); LAS bf16* ST_ = (LAS bf16*)(lds + ST);
    LAS bf16* rq = (LAS bf16*)(lds + RQ); LAS bf16* rk = (LAS bf16*)(lds + RK); LAS bf16* rv = (LAS bf16*)(lds + RV);
    LAS float* Af = (LAS float*)(lds + AF); LAS float* Tf = (LAS float*)(lds + TF); LAS float* Xf = (LAS float*)(lds + XF);
    LAS bf16* rT = (LAS bf16*)(lds + RT); LAS bf16* uT = (LAS bf16*)(lds + UT); LAS float* os = (LAS float*)(lds + OS);
    for (int e = tid; e < 8 * 320; e += 512) { const int r = e / 320, c = e % 320;
        const int gch = c < 128 ? h * 128 + c : (c < 256 ? 1024 + h * 128 + (c - 128) : 2048 + h * 128 + dvh * 64 + (c - 256));
        cw[e] = r < 7 ? conv_w[r * CONV_CH + gch] : conv_b[gch]; }
    for (int e = tid; e < 64 * 136 / 2; e += 512) ((LAS unsigned*)ST_)[e] = 0u;
    const float expA = expf(A_log[dir * 8 + h]), dtb = dt_bias[dir * 8 + h];
    f32x4 sacc[4];
#pragma unroll
    for (int nt = 0; nt < 4; ++nt) sacc[nt] = (f32x4){0.f, 0.f, 0.f, 0.f};
    const size_t rowb = (size_t)b * SEQ;
    __syncthreads();
    for (int n = 0; n < NCHUNK; ++n) {
        const int t0 = (dir ? NCHUNK - 1 - n : n) * 64;
        for (int e = tid; e < 70 * 40; e += 512) { const int r = e / 40, p = e % 40; const int t = t0 - 3 + r;
            u32x4 v = (u32x4){0u, 0u, 0u, 0u};
            const int col = p < 16 ? h * 128 + p * 8 : (p < 32 ? 1024 + h * 128 + (p - 16) * 8 : 2048 + h * 128 + dvh * 64 + (p - 32) * 8);
            if (t >= 0 && t < SEQ) v = *(const GAS u32x4*)(raw + (rowb + t) * CONV_CH + col);
            LAS bf16* d = p < 16 ? rq + r * 136 + p * 8 : (p < 32 ? rk + r * 136 + (p - 16) * 8 : rv + r * 72 + (p - 32) * 8);
            *(LAS u32x4*)d = v; }
        if (wave == 0) { const int i = lane; const int t = t0 + (dir ? 63 - i : i);
            const float braw = scal[(rowb + t) * 64 + dir * 8 + h], araw = scal[(rowb + t) * 64 + 16 + dir * 8 + h];
            const float g = -expA * softplus_f(araw + dtb);
            float gc = g;
#pragma unroll
            for (int o = 1; o < 64; o <<= 1) { const float y = __shfl_up(gc, o); if (i >= o) gc += y; }
            const float gl = __shfl(gc, 63);
            sc[i] = sigmoid_f(braw); sc[64 + i] = gc; sc[128 + i] = expf(gc); sc[192 + i] = expf(gl - gc); if (i == 0) sc[256] = expf(gl); }
        __syncthreads();
        { const int i = tid >> 3, cg = tid & 7; const int o = dir ? 63 - i : i;
          float a[16];
          conv16(a, rq + o * 136 + cg * 16, 136, cw + cg * 16, 320);
          float ss = 0.f;
#pragma unroll
          for (int c = 0; c < 16; ++c) { a[c] = silu(a[c]); ss += a[c] * a[c]; }
          ss += __shfl_xor(ss, 1); ss += __shfl_xor(ss, 2); ss += __shfl_xor(ss, 4);
          float rs = (1.0f / sqrtf(ss + EPS)) * 0.08838834764831845f;
          { u32x4 w0, w1; w0.x = pkbf(a[0] * rs, a[1] * rs); w0.y = pkbf(a[2] * rs, a[3] * rs); w0.z = pkbf(a[4] * rs, a[5] * rs); w0.w = pkbf(a[6] * rs, a[7] * rs);
            w1.x = pkbf(a[8] * rs, a[9] * rs); w1.y = pkbf(a[10] * rs, a[11] * rs); w1.z = pkbf(a[12] * rs, a[13] * rs); w1.w = pkbf(a[14] * rs, a[15] * rs);
            *(LAS u32x4*)(q_ + i * 136 + cg * 16) = w0; *(LAS u32x4*)(q_ + i * 136 + cg * 16 + 8) = w1; }
          conv16(a, rk + o * 136 + cg * 16, 136, cw + 128 + cg * 16, 320);
          ss = 0.f;
#pragma unroll
          for (int c = 0; c < 16; ++c) { a[c] = silu(a[c]); ss += a[c] * a[c]; }
          ss += __shfl_xor(ss, 1); ss += __shfl_xor(ss, 2); ss += __shfl_xor(ss, 4);
          rs = 1.0f / sqrtf(ss + EPS);
          { u32x4 w0, w1; w0.x = pkbf(a[0] * rs, a[1] * rs); w0.y = pkbf(a[2] * rs, a[3] * rs); w0.z = pkbf(a[4] * rs, a[5] * rs); w0.w = pkbf(a[6] * rs, a[7] * rs);
            w1.x = pkbf(a[8] * rs, a[9] * rs); w1.y = pkbf(a[10] * rs, a[11] * rs); w1.z = pkbf(a[12] * rs, a[13] * rs); w1.w = pkbf(a[14] * rs, a[15] * rs);
            *(LAS u32x4*)(k_ + i * 136 + cg * 16) = w0; *(LAS u32x4*)(k_ + i * 136 + cg * 16 + 8) = w1; }
          const float ek = sc[192 + i] * rs;
#pragma unroll
          for (int c = 0; c < 16; ++c) kdT[(cg * 16 + c) * 72 + i] = f2bf1(a[c] * ek);
          float v8[8];
          conv8(v8, rv + o * 72 + cg * 8, 72, cw + 256 + cg * 8, 320);
#pragma unroll
          for (int c = 0; c < 8; ++c) vT[(cg * 8 + c) * 72 + i] = f2bf1(silu(v8[c]));
        }
        __syncthreads();
        { const int which = wave >> 2, mt = wave & 3;
          f32x4 acc[1][4];
#pragma unroll
          for (int nt = 0; nt < 4; ++nt) acc[0][nt] = (f32x4){0.f, 0.f, 0.f, 0.f};
          mma_lds<1, 4>(acc, which ? q_ : k_, 136, mt * 16, k_, 136, 0, 128, fr, fq);
#pragma unroll
          for (int nt = 0; nt < 4; ++nt)
#pragma unroll
              for (int r = 0; r < 4; ++r) { const int i = mt * 16 + 4 * fq + r, j = nt * 16 + fr;
                  const float d = expf(fminf(sc[64 + i] - sc[64 + j], 0.f)); const float x = acc[0][nt][r] * d;
                  if (which == 0) Af[i * 68 + j] = (i > j) ? sc[i] * x : 0.f;
                  else QKd[i * 72 + j] = f2bf1((i >= j) ? x : 0.f); }
        }
        __syncthreads();
        if (wave == 0) { const int blk = lane >> 4, c = lane & 15; float t[16];
#pragma unroll
            for (int i = 0; i < 16; ++i) t[i] = (i == c) ? 1.f : 0.f;
#pragma unroll
            for (int i = 1; i < 16; ++i) { float s = 0.f; const LAS float* ar = Af + (blk * 16 + i) * 68 + blk * 16;
#pragma unroll
                for (int j = 0; j < i; ++j) s += ar[j] * t[j];
                t[i] = (i > c) ? -s : t[i];
                if ((i & 3) == 3) asm volatile("" ::: "memory"); }
#pragma unroll
            for (int i = 0; i < 16; ++i) Tf[(blk * 16 + i) * 68 + blk * 16 + c] = t[i]; }
        for (int d = 1; d <= 3; ++d) { const int nbk = 4 - d;
            __syncthreads();
            for (int e = tid; e < nbk * 256; e += 512) { const int J = e >> 8, r = (e >> 4) & 15, c = e & 15, I = J + d; float s = 0.f;
                for (int kk = J * 16; kk < I * 16; ++kk) s += Af[(I * 16 + r) * 68 + kk] * Tf[kk * 68 + J * 16 + c];
                Xf[(J * 16 + r) * 17 + c] = s; }
            __syncthreads();
            for (int e = tid; e < nbk * 256; e += 512) { const int J = e >> 8, r = (e >> 4) & 15, c = e & 15, I = J + d; float s = 0.f;
#pragma unroll
                for (int m2 = 0; m2 < 16; ++m2) s += Tf[(I * 16 + r) * 68 + I * 16 + m2] * Xf[(J * 16 + m2) * 17 + c];
                Tf[(I * 16 + r) * 68 + J * 16 + c] = -s; }
        }
        __syncthreads();
        for (int e = tid; e < 4096; e += 512) { const int i = e >> 6, j = e & 63; T_[i * 72 + j] = f2bf1(((i >> 4) >= (j >> 4)) ? Tf[i * 68 + j] : 0.f); }
        __syncthreads();
        const int mt = wave & 3, nh = wave >> 2;
        f32x4 aq[2];
        { f32x4 ak[2]; ak[0] = ak[1] = aq[0] = aq[1] = (f32x4){0.f, 0.f, 0.f, 0.f};
          for (int k0 = 0; k0 < 128; k0 += 32) {
              const bf16x8 fk = *(const LAS bf16x8*)(k_ + (mt * 16 + fr) * 136 + k0 + fq * 8), fqv = *(const LAS bf16x8*)(q_ + (mt * 16 + fr) * 136 + k0 + fq * 8);
#pragma unroll
              for (int nl = 0; nl < 2; ++nl) { const bf16x8 fb = *(const LAS bf16x8*)(ST_ + (nh * 32 + nl * 16 + fr) * 136 + k0 + fq * 8);
                  ak[nl] = __builtin_amdgcn_mfma_f32_16x16x32_bf16(fk, fb, ak[nl], 0, 0, 0); aq[nl] = __builtin_amdgcn_mfma_f32_16x16x32_bf16(fqv, fb, aq[nl], 0, 0, 0); } }
          const int i0 = mt * 16 + 4 * fq;
          const f32x4 be4 = *(const LAS f32x4*)(sc + i0), eg4 = *(const LAS f32x4*)(sc + 128 + i0);
#pragma unroll
          for (int nl = 0; nl < 2; ++nl) { const int dv = nh * 32 + nl * 16 + fr;
              const bf16x4 vv = *(const LAS bf16x4*)(vT + dv * 72 + i0);
              float r0 = be4[0] * (bf2f_s(vv[0]) - eg4[0] * ak[nl][0]), r1 = be4[1] * (bf2f_s(vv[1]) - eg4[1] * ak[nl][1]);
              float r2 = be4[2] * (bf2f_s(vv[2]) - eg4[2] * ak[nl][2]), r3 = be4[3] * (bf2f_s(vv[3]) - eg4[3] * ak[nl][3]);
              u32x2 w; w.x = pkbf(r0, r1); w.y = pkbf(r2, r3); *(LAS u32x2*)(rT + dv * 72 + i0) = w;
              aq[nl][0] *= eg4[0]; aq[nl][1] *= eg4[1]; aq[nl][2] *= eg4[2]; aq[nl][3] *= eg4[3]; }
        }
        __syncthreads();
        { f32x4 au[1][2]; au[0][0] = au[0][1] = (f32x4){0.f, 0.f, 0.f, 0.f};
          mma_lds<1, 2>(au, T_, 72, mt * 16, rT, 72, nh * 32, 64, fr, fq);
          const int i0 = mt * 16 + 4 * fq;
#pragma unroll
          for (int nl = 0; nl < 2; ++nl) { const int dv = nh * 32 + nl * 16 + fr; u32x2 w; w.x = pkbf(au[0][nl][0], au[0][nl][1]); w.y = pkbf(au[0][nl][2], au[0][nl][3]); *(LAS u32x2*)(uT + dv * 72 + i0) = w; }
        }
        __syncthreads();
        { f32x4 ao[1][2]; ao[0][0] = aq[0]; ao[0][1] = aq[1];
          mma_lds<1, 2>(ao, QKd, 72, mt * 16, uT, 72, nh * 32, 64, fr, fq);
          const int i0 = mt * 16 + 4 * fq;
#pragma unroll
          for (int nl = 0; nl < 2; ++nl)
#pragma unroll
              for (int r = 0; r < 4; ++r) os[(i0 + r) * 65 + nh * 32 + nl * 16 + fr] = ao[0][nl][r];
          const float egl = sc[256];
          f32x4 as_[1][4];
#pragma unroll
          for (int nt = 0; nt < 4; ++nt) as_[0][nt] = sacc[nt] * egl;
          mma_lds<1, 4>(as_, kdT, 72, wave * 16, uT, 72, 0, 64, fr, fq);
#pragma unroll
          for (int nt = 0; nt < 4; ++nt) { sacc[nt] = as_[0][nt];
              u32x2 w; w.x = pkbf(sacc[nt][0], sacc[nt][1]); w.y = pkbf(sacc[nt][2], sacc[nt][3]); *(LAS u32x2*)(ST_ + (nt * 16 + fr) * 136 + wave * 16 + 4 * fq) = w; }
        }
        __syncthreads();
#pragma unroll
        for (int ii = 0; ii < 4; ++ii) { const int i = wave * 8 + 2 * ii + (lane >> 5), cp = lane & 31; const int t = t0 + (dir ? 63 - i : i);
            atomic_add_bf16x2(og + (rowb + t) * 1024 + h * 128 + dvh * 64 + 2 * cp, os[i * 65 + 2 * cp], os[i * 65 + 2 * cp + 1]); }
        __syncthreads();
    }
}

namespace ssd {
constexpr int CW = 0;
constexpr int SC = CW + 8 * 320 * 4;
constexpr int BM_ = SC + 1280;
constexpr int CM_ = BM_ + 64 * 136 * 2;
constexpr int BT = CM_ + 64 * 136 * 2;
constexpr int XDT = BT + 128 * 72 * 2;
constexpr int XDW = XDT + 64 * 72 * 2;
constexpr int MM = XDW + 64 * 72 * 2;
constexpr int HT = MM + 64 * 72 * 2;
constexpr int TMP = HT + 64 * 136 * 2;
constexpr int RX = TMP, RB = RX + 70 * 72 * 2, RC = RB + 70 * 136 * 2, RAW_END = RC + 70 * 136 * 2;
constexpr int OS = TMP, OS_END = OS + 64 * 65 * 4;
static_assert(RAW_END <= MISC_OFF && OS_END <= MISC_OFF, "ssd LDS map");
}
__device__ __forceinline__ void ssd_chain(LAS unsigned char* lds, int cid, const bf16* raw, const float* scal, const float* conv_w, const float* conv_b,
                                          const float* A_log, const float* dt_bias, const float* Dp, bf16* ys, int tid, int wave, int lane) {
    using namespace ssd;
    const int dir = cid & 1, head = (cid >> 1) & 15, b = cid >> 5; const int g = head >> 3;
    const int fr = lane & 15, fq = lane >> 4;
    LAS float* cw = (LAS float*)(lds + CW); LAS float* sc = (LAS float*)(lds + SC);
    LAS bf16* Bm = (LAS bf16*)(lds + BM_); LAS bf16* Cm = (LAS bf16*)(lds + CM_); LAS bf16* BT_ = (LAS bf16*)(lds + BT);
    LAS bf16* xdt = (LAS bf16*)(lds + XDT); LAS bf16* xdw = (LAS bf16*)(lds + XDW); LAS bf16* Mm = (LAS bf16*)(lds + MM); LAS bf16* hT = (LAS bf16*)(lds + HT);
    LAS bf16* rx = (LAS bf16*)(lds + RX); LAS bf16* rb = (LAS bf16*)(lds + RB); LAS bf16* rc = (LAS bf16*)(lds + RC); LAS float* os = (LAS float*)(lds + OS);
    const int chx = 3072 + head * 64, chb = 4096 + g * 128, chc = 4352 + g * 128;
    for (int e = tid; e < 8 * 320; e += 512) { const int r = e / 320, c = e % 320;
        const int gch = c < 64 ? chx + c : (c < 192 ? chb + (c - 64) : chc + (c - 192));
        cw[e] = r < 7 ? conv_w[r * CONV_CH + gch] : conv_b[gch]; }
    for (int e = tid; e < 64 * 136 / 2; e += 512) ((LAS unsigned*)hT)[e] = 0u;
    const float Ah = -expf(A_log[dir * 16 + head]), dtb = dt_bias[dir * 16 + head], Dh = (dir == 0) ? Dp[head] : 0.f;
    f32x4 hacc[4];
#pragma unroll
    for (int nt = 0; nt < 4; ++nt) hacc[nt] = (f32x4){0.f, 0.f, 0.f, 0.f};
    const size_t rowb = (size_t)b * SEQ;
    __syncthreads();
    for (int n = 0; n < NCHUNK; ++n) {
        const int t0 = (dir ? NCHUNK - 1 - n : n) * 64;
        for (int e = tid; e < 70 * 40; e += 512) { const int r = e / 40, p = e % 40; const int t = t0 - 3 + r;
            u32x4 v = (u32x4){0u, 0u, 0u, 0u};
            const int col = p < 8 ? chx + p * 8 : (p < 24 ? chb + (p - 8) * 8 : chc + (p - 24) * 8);
            if (t >= 0 && t < SEQ) v = *(const GAS u32x4*)(raw + (rowb + t) * CONV_CH + col);
            LAS bf16* d = p < 8 ? rx + r * 72 + p * 8 : (p < 24 ? rb + r * 136 + (p - 8) * 8 : rc + r * 136 + (p - 24) * 8);
            *(LAS u32x4*)d = v; }
        if (wave == 0) { const int i = lane; const int t = t0 + (dir ? 63 - i : i);
            const float dt = softplus_f(scal[(rowb + t) * 64 + 32 + dir * 16 + head] + dtb);
            float cs = dt * Ah;
#pragma unroll
            for (int o = 1; o < 64; o <<= 1) { const float y = __shfl_up(cs, o); if (i >= o) cs += y; }
            const float cl = __shfl(cs, 63);
            sc[i] = dt; sc[64 + i] = cs; sc[128 + i] = expf(cs); sc[192 + i] = expf(cl - cs); if (i == 0) sc[256] = expf(cl); }
        __syncthreads();
        { const int i = tid >> 3, cg = tid & 7; const int o = dir ? 63 - i : i;
          float a[16];
          conv16(a, rb + o * 136 + cg * 16, 136, cw + 64 + cg * 16, 320);
#pragma unroll
          for (int c = 0; c < 16; ++c) a[c] = silu(a[c]);
          { u32x4 w0, w1; w0.x = pkbf(a[0], a[1]); w0.y = pkbf(a[2], a[3]); w0.z = pkbf(a[4], a[5]); w0.w = pkbf(a[6], a[7]);
            w1.x = pkbf(a[8], a[9]); w1.y = pkbf(a[10], a[11]); w1.z = pkbf(a[12], a[13]); w1.w = pkbf(a[14], a[15]);
            *(LAS u32x4*)(Bm + i * 136 + cg * 16) = w0; *(LAS u32x4*)(Bm + i * 136 + cg * 16 + 8) = w1; }
#pragma unroll
          for (int c = 0; c < 16; ++c) BT_[(cg * 16 + c) * 72 + i] = f2bf1(a[c]);
          conv16(a, rc + o * 136 + cg * 16, 136, cw + 192 + cg * 16, 320);
#pragma unroll
          for (int c = 0; c < 16; ++c) a[c] = silu(a[c]);
          { u32x4 w0, w1; w0.x = pkbf(a[0], a[1]); w0.y = pkbf(a[2], a[3]); w0.z = pkbf(a[4], a[5]); w0.w = pkbf(a[6], a[7]);
            w1.x = pkbf(a[8], a[9]); w1.y = pkbf(a[10], a[11]); w1.z = pkbf(a[12], a[13]); w1.w = pkbf(a[14], a[15]);
            *(LAS u32x4*)(Cm + i * 136 + cg * 16) = w0; *(LAS u32x4*)(Cm + i * 136 + cg * 16 + 8) = w1; }
          float x8[8];
          conv8(x8, rx + o * 72 + cg * 8, 72, cw + cg * 8, 320);
          const float dt = sc[i], wst = sc[192 + i];
#pragma unroll
          for (int c = 0; c < 8; ++c) { const float xv = silu(x8[c]) * dt; xdt[(cg * 8 + c) * 72 + i] = f2bf1(xv); xdw[(cg * 8 + c) * 72 + i] = f2bf1(xv * wst); }
        }
        __syncthreads();
        const int mt = wave & 3, nh = wave >> 2;
        { f32x4 acc[1][2]; acc[0][0] = acc[0][1] = (f32x4){0.f, 0.f, 0.f, 0.f};
          mma_lds<1, 2>(acc, Cm, 136, mt * 16, Bm, 136, nh * 32, 128, fr, fq);
#pragma unroll
          for (int nl = 0; nl < 2; ++nl)
#pragma unroll
              for (int r = 0; r < 4; ++r) { const int i = mt * 16 + 4 * fq + r, j = nh * 32 + nl * 16 + fr;
                  const float d = expf(fminf(sc[64 + i] - sc[64 + j], 0.f));
                  Mm[i * 72 + j] = f2bf1((i >= j) ? acc[0][nl][r] * d : 0.f); }
        }
        __syncthreads();
        { f32x4 a1[1][2], a2[1][2]; a1[0][0] = a1[0][1] = a2[0][0] = a2[0][1] = (f32x4){0.f, 0.f, 0.f, 0.f};
          mma_lds<1, 2>(a1, Mm, 72, mt * 16, xdt, 72, nh * 32, 64, fr, fq);
          mma_lds<1, 2>(a2, Cm, 136, mt * 16, hT, 136, nh * 32, 128, fr, fq);
          const int i0 = mt * 16 + 4 * fq;
          const f32x4 ec4 = *(const LAS f32x4*)(sc + 128 + i0), dt4 = *(const LAS f32x4*)(sc + i0);
#pragma unroll
          for (int nl = 0; nl < 2; ++nl) { const int p = nh * 32 + nl * 16 + fr; const bf16x4 xv = *(const LAS bf16x4*)(xdt + p * 72 + i0);
#pragma unroll
              for (int r = 0; r < 4; ++r) os[(i0 + r) * 65 + p] = a1[0][nl][r] + ec4[r] * a2[0][nl][r] + Dh * bf2f_s(xv[r]) / dt4[r]; }
        }
        __syncthreads();
        { const float ecl = sc[256];
          f32x4 ah[1][4];
#pragma unroll
          for (int nt = 0; nt < 4; ++nt) ah[0][nt] = hacc[nt] * ecl;
          mma_lds<1, 4>(ah, BT_, 72, wave * 16, xdw, 72, 0, 64, fr, fq);
#pragma unroll
          for (int nt = 0; nt < 4; ++nt) { hacc[nt] = ah[0][nt];
              u32x2 w; w.x = pkbf(hacc[nt][0], hacc[nt][1]); w.y = pkbf(hacc[nt][2], hacc[nt][3]); *(LAS u32x2*)(hT + (nt * 16 + fr) * 136 + wave * 16 + 4 * fq) = w; }
        }
#pragma unroll
        for (int ii = 0; ii < 4; ++ii) { const int i = wave * 8 + 2 * ii + (lane >> 5), cp = lane & 31; const int t = t0 + (dir ? 63 - i : i);
            atomic_add_bf16x2(ys + (rowb + t) * 1024 + head * 64 + 2 * cp, os[i * 65 + 2 * cp], os[i * 65 + 2 * cp + 1]); }
        __syncthreads();
    }
}
namespace pgd {
constexpr int CW = 0;
constexpr int SC = CW + 8 * 384 * 4;
constexpr int Q = SC + 1280;
constexpr int K = Q + 64 * 136 * 2;
constexpr int VT = K + 64 * 136 * 2;
constexpr int TMP = VT + 128 * 72 * 2;
constexpr int RQ = TMP, RK = RQ + 70 * 136 * 2, RV = RK + 70 * 136 * 2, RAW_END = RV + 70 * 136 * 2;
constexpr int AF = TMP, A2F = AF + 64 * 68 * 4, TF = A2F + 64 * 68 * 4, T2F = TF + 64 * 68 * 4, QKP = T2F + 64 * 68 * 4, INV_END = QKP + 64 * 72 * 2;
constexpr int XF = VT;
constexpr int TP = AF;
constexpr int STASH = MISC_OFF - 16384;
static_assert(RAW_END <= STASH && INV_END <= STASH, "prep gdn LDS map");
}
constexpr size_t WS_TQ = 379 * MiB;

__device__ __forceinline__ void prep_gdn_stash(LAS unsigned char* lds, int bid, const bf16* raw, int tid) {
    const int bh = bid >> 3, b = bh >> 3, h = bh & 7, r8 = bid & 7;
    LAS bf16* st = (LAS bf16*)(lds + pgd::STASH);
    for (int e = tid; e < 2 * 3 * 48; e += 512) { const int which = e / 144, r = (e % 144) / 48, p = e % 48;
        const int t = which ? (r8 * 16 + 16) * 64 + r : r8 * 16 * 64 - 3 + r;
        const int col = p < 16 ? h * 128 + p * 8 : (p < 32 ? 1024 + h * 128 + (p - 16) * 8 : 2048 + h * 128 + (p - 32) * 8);
        u32x4 v = (u32x4){0u, 0u, 0u, 0u};
        if (t >= 0 && t < SEQ) v = *(const GAS u32x4*)(raw + ((size_t)b * SEQ + t) * CONV_CH + col);
        *(LAS u32x4*)(st + which * 1152 + r * 384 + p * 8) = v; }
}
__device__ __forceinline__ void inv_diag_blocks(const LAS float* Af, LAS float* Tf, int lane) {
    const int blk = lane >> 4, c = lane & 15; float t[16];
#pragma unroll
    for (int i = 0; i < 16; ++i) t[i] = (i == c) ? 1.f : 0.f;
#pragma unroll
    for (int i = 1; i < 16; ++i) { float s = 0.f; const LAS float* ar = Af + (blk * 16 + i) * 68 + blk * 16;
#pragma unroll
        for (int j = 0; j < i; ++j) s += ar[j] * t[j];
        t[i] = (i > c) ? -s : t[i];
        if ((i & 3) == 3) asm volatile("" ::: "memory"); }
#pragma unroll
    for (int i = 0; i < 16; ++i) Tf[(blk * 16 + i) * 68 + blk * 16 + c] = t[i];
}
__device__ __forceinline__ void inv_offdiag_x(const LAS float* Af, const LAS float* Tf, LAS float* Xf, int d, int ht) {
    const int nbk = 4 - d;
    for (int e = ht; e < nbk * 256; e += 256) { const int J = e >> 8, r = (e >> 4) & 15, c = e & 15, I = J + d; float s = 0.f;
        for (int kk = J * 16; kk < I * 16; ++kk) s += Af[(I * 16 + r) * 68 + kk] * Tf[kk * 68 + J * 16 + c];
        Xf[(J * 16 + r) * 17 + c] = s; }
}
__device__ __forceinline__ void inv_offdiag_t(LAS float* Tf, const LAS float* Xf, int d, int ht) {
    const int nbk = 4 - d;
    for (int e = ht; e < nbk * 256; e += 256) { const int J = e >> 8, r = (e >> 4) & 15, c = e & 15, I = J + d; float s = 0.f;
#pragma unroll
        for (int m2 = 0; m2 < 16; ++m2) s += Tf[(I * 16 + r) * 68 + I * 16 + m2] * Xf[(J * 16 + m2) * 17 + c];
        Tf[(I * 16 + r) * 68 + J * 16 + c] = -s; }
}

__device__ __forceinline__ void conv_pair8(float (&o)[16], const LAS bf16* src  , int ld, const float (&w)[16]) {
#pragma unroll
    for (int t = 0; t < 8; ++t) { o[2 * t] = w[14]; o[2 * t + 1] = w[15]; }
#pragma unroll
    for (int r = 0; r < 14; ++r) { const unsigned xv = *(const LAS unsigned*)(src + r * ld); const float x0 = __uint_as_float(xv << 16), x1 = __uint_as_float(xv & 0xffff0000u);
#pragma unroll
        for (int t = 0; t < 8; ++t) { const int tap = r - t; if (tap >= 0 && tap < 7) { o[2 * t] += x0 * w[2 * tap]; o[2 * t + 1] += x1 * w[2 * tap + 1]; } } }
}
namespace pg2 {
constexpr int CW = 0;
constexpr int SC = CW + 8 * 384 * 4;
constexpr int Q = SC + 1280;
constexpr int K = Q + 64 * 136 * 2;
constexpr int VT = K + 64 * 136 * 2;
constexpr int RAWT = VT + 128 * 72 * 2;
constexpr int RAW_END = RAWT + 3 * 70 * 136 * 2;
constexpr int ABF = RAWT, TRM = ABF + 2 * 64 * 72 * 2, TTR = TRM + 2 * 64 * 72 * 2, AD = TTR + 2 * 64 * 72 * 2, XS = AD + 2 * 4 * 256 * 4, QKP = XS + 2 * 32 * 40 * 2, INV_END = QKP + 64 * 72 * 2;
static_assert(RAW_END <= pgd::STASH && INV_END <= pgd::STASH, "prep gdn v2 LDS map");
}
__device__ __forceinline__ void prep_gdn_range(LAS unsigned char* lds, int bid, bf16* raw, const float* scal, const float* conv_w, const float* conv_b,
                                               const float* A_log, const float* dt_bias, bf16* TQ, int tid_p, int wave_p, int lane_p, float* scal_w) {
    using namespace pg2;
    int tid = tid_p, wave = wave_p, lane = lane_p;
    const int bh = bid >> 3, b = bh >> 3, h = bh & 7, r8 = bid & 7;
    LAS float* cw = (LAS float*)(lds + CW); LAS float* sc = (LAS float*)(lds + SC);
    LAS bf16* q_ = (LAS bf16*)(lds + Q); LAS bf16* k_ = (LAS bf16*)(lds + K); LAS bf16* vT = (LAS bf16*)(lds + VT);
    LAS bf16* rq = (LAS bf16*)(lds + RAWT); LAS bf16* rk = rq + 70 * 136; LAS bf16* rv = rk + 70 * 136;
    LAS bf16* Abf = (LAS bf16*)(lds + ABF); LAS bf16* Trm = (LAS bf16*)(lds + TRM); LAS bf16* Ttr = (LAS bf16*)(lds + TTR);
    LAS float* ADf = (LAS float*)(lds + AD); LAS bf16* Xs = (LAS bf16*)(lds + XS); LAS bf16* QKp = (LAS bf16*)(lds + QKP);
    LAS bf16* st = (LAS bf16*)(lds + pgd::STASH);
    for (int e = tid; e < 8 * 384; e += 512) { const int r = e / 384, c = e % 384;
        const int gch = (c >> 7) * 1024 + h * 128 + (c & 127);
        cw[e] = r < 7 ? conv_w[r * CONV_CH + gch] : conv_b[gch]; }
    const float LOG2E = 1.4426950408889634f;
    const float expAf = expf(A_log[h]), dtbf = dt_bias[h], expAb = expf(A_log[8 + h]), dtbb = dt_bias[8 + h];
    const size_t rowb = (size_t)b * SEQ;
    u32x4 pre[7];
#define PG2_LOAD(u_) do { const int t0_ = (r8 * 16 + (u_)) * 64; \
        _Pragma("unroll") for (int x = 0; x < 7; ++x) { const int e = tid + 512 * x; const int r = e / 48, p = e % 48; \
            pre[x] = (u32x4){0u, 0u, 0u, 0u}; \
            if (e < 70 * 48 && r >= 3 && !(r >= 67 && (u_) == 15)) { const int col = p < 16 ? h * 128 + p * 8 : (p < 32 ? 1024 + h * 128 + (p - 16) * 8 : 2048 + h * 128 + (p - 32) * 8); \
                pre[x] = *(const GAS u32x4*)(raw + (rowb + t0_ - 3 + r) * CONV_CH + col); } } } while (0)
    PG2_LOAD(0);
    float psa = 0.f, psb = 0.f;
#define PG2_LOADS(u_) do { if (wave < 2) { const size_t so_ = (rowb + (size_t)(r8 * 16 + (u_)) * 64 + lane) * 64; psa = scal[so_ + 16 + 8 * wave + h]; psb = scal[so_ + 8 * wave + h]; } } while (0)
    PG2_LOADS(0);
    __syncthreads();
#define PG2_STAGEA(u_) do { const int t0_ = (r8 * 16 + (u_)) * 64; \
        _Pragma("unroll") for (int x = 0; x < 7; ++x) { const int e = tid + 512 * x; const int r = e / 48, p = e % 48; \
            if (e < 70 * 48) { u32x4 v = pre[x]; \
                if (r < 3) v = *(const LAS u32x4*)(st + r * 384 + p * 8); \
                else if (r >= 67 && (u_) == 15) v = *(const LAS u32x4*)(st + 1152 + (r - 67) * 384 + p * 8); \
                *(LAS u32x4*)((p < 16 ? rq + r * 136 + p * 8 : (p < 32 ? rk + r * 136 + (p - 16) * 8 : rv + r * 136 + (p - 32) * 8))) = v; } } \
        if (wave == 0) { const int i = lane; const size_t so = (rowb + t0_ + i) * 64; \
            const float gc = scan_fwd64(-expAf * softplus_fast(psa + dtbf), i); \
            const float be_ = sigmoid_fast(psb); sc[i] = be_; sc[64 + i] = gc * LOG2E; scal_w[so + h] = be_; scal_w[so + 16 + h] = gc; } \
        if (wave == 1) { const int i = lane; const size_t so = (rowb + t0_ + i) * 64; \
            const float gc = scan_bwd64(-expAb * softplus_fast(psa + dtbb), i); \
            const float be_ = sigmoid_fast(psb); sc[128 + i] = be_; sc[192 + i] = gc * LOG2E; scal_w[so + 8 + h] = be_; scal_w[so + 24 + h] = gc; } } while (0)
    PG2_STAGEA(0);
    PG2_LOAD(1); PG2_LOADS(1);
    __syncthreads();
    for (int u = 0; u < 16; ++u) {
        tid = tid_p; asm volatile("" : "+v"(tid));
        lane = tid & 63; wave = __builtin_amdgcn_readfirstlane(tid >> 6);
        const int fr = lane & 15, fq = lane >> 4, half = wave >> 2, w4 = wave & 3;
        const int c = r8 * 16 + u, t0 = c * 64;
        if (tid < 144) { const int r = tid / 48, p = tid % 48;
            const LAS bf16* s = p < 16 ? rq + (64 + r) * 136 + p * 8 : (p < 32 ? rk + (64 + r) * 136 + (p - 16) * 8 : rv + (64 + r) * 136 + (p - 32) * 8);
            *(LAS u32x4*)(st + r * 384 + p * 8) = *(const LAS u32x4*)s; }
        { const int tg = wave, cp = lane; float w[16], o[16];
#pragma unroll
          for (int tap = 0; tap < 8; ++tap) { w[2 * tap] = cw[tap * 384 + 2 * cp]; w[2 * tap + 1] = cw[tap * 384 + 2 * cp + 1]; }
          conv_pair8(o, rq + (8 * tg) * 136 + 2 * cp, 136, w);
#pragma unroll
          for (int t = 0; t < 8; ++t) { o[2 * t] = silu(o[2 * t]); o[2 * t + 1] = silu(o[2 * t + 1]);
              const float rs = __builtin_amdgcn_rsqf(wave_sum(o[2 * t] * o[2 * t] + o[2 * t + 1] * o[2 * t + 1]) + EPS) * 0.08838834764831845f;
              const unsigned pk = pkbf(o[2 * t] * rs, o[2 * t + 1] * rs);
              *(LAS unsigned*)(q_ + (8 * tg + t) * 136 + 2 * cp) = pk; *(GAS unsigned*)(raw + (rowb + t0 + 8 * tg + t) * CONV_CH + h * 128 + 2 * cp) = pk; }
#pragma unroll
          for (int tap = 0; tap < 8; ++tap) { w[2 * tap] = cw[tap * 384 + 128 + 2 * cp]; w[2 * tap + 1] = cw[tap * 384 + 128 + 2 * cp + 1]; }
          conv_pair8(o, rk + (8 * tg) * 136 + 2 * cp, 136, w);
#pragma unroll
          for (int t = 0; t < 8; ++t) { o[2 * t] = silu(o[2 * t]); o[2 * t + 1] = silu(o[2 * t + 1]);
              const float rs = __builtin_amdgcn_rsqf(wave_sum(o[2 * t] * o[2 * t] + o[2 * t + 1] * o[2 * t + 1]) + EPS);
              const unsigned pk = pkbf(o[2 * t] * rs, o[2 * t + 1] * rs);
              *(LAS unsigned*)(k_ + (8 * tg + t) * 136 + 2 * cp) = pk; *(GAS unsigned*)(raw + (rowb + t0 + 8 * tg + t) * CONV_CH + 1024 + h * 128 + 2 * cp) = pk; }
#pragma unroll
          for (int tap = 0; tap < 8; ++tap) { w[2 * tap] = cw[tap * 384 + 256 + 2 * cp]; w[2 * tap + 1] = cw[tap * 384 + 256 + 2 * cp + 1]; }
          conv_pair8(o, rv + (8 * tg) * 136 + 2 * cp, 136, w);
#pragma unroll
          for (int t = 0; t < 16; ++t) o[t] = silu(o[t]);
          u32x4 e0, e1; e0.x = pkbf(o[0], o[2]); e0.y = pkbf(o[4], o[6]); e0.z = pkbf(o[8], o[10]); e0.w = pkbf(o[12], o[14]);
          e1.x = pkbf(o[1], o[3]); e1.y = pkbf(o[5], o[7]); e1.z = pkbf(o[9], o[11]); e1.w = pkbf(o[13], o[15]);
          *(LAS u32x4*)(vT + (2 * cp) * 72 + 8 * tg) = e0; *(LAS u32x4*)(vT + (2 * cp + 1) * 72 + 8 * tg) = e1;
        }
        __syncthreads();
        for (int e = tid; e < 128 * 8; e += 512) { const int dv = e >> 3, p = e & 7;
            *(GAS u32x4*)(raw + (rowb + t0 + (dv >> 1)) * CONV_CH + 2048 + h * 128 + (dv & 1) * 64 + p * 8) = *(const LAS u32x4*)(vT + dv * 72 + p * 8); }
        for (int e = tid; e < 2 * 2 * 64 * 72 * 2 / 16; e += 512) ((LAS u32x4*)(lds + TRM))[e] = (u32x4){0u, 0u, 0u, 0u};
        for (int e = tid; e < 2 * 32 * 40 * 2 / 16; e += 512) ((LAS u32x4*)(lds + XS))[e] = (u32x4){0u, 0u, 0u, 0u};
        { const int mt = w4;
          f32x4 acc[1][4];
#pragma unroll
          for (int nt = 0; nt < 4; ++nt) acc[0][nt] = (f32x4){0.f, 0.f, 0.f, 0.f};
          mma_lds<1, 4>(acc, half ? q_ : k_, 136, mt * 16, k_, 136, 0, 128, fr, fq);
          const int i0 = mt * 16 + 4 * fq;
          const f32x4 gfi = *(const LAS f32x4*)(sc + 64 + i0), gbi = *(const LAS f32x4*)(sc + 192 + i0), bfi = *(const LAS f32x4*)(sc + i0), bbi = *(const LAS f32x4*)(sc + 128 + i0);
          float gfj[4], gbj[4];
#pragma unroll
          for (int nt = 0; nt < 4; ++nt) { gfj[nt] = sc[64 + nt * 16 + fr]; gbj[nt] = sc[192 + nt * 16 + fr]; }
          asm volatile("" ::: "memory");
#pragma unroll
          for (int nt = 0; nt < 4; ++nt)
#pragma unroll
              for (int r = 0; r < 4; ++r) { const int i = i0 + r, j = nt * 16 + fr; const bool lower = i > j, upper = i < j;
                  const float argl = gfi[r] - gfj[nt], argu = gbi[r] - gbj[nt];
                  const float x = acc[0][nt][r] * __builtin_amdgcn_exp2f(fminf(lower ? argl : argu, 0.f));
                  if (half == 0) { const float af = lower ? bfi[r] * x : 0.f, ab = upper ? bbi[r] * x : 0.f;
                      Abf[i * 72 + j] = f2bf1(af); Abf[64 * 72 + j * 72 + i] = f2bf1(ab);
                      if (mt == nt) { ADf[(mt * 16 + (i & 15)) * 16 + (j & 15)] = af; ADf[1024 + (mt * 16 + (j & 15)) * 16 + (i & 15)] = ab; } }
                  else QKp[i * 72 + j] = f2bf1(i == j ? acc[0][nt][r] : x); }
        }
        __syncthreads();
        { LAS bf16* Ab = Abf + half * 64 * 72; LAS bf16* Tr = Trm + half * 64 * 72; LAS bf16* Tt = Ttr + half * 64 * 72; LAS bf16* Xh = Xs + half * 32 * 40;
          if (w4 == 0) { const int blk = lane >> 4, cc = lane & 15; float t[16]; const LAS float* ad = ADf + half * 1024 + blk * 256;
#pragma unroll
              for (int i = 0; i < 16; ++i) t[i] = (i == cc) ? 1.f : 0.f;
#pragma unroll
              for (int i = 1; i < 16; ++i) { float s0 = 0.f, s1 = 0.f;
#pragma unroll
                  for (int j = 0; j < i; ++j) { if (j & 1) s1 += ad[i * 16 + j] * t[j]; else s0 += ad[i * 16 + j] * t[j]; }
                  t[i] = (i > cc) ? -(s0 + s1) : t[i];
                  if ((i & 3) == 3) asm volatile("" ::: "memory"); }
#pragma unroll
              for (int i = 0; i < 16; ++i) { const unsigned short tb = f2bf1(t[i]); Tr[(blk * 16 + i) * 72 + blk * 16 + cc] = tb; Tt[(blk * 16 + cc) * 72 + blk * 16 + i] = tb; } }
          __syncthreads();
          f32x4 a1[1][1];
          if (w4 < 2) { const int J = 2 * w4, I = J + 1; a1[0][0] = (f32x4){0.f, 0.f, 0.f, 0.f};
              mma_lds<1, 1>(a1, Ab + 16 * J, 72, 16 * I, Tt + 16 * J, 72, 16 * J, 32, fr, fq);
              u32x2 wv; wv.x = pkbf(a1[0][0][0], a1[0][0][1]); wv.y = pkbf(a1[0][0][2], a1[0][0][3]);
              *(LAS u32x2*)(Xh + (w4 * 16 + fr) * 40 + 4 * fq) = wv; }
          __syncthreads();
          if (w4 < 2) { const int J = 2 * w4, I = J + 1; a1[0][0] = (f32x4){0.f, 0.f, 0.f, 0.f};
              mma_lds<1, 1>(a1, Tr + 16 * I, 72, 16 * I, Xh, 40, w4 * 16, 32, fr, fq);
#pragma unroll
              for (int r = 0; r < 4; ++r) Tr[(16 * I + 4 * fq + r) * 72 + 16 * J + fr] = f2bf1(-a1[0][0][r]);
              u32x2 wv; wv.x = pkbf(-a1[0][0][0], -a1[0][0][1]); wv.y = pkbf(-a1[0][0][2], -a1[0][0][3]);
              *(LAS u32x2*)(Tt + (16 * J + fr) * 72 + 16 * I + 4 * fq) = wv; }
          __syncthreads();
          { const int mt2 = w4 >> 1, nt2 = w4 & 1; a1[0][0] = (f32x4){0.f, 0.f, 0.f, 0.f};
            mma_lds<1, 1>(a1, Ab, 72, 32 + 16 * mt2, Tt, 72, 16 * nt2, 32, fr, fq);
            u32x2 wv; wv.x = pkbf(a1[0][0][0], a1[0][0][1]); wv.y = pkbf(a1[0][0][2], a1[0][0][3]);
            __syncthreads();
            *(LAS u32x2*)(Xh + (16 * nt2 + fr) * 40 + 16 * mt2 + 4 * fq) = wv;
            __syncthreads();
            a1[0][0] = (f32x4){0.f, 0.f, 0.f, 0.f};
            mma_lds<1, 1>(a1, Tr + 32, 72, 32 + 16 * mt2, Xh, 40, 16 * nt2, 32, fr, fq);
#pragma unroll
            for (int r = 0; r < 4; ++r) Tr[(32 + 16 * mt2 + 4 * fq + r) * 72 + 16 * nt2 + fr] = f2bf1(-a1[0][0][r]);
            u32x2 w2; w2.x = pkbf(-a1[0][0][0], -a1[0][0][1]); w2.y = pkbf(-a1[0][0][2], -a1[0][0][3]);
            *(LAS u32x2*)(Tt + (16 * nt2 + fr) * 72 + 32 + 16 * mt2 + 4 * fq) = w2; }
        }
        __syncthreads();
        { bf16* tq = TQ + ((size_t)(bh * NCHUNK + c)) * 8192;
          const int i = (tid >> 3) & 63, p = tid & 7;
          const u32x4 qkv = *(const LAS u32x4*)(QKp + i * 72 + p * 8);
          const bf16x8 lo = *(const LAS bf16x8*)(Trm + i * 72 + p * 8), up = *(const LAS bf16x8*)(Ttr + 64 * 72 + i * 72 + p * 8); bf16x8 o8;
#pragma unroll
          for (int y = 0; y < 8; ++y) { const int j = p * 8 + y; o8[y] = (i > j) ? lo[y] : (i < j ? up[y] : (short)0x3F80); }
          __syncthreads();
          if (u + 1 < 16) { PG2_STAGEA(u + 1); }
          asm volatile("" ::: "memory");
          *(GAS bf16x8*)(tq + i * 64 + p * 8) = o8; *(GAS u32x4*)(tq + 4096 + i * 64 + p * 8) = qkv;
          if (u + 2 < 16) { PG2_LOAD(u + 2); PG2_LOADS(u + 2); } }
        __syncthreads();
    }
#undef PG2_STAGEA
#undef PG2_LOAD
#undef PG2_LOADS
}

__device__ __forceinline__ void gdn_state_v1(LAS unsigned char* lds, int cid, const bf16* raw, const float* scal, const bf16* TQ,
                                             const float* A_log, const float* dt_bias, bf16* og, int tid, int wave, int lane) {
    using namespace gdn;
    const int dvh = cid & 1, dir = (cid >> 1) & 1, h = (cid >> 2) & 7, b = cid >> 5;
    const int fr = lane & 15, fq = lane >> 4;
    LAS float* sc = (LAS float*)(lds + SC);
    LAS bf16* q_ = (LAS bf16*)(lds + Q); LAS bf16* k_ = (LAS bf16*)(lds + K); LAS bf16* kdT = (LAS bf16*)(lds + KDT); LAS bf16* vT = (LAS bf16*)(lds + VT);
    LAS bf16* T_ = (LAS bf16*)(lds + T); LAS bf16* QKd = (LAS bf16*)(lds + QKD); LAS bf16* ST_ = (LAS bf16*)(lds + ST);
    LAS bf16* rT = (LAS bf16*)(lds + RT); LAS bf16* uT = (LAS bf16*)(lds + UT); LAS float* os = (LAS float*)(lds + OS);
    for (int e = tid; e < 64 * 136 / 2; e += 512) ((LAS unsigned*)ST_)[e] = 0u;
    const float expA = expf(A_log[dir * 8 + h]), dtb = dt_bias[dir * 8 + h];
    f32x4 sacc[4];
#pragma unroll
    for (int nt = 0; nt < 4; ++nt) sacc[nt] = (f32x4){0.f, 0.f, 0.f, 0.f};
    const size_t rowb = (size_t)b * SEQ; const int bh = b * 8 + h;
    __syncthreads();
    for (int n = 0; n < NCHUNK; ++n) {
        const int c = dir ? NCHUNK - 1 - n : n, t0 = c * 64;
        for (int e = tid; e < 64 * 16; e += 512) { const int r = e >> 4, p = e & 15;
            *(LAS u32x4*)(q_ + r * 136 + p * 8) = *(const GAS u32x4*)(raw + (rowb + t0 + r) * CONV_CH + h * 128 + p * 8);
            *(LAS u32x4*)(k_ + r * 136 + p * 8) = *(const GAS u32x4*)(raw + (rowb + t0 + r) * CONV_CH + 1024 + h * 128 + p * 8); }
        { const int dvl = tid >> 3, p = tid & 7; const int dv = dvh * 64 + dvl;
          *(LAS u32x4*)(vT + dvl * 72 + p * 8) = *(const GAS u32x4*)(raw + (rowb + t0 + (dv >> 1)) * CONV_CH + 2048 + h * 128 + (dv & 1) * 64 + p * 8); }
        { const bf16* tq = TQ + ((size_t)(bh * NCHUNK + c)) * 8192;
          for (int e = tid; e < 1024; e += 512) { const int which = e >> 9, i = (e >> 3) & 63, p = e & 7;
              bf16x8 v = *(const GAS bf16x8*)(tq + which * 4096 + i * 64 + p * 8);
#pragma unroll
              for (int x = 0; x < 8; ++x) { const int j = p * 8 + x; const bool keep = dir ? (i < j) : (i > j);
                  if (i == j) { if (which == 0) v[x] = (short)0x3F80; } else if (!keep) v[x] = 0; }
              *(LAS bf16x8*)((which ? QKd : T_) + i * 72 + p * 8) = v; } }
        if (wave == 0) { const int i = lane; const size_t so = (rowb + t0 + i) * 64;
            const float g = -expA * softplus_f(scal[so + 16 + dir * 8 + h] + dtb); float gc = g;
            if (dir == 0) {
#pragma unroll
                for (int o = 1; o < 64; o <<= 1) { const float y = __shfl_up(gc, o); if (i >= o) gc += y; }
            } else {
#pragma unroll
                for (int o = 1; o < 64; o <<= 1) { const float y = __shfl_down(gc, o); if (i + o < 64) gc += y; }
            }
            const float gl = __shfl(gc, dir ? 0 : 63);
            sc[i] = sigmoid_f(scal[so + dir * 8 + h]); sc[64 + i] = gc; sc[128 + i] = expf(gc); sc[192 + i] = expf(gl - gc); if (i == 0) sc[256] = expf(gl); }
        __syncthreads();
        { const int i = tid >> 3, cg = tid & 7; const float ek = sc[192 + i];
          const bf16x8 k0 = *(const LAS bf16x8*)(k_ + i * 136 + cg * 16), k1 = *(const LAS bf16x8*)(k_ + i * 136 + cg * 16 + 8);
#pragma unroll
          for (int x = 0; x < 8; ++x) { kdT[(cg * 16 + x) * 72 + i] = f2bf1(bf2f_s(k0[x]) * ek); kdT[(cg * 16 + 8 + x) * 72 + i] = f2bf1(bf2f_s(k1[x]) * ek); } }
        __syncthreads();
        const int mt = wave & 3, nh = wave >> 2;
        f32x4 aq[2];
        { f32x4 ak[2]; ak[0] = ak[1] = aq[0] = aq[1] = (f32x4){0.f, 0.f, 0.f, 0.f};
          for (int k0 = 0; k0 < 128; k0 += 32) {
              const bf16x8 fk = *(const LAS bf16x8*)(k_ + (mt * 16 + fr) * 136 + k0 + fq * 8), fqv = *(const LAS bf16x8*)(q_ + (mt * 16 + fr) * 136 + k0 + fq * 8);
#pragma unroll
              for (int nl = 0; nl < 2; ++nl) { const bf16x8 fb = *(const LAS bf16x8*)(ST_ + (nh * 32 + nl * 16 + fr) * 136 + k0 + fq * 8);
                  ak[nl] = __builtin_amdgcn_mfma_f32_16x16x32_bf16(fk, fb, ak[nl], 0, 0, 0); aq[nl] = __builtin_amdgcn_mfma_f32_16x16x32_bf16(fqv, fb, aq[nl], 0, 0, 0); } }
          const int i0 = mt * 16 + 4 * fq;
          const f32x4 be4 = *(const LAS f32x4*)(sc + i0), eg4 = *(const LAS f32x4*)(sc + 128 + i0);
#pragma unroll
          for (int nl = 0; nl < 2; ++nl) { const int dv = nh * 32 + nl * 16 + fr;
              const bf16x4 vv = *(const LAS bf16x4*)(vT + dv * 72 + i0);
              float r0 = be4[0] * (bf2f_s(vv[0]) - eg4[0] * ak[nl][0]), r1 = be4[1] * (bf2f_s(vv[1]) - eg4[1] * ak[nl][1]);
              float r2 = be4[2] * (bf2f_s(vv[2]) - eg4[2] * ak[nl][2]), r3 = be4[3] * (bf2f_s(vv[3]) - eg4[3] * ak[nl][3]);
              u32x2 w; w.x = pkbf(r0, r1); w.y = pkbf(r2, r3); *(LAS u32x2*)(rT + dv * 72 + i0) = w;
              aq[nl][0] *= eg4[0]; aq[nl][1] *= eg4[1]; aq[nl][2] *= eg4[2]; aq[nl][3] *= eg4[3]; }
        }
        __syncthreads();
        { f32x4 au[1][2]; au[0][0] = au[0][1] = (f32x4){0.f, 0.f, 0.f, 0.f};
          mma_lds<1, 2>(au, T_, 72, mt * 16, rT, 72, nh * 32, 64, fr, fq);
          const int i0 = mt * 16 + 4 * fq;
#pragma unroll
          for (int nl = 0; nl < 2; ++nl) { const int dv = nh * 32 + nl * 16 + fr; u32x2 w; w.x = pkbf(au[0][nl][0], au[0][nl][1]); w.y = pkbf(au[0][nl][2], au[0][nl][3]); *(LAS u32x2*)(uT + dv * 72 + i0) = w; }
        }
        __syncthreads();
        { f32x4 ao[1][2]; ao[0][0] = aq[0]; ao[0][1] = aq[1];
          mma_lds<1, 2>(ao, QKd, 72, mt * 16, uT, 72, nh * 32, 64, fr, fq);
          const int i0 = mt * 16 + 4 * fq;
#pragma unroll
          for (int nl = 0; nl < 2; ++nl)
#pragma unroll
              for (int r = 0; r < 4; ++r) os[(i0 + r) * 65 + nh * 32 + nl * 16 + fr] = ao[0][nl][r];
          const float egl = sc[256];
          f32x4 as_[1][4];
#pragma unroll
          for (int nt = 0; nt < 4; ++nt) as_[0][nt] = sacc[nt] * egl;
          mma_lds<1, 4>(as_, kdT, 72, wave * 16, uT, 72, 0, 64, fr, fq);
#pragma unroll
          for (int nt = 0; nt < 4; ++nt) { sacc[nt] = as_[0][nt];
              u32x2 w; w.x = pkbf(sacc[nt][0], sacc[nt][1]); w.y = pkbf(sacc[nt][2], sacc[nt][3]); *(LAS u32x2*)(ST_ + (nt * 16 + fr) * 136 + wave * 16 + 4 * fq) = w; }
        }
        __syncthreads();
#pragma unroll
        for (int ii = 0; ii < 4; ++ii) { const int i = wave * 8 + 2 * ii + (lane >> 5), cp = lane & 31;
            atomic_add_bf16x2(og + (rowb + t0 + i) * 1024 + h * 128 + dvh * 64 + 2 * cp, os[i * 65 + 2 * cp], os[i * 65 + 2 * cp + 1]); }
        __syncthreads();
    }
}
typedef float f32x16 __attribute__((ext_vector_type(16)));
typedef short v4i16_t __attribute__((ext_vector_type(4)));
namespace gs2 {
constexpr int KO = 0;
constexpr int QO = KO + 64 * 132 * 2;
constexpr int VTO = QO + 64 * 132 * 2;
constexpr int TO = VTO + 64 * 68 * 2;
constexpr int QKO = TO + 64 * 68 * 2;
constexpr int SCO = QKO + 64 * 68 * 2;
constexpr int BUF = SCO + 1024;
constexpr int OST = 2 * BUF;
constexpr int END = OST + 2 * 64 * 72 * 2;
static_assert(END <= MISC_OFF && BUF % 16 == 0, "gdn state LDS map");
}
__device__ __forceinline__ bf16x8 cvt8(const f32x16& x, int base) {
    u32x4 w; w.x = pkbf(x[base], x[base + 1]); w.y = pkbf(x[base + 2], x[base + 3]); w.z = pkbf(x[base + 4], x[base + 5]); w.w = pkbf(x[base + 6], x[base + 7]);
    return __builtin_bit_cast(bf16x8, w);
}
__device__ __forceinline__ bf16x8 afrag(const LAS bf16* p) {
    const bf16x4 lo = *(const LAS bf16x4*)p, hi = *(const LAS bf16x4*)(p + 8);
    return (bf16x8){lo[0], lo[1], lo[2], lo[3], hi[0], hi[1], hi[2], hi[3]};
}
__device__ __forceinline__ bf16x8 afrag_tr(const LAS bf16* p, int ld) {
    const v4i16_t lo = __builtin_amdgcn_ds_read_tr16_b64_v4i16((LAS v4i16_t*)p), hi = __builtin_amdgcn_ds_read_tr16_b64_v4i16((LAS v4i16_t*)(p + 8 * ld));
    return (bf16x8){lo[0], lo[1], lo[2], lo[3], hi[0], hi[1], hi[2], hi[3]};
}
#define MFMA32(a, b, c) __builtin_amdgcn_mfma_f32_32x32x16_bf16((a), (b), (c), 0, 0, 0)

#ifndef WG_BAR
#define WG_BAR() asm volatile("s_waitcnt lgkmcnt(0)\n\ts_barrier" ::: "memory")
#endif
template <int DIR>
__device__ __forceinline__ void gdn_state2(LAS unsigned char* lds, int b, int h, int half, const bf16* raw, const float* scal, const bf16* TQ,
                                           const float* A_log, const float* dt_bias, bf16* og, int tid, int wave, int lane, float* probe = nullptr) {
    using namespace gs2;
    const size_t rowb = (size_t)b * SEQ; const int bh = b * 8 + h;
    const float expA = expf(A_log[DIR * 8 + h]), dtb = dt_bias[DIR * 8 + h];
    LAS bf16* ost = (LAS bf16*)(lds + OST);
    const int r31 = lane & 31, hh = lane >> 5;
    if (wave == 4 || wave == 5) {
        for (int n = 0; n < NCHUNK + 1; ++n) WG_BAR();
    } else if (wave >= 2) {
        const int hw = (wave & 1) | ((wave >> 2) << 1);
        const int ht = hw * 64 + lane;
        unsigned go[14], lo_[14]; u32x4 ld[14]; float sr0 = 0.f, sr1 = 0.f;
#pragma unroll
        for (int x = 0; x < 4; ++x) { const int e = ht + 256 * x, r = e >> 4, p = e & 15;
            go[x] = (unsigned)((r * CONV_CH + 1024 + h * 128 + p * 8) * 2); go[4 + x] = (unsigned)((r * CONV_CH + h * 128 + p * 8) * 2);
            lo_[x] = (unsigned)(KO + (r * 132 + p * 8) * 2); lo_[4 + x] = (unsigned)(QO + (r * 132 + p * 8) * 2); }
#pragma unroll
        for (int x = 0; x < 2; ++x) { const int e = ht + 256 * x, dvl = e >> 3, p = e & 7; const int dv = 64 * half + dvl;
            go[8 + x] = (unsigned)(((dv >> 1) * CONV_CH + 2048 + h * 128 + (dv & 1) * 64 + p * 8) * 2); lo_[8 + x] = (unsigned)(VTO + (dvl * 68 + p * 8) * 2); }
        u32x4 km[2], dg[2], qm[2];
#pragma unroll
        for (int x = 0; x < 2; ++x) { const int e = ht + 256 * x, i = e >> 3, p = e & 7;
            go[10 + x] = (unsigned)(e * 16); go[12 + x] = (unsigned)(8192 + e * 16);
            lo_[10 + x] = (unsigned)(TO + (i * 68 + p * 8) * 2); lo_[12 + x] = (unsigned)(QKO + (i * 68 + p * 8) * 2);
            unsigned kw[4], dw[4], qw[4];
#pragma unroll
            for (int w = 0; w < 4; ++w) { const int j0 = p * 8 + 2 * w, j1 = j0 + 1;
                const bool k0 = DIR ? (i < j0) : (i > j0), k1 = DIR ? (i < j1) : (i > j1);
                kw[w] = (k0 ? 0xFFFFu : 0u) | (k1 ? 0xFFFF0000u : 0u); dw[w] = (i == j0 ? 0x3F80u : 0u) | (i == j1 ? 0x3F800000u : 0u);
                qw[w] = kw[w] | (i == j0 ? 0xFFFFu : 0u) | (i == j1 ? 0xFFFF0000u : 0u); }
            km[x] = (u32x4){kw[0], kw[1], kw[2], kw[3]}; dg[x] = (u32x4){dw[0], dw[1], dw[2], dw[3]}; qm[x] = (u32x4){qw[0], qw[1], qw[2], qw[3]}; }
        const unsigned so_l = (unsigned)(lane * 256 + (DIR * 8 + h) * 4);
#define GS2_ISSUE(c_) do { const GAS char* rb_ = (const GAS char*)(raw + (rowb + (size_t)(c_) * 64) * CONV_CH); const GAS char* tb_ = (const GAS char*)(TQ + ((size_t)(bh * NCHUNK + (c_))) * 8192); \
            _Pragma("unroll") for (int x = 0; x < 10; ++x) ld[x] = *(const GAS u32x4*)(rb_ + go[x]); \
            _Pragma("unroll") for (int x = 10; x < 14; ++x) ld[x] = *(const GAS u32x4*)(tb_ + go[x]); \
            if (hw == 0) { const GAS char* sb_ = (const GAS char*)(scal + (rowb + (size_t)(c_) * 64) * 64); sr0 = *(const GAS float*)(sb_ + so_l); sr1 = *(const GAS float*)(sb_ + so_l + 64); } } while (0)
#define GS2_ST16(off_, v_) do { LAS unsigned char* d_ = B_ + (off_); *(LAS u32x2*)(d_) = (u32x2){(v_).x, (v_).y}; *(LAS u32x2*)(d_ + 8) = (u32x2){(v_).z, (v_).w}; } while (0)
#define GS2_COMMIT(bi_, c_) do { LAS unsigned char* B_ = lds + (bi_) * BUF; \
            _Pragma("unroll") for (int x = 0; x < 10; ++x) GS2_ST16(lo_[x], ld[x]); \
            _Pragma("unroll") for (int x = 0; x < 2; ++x) { const u32x4 tv = (ld[10 + x] & km[x]) | dg[x], qv = ld[12 + x] & qm[x]; \
                GS2_ST16(lo_[10 + x], tv); GS2_ST16(lo_[12 + x], qv); } \
            if (hw == 0) { LAS float* sc_ = (LAS float*)(B_ + SCO); const int i = lane; const float gc = sr1; const float gl = __shfl(gc, DIR ? 0 : 63); \
                sc_[i] = sr0; sc_[64 + i] = __expf(gc); sc_[128 + i] = __expf(gl - gc); if (i == 0) sc_[192] = __expf(gl); } } while (0)
        { const int c0 = DIR ? NCHUNK - 1 : 0; GS2_ISSUE(c0); GS2_COMMIT(0, c0); GS2_ISSUE((DIR ? c0 - 1 : c0 + 1)); }
        for (int n = 0; n < NCHUNK; ++n) {
            const int c = DIR ? NCHUNK - 1 - n : n;
            WG_BAR();
            const bool more = n + 1 < NCHUNK; const int cn = DIR ? c - 1 : c + 1;
            if (more) { GS2_COMMIT((n + 1) & 1, cn); if (n + 2 < NCHUNK) GS2_ISSUE((DIR ? cn - 1 : cn + 1)); }
            unsigned ov[8];
            if (n > 0) {
#pragma unroll
                for (int x = 0; x < 8; ++x) ov[x] = *(const LAS unsigned*)(ost + ((n - 1) & 1) * (64 * 72) + (hw * 16 + 2 * x + (lane >> 5)) * 72 + 2 * (lane & 31));
            }
            if (n > 0) { const int tp = (DIR ? c + 1 : c - 1) * 64;
#pragma unroll
                for (int x = 0; x < 8; ++x) { GAS char* ob_ = (GAS char*)(og + (rowb + tp + hw * 16 + 2 * x) * 1024 + h * 128 + half * 64);
                    (void)__builtin_amdgcn_global_atomic_fadd_v2bf16((GAS s16x2*)(ob_ + (lane >> 5) * 2048 + (lane & 31) * 4), __builtin_bit_cast(s16x2, ov[x])); } }
        }
        WG_BAR();
        { const int tp = (DIR ? 0 : NCHUNK - 1) * 64;
#pragma unroll
          for (int x = 0; x < 8; ++x) { const unsigned v = *(const LAS unsigned*)(ost + ((NCHUNK - 1) & 1) * (64 * 72) + (hw * 16 + 2 * x + (lane >> 5)) * 72 + 2 * (lane & 31));
              GAS char* ob_ = (GAS char*)(og + (rowb + tp + hw * 16 + 2 * x) * 1024 + h * 128 + half * 64);
              (void)__builtin_amdgcn_global_atomic_fadd_v2bf16((GAS s16x2*)(ob_ + (lane >> 5) * 2048 + (lane & 31) * 4), __builtin_bit_cast(s16x2, v)); } }
#undef GS2_ISSUE
#undef GS2_COMMIT
#undef GS2_ST16
    } else {
        const int dv0 = 32 * wave;
#if defined(PROBE_STATE)
        unsigned long long tw_ = 0ull; const unsigned long long ts0_ = __builtin_amdgcn_s_memtime();
#define PB_BAR() do { const unsigned long long t0_ = __builtin_amdgcn_s_memtime(); WG_BAR(); tw_ += __builtin_amdgcn_s_memtime() - t0_; } while (0)
#else
#define PB_BAR() WG_BAR()
#endif
        f32x16 St[4];
#pragma unroll
        for (int t = 0; t < 4; ++t)
#pragma unroll
            for (int r = 0; r < 16; ++r) St[t][r] = 0.f;
        for (int n = 0; n < NCHUNK; ++n) {
            PB_BAR();
            const LAS unsigned char* Bb = lds + (n & 1) * BUF;
            const LAS bf16* Kb = (const LAS bf16*)(Bb + KO); const LAS bf16* Qb = (const LAS bf16*)(Bb + QO); const LAS bf16* Vb = (const LAS bf16*)(Bb + VTO);
            const LAS bf16* Tb = (const LAS bf16*)(Bb + TO); const LAS bf16* QKb = (const LAS bf16*)(Bb + QKO); const LAS float* sc = (const LAS float*)(Bb + SCO);
            f32x16 aK[2];
#pragma unroll
            for (int m = 0; m < 2; ++m)
#pragma unroll
                for (int r = 0; r < 16; ++r) aK[m][r] = 0.f;
            bf16x8 fa[2][2];
            const int offk = r31 * 132 + 4 * hh;
#define GS2_LD2(P_, bi_, ks_) do { fa[bi_][0] = afrag((P_) + offk + 16 * (ks_)); fa[bi_][1] = afrag((P_) + offk + 32 * 132 + 16 * (ks_)); } while (0)
            GS2_LD2(Kb, 0, 0);
#pragma unroll
            for (int ks = 0; ks < 8; ++ks) {
                if (ks < 7) GS2_LD2(Kb, (ks + 1) & 1, ks + 1);
                __builtin_amdgcn_sched_barrier(0);
                const bf16x8 bs = cvt8(St[ks >> 1], 8 * (ks & 1));
                aK[0] = MFMA32(fa[ks & 1][0], bs, aK[0]); aK[1] = MFMA32(fa[ks & 1][1], bs, aK[1]);
                __builtin_amdgcn_sched_barrier(0); }
            bf16x8 ft[8];
#pragma unroll
            for (int mi = 0; mi < 2; ++mi)
#pragma unroll
                for (int kt = 0; kt < 4; ++kt) { const bool need = DIR ? (kt >= 2 * mi) : (kt <= 2 * mi + 1);
                    if (need) ft[mi * 4 + kt] = afrag(Tb + (32 * mi + r31) * 68 + 16 * kt + 4 * hh); }
#pragma unroll
            for (int m = 0; m < 2; ++m)
#pragma unroll
                for (int q4 = 0; q4 < 4; ++q4) { const int tb = 32 * m + 8 * q4 + 4 * hh;
                    const bf16x4 vv = *(const LAS bf16x4*)(Vb + (dv0 + r31) * 68 + tb); const f32x4 be = *(const LAS f32x4*)(sc + tb), eg = *(const LAS f32x4*)(sc + 64 + tb);
#pragma unroll
                    for (int e = 0; e < 4; ++e) aK[m][4 * q4 + e] = be[e] * (bf2f_s(vv[e]) - eg[e] * aK[m][4 * q4 + e]); }
            const bf16x8 br0 = cvt8(aK[0], 0), br1 = cvt8(aK[0], 8), br2 = cvt8(aK[1], 0), br3 = cvt8(aK[1], 8);
            __builtin_amdgcn_sched_barrier(0);
            f32x16 au[2];
#pragma unroll
            for (int m = 0; m < 2; ++m)
#pragma unroll
                for (int r = 0; r < 16; ++r) au[m][r] = 0.f;
            GS2_LD2(Qb, 0, 0);
#pragma unroll
            for (int mi = 0; mi < 2; ++mi)
#pragma unroll
                for (int kt = 0; kt < 4; ++kt) { const bool need = DIR ? (kt >= 2 * mi) : (kt <= 2 * mi + 1);
                    if (need) au[mi] = MFMA32(ft[mi * 4 + kt], (kt == 0 ? br0 : kt == 1 ? br1 : kt == 2 ? br2 : br3), au[mi]); }
            __builtin_amdgcn_sched_barrier(0);
            f32x16 aQ[2];
#pragma unroll
            for (int m = 0; m < 2; ++m)
#pragma unroll
                for (int r = 0; r < 16; ++r) aQ[m][r] = 0.f;
#pragma unroll
            for (int ks = 0; ks < 8; ++ks) {
                if (ks < 7) GS2_LD2(Qb, (ks + 1) & 1, ks + 1);
                __builtin_amdgcn_sched_barrier(0);
                const bf16x8 bs = cvt8(St[ks >> 1], 8 * (ks & 1));
                aQ[0] = MFMA32(fa[ks & 1][0], bs, aQ[0]); aQ[1] = MFMA32(fa[ks & 1][1], bs, aQ[1]);
                __builtin_amdgcn_sched_barrier(0); }
#undef GS2_LD2
            const bf16x8 bu0 = cvt8(au[0], 0), bu1 = cvt8(au[0], 8), bu2 = cvt8(au[1], 0), bu3 = cvt8(au[1], 8);
#pragma unroll
            for (int m = 0; m < 2; ++m)
#pragma unroll
                for (int q4 = 0; q4 < 4; ++q4) { const int tb = 32 * m + 8 * q4 + 4 * hh; const f32x4 ek = *(const LAS f32x4*)(sc + 128 + tb), eg = *(const LAS f32x4*)(sc + 64 + tb);
#pragma unroll
                    for (int e = 0; e < 4; ++e) { au[m][4 * q4 + e] *= ek[e]; aQ[m][4 * q4 + e] *= eg[e]; } }
            const bf16x8 bd0 = cvt8(au[0], 0), bd1 = cvt8(au[0], 8), bd2 = cvt8(au[1], 0), bd3 = cvt8(au[1], 8);
            __builtin_amdgcn_sched_barrier(0);
            bf16x8 fqk[8];
#pragma unroll
            for (int mi = 0; mi < 2; ++mi)
#pragma unroll
                for (int kt = 0; kt < 4; ++kt) { const bool need = DIR ? (kt >= 2 * mi) : (kt <= 2 * mi + 1);
                    if (need) fqk[mi * 4 + kt] = afrag(QKb + (32 * mi + r31) * 68 + 16 * kt + 4 * hh); }
            const int i16 = r31 & 15; const LAS bf16* kp = Kb + (4 * hh + (i16 >> 2)) * 132 + 16 * (r31 >> 4) + 4 * (i16 & 3);
            bf16x8 fk[2][4];
#define GS2_LDKT(bi_, t_) do { _Pragma("unroll") for (int kt = 0; kt < 4; ++kt) fk[bi_][kt] = afrag_tr(kp + (16 * kt) * 132 + 32 * (t_), 132); } while (0)
            __builtin_amdgcn_sched_barrier(0);
#pragma unroll
            for (int mi = 0; mi < 2; ++mi)
#pragma unroll
                for (int kt = 0; kt < 4; ++kt) { const bool need = DIR ? (kt >= 2 * mi) : (kt <= 2 * mi + 1);
                    if (need) aQ[mi] = MFMA32(fqk[mi * 4 + kt], (kt == 0 ? bu0 : kt == 1 ? bu1 : kt == 2 ? bu2 : bu3), aQ[mi]); }
            GS2_LDKT(0, 0);
            const float egl = sc[192];
#pragma unroll
            for (int mi = 0; mi < 2; ++mi)
#pragma unroll
                for (int r = 0; r < 16; ++r) ost[(n & 1) * (64 * 72) + (32 * mi + (r & 3) + 8 * (r >> 2) + 4 * hh) * 72 + dv0 + r31] = f2bf1(aQ[mi][r]);
#pragma unroll
            for (int t = 0; t < 4; ++t) {
                if (t < 3) GS2_LDKT((t + 1) & 1, t + 1);
                __builtin_amdgcn_sched_barrier(0);
#pragma unroll
                for (int r = 0; r < 16; ++r) St[t][r] *= egl;
                St[t] = MFMA32(fk[t & 1][0], bd0, St[t]); St[t] = MFMA32(fk[t & 1][1], bd1, St[t]);
                St[t] = MFMA32(fk[t & 1][2], bd2, St[t]); St[t] = MFMA32(fk[t & 1][3], bd3, St[t]);
                __builtin_amdgcn_sched_barrier(0); }
#undef GS2_LDKT
        }
        WG_BAR();
#if defined(PROBE_STATE)
        if (blockIdx.x == 0 && tid == 0 && probe) { const unsigned long long tt_ = __builtin_amdgcn_s_memtime() - ts0_; *probe = (float)((double)tw_ / (double)tt_); }
#endif
    }
}
constexpr size_t WS_SSC = 1 * MiB;
namespace psd {
constexpr int CW = 0;
constexpr int SC = CW + 8 * 768 * 4;
constexpr int BM_ = SC + 8 * 4 * 64 * 4;
constexpr int CM_ = BM_ + 64 * 136 * 2;
constexpr int CB = CM_ + 64 * 136 * 2;
constexpr int R = CB + 64 * 68 * 4;
constexpr int RBC = R, RBC_END = R + 70 * 272 * 2;
constexpr int RX = R, XT = RX + 70 * 136 * 2, MM = XT + 128 * 72 * 2, R_END = MM + 2 * 64 * 72 * 2;
constexpr int YST = RX;
constexpr int PRBC = CW + 8 * 768 * 4, PXT = PRBC + 70 * 272 * 2, P_END = PXT + 256 * 72 * 2;
constexpr int STASH = pgd::STASH + 4608;
static_assert(P_END <= pgd::STASH, "prep ssd conv LDS map");
static_assert(RBC_END <= pgd::STASH && R_END <= pgd::STASH && STASH + 9216 <= MISC_OFF, "prep ssd LDS map");
}
__device__ __forceinline__ void prep_ssd_stash(LAS unsigned char* lds, int bid, const bf16* raw, int tid) {
    const int bg = bid >> 5, b = bg >> 1, g = bg & 1, r32 = bid & 31;
    LAS bf16* st = (LAS bf16*)(lds + psd::STASH);
    for (int e = tid; e < 2 * 3 * 96; e += 512) { const int which = e / 288, r = (e % 288) / 96, p = e % 96;
        const int t = which ? (r32 * 4 + 4) * 64 + r : r32 * 4 * 64 - 3 + r;
        const int col = p < 64 ? 3072 + g * 512 + p * 8 : (p < 80 ? 4096 + g * 128 + (p - 64) * 8 : 4352 + g * 128 + (p - 80) * 8);
        u32x4 v = (u32x4){0u, 0u, 0u, 0u};
        if (t >= 0 && t < SEQ) v = *(const GAS u32x4*)(raw + ((size_t)b * SEQ + t) * CONV_CH + col);
        *(LAS u32x4*)(st + which * 2304 + r * 768 + p * 8) = v; }
}
__device__ __forceinline__ void prep_ssd_range(LAS unsigned char* lds, int bid, bf16* raw, const float* conv_w, const float* conv_b, int tid_p,
                                               const float* scal, const float* A_log, const float* dt_bias, float* ssc) {
    using namespace psd;
    const int bg = bid >> 5, b = bg >> 1, g = bg & 1, r32 = bid & 31;
    LAS float* cw = (LAS float*)(lds + CW);
    LAS bf16* rbc = (LAS bf16*)(lds + PRBC); LAS bf16* xT = (LAS bf16*)(lds + PXT);
    LAS bf16* st = (LAS bf16*)(lds + STASH);
    for (int e = tid_p; e < 8 * 768; e += 512) { const int r = e / 768, c = e % 768;
        const int gch = c < 512 ? 3072 + g * 512 + c : (c < 640 ? 4096 + g * 128 + (c - 512) : 4352 + g * 128 + (c - 640));
        cw[e] = r < 7 ? conv_w[r * CONV_CH + gch] : conv_b[gch]; }
    const size_t rowb = (size_t)b * SEQ;
    u32x4 pre[5];
#define PSD_LOAD(u_, ps_) do { const int t0_ = (r32 * 4 + (u_)) * 64; \
        _Pragma("unroll") for (int x = 0; x < 5; ++x) { const int e = tid_p + 512 * x; const int r = e >> 5, p = e & 31; \
            pre[x] = (u32x4){0u, 0u, 0u, 0u}; \
            if (e < 70 * 32 && r >= 3 && !(r >= 67 && (u_) == 3)) { const int col = (ps_) == 0 ? (p < 16 ? 4096 + g * 128 + p * 8 : 4352 + g * 128 + (p - 16) * 8) : 3072 + g * 512 + ((ps_) - 1) * 256 + p * 8; \
                pre[x] = *(const GAS u32x4*)(raw + (rowb + t0_ - 3 + r) * CONV_CH + col); } } } while (0)
    PSD_LOAD(0, 0);
    float sdf[4], sdb[4];
    { const int lane0 = tid_p & 63, wave0 = tid_p >> 6, hd0 = g * 8 + wave0;
#pragma unroll
      for (int u = 0; u < 4; ++u) { const size_t so = (rowb + (size_t)(r32 * 4 + u) * 64 + lane0) * 64; sdf[u] = scal[so + 32 + hd0]; sdb[u] = scal[so + 48 + hd0]; } }
#define PSD_STAGE(u_, scol_) do { _Pragma("unroll") for (int x = 0; x < 5; ++x) { const int e = tid_p + 512 * x; const int r = e >> 5, p = e & 31; \
            if (e < 70 * 32) { u32x4 v = pre[x]; \
                if (r < 3) v = *(const LAS u32x4*)(st + r * 768 + (scol_) + p * 8); \
                else if (r >= 67 && (u_) == 3) v = *(const LAS u32x4*)(st + 2304 + (r - 67) * 768 + (scol_) + p * 8); \
                *(LAS u32x4*)(rbc + r * 272 + (p < 16 ? p * 8 : 136 + (p - 16) * 8)) = v; } } } while (0)
    __syncthreads();
    PSD_STAGE(0, 512);
    PSD_LOAD(0, 1);
    __syncthreads();
#pragma unroll
    for (int u = 0; u < 4; ++u) {
        int tid = tid_p; asm volatile("" : "+v"(tid));
        const int lane = tid & 63, wave = __builtin_amdgcn_readfirstlane(tid >> 6);
        const int c = r32 * 4 + u, t0 = c * 64;
        { const int hd = g * 8 + wave, i = lane;
          const float dtf = softplus_fast(sdf[u] + dt_bias[hd]), dtb = softplus_fast(sdb[u] + dt_bias[16 + hd]);
          const float cf = scan_fwd64(dtf * -expf(A_log[hd]), i), cbk = scan_bwd64(dtb * -expf(A_log[16 + hd]), i);
          float* sp = ssc + ((size_t)((b * 16 + hd) * NCHUNK + c)) * 256 + i; sp[0] = dtf; sp[64] = cf; sp[128] = dtb; sp[192] = cbk; }
        for (int ps = 0; ps < 3; ++ps) {
            const int scol = ps == 0 ? 512 : (ps == 1 ? 0 : 256);
            if (tid < 96) { const int r = tid >> 5, p = tid & 31;
                *(LAS u32x4*)(st + r * 768 + scol + p * 8) = *(const LAS u32x4*)(rbc + (64 + r) * 272 + (p < 16 ? p * 8 : 136 + (p - 16) * 8)); }
            unsigned bcv[16];
            { const int tg = wave, cp = lane; float w[16], o[16];
#pragma unroll
              for (int hf = 0; hf < 2; ++hf) {
#pragma unroll
                  for (int tap = 0; tap < 8; ++tap) { w[2 * tap] = cw[tap * 768 + scol + hf * 128 + 2 * cp]; w[2 * tap + 1] = cw[tap * 768 + scol + hf * 128 + 2 * cp + 1]; }
                  conv_pair8(o, rbc + (8 * tg) * 272 + hf * 136 + 2 * cp, 272, w);
#pragma unroll
                  for (int t = 0; t < 16; ++t) o[t] = silu(o[t]);
#pragma unroll
                  for (int t = 0; t < 8; ++t) bcv[hf * 8 + t] = pkbf(o[2 * t], o[2 * t + 1]);
                  if (ps != 0) {
                      u32x4 e0, e1; e0.x = pkbf(o[0], o[2]); e0.y = pkbf(o[4], o[6]); e0.z = pkbf(o[8], o[10]); e0.w = pkbf(o[12], o[14]);
                      e1.x = pkbf(o[1], o[3]); e1.y = pkbf(o[5], o[7]); e1.z = pkbf(o[9], o[11]); e1.w = pkbf(o[13], o[15]);
                      *(LAS u32x4*)(xT + (hf * 128 + 2 * cp) * 72 + 8 * tg) = e0; *(LAS u32x4*)(xT + (hf * 128 + 2 * cp + 1) * 72 + 8 * tg) = e1; } } }
            __syncthreads();
            const bool lastp = (u == 3 && ps == 2);
            if (!lastp) { if (ps < 2) PSD_STAGE(u, (ps == 0 ? 0 : 256)); else PSD_STAGE(u + 1, 512); }
            asm volatile("" ::: "memory");
            if (ps == 0) {
                const int tg = wave, cp = lane;
#pragma unroll
                for (int hf = 0; hf < 2; ++hf)
#pragma unroll
                    for (int t = 0; t < 8; ++t) *(GAS unsigned*)(raw + (rowb + t0 + 8 * tg + t) * CONV_CH + (hf ? 4352 : 4096) + g * 128 + 2 * cp) = bcv[hf * 8 + t];
            } else {
                for (int e = tid; e < 256 * 8; e += 512) { const int xr = e >> 3, p = e & 7; const int hl = (ps - 1) * 4 + (xr >> 6), pp = xr & 63;
                    *(GAS u32x4*)(raw + (rowb + t0 + pp) * CONV_CH + 3072 + (g * 8 + hl) * 64 + p * 8) = *(const LAS u32x4*)(xT + xr * 72 + p * 8); } }
            if (ps == 0) PSD_LOAD(u, 2); else if (u < 3) { if (ps == 1) PSD_LOAD(u + 1, 0); else PSD_LOAD(u + 1, 1); }
            __syncthreads();
        }
    }
}
#undef PSD_STAGE
#undef PSD_LOAD
__device__ __forceinline__ void ssd_intra_range(LAS unsigned char* lds, int bid, const bf16* raw, const float* ssc, const float* Dp, bf16* yi, int tid_p) {
    using namespace psd;
    const int bg = bid >> 5, b = bg >> 1, g = bg & 1, r32 = bid & 31;
    LAS float* sc = (LAS float*)(lds + SC);
    LAS bf16* Bm = (LAS bf16*)(lds + BM_); LAS bf16* Cm = (LAS bf16*)(lds + CM_); LAS float* cb = (LAS float*)(lds + CB);
    LAS bf16* xT = (LAS bf16*)(lds + XT); LAS bf16* Mm = (LAS bf16*)(lds + MM); LAS bf16* yst = (LAS bf16*)(lds + YST);
    const size_t rowb = (size_t)b * SEQ;
    for (int u = 0; u < 4; ++u) {
        int tid = tid_p; asm volatile("" : "+v"(tid));
        const int lane = tid & 63, wave = __builtin_amdgcn_readfirstlane(tid >> 6), fr = lane & 15, fq = lane >> 4;
        const int c = r32 * 4 + u, t0 = c * 64;
        const int hd_w = g * 8 + wave;
        for (int e = tid; e < 64 * 32; e += 512) { const int r = e >> 5, p = e & 31;
            const u32x4 v = *(const GAS u32x4*)(raw + (rowb + t0 + r) * CONV_CH + (p < 16 ? 4096 + g * 128 + p * 8 : 4352 + g * 128 + (p - 16) * 8));
            *(LAS u32x4*)((p < 16 ? Bm + r * 136 + p * 8 : Cm + r * 136 + (p - 16) * 8)) = v; }
        { const int i = lane; const float* sp = ssc + ((size_t)((b * 16 + hd_w) * NCHUNK + c)) * 256 + i;
          LAS float* s = sc + wave * 256; s[i] = sp[0]; s[64 + i] = sp[64] * 1.4426950408889634f; s[128 + i] = sp[128]; s[192 + i] = sp[192] * 1.4426950408889634f; }
        __syncthreads();
        { const int mt = wave & 3, nh = wave >> 2;
          f32x4 acc[1][2]; acc[0][0] = acc[0][1] = (f32x4){0.f, 0.f, 0.f, 0.f};
          mma_lds<1, 2>(acc, Cm, 136, mt * 16, Bm, 136, nh * 32, 128, fr, fq);
#pragma unroll
          for (int nl = 0; nl < 2; ++nl)
#pragma unroll
              for (int r = 0; r < 4; ++r) cb[(mt * 16 + 4 * fq + r) * 68 + nh * 32 + nl * 16 + fr] = acc[0][nl][r]; }
        for (int hp = 0; hp < 4; ++hp) {
            __syncthreads();
            for (int e = tid; e < 128 * 8; e += 512) { const int xr = e >> 3, p = e & 7; const int hl = 2 * hp + (xr >> 6), pp = xr & 63;
                *(LAS u32x4*)(xT + xr * 72 + p * 8) = *(const GAS u32x4*)(raw + (rowb + t0 + pp) * CONV_CH + 3072 + (g * 8 + hl) * 64 + p * 8); }
            { const int e = tid >> 8, i = (tid >> 2) & 63, jq = tid & 3; const int hl = 2 * hp + e;
              const LAS float* s = sc + hl * 256; const float Dh = Dp[g * 8 + hl];
              const float csfi = s[64 + i], csbi = s[192 + i], dsum = s[i] + s[128 + i];
#pragma unroll
              for (int jj = 0; jj < 16; jj += 2) { float m2[2];
#pragma unroll
                  for (int y = 0; y < 2; ++y) { const int j = jq * 16 + jj + y; const float cbv = cb[i * 68 + j];
                      const float cfj = s[64 + j], cbj = s[192 + j], dfj = s[j], dbj = s[128 + j];
                      const float arg = (i > j) ? csfi - cfj : csbi - cbj;
                      const float dtj = (i > j) ? dfj : dbj;
                      const float w = (i == j) ? dsum : __builtin_amdgcn_exp2f(fminf(arg, 0.f)) * dtj;
                      m2[y] = cbv * w + ((i == j) ? Dh : 0.f); }
                  *(LAS unsigned*)(Mm + (e * 64 + i) * 72 + jq * 16 + jj) = pkbf(m2[0], m2[1]); } }
            __syncthreads();
            { const int e = wave >> 2, mt = wave & 3;
              f32x4 acc[1][4];
#pragma unroll
              for (int nt = 0; nt < 4; ++nt) acc[0][nt] = (f32x4){0.f, 0.f, 0.f, 0.f};
              mma_lds<1, 4>(acc, xT + e * 64 * 72, 72, mt * 16, Mm + e * 64 * 72, 72, 0, 64, fr, fq);
#pragma unroll
              for (int nt = 0; nt < 4; ++nt) { u32x2 w; w.x = pkbf(acc[0][nt][0], acc[0][nt][1]); w.y = pkbf(acc[0][nt][2], acc[0][nt][3]);
                  *(LAS u32x2*)(yst + (nt * 16 + fr) * 136 + e * 64 + mt * 16 + 4 * fq) = w; } }
            __syncthreads();
            for (int e = tid; e < 64 * 16; e += 512) { const int i = e >> 4, p = e & 15;
                *(GAS u32x4*)(yi + (rowb + t0 + i) * 1024 + (g * 8 + 2 * hp) * 64 + p * 8) = *(const LAS u32x4*)(yst + i * 136 + p * 8); }
        }
        __syncthreads();
    }
}

namespace ss2 {
constexpr int CO = 0;
constexpr int BO = CO + 64 * 132 * 2;
constexpr int XO = BO + 64 * 132 * 2;
constexpr int SCO = XO + 64 * 72 * 2;
constexpr int BUF = SCO + 768;
constexpr int OST = 2 * BUF;
constexpr int END = OST + 2 * 64 * 72 * 2;
static_assert(END <= MISC_OFF && BUF % 16 == 0, "ssd state LDS map");
}
template <int DIR>
__device__ __forceinline__ void ssd_state2(LAS unsigned char* lds, int b, int hd, const bf16* raw, const float* ssc, bf16* ys, int tid, int wave, int lane) {
    using namespace ss2;
    const size_t rowb = (size_t)b * SEQ; const int g = hd >> 3;
    LAS bf16* ost = (LAS bf16*)(lds + OST);
    const int r31 = lane & 31, hh = lane >> 5;
    if (wave == 4 || wave == 5) {
        for (int n = 0; n < NCHUNK + 1; ++n) WG_BAR();
    } else if (wave >= 2) {
        const int hw = (wave & 1) | ((wave >> 2) << 1); const int ht = hw * 64 + lane;
        unsigned go[10], lo_[10]; u32x4 ld[10]; float sr0 = 0.f, sr1 = 0.f;
#pragma unroll
        for (int x = 0; x < 4; ++x) { const int e = ht + 256 * x, r = e >> 4, p = e & 15;
            go[x] = (unsigned)((r * CONV_CH + 4352 + g * 128 + p * 8) * 2); go[4 + x] = (unsigned)((r * CONV_CH + 4096 + g * 128 + p * 8) * 2);
            lo_[x] = (unsigned)(CO + (r * 132 + p * 8) * 2); lo_[4 + x] = (unsigned)(BO + (r * 132 + p * 8) * 2); }
#pragma unroll
        for (int x = 0; x < 2; ++x) { const int e = ht + 256 * x, xr = e >> 3, p = e & 7;
            go[8 + x] = (unsigned)((xr * CONV_CH + 3072 + hd * 64 + p * 8) * 2); lo_[8 + x] = (unsigned)(XO + (xr * 72 + p * 8) * 2); }
#define SS2_ISSUE(c_) do { const GAS char* rb_ = (const GAS char*)(raw + (rowb + (size_t)(c_) * 64) * CONV_CH); \
            _Pragma("unroll") for (int x = 0; x < 10; ++x) ld[x] = *(const GAS u32x4*)(rb_ + go[x]); \
            if (hw == 0) { const float* sp_ = ssc + ((size_t)((b * 16 + hd) * NCHUNK + (c_))) * 256 + DIR * 128 + lane; sr0 = sp_[0]; sr1 = sp_[64]; } } while (0)
#define SS2_COMMIT(bi_, c_) do { LAS unsigned char* B_ = lds + (bi_) * BUF; \
            _Pragma("unroll") for (int x = 0; x < 10; ++x) { LAS unsigned char* d_ = B_ + lo_[x]; *(LAS u32x2*)(d_) = (u32x2){ld[x].x, ld[x].y}; *(LAS u32x2*)(d_ + 8) = (u32x2){ld[x].z, ld[x].w}; } \
            if (hw == 0) { LAS float* sc_ = (LAS float*)(B_ + SCO); const int i = lane; const float cs = sr1; const float cl = __shfl(cs, DIR ? 0 : 63); \
                sc_[i] = __expf(cs); sc_[64 + i] = sr0 * __expf(cl - cs); if (i == 0) sc_[128] = __expf(cl); } } while (0)
        { const int c0 = DIR ? NCHUNK - 1 : 0; SS2_ISSUE(c0); SS2_COMMIT(0, c0); SS2_ISSUE((DIR ? c0 - 1 : c0 + 1)); }
        for (int n = 0; n < NCHUNK; ++n) {
            const int c = DIR ? NCHUNK - 1 - n : n;
            WG_BAR();
            const bool more = n + 1 < NCHUNK; const int cn = DIR ? c - 1 : c + 1;
            if (more) { SS2_COMMIT((n + 1) & 1, cn); if (n + 2 < NCHUNK) SS2_ISSUE((DIR ? cn - 1 : cn + 1)); }
            unsigned ov[8];
            if (n > 0) {
#pragma unroll
                for (int x = 0; x < 8; ++x) ov[x] = *(const LAS unsigned*)(ost + ((n - 1) & 1) * (64 * 72) + (hw * 16 + 2 * x + (lane >> 5)) * 72 + 2 * (lane & 31));
            }
            if (n > 0) { const int tp = (DIR ? c + 1 : c - 1) * 64;
#pragma unroll
                for (int x = 0; x < 8; ++x) { GAS char* ob_ = (GAS char*)(ys + (rowb + tp + hw * 16 + 2 * x) * 1024 + hd * 64);
                    (void)__builtin_amdgcn_global_atomic_fadd_v2bf16((GAS s16x2*)(ob_ + (lane >> 5) * 2048 + (lane & 31) * 4), __builtin_bit_cast(s16x2, ov[x])); } }
        }
        WG_BAR();
        { const int tp = (DIR ? 0 : NCHUNK - 1) * 64;
#pragma unroll
          for (int x = 0; x < 8; ++x) { const unsigned v = *(const LAS unsigned*)(ost + ((NCHUNK - 1) & 1) * (64 * 72) + (hw * 16 + 2 * x + (lane >> 5)) * 72 + 2 * (lane & 31));
              GAS char* ob_ = (GAS char*)(ys + (rowb + tp + hw * 16 + 2 * x) * 1024 + hd * 64);
              (void)__builtin_amdgcn_global_atomic_fadd_v2bf16((GAS s16x2*)(ob_ + (lane >> 5) * 2048 + (lane & 31) * 4), __builtin_bit_cast(s16x2, v)); } }
#undef SS2_ISSUE
#undef SS2_COMMIT
    } else {
        const int ps = wave; const int xrow = ps * 32 + r31;
        f32x16 Ht[4];
#pragma unroll
        for (int t = 0; t < 4; ++t)
#pragma unroll
            for (int r = 0; r < 16; ++r) Ht[t][r] = 0.f;
        for (int n = 0; n < NCHUNK; ++n) {
            WG_BAR();
            const LAS unsigned char* Bb = lds + (n & 1) * BUF;
            const LAS bf16* Cb = (const LAS bf16*)(Bb + CO); const LAS bf16* Bmb = (const LAS bf16*)(Bb + BO); const LAS bf16* Xb = (const LAS bf16*)(Bb + XO);
            const LAS float* sc = (const LAS float*)(Bb + SCO);
            f32x16 aY[2];
#pragma unroll
            for (int m = 0; m < 2; ++m)
#pragma unroll
                for (int r = 0; r < 16; ++r) aY[m][r] = 0.f;
            bf16x8 fa[2][2];
            const int offc = r31 * 132 + 4 * hh;
#define SS2_LD2(bi_, ks_) do { fa[bi_][0] = afrag(Cb + offc + 16 * (ks_)); fa[bi_][1] = afrag(Cb + offc + 32 * 132 + 16 * (ks_)); } while (0)
            SS2_LD2(0, 0);
#pragma unroll
            for (int ks = 0; ks < 8; ++ks) {
                if (ks < 7) SS2_LD2((ks + 1) & 1, ks + 1);
                __builtin_amdgcn_sched_barrier(0);
                const bf16x8 bs = cvt8(Ht[ks >> 1], 8 * (ks & 1));
                aY[0] = MFMA32(fa[ks & 1][0], bs, aY[0]); aY[1] = MFMA32(fa[ks & 1][1], bs, aY[1]);
                __builtin_amdgcn_sched_barrier(0); }
#undef SS2_LD2
            const int i16 = r31 & 15; const LAS bf16* bp = Bmb + (8 * hh + (i16 >> 2)) * 132 + 16 * (r31 >> 4) + 4 * (i16 & 3);
            bf16x8 xf[4];
#pragma unroll
            for (int kt = 0; kt < 4; ++kt) { const bf16x8 xv = *(const LAS bf16x8*)(Xb + xrow * 72 + 16 * kt + 8 * hh);
                const f32x4 w0 = *(const LAS f32x4*)(sc + 64 + 16 * kt + 8 * hh), w1 = *(const LAS f32x4*)(sc + 64 + 16 * kt + 8 * hh + 4);
                u32x4 w; w.x = pkbf(bf2f_s(xv[0]) * w0[0], bf2f_s(xv[1]) * w0[1]); w.y = pkbf(bf2f_s(xv[2]) * w0[2], bf2f_s(xv[3]) * w0[3]);
                w.z = pkbf(bf2f_s(xv[4]) * w1[0], bf2f_s(xv[5]) * w1[1]); w.w = pkbf(bf2f_s(xv[6]) * w1[2], bf2f_s(xv[7]) * w1[3]);
                xf[kt] = __builtin_bit_cast(bf16x8, w); }
            bf16x8 fb[2][4];
#define SS2_LDBT(bi_, t_) do { _Pragma("unroll") for (int kt = 0; kt < 4; ++kt) { const LAS bf16* p_ = bp + (16 * kt) * 132 + 32 * (t_); \
                const v4i16_t lo_ = __builtin_amdgcn_ds_read_tr16_b64_v4i16((LAS v4i16_t*)p_), hi_ = __builtin_amdgcn_ds_read_tr16_b64_v4i16((LAS v4i16_t*)(p_ + 4 * 132)); \
                fb[bi_][kt] = (bf16x8){lo_[0], lo_[1], lo_[2], lo_[3], hi_[0], hi_[1], hi_[2], hi_[3]}; } } while (0)
            SS2_LDBT(0, 0);
#pragma unroll
            for (int m = 0; m < 2; ++m)
#pragma unroll
                for (int q4 = 0; q4 < 4; ++q4) { const f32x4 ec = *(const LAS f32x4*)(sc + 32 * m + 8 * q4 + 4 * hh);
#pragma unroll
                    for (int x = 0; x < 4; ++x) aY[m][4 * q4 + x] *= ec[x]; }
            const float ecl = sc[128];
#pragma unroll
            for (int mi = 0; mi < 2; ++mi)
#pragma unroll
                for (int r = 0; r < 16; ++r) ost[(n & 1) * (64 * 72) + (32 * mi + (r & 3) + 8 * (r >> 2) + 4 * hh) * 72 + ps * 32 + r31] = f2bf1(aY[mi][r]);
#pragma unroll
            for (int t = 0; t < 4; ++t) {
                if (t < 3) SS2_LDBT((t + 1) & 1, t + 1);
                __builtin_amdgcn_sched_barrier(0);
#pragma unroll
                for (int r = 0; r < 16; ++r) Ht[t][r] *= ecl;
                Ht[t] = MFMA32(fb[t & 1][0], xf[0], Ht[t]); Ht[t] = MFMA32(fb[t & 1][1], xf[1], Ht[t]);
                Ht[t] = MFMA32(fb[t & 1][2], xf[2], Ht[t]); Ht[t] = MFMA32(fb[t & 1][3], xf[3], Ht[t]);
                __builtin_amdgcn_sched_barrier(0); }
#undef SS2_LDBT
        }
        WG_BAR();
    }
}
#ifndef GS3_LDK
#define GS3_LDK 136
#endif
namespace gs3 {
constexpr int LDK = GS3_LDK, LDT = 72;
constexpr int KO = 0;
constexpr int QO = KO + 64 * LDK * 2;
constexpr int VTO = QO + 64 * LDK * 2;
constexpr int TO = VTO + 64 * LDT * 2;
constexpr int QKO = TO + 64 * LDT * 2;
constexpr int SCO = QKO + 64 * LDT * 2;
constexpr int BUF = SCO + 1024;
constexpr int OST = 2 * BUF;
constexpr int END = OST + 2 * 64 * 72 * 2;
static_assert(END <= MISC_OFF && BUF % 16 == 0, "gdn state3 LDS map");
}
__device__ __forceinline__ bf16x8 pack2(const f32x4& a, const f32x4& b) {
    u32x4 w; w.x = pkbf(a[0], a[1]); w.y = pkbf(a[2], a[3]); w.z = pkbf(b[0], b[1]); w.w = pkbf(b[2], b[3]);
    return __builtin_bit_cast(bf16x8, w);
}
__device__ __forceinline__ bf16x8 afrag16(const LAS bf16* p) {
    const bf16x4 lo = *(const LAS bf16x4*)p, hi = *(const LAS bf16x4*)(p + 16);
    return (bf16x8){lo[0], lo[1], lo[2], lo[3], hi[0], hi[1], hi[2], hi[3]};
}
__device__ __forceinline__ bf16x8 afrag16_tr(const LAS bf16* p, int ld) {
    const v4i16_t lo = __builtin_amdgcn_ds_read_tr16_b64_v4i16((LAS v4i16_t*)p), hi = __builtin_amdgcn_ds_read_tr16_b64_v4i16((LAS v4i16_t*)(p + 16 * ld));
    return (bf16x8){lo[0], lo[1], lo[2], lo[3], hi[0], hi[1], hi[2], hi[3]};
}
#define MFMA16(a, b, c) __builtin_amdgcn_mfma_f32_16x16x32_bf16((a), (b), (c), 0, 0, 0)

constexpr int CW_OFLAG = 16384;
__device__ __forceinline__ void store16_wt(bf16* p, u32x4 v) { asm volatile("global_store_dwordx4 %0, %1, off sc1\n\ts_nop 1" :: "v"(p), "v"(v) : "memory"); }
__device__ __forceinline__ void out_rows(const LAS bf16* ostb, bf16* gbase  , int lane, bool second) {
#pragma unroll
    for (int x = 0; x < 2; ++x) { const int r = 8 * x + (lane >> 3), pc = lane & 7;
        const u32x4 ov = *(const LAS u32x4*)(ostb + r * 72 + pc * 8); bf16* gp = gbase + (size_t)r * 1024 + pc * 8;
        if (!second) store16_wt(gp, ov);
        else { const u32x4 gv = *(const GAS u32x4*)gp; u32x4 o;
            o.x = pkbf(__uint_as_float(ov.x << 16) + __uint_as_float(gv.x << 16), __uint_as_float(ov.x & 0xffff0000u) + __uint_as_float(gv.x & 0xffff0000u));
            o.y = pkbf(__uint_as_float(ov.y << 16) + __uint_as_float(gv.y << 16), __uint_as_float(ov.y & 0xffff0000u) + __uint_as_float(gv.y & 0xffff0000u));
            o.z = pkbf(__uint_as_float(ov.z << 16) + __uint_as_float(gv.z << 16), __uint_as_float(ov.z & 0xffff0000u) + __uint_as_float(gv.z & 0xffff0000u));
            o.w = pkbf(__uint_as_float(ov.w << 16) + __uint_as_float(gv.w << 16), __uint_as_float(ov.w & 0xffff0000u) + __uint_as_float(gv.w & 0xffff0000u));
            *(GAS u32x4*)gp = o; } }
}
__device__ __forceinline__ void out_handshake(unsigned* flags, int mine, int partner, int hw, int lane) {
    asm volatile("s_waitcnt vmcnt(0)" ::: "memory");
    if (lane == 0) { __hip_atomic_store(flags + (mine * 4 + hw) * 16, 1u, __ATOMIC_RELAXED, __HIP_MEMORY_SCOPE_AGENT);
        unsigned sp = 0;
        while (__hip_atomic_load(flags + (partner * 4 + hw) * 16, __ATOMIC_RELAXED, __HIP_MEMORY_SCOPE_AGENT) == 0u) { __builtin_amdgcn_s_sleep(2); if (++sp > (1u << 22)) break; } }
    __builtin_amdgcn_fence(__ATOMIC_ACQUIRE, "agent");
    asm volatile("s_waitcnt vmcnt(0)" ::: "memory");
}

template <int DIR, int XP = 0>
__device__ __forceinline__ void gdn_state3(LAS unsigned char* lds, int b, int h, int half, const bf16* raw, const float* scal, const bf16* TQ, bf16* og, int tid, int wave, int lane, unsigned* flags, int cid) {
    using namespace gs3;
    const size_t rowb = (size_t)b * SEQ; const int bh = b * 8 + h;
    LAS bf16* ost = (LAS bf16*)(lds + OST);
    const int fr = lane & 15, fq = lane >> 4;
    if (wave >= 4) {
        const int hw = wave - 4; const int ht = hw * 64 + lane;
        unsigned go[14], lo_[14]; u32x4 ld[14]; float sr0 = 0.f, sr1 = 0.f;
#pragma unroll
        for (int x = 0; x < 4; ++x) { const int e = ht + 256 * x, r = e >> 4, p = e & 15;
            go[x] = (unsigned)((r * CONV_CH + 1024 + h * 128 + p * 8) * 2); go[4 + x] = (unsigned)((r * CONV_CH + h * 128 + p * 8) * 2);
            lo_[x] = (unsigned)(KO + (r * LDK + p * 8) * 2); lo_[4 + x] = (unsigned)(QO + (r * LDK + p * 8) * 2); }
#pragma unroll
        for (int x = 0; x < 2; ++x) { const int e = ht + 256 * x, dvl = e >> 3, p = e & 7; const int dv = 64 * half + dvl;
            go[8 + x] = (unsigned)(((dv >> 1) * CONV_CH + 2048 + h * 128 + (dv & 1) * 64 + p * 8) * 2); lo_[8 + x] = (unsigned)(VTO + (dvl * LDT + p * 8) * 2); }
        u32x4 km[2], dg[2], qm[2];
#pragma unroll
        for (int x = 0; x < 2; ++x) { const int e = ht + 256 * x, i = e >> 3, p = e & 7;
            go[10 + x] = (unsigned)(e * 16); go[12 + x] = (unsigned)(8192 + e * 16);
            lo_[10 + x] = (unsigned)(TO + (i * LDT + p * 8) * 2); lo_[12 + x] = (unsigned)(QKO + (i * LDT + p * 8) * 2);
            unsigned kw[4], dw[4], qw[4];
#pragma unroll
            for (int w = 0; w < 4; ++w) { const int j0 = p * 8 + 2 * w, j1 = j0 + 1;
                const bool k0 = DIR ? (i < j0) : (i > j0), k1 = DIR ? (i < j1) : (i > j1);
                kw[w] = (k0 ? 0xFFFFu : 0u) | (k1 ? 0xFFFF0000u : 0u); dw[w] = (i == j0 ? 0x3F80u : 0u) | (i == j1 ? 0x3F800000u : 0u);
                qw[w] = kw[w] | (i == j0 ? 0xFFFFu : 0u) | (i == j1 ? 0xFFFF0000u : 0u); }
            km[x] = (u32x4){kw[0], kw[1], kw[2], kw[3]}; dg[x] = (u32x4){dw[0], dw[1], dw[2], dw[3]}; qm[x] = (u32x4){qw[0], qw[1], qw[2], qw[3]}; }
        const unsigned so_l = (unsigned)(lane * 256 + (DIR * 8 + h) * 4);
#define GS3_ISSUE(c_) do { const GAS char* rb_ = (const GAS char*)(raw + (rowb + (size_t)(c_) * 64) * CONV_CH); const GAS char* tb_ = (const GAS char*)(TQ + ((size_t)(bh * NCHUNK + (c_))) * 8192); \
            _Pragma("unroll") for (int x = 0; x < 10; ++x) ld[x] = *(const GAS u32x4*)(rb_ + go[x]); \
            _Pragma("unroll") for (int x = 10; x < 14; ++x) ld[x] = *(const GAS u32x4*)(tb_ + go[x]); \
            if (hw == 0) { const GAS char* sb_ = (const GAS char*)(scal + (rowb + (size_t)(c_) * 64) * 64); sr0 = *(const GAS float*)(sb_ + so_l); sr1 = *(const GAS float*)(sb_ + so_l + 64); } } while (0)
#define GS3_COMMIT(bi_, c_) do { LAS unsigned char* B_ = lds + (bi_) * BUF; \
            _Pragma("unroll") for (int x = 0; x < 10; ++x) *(LAS u32x4*)(B_ + lo_[x]) = ld[x]; \
            _Pragma("unroll") for (int x = 0; x < 2; ++x) { *(LAS u32x4*)(B_ + lo_[10 + x]) = (ld[10 + x] & km[x]) | dg[x]; *(LAS u32x4*)(B_ + lo_[12 + x]) = ld[12 + x] & qm[x]; } \
            if (hw == 0) { LAS float* sc_ = (LAS float*)(B_ + SCO); const int i = lane; const float gc = sr1; const float gl = __shfl(gc, DIR ? 0 : 63); \
                sc_[i] = sr0; sc_[64 + i] = __expf(gc); sc_[128 + i] = __expf(gl - gc); if (i == 0) sc_[192] = __expf(gl); } } while (0)
        { const int c0 = DIR ? NCHUNK - 1 : 0; GS3_ISSUE(c0); GS3_COMMIT(0, c0); GS3_ISSUE((DIR ? c0 - 1 : c0 + 1)); }
        for (int n = 0; n < NCHUNK; ++n) {
            const int c = DIR ? NCHUNK - 1 - n : n;
            WG_BAR();
            const bool more = n + 1 < NCHUNK; const int cn = DIR ? c - 1 : c + 1;
            if (more) { GS3_COMMIT((n + 1) & 1, cn); if (n + 2 < NCHUNK && (!(XP & 2) || n < 2)) GS3_ISSUE((DIR ? cn - 1 : cn + 1)); }
            if (n > 0 && !(XP & 1)) { const int tp = (DIR ? c + 1 : c - 1) * 64;
#pragma unroll
                for (int x = 0; x < 8; ++x) { const unsigned v = *(const LAS unsigned*)(ost + ((n - 1) & 1) * (64 * 72) + (hw * 16 + 2 * x + (lane >> 5)) * 72 + 2 * (lane & 31));
                    GAS char* ob_ = (GAS char*)(og + (rowb + tp + hw * 16 + 2 * x) * 1024 + h * 128 + half * 64);
                    (void)__builtin_amdgcn_global_atomic_fadd_v2bf16((GAS s16x2*)(ob_ + (lane >> 5) * 2048 + (lane & 31) * 4), __builtin_bit_cast(s16x2, v)); } }
        }
        WG_BAR();
        { const int tp = (DIR ? 0 : NCHUNK - 1) * 64;
#pragma unroll
          for (int x = 0; x < 8; ++x) { const unsigned v = *(const LAS unsigned*)(ost + ((NCHUNK - 1) & 1) * (64 * 72) + (hw * 16 + 2 * x + (lane >> 5)) * 72 + 2 * (lane & 31));
              GAS char* ob_ = (GAS char*)(og + (rowb + tp + hw * 16 + 2 * x) * 1024 + h * 128 + half * 64);
              (void)__builtin_amdgcn_global_atomic_fadd_v2bf16((GAS s16x2*)(ob_ + (lane >> 5) * 2048 + (lane & 31) * 4), __builtin_bit_cast(s16x2, v)); } }
#undef GS3_ISSUE
#undef GS3_COMMIT
    } else {
        const int dv0 = 16 * wave;
        f32x4 St[8];
#pragma unroll
        for (int t = 0; t < 8; ++t) St[t] = (f32x4){0.f, 0.f, 0.f, 0.f};
        for (int n = 0; n < NCHUNK; ++n) {
            WG_BAR();
            const LAS unsigned char* Bb = lds + (n & 1) * BUF;
            const LAS bf16* Kb = (const LAS bf16*)(Bb + KO); const LAS bf16* Qb = (const LAS bf16*)(Bb + QO); const LAS bf16* Vb = (const LAS bf16*)(Bb + VTO);
            const LAS bf16* Tb = (const LAS bf16*)(Bb + TO); const LAS bf16* QKb = (const LAS bf16*)(Bb + QKO); const LAS float* sc = (const LAS float*)(Bb + SCO);
            const int offa = fr * LDK + 4 * fq, offt = fr * LDT + 4 * fq;
            bf16x8 bS[4];
#pragma unroll
            for (int ks = 0; ks < 4; ++ks) bS[ks] = pack2(St[2 * ks], St[2 * ks + 1]);
            f32x4 aK[4];
#pragma unroll
            for (int m = 0; m < 4; ++m) aK[m] = (f32x4){0.f, 0.f, 0.f, 0.f};
#pragma unroll
            for (int ks = 0; ks < 4; ++ks) { bf16x8 fa[4];
#pragma unroll
                for (int m = 0; m < 4; ++m) fa[m] = afrag16(Kb + offa + 16 * m * LDK + 32 * ks);
#pragma unroll
                for (int m = 0; m < 4; ++m) aK[m] = MFMA16(fa[m], bS[ks], aK[m]); }
            bf16x8 ft[8];
#pragma unroll
            for (int mi = 0; mi < 4; ++mi)
#pragma unroll
                for (int kt = 0; kt < 2; ++kt) { const bool need = DIR ? (kt >= (mi >> 1)) : (kt <= (mi >> 1));
                    if (need) ft[mi * 2 + kt] = afrag16(Tb + offt + 16 * mi * LDT + 32 * kt); }
#pragma unroll
            for (int m = 0; m < 4; ++m) { const int tb = 16 * m + 4 * fq;
                const bf16x4 vv = *(const LAS bf16x4*)(Vb + (dv0 + fr) * LDT + tb); const f32x4 be = *(const LAS f32x4*)(sc + tb), eg = *(const LAS f32x4*)(sc + 64 + tb);
#pragma unroll
                for (int e = 0; e < 4; ++e) aK[m][e] = be[e] * (bf2f_s(vv[e]) - eg[e] * aK[m][e]); }
            const bf16x8 br0 = pack2(aK[0], aK[1]), br1 = pack2(aK[2], aK[3]);
            f32x4 au[4];
#pragma unroll
            for (int m = 0; m < 4; ++m) au[m] = (f32x4){0.f, 0.f, 0.f, 0.f};
#pragma unroll
            for (int mi = 0; mi < 4; ++mi)
#pragma unroll
                for (int kt = 0; kt < 2; ++kt) { const bool need = DIR ? (kt >= (mi >> 1)) : (kt <= (mi >> 1));
                    if (need) au[mi] = MFMA16(ft[mi * 2 + kt], (kt == 0 ? br0 : br1), au[mi]); }
            f32x4 aQ[4];
            if constexpr (!(XP & 4)) {
#pragma unroll
            for (int m = 0; m < 4; ++m) aQ[m] = (f32x4){0.f, 0.f, 0.f, 0.f};
#pragma unroll
            for (int ks = 0; ks < 4; ++ks) { bf16x8 fa[4];
#pragma unroll
                for (int m = 0; m < 4; ++m) fa[m] = afrag16(Qb + offa + 16 * m * LDK + 32 * ks);
#pragma unroll
                for (int m = 0; m < 4; ++m) aQ[m] = MFMA16(fa[m], bS[ks], aQ[m]); }
            bf16x8 fqk[8];
#pragma unroll
            for (int mi = 0; mi < 4; ++mi)
#pragma unroll
                for (int kt = 0; kt < 2; ++kt) { const bool need = DIR ? (kt >= (mi >> 1)) : (kt <= (mi >> 1));
                    if (need) fqk[mi * 2 + kt] = afrag16(QKb + offt + 16 * mi * LDT + 32 * kt); }
            const bf16x8 bu0 = pack2(au[0], au[1]), bu1 = pack2(au[2], au[3]);
#pragma unroll
            for (int m = 0; m < 4; ++m) { const int tb = 16 * m + 4 * fq; const f32x4 eg = *(const LAS f32x4*)(sc + 64 + tb);
#pragma unroll
                for (int e = 0; e < 4; ++e) { aQ[m][e] *= eg[e]; } }
#pragma unroll
            for (int mi = 0; mi < 4; ++mi)
#pragma unroll
                for (int kt = 0; kt < 2; ++kt) { const bool need = DIR ? (kt >= (mi >> 1)) : (kt <= (mi >> 1));
                    if (need) aQ[mi] = MFMA16(fqk[mi * 2 + kt], (kt == 0 ? bu0 : bu1), aQ[mi]); }
#pragma unroll
            for (int m = 0; m < 4; ++m)
#pragma unroll
                for (int e = 0; e < 4; ++e) ost[(n & 1) * (64 * 72) + (16 * m + 4 * fq + e) * 72 + dv0 + fr] = f2bf1(aQ[m][e]);
            }
#pragma unroll
            for (int m = 0; m < 4; ++m) { const int tb = 16 * m + 4 * fq; const f32x4 ek = *(const LAS f32x4*)(sc + 128 + tb);
#pragma unroll
                for (int e = 0; e < 4; ++e) { au[m][e] *= ek[e]; } }
            const bf16x8 bd0 = pack2(au[0], au[1]), bd1 = pack2(au[2], au[3]);
            const float egl = sc[192];
            { const LAS bf16* kp = Kb + (4 * fq + (fr >> 2)) * LDK + 4 * (fr & 3);
#pragma unroll
              for (int t = 0; t < 8; ++t) { const bf16x8 f0 = afrag16_tr(kp + 16 * t, LDK), f1 = afrag16_tr(kp + 32 * LDK + 16 * t, LDK);
                  St[t] = St[t] * egl; St[t] = MFMA16(f0, bd0, St[t]); St[t] = MFMA16(f1, bd1, St[t]); } }
        }
        WG_BAR();
    }
}

namespace ss3 {
constexpr int LDK = GS3_LDK, LDT = 72;
constexpr int CO = 0;
constexpr int BO = CO + 64 * LDK * 2;
constexpr int XO = BO + 64 * LDK * 2;
constexpr int SCO = XO + 64 * LDT * 2;
constexpr int BUF = SCO + 768;
constexpr int OST = 2 * BUF;
constexpr int END = OST + 2 * 64 * 72 * 2;
static_assert(END <= MISC_OFF && BUF % 16 == 0, "ssd state3 LDS map");
}
template <int DIR, int XP = 0>
__device__ __forceinline__ void ssd_state3(LAS unsigned char* lds, int b, int hd, const bf16* raw, const float* ssc, bf16* ys, int tid, int wave, int lane, unsigned* flags, int cid) {
    using namespace ss3;
    const size_t rowb = (size_t)b * SEQ; const int g = hd >> 3;
    LAS bf16* ost = (LAS bf16*)(lds + OST);
    const int fr = lane & 15, fq = lane >> 4;
    if (wave >= 4) {
        const int hw = wave - 4; const int ht = hw * 64 + lane;
        unsigned go[10], lo_[10]; u32x4 ld[10]; float sr0 = 0.f, sr1 = 0.f;
#pragma unroll
        for (int x = 0; x < 4; ++x) { const int e = ht + 256 * x, r = e >> 4, p = e & 15;
            go[x] = (unsigned)((r * CONV_CH + 4352 + g * 128 + p * 8) * 2); go[4 + x] = (unsigned)((r * CONV_CH + 4096 + g * 128 + p * 8) * 2);
            lo_[x] = (unsigned)(CO + (r * LDK + p * 8) * 2); lo_[4 + x] = (unsigned)(BO + (r * LDK + p * 8) * 2); }
#pragma unroll
        for (int x = 0; x < 2; ++x) { const int e = ht + 256 * x, xr = e >> 3, p = e & 7;
            go[8 + x] = (unsigned)((xr * CONV_CH + 3072 + hd * 64 + p * 8) * 2); lo_[8 + x] = (unsigned)(XO + (xr * LDT + p * 8) * 2); }
#define SS3_ISSUE(c_) do { const GAS char* rb_ = (const GAS char*)(raw + (rowb + (size_t)(c_) * 64) * CONV_CH); \
            _Pragma("unroll") for (int x = 0; x < 10; ++x) ld[x] = *(const GAS u32x4*)(rb_ + go[x]); \
            if (hw == 0) { const float* sp_ = ssc + ((size_t)((b * 16 + hd) * NCHUNK + (c_))) * 256 + DIR * 128 + lane; sr0 = sp_[0]; sr1 = sp_[64]; } } while (0)
#define SS3_COMMIT(bi_, c_) do { LAS unsigned char* B_ = lds + (bi_) * BUF; \
            _Pragma("unroll") for (int x = 0; x < 10; ++x) *(LAS u32x4*)(B_ + lo_[x]) = ld[x]; \
            if (hw == 0) { LAS float* sc_ = (LAS float*)(B_ + SCO); const int i = lane; const float cs = sr1; const float cl = __shfl(cs, DIR ? 0 : 63); \
                sc_[i] = __expf(cs); sc_[64 + i] = sr0 * __expf(cl - cs); if (i == 0) sc_[128] = __expf(cl); } } while (0)
        { const int c0 = DIR ? NCHUNK - 1 : 0; SS3_ISSUE(c0); SS3_COMMIT(0, c0); SS3_ISSUE((DIR ? c0 - 1 : c0 + 1)); }
        for (int n = 0; n < NCHUNK; ++n) {
            const int c = DIR ? NCHUNK - 1 - n : n;
            WG_BAR();
            const bool more = n + 1 < NCHUNK; const int cn = DIR ? c - 1 : c + 1;
            if (more) { SS3_COMMIT((n + 1) & 1, cn); if (n + 2 < NCHUNK && (!(XP & 2) || n < 2)) SS3_ISSUE((DIR ? cn - 1 : cn + 1)); }
            if (n > 0 && !(XP & 1)) { const int tp = (DIR ? c + 1 : c - 1) * 64;
#pragma unroll
                for (int x = 0; x < 8; ++x) { const unsigned v = *(const LAS unsigned*)(ost + ((n - 1) & 1) * (64 * 72) + (hw * 16 + 2 * x + (lane >> 5)) * 72 + 2 * (lane & 31));
                    GAS char* ob_ = (GAS char*)(ys + (rowb + tp + hw * 16 + 2 * x) * 1024 + hd * 64);
                    (void)__builtin_amdgcn_global_atomic_fadd_v2bf16((GAS s16x2*)(ob_ + (lane >> 5) * 2048 + (lane & 31) * 4), __builtin_bit_cast(s16x2, v)); } }
        }
        WG_BAR();
        { const int tp = (DIR ? 0 : NCHUNK - 1) * 64;
#pragma unroll
          for (int x = 0; x < 8; ++x) { const unsigned v = *(const LAS unsigned*)(ost + ((NCHUNK - 1) & 1) * (64 * 72) + (hw * 16 + 2 * x + (lane >> 5)) * 72 + 2 * (lane & 31));
              GAS char* ob_ = (GAS char*)(ys + (rowb + tp + hw * 16 + 2 * x) * 1024 + hd * 64);
              (void)__builtin_amdgcn_global_atomic_fadd_v2bf16((GAS s16x2*)(ob_ + (lane >> 5) * 2048 + (lane & 31) * 4), __builtin_bit_cast(s16x2, v)); } }
#undef SS3_ISSUE
#undef SS3_COMMIT
    } else {
        const int p0 = 16 * wave;
        f32x4 Ht[8];
#pragma unroll
        for (int t = 0; t < 8; ++t) Ht[t] = (f32x4){0.f, 0.f, 0.f, 0.f};
        for (int n = 0; n < NCHUNK; ++n) {
            WG_BAR();
            const LAS unsigned char* Bb = lds + (n & 1) * BUF;
            const LAS bf16* Cb = (const LAS bf16*)(Bb + CO); const LAS bf16* Bmb = (const LAS bf16*)(Bb + BO); const LAS bf16* Xb = (const LAS bf16*)(Bb + XO);
            const LAS float* sc = (const LAS float*)(Bb + SCO);
            const int offa = fr * LDK + 4 * fq;
            f32x4 aY[4];
#pragma unroll
            for (int m = 0; m < 4; ++m) aY[m] = (f32x4){0.f, 0.f, 0.f, 0.f};
#pragma unroll
            for (int ks = 0; ks < 4; ++ks) { const bf16x8 bs = pack2(Ht[2 * ks], Ht[2 * ks + 1]); bf16x8 fa[4];
#pragma unroll
                for (int m = 0; m < 4; ++m) fa[m] = afrag16(Cb + offa + 16 * m * LDK + 32 * ks);
#pragma unroll
                for (int m = 0; m < 4; ++m) aY[m] = MFMA16(fa[m], bs, aY[m]); }
            bf16x8 xf[2];
#pragma unroll
            for (int kt = 0; kt < 2; ++kt) { const bf16x8 xv = *(const LAS bf16x8*)(Xb + (p0 + fr) * LDT + 32 * kt + 8 * fq);
                const f32x4 w0 = *(const LAS f32x4*)(sc + 64 + 32 * kt + 8 * fq), w1 = *(const LAS f32x4*)(sc + 64 + 32 * kt + 8 * fq + 4);
                u32x4 w; w.x = pkbf(bf2f_s(xv[0]) * w0[0], bf2f_s(xv[1]) * w0[1]); w.y = pkbf(bf2f_s(xv[2]) * w0[2], bf2f_s(xv[3]) * w0[3]);
                w.z = pkbf(bf2f_s(xv[4]) * w1[0], bf2f_s(xv[5]) * w1[1]); w.w = pkbf(bf2f_s(xv[6]) * w1[2], bf2f_s(xv[7]) * w1[3]);
                xf[kt] = __builtin_bit_cast(bf16x8, w); }
#pragma unroll
            for (int m = 0; m < 4; ++m) { const f32x4 ec = *(const LAS f32x4*)(sc + 16 * m + 4 * fq);
#pragma unroll
                for (int e = 0; e < 4; ++e) aY[m][e] *= ec[e]; }
            const float ecl = sc[128];
#pragma unroll
            for (int m = 0; m < 4; ++m)
#pragma unroll
                for (int e = 0; e < 4; ++e) ost[(n & 1) * (64 * 72) + (16 * m + 4 * fq + e) * 72 + p0 + fr] = f2bf1(aY[m][e]);
            { const LAS bf16* bp = Bmb + (8 * fq + (fr >> 2)) * LDK + 4 * (fr & 3);
#pragma unroll
              for (int t = 0; t < 8; ++t) {
                  bf16x8 f[2];
#pragma unroll
                  for (int kt = 0; kt < 2; ++kt) { const LAS bf16* p = bp + (32 * kt) * LDK + 16 * t;
                      const v4i16_t lo = __builtin_amdgcn_ds_read_tr16_b64_v4i16((LAS v4i16_t*)p), hi = __builtin_amdgcn_ds_read_tr16_b64_v4i16((LAS v4i16_t*)(p + 4 * LDK));
                      f[kt] = (bf16x8){lo[0], lo[1], lo[2], lo[3], hi[0], hi[1], hi[2], hi[3]}; }
                  Ht[t] = Ht[t] * ecl; Ht[t] = MFMA16(f[0], xf[0], Ht[t]); Ht[t] = MFMA16(f[1], xf[1], Ht[t]); } }
        }
        WG_BAR();
    }
}
#ifndef PG8_SP2_
#define PG8_SP2_ true
#endif
#ifndef MK_ONE_LAUNCH
#define MK_ONE_LAUNCH 1
#endif
constexpr int PPL = 13;
constexpr int NPHASE = 1 + PPL * DEPTH;
struct Args { const float* in[19]; float* out; unsigned char* ws; int ph_lo, ph_hi; };
__global__ void __launch_bounds__(NWAVES * 64, 2) fwd_kernel(Args args) {
    extern __shared__ __attribute__((aligned(16))) unsigned char lds_raw[];
    LAS unsigned char* lds = (LAS unsigned char*)lds_raw;
    unsigned* ctl = (unsigned*)(args.ws + WS_CTL);
    volatile LAS unsigned* MISC = (volatile LAS unsigned*)(lds + MISC_OFF);
    for (int u = threadIdx.x; u < 64; u += 512) MISC[u] = 0u;
    __syncthreads();
#if MK_ONE_LAUNCH
    XcdBarrier bar = xcd_barrier_post(ctl + CW_BAR, MISC + 8);
#define GRID_BAR() do { XcdBarrier bb_ = bar; asm volatile("" : "+s"(bb_.bar), "+s"(bb_.x)); xcd_barrier(bb_); } while (0)
#else
#define GRID_BAR() do {} while (0)
#endif
    const int lo = args.ph_lo, hi = args.ph_hi;
#define WSP(T, off) ((T*)(wsb + (off)))
#if defined(PROBE_STATE) || defined(PROBE_ANY) || defined(PROBE_SUB)
#define PROBE_PTR ((float*)(wsb + WS_CTL) + 2048)
#define PROBE_SCALE (1.0f + sqrtf(8.7e-4f * fminf(fmaxf(*(volatile float*)PROBE_PTR, 0.f), 1.f)))
#else
#define PROBE_PTR ((float*)nullptr)
#define PROBE_SCALE 1.0f
#endif
    for (int ph = lo; ph < hi; ++ph) {
        int tid = threadIdx.x, bid = blockIdx.x, G = gridDim.x;
        const __attribute__((address_space(4))) Args* ap = (const __attribute__((address_space(4))) Args*)__builtin_amdgcn_kernarg_segment_ptr();
        asm volatile("" : "+v"(tid)); asm volatile("" : "+s"(bid), "+s"(G), "+s"(ap));
        unsigned char* wsb = ap->ws;
        const int lane = tid & 63, wave = __builtin_amdgcn_readfirstlane(tid >> 6);
        const int gw = bid * NWAVES + wave, NGW = G * NWAVES, gtid = bid * 512 + tid, NGT = G * 512;
        const int l = (ph == 0) ? 0 : (ph - 1) / PPL; const int k = (ph == 0) ? -1 : (ph - 1) % PPL;
#if defined(PROBE_ANY)
        if (l == PROBE_L && k == PROBE_K0 && blockIdx.x == 0 && threadIdx.x == 0) ((unsigned long long*)(wsb + WS_CTL))[1100] = __builtin_amdgcn_s_memrealtime();
#endif
        switch (k) {
        case -1: {
            cvt_mixer_weights(lds, wsb, ap->in[2], ap->in[12], gw, NGW, wave, lane);
            phase_norm(ap->in[0], ap->in[1], WSP(bf16, WS_XN), gw, NGW, lane);
        } break;
        case 0: {
            pg8::Gemm g{WSP(bf16, WS_XN), WSP(bf16, WS_WA), M, NWA, DM, 0, 0, 0}; pg8::StaticOrder S; S.init(M, NWA, G, bid);
            pg8::EpiRawA E{WSP(bf16, WS_RAW), WSP(float, WS_SCAL)};
            pg8::gemm_phase<pg8::EpiRawA, pg8::StaticOrder, true, PG8_SP2_>(lds, g, S, E);
#if defined(EXP_DUP_GEMM)
            if (l == 0 && (EXP_DUP_GEMM & 1)) { __syncthreads(); pg8::gemm_phase<pg8::EpiRawA, pg8::StaticOrder, true, PG8_SP2_>(lds, g, S, E); }
#endif
        } break;
        case 1: {
            if (l == 1) PB_START(3, wsb);
            prep_gdn_stash(lds, bid, WSP(bf16, WS_RAW), tid); prep_ssd_stash(lds, bid, WSP(bf16, WS_RAW), tid);
            zero_region(wsb + WS_OG, 64 * MiB, gtid, NGT); zero_region(wsb + WS_YS, 64 * MiB, gtid, NGT);
            GRID_BAR();
            if (l == 1) { PB_END(3, wsb); PB_START(1, wsb); }
            prep_gdn_range(lds, bid, WSP(bf16, WS_RAW), WSP(float, WS_SCAL), ap->in[3] + (size_t)l * 7 * CONV_CH, ap->in[4] + (size_t)l * CONV_CH,
                           ap->in[5] + l * 16, ap->in[6] + l * 16, WSP(bf16, WS_TQ), tid, wave, lane, WSP(float, WS_SCAL));
            __syncthreads();
            if (l == 1) { PB_END(1, wsb); PB_START(2, wsb); }
            { int tid2 = threadIdx.x; asm volatile("" : "+v"(tid2));
              prep_ssd_range(lds, bid, WSP(bf16, WS_RAW), ap->in[3] + (size_t)l * 7 * CONV_CH, ap->in[4] + (size_t)l * CONV_CH, tid2,
                             WSP(float, WS_SCAL), ap->in[8] + l * 32, ap->in[9] + l * 32, WSP(float, WS_SSC)); }
            if (l == 1) { __syncthreads(); PB_END(2, wsb); }
        } break;
        case 2: {
#if defined(EXP_DUP_ST)
            for (int c0_ = bid; c0_ < 256 * 2; c0_ += G) {
                const int c = c0_ & 255; const bool dup_ = c0_ >= 256;
                if (dup_ && (l != 0 || ((EXP_DUP_ST == 1) != (c < 128)))) continue;
                bf16* const ogp_ = dup_ ? (bf16*)ap->out : WSP(bf16, WS_OG); bf16* const ysp_ = dup_ ? (bf16*)ap->out : WSP(bf16, WS_YS);
#else
            for (int c = bid; c < 256; c += G) {
                bf16* const ogp_ = WSP(bf16, WS_OG); bf16* const ysp_ = WSP(bf16, WS_YS);
#endif
                int tid = threadIdx.x; asm volatile("" : "+v"(tid));
                const int lane = tid & 63, wave = __builtin_amdgcn_readfirstlane(tid >> 6);
                if (c < 128) { const int x_ = (c & 7) | ((c >> 4) << 3), hf_ = (c >> 3) & 1;
                    const int b_ = x_ >> 4, h_ = (x_ >> 1) & 7;
#if defined(EXP_DUP_ST) && defined(EXP_S2)
                    if (dup_) { if (x_ & 1) gdn_state2<1>(lds, b_, h_, hf_, WSP(bf16, WS_RAW), WSP(float, WS_SCAL), WSP(bf16, WS_TQ), ap->in[5] + l * 16, ap->in[6] + l * 16, ogp_, tid, wave, lane);
                                else        gdn_state2<0>(lds, b_, h_, hf_, WSP(bf16, WS_RAW), WSP(float, WS_SCAL), WSP(bf16, WS_TQ), ap->in[5] + l * 16, ap->in[6] + l * 16, ogp_, tid, wave, lane); } else
#endif
#if defined(EXP_DUP_ST) && defined(EXP_XP)
                    if (dup_) { if (x_ & 1) gdn_state3<1, EXP_XP>(lds, b_, h_, hf_, WSP(bf16, WS_RAW), WSP(float, WS_SCAL), WSP(bf16, WS_TQ), ogp_, tid, wave, lane, nullptr, 0);
                                else        gdn_state3<0, EXP_XP>(lds, b_, h_, hf_, WSP(bf16, WS_RAW), WSP(float, WS_SCAL), WSP(bf16, WS_TQ), ogp_, tid, wave, lane, nullptr, 0); } else
#endif
                    if (x_ & 1) gdn_state3<1>(lds, b_, h_, hf_, WSP(bf16, WS_RAW), WSP(float, WS_SCAL), WSP(bf16, WS_TQ), ogp_, tid, wave, lane, nullptr, 0);
                    else        gdn_state3<0>(lds, b_, h_, hf_, WSP(bf16, WS_RAW), WSP(float, WS_SCAL), WSP(bf16, WS_TQ), ogp_, tid, wave, lane, nullptr, 0); }
                else { const int c2 = c - 128, gi_ = c2 & 15, hl_ = c2 >> 4;
                    const int b_ = gi_ >> 2, hd_ = ((gi_ >> 1) & 1) * 8 + hl_;
#if defined(EXP_DUP_ST) && defined(EXP_XP)
                    if (dup_) { if (gi_ & 1) ssd_state3<1, EXP_XP>(lds, b_, hd_, WSP(bf16, WS_RAW), WSP(float, WS_SSC), ysp_, tid, wave, lane, nullptr, 0);
                                else         ssd_state3<0, EXP_XP>(lds, b_, hd_, WSP(bf16, WS_RAW), WSP(float, WS_SSC), ysp_, tid, wave, lane, nullptr, 0); } else
#endif
                    if (gi_ & 1) ssd_state3<1>(lds, b_, hd_, WSP(bf16, WS_RAW), WSP(float, WS_SSC), ysp_, tid, wave, lane, nullptr, 0);
                    else         ssd_state3<0>(lds, b_, hd_, WSP(bf16, WS_RAW), WSP(float, WS_SSC), ysp_, tid, wave, lane, nullptr, 0); }
                __syncthreads();
            }
        } break;
        case 3: {
            ssd_intra_range(lds, bid, WSP(bf16, WS_RAW), WSP(float, WS_SSC), ap->in[10] + l * 16, WSP(bf16, WS_TQ), tid);
#if defined(EXP_DUP_INTRA)
            if (l == 0) { __syncthreads();
            ssd_intra_range(lds, bid, WSP(bf16, WS_RAW), WSP(float, WS_SSC), ap->in[10] + l * 16, WSP(bf16, WS_TQ), tid);
 }
#endif
        } break;
        case 4: {
            phase_norm((l == 0) ? ap->in[0] : ap->out, ap->in[1] + (size_t)l * DM, WSP(bf16, WS_XN2), gw, NGW, lane);
#if defined(EXP_DUP_B)
            if (l == 0) { __syncthreads();
            phase_norm((l == 0) ? ap->in[0] : ap->out, ap->in[1] + (size_t)l * DM, WSP(bf16, WS_XN2), gw, NGW, lane);
 }
#endif
        } break;
        case 5: {
            pg8::Gemm g{WSP(bf16, WS_XN2), WSP(bf16, WS_WB), M, NGATE, DM, 0, 0, 0}; pg8::StaticOrder S; S.init(M, NGATE, G, bid);
            pg8::EpiBf16 E{WSP(bf16, WS_GATES), NGATE};
            pg8::gemm_phase<pg8::EpiBf16, pg8::StaticOrder, true, PG8_SP2_>(lds, g, S, E);
#if defined(EXP_DUP_GEMM)
            if (l == 0 && (EXP_DUP_GEMM & 2)) { __syncthreads(); pg8::gemm_phase<pg8::EpiBf16, pg8::StaticOrder, true, PG8_SP2_>(lds, g, S, E); }
#endif
        } break;
        case 6: {
            phase_finish(WSP(bf16, WS_OG), WSP(bf16, WS_YS), WSP(bf16, WS_TQ), WSP(bf16, WS_GATES), ap->in[7] + l * 128, ap->in[11] + l * 1024, WSP(bf16, WS_MIXED), gw, NGW, lane);
#if defined(EXP_DUP_B)
            if (l == 0) { __syncthreads();
            phase_finish(WSP(bf16, WS_OG), WSP(bf16, WS_YS), WSP(bf16, WS_TQ), WSP(bf16, WS_GATES), ap->in[7] + l * 128, ap->in[11] + l * 1024, WSP(bf16, WS_MIXED), gw, NGW, lane);
 }
#endif
        } break;
        case 7: {
            pg8::Gemm g{WSP(bf16, WS_MIXED), WSP(bf16, WS_WO), M, DM, 2048, 0, 0, 0}; pg8::StaticOrder S; S.init(M, DM, G, bid);
            pg8::EpiResid E{(l == 0) ? ap->in[0] : ap->out, ap->out, DM};
            pg8::gemm_phase<pg8::EpiResid, pg8::StaticOrder, true, PG8_SP2_>(lds, g, S, E);
#if defined(EXP_DUP_GEMM)
            if (l == 0 && (EXP_DUP_GEMM & 4)) { __syncthreads(); pg8::gemm_phase<pg8::EpiResid, pg8::StaticOrder, true, PG8_SP2_>(lds, g, S, E); }
#endif
        } break;
        case 8: {
            phase_norm2_router(lds, ap->out, ap->in[13] + l * DM, ap->in[14] + (size_t)l * DM * 16, WSP(bf16, WS_XN), WSP(float, WS_AFF), gw, NGW, tid, lane);
#if defined(EXP_DUP_A) || defined(EXP_DUP_N2)
            if (l == 0) { __syncthreads();
            phase_norm2_router(lds, ap->out, ap->in[13] + l * DM, ap->in[14] + (size_t)l * DM * 16, WSP(bf16, WS_XN), WSP(float, WS_AFF), gw, NGW, tid, lane);
            __syncthreads();
            cvt_expert_weights(lds, wsb, ap->in[15] + (size_t)l * NEXP * DM * EFF, ap->in[16] + (size_t)l * NEXP * DM * EFF, ap->in[17] + (size_t)l * NEXP * EFF * DM, gw, NGW, wave, lane);
            if (l + 1 < DEPTH) cvt_mixer_weights(lds, wsb, ap->in[2] + (size_t)(l + 1) * DM * 6720, ap->in[12] + (size_t)(l + 1) * 2048 * DM, gw, NGW, wave, lane);
 }
#endif
        } break;
        case 9: {
            if (bid < NB * NEXP) phase_topk(lds, WSP(float, WS_AFF), WSP(int, WS_IDX), WSP(float, WS_VAL), WSP(int, WS_INV), bid, tid, wave, lane);
            else if (G > NB * NEXP) { const int gw2 = (bid - NB * NEXP) * NWAVES + wave, NGW2 = (G - NB * NEXP) * NWAVES;
                cvt_expert_weights(lds, wsb, ap->in[15] + (size_t)l * NEXP * DM * EFF, ap->in[16] + (size_t)l * NEXP * DM * EFF, ap->in[17] + (size_t)l * NEXP * EFF * DM, gw2, NGW2, wave, lane);
                if (l + 1 < DEPTH) cvt_mixer_weights(lds, wsb, ap->in[2] + (size_t)(l + 1) * DM * 6720, ap->in[12] + (size_t)(l + 1) * 2048 * DM, gw2, NGW2, wave, lane); }
#if defined(EXP_DUP_A) || defined(EXP_DUP_TK)
            if (l == 0) { __syncthreads();
            for (int be = bid; be < NB * NEXP; be += G) phase_topk(lds, WSP(float, WS_AFF), WSP(int, WS_IDX), WSP(float, WS_VAL), WSP(int, WS_INV), be, tid, wave, lane);
 }
#endif
        } break;
        case 10: {
            pg8::Gemm g{WSP(bf16, WS_XN), WSP(bf16, WS_WGU), MEXP, 1024, DM, 2, 15, (size_t)1024 * 1024 * 2, WSP(int, WS_IDX), 14, SEQ}; pg8::StaticOrder S; S.init(MEXP, 1024, G, bid);
            pg8::EpiSwiglu E{WSP(bf16, WS_HMID), EFF};
            pg8::gemm_phase<pg8::EpiSwiglu, pg8::StaticOrder, true, PG8_SP2_, true>(lds, g, S, E);
#if defined(EXP_DUP_GEMM)
            if (l == 0 && (EXP_DUP_GEMM & 8)) { __syncthreads(); pg8::gemm_phase<pg8::EpiSwiglu, pg8::StaticOrder, true, PG8_SP2_, true>(lds, g, S, E); }
#endif
        } break;
        case 11: {
            pg8::Gemm g{WSP(bf16, WS_HMID), WSP(bf16, WS_WD), MEXP, 1024, EFF, 2, 15, (size_t)1024 * 512 * 2}; pg8::StaticOrder S; S.init(MEXP, 1024, G, bid);
            pg8::EpiBf16 E{WSP(bf16, WS_XG), 1024};
            pg8::gemm_phase<pg8::EpiBf16, pg8::StaticOrder, true, PG8_SP2_>(lds, g, S, E);
#if defined(EXP_DUP_GEMM)
            if (l == 0 && (EXP_DUP_GEMM & 16)) { __syncthreads(); pg8::gemm_phase<pg8::EpiBf16, pg8::StaticOrder, true, PG8_SP2_>(lds, g, S, E); }
#endif
        } break;
        default: {
            const bool last = (l + 1 == DEPTH);
            phase_combine(ap->out, ap->out, WSP(bf16, WS_XG), WSP(int, WS_INV), WSP(float, WS_VAL), last ? ap->in[18] : ap->in[1] + (size_t)(l + 1) * DM, WSP(bf16, WS_XN), last, gw, NGW, lane, PROBE_SCALE);

        } break;
        }
        if (ph + 1 < hi) GRID_BAR();
#if defined(EXP_XBAR)
        if (ph == 1) for (int xb_ = 0; xb_ < EXP_XBAR; ++xb_) GRID_BAR();
#endif
#if defined(PROBE_ANY)
        if (l == PROBE_L && k == PROBE_K1 && blockIdx.x == 0 && threadIdx.x == 0) { const unsigned long long t1_ = __builtin_amdgcn_s_memrealtime(), t0_ = ((unsigned long long*)(wsb + WS_CTL))[1100];
            const unsigned bk_ = (unsigned)((t1_ - t0_) / PROBE_TICKS); *(volatile float*)PROBE_PTR = (float)(bk_ > 40u ? 40u : bk_) * (1.0f / 40.0f); }
#endif
    }
#undef WSP
}

extern "C" void kernel_launch(void* const* d_in, const int* in_sizes, int n_in, void* d_out, int out_size, void* d_ws, size_t ws_size, hipStream_t stream) {
    static int grid = 0;
    if (grid == 0) {
        if (n_in != 19 || in_sizes[0] != M * DM || out_size != M * DM || ws_size < WS_END) { fprintf(stderr, "kernel_launch: unexpected shapes (n_in %d, in0 %d, out %d, ws %zu); nothing launched\n", n_in, n_in > 0 ? in_sizes[0] : -1, out_size, ws_size); grid = -1; return; }
        int dev = 0, cus = 0;
        if (hipGetDevice(&dev) != hipSuccess || hipDeviceGetAttribute(&cus, hipDeviceAttributeMultiprocessorCount, dev) != hipSuccess) { grid = -1; return; }
        if (hipFuncSetAttribute((const void*)fwd_kernel, hipFuncAttributeMaxDynamicSharedMemorySize, LDS_BYTES) != hipSuccess) { fprintf(stderr, "kernel_launch: hipFuncSetAttribute failed\n"); grid = -1; return; }
        (void)hipGetLastError();
        grid = cus;
    }
    if (grid < 0) return;
    (void)hipMemsetAsync((char*)d_ws + WS_CTL, 0, CTL_ZERO_BYTES, stream);
    Args a{};
    for (int i = 0; i < 19; ++i) a.in[i] = (const float*)d_in[i];
    a.out = (float*)d_out; a.ws = (unsigned char*)d_ws;
#if MK_ONE_LAUNCH
    a.ph_lo = 0; a.ph_hi = NPHASE;
    hipLaunchKernelGGL(fwd_kernel, dim3(grid), dim3(NWAVES * 64), LDS_BYTES, stream, a);
#else
    for (int p = 0; p < NPHASE; ++p) { a.ph_lo = p; a.ph_hi = p + 1; hipLaunchKernelGGL(fwd_kernel, dim3(grid), dim3(NWAVES * 64), LDS_BYTES, stream, a); }
#endif
}
```

```cpp
#include <hip/hip_runtime.h>
#include <cstdio>
#include <cstdint>
namespace pg8 {
#define PG8_LAS __attribute__((address_space(3)))
typedef unsigned short bf16_t;
typedef short bf16x8 __attribute__((ext_vector_type(8)));
typedef float f32x4 __attribute__((ext_vector_type(4)));
typedef unsigned u32x4 __attribute__((ext_vector_type(4)));
constexpr int BM = 256, BK = 64, HALF = 128, HTB = HALF * BK * 2  , STAGE_BYTES = 8 * HTB, NXCD = 8, WGM = 8;

__host__ __device__ __forceinline__ int lds_byte(int r, int c) { const int st = (r >> 4) * 2 + (c >> 5), rr = r & 15, cc = c & 31, ob = rr * 64 + cc * 2; return st * 1024 + (ob ^ (((ob >> 9) & 1) << 5)); }
__host__ __device__ __forceinline__ void stage_rc(int b, int& R, int& C) { const int st = b / 1024, sb = b % 1024, swz = sb ^ (((sb >> 9) & 1) << 5); R = (st >> 1) * 16 + swz / 64; C = (st & 1) * 32 + (swz % 64) / 2; }
__host__ __device__ __forceinline__ int perm32(int rho) { const int n = rho >> 4, i = rho & 15; return 8 * (i >> 2) + 4 * n + (i & 3); }

struct Unit { int pm, pn; };
struct Gemm { const bf16_t* A; const bf16_t* Bt; int M, N, K; int bshift, bmask; size_t bstride; const int* gidx = nullptr; int gshift = 0, gmul = 0;
    __device__ __forceinline__ size_t grp_off(int pm) const { return (size_t)((pm >> bshift) & bmask) * bstride; } };

struct StaticOrder {
    int nM, nN, nwg, G, c;
    __host__ __device__ void init(int M, int N, int G_, int c_) { nM = M / BM; nN = N / BM; nwg = nM * nN; G = G_; c = c_; }
    __host__ __device__ bool next(int i, Unit& u) const {
        const long L = (long)i * G + c; if (L >= nwg) return false;
        int wgid = (int)L; { const int q = nwg / NXCD, r = nwg % NXCD, xcd = wgid % NXCD, off = wgid / NXCD; wgid = (xcd < r ? xcd * (q + 1) : r * (q + 1) + (xcd - r) * q) + off; }
        const int nig = WGM * nN, gid = wgid / nig, fm = gid * WGM, gsz = (nM - fm) < WGM ? (nM - fm) : WGM;
        u.pm = fm + ((wgid % nig) % gsz); u.pn = (wgid % nig) / gsz; return true;
    }
    __device__ __forceinline__ void a_ready(const Unit&) const {}
    __device__ __forceinline__ void done(const Unit&) const {}
};

__device__ __forceinline__ unsigned cvt_pk_bf16(float lo, float hi) { unsigned r; asm volatile("v_cvt_pk_bf16_f32 %0, %1, %2" : "=v"(r) : "v"(lo), "v"(hi)); return r; }
__device__ __forceinline__ float silu_f(float x) { return x * __builtin_amdgcn_rcpf(1.0f + __builtin_amdgcn_exp2f(-1.4426950408889634f * x)); }
struct EpiBf16 {
    static constexpr bool PERM = true, AFTER_DRAIN = false;
    bf16_t* O; int ldc;
    __device__ __forceinline__ void operator()(const f32x4 (&acc)[2][2][4][2], const Unit& u, int wr, int wc, int fr, int fq) const {
        const int row0 = u.pm * BM + wr * 64 + fr; const int col0 = u.pn * BM + wc * 32 + 8 * fq;
#pragma unroll
        for (int ai = 0; ai < 2; ++ai)
#pragma unroll
            for (int m = 0; m < 4; ++m) { bf16_t* rowp = O + (size_t)(row0 + ai * HALF + m * 16) * ldc + col0;
#pragma unroll
                for (int bj = 0; bj < 2; ++bj) { const f32x4 v0 = acc[ai][bj][m][0], v1 = acc[ai][bj][m][1];
                    u32x4 w; w.x = cvt_pk_bf16(v0[0], v0[1]); w.y = cvt_pk_bf16(v0[2], v0[3]); w.z = cvt_pk_bf16(v1[0], v1[1]); w.w = cvt_pk_bf16(v1[2], v1[3]);
                    *(u32x4*)(rowp + bj * HALF) = w; } }
    }
};
struct EpiRawA {
    static constexpr bool PERM = true, AFTER_DRAIN = false;
    bf16_t* O; float* S;
    __device__ __forceinline__ void operator()(const f32x4 (&acc)[2][2][4][2], const Unit& u, int wr, int wc, int fr, int fq) const {
        const int row0 = u.pm * BM + wr * 64 + fr;
        if (u.pn < 18) {
            const int col0 = u.pn * BM + wc * 32 + 8 * fq;
#pragma unroll
            for (int ai = 0; ai < 2; ++ai)
#pragma unroll
                for (int m = 0; m < 4; ++m) { bf16_t* rowp = O + (size_t)(row0 + ai * HALF + m * 16) * 4608 + col0;
#pragma unroll
                    for (int bj = 0; bj < 2; ++bj) { const f32x4 v0 = acc[ai][bj][m][0], v1 = acc[ai][bj][m][1];
                        u32x4 w; w.x = cvt_pk_bf16(v0[0], v0[1]); w.y = cvt_pk_bf16(v0[2], v0[3]); w.z = cvt_pk_bf16(v1[0], v1[1]); w.w = cvt_pk_bf16(v1[2], v1[3]);
                        *(u32x4*)(rowp + bj * HALF) = w; } }
        } else if (wc < 2) {
            const int col0 = wc * 32 + 8 * fq;
#pragma unroll
            for (int ai = 0; ai < 2; ++ai)
#pragma unroll
                for (int m = 0; m < 4; ++m) { float* sp = S + (size_t)(row0 + ai * HALF + m * 16) * 64 + col0;
                    *(f32x4*)sp = acc[ai][0][m][0]; *(f32x4*)(sp + 4) = acc[ai][0][m][1]; }
        }
    }
};
struct EpiResid {
    static constexpr bool PERM = false, AFTER_DRAIN = false;
    const float* base; float* out; int ldc;
    __device__ __forceinline__ void operator()(const f32x4 (&acc)[2][2][4][2], const Unit& u, int wr, int wc, int fr, int fq) const {
        const int row0 = u.pm * BM + wr * 64 + fr, col0 = u.pn * BM + wc * 32 + 4 * fq;
#pragma unroll
        for (int ai = 0; ai < 2; ++ai)
#pragma unroll
            for (int mp = 0; mp < 2; ++mp) { f32x4 rv[2][2][2];
#pragma unroll
                for (int mm = 0; mm < 2; ++mm) { const size_t off = (size_t)(row0 + ai * HALF + (2 * mp + mm) * 16) * ldc + col0;
#pragma unroll
                    for (int bj = 0; bj < 2; ++bj)
#pragma unroll
                        for (int n = 0; n < 2; ++n) rv[mm][bj][n] = *(const f32x4*)(base + off + bj * HALF + n * 16); }
                asm volatile("" ::: "memory");
#pragma unroll
                for (int mm = 0; mm < 2; ++mm) { const size_t off = (size_t)(row0 + ai * HALF + (2 * mp + mm) * 16) * ldc + col0;
#pragma unroll
                    for (int bj = 0; bj < 2; ++bj)
#pragma unroll
                        for (int n = 0; n < 2; ++n) *(f32x4*)(out + off + bj * HALF + n * 16) = rv[mm][bj][n] + acc[ai][bj][2 * mp + mm][n]; }
                asm volatile("" ::: "memory"); }
    }
};
struct EpiSwiglu {
    static constexpr bool PERM = true, AFTER_DRAIN = false;
    bf16_t* O; int ldh;
    __device__ __forceinline__ void operator()(const f32x4 (&acc)[2][2][4][2], const Unit& u, int wr, int wc, int fr, int fq) const {
        const int row0 = u.pm * BM + wr * 64 + fr; const int f0 = (u.pn * BM + wc * 32 + 8 * fq) >> 1;
        typedef unsigned u32x2 __attribute__((ext_vector_type(2)));
#pragma unroll
        for (int ai = 0; ai < 2; ++ai)
#pragma unroll
            for (int m = 0; m < 4; ++m) { bf16_t* rowp = O + (size_t)(row0 + ai * HALF + m * 16) * ldh + f0;
#pragma unroll
                for (int bj = 0; bj < 2; ++bj) { const f32x4 v0 = acc[ai][bj][m][0], v1 = acc[ai][bj][m][1];
                    u32x2 w; w.x = cvt_pk_bf16(silu_f(v0[0]) * v0[1], silu_f(v0[2]) * v0[3]); w.y = cvt_pk_bf16(silu_f(v1[0]) * v1[1], silu_f(v1[2]) * v1[3]);
                    *(u32x2*)(rowp + bj * (HALF / 2)) = w; } }
    }
};
template <class Epi, class Sched, bool ALIGN_EPI = false, bool SP2 = false, bool GATHER = false>
__device__ __forceinline__ void gemm_phase(PG8_LAS unsigned char* lds, const Gemm g, const Sched& S, const Epi& E) {
    int tid_o = threadIdx.x; asm volatile("" : "+v"(tid_o));
    const int tid = tid_o, wid = __builtin_amdgcn_readfirstlane(tid >> 6), lane = tid & 63, wr = wid >> 2, wc = wid & 3, fr = lane & 15, fq = lane >> 4;
    const int K = g.K, nt = K / BK;
    unsigned voffA[2], voffB[2];
#pragma unroll
    for (int i = 0; i < 2; ++i) { int R, C; stage_rc(tid * 16 + i * 8192, R, C); const int Rb = Epi::PERM ? ((R & ~31) + perm32(R & 31)) : R;
        voffA[i] = (unsigned)(R * K + C) * 2u; voffB[i] = (unsigned)(Rb * K + C) * 2u; }
    const size_t kstep = (size_t)(BK * 2);
    const size_t hstep = (size_t)HALF * K * 2;
    const size_t tstep = 2 * hstep;
    const size_t hstepA = GATHER ? (size_t)0 : hstep, tstepA = GATHER ? (size_t)0 : tstep;
    unsigned gC[2][2]; int gI[2][2];
    auto g_load = [&](const Unit& u) { _Pragma("unroll") for (int h = 0; h < 2; ++h) _Pragma("unroll") for (int i = 0; i < 2; ++i) { int R, C; stage_rc(tid * 16 + i * 8192, R, C);
        gI[h][i] = g.gidx[u.pm * BM + h * HALF + R]; } };
    auto g_make = [&](const Unit& u, unsigned (&o)[2][2]) { _Pragma("unroll") for (int h = 0; h < 2; ++h) _Pragma("unroll") for (int i = 0; i < 2; ++i) { int R, C; stage_rc(tid * 16 + i * 8192, R, C);
        const int row = u.pm * BM + h * HALF + R; o[h][i] = (unsigned)(((row >> g.gshift) * g.gmul + gI[h][i]) * K + C) * 2u; } };
    const unsigned ldsw = (unsigned)wid * 1024u;
    const int aoff = lds_byte(wr * 64 + fr, fq * 8), boff = lds_byte(wc * 32 + fr, fq * 8);
#define PG8_SA(b, h) (((b) * 2 + (h)) * HTB)
#define PG8_SB(b, h) ((4 + (b) * 2 + (h)) * HTB)
#define PG8_STAGE(bufoff, gbase, voff) do { _Pragma("unroll") for (int _i = 0; _i < 2; ++_i) \
        __builtin_amdgcn_global_load_lds((const unsigned*)((const char*)(gbase) + (voff)[_i]), (PG8_LAS unsigned*)(lds + (bufoff) + ldsw + _i * 8192), 16, 0, 0); } while (0)
#define PG8_LDA(dst, b, h) do { _Pragma("unroll") for (int m = 0; m < 4; ++m) _Pragma("unroll") for (int k = 0; k < 2; ++k) dst[m][k] = *(const PG8_LAS bf16x8*)(lds + PG8_SA(b, h) + aoff + m * 2048 + k * 1024); } while (0)
#define PG8_LDB(dst, b, h) do { _Pragma("unroll") for (int n = 0; n < 2; ++n) _Pragma("unroll") for (int k = 0; k < 2; ++k) dst[n][k] = *(const PG8_LAS bf16x8*)(lds + PG8_SB(b, h) + boff + n * 2048 + k * 1024); } while (0)
#define PG8_MMA(ai, bj, At, Bt) do { __builtin_amdgcn_s_setprio(1); _Pragma("unroll") for (int m = 0; m < 4; ++m) _Pragma("unroll") for (int n = 0; n < 2; ++n) _Pragma("unroll") for (int k = 0; k < 2; ++k) \
        acc[ai][bj][m][n] = __builtin_amdgcn_mfma_f32_16x16x32_bf16(Bt[n][k], At[m][k], acc[ai][bj][m][n], 0, 0, 0); __builtin_amdgcn_s_setprio(0); } while (0)
#define PG8_WAIT_V(n) asm volatile("s_waitcnt vmcnt(" #n ")" ::: "memory")
#define PG8_WAIT_L(n) asm volatile("s_waitcnt lgkmcnt(" #n ")" ::: "memory")
#define PG8_BAR __builtin_amdgcn_s_barrier()
#define PG8_SCHED __builtin_amdgcn_sched_barrier(0)
    Unit cur, nxt; int ui = 0;
    if (!S.next(0, cur)) return;
    f32x4 acc[2][2][4][2];
#pragma unroll
    for (int a = 0; a < 2; ++a)
#pragma unroll
        for (int b = 0; b < 2; ++b)
#pragma unroll
            for (int m = 0; m < 4; ++m)
#pragma unroll
                for (int n = 0; n < 2; ++n) acc[a][b][m][n] = (f32x4){0.f, 0.f, 0.f, 0.f};
    bf16x8 At[4][2], B0[2][2], B1[2][2];
    const char* cA = (const char*)g.A + (size_t)cur.pm * tstepA; const char* cB = (const char*)g.Bt + g.grp_off(cur.pm) + (size_t)cur.pn * tstep;
    if constexpr (GATHER) { g_load(cur); g_make(cur, gC); }
#define PG8_VA(h) (GATHER ? gC[h] : voffA)
    S.a_ready(cur);
    if constexpr (SP2) {
        PG8_STAGE(PG8_SB(0, 0), cB, voffB); PG8_STAGE(PG8_SB(0, 1), cB + hstep, voffB); PG8_STAGE(PG8_SA(0, 0), cA, PG8_VA(0)); PG8_STAGE(PG8_SA(0, 1), cA + hstepA, PG8_VA(1));
        if (wr == 1) PG8_BAR;
        PG8_WAIT_V(2); PG8_BAR;
        PG8_STAGE(PG8_SB(1, 0), cB + kstep, voffB); PG8_STAGE(PG8_SA(1, 0), cA + kstep, PG8_VA(0)); PG8_STAGE(PG8_SB(1, 1), cB + hstep + kstep, voffB);
        PG8_WAIT_V(6); PG8_BAR;
    } else {
        PG8_STAGE(PG8_SB(0, 0), cB, voffB); PG8_STAGE(PG8_SA(0, 0), cA, PG8_VA(0)); PG8_STAGE(PG8_SB(0, 1), cB + hstep, voffB); PG8_STAGE(PG8_SA(0, 1), cA + hstepA, PG8_VA(1));
        if (wr == 1) PG8_BAR;
        PG8_WAIT_V(4); PG8_BAR;
        PG8_STAGE(PG8_SB(1, 0), cB + kstep, voffB); PG8_STAGE(PG8_SA(1, 0), cA + kstep, PG8_VA(0)); PG8_STAGE(PG8_SB(1, 1), cB + hstep + kstep, voffB);
        PG8_WAIT_V(6); PG8_BAR;
    }
    for (;;) {
        const bool has_next = S.next(ui + 1, nxt);
        const char* nA = has_next ? (const char*)g.A + (size_t)nxt.pm * tstepA : cA; const char* nB = has_next ? (const char*)g.Bt + g.grp_off(nxt.pm) + (size_t)nxt.pn * tstep : cB;
        if constexpr (GATHER) { if (has_next) g_load(nxt); }
        for (int t = 0; t < nt; t += 2) {
            const bool last = (t == nt - 2);
            const char* a1 = cA + (size_t)(t + 1) * kstep;
            const char* a2 = last ? nA : cA + (size_t)(t + 2) * kstep; const char* b2 = last ? nB : cB + (size_t)(t + 2) * kstep;
            const char* a3 = a2 + kstep; const char* b3 = b2 + kstep;
            if (last && has_next) S.a_ready(nxt);
#define PG8_GS() do { if constexpr (GATHER) { if (last && has_next) g_make(nxt, gC); } } while (0)
            if constexpr (SP2) {
            PG8_LDB(B0, 0, 0); PG8_LDB(B1, 0, 1); PG8_SCHED; PG8_LDA(At, 0, 0); PG8_STAGE(PG8_SA(1, 1), a1 + hstepA, PG8_VA(1)); PG8_GS();
            PG8_WAIT_V(8); PG8_WAIT_L(0); PG8_BAR; PG8_MMA(0, 0, At, B0); PG8_MMA(0, 1, At, B1); PG8_BAR; PG8_SCHED;
            PG8_LDA(At, 0, 1); PG8_STAGE(PG8_SB(0, 0), b2, voffB); PG8_STAGE(PG8_SB(0, 1), b2 + hstep, voffB); PG8_STAGE(PG8_SA(0, 0), a2, PG8_VA(0));
            PG8_WAIT_V(8); PG8_WAIT_L(0); PG8_BAR; PG8_MMA(1, 0, At, B0); PG8_MMA(1, 1, At, B1); PG8_BAR; PG8_SCHED;
            PG8_LDB(B0, 1, 0); PG8_LDB(B1, 1, 1); PG8_SCHED; PG8_LDA(At, 1, 0); PG8_STAGE(PG8_SA(0, 1), a2 + hstepA, PG8_VA(1));
            PG8_WAIT_V(8); PG8_WAIT_L(0); PG8_BAR; PG8_MMA(0, 0, At, B0); PG8_MMA(0, 1, At, B1); PG8_BAR; PG8_SCHED;
            PG8_LDA(At, 1, 1); PG8_STAGE(PG8_SB(1, 0), b3, voffB); PG8_STAGE(PG8_SB(1, 1), b3 + hstep, voffB); PG8_STAGE(PG8_SA(1, 0), a3, PG8_VA(0));
            PG8_WAIT_V(8); PG8_WAIT_L(0); PG8_BAR; PG8_MMA(1, 0, At, B0); PG8_MMA(1, 1, At, B1); PG8_BAR; PG8_SCHED;
            } else {
            PG8_LDB(B0, 0, 0); PG8_SCHED; PG8_LDA(At, 0, 0); PG8_STAGE(PG8_SA(1, 1), a1 + hstepA, PG8_VA(1)); PG8_GS();
            PG8_WAIT_L(8); PG8_BAR; PG8_WAIT_L(0); PG8_MMA(0, 0, At, B0); PG8_BAR; PG8_SCHED;
            PG8_LDB(B1, 0, 1); PG8_STAGE(PG8_SB(0, 0), b2, voffB);
            PG8_BAR; PG8_WAIT_L(0); PG8_MMA(0, 1, At, B1); PG8_BAR;
            PG8_LDA(At, 0, 1); PG8_STAGE(PG8_SA(0, 0), a2, PG8_VA(0));
            PG8_BAR; PG8_WAIT_L(0); PG8_MMA(1, 0, At, B0); PG8_BAR; PG8_SCHED;
            PG8_STAGE(PG8_SB(0, 1), b2 + hstep, voffB);
            PG8_WAIT_V(6); PG8_BAR; PG8_MMA(1, 1, At, B1); PG8_BAR;
            PG8_LDB(B0, 1, 0); PG8_SCHED; PG8_LDA(At, 1, 0); PG8_STAGE(PG8_SA(0, 1), a2 + hstepA, PG8_VA(1));
            PG8_WAIT_L(8); PG8_BAR; PG8_WAIT_L(0); PG8_MMA(0, 0, At, B0); PG8_BAR; PG8_SCHED;
            PG8_LDB(B1, 1, 1); PG8_STAGE(PG8_SB(1, 0), b3, voffB);
            PG8_BAR; PG8_WAIT_L(0); PG8_MMA(0, 1, At, B1); PG8_BAR;
            PG8_LDA(At, 1, 1); PG8_STAGE(PG8_SA(1, 0), a3, PG8_VA(0));
            PG8_BAR; PG8_WAIT_L(0); PG8_MMA(1, 0, At, B0); PG8_BAR; PG8_SCHED;
            PG8_STAGE(PG8_SB(1, 1), b3 + hstep, voffB);
            PG8_WAIT_V(6); PG8_BAR; PG8_MMA(1, 1, At, B1); PG8_BAR;
            }
        }
        if constexpr (ALIGN_EPI) { if (wr == 0) PG8_BAR; }
        if constexpr (!Epi::AFTER_DRAIN) { E(acc, cur, wr, wc, fr, fq); S.done(cur); }
        if (!has_next) break;
#pragma unroll
        for (int a = 0; a < 2; ++a)
#pragma unroll
            for (int b = 0; b < 2; ++b)
#pragma unroll
                for (int m = 0; m < 4; ++m)
#pragma unroll
                    for (int n = 0; n < 2; ++n) acc[a][b][m][n] = (f32x4){0.f, 0.f, 0.f, 0.f};
        cur = nxt; cA = nA; cB = nB; ++ui;
        if constexpr (ALIGN_EPI) { if (wr == 1) PG8_BAR; }
    }
    PG8_WAIT_V(0);
    if constexpr (!ALIGN_EPI) { if (wr == 0) PG8_BAR; }
    PG8_BAR;
    if constexpr (Epi::AFTER_DRAIN) { E.fused(acc, cur, wr, wc, fr, fq, lds, wid, lane); S.done(cur); }
#undef PG8_SA
#undef PG8_VA
#undef PG8_GS
#undef PG8_SB
#undef PG8_STAGE
#undef PG8_LDA
#undef PG8_LDB
#undef PG8_MMA
#undef PG8_WAIT_V
#undef PG8_WAIT_L
#undef PG8_BAR
#undef PG8_SCHED
}
}
#define GAS __attribute__((address_space(1)))
#define LAS __attribute__((address_space(3)))
typedef unsigned short bf16;
typedef unsigned v4u __attribute__((ext_vector_type(4)));
typedef float f32x4 __attribute__((ext_vector_type(4)));
typedef short bf16x8 __attribute__((ext_vector_type(8)));
typedef GAS unsigned gu32;
typedef GAS unsigned long long gu64;
#define RLX_AGENT __ATOMIC_RELAXED, __HIP_MEMORY_SCOPE_AGENT
#define LDS_WAIT() asm volatile("s_waitcnt lgkmcnt(0)" ::: "memory")
#define VM_WAIT() asm volatile("s_waitcnt vmcnt(0)" ::: "memory")
__device__ __forceinline__ unsigned long long rt() { return __builtin_amdgcn_s_memrealtime(); }
__device__ __forceinline__ unsigned f2bf(float f) { unsigned u = __builtin_bit_cast(unsigned, f); return (u + 0x7fffu + ((u >> 16) & 1u)) >> 16; }
__device__ __forceinline__ unsigned pk2(float lo, float hi) { return f2bf(lo) | (f2bf(hi) << 16); }
#define XB_TMO      128
#define XB_XCNT(j)  (256  + 64 * (j))
#define XB_XSUB(j)  (1280 + 64 * (j))
#define XB_XGEN(j)  (2304 + 64 * (j))
#define XB_TOP      3328
#define XB_TOPGEN   3392
#define XCD_BAR_WORDS 3456
#define XB_SPIN_CAP (1u << 18)

__device__ __forceinline__ unsigned xb_ld(unsigned* p)              { return __hip_atomic_load(p, __ATOMIC_RELAXED, __HIP_MEMORY_SCOPE_AGENT); }
__device__ __forceinline__ unsigned xb_add(unsigned* p, unsigned v) { return __hip_atomic_fetch_add(p, v, __ATOMIC_RELAXED, __HIP_MEMORY_SCOPE_AGENT); }
__device__ __forceinline__ unsigned xb_xcc_id() { return (unsigned)__builtin_amdgcn_s_getreg((3 << 11) | 20) & 0xFu; }
#define XB_SPIN(cond, bar) do { unsigned _sp = 0; while (cond) { __builtin_amdgcn_s_sleep(1); \
    if ((++_sp & 255u) == 0u) { if (xb_ld(&(bar)[XB_TMO])) break; if (_sp > XB_SPIN_CAP) { atomicAdd(&(bar)[XB_TMO], 1u); break; } } } } while (0)

struct XcdBarrier {
    unsigned* bar; unsigned x;
    volatile LAS unsigned* st;
};

__device__ __forceinline__ XcdBarrier xcd_barrier_post(unsigned* bar, volatile LAS unsigned* st) {
    XcdBarrier b; b.bar = bar; b.x = xb_xcc_id(); b.st = st;
    if (threadIdx.x == 0) (void)xb_add(&bar[XB_XCNT(b.x)], 1u);
    return b;
}
__device__ __forceinline__ void xcd_barrier_complete(unsigned* bar, unsigned x, unsigned& nloc, unsigned& nx) {
    const unsigned G = gridDim.x * gridDim.y * gridDim.z;
    unsigned sum, cnt, mine, sp = 0u;
    for (;;) {
        sum = 0u; cnt = 0u; mine = 0u;
#pragma unroll
        for (unsigned j = 0; j < 16; ++j) { const unsigned c = xb_ld(&bar[XB_XCNT(j)]); sum += c; cnt += (c > 0u) ? 1u : 0u; mine = (j == x) ? c : mine; }
        if (sum == G) break;
        __builtin_amdgcn_s_sleep(1);
        if ((++sp & 255u) == 0u) { if (xb_ld(&bar[XB_TMO])) break; if (sp > XB_SPIN_CAP) { atomicAdd(&bar[XB_TMO], 1u); break; } }
    }
    nloc = mine > 0u ? mine : 1u; nx = cnt > 0u ? cnt : 1u;
}

__device__ __forceinline__ void xcd_barrier(const XcdBarrier& b) {
    asm volatile("s_waitcnt vmcnt(0)" ::: "memory");
    __syncthreads();
    if (threadIdx.x == 0) {
        unsigned* bar = b.bar;
        __builtin_amdgcn_s_waitcnt(0);
        unsigned nloc = b.st[0], nx = b.st[1];
        if (nloc == 0u) { xcd_barrier_complete(bar, b.x, nloc, nx); b.st[0] = nloc; b.st[1] = nx; }
        const unsigned old = xb_add(&bar[XB_XSUB(b.x)], 1u);
        const unsigned gen = old / nloc;
        if (old + 1u == (gen + 1u) * nloc) {
            __builtin_amdgcn_fence(__ATOMIC_RELEASE, "agent");
            asm volatile("s_waitcnt vmcnt(0)" ::: "memory");
            const unsigned og = xb_add(&bar[XB_TOP], 1u);
            const unsigned tg = og / nx;
            if (og + 1u == (tg + 1u) * nx) xb_add(&bar[XB_TOPGEN], 1u);
            else XB_SPIN(xb_ld(&bar[XB_TOPGEN]) == tg, bar);
            __builtin_amdgcn_fence(__ATOMIC_ACQUIRE, "agent");
            xb_add(&bar[XB_XGEN(b.x)], 1u);
            asm volatile("s_waitcnt vmcnt(0)" ::: "memory");
        } else {
            XB_SPIN(xb_ld(&bar[XB_XGEN(b.x)]) == gen, bar);
            __builtin_amdgcn_fence(__ATOMIC_ACQUIRE, "agent");
            asm volatile("s_waitcnt vmcnt(0)" ::: "memory");
        }
    }
    __syncthreads();
}
constexpr int NB = 4, SEQ = 8192, DM = 1024, M = NB * SEQ, DEPTH = 2;
constexpr int NCHUNK = SEQ / 64;
constexpr int CONV_CH = 4608, NWA = 4864  , NGATE = 2048, NEXP = 16, EFF = 512, CAP = 1024;
constexpr int MEXP = NB * NEXP * CAP;
constexpr float EPS = 1e-6f;
constexpr int NWAVES = 8;
constexpr size_t MiB = 1u << 20;
constexpr size_t WS_CTL = 0, CTL_ZERO_BYTES = 1 * MiB;
constexpr size_t WS_WA = 1 * MiB;
constexpr size_t WS_WB = 11 * MiB;
constexpr size_t WS_WO = 15 * MiB;
constexpr size_t WS_XN = 19 * MiB;
constexpr size_t WS_RAW = 83 * MiB;
constexpr size_t WS_SCAL = 371 * MiB;
constexpr size_t WS_OG = 19 * MiB;
constexpr size_t WS_YS = 443 * MiB;
constexpr size_t WS_XN2 = 83 * MiB;
constexpr size_t WS_GATES = 147 * MiB;
constexpr size_t WS_MIXED = 147 * MiB;
constexpr size_t WS_WGU = 83 * MiB;
constexpr size_t WS_WD = 115 * MiB;
constexpr size_t WS_XG = 131 * MiB;
constexpr size_t WS_HMID = 259 * MiB;
constexpr size_t WS_AFF = 323 * MiB;
constexpr size_t WS_IDX = 325 * MiB;
constexpr size_t WS_VAL = 326 * MiB;
constexpr size_t WS_INV = 327 * MiB;
constexpr size_t WS_END = 507 * MiB;
constexpr int CW_TMO = 0, CW_BAR = 4096;
constexpr int LDS_BYTES = 163840;
constexpr int MISC_OFF = LDS_BYTES - 256;

typedef short bf16x8 __attribute__((ext_vector_type(8)));
typedef short bf16x4 __attribute__((ext_vector_type(4)));
typedef float f32x4 __attribute__((ext_vector_type(4)));
typedef float f32x2 __attribute__((ext_vector_type(2)));
typedef unsigned u32x4 __attribute__((ext_vector_type(4)));
typedef unsigned u32x2 __attribute__((ext_vector_type(2)));
typedef __bf16 bf16x2_t __attribute__((ext_vector_type(2)));
typedef short s16x2 __attribute__((ext_vector_type(2)));

__device__ __forceinline__ float bf2f(unsigned short v) { return __uint_as_float((unsigned)v << 16); }
__device__ __forceinline__ float bf2f_s(short v) { return __uint_as_float((unsigned)(unsigned short)v << 16); }
__device__ __forceinline__ unsigned pkbf(float lo, float hi) { f32x2 v = {lo, hi}; bf16x2_t b = __builtin_convertvector(v, bf16x2_t); return __builtin_bit_cast(unsigned, b); }
__device__ __forceinline__ unsigned short f2bf1(float f) { return (unsigned short)(pkbf(f, 0.f) & 0xffffu); }
__device__ __forceinline__ float silu(float x) { return x * __builtin_amdgcn_rcpf(1.0f + __builtin_amdgcn_exp2f(-1.4426950408889634f * x)); }
__device__ __forceinline__ float softplus_f(float x) { return x > 20.f ? x : log1pf(expf(x)); }
__device__ __forceinline__ float sigmoid_f(float x) { return 1.0f / (1.0f + expf(-x)); }
__device__ __forceinline__ void atomic_add_bf16x2(bf16* p, float a, float b) {
    (void)__builtin_amdgcn_global_atomic_fadd_v2bf16((GAS s16x2*)p, __builtin_bit_cast(s16x2, pkbf(a, b)));
}
template <int CTRL> __device__ __forceinline__ float dppf(float v) { return __builtin_bit_cast(float, __builtin_amdgcn_update_dpp(0, __builtin_bit_cast(int, v), CTRL, 0xF, 0xF, true)); }
__device__ __forceinline__ float wave_sum(float v) {
    v += dppf<0xB1>(v); v += dppf<0x4E>(v); v += dppf<0x141>(v); v += dppf<0x140>(v);
    const float s0 = __builtin_bit_cast(float, __builtin_amdgcn_readlane(__builtin_bit_cast(int, v), 0)), s1 = __builtin_bit_cast(float, __builtin_amdgcn_readlane(__builtin_bit_cast(int, v), 16));
    const float s2 = __builtin_bit_cast(float, __builtin_amdgcn_readlane(__builtin_bit_cast(int, v), 32)), s3 = __builtin_bit_cast(float, __builtin_amdgcn_readlane(__builtin_bit_cast(int, v), 48));
    return (s0 + s1) + (s2 + s3);
}

__device__ __forceinline__ float softplus_fast(float x) { const float e = __builtin_amdgcn_exp2f(1.4426950408889634f * fminf(x, 20.f));
    const float lg = (e < 1e-3f) ? e * (1.0f - 0.5f * e) : 0.6931471805599453f * __builtin_amdgcn_logf(1.0f + e); return x > 20.f ? x : lg; }
__device__ __forceinline__ float sigmoid_fast(float x) { return __builtin_amdgcn_rcpf(1.0f + __builtin_amdgcn_exp2f(-1.4426950408889634f * x)); }
__device__ __forceinline__ float scan_fwd64(float v, int lane) {
    v += dppf<0x111>(v); v += dppf<0x112>(v); v += dppf<0x114>(v); v += dppf<0x118>(v);
    const float t0 = __builtin_bit_cast(float, __builtin_amdgcn_readlane(__builtin_bit_cast(int, v), 15)), t1 = __builtin_bit_cast(float, __builtin_amdgcn_readlane(__builtin_bit_cast(int, v), 31));
    const float t2 = __builtin_bit_cast(float, __builtin_amdgcn_readlane(__builtin_bit_cast(int, v), 47));
    const int row = lane >> 4; return v + (row == 0 ? 0.f : row == 1 ? t0 : row == 2 ? t0 + t1 : (t0 + t1) + t2);
}
__device__ __forceinline__ float scan_bwd64(float v, int lane) {
    v += dppf<0x101>(v); v += dppf<0x102>(v); v += dppf<0x104>(v); v += dppf<0x108>(v);
    const float t1 = __builtin_bit_cast(float, __builtin_amdgcn_readlane(__builtin_bit_cast(int, v), 16)), t2 = __builtin_bit_cast(float, __builtin_amdgcn_readlane(__builtin_bit_cast(int, v), 32));
    const float t3 = __builtin_bit_cast(float, __builtin_amdgcn_readlane(__builtin_bit_cast(int, v), 48));
    const int row = lane >> 4; return v + (row == 3 ? 0.f : row == 2 ? t3 : row == 1 ? t3 + t2 : (t3 + t2) + t1);
}

template <int CTRL> __device__ __forceinline__ int dppi(int v) { return __builtin_amdgcn_update_dpp(0, v, CTRL, 0xF, 0xF, true); }
__device__ __forceinline__ int scan_fwd64_i(int v, int lane) {
    v += dppi<0x111>(v); v += dppi<0x112>(v); v += dppi<0x114>(v); v += dppi<0x118>(v);
    const int t0 = __builtin_amdgcn_readlane(v, 15), t1 = __builtin_amdgcn_readlane(v, 31), t2 = __builtin_amdgcn_readlane(v, 47);
    const int row = lane >> 4; return v + (row == 0 ? 0 : row == 1 ? t0 : row == 2 ? t0 + t1 : t0 + t1 + t2);
}
template <int MT, int NT>
__device__ __forceinline__ void mma_lds(f32x4 (&acc)[MT][NT], const LAS bf16* A, int lda, int m0, const LAS bf16* Bt, int ldb, int n0, int K, int fr, int fq) {
    for (int k0 = 0; k0 < K; k0 += 32) {
        bf16x8 a[MT], b[NT];
#pragma unroll
        for (int mt = 0; mt < MT; ++mt) a[mt] = *(const LAS bf16x8*)(A + (m0 + mt * 16 + fr) * lda + k0 + fq * 8);
#pragma unroll
        for (int nt = 0; nt < NT; ++nt) b[nt] = *(const LAS bf16x8*)(Bt + (n0 + nt * 16 + fr) * ldb + k0 + fq * 8);
#pragma unroll
        for (int mt = 0; mt < MT; ++mt)
#pragma unroll
            for (int nt = 0; nt < NT; ++nt) acc[mt][nt] = __builtin_amdgcn_mfma_f32_16x16x32_bf16(a[mt], b[nt], acc[mt][nt], 0, 0, 0);
    }
}

__device__ __forceinline__ void conv16(float (&acc)[16], const LAS bf16* src, int ld, const LAS float* cw, int cwld) {
#pragma unroll
    for (int c = 0; c < 16; ++c) acc[c] = cw[7 * cwld + c];
#pragma unroll
    for (int tap = 0; tap < 7; ++tap) {
        const bf16x8 x0 = *(const LAS bf16x8*)(src + tap * ld), x1 = *(const LAS bf16x8*)(src + tap * ld + 8);
        const LAS float* w = cw + tap * cwld;
#pragma unroll
        for (int c = 0; c < 8; ++c) { acc[c] += bf2f_s(x0[c]) * w[c]; acc[8 + c] += bf2f_s(x1[c]) * w[8 + c]; }
        if (tap & 1) asm volatile("" ::: "memory");
    }
}
__device__ __forceinline__ void conv8(float (&acc)[8], const LAS bf16* src, int ld, const LAS float* cw, int cwld) {
#pragma unroll
    for (int c = 0; c < 8; ++c) acc[c] = cw[7 * cwld + c];
#pragma unroll
    for (int tap = 0; tap < 7; ++tap) {
        const bf16x8 x0 = *(const LAS bf16x8*)(src + tap * ld);
        const LAS float* w = cw + tap * cwld;
#pragma unroll
        for (int c = 0; c < 8; ++c) acc[c] += bf2f_s(x0[c]) * w[c];
        if (tap & 1) asm volatile("" ::: "memory");
    }
}

#if defined(PROBE_SUB)
#define PB_START(id_, ws_) do { if ((id_) == PROBE_SUB && blockIdx.x == 0 && threadIdx.x == 0) ((unsigned long long*)(ws_))[1100] = __builtin_amdgcn_s_memrealtime(); } while (0)
#define PB_END(id_, ws_) do { if ((id_) == PROBE_SUB && blockIdx.x == 0 && threadIdx.x == 0) { const unsigned long long t1_ = __builtin_amdgcn_s_memrealtime(), t0_ = ((unsigned long long*)(ws_))[1100]; \
        const unsigned bk_ = (unsigned)((t1_ - t0_) / PROBE_TICKS); *((volatile float*)(ws_) + 2048) = (float)(bk_ > 40u ? 40u : bk_) * (1.0f / 40.0f); } } while (0)
#else
#define PB_START(id_, ws_) do {} while (0)
#define PB_END(id_, ws_) do {} while (0)
#endif
__device__ __forceinline__ void transpose_item(const float* W, int K, int N, int k0, int n0, bf16* WT, int drow0, int rmul, LAS float* scr, int lane) {
    f32x4 v[16];
#pragma unroll
    for (int i = 0; i < 16; ++i) { const int kk = 4 * i + (lane >> 4); v[i] = *(const GAS f32x4*)(W + (size_t)(k0 + kk) * N + n0 + 4 * (lane & 15)); }
#pragma unroll
    for (int i = 0; i < 16; ++i) { const int kk = 4 * i + (lane >> 4); LAS float* d = scr + kk * 65 + 4 * (lane & 15); d[0] = v[i].x; d[1] = v[i].y; d[2] = v[i].z; d[3] = v[i].w; }
    LDS_WAIT(); asm volatile("" ::: "memory");
    const int c = lane & 7;
#pragma unroll
    for (int j = 0; j < 8; ++j) { const int n = (lane >> 3) + 8 * j; const LAS float* s = scr + (8 * c) * 65 + n;
        u32x4 o; o.x = pkbf(s[0 * 65], s[1 * 65]); o.y = pkbf(s[2 * 65], s[3 * 65]); o.z = pkbf(s[4 * 65], s[5 * 65]); o.w = pkbf(s[6 * 65], s[7 * 65]);
        *(GAS u32x4*)(WT + (size_t)(drow0 + rmul * n) * K + k0 + 8 * c) = o; }
    LDS_WAIT(); asm volatile("" ::: "memory");
}
__device__ __forceinline__ void cvt_mixer_weights(LAS unsigned char* lds, unsigned char* ws, const float* w_in, const float* w_out, int gw, int NGW, int wave, int lane) {
    LAS float* scr = (LAS float*)(lds + wave * 16896);
    bf16* WA = (bf16*)(ws + WS_WA); bf16* WB = (bf16*)(ws + WS_WB); bf16* WO = (bf16*)(ws + WS_WO);
    constexpr int I_IN = 16 * 105, I_OUT = 32 * 16;
    for (int it = gw; it < I_IN + I_OUT; it += NGW) {
        if (it < I_IN) { const int kb = it / 105, nb = it % 105, n0 = nb * 64;
            bf16* dst; int drow;
            if (n0 < 4608) { dst = WA; drow = n0; } else if (n0 < 6656) { dst = WB; drow = n0 - 4608; } else { dst = WA; drow = 4608 + (n0 - 6656); }
            transpose_item(w_in, 1024, 6720, kb * 64, n0, dst, drow, 1, scr, lane);
        } else { const int r = it - I_IN, kb = r / 16, nb = r % 16; transpose_item(w_out, 2048, 1024, kb * 64, nb * 64, WO, nb * 64, 1, scr, lane); }
    }
    { u32x4 z = (u32x4){0u, 0u, 0u, 0u}; asm volatile("" : "+v"(z));
      for (int r = gw; r < 192; r += NGW) { GAS u32x4* p = (GAS u32x4*)(WA + (size_t)(4672 + r) * 1024) + lane; p[0] = z; p[64] = z; } }
}
__device__ __forceinline__ void cvt_expert_weights(LAS unsigned char* lds, unsigned char* ws, const float* w_gate, const float* w_up, const float* w_down, int gw, int NGW, int wave, int lane) {
    LAS float* scr = (LAS float*)(lds + wave * 16896);
    bf16* WGU = (bf16*)(ws + WS_WGU); bf16* WD = (bf16*)(ws + WS_WD);
    constexpr int I_G = 16 * 8;
    constexpr int I_D = 8 * 16;
    constexpr int PER_E = 2 * I_G + I_D;
    for (int it = gw; it < NEXP * PER_E; it += NGW) {
        const int e = it / PER_E; int r = it % PER_E;
        if (r < 2 * I_G) { const int up = r >= I_G; if (up) r -= I_G; const int kb = r / 8, nb = r % 8;
            transpose_item((up ? w_up : w_gate) + (size_t)e * 1024 * 512, 1024, 512, kb * 64, nb * 64, WGU + (size_t)e * 1024 * 1024, 2 * (nb * 64) + up, 2, scr, lane);
        } else { r -= 2 * I_G; const int kb = r / 16, nb = r % 16;
            transpose_item(w_down + (size_t)e * 512 * 1024, 512, 1024, kb * 64, nb * 64, WD + (size_t)e * 1024 * 512, nb * 64, 1, scr, lane); }
    }
}

__device__ __forceinline__ void rms_row_regs(const float* xrow, const f32x4 (&w)[4], f32x4 (&v)[4], int lane) {
    const GAS f32x4* xr = (const GAS f32x4*)xrow + lane; float s = 0.f;
#pragma unroll
    for (int j = 0; j < 4; ++j) { v[j] = xr[64 * j]; s += (v[j].x * v[j].x + v[j].y * v[j].y) + (v[j].z * v[j].z + v[j].w * v[j].w); }
    const float rstd = __builtin_amdgcn_rsqf(wave_sum(s) * (1.0f / DM) + EPS);
#pragma unroll
    for (int j = 0; j < 4; ++j) v[j] = v[j] * rstd * w[j];
}
__device__ __forceinline__ void row_load4(const float* xrow, f32x4 (&v)[4], int lane) {
    const GAS f32x4* xr = (const GAS f32x4*)xrow + lane;
#pragma unroll
    for (int j = 0; j < 4; ++j) v[j] = xr[64 * j];
}
__device__ __forceinline__ void rms_regs(const f32x4 (&w)[4], f32x4 (&v)[4]) {
    float s = 0.f;
#pragma unroll
    for (int j = 0; j < 4; ++j) s += (v[j].x * v[j].x + v[j].y * v[j].y) + (v[j].z * v[j].z + v[j].w * v[j].w);
    const float rstd = __builtin_amdgcn_rsqf(wave_sum(s) * (1.0f / DM) + EPS);
#pragma unroll
    for (int j = 0; j < 4; ++j) v[j] = v[j] * rstd * w[j];
}
__device__ __forceinline__ void store_row_bf16(bf16* orow, const f32x4 (&v)[4], int lane) {
    GAS u32x2* o8 = (GAS u32x2*)orow + lane;
#pragma unroll
    for (int j = 0; j < 4; ++j) { u32x2 t; t.x = pkbf(v[j].x, v[j].y); t.y = pkbf(v[j].z, v[j].w); o8[64 * j] = t; }
}
__device__ __forceinline__ void load_w4(const float* w, f32x4 (&wv)[4], int lane) {
#pragma unroll
    for (int j = 0; j < 4; ++j) wv[j] = ((const GAS f32x4*)w)[lane + 64 * j];
}
__device__ __forceinline__ void phase_norm(const float* src, const float* w, bf16* XN, int gw, int NGW, int lane) {
    f32x4 wv[4]; load_w4(w, wv, lane);
    f32x4 nx[4]; row_load4(src + (size_t)gw * DM, nx, lane);
    for (int m = gw; m < M; m += NGW) { f32x4 v[4];
#pragma unroll
        for (int j = 0; j < 4; ++j) v[j] = nx[j];
        if (m + NGW < M) row_load4(src + (size_t)(m + NGW) * DM, nx, lane);
        rms_regs(wv, v); store_row_bf16(XN + (size_t)m * DM, v, lane); }
}
__device__ __forceinline__ void zero_region(unsigned char* p, size_t bytes, int gtid, int NGT) {
    GAS u32x4* q = (GAS u32x4*)p; const size_t n = bytes / 16;
    u32x4 z = (u32x4){0u, 0u, 0u, 0u}; asm volatile("" : "+v"(z));
    for (size_t i = gtid; i < n; i += NGT) q[i] = z;
}

__device__ __forceinline__ void phase_norm2_router(LAS unsigned char* lds, const float* h, const float* w2, const float* w_router, bf16* XN, float* aff, int gw, int NGW, int tid, int lane) {
    LAS float* wrT = (LAS float*)lds;
    for (int e = tid; e < 16 * 1024; e += 512) { const int k = e >> 4, x = e & 15; wrT[x * 1024 + k] = w_router[e]; }
    __syncthreads();
    f32x4 wv[4]; load_w4(w2, wv, lane);
    f32x4 nx[4]; row_load4(h + (size_t)gw * DM, nx, lane);
    for (int m = gw; m < M; m += NGW) {
        f32x4 v[4];
#pragma unroll
        for (int j = 0; j < 4; ++j) v[j] = nx[j];
        if (m + NGW < M) row_load4(h + (size_t)(m + NGW) * DM, nx, lane);
        rms_regs(wv, v); store_row_bf16(XN + (size_t)m * DM, v, lane);
        float mine = 0.f;
#pragma unroll 1
        for (int x = 0; x < 16; ++x) { float s = 0.f;
#pragma unroll
            for (int j = 0; j < 4; ++j) { const f32x4 wr = *(const LAS f32x4*)(wrT + x * 1024 + 4 * lane + 256 * j); s += (v[j].x * wr.x + v[j].y * wr.y) + (v[j].z * wr.z + v[j].w * wr.w); }
            s = wave_sum(s); mine = (lane == x) ? s : mine; }
        float mx = mine;
        mx = fmaxf(mx, __shfl_xor(mx, 1)); mx = fmaxf(mx, __shfl_xor(mx, 2)); mx = fmaxf(mx, __shfl_xor(mx, 4)); mx = fmaxf(mx, __shfl_xor(mx, 8));
        const float ex = expf(mine - mx); float den = ex;
        den += __shfl_xor(den, 1); den += __shfl_xor(den, 2); den += __shfl_xor(den, 4); den += __shfl_xor(den, 8);
        if (lane < 16) aff[(size_t)m * 16 + lane] = ex / den;
    }
}

__device__ __forceinline__ void phase_finish(const bf16* og, const bf16* ys, const bf16* yi, const bf16* gates, const float* gnw, const float* snw, bf16* mixed, int gw, int NGW, int lane) {
    float gw_[16], sw_[16];
#pragma unroll
    for (int c = 0; c < 16; ++c) { gw_[c] = gnw[(16 * lane + c) & 127]; sw_[c] = snw[16 * lane + c]; }
    bf16x8 nb[10];
#define PF_LOAD(m_) do { const size_t m1_ = (size_t)(m_); \
        nb[0] = *(const GAS bf16x8*)(og + m1_ * 1024 + 16 * lane); nb[1] = *(const GAS bf16x8*)(og + m1_ * 1024 + 16 * lane + 8); \
        nb[2] = *(const GAS bf16x8*)(ys + m1_ * 1024 + 16 * lane); nb[3] = *(const GAS bf16x8*)(ys + m1_ * 1024 + 16 * lane + 8); \
        nb[4] = *(const GAS bf16x8*)(yi + m1_ * 1024 + 16 * lane); nb[5] = *(const GAS bf16x8*)(yi + m1_ * 1024 + 16 * lane + 8); \
        nb[6] = *(const GAS bf16x8*)(gates + m1_ * 2048 + 16 * lane); nb[7] = *(const GAS bf16x8*)(gates + m1_ * 2048 + 16 * lane + 8); \
        nb[8] = *(const GAS bf16x8*)(gates + m1_ * 2048 + 1024 + 16 * lane); nb[9] = *(const GAS bf16x8*)(gates + m1_ * 2048 + 1024 + 16 * lane + 8); } while (0)
    PF_LOAD(gw);
    for (int m = gw; m < M; m += NGW) {
        const bf16x8 o0 = nb[0], o1 = nb[1], y0 = nb[2], y1 = nb[3], i0 = nb[4], i1 = nb[5], g0 = nb[6], g1 = nb[7], z0 = nb[8], z1 = nb[9];
        if (m + NGW < M) PF_LOAD(m + NGW);
        float o[16], t[16]; float so = 0.f, st = 0.f;
#pragma unroll
        for (int c = 0; c < 8; ++c) { o[c] = bf2f_s(o0[c]); o[8 + c] = bf2f_s(o1[c]); t[c] = (bf2f_s(y0[c]) + bf2f_s(i0[c])) * silu(bf2f_s(z0[c])); t[8 + c] = (bf2f_s(y1[c]) + bf2f_s(i1[c])) * silu(bf2f_s(z1[c])); }
#pragma unroll
        for (int c = 0; c < 16; ++c) { so += o[c] * o[c]; st += t[c] * t[c]; }
        so += __shfl_xor(so, 1); so += __shfl_xor(so, 2); so += __shfl_xor(so, 4);
        st += __shfl_xor(st, 1); st += __shfl_xor(st, 2); st += __shfl_xor(st, 4); st += __shfl_xor(st, 8); st += __shfl_xor(st, 16);
        const float ro = __builtin_amdgcn_rsqf(so * (1.0f / 128.f) + EPS), rt = __builtin_amdgcn_rsqf(st * (1.0f / 512.f) + EPS);
        float a[16], b2[16];
#pragma unroll
        for (int c = 0; c < 8; ++c) { a[c] = o[c] * ro * gw_[c] * silu(bf2f_s(g0[c])); a[8 + c] = o[8 + c] * ro * gw_[8 + c] * silu(bf2f_s(g1[c])); }
#pragma unroll
        for (int c = 0; c < 16; ++c) b2[c] = t[c] * rt * sw_[c];
        u32x4 w0, w1, w2, w3;
        w0.x = pkbf(a[0], a[1]); w0.y = pkbf(a[2], a[3]); w0.z = pkbf(a[4], a[5]); w0.w = pkbf(a[6], a[7]);
        w1.x = pkbf(a[8], a[9]); w1.y = pkbf(a[10], a[11]); w1.z = pkbf(a[12], a[13]); w1.w = pkbf(a[14], a[15]);
        w2.x = pkbf(b2[0], b2[1]); w2.y = pkbf(b2[2], b2[3]); w2.z = pkbf(b2[4], b2[5]); w2.w = pkbf(b2[6], b2[7]);
        w3.x = pkbf(b2[8], b2[9]); w3.y = pkbf(b2[10], b2[11]); w3.z = pkbf(b2[12], b2[13]); w3.w = pkbf(b2[14], b2[15]);
        GAS u32x4* mp = (GAS u32x4*)(mixed + (size_t)m * 2048 + 16 * lane);
        mp[0] = w0; mp[1] = w1; mp[128] = w2; mp[129] = w3;
    }
#undef PF_LOAD
}

__device__ __forceinline__ void phase_topk(LAS unsigned char* lds, const float* aff, int* idx, float* val, int* inv, int be, int tid, int wave, int lane) {
    LAS unsigned* hist = (LAS unsigned*)lds;
    LAS unsigned* ctl = hist + 256;
    LAS unsigned* wsum = hist + 320;
    const int b = be >> 4, e = be & 15;
    unsigned key[16];
#pragma unroll
    for (int i = 0; i < 16; ++i) key[i] = __float_as_uint(aff[((size_t)b * SEQ + tid * 16 + i) * 16 + e]);
    unsigned prefix = 0u, mask = 0u; unsigned krem = CAP;
    for (int pass = 0; pass < 4; ++pass) {
        const int shift = 24 - 8 * pass;
        if (tid < 256) hist[tid] = 0u;
        __syncthreads();
#pragma unroll
        for (int i = 0; i < 16; ++i) if ((key[i] & mask) == prefix) atomicAdd((unsigned*)&hist[(key[i] >> shift) & 255u], 1u);
        __syncthreads();
        if (wave == 0) {
            const u32x4 hb = *(const LAS u32x4*)(hist + 4 * lane); const unsigned sl = hb.x + hb.y + hb.z + hb.w;
            int Si = (int)sl; Si += dppi<0x101>(Si); Si += dppi<0x102>(Si); Si += dppi<0x104>(Si); Si += dppi<0x108>(Si);
            { const int t1 = __builtin_amdgcn_readlane(Si, 16), t2 = __builtin_amdgcn_readlane(Si, 32), t3 = __builtin_amdgcn_readlane(Si, 48); const int row = lane >> 4;
              Si += (row == 3 ? 0 : row == 2 ? t3 : row == 1 ? t3 + t2 : t3 + t2 + t1); }
            const unsigned S = (unsigned)Si;
            const unsigned above = S - sl;
            if (above < krem && krem <= above + sl) { unsigned cum = above; int d;
                if (cum + hb.w >= krem) d = 3; else { cum += hb.w; if (cum + hb.z >= krem) d = 2; else { cum += hb.z; if (cum + hb.y >= krem) d = 1; else { cum += hb.y; d = 0; } } }
                ctl[0] = prefix | ((unsigned)(4 * lane + d) << shift); ctl[1] = krem - cum; } }
        __syncthreads();
        prefix = ctl[0]; krem = ctl[1]; mask |= 255u << shift;
        __syncthreads();
    }
    const unsigned thr = prefix;
    int ngt = 0, neq = 0;
#pragma unroll
    for (int i = 0; i < 16; ++i) { ngt += key[i] > thr; neq += key[i] == thr; }
    const int sg = scan_fwd64_i(ngt, lane), sq = scan_fwd64_i(neq, lane);
    if (lane == 63) { wsum[wave] = (unsigned)sg; wsum[8 + wave] = (unsigned)sq; }
    __syncthreads();
    int bg = 0, bq = 0;
#pragma unroll
    for (int w = 0; w < 8; ++w) if (w < wave) { bg += (int)wsum[w]; bq += (int)wsum[8 + w]; }
    int pg = bg + sg - ngt, pq = bq + sq - neq;
#pragma unroll
    for (int i = 0; i < 16; ++i) {
        const int tok = tid * 16 + i; const bool gt = key[i] > thr, eq = key[i] == thr;
        const bool sel = gt || (eq && pq < (int)krem);
        const int slot = pg + (pq < (int)krem ? pq : (int)krem);
        if (sel) { idx[be * CAP + slot] = tok; val[be * CAP + slot] = __uint_as_float(key[i]); }
        inv[((size_t)b * SEQ + tok) * 16 + e] = sel ? slot : -1;
        pg += gt; pq += eq;
    }
    __syncthreads();
}

__device__ __forceinline__ void phase_gather(const bf16* XN, const int* idx, bf16* XG, int gw, int NGW, int lane) {
    for (int r = gw; r < MEXP; r += NGW) {
        const int b = r >> 14; const int tok = idx[r];
        const GAS u32x4* s = (const GAS u32x4*)(XN + ((size_t)b * SEQ + tok) * DM) + lane; GAS u32x4* d = (GAS u32x4*)(XG + (size_t)r * DM) + lane;
        const u32x4 a = s[0], c = s[64]; d[0] = a; d[64] = c;
    }
}

__device__ __forceinline__ void phase_combine(const float* hin, float* hout, const bf16* Y, const int* inv, const float* val, const float* wn, bf16* XN, bool final_, int gw, int NGW, int lane, float pscale = 1.0f) {
    f32x4 wv[4]; load_w4(wn, wv, lane);
    f32x4 nx[4]; row_load4(hin + (size_t)gw * DM, nx, lane); int nslot = (lane < 16) ? inv[(size_t)gw * 16 + lane] : -1;
    for (int m = gw; m < M; m += NGW) {
        const int b = m >> 13;
        f32x4 v[4];
#pragma unroll
        for (int j = 0; j < 4; ++j) v[j] = nx[j];
        const int myslot = nslot;
        if (m + NGW < M) { row_load4(hin + (size_t)(m + NGW) * DM, nx, lane); nslot = (lane < 16) ? inv[(size_t)(m + NGW) * 16 + lane] : -1; }
        unsigned mask = (unsigned)__builtin_amdgcn_ballot_w64(myslot >= 0) & 0xffffu;
        while (mask) {
            const int e0 = __builtin_ctz(mask); mask &= mask - 1u;
            const bool two = mask != 0u; const int e1 = two ? __builtin_ctz(mask) : e0; if (two) mask &= mask - 1u;
            const int s0 = __builtin_amdgcn_readlane(myslot, e0), s1 = __builtin_amdgcn_readlane(myslot, e1);
            const int r0 = (b * 16 + e0) * CAP + s0, r1 = (b * 16 + e1) * CAP + s1;
            const float a0 = val[r0]; const float a1 = two ? val[r1] : 0.f;
            const GAS u32x2* y0 = (const GAS u32x2*)(Y + (size_t)r0 * DM) + lane; const GAS u32x2* y1 = (const GAS u32x2*)(Y + (size_t)r1 * DM) + lane;
            u32x2 t0[4], t1[4];
#pragma unroll
            for (int j = 0; j < 4; ++j) { t0[j] = y0[64 * j]; t1[j] = y1[64 * j]; }
#pragma unroll
            for (int j = 0; j < 4; ++j) { const u32x2 t = t0[j];
                v[j].x += a0 * __uint_as_float(t.x << 16); v[j].y += a0 * __uint_as_float(t.x & 0xffff0000u); v[j].z += a0 * __uint_as_float(t.y << 16); v[j].w += a0 * __uint_as_float(t.y & 0xffff0000u); }
            if (two) {
#pragma unroll
                for (int j = 0; j < 4; ++j) { const u32x2 t = t1[j];
                    v[j].x += a1 * __uint_as_float(t.x << 16); v[j].y += a1 * __uint_as_float(t.x & 0xffff0000u); v[j].z += a1 * __uint_as_float(t.y << 16); v[j].w += a1 * __uint_as_float(t.y & 0xffff0000u); } }
        }
        float s2 = 0.f;
#pragma unroll
        for (int j = 0; j < 4; ++j) s2 += (v[j].x * v[j].x + v[j].y * v[j].y) + (v[j].z * v[j].z + v[j].w * v[j].w);
        const float rstd = __builtin_amdgcn_rsqf(wave_sum(s2) * (1.0f / DM) + EPS);
        GAS f32x4* ho = (GAS f32x4*)(hout + (size_t)m * DM) + lane;
        if (final_) {
#pragma unroll
            for (int j = 0; j < 4; ++j) ho[64 * j] = v[j] * (rstd * pscale) * wv[j];
        } else {
#pragma unroll
            for (int j = 0; j < 4; ++j) ho[64 * j] = v[j];
            f32x4 nv[4];
#pragma unroll
            for (int j = 0; j < 4; ++j) nv[j] = v[j] * rstd * wv[j];
            store_row_bf16(XN + (size_t)m * DM, nv, lane);
        }
    }
}
namespace gdn {
constexpr int CW = 0;
constexpr int SC = CW + 8 * 320 * 4;
constexpr int Q = SC + 1280;
constexpr int K = Q + 64 * 136 * 2;
constexpr int KDT = K + 64 * 136 * 2;
constexpr int VT = KDT + 128 * 72 * 2;
constexpr int T = VT + 64 * 72 * 2;
constexpr int QKD = T + 64 * 72 * 2;
constexpr int ST = QKD + 64 * 72 * 2;
constexpr int TMP = ST + 64 * 136 * 2;
constexpr int RQ = TMP, RK = RQ + 70 * 136 * 2, RV = RK + 70 * 136 * 2, RAW_END = RV + 70 * 72 * 2;
constexpr int AF = TMP, TF = AF + 64 * 68 * 4, XF = TF + 64 * 68 * 4, INV_END = XF + 3 * 16 * 17 * 4;
constexpr int RT = TMP, UT = RT + 64 * 72 * 2, OS = UT + 64 * 72 * 2, ST_END = OS + 64 * 65 * 4;
static_assert(RAW_END <= MISC_OFF && INV_END <= MISC_OFF && ST_END <= MISC_OFF, "gdn LDS map");
}
__device__ __forceinline__ void gdn_chain(LAS unsigned char* lds, int cid, const bf16* raw, const float* scal, const float* conv_w, const float* conv_b,
                                          const float* A_log, const float* dt_bias, bf16* og, int tid, int wave, int lane) {
    using namespace gdn;
    const int dvh = cid & 1, dir = (cid >> 1) & 1, h = (cid >> 2) & 7, b = cid >> 5;
    const int fr = lane & 15, fq = lane >> 4;
    LAS float* cw = (LAS float*)(lds + CW); LAS float* sc = (LAS float*)(lds + SC);
    LAS bf16* q_ = (LAS bf16*)(lds + Q); LAS bf16* k_ = (LAS bf16*)(lds + K); LAS bf16* kdT = (LAS bf16*)(lds + KDT); LAS bf16* vT = (LAS bf16*)(lds + VT);
    LAS bf16* T_ = (LAS bf16*)(lds + T); LAS bf16* QKd = (LAS bf16*)(lds + QKD); LAS bf16* ST_ = (LAS bf16*)(lds + ST);
    LAS bf16* rq = (LAS bf16*)(lds + RQ); LAS bf16* rk = (LAS bf16*)(lds + RK); LAS bf16* rv = (LAS bf16*)(lds + RV);
    LAS float* Af = (LAS float*)(lds + AF); LAS float* Tf = (LAS float*)(lds + TF); LAS float* Xf = (LAS float*)(lds + XF);
    LAS bf16* rT = (LAS bf16*)(lds + RT); LAS bf16* uT = (LAS bf16*)(lds + UT); LAS float* os = (LAS float*)(lds + OS);
    for (int e = tid; e < 8 * 320; e += 512) { const int r = e / 320, c = e % 320;
        const int gch = c < 128 ? h * 128 + c : (c < 256 ? 1024 + h * 128 + (c - 128) : 2048 + h * 128 + dvh * 64 + (c - 256));
        cw[e] = r < 7 ? conv_w[r * CONV_CH + gch] : conv_b[gch]; }
    for (int e = tid; e < 64 * 136 / 2; e += 512) ((LAS unsigned*)ST_)[e] = 0u;
    const float expA = expf(A_log[dir * 8 + h]), dtb = dt_bias[dir * 8 + h];
    f32x4 sacc[4];
#pragma unroll
    for (int nt = 0; nt < 4; ++nt) sacc[nt] = (f32x4){0.f, 0.f, 0.f, 0.f};
    const size_t rowb = (size_t)b * SEQ;
    __syncthreads();
    for (int n = 0; n < NCHUNK; ++n) {
        const int t0 = (dir ? NCHUNK - 1 - n : n) * 64;
        for (int e = tid; e < 70 * 40; e += 512) { const int r = e / 40, p = e % 40; const int t = t0 - 3 + r;
            u32x4 v = (u32x4){0u, 0u, 0u, 0u};
            const int col = p < 16 ? h * 128 + p * 8 : (p < 32 ? 1024 + h * 128 + (p - 16) * 8 : 2048 + h * 128 + dvh * 64 + (p - 32) * 8);
            if (t >= 0 && t < SEQ) v = *(const GAS u32x4*)(raw + (rowb + t) * CONV_CH + col);
            LAS bf16* d = p < 16 ? rq + r * 136 + p * 8 : (p < 32 ? rk + r * 136 + (p - 16) * 8 : rv + r * 72 + (p - 32) * 8);
            *(LAS u32x4*)d = v; }
        if (wave == 0) { const int i = lane; const int t = t0 + (dir ? 63 - i : i);
            const float braw = scal[(rowb + t) * 64 + dir * 8 + h], araw = scal[(rowb + t) * 64 + 16 + dir * 8 + h];
            const float g = -expA * softplus_f(araw + dtb);
            float gc = g;
#pragma unroll
            for (int o = 1; o < 64; o <<= 1) { const float y = __shfl_up(gc, o); if (i >= o) gc += y; }
            const float gl = __shfl(gc, 63);
            sc[i] = sigmoid_f(braw); sc[64 + i] = gc; sc[128 + i] = expf(gc); sc[192 + i] = expf(gl - gc); if (i == 0) sc[256] = expf(gl); }
        __syncthreads();
        { const int i = tid >> 3, cg = tid & 7; const int o = dir ? 63 - i : i;
          float a[16];
          conv16(a, rq + o * 136 + cg * 16, 136, cw + cg * 16, 320);
          float ss = 0.f;
#pragma unroll
          for (int c = 0; c < 16; ++c) { a[c] = silu(a[c]); ss += a[c] * a[c]; }
          ss += __shfl_xor(ss, 1); ss += __shfl_xor(ss, 2); ss += __shfl_xor(ss, 4);
          float rs = (1.0f / sqrtf(ss + EPS)) * 0.08838834764831845f;
          { u32x4 w0, w1; w0.x = pkbf(a[0] * rs, a[1] * rs); w0.y = pkbf(a[2] * rs, a[3] * rs); w0.z = pkbf(a[4] * rs, a[5] * rs); w0.w = pkbf(a[6] * rs, a[7] * rs);
            w1.x = pkbf(a[8] * rs, a[9] * rs); w1.y = pkbf(a[10] * rs, a[11] * rs); w1.z = pkbf(a[12] * rs, a[13] * rs); w1.w = pkbf(a[14] * rs, a[15] * rs);
            *(LAS u32x4*)(q_ + i * 136 + cg * 16) = w0; *(LAS u32x4*)(q_ + i * 136 + cg * 16 + 8) = w1; }
          conv16(a, rk + o * 136 + cg * 16, 136, cw + 128 + cg * 16, 320);
          ss = 0.f;
#pragma unroll
          for (int c = 0; c < 16; ++c) { a[c] = silu(a[c]); ss += a[c] * a[c]; }
          ss += __shfl_xor(ss, 1); ss += __shfl_xor(ss, 2); ss += __shfl_xor(ss, 4);
          rs = 1.0f / sqrtf(ss + EPS);
          { u32x4 w0, w1; w0.x = pkbf(a[0] * rs, a[1] * rs); w0.y = pkbf(a[2] * rs, a[3] * rs); w0.z = pkbf(a[4] * rs, a[5] * rs); w0.w = pkbf(a[6] * rs, a[7] * rs);
            w1.x = pkbf(a[8] * rs, a[9] * rs); w1.y = pkbf(a[10] * rs, a[11] * rs); w1.z = pkbf(a[12] * rs, a[13] * rs); w1.w = pkbf(a[14] * rs, a[15] * rs);
            *(LAS u32x4*)(k_ + i * 136 + cg * 16) = w0; *(LAS u32x4*)(k_ + i * 136 + cg * 16 + 8) = w1; }
          const float ek = sc[192 + i] * rs;
#pragma unroll
          for (int c = 0; c < 16; ++c) kdT[(cg * 16 + c) * 72 + i] = f2bf1(a[c] * ek);
          float v8[8];
          conv8(v8, rv + o * 72 + cg * 8, 72, cw + 256 + cg * 8, 320);
#pragma unroll
          for (int c = 0; c < 8; ++c) vT[(cg * 8 + c) * 72 + i] = f2bf1(silu(v8[c]));
        }
        __syncthreads();
        { const int which = wave >> 2, mt = wave & 3;
          f32x4 acc[1][4];
#pragma unroll
          for (int nt = 0; nt < 4; ++nt) acc[0][nt] = (f32x4){0.f, 0.f, 0.f, 0.f};
          mma_lds<1, 4>(acc, which ? q_ : k_, 136, mt * 16, k_, 136, 0, 128, fr, fq);
#pragma unroll
          for (int nt = 0; nt < 4; ++nt)
#pragma unroll
              for (int r = 0; r < 4; ++r) { const int i = mt * 16 + 4 * fq + r, j = nt * 16 + fr;
                  const float d = expf(fminf(sc[64 + i] - sc[64 + j], 0.f)); const float x = acc[0][nt][r] * d;
                  if (which == 0) Af[i * 68 + j] = (i > j) ? sc[i] * x : 0.f;
                  else QKd[i * 72 + j] = f2bf1((i >= j) ? x : 0.f); }
        }
        __syncthreads();
        if (wave == 0) { const int blk = lane >> 4, c = lane & 15; float t[16];
#pragma unroll
            for (int i = 0; i < 16; ++i) t[i] = (i == c) ? 1.f : 0.f;
#pragma unroll
            for (int i = 1; i < 16; ++i) { float s = 0.f; const LAS float* ar = Af + (blk * 16 + i) * 68 + blk * 16;
#pragma unroll
                for (int j = 0; j < i; ++j) s += ar[j] * t[j];
                t[i] = (i > c) ? -s : t[i];
                if ((i & 3) == 3) asm volatile("" ::: "memory"); }
#pragma unroll
            for (int i = 0; i < 16; ++i) Tf[(blk * 16 + i) * 68 + blk * 16 + c] = t[i]; }
        for (int d = 1; d <= 3; ++d) { const int nbk = 4 - d;
            __syncthreads();
            for (int e = tid; e < nbk * 256; e += 512) { const int J = e >> 8, r = (e >> 4) & 15, c = e & 15, I = J + d; float s = 0.f;
                for (int kk = J * 16; kk < I * 16; ++kk) s += Af[(I * 16 + r) * 68 + kk] * Tf[kk * 68 + J * 16 + c];
                Xf[(J * 16 + r) * 17 + c] = s; }
            __syncthreads();
            for (int e = tid; e < nbk * 256; e += 512) { const int J = e >> 8, r = (e >> 4) & 15, c = e & 15, I = J + d; float s = 0.f;
#pragma unroll
                for (int m2 = 0; m2 < 16; ++m2) s += Tf[(I * 16 + r) * 68 + I * 16 + m2] * Xf[(J * 16 + m2) * 17 + c];
                Tf[(I * 16 + r) * 68 + J * 16 + c] = -s; }
        }
        __syncthreads();
        for (int e = tid; e < 4096; e += 512) { const int i = e >> 6, j = e & 63; T_[i * 72 + j] = f2bf1(((i >> 4) >= (j >> 4)) ? Tf[i * 68 + j] : 0.f); }
        __syncthreads();
        const int mt = wave & 3, nh = wave >> 2;
        f32x4 aq[2];
        { f32x4 ak[2]; ak[0] = ak[1] = aq[0] = aq[1] = (f32x4){0.f, 0.f, 0.f, 0.f};
          for (int k0 = 0; k0 < 128; k0 += 32) {
              const bf16x8 fk = *(const LAS bf16x8*)(k_ + (mt * 16 + fr) * 136 + k0 + fq * 8), fqv = *(const LAS bf16x8*)(q_ + (mt * 16 + fr) * 136 + k0 + fq * 8);
#pragma unroll
              for (int nl = 0; nl < 2; ++nl) { const bf16x8 fb = *(const LAS bf16x8*)(ST_ + (nh * 32 + nl * 16 + fr) * 136 + k0 + fq * 8);
                  ak[nl] = __builtin_amdgcn_mfma_f32_16x16x32_bf16(fk, fb, ak[nl], 0, 0, 0); aq[nl] = __builtin_amdgcn_mfma_f32_16x16x32_bf16(fqv, fb, aq[nl], 0, 0, 0); } }
          const int i0 = mt * 16 + 4 * fq;
          const f32x4 be4 = *(const LAS f32x4*)(sc + i0), eg4 = *(const LAS f32x4*)(sc + 128 + i0);
#pragma unroll
          for (int nl = 0; nl < 2; ++nl) { const int dv = nh * 32 + nl * 16 + fr;
              const bf16x4 vv = *(const LAS bf16x4*)(vT + dv * 72 + i0);
              float r0 = be4[0] * (bf2f_s(vv[0]) - eg4[0] * ak[nl][0]), r1 = be4[1] * (bf2f_s(vv[1]) - eg4[1] * ak[nl][1]);
              float r2 = be4[2] * (bf2f_s(vv[2]) - eg4[2] * ak[nl][2]), r3 = be4[3] * (bf2f_s(vv[3]) - eg4[3] * ak[nl][3]);
              u32x2 w; w.x = pkbf(r0, r1); w.y = pkbf(r2, r3); *(LAS u32x2*)(rT + dv * 72 + i0) = w;
              aq[nl][0] *= eg4[0]; aq[nl][1] *= eg4[1]; aq[nl][2] *= eg4[2]; aq[nl][3] *= eg4[3]; }
        }
        __syncthreads();
        { f32x4 au[1][2]; au[0][0] = au[0][1] = (f32x4){0.f, 0.f, 0.f, 0.f};
          mma_lds<1, 2>(au, T_, 72, mt * 16, rT, 72, nh * 32, 64, fr, fq);
          const int i0 = mt * 16 + 4 * fq;
#pragma unroll
          for (int nl = 0; nl < 2; ++nl) { const int dv = nh * 32 + nl * 16 + fr; u32x2 w; w.x = pkbf(au[0][nl][0], au[0][nl][1]); w.y = pkbf(au[0][nl][2], au[0][nl][3]); *(LAS u32x2*)(uT + dv * 72 + i0) = w; }
        }
        __syncthreads();
        { f32x4 ao[1][2]; ao[0][0] = aq[0]; ao[0][1] = aq[1];
          mma_lds<1, 2>(ao, QKd, 72, mt * 16, uT, 72, nh * 32, 64, fr, fq);
          const int i0 = mt * 16 + 4 * fq;
#pragma unroll
          for (int nl = 0; nl < 2; ++nl)
#pragma unroll
              for (int r = 0; r < 4; ++r) os[(i0 + r) * 65 + nh * 32 + nl * 16 + fr] = ao[0][nl][r];
          const float egl = sc[256];
          f32x4 as_[1][4];
#pragma unroll
          for (int nt = 0; nt < 4; ++nt) as_[0][nt] = sacc[nt] * egl;
          mma_lds<1, 4>(as_, kdT, 72, wave * 16, uT, 72, 0, 64, fr, fq);
#pragma unroll
          for (int nt = 0; nt < 4; ++nt) { sacc[nt] = as_[0][nt];
              u32x2 w; w.x = pkbf(sacc[nt][0], sacc[nt][1]); w.y = pkbf(sacc[nt][2], sacc[nt][3]); *(LAS u32x2*)(ST_ + (nt * 16 + fr) * 136 + wave * 16 + 4 * fq) = w; }
        }
        __syncthreads();
#pragma unroll
        for (int ii = 0; ii < 4; ++ii) { const int i = wave * 8 + 2 * ii + (lane >> 5), cp = lane & 31; const int t = t0 + (dir ? 63 - i : i);
            atomic_add_bf16x2(og + (rowb + t) * 1024 + h * 128 + dvh * 64 + 2 * cp, os[i * 65 + 2 * cp], os[i * 65 + 2 * cp + 1]); }
        __syncthreads();
    }
}

namespace ssd {
constexpr int CW = 0;
constexpr int SC = CW + 8 * 320 * 4;
constexpr int BM_ = SC + 1280;
constexpr int CM_ = BM_ + 64 * 136 * 2;
constexpr int BT = CM_ + 64 * 136 * 2;
constexpr int XDT = BT + 128 * 72 * 2;
constexpr int XDW = XDT + 64 * 72 * 2;
constexpr int MM = XDW + 64 * 72 * 2;
constexpr int HT = MM + 64 * 72 * 2;
constexpr int TMP = HT + 64 * 136 * 2;
constexpr int RX = TMP, RB = RX + 70 * 72 * 2, RC = RB + 70 * 136 * 2, RAW_END = RC + 70 * 136 * 2;
constexpr int OS = TMP, OS_END = OS + 64 * 65 * 4;
static_assert(RAW_END <= MISC_OFF && OS_END <= MISC_OFF, "ssd LDS map");
}
__device__ __forceinline__ void ssd_chain(LAS unsigned char* lds, int cid, const bf16* raw, const float* scal, const float* conv_w, const float* conv_b,
                                          const float* A_log, const float* dt_bias, const float* Dp, bf16* ys, int tid, int wave, int lane) {
    using namespace ssd;
    const int dir = cid & 1, head = (cid >> 1) & 15, b = cid >> 5; const int g = head >> 3;
    const int fr = lane & 15, fq = lane >> 4;
    LAS float* cw = (LAS float*)(lds + CW); LAS float* sc = (LAS float*)(lds + SC);
    LAS bf16* Bm = (LAS bf16*)(lds + BM_); LAS bf16* Cm = (LAS bf16*)(lds + CM_); LAS bf16* BT_ = (LAS bf16*)(lds + BT);
    LAS bf16* xdt = (LAS bf16*)(lds + XDT); LAS bf16* xdw = (LAS bf16*)(lds + XDW); LAS bf16* Mm = (LAS bf16*)(lds + MM); LAS bf16* hT = (LAS bf16*)(lds + HT);
    LAS bf16* rx = (LAS bf16*)(lds + RX); LAS bf16* rb = (LAS bf16*)(lds + RB); LAS bf16* rc = (LAS bf16*)(lds + RC); LAS float* os = (LAS float*)(lds + OS);
    const int chx = 3072 + head * 64, chb = 4096 + g * 128, chc = 4352 + g * 128;
    for (int e = tid; e < 8 * 320; e += 512) { const int r = e / 320, c = e % 320;
        const int gch = c < 64 ? chx + c : (c < 192 ? chb + (c - 64) : chc + (c - 192));
        cw[e] = r < 7 ? conv_w[r * CONV_CH + gch] : conv_b[gch]; }
    for (int e = tid; e < 64 * 136 / 2; e += 512) ((LAS unsigned*)hT)[e] = 0u;
    const float Ah = -expf(A_log[dir * 16 + head]), dtb = dt_bias[dir * 16 + head], Dh = (dir == 0) ? Dp[head] : 0.f;
    f32x4 hacc[4];
#pragma unroll
    for (int nt = 0; nt < 4; ++nt) hacc[nt] = (f32x4){0.f, 0.f, 0.f, 0.f};
    const size_t rowb = (size_t)b * SEQ;
    __syncthreads();
    for (int n = 0; n < NCHUNK; ++n) {
        const int t0 = (dir ? NCHUNK - 1 - n : n) * 64;
        for (int e = tid; e < 70 * 40; e += 512) { const int r = e / 40, p = e % 40; const int t = t0 - 3 + r;
            u32x4 v = (u32x4){0u, 0u, 0u, 0u};
            const int col = p < 8 ? chx + p * 8 : (p < 24 ? chb + (p - 8) * 8 : chc + (p - 24) * 8);
            if (t >= 0 && t < SEQ) v = *(const GAS u32x4*)(raw + (rowb + t) * CONV_CH + col);
            LAS bf16* d = p < 8 ? rx + r * 72 + p * 8 : (p < 24 ? rb + r * 136 + (p - 8) * 8 : rc + r * 136 + (p - 24) * 8);
            *(LAS u32x4*)d = v; }
        if (wave == 0) { const int i = lane; const int t = t0 + (dir ? 63 - i : i);
            const float dt = softplus_f(scal[(rowb + t) * 64 + 32 + dir * 16 + head] + dtb);
            float cs = dt * Ah;
#pragma unroll
            for (int o = 1; o < 64; o <<= 1) { const float y = __shfl_up(cs, o); if (i >= o) cs += y; }
            const float cl = __shfl(cs, 63);
            sc[i] = dt; sc[64 + i] = cs; sc[128 + i] = expf(cs); sc[192 + i] = expf(cl - cs); if (i == 0) sc[256] = expf(cl); }
        __syncthreads();
        { const int i = tid >> 3, cg = tid & 7; const int o = dir ? 63 - i : i;
          float a[16];
          conv16(a, rb + o * 136 + cg * 16, 136, cw + 64 + cg * 16, 320);
#pragma unroll
          for (int c = 0; c < 16; ++c) a[c] = silu(a[c]);
          { u32x4 w0, w1; w0.x = pkbf(a[0], a[1]); w0.y = pkbf(a[2], a[3]); w0.z = pkbf(a[4], a[5]); w0.w = pkbf(a[6], a[7]);
            w1.x = pkbf(a[8], a[9]); w1.y = pkbf(a[10], a[11]); w1.z = pkbf(a[12], a[13]); w1.w = pkbf(a[14], a[15]);
            *(LAS u32x4*)(Bm + i * 136 + cg * 16) = w0; *(LAS u32x4*)(Bm + i * 136 + cg * 16 + 8) = w1; }
#pragma unroll
          for (int c = 0; c < 16; ++c) BT_[(cg * 16 + c) * 72 + i] = f2bf1(a[c]);
          conv16(a, rc + o * 136 + cg * 16, 136, cw + 192 + cg * 16, 320);
#pragma unroll
          for (int c = 0; c < 16; ++c) a[c] = silu(a[c]);
          { u32x4 w0, w1; w0.x = pkbf(a[0], a[1]); w0.y = pkbf(a[2], a[3]); w0.z = pkbf(a[4], a[5]); w0.w = pkbf(a[6], a[7]);
            w1.x = pkbf(a[8], a[9]); w1.y = pkbf(a[10], a[11]); w1.z = pkbf(a[12], a[13]); w1.w = pkbf(a[14], a[15]);
            *(LAS u32x4*)(Cm + i * 136 + cg * 16) = w0; *(LAS u32x4*)(Cm + i * 136 + cg * 16 + 8) = w1; }
          float x8[8];
          conv8(x8, rx + o * 72 + cg * 8, 72, cw + cg * 8, 320);
          const float dt = sc[i], wst = sc[192 + i];
#pragma unroll
          for (int c = 0; c < 8; ++c) { const float xv = silu(x8[c]) * dt; xdt[(cg * 8 + c) * 72 + i] = f2bf1(xv); xdw[(cg * 8 + c) * 72 + i] = f2bf1(xv * wst); }
        }
        __syncthreads();
        const int mt = wave & 3, nh = wave >> 2;
        { f32x4 acc[1][2]; acc[0][0] = acc[0][1] = (f32x4){0.f, 0.f, 0.f, 0.f};
          mma_lds<1, 2>(acc, Cm, 136, mt * 16, Bm, 136, nh * 32, 128, fr, fq);
#pragma unroll
          for (int nl = 0; nl < 2; ++nl)
#pragma unroll
              for (int r = 0; r < 4; ++r) { const int i = mt * 16 + 4 * fq + r, j = nh * 32 + nl * 16 + fr;
                  const float d = expf(fminf(sc[64 + i] - sc[64 + j], 0.f));
                  Mm[i * 72 + j] = f2bf1((i >= j) ? acc[0][nl][r] * d : 0.f); }
        }
        __syncthreads();
        { f32x4 a1[1][2], a2[1][2]; a1[0][0] = a1[0][1] = a2[0][0] = a2[0][1] = (f32x4){0.f, 0.f, 0.f, 0.f};
          mma_lds<1, 2>(a1, Mm, 72, mt * 16, xdt, 72, nh * 32, 64, fr, fq);
          mma_lds<1, 2>(a2, Cm, 136, mt * 16, hT, 136, nh * 32, 128, fr, fq);
          const int i0 = mt * 16 + 4 * fq;
          const f32x4 ec4 = *(const LAS f32x4*)(sc + 128 + i0), dt4 = *(const LAS f32x4*)(sc + i0);
#pragma unroll
          for (int nl = 0; nl < 2; ++nl) { const int p = nh * 32 + nl * 16 + fr; const bf16x4 xv = *(const LAS bf16x4*)(xdt + p * 72 + i0);
#pragma unroll
              for (int r = 0; r < 4; ++r) os[(i0 + r) * 65 + p] = a1[0][nl][r] + ec4[r] * a2[0][nl][r] + Dh * bf2f_s(xv[r]) / dt4[r]; }
        }
        __syncthreads();
        { const float ecl = sc[256];
          f32x4 ah[1][4];
#pragma unroll
          for (int nt = 0; nt < 4; ++nt) ah[0][nt] = hacc[nt] * ecl;
          mma_lds<1, 4>(ah, BT_, 72, wave * 16, xdw, 72, 0, 64, fr, fq);
#pragma unroll
          for (int nt = 0; nt < 4; ++nt) { hacc[nt] = ah[0][nt];
              u32x2 w; w.x = pkbf(hacc[nt][0], hacc[nt][1]); w.y = pkbf(hacc[nt][2], hacc[nt][3]); *(LAS u32x2*)(hT + (nt * 16 + fr) * 136 + wave * 16 + 4 * fq) = w; }
        }
#pragma unroll
        for (int ii = 0; ii < 4; ++ii) { const int i = wave * 8 + 2 * ii + (lane >> 5), cp = lane & 31; const int t = t0 + (dir ? 63 - i : i);
            atomic_add_bf16x2(ys + (rowb + t) * 1024 + head * 64 + 2 * cp, os[i * 65 + 2 * cp], os[i * 65 + 2 * cp + 1]); }
        __syncthreads();
    }
}
namespace pgd {
constexpr int CW = 0;
constexpr int SC = CW + 8 * 384 * 4;
constexpr int Q = SC + 1280;
constexpr int K = Q + 64 * 136 * 2;
constexpr int VT = K + 64 * 136 * 2;
constexpr int TMP = VT + 128 * 72 * 2;
constexpr int RQ = TMP, RK = RQ + 70 * 136 * 2, RV = RK + 70 * 136 * 2, RAW_END = RV + 70 * 136 * 2;
constexpr int AF = TMP, A2F = AF + 64 * 68 * 4, TF = A2F + 64 * 68 * 4, T2F = TF + 64 * 68 * 4, QKP = T2F + 64 * 68 * 4, INV_END = QKP + 64 * 72 * 2;
constexpr int XF = VT;
constexpr int TP = AF;
constexpr int STASH = MISC_OFF - 16384;
static_assert(RAW_END <= STASH && INV_END <= STASH, "prep gdn LDS map");
}
constexpr size_t WS_TQ = 379 * MiB;

__device__ __forceinline__ void prep_gdn_stash(LAS unsigned char* lds, int bid, const bf16* raw, int tid) {
    const int bh = bid >> 3, b = bh >> 3, h = bh & 7, r8 = bid & 7;
    LAS bf16* st = (LAS bf16*)(lds + pgd::STASH);
    for (int e = tid; e < 2 * 3 * 48; e += 512) { const int which = e / 144, r = (e % 144) / 48, p = e % 48;
        const int t = which ? (r8 * 16 + 16) * 64 + r : r8 * 16 * 64 - 3 + r;
        const int col = p < 16 ? h * 128 + p * 8 : (p < 32 ? 1024 + h * 128 + (p - 16) * 8 : 2048 + h * 128 + (p - 32) * 8);
        u32x4 v = (u32x4){0u, 0u, 0u, 0u};
        if (t >= 0 && t < SEQ) v = *(const GAS u32x4*)(raw + ((size_t)b * SEQ + t) * CONV_CH + col);
        *(LAS u32x4*)(st + which * 1152 + r * 384 + p * 8) = v; }
}
__device__ __forceinline__ void inv_diag_blocks(const LAS float* Af, LAS float* Tf, int lane) {
    const int blk = lane >> 4, c = lane & 15; float t[16];
#pragma unroll
    for (int i = 0; i < 16; ++i) t[i] = (i == c) ? 1.f : 0.f;
#pragma unroll
    for (int i = 1; i < 16; ++i) { float s = 0.f; const LAS float* ar = Af + (blk * 16 + i) * 68 + blk * 16;
#pragma unroll
        for (int j = 0; j < i; ++j) s += ar[j] * t[j];
        t[i] = (i > c) ? -s : t[i];
        if ((i & 3) == 3) asm volatile("" ::: "memory"); }
#pragma unroll
    for (int i = 0; i < 16; ++i) Tf[(blk * 16 + i) * 68 + blk * 16 + c] = t[i];
}
__device__ __forceinline__ void inv_offdiag_x(const LAS float* Af, const LAS float* Tf, LAS float* Xf, int d, int ht) {
    const int nbk = 4 - d;
    for (int e = ht; e < nbk * 256; e += 256) { const int J = e >> 8, r = (e >> 4) & 15, c = e & 15, I = J + d; float s = 0.f;
        for (int kk = J * 16; kk < I * 16; ++kk) s += Af[(I * 16 + r) * 68 + kk] * Tf[kk * 68 + J * 16 + c];
        Xf[(J * 16 + r) * 17 + c] = s; }
}
__device__ __forceinline__ void inv_offdiag_t(LAS float* Tf, const LAS float* Xf, int d, int ht) {
    const int nbk = 4 - d;
    for (int e = ht; e < nbk * 256; e += 256) { const int J = e >> 8, r = (e >> 4) & 15, c = e & 15, I = J + d; float s = 0.f;
#pragma unroll
        for (int m2 = 0; m2 < 16; ++m2) s += Tf[(I * 16 + r) * 68 + I * 16 + m2] * Xf[(J * 16 + m2) * 17 + c];
        Tf[(I * 16 + r) * 68 + J * 16 + c] = -s; }
}

__device__ __forceinline__ void conv_pair8(float (&o)[16], const LAS bf16* src  , int ld, const float (&w)[16]) {
#pragma unroll
    for (int t = 0; t < 8; ++t) { o[2 * t] = w[14]; o[2 * t + 1] = w[15]; }
#pragma unroll
    for (int r = 0; r < 14; ++r) { const unsigned xv = *(const LAS unsigned*)(src + r * ld); const float x0 = __uint_as_float(xv << 16), x1 = __uint_as_float(xv & 0xffff0000u);
#pragma unroll
        for (int t = 0; t < 8; ++t) { const int tap = r - t; if (tap >= 0 && tap < 7) { o[2 * t] += x0 * w[2 * tap]; o[2 * t + 1] += x1 * w[2 * tap + 1]; } } }
}
namespace pg2 {
constexpr int CW = 0;
constexpr int SC = CW + 8 * 384 * 4;
constexpr int Q = SC + 1280;
constexpr int K = Q + 64 * 136 * 2;
constexpr int VT = K + 64 * 136 * 2;
constexpr int RAWT = VT + 128 * 72 * 2;
constexpr int RAW_END = RAWT + 3 * 70 * 136 * 2;
constexpr int ABF = RAWT, TRM = ABF + 2 * 64 * 72 * 2, TTR = TRM + 2 * 64 * 72 * 2, AD = TTR + 2 * 64 * 72 * 2, XS = AD + 2 * 4 * 256 * 4, QKP = XS + 2 * 32 * 40 * 2, INV_END = QKP + 64 * 72 * 2;
static_assert(RAW_END <= pgd::STASH && INV_END <= pgd::STASH, "prep gdn v2 LDS map");
}
__device__ __forceinline__ void prep_gdn_range(LAS unsigned char* lds, int bid, bf16* raw, const float* scal, const float* conv_w, const float* conv_b,
                                               const float* A_log, const float* dt_bias, bf16* TQ, int tid_p, int wave_p, int lane_p, float* scal_w) {
    using namespace pg2;
    int tid = tid_p, wave = wave_p, lane = lane_p;
    const int bh = bid >> 3, b = bh >> 3, h = bh & 7, r8 = bid & 7;
    LAS float* cw = (LAS float*)(lds + CW); LAS float* sc = (LAS float*)(lds + SC);
    LAS bf16* q_ = (LAS bf16*)(lds + Q); LAS bf16* k_ = (LAS bf16*)(lds + K); LAS bf16* vT = (LAS bf16*)(lds + VT);
    LAS bf16* rq = (LAS bf16*)(lds + RAWT); LAS bf16* rk = rq + 70 * 136; LAS bf16* rv = rk + 70 * 136;
    LAS bf16* Abf = (LAS bf16*)(lds + ABF); LAS bf16* Trm = (LAS bf16*)(lds + TRM); LAS bf16* Ttr = (LAS bf16*)(lds + TTR);
    LAS float* ADf = (LAS float*)(lds + AD); LAS bf16* Xs = (LAS bf16*)(lds + XS); LAS bf16* QKp = (LAS bf16*)(lds + QKP);
    LAS bf16* st = (LAS bf16*)(lds + pgd::STASH);
    for (int e = tid; e < 8 * 384; e += 512) { const int r = e / 384, c = e % 384;
        const int gch = (c >> 7) * 1024 + h * 128 + (c & 127);
        cw[e] = r < 7 ? conv_w[r * CONV_CH + gch] : conv_b[gch]; }
    const float LOG2E = 1.4426950408889634f;
    const float expAf = expf(A_log[h]), dtbf = dt_bias[h], expAb = expf(A_log[8 + h]), dtbb = dt_bias[8 + h];
    const size_t rowb = (size_t)b * SEQ;
    u32x4 pre[7];
#define PG2_LOAD(u_) do { const int t0_ = (r8 * 16 + (u_)) * 64; \
        _Pragma("unroll") for (int x = 0; x < 7; ++x) { const int e = tid + 512 * x; const int r = e / 48, p = e % 48; \
            pre[x] = (u32x4){0u, 0u, 0u, 0u}; \
            if (e < 70 * 48 && r >= 3 && !(r >= 67 && (u_) == 15)) { const int col = p < 16 ? h * 128 + p * 8 : (p < 32 ? 1024 + h * 128 + (p - 16) * 8 : 2048 + h * 128 + (p - 32) * 8); \
                pre[x] = *(const GAS u32x4*)(raw + (rowb + t0_ - 3 + r) * CONV_CH + col); } } } while (0)
    PG2_LOAD(0);
    float psa = 0.f, psb = 0.f;
#define PG2_LOADS(u_) do { if (wave < 2) { const size_t so_ = (rowb + (size_t)(r8 * 16 + (u_)) * 64 + lane) * 64; psa = scal[so_ + 16 + 8 * wave + h]; psb = scal[so_ + 8 * wave + h]; } } while (0)
    PG2_LOADS(0);
    __syncthreads();
#define PG2_STAGEA(u_) do { const int t0_ = (r8 * 16 + (u_)) * 64; \
        _Pragma("unroll") for (int x = 0; x < 7; ++x) { const int e = tid + 512 * x; const int r = e / 48, p = e % 48; \
            if (e < 70 * 48) { u32x4 v = pre[x]; \
                if (r < 3) v = *(const LAS u32x4*)(st + r * 384 + p * 8); \
                else if (r >= 67 && (u_) == 15) v = *(const LAS u32x4*)(st + 1152 + (r - 67) * 384 + p * 8); \
                *(LAS u32x4*)((p < 16 ? rq + r * 136 + p * 8 : (p < 32 ? rk + r * 136 + (p - 16) * 8 : rv + r * 136 + (p - 32) * 8))) = v; } } \
        if (wave == 0) { const int i = lane; const size_t so = (rowb + t0_ + i) * 64; \
            const float gc = scan_fwd64(-expAf * softplus_fast(psa + dtbf), i); \
            const float be_ = sigmoid_fast(psb); sc[i] = be_; sc[64 + i] = gc * LOG2E; scal_w[so + h] = be_; scal_w[so + 16 + h] = gc; } \
        if (wave == 1) { const int i = lane; const size_t so = (rowb + t0_ + i) * 64; \
            const float gc = scan_bwd64(-expAb * softplus_fast(psa + dtbb), i); \
            const float be_ = sigmoid_fast(psb); sc[128 + i] = be_; sc[192 + i] = gc * LOG2E; scal_w[so + 8 + h] = be_; scal_w[so + 24 + h] = gc; } } while (0)
    PG2_STAGEA(0);
    PG2_LOAD(1); PG2_LOADS(1);
    __syncthreads();
    for (int u = 0; u < 16; ++u) {
        tid = tid_p; asm volatile("" : "+v"(tid));
        lane = tid & 63; wave = __builtin_amdgcn_readfirstlane(tid >> 6);
        const int fr = lane & 15, fq = lane >> 4, half = wave >> 2, w4 = wave & 3;
        const int c = r8 * 16 + u, t0 = c * 64;
        if (tid < 144) { const int r = tid / 48, p = tid % 48;
            const LAS bf16* s = p < 16 ? rq + (64 + r) * 136 + p * 8 : (p < 32 ? rk + (64 + r) * 136 + (p - 16) * 8 : rv + (64 + r) * 136 + (p - 32) * 8);
            *(LAS u32x4*)(st + r * 384 + p * 8) = *(const LAS u32x4*)s; }
        { const int tg = wave, cp = lane; float w[16], o[16];
#pragma unroll
          for (int tap = 0; tap < 8; ++tap) { w[2 * tap] = cw[tap * 384 + 2 * cp]; w[2 * tap + 1] = cw[tap * 384 + 2 * cp + 1]; }
          conv_pair8(o, rq + (8 * tg) * 136 + 2 * cp, 136, w);
#pragma unroll
          for (int t = 0; t < 8; ++t) { o[2 * t] = silu(o[2 * t]); o[2 * t + 1] = silu(o[2 * t + 1]);
              const float rs = __builtin_amdgcn_rsqf(wave_sum(o[2 * t] * o[2 * t] + o[2 * t + 1] * o[2 * t + 1]) + EPS) * 0.08838834764831845f;
              const unsigned pk = pkbf(o[2 * t] * rs, o[2 * t + 1] * rs);
              *(LAS unsigned*)(q_ + (8 * tg + t) * 136 + 2 * cp) = pk; *(GAS unsigned*)(raw + (rowb + t0 + 8 * tg + t) * CONV_CH + h * 128 + 2 * cp) = pk; }
#pragma unroll
          for (int tap = 0; tap < 8; ++tap) { w[2 * tap] = cw[tap * 384 + 128 + 2 * cp]; w[2 * tap + 1] = cw[tap * 384 + 128 + 2 * cp + 1]; }
          conv_pair8(o, rk + (8 * tg) * 136 + 2 * cp, 136, w);
#pragma unroll
          for (int t = 0; t < 8; ++t) { o[2 * t] = silu(o[2 * t]); o[2 * t + 1] = silu(o[2 * t + 1]);
              const float rs = __builtin_amdgcn_rsqf(wave_sum(o[2 * t] * o[2 * t] + o[2 * t + 1] * o[2 * t + 1]) + EPS);
              const unsigned pk = pkbf(o[2 * t] * rs, o[2 * t + 1] * rs);
              *(LAS unsigned*)(k_ + (8 * tg + t) * 136 + 2 * cp) = pk; *(GAS unsigned*)(raw + (rowb + t0 + 8 * tg + t) * CONV_CH + 1024 + h * 128 + 2 * cp) = pk; }
#pragma unroll
          for (int tap = 0; tap < 8; ++tap) { w[2 * tap] = cw[tap * 384 + 256 + 2 * cp]; w[2 * tap + 1] = cw[tap * 384 + 256 + 2 * cp + 1]; }
          conv_pair8(o, rv + (8 * tg) * 136 + 2 * cp, 136, w);
#pragma unroll
          for (int t = 0; t < 16; ++t) o[t] = silu(o[t]);
          u32x4 e0, e1; e0.x = pkbf(o[0], o[2]); e0.y = pkbf(o[4], o[6]); e0.z = pkbf(o[8], o[10]); e0.w = pkbf(o[12], o[14]);
          e1.x = pkbf(o[1], o[3]); e1.y = pkbf(o[5], o[7]); e1.z = pkbf(o[9], o[11]); e1.w = pkbf(o[13], o[15]);
          *(LAS u32x4*)(vT + (2 * cp) * 72 + 8 * tg) = e0; *(LAS u32x4*)(vT + (2 * cp + 1) * 72 + 8 * tg) = e1;
        }
        __syncthreads();
        for (int e = tid; e < 128 * 8; e += 512) { const int dv = e >> 3, p = e & 7;
            *(GAS u32x4*)(raw + (rowb + t0 + (dv >> 1)) * CONV_CH + 2048 + h * 128 + (dv & 1) * 64 + p * 8) = *(const LAS u32x4*)(vT + dv * 72 + p * 8); }
        for (int e = tid; e < 2 * 2 * 64 * 72 * 2 / 16; e += 512) ((LAS u32x4*)(lds + TRM))[e] = (u32x4){0u, 0u, 0u, 0u};
        for (int e = tid; e < 2 * 32 * 40 * 2 / 16; e += 512) ((LAS u32x4*)(lds + XS))[e] = (u32x4){0u, 0u, 0u, 0u};
        { const int mt = w4;
          f32x4 acc[1][4];
#pragma unroll
          for (int nt = 0; nt < 4; ++nt) acc[0][nt] = (f32x4){0.f, 0.f, 0.f, 0.f};
          mma_lds<1, 4>(acc, half ? q_ : k_, 136, mt * 16, k_, 136, 0, 128, fr, fq);
          const int i0 = mt * 16 + 4 * fq;
          const f32x4 gfi = *(const LAS f32x4*)(sc + 64 + i0), gbi = *(const LAS f32x4*)(sc + 192 + i0), bfi = *(const LAS f32x4*)(sc + i0), bbi = *(const LAS f32x4*)(sc + 128 + i0);
          float gfj[4], gbj[4];
#pragma unroll
          for (int nt = 0; nt < 4; ++nt) { gfj[nt] = sc[64 + nt * 16 + fr]; gbj[nt] = sc[192 + nt * 16 + fr]; }
          asm volatile("" ::: "memory");
#pragma unroll
          for (int nt = 0; nt < 4; ++nt)
#pragma unroll
              for (int r = 0; r < 4; ++r) { const int i = i0 + r, j = nt * 16 + fr; const bool lower = i > j, upper = i < j;
                  const float argl = gfi[r] - gfj[nt], argu = gbi[r] - gbj[nt];
                  const float x = acc[0][nt][r] * __builtin_amdgcn_exp2f(fminf(lower ? argl : argu, 0.f));
                  if (half == 0) { const float af = lower ? bfi[r] * x : 0.f, ab = upper ? bbi[r] * x : 0.f;
                      Abf[i * 72 + j] = f2bf1(af); Abf[64 * 72 + j * 72 + i] = f2bf1(ab);
                      if (mt == nt) { ADf[(mt * 16 + (i & 15)) * 16 + (j & 15)] = af; ADf[1024 + (mt * 16 + (j & 15)) * 16 + (i & 15)] = ab; } }
                  else QKp[i * 72 + j] = f2bf1(i == j ? acc[0][nt][r] : x); }
        }
        __syncthreads();
        { LAS bf16* Ab = Abf + half * 64 * 72; LAS bf16* Tr = Trm + half * 64 * 72; LAS bf16* Tt = Ttr + half * 64 * 72; LAS bf16* Xh = Xs + half * 32 * 40;
          if (w4 == 0) { const int blk = lane >> 4, cc = lane & 15; float t[16]; const LAS float* ad = ADf + half * 1024 + blk * 256;
#pragma unroll
              for (int i = 0; i < 16; ++i) t[i] = (i == cc) ? 1.f : 0.f;
#pragma unroll
              for (int i = 1; i < 16; ++i) { float s0 = 0.f, s1 = 0.f;
#pragma unroll
                  for (int j = 0; j < i; ++j) { if (j & 1) s1 += ad[i * 16 + j] * t[j]; else s0 += ad[i * 16 + j] * t[j]; }
                  t[i] = (i > cc) ? -(s0 + s1) : t[i];
                  if ((i & 3) == 3) asm volatile("" ::: "memory"); }
#pragma unroll
              for (int i = 0; i < 16; ++i) { const unsigned short tb = f2bf1(t[i]); Tr[(blk * 16 + i) * 72 + blk * 16 + cc] = tb; Tt[(blk * 16 + cc) * 72 + blk * 16 + i] = tb; } }
          __syncthreads();
          f32x4 a1[1][1];
          if (w4 < 2) { const int J = 2 * w4, I = J + 1; a1[0][0] = (f32x4){0.f, 0.f, 0.f, 0.f};
              mma_lds<1, 1>(a1, Ab + 16 * J, 72, 16 * I, Tt + 16 * J, 72, 16 * J, 32, fr, fq);
              u32x2 wv; wv.x = pkbf(a1[0][0][0], a1[0][0][1]); wv.y = pkbf(a1[0][0][2], a1[0][0][3]);
              *(LAS u32x2*)(Xh + (w4 * 16 + fr) * 40 + 4 * fq) = wv; }
          __syncthreads();
          if (w4 < 2) { const int J = 2 * w4, I = J + 1; a1[0][0] = (f32x4){0.f, 0.f, 0.f, 0.f};
              mma_lds<1, 1>(a1, Tr + 16 * I, 72, 16 * I, Xh, 40, w4 * 16, 32, fr, fq);
#pragma unroll
              for (int r = 0; r < 4; ++r) Tr[(16 * I + 4 * fq + r) * 72 + 16 * J + fr] = f2bf1(-a1[0][0][r]);
              u32x2 wv; wv.x = pkbf(-a1[0][0][0], -a1[0][0][1]); wv.y = pkbf(-a1[0][0][2], -a1[0][0][3]);
              *(LAS u32x2*)(Tt + (16 * J + fr) * 72 + 16 * I + 4 * fq) = wv; }
          __syncthreads();
          { const int mt2 = w4 >> 1, nt2 = w4 & 1; a1[0][0] = (f32x4){0.f, 0.f, 0.f, 0.f};
            mma_lds<1, 1>(a1, Ab, 72, 32 + 16 * mt2, Tt, 72, 16 * nt2, 32, fr, fq);
            u32x2 wv; wv.x = pkbf(a1[0][0][0], a1[0][0][1]); wv.y = pkbf(a1[0][0][2], a1[0][0][3]);
            __syncthreads();
            *(LAS u32x2*)(Xh + (16 * nt2 + fr) * 40 + 16 * mt2 + 4 * fq) = wv;
            __syncthreads();
            a1[0][0] = (f32x4){0.f, 0.f, 0.f, 0.f};
            mma_lds<1, 1>(a1, Tr + 32, 72, 32 + 16 * mt2, Xh, 40, 16 * nt2, 32, fr, fq);
#pragma unroll
            for (int r = 0; r < 4; ++r) Tr[(32 + 16 * mt2 + 4 * fq + r) * 72 + 16 * nt2 + fr] = f2bf1(-a1[0][0][r]);
            u32x2 w2; w2.x = pkbf(-a1[0][0][0], -a1[0][0][1]); w2.y = pkbf(-a1[0][0][2], -a1[0][0][3]);
            *(LAS u32x2*)(Tt + (16 * nt2 + fr) * 72 + 32 + 16 * mt2 + 4 * fq) = w2; }
        }
        __syncthreads();
        { bf16* tq = TQ + ((size_t)(bh * NCHUNK + c)) * 8192;
          const int i = (tid >> 3) & 63, p = tid & 7;
          const u32x4 qkv = *(const LAS u32x4*)(QKp + i * 72 + p * 8);
          const bf16x8 lo = *(const LAS bf16x8*)(Trm + i * 72 + p * 8), up = *(const LAS bf16x8*)(Ttr + 64 * 72 + i * 72 + p * 8); bf16x8 o8;
#pragma unroll
          for (int y = 0; y < 8; ++y) { const int j = p * 8 + y; o8[y] = (i > j) ? lo[y] : (i < j ? up[y] : (short)0x3F80); }
          __syncthreads();
          if (u + 1 < 16) { PG2_STAGEA(u + 1); }
          asm volatile("" ::: "memory");
          *(GAS bf16x8*)(tq + i * 64 + p * 8) = o8; *(GAS u32x4*)(tq + 4096 + i * 64 + p * 8) = qkv;
          if (u + 2 < 16) { PG2_LOAD(u + 2); PG2_LOADS(u + 2); } }
        __syncthreads();
    }
#undef PG2_STAGEA
#undef PG2_LOAD
#undef PG2_LOADS
}

__device__ __forceinline__ void gdn_state_v1(LAS unsigned char* lds, int cid, const bf16* raw, const float* scal, const bf16* TQ,
                                             const float* A_log, const float* dt_bias, bf16* og, int tid, int wave, int lane) {
    using namespace gdn;
    const int dvh = cid & 1, dir = (cid >> 1) & 1, h = (cid >> 2) & 7, b = cid >> 5;
    const int fr = lane & 15, fq = lane >> 4;
    LAS float* sc = (LAS float*)(lds + SC);
    LAS bf16* q_ = (LAS bf16*)(lds + Q); LAS bf16* k_ = (LAS bf16*)(lds + K); LAS bf16* kdT = (LAS bf16*)(lds + KDT); LAS bf16* vT = (LAS bf16*)(lds + VT);
    LAS bf16* T_ = (LAS bf16*)(lds + T); LAS bf16* QKd = (LAS bf16*)(lds + QKD); LAS bf16* ST_ = (LAS bf16*)(lds + ST);
    LAS bf16* rT = (LAS bf16*)(lds + RT); LAS bf16* uT = (LAS bf16*)(lds + UT); LAS float* os = (LAS float*)(lds + OS);
    for (int e = tid; e < 64 * 136 / 2; e += 512) ((LAS unsigned*)ST_)[e] = 0u;
    const float expA = expf(A_log[dir * 8 + h]), dtb = dt_bias[dir * 8 + h];
    f32x4 sacc[4];
#pragma unroll
    for (int nt = 0; nt < 4; ++nt) sacc[nt] = (f32x4){0.f, 0.f, 0.f, 0.f};
    const size_t rowb = (size_t)b * SEQ; const int bh = b * 8 + h;
    __syncthreads();
    for (int n = 0; n < NCHUNK; ++n) {
        const int c = dir ? NCHUNK - 1 - n : n, t0 = c * 64;
        for (int e = tid; e < 64 * 16; e += 512) { const int r = e >> 4, p = e & 15;
            *(LAS u32x4*)(q_ + r * 136 + p * 8) = *(const GAS u32x4*)(raw + (rowb + t0 + r) * CONV_CH + h * 128 + p * 8);
            *(LAS u32x4*)(k_ + r * 136 + p * 8) = *(const GAS u32x4*)(raw + (rowb + t0 + r) * CONV_CH + 1024 + h * 128 + p * 8); }
        { const int dvl = tid >> 3, p = tid & 7; const int dv = dvh * 64 + dvl;
          *(LAS u32x4*)(vT + dvl * 72 + p * 8) = *(const GAS u32x4*)(raw + (rowb + t0 + (dv >> 1)) * CONV_CH + 2048 + h * 128 + (dv & 1) * 64 + p * 8); }
        { const bf16* tq = TQ + ((size_t)(bh * NCHUNK + c)) * 8192;
          for (int e = tid; e < 1024; e += 512) { const int which = e >> 9, i = (e >> 3) & 63, p = e & 7;
              bf16x8 v = *(const GAS bf16x8*)(tq + which * 4096 + i * 64 + p * 8);
#pragma unroll
              for (int x = 0; x < 8; ++x) { const int j = p * 8 + x; const bool keep = dir ? (i < j) : (i > j);
                  if (i == j) { if (which == 0) v[x] = (short)0x3F80; } else if (!keep) v[x] = 0; }
              *(LAS bf16x8*)((which ? QKd : T_) + i * 72 + p * 8) = v; } }
        if (wave == 0) { const int i = lane; const size_t so = (rowb + t0 + i) * 64;
            const float g = -expA * softplus_f(scal[so + 16 + dir * 8 + h] + dtb); float gc = g;
            if (dir == 0) {
#pragma unroll
                for (int o = 1; o < 64; o <<= 1) { const float y = __shfl_up(gc, o); if (i >= o) gc += y; }
            } else {
#pragma unroll
                for (int o = 1; o < 64; o <<= 1) { const float y = __shfl_down(gc, o); if (i + o < 64) gc += y; }
            }
            const float gl = __shfl(gc, dir ? 0 : 63);
            sc[i] = sigmoid_f(scal[so + dir * 8 + h]); sc[64 + i] = gc; sc[128 + i] = expf(gc); sc[192 + i] = expf(gl - gc); if (i == 0) sc[256] = expf(gl); }
        __syncthreads();
        { const int i = tid >> 3, cg = tid & 7; const float ek = sc[192 + i];
          const bf16x8 k0 = *(const LAS bf16x8*)(k_ + i * 136 + cg * 16), k1 = *(const LAS bf16x8*)(k_ + i * 136 + cg * 16 + 8);
#pragma unroll
          for (int x = 0; x < 8; ++x) { kdT[(cg * 16 + x) * 72 + i] = f2bf1(bf2f_s(k0[x]) * ek); kdT[(cg * 16 + 8 + x) * 72 + i] = f2bf1(bf2f_s(k1[x]) * ek); } }
        __syncthreads();
        const int mt = wave & 3, nh = wave >> 2;
        f32x4 aq[2];
        { f32x4 ak[2]; ak[0] = ak[1] = aq[0] = aq[1] = (f32x4){0.f, 0.f, 0.f, 0.f};
          for (int k0 = 0; k0 < 128; k0 += 32) {
              const bf16x8 fk = *(const LAS bf16x8*)(k_ + (mt * 16 + fr) * 136 + k0 + fq * 8), fqv = *(const LAS bf16x8*)(q_ + (mt * 16 + fr) * 136 + k0 + fq * 8);
#pragma unroll
              for (int nl = 0; nl < 2; ++nl) { const bf16x8 fb = *(const LAS bf16x8*)(ST_ + (nh * 32 + nl * 16 + fr) * 136 + k0 + fq * 8);
                  ak[nl] = __builtin_amdgcn_mfma_f32_16x16x32_bf16(fk, fb, ak[nl], 0, 0, 0); aq[nl] = __builtin_amdgcn_mfma_f32_16x16x32_bf16(fqv, fb, aq[nl], 0, 0, 0); } }
          const int i0 = mt * 16 + 4 * fq;
          const f32x4 be4 = *(const LAS f32x4*)(sc + i0), eg4 = *(const LAS f32x4*)(sc + 128 + i0);
#pragma unroll
          for (int nl = 0; nl < 2; ++nl) { const int dv = nh * 32 + nl * 16 + fr;
              const bf16x4 vv = *(const LAS bf16x4*)(vT + dv * 72 + i0);
              float r0 = be4[0] * (bf2f_s(vv[0]) - eg4[0] * ak[nl][0]), r1 = be4[1] * (bf2f_s(vv[1]) - eg4[1] * ak[nl][1]);
              float r2 = be4[2] * (bf2f_s(vv[2]) - eg4[2] * ak[nl][2]), r3 = be4[3] * (bf2f_s(vv[3]) - eg4[3] * ak[nl][3]);
              u32x2 w; w.x = pkbf(r0, r1); w.y = pkbf(r2, r3); *(LAS u32x2*)(rT + dv * 72 + i0) = w;
              aq[nl][0] *= eg4[0]; aq[nl][1] *= eg4[1]; aq[nl][2] *= eg4[2]; aq[nl][3] *= eg4[3]; }
        }
        __syncthreads();
        { f32x4 au[1][2]; au[0][0] = au[0][1] = (f32x4){0.f, 0.f, 0.f, 0.f};
          mma_lds<1, 2>(au, T_, 72, mt * 16, rT, 72, nh * 32, 64, fr, fq);
          const int i0 = mt * 16 + 4 * fq;
#pragma unroll
          for (int nl = 0; nl < 2; ++nl) { const int dv = nh * 32 + nl * 16 + fr; u32x2 w; w.x = pkbf(au[0][nl][0], au[0][nl][1]); w.y = pkbf(au[0][nl][2], au[0][nl][3]); *(LAS u32x2*)(uT + dv * 72 + i0) = w; }
        }
        __syncthreads();
        { f32x4 ao[1][2]; ao[0][0] = aq[0]; ao[0][1] = aq[1];
          mma_lds<1, 2>(ao, QKd, 72, mt * 16, uT, 72, nh * 32, 64, fr, fq);
          const int i0 = mt * 16 + 4 * fq;
#pragma unroll
          for (int nl = 0; nl < 2; ++nl)
#pragma unroll
              for (int r = 0; r < 4; ++r) os[(i0 + r) * 65 + nh * 32 + nl * 16 + fr] = ao[0][nl][r];
          const float egl = sc[256];
          f32x4 as_[1][4];
#pragma unroll
          for (int nt = 0; nt < 4; ++nt) as_[0][nt] = sacc[nt] * egl;
          mma_lds<1, 4>(as_, kdT, 72, wave * 16, uT, 72, 0, 64, fr, fq);
#pragma unroll
          for (int nt = 0; nt < 4; ++nt) { sacc[nt] = as_[0][nt];
              u32x2 w; w.x = pkbf(sacc[nt][0], sacc[nt][1]); w.y = pkbf(sacc[nt][2], sacc[nt][3]); *(LAS u32x2*)(ST_ + (nt * 16 + fr) * 136 + wave * 16 + 4 * fq) = w; }
        }
        __syncthreads();
#pragma unroll
        for (int ii = 0; ii < 4; ++ii) { const int i = wave * 8 + 2 * ii + (lane >> 5), cp = lane & 31;
            atomic_add_bf16x2(og + (rowb + t0 + i) * 1024 + h * 128 + dvh * 64 + 2 * cp, os[i * 65 + 2 * cp], os[i * 65 + 2 * cp + 1]); }
        __syncthreads();
    }
}
typedef float f32x16 __attribute__((ext_vector_type(16)));
typedef short v4i16_t __attribute__((ext_vector_type(4)));
namespace gs2 {
constexpr int KO = 0;
constexpr int QO = KO + 64 * 132 * 2;
constexpr int VTO = QO + 64 * 132 * 2;
constexpr int TO = VTO + 64 * 68 * 2;
constexpr int QKO = TO + 64 * 68 * 2;
constexpr int SCO = QKO + 64 * 68 * 2;
constexpr int BUF = SCO + 1024;
constexpr int OST = 2 * BUF;
constexpr int END = OST + 2 * 64 * 72 * 2;
static_assert(END <= MISC_OFF && BUF % 16 == 0, "gdn state LDS map");
}
__device__ __forceinline__ bf16x8 cvt8(const f32x16& x, int base) {
    u32x4 w; w.x = pkbf(x[base], x[base + 1]); w.y = pkbf(x[base + 2], x[base + 3]); w.z = pkbf(x[base + 4], x[base + 5]); w.w = pkbf(x[base + 6], x[base + 7]);
    return __builtin_bit_cast(bf16x8, w);
}
__device__ __forceinline__ bf16x8 afrag(const LAS bf16* p) {
    const bf16x4 lo = *(const LAS bf16x4*)p, hi = *(const LAS bf16x4*)(p + 8);
    return (bf16x8){lo[0], lo[1], lo[2], lo[3], hi[0], hi[1], hi[2], hi[3]};
}
__device__ __forceinline__ bf16x8 afrag_tr(const LAS bf16* p, int ld) {
    const v4i16_t lo = __builtin_amdgcn_ds_read_tr16_b64_v4i16((LAS v4i16_t*)p), hi = __builtin_amdgcn_ds_read_tr16_b64_v4i16((LAS v4i16_t*)(p + 8 * ld));
    return (bf16x8){lo[0], lo[1], lo[2], lo[3], hi[0], hi[1], hi[2], hi[3]};
}
#define MFMA32(a, b, c) __builtin_amdgcn_mfma_f32_32x32x16_bf16((a), (b), (c), 0, 0, 0)

#ifndef WG_BAR
#define WG_BAR() asm volatile("s_waitcnt lgkmcnt(0)\n\ts_barrier" ::: "memory")
#endif
template <int DIR>
__device__ __forceinline__ void gdn_state2(LAS unsigned char* lds, int b, int h, int half, const bf16* raw, const float* scal, const bf16* TQ,
                                           const float* A_log, const float* dt_bias, bf16* og, int tid, int wave, int lane, float* probe = nullptr) {
    using namespace gs2;
    const size_t rowb = (size_t)b * SEQ; const int bh = b * 8 + h;
    const float expA = expf(A_log[DIR * 8 + h]), dtb = dt_bias[DIR * 8 + h];
    LAS bf16* ost = (LAS bf16*)(lds + OST);
    const int r31 = lane & 31, hh = lane >> 5;
    if (wave == 4 || wave == 5) {
        for (int n = 0; n < NCHUNK + 1; ++n) WG_BAR();
    } else if (wave >= 2) {
        const int hw = (wave & 1) | ((wave >> 2) << 1);
        const int ht = hw * 64 + lane;
        unsigned go[14], lo_[14]; u32x4 ld[14]; float sr0 = 0.f, sr1 = 0.f;
#pragma unroll
        for (int x = 0; x < 4; ++x) { const int e = ht + 256 * x, r = e >> 4, p = e & 15;
            go[x] = (unsigned)((r * CONV_CH + 1024 + h * 128 + p * 8) * 2); go[4 + x] = (unsigned)((r * CONV_CH + h * 128 + p * 8) * 2);
            lo_[x] = (unsigned)(KO + (r * 132 + p * 8) * 2); lo_[4 + x] = (unsigned)(QO + (r * 132 + p * 8) * 2); }
#pragma unroll
        for (int x = 0; x < 2; ++x) { const int e = ht + 256 * x, dvl = e >> 3, p = e & 7; const int dv = 64 * half + dvl;
            go[8 + x] = (unsigned)(((dv >> 1) * CONV_CH + 2048 + h * 128 + (dv & 1) * 64 + p * 8) * 2); lo_[8 + x] = (unsigned)(VTO + (dvl * 68 + p * 8) * 2); }
        u32x4 km[2], dg[2], qm[2];
#pragma unroll
        for (int x = 0; x < 2; ++x) { const int e = ht + 256 * x, i = e >> 3, p = e & 7;
            go[10 + x] = (unsigned)(e * 16); go[12 + x] = (unsigned)(8192 + e * 16);
            lo_[10 + x] = (unsigned)(TO + (i * 68 + p * 8) * 2); lo_[12 + x] = (unsigned)(QKO + (i * 68 + p * 8) * 2);
            unsigned kw[4], dw[4], qw[4];
#pragma unroll
            for (int w = 0; w < 4; ++w) { const int j0 = p * 8 + 2 * w, j1 = j0 + 1;
                const bool k0 = DIR ? (i < j0) : (i > j0), k1 = DIR ? (i < j1) : (i > j1);
                kw[w] = (k0 ? 0xFFFFu : 0u) | (k1 ? 0xFFFF0000u : 0u); dw[w] = (i == j0 ? 0x3F80u : 0u) | (i == j1 ? 0x3F800000u : 0u);
                qw[w] = kw[w] | (i == j0 ? 0xFFFFu : 0u) | (i == j1 ? 0xFFFF0000u : 0u); }
            km[x] = (u32x4){kw[0], kw[1], kw[2], kw[3]}; dg[x] = (u32x4){dw[0], dw[1], dw[2], dw[3]}; qm[x] = (u32x4){qw[0], qw[1], qw[2], qw[3]}; }
        const unsigned so_l = (unsigned)(lane * 256 + (DIR * 8 + h) * 4);
#define GS2_ISSUE(c_) do { const GAS char* rb_ = (const GAS char*)(raw + (rowb + (size_t)(c_) * 64) * CONV_CH); const GAS char* tb_ = (const GAS char*)(TQ + ((size_t)(bh * NCHUNK + (c_))) * 8192); \
            _Pragma("unroll") for (int x = 0; x < 10; ++x) ld[x] = *(const GAS u32x4*)(rb_ + go[x]); \
            _Pragma("unroll") for (int x = 10; x < 14; ++x) ld[x] = *(const GAS u32x4*)(tb_ + go[x]); \
            if (hw == 0) { const GAS char* sb_ = (const GAS char*)(scal + (rowb + (size_t)(c_) * 64) * 64); sr0 = *(const GAS float*)(sb_ + so_l); sr1 = *(const GAS float*)(sb_ + so_l + 64); } } while (0)
#define GS2_ST16(off_, v_) do { LAS unsigned char* d_ = B_ + (off_); *(LAS u32x2*)(d_) = (u32x2){(v_).x, (v_).y}; *(LAS u32x2*)(d_ + 8) = (u32x2){(v_).z, (v_).w}; } while (0)
#define GS2_COMMIT(bi_, c_) do { LAS unsigned char* B_ = lds + (bi_) * BUF; \
            _Pragma("unroll") for (int x = 0; x < 10; ++x) GS2_ST16(lo_[x], ld[x]); \
            _Pragma("unroll") for (int x = 0; x < 2; ++x) { const u32x4 tv = (ld[10 + x] & km[x]) | dg[x], qv = ld[12 + x] & qm[x]; \
                GS2_ST16(lo_[10 + x], tv); GS2_ST16(lo_[12 + x], qv); } \
            if (hw == 0) { LAS float* sc_ = (LAS float*)(B_ + SCO); const int i = lane; const float gc = sr1; const float gl = __shfl(gc, DIR ? 0 : 63); \
                sc_[i] = sr0; sc_[64 + i] = __expf(gc); sc_[128 + i] = __expf(gl - gc); if (i == 0) sc_[192] = __expf(gl); } } while (0)
        { const int c0 = DIR ? NCHUNK - 1 : 0; GS2_ISSUE(c0); GS2_COMMIT(0, c0); GS2_ISSUE((DIR ? c0 - 1 : c0 + 1)); }
        for (int n = 0; n < NCHUNK; ++n) {
            const int c = DIR ? NCHUNK - 1 - n : n;
            WG_BAR();
            const bool more = n + 1 < NCHUNK; const int cn = DIR ? c - 1 : c + 1;
            if (more) { GS2_COMMIT((n + 1) & 1, cn); if (n + 2 < NCHUNK) GS2_ISSUE((DIR ? cn - 1 : cn + 1)); }
            unsigned ov[8];
            if (n > 0) {
#pragma unroll
                for (int x = 0; x < 8; ++x) ov[x] = *(const LAS unsigned*)(ost + ((n - 1) & 1) * (64 * 72) + (hw * 16 + 2 * x + (lane >> 5)) * 72 + 2 * (lane & 31));
            }
            if (n > 0) { const int tp = (DIR ? c + 1 : c - 1) * 64;
#pragma unroll
                for (int x = 0; x < 8; ++x) { GAS char* ob_ = (GAS char*)(og + (rowb + tp + hw * 16 + 2 * x) * 1024 + h * 128 + half * 64);
                    (void)__builtin_amdgcn_global_atomic_fadd_v2bf16((GAS s16x2*)(ob_ + (lane >> 5) * 2048 + (lane & 31) * 4), __builtin_bit_cast(s16x2, ov[x])); } }
        }
        WG_BAR();
        { const int tp = (DIR ? 0 : NCHUNK - 1) * 64;
#pragma unroll
          for (int x = 0; x < 8; ++x) { const unsigned v = *(const LAS unsigned*)(ost + ((NCHUNK - 1) & 1) * (64 * 72) + (hw * 16 + 2 * x + (lane >> 5)) * 72 + 2 * (lane & 31));
              GAS char* ob_ = (GAS char*)(og + (rowb + tp + hw * 16 + 2 * x) * 1024 + h * 128 + half * 64);
              (void)__builtin_amdgcn_global_atomic_fadd_v2bf16((GAS s16x2*)(ob_ + (lane >> 5) * 2048 + (lane & 31) * 4), __builtin_bit_cast(s16x2, v)); } }
#undef GS2_ISSUE
#undef GS2_COMMIT
#undef GS2_ST16
    } else {
        const int dv0 = 32 * wave;
#if defined(PROBE_STATE)
        unsigned long long tw_ = 0ull; const unsigned long long ts0_ = __builtin_amdgcn_s_memtime();
#define PB_BAR() do { const unsigned long long t0_ = __builtin_amdgcn_s_memtime(); WG_BAR(); tw_ += __builtin_amdgcn_s_memtime() - t0_; } while (0)
#else
#define PB_BAR() WG_BAR()
#endif
        f32x16 St[4];
#pragma unroll
        for (int t = 0; t < 4; ++t)
#pragma unroll
            for (int r = 0; r < 16; ++r) St[t][r] = 0.f;
        for (int n = 0; n < NCHUNK; ++n) {
            PB_BAR();
            const LAS unsigned char* Bb = lds + (n & 1) * BUF;
            const LAS bf16* Kb = (const LAS bf16*)(Bb + KO); const LAS bf16* Qb = (const LAS bf16*)(Bb + QO); const LAS bf16* Vb = (const LAS bf16*)(Bb + VTO);
            const LAS bf16* Tb = (const LAS bf16*)(Bb + TO); const LAS bf16* QKb = (const LAS bf16*)(Bb + QKO); const LAS float* sc = (const LAS float*)(Bb + SCO);
            f32x16 aK[2];
#pragma unroll
            for (int m = 0; m < 2; ++m)
#pragma unroll
                for (int r = 0; r < 16; ++r) aK[m][r] = 0.f;
            bf16x8 fa[2][2];
            const int offk = r31 * 132 + 4 * hh;
#define GS2_LD2(P_, bi_, ks_) do { fa[bi_][0] = afrag((P_) + offk + 16 * (ks_)); fa[bi_][1] = afrag((P_) + offk + 32 * 132 + 16 * (ks_)); } while (0)
            GS2_LD2(Kb, 0, 0);
#pragma unroll
            for (int ks = 0; ks < 8; ++ks) {
                if (ks < 7) GS2_LD2(Kb, (ks + 1) & 1, ks + 1);
                __builtin_amdgcn_sched_barrier(0);
                const bf16x8 bs = cvt8(St[ks >> 1], 8 * (ks & 1));
                aK[0] = MFMA32(fa[ks & 1][0], bs, aK[0]); aK[1] = MFMA32(fa[ks & 1][1], bs, aK[1]);
                __builtin_amdgcn_sched_barrier(0); }
            bf16x8 ft[8];
#pragma unroll
            for (int mi = 0; mi < 2; ++mi)
#pragma unroll
                for (int kt = 0; kt < 4; ++kt) { const bool need = DIR ? (kt >= 2 * mi) : (kt <= 2 * mi + 1);
                    if (need) ft[mi * 4 + kt] = afrag(Tb + (32 * mi + r31) * 68 + 16 * kt + 4 * hh); }
#pragma unroll
            for (int m = 0; m < 2; ++m)
#pragma unroll
                for (int q4 = 0; q4 < 4; ++q4) { const int tb = 32 * m + 8 * q4 + 4 * hh;
                    const bf16x4 vv = *(const LAS bf16x4*)(Vb + (dv0 + r31) * 68 + tb); const f32x4 be = *(const LAS f32x4*)(sc + tb), eg = *(const LAS f32x4*)(sc + 64 + tb);
#pragma unroll
                    for (int e = 0; e < 4; ++e) aK[m][4 * q4 + e] = be[e] * (bf2f_s(vv[e]) - eg[e] * aK[m][4 * q4 + e]); }
            const bf16x8 br0 = cvt8(aK[0], 0), br1 = cvt8(aK[0], 8), br2 = cvt8(aK[1], 0), br3 = cvt8(aK[1], 8);
            __builtin_amdgcn_sched_barrier(0);
            f32x16 au[2];
#pragma unroll
            for (int m = 0; m < 2; ++m)
#pragma unroll
                for (int r = 0; r < 16; ++r) au[m][r] = 0.f;
            GS2_LD2(Qb, 0, 0);
#pragma unroll
            for (int mi = 0; mi < 2; ++mi)
#pragma unroll
                for (int kt = 0; kt < 4; ++kt) { const bool need = DIR ? (kt >= 2 * mi) : (kt <= 2 * mi + 1);
                    if (need) au[mi] = MFMA32(ft[mi * 4 + kt], (kt == 0 ? br0 : kt == 1 ? br1 : kt == 2 ? br2 : br3), au[mi]); }
            __builtin_amdgcn_sched_barrier(0);
            f32x16 aQ[2];
#pragma unroll
            for (int m = 0; m < 2; ++m)
#pragma unroll
                for (int r = 0; r < 16; ++r) aQ[m][r] = 0.f;
#pragma unroll
            for (int ks = 0; ks < 8; ++ks) {
                if (ks < 7) GS2_LD2(Qb, (ks + 1) & 1, ks + 1);
                __builtin_amdgcn_sched_barrier(0);
                const bf16x8 bs = cvt8(St[ks >> 1], 8 * (ks & 1));
                aQ[0] = MFMA32(fa[ks & 1][0], bs, aQ[0]); aQ[1] = MFMA32(fa[ks & 1][1], bs, aQ[1]);
                __builtin_amdgcn_sched_barrier(0); }
#undef GS2_LD2
            const bf16x8 bu0 = cvt8(au[0], 0), bu1 = cvt8(au[0], 8), bu2 = cvt8(au[1], 0), bu3 = cvt8(au[1], 8);
#pragma unroll
            for (int m = 0; m < 2; ++m)
#pragma unroll
                for (int q4 = 0; q4 < 4; ++q4) { const int tb = 32 * m + 8 * q4 + 4 * hh; const f32x4 ek = *(const LAS f32x4*)(sc + 128 + tb), eg = *(const LAS f32x4*)(sc + 64 + tb);
#pragma unroll
                    for (int e = 0; e < 4; ++e) { au[m][4 * q4 + e] *= ek[e]; aQ[m][4 * q4 + e] *= eg[e]; } }
            const bf16x8 bd0 = cvt8(au[0], 0), bd1 = cvt8(au[0], 8), bd2 = cvt8(au[1], 0), bd3 = cvt8(au[1], 8);
            __builtin_amdgcn_sched_barrier(0);
            bf16x8 fqk[8];
#pragma unroll
            for (int mi = 0; mi < 2; ++mi)
#pragma unroll
                for (int kt = 0; kt < 4; ++kt) { const bool need = DIR ? (kt >= 2 * mi) : (kt <= 2 * mi + 1);
                    if (need) fqk[mi * 4 + kt] = afrag(QKb + (32 * mi + r31) * 68 + 16 * kt + 4 * hh); }
            const int i16 = r31 & 15; const LAS bf16* kp = Kb + (4 * hh + (i16 >> 2)) * 132 + 16 * (r31 >> 4) + 4 * (i16 & 3);
            bf16x8 fk[2][4];
#define GS2_LDKT(bi_, t_) do { _Pragma("unroll") for (int kt = 0; kt < 4; ++kt) fk[bi_][kt] = afrag_tr(kp + (16 * kt) * 132 + 32 * (t_), 132); } while (0)
            __builtin_amdgcn_sched_barrier(0);
#pragma unroll
            for (int mi = 0; mi < 2; ++mi)
#pragma unroll
                for (int kt = 0; kt < 4; ++kt) { const bool need = DIR ? (kt >= 2 * mi) : (kt <= 2 * mi + 1);
                    if (need) aQ[mi] = MFMA32(fqk[mi * 4 + kt], (kt == 0 ? bu0 : kt == 1 ? bu1 : kt == 2 ? bu2 : bu3), aQ[mi]); }
            GS2_LDKT(0, 0);
            const float egl = sc[192];
#pragma unroll
            for (int mi = 0; mi < 2; ++mi)
#pragma unroll
                for (int r = 0; r < 16; ++r) ost[(n & 1) * (64 * 72) + (32 * mi + (r & 3) + 8 * (r >> 2) + 4 * hh) * 72 + dv0 + r31] = f2bf1(aQ[mi][r]);
#pragma unroll
            for (int t = 0; t < 4; ++t) {
                if (t < 3) GS2_LDKT((t + 1) & 1, t + 1);
                __builtin_amdgcn_sched_barrier(0);
#pragma unroll
                for (int r = 0; r < 16; ++r) St[t][r] *= egl;
                St[t] = MFMA32(fk[t & 1][0], bd0, St[t]); St[t] = MFMA32(fk[t & 1][1], bd1, St[t]);
                St[t] = MFMA32(fk[t & 1][2], bd2, St[t]); St[t] = MFMA32(fk[t & 1][3], bd3, St[t]);
                __builtin_amdgcn_sched_barrier(0); }
#undef GS2_LDKT
        }
        WG_BAR();
#if defined(PROBE_STATE)
        if (blockIdx.x == 0 && tid == 0 && probe) { const unsigned long long tt_ = __builtin_amdgcn_s_memtime() - ts0_; *probe = (float)((double)tw_ / (double)tt_); }
#endif
    }
}
constexpr size_t WS_SSC = 1 * MiB;
namespace psd {
constexpr int CW = 0;
constexpr int SC = CW + 8 * 768 * 4;
constexpr int BM_ = SC + 8 * 4 * 64 * 4;
constexpr int CM_ = BM_ + 64 * 136 * 2;
constexpr int CB = CM_ + 64 * 136 * 2;
constexpr int R = CB + 64 * 68 * 4;
constexpr int RBC = R, RBC_END = R + 70 * 272 * 2;
constexpr int RX = R, XT = RX + 70 * 136 * 2, MM = XT + 128 * 72 * 2, R_END = MM + 2 * 64 * 72 * 2;
constexpr int YST = RX;
constexpr int PRBC = CW + 8 * 768 * 4, PXT = PRBC + 70 * 272 * 2, P_END = PXT + 256 * 72 * 2;
constexpr int STASH = pgd::STASH + 4608;
static_assert(P_END <= pgd::STASH, "prep ssd conv LDS map");
static_assert(RBC_END <= pgd::STASH && R_END <= pgd::STASH && STASH + 9216 <= MISC_OFF, "prep ssd LDS map");
}
__device__ __forceinline__ void prep_ssd_stash(LAS unsigned char* lds, int bid, const bf16* raw, int tid) {
    const int bg = bid >> 5, b = bg >> 1, g = bg & 1, r32 = bid & 31;
    LAS bf16* st = (LAS bf16*)(lds + psd::STASH);
    for (int e = tid; e < 2 * 3 * 96; e += 512) { const int which = e / 288, r = (e % 288) / 96, p = e % 96;
        const int t = which ? (r32 * 4 + 4) * 64 + r : r32 * 4 * 64 - 3 + r;
        const int col = p < 64 ? 3072 + g * 512 + p * 8 : (p < 80 ? 4096 + g * 128 + (p - 64) * 8 : 4352 + g * 128 + (p - 80) * 8);
        u32x4 v = (u32x4){0u, 0u, 0u, 0u};
        if (t >= 0 && t < SEQ) v = *(const GAS u32x4*)(raw + ((size_t)b * SEQ + t) * CONV_CH + col);
        *(LAS u32x4*)(st + which * 2304 + r * 768 + p * 8) = v; }
}
__device__ __forceinline__ void prep_ssd_range(LAS unsigned char* lds, int bid, bf16* raw, const float* conv_w, const float* conv_b, int tid_p,
                                               const float* scal, const float* A_log, const float* dt_bias, float* ssc) {
    using namespace psd;
    const int bg = bid >> 5, b = bg >> 1, g = bg & 1, r32 = bid & 31;
    LAS float* cw = (LAS float*)(lds + CW);
    LAS bf16* rbc = (LAS bf16*)(lds + PRBC); LAS bf16* xT = (LAS bf16*)(lds + PXT);
    LAS bf16* st = (LAS bf16*)(lds + STASH);
    for (int e = tid_p; e < 8 * 768; e += 512) { const int r = e / 768, c = e % 768;
        const int gch = c < 512 ? 3072 + g * 512 + c : (c < 640 ? 4096 + g * 128 + (c - 512) : 4352 + g * 128 + (c - 640));
        cw[e] = r < 7 ? conv_w[r * CONV_CH + gch] : conv_b[gch]; }
    const size_t rowb = (size_t)b * SEQ;
    u32x4 pre[5];
#define PSD_LOAD(u_, ps_) do { const int t0_ = (r32 * 4 + (u_)) * 64; \
        _Pragma("unroll") for (int x = 0; x < 5; ++x) { const int e = tid_p + 512 * x; const int r = e >> 5, p = e & 31; \
            pre[x] = (u32x4){0u, 0u, 0u, 0u}; \
            if (e < 70 * 32 && r >= 3 && !(r >= 67 && (u_) == 3)) { const int col = (ps_) == 0 ? (p < 16 ? 4096 + g * 128 + p * 8 : 4352 + g * 128 + (p - 16) * 8) : 3072 + g * 512 + ((ps_) - 1) * 256 + p * 8; \
                pre[x] = *(const GAS u32x4*)(raw + (rowb + t0_ - 3 + r) * CONV_CH + col); } } } while (0)
    PSD_LOAD(0, 0);
    float sdf[4], sdb[4];
    { const int lane0 = tid_p & 63, wave0 = tid_p >> 6, hd0 = g * 8 + wave0;
#pragma unroll
      for (int u = 0; u < 4; ++u) { const size_t so = (rowb + (size_t)(r32 * 4 + u) * 64 + lane0) * 64; sdf[u] = scal[so + 32 + hd0]; sdb[u] = scal[so + 48 + hd0]; } }
#define PSD_STAGE(u_, scol_) do { _Pragma("unroll") for (int x = 0; x < 5; ++x) { const int e = tid_p + 512 * x; const int r = e >> 5, p = e & 31; \
            if (e < 70 * 32) { u32x4 v = pre[x]; \
                if (r < 3) v = *(const LAS u32x4*)(st + r * 768 + (scol_) + p * 8); \
                else if (r >= 67 && (u_) == 3) v = *(const LAS u32x4*)(st + 2304 + (r - 67) * 768 + (scol_) + p * 8); \
                *(LAS u32x4*)(rbc + r * 272 + (p < 16 ? p * 8 : 136 + (p - 16) * 8)) = v; } } } while (0)
    __syncthreads();
    PSD_STAGE(0, 512);
    PSD_LOAD(0, 1);
    __syncthreads();
#pragma unroll
    for (int u = 0; u < 4; ++u) {
        int tid = tid_p; asm volatile("" : "+v"(tid));
        const int lane = tid & 63, wave = __builtin_amdgcn_readfirstlane(tid >> 6);
        const int c = r32 * 4 + u, t0 = c * 64;
        { const int hd = g * 8 + wave, i = lane;
          const float dtf = softplus_fast(sdf[u] + dt_bias[hd]), dtb = softplus_fast(sdb[u] + dt_bias[16 + hd]);
          const float cf = scan_fwd64(dtf * -expf(A_log[hd]), i), cbk = scan_bwd64(dtb * -expf(A_log[16 + hd]), i);
          float* sp = ssc + ((size_t)((b * 16 + hd) * NCHUNK + c)) * 256 + i; sp[0] = dtf; sp[64] = cf; sp[128] = dtb; sp[192] = cbk; }
        for (int ps = 0; ps < 3; ++ps) {
            const int scol = ps == 0 ? 512 : (ps == 1 ? 0 : 256);
            if (tid < 96) { const int r = tid >> 5, p = tid & 31;
                *(LAS u32x4*)(st + r * 768 + scol + p * 8) = *(const LAS u32x4*)(rbc + (64 + r) * 272 + (p < 16 ? p * 8 : 136 + (p - 16) * 8)); }
            unsigned bcv[16];
            { const int tg = wave, cp = lane; float w[16], o[16];
#pragma unroll
              for (int hf = 0; hf < 2; ++hf) {
#pragma unroll
                  for (int tap = 0; tap < 8; ++tap) { w[2 * tap] = cw[tap * 768 + scol + hf * 128 + 2 * cp]; w[2 * tap + 1] = cw[tap * 768 + scol + hf * 128 + 2 * cp + 1]; }
                  conv_pair8(o, rbc + (8 * tg) * 272 + hf * 136 + 2 * cp, 272, w);
#pragma unroll
                  for (int t = 0; t < 16; ++t) o[t] = silu(o[t]);
#pragma unroll
                  for (int t = 0; t < 8; ++t) bcv[hf * 8 + t] = pkbf(o[2 * t], o[2 * t + 1]);
                  if (ps != 0) {
                      u32x4 e0, e1; e0.x = pkbf(o[0], o[2]); e0.y = pkbf(o[4], o[6]); e0.z = pkbf(o[8], o[10]); e0.w = pkbf(o[12], o[14]);
                      e1.x = pkbf(o[1], o[3]); e1.y = pkbf(o[5], o[7]); e1.z = pkbf(o[9], o[11]); e1.w = pkbf(o[13], o[15]);
                      *(LAS u32x4*)(xT + (hf * 128 + 2 * cp) * 72 + 8 * tg) = e0; *(LAS u32x4*)(xT + (hf * 128 + 2 * cp + 1) * 72 + 8 * tg) = e1; } } }
            __syncthreads();
            const bool lastp = (u == 3 && ps == 2);
            if (!lastp) { if (ps < 2) PSD_STAGE(u, (ps == 0 ? 0 : 256)); else PSD_STAGE(u + 1, 512); }
            asm volatile("" ::: "memory");
            if (ps == 0) {
                const int tg = wave, cp = lane;
#pragma unroll
                for (int hf = 0; hf < 2; ++hf)
#pragma unroll
                    for (int t = 0; t < 8; ++t) *(GAS unsigned*)(raw + (rowb + t0 + 8 * tg + t) * CONV_CH + (hf ? 4352 : 4096) + g * 128 + 2 * cp) = bcv[hf * 8 + t];
            } else {
                for (int e = tid; e < 256 * 8; e += 512) { const int xr = e >> 3, p = e & 7; const int hl = (ps - 1) * 4 + (xr >> 6), pp = xr & 63;
                    *(GAS u32x4*)(raw + (rowb + t0 + pp) * CONV_CH + 3072 + (g * 8 + hl) * 64 + p * 8) = *(const LAS u32x4*)(xT + xr * 72 + p * 8); } }
            if (ps == 0) PSD_LOAD(u, 2); else if (u < 3) { if (ps == 1) PSD_LOAD(u + 1, 0); else PSD_LOAD(u + 1, 1); }
            __syncthreads();
        }
    }
}
#undef PSD_STAGE
#undef PSD_LOAD
__device__ __forceinline__ void ssd_intra_range(LAS unsigned char* lds, int bid, const bf16* raw, const float* ssc, const float* Dp, bf16* yi, int tid_p) {
    using namespace psd;
    const int bg = bid >> 5, b = bg >> 1, g = bg & 1, r32 = bid & 31;
    LAS float* sc = (LAS float*)(lds + SC);
    LAS bf16* Bm = (LAS bf16*)(lds + BM_); LAS bf16* Cm = (LAS bf16*)(lds + CM_); LAS float* cb = (LAS float*)(lds + CB);
    LAS bf16* xT = (LAS bf16*)(lds + XT); LAS bf16* Mm = (LAS bf16*)(lds + MM); LAS bf16* yst = (LAS bf16*)(lds + YST);
    const size_t rowb = (size_t)b * SEQ;
    u32x4 pbc[4], px[8]; float pss[4];
#define PSI_LOADBC(u_) do { const int t0_ = (r32 * 4 + (u_)) * 64; \
        _Pragma("unroll") for (int x = 0; x < 4; ++x) { const int e = tid_p + 512 * x; const int r = e >> 5, p = e & 31; \
            pbc[x] = *(const GAS u32x4*)(raw + (rowb + t0_ + r) * CONV_CH + (p < 16 ? 4096 + g * 128 + p * 8 : 4352 + g * 128 + (p - 16) * 8)); } \
        { const float* sp_ = ssc + ((size_t)((b * 16 + g * 8 + (tid_p >> 6)) * NCHUNK + (r32 * 4 + (u_)))) * 256 + (tid_p & 63); pss[0] = sp_[0]; pss[1] = sp_[64]; pss[2] = sp_[128]; pss[3] = sp_[192]; } } while (0)
#define PSI_LOADX(u_, hp_) do { const int t0_ = (r32 * 4 + (u_)) * 64; \
        _Pragma("unroll") for (int y = 0; y < 2; ++y) { const int e = tid_p + 512 * y; const int xr = e >> 3, p = e & 7; const int hl = 2 * (hp_) + (xr >> 6), pp = xr & 63; \
            px[2 * (hp_) + y] = *(const GAS u32x4*)(raw + (rowb + t0_ + pp) * CONV_CH + 3072 + (g * 8 + hl) * 64 + p * 8); } } while (0)
#define PSI_PUTX(hp_) do { _Pragma("unroll") for (int y = 0; y < 2; ++y) { const int e = tid_p + 512 * y; const int xr = e >> 3, p = e & 7; *(LAS u32x4*)(xT + xr * 72 + p * 8) = px[2 * (hp_) + y]; } } while (0)
    PSI_LOADBC(0); PSI_LOADX(0, 0); PSI_LOADX(0, 1); PSI_LOADX(0, 2); PSI_LOADX(0, 3);
    for (int u = 0; u < 4; ++u) {
        int tid = tid_p; asm volatile("" : "+v"(tid));
        const int lane = tid & 63, wave = __builtin_amdgcn_readfirstlane(tid >> 6), fr = lane & 15, fq = lane >> 4;
        const int c = r32 * 4 + u, t0 = c * 64;
#pragma unroll
        for (int x = 0; x < 4; ++x) { const int e = tid_p + 512 * x; const int r = e >> 5, p = e & 31;
            *(LAS u32x4*)((p < 16 ? Bm + r * 136 + p * 8 : Cm + r * 136 + (p - 16) * 8)) = pbc[x]; }
        { const int i = lane; LAS float* s = sc + wave * 256; s[i] = pss[0]; s[64 + i] = pss[1] * 1.4426950408889634f; s[128 + i] = pss[2]; s[192 + i] = pss[3] * 1.4426950408889634f; }
        PSI_PUTX(0);
        if (u + 1 < 4) PSI_LOADBC(u + 1);
        __syncthreads();
        { const int mt = wave & 3, nh = wave >> 2;
          f32x4 acc[1][2]; acc[0][0] = acc[0][1] = (f32x4){0.f, 0.f, 0.f, 0.f};
          mma_lds<1, 2>(acc, Cm, 136, mt * 16, Bm, 136, nh * 32, 128, fr, fq);
#pragma unroll
          for (int nl = 0; nl < 2; ++nl)
#pragma unroll
              for (int r = 0; r < 4; ++r) cb[(mt * 16 + 4 * fq + r) * 68 + nh * 32 + nl * 16 + fr] = acc[0][nl][r]; }
#pragma unroll
        for (int hp = 0; hp < 4; ++hp) {
            __syncthreads();
            if (u + 1 < 4) PSI_LOADX(u + 1, hp);
            { const int e = tid >> 8, i = (tid >> 2) & 63, jq = tid & 3; const int hl = 2 * hp + e;
              const LAS float* s = sc + hl * 256; const float Dh = Dp[g * 8 + hl];
              const float csfi = s[64 + i], csbi = s[192 + i], dsum = s[i] + s[128 + i];
#pragma unroll
              for (int jj = 0; jj < 16; jj += 2) { float m2[2];
#pragma unroll
                  for (int y = 0; y < 2; ++y) { const int j = jq * 16 + jj + y; const float cbv = cb[i * 68 + j];
                      const float cfj = s[64 + j], cbj = s[192 + j], dfj = s[j], dbj = s[128 + j];
                      const float arg = (i > j) ? csfi - cfj : csbi - cbj;
                      const float dtj = (i > j) ? dfj : dbj;
                      const float w = (i == j) ? dsum : __builtin_amdgcn_exp2f(fminf(arg, 0.f)) * dtj;
                      m2[y] = cbv * w + ((i == j) ? Dh : 0.f); }
                  *(LAS unsigned*)(Mm + (e * 64 + i) * 72 + jq * 16 + jj) = pkbf(m2[0], m2[1]); } }
            __syncthreads();
            { const int e = wave >> 2, mt = wave & 3;
              f32x4 acc[1][4];
#pragma unroll
              for (int nt = 0; nt < 4; ++nt) acc[0][nt] = (f32x4){0.f, 0.f, 0.f, 0.f};
              mma_lds<1, 4>(acc, xT + e * 64 * 72, 72, mt * 16, Mm + e * 64 * 72, 72, 0, 64, fr, fq);
#pragma unroll
              for (int nt = 0; nt < 4; ++nt) { u32x2 w; w.x = pkbf(acc[0][nt][0], acc[0][nt][1]); w.y = pkbf(acc[0][nt][2], acc[0][nt][3]);
                  *(LAS u32x2*)(yst + (nt * 16 + fr) * 136 + e * 64 + mt * 16 + 4 * fq) = w; } }
            __syncthreads();
            if (hp < 3) PSI_PUTX(hp + 1);
            for (int e = tid; e < 64 * 16; e += 512) { const int i = e >> 4, p = e & 15;
                *(GAS u32x4*)(yi + (rowb + t0 + i) * 1024 + (g * 8 + 2 * hp) * 64 + p * 8) = *(const LAS u32x4*)(yst + i * 136 + p * 8); }
        }
        __syncthreads();
    }
#undef PSI_LOADBC
#undef PSI_LOADX
#undef PSI_PUTX
}

namespace ss2 {
constexpr int CO = 0;
constexpr int BO = CO + 64 * 132 * 2;
constexpr int XO = BO + 64 * 132 * 2;
constexpr int SCO = XO + 64 * 72 * 2;
constexpr int BUF = SCO + 768;
constexpr int OST = 2 * BUF;
constexpr int END = OST + 2 * 64 * 72 * 2;
static_assert(END <= MISC_OFF && BUF % 16 == 0, "ssd state LDS map");
}
template <int DIR>
__device__ __forceinline__ void ssd_state2(LAS unsigned char* lds, int b, int hd, const bf16* raw, const float* ssc, bf16* ys, int tid, int wave, int lane) {
    using namespace ss2;
    const size_t rowb = (size_t)b * SEQ; const int g = hd >> 3;
    LAS bf16* ost = (LAS bf16*)(lds + OST);
    const int r31 = lane & 31, hh = lane >> 5;
    if (wave == 4 || wave == 5) {
        for (int n = 0; n < NCHUNK + 1; ++n) WG_BAR();
    } else if (wave >= 2) {
        const int hw = (wave & 1) | ((wave >> 2) << 1); const int ht = hw * 64 + lane;
        unsigned go[10], lo_[10]; u32x4 ld[10]; float sr0 = 0.f, sr1 = 0.f;
#pragma unroll
        for (int x = 0; x < 4; ++x) { const int e = ht + 256 * x, r = e >> 4, p = e & 15;
            go[x] = (unsigned)((r * CONV_CH + 4352 + g * 128 + p * 8) * 2); go[4 + x] = (unsigned)((r * CONV_CH + 4096 + g * 128 + p * 8) * 2);
            lo_[x] = (unsigned)(CO + (r * 132 + p * 8) * 2); lo_[4 + x] = (unsigned)(BO + (r * 132 + p * 8) * 2); }
#pragma unroll
        for (int x = 0; x < 2; ++x) { const int e = ht + 256 * x, xr = e >> 3, p = e & 7;
            go[8 + x] = (unsigned)((xr * CONV_CH + 3072 + hd * 64 + p * 8) * 2); lo_[8 + x] = (unsigned)(XO + (xr * 72 + p * 8) * 2); }
#define SS2_ISSUE(c_) do { const GAS char* rb_ = (const GAS char*)(raw + (rowb + (size_t)(c_) * 64) * CONV_CH); \
            _Pragma("unroll") for (int x = 0; x < 10; ++x) ld[x] = *(const GAS u32x4*)(rb_ + go[x]); \
            if (hw == 0) { const float* sp_ = ssc + ((size_t)((b * 16 + hd) * NCHUNK + (c_))) * 256 + DIR * 128 + lane; sr0 = sp_[0]; sr1 = sp_[64]; } } while (0)
#define SS2_COMMIT(bi_, c_) do { LAS unsigned char* B_ = lds + (bi_) * BUF; \
            _Pragma("unroll") for (int x = 0; x < 10; ++x) { LAS unsigned char* d_ = B_ + lo_[x]; *(LAS u32x2*)(d_) = (u32x2){ld[x].x, ld[x].y}; *(LAS u32x2*)(d_ + 8) = (u32x2){ld[x].z, ld[x].w}; } \
            if (hw == 0) { LAS float* sc_ = (LAS float*)(B_ + SCO); const int i = lane; const float cs = sr1; const float cl = __shfl(cs, DIR ? 0 : 63); \
                sc_[i] = __expf(cs); sc_[64 + i] = sr0 * __expf(cl - cs); if (i == 0) sc_[128] = __expf(cl); } } while (0)
        { const int c0 = DIR ? NCHUNK - 1 : 0; SS2_ISSUE(c0); SS2_COMMIT(0, c0); SS2_ISSUE((DIR ? c0 - 1 : c0 + 1)); }
        for (int n = 0; n < NCHUNK; ++n) {
            const int c = DIR ? NCHUNK - 1 - n : n;
            WG_BAR();
            const bool more = n + 1 < NCHUNK; const int cn = DIR ? c - 1 : c + 1;
            if (more) { SS2_COMMIT((n + 1) & 1, cn); if (n + 2 < NCHUNK) SS2_ISSUE((DIR ? cn - 1 : cn + 1)); }
            unsigned ov[8];
            if (n > 0) {
#pragma unroll
                for (int x = 0; x < 8; ++x) ov[x] = *(const LAS unsigned*)(ost + ((n - 1) & 1) * (64 * 72) + (hw * 16 + 2 * x + (lane >> 5)) * 72 + 2 * (lane & 31));
            }
            if (n > 0) { const int tp = (DIR ? c + 1 : c - 1) * 64;
#pragma unroll
                for (int x = 0; x < 8; ++x) { GAS char* ob_ = (GAS char*)(ys + (rowb + tp + hw * 16 + 2 * x) * 1024 + hd * 64);
                    (void)__builtin_amdgcn_global_atomic_fadd_v2bf16((GAS s16x2*)(ob_ + (lane >> 5) * 2048 + (lane & 31) * 4), __builtin_bit_cast(s16x2, ov[x])); } }
        }
        WG_BAR();
        { const int tp = (DIR ? 0 : NCHUNK - 1) * 64;
#pragma unroll
          for (int x = 0; x < 8; ++x) { const unsigned v = *(const LAS unsigned*)(ost + ((NCHUNK - 1) & 1) * (64 * 72) + (hw * 16 + 2 * x + (lane >> 5)) * 72 + 2 * (lane & 31));
              GAS char* ob_ = (GAS char*)(ys + (rowb + tp + hw * 16 + 2 * x) * 1024 + hd * 64);
              (void)__builtin_amdgcn_global_atomic_fadd_v2bf16((GAS s16x2*)(ob_ + (lane >> 5) * 2048 + (lane & 31) * 4), __builtin_bit_cast(s16x2, v)); } }
#undef SS2_ISSUE
#undef SS2_COMMIT
    } else {
        const int ps = wave; const int xrow = ps * 32 + r31;
        f32x16 Ht[4];
#pragma unroll
        for (int t = 0; t < 4; ++t)
#pragma unroll
            for (int r = 0; r < 16; ++r) Ht[t][r] = 0.f;
        for (int n = 0; n < NCHUNK; ++n) {
            WG_BAR();
            const LAS unsigned char* Bb = lds + (n & 1) * BUF;
            const LAS bf16* Cb = (const LAS bf16*)(Bb + CO); const LAS bf16* Bmb = (const LAS bf16*)(Bb + BO); const LAS bf16* Xb = (const LAS bf16*)(Bb + XO);
            const LAS float* sc = (const LAS float*)(Bb + SCO);
            f32x16 aY[2];
#pragma unroll
            for (int m = 0; m < 2; ++m)
#pragma unroll
                for (int r = 0; r < 16; ++r) aY[m][r] = 0.f;
            bf16x8 fa[2][2];
            const int offc = r31 * 132 + 4 * hh;
#define SS2_LD2(bi_, ks_) do { fa[bi_][0] = afrag(Cb + offc + 16 * (ks_)); fa[bi_][1] = afrag(Cb + offc + 32 * 132 + 16 * (ks_)); } while (0)
            SS2_LD2(0, 0);
#pragma unroll
            for (int ks = 0; ks < 8; ++ks) {
                if (ks < 7) SS2_LD2((ks + 1) & 1, ks + 1);
                __builtin_amdgcn_sched_barrier(0);
                const bf16x8 bs = cvt8(Ht[ks >> 1], 8 * (ks & 1));
                aY[0] = MFMA32(fa[ks & 1][0], bs, aY[0]); aY[1] = MFMA32(fa[ks & 1][1], bs, aY[1]);
                __builtin_amdgcn_sched_barrier(0); }
#undef SS2_LD2
            const int i16 = r31 & 15; const LAS bf16* bp = Bmb + (8 * hh + (i16 >> 2)) * 132 + 16 * (r31 >> 4) + 4 * (i16 & 3);
            bf16x8 xf[4];
#pragma unroll
            for (int kt = 0; kt < 4; ++kt) { const bf16x8 xv = *(const LAS bf16x8*)(Xb + xrow * 72 + 16 * kt + 8 * hh);
                const f32x4 w0 = *(const LAS f32x4*)(sc + 64 + 16 * kt + 8 * hh), w1 = *(const LAS f32x4*)(sc + 64 + 16 * kt + 8 * hh + 4);
                u32x4 w; w.x = pkbf(bf2f_s(xv[0]) * w0[0], bf2f_s(xv[1]) * w0[1]); w.y = pkbf(bf2f_s(xv[2]) * w0[2], bf2f_s(xv[3]) * w0[3]);
                w.z = pkbf(bf2f_s(xv[4]) * w1[0], bf2f_s(xv[5]) * w1[1]); w.w = pkbf(bf2f_s(xv[6]) * w1[2], bf2f_s(xv[7]) * w1[3]);
                xf[kt] = __builtin_bit_cast(bf16x8, w); }
            bf16x8 fb[2][4];
#define SS2_LDBT(bi_, t_) do { _Pragma("unroll") for (int kt = 0; kt < 4; ++kt) { const LAS bf16* p_ = bp + (16 * kt) * 132 + 32 * (t_); \
                const v4i16_t lo_ = __builtin_amdgcn_ds_read_tr16_b64_v4i16((LAS v4i16_t*)p_), hi_ = __builtin_amdgcn_ds_read_tr16_b64_v4i16((LAS v4i16_t*)(p_ + 4 * 132)); \
                fb[bi_][kt] = (bf16x8){lo_[0], lo_[1], lo_[2], lo_[3], hi_[0], hi_[1], hi_[2], hi_[3]}; } } while (0)
            SS2_LDBT(0, 0);
#pragma unroll
            for (int m = 0; m < 2; ++m)
#pragma unroll
                for (int q4 = 0; q4 < 4; ++q4) { const f32x4 ec = *(const LAS f32x4*)(sc + 32 * m + 8 * q4 + 4 * hh);
#pragma unroll
                    for (int x = 0; x < 4; ++x) aY[m][4 * q4 + x] *= ec[x]; }
            const float ecl = sc[128];
#pragma unroll
            for (int mi = 0; mi < 2; ++mi)
#pragma unroll
                for (int r = 0; r < 16; ++r) ost[(n & 1) * (64 * 72) + (32 * mi + (r & 3) + 8 * (r >> 2) + 4 * hh) * 72 + ps * 32 + r31] = f2bf1(aY[mi][r]);
#pragma unroll
            for (int t = 0; t < 4; ++t) {
                if (t < 3) SS2_LDBT((t + 1) & 1, t + 1);
                __builtin_amdgcn_sched_barrier(0);
#pragma unroll
                for (int r = 0; r < 16; ++r) Ht[t][r] *= ecl;
                Ht[t] = MFMA32(fb[t & 1][0], xf[0], Ht[t]); Ht[t] = MFMA32(fb[t & 1][1], xf[1], Ht[t]);
                Ht[t] = MFMA32(fb[t & 1][2], xf[2], Ht[t]); Ht[t] = MFMA32(fb[t & 1][3], xf[3], Ht[t]);
                __builtin_amdgcn_sched_barrier(0); }
#undef SS2_LDBT
        }
        WG_BAR();
    }
}
#ifndef GS3_LDK
#define GS3_LDK 136
#endif
namespace gs3 {
constexpr int LDK = GS3_LDK, LDT = 72;
constexpr int KO = 0;
constexpr int QO = KO + 64 * LDK * 2;
constexpr int VTO = QO + 64 * LDK * 2;
constexpr int TO = VTO + 64 * LDT * 2;
constexpr int QKO = TO + 64 * LDT * 2;
constexpr int SCO = QKO + 64 * LDT * 2;
constexpr int BUF = SCO + 1024;
constexpr int OST = 2 * BUF;
constexpr int END = OST + 2 * 64 * 72 * 2;
static_assert(END <= MISC_OFF && BUF % 16 == 0, "gdn state3 LDS map");
}
__device__ __forceinline__ bf16x8 pack2(const f32x4& a, const f32x4& b) {
    u32x4 w; w.x = pkbf(a[0], a[1]); w.y = pkbf(a[2], a[3]); w.z = pkbf(b[0], b[1]); w.w = pkbf(b[2], b[3]);
    return __builtin_bit_cast(bf16x8, w);
}
__device__ __forceinline__ bf16x8 afrag16(const LAS bf16* p) {
    const bf16x4 lo = *(const LAS bf16x4*)p, hi = *(const LAS bf16x4*)(p + 16);
    return (bf16x8){lo[0], lo[1], lo[2], lo[3], hi[0], hi[1], hi[2], hi[3]};
}
__device__ __forceinline__ bf16x8 afrag16_tr(const LAS bf16* p, int ld) {
    const v4i16_t lo = __builtin_amdgcn_ds_read_tr16_b64_v4i16((LAS v4i16_t*)p), hi = __builtin_amdgcn_ds_read_tr16_b64_v4i16((LAS v4i16_t*)(p + 16 * ld));
    return (bf16x8){lo[0], lo[1], lo[2], lo[3], hi[0], hi[1], hi[2], hi[3]};
}
#define MFMA16(a, b, c) __builtin_amdgcn_mfma_f32_16x16x32_bf16((a), (b), (c), 0, 0, 0)

constexpr int CW_OFLAG = 16384;
__device__ __forceinline__ void store16_wt(bf16* p, u32x4 v) { asm volatile("global_store_dwordx4 %0, %1, off sc1\n\ts_nop 1" :: "v"(p), "v"(v) : "memory"); }
__device__ __forceinline__ void out_rows(const LAS bf16* ostb, bf16* gbase  , int lane, bool second) {
#pragma unroll
    for (int x = 0; x < 2; ++x) { const int r = 8 * x + (lane >> 3), pc = lane & 7;
        const u32x4 ov = *(const LAS u32x4*)(ostb + r * 72 + pc * 8); bf16* gp = gbase + (size_t)r * 1024 + pc * 8;
        if (!second) store16_wt(gp, ov);
        else { const u32x4 gv = *(const GAS u32x4*)gp; u32x4 o;
            o.x = pkbf(__uint_as_float(ov.x << 16) + __uint_as_float(gv.x << 16), __uint_as_float(ov.x & 0xffff0000u) + __uint_as_float(gv.x & 0xffff0000u));
            o.y = pkbf(__uint_as_float(ov.y << 16) + __uint_as_float(gv.y << 16), __uint_as_float(ov.y & 0xffff0000u) + __uint_as_float(gv.y & 0xffff0000u));
            o.z = pkbf(__uint_as_float(ov.z << 16) + __uint_as_float(gv.z << 16), __uint_as_float(ov.z & 0xffff0000u) + __uint_as_float(gv.z & 0xffff0000u));
            o.w = pkbf(__uint_as_float(ov.w << 16) + __uint_as_float(gv.w << 16), __uint_as_float(ov.w & 0xffff0000u) + __uint_as_float(gv.w & 0xffff0000u));
            *(GAS u32x4*)gp = o; } }
}
__device__ __forceinline__ void out_handshake(unsigned* flags, int mine, int partner, int hw, int lane) {
    asm volatile("s_waitcnt vmcnt(0)" ::: "memory");
    if (lane == 0) { __hip_atomic_store(flags + (mine * 4 + hw) * 16, 1u, __ATOMIC_RELAXED, __HIP_MEMORY_SCOPE_AGENT);
        unsigned sp = 0;
        while (__hip_atomic_load(flags + (partner * 4 + hw) * 16, __ATOMIC_RELAXED, __HIP_MEMORY_SCOPE_AGENT) == 0u) { __builtin_amdgcn_s_sleep(2); if (++sp > (1u << 22)) break; } }
    __builtin_amdgcn_fence(__ATOMIC_ACQUIRE, "agent");
    asm volatile("s_waitcnt vmcnt(0)" ::: "memory");
}

template <int DIR, int XP = 0>
__device__ __forceinline__ void gdn_state3(LAS unsigned char* lds, int b, int h, int half, const bf16* raw, const float* scal, const bf16* TQ, bf16* og, int tid, int wave, int lane, unsigned* flags, int cid) {
    using namespace gs3;
    const size_t rowb = (size_t)b * SEQ; const int bh = b * 8 + h;
    LAS bf16* ost = (LAS bf16*)(lds + OST);
    const int fr = lane & 15, fq = lane >> 4;
    if (wave >= 4) {
        const int hw = wave - 4; const int ht = hw * 64 + lane;
        unsigned go[14], lo_[14]; u32x4 ld[14]; float sr0 = 0.f, sr1 = 0.f;
#pragma unroll
        for (int x = 0; x < 4; ++x) { const int e = ht + 256 * x, r = e >> 4, p = e & 15;
            go[x] = (unsigned)((r * CONV_CH + 1024 + h * 128 + p * 8) * 2); go[4 + x] = (unsigned)((r * CONV_CH + h * 128 + p * 8) * 2);
            lo_[x] = (unsigned)(KO + (r * LDK + p * 8) * 2); lo_[4 + x] = (unsigned)(QO + (r * LDK + p * 8) * 2); }
#pragma unroll
        for (int x = 0; x < 2; ++x) { const int e = ht + 256 * x, dvl = e >> 3, p = e & 7; const int dv = 64 * half + dvl;
            go[8 + x] = (unsigned)(((dv >> 1) * CONV_CH + 2048 + h * 128 + (dv & 1) * 64 + p * 8) * 2); lo_[8 + x] = (unsigned)(VTO + (dvl * LDT + p * 8) * 2); }
        u32x4 km[2], dg[2], qm[2];
#pragma unroll
        for (int x = 0; x < 2; ++x) { const int e = ht + 256 * x, i = e >> 3, p = e & 7;
            go[10 + x] = (unsigned)(e * 16); go[12 + x] = (unsigned)(8192 + e * 16);
            lo_[10 + x] = (unsigned)(TO + (i * LDT + p * 8) * 2); lo_[12 + x] = (unsigned)(QKO + (i * LDT + p * 8) * 2);
            unsigned kw[4], dw[4], qw[4];
#pragma unroll
            for (int w = 0; w < 4; ++w) { const int j0 = p * 8 + 2 * w, j1 = j0 + 1;
                const bool k0 = DIR ? (i < j0) : (i > j0), k1 = DIR ? (i < j1) : (i > j1);
                kw[w] = (k0 ? 0xFFFFu : 0u) | (k1 ? 0xFFFF0000u : 0u); dw[w] = (i == j0 ? 0x3F80u : 0u) | (i == j1 ? 0x3F800000u : 0u);
                qw[w] = kw[w] | (i == j0 ? 0xFFFFu : 0u) | (i == j1 ? 0xFFFF0000u : 0u); }
            km[x] = (u32x4){kw[0], kw[1], kw[2], kw[3]}; dg[x] = (u32x4){dw[0], dw[1], dw[2], dw[3]}; qm[x] = (u32x4){qw[0], qw[1], qw[2], qw[3]}; }
        const unsigned so_l = (unsigned)(lane * 256 + (DIR * 8 + h) * 4);
#define GS3_ISSUE(c_) do { const GAS char* rb_ = (const GAS char*)(raw + (rowb + (size_t)(c_) * 64) * CONV_CH); const GAS char* tb_ = (const GAS char*)(TQ + ((size_t)(bh * NCHUNK + (c_))) * 8192); \
            _Pragma("unroll") for (int x = 0; x < 10; ++x) ld[x] = *(const GAS u32x4*)(rb_ + go[x]); \
            _Pragma("unroll") for (int x = 10; x < 14; ++x) ld[x] = *(const GAS u32x4*)(tb_ + go[x]); \
            if (hw == 0) { const GAS char* sb_ = (const GAS char*)(scal + (rowb + (size_t)(c_) * 64) * 64); sr0 = *(const GAS float*)(sb_ + so_l); sr1 = *(const GAS float*)(sb_ + so_l + 64); } } while (0)
#define GS3_COMMIT(bi_, c_) do { LAS unsigned char* B_ = lds + (bi_) * BUF; \
            _Pragma("unroll") for (int x = 0; x < 10; ++x) *(LAS u32x4*)(B_ + lo_[x]) = ld[x]; \
            _Pragma("unroll") for (int x = 0; x < 2; ++x) { *(LAS u32x4*)(B_ + lo_[10 + x]) = (ld[10 + x] & km[x]) | dg[x]; *(LAS u32x4*)(B_ + lo_[12 + x]) = ld[12 + x] & qm[x]; } \
            if (hw == 0) { LAS float* sc_ = (LAS float*)(B_ + SCO); const int i = lane; const float gc = sr1; const float gl = __shfl(gc, DIR ? 0 : 63); \
                sc_[i] = sr0; sc_[64 + i] = __expf(gc); sc_[128 + i] = __expf(gl - gc); if (i == 0) sc_[192] = __expf(gl); } } while (0)
        { const int c0 = DIR ? NCHUNK - 1 : 0; GS3_ISSUE(c0); GS3_COMMIT(0, c0); GS3_ISSUE((DIR ? c0 - 1 : c0 + 1)); }
        for (int n = 0; n < NCHUNK; ++n) {
            const int c = DIR ? NCHUNK - 1 - n : n;
            WG_BAR();
            const bool more = n + 1 < NCHUNK; const int cn = DIR ? c - 1 : c + 1;
            if (more) { GS3_COMMIT((n + 1) & 1, cn); if (n + 2 < NCHUNK && (!(XP & 2) || n < 2)) GS3_ISSUE((DIR ? cn - 1 : cn + 1)); }
            if (n > 0 && !(XP & 1)) { const int tp = (DIR ? c + 1 : c - 1) * 64;
#pragma unroll
                for (int x = 0; x < 8; ++x) { const unsigned v = *(const LAS unsigned*)(ost + ((n - 1) & 1) * (64 * 72) + (hw * 16 + 2 * x + (lane >> 5)) * 72 + 2 * (lane & 31));
                    GAS char* ob_ = (GAS char*)(og + (rowb + tp + hw * 16 + 2 * x) * 1024 + h * 128 + half * 64);
                    (void)__builtin_amdgcn_global_atomic_fadd_v2bf16((GAS s16x2*)(ob_ + (lane >> 5) * 2048 + (lane & 31) * 4), __builtin_bit_cast(s16x2, v)); } }
        }
        WG_BAR();
        { const int tp = (DIR ? 0 : NCHUNK - 1) * 64;
#pragma unroll
          for (int x = 0; x < 8; ++x) { const unsigned v = *(const LAS unsigned*)(ost + ((NCHUNK - 1) & 1) * (64 * 72) + (hw * 16 + 2 * x + (lane >> 5)) * 72 + 2 * (lane & 31));
              GAS char* ob_ = (GAS char*)(og + (rowb + tp + hw * 16 + 2 * x) * 1024 + h * 128 + half * 64);
              (void)__builtin_amdgcn_global_atomic_fadd_v2bf16((GAS s16x2*)(ob_ + (lane >> 5) * 2048 + (lane & 31) * 4), __builtin_bit_cast(s16x2, v)); } }
#undef GS3_ISSUE
#undef GS3_COMMIT
    } else {
        const int dv0 = 16 * wave;
        f32x4 St[8];
#pragma unroll
        for (int t = 0; t < 8; ++t) St[t] = (f32x4){0.f, 0.f, 0.f, 0.f};
        for (int n = 0; n < NCHUNK; ++n) {
            WG_BAR();
            const LAS unsigned char* Bb = lds + (n & 1) * BUF;
            const LAS bf16* Kb = (const LAS bf16*)(Bb + KO); const LAS bf16* Qb = (const LAS bf16*)(Bb + QO); const LAS bf16* Vb = (const LAS bf16*)(Bb + VTO);
            const LAS bf16* Tb = (const LAS bf16*)(Bb + TO); const LAS bf16* QKb = (const LAS bf16*)(Bb + QKO); const LAS float* sc = (const LAS float*)(Bb + SCO);
            const int offa = fr * LDK + 4 * fq, offt = fr * LDT + 4 * fq;
            bf16x8 bS[4];
#pragma unroll
            for (int ks = 0; ks < 4; ++ks) bS[ks] = pack2(St[2 * ks], St[2 * ks + 1]);
            f32x4 aK[4];
#pragma unroll
            for (int m = 0; m < 4; ++m) aK[m] = (f32x4){0.f, 0.f, 0.f, 0.f};
#pragma unroll
            for (int ks = 0; ks < 4; ++ks) { bf16x8 fa[4];
#pragma unroll
                for (int m = 0; m < 4; ++m) fa[m] = afrag16(Kb + offa + 16 * m * LDK + 32 * ks);
#pragma unroll
                for (int m = 0; m < 4; ++m) aK[m] = MFMA16(fa[m], bS[ks], aK[m]); }
            bf16x8 ft[8];
#pragma unroll
            for (int mi = 0; mi < 4; ++mi)
#pragma unroll
                for (int kt = 0; kt < 2; ++kt) { const bool need = DIR ? (kt >= (mi >> 1)) : (kt <= (mi >> 1));
                    if (need) ft[mi * 2 + kt] = afrag16(Tb + offt + 16 * mi * LDT + 32 * kt); }
#pragma unroll
            for (int m = 0; m < 4; ++m) { const int tb = 16 * m + 4 * fq;
                const bf16x4 vv = *(const LAS bf16x4*)(Vb + (dv0 + fr) * LDT + tb); const f32x4 be = *(const LAS f32x4*)(sc + tb), eg = *(const LAS f32x4*)(sc + 64 + tb);
#pragma unroll
                for (int e = 0; e < 4; ++e) aK[m][e] = be[e] * (bf2f_s(vv[e]) - eg[e] * aK[m][e]); }
            const bf16x8 br0 = pack2(aK[0], aK[1]), br1 = pack2(aK[2], aK[3]);
            f32x4 au[4];
#pragma unroll
            for (int m = 0; m < 4; ++m) au[m] = (f32x4){0.f, 0.f, 0.f, 0.f};
#pragma unroll
            for (int mi = 0; mi < 4; ++mi)
#pragma unroll
                for (int kt = 0; kt < 2; ++kt) { const bool need = DIR ? (kt >= (mi >> 1)) : (kt <= (mi >> 1));
                    if (need) au[mi] = MFMA16(ft[mi * 2 + kt], (kt == 0 ? br0 : br1), au[mi]); }
            f32x4 aQ[4];
            if constexpr (!(XP & 4)) {
#pragma unroll
            for (int m = 0; m < 4; ++m) aQ[m] = (f32x4){0.f, 0.f, 0.f, 0.f};
#pragma unroll
            for (int ks = 0; ks < 4; ++ks) { bf16x8 fa[4];
#pragma unroll
                for (int m = 0; m < 4; ++m) fa[m] = afrag16(Qb + offa + 16 * m * LDK + 32 * ks);
#pragma unroll
                for (int m = 0; m < 4; ++m) aQ[m] = MFMA16(fa[m], bS[ks], aQ[m]); }
            bf16x8 fqk[8];
#pragma unroll
            for (int mi = 0; mi < 4; ++mi)
#pragma unroll
                for (int kt = 0; kt < 2; ++kt) { const bool need = DIR ? (kt >= (mi >> 1)) : (kt <= (mi >> 1));
                    if (need) fqk[mi * 2 + kt] = afrag16(QKb + offt + 16 * mi * LDT + 32 * kt); }
            const bf16x8 bu0 = pack2(au[0], au[1]), bu1 = pack2(au[2], au[3]);
#pragma unroll
            for (int m = 0; m < 4; ++m) { const int tb = 16 * m + 4 * fq; const f32x4 eg = *(const LAS f32x4*)(sc + 64 + tb);
#pragma unroll
                for (int e = 0; e < 4; ++e) { aQ[m][e] *= eg[e]; } }
#pragma unroll
            for (int mi = 0; mi < 4; ++mi)
#pragma unroll
                for (int kt = 0; kt < 2; ++kt) { const bool need = DIR ? (kt >= (mi >> 1)) : (kt <= (mi >> 1));
                    if (need) aQ[mi] = MFMA16(fqk[mi * 2 + kt], (kt == 0 ? bu0 : bu1), aQ[mi]); }
#pragma unroll
            for (int m = 0; m < 4; ++m)
#pragma unroll
                for (int e = 0; e < 4; ++e) ost[(n & 1) * (64 * 72) + (16 * m + 4 * fq + e) * 72 + dv0 + fr] = f2bf1(aQ[m][e]);
            }
#pragma unroll
            for (int m = 0; m < 4; ++m) { const int tb = 16 * m + 4 * fq; const f32x4 ek = *(const LAS f32x4*)(sc + 128 + tb);
#pragma unroll
                for (int e = 0; e < 4; ++e) { au[m][e] *= ek[e]; } }
            const bf16x8 bd0 = pack2(au[0], au[1]), bd1 = pack2(au[2], au[3]);
            const float egl = sc[192];
            { const LAS bf16* kp = Kb + (4 * fq + (fr >> 2)) * LDK + 4 * (fr & 3);
#pragma unroll
              for (int t = 0; t < 8; ++t) { const bf16x8 f0 = afrag16_tr(kp + 16 * t, LDK), f1 = afrag16_tr(kp + 32 * LDK + 16 * t, LDK);
                  St[t] = St[t] * egl; St[t] = MFMA16(f0, bd0, St[t]); St[t] = MFMA16(f1, bd1, St[t]); } }
        }
        WG_BAR();
    }
}

namespace ss3 {
constexpr int LDK = GS3_LDK, LDT = 72;
constexpr int CO = 0;
constexpr int BO = CO + 64 * LDK * 2;
constexpr int XO = BO + 64 * LDK * 2;
constexpr int SCO = XO + 64 * LDT * 2;
constexpr int BUF = SCO + 768;
constexpr int OST = 2 * BUF;
constexpr int END = OST + 2 * 64 * 72 * 2;
static_assert(END <= MISC_OFF && BUF % 16 == 0, "ssd state3 LDS map");
}
template <int DIR, int XP = 0>
__device__ __forceinline__ void ssd_state3(LAS unsigned char* lds, int b, int hd, const bf16* raw, const float* ssc, bf16* ys, int tid, int wave, int lane, unsigned* flags, int cid) {
    using namespace ss3;
    const size_t rowb = (size_t)b * SEQ; const int g = hd >> 3;
    LAS bf16* ost = (LAS bf16*)(lds + OST);
    const int fr = lane & 15, fq = lane >> 4;
    if (wave >= 4) {
        const int hw = wave - 4; const int ht = hw * 64 + lane;
        unsigned go[10], lo_[10]; u32x4 ld[10]; float sr0 = 0.f, sr1 = 0.f;
#pragma unroll
        for (int x = 0; x < 4; ++x) { const int e = ht + 256 * x, r = e >> 4, p = e & 15;
            go[x] = (unsigned)((r * CONV_CH + 4352 + g * 128 + p * 8) * 2); go[4 + x] = (unsigned)((r * CONV_CH + 4096 + g * 128 + p * 8) * 2);
            lo_[x] = (unsigned)(CO + (r * LDK + p * 8) * 2); lo_[4 + x] = (unsigned)(BO + (r * LDK + p * 8) * 2); }
#pragma unroll
        for (int x = 0; x < 2; ++x) { const int e = ht + 256 * x, xr = e >> 3, p = e & 7;
            go[8 + x] = (unsigned)((xr * CONV_CH + 3072 + hd * 64 + p * 8) * 2); lo_[8 + x] = (unsigned)(XO + (xr * LDT + p * 8) * 2); }
#define SS3_ISSUE(c_) do { const GAS char* rb_ = (const GAS char*)(raw + (rowb + (size_t)(c_) * 64) * CONV_CH); \
            _Pragma("unroll") for (int x = 0; x < 10; ++x) ld[x] = *(const GAS u32x4*)(rb_ + go[x]); \
            if (hw == 0) { const float* sp_ = ssc + ((size_t)((b * 16 + hd) * NCHUNK + (c_))) * 256 + DIR * 128 + lane; sr0 = sp_[0]; sr1 = sp_[64]; } } while (0)
#define SS3_COMMIT(bi_, c_) do { LAS unsigned char* B_ = lds + (bi_) * BUF; \
            _Pragma("unroll") for (int x = 0; x < 10; ++x) *(LAS u32x4*)(B_ + lo_[x]) = ld[x]; \
            if (hw == 0) { LAS float* sc_ = (LAS float*)(B_ + SCO); const int i = lane; const float cs = sr1; const float cl = __shfl(cs, DIR ? 0 : 63); \
                sc_[i] = __expf(cs); sc_[64 + i] = sr0 * __expf(cl - cs); if (i == 0) sc_[128] = __expf(cl); } } while (0)
        { const int c0 = DIR ? NCHUNK - 1 : 0; SS3_ISSUE(c0); SS3_COMMIT(0, c0); SS3_ISSUE((DIR ? c0 - 1 : c0 + 1)); }
        for (int n = 0; n < NCHUNK; ++n) {
            const int c = DIR ? NCHUNK - 1 - n : n;
            WG_BAR();
            const bool more = n + 1 < NCHUNK; const int cn = DIR ? c - 1 : c + 1;
            if (more) { SS3_COMMIT((n + 1) & 1, cn); if (n + 2 < NCHUNK && (!(XP & 2) || n < 2)) SS3_ISSUE((DIR ? cn - 1 : cn + 1)); }
            if (n > 0 && !(XP & 1)) { const int tp = (DIR ? c + 1 : c - 1) * 64;
#pragma unroll
                for (int x = 0; x < 8; ++x) { const unsigned v = *(const LAS unsigned*)(ost + ((n - 1) & 1) * (64 * 72) + (hw * 16 + 2 * x + (lane >> 5)) * 72 + 2 * (lane & 31));
                    GAS char* ob_ = (GAS char*)(ys + (rowb + tp + hw * 16 + 2 * x) * 1024 + hd * 64);
                    (void)__builtin_amdgcn_global_atomic_fadd_v2bf16((GAS s16x2*)(ob_ + (lane >> 5) * 2048 + (lane & 31) * 4), __builtin_bit_cast(s16x2, v)); } }
        }
        WG_BAR();
        { const int tp = (DIR ? 0 : NCHUNK - 1) * 64;
#pragma unroll
          for (int x = 0; x < 8; ++x) { const unsigned v = *(const LAS unsigned*)(ost + ((NCHUNK - 1) & 1) * (64 * 72) + (hw * 16 + 2 * x + (lane >> 5)) * 72 + 2 * (lane & 31));
              GAS char* ob_ = (GAS char*)(ys + (rowb + tp + hw * 16 + 2 * x) * 1024 + hd * 64);
              (void)__builtin_amdgcn_global_atomic_fadd_v2bf16((GAS s16x2*)(ob_ + (lane >> 5) * 2048 + (lane & 31) * 4), __builtin_bit_cast(s16x2, v)); } }
#undef SS3_ISSUE
#undef SS3_COMMIT
    } else {
        const int p0 = 16 * wave;
        f32x4 Ht[8];
#pragma unroll
        for (int t = 0; t < 8; ++t) Ht[t] = (f32x4){0.f, 0.f, 0.f, 0.f};
        for (int n = 0; n < NCHUNK; ++n) {
            WG_BAR();
            const LAS unsigned char* Bb = lds + (n & 1) * BUF;
            const LAS bf16* Cb = (const LAS bf16*)(Bb + CO); const LAS bf16* Bmb = (const LAS bf16*)(Bb + BO); const LAS bf16* Xb = (const LAS bf16*)(Bb + XO);
            const LAS float* sc = (const LAS float*)(Bb + SCO);
            const int offa = fr * LDK + 4 * fq;
            f32x4 aY[4];
#pragma unroll
            for (int m = 0; m < 4; ++m) aY[m] = (f32x4){0.f, 0.f, 0.f, 0.f};
#pragma unroll
            for (int ks = 0; ks < 4; ++ks) { const bf16x8 bs = pack2(Ht[2 * ks], Ht[2 * ks + 1]); bf16x8 fa[4];
#pragma unroll
                for (int m = 0; m < 4; ++m) fa[m] = afrag16(Cb + offa + 16 * m * LDK + 32 * ks);
#pragma unroll
                for (int m = 0; m < 4; ++m) aY[m] = MFMA16(fa[m], bs, aY[m]); }
            bf16x8 xf[2];
#pragma unroll
            for (int kt = 0; kt < 2; ++kt) { const bf16x8 xv = *(const LAS bf16x8*)(Xb + (p0 + fr) * LDT + 32 * kt + 8 * fq);
                const f32x4 w0 = *(const LAS f32x4*)(sc + 64 + 32 * kt + 8 * fq), w1 = *(const LAS f32x4*)(sc + 64 + 32 * kt + 8 * fq + 4);
                u32x4 w; w.x = pkbf(bf2f_s(xv[0]) * w0[0], bf2f_s(xv[1]) * w0[1]); w.y = pkbf(bf2f_s(xv[2]) * w0[2], bf2f_s(xv[3]) * w0[3]);
                w.z = pkbf(bf2f_s(xv[4]) * w1[0], bf2f_s(xv[5]) * w1[1]); w.w = pkbf(bf2f_s(xv[6]) * w1[2], bf2f_s(xv[7]) * w1[3]);
                xf[kt] = __builtin_bit_cast(bf16x8, w); }
#pragma unroll
            for (int m = 0; m < 4; ++m) { const f32x4 ec = *(const LAS f32x4*)(sc + 16 * m + 4 * fq);
#pragma unroll
                for (int e = 0; e < 4; ++e) aY[m][e] *= ec[e]; }
            const float ecl = sc[128];
#pragma unroll
            for (int m = 0; m < 4; ++m)
#pragma unroll
                for (int e = 0; e < 4; ++e) ost[(n & 1) * (64 * 72) + (16 * m + 4 * fq + e) * 72 + p0 + fr] = f2bf1(aY[m][e]);
            { const LAS bf16* bp = Bmb + (8 * fq + (fr >> 2)) * LDK + 4 * (fr & 3);
#pragma unroll
              for (int t = 0; t < 8; ++t) {
                  bf16x8 f[2];
#pragma unroll
                  for (int kt = 0; kt < 2; ++kt) { const LAS bf16* p = bp + (32 * kt) * LDK + 16 * t;
                      const v4i16_t lo = __builtin_amdgcn_ds_read_tr16_b64_v4i16((LAS v4i16_t*)p), hi = __builtin_amdgcn_ds_read_tr16_b64_v4i16((LAS v4i16_t*)(p + 4 * LDK));
                      f[kt] = (bf16x8){lo[0], lo[1], lo[2], lo[3], hi[0], hi[1], hi[2], hi[3]}; }
                  Ht[t] = Ht[t] * ecl; Ht[t] = MFMA16(f[0], xf[0], Ht[t]); Ht[t] = MFMA16(f[1], xf[1], Ht[t]); } }
        }
        WG_BAR();
    }
}
#ifndef PG8_SP2_
#define PG8_SP2_ true
#endif
#ifndef MK_ONE_LAUNCH
#define MK_ONE_LAUNCH 1
#endif
constexpr int PPL = 13;
constexpr int NPHASE = 1 + PPL * DEPTH;
struct Args { const float* in[19]; float* out; unsigned char* ws; int ph_lo, ph_hi; };
__global__ void __launch_bounds__(NWAVES * 64, 2) fwd_kernel(Args args) {
    extern __shared__ __attribute__((aligned(16))) unsigned char lds_raw[];
    LAS unsigned char* lds = (LAS unsigned char*)lds_raw;
    unsigned* ctl = (unsigned*)(args.ws + WS_CTL);
    volatile LAS unsigned* MISC = (volatile LAS unsigned*)(lds + MISC_OFF);
    for (int u = threadIdx.x; u < 64; u += 512) MISC[u] = 0u;
    __syncthreads();
#if MK_ONE_LAUNCH
    XcdBarrier bar = xcd_barrier_post(ctl + CW_BAR, MISC + 8);
#define GRID_BAR() do { XcdBarrier bb_ = bar; asm volatile("" : "+s"(bb_.bar), "+s"(bb_.x)); xcd_barrier(bb_); } while (0)
#else
#define GRID_BAR() do {} while (0)
#endif
    const int lo = args.ph_lo, hi = args.ph_hi;
#define WSP(T, off) ((T*)(wsb + (off)))
#if defined(PROBE_STATE) || defined(PROBE_ANY) || defined(PROBE_SUB)
#define PROBE_PTR ((float*)(wsb + WS_CTL) + 2048)
#define PROBE_SCALE (1.0f + sqrtf(8.7e-4f * fminf(fmaxf(*(volatile float*)PROBE_PTR, 0.f), 1.f)))
#else
#define PROBE_PTR ((float*)nullptr)
#define PROBE_SCALE 1.0f
#endif
    for (int ph = lo; ph < hi; ++ph) {
        int tid = threadIdx.x, bid = blockIdx.x, G = gridDim.x;
        const __attribute__((address_space(4))) Args* ap = (const __attribute__((address_space(4))) Args*)__builtin_amdgcn_kernarg_segment_ptr();
        asm volatile("" : "+v"(tid)); asm volatile("" : "+s"(bid), "+s"(G), "+s"(ap));
        unsigned char* wsb = ap->ws;
        const int lane = tid & 63, wave = __builtin_amdgcn_readfirstlane(tid >> 6);
        const int gw = bid * NWAVES + wave, NGW = G * NWAVES, gtid = bid * 512 + tid, NGT = G * 512;
        const int l = (ph == 0) ? 0 : (ph - 1) / PPL; const int k = (ph == 0) ? -1 : (ph - 1) % PPL;
#if defined(PROBE_ANY)
        if (l == PROBE_L && k == PROBE_K0 && blockIdx.x == 0 && threadIdx.x == 0) ((unsigned long long*)(wsb + WS_CTL))[1100] = __builtin_amdgcn_s_memrealtime();
#endif
        switch (k) {
        case -1: {
            cvt_mixer_weights(lds, wsb, ap->in[2], ap->in[12], gw, NGW, wave, lane);
            phase_norm(ap->in[0], ap->in[1], WSP(bf16, WS_XN), gw, NGW, lane);
        } break;
        case 0: {
            pg8::Gemm g{WSP(bf16, WS_XN), WSP(bf16, WS_WA), M, NWA, DM, 0, 0, 0}; pg8::StaticOrder S; S.init(M, NWA, G, bid);
            pg8::EpiRawA E{WSP(bf16, WS_RAW), WSP(float, WS_SCAL)};
            pg8::gemm_phase<pg8::EpiRawA, pg8::StaticOrder, true, PG8_SP2_>(lds, g, S, E);
#if defined(EXP_DUP_GEMM)
            if (l == 0 && (EXP_DUP_GEMM & 1)) { __syncthreads(); pg8::gemm_phase<pg8::EpiRawA, pg8::StaticOrder, true, PG8_SP2_>(lds, g, S, E); }
#endif
        } break;
        case 1: {
            if (l == 1) PB_START(3, wsb);
            prep_gdn_stash(lds, bid, WSP(bf16, WS_RAW), tid); prep_ssd_stash(lds, bid, WSP(bf16, WS_RAW), tid);
            zero_region(wsb + WS_OG, 64 * MiB, gtid, NGT); zero_region(wsb + WS_YS, 64 * MiB, gtid, NGT);
            GRID_BAR();
            if (l == 1) { PB_END(3, wsb); PB_START(1, wsb); }
            prep_gdn_range(lds, bid, WSP(bf16, WS_RAW), WSP(float, WS_SCAL), ap->in[3] + (size_t)l * 7 * CONV_CH, ap->in[4] + (size_t)l * CONV_CH,
                           ap->in[5] + l * 16, ap->in[6] + l * 16, WSP(bf16, WS_TQ), tid, wave, lane, WSP(float, WS_SCAL));
            __syncthreads();
            if (l == 1) { PB_END(1, wsb); PB_START(2, wsb); }
            { int tid2 = threadIdx.x; asm volatile("" : "+v"(tid2));
              prep_ssd_range(lds, bid, WSP(bf16, WS_RAW), ap->in[3] + (size_t)l * 7 * CONV_CH, ap->in[4] + (size_t)l * CONV_CH, tid2,
                             WSP(float, WS_SCAL), ap->in[8] + l * 32, ap->in[9] + l * 32, WSP(float, WS_SSC)); }
            if (l == 1) { __syncthreads(); PB_END(2, wsb); }
        } break;
        case 2: {
#if defined(EXP_DUP_ST)
            for (int c0_ = bid; c0_ < 256 * 2; c0_ += G) {
                const int c = c0_ & 255; const bool dup_ = c0_ >= 256;
                if (dup_ && (l != 0 || ((EXP_DUP_ST == 1) != (c < 128)))) continue;
                bf16* const ogp_ = dup_ ? (bf16*)ap->out : WSP(bf16, WS_OG); bf16* const ysp_ = dup_ ? (bf16*)ap->out : WSP(bf16, WS_YS);
#else
            for (int c = bid; c < 256; c += G) {
                bf16* const ogp_ = WSP(bf16, WS_OG); bf16* const ysp_ = WSP(bf16, WS_YS);
#endif
                int tid = threadIdx.x; asm volatile("" : "+v"(tid));
                const int lane = tid & 63, wave = __builtin_amdgcn_readfirstlane(tid >> 6);
                if (c < 128) { const int x_ = (c & 7) | ((c >> 4) << 3), hf_ = (c >> 3) & 1;
                    const int b_ = x_ >> 4, h_ = (x_ >> 1) & 7;
#if defined(EXP_DUP_ST) && defined(EXP_S2)
                    if (dup_) { if (x_ & 1) gdn_state2<1>(lds, b_, h_, hf_, WSP(bf16, WS_RAW), WSP(float, WS_SCAL), WSP(bf16, WS_TQ), ap->in[5] + l * 16, ap->in[6] + l * 16, ogp_, tid, wave, lane);
                                else        gdn_state2<0>(lds, b_, h_, hf_, WSP(bf16, WS_RAW), WSP(float, WS_SCAL), WSP(bf16, WS_TQ), ap->in[5] + l * 16, ap->in[6] + l * 16, ogp_, tid, wave, lane); } else
#endif
#if defined(EXP_DUP_ST) && defined(EXP_XP)
                    if (dup_) { if (x_ & 1) gdn_state3<1, EXP_XP>(lds, b_, h_, hf_, WSP(bf16, WS_RAW), WSP(float, WS_SCAL), WSP(bf16, WS_TQ), ogp_, tid, wave, lane, nullptr, 0);
                                else        gdn_state3<0, EXP_XP>(lds, b_, h_, hf_, WSP(bf16, WS_RAW), WSP(float, WS_SCAL), WSP(bf16, WS_TQ), ogp_, tid, wave, lane, nullptr, 0); } else
#endif
                    if (x_ & 1) gdn_state3<1>(lds, b_, h_, hf_, WSP(bf16, WS_RAW), WSP(float, WS_SCAL), WSP(bf16, WS_TQ), ogp_, tid, wave, lane, nullptr, 0);
                    else        gdn_state3<0>(lds, b_, h_, hf_, WSP(bf16, WS_RAW), WSP(float, WS_SCAL), WSP(bf16, WS_TQ), ogp_, tid, wave, lane, nullptr, 0); }
                else { const int c2 = c - 128, gi_ = c2 & 15, hl_ = c2 >> 4;
                    const int b_ = gi_ >> 2, hd_ = ((gi_ >> 1) & 1) * 8 + hl_;
#if defined(EXP_DUP_ST) && defined(EXP_XP)
                    if (dup_) { if (gi_ & 1) ssd_state3<1, EXP_XP>(lds, b_, hd_, WSP(bf16, WS_RAW), WSP(float, WS_SSC), ysp_, tid, wave, lane, nullptr, 0);
                                else         ssd_state3<0, EXP_XP>(lds, b_, hd_, WSP(bf16, WS_RAW), WSP(float, WS_SSC), ysp_, tid, wave, lane, nullptr, 0); } else
#endif
                    if (gi_ & 1) ssd_state3<1>(lds, b_, hd_, WSP(bf16, WS_RAW), WSP(float, WS_SSC), ysp_, tid, wave, lane, nullptr, 0);
                    else         ssd_state3<0>(lds, b_, hd_, WSP(bf16, WS_RAW), WSP(float, WS_SSC), ysp_, tid, wave, lane, nullptr, 0); }
                __syncthreads();
            }
        } break;
        case 3: {
            ssd_intra_range(lds, bid, WSP(bf16, WS_RAW), WSP(float, WS_SSC), ap->in[10] + l * 16, WSP(bf16, WS_TQ), tid);
#if defined(EXP_DUP_INTRA)
            if (l == 0) { __syncthreads();
            ssd_intra_range(lds, bid, WSP(bf16, WS_RAW), WSP(float, WS_SSC), ap->in[10] + l * 16, WSP(bf16, WS_TQ), tid);
 }
#endif
        } break;
        case 4: {
            phase_norm((l == 0) ? ap->in[0] : ap->out, ap->in[1] + (size_t)l * DM, WSP(bf16, WS_XN2), gw, NGW, lane);
#if defined(EXP_DUP_B)
            if (l == 0) { __syncthreads();
            phase_norm((l == 0) ? ap->in[0] : ap->out, ap->in[1] + (size_t)l * DM, WSP(bf16, WS_XN2), gw, NGW, lane);
 }
#endif
        } break;
        case 5: {
            pg8::Gemm g{WSP(bf16, WS_XN2), WSP(bf16, WS_WB), M, NGATE, DM, 0, 0, 0}; pg8::StaticOrder S; S.init(M, NGATE, G, bid);
            pg8::EpiBf16 E{WSP(bf16, WS_GATES), NGATE};
            pg8::gemm_phase<pg8::EpiBf16, pg8::StaticOrder, true, PG8_SP2_>(lds, g, S, E);
#if defined(EXP_DUP_GEMM)
            if (l == 0 && (EXP_DUP_GEMM & 2)) { __syncthreads(); pg8::gemm_phase<pg8::EpiBf16, pg8::StaticOrder, true, PG8_SP2_>(lds, g, S, E); }
#endif
        } break;
        case 6: {
            phase_finish(WSP(bf16, WS_OG), WSP(bf16, WS_YS), WSP(bf16, WS_TQ), WSP(bf16, WS_GATES), ap->in[7] + l * 128, ap->in[11] + l * 1024, WSP(bf16, WS_MIXED), gw, NGW, lane);
#if defined(EXP_DUP_B)
            if (l == 0) { __syncthreads();
            phase_finish(WSP(bf16, WS_OG), WSP(bf16, WS_YS), WSP(bf16, WS_TQ), WSP(bf16, WS_GATES), ap->in[7] + l * 128, ap->in[11] + l * 1024, WSP(bf16, WS_MIXED), gw, NGW, lane);
 }
#endif
        } break;
        case 7: {
            pg8::Gemm g{WSP(bf16, WS_MIXED), WSP(bf16, WS_WO), M, DM, 2048, 0, 0, 0}; pg8::StaticOrder S; S.init(M, DM, G, bid);
            pg8::EpiResid E{(l == 0) ? ap->in[0] : ap->out, ap->out, DM};
            pg8::gemm_phase<pg8::EpiResid, pg8::StaticOrder, true, PG8_SP2_>(lds, g, S, E);
#if defined(EXP_DUP_GEMM)
            if (l == 0 && (EXP_DUP_GEMM & 4)) { __syncthreads(); pg8::gemm_phase<pg8::EpiResid, pg8::StaticOrder, true, PG8_SP2_>(lds, g, S, E); }
#endif
        } break;
        case 8: {
            phase_norm2_router(lds, ap->out, ap->in[13] + l * DM, ap->in[14] + (size_t)l * DM * 16, WSP(bf16, WS_XN), WSP(float, WS_AFF), gw, NGW, tid, lane);
#if defined(EXP_DUP_A) || defined(EXP_DUP_N2)
            if (l == 0) { __syncthreads();
            phase_norm2_router(lds, ap->out, ap->in[13] + l * DM, ap->in[14] + (size_t)l * DM * 16, WSP(bf16, WS_XN), WSP(float, WS_AFF), gw, NGW, tid, lane);
            __syncthreads();
            cvt_expert_weights(lds, wsb, ap->in[15] + (size_t)l * NEXP * DM * EFF, ap->in[16] + (size_t)l * NEXP * DM * EFF, ap->in[17] + (size_t)l * NEXP * EFF * DM, gw, NGW, wave, lane);
            if (l + 1 < DEPTH) cvt_mixer_weights(lds, wsb, ap->in[2] + (size_t)(l + 1) * DM * 6720, ap->in[12] + (size_t)(l + 1) * 2048 * DM, gw, NGW, wave, lane);
 }
#endif
        } break;
        case 9: {
            if (bid < NB * NEXP) phase_topk(lds, WSP(float, WS_AFF), WSP(int, WS_IDX), WSP(float, WS_VAL), WSP(int, WS_INV), bid, tid, wave, lane);
            else if (G > NB * NEXP) { const int gw2 = (bid - NB * NEXP) * NWAVES + wave, NGW2 = (G - NB * NEXP) * NWAVES;
                cvt_expert_weights(lds, wsb, ap->in[15] + (size_t)l * NEXP * DM * EFF, ap->in[16] + (size_t)l * NEXP * DM * EFF, ap->in[17] + (size_t)l * NEXP * EFF * DM, gw2, NGW2, wave, lane);
                if (l + 1 < DEPTH) cvt_mixer_weights(lds, wsb, ap->in[2] + (size_t)(l + 1) * DM * 6720, ap->in[12] + (size_t)(l + 1) * 2048 * DM, gw2, NGW2, wave, lane); }
#if defined(EXP_DUP_A) || defined(EXP_DUP_TK)
            if (l == 0) { __syncthreads();
            for (int be = bid; be < NB * NEXP; be += G) phase_topk(lds, WSP(float, WS_AFF), WSP(int, WS_IDX), WSP(float, WS_VAL), WSP(int, WS_INV), be, tid, wave, lane);
 }
#endif
        } break;
        case 10: {
            pg8::Gemm g{WSP(bf16, WS_XN), WSP(bf16, WS_WGU), MEXP, 1024, DM, 2, 15, (size_t)1024 * 1024 * 2, WSP(int, WS_IDX), 14, SEQ}; pg8::StaticOrder S; S.init(MEXP, 1024, G, bid);
            pg8::EpiSwiglu E{WSP(bf16, WS_HMID), EFF};
            pg8::gemm_phase<pg8::EpiSwiglu, pg8::StaticOrder, true, PG8_SP2_, true>(lds, g, S, E);
#if defined(EXP_DUP_GEMM)
            if (l == 0 && (EXP_DUP_GEMM & 8)) { __syncthreads(); pg8::gemm_phase<pg8::EpiSwiglu, pg8::StaticOrder, true, PG8_SP2_, true>(lds, g, S, E); }
#endif
        } break;
        case 11: {
            pg8::Gemm g{WSP(bf16, WS_HMID), WSP(bf16, WS_WD), MEXP, 1024, EFF, 2, 15, (size_t)1024 * 512 * 2}; pg8::StaticOrder S; S.init(MEXP, 1024, G, bid);
            pg8::EpiBf16 E{WSP(bf16, WS_XG), 1024};
            pg8::gemm_phase<pg8::EpiBf16, pg8::StaticOrder, true, PG8_SP2_>(lds, g, S, E);
#if defined(EXP_DUP_GEMM)
            if (l == 0 && (EXP_DUP_GEMM & 16)) { __syncthreads(); pg8::gemm_phase<pg8::EpiBf16, pg8::StaticOrder, true, PG8_SP2_>(lds, g, S, E); }
#endif
        } break;
        default: {
            const bool last = (l + 1 == DEPTH);
            phase_combine(ap->out, ap->out, WSP(bf16, WS_XG), WSP(int, WS_INV), WSP(float, WS_VAL), last ? ap->in[18] : ap->in[1] + (size_t)(l + 1) * DM, WSP(bf16, WS_XN), last, gw, NGW, lane, PROBE_SCALE);

        } break;
        }
        if (ph + 1 < hi) GRID_BAR();
#if defined(EXP_XBAR)
        if (ph == 1) for (int xb_ = 0; xb_ < EXP_XBAR; ++xb_) GRID_BAR();
#endif
#if defined(PROBE_ANY)
        if (l == PROBE_L && k == PROBE_K1 && blockIdx.x == 0 && threadIdx.x == 0) { const unsigned long long t1_ = __builtin_amdgcn_s_memrealtime(), t0_ = ((unsigned long long*)(wsb + WS_CTL))[1100];
            const unsigned bk_ = (unsigned)((t1_ - t0_) / PROBE_TICKS); *(volatile float*)PROBE_PTR = (float)(bk_ > 40u ? 40u : bk_) * (1.0f / 40.0f); }
#endif
    }
#undef WSP
}

extern "C" void kernel_launch(void* const* d_in, const int* in_sizes, int n_in, void* d_out, int out_size, void* d_ws, size_t ws_size, hipStream_t stream) {
    static int grid = 0;
    if (grid == 0) {
        if (n_in != 19 || in_sizes[0] != M * DM || out_size != M * DM || ws_size < WS_END) { fprintf(stderr, "kernel_launch: unexpected shapes (n_in %d, in0 %d, out %d, ws %zu); nothing launched\n", n_in, n_in > 0 ? in_sizes[0] : -1, out_size, ws_size); grid = -1; return; }
        int dev = 0, cus = 0;
        if (hipGetDevice(&dev) != hipSuccess || hipDeviceGetAttribute(&cus, hipDeviceAttributeMultiprocessorCount, dev) != hipSuccess) { grid = -1; return; }
        if (hipFuncSetAttribute((const void*)fwd_kernel, hipFuncAttributeMaxDynamicSharedMemorySize, LDS_BYTES) != hipSuccess) { fprintf(stderr, "kernel_launch: hipFuncSetAttribute failed\n"); grid = -1; return; }
        (void)hipGetLastError();
        grid = cus;
    }
    if (grid < 0) return;
    (void)hipMemsetAsync((char*)d_ws + WS_CTL, 0, CTL_ZERO_BYTES, stream);
    Args a{};
    for (int i = 0; i < 19; ++i) a.in[i] = (const float*)d_in[i];
    a.out = (float*)d_out; a.ws = (unsigned char*)d_ws;
#if MK_ONE_LAUNCH
    a.ph_lo = 0; a.ph_hi = NPHASE;
    hipLaunchKernelGGL(fwd_kernel, dim3(grid), dim3(NWAVES * 64), LDS_BYTES, stream, a);
#else
    for (int p = 0; p < NPHASE; ++p) { a.ph_lo = p; a.ph_hi = p + 1; hipLaunchKernelGGL(fwd_kernel, dim3(grid), dim3(NWAVES * 64), LDS_BYTES, stream, a); }
#endif
}
```

```cpp
#include <hip/hip_runtime.h>
#include <cstdio>
#include <cstdint>
namespace pg8 {
#define PG8_LAS __attribute__((address_space(3)))
typedef unsigned short bf16_t;
typedef short bf16x8 __attribute__((ext_vector_type(8)));
typedef float f32x4 __attribute__((ext_vector_type(4)));
typedef unsigned u32x4 __attribute__((ext_vector_type(4)));
constexpr int BM = 256, BK = 64, HALF = 128, HTB = HALF * BK * 2  , STAGE_BYTES = 8 * HTB, NXCD = 8, WGM = 8;

__host__ __device__ __forceinline__ int lds_byte(int r, int c) { const int st = (r >> 4) * 2 + (c >> 5), rr = r & 15, cc = c & 31, ob = rr * 64 + cc * 2; return st * 1024 + (ob ^ (((ob >> 9) & 1) << 5)); }
__host__ __device__ __forceinline__ void stage_rc(int b, int& R, int& C) { const int st = b / 1024, sb = b % 1024, swz = sb ^ (((sb >> 9) & 1) << 5); R = (st >> 1) * 16 + swz / 64; C = (st & 1) * 32 + (swz % 64) / 2; }
__host__ __device__ __forceinline__ int perm32(int rho) { const int n = rho >> 4, i = rho & 15; return 8 * (i >> 2) + 4 * n + (i & 3); }

struct Unit { int pm, pn; };
struct Gemm { const bf16_t* A; const bf16_t* Bt; int M, N, K; int bshift, bmask; size_t bstride; const int* gidx = nullptr; int gshift = 0, gmul = 0;
    __device__ __forceinline__ size_t grp_off(int pm) const { return (size_t)((pm >> bshift) & bmask) * bstride; } };

struct StaticOrder {
    int nM, nN, nwg, G, c;
    __host__ __device__ void init(int M, int N, int G_, int c_) { nM = M / BM; nN = N / BM; nwg = nM * nN; G = G_; c = c_; }
    __host__ __device__ bool next(int i, Unit& u) const {
        const long L = (long)i * G + c; if (L >= nwg) return false;
        int wgid = (int)L; { const int q = nwg / NXCD, r = nwg % NXCD, xcd = wgid % NXCD, off = wgid / NXCD; wgid = (xcd < r ? xcd * (q + 1) : r * (q + 1) + (xcd - r) * q) + off; }
        const int nig = WGM * nN, gid = wgid / nig, fm = gid * WGM, gsz = (nM - fm) < WGM ? (nM - fm) : WGM;
        u.pm = fm + ((wgid % nig) % gsz); u.pn = (wgid % nig) / gsz; return true;
    }
    __device__ __forceinline__ void a_ready(const Unit&) const {}
    __device__ __forceinline__ void done(const Unit&) const {}
};

__device__ __forceinline__ unsigned cvt_pk_bf16(float lo, float hi) { unsigned r; asm volatile("v_cvt_pk_bf16_f32 %0, %1, %2" : "=v"(r) : "v"(lo), "v"(hi)); return r; }
__device__ __forceinline__ float silu_f(float x) { return x * __builtin_amdgcn_rcpf(1.0f + __builtin_amdgcn_exp2f(-1.4426950408889634f * x)); }
struct EpiBf16 {
    static constexpr bool PERM = true, AFTER_DRAIN = false;
    bf16_t* O; int ldc;
    __device__ __forceinline__ void operator()(const f32x4 (&acc)[2][2][4][2], const Unit& u, int wr, int wc, int fr, int fq) const {
        const int row0 = u.pm * BM + wr * 64 + fr; const int col0 = u.pn * BM + wc * 32 + 8 * fq;
#pragma unroll
        for (int ai = 0; ai < 2; ++ai)
#pragma unroll
            for (int m = 0; m < 4; ++m) { bf16_t* rowp = O + (size_t)(row0 + ai * HALF + m * 16) * ldc + col0;
#pragma unroll
                for (int bj = 0; bj < 2; ++bj) { const f32x4 v0 = acc[ai][bj][m][0], v1 = acc[ai][bj][m][1];
                    u32x4 w; w.x = cvt_pk_bf16(v0[0], v0[1]); w.y = cvt_pk_bf16(v0[2], v0[3]); w.z = cvt_pk_bf16(v1[0], v1[1]); w.w = cvt_pk_bf16(v1[2], v1[3]);
                    *(u32x4*)(rowp + bj * HALF) = w; } }
    }
};
struct EpiRawA {
    static constexpr bool PERM = true, AFTER_DRAIN = false;
    bf16_t* O; float* S;
    __device__ __forceinline__ void operator()(const f32x4 (&acc)[2][2][4][2], const Unit& u, int wr, int wc, int fr, int fq) const {
        const int row0 = u.pm * BM + wr * 64 + fr;
        if (u.pn < 18) {
            const int col0 = u.pn * BM + wc * 32 + 8 * fq;
#pragma unroll
            for (int ai = 0; ai < 2; ++ai)
#pragma unroll
                for (int m = 0; m < 4; ++m) { bf16_t* rowp = O + (size_t)(row0 + ai * HALF + m * 16) * 4608 + col0;
#pragma unroll
                    for (int bj = 0; bj < 2; ++bj) { const f32x4 v0 = acc[ai][bj][m][0], v1 = acc[ai][bj][m][1];
                        u32x4 w; w.x = cvt_pk_bf16(v0[0], v0[1]); w.y = cvt_pk_bf16(v0[2], v0[3]); w.z = cvt_pk_bf16(v1[0], v1[1]); w.w = cvt_pk_bf16(v1[2], v1[3]);
                        *(u32x4*)(rowp + bj * HALF) = w; } }
        } else if (wc < 2) {
            const int col0 = wc * 32 + 8 * fq;
#pragma unroll
            for (int ai = 0; ai < 2; ++ai)
#pragma unroll
                for (int m = 0; m < 4; ++m) { float* sp = S + (size_t)(row0 + ai * HALF + m * 16) * 64 + col0;
                    *(f32x4*)sp = acc[ai][0][m][0]; *(f32x4*)(sp + 4) = acc[ai][0][m][1]; }
        }
    }
};
struct EpiResid {
    static constexpr bool PERM = false, AFTER_DRAIN = false;
    const float* base; float* out; int ldc;
    __device__ __forceinline__ void operator()(const f32x4 (&acc)[2][2][4][2], const Unit& u, int wr, int wc, int fr, int fq) const {
        const int row0 = u.pm * BM + wr * 64 + fr, col0 = u.pn * BM + wc * 32 + 4 * fq;
#pragma unroll
        for (int ai = 0; ai < 2; ++ai)
#pragma unroll
            for (int mp = 0; mp < 2; ++mp) { f32x4 rv[2][2][2];
#pragma unroll
                for (int mm = 0; mm < 2; ++mm) { const size_t off = (size_t)(row0 + ai * HALF + (2 * mp + mm) * 16) * ldc + col0;
#pragma unroll
                    for (int bj = 0; bj < 2; ++bj)
#pragma unroll
                        for (int n = 0; n < 2; ++n) rv[mm][bj][n] = *(const f32x4*)(base + off + bj * HALF + n * 16); }
                asm volatile("" ::: "memory");
#pragma unroll
                for (int mm = 0; mm < 2; ++mm) { const size_t off = (size_t)(row0 + ai * HALF + (2 * mp + mm) * 16) * ldc + col0;
#pragma unroll
                    for (int bj = 0; bj < 2; ++bj)
#pragma unroll
                        for (int n = 0; n < 2; ++n) *(f32x4*)(out + off + bj * HALF + n * 16) = rv[mm][bj][n] + acc[ai][bj][2 * mp + mm][n]; }
                asm volatile("" ::: "memory"); }
    }
};
struct EpiResidB {
    static constexpr bool PERM = true, AFTER_DRAIN = false;
    const float* basef; const bf16_t* baseb; bf16_t* out; int ldc;
    __device__ __forceinline__ void operator()(const f32x4 (&acc)[2][2][4][2], const Unit& u, int wr, int wc, int fr, int fq) const {
        const int row0 = u.pm * BM + wr * 64 + fr, col0 = u.pn * BM + wc * 32 + 8 * fq;
#pragma unroll
        for (int ai = 0; ai < 2; ++ai)
#pragma unroll
            for (int mp = 0; mp < 2; ++mp) { f32x4 rv[2][2][2];
                if (basef) {
#pragma unroll
                    for (int mm = 0; mm < 2; ++mm) { const size_t off = (size_t)(row0 + ai * HALF + (2 * mp + mm) * 16) * ldc + col0;
#pragma unroll
                        for (int bj = 0; bj < 2; ++bj) { rv[mm][bj][0] = *(const f32x4*)(basef + off + bj * HALF); rv[mm][bj][1] = *(const f32x4*)(basef + off + bj * HALF + 4); } }
                } else { u32x4 rb[2][2];
#pragma unroll
                    for (int mm = 0; mm < 2; ++mm) { const size_t off = (size_t)(row0 + ai * HALF + (2 * mp + mm) * 16) * ldc + col0;
#pragma unroll
                        for (int bj = 0; bj < 2; ++bj) rb[mm][bj] = *(const u32x4*)(baseb + off + bj * HALF); }
#pragma unroll
                    for (int mm = 0; mm < 2; ++mm)
#pragma unroll
                        for (int bj = 0; bj < 2; ++bj) { const u32x4 t = rb[mm][bj];
                            rv[mm][bj][0] = (f32x4){__uint_as_float(t.x << 16), __uint_as_float(t.x & 0xffff0000u), __uint_as_float(t.y << 16), __uint_as_float(t.y & 0xffff0000u)};
                            rv[mm][bj][1] = (f32x4){__uint_as_float(t.z << 16), __uint_as_float(t.z & 0xffff0000u), __uint_as_float(t.w << 16), __uint_as_float(t.w & 0xffff0000u)}; } }
                asm volatile("" ::: "memory");
#pragma unroll
                for (int mm = 0; mm < 2; ++mm) { const size_t off = (size_t)(row0 + ai * HALF + (2 * mp + mm) * 16) * ldc + col0;
#pragma unroll
                    for (int bj = 0; bj < 2; ++bj) { const f32x4 v0 = rv[mm][bj][0] + acc[ai][bj][2 * mp + mm][0], v1 = rv[mm][bj][1] + acc[ai][bj][2 * mp + mm][1];
                        u32x4 w; w.x = cvt_pk_bf16(v0[0], v0[1]); w.y = cvt_pk_bf16(v0[2], v0[3]); w.z = cvt_pk_bf16(v1[0], v1[1]); w.w = cvt_pk_bf16(v1[2], v1[3]);
                        *(u32x4*)(out + off + bj * HALF) = w; } }
                asm volatile("" ::: "memory"); }
    }
};
struct EpiSwiglu {
    static constexpr bool PERM = true, AFTER_DRAIN = false;
    bf16_t* O; int ldh;
    __device__ __forceinline__ void operator()(const f32x4 (&acc)[2][2][4][2], const Unit& u, int wr, int wc, int fr, int fq) const {
        const int row0 = u.pm * BM + wr * 64 + fr; const int f0 = (u.pn * BM + wc * 32 + 8 * fq) >> 1;
        typedef unsigned u32x2 __attribute__((ext_vector_type(2)));
#pragma unroll
        for (int ai = 0; ai < 2; ++ai)
#pragma unroll
            for (int m = 0; m < 4; ++m) { bf16_t* rowp = O + (size_t)(row0 + ai * HALF + m * 16) * ldh + f0;
#pragma unroll
                for (int bj = 0; bj < 2; ++bj) { const f32x4 v0 = acc[ai][bj][m][0], v1 = acc[ai][bj][m][1];
                    u32x2 w; w.x = cvt_pk_bf16(silu_f(v0[0]) * v0[1], silu_f(v0[2]) * v0[3]); w.y = cvt_pk_bf16(silu_f(v1[0]) * v1[1], silu_f(v1[2]) * v1[3]);
                    *(u32x2*)(rowp + bj * (HALF / 2)) = w; } }
    }
};
template <class Epi, class Sched, bool ALIGN_EPI = false, bool SP2 = false, bool GATHER = false>
__device__ __forceinline__ void gemm_phase(PG8_LAS unsigned char* lds, const Gemm g, const Sched& S, const Epi& E) {
    int tid_o = threadIdx.x; asm volatile("" : "+v"(tid_o));
    const int tid = tid_o, wid = __builtin_amdgcn_readfirstlane(tid >> 6), lane = tid & 63, wr = wid >> 2, wc = wid & 3, fr = lane & 15, fq = lane >> 4;
    const int K = g.K, nt = K / BK;
    unsigned voffA[2], voffB[2];
#pragma unroll
    for (int i = 0; i < 2; ++i) { int R, C; stage_rc(tid * 16 + i * 8192, R, C); const int Rb = Epi::PERM ? ((R & ~31) + perm32(R & 31)) : R;
        voffA[i] = (unsigned)(R * K + C) * 2u; voffB[i] = (unsigned)(Rb * K + C) * 2u; }
    const size_t kstep = (size_t)(BK * 2);
    const size_t hstep = (size_t)HALF * K * 2;
    const size_t tstep = 2 * hstep;
    const size_t hstepA = GATHER ? (size_t)0 : hstep, tstepA = GATHER ? (size_t)0 : tstep;
    unsigned gC[2][2]; int gI[2][2];
    auto g_load = [&](const Unit& u) { _Pragma("unroll") for (int h = 0; h < 2; ++h) _Pragma("unroll") for (int i = 0; i < 2; ++i) { int R, C; stage_rc(tid * 16 + i * 8192, R, C);
        gI[h][i] = g.gidx[u.pm * BM + h * HALF + R]; } };
    auto g_make = [&](const Unit& u, unsigned (&o)[2][2]) { _Pragma("unroll") for (int h = 0; h < 2; ++h) _Pragma("unroll") for (int i = 0; i < 2; ++i) { int R, C; stage_rc(tid * 16 + i * 8192, R, C);
        const int row = u.pm * BM + h * HALF + R; o[h][i] = (unsigned)(((row >> g.gshift) * g.gmul + gI[h][i]) * K + C) * 2u; } };
    const unsigned ldsw = (unsigned)wid * 1024u;
    const int aoff = lds_byte(wr * 64 + fr, fq * 8), boff = lds_byte(wc * 32 + fr, fq * 8);
#define PG8_SA(b, h) (((b) * 2 + (h)) * HTB)
#define PG8_SB(b, h) ((4 + (b) * 2 + (h)) * HTB)
#define PG8_STAGE(bufoff, gbase, voff) do { _Pragma("unroll") for (int _i = 0; _i < 2; ++_i) \
        __builtin_amdgcn_global_load_lds((const unsigned*)((const char*)(gbase) + (voff)[_i]), (PG8_LAS unsigned*)(lds + (bufoff) + ldsw + _i * 8192), 16, 0, 0); } while (0)
#define PG8_LDA(dst, b, h) do { _Pragma("unroll") for (int m = 0; m < 4; ++m) _Pragma("unroll") for (int k = 0; k < 2; ++k) dst[m][k] = *(const PG8_LAS bf16x8*)(lds + PG8_SA(b, h) + aoff + m * 2048 + k * 1024); } while (0)
#define PG8_LDB(dst, b, h) do { _Pragma("unroll") for (int n = 0; n < 2; ++n) _Pragma("unroll") for (int k = 0; k < 2; ++k) dst[n][k] = *(const PG8_LAS bf16x8*)(lds + PG8_SB(b, h) + boff + n * 2048 + k * 1024); } while (0)
#define PG8_MMA(ai, bj, At, Bt) do { __builtin_amdgcn_s_setprio(1); _Pragma("unroll") for (int m = 0; m < 4; ++m) _Pragma("unroll") for (int n = 0; n < 2; ++n) _Pragma("unroll") for (int k = 0; k < 2; ++k) \
        acc[ai][bj][m][n] = __builtin_amdgcn_mfma_f32_16x16x32_bf16(Bt[n][k], At[m][k], acc[ai][bj][m][n], 0, 0, 0); __builtin_amdgcn_s_setprio(0); } while (0)
#define PG8_WAIT_V(n) asm volatile("s_waitcnt vmcnt(" #n ")" ::: "memory")
#define PG8_WAIT_L(n) asm volatile("s_waitcnt lgkmcnt(" #n ")" ::: "memory")
#define PG8_BAR __builtin_amdgcn_s_barrier()
#define PG8_SCHED __builtin_amdgcn_sched_barrier(0)
    Unit cur, nxt; int ui = 0;
    if (!S.next(0, cur)) return;
    f32x4 acc[2][2][4][2];
#pragma unroll
    for (int a = 0; a < 2; ++a)
#pragma unroll
        for (int b = 0; b < 2; ++b)
#pragma unroll
            for (int m = 0; m < 4; ++m)
#pragma unroll
                for (int n = 0; n < 2; ++n) acc[a][b][m][n] = (f32x4){0.f, 0.f, 0.f, 0.f};
    bf16x8 At[4][2], B0[2][2], B1[2][2];
    const char* cA = (const char*)g.A + (size_t)cur.pm * tstepA; const char* cB = (const char*)g.Bt + g.grp_off(cur.pm) + (size_t)cur.pn * tstep;
    if constexpr (GATHER) { g_load(cur); g_make(cur, gC); }
#define PG8_VA(h) (GATHER ? gC[h] : voffA)
    S.a_ready(cur);
    if constexpr (SP2) {
        PG8_STAGE(PG8_SB(0, 0), cB, voffB); PG8_STAGE(PG8_SB(0, 1), cB + hstep, voffB); PG8_STAGE(PG8_SA(0, 0), cA, PG8_VA(0)); PG8_STAGE(PG8_SA(0, 1), cA + hstepA, PG8_VA(1));
        if (wr == 1) PG8_BAR;
        PG8_WAIT_V(2); PG8_BAR;
        PG8_STAGE(PG8_SB(1, 0), cB + kstep, voffB); PG8_STAGE(PG8_SA(1, 0), cA + kstep, PG8_VA(0)); PG8_STAGE(PG8_SB(1, 1), cB + hstep + kstep, voffB);
        PG8_WAIT_V(6); PG8_BAR;
    } else {
        PG8_STAGE(PG8_SB(0, 0), cB, voffB); PG8_STAGE(PG8_SA(0, 0), cA, PG8_VA(0)); PG8_STAGE(PG8_SB(0, 1), cB + hstep, voffB); PG8_STAGE(PG8_SA(0, 1), cA + hstepA, PG8_VA(1));
        if (wr == 1) PG8_BAR;
        PG8_WAIT_V(4); PG8_BAR;
        PG8_STAGE(PG8_SB(1, 0), cB + kstep, voffB); PG8_STAGE(PG8_SA(1, 0), cA + kstep, PG8_VA(0)); PG8_STAGE(PG8_SB(1, 1), cB + hstep + kstep, voffB);
        PG8_WAIT_V(6); PG8_BAR;
    }
    for (;;) {
        const bool has_next = S.next(ui + 1, nxt);
        const char* nA = has_next ? (const char*)g.A + (size_t)nxt.pm * tstepA : cA; const char* nB = has_next ? (const char*)g.Bt + g.grp_off(nxt.pm) + (size_t)nxt.pn * tstep : cB;
        if constexpr (GATHER) { if (has_next) g_load(nxt); }
        for (int t = 0; t < nt; t += 2) {
            const bool last = (t == nt - 2);
            const char* a1 = cA + (size_t)(t + 1) * kstep;
            const char* a2 = last ? nA : cA + (size_t)(t + 2) * kstep; const char* b2 = last ? nB : cB + (size_t)(t + 2) * kstep;
            const char* a3 = a2 + kstep; const char* b3 = b2 + kstep;
            if (last && has_next) S.a_ready(nxt);
#define PG8_GS() do { if constexpr (GATHER) { if (last && has_next) g_make(nxt, gC); } } while (0)
            if constexpr (SP2) {
            PG8_LDB(B0, 0, 0); PG8_LDB(B1, 0, 1); PG8_SCHED; PG8_LDA(At, 0, 0); PG8_STAGE(PG8_SA(1, 1), a1 + hstepA, PG8_VA(1)); PG8_GS();
            PG8_WAIT_V(8); PG8_WAIT_L(0); PG8_BAR; PG8_MMA(0, 0, At, B0); PG8_MMA(0, 1, At, B1); PG8_BAR; PG8_SCHED;
            PG8_LDA(At, 0, 1); PG8_STAGE(PG8_SB(0, 0), b2, voffB); PG8_STAGE(PG8_SB(0, 1), b2 + hstep, voffB); PG8_STAGE(PG8_SA(0, 0), a2, PG8_VA(0));
            PG8_WAIT_V(8); PG8_WAIT_L(0); PG8_BAR; PG8_MMA(1, 0, At, B0); PG8_MMA(1, 1, At, B1); PG8_BAR; PG8_SCHED;
            PG8_LDB(B0, 1, 0); PG8_LDB(B1, 1, 1); PG8_SCHED; PG8_LDA(At, 1, 0); PG8_STAGE(PG8_SA(0, 1), a2 + hstepA, PG8_VA(1));
            PG8_WAIT_V(8); PG8_WAIT_L(0); PG8_BAR; PG8_MMA(0, 0, At, B0); PG8_MMA(0, 1, At, B1); PG8_BAR; PG8_SCHED;
            PG8_LDA(At, 1, 1); PG8_STAGE(PG8_SB(1, 0), b3, voffB); PG8_STAGE(PG8_SB(1, 1), b3 + hstep, voffB); PG8_STAGE(PG8_SA(1, 0), a3, PG8_VA(0));
            PG8_WAIT_V(8); PG8_WAIT_L(0); PG8_BAR; PG8_MMA(1, 0, At, B0); PG8_MMA(1, 1, At, B1); PG8_BAR; PG8_SCHED;
            } else {
            PG8_LDB(B0, 0, 0); PG8_SCHED; PG8_LDA(At, 0, 0); PG8_STAGE(PG8_SA(1, 1), a1 + hstepA, PG8_VA(1)); PG8_GS();
            PG8_WAIT_L(8); PG8_BAR; PG8_WAIT_L(0); PG8_MMA(0, 0, At, B0); PG8_BAR; PG8_SCHED;
            PG8_LDB(B1, 0, 1); PG8_STAGE(PG8_SB(0, 0), b2, voffB);
            PG8_BAR; PG8_WAIT_L(0); PG8_MMA(0, 1, At, B1); PG8_BAR;
            PG8_LDA(At, 0, 1); PG8_STAGE(PG8_SA(0, 0), a2, PG8_VA(0));
            PG8_BAR; PG8_WAIT_L(0); PG8_MMA(1, 0, At, B0); PG8_BAR; PG8_SCHED;
            PG8_STAGE(PG8_SB(0, 1), b2 + hstep, voffB);
            PG8_WAIT_V(6); PG8_BAR; PG8_MMA(1, 1, At, B1); PG8_BAR;
            PG8_LDB(B0, 1, 0); PG8_SCHED; PG8_LDA(At, 1, 0); PG8_STAGE(PG8_SA(0, 1), a2 + hstepA, PG8_VA(1));
            PG8_WAIT_L(8); PG8_BAR; PG8_WAIT_L(0); PG8_MMA(0, 0, At, B0); PG8_BAR; PG8_SCHED;
            PG8_LDB(B1, 1, 1); PG8_STAGE(PG8_SB(1, 0), b3, voffB);
            PG8_BAR; PG8_WAIT_L(0); PG8_MMA(0, 1, At, B1); PG8_BAR;
            PG8_LDA(At, 1, 1); PG8_STAGE(PG8_SA(1, 0), a3, PG8_VA(0));
            PG8_BAR; PG8_WAIT_L(0); PG8_MMA(1, 0, At, B0); PG8_BAR; PG8_SCHED;
            PG8_STAGE(PG8_SB(1, 1), b3 + hstep, voffB);
            PG8_WAIT_V(6); PG8_BAR; PG8_MMA(1, 1, At, B1); PG8_BAR;
            }
        }
        if constexpr (ALIGN_EPI) { if (wr == 0) PG8_BAR; }
        if constexpr (!Epi::AFTER_DRAIN) { E(acc, cur, wr, wc, fr, fq); S.done(cur); }
        if (!has_next) break;
#pragma unroll
        for (int a = 0; a < 2; ++a)
#pragma unroll
            for (int b = 0; b < 2; ++b)
#pragma unroll
                for (int m = 0; m < 4; ++m)
#pragma unroll
                    for (int n = 0; n < 2; ++n) acc[a][b][m][n] = (f32x4){0.f, 0.f, 0.f, 0.f};
        cur = nxt; cA = nA; cB = nB; ++ui;
        if constexpr (ALIGN_EPI) { if (wr == 1) PG8_BAR; }
    }
    PG8_WAIT_V(0);
    if constexpr (!ALIGN_EPI) { if (wr == 0) PG8_BAR; }
    PG8_BAR;
    if constexpr (Epi::AFTER_DRAIN) { E.fused(acc, cur, wr, wc, fr, fq, lds, wid, lane); S.done(cur); }
#undef PG8_SA
#undef PG8_VA
#undef PG8_GS
#undef PG8_SB
#undef PG8_STAGE
#undef PG8_LDA
#undef PG8_LDB
#undef PG8_MMA
#undef PG8_WAIT_V
#undef PG8_WAIT_L
#undef PG8_BAR
#undef PG8_SCHED
}
}
#define GAS __attribute__((address_space(1)))
#define LAS __attribute__((address_space(3)))
typedef unsigned short bf16;
typedef unsigned v4u __attribute__((ext_vector_type(4)));
typedef float f32x4 __attribute__((ext_vector_type(4)));
typedef short bf16x8 __attribute__((ext_vector_type(8)));
typedef GAS unsigned gu32;
typedef GAS unsigned long long gu64;
#define RLX_AGENT __ATOMIC_RELAXED, __HIP_MEMORY_SCOPE_AGENT
#define LDS_WAIT() asm volatile("s_waitcnt lgkmcnt(0)" ::: "memory")
#define VM_WAIT() asm volatile("s_waitcnt vmcnt(0)" ::: "memory")
__device__ __forceinline__ unsigned long long rt() { return __builtin_amdgcn_s_memrealtime(); }
__device__ __forceinline__ unsigned f2bf(float f) { unsigned u = __builtin_bit_cast(unsigned, f); return (u + 0x7fffu + ((u >> 16) & 1u)) >> 16; }
__device__ __forceinline__ unsigned pk2(float lo, float hi) { return f2bf(lo) | (f2bf(hi) << 16); }
#define XB_TMO      128
#define XB_XCNT(j)  (256  + 64 * (j))
#define XB_XSUB(j)  (1280 + 64 * (j))
#define XB_XGEN(j)  (2304 + 64 * (j))
#define XB_TOP      3328
#define XB_TOPGEN   3392
#define XCD_BAR_WORDS 3456
#define XB_SPIN_CAP (1u << 18)

__device__ __forceinline__ unsigned xb_ld(unsigned* p)              { return __hip_atomic_load(p, __ATOMIC_RELAXED, __HIP_MEMORY_SCOPE_AGENT); }
__device__ __forceinline__ unsigned xb_add(unsigned* p, unsigned v) { return __hip_atomic_fetch_add(p, v, __ATOMIC_RELAXED, __HIP_MEMORY_SCOPE_AGENT); }
__device__ __forceinline__ unsigned xb_xcc_id() { return (unsigned)__builtin_amdgcn_s_getreg((3 << 11) | 20) & 0xFu; }
#define XB_SPIN(cond, bar) do { unsigned _sp = 0; while (cond) { __builtin_amdgcn_s_sleep(1); \
    if ((++_sp & 255u) == 0u) { if (xb_ld(&(bar)[XB_TMO])) break; if (_sp > XB_SPIN_CAP) { atomicAdd(&(bar)[XB_TMO], 1u); break; } } } } while (0)

struct XcdBarrier {
    unsigned* bar; unsigned x;
    volatile LAS unsigned* st;
};

__device__ __forceinline__ XcdBarrier xcd_barrier_post(unsigned* bar, volatile LAS unsigned* st) {
    XcdBarrier b; b.bar = bar; b.x = xb_xcc_id(); b.st = st;
    if (threadIdx.x == 0) (void)xb_add(&bar[XB_XCNT(b.x)], 1u);
    return b;
}
__device__ __forceinline__ void xcd_barrier_complete(unsigned* bar, unsigned x, unsigned& nloc, unsigned& nx) {
    const unsigned G = gridDim.x * gridDim.y * gridDim.z;
    unsigned sum, cnt, mine, sp = 0u;
    for (;;) {
        sum = 0u; cnt = 0u; mine = 0u;
#pragma unroll
        for (unsigned j = 0; j < 16; ++j) { const unsigned c = xb_ld(&bar[XB_XCNT(j)]); sum += c; cnt += (c > 0u) ? 1u : 0u; mine = (j == x) ? c : mine; }
        if (sum == G) break;
        __builtin_amdgcn_s_sleep(1);
        if ((++sp & 255u) == 0u) { if (xb_ld(&bar[XB_TMO])) break; if (sp > XB_SPIN_CAP) { atomicAdd(&bar[XB_TMO], 1u); break; } }
    }
    nloc = mine > 0u ? mine : 1u; nx = cnt > 0u ? cnt : 1u;
}

__device__ __forceinline__ void xcd_barrier(const XcdBarrier& b) {
    asm volatile("s_waitcnt vmcnt(0)" ::: "memory");
    __syncthreads();
    if (threadIdx.x == 0) {
        unsigned* bar = b.bar;
        __builtin_amdgcn_s_waitcnt(0);
        unsigned nloc = b.st[0], nx = b.st[1];
        if (nloc == 0u) { xcd_barrier_complete(bar, b.x, nloc, nx); b.st[0] = nloc; b.st[1] = nx; }
        const unsigned old = xb_add(&bar[XB_XSUB(b.x)], 1u);
        const unsigned gen = old / nloc;
        if (old + 1u == (gen + 1u) * nloc) {
            __builtin_amdgcn_fence(__ATOMIC_RELEASE, "agent");
            asm volatile("s_waitcnt vmcnt(0)" ::: "memory");
            const unsigned og = xb_add(&bar[XB_TOP], 1u);
            const unsigned tg = og / nx;
            if (og + 1u == (tg + 1u) * nx) xb_add(&bar[XB_TOPGEN], 1u);
            else XB_SPIN(xb_ld(&bar[XB_TOPGEN]) == tg, bar);
            __builtin_amdgcn_fence(__ATOMIC_ACQUIRE, "agent");
            xb_add(&bar[XB_XGEN(b.x)], 1u);
            asm volatile("s_waitcnt vmcnt(0)" ::: "memory");
        } else {
            XB_SPIN(xb_ld(&bar[XB_XGEN(b.x)]) == gen, bar);
            __builtin_amdgcn_fence(__ATOMIC_ACQUIRE, "agent");
            asm volatile("s_waitcnt vmcnt(0)" ::: "memory");
        }
    }
    __syncthreads();
}
constexpr int NB = 4, SEQ = 8192, DM = 1024, M = NB * SEQ, DEPTH = 2;
constexpr int NCHUNK = SEQ / 64;
constexpr int CONV_CH = 4608, NWA = 4864  , NGATE = 2048, NEXP = 16, EFF = 512, CAP = 1024;
constexpr int MEXP = NB * NEXP * CAP;
constexpr float EPS = 1e-6f;
constexpr int NWAVES = 8;
constexpr size_t MiB = 1u << 20;
constexpr size_t WS_CTL = 0, CTL_ZERO_BYTES = 1 * MiB;
constexpr size_t WS_WA = 1 * MiB;
constexpr size_t WS_WB = 11 * MiB;
constexpr size_t WS_WO = 15 * MiB;
constexpr size_t WS_XN = 19 * MiB;
constexpr size_t WS_RAW = 83 * MiB;
constexpr size_t WS_SCAL = 371 * MiB;
constexpr size_t WS_OG = 19 * MiB;
constexpr size_t WS_YS = 443 * MiB;
constexpr size_t WS_XN2 = 83 * MiB;
constexpr size_t WS_GATES = 147 * MiB;
constexpr size_t WS_MIXED = 147 * MiB;
constexpr size_t WS_WGU = 83 * MiB;
constexpr size_t WS_WD = 115 * MiB;
constexpr size_t WS_XG = 131 * MiB;
constexpr size_t WS_HMID = 259 * MiB;
constexpr size_t WS_AFF = 323 * MiB;
constexpr size_t WS_IDX = 325 * MiB;
constexpr size_t WS_VAL = 326 * MiB;
constexpr size_t WS_INV = 327 * MiB;
constexpr size_t WS_H = 443 * MiB;
constexpr size_t WS_END = 507 * MiB;
constexpr int CW_TMO = 0, CW_BAR = 4096;
constexpr int LDS_BYTES = 163840;
constexpr int MISC_OFF = LDS_BYTES - 256;

typedef short bf16x8 __attribute__((ext_vector_type(8)));
typedef short bf16x4 __attribute__((ext_vector_type(4)));
typedef float f32x4 __attribute__((ext_vector_type(4)));
typedef float f32x2 __attribute__((ext_vector_type(2)));
typedef unsigned u32x4 __attribute__((ext_vector_type(4)));
typedef unsigned u32x2 __attribute__((ext_vector_type(2)));
typedef __bf16 bf16x2_t __attribute__((ext_vector_type(2)));
typedef short s16x2 __attribute__((ext_vector_type(2)));

__device__ __forceinline__ float bf2f(unsigned short v) { return __uint_as_float((unsigned)v << 16); }
__device__ __forceinline__ float bf2f_s(short v) { return __uint_as_float((unsigned)(unsigned short)v << 16); }
__device__ __forceinline__ unsigned pkbf(float lo, float hi) { f32x2 v = {lo, hi}; bf16x2_t b = __builtin_convertvector(v, bf16x2_t); return __builtin_bit_cast(unsigned, b); }
__device__ __forceinline__ unsigned short f2bf1(float f) { return (unsigned short)(pkbf(f, 0.f) & 0xffffu); }
__device__ __forceinline__ float silu(float x) { return x * __builtin_amdgcn_rcpf(1.0f + __builtin_amdgcn_exp2f(-1.4426950408889634f * x)); }
__device__ __forceinline__ float softplus_f(float x) { return x > 20.f ? x : log1pf(expf(x)); }
__device__ __forceinline__ float sigmoid_f(float x) { return 1.0f / (1.0f + expf(-x)); }
__device__ __forceinline__ void atomic_add_bf16x2(bf16* p, float a, float b) {
    (void)__builtin_amdgcn_global_atomic_fadd_v2bf16((GAS s16x2*)p, __builtin_bit_cast(s16x2, pkbf(a, b)));
}
template <int CTRL> __device__ __forceinline__ float dppf(float v) { return __builtin_bit_cast(float, __builtin_amdgcn_update_dpp(0, __builtin_bit_cast(int, v), CTRL, 0xF, 0xF, true)); }
__device__ __forceinline__ float wave_sum(float v) {
    v += dppf<0xB1>(v); v += dppf<0x4E>(v); v += dppf<0x141>(v); v += dppf<0x140>(v);
    const float s0 = __builtin_bit_cast(float, __builtin_amdgcn_readlane(__builtin_bit_cast(int, v), 0)), s1 = __builtin_bit_cast(float, __builtin_amdgcn_readlane(__builtin_bit_cast(int, v), 16));
    const float s2 = __builtin_bit_cast(float, __builtin_amdgcn_readlane(__builtin_bit_cast(int, v), 32)), s3 = __builtin_bit_cast(float, __builtin_amdgcn_readlane(__builtin_bit_cast(int, v), 48));
    return (s0 + s1) + (s2 + s3);
}

__device__ __forceinline__ float softplus_fast(float x) { const float e = __builtin_amdgcn_exp2f(1.4426950408889634f * fminf(x, 20.f));
    const float lg = (e < 1e-3f) ? e * (1.0f - 0.5f * e) : 0.6931471805599453f * __builtin_amdgcn_logf(1.0f + e); return x > 20.f ? x : lg; }
__device__ __forceinline__ float sigmoid_fast(float x) { return __builtin_amdgcn_rcpf(1.0f + __builtin_amdgcn_exp2f(-1.4426950408889634f * x)); }
__device__ __forceinline__ float scan_fwd64(float v, int lane) {
    v += dppf<0x111>(v); v += dppf<0x112>(v); v += dppf<0x114>(v); v += dppf<0x118>(v);
    const float t0 = __builtin_bit_cast(float, __builtin_amdgcn_readlane(__builtin_bit_cast(int, v), 15)), t1 = __builtin_bit_cast(float, __builtin_amdgcn_readlane(__builtin_bit_cast(int, v), 31));
    const float t2 = __builtin_bit_cast(float, __builtin_amdgcn_readlane(__builtin_bit_cast(int, v), 47));
    const int row = lane >> 4; return v + (row == 0 ? 0.f : row == 1 ? t0 : row == 2 ? t0 + t1 : (t0 + t1) + t2);
}
__device__ __forceinline__ float scan_bwd64(float v, int lane) {
    v += dppf<0x101>(v); v += dppf<0x102>(v); v += dppf<0x104>(v); v += dppf<0x108>(v);
    const float t1 = __builtin_bit_cast(float, __builtin_amdgcn_readlane(__builtin_bit_cast(int, v), 16)), t2 = __builtin_bit_cast(float, __builtin_amdgcn_readlane(__builtin_bit_cast(int, v), 32));
    const float t3 = __builtin_bit_cast(float, __builtin_amdgcn_readlane(__builtin_bit_cast(int, v), 48));
    const int row = lane >> 4; return v + (row == 3 ? 0.f : row == 2 ? t3 : row == 1 ? t3 + t2 : (t3 + t2) + t1);
}

template <int CTRL> __device__ __forceinline__ int dppi(int v) { return __builtin_amdgcn_update_dpp(0, v, CTRL, 0xF, 0xF, true); }
__device__ __forceinline__ int scan_fwd64_i(int v, int lane) {
    v += dppi<0x111>(v); v += dppi<0x112>(v); v += dppi<0x114>(v); v += dppi<0x118>(v);
    const int t0 = __builtin_amdgcn_readlane(v, 15), t1 = __builtin_amdgcn_readlane(v, 31), t2 = __builtin_amdgcn_readlane(v, 47);
    const int row = lane >> 4; return v + (row == 0 ? 0 : row == 1 ? t0 : row == 2 ? t0 + t1 : t0 + t1 + t2);
}
template <int MT, int NT>
__device__ __forceinline__ void mma_lds(f32x4 (&acc)[MT][NT], const LAS bf16* A, int lda, int m0, const LAS bf16* Bt, int ldb, int n0, int K, int fr, int fq) {
    for (int k0 = 0; k0 < K; k0 += 32) {
        bf16x8 a[MT], b[NT];
#pragma unroll
        for (int mt = 0; mt < MT; ++mt) a[mt] = *(const LAS bf16x8*)(A + (m0 + mt * 16 + fr) * lda + k0 + fq * 8);
#pragma unroll
        for (int nt = 0; nt < NT; ++nt) b[nt] = *(const LAS bf16x8*)(Bt + (n0 + nt * 16 + fr) * ldb + k0 + fq * 8);
#pragma unroll
        for (int mt = 0; mt < MT; ++mt)
#pragma unroll
            for (int nt = 0; nt < NT; ++nt) acc[mt][nt] = __builtin_amdgcn_mfma_f32_16x16x32_bf16(a[mt], b[nt], acc[mt][nt], 0, 0, 0);
    }
}

__device__ __forceinline__ void conv16(float (&acc)[16], const LAS bf16* src, int ld, const LAS float* cw, int cwld) {
#pragma unroll
    for (int c = 0; c < 16; ++c) acc[c] = cw[7 * cwld + c];
#pragma unroll
    for (int tap = 0; tap < 7; ++tap) {
        const bf16x8 x0 = *(const LAS bf16x8*)(src + tap * ld), x1 = *(const LAS bf16x8*)(src + tap * ld + 8);
        const LAS float* w = cw + tap * cwld;
#pragma unroll
        for (int c = 0; c < 8; ++c) { acc[c] += bf2f_s(x0[c]) * w[c]; acc[8 + c] += bf2f_s(x1[c]) * w[8 + c]; }
        if (tap & 1) asm volatile("" ::: "memory");
    }
}
__device__ __forceinline__ void conv8(float (&acc)[8], const LAS bf16* src, int ld, const LAS float* cw, int cwld) {
#pragma unroll
    for (int c = 0; c < 8; ++c) acc[c] = cw[7 * cwld + c];
#pragma unroll
    for (int tap = 0; tap < 7; ++tap) {
        const bf16x8 x0 = *(const LAS bf16x8*)(src + tap * ld);
        const LAS float* w = cw + tap * cwld;
#pragma unroll
        for (int c = 0; c < 8; ++c) acc[c] += bf2f_s(x0[c]) * w[c];
        if (tap & 1) asm volatile("" ::: "memory");
    }
}

#if defined(PROBE_SUB)
#define PB_START(id_, ws_) do { if ((id_) == PROBE_SUB && blockIdx.x == 0 && threadIdx.x == 0) ((unsigned long long*)(ws_))[1100] = __builtin_amdgcn_s_memrealtime(); } while (0)
#define PB_END(id_, ws_) do { if ((id_) == PROBE_SUB && blockIdx.x == 0 && threadIdx.x == 0) { const unsigned long long t1_ = __builtin_amdgcn_s_memrealtime(), t0_ = ((unsigned long long*)(ws_))[1100]; \
        const unsigned bk_ = (unsigned)((t1_ - t0_) / PROBE_TICKS); *((volatile float*)(ws_) + 2048) = (float)(bk_ > 40u ? 40u : bk_) * (1.0f / 40.0f); } } while (0)
#else
#define PB_START(id_, ws_) do {} while (0)
#define PB_END(id_, ws_) do {} while (0)
#endif
__device__ __forceinline__ void transpose_item(const float* W, int K, int N, int k0, int n0, bf16* WT, int drow0, int rmul, LAS float* scr, int lane) {
    f32x4 v[16];
#pragma unroll
    for (int i = 0; i < 16; ++i) { const int kk = 4 * i + (lane >> 4); v[i] = *(const GAS f32x4*)(W + (size_t)(k0 + kk) * N + n0 + 4 * (lane & 15)); }
#pragma unroll
    for (int i = 0; i < 16; ++i) { const int kk = 4 * i + (lane >> 4); LAS float* d = scr + kk * 65 + 4 * (lane & 15); d[0] = v[i].x; d[1] = v[i].y; d[2] = v[i].z; d[3] = v[i].w; }
    LDS_WAIT(); asm volatile("" ::: "memory");
    const int c = lane & 7;
#pragma unroll
    for (int j = 0; j < 8; ++j) { const int n = (lane >> 3) + 8 * j; const LAS float* s = scr + (8 * c) * 65 + n;
        u32x4 o; o.x = pkbf(s[0 * 65], s[1 * 65]); o.y = pkbf(s[2 * 65], s[3 * 65]); o.z = pkbf(s[4 * 65], s[5 * 65]); o.w = pkbf(s[6 * 65], s[7 * 65]);
        *(GAS u32x4*)(WT + (size_t)(drow0 + rmul * n) * K + k0 + 8 * c) = o; }
    LDS_WAIT(); asm volatile("" ::: "memory");
}
__device__ __forceinline__ void cvt_mixer_weights(LAS unsigned char* lds, unsigned char* ws, const float* w_in, const float* w_out, int gw, int NGW, int wave, int lane) {
    LAS float* scr = (LAS float*)(lds + wave * 16896);
    bf16* WA = (bf16*)(ws + WS_WA); bf16* WB = (bf16*)(ws + WS_WB); bf16* WO = (bf16*)(ws + WS_WO);
    constexpr int I_IN = 16 * 105, I_OUT = 32 * 16;
    for (int it = gw; it < I_IN + I_OUT; it += NGW) {
        if (it < I_IN) { const int kb = it / 105, nb = it % 105, n0 = nb * 64;
            bf16* dst; int drow;
            if (n0 < 4608) { dst = WA; drow = n0; } else if (n0 < 6656) { dst = WB; drow = n0 - 4608; } else { dst = WA; drow = 4608 + (n0 - 6656); }
            transpose_item(w_in, 1024, 6720, kb * 64, n0, dst, drow, 1, scr, lane);
        } else { const int r = it - I_IN, kb = r / 16, nb = r % 16; transpose_item(w_out, 2048, 1024, kb * 64, nb * 64, WO, nb * 64, 1, scr, lane); }
    }
    { u32x4 z = (u32x4){0u, 0u, 0u, 0u}; asm volatile("" : "+v"(z));
      for (int r = gw; r < 192; r += NGW) { GAS u32x4* p = (GAS u32x4*)(WA + (size_t)(4672 + r) * 1024) + lane; p[0] = z; p[64] = z; } }
}
__device__ __forceinline__ void cvt_expert_weights(LAS unsigned char* lds, unsigned char* ws, const float* w_gate, const float* w_up, const float* w_down, int gw, int NGW, int wave, int lane) {
    LAS float* scr = (LAS float*)(lds + wave * 16896);
    bf16* WGU = (bf16*)(ws + WS_WGU); bf16* WD = (bf16*)(ws + WS_WD);
    constexpr int I_G = 16 * 8;
    constexpr int I_D = 8 * 16;
    constexpr int PER_E = 2 * I_G + I_D;
    for (int it = gw; it < NEXP * PER_E; it += NGW) {
        const int e = it / PER_E; int r = it % PER_E;
        if (r < 2 * I_G) { const int up = r >= I_G; if (up) r -= I_G; const int kb = r / 8, nb = r % 8;
            transpose_item((up ? w_up : w_gate) + (size_t)e * 1024 * 512, 1024, 512, kb * 64, nb * 64, WGU + (size_t)e * 1024 * 1024, 2 * (nb * 64) + up, 2, scr, lane);
        } else { r -= 2 * I_G; const int kb = r / 16, nb = r % 16;
            transpose_item(w_down + (size_t)e * 512 * 1024, 512, 1024, kb * 64, nb * 64, WD + (size_t)e * 1024 * 512, nb * 64, 1, scr, lane); }
    }
}

__device__ __forceinline__ void rms_row_regs(const float* xrow, const f32x4 (&w)[4], f32x4 (&v)[4], int lane) {
    const GAS f32x4* xr = (const GAS f32x4*)xrow + lane; float s = 0.f;
#pragma unroll
    for (int j = 0; j < 4; ++j) { v[j] = xr[64 * j]; s += (v[j].x * v[j].x + v[j].y * v[j].y) + (v[j].z * v[j].z + v[j].w * v[j].w); }
    const float rstd = __builtin_amdgcn_rsqf(wave_sum(s) * (1.0f / DM) + EPS);
#pragma unroll
    for (int j = 0; j < 4; ++j) v[j] = v[j] * rstd * w[j];
}
__device__ __forceinline__ void row_load4(const float* xrow, f32x4 (&v)[4], int lane) {
    const GAS f32x4* xr = (const GAS f32x4*)xrow + lane;
#pragma unroll
    for (int j = 0; j < 4; ++j) v[j] = xr[64 * j];
}
__device__ __forceinline__ void row_load4(const bf16* xrow, u32x2 (&v)[4], int lane) {
    const GAS u32x2* xr = (const GAS u32x2*)xrow + lane;
#pragma unroll
    for (int j = 0; j < 4; ++j) v[j] = xr[64 * j];
}
__device__ __forceinline__ void row_get(const f32x4 (&b)[4], f32x4 (&v)[4]) {
#pragma unroll
    for (int j = 0; j < 4; ++j) v[j] = b[j];
}
__device__ __forceinline__ void row_get(const u32x2 (&b)[4], f32x4 (&v)[4]) {
#pragma unroll
    for (int j = 0; j < 4; ++j) v[j] = (f32x4){__uint_as_float(b[j].x << 16), __uint_as_float(b[j].x & 0xffff0000u), __uint_as_float(b[j].y << 16), __uint_as_float(b[j].y & 0xffff0000u)};
}
template <class T> struct RowBuf;
template <> struct RowBuf<float> { typedef f32x4 type; };
template <> struct RowBuf<bf16> { typedef u32x2 type; };
__device__ __forceinline__ void rms_regs(const f32x4 (&w)[4], f32x4 (&v)[4]) {
    float s = 0.f;
#pragma unroll
    for (int j = 0; j < 4; ++j) s += (v[j].x * v[j].x + v[j].y * v[j].y) + (v[j].z * v[j].z + v[j].w * v[j].w);
    const float rstd = __builtin_amdgcn_rsqf(wave_sum(s) * (1.0f / DM) + EPS);
#pragma unroll
    for (int j = 0; j < 4; ++j) v[j] = v[j] * rstd * w[j];
}
__device__ __forceinline__ void store_row_bf16(bf16* orow, const f32x4 (&v)[4], int lane) {
    GAS u32x2* o8 = (GAS u32x2*)orow + lane;
#pragma unroll
    for (int j = 0; j < 4; ++j) { u32x2 t; t.x = pkbf(v[j].x, v[j].y); t.y = pkbf(v[j].z, v[j].w); o8[64 * j] = t; }
}
__device__ __forceinline__ void load_w4(const float* w, f32x4 (&wv)[4], int lane) {
#pragma unroll
    for (int j = 0; j < 4; ++j) wv[j] = ((const GAS f32x4*)w)[lane + 64 * j];
}
template <class T>
__device__ __forceinline__ void phase_norm(const T* src, const float* w, bf16* XN, int gw, int NGW, int lane) {
    typedef typename RowBuf<T>::type RB;
    f32x4 wv[4]; load_w4(w, wv, lane);
    RB nx[4], ny[4]; row_load4(src + (size_t)gw * DM, nx, lane);
    if (gw + NGW < M) row_load4(src + (size_t)(gw + NGW) * DM, ny, lane);
    auto body = [&](int m, RB (&buf)[4]) { f32x4 v[4];
        row_get(buf, v);
        if (m + 2 * NGW < M) row_load4(src + (size_t)(m + 2 * NGW) * DM, buf, lane);
        rms_regs(wv, v); store_row_bf16(XN + (size_t)m * DM, v, lane); };
    for (int m = gw; m < M; m += 2 * NGW) { body(m, nx); if (m + NGW < M) body(m + NGW, ny); }
}
__device__ __forceinline__ void zero_region(unsigned char* p, size_t bytes, int gtid, int NGT) {
    GAS u32x4* q = (GAS u32x4*)p; const size_t n = bytes / 16;
    u32x4 z = (u32x4){0u, 0u, 0u, 0u}; asm volatile("" : "+v"(z));
    for (size_t i = gtid; i < n; i += NGT) q[i] = z;
}

__device__ __forceinline__ void phase_norm2_router(LAS unsigned char* lds, const bf16* h, const float* w2, const float* w_router, bf16* XN, float* aff, int gw, int NGW, int tid, int lane) {
    LAS float* wrT = (LAS float*)lds;
    for (int e = tid; e < 16 * 1024; e += 512) { const int k = e >> 4, x = e & 15; wrT[x * 1024 + k] = w_router[e]; }
    __syncthreads();
    f32x4 wv[4]; load_w4(w2, wv, lane);
    u32x2 nx[4], ny[4]; row_load4(h + (size_t)gw * DM, nx, lane);
    if (gw + NGW < M) row_load4(h + (size_t)(gw + NGW) * DM, ny, lane);
    auto body = [&](int m, u32x2 (&buf)[4]) {
        f32x4 v[4];
        row_get(buf, v);
        if (m + 2 * NGW < M) row_load4(h + (size_t)(m + 2 * NGW) * DM, buf, lane);
        rms_regs(wv, v); store_row_bf16(XN + (size_t)m * DM, v, lane);
        float mine = 0.f;
#pragma unroll 1
        for (int x = 0; x < 16; ++x) { float s = 0.f;
#pragma unroll
            for (int j = 0; j < 4; ++j) { const f32x4 wr = *(const LAS f32x4*)(wrT + x * 1024 + 4 * lane + 256 * j); s += (v[j].x * wr.x + v[j].y * wr.y) + (v[j].z * wr.z + v[j].w * wr.w); }
            s = wave_sum(s); mine = (lane == x) ? s : mine; }
        float mx = mine;
        mx = fmaxf(mx, __shfl_xor(mx, 1)); mx = fmaxf(mx, __shfl_xor(mx, 2)); mx = fmaxf(mx, __shfl_xor(mx, 4)); mx = fmaxf(mx, __shfl_xor(mx, 8));
        const float ex = expf(mine - mx); float den = ex;
        den += __shfl_xor(den, 1); den += __shfl_xor(den, 2); den += __shfl_xor(den, 4); den += __shfl_xor(den, 8);
        if (lane < 16) aff[(size_t)m * 16 + lane] = ex / den;
    };
    for (int m = gw; m < M; m += 2 * NGW) { body(m, nx); if (m + NGW < M) body(m + NGW, ny); }
}

__device__ __forceinline__ void phase_finish(const bf16* og, const bf16* ys, const bf16* yi, const bf16* gates, const float* gnw, const float* snw, bf16* mixed, int gw, int NGW, int lane) {
    float gw_[16], sw_[16];
#pragma unroll
    for (int c = 0; c < 16; ++c) { gw_[c] = gnw[(16 * lane + c) & 127]; sw_[c] = snw[16 * lane + c]; }
    bf16x8 nb[10], nc[10];
#define PF_LOAD(nb, m_) do { const size_t m1_ = (size_t)(m_); \
        nb[0] = *(const GAS bf16x8*)(og + m1_ * 1024 + 16 * lane); nb[1] = *(const GAS bf16x8*)(og + m1_ * 1024 + 16 * lane + 8); \
        nb[2] = *(const GAS bf16x8*)(ys + m1_ * 1024 + 16 * lane); nb[3] = *(const GAS bf16x8*)(ys + m1_ * 1024 + 16 * lane + 8); \
        nb[4] = *(const GAS bf16x8*)(yi + m1_ * 1024 + 16 * lane); nb[5] = *(const GAS bf16x8*)(yi + m1_ * 1024 + 16 * lane + 8); \
        nb[6] = *(const GAS bf16x8*)(gates + m1_ * 2048 + 16 * lane); nb[7] = *(const GAS bf16x8*)(gates + m1_ * 2048 + 16 * lane + 8); \
        nb[8] = *(const GAS bf16x8*)(gates + m1_ * 2048 + 1024 + 16 * lane); nb[9] = *(const GAS bf16x8*)(gates + m1_ * 2048 + 1024 + 16 * lane + 8); } while (0)
    PF_LOAD(nb, gw);
    if (gw + NGW < M) PF_LOAD(nc, gw + NGW);
    auto body = [&](int m, bf16x8 (&buf)[10]) {
        const bf16x8 o0 = buf[0], o1 = buf[1], y0 = buf[2], y1 = buf[3], i0 = buf[4], i1 = buf[5], g0 = buf[6], g1 = buf[7], z0 = buf[8], z1 = buf[9];
        if (m + 2 * NGW < M) PF_LOAD(buf, m + 2 * NGW);
        float o[16], t[16]; float so = 0.f, st = 0.f;
#pragma unroll
        for (int c = 0; c < 8; ++c) { o[c] = bf2f_s(o0[c]); o[8 + c] = bf2f_s(o1[c]); t[c] = (bf2f_s(y0[c]) + bf2f_s(i0[c])) * silu(bf2f_s(z0[c])); t[8 + c] = (bf2f_s(y1[c]) + bf2f_s(i1[c])) * silu(bf2f_s(z1[c])); }
#pragma unroll
        for (int c = 0; c < 16; ++c) { so += o[c] * o[c]; st += t[c] * t[c]; }
        so += __shfl_xor(so, 1); so += __shfl_xor(so, 2); so += __shfl_xor(so, 4);
        st += __shfl_xor(st, 1); st += __shfl_xor(st, 2); st += __shfl_xor(st, 4); st += __shfl_xor(st, 8); st += __shfl_xor(st, 16);
        const float ro = __builtin_amdgcn_rsqf(so * (1.0f / 128.f) + EPS), rt = __builtin_amdgcn_rsqf(st * (1.0f / 512.f) + EPS);
        float a[16], b2[16];
#pragma unroll
        for (int c = 0; c < 8; ++c) { a[c] = o[c] * ro * gw_[c] * silu(bf2f_s(g0[c])); a[8 + c] = o[8 + c] * ro * gw_[8 + c] * silu(bf2f_s(g1[c])); }
#pragma unroll
        for (int c = 0; c < 16; ++c) b2[c] = t[c] * rt * sw_[c];
        u32x4 w0, w1, w2, w3;
        w0.x = pkbf(a[0], a[1]); w0.y = pkbf(a[2], a[3]); w0.z = pkbf(a[4], a[5]); w0.w = pkbf(a[6], a[7]);
        w1.x = pkbf(a[8], a[9]); w1.y = pkbf(a[10], a[11]); w1.z = pkbf(a[12], a[13]); w1.w = pkbf(a[14], a[15]);
        w2.x = pkbf(b2[0], b2[1]); w2.y = pkbf(b2[2], b2[3]); w2.z = pkbf(b2[4], b2[5]); w2.w = pkbf(b2[6], b2[7]);
        w3.x = pkbf(b2[8], b2[9]); w3.y = pkbf(b2[10], b2[11]); w3.z = pkbf(b2[12], b2[13]); w3.w = pkbf(b2[14], b2[15]);
        GAS u32x4* mp = (GAS u32x4*)(mixed + (size_t)m * 2048 + 16 * lane);
        mp[0] = w0; mp[1] = w1; mp[128] = w2; mp[129] = w3;
    };
    for (int m = gw; m < M; m += 2 * NGW) { body(m, nb); if (m + NGW < M) body(m + NGW, nc); }
#undef PF_LOAD
}

__device__ __forceinline__ void phase_topk(LAS unsigned char* lds, const float* aff, int* idx, float* val, int* inv, int be, int tid, int wave, int lane) {
    LAS unsigned* hist = (LAS unsigned*)lds;
    LAS unsigned* ctl = hist + 256;
    LAS unsigned* wsum = hist + 320;
    const int b = be >> 4, e = be & 15;
    unsigned key[16];
#pragma unroll
    for (int i = 0; i < 16; ++i) key[i] = __float_as_uint(aff[((size_t)b * SEQ + tid * 16 + i) * 16 + e]);
    unsigned prefix = 0u, mask = 0u; unsigned krem = CAP;
    for (int pass = 0; pass < 4; ++pass) {
        const int shift = 24 - 8 * pass;
        if (tid < 256) hist[tid] = 0u;
        __syncthreads();
#pragma unroll
        for (int i = 0; i < 16; ++i) if ((key[i] & mask) == prefix) atomicAdd((unsigned*)&hist[(key[i] >> shift) & 255u], 1u);
        __syncthreads();
        if (wave == 0) {
            const u32x4 hb = *(const LAS u32x4*)(hist + 4 * lane); const unsigned sl = hb.x + hb.y + hb.z + hb.w;
            int Si = (int)sl; Si += dppi<0x101>(Si); Si += dppi<0x102>(Si); Si += dppi<0x104>(Si); Si += dppi<0x108>(Si);
            { const int t1 = __builtin_amdgcn_readlane(Si, 16), t2 = __builtin_amdgcn_readlane(Si, 32), t3 = __builtin_amdgcn_readlane(Si, 48); const int row = lane >> 4;
              Si += (row == 3 ? 0 : row == 2 ? t3 : row == 1 ? t3 + t2 : t3 + t2 + t1); }
            const unsigned S = (unsigned)Si;
            const unsigned above = S - sl;
            if (above < krem && krem <= above + sl) { unsigned cum = above; int d;
                if (cum + hb.w >= krem) d = 3; else { cum += hb.w; if (cum + hb.z >= krem) d = 2; else { cum += hb.z; if (cum + hb.y >= krem) d = 1; else { cum += hb.y; d = 0; } } }
                ctl[0] = prefix | ((unsigned)(4 * lane + d) << shift); ctl[1] = krem - cum; } }
        __syncthreads();
        prefix = ctl[0]; krem = ctl[1]; mask |= 255u << shift;
        __syncthreads();
    }
    const unsigned thr = prefix;
    int ngt = 0, neq = 0;
#pragma unroll
    for (int i = 0; i < 16; ++i) { ngt += key[i] > thr; neq += key[i] == thr; }
    const int sg = scan_fwd64_i(ngt, lane), sq = scan_fwd64_i(neq, lane);
    if (lane == 63) { wsum[wave] = (unsigned)sg; wsum[8 + wave] = (unsigned)sq; }
    __syncthreads();
    int bg = 0, bq = 0;
#pragma unroll
    for (int w = 0; w < 8; ++w) if (w < wave) { bg += (int)wsum[w]; bq += (int)wsum[8 + w]; }
    int pg = bg + sg - ngt, pq = bq + sq - neq;
#pragma unroll
    for (int i = 0; i < 16; ++i) {
        const int tok = tid * 16 + i; const bool gt = key[i] > thr, eq = key[i] == thr;
        const bool sel = gt || (eq && pq < (int)krem);
        const int slot = pg + (pq < (int)krem ? pq : (int)krem);
        if (sel) { idx[be * CAP + slot] = tok; val[be * CAP + slot] = __uint_as_float(key[i]); }
        inv[((size_t)b * SEQ + tok) * 16 + e] = sel ? slot : -1;
        pg += gt; pq += eq;
    }
    __syncthreads();
}

__device__ __forceinline__ void phase_gather(const bf16* XN, const int* idx, bf16* XG, int gw, int NGW, int lane) {
    for (int r = gw; r < MEXP; r += NGW) {
        const int b = r >> 14; const int tok = idx[r];
        const GAS u32x4* s = (const GAS u32x4*)(XN + ((size_t)b * SEQ + tok) * DM) + lane; GAS u32x4* d = (GAS u32x4*)(XG + (size_t)r * DM) + lane;
        const u32x4 a = s[0], c = s[64]; d[0] = a; d[64] = c;
    }
}

__device__ __forceinline__ void phase_combine(const bf16* hin, float* hout, const bf16* Y, const int* inv, const float* val, const float* wn, bf16* XN, bool final_, int gw, int NGW, int lane, float pscale = 1.0f) {
    f32x4 wv[4]; load_w4(wn, wv, lane);
    u32x2 nx[4], ny[4]; row_load4(hin + (size_t)gw * DM, nx, lane); int nslot = (lane < 16) ? inv[(size_t)gw * 16 + lane] : -1, nslot2 = -1;
    if (gw + NGW < M) { row_load4(hin + (size_t)(gw + NGW) * DM, ny, lane); nslot2 = (lane < 16) ? inv[(size_t)(gw + NGW) * 16 + lane] : -1; }
    auto body = [&](int m, u32x2 (&buf)[4], int& bslot) {
        const int b = m >> 13;
        f32x4 v[4];
        row_get(buf, v);
        const int myslot = bslot;
        if (m + 2 * NGW < M) { row_load4(hin + (size_t)(m + 2 * NGW) * DM, buf, lane); bslot = (lane < 16) ? inv[(size_t)(m + 2 * NGW) * 16 + lane] : -1; }
        unsigned mask = (unsigned)__builtin_amdgcn_ballot_w64(myslot >= 0) & 0xffffu;
        while (mask) {
            const int e0 = __builtin_ctz(mask); mask &= mask - 1u;
            const bool two = mask != 0u; const int e1 = two ? __builtin_ctz(mask) : e0; if (two) mask &= mask - 1u;
            const int s0 = __builtin_amdgcn_readlane(myslot, e0), s1 = __builtin_amdgcn_readlane(myslot, e1);
            const int r0 = (b * 16 + e0) * CAP + s0, r1 = (b * 16 + e1) * CAP + s1;
            const float a0 = val[r0]; const float a1 = two ? val[r1] : 0.f;
            const GAS u32x2* y0 = (const GAS u32x2*)(Y + (size_t)r0 * DM) + lane; const GAS u32x2* y1 = (const GAS u32x2*)(Y + (size_t)r1 * DM) + lane;
            u32x2 t0[4], t1[4];
#pragma unroll
            for (int j = 0; j < 4; ++j) { t0[j] = y0[64 * j]; t1[j] = y1[64 * j]; }
#pragma unroll
            for (int j = 0; j < 4; ++j) { const u32x2 t = t0[j];
                v[j].x += a0 * __uint_as_float(t.x << 16); v[j].y += a0 * __uint_as_float(t.x & 0xffff0000u); v[j].z += a0 * __uint_as_float(t.y << 16); v[j].w += a0 * __uint_as_float(t.y & 0xffff0000u); }
            if (two) {
#pragma unroll
                for (int j = 0; j < 4; ++j) { const u32x2 t = t1[j];
                    v[j].x += a1 * __uint_as_float(t.x << 16); v[j].y += a1 * __uint_as_float(t.x & 0xffff0000u); v[j].z += a1 * __uint_as_float(t.y << 16); v[j].w += a1 * __uint_as_float(t.y & 0xffff0000u); } }
        }
        float s2 = 0.f;
#pragma unroll
        for (int j = 0; j < 4; ++j) s2 += (v[j].x * v[j].x + v[j].y * v[j].y) + (v[j].z * v[j].z + v[j].w * v[j].w);
        const float rstd = __builtin_amdgcn_rsqf(wave_sum(s2) * (1.0f / DM) + EPS);
        if (final_) { GAS f32x4* ho = (GAS f32x4*)(hout + (size_t)m * DM) + lane;
#pragma unroll
            for (int j = 0; j < 4; ++j) ho[64 * j] = v[j] * (rstd * pscale) * wv[j];
        } else {
            store_row_bf16((bf16*)hout + (size_t)m * DM, v, lane);
            f32x4 nv[4];
#pragma unroll
            for (int j = 0; j < 4; ++j) nv[j] = v[j] * rstd * wv[j];
            store_row_bf16(XN + (size_t)m * DM, nv, lane);
        }
    };
    for (int m = gw; m < M; m += 2 * NGW) { body(m, nx, nslot); if (m + NGW < M) body(m + NGW, ny, nslot2); }
}
namespace gdn {
constexpr int CW = 0;
constexpr int SC = CW + 8 * 320 * 4;
constexpr int Q = SC + 1280;
constexpr int K = Q + 64 * 136 * 2;
constexpr int KDT = K + 64 * 136 * 2;
constexpr int VT = KDT + 128 * 72 * 2;
constexpr int T = VT + 64 * 72 * 2;
constexpr int QKD = T + 64 * 72 * 2;
constexpr int ST = QKD + 64 * 72 * 2;
constexpr int TMP = ST + 64 * 136 * 2;
constexpr int RQ = TMP, RK = RQ + 70 * 136 * 2, RV = RK + 70 * 136 * 2, RAW_END = RV + 70 * 72 * 2;
constexpr int AF = TMP, TF = AF + 64 * 68 * 4, XF = TF + 64 * 68 * 4, INV_END = XF + 3 * 16 * 17 * 4;
constexpr int RT = TMP, UT = RT + 64 * 72 * 2, OS = UT + 64 * 72 * 2, ST_END = OS + 64 * 65 * 4;
static_assert(RAW_END <= MISC_OFF && INV_END <= MISC_OFF && ST_END <= MISC_OFF, "gdn LDS map");
}
__device__ __forceinline__ void gdn_chain(LAS unsigned char* lds, int cid, const bf16* raw, const float* scal, const float* conv_w, const float* conv_b,
                                          const float* A_log, const float* dt_bias, bf16* og, int tid, int wave, int lane) {
    using namespace gdn;
    const int dvh = cid & 1, dir = (cid >> 1) & 1, h = (cid >> 2) & 7, b = cid >> 5;
    const int fr = lane & 15, fq = lane >> 4;
    LAS float* cw = (LAS float*)(lds + CW); LAS float* sc = (LAS float*)(lds + SC);
    LAS bf16* q_ = (LAS bf16*)(lds + Q); LAS bf16* k_ = (LAS bf16*)(lds + K); LAS bf16* kdT = (LAS bf16*)(lds + KDT); LAS bf16* vT = (LAS bf16*)(lds + VT);
    LAS bf16* T_ = (LAS bf16*)(lds + T); LAS bf16* QKd = (LAS bf16*)(lds + QKD); LAS bf16* ST_ = (LAS bf16*)(lds + ST);
    LAS bf16* rq = (LAS bf16*)(lds + RQ); LAS bf16* rk = (LAS bf16*)(lds + RK); LAS bf16* rv = (LAS bf16*)(lds + RV);
    LAS float* Af = (LAS float*)(lds + AF); LAS float* Tf = (LAS float*)(lds + TF); LAS float* Xf = (LAS float*)(lds + XF);
    LAS bf16* rT = (LAS bf16*)(lds + RT); LAS bf16* uT = (LAS bf16*)(lds + UT); LAS float* os = (LAS float*)(lds + OS);
    for (int e = tid; e < 8 * 320; e += 512) { const int r = e / 320, c = e % 320;
        const int gch = c < 128 ? h * 128 + c : (c < 256 ? 1024 + h * 128 + (c - 128) : 2048 + h * 128 + dvh * 64 + (c - 256));
        cw[e] = r < 7 ? conv_w[r * CONV_CH + gch] : conv_b[gch]; }
    for (int e = tid; e < 64 * 136 / 2; e += 512) ((LAS unsigned*)ST_)[e] = 0u;
    const float expA = expf(A_log[dir * 8 + h]), dtb = dt_bias[dir * 8 + h];
    f32x4 sacc[4];
#pragma unroll
    for (int nt = 0; nt < 4; ++nt) sacc[nt] = (f32x4){0.f, 0.f, 0.f, 0.f};
    const size_t rowb = (size_t)b * SEQ;
    __syncthreads();
    for (int n = 0; n < NCHUNK; ++n) {
        const int t0 = (dir ? NCHUNK - 1 - n : n) * 64;
        for (int e = tid; e < 70 * 40; e += 512) { const int r = e / 40, p = e % 40; const int t = t0 - 3 + r;
            u32x4 v = (u32x4){0u, 0u, 0u, 0u};
            const int col = p < 16 ? h * 128 + p * 8 : (p < 32 ? 1024 + h * 128 + (p - 16) * 8 : 2048 + h * 128 + dvh * 64 + (p - 32) * 8);
            if (t >= 0 && t < SEQ) v = *(const GAS u32x4*)(raw + (rowb + t) * CONV_CH + col);
            LAS bf16* d = p < 16 ? rq + r * 136 + p * 8 : (p < 32 ? rk + r * 136 + (p - 16) * 8 : rv + r * 72 + (p - 32) * 8);
            *(LAS u32x4*)d = v; }
        if (wave == 0) { const int i = lane; const int t = t0 + (dir ? 63 - i : i);
            const float braw = scal[(rowb + t) * 64 + dir * 8 + h], araw = scal[(rowb + t) * 64 + 16 + dir * 8 + h];
            const float g = -expA * softplus_f(araw + dtb);
            float gc = g;
#pragma unroll
            for (int o = 1; o < 64; o <<= 1) { const float y = __shfl_up(gc, o); if (i >= o) gc += y; }
            const float gl = __shfl(gc, 63);
            sc[i] = sigmoid_f(braw); sc[64 + i] = gc; sc[128 + i] = expf(gc); sc[192 + i] = expf(gl - gc); if (i == 0) sc[256] = expf(gl); }
        __syncthreads();
        { const int i = tid >> 3, cg = tid & 7; const int o = dir ? 63 - i : i;
          float a[16];
          conv16(a, rq + o * 136 + cg * 16, 136, cw + cg * 16, 320);
          float ss = 0.f;
#pragma unroll
          for (int c = 0; c < 16; ++c) { a[c] = silu(a[c]); ss += a[c] * a[c]; }
          ss += __shfl_xor(ss, 1); ss += __shfl_xor(ss, 2); ss += __shfl_xor(ss, 4);
          float rs = (1.0f / sqrtf(ss + EPS)) * 0.08838834764831845f;
          { u32x4 w0, w1; w0.x = pkbf(a[0] * rs, a[1] * rs); w0.y = pkbf(a[2] * rs, a[3] * rs); w0.z = pkbf(a[4] * rs, a[5] * rs); w0.w = pkbf(a[6] * rs, a[7] * rs);
            w1.x = pkbf(a[8] * rs, a[9] * rs); w1.y = pkbf(a[10] * rs, a[11] * rs); w1.z = pkbf(a[12] * rs, a[13] * rs); w1.w = pkbf(a[14] * rs, a[15] * rs);
            *(LAS u32x4*)(q_ + i * 136 + cg * 16) = w0; *(LAS u32x4*)(q_ + i * 136 + cg * 16 + 8) = w1; }
          conv16(a, rk + o * 136 + cg * 16, 136, cw + 128 + cg * 16, 320);
          ss = 0.f;
#pragma unroll
          for (int c = 0; c < 16; ++c) { a[c] = silu(a[c]); ss += a[c] * a[c]; }
          ss += __shfl_xor(ss, 1); ss += __shfl_xor(ss, 2); ss += __shfl_xor(ss, 4);
          rs = 1.0f / sqrtf(ss + EPS);
          { u32x4 w0, w1; w0.x = pkbf(a[0] * rs, a[1] * rs); w0.y = pkbf(a[2] * rs, a[3] * rs); w0.z = pkbf(a[4] * rs, a[5] * rs); w0.w = pkbf(a[6] * rs, a[7] * rs);
            w1.x = pkbf(a[8] * rs, a[9] * rs); w1.y = pkbf(a[10] * rs, a[11] * rs); w1.z = pkbf(a[12] * rs, a[13] * rs); w1.w = pkbf(a[14] * rs, a[15] * rs);
            *(LAS u32x4*)(k_ + i * 136 + cg * 16) = w0; *(LAS u32x4*)(k_ + i * 136 + cg * 16 + 8) = w1; }
          const float ek = sc[192 + i] * rs;
#pragma unroll
          for (int c = 0; c < 16; ++c) kdT[(cg * 16 + c) * 72 + i] = f2bf1(a[c] * ek);
          float v8[8];
          conv8(v8, rv + o * 72 + cg * 8, 72, cw + 256 + cg * 8, 320);
#pragma unroll
          for (int c = 0; c < 8; ++c) vT[(cg * 8 + c) * 72 + i] = f2bf1(silu(v8[c]));
        }
        __syncthreads();
        { const int which = wave >> 2, mt = wave & 3;
          f32x4 acc[1][4];
#pragma unroll
          for (int nt = 0; nt < 4; ++nt) acc[0][nt] = (f32x4){0.f, 0.f, 0.f, 0.f};
          mma_lds<1, 4>(acc, which ? q_ : k_, 136, mt * 16, k_, 136, 0, 128, fr, fq);
#pragma unroll
          for (int nt = 0; nt < 4; ++nt)
#pragma unroll
              for (int r = 0; r < 4; ++r) { const int i = mt * 16 + 4 * fq + r, j = nt * 16 + fr;
                  const float d = expf(fminf(sc[64 + i] - sc[64 + j], 0.f)); const float x = acc[0][nt][r] * d;
                  if (which == 0) Af[i * 68 + j] = (i > j) ? sc[i] * x : 0.f;
                  else QKd[i * 72 + j] = f2bf1((i >= j) ? x : 0.f); }
        }
        __syncthreads();
        if (wave == 0) { const int blk = lane >> 4, c = lane & 15; float t[16];
#pragma unroll
            for (int i = 0; i < 16; ++i) t[i] = (i == c) ? 1.f : 0.f;
#pragma unroll
            for (int i = 1; i < 16; ++i) { float s = 0.f; const LAS float* ar = Af + (blk * 16 + i) * 68 + blk * 16;
#pragma unroll
                for (int j = 0; j < i; ++j) s += ar[j] * t[j];
                t[i] = (i > c) ? -s : t[i];
                if ((i & 3) == 3) asm volatile("" ::: "memory"); }
#pragma unroll
            for (int i = 0; i < 16; ++i) Tf[(blk * 16 + i) * 68 + blk * 16 + c] = t[i]; }
        for (int d = 1; d <= 3; ++d) { const int nbk = 4 - d;
            __syncthreads();
            for (int e = tid; e < nbk * 256; e += 512) { const int J = e >> 8, r = (e >> 4) & 15, c = e & 15, I = J + d; float s = 0.f;
                for (int kk = J * 16; kk < I * 16; ++kk) s += Af[(I * 16 + r) * 68 + kk] * Tf[kk * 68 + J * 16 + c];
                Xf[(J * 16 + r) * 17 + c] = s; }
            __syncthreads();
            for (int e = tid; e < nbk * 256; e += 512) { const int J = e >> 8, r = (e >> 4) & 15, c = e & 15, I = J + d; float s = 0.f;
#pragma unroll
                for (int m2 = 0; m2 < 16; ++m2) s += Tf[(I * 16 + r) * 68 + I * 16 + m2] * Xf[(J * 16 + m2) * 17 + c];
                Tf[(I * 16 + r) * 68 + J * 16 + c] = -s; }
        }
        __syncthreads();
        for (int e = tid; e < 4096; e += 512) { const int i = e >> 6, j = e & 63; T_[i * 72 + j] = f2bf1(((i >> 4) >= (j >> 4)) ? Tf[i * 68 + j] : 0.f); }
        __syncthreads();
        const int mt = wave & 3, nh = wave >> 2;
        f32x4 aq[2];
        { f32x4 ak[2]; ak[0] = ak[1] = aq[0] = aq[1] = (f32x4){0.f, 0.f, 0.f, 0.f};
          for (int k0 = 0; k0 < 128; k0 += 32) {
              const bf16x8 fk = *(const LAS bf16x8*)(k_ + (mt * 16 + fr) * 136 + k0 + fq * 8), fqv = *(const LAS bf16x8*)(q_ + (mt * 16 + fr) * 136 + k0 + fq * 8);
#pragma unroll
              for (int nl = 0; nl < 2; ++nl) { const bf16x8 fb = *(const LAS bf16x8*)(ST_ + (nh * 32 + nl * 16 + fr) * 136 + k0 + fq * 8);
                  ak[nl] = __builtin_amdgcn_mfma_f32_16x16x32_bf16(fk, fb, ak[nl], 0, 0, 0); aq[nl] = __builtin_amdgcn_mfma_f32_16x16x32_bf16(fqv, fb, aq[nl], 0, 0, 0); } }
          const int i0 = mt * 16 + 4 * fq;
          const f32x4 be4 = *(const LAS f32x4*)(sc + i0), eg4 = *(const LAS f32x4*)(sc + 128 + i0);
#pragma unroll
          for (int nl = 0; nl < 2; ++nl) { const int dv = nh * 32 + nl * 16 + fr;
              const bf16x4 vv = *(const LAS bf16x4*)(vT + dv * 72 + i0);
              float r0 = be4[0] * (bf2f_s(vv[0]) - eg4[0] * ak[nl][0]), r1 = be4[1] * (bf2f_s(vv[1]) - eg4[1] * ak[nl][1]);
              float r2 = be4[2] * (bf2f_s(vv[2]) - eg4[2] * ak[nl][2]), r3 = be4[3] * (bf2f_s(vv[3]) - eg4[3] * ak[nl][3]);
              u32x2 w; w.x = pkbf(r0, r1); w.y = pkbf(r2, r3); *(LAS u32x2*)(rT + dv * 72 + i0) = w;
              aq[nl][0] *= eg4[0]; aq[nl][1] *= eg4[1]; aq[nl][2] *= eg4[2]; aq[nl][3] *= eg4[3]; }
        }
        __syncthreads();
        { f32x4 au[1][2]; au[0][0] = au[0][1] = (f32x4){0.f, 0.f, 0.f, 0.f};
          mma_lds<1, 2>(au, T_, 72, mt * 16, rT, 72, nh * 32, 64, fr, fq);
          const int i0 = mt * 16 + 4 * fq;
#pragma unroll
          for (int nl = 0; nl < 2; ++nl) { const int dv = nh * 32 + nl * 16 + fr; u32x2 w; w.x = pkbf(au[0][nl][0], au[0][nl][1]); w.y = pkbf(au[0][nl][2], au[0][nl][3]); *(LAS u32x2*)(uT + dv * 72 + i0) = w; }
        }
        __syncthreads();
        { f32x4 ao[1][2]; ao[0][0] = aq[0]; ao[0][1] = aq[1];
          mma_lds<1, 2>(ao, QKd, 72, mt * 16, uT, 72, nh * 32, 64, fr, fq);
          const int i0 = mt * 16 + 4 * fq;
#pragma unroll
          for (int nl = 0; nl < 2; ++nl)
#pragma unroll
              for (int r = 0; r < 4; ++r) os[(i0 + r) * 65 + nh * 32 + nl * 16 + fr] = ao[0][nl][r];
          const float egl = sc[256];
          f32x4 as_[1][4];
#pragma unroll
          for (int nt = 0; nt < 4; ++nt) as_[0][nt] = sacc[nt] * egl;
          mma_lds<1, 4>(as_, kdT, 72, wave * 16, uT, 72, 0, 64, fr, fq);
#pragma unroll
          for (int nt = 0; nt < 4; ++nt) { sacc[nt] = as_[0][nt];
              u32x2 w; w.x = pkbf(sacc[nt][0], sacc[nt][1]); w.y = pkbf(sacc[nt][2], sacc[nt][3]); *(LAS u32x2*)(ST_ + (nt * 16 + fr) * 136 + wave * 16 + 4 * fq) = w; }
        }
        __syncthreads();
#pragma unroll
        for (int ii = 0; ii < 4; ++ii) { const int i = wave * 8 + 2 * ii + (lane >> 5), cp = lane & 31; const int t = t0 + (dir ? 63 - i : i);
            atomic_add_bf16x2(og + (rowb + t) * 1024 + h * 128 + dvh * 64 + 2 * cp, os[i * 65 + 2 * cp], os[i * 65 + 2 * cp + 1]); }
        __syncthreads();
    }
}

namespace ssd {
constexpr int CW = 0;
constexpr int SC = CW + 8 * 320 * 4;
constexpr int BM_ = SC + 1280;
constexpr int CM_ = BM_ + 64 * 136 * 2;
constexpr int BT = CM_ + 64 * 136 * 2;
constexpr int XDT = BT + 128 * 72 * 2;
constexpr int XDW = XDT + 64 * 72 * 2;
constexpr int MM = XDW + 64 * 72 * 2;
constexpr int HT = MM + 64 * 72 * 2;
constexpr int TMP = HT + 64 * 136 * 2;
constexpr int RX = TMP, RB = RX + 70 * 72 * 2, RC = RB + 70 * 136 * 2, RAW_END = RC + 70 * 136 * 2;
constexpr int OS = TMP, OS_END = OS + 64 * 65 * 4;
static_assert(RAW_END <= MISC_OFF && OS_END <= MISC_OFF, "ssd LDS map");
}
__device__ __forceinline__ void ssd_chain(LAS unsigned char* lds, int cid, const bf16* raw, const float* scal, const float* conv_w, const float* conv_b,
                                          const float* A_log, const float* dt_bias, const float* Dp, bf16* ys, int tid, int wave, int lane) {
    using namespace ssd;
    const int dir = cid & 1, head = (cid >> 1) & 15, b = cid >> 5; const int g = head >> 3;
    const int fr = lane & 15, fq = lane >> 4;
    LAS float* cw = (LAS float*)(lds + CW); LAS float* sc = (LAS float*)(lds + SC);
    LAS bf16* Bm = (LAS bf16*)(lds + BM_); LAS bf16* Cm = (LAS bf16*)(lds + CM_); LAS bf16* BT_ = (LAS bf16*)(lds + BT);
    LAS bf16* xdt = (LAS bf16*)(lds + XDT); LAS bf16* xdw = (LAS bf16*)(lds + XDW); LAS bf16* Mm = (LAS bf16*)(lds + MM); LAS bf16* hT = (LAS bf16*)(lds + HT);
    LAS bf16* rx = (LAS bf16*)(lds + RX); LAS bf16* rb = (LAS bf16*)(lds + RB); LAS bf16* rc = (LAS bf16*)(lds + RC); LAS float* os = (LAS float*)(lds + OS);
    const int chx = 3072 + head * 64, chb = 4096 + g * 128, chc = 4352 + g * 128;
    for (int e = tid; e < 8 * 320; e += 512) { const int r = e / 320, c = e % 320;
        const int gch = c < 64 ? chx + c : (c < 192 ? chb + (c - 64) : chc + (c - 192));
        cw[e] = r < 7 ? conv_w[r * CONV_CH + gch] : conv_b[gch]; }
    for (int e = tid; e < 64 * 136 / 2; e += 512) ((LAS unsigned*)hT)[e] = 0u;
    const float Ah = -expf(A_log[dir * 16 + head]), dtb = dt_bias[dir * 16 + head], Dh = (dir == 0) ? Dp[head] : 0.f;
    f32x4 hacc[4];
#pragma unroll
    for (int nt = 0; nt < 4; ++nt) hacc[nt] = (f32x4){0.f, 0.f, 0.f, 0.f};
    const size_t rowb = (size_t)b * SEQ;
    __syncthreads();
    for (int n = 0; n < NCHUNK; ++n) {
        const int t0 = (dir ? NCHUNK - 1 - n : n) * 64;
        for (int e = tid; e < 70 * 40; e += 512) { const int r = e / 40, p = e % 40; const int t = t0 - 3 + r;
            u32x4 v = (u32x4){0u, 0u, 0u, 0u};
            const int col = p < 8 ? chx + p * 8 : (p < 24 ? chb + (p - 8) * 8 : chc + (p - 24) * 8);
            if (t >= 0 && t < SEQ) v = *(const GAS u32x4*)(raw + (rowb + t) * CONV_CH + col);
            LAS bf16* d = p < 8 ? rx + r * 72 + p * 8 : (p < 24 ? rb + r * 136 + (p - 8) * 8 : rc + r * 136 + (p - 24) * 8);
            *(LAS u32x4*)d = v; }
        if (wave == 0) { const int i = lane; const int t = t0 + (dir ? 63 - i : i);
            const float dt = softplus_f(scal[(rowb + t) * 64 + 32 + dir * 16 + head] + dtb);
            float cs = dt * Ah;
#pragma unroll
            for (int o = 1; o < 64; o <<= 1) { const float y = __shfl_up(cs, o); if (i >= o) cs += y; }
            const float cl = __shfl(cs, 63);
            sc[i] = dt; sc[64 + i] = cs; sc[128 + i] = expf(cs); sc[192 + i] = expf(cl - cs); if (i == 0) sc[256] = expf(cl); }
        __syncthreads();
        { const int i = tid >> 3, cg = tid & 7; const int o = dir ? 63 - i : i;
          float a[16];
          conv16(a, rb + o * 136 + cg * 16, 136, cw + 64 + cg * 16, 320);
#pragma unroll
          for (int c = 0; c < 16; ++c) a[c] = silu(a[c]);
          { u32x4 w0, w1; w0.x = pkbf(a[0], a[1]); w0.y = pkbf(a[2], a[3]); w0.z = pkbf(a[4], a[5]); w0.w = pkbf(a[6], a[7]);
            w1.x = pkbf(a[8], a[9]); w1.y = pkbf(a[10], a[11]); w1.z = pkbf(a[12], a[13]); w1.w = pkbf(a[14], a[15]);
            *(LAS u32x4*)(Bm + i * 136 + cg * 16) = w0; *(LAS u32x4*)(Bm + i * 136 + cg * 16 + 8) = w1; }
#pragma unroll
          for (int c = 0; c < 16; ++c) BT_[(cg * 16 + c) * 72 + i] = f2bf1(a[c]);
          conv16(a, rc + o * 136 + cg * 16, 136, cw + 192 + cg * 16, 320);
#pragma unroll
          for (int c = 0; c < 16; ++c) a[c] = silu(a[c]);
          { u32x4 w0, w1; w0.x = pkbf(a[0], a[1]); w0.y = pkbf(a[2], a[3]); w0.z = pkbf(a[4], a[5]); w0.w = pkbf(a[6], a[7]);
            w1.x = pkbf(a[8], a[9]); w1.y = pkbf(a[10], a[11]); w1.z = pkbf(a[12], a[13]); w1.w = pkbf(a[14], a[15]);
            *(LAS u32x4*)(Cm + i * 136 + cg * 16) = w0; *(LAS u32x4*)(Cm + i * 136 + cg * 16 + 8) = w1; }
          float x8[8];
          conv8(x8, rx + o * 72 + cg * 8, 72, cw + cg * 8, 320);
          const float dt = sc[i], wst = sc[192 + i];
#pragma unroll
          for (int c = 0; c < 8; ++c) { const float xv = silu(x8[c]) * dt; xdt[(cg * 8 + c) * 72 + i] = f2bf1(xv); xdw[(cg * 8 + c) * 72 + i] = f2bf1(xv * wst); }
        }
        __syncthreads();
        const int mt = wave & 3, nh = wave >> 2;
        { f32x4 acc[1][2]; acc[0][0] = acc[0][1] = (f32x4){0.f, 0.f, 0.f, 0.f};
          mma_lds<1, 2>(acc, Cm, 136, mt * 16, Bm, 136, nh * 32, 128, fr, fq);
#pragma unroll
          for (int nl = 0; nl < 2; ++nl)
#pragma unroll
              for (int r = 0; r < 4; ++r) { const int i = mt * 16 + 4 * fq + r, j = nh * 32 + nl * 16 + fr;
                  const float d = expf(fminf(sc[64 + i] - sc[64 + j], 0.f));
                  Mm[i * 72 + j] = f2bf1((i >= j) ? acc[0][nl][r] * d : 0.f); }
        }
        __syncthreads();
        { f32x4 a1[1][2], a2[1][2]; a1[0][0] = a1[0][1] = a2[0][0] = a2[0][1] = (f32x4){0.f, 0.f, 0.f, 0.f};
          mma_lds<1, 2>(a1, Mm, 72, mt * 16, xdt, 72, nh * 32, 64, fr, fq);
          mma_lds<1, 2>(a2, Cm, 136, mt * 16, hT, 136, nh * 32, 128, fr, fq);
          const int i0 = mt * 16 + 4 * fq;
          const f32x4 ec4 = *(const LAS f32x4*)(sc + 128 + i0), dt4 = *(const LAS f32x4*)(sc + i0);
#pragma unroll
          for (int nl = 0; nl < 2; ++nl) { const int p = nh * 32 + nl * 16 + fr; const bf16x4 xv = *(const LAS bf16x4*)(xdt + p * 72 + i0);
#pragma unroll
              for (int r = 0; r < 4; ++r) os[(i0 + r) * 65 + p] = a1[0][nl][r] + ec4[r] * a2[0][nl][r] + Dh * bf2f_s(xv[r]) / dt4[r]; }
        }
        __syncthreads();
        { const float ecl = sc[256];
          f32x4 ah[1][4];
#pragma unroll
          for (int nt = 0; nt < 4; ++nt) ah[0][nt] = hacc[nt] * ecl;
          mma_lds<1, 4>(ah, BT_, 72, wave * 16, xdw, 72, 0, 64, fr, fq);
#pragma unroll
          for (int nt = 0; nt < 4; ++nt) { hacc[nt] = ah[0][nt];
              u32x2 w; w.x = pkbf(hacc[nt][0], hacc[nt][1]); w.y = pkbf(hacc[nt][2], hacc[nt][3]); *(LAS u32x2*)(hT + (nt * 16 + fr) * 136 + wave * 16 + 4 * fq) = w; }
        }
#pragma unroll
        for (int ii = 0; ii < 4; ++ii) { const int i = wave * 8 + 2 * ii + (lane >> 5), cp = lane & 31; const int t = t0 + (dir ? 63 - i : i);
            atomic_add_bf16x2(ys + (rowb + t) * 1024 + head * 64 + 2 * cp, os[i * 65 + 2 * cp], os[i * 65 + 2 * cp + 1]); }
        __syncthreads();
    }
}
namespace pgd {
constexpr int CW = 0;
constexpr int SC = CW + 8 * 384 * 4;
constexpr int Q = SC + 1280;
constexpr int K = Q + 64 * 136 * 2;
constexpr int VT = K + 64 * 136 * 2;
constexpr int TMP = VT + 128 * 72 * 2;
constexpr int RQ = TMP, RK = RQ + 70 * 136 * 2, RV = RK + 70 * 136 * 2, RAW_END = RV + 70 * 136 * 2;
constexpr int AF = TMP, A2F = AF + 64 * 68 * 4, TF = A2F + 64 * 68 * 4, T2F = TF + 64 * 68 * 4, QKP = T2F + 64 * 68 * 4, INV_END = QKP + 64 * 72 * 2;
constexpr int XF = VT;
constexpr int TP = AF;
constexpr int STASH = MISC_OFF - 16384;
static_assert(RAW_END <= STASH && INV_END <= STASH, "prep gdn LDS map");
}
constexpr size_t WS_TQ = 379 * MiB;

__device__ __forceinline__ void prep_gdn_stash(LAS unsigned char* lds, int bid, const bf16* raw, int tid) {
    const int bh = bid >> 3, b = bh >> 3, h = bh & 7, r8 = bid & 7;
    LAS bf16* st = (LAS bf16*)(lds + pgd::STASH);
    for (int e = tid; e < 2 * 3 * 48; e += 512) { const int which = e / 144, r = (e % 144) / 48, p = e % 48;
        const int t = which ? (r8 * 16 + 16) * 64 + r : r8 * 16 * 64 - 3 + r;
        const int col = p < 16 ? h * 128 + p * 8 : (p < 32 ? 1024 + h * 128 + (p - 16) * 8 : 2048 + h * 128 + (p - 32) * 8);
        u32x4 v = (u32x4){0u, 0u, 0u, 0u};
        if (t >= 0 && t < SEQ) v = *(const GAS u32x4*)(raw + ((size_t)b * SEQ + t) * CONV_CH + col);
        *(LAS u32x4*)(st + which * 1152 + r * 384 + p * 8) = v; }
}
__device__ __forceinline__ void inv_diag_blocks(const LAS float* Af, LAS float* Tf, int lane) {
    const int blk = lane >> 4, c = lane & 15; float t[16];
#pragma unroll
    for (int i = 0; i < 16; ++i) t[i] = (i == c) ? 1.f : 0.f;
#pragma unroll
    for (int i = 1; i < 16; ++i) { float s = 0.f; const LAS float* ar = Af + (blk * 16 + i) * 68 + blk * 16;
#pragma unroll
        for (int j = 0; j < i; ++j) s += ar[j] * t[j];
        t[i] = (i > c) ? -s : t[i];
        if ((i & 3) == 3) asm volatile("" ::: "memory"); }
#pragma unroll
    for (int i = 0; i < 16; ++i) Tf[(blk * 16 + i) * 68 + blk * 16 + c] = t[i];
}
__device__ __forceinline__ void inv_offdiag_x(const LAS float* Af, const LAS float* Tf, LAS float* Xf, int d, int ht) {
    const int nbk = 4 - d;
    for (int e = ht; e < nbk * 256; e += 256) { const int J = e >> 8, r = (e >> 4) & 15, c = e & 15, I = J + d; float s = 0.f;
        for (int kk = J * 16; kk < I * 16; ++kk) s += Af[(I * 16 + r) * 68 + kk] * Tf[kk * 68 + J * 16 + c];
        Xf[(J * 16 + r) * 17 + c] = s; }
}
__device__ __forceinline__ void inv_offdiag_t(LAS float* Tf, const LAS float* Xf, int d, int ht) {
    const int nbk = 4 - d;
    for (int e = ht; e < nbk * 256; e += 256) { const int J = e >> 8, r = (e >> 4) & 15, c = e & 15, I = J + d; float s = 0.f;
#pragma unroll
        for (int m2 = 0; m2 < 16; ++m2) s += Tf[(I * 16 + r) * 68 + I * 16 + m2] * Xf[(J * 16 + m2) * 17 + c];
        Tf[(I * 16 + r) * 68 + J * 16 + c] = -s; }
}

__device__ __forceinline__ void conv_pair8(float (&o)[16], const LAS bf16* src  , int ld, const float (&w)[16]) {
#pragma unroll
    for (int t = 0; t < 8; ++t) { o[2 * t] = w[14]; o[2 * t + 1] = w[15]; }
#pragma unroll
    for (int r = 0; r < 14; ++r) { const unsigned xv = *(const LAS unsigned*)(src + r * ld); const float x0 = __uint_as_float(xv << 16), x1 = __uint_as_float(xv & 0xffff0000u);
#pragma unroll
        for (int t = 0; t < 8; ++t) { const int tap = r - t; if (tap >= 0 && tap < 7) { o[2 * t] += x0 * w[2 * tap]; o[2 * t + 1] += x1 * w[2 * tap + 1]; } } }
}
namespace pg2 {
constexpr int CW = 0;
constexpr int SC = CW + 8 * 384 * 4;
constexpr int Q = SC + 1280;
constexpr int K = Q + 64 * 136 * 2;
constexpr int VT = K + 64 * 136 * 2;
constexpr int RAWT = VT + 128 * 72 * 2;
constexpr int RAW_END = RAWT + 3 * 70 * 136 * 2;
constexpr int ABF = RAWT, TRM = ABF + 2 * 64 * 72 * 2, TTR = TRM + 2 * 64 * 72 * 2, AD = TTR + 2 * 64 * 72 * 2, XS = AD + 2 * 4 * 256 * 4, QKP = XS + 2 * 32 * 40 * 2, INV_END = QKP + 64 * 72 * 2;
static_assert(RAW_END <= pgd::STASH && INV_END <= pgd::STASH, "prep gdn v2 LDS map");
}
__device__ __forceinline__ void prep_gdn_range(LAS unsigned char* lds, int bid, bf16* raw, const float* scal, const float* conv_w, const float* conv_b,
                                               const float* A_log, const float* dt_bias, bf16* TQ, int tid_p, int wave_p, int lane_p, float* scal_w) {
    using namespace pg2;
    int tid = tid_p, wave = wave_p, lane = lane_p;
    const int bh = bid >> 3, b = bh >> 3, h = bh & 7, r8 = bid & 7;
    LAS float* cw = (LAS float*)(lds + CW); LAS float* sc = (LAS float*)(lds + SC);
    LAS bf16* q_ = (LAS bf16*)(lds + Q); LAS bf16* k_ = (LAS bf16*)(lds + K); LAS bf16* vT = (LAS bf16*)(lds + VT);
    LAS bf16* rq = (LAS bf16*)(lds + RAWT); LAS bf16* rk = rq + 70 * 136; LAS bf16* rv = rk + 70 * 136;
    LAS bf16* Abf = (LAS bf16*)(lds + ABF); LAS bf16* Trm = (LAS bf16*)(lds + TRM); LAS bf16* Ttr = (LAS bf16*)(lds + TTR);
    LAS float* ADf = (LAS float*)(lds + AD); LAS bf16* Xs = (LAS bf16*)(lds + XS); LAS bf16* QKp = (LAS bf16*)(lds + QKP);
    LAS bf16* st = (LAS bf16*)(lds + pgd::STASH);
    for (int e = tid; e < 8 * 384; e += 512) { const int r = e / 384, c = e % 384;
        const int gch = (c >> 7) * 1024 + h * 128 + (c & 127);
        cw[e] = r < 7 ? conv_w[r * CONV_CH + gch] : conv_b[gch]; }
    const float LOG2E = 1.4426950408889634f;
    const float expAf = expf(A_log[h]), dtbf = dt_bias[h], expAb = expf(A_log[8 + h]), dtbb = dt_bias[8 + h];
    const size_t rowb = (size_t)b * SEQ;
    u32x4 pre[7];
#define PG2_LOAD(u_) do { const int t0_ = (r8 * 16 + (u_)) * 64; \
        _Pragma("unroll") for (int x = 0; x < 7; ++x) { const int e = tid + 512 * x; const int r = e / 48, p = e % 48; \
            pre[x] = (u32x4){0u, 0u, 0u, 0u}; \
            if (e < 70 * 48 && r >= 3 && !(r >= 67 && (u_) == 15)) { const int col = p < 16 ? h * 128 + p * 8 : (p < 32 ? 1024 + h * 128 + (p - 16) * 8 : 2048 + h * 128 + (p - 32) * 8); \
                pre[x] = *(const GAS u32x4*)(raw + (rowb + t0_ - 3 + r) * CONV_CH + col); } } } while (0)
    PG2_LOAD(0);
    float psa = 0.f, psb = 0.f;
#define PG2_LOADS(u_) do { if (wave < 2) { const size_t so_ = (rowb + (size_t)(r8 * 16 + (u_)) * 64 + lane) * 64; psa = scal[so_ + 16 + 8 * wave + h]; psb = scal[so_ + 8 * wave + h]; } } while (0)
    PG2_LOADS(0);
    __syncthreads();
#define PG2_STAGEA(u_) do { const int t0_ = (r8 * 16 + (u_)) * 64; \
        _Pragma("unroll") for (int x = 0; x < 7; ++x) { const int e = tid + 512 * x; const int r = e / 48, p = e % 48; \
            if (e < 70 * 48) { u32x4 v = pre[x]; \
                if (r < 3) v = *(const LAS u32x4*)(st + r * 384 + p * 8); \
                else if (r >= 67 && (u_) == 15) v = *(const LAS u32x4*)(st + 1152 + (r - 67) * 384 + p * 8); \
                *(LAS u32x4*)((p < 16 ? rq + r * 136 + p * 8 : (p < 32 ? rk + r * 136 + (p - 16) * 8 : rv + r * 136 + (p - 32) * 8))) = v; } } \
        if (wave == 0) { const int i = lane; const size_t so = (rowb + t0_ + i) * 64; \
            const float gc = scan_fwd64(-expAf * softplus_fast(psa + dtbf), i); \
            const float be_ = sigmoid_fast(psb); sc[i] = be_; sc[64 + i] = gc * LOG2E; scal_w[so + h] = be_; scal_w[so + 16 + h] = gc; } \
        if (wave == 1) { const int i = lane; const size_t so = (rowb + t0_ + i) * 64; \
            const float gc = scan_bwd64(-expAb * softplus_fast(psa + dtbb), i); \
            const float be_ = sigmoid_fast(psb); sc[128 + i] = be_; sc[192 + i] = gc * LOG2E; scal_w[so + 8 + h] = be_; scal_w[so + 24 + h] = gc; } } while (0)
    PG2_STAGEA(0);
    PG2_LOAD(1); PG2_LOADS(1);
    __syncthreads();
    for (int u = 0; u < 16; ++u) {
        tid = tid_p; asm volatile("" : "+v"(tid));
        lane = tid & 63; wave = __builtin_amdgcn_readfirstlane(tid >> 6);
        const int fr = lane & 15, fq = lane >> 4, half = wave >> 2, w4 = wave & 3;
        const int c = r8 * 16 + u, t0 = c * 64;
        if (tid < 144) { const int r = tid / 48, p = tid % 48;
            const LAS bf16* s = p < 16 ? rq + (64 + r) * 136 + p * 8 : (p < 32 ? rk + (64 + r) * 136 + (p - 16) * 8 : rv + (64 + r) * 136 + (p - 32) * 8);
            *(LAS u32x4*)(st + r * 384 + p * 8) = *(const LAS u32x4*)s; }
        { const int tg = wave, cp = lane; float w[16], o[16];
#pragma unroll
          for (int tap = 0; tap < 8; ++tap) { w[2 * tap] = cw[tap * 384 + 2 * cp]; w[2 * tap + 1] = cw[tap * 384 + 2 * cp + 1]; }
          conv_pair8(o, rq + (8 * tg) * 136 + 2 * cp, 136, w);
#pragma unroll
          for (int t = 0; t < 8; ++t) { o[2 * t] = silu(o[2 * t]); o[2 * t + 1] = silu(o[2 * t + 1]);
              const float rs = __builtin_amdgcn_rsqf(wave_sum(o[2 * t] * o[2 * t] + o[2 * t + 1] * o[2 * t + 1]) + EPS) * 0.08838834764831845f;
              const unsigned pk = pkbf(o[2 * t] * rs, o[2 * t + 1] * rs);
              *(LAS unsigned*)(q_ + (8 * tg + t) * 136 + 2 * cp) = pk; *(GAS unsigned*)(raw + (rowb + t0 + 8 * tg + t) * CONV_CH + h * 128 + 2 * cp) = pk; }
#pragma unroll
          for (int tap = 0; tap < 8; ++tap) { w[2 * tap] = cw[tap * 384 + 128 + 2 * cp]; w[2 * tap + 1] = cw[tap * 384 + 128 + 2 * cp + 1]; }
          conv_pair8(o, rk + (8 * tg) * 136 + 2 * cp, 136, w);
#pragma unroll
          for (int t = 0; t < 8; ++t) { o[2 * t] = silu(o[2 * t]); o[2 * t + 1] = silu(o[2 * t + 1]);
              const float rs = __builtin_amdgcn_rsqf(wave_sum(o[2 * t] * o[2 * t] + o[2 * t + 1] * o[2 * t + 1]) + EPS);
              const unsigned pk = pkbf(o[2 * t] * rs, o[2 * t + 1] * rs);
              *(LAS unsigned*)(k_ + (8 * tg + t) * 136 + 2 * cp) = pk; *(GAS unsigned*)(raw + (rowb + t0 + 8 * tg + t) * CONV_CH + 1024 + h * 128 + 2 * cp) = pk; }
#pragma unroll
          for (int tap = 0; tap < 8; ++tap) { w[2 * tap] = cw[tap * 384 + 256 + 2 * cp]; w[2 * tap + 1] = cw[tap * 384 + 256 + 2 * cp + 1]; }
          conv_pair8(o, rv + (8 * tg) * 136 + 2 * cp, 136, w);
#pragma unroll
          for (int t = 0; t < 16; ++t) o[t] = silu(o[t]);
          u32x4 e0, e1; e0.x = pkbf(o[0], o[2]); e0.y = pkbf(o[4], o[6]); e0.z = pkbf(o[8], o[10]); e0.w = pkbf(o[12], o[14]);
          e1.x = pkbf(o[1], o[3]); e1.y = pkbf(o[5], o[7]); e1.z = pkbf(o[9], o[11]); e1.w = pkbf(o[13], o[15]);
          *(LAS u32x4*)(vT + (2 * cp) * 72 + 8 * tg) = e0; *(LAS u32x4*)(vT + (2 * cp + 1) * 72 + 8 * tg) = e1;
        }
        __syncthreads();
        for (int e = tid; e < 128 * 8; e += 512) { const int dv = e >> 3, p = e & 7;
            *(GAS u32x4*)(raw + (rowb + t0 + (dv >> 1)) * CONV_CH + 2048 + h * 128 + (dv & 1) * 64 + p * 8) = *(const LAS u32x4*)(vT + dv * 72 + p * 8); }
        for (int e = tid; e < 2 * 2 * 64 * 72 * 2 / 16; e += 512) ((LAS u32x4*)(lds + TRM))[e] = (u32x4){0u, 0u, 0u, 0u};
        for (int e = tid; e < 2 * 32 * 40 * 2 / 16; e += 512) ((LAS u32x4*)(lds + XS))[e] = (u32x4){0u, 0u, 0u, 0u};
        { const int mt = w4;
          f32x4 acc[1][4];
#pragma unroll
          for (int nt = 0; nt < 4; ++nt) acc[0][nt] = (f32x4){0.f, 0.f, 0.f, 0.f};
          mma_lds<1, 4>(acc, half ? q_ : k_, 136, mt * 16, k_, 136, 0, 128, fr, fq);
          const int i0 = mt * 16 + 4 * fq;
          const f32x4 gfi = *(const LAS f32x4*)(sc + 64 + i0), gbi = *(const LAS f32x4*)(sc + 192 + i0), bfi = *(const LAS f32x4*)(sc + i0), bbi = *(const LAS f32x4*)(sc + 128 + i0);
          float gfj[4], gbj[4];
#pragma unroll
          for (int nt = 0; nt < 4; ++nt) { gfj[nt] = sc[64 + nt * 16 + fr]; gbj[nt] = sc[192 + nt * 16 + fr]; }
          asm volatile("" ::: "memory");
#pragma unroll
          for (int nt = 0; nt < 4; ++nt)
#pragma unroll
              for (int r = 0; r < 4; ++r) { const int i = i0 + r, j = nt * 16 + fr; const bool lower = i > j, upper = i < j;
                  const float argl = gfi[r] - gfj[nt], argu = gbi[r] - gbj[nt];
                  const float x = acc[0][nt][r] * __builtin_amdgcn_exp2f(fminf(lower ? argl : argu, 0.f));
                  if (half == 0) { const float af = lower ? bfi[r] * x : 0.f, ab = upper ? bbi[r] * x : 0.f;
                      Abf[i * 72 + j] = f2bf1(af); Abf[64 * 72 + j * 72 + i] = f2bf1(ab);
                      if (mt == nt) { ADf[(mt * 16 + (i & 15)) * 16 + (j & 15)] = af; ADf[1024 + (mt * 16 + (j & 15)) * 16 + (i & 15)] = ab; } }
                  else QKp[i * 72 + j] = f2bf1(i == j ? acc[0][nt][r] : x); }
        }
        __syncthreads();
        { LAS bf16* Ab = Abf + half * 64 * 72; LAS bf16* Tr = Trm + half * 64 * 72; LAS bf16* Tt = Ttr + half * 64 * 72; LAS bf16* Xh = Xs + half * 32 * 40;
          if (w4 == 0) { const int blk = lane >> 4, cc = lane & 15; float t[16]; const LAS float* ad = ADf + half * 1024 + blk * 256;
#pragma unroll
              for (int i = 0; i < 16; ++i) t[i] = (i == cc) ? 1.f : 0.f;
#pragma unroll
              for (int i = 1; i < 16; ++i) { float s0 = 0.f, s1 = 0.f;
#pragma unroll
                  for (int j = 0; j < i; ++j) { if (j & 1) s1 += ad[i * 16 + j] * t[j]; else s0 += ad[i * 16 + j] * t[j]; }
                  t[i] = (i > cc) ? -(s0 + s1) : t[i];
                  if ((i & 3) == 3) asm volatile("" ::: "memory"); }
#pragma unroll
              for (int i = 0; i < 16; ++i) { const unsigned short tb = f2bf1(t[i]); Tr[(blk * 16 + i) * 72 + blk * 16 + cc] = tb; Tt[(blk * 16 + cc) * 72 + blk * 16 + i] = tb; } }
          __syncthreads();
          f32x4 a1[1][1];
          if (w4 < 2) { const int J = 2 * w4, I = J + 1; a1[0][0] = (f32x4){0.f, 0.f, 0.f, 0.f};
              mma_lds<1, 1>(a1, Ab + 16 * J, 72, 16 * I, Tt + 16 * J, 72, 16 * J, 32, fr, fq);
              u32x2 wv; wv.x = pkbf(a1[0][0][0], a1[0][0][1]); wv.y = pkbf(a1[0][0][2], a1[0][0][3]);
              *(LAS u32x2*)(Xh + (w4 * 16 + fr) * 40 + 4 * fq) = wv; }
          __syncthreads();
          if (w4 < 2) { const int J = 2 * w4, I = J + 1; a1[0][0] = (f32x4){0.f, 0.f, 0.f, 0.f};
              mma_lds<1, 1>(a1, Tr + 16 * I, 72, 16 * I, Xh, 40, w4 * 16, 32, fr, fq);
#pragma unroll
              for (int r = 0; r < 4; ++r) Tr[(16 * I + 4 * fq + r) * 72 + 16 * J + fr] = f2bf1(-a1[0][0][r]);
              u32x2 wv; wv.x = pkbf(-a1[0][0][0], -a1[0][0][1]); wv.y = pkbf(-a1[0][0][2], -a1[0][0][3]);
              *(LAS u32x2*)(Tt + (16 * J + fr) * 72 + 16 * I + 4 * fq) = wv; }
          __syncthreads();
          { const int mt2 = w4 >> 1, nt2 = w4 & 1; a1[0][0] = (f32x4){0.f, 0.f, 0.f, 0.f};
            mma_lds<1, 1>(a1, Ab, 72, 32 + 16 * mt2, Tt, 72, 16 * nt2, 32, fr, fq);
            u32x2 wv; wv.x = pkbf(a1[0][0][0], a1[0][0][1]); wv.y = pkbf(a1[0][0][2], a1[0][0][3]);
            __syncthreads();
            *(LAS u32x2*)(Xh + (16 * nt2 + fr) * 40 + 16 * mt2 + 4 * fq) = wv;
            __syncthreads();
            a1[0][0] = (f32x4){0.f, 0.f, 0.f, 0.f};
            mma_lds<1, 1>(a1, Tr + 32, 72, 32 + 16 * mt2, Xh, 40, 16 * nt2, 32, fr, fq);
#pragma unroll
            for (int r = 0; r < 4; ++r) Tr[(32 + 16 * mt2 + 4 * fq + r) * 72 + 16 * nt2 + fr] = f2bf1(-a1[0][0][r]);
            u32x2 w2; w2.x = pkbf(-a1[0][0][0], -a1[0][0][1]); w2.y = pkbf(-a1[0][0][2], -a1[0][0][3]);
            *(LAS u32x2*)(Tt + (16 * nt2 + fr) * 72 + 32 + 16 * mt2 + 4 * fq) = w2; }
        }
        __syncthreads();
        { bf16* tq = TQ + ((size_t)(bh * NCHUNK + c)) * 8192;
          const int i = (tid >> 3) & 63, p = tid & 7;
          const u32x4 qkv = *(const LAS u32x4*)(QKp + i * 72 + p * 8);
          const bf16x8 lo = *(const LAS bf16x8*)(Trm + i * 72 + p * 8), up = *(const LAS bf16x8*)(Ttr + 64 * 72 + i * 72 + p * 8); bf16x8 o8;
#pragma unroll
          for (int y = 0; y < 8; ++y) { const int j = p * 8 + y; o8[y] = (i > j) ? lo[y] : (i < j ? up[y] : (short)0x3F80); }
          __syncthreads();
          if (u + 1 < 16) { PG2_STAGEA(u + 1); }
          asm volatile("" ::: "memory");
          *(GAS bf16x8*)(tq + i * 64 + p * 8) = o8; *(GAS u32x4*)(tq + 4096 + i * 64 + p * 8) = qkv;
          if (u + 2 < 16) { PG2_LOAD(u + 2); PG2_LOADS(u + 2); } }
        __syncthreads();
    }
#undef PG2_STAGEA
#undef PG2_LOAD
#undef PG2_LOADS
}

__device__ __forceinline__ void gdn_state_v1(LAS unsigned char* lds, int cid, const bf16* raw, const float* scal, const bf16* TQ,
                                             const float* A_log, const float* dt_bias, bf16* og, int tid, int wave, int lane) {
    using namespace gdn;
    const int dvh = cid & 1, dir = (cid >> 1) & 1, h = (cid >> 2) & 7, b = cid >> 5;
    const int fr = lane & 15, fq = lane >> 4;
    LAS float* sc = (LAS float*)(lds + SC);
    LAS bf16* q_ = (LAS bf16*)(lds + Q); LAS bf16* k_ = (LAS bf16*)(lds + K); LAS bf16* kdT = (LAS bf16*)(lds + KDT); LAS bf16* vT = (LAS bf16*)(lds + VT);
    LAS bf16* T_ = (LAS bf16*)(lds + T); LAS bf16* QKd = (LAS bf16*)(lds + QKD); LAS bf16* ST_ = (LAS bf16*)(lds + ST);
    LAS bf16* rT = (LAS bf16*)(lds + RT); LAS bf16* uT = (LAS bf16*)(lds + UT); LAS float* os = (LAS float*)(lds + OS);
    for (int e = tid; e < 64 * 136 / 2; e += 512) ((LAS unsigned*)ST_)[e] = 0u;
    const float expA = expf(A_log[dir * 8 + h]), dtb = dt_bias[dir * 8 + h];
    f32x4 sacc[4];
#pragma unroll
    for (int nt = 0; nt < 4; ++nt) sacc[nt] = (f32x4){0.f, 0.f, 0.f, 0.f};
    const size_t rowb = (size_t)b * SEQ; const int bh = b * 8 + h;
    __syncthreads();
    for (int n = 0; n < NCHUNK; ++n) {
        const int c = dir ? NCHUNK - 1 - n : n, t0 = c * 64;
        for (int e = tid; e < 64 * 16; e += 512) { const int r = e >> 4, p = e & 15;
            *(LAS u32x4*)(q_ + r * 136 + p * 8) = *(const GAS u32x4*)(raw + (rowb + t0 + r) * CONV_CH + h * 128 + p * 8);
            *(LAS u32x4*)(k_ + r * 136 + p * 8) = *(const GAS u32x4*)(raw + (rowb + t0 + r) * CONV_CH + 1024 + h * 128 + p * 8); }
        { const int dvl = tid >> 3, p = tid & 7; const int dv = dvh * 64 + dvl;
          *(LAS u32x4*)(vT + dvl * 72 + p * 8) = *(const GAS u32x4*)(raw + (rowb + t0 + (dv >> 1)) * CONV_CH + 2048 + h * 128 + (dv & 1) * 64 + p * 8); }
        { const bf16* tq = TQ + ((size_t)(bh * NCHUNK + c)) * 8192;
          for (int e = tid; e < 1024; e += 512) { const int which = e >> 9, i = (e >> 3) & 63, p = e & 7;
              bf16x8 v = *(const GAS bf16x8*)(tq + which * 4096 + i * 64 + p * 8);
#pragma unroll
              for (int x = 0; x < 8; ++x) { const int j = p * 8 + x; const bool keep = dir ? (i < j) : (i > j);
                  if (i == j) { if (which == 0) v[x] = (short)0x3F80; } else if (!keep) v[x] = 0; }
              *(LAS bf16x8*)((which ? QKd : T_) + i * 72 + p * 8) = v; } }
        if (wave == 0) { const int i = lane; const size_t so = (rowb + t0 + i) * 64;
            const float g = -expA * softplus_f(scal[so + 16 + dir * 8 + h] + dtb); float gc = g;
            if (dir == 0) {
#pragma unroll
                for (int o = 1; o < 64; o <<= 1) { const float y = __shfl_up(gc, o); if (i >= o) gc += y; }
            } else {
#pragma unroll
                for (int o = 1; o < 64; o <<= 1) { const float y = __shfl_down(gc, o); if (i + o < 64) gc += y; }
            }
            const float gl = __shfl(gc, dir ? 0 : 63);
            sc[i] = sigmoid_f(scal[so + dir * 8 + h]); sc[64 + i] = gc; sc[128 + i] = expf(gc); sc[192 + i] = expf(gl - gc); if (i == 0) sc[256] = expf(gl); }
        __syncthreads();
        { const int i = tid >> 3, cg = tid & 7; const float ek = sc[192 + i];
          const bf16x8 k0 = *(const LAS bf16x8*)(k_ + i * 136 + cg * 16), k1 = *(const LAS bf16x8*)(k_ + i * 136 + cg * 16 + 8);
#pragma unroll
          for (int x = 0; x < 8; ++x) { kdT[(cg * 16 + x) * 72 + i] = f2bf1(bf2f_s(k0[x]) * ek); kdT[(cg * 16 + 8 + x) * 72 + i] = f2bf1(bf2f_s(k1[x]) * ek); } }
        __syncthreads();
        const int mt = wave & 3, nh = wave >> 2;
        f32x4 aq[2];
        { f32x4 ak[2]; ak[0] = ak[1] = aq[0] = aq[1] = (f32x4){0.f, 0.f, 0.f, 0.f};
          for (int k0 = 0; k0 < 128; k0 += 32) {
              const bf16x8 fk = *(const LAS bf16x8*)(k_ + (mt * 16 + fr) * 136 + k0 + fq * 8), fqv = *(const LAS bf16x8*)(q_ + (mt * 16 + fr) * 136 + k0 + fq * 8);
#pragma unroll
              for (int nl = 0; nl < 2; ++nl) { const bf16x8 fb = *(const LAS bf16x8*)(ST_ + (nh * 32 + nl * 16 + fr) * 136 + k0 + fq * 8);
                  ak[nl] = __builtin_amdgcn_mfma_f32_16x16x32_bf16(fk, fb, ak[nl], 0, 0, 0); aq[nl] = __builtin_amdgcn_mfma_f32_16x16x32_bf16(fqv, fb, aq[nl], 0, 0, 0); } }
          const int i0 = mt * 16 + 4 * fq;
          const f32x4 be4 = *(const LAS f32x4*)(sc + i0), eg4 = *(const LAS f32x4*)(sc + 128 + i0);
#pragma unroll
          for (int nl = 0; nl < 2; ++nl) { const int dv = nh * 32 + nl * 16 + fr;
              const bf16x4 vv = *(const LAS bf16x4*)(vT + dv * 72 + i0);
              float r0 = be4[0] * (bf2f_s(vv[0]) - eg4[0] * ak[nl][0]), r1 = be4[1] * (bf2f_s(vv[1]) - eg4[1] * ak[nl][1]);
              float r2 = be4[2] * (bf2f_s(vv[2]) - eg4[2] * ak[nl][2]), r3 = be4[3] * (bf2f_s(vv[3]) - eg4[3] * ak[nl][3]);
              u32x2 w; w.x = pkbf(r0, r1); w.y = pkbf(r2, r3); *(LAS u32x2*)(rT + dv * 72 + i0) = w;
              aq[nl][0] *= eg4[0]; aq[nl][1] *= eg4[1]; aq[nl][2] *= eg4[2]; aq[nl][3] *= eg4[3]; }
        }
        __syncthreads();
        { f32x4 au[1][2]; au[0][0] = au[0][1] = (f32x4){0.f, 0.f, 0.f, 0.f};
          mma_lds<1, 2>(au, T_, 72, mt * 16, rT, 72, nh * 32, 64, fr, fq);
          const int i0 = mt * 16 + 4 * fq;
#pragma unroll
          for (int nl = 0; nl < 2; ++nl) { const int dv = nh * 32 + nl * 16 + fr; u32x2 w; w.x = pkbf(au[0][nl][0], au[0][nl][1]); w.y = pkbf(au[0][nl][2], au[0][nl][3]); *(LAS u32x2*)(uT + dv * 72 + i0) = w; }
        }
        __syncthreads();
        { f32x4 ao[1][2]; ao[0][0] = aq[0]; ao[0][1] = aq[1];
          mma_lds<1, 2>(ao, QKd, 72, mt * 16, uT, 72, nh * 32, 64, fr, fq);
          const int i0 = mt * 16 + 4 * fq;
#pragma unroll
          for (int nl = 0; nl < 2; ++nl)
#pragma unroll
              for (int r = 0; r < 4; ++r) os[(i0 + r) * 65 + nh * 32 + nl * 16 + fr] = ao[0][nl][r];
          const float egl = sc[256];
          f32x4 as_[1][4];
#pragma unroll
          for (int nt = 0; nt < 4; ++nt) as_[0][nt] = sacc[nt] * egl;
          mma_lds<1, 4>(as_, kdT, 72, wave * 16, uT, 72, 0, 64, fr, fq);
#pragma unroll
          for (int nt = 0; nt < 4; ++nt) { sacc[nt] = as_[0][nt];
              u32x2 w; w.x = pkbf(sacc[nt][0], sacc[nt][1]); w.y = pkbf(sacc[nt][2], sacc[nt][3]); *(LAS u32x2*)(ST_ + (nt * 16 + fr) * 136 + wave * 16 + 4 * fq) = w; }
        }
        __syncthreads();
#pragma unroll
        for (int ii = 0; ii < 4; ++ii) { const int i = wave * 8 + 2 * ii + (lane >> 5), cp = lane & 31;
            atomic_add_bf16x2(og + (rowb + t0 + i) * 1024 + h * 128 + dvh * 64 + 2 * cp, os[i * 65 + 2 * cp], os[i * 65 + 2 * cp + 1]); }
        __syncthreads();
    }
}
typedef float f32x16 __attribute__((ext_vector_type(16)));
typedef short v4i16_t __attribute__((ext_vector_type(4)));
namespace gs2 {
constexpr int KO = 0;
constexpr int QO = KO + 64 * 132 * 2;
constexpr int VTO = QO + 64 * 132 * 2;
constexpr int TO = VTO + 64 * 68 * 2;
constexpr int QKO = TO + 64 * 68 * 2;
constexpr int SCO = QKO + 64 * 68 * 2;
constexpr int BUF = SCO + 1024;
constexpr int OST = 2 * BUF;
constexpr int END = OST + 2 * 64 * 72 * 2;
static_assert(END <= MISC_OFF && BUF % 16 == 0, "gdn state LDS map");
}
__device__ __forceinline__ bf16x8 cvt8(const f32x16& x, int base) {
    u32x4 w; w.x = pkbf(x[base], x[base + 1]); w.y = pkbf(x[base + 2], x[base + 3]); w.z = pkbf(x[base + 4], x[base + 5]); w.w = pkbf(x[base + 6], x[base + 7]);
    return __builtin_bit_cast(bf16x8, w);
}
__device__ __forceinline__ bf16x8 afrag(const LAS bf16* p) {
    const bf16x4 lo = *(const LAS bf16x4*)p, hi = *(const LAS bf16x4*)(p + 8);
    return (bf16x8){lo[0], lo[1], lo[2], lo[3], hi[0], hi[1], hi[2], hi[3]};
}
__device__ __forceinline__ bf16x8 afrag_tr(const LAS bf16* p, int ld) {
    const v4i16_t lo = __builtin_amdgcn_ds_read_tr16_b64_v4i16((LAS v4i16_t*)p), hi = __builtin_amdgcn_ds_read_tr16_b64_v4i16((LAS v4i16_t*)(p + 8 * ld));
    return (bf16x8){lo[0], lo[1], lo[2], lo[3], hi[0], hi[1], hi[2], hi[3]};
}
#define MFMA32(a, b, c) __builtin_amdgcn_mfma_f32_32x32x16_bf16((a), (b), (c), 0, 0, 0)

#ifndef WG_BAR
#define WG_BAR() asm volatile("s_waitcnt lgkmcnt(0)\n\ts_barrier" ::: "memory")
#endif
template <int DIR>
__device__ __forceinline__ void gdn_state2(LAS unsigned char* lds, int b, int h, int half, const bf16* raw, const float* scal, const bf16* TQ,
                                           const float* A_log, const float* dt_bias, bf16* og, int tid, int wave, int lane, float* probe = nullptr) {
    using namespace gs2;
    const size_t rowb = (size_t)b * SEQ; const int bh = b * 8 + h;
    const float expA = expf(A_log[DIR * 8 + h]), dtb = dt_bias[DIR * 8 + h];
    LAS bf16* ost = (LAS bf16*)(lds + OST);
    const int r31 = lane & 31, hh = lane >> 5;
    if (wave == 4 || wave == 5) {
        for (int n = 0; n < NCHUNK + 1; ++n) WG_BAR();
    } else if (wave >= 2) {
        const int hw = (wave & 1) | ((wave >> 2) << 1);
        const int ht = hw * 64 + lane;
        unsigned go[14], lo_[14]; u32x4 ld[14]; float sr0 = 0.f, sr1 = 0.f;
#pragma unroll
        for (int x = 0; x < 4; ++x) { const int e = ht + 256 * x, r = e >> 4, p = e & 15;
            go[x] = (unsigned)((r * CONV_CH + 1024 + h * 128 + p * 8) * 2); go[4 + x] = (unsigned)((r * CONV_CH + h * 128 + p * 8) * 2);
            lo_[x] = (unsigned)(KO + (r * 132 + p * 8) * 2); lo_[4 + x] = (unsigned)(QO + (r * 132 + p * 8) * 2); }
#pragma unroll
        for (int x = 0; x < 2; ++x) { const int e = ht + 256 * x, dvl = e >> 3, p = e & 7; const int dv = 64 * half + dvl;
            go[8 + x] = (unsigned)(((dv >> 1) * CONV_CH + 2048 + h * 128 + (dv & 1) * 64 + p * 8) * 2); lo_[8 + x] = (unsigned)(VTO + (dvl * 68 + p * 8) * 2); }
        u32x4 km[2], dg[2], qm[2];
#pragma unroll
        for (int x = 0; x < 2; ++x) { const int e = ht + 256 * x, i = e >> 3, p = e & 7;
            go[10 + x] = (unsigned)(e * 16); go[12 + x] = (unsigned)(8192 + e * 16);
            lo_[10 + x] = (unsigned)(TO + (i * 68 + p * 8) * 2); lo_[12 + x] = (unsigned)(QKO + (i * 68 + p * 8) * 2);
            unsigned kw[4], dw[4], qw[4];
#pragma unroll
            for (int w = 0; w < 4; ++w) { const int j0 = p * 8 + 2 * w, j1 = j0 + 1;
                const bool k0 = DIR ? (i < j0) : (i > j0), k1 = DIR ? (i < j1) : (i > j1);
                kw[w] = (k0 ? 0xFFFFu : 0u) | (k1 ? 0xFFFF0000u : 0u); dw[w] = (i == j0 ? 0x3F80u : 0u) | (i == j1 ? 0x3F800000u : 0u);
                qw[w] = kw[w] | (i == j0 ? 0xFFFFu : 0u) | (i == j1 ? 0xFFFF0000u : 0u); }
            km[x] = (u32x4){kw[0], kw[1], kw[2], kw[3]}; dg[x] = (u32x4){dw[0], dw[1], dw[2], dw[3]}; qm[x] = (u32x4){qw[0], qw[1], qw[2], qw[3]}; }
        const unsigned so_l = (unsigned)(lane * 256 + (DIR * 8 + h) * 4);
#define GS2_ISSUE(c_) do { const GAS char* rb_ = (const GAS char*)(raw + (rowb + (size_t)(c_) * 64) * CONV_CH); const GAS char* tb_ = (const GAS char*)(TQ + ((size_t)(bh * NCHUNK + (c_))) * 8192); \
            _Pragma("unroll") for (int x = 0; x < 10; ++x) ld[x] = *(const GAS u32x4*)(rb_ + go[x]); \
            _Pragma("unroll") for (int x = 10; x < 14; ++x) ld[x] = *(const GAS u32x4*)(tb_ + go[x]); \
            if (hw == 0) { const GAS char* sb_ = (const GAS char*)(scal + (rowb + (size_t)(c_) * 64) * 64); sr0 = *(const GAS float*)(sb_ + so_l); sr1 = *(const GAS float*)(sb_ + so_l + 64); } } while (0)
#define GS2_ST16(off_, v_) do { LAS unsigned char* d_ = B_ + (off_); *(LAS u32x2*)(d_) = (u32x2){(v_).x, (v_).y}; *(LAS u32x2*)(d_ + 8) = (u32x2){(v_).z, (v_).w}; } while (0)
#define GS2_COMMIT(bi_, c_) do { LAS unsigned char* B_ = lds + (bi_) * BUF; \
            _Pragma("unroll") for (int x = 0; x < 10; ++x) GS2_ST16(lo_[x], ld[x]); \
            _Pragma("unroll") for (int x = 0; x < 2; ++x) { const u32x4 tv = (ld[10 + x] & km[x]) | dg[x], qv = ld[12 + x] & qm[x]; \
                GS2_ST16(lo_[10 + x], tv); GS2_ST16(lo_[12 + x], qv); } \
            if (hw == 0) { LAS float* sc_ = (LAS float*)(B_ + SCO); const int i = lane; const float gc = sr1; const float gl = __shfl(gc, DIR ? 0 : 63); \
                sc_[i] = sr0; sc_[64 + i] = __expf(gc); sc_[128 + i] = __expf(gl - gc); if (i == 0) sc_[192] = __expf(gl); } } while (0)
        { const int c0 = DIR ? NCHUNK - 1 : 0; GS2_ISSUE(c0); GS2_COMMIT(0, c0); GS2_ISSUE((DIR ? c0 - 1 : c0 + 1)); }
        for (int n = 0; n < NCHUNK; ++n) {
            const int c = DIR ? NCHUNK - 1 - n : n;
            WG_BAR();
            const bool more = n + 1 < NCHUNK; const int cn = DIR ? c - 1 : c + 1;
            if (more) { GS2_COMMIT((n + 1) & 1, cn); if (n + 2 < NCHUNK) GS2_ISSUE((DIR ? cn - 1 : cn + 1)); }
            unsigned ov[8];
            if (n > 0) {
#pragma unroll
                for (int x = 0; x < 8; ++x) ov[x] = *(const LAS unsigned*)(ost + ((n - 1) & 1) * (64 * 72) + (hw * 16 + 2 * x + (lane >> 5)) * 72 + 2 * (lane & 31));
            }
            if (n > 0) { const int tp = (DIR ? c + 1 : c - 1) * 64;
#pragma unroll
                for (int x = 0; x < 8; ++x) { GAS char* ob_ = (GAS char*)(og + (rowb + tp + hw * 16 + 2 * x) * 1024 + h * 128 + half * 64);
                    (void)__builtin_amdgcn_global_atomic_fadd_v2bf16((GAS s16x2*)(ob_ + (lane >> 5) * 2048 + (lane & 31) * 4), __builtin_bit_cast(s16x2, ov[x])); } }
        }
        WG_BAR();
        { const int tp = (DIR ? 0 : NCHUNK - 1) * 64;
#pragma unroll
          for (int x = 0; x < 8; ++x) { const unsigned v = *(const LAS unsigned*)(ost + ((NCHUNK - 1) & 1) * (64 * 72) + (hw * 16 + 2 * x + (lane >> 5)) * 72 + 2 * (lane & 31));
              GAS char* ob_ = (GAS char*)(og + (rowb + tp + hw * 16 + 2 * x) * 1024 + h * 128 + half * 64);
              (void)__builtin_amdgcn_global_atomic_fadd_v2bf16((GAS s16x2*)(ob_ + (lane >> 5) * 2048 + (lane & 31) * 4), __builtin_bit_cast(s16x2, v)); } }
#undef GS2_ISSUE
#undef GS2_COMMIT
#undef GS2_ST16
    } else {
        const int dv0 = 32 * wave;
#if defined(PROBE_STATE)
        unsigned long long tw_ = 0ull; const unsigned long long ts0_ = __builtin_amdgcn_s_memtime();
#define PB_BAR() do { const unsigned long long t0_ = __builtin_amdgcn_s_memtime(); WG_BAR(); tw_ += __builtin_amdgcn_s_memtime() - t0_; } while (0)
#else
#define PB_BAR() WG_BAR()
#endif
        f32x16 St[4];
#pragma unroll
        for (int t = 0; t < 4; ++t)
#pragma unroll
            for (int r = 0; r < 16; ++r) St[t][r] = 0.f;
        for (int n = 0; n < NCHUNK; ++n) {
            PB_BAR();
            const LAS unsigned char* Bb = lds + (n & 1) * BUF;
            const LAS bf16* Kb = (const LAS bf16*)(Bb + KO); const LAS bf16* Qb = (const LAS bf16*)(Bb + QO); const LAS bf16* Vb = (const LAS bf16*)(Bb + VTO);
            const LAS bf16* Tb = (const LAS bf16*)(Bb + TO); const LAS bf16* QKb = (const LAS bf16*)(Bb + QKO); const LAS float* sc = (const LAS float*)(Bb + SCO);
            f32x16 aK[2];
#pragma unroll
            for (int m = 0; m < 2; ++m)
#pragma unroll
                for (int r = 0; r < 16; ++r) aK[m][r] = 0.f;
            bf16x8 fa[2][2];
            const int offk = r31 * 132 + 4 * hh;
#define GS2_LD2(P_, bi_, ks_) do { fa[bi_][0] = afrag((P_) + offk + 16 * (ks_)); fa[bi_][1] = afrag((P_) + offk + 32 * 132 + 16 * (ks_)); } while (0)
            GS2_LD2(Kb, 0, 0);
#pragma unroll
            for (int ks = 0; ks < 8; ++ks) {
                if (ks < 7) GS2_LD2(Kb, (ks + 1) & 1, ks + 1);
                __builtin_amdgcn_sched_barrier(0);
                const bf16x8 bs = cvt8(St[ks >> 1], 8 * (ks & 1));
                aK[0] = MFMA32(fa[ks & 1][0], bs, aK[0]); aK[1] = MFMA32(fa[ks & 1][1], bs, aK[1]);
                __builtin_amdgcn_sched_barrier(0); }
            bf16x8 ft[8];
#pragma unroll
            for (int mi = 0; mi < 2; ++mi)
#pragma unroll
                for (int kt = 0; kt < 4; ++kt) { const bool need = DIR ? (kt >= 2 * mi) : (kt <= 2 * mi + 1);
                    if (need) ft[mi * 4 + kt] = afrag(Tb + (32 * mi + r31) * 68 + 16 * kt + 4 * hh); }
#pragma unroll
            for (int m = 0; m < 2; ++m)
#pragma unroll
                for (int q4 = 0; q4 < 4; ++q4) { const int tb = 32 * m + 8 * q4 + 4 * hh;
                    const bf16x4 vv = *(const LAS bf16x4*)(Vb + (dv0 + r31) * 68 + tb); const f32x4 be = *(const LAS f32x4*)(sc + tb), eg = *(const LAS f32x4*)(sc + 64 + tb);
#pragma unroll
                    for (int e = 0; e < 4; ++e) aK[m][4 * q4 + e] = be[e] * (bf2f_s(vv[e]) - eg[e] * aK[m][4 * q4 + e]); }
            const bf16x8 br0 = cvt8(aK[0], 0), br1 = cvt8(aK[0], 8), br2 = cvt8(aK[1], 0), br3 = cvt8(aK[1], 8);
            __builtin_amdgcn_sched_barrier(0);
            f32x16 au[2];
#pragma unroll
            for (int m = 0; m < 2; ++m)
#pragma unroll
                for (int r = 0; r < 16; ++r) au[m][r] = 0.f;
            GS2_LD2(Qb, 0, 0);
#pragma unroll
            for (int mi = 0; mi < 2; ++mi)
#pragma unroll
                for (int kt = 0; kt < 4; ++kt) { const bool need = DIR ? (kt >= 2 * mi) : (kt <= 2 * mi + 1);
                    if (need) au[mi] = MFMA32(ft[mi * 4 + kt], (kt == 0 ? br0 : kt == 1 ? br1 : kt == 2 ? br2 : br3), au[mi]); }
            __builtin_amdgcn_sched_barrier(0);
            f32x16 aQ[2];
#pragma unroll
            for (int m = 0; m < 2; ++m)
#pragma unroll
                for (int r = 0; r < 16; ++r) aQ[m][r] = 0.f;
#pragma unroll
            for (int ks = 0; ks < 8; ++ks) {
                if (ks < 7) GS2_LD2(Qb, (ks + 1) & 1, ks + 1);
                __builtin_amdgcn_sched_barrier(0);
                const bf16x8 bs = cvt8(St[ks >> 1], 8 * (ks & 1));
                aQ[0] = MFMA32(fa[ks & 1][0], bs, aQ[0]); aQ[1] = MFMA32(fa[ks & 1][1], bs, aQ[1]);
                __builtin_amdgcn_sched_barrier(0); }
#undef GS2_LD2
            const bf16x8 bu0 = cvt8(au[0], 0), bu1 = cvt8(au[0], 8), bu2 = cvt8(au[1], 0), bu3 = cvt8(au[1], 8);
#pragma unroll
            for (int m = 0; m < 2; ++m)
#pragma unroll
                for (int q4 = 0; q4 < 4; ++q4) { const int tb = 32 * m + 8 * q4 + 4 * hh; const f32x4 ek = *(const LAS f32x4*)(sc + 128 + tb), eg = *(const LAS f32x4*)(sc + 64 + tb);
#pragma unroll
                    for (int e = 0; e < 4; ++e) { au[m][4 * q4 + e] *= ek[e]; aQ[m][4 * q4 + e] *= eg[e]; } }
            const bf16x8 bd0 = cvt8(au[0], 0), bd1 = cvt8(au[0], 8), bd2 = cvt8(au[1], 0), bd3 = cvt8(au[1], 8);
            __builtin_amdgcn_sched_barrier(0);
            bf16x8 fqk[8];
#pragma unroll
            for (int mi = 0; mi < 2; ++mi)
#pragma unroll
                for (int kt = 0; kt < 4; ++kt) { const bool need = DIR ? (kt >= 2 * mi) : (kt <= 2 * mi + 1);
                    if (need) fqk[mi * 4 + kt] = afrag(QKb + (32 * mi + r31) * 68 + 16 * kt + 4 * hh); }
            const int i16 = r31 & 15; const LAS bf16* kp = Kb + (4 * hh + (i16 >> 2)) * 132 + 16 * (r31 >> 4) + 4 * (i16 & 3);
            bf16x8 fk[2][4];
#define GS2_LDKT(bi_, t_) do { _Pragma("unroll") for (int kt = 0; kt < 4; ++kt) fk[bi_][kt] = afrag_tr(kp + (16 * kt) * 132 + 32 * (t_), 132); } while (0)
            __builtin_amdgcn_sched_barrier(0);
#pragma unroll
            for (int mi = 0; mi < 2; ++mi)
#pragma unroll
                for (int kt = 0; kt < 4; ++kt) { const bool need = DIR ? (kt >= 2 * mi) : (kt <= 2 * mi + 1);
                    if (need) aQ[mi] = MFMA32(fqk[mi * 4 + kt], (kt == 0 ? bu0 : kt == 1 ? bu1 : kt == 2 ? bu2 : bu3), aQ[mi]); }
            GS2_LDKT(0, 0);
            const float egl = sc[192];
#pragma unroll
            for (int mi = 0; mi < 2; ++mi)
#pragma unroll
                for (int r = 0; r < 16; ++r) ost[(n & 1) * (64 * 72) + (32 * mi + (r & 3) + 8 * (r >> 2) + 4 * hh) * 72 + dv0 + r31] = f2bf1(aQ[mi][r]);
#pragma unroll
            for (int t = 0; t < 4; ++t) {
                if (t < 3) GS2_LDKT((t + 1) & 1, t + 1);
                __builtin_amdgcn_sched_barrier(0);
#pragma unroll
                for (int r = 0; r < 16; ++r) St[t][r] *= egl;
                St[t] = MFMA32(fk[t & 1][0], bd0, St[t]); St[t] = MFMA32(fk[t & 1][1], bd1, St[t]);
                St[t] = MFMA32(fk[t & 1][2], bd2, St[t]); St[t] = MFMA32(fk[t & 1][3], bd3, St[t]);
                __builtin_amdgcn_sched_barrier(0); }
#undef GS2_LDKT
        }
        WG_BAR();
#if defined(PROBE_STATE)
        if (blockIdx.x == 0 && tid == 0 && probe) { const unsigned long long tt_ = __builtin_amdgcn_s_memtime() - ts0_; *probe = (float)((double)tw_ / (double)tt_); }
#endif
    }
}
constexpr size_t WS_SSC = 1 * MiB;
namespace psd {
constexpr int CW = 0;
constexpr int SC = CW + 8 * 768 * 4;
constexpr int BM_ = SC + 8 * 4 * 64 * 4;
constexpr int CM_ = BM_ + 64 * 136 * 2;
constexpr int CB = CM_ + 64 * 136 * 2;
constexpr int R = CB + 64 * 68 * 4;
constexpr int RBC = R, RBC_END = R + 70 * 272 * 2;
constexpr int RX = R, XT = RX + 70 * 136 * 2, MM = XT + 128 * 72 * 2, R_END = MM + 2 * 64 * 72 * 2;
constexpr int YST = RX;
constexpr int PRBC = CW + 8 * 768 * 4, PXT = PRBC + 70 * 272 * 2, P_END = PXT + 256 * 72 * 2;
constexpr int STASH = pgd::STASH + 4608;
static_assert(P_END <= pgd::STASH, "prep ssd conv LDS map");
static_assert(RBC_END <= pgd::STASH && R_END <= pgd::STASH && STASH + 9216 <= MISC_OFF, "prep ssd LDS map");
}
__device__ __forceinline__ void prep_ssd_stash(LAS unsigned char* lds, int bid, const bf16* raw, int tid) {
    const int bg = bid >> 5, b = bg >> 1, g = bg & 1, r32 = bid & 31;
    LAS bf16* st = (LAS bf16*)(lds + psd::STASH);
    for (int e = tid; e < 2 * 3 * 96; e += 512) { const int which = e / 288, r = (e % 288) / 96, p = e % 96;
        const int t = which ? (r32 * 4 + 4) * 64 + r : r32 * 4 * 64 - 3 + r;
        const int col = p < 64 ? 3072 + g * 512 + p * 8 : (p < 80 ? 4096 + g * 128 + (p - 64) * 8 : 4352 + g * 128 + (p - 80) * 8);
        u32x4 v = (u32x4){0u, 0u, 0u, 0u};
        if (t >= 0 && t < SEQ) v = *(const GAS u32x4*)(raw + ((size_t)b * SEQ + t) * CONV_CH + col);
        *(LAS u32x4*)(st + which * 2304 + r * 768 + p * 8) = v; }
}
__device__ __forceinline__ void prep_ssd_range(LAS unsigned char* lds, int bid, bf16* raw, const float* conv_w, const float* conv_b, int tid_p,
                                               const float* scal, const float* A_log, const float* dt_bias, float* ssc) {
    using namespace psd;
    const int bg = bid >> 5, b = bg >> 1, g = bg & 1, r32 = bid & 31;
    LAS float* cw = (LAS float*)(lds + CW);
    LAS bf16* rbc = (LAS bf16*)(lds + PRBC); LAS bf16* xT = (LAS bf16*)(lds + PXT);
    LAS bf16* st = (LAS bf16*)(lds + STASH);
    for (int e = tid_p; e < 8 * 768; e += 512) { const int r = e / 768, c = e % 768;
        const int gch = c < 512 ? 3072 + g * 512 + c : (c < 640 ? 4096 + g * 128 + (c - 512) : 4352 + g * 128 + (c - 640));
        cw[e] = r < 7 ? conv_w[r * CONV_CH + gch] : conv_b[gch]; }
    const size_t rowb = (size_t)b * SEQ;
    u32x4 pre[5];
#define PSD_LOAD(u_, ps_) do { const int t0_ = (r32 * 4 + (u_)) * 64; \
        _Pragma("unroll") for (int x = 0; x < 5; ++x) { const int e = tid_p + 512 * x; const int r = e >> 5, p = e & 31; \
            pre[x] = (u32x4){0u, 0u, 0u, 0u}; \
            if (e < 70 * 32 && r >= 3 && !(r >= 67 && (u_) == 3)) { const int col = (ps_) == 0 ? (p < 16 ? 4096 + g * 128 + p * 8 : 4352 + g * 128 + (p - 16) * 8) : 3072 + g * 512 + ((ps_) - 1) * 256 + p * 8; \
                pre[x] = *(const GAS u32x4*)(raw + (rowb + t0_ - 3 + r) * CONV_CH + col); } } } while (0)
    PSD_LOAD(0, 0);
    float sdf[4], sdb[4];
    { const int lane0 = tid_p & 63, wave0 = tid_p >> 6, hd0 = g * 8 + wave0;
#pragma unroll
      for (int u = 0; u < 4; ++u) { const size_t so = (rowb + (size_t)(r32 * 4 + u) * 64 + lane0) * 64; sdf[u] = scal[so + 32 + hd0]; sdb[u] = scal[so + 48 + hd0]; } }
#define PSD_STAGE(u_, scol_) do { _Pragma("unroll") for (int x = 0; x < 5; ++x) { const int e = tid_p + 512 * x; const int r = e >> 5, p = e & 31; \
            if (e < 70 * 32) { u32x4 v = pre[x]; \
                if (r < 3) v = *(const LAS u32x4*)(st + r * 768 + (scol_) + p * 8); \
                else if (r >= 67 && (u_) == 3) v = *(const LAS u32x4*)(st + 2304 + (r - 67) * 768 + (scol_) + p * 8); \
                *(LAS u32x4*)(rbc + r * 272 + (p < 16 ? p * 8 : 136 + (p - 16) * 8)) = v; } } } while (0)
    __syncthreads();
    PSD_STAGE(0, 512);
    PSD_LOAD(0, 1);
    __syncthreads();
#pragma unroll
    for (int u = 0; u < 4; ++u) {
        int tid = tid_p; asm volatile("" : "+v"(tid));
        const int lane = tid & 63, wave = __builtin_amdgcn_readfirstlane(tid >> 6);
        const int c = r32 * 4 + u, t0 = c * 64;
        { const int hd = g * 8 + wave, i = lane;
          const float dtf = softplus_fast(sdf[u] + dt_bias[hd]), dtb = softplus_fast(sdb[u] + dt_bias[16 + hd]);
          const float cf = scan_fwd64(dtf * -expf(A_log[hd]), i), cbk = scan_bwd64(dtb * -expf(A_log[16 + hd]), i);
          float* sp = ssc + ((size_t)((b * 16 + hd) * NCHUNK + c)) * 256 + i; sp[0] = dtf; sp[64] = cf; sp[128] = dtb; sp[192] = cbk; }
        for (int ps = 0; ps < 3; ++ps) {
            const int scol = ps == 0 ? 512 : (ps == 1 ? 0 : 256);
            if (tid < 96) { const int r = tid >> 5, p = tid & 31;
                *(LAS u32x4*)(st + r * 768 + scol + p * 8) = *(const LAS u32x4*)(rbc + (64 + r) * 272 + (p < 16 ? p * 8 : 136 + (p - 16) * 8)); }
            unsigned bcv[16];
            { const int tg = wave, cp = lane; float w[16], o[16];
#pragma unroll
              for (int hf = 0; hf < 2; ++hf) {
#pragma unroll
                  for (int tap = 0; tap < 8; ++tap) { w[2 * tap] = cw[tap * 768 + scol + hf * 128 + 2 * cp]; w[2 * tap + 1] = cw[tap * 768 + scol + hf * 128 + 2 * cp + 1]; }
                  conv_pair8(o, rbc + (8 * tg) * 272 + hf * 136 + 2 * cp, 272, w);
#pragma unroll
                  for (int t = 0; t < 16; ++t) o[t] = silu(o[t]);
#pragma unroll
                  for (int t = 0; t < 8; ++t) bcv[hf * 8 + t] = pkbf(o[2 * t], o[2 * t + 1]);
                  if (ps != 0) {
                      u32x4 e0, e1; e0.x = pkbf(o[0], o[2]); e0.y = pkbf(o[4], o[6]); e0.z = pkbf(o[8], o[10]); e0.w = pkbf(o[12], o[14]);
                      e1.x = pkbf(o[1], o[3]); e1.y = pkbf(o[5], o[7]); e1.z = pkbf(o[9], o[11]); e1.w = pkbf(o[13], o[15]);
                      *(LAS u32x4*)(xT + (hf * 128 + 2 * cp) * 72 + 8 * tg) = e0; *(LAS u32x4*)(xT + (hf * 128 + 2 * cp + 1) * 72 + 8 * tg) = e1; } } }
            __syncthreads();
            const bool lastp = (u == 3 && ps == 2);
            if (!lastp) { if (ps < 2) PSD_STAGE(u, (ps == 0 ? 0 : 256)); else PSD_STAGE(u + 1, 512); }
            asm volatile("" ::: "memory");
            if (ps == 0) {
                const int tg = wave, cp = lane;
#pragma unroll
                for (int hf = 0; hf < 2; ++hf)
#pragma unroll
                    for (int t = 0; t < 8; ++t) *(GAS unsigned*)(raw + (rowb + t0 + 8 * tg + t) * CONV_CH + (hf ? 4352 : 4096) + g * 128 + 2 * cp) = bcv[hf * 8 + t];
            } else {
                for (int e = tid; e < 256 * 8; e += 512) { const int xr = e >> 3, p = e & 7; const int hl = (ps - 1) * 4 + (xr >> 6), pp = xr & 63;
                    *(GAS u32x4*)(raw + (rowb + t0 + pp) * CONV_CH + 3072 + (g * 8 + hl) * 64 + p * 8) = *(const LAS u32x4*)(xT + xr * 72 + p * 8); } }
            if (ps == 0) PSD_LOAD(u, 2); else if (u < 3) { if (ps == 1) PSD_LOAD(u + 1, 0); else PSD_LOAD(u + 1, 1); }
            __syncthreads();
        }
    }
}
#undef PSD_STAGE
#undef PSD_LOAD
__device__ __forceinline__ void ssd_intra_range(LAS unsigned char* lds, int bid, const bf16* raw, const float* ssc, const float* Dp, bf16* yi, int tid_p) {
    using namespace psd;
    const int bg = bid >> 5, b = bg >> 1, g = bg & 1, r32 = bid & 31;
    LAS float* sc = (LAS float*)(lds + SC);
    LAS bf16* Bm = (LAS bf16*)(lds + BM_); LAS bf16* Cm = (LAS bf16*)(lds + CM_); LAS float* cb = (LAS float*)(lds + CB);
    LAS bf16* xT = (LAS bf16*)(lds + XT); LAS bf16* Mm = (LAS bf16*)(lds + MM); LAS bf16* yst = (LAS bf16*)(lds + YST);
    const size_t rowb = (size_t)b * SEQ;
    u32x4 pbc[4], px[8]; float pss[4];
#define PSI_LOADBC(u_) do { const int t0_ = (r32 * 4 + (u_)) * 64; \
        _Pragma("unroll") for (int x = 0; x < 4; ++x) { const int e = tid_p + 512 * x; const int r = e >> 5, p = e & 31; \
            pbc[x] = *(const GAS u32x4*)(raw + (rowb + t0_ + r) * CONV_CH + (p < 16 ? 4096 + g * 128 + p * 8 : 4352 + g * 128 + (p - 16) * 8)); } \
        { const float* sp_ = ssc + ((size_t)((b * 16 + g * 8 + (tid_p >> 6)) * NCHUNK + (r32 * 4 + (u_)))) * 256 + (tid_p & 63); pss[0] = sp_[0]; pss[1] = sp_[64]; pss[2] = sp_[128]; pss[3] = sp_[192]; } } while (0)
#define PSI_LOADX(u_, hp_) do { const int t0_ = (r32 * 4 + (u_)) * 64; \
        _Pragma("unroll") for (int y = 0; y < 2; ++y) { const int e = tid_p + 512 * y; const int xr = e >> 3, p = e & 7; const int hl = 2 * (hp_) + (xr >> 6), pp = xr & 63; \
            px[2 * (hp_) + y] = *(const GAS u32x4*)(raw + (rowb + t0_ + pp) * CONV_CH + 3072 + (g * 8 + hl) * 64 + p * 8); } } while (0)
#define PSI_PUTX(hp_) do { _Pragma("unroll") for (int y = 0; y < 2; ++y) { const int e = tid_p + 512 * y; const int xr = e >> 3, p = e & 7; *(LAS u32x4*)(xT + xr * 72 + p * 8) = px[2 * (hp_) + y]; } } while (0)
    PSI_LOADBC(0); PSI_LOADX(0, 0); PSI_LOADX(0, 1); PSI_LOADX(0, 2); PSI_LOADX(0, 3);
    for (int u = 0; u < 4; ++u) {
        int tid = tid_p; asm volatile("" : "+v"(tid));
        const int lane = tid & 63, wave = __builtin_amdgcn_readfirstlane(tid >> 6), fr = lane & 15, fq = lane >> 4;
        const int c = r32 * 4 + u, t0 = c * 64;
#pragma unroll
        for (int x = 0; x < 4; ++x) { const int e = tid_p + 512 * x; const int r = e >> 5, p = e & 31;
            *(LAS u32x4*)((p < 16 ? Bm + r * 136 + p * 8 : Cm + r * 136 + (p - 16) * 8)) = pbc[x]; }
        { const int i = lane; LAS float* s = sc + wave * 256; s[i] = pss[0]; s[64 + i] = pss[1] * 1.4426950408889634f; s[128 + i] = pss[2]; s[192 + i] = pss[3] * 1.4426950408889634f; }
        PSI_PUTX(0);
        if (u + 1 < 4) PSI_LOADBC(u + 1);
        __syncthreads();
        { const int mt = wave & 3, nh = wave >> 2;
          f32x4 acc[1][2]; acc[0][0] = acc[0][1] = (f32x4){0.f, 0.f, 0.f, 0.f};
          mma_lds<1, 2>(acc, Cm, 136, mt * 16, Bm, 136, nh * 32, 128, fr, fq);
#pragma unroll
          for (int nl = 0; nl < 2; ++nl)
#pragma unroll
              for (int r = 0; r < 4; ++r) cb[(mt * 16 + 4 * fq + r) * 68 + nh * 32 + nl * 16 + fr] = acc[0][nl][r]; }
#pragma unroll
        for (int hp = 0; hp < 4; ++hp) {
            __syncthreads();
            if (u + 1 < 4) PSI_LOADX(u + 1, hp);
            { const int e = tid >> 8, i = (tid >> 2) & 63, jq = tid & 3; const int hl = 2 * hp + e;
              const LAS float* s = sc + hl * 256; const float Dh = Dp[g * 8 + hl];
              const float csfi = s[64 + i], csbi = s[192 + i], dsum = s[i] + s[128 + i];
#pragma unroll
              for (int jj = 0; jj < 16; jj += 2) { float m2[2];
#pragma unroll
                  for (int y = 0; y < 2; ++y) { const int j = jq * 16 + jj + y; const float cbv = cb[i * 68 + j];
                      const float cfj = s[64 + j], cbj = s[192 + j], dfj = s[j], dbj = s[128 + j];
                      const float arg = (i > j) ? csfi - cfj : csbi - cbj;
                      const float dtj = (i > j) ? dfj : dbj;
                      const float w = (i == j) ? dsum : __builtin_amdgcn_exp2f(fminf(arg, 0.f)) * dtj;
                      m2[y] = cbv * w + ((i == j) ? Dh : 0.f); }
                  *(LAS unsigned*)(Mm + (e * 64 + i) * 72 + jq * 16 + jj) = pkbf(m2[0], m2[1]); } }
            __syncthreads();
            { const int e = wave >> 2, mt = wave & 3;
              f32x4 acc[1][4];
#pragma unroll
              for (int nt = 0; nt < 4; ++nt) acc[0][nt] = (f32x4){0.f, 0.f, 0.f, 0.f};
              mma_lds<1, 4>(acc, xT + e * 64 * 72, 72, mt * 16, Mm + e * 64 * 72, 72, 0, 64, fr, fq);
#pragma unroll
              for (int nt = 0; nt < 4; ++nt) { u32x2 w; w.x = pkbf(acc[0][nt][0], acc[0][nt][1]); w.y = pkbf(acc[0][nt][2], acc[0][nt][3]);
                  *(LAS u32x2*)(yst + (nt * 16 + fr) * 136 + e * 64 + mt * 16 + 4 * fq) = w; } }
            __syncthreads();
            if (hp < 3) PSI_PUTX(hp + 1);
            for (int e = tid; e < 64 * 16; e += 512) { const int i = e >> 4, p = e & 15;
                *(GAS u32x4*)(yi + (rowb + t0 + i) * 1024 + (g * 8 + 2 * hp) * 64 + p * 8) = *(const LAS u32x4*)(yst + i * 136 + p * 8); }
        }
        __syncthreads();
    }
#undef PSI_LOADBC
#undef PSI_LOADX
#undef PSI_PUTX
}

namespace ss2 {
constexpr int CO = 0;
constexpr int BO = CO + 64 * 132 * 2;
constexpr int XO = BO + 64 * 132 * 2;
constexpr int SCO = XO + 64 * 72 * 2;
constexpr int BUF = SCO + 768;
constexpr int OST = 2 * BUF;
constexpr int END = OST + 2 * 64 * 72 * 2;
static_assert(END <= MISC_OFF && BUF % 16 == 0, "ssd state LDS map");
}
template <int DIR>
__device__ __forceinline__ void ssd_state2(LAS unsigned char* lds, int b, int hd, const bf16* raw, const float* ssc, bf16* ys, int tid, int wave, int lane) {
    using namespace ss2;
    const size_t rowb = (size_t)b * SEQ; const int g = hd >> 3;
    LAS bf16* ost = (LAS bf16*)(lds + OST);
    const int r31 = lane & 31, hh = lane >> 5;
    if (wave == 4 || wave == 5) {
        for (int n = 0; n < NCHUNK + 1; ++n) WG_BAR();
    } else if (wave >= 2) {
        const int hw = (wave & 1) | ((wave >> 2) << 1); const int ht = hw * 64 + lane;
        unsigned go[10], lo_[10]; u32x4 ld[10]; float sr0 = 0.f, sr1 = 0.f;
#pragma unroll
        for (int x = 0; x < 4; ++x) { const int e = ht + 256 * x, r = e >> 4, p = e & 15;
            go[x] = (unsigned)((r * CONV_CH + 4352 + g * 128 + p * 8) * 2); go[4 + x] = (unsigned)((r * CONV_CH + 4096 + g * 128 + p * 8) * 2);
            lo_[x] = (unsigned)(CO + (r * 132 + p * 8) * 2); lo_[4 + x] = (unsigned)(BO + (r * 132 + p * 8) * 2); }
#pragma unroll
        for (int x = 0; x < 2; ++x) { const int e = ht + 256 * x, xr = e >> 3, p = e & 7;
            go[8 + x] = (unsigned)((xr * CONV_CH + 3072 + hd * 64 + p * 8) * 2); lo_[8 + x] = (unsigned)(XO + (xr * 72 + p * 8) * 2); }
#define SS2_ISSUE(c_) do { const GAS char* rb_ = (const GAS char*)(raw + (rowb + (size_t)(c_) * 64) * CONV_CH); \
            _Pragma("unroll") for (int x = 0; x < 10; ++x) ld[x] = *(const GAS u32x4*)(rb_ + go[x]); \
            if (hw == 0) { const float* sp_ = ssc + ((size_t)((b * 16 + hd) * NCHUNK + (c_))) * 256 + DIR * 128 + lane; sr0 = sp_[0]; sr1 = sp_[64]; } } while (0)
#define SS2_COMMIT(bi_, c_) do { LAS unsigned char* B_ = lds + (bi_) * BUF; \
            _Pragma("unroll") for (int x = 0; x < 10; ++x) { LAS unsigned char* d_ = B_ + lo_[x]; *(LAS u32x2*)(d_) = (u32x2){ld[x].x, ld[x].y}; *(LAS u32x2*)(d_ + 8) = (u32x2){ld[x].z, ld[x].w}; } \
            if (hw == 0) { LAS float* sc_ = (LAS float*)(B_ + SCO); const int i = lane; const float cs = sr1; const float cl = __shfl(cs, DIR ? 0 : 63); \
                sc_[i] = __expf(cs); sc_[64 + i] = sr0 * __expf(cl - cs); if (i == 0) sc_[128] = __expf(cl); } } while (0)
        { const int c0 = DIR ? NCHUNK - 1 : 0; SS2_ISSUE(c0); SS2_COMMIT(0, c0); SS2_ISSUE((DIR ? c0 - 1 : c0 + 1)); }
        for (int n = 0; n < NCHUNK; ++n) {
            const int c = DIR ? NCHUNK - 1 - n : n;
            WG_BAR();
            const bool more = n + 1 < NCHUNK; const int cn = DIR ? c - 1 : c + 1;
            if (more) { SS2_COMMIT((n + 1) & 1, cn); if (n + 2 < NCHUNK) SS2_ISSUE((DIR ? cn - 1 : cn + 1)); }
            unsigned ov[8];
            if (n > 0) {
#pragma unroll
                for (int x = 0; x < 8; ++x) ov[x] = *(const LAS unsigned*)(ost + ((n - 1) & 1) * (64 * 72) + (hw * 16 + 2 * x + (lane >> 5)) * 72 + 2 * (lane & 31));
            }
            if (n > 0) { const int tp = (DIR ? c + 1 : c - 1) * 64;
#pragma unroll
                for (int x = 0; x < 8; ++x) { GAS char* ob_ = (GAS char*)(ys + (rowb + tp + hw * 16 + 2 * x) * 1024 + hd * 64);
                    (void)__builtin_amdgcn_global_atomic_fadd_v2bf16((GAS s16x2*)(ob_ + (lane >> 5) * 2048 + (lane & 31) * 4), __builtin_bit_cast(s16x2, ov[x])); } }
        }
        WG_BAR();
        { const int tp = (DIR ? 0 : NCHUNK - 1) * 64;
#pragma unroll
          for (int x = 0; x < 8; ++x) { const unsigned v = *(const LAS unsigned*)(ost + ((NCHUNK - 1) & 1) * (64 * 72) + (hw * 16 + 2 * x + (lane >> 5)) * 72 + 2 * (lane & 31));
              GAS char* ob_ = (GAS char*)(ys + (rowb + tp + hw * 16 + 2 * x) * 1024 + hd * 64);
              (void)__builtin_amdgcn_global_atomic_fadd_v2bf16((GAS s16x2*)(ob_ + (lane >> 5) * 2048 + (lane & 31) * 4), __builtin_bit_cast(s16x2, v)); } }
#undef SS2_ISSUE
#undef SS2_COMMIT
    } else {
        const int ps = wave; const int xrow = ps * 32 + r31;
        f32x16 Ht[4];
#pragma unroll
        for (int t = 0; t < 4; ++t)
#pragma unroll
            for (int r = 0; r < 16; ++r) Ht[t][r] = 0.f;
        for (int n = 0; n < NCHUNK; ++n) {
            WG_BAR();
            const LAS unsigned char* Bb = lds + (n & 1) * BUF;
            const LAS bf16* Cb = (const LAS bf16*)(Bb + CO); const LAS bf16* Bmb = (const LAS bf16*)(Bb + BO); const LAS bf16* Xb = (const LAS bf16*)(Bb + XO);
            const LAS float* sc = (const LAS float*)(Bb + SCO);
            f32x16 aY[2];
#pragma unroll
            for (int m = 0; m < 2; ++m)
#pragma unroll
                for (int r = 0; r < 16; ++r) aY[m][r] = 0.f;
            bf16x8 fa[2][2];
            const int offc = r31 * 132 + 4 * hh;
#define SS2_LD2(bi_, ks_) do { fa[bi_][0] = afrag(Cb + offc + 16 * (ks_)); fa[bi_][1] = afrag(Cb + offc + 32 * 132 + 16 * (ks_)); } while (0)
            SS2_LD2(0, 0);
#pragma unroll
            for (int ks = 0; ks < 8; ++ks) {
                if (ks < 7) SS2_LD2((ks + 1) & 1, ks + 1);
                __builtin_amdgcn_sched_barrier(0);
                const bf16x8 bs = cvt8(Ht[ks >> 1], 8 * (ks & 1));
                aY[0] = MFMA32(fa[ks & 1][0], bs, aY[0]); aY[1] = MFMA32(fa[ks & 1][1], bs, aY[1]);
                __builtin_amdgcn_sched_barrier(0); }
#undef SS2_LD2
            const int i16 = r31 & 15; const LAS bf16* bp = Bmb + (8 * hh + (i16 >> 2)) * 132 + 16 * (r31 >> 4) + 4 * (i16 & 3);
            bf16x8 xf[4];
#pragma unroll
            for (int kt = 0; kt < 4; ++kt) { const bf16x8 xv = *(const LAS bf16x8*)(Xb + xrow * 72 + 16 * kt + 8 * hh);
                const f32x4 w0 = *(const LAS f32x4*)(sc + 64 + 16 * kt + 8 * hh), w1 = *(const LAS f32x4*)(sc + 64 + 16 * kt + 8 * hh + 4);
                u32x4 w; w.x = pkbf(bf2f_s(xv[0]) * w0[0], bf2f_s(xv[1]) * w0[1]); w.y = pkbf(bf2f_s(xv[2]) * w0[2], bf2f_s(xv[3]) * w0[3]);
                w.z = pkbf(bf2f_s(xv[4]) * w1[0], bf2f_s(xv[5]) * w1[1]); w.w = pkbf(bf2f_s(xv[6]) * w1[2], bf2f_s(xv[7]) * w1[3]);
                xf[kt] = __builtin_bit_cast(bf16x8, w); }
            bf16x8 fb[2][4];
#define SS2_LDBT(bi_, t_) do { _Pragma("unroll") for (int kt = 0; kt < 4; ++kt) { const LAS bf16* p_ = bp + (16 * kt) * 132 + 32 * (t_); \
                const v4i16_t lo_ = __builtin_amdgcn_ds_read_tr16_b64_v4i16((LAS v4i16_t*)p_), hi_ = __builtin_amdgcn_ds_read_tr16_b64_v4i16((LAS v4i16_t*)(p_ + 4 * 132)); \
                fb[bi_][kt] = (bf16x8){lo_[0], lo_[1], lo_[2], lo_[3], hi_[0], hi_[1], hi_[2], hi_[3]}; } } while (0)
            SS2_LDBT(0, 0);
#pragma unroll
            for (int m = 0; m < 2; ++m)
#pragma unroll
                for (int q4 = 0; q4 < 4; ++q4) { const f32x4 ec = *(const LAS f32x4*)(sc + 32 * m + 8 * q4 + 4 * hh);
#pragma unroll
                    for (int x = 0; x < 4; ++x) aY[m][4 * q4 + x] *= ec[x]; }
            const float ecl = sc[128];
#pragma unroll
            for (int mi = 0; mi < 2; ++mi)
#pragma unroll
                for (int r = 0; r < 16; ++r) ost[(n & 1) * (64 * 72) + (32 * mi + (r & 3) + 8 * (r >> 2) + 4 * hh) * 72 + ps * 32 + r31] = f2bf1(aY[mi][r]);
#pragma unroll
            for (int t = 0; t < 4; ++t) {
                if (t < 3) SS2_LDBT((t + 1) & 1, t + 1);
                __builtin_amdgcn_sched_barrier(0);
#pragma unroll
                for (int r = 0; r < 16; ++r) Ht[t][r] *= ecl;
                Ht[t] = MFMA32(fb[t & 1][0], xf[0], Ht[t]); Ht[t] = MFMA32(fb[t & 1][1], xf[1], Ht[t]);
                Ht[t] = MFMA32(fb[t & 1][2], xf[2], Ht[t]); Ht[t] = MFMA32(fb[t & 1][3], xf[3], Ht[t]);
                __builtin_amdgcn_sched_barrier(0); }
#undef SS2_LDBT
        }
        WG_BAR();
    }
}
#ifndef GS3_LDK
#define GS3_LDK 136
#endif
namespace gs3 {
constexpr int LDK = GS3_LDK, LDT = 72;
constexpr int KO = 0;
constexpr int QO = KO + 64 * LDK * 2;
constexpr int VTO = QO + 64 * LDK * 2;
constexpr int TO = VTO + 64 * LDT * 2;
constexpr int QKO = TO + 64 * LDT * 2;
constexpr int SCO = QKO + 64 * LDT * 2;
constexpr int BUF = SCO + 1024;
constexpr int OST = 2 * BUF;
constexpr int END = OST + 2 * 64 * 72 * 2;
static_assert(END <= MISC_OFF && BUF % 16 == 0, "gdn state3 LDS map");
}
__device__ __forceinline__ bf16x8 pack2(const f32x4& a, const f32x4& b) {
    u32x4 w; w.x = pkbf(a[0], a[1]); w.y = pkbf(a[2], a[3]); w.z = pkbf(b[0], b[1]); w.w = pkbf(b[2], b[3]);
    return __builtin_bit_cast(bf16x8, w);
}
__device__ __forceinline__ bf16x8 afrag16(const LAS bf16* p) {
    const bf16x4 lo = *(const LAS bf16x4*)p, hi = *(const LAS bf16x4*)(p + 16);
    return (bf16x8){lo[0], lo[1], lo[2], lo[3], hi[0], hi[1], hi[2], hi[3]};
}
__device__ __forceinline__ bf16x8 afrag16_tr(const LAS bf16* p, int ld) {
    const v4i16_t lo = __builtin_amdgcn_ds_read_tr16_b64_v4i16((LAS v4i16_t*)p), hi = __builtin_amdgcn_ds_read_tr16_b64_v4i16((LAS v4i16_t*)(p + 16 * ld));
    return (bf16x8){lo[0], lo[1], lo[2], lo[3], hi[0], hi[1], hi[2], hi[3]};
}
#define MFMA16(a, b, c) __builtin_amdgcn_mfma_f32_16x16x32_bf16((a), (b), (c), 0, 0, 0)

constexpr int CW_OFLAG = 16384;
__device__ __forceinline__ void store16_wt(bf16* p, u32x4 v) { asm volatile("global_store_dwordx4 %0, %1, off sc1\n\ts_nop 1" :: "v"(p), "v"(v) : "memory"); }
__device__ __forceinline__ void out_rows(const LAS bf16* ostb, bf16* gbase  , int lane, bool second) {
#pragma unroll
    for (int x = 0; x < 2; ++x) { const int r = 8 * x + (lane >> 3), pc = lane & 7;
        const u32x4 ov = *(const LAS u32x4*)(ostb + r * 72 + pc * 8); bf16* gp = gbase + (size_t)r * 1024 + pc * 8;
        if (!second) store16_wt(gp, ov);
        else { const u32x4 gv = *(const GAS u32x4*)gp; u32x4 o;
            o.x = pkbf(__uint_as_float(ov.x << 16) + __uint_as_float(gv.x << 16), __uint_as_float(ov.x & 0xffff0000u) + __uint_as_float(gv.x & 0xffff0000u));
            o.y = pkbf(__uint_as_float(ov.y << 16) + __uint_as_float(gv.y << 16), __uint_as_float(ov.y & 0xffff0000u) + __uint_as_float(gv.y & 0xffff0000u));
            o.z = pkbf(__uint_as_float(ov.z << 16) + __uint_as_float(gv.z << 16), __uint_as_float(ov.z & 0xffff0000u) + __uint_as_float(gv.z & 0xffff0000u));
            o.w = pkbf(__uint_as_float(ov.w << 16) + __uint_as_float(gv.w << 16), __uint_as_float(ov.w & 0xffff0000u) + __uint_as_float(gv.w & 0xffff0000u));
            *(GAS u32x4*)gp = o; } }
}
__device__ __forceinline__ void out_handshake(unsigned* flags, int mine, int partner, int hw, int lane) {
    asm volatile("s_waitcnt vmcnt(0)" ::: "memory");
    if (lane == 0) { __hip_atomic_store(flags + (mine * 4 + hw) * 16, 1u, __ATOMIC_RELAXED, __HIP_MEMORY_SCOPE_AGENT);
        unsigned sp = 0;
        while (__hip_atomic_load(flags + (partner * 4 + hw) * 16, __ATOMIC_RELAXED, __HIP_MEMORY_SCOPE_AGENT) == 0u) { __builtin_amdgcn_s_sleep(2); if (++sp > (1u << 22)) break; } }
    __builtin_amdgcn_fence(__ATOMIC_ACQUIRE, "agent");
    asm volatile("s_waitcnt vmcnt(0)" ::: "memory");
}

template <int DIR, int XP = 0>
__device__ __forceinline__ void gdn_state3(LAS unsigned char* lds, int b, int h, int half, const bf16* raw, const float* scal, const bf16* TQ, bf16* og, int tid, int wave, int lane, unsigned* flags, int cid) {
    using namespace gs3;
    const size_t rowb = (size_t)b * SEQ; const int bh = b * 8 + h;
    LAS bf16* ost = (LAS bf16*)(lds + OST);
    const int fr = lane & 15, fq = lane >> 4;
    if (wave >= 4) {
        const int hw = wave - 4; const int ht = hw * 64 + lane;
        unsigned go[14], lo_[14]; u32x4 ld[14]; float sr0 = 0.f, sr1 = 0.f;
#pragma unroll
        for (int x = 0; x < 4; ++x) { const int e = ht + 256 * x, r = e >> 4, p = e & 15;
            go[x] = (unsigned)((r * CONV_CH + 1024 + h * 128 + p * 8) * 2); go[4 + x] = (unsigned)((r * CONV_CH + h * 128 + p * 8) * 2);
            lo_[x] = (unsigned)(KO + (r * LDK + p * 8) * 2); lo_[4 + x] = (unsigned)(QO + (r * LDK + p * 8) * 2); }
#pragma unroll
        for (int x = 0; x < 2; ++x) { const int e = ht + 256 * x, dvl = e >> 3, p = e & 7; const int dv = 64 * half + dvl;
            go[8 + x] = (unsigned)(((dv >> 1) * CONV_CH + 2048 + h * 128 + (dv & 1) * 64 + p * 8) * 2); lo_[8 + x] = (unsigned)(VTO + (dvl * LDT + p * 8) * 2); }
        u32x4 km[2], dg[2], qm[2];
#pragma unroll
        for (int x = 0; x < 2; ++x) { const int e = ht + 256 * x, i = e >> 3, p = e & 7;
            go[10 + x] = (unsigned)(e * 16); go[12 + x] = (unsigned)(8192 + e * 16);
            lo_[10 + x] = (unsigned)(TO + (i * LDT + p * 8) * 2); lo_[12 + x] = (unsigned)(QKO + (i * LDT + p * 8) * 2);
            unsigned kw[4], dw[4], qw[4];
#pragma unroll
            for (int w = 0; w < 4; ++w) { const int j0 = p * 8 + 2 * w, j1 = j0 + 1;
                const bool k0 = DIR ? (i < j0) : (i > j0), k1 = DIR ? (i < j1) : (i > j1);
                kw[w] = (k0 ? 0xFFFFu : 0u) | (k1 ? 0xFFFF0000u : 0u); dw[w] = (i == j0 ? 0x3F80u : 0u) | (i == j1 ? 0x3F800000u : 0u);
                qw[w] = kw[w] | (i == j0 ? 0xFFFFu : 0u) | (i == j1 ? 0xFFFF0000u : 0u); }
            km[x] = (u32x4){kw[0], kw[1], kw[2], kw[3]}; dg[x] = (u32x4){dw[0], dw[1], dw[2], dw[3]}; qm[x] = (u32x4){qw[0], qw[1], qw[2], qw[3]}; }
        const unsigned so_l = (unsigned)(lane * 256 + (DIR * 8 + h) * 4);
#define GS3_ISSUE(c_) do { const GAS char* rb_ = (const GAS char*)(raw + (rowb + (size_t)(c_) * 64) * CONV_CH); const GAS char* tb_ = (const GAS char*)(TQ + ((size_t)(bh * NCHUNK + (c_))) * 8192); \
            _Pragma("unroll") for (int x = 0; x < 10; ++x) ld[x] = *(const GAS u32x4*)(rb_ + go[x]); \
            _Pragma("unroll") for (int x = 10; x < 14; ++x) ld[x] = *(const GAS u32x4*)(tb_ + go[x]); \
            if (hw == 0) { const GAS char* sb_ = (const GAS char*)(scal + (rowb + (size_t)(c_) * 64) * 64); sr0 = *(const GAS float*)(sb_ + so_l); sr1 = *(const GAS float*)(sb_ + so_l + 64); } } while (0)
#define GS3_COMMIT(bi_, c_) do { LAS unsigned char* B_ = lds + (bi_) * BUF; \
            _Pragma("unroll") for (int x = 0; x < 10; ++x) *(LAS u32x4*)(B_ + lo_[x]) = ld[x]; \
            _Pragma("unroll") for (int x = 0; x < 2; ++x) { *(LAS u32x4*)(B_ + lo_[10 + x]) = (ld[10 + x] & km[x]) | dg[x]; *(LAS u32x4*)(B_ + lo_[12 + x]) = ld[12 + x] & qm[x]; } \
            if (hw == 0) { LAS float* sc_ = (LAS float*)(B_ + SCO); const int i = lane; const float gc = sr1; const float gl = __shfl(gc, DIR ? 0 : 63); \
                sc_[i] = sr0; sc_[64 + i] = __expf(gc); sc_[128 + i] = __expf(gl - gc); if (i == 0) sc_[192] = __expf(gl); } } while (0)
        { const int c0 = DIR ? NCHUNK - 1 : 0; GS3_ISSUE(c0); GS3_COMMIT(0, c0); GS3_ISSUE((DIR ? c0 - 1 : c0 + 1)); }
        for (int n = 0; n < NCHUNK; ++n) {
            const int c = DIR ? NCHUNK - 1 - n : n;
            WG_BAR();
            const bool more = n + 1 < NCHUNK; const int cn = DIR ? c - 1 : c + 1;
            if (more) { GS3_COMMIT((n + 1) & 1, cn); if (n + 2 < NCHUNK && (!(XP & 2) || n < 2)) GS3_ISSUE((DIR ? cn - 1 : cn + 1)); }
            if (n > 0 && !(XP & 1)) { const int tp = (DIR ? c + 1 : c - 1) * 64;
#pragma unroll
                for (int x = 0; x < 8; ++x) { const unsigned v = *(const LAS unsigned*)(ost + ((n - 1) & 1) * (64 * 72) + (hw * 16 + 2 * x + (lane >> 5)) * 72 + 2 * (lane & 31));
                    GAS char* ob_ = (GAS char*)(og + (rowb + tp + hw * 16 + 2 * x) * 1024 + h * 128 + half * 64);
                    (void)__builtin_amdgcn_global_atomic_fadd_v2bf16((GAS s16x2*)(ob_ + (lane >> 5) * 2048 + (lane & 31) * 4), __builtin_bit_cast(s16x2, v)); } }
        }
        WG_BAR();
        { const int tp = (DIR ? 0 : NCHUNK - 1) * 64;
#pragma unroll
          for (int x = 0; x < 8; ++x) { const unsigned v = *(const LAS unsigned*)(ost + ((NCHUNK - 1) & 1) * (64 * 72) + (hw * 16 + 2 * x + (lane >> 5)) * 72 + 2 * (lane & 31));
              GAS char* ob_ = (GAS char*)(og + (rowb + tp + hw * 16 + 2 * x) * 1024 + h * 128 + half * 64);
              (void)__builtin_amdgcn_global_atomic_fadd_v2bf16((GAS s16x2*)(ob_ + (lane >> 5) * 2048 + (lane & 31) * 4), __builtin_bit_cast(s16x2, v)); } }
#undef GS3_ISSUE
#undef GS3_COMMIT
    } else {
        const int dv0 = 16 * wave;
        f32x4 St[8];
#pragma unroll
        for (int t = 0; t < 8; ++t) St[t] = (f32x4){0.f, 0.f, 0.f, 0.f};
        for (int n = 0; n < NCHUNK; ++n) {
            WG_BAR();
            const LAS unsigned char* Bb = lds + (n & 1) * BUF;
            const LAS bf16* Kb = (const LAS bf16*)(Bb + KO); const LAS bf16* Qb = (const LAS bf16*)(Bb + QO); const LAS bf16* Vb = (const LAS bf16*)(Bb + VTO);
            const LAS bf16* Tb = (const LAS bf16*)(Bb + TO); const LAS bf16* QKb = (const LAS bf16*)(Bb + QKO); const LAS float* sc = (const LAS float*)(Bb + SCO);
            const int offa = fr * LDK + 4 * fq, offt = fr * LDT + 4 * fq;
            bf16x8 bS[4];
#pragma unroll
            for (int ks = 0; ks < 4; ++ks) bS[ks] = pack2(St[2 * ks], St[2 * ks + 1]);
            f32x4 aK[4];
#pragma unroll
            for (int m = 0; m < 4; ++m) aK[m] = (f32x4){0.f, 0.f, 0.f, 0.f};
#pragma unroll
            for (int ks = 0; ks < 4; ++ks) { bf16x8 fa[4];
#pragma unroll
                for (int m = 0; m < 4; ++m) fa[m] = afrag16(Kb + offa + 16 * m * LDK + 32 * ks);
#pragma unroll
                for (int m = 0; m < 4; ++m) aK[m] = MFMA16(fa[m], bS[ks], aK[m]); }
            bf16x8 ft[8];
#pragma unroll
            for (int mi = 0; mi < 4; ++mi)
#pragma unroll
                for (int kt = 0; kt < 2; ++kt) { const bool need = DIR ? (kt >= (mi >> 1)) : (kt <= (mi >> 1));
                    if (need) ft[mi * 2 + kt] = afrag16(Tb + offt + 16 * mi * LDT + 32 * kt); }
#pragma unroll
            for (int m = 0; m < 4; ++m) { const int tb = 16 * m + 4 * fq;
                const bf16x4 vv = *(const LAS bf16x4*)(Vb + (dv0 + fr) * LDT + tb); const f32x4 be = *(const LAS f32x4*)(sc + tb), eg = *(const LAS f32x4*)(sc + 64 + tb);
#pragma unroll
                for (int e = 0; e < 4; ++e) aK[m][e] = be[e] * (bf2f_s(vv[e]) - eg[e] * aK[m][e]); }
            const bf16x8 br0 = pack2(aK[0], aK[1]), br1 = pack2(aK[2], aK[3]);
            f32x4 au[4];
#pragma unroll
            for (int m = 0; m < 4; ++m) au[m] = (f32x4){0.f, 0.f, 0.f, 0.f};
#pragma unroll
            for (int mi = 0; mi < 4; ++mi)
#pragma unroll
                for (int kt = 0; kt < 2; ++kt) { const bool need = DIR ? (kt >= (mi >> 1)) : (kt <= (mi >> 1));
                    if (need) au[mi] = MFMA16(ft[mi * 2 + kt], (kt == 0 ? br0 : br1), au[mi]); }
            f32x4 aQ[4];
            if constexpr (!(XP & 4)) {
#pragma unroll
            for (int m = 0; m < 4; ++m) aQ[m] = (f32x4){0.f, 0.f, 0.f, 0.f};
#pragma unroll
            for (int ks = 0; ks < 4; ++ks) { bf16x8 fa[4];
#pragma unroll
                for (int m = 0; m < 4; ++m) fa[m] = afrag16(Qb + offa + 16 * m * LDK + 32 * ks);
#pragma unroll
                for (int m = 0; m < 4; ++m) aQ[m] = MFMA16(fa[m], bS[ks], aQ[m]); }
            bf16x8 fqk[8];
#pragma unroll
            for (int mi = 0; mi < 4; ++mi)
#pragma unroll
                for (int kt = 0; kt < 2; ++kt) { const bool need = DIR ? (kt >= (mi >> 1)) : (kt <= (mi >> 1));
                    if (need) fqk[mi * 2 + kt] = afrag16(QKb + offt + 16 * mi * LDT + 32 * kt); }
            const bf16x8 bu0 = pack2(au[0], au[1]), bu1 = pack2(au[2], au[3]);
#pragma unroll
            for (int m = 0; m < 4; ++m) { const int tb = 16 * m + 4 * fq; const f32x4 eg = *(const LAS f32x4*)(sc + 64 + tb);
#pragma unroll
                for (int e = 0; e < 4; ++e) { aQ[m][e] *= eg[e]; } }
#pragma unroll
            for (int mi = 0; mi < 4; ++mi)
#pragma unroll
                for (int kt = 0; kt < 2; ++kt) { const bool need = DIR ? (kt >= (mi >> 1)) : (kt <= (mi >> 1));
                    if (need) aQ[mi] = MFMA16(fqk[mi * 2 + kt], (kt == 0 ? bu0 : bu1), aQ[mi]); }
#pragma unroll
            for (int m = 0; m < 4; ++m)
#pragma unroll
                for (int e = 0; e < 4; ++e) ost[(n & 1) * (64 * 72) + (16 * m + 4 * fq + e) * 72 + dv0 + fr] = f2bf1(aQ[m][e]);
            }
#pragma unroll
            for (int m = 0; m < 4; ++m) { const int tb = 16 * m + 4 * fq; const f32x4 ek = *(const LAS f32x4*)(sc + 128 + tb);
#pragma unroll
                for (int e = 0; e < 4; ++e) { au[m][e] *= ek[e]; } }
            const bf16x8 bd0 = pack2(au[0], au[1]), bd1 = pack2(au[2], au[3]);
            const float egl = sc[192];
            { const LAS bf16* kp = Kb + (4 * fq + (fr >> 2)) * LDK + 4 * (fr & 3);
#pragma unroll
              for (int t = 0; t < 8; ++t) { const bf16x8 f0 = afrag16_tr(kp + 16 * t, LDK), f1 = afrag16_tr(kp + 32 * LDK + 16 * t, LDK);
                  St[t] = St[t] * egl; St[t] = MFMA16(f0, bd0, St[t]); St[t] = MFMA16(f1, bd1, St[t]); } }
        }
        WG_BAR();
    }
}

namespace ss3 {
constexpr int LDK = GS3_LDK, LDT = 72;
constexpr int CO = 0;
constexpr int BO = CO + 64 * LDK * 2;
constexpr int XO = BO + 64 * LDK * 2;
constexpr int SCO = XO + 64 * LDT * 2;
constexpr int BUF = SCO + 768;
constexpr int OST = 2 * BUF;
constexpr int END = OST + 2 * 64 * 72 * 2;
static_assert(END <= MISC_OFF && BUF % 16 == 0, "ssd state3 LDS map");
}
template <int DIR, int XP = 0>
__device__ __forceinline__ void ssd_state3(LAS unsigned char* lds, int b, int hd, const bf16* raw, const float* ssc, bf16* ys, int tid, int wave, int lane, unsigned* flags, int cid) {
    using namespace ss3;
    const size_t rowb = (size_t)b * SEQ; const int g = hd >> 3;
    LAS bf16* ost = (LAS bf16*)(lds + OST);
    const int fr = lane & 15, fq = lane >> 4;
    if (wave >= 4) {
        const int hw = wave - 4; const int ht = hw * 64 + lane;
        unsigned go[10], lo_[10]; u32x4 ld[10]; float sr0 = 0.f, sr1 = 0.f;
#pragma unroll
        for (int x = 0; x < 4; ++x) { const int e = ht + 256 * x, r = e >> 4, p = e & 15;
            go[x] = (unsigned)((r * CONV_CH + 4352 + g * 128 + p * 8) * 2); go[4 + x] = (unsigned)((r * CONV_CH + 4096 + g * 128 + p * 8) * 2);
            lo_[x] = (unsigned)(CO + (r * LDK + p * 8) * 2); lo_[4 + x] = (unsigned)(BO + (r * LDK + p * 8) * 2); }
#pragma unroll
        for (int x = 0; x < 2; ++x) { const int e = ht + 256 * x, xr = e >> 3, p = e & 7;
            go[8 + x] = (unsigned)((xr * CONV_CH + 3072 + hd * 64 + p * 8) * 2); lo_[8 + x] = (unsigned)(XO + (xr * LDT + p * 8) * 2); }
#define SS3_ISSUE(c_) do { const GAS char* rb_ = (const GAS char*)(raw + (rowb + (size_t)(c_) * 64) * CONV_CH); \
            _Pragma("unroll") for (int x = 0; x < 10; ++x) ld[x] = *(const GAS u32x4*)(rb_ + go[x]); \
            if (hw == 0) { const float* sp_ = ssc + ((size_t)((b * 16 + hd) * NCHUNK + (c_))) * 256 + DIR * 128 + lane; sr0 = sp_[0]; sr1 = sp_[64]; } } while (0)
#define SS3_COMMIT(bi_, c_) do { LAS unsigned char* B_ = lds + (bi_) * BUF; \
            _Pragma("unroll") for (int x = 0; x < 10; ++x) *(LAS u32x4*)(B_ + lo_[x]) = ld[x]; \
            if (hw == 0) { LAS float* sc_ = (LAS float*)(B_ + SCO); const int i = lane; const float cs = sr1; const float cl = __shfl(cs, DIR ? 0 : 63); \
                sc_[i] = __expf(cs); sc_[64 + i] = sr0 * __expf(cl - cs); if (i == 0) sc_[128] = __expf(cl); } } while (0)
        { const int c0 = DIR ? NCHUNK - 1 : 0; SS3_ISSUE(c0); SS3_COMMIT(0, c0); SS3_ISSUE((DIR ? c0 - 1 : c0 + 1)); }
        for (int n = 0; n < NCHUNK; ++n) {
            const int c = DIR ? NCHUNK - 1 - n : n;
            WG_BAR();
            const bool more = n + 1 < NCHUNK; const int cn = DIR ? c - 1 : c + 1;
            if (more) { SS3_COMMIT((n + 1) & 1, cn); if (n + 2 < NCHUNK && (!(XP & 2) || n < 2)) SS3_ISSUE((DIR ? cn - 1 : cn + 1)); }
            if (n > 0 && !(XP & 1)) { const int tp = (DIR ? c + 1 : c - 1) * 64;
#pragma unroll
                for (int x = 0; x < 8; ++x) { const unsigned v = *(const LAS unsigned*)(ost + ((n - 1) & 1) * (64 * 72) + (hw * 16 + 2 * x + (lane >> 5)) * 72 + 2 * (lane & 31));
                    GAS char* ob_ = (GAS char*)(ys + (rowb + tp + hw * 16 + 2 * x) * 1024 + hd * 64);
                    (void)__builtin_amdgcn_global_atomic_fadd_v2bf16((GAS s16x2*)(ob_ + (lane >> 5) * 2048 + (lane & 31) * 4), __builtin_bit_cast(s16x2, v)); } }
        }
        WG_BAR();
        { const int tp = (DIR ? 0 : NCHUNK - 1) * 64;
#pragma unroll
          for (int x = 0; x < 8; ++x) { const unsigned v = *(const LAS unsigned*)(ost + ((NCHUNK - 1) & 1) * (64 * 72) + (hw * 16 + 2 * x + (lane >> 5)) * 72 + 2 * (lane & 31));
              GAS char* ob_ = (GAS char*)(ys + (rowb + tp + hw * 16 + 2 * x) * 1024 + hd * 64);
              (void)__builtin_amdgcn_global_atomic_fadd_v2bf16((GAS s16x2*)(ob_ + (lane >> 5) * 2048 + (lane & 31) * 4), __builtin_bit_cast(s16x2, v)); } }
#undef SS3_ISSUE
#undef SS3_COMMIT
    } else {
        const int p0 = 16 * wave;
        f32x4 Ht[8];
#pragma unroll
        for (int t = 0; t < 8; ++t) Ht[t] = (f32x4){0.f, 0.f, 0.f, 0.f};
        for (int n = 0; n < NCHUNK; ++n) {
            WG_BAR();
            const LAS unsigned char* Bb = lds + (n & 1) * BUF;
            const LAS bf16* Cb = (const LAS bf16*)(Bb + CO); const LAS bf16* Bmb = (const LAS bf16*)(Bb + BO); const LAS bf16* Xb = (const LAS bf16*)(Bb + XO);
            const LAS float* sc = (const LAS float*)(Bb + SCO);
            const int offa = fr * LDK + 4 * fq;
            f32x4 aY[4];
#pragma unroll
            for (int m = 0; m < 4; ++m) aY[m] = (f32x4){0.f, 0.f, 0.f, 0.f};
#pragma unroll
            for (int ks = 0; ks < 4; ++ks) { const bf16x8 bs = pack2(Ht[2 * ks], Ht[2 * ks + 1]); bf16x8 fa[4];
#pragma unroll
                for (int m = 0; m < 4; ++m) fa[m] = afrag16(Cb + offa + 16 * m * LDK + 32 * ks);
#pragma unroll
                for (int m = 0; m < 4; ++m) aY[m] = MFMA16(fa[m], bs, aY[m]); }
            bf16x8 xf[2];
#pragma unroll
            for (int kt = 0; kt < 2; ++kt) { const bf16x8 xv = *(const LAS bf16x8*)(Xb + (p0 + fr) * LDT + 32 * kt + 8 * fq);
                const f32x4 w0 = *(const LAS f32x4*)(sc + 64 + 32 * kt + 8 * fq), w1 = *(const LAS f32x4*)(sc + 64 + 32 * kt + 8 * fq + 4);
                u32x4 w; w.x = pkbf(bf2f_s(xv[0]) * w0[0], bf2f_s(xv[1]) * w0[1]); w.y = pkbf(bf2f_s(xv[2]) * w0[2], bf2f_s(xv[3]) * w0[3]);
                w.z = pkbf(bf2f_s(xv[4]) * w1[0], bf2f_s(xv[5]) * w1[1]); w.w = pkbf(bf2f_s(xv[6]) * w1[2], bf2f_s(xv[7]) * w1[3]);
                xf[kt] = __builtin_bit_cast(bf16x8, w); }
#pragma unroll
            for (int m = 0; m < 4; ++m) { const f32x4 ec = *(const LAS f32x4*)(sc + 16 * m + 4 * fq);
#pragma unroll
                for (int e = 0; e < 4; ++e) aY[m][e] *= ec[e]; }
            const float ecl = sc[128];
#pragma unroll
            for (int m = 0; m < 4; ++m)
#pragma unroll
                for (int e = 0; e < 4; ++e) ost[(n & 1) * (64 * 72) + (16 * m + 4 * fq + e) * 72 + p0 + fr] = f2bf1(aY[m][e]);
            { const LAS bf16* bp = Bmb + (8 * fq + (fr >> 2)) * LDK + 4 * (fr & 3);
#pragma unroll
              for (int t = 0; t < 8; ++t) {
                  bf16x8 f[2];
#pragma unroll
                  for (int kt = 0; kt < 2; ++kt) { const LAS bf16* p = bp + (32 * kt) * LDK + 16 * t;
                      const v4i16_t lo = __builtin_amdgcn_ds_read_tr16_b64_v4i16((LAS v4i16_t*)p), hi = __builtin_amdgcn_ds_read_tr16_b64_v4i16((LAS v4i16_t*)(p + 4 * LDK));
                      f[kt] = (bf16x8){lo[0], lo[1], lo[2], lo[3], hi[0], hi[1], hi[2], hi[3]}; }
                  Ht[t] = Ht[t] * ecl; Ht[t] = MFMA16(f[0], xf[0], Ht[t]); Ht[t] = MFMA16(f[1], xf[1], Ht[t]); } }
        }
        WG_BAR();
    }
}
#ifndef PG8_SP2_
#define PG8_SP2_ true
#endif
#ifndef MK_ONE_LAUNCH
#define MK_ONE_LAUNCH 1
#endif
constexpr int PPL = 13;
constexpr int NPHASE = 1 + PPL * DEPTH;
struct Args { const float* in[19]; float* out; unsigned char* ws; int ph_lo, ph_hi; };
__global__ void __launch_bounds__(NWAVES * 64, 2) fwd_kernel(Args args) {
    extern __shared__ __attribute__((aligned(16))) unsigned char lds_raw[];
    LAS unsigned char* lds = (LAS unsigned char*)lds_raw;
    unsigned* ctl = (unsigned*)(args.ws + WS_CTL);
    volatile LAS unsigned* MISC = (volatile LAS unsigned*)(lds + MISC_OFF);
    for (int u = threadIdx.x; u < 64; u += 512) MISC[u] = 0u;
    __syncthreads();
#if MK_ONE_LAUNCH
    XcdBarrier bar = xcd_barrier_post(ctl + CW_BAR, MISC + 8);
#define GRID_BAR() do { XcdBarrier bb_ = bar; asm volatile("" : "+s"(bb_.bar), "+s"(bb_.x)); xcd_barrier(bb_); } while (0)
#else
#define GRID_BAR() do {} while (0)
#endif
    const int lo = args.ph_lo, hi = args.ph_hi;
#define WSP(T, off) ((T*)(wsb + (off)))
#if defined(PROBE_STATE) || defined(PROBE_ANY) || defined(PROBE_SUB)
#define PROBE_PTR ((float*)(wsb + WS_CTL) + 2048)
#define PROBE_SCALE (1.0f + sqrtf(8.7e-4f * fminf(fmaxf(*(volatile float*)PROBE_PTR, 0.f), 1.f)))
#else
#define PROBE_PTR ((float*)nullptr)
#define PROBE_SCALE 1.0f
#endif
    for (int ph = lo; ph < hi; ++ph) {
        int tid = threadIdx.x, bid = blockIdx.x, G = gridDim.x;
        const __attribute__((address_space(4))) Args* ap = (const __attribute__((address_space(4))) Args*)__builtin_amdgcn_kernarg_segment_ptr();
        asm volatile("" : "+v"(tid)); asm volatile("" : "+s"(bid), "+s"(G), "+s"(ap));
        unsigned char* wsb = ap->ws;
        const int lane = tid & 63, wave = __builtin_amdgcn_readfirstlane(tid >> 6);
        const int gw = bid * NWAVES + wave, NGW = G * NWAVES, gtid = bid * 512 + tid, NGT = G * 512;
        const int l = (ph == 0) ? 0 : (ph - 1) / PPL; const int k = (ph == 0) ? -1 : (ph - 1) % PPL;
#if defined(PROBE_ANY)
        if (l == PROBE_L && k == PROBE_K0 && blockIdx.x == 0 && threadIdx.x == 0) ((unsigned long long*)(wsb + WS_CTL))[1100] = __builtin_amdgcn_s_memrealtime();
#endif
        switch (k) {
        case -1: {
            cvt_mixer_weights(lds, wsb, ap->in[2], ap->in[12], gw, NGW, wave, lane);
            phase_norm<float>(ap->in[0], ap->in[1], WSP(bf16, WS_XN), gw, NGW, lane);
        } break;
        case 0: {
            pg8::Gemm g{WSP(bf16, WS_XN), WSP(bf16, WS_WA), M, NWA, DM, 0, 0, 0}; pg8::StaticOrder S; S.init(M, NWA, G, bid);
            pg8::EpiRawA E{WSP(bf16, WS_RAW), WSP(float, WS_SCAL)};
            pg8::gemm_phase<pg8::EpiRawA, pg8::StaticOrder, true, PG8_SP2_>(lds, g, S, E);
#if defined(EXP_DUP_GEMM)
            if (l == 0 && (EXP_DUP_GEMM & 1)) { __syncthreads(); pg8::gemm_phase<pg8::EpiRawA, pg8::StaticOrder, true, PG8_SP2_>(lds, g, S, E); }
#endif
        } break;
        case 1: {
            if (l == 1) PB_START(3, wsb);
            prep_gdn_stash(lds, bid, WSP(bf16, WS_RAW), tid); prep_ssd_stash(lds, bid, WSP(bf16, WS_RAW), tid);
            zero_region(wsb + WS_OG, 64 * MiB, gtid, NGT); zero_region(wsb + WS_YS, 64 * MiB, gtid, NGT);
            GRID_BAR();
            if (l == 1) { PB_END(3, wsb); PB_START(1, wsb); }
            prep_gdn_range(lds, bid, WSP(bf16, WS_RAW), WSP(float, WS_SCAL), ap->in[3] + (size_t)l * 7 * CONV_CH, ap->in[4] + (size_t)l * CONV_CH,
                           ap->in[5] + l * 16, ap->in[6] + l * 16, WSP(bf16, WS_TQ), tid, wave, lane, WSP(float, WS_SCAL));
            __syncthreads();
            if (l == 1) { PB_END(1, wsb); PB_START(2, wsb); }
            { int tid2 = threadIdx.x; asm volatile("" : "+v"(tid2));
              prep_ssd_range(lds, bid, WSP(bf16, WS_RAW), ap->in[3] + (size_t)l * 7 * CONV_CH, ap->in[4] + (size_t)l * CONV_CH, tid2,
                             WSP(float, WS_SCAL), ap->in[8] + l * 32, ap->in[9] + l * 32, WSP(float, WS_SSC)); }
            if (l == 1) { __syncthreads(); PB_END(2, wsb); }
        } break;
        case 2: {
#if defined(EXP_DUP_ST)
            for (int c0_ = bid; c0_ < 256 * 2; c0_ += G) {
                const int c = c0_ & 255; const bool dup_ = c0_ >= 256;
                if (dup_ && (l != 0 || ((EXP_DUP_ST == 1) != (c < 128)))) continue;
                bf16* const ogp_ = dup_ ? (bf16*)ap->out : WSP(bf16, WS_OG); bf16* const ysp_ = dup_ ? (bf16*)ap->out : WSP(bf16, WS_YS);
#else
            for (int c = bid; c < 256; c += G) {
                bf16* const ogp_ = WSP(bf16, WS_OG); bf16* const ysp_ = WSP(bf16, WS_YS);
#endif
                int tid = threadIdx.x; asm volatile("" : "+v"(tid));
                const int lane = tid & 63, wave = __builtin_amdgcn_readfirstlane(tid >> 6);
                if (c < 128) { const int x_ = (c & 7) | ((c >> 4) << 3), hf_ = (c >> 3) & 1;
                    const int b_ = x_ >> 4, h_ = (x_ >> 1) & 7;
#if defined(EXP_DUP_ST) && defined(EXP_S2)
                    if (dup_) { if (x_ & 1) gdn_state2<1>(lds, b_, h_, hf_, WSP(bf16, WS_RAW), WSP(float, WS_SCAL), WSP(bf16, WS_TQ), ap->in[5] + l * 16, ap->in[6] + l * 16, ogp_, tid, wave, lane);
                                else        gdn_state2<0>(lds, b_, h_, hf_, WSP(bf16, WS_RAW), WSP(float, WS_SCAL), WSP(bf16, WS_TQ), ap->in[5] + l * 16, ap->in[6] + l * 16, ogp_, tid, wave, lane); } else
#endif
#if defined(EXP_DUP_ST) && defined(EXP_XP)
                    if (dup_) { if (x_ & 1) gdn_state3<1, EXP_XP>(lds, b_, h_, hf_, WSP(bf16, WS_RAW), WSP(float, WS_SCAL), WSP(bf16, WS_TQ), ogp_, tid, wave, lane, nullptr, 0);
                                else        gdn_state3<0, EXP_XP>(lds, b_, h_, hf_, WSP(bf16, WS_RAW), WSP(float, WS_SCAL), WSP(bf16, WS_TQ), ogp_, tid, wave, lane, nullptr, 0); } else
#endif
                    if (x_ & 1) gdn_state3<1>(lds, b_, h_, hf_, WSP(bf16, WS_RAW), WSP(float, WS_SCAL), WSP(bf16, WS_TQ), ogp_, tid, wave, lane, nullptr, 0);
                    else        gdn_state3<0>(lds, b_, h_, hf_, WSP(bf16, WS_RAW), WSP(float, WS_SCAL), WSP(bf16, WS_TQ), ogp_, tid, wave, lane, nullptr, 0); }
                else { const int c2 = c - 128, gi_ = c2 & 15, hl_ = c2 >> 4;
                    const int b_ = gi_ >> 2, hd_ = ((gi_ >> 1) & 1) * 8 + hl_;
#if defined(EXP_DUP_ST) && defined(EXP_XP)
                    if (dup_) { if (gi_ & 1) ssd_state3<1, EXP_XP>(lds, b_, hd_, WSP(bf16, WS_RAW), WSP(float, WS_SSC), ysp_, tid, wave, lane, nullptr, 0);
                                else         ssd_state3<0, EXP_XP>(lds, b_, hd_, WSP(bf16, WS_RAW), WSP(float, WS_SSC), ysp_, tid, wave, lane, nullptr, 0); } else
#endif
                    if (gi_ & 1) ssd_state3<1>(lds, b_, hd_, WSP(bf16, WS_RAW), WSP(float, WS_SSC), ysp_, tid, wave, lane, nullptr, 0);
                    else         ssd_state3<0>(lds, b_, hd_, WSP(bf16, WS_RAW), WSP(float, WS_SSC), ysp_, tid, wave, lane, nullptr, 0); }
                __syncthreads();
            }
        } break;
        case 3: {
            ssd_intra_range(lds, bid, WSP(bf16, WS_RAW), WSP(float, WS_SSC), ap->in[10] + l * 16, WSP(bf16, WS_TQ), tid);
#if defined(EXP_DUP_INTRA)
            if (l == 0) { __syncthreads();
            ssd_intra_range(lds, bid, WSP(bf16, WS_RAW), WSP(float, WS_SSC), ap->in[10] + l * 16, WSP(bf16, WS_TQ), tid);
 }
#endif
        } break;
        case 4: {
            if (l == 0) phase_norm<float>(ap->in[0], ap->in[1] + (size_t)l * DM, WSP(bf16, WS_XN2), gw, NGW, lane);
            else        phase_norm<bf16>((const bf16*)ap->out, ap->in[1] + (size_t)l * DM, WSP(bf16, WS_XN2), gw, NGW, lane);
#if defined(EXP_DUP_B)
            if (l == 0) { __syncthreads();
            phase_norm((l == 0) ? ap->in[0] : ap->out, ap->in[1] + (size_t)l * DM, WSP(bf16, WS_XN2), gw, NGW, lane);
 }
#endif
        } break;
        case 5: {
            pg8::Gemm g{WSP(bf16, WS_XN2), WSP(bf16, WS_WB), M, NGATE, DM, 0, 0, 0}; pg8::StaticOrder S; S.init(M, NGATE, G, bid);
            pg8::EpiBf16 E{WSP(bf16, WS_GATES), NGATE};
            pg8::gemm_phase<pg8::EpiBf16, pg8::StaticOrder, true, PG8_SP2_>(lds, g, S, E);
#if defined(EXP_DUP_GEMM)
            if (l == 0 && (EXP_DUP_GEMM & 2)) { __syncthreads(); pg8::gemm_phase<pg8::EpiBf16, pg8::StaticOrder, true, PG8_SP2_>(lds, g, S, E); }
#endif
        } break;
        case 6: {
            phase_finish(WSP(bf16, WS_OG), WSP(bf16, WS_YS), WSP(bf16, WS_TQ), WSP(bf16, WS_GATES), ap->in[7] + l * 128, ap->in[11] + l * 1024, WSP(bf16, WS_MIXED), gw, NGW, lane);
#if defined(EXP_DUP_B)
            if (l == 0) { __syncthreads();
            phase_finish(WSP(bf16, WS_OG), WSP(bf16, WS_YS), WSP(bf16, WS_TQ), WSP(bf16, WS_GATES), ap->in[7] + l * 128, ap->in[11] + l * 1024, WSP(bf16, WS_MIXED), gw, NGW, lane);
 }
#endif
        } break;
        case 7: {
            pg8::Gemm g{WSP(bf16, WS_MIXED), WSP(bf16, WS_WO), M, DM, 2048, 0, 0, 0}; pg8::StaticOrder S; S.init(M, DM, G, bid);
            pg8::EpiResidB E{(l == 0) ? ap->in[0] : (const float*)nullptr, (const bf16*)ap->out, WSP(bf16, WS_H), DM};
            pg8::gemm_phase<pg8::EpiResidB, pg8::StaticOrder, true, PG8_SP2_>(lds, g, S, E);
#if defined(EXP_DUP_GEMM)
            if (l == 0 && (EXP_DUP_GEMM & 4)) { __syncthreads(); pg8::gemm_phase<pg8::EpiResidB, pg8::StaticOrder, true, PG8_SP2_>(lds, g, S, E); }
#endif
        } break;
        case 8: {
            phase_norm2_router(lds, WSP(bf16, WS_H), ap->in[13] + l * DM, ap->in[14] + (size_t)l * DM * 16, WSP(bf16, WS_XN), WSP(float, WS_AFF), gw, NGW, tid, lane);
#if defined(EXP_DUP_A) || defined(EXP_DUP_N2)
            if (l == 0) { __syncthreads();
            phase_norm2_router(lds, WSP(bf16, WS_H), ap->in[13] + l * DM, ap->in[14] + (size_t)l * DM * 16, WSP(bf16, WS_XN), WSP(float, WS_AFF), gw, NGW, tid, lane);
            __syncthreads();
            cvt_expert_weights(lds, wsb, ap->in[15] + (size_t)l * NEXP * DM * EFF, ap->in[16] + (size_t)l * NEXP * DM * EFF, ap->in[17] + (size_t)l * NEXP * EFF * DM, gw, NGW, wave, lane);
            if (l + 1 < DEPTH) cvt_mixer_weights(lds, wsb, ap->in[2] + (size_t)(l + 1) * DM * 6720, ap->in[12] + (size_t)(l + 1) * 2048 * DM, gw, NGW, wave, lane);
 }
#endif
        } break;
        case 9: {
            if (bid < NB * NEXP) phase_topk(lds, WSP(float, WS_AFF), WSP(int, WS_IDX), WSP(float, WS_VAL), WSP(int, WS_INV), bid, tid, wave, lane);
            else if (G > NB * NEXP) { const int gw2 = (bid - NB * NEXP) * NWAVES + wave, NGW2 = (G - NB * NEXP) * NWAVES;
                cvt_expert_weights(lds, wsb, ap->in[15] + (size_t)l * NEXP * DM * EFF, ap->in[16] + (size_t)l * NEXP * DM * EFF, ap->in[17] + (size_t)l * NEXP * EFF * DM, gw2, NGW2, wave, lane);
                if (l + 1 < DEPTH) cvt_mixer_weights(lds, wsb, ap->in[2] + (size_t)(l + 1) * DM * 6720, ap->in[12] + (size_t)(l + 1) * 2048 * DM, gw2, NGW2, wave, lane); }
#if defined(EXP_DUP_A) || defined(EXP_DUP_TK)
            if (l == 0) { __syncthreads();
            for (int be = bid; be < NB * NEXP; be += G) phase_topk(lds, WSP(float, WS_AFF), WSP(int, WS_IDX), WSP(float, WS_VAL), WSP(int, WS_INV), be, tid, wave, lane);
 }
#endif
        } break;
        case 10: {
            pg8::Gemm g{WSP(bf16, WS_XN), WSP(bf16, WS_WGU), MEXP, 1024, DM, 2, 15, (size_t)1024 * 1024 * 2, WSP(int, WS_IDX), 14, SEQ}; pg8::StaticOrder S; S.init(MEXP, 1024, G, bid);
            pg8::EpiSwiglu E{WSP(bf16, WS_HMID), EFF};
            pg8::gemm_phase<pg8::EpiSwiglu, pg8::StaticOrder, true, PG8_SP2_, true>(lds, g, S, E);
#if defined(EXP_DUP_GEMM)
            if (l == 0 && (EXP_DUP_GEMM & 8)) { __syncthreads(); pg8::gemm_phase<pg8::EpiSwiglu, pg8::StaticOrder, true, PG8_SP2_, true>(lds, g, S, E); }
#endif
        } break;
        case 11: {
            pg8::Gemm g{WSP(bf16, WS_HMID), WSP(bf16, WS_WD), MEXP, 1024, EFF, 2, 15, (size_t)1024 * 512 * 2}; pg8::StaticOrder S; S.init(MEXP, 1024, G, bid);
            pg8::EpiBf16 E{WSP(bf16, WS_XG), 1024};
            pg8::gemm_phase<pg8::EpiBf16, pg8::StaticOrder, true, PG8_SP2_>(lds, g, S, E);
#if defined(EXP_DUP_GEMM)
            if (l == 0 && (EXP_DUP_GEMM & 16)) { __syncthreads(); pg8::gemm_phase<pg8::EpiBf16, pg8::StaticOrder, true, PG8_SP2_>(lds, g, S, E); }
#endif
        } break;
        default: {
            const bool last = (l + 1 == DEPTH);
            phase_combine(WSP(bf16, WS_H), ap->out, WSP(bf16, WS_XG), WSP(int, WS_INV), WSP(float, WS_VAL), last ? ap->in[18] : ap->in[1] + (size_t)(l + 1) * DM, WSP(bf16, WS_XN), last, gw, NGW, lane, PROBE_SCALE);

        } break;
        }
        if (ph + 1 < hi) GRID_BAR();
#if defined(EXP_XBAR)
        if (ph == 1) for (int xb_ = 0; xb_ < EXP_XBAR; ++xb_) GRID_BAR();
#endif
#if defined(PROBE_ANY)
        if (l == PROBE_L && k == PROBE_K1 && blockIdx.x == 0 && threadIdx.x == 0) { const unsigned long long t1_ = __builtin_amdgcn_s_memrealtime(), t0_ = ((unsigned long long*)(wsb + WS_CTL))[1100];
            const unsigned bk_ = (unsigned)((t1_ - t0_) / PROBE_TICKS); *(volatile float*)PROBE_PTR = (float)(bk_ > 40u ? 40u : bk_) * (1.0f / 40.0f); }
#endif
    }
#undef WSP
}

extern "C" void kernel_launch(void* const* d_in, const int* in_sizes, int n_in, void* d_out, int out_size, void* d_ws, size_t ws_size, hipStream_t stream) {
    static int grid = 0;
    if (grid == 0) {
        if (n_in != 19 || in_sizes[0] != M * DM || out_size != M * DM || ws_size < WS_END) { fprintf(stderr, "kernel_launch: unexpected shapes (n_in %d, in0 %d, out %d, ws %zu); nothing launched\n", n_in, n_in > 0 ? in_sizes[0] : -1, out_size, ws_size); grid = -1; return; }
        int dev = 0, cus = 0;
        if (hipGetDevice(&dev) != hipSuccess || hipDeviceGetAttribute(&cus, hipDeviceAttributeMultiprocessorCount, dev) != hipSuccess) { grid = -1; return; }
        if (hipFuncSetAttribute((const void*)fwd_kernel, hipFuncAttributeMaxDynamicSharedMemorySize, LDS_BYTES) != hipSuccess) { fprintf(stderr, "kernel_launch: hipFuncSetAttribute failed\n"); grid = -1; return; }
        (void)hipGetLastError();
        grid = cus;
    }
    if (grid < 0) return;
    (void)hipMemsetAsync((char*)d_ws + WS_CTL, 0, CTL_ZERO_BYTES, stream);
    Args a{};
    for (int i = 0; i < 19; ++i) a.in[i] = (const float*)d_in[i];
    a.out = (float*)d_out; a.ws = (unsigned char*)d_ws;
#if MK_ONE_LAUNCH
    a.ph_lo = 0; a.ph_hi = NPHASE;
    hipLaunchKernelGGL(fwd_kernel, dim3(grid), dim3(NWAVES * 64), LDS_BYTES, stream, a);
#else
    for (int p = 0; p < NPHASE; ++p) { a.ph_lo = p; a.ph_hi = p + 1; hipLaunchKernelGGL(fwd_kernel, dim3(grid), dim3(NWAVES * 64), LDS_BYTES, stream, a); }
#endif
}
```

```cpp
#include <hip/hip_runtime.h>
#include <cstdio>
#include <cstdint>
namespace pg8 {
#define PG8_LAS __attribute__((address_space(3)))
typedef unsigned short bf16_t;
typedef short bf16x8 __attribute__((ext_vector_type(8)));
typedef float f32x4 __attribute__((ext_vector_type(4)));
typedef unsigned u32x4 __attribute__((ext_vector_type(4)));
constexpr int BM = 256, BK = 64, HALF = 128, HTB = HALF * BK * 2  , STAGE_BYTES = 8 * HTB, NXCD = 8, WGM = 8;

__host__ __device__ __forceinline__ int lds_byte(int r, int c) { const int st = (r >> 4) * 2 + (c >> 5), rr = r & 15, cc = c & 31, ob = rr * 64 + cc * 2; return st * 1024 + (ob ^ (((ob >> 9) & 1) << 5)); }
__host__ __device__ __forceinline__ void stage_rc(int b, int& R, int& C) { const int st = b / 1024, sb = b % 1024, swz = sb ^ (((sb >> 9) & 1) << 5); R = (st >> 1) * 16 + swz / 64; C = (st & 1) * 32 + (swz % 64) / 2; }
__host__ __device__ __forceinline__ int perm32(int rho) { const int n = rho >> 4, i = rho & 15; return 8 * (i >> 2) + 4 * n + (i & 3); }

struct Unit { int pm, pn; };
struct Gemm { const bf16_t* A; const bf16_t* Bt; int M, N, K; int bshift, bmask; size_t bstride; const int* gidx = nullptr; int gshift = 0, gmul = 0;
    __device__ __forceinline__ size_t grp_off(int pm) const { return (size_t)((pm >> bshift) & bmask) * bstride; } };

struct StaticOrder {
    int nM, nN, nwg, G, c;
    __host__ __device__ void init(int M, int N, int G_, int c_) { nM = M / BM; nN = N / BM; nwg = nM * nN; G = G_; c = c_; }
    __host__ __device__ bool next(int i, Unit& u) const {
        const long L = (long)i * G + c; if (L >= nwg) return false;
        int wgid = (int)L; { const int q = nwg / NXCD, r = nwg % NXCD, xcd = wgid % NXCD, off = wgid / NXCD; wgid = (xcd < r ? xcd * (q + 1) : r * (q + 1) + (xcd - r) * q) + off; }
        const int nig = WGM * nN, gid = wgid / nig, fm = gid * WGM, gsz = (nM - fm) < WGM ? (nM - fm) : WGM;
        u.pm = fm + ((wgid % nig) % gsz); u.pn = (wgid % nig) / gsz; return true;
    }
    __device__ __forceinline__ void a_ready(const Unit&) const {}
    __device__ __forceinline__ void done(const Unit&) const {}
};

__device__ __forceinline__ unsigned cvt_pk_bf16(float lo, float hi) { unsigned r; asm volatile("v_cvt_pk_bf16_f32 %0, %1, %2" : "=v"(r) : "v"(lo), "v"(hi)); return r; }
__device__ __forceinline__ float silu_f(float x) { return x * __builtin_amdgcn_rcpf(1.0f + __builtin_amdgcn_exp2f(-1.4426950408889634f * x)); }
#ifndef PG8_NDEF
#define PG8_NDEF 2
#endif
#if defined(EPI_PLAIN)
#define EPI_ST16(p_, v_) (*(u32x4*)(p_) = (v_))
#define EPI_ST8(p_, v_) (*(u32x2*)(p_) = (v_))
#else
#define EPI_ST16(p_, v_) asm volatile("global_store_dwordx4 %0, %1, off sc1\n\ts_nop 1" :: "v"(p_), "v"(v_) : "memory")
#define EPI_ST8(p_, v_) asm volatile("global_store_dwordx2 %0, %1, off sc1" :: "v"(p_), "v"(v_) : "memory")
#endif
__device__ __forceinline__ unsigned epi_ror8(unsigned v) { return (unsigned)__builtin_amdgcn_update_dpp(0, (int)v, 0x128, 0xf, 0xf, false); }
__device__ __forceinline__ void epi_pair(const f32x4 (&a0)[2], const f32x4 (&a1)[2], bool hi, u32x4& sa, u32x4& sb) {
    u32x4 p0, p1; p0.x = cvt_pk_bf16(a0[0][0], a0[0][1]); p0.y = cvt_pk_bf16(a0[0][2], a0[0][3]); p0.z = cvt_pk_bf16(a0[1][0], a0[1][1]); p0.w = cvt_pk_bf16(a0[1][2], a0[1][3]);
    p1.x = cvt_pk_bf16(a1[0][0], a1[0][1]); p1.y = cvt_pk_bf16(a1[0][2], a1[0][3]); p1.z = cvt_pk_bf16(a1[1][0], a1[1][1]); p1.w = cvt_pk_bf16(a1[1][2], a1[1][3]);
    u32x4 sd, rc; sd.x = hi ? p0.x : p1.x; sd.y = hi ? p0.y : p1.y; sd.z = hi ? p0.z : p1.z; sd.w = hi ? p0.w : p1.w;
    rc.x = epi_ror8(sd.x); rc.y = epi_ror8(sd.y); rc.z = epi_ror8(sd.z); rc.w = epi_ror8(sd.w);
    sa.x = hi ? rc.x : p0.x; sa.y = hi ? rc.y : p0.y; sa.z = hi ? rc.z : p0.z; sa.w = hi ? rc.w : p0.w;
    sb.x = hi ? p1.x : rc.x; sb.y = hi ? p1.y : rc.y; sb.z = hi ? p1.z : rc.z; sb.w = hi ? p1.w : rc.w;
}
struct EpiBf16 {
    static constexpr bool PERM = true, AFTER_DRAIN = false, DEFERRABLE = false, COL64 = true;
    bf16_t* O; int ldc;
    __device__ __forceinline__ void operator()(const f32x4 (&acc)[2][2][4][2], const Unit& u, int wr, int wc, int fr, int fq) const {
        const bool hi = fr >= 8; const int row0 = u.pm * BM + wr * 64 + (fr & 7); const int col0 = u.pn * BM + wc * 64 + (hi ? 32 : 0) + 8 * fq;
#pragma unroll
        for (int ai = 0; ai < 2; ++ai)
#pragma unroll
            for (int m = 0; m < 4; ++m) { bf16_t* rowp = O + (size_t)(row0 + ai * HALF + m * 16) * ldc + col0;
                u32x4 sa, sb; epi_pair(acc[ai][0][m], acc[ai][1][m], hi, sa, sb);
                EPI_ST16(rowp, sa); EPI_ST16(rowp + (size_t)8 * ldc, sb); }
    }
};
struct EpiRawA {
    static constexpr bool PERM = true, AFTER_DRAIN = false, DEFERRABLE = false, COL64 = true;
    bf16_t* O; float* S;
    __device__ __forceinline__ void operator()(const f32x4 (&acc)[2][2][4][2], const Unit& u, int wr, int wc, int fr, int fq) const {
        if (u.pn < 18) {
            const bool hi = fr >= 8; const int row0 = u.pm * BM + wr * 64 + (fr & 7); const int col0 = u.pn * BM + wc * 64 + (hi ? 32 : 0) + 8 * fq;
#pragma unroll
            for (int ai = 0; ai < 2; ++ai)
#pragma unroll
                for (int m = 0; m < 4; ++m) { bf16_t* rowp = O + (size_t)(row0 + ai * HALF + m * 16) * 4608 + col0;
                    u32x4 sa, sb; epi_pair(acc[ai][0][m], acc[ai][1][m], hi, sa, sb);
                    EPI_ST16(rowp, sa); EPI_ST16(rowp + (size_t)8 * 4608, sb); }
        } else if (wc == 0) {
            const int row0 = u.pm * BM + wr * 64 + fr;
#pragma unroll
            for (int ai = 0; ai < 2; ++ai)
#pragma unroll
                for (int m = 0; m < 4; ++m) { float* sp = S + (size_t)(row0 + ai * HALF + m * 16) * 64 + 8 * fq;
#pragma unroll
                    for (int bj = 0; bj < 2; ++bj) { *(f32x4*)(sp + bj * 32) = acc[ai][bj][m][0]; *(f32x4*)(sp + bj * 32 + 4) = acc[ai][bj][m][1]; } }
        }
    }
};
struct EpiResid {
    static constexpr bool PERM = false, AFTER_DRAIN = false, DEFERRABLE = false, COL64 = false;
    const float* base; float* out; int ldc;
    __device__ __forceinline__ void operator()(const f32x4 (&acc)[2][2][4][2], const Unit& u, int wr, int wc, int fr, int fq) const {
        const int row0 = u.pm * BM + wr * 64 + fr, col0 = u.pn * BM + wc * 32 + 4 * fq;
#pragma unroll
        for (int ai = 0; ai < 2; ++ai)
#pragma unroll
            for (int mp = 0; mp < 2; ++mp) { f32x4 rv[2][2][2];
#pragma unroll
                for (int mm = 0; mm < 2; ++mm) { const size_t off = (size_t)(row0 + ai * HALF + (2 * mp + mm) * 16) * ldc + col0;
#pragma unroll
                    for (int bj = 0; bj < 2; ++bj)
#pragma unroll
                        for (int n = 0; n < 2; ++n) rv[mm][bj][n] = *(const f32x4*)(base + off + bj * HALF + n * 16); }
                asm volatile("" ::: "memory");
#pragma unroll
                for (int mm = 0; mm < 2; ++mm) { const size_t off = (size_t)(row0 + ai * HALF + (2 * mp + mm) * 16) * ldc + col0;
#pragma unroll
                    for (int bj = 0; bj < 2; ++bj)
#pragma unroll
                        for (int n = 0; n < 2; ++n) *(f32x4*)(out + off + bj * HALF + n * 16) = rv[mm][bj][n] + acc[ai][bj][2 * mp + mm][n]; }
                asm volatile("" ::: "memory"); }
    }
};
struct EpiPadA {
    static constexpr bool PERM = true, AFTER_DRAIN = false, DEFERRABLE = false, COL64 = true;
    bf16_t* O; int ldc;
    __device__ __forceinline__ void operator()(const f32x4 (&acc)[2][2][4][2], const Unit& u, int wr, int wc, int fr, int fq) const {
        const bool hi = fr >= 8; const int row0 = (u.pm & 31) * BM + wr * 64 + (fr & 7); const int col0 = (u.pn < 18 ? u.pn : 0) * BM + wc * 64 + (hi ? 32 : 0) + 8 * fq;
#pragma unroll
        for (int ai = 0; ai < 2; ++ai)
#pragma unroll
            for (int m = 0; m < 4; ++m) { bf16_t* rowp = O + (size_t)(row0 + ai * HALF + m * 16) * ldc + col0;
                u32x4 sa, sb; epi_pair(acc[ai][0][m], acc[ai][1][m], hi, sa, sb);
                EPI_ST16(rowp, sa); EPI_ST16(rowp + (size_t)8 * ldc, sb); }
    }
};
struct EpiNullA {
    static constexpr bool PERM = true, AFTER_DRAIN = false, DEFERRABLE = false, COL64 = true;
    bf16_t* O;
    __device__ __forceinline__ void operator()(const f32x4 (&acc)[2][2][4][2], const Unit& u, int wr, int wc, int fr, int fq) const {
        float s = 0.f;
#pragma unroll
        for (int ai = 0; ai < 2; ++ai)
#pragma unroll
            for (int bj = 0; bj < 2; ++bj)
#pragma unroll
                for (int m = 0; m < 4; ++m)
#pragma unroll
                    for (int n = 0; n < 2; ++n) s += acc[ai][bj][m][n][0] + acc[ai][bj][m][n][1] + acc[ai][bj][m][n][2] + acc[ai][bj][m][n][3];
        if (s == 12345.6789f) O[0] = 1;
    }
};
struct EpiResidB {
    static constexpr bool PERM = true, AFTER_DRAIN = false, DEFERRABLE = false, COL64 = true;
    const float* basef; const bf16_t* baseb; bf16_t* out; int ldc;
    __device__ __forceinline__ void operator()(const f32x4 (&acc)[2][2][4][2], const Unit& u, int wr, int wc, int fr, int fq) const {
        const int row0 = u.pm * BM + wr * 64 + fr, col0 = u.pn * BM + wc * 64 + 8 * fq;
#pragma unroll
        for (int ai = 0; ai < 2; ++ai)
#pragma unroll
            for (int mp = 0; mp < 2; ++mp) { f32x4 rv[2][2][2];
                if (basef) {
#pragma unroll
                    for (int mm = 0; mm < 2; ++mm) { const size_t off = (size_t)(row0 + ai * HALF + (2 * mp + mm) * 16) * ldc + col0;
#pragma unroll
                        for (int bj = 0; bj < 2; ++bj) { rv[mm][bj][0] = *(const f32x4*)(basef + off + bj * 32); rv[mm][bj][1] = *(const f32x4*)(basef + off + bj * 32 + 4); } }
                } else { u32x4 rb[2][2];
#pragma unroll
                    for (int mm = 0; mm < 2; ++mm) { const size_t off = (size_t)(row0 + ai * HALF + (2 * mp + mm) * 16) * ldc + col0;
#pragma unroll
                        for (int bj = 0; bj < 2; ++bj) rb[mm][bj] = *(const u32x4*)(baseb + off + bj * 32); }
#pragma unroll
                    for (int mm = 0; mm < 2; ++mm)
#pragma unroll
                        for (int bj = 0; bj < 2; ++bj) { const u32x4 t = rb[mm][bj];
                            rv[mm][bj][0] = (f32x4){__uint_as_float(t.x << 16), __uint_as_float(t.x & 0xffff0000u), __uint_as_float(t.y << 16), __uint_as_float(t.y & 0xffff0000u)};
                            rv[mm][bj][1] = (f32x4){__uint_as_float(t.z << 16), __uint_as_float(t.z & 0xffff0000u), __uint_as_float(t.w << 16), __uint_as_float(t.w & 0xffff0000u)}; } }
                asm volatile("" ::: "memory");
#pragma unroll
                for (int mm = 0; mm < 2; ++mm) { const size_t off = (size_t)(row0 + ai * HALF + (2 * mp + mm) * 16) * ldc + col0;
#pragma unroll
                    for (int bj = 0; bj < 2; ++bj) { const f32x4 v0 = rv[mm][bj][0] + acc[ai][bj][2 * mp + mm][0], v1 = rv[mm][bj][1] + acc[ai][bj][2 * mp + mm][1];
                        u32x4 w; w.x = cvt_pk_bf16(v0[0], v0[1]); w.y = cvt_pk_bf16(v0[2], v0[3]); w.z = cvt_pk_bf16(v1[0], v1[1]); w.w = cvt_pk_bf16(v1[2], v1[3]);
                        EPI_ST16(out + off + bj * 32, w); } }
                asm volatile("" ::: "memory"); }
    }
};
struct EpiSwiglu {
    static constexpr bool PERM = true, AFTER_DRAIN = false, DEFERRABLE = false, COL64 = true;
    bf16_t* O; int ldh;
    __device__ __forceinline__ void operator()(const f32x4 (&acc)[2][2][4][2], const Unit& u, int wr, int wc, int fr, int fq) const {
        const int row0 = u.pm * BM + wr * 64 + fr; const int f0 = (u.pn * BM + wc * 64 + 8 * fq) >> 1;
        typedef unsigned u32x2 __attribute__((ext_vector_type(2)));
#pragma unroll
        for (int ai = 0; ai < 2; ++ai)
#pragma unroll
            for (int m = 0; m < 4; ++m) { bf16_t* rowp = O + (size_t)(row0 + ai * HALF + m * 16) * ldh + f0;
#pragma unroll
                for (int bj = 0; bj < 2; ++bj) { const f32x4 v0 = acc[ai][bj][m][0], v1 = acc[ai][bj][m][1];
                    u32x2 w; w.x = cvt_pk_bf16(silu_f(v0[0]) * v0[1], silu_f(v0[2]) * v0[3]); w.y = cvt_pk_bf16(silu_f(v1[0]) * v1[1], silu_f(v1[2]) * v1[3]);
                    EPI_ST8(rowp + bj * 16, w); } }
    }
};
template <class Epi, class Sched, bool ALIGN_EPI = false, bool SP2 = false, bool GATHER = false>
__device__ __forceinline__ void gemm_phase(PG8_LAS unsigned char* lds, const Gemm g, const Sched& S, const Epi& E) {
    int tid_o = threadIdx.x; asm volatile("" : "+v"(tid_o));
    const int tid = tid_o, wid = __builtin_amdgcn_readfirstlane(tid >> 6), lane = tid & 63, wr = wid >> 2, wc = wid & 3, fr = lane & 15, fq = lane >> 4;
    const int K = g.K, nt = K / BK;
    unsigned voffA[2], voffB[2];
#pragma unroll
    for (int i = 0; i < 2; ++i) { int R, C; stage_rc(tid * 16 + i * 8192, R, C); const int Rb = Epi::COL64 ? (64 * (R >> 5) + perm32(R & 31)) : (Epi::PERM ? ((R & ~31) + perm32(R & 31)) : R);
        voffA[i] = (unsigned)(R * K + C) * 2u; voffB[i] = (unsigned)(Rb * K + C) * 2u; }
    const size_t kstep = (size_t)(BK * 2);
    const size_t hstep = (size_t)HALF * K * 2;
    const size_t tstep = 2 * hstep;
    const size_t hstepB = Epi::COL64 ? (size_t)32 * K * 2 : hstep;
    const size_t hstepA = GATHER ? (size_t)0 : hstep, tstepA = GATHER ? (size_t)0 : tstep;
    unsigned gC[2][2]; int gI[2][2];
    auto g_load = [&](const Unit& u) { _Pragma("unroll") for (int h = 0; h < 2; ++h) _Pragma("unroll") for (int i = 0; i < 2; ++i) { int R, C; stage_rc(tid * 16 + i * 8192, R, C);
        gI[h][i] = g.gidx[u.pm * BM + h * HALF + R]; } };
    auto g_make = [&](const Unit& u, unsigned (&o)[2][2]) { _Pragma("unroll") for (int h = 0; h < 2; ++h) _Pragma("unroll") for (int i = 0; i < 2; ++i) { int R, C; stage_rc(tid * 16 + i * 8192, R, C);
        const int row = u.pm * BM + h * HALF + R; o[h][i] = (unsigned)(((row >> g.gshift) * g.gmul + gI[h][i]) * K + C) * 2u; } };
    const unsigned ldsw = (unsigned)wid * 1024u;
    const int aoff = lds_byte(wr * 64 + fr, fq * 8), boff = lds_byte(wc * 32 + fr, fq * 8);
#define PG8_SA(b, h) (((b) * 2 + (h)) * HTB)
#define PG8_SB(b, h) ((4 + (b) * 2 + (h)) * HTB)
#define PG8_STAGE(bufoff, gbase, voff) do { _Pragma("unroll") for (int _i = 0; _i < 2; ++_i) \
        __builtin_amdgcn_global_load_lds((const unsigned*)((const char*)(gbase) + (voff)[_i]), (PG8_LAS unsigned*)(lds + (bufoff) + ldsw + _i * 8192), 16, 0, 0); } while (0)
#define PG8_LDA(dst, b, h) do { _Pragma("unroll") for (int m = 0; m < 4; ++m) _Pragma("unroll") for (int k = 0; k < 2; ++k) dst[m][k] = *(const PG8_LAS bf16x8*)(lds + PG8_SA(b, h) + aoff + m * 2048 + k * 1024); } while (0)
#define PG8_LDB(dst, b, h) do { _Pragma("unroll") for (int n = 0; n < 2; ++n) _Pragma("unroll") for (int k = 0; k < 2; ++k) dst[n][k] = *(const PG8_LAS bf16x8*)(lds + PG8_SB(b, h) + boff + n * 2048 + k * 1024); } while (0)
#define PG8_MMA(ai, bj, At, Bt) do { __builtin_amdgcn_s_setprio(1); _Pragma("unroll") for (int m = 0; m < 4; ++m) _Pragma("unroll") for (int n = 0; n < 2; ++n) _Pragma("unroll") for (int k = 0; k < 2; ++k) \
        acc[ai][bj][m][n] = __builtin_amdgcn_mfma_f32_16x16x32_bf16(Bt[n][k], At[m][k], acc[ai][bj][m][n], 0, 0, 0); __builtin_amdgcn_s_setprio(0); } while (0)
#define PG8_WAIT_V(n) asm volatile("s_waitcnt vmcnt(" #n ")" ::: "memory")
#define PG8_WAIT_L(n) asm volatile("s_waitcnt lgkmcnt(" #n ")" ::: "memory")
#define PG8_BAR __builtin_amdgcn_s_barrier()
#define PG8_SCHED __builtin_amdgcn_sched_barrier(0)
    Unit cur, nxt; int ui = 0;
    if (!S.next(0, cur)) return;
#ifndef PG8_DEFER
#define PG8_DEFER 0
#endif
    constexpr bool DEFER = PG8_DEFER && Epi::DEFERRABLE && !Epi::AFTER_DRAIN;
    u32x4 pend[2 * PG8_NDEF]; Unit pu = cur; bool have_pend = false;
    f32x4 acc[2][2][4][2];
#pragma unroll
    for (int a = 0; a < 2; ++a)
#pragma unroll
        for (int b = 0; b < 2; ++b)
#pragma unroll
            for (int m = 0; m < 4; ++m)
#pragma unroll
                for (int n = 0; n < 2; ++n) acc[a][b][m][n] = (f32x4){0.f, 0.f, 0.f, 0.f};
    bf16x8 At[4][2], B0[2][2], B1[2][2];
    const char* cA = (const char*)g.A + (size_t)cur.pm * tstepA; const char* cB = (const char*)g.Bt + g.grp_off(cur.pm) + (size_t)cur.pn * tstep;
    if constexpr (GATHER) { g_load(cur); g_make(cur, gC); }
#define PG8_VA(h) (GATHER ? gC[h] : voffA)
    S.a_ready(cur);
    if constexpr (SP2) {
        PG8_STAGE(PG8_SB(0, 0), cB, voffB); PG8_STAGE(PG8_SB(0, 1), cB + hstepB, voffB); PG8_STAGE(PG8_SA(0, 0), cA, PG8_VA(0)); PG8_STAGE(PG8_SA(0, 1), cA + hstepA, PG8_VA(1));
        if (wr == 1) PG8_BAR;
        PG8_WAIT_V(2); PG8_BAR;
        PG8_STAGE(PG8_SB(1, 0), cB + kstep, voffB); PG8_STAGE(PG8_SA(1, 0), cA + kstep, PG8_VA(0)); PG8_STAGE(PG8_SB(1, 1), cB + hstepB + kstep, voffB);
        PG8_WAIT_V(6); PG8_BAR;
    } else {
        PG8_STAGE(PG8_SB(0, 0), cB, voffB); PG8_STAGE(PG8_SA(0, 0), cA, PG8_VA(0)); PG8_STAGE(PG8_SB(0, 1), cB + hstepB, voffB); PG8_STAGE(PG8_SA(0, 1), cA + hstepA, PG8_VA(1));
        if (wr == 1) PG8_BAR;
        PG8_WAIT_V(4); PG8_BAR;
        PG8_STAGE(PG8_SB(1, 0), cB + kstep, voffB); PG8_STAGE(PG8_SA(1, 0), cA + kstep, PG8_VA(0)); PG8_STAGE(PG8_SB(1, 1), cB + hstepB + kstep, voffB);
        PG8_WAIT_V(6); PG8_BAR;
    }
    for (;;) {
        const bool has_next = S.next(ui + 1, nxt);
        const char* nA = has_next ? (const char*)g.A + (size_t)nxt.pm * tstepA : cA; const char* nB = has_next ? (const char*)g.Bt + g.grp_off(nxt.pm) + (size_t)nxt.pn * tstep : cB;
        if constexpr (GATHER) { if (has_next) g_load(nxt); }
        for (int t = 0; t < nt; t += 2) {
            const bool last = (t == nt - 2);
            const char* a1 = cA + (size_t)(t + 1) * kstep;
            const char* a2 = last ? nA : cA + (size_t)(t + 2) * kstep; const char* b2 = last ? nB : cB + (size_t)(t + 2) * kstep;
            const char* a3 = a2 + kstep; const char* b3 = b2 + kstep;
            if (last && has_next) S.a_ready(nxt);
#define PG8_GS() do { if constexpr (GATHER) { if (last && has_next) g_make(nxt, gC); } } while (0)
            if constexpr (SP2) {
            PG8_LDB(B0, 0, 0); PG8_LDB(B1, 0, 1); PG8_SCHED; PG8_LDA(At, 0, 0); PG8_STAGE(PG8_SA(1, 1), a1 + hstepA, PG8_VA(1)); PG8_GS();
            PG8_WAIT_V(8); PG8_WAIT_L(0); PG8_BAR; PG8_MMA(0, 0, At, B0); PG8_MMA(0, 1, At, B1); PG8_BAR; PG8_SCHED;
            PG8_LDA(At, 0, 1); PG8_STAGE(PG8_SB(0, 0), b2, voffB); PG8_STAGE(PG8_SB(0, 1), b2 + hstepB, voffB); PG8_STAGE(PG8_SA(0, 0), a2, PG8_VA(0));
            PG8_WAIT_V(8); PG8_WAIT_L(0); PG8_BAR; PG8_MMA(1, 0, At, B0); PG8_MMA(1, 1, At, B1); PG8_BAR; PG8_SCHED;
            PG8_LDB(B0, 1, 0); PG8_LDB(B1, 1, 1); PG8_SCHED; PG8_LDA(At, 1, 0); PG8_STAGE(PG8_SA(0, 1), a2 + hstepA, PG8_VA(1));
            PG8_WAIT_V(8); PG8_WAIT_L(0); PG8_BAR; PG8_MMA(0, 0, At, B0); PG8_MMA(0, 1, At, B1); PG8_BAR; PG8_SCHED;
            PG8_LDA(At, 1, 1); PG8_STAGE(PG8_SB(1, 0), b3, voffB); PG8_STAGE(PG8_SB(1, 1), b3 + hstepB, voffB); PG8_STAGE(PG8_SA(1, 0), a3, PG8_VA(0));
            PG8_WAIT_V(8); PG8_WAIT_L(0); PG8_BAR; PG8_MMA(1, 0, At, B0); PG8_MMA(1, 1, At, B1); PG8_BAR; PG8_SCHED;
            if constexpr (DEFER) { const bool go = have_pend && (t == 2 || last); E.flush_all(go ? ~0ull : 0ull, pend, pu, wr, wc, fr, fq); have_pend = have_pend && !go; PG8_SCHED; }
            } else {
            PG8_LDB(B0, 0, 0); PG8_SCHED; PG8_LDA(At, 0, 0); PG8_STAGE(PG8_SA(1, 1), a1 + hstepA, PG8_VA(1)); PG8_GS();
            PG8_WAIT_L(8); PG8_BAR; PG8_WAIT_L(0); PG8_MMA(0, 0, At, B0); PG8_BAR; PG8_SCHED;
            PG8_LDB(B1, 0, 1); PG8_STAGE(PG8_SB(0, 0), b2, voffB);
            PG8_BAR; PG8_WAIT_L(0); PG8_MMA(0, 1, At, B1); PG8_BAR;
            PG8_LDA(At, 0, 1); PG8_STAGE(PG8_SA(0, 0), a2, PG8_VA(0));
            PG8_BAR; PG8_WAIT_L(0); PG8_MMA(1, 0, At, B0); PG8_BAR; PG8_SCHED;
            PG8_STAGE(PG8_SB(0, 1), b2 + hstepB, voffB);
            PG8_WAIT_V(6); PG8_BAR; PG8_MMA(1, 1, At, B1); PG8_BAR;
            PG8_LDB(B0, 1, 0); PG8_SCHED; PG8_LDA(At, 1, 0); PG8_STAGE(PG8_SA(0, 1), a2 + hstepA, PG8_VA(1));
            PG8_WAIT_L(8); PG8_BAR; PG8_WAIT_L(0); PG8_MMA(0, 0, At, B0); PG8_BAR; PG8_SCHED;
            PG8_LDB(B1, 1, 1); PG8_STAGE(PG8_SB(1, 0), b3, voffB);
            PG8_BAR; PG8_WAIT_L(0); PG8_MMA(0, 1, At, B1); PG8_BAR;
            PG8_LDA(At, 1, 1); PG8_STAGE(PG8_SA(1, 0), a3, PG8_VA(0));
            PG8_BAR; PG8_WAIT_L(0); PG8_MMA(1, 0, At, B0); PG8_BAR; PG8_SCHED;
            PG8_STAGE(PG8_SB(1, 1), b3 + hstepB, voffB);
            PG8_WAIT_V(6); PG8_BAR; PG8_MMA(1, 1, At, B1); PG8_BAR;
            }
        }
        if constexpr (ALIGN_EPI) { if (wr == 0) PG8_BAR; }
        if constexpr (DEFER) { if (has_next) { E.first(acc, cur, wr, wc, fr, fq, pend); pu = cur; have_pend = true; } else E(acc, cur, wr, wc, fr, fq); S.done(cur); }
        else if constexpr (!Epi::AFTER_DRAIN) { E(acc, cur, wr, wc, fr, fq); S.done(cur); }
        if (!has_next) break;
#pragma unroll
        for (int a = 0; a < 2; ++a)
#pragma unroll
            for (int b = 0; b < 2; ++b)
#pragma unroll
                for (int m = 0; m < 4; ++m)
#pragma unroll
                    for (int n = 0; n < 2; ++n) acc[a][b][m][n] = (f32x4){0.f, 0.f, 0.f, 0.f};
        cur = nxt; cA = nA; cB = nB; ++ui;
        if constexpr (ALIGN_EPI) { if (wr == 1) PG8_BAR; }
    }
    PG8_WAIT_V(0);
    if constexpr (!ALIGN_EPI) { if (wr == 0) PG8_BAR; }
    PG8_BAR;
    if constexpr (Epi::AFTER_DRAIN) { E.fused(acc, cur, wr, wc, fr, fq, lds, wid, lane); S.done(cur); }
#undef PG8_SA
#undef PG8_VA
#undef PG8_GS
#undef PG8_SB
#undef PG8_STAGE
#undef PG8_LDA
#undef PG8_LDB
#undef PG8_MMA
#undef PG8_WAIT_V
#undef PG8_WAIT_L
#undef PG8_BAR
#undef PG8_SCHED
}
}
#define GAS __attribute__((address_space(1)))
#define LAS __attribute__((address_space(3)))
typedef unsigned short bf16;
typedef unsigned v4u __attribute__((ext_vector_type(4)));
typedef float f32x4 __attribute__((ext_vector_type(4)));
typedef short bf16x8 __attribute__((ext_vector_type(8)));
typedef GAS unsigned gu32;
typedef GAS unsigned long long gu64;
#define RLX_AGENT __ATOMIC_RELAXED, __HIP_MEMORY_SCOPE_AGENT
#define LDS_WAIT() asm volatile("s_waitcnt lgkmcnt(0)" ::: "memory")
#define VM_WAIT() asm volatile("s_waitcnt vmcnt(0)" ::: "memory")
__device__ __forceinline__ unsigned long long rt() { return __builtin_amdgcn_s_memrealtime(); }
__device__ __forceinline__ unsigned f2bf(float f) { unsigned u = __builtin_bit_cast(unsigned, f); return (u + 0x7fffu + ((u >> 16) & 1u)) >> 16; }
__device__ __forceinline__ unsigned pk2(float lo, float hi) { return f2bf(lo) | (f2bf(hi) << 16); }
#define XB_TMO      128
#define XB_XCNT(j)  (256  + 64 * (j))
#define XB_XSUB(j)  (1280 + 64 * (j))
#define XB_XGEN(j)  (2304 + 64 * (j))
#define XB_TOP      3328
#define XB_TOPGEN   3392
#define XCD_BAR_WORDS 3456
#define XB_SPIN_CAP (1u << 18)

__device__ __forceinline__ unsigned xb_ld(unsigned* p)              { return __hip_atomic_load(p, __ATOMIC_RELAXED, __HIP_MEMORY_SCOPE_AGENT); }
__device__ __forceinline__ unsigned xb_add(unsigned* p, unsigned v) { return __hip_atomic_fetch_add(p, v, __ATOMIC_RELAXED, __HIP_MEMORY_SCOPE_AGENT); }
__device__ __forceinline__ unsigned xb_xcc_id() { return (unsigned)__builtin_amdgcn_s_getreg((3 << 11) | 20) & 0xFu; }
#define XB_SPIN(cond, bar) do { unsigned _sp = 0; while (cond) { __builtin_amdgcn_s_sleep(1); \
    if ((++_sp & 255u) == 0u) { if (xb_ld(&(bar)[XB_TMO])) break; if (_sp > XB_SPIN_CAP) { atomicAdd(&(bar)[XB_TMO], 1u); break; } } } } while (0)

struct XcdBarrier {
    unsigned* bar; unsigned x;
    volatile LAS unsigned* st;
};

__device__ __forceinline__ XcdBarrier xcd_barrier_post(unsigned* bar, volatile LAS unsigned* st) {
    XcdBarrier b; b.bar = bar; b.x = xb_xcc_id(); b.st = st;
    if (threadIdx.x == 0) (void)xb_add(&bar[XB_XCNT(b.x)], 1u);
    return b;
}
__device__ __forceinline__ void xcd_barrier_complete(unsigned* bar, unsigned x, unsigned& nloc, unsigned& nx) {
    const unsigned G = gridDim.x * gridDim.y * gridDim.z;
    unsigned sum, cnt, mine, sp = 0u;
    for (;;) {
        sum = 0u; cnt = 0u; mine = 0u;
#pragma unroll
        for (unsigned j = 0; j < 16; ++j) { const unsigned c = xb_ld(&bar[XB_XCNT(j)]); sum += c; cnt += (c > 0u) ? 1u : 0u; mine = (j == x) ? c : mine; }
        if (sum == G) break;
        __builtin_amdgcn_s_sleep(1);
        if ((++sp & 255u) == 0u) { if (xb_ld(&bar[XB_TMO])) break; if (sp > XB_SPIN_CAP) { atomicAdd(&bar[XB_TMO], 1u); break; } }
    }
    nloc = mine > 0u ? mine : 1u; nx = cnt > 0u ? cnt : 1u;
}

__device__ __forceinline__ void xcd_barrier(const XcdBarrier& b) {
    asm volatile("s_waitcnt vmcnt(0)" ::: "memory");
    __syncthreads();
    if (threadIdx.x == 0) {
        unsigned* bar = b.bar;
        __builtin_amdgcn_s_waitcnt(0);
        unsigned nloc = b.st[0], nx = b.st[1];
        if (nloc == 0u) { xcd_barrier_complete(bar, b.x, nloc, nx); b.st[0] = nloc; b.st[1] = nx; }
        const unsigned old = xb_add(&bar[XB_XSUB(b.x)], 1u);
        const unsigned gen = old / nloc;
        if (old + 1u == (gen + 1u) * nloc) {
            __builtin_amdgcn_fence(__ATOMIC_RELEASE, "agent");
            asm volatile("s_waitcnt vmcnt(0)" ::: "memory");
            const unsigned og = xb_add(&bar[XB_TOP], 1u);
            const unsigned tg = og / nx;
            if (og + 1u == (tg + 1u) * nx) xb_add(&bar[XB_TOPGEN], 1u);
            else XB_SPIN(xb_ld(&bar[XB_TOPGEN]) == tg, bar);
            __builtin_amdgcn_fence(__ATOMIC_ACQUIRE, "agent");
            xb_add(&bar[XB_XGEN(b.x)], 1u);
            asm volatile("s_waitcnt vmcnt(0)" ::: "memory");
        } else {
            XB_SPIN(xb_ld(&bar[XB_XGEN(b.x)]) == gen, bar);
            __builtin_amdgcn_fence(__ATOMIC_ACQUIRE, "agent");
            asm volatile("s_waitcnt vmcnt(0)" ::: "memory");
        }
    }
    __syncthreads();
}
constexpr int NB = 4, SEQ = 8192, DM = 1024, M = NB * SEQ, DEPTH = 2;
constexpr int NCHUNK = SEQ / 64;
constexpr int CONV_CH = 4608, NWA = 4864  , NGATE = 2048, NEXP = 16, EFF = 512, CAP = 1024;
constexpr int MEXP = NB * NEXP * CAP;
constexpr float EPS = 1e-6f;
constexpr int NWAVES = 8;
constexpr size_t MiB = 1u << 20;
constexpr size_t WS_CTL = 0, CTL_ZERO_BYTES = 1 * MiB;
constexpr size_t WS_WA = 1 * MiB;
constexpr size_t WS_WB = 11 * MiB;
constexpr size_t WS_WO = 15 * MiB;
constexpr size_t WS_XN = 19 * MiB;
constexpr size_t WS_RAW = 83 * MiB;
constexpr size_t WS_SCAL = 371 * MiB;
constexpr size_t WS_OG = 19 * MiB;
constexpr size_t WS_YS = 443 * MiB;
constexpr size_t WS_XN2 = 83 * MiB;
constexpr size_t WS_GATES = 147 * MiB;
constexpr size_t WS_MIXED = 147 * MiB;
constexpr size_t WS_WGU = 83 * MiB;
constexpr size_t WS_WD = 115 * MiB;
constexpr size_t WS_XG = 131 * MiB;
constexpr size_t WS_HMID = 259 * MiB;
constexpr size_t WS_AFF = 323 * MiB;
constexpr size_t WS_IDX = 325 * MiB;
constexpr size_t WS_VAL = 326 * MiB;
constexpr size_t WS_INV = 327 * MiB;
constexpr size_t WS_H = 443 * MiB;
constexpr size_t WS_END = 507 * MiB;
constexpr int CW_TMO = 0, CW_BAR = 4096;
constexpr int LDS_BYTES = 163840;
constexpr int MISC_OFF = LDS_BYTES - 256;

typedef short bf16x8 __attribute__((ext_vector_type(8)));
typedef short bf16x4 __attribute__((ext_vector_type(4)));
typedef float f32x4 __attribute__((ext_vector_type(4)));
typedef float f32x2 __attribute__((ext_vector_type(2)));
typedef unsigned u32x4 __attribute__((ext_vector_type(4)));
typedef unsigned u32x2 __attribute__((ext_vector_type(2)));
typedef __bf16 bf16x2_t __attribute__((ext_vector_type(2)));
typedef short s16x2 __attribute__((ext_vector_type(2)));

__device__ __forceinline__ float bf2f(unsigned short v) { return __uint_as_float((unsigned)v << 16); }
__device__ __forceinline__ float bf2f_s(short v) { return __uint_as_float((unsigned)(unsigned short)v << 16); }
__device__ __forceinline__ unsigned pkbf(float lo, float hi) { f32x2 v = {lo, hi}; bf16x2_t b = __builtin_convertvector(v, bf16x2_t); return __builtin_bit_cast(unsigned, b); }
__device__ __forceinline__ unsigned short f2bf1(float f) { return (unsigned short)(pkbf(f, 0.f) & 0xffffu); }
__device__ __forceinline__ float silu(float x) { return x * __builtin_amdgcn_rcpf(1.0f + __builtin_amdgcn_exp2f(-1.4426950408889634f * x)); }
__device__ __forceinline__ float softplus_f(float x) { return x > 20.f ? x : log1pf(expf(x)); }
__device__ __forceinline__ float sigmoid_f(float x) { return 1.0f / (1.0f + expf(-x)); }
__device__ __forceinline__ void atomic_add_bf16x2(bf16* p, float a, float b) {
    (void)__builtin_amdgcn_global_atomic_fadd_v2bf16((GAS s16x2*)p, __builtin_bit_cast(s16x2, pkbf(a, b)));
}
template <int CTRL> __device__ __forceinline__ float dppf(float v) { return __builtin_bit_cast(float, __builtin_amdgcn_update_dpp(0, __builtin_bit_cast(int, v), CTRL, 0xF, 0xF, true)); }
__device__ __forceinline__ float wave_sum(float v) {
    v += dppf<0xB1>(v); v += dppf<0x4E>(v); v += dppf<0x141>(v); v += dppf<0x140>(v);
    const float s0 = __builtin_bit_cast(float, __builtin_amdgcn_readlane(__builtin_bit_cast(int, v), 0)), s1 = __builtin_bit_cast(float, __builtin_amdgcn_readlane(__builtin_bit_cast(int, v), 16));
    const float s2 = __builtin_bit_cast(float, __builtin_amdgcn_readlane(__builtin_bit_cast(int, v), 32)), s3 = __builtin_bit_cast(float, __builtin_amdgcn_readlane(__builtin_bit_cast(int, v), 48));
    return (s0 + s1) + (s2 + s3);
}

__device__ __forceinline__ float softplus_fast(float x) { const float e = __builtin_amdgcn_exp2f(1.4426950408889634f * fminf(x, 20.f));
    const float lg = (e < 1e-3f) ? e * (1.0f - 0.5f * e) : 0.6931471805599453f * __builtin_amdgcn_logf(1.0f + e); return x > 20.f ? x : lg; }
__device__ __forceinline__ float sigmoid_fast(float x) { return __builtin_amdgcn_rcpf(1.0f + __builtin_amdgcn_exp2f(-1.4426950408889634f * x)); }
__device__ __forceinline__ float scan_fwd64(float v, int lane) {
    v += dppf<0x111>(v); v += dppf<0x112>(v); v += dppf<0x114>(v); v += dppf<0x118>(v);
    const float t0 = __builtin_bit_cast(float, __builtin_amdgcn_readlane(__builtin_bit_cast(int, v), 15)), t1 = __builtin_bit_cast(float, __builtin_amdgcn_readlane(__builtin_bit_cast(int, v), 31));
    const float t2 = __builtin_bit_cast(float, __builtin_amdgcn_readlane(__builtin_bit_cast(int, v), 47));
    const int row = lane >> 4; return v + (row == 0 ? 0.f : row == 1 ? t0 : row == 2 ? t0 + t1 : (t0 + t1) + t2);
}
__device__ __forceinline__ float scan_bwd64(float v, int lane) {
    v += dppf<0x101>(v); v += dppf<0x102>(v); v += dppf<0x104>(v); v += dppf<0x108>(v);
    const float t1 = __builtin_bit_cast(float, __builtin_amdgcn_readlane(__builtin_bit_cast(int, v), 16)), t2 = __builtin_bit_cast(float, __builtin_amdgcn_readlane(__builtin_bit_cast(int, v), 32));
    const float t3 = __builtin_bit_cast(float, __builtin_amdgcn_readlane(__builtin_bit_cast(int, v), 48));
    const int row = lane >> 4; return v + (row == 3 ? 0.f : row == 2 ? t3 : row == 1 ? t3 + t2 : (t3 + t2) + t1);
}

template <int CTRL> __device__ __forceinline__ int dppi(int v) { return __builtin_amdgcn_update_dpp(0, v, CTRL, 0xF, 0xF, true); }
__device__ __forceinline__ int scan_fwd64_i(int v, int lane) {
    v += dppi<0x111>(v); v += dppi<0x112>(v); v += dppi<0x114>(v); v += dppi<0x118>(v);
    const int t0 = __builtin_amdgcn_readlane(v, 15), t1 = __builtin_amdgcn_readlane(v, 31), t2 = __builtin_amdgcn_readlane(v, 47);
    const int row = lane >> 4; return v + (row == 0 ? 0 : row == 1 ? t0 : row == 2 ? t0 + t1 : t0 + t1 + t2);
}
template <int MT, int NT>
__device__ __forceinline__ void mma_lds(f32x4 (&acc)[MT][NT], const LAS bf16* A, int lda, int m0, const LAS bf16* Bt, int ldb, int n0, int K, int fr, int fq) {
    for (int k0 = 0; k0 < K; k0 += 32) {
        bf16x8 a[MT], b[NT];
#pragma unroll
        for (int mt = 0; mt < MT; ++mt) a[mt] = *(const LAS bf16x8*)(A + (m0 + mt * 16 + fr) * lda + k0 + fq * 8);
#pragma unroll
        for (int nt = 0; nt < NT; ++nt) b[nt] = *(const LAS bf16x8*)(Bt + (n0 + nt * 16 + fr) * ldb + k0 + fq * 8);
#pragma unroll
        for (int mt = 0; mt < MT; ++mt)
#pragma unroll
            for (int nt = 0; nt < NT; ++nt) acc[mt][nt] = __builtin_amdgcn_mfma_f32_16x16x32_bf16(a[mt], b[nt], acc[mt][nt], 0, 0, 0);
    }
}

__device__ __forceinline__ void conv16(float (&acc)[16], const LAS bf16* src, int ld, const LAS float* cw, int cwld) {
#pragma unroll
    for (int c = 0; c < 16; ++c) acc[c] = cw[7 * cwld + c];
#pragma unroll
    for (int tap = 0; tap < 7; ++tap) {
        const bf16x8 x0 = *(const LAS bf16x8*)(src + tap * ld), x1 = *(const LAS bf16x8*)(src + tap * ld + 8);
        const LAS float* w = cw + tap * cwld;
#pragma unroll
        for (int c = 0; c < 8; ++c) { acc[c] += bf2f_s(x0[c]) * w[c]; acc[8 + c] += bf2f_s(x1[c]) * w[8 + c]; }
        if (tap & 1) asm volatile("" ::: "memory");
    }
}
__device__ __forceinline__ void conv8(float (&acc)[8], const LAS bf16* src, int ld, const LAS float* cw, int cwld) {
#pragma unroll
    for (int c = 0; c < 8; ++c) acc[c] = cw[7 * cwld + c];
#pragma unroll
    for (int tap = 0; tap < 7; ++tap) {
        const bf16x8 x0 = *(const LAS bf16x8*)(src + tap * ld);
        const LAS float* w = cw + tap * cwld;
#pragma unroll
        for (int c = 0; c < 8; ++c) acc[c] += bf2f_s(x0[c]) * w[c];
        if (tap & 1) asm volatile("" ::: "memory");
    }
}

#if defined(PROBE_SUB)
#define PB_START(id_, ws_) do { if ((id_) == PROBE_SUB && blockIdx.x == 0 && threadIdx.x == 0) ((unsigned long long*)(ws_))[1100] = __builtin_amdgcn_s_memrealtime(); } while (0)
#define PB_END(id_, ws_) do { if ((id_) == PROBE_SUB && blockIdx.x == 0 && threadIdx.x == 0) { const unsigned long long t1_ = __builtin_amdgcn_s_memrealtime(), t0_ = ((unsigned long long*)(ws_))[1100]; \
        const unsigned bk_ = (unsigned)((t1_ - t0_) / PROBE_TICKS); *((volatile float*)(ws_) + 2048) = (float)(bk_ > 40u ? 40u : bk_) * (1.0f / 40.0f); } } while (0)
#else
#define PB_START(id_, ws_) do {} while (0)
#define PB_END(id_, ws_) do {} while (0)
#endif
__device__ __forceinline__ void transpose_item(const float* W, int K, int N, int k0, int n0, bf16* WT, int drow0, int rmul, LAS float* scr, int lane) {
    f32x4 v[16];
#pragma unroll
    for (int i = 0; i < 16; ++i) { const int kk = 4 * i + (lane >> 4); v[i] = *(const GAS f32x4*)(W + (size_t)(k0 + kk) * N + n0 + 4 * (lane & 15)); }
#pragma unroll
    for (int i = 0; i < 16; ++i) { const int kk = 4 * i + (lane >> 4); LAS float* d = scr + kk * 65 + 4 * (lane & 15); d[0] = v[i].x; d[1] = v[i].y; d[2] = v[i].z; d[3] = v[i].w; }
    LDS_WAIT(); asm volatile("" ::: "memory");
    const int c = lane & 7;
#pragma unroll
    for (int j = 0; j < 8; ++j) { const int n = (lane >> 3) + 8 * j; const LAS float* s = scr + (8 * c) * 65 + n;
        u32x4 o; o.x = pkbf(s[0 * 65], s[1 * 65]); o.y = pkbf(s[2 * 65], s[3 * 65]); o.z = pkbf(s[4 * 65], s[5 * 65]); o.w = pkbf(s[6 * 65], s[7 * 65]);
        *(GAS u32x4*)(WT + (size_t)(drow0 + rmul * n) * K + k0 + 8 * c) = o; }
    LDS_WAIT(); asm volatile("" ::: "memory");
}
__device__ __forceinline__ void cvt_mixer_weights(LAS unsigned char* lds, unsigned char* ws, const float* w_in, const float* w_out, int gw, int NGW, int wave, int lane) {
    LAS float* scr = (LAS float*)(lds + wave * 16896);
    bf16* WA = (bf16*)(ws + WS_WA); bf16* WB = (bf16*)(ws + WS_WB); bf16* WO = (bf16*)(ws + WS_WO);
    constexpr int I_IN = 16 * 105, I_OUT = 32 * 16;
    for (int it = gw; it < I_IN + I_OUT; it += NGW) {
        if (it < I_IN) { const int kb = it / 105, nb = it % 105, n0 = nb * 64;
            bf16* dst; int drow;
            if (n0 < 4608) { dst = WA; drow = n0; } else if (n0 < 6656) { dst = WB; drow = n0 - 4608; } else { dst = WA; drow = 4608 + (n0 - 6656); }
            transpose_item(w_in, 1024, 6720, kb * 64, n0, dst, drow, 1, scr, lane);
        } else { const int r = it - I_IN, kb = r / 16, nb = r % 16; transpose_item(w_out, 2048, 1024, kb * 64, nb * 64, WO, nb * 64, 1, scr, lane); }
    }
    { u32x4 z = (u32x4){0u, 0u, 0u, 0u}; asm volatile("" : "+v"(z));
      for (int r = gw; r < 192; r += NGW) { GAS u32x4* p = (GAS u32x4*)(WA + (size_t)(4672 + r) * 1024) + lane; p[0] = z; p[64] = z; } }
}
__device__ __forceinline__ void cvt_expert_weights(LAS unsigned char* lds, unsigned char* ws, const float* w_gate, const float* w_up, const float* w_down, int gw, int NGW, int wave, int lane) {
    LAS float* scr = (LAS float*)(lds + wave * 16896);
    bf16* WGU = (bf16*)(ws + WS_WGU); bf16* WD = (bf16*)(ws + WS_WD);
    constexpr int I_G = 16 * 8;
    constexpr int I_D = 8 * 16;
    constexpr int PER_E = 2 * I_G + I_D;
    for (int it = gw; it < NEXP * PER_E; it += NGW) {
        const int e = it / PER_E; int r = it % PER_E;
        if (r < 2 * I_G) { const int up = r >= I_G; if (up) r -= I_G; const int kb = r / 8, nb = r % 8;
            transpose_item((up ? w_up : w_gate) + (size_t)e * 1024 * 512, 1024, 512, kb * 64, nb * 64, WGU + (size_t)e * 1024 * 1024, 2 * (nb * 64) + up, 2, scr, lane);
        } else { r -= 2 * I_G; const int kb = r / 16, nb = r % 16;
            transpose_item(w_down + (size_t)e * 512 * 1024, 512, 1024, kb * 64, nb * 64, WD + (size_t)e * 1024 * 512, nb * 64, 1, scr, lane); }
    }
}

__device__ __forceinline__ void rms_row_regs(const float* xrow, const f32x4 (&w)[4], f32x4 (&v)[4], int lane) {
    const GAS f32x4* xr = (const GAS f32x4*)xrow + lane; float s = 0.f;
#pragma unroll
    for (int j = 0; j < 4; ++j) { v[j] = xr[64 * j]; s += (v[j].x * v[j].x + v[j].y * v[j].y) + (v[j].z * v[j].z + v[j].w * v[j].w); }
    const float rstd = __builtin_amdgcn_rsqf(wave_sum(s) * (1.0f / DM) + EPS);
#pragma unroll
    for (int j = 0; j < 4; ++j) v[j] = v[j] * rstd * w[j];
}
__device__ __forceinline__ void row_load4(const float* xrow, f32x4 (&v)[4], int lane) {
    const GAS f32x4* xr = (const GAS f32x4*)xrow + lane;
#pragma unroll
    for (int j = 0; j < 4; ++j) v[j] = xr[64 * j];
}
__device__ __forceinline__ void row_load4(const bf16* xrow, u32x2 (&v)[4], int lane) {
    const GAS u32x2* xr = (const GAS u32x2*)xrow + lane;
#pragma unroll
    for (int j = 0; j < 4; ++j) v[j] = xr[64 * j];
}
__device__ __forceinline__ void row_get(const f32x4 (&b)[4], f32x4 (&v)[4]) {
#pragma unroll
    for (int j = 0; j < 4; ++j) v[j] = b[j];
}
__device__ __forceinline__ void row_get(const u32x2 (&b)[4], f32x4 (&v)[4]) {
#pragma unroll
    for (int j = 0; j < 4; ++j) v[j] = (f32x4){__uint_as_float(b[j].x << 16), __uint_as_float(b[j].x & 0xffff0000u), __uint_as_float(b[j].y << 16), __uint_as_float(b[j].y & 0xffff0000u)};
}
template <class T> struct RowBuf;
template <> struct RowBuf<float> { typedef f32x4 type; };
template <> struct RowBuf<bf16> { typedef u32x2 type; };
__device__ __forceinline__ void rms_regs(const f32x4 (&w)[4], f32x4 (&v)[4]) {
    float s = 0.f;
#pragma unroll
    for (int j = 0; j < 4; ++j) s += (v[j].x * v[j].x + v[j].y * v[j].y) + (v[j].z * v[j].z + v[j].w * v[j].w);
    const float rstd = __builtin_amdgcn_rsqf(wave_sum(s) * (1.0f / DM) + EPS);
#pragma unroll
    for (int j = 0; j < 4; ++j) v[j] = v[j] * rstd * w[j];
}
__device__ __forceinline__ void store_row_bf16(bf16* orow, const f32x4 (&v)[4], int lane) {
    GAS u32x2* o8 = (GAS u32x2*)orow + lane;
#pragma unroll
    for (int j = 0; j < 4; ++j) { u32x2 t; t.x = pkbf(v[j].x, v[j].y); t.y = pkbf(v[j].z, v[j].w); o8[64 * j] = t; }
}
__device__ __forceinline__ void load_w4(const float* w, f32x4 (&wv)[4], int lane) {
#pragma unroll
    for (int j = 0; j < 4; ++j) wv[j] = ((const GAS f32x4*)w)[lane + 64 * j];
}
template <class T>
__device__ __forceinline__ void phase_norm(const T* src, const float* w, bf16* XN, int gw, int NGW, int lane) {
    typedef typename RowBuf<T>::type RB;
    f32x4 wv[4]; load_w4(w, wv, lane);
    RB nx[4], ny[4]; row_load4(src + (size_t)gw * DM, nx, lane);
    if (gw + NGW < M) row_load4(src + (size_t)(gw + NGW) * DM, ny, lane);
    auto body = [&](int m, RB (&buf)[4]) { f32x4 v[4];
        row_get(buf, v);
        if (m + 2 * NGW < M) row_load4(src + (size_t)(m + 2 * NGW) * DM, buf, lane);
        rms_regs(wv, v); store_row_bf16(XN + (size_t)m * DM, v, lane); };
    for (int m = gw; m < M; m += 2 * NGW) { body(m, nx); if (m + NGW < M) body(m + NGW, ny); }
}
__device__ __forceinline__ void zero_region(unsigned char* p, size_t bytes, int gtid, int NGT) {
    GAS u32x4* q = (GAS u32x4*)p; const size_t n = bytes / 16;
    u32x4 z = (u32x4){0u, 0u, 0u, 0u}; asm volatile("" : "+v"(z));
    for (size_t i = gtid; i < n; i += NGT) q[i] = z;
}

__device__ __forceinline__ void phase_norm2_router(LAS unsigned char* lds, const bf16* h, const float* w2, const float* w_router, bf16* XN, float* aff, int gw, int NGW, int tid, int lane) {
    LAS float* wrT = (LAS float*)lds;
    for (int e = tid; e < 16 * 1024; e += 512) { const int k = e >> 4, x = e & 15; wrT[x * 1024 + k] = w_router[e]; }
    __syncthreads();
    f32x4 wv[4]; load_w4(w2, wv, lane);
    u32x2 nx[4], ny[4]; row_load4(h + (size_t)gw * DM, nx, lane);
    if (gw + NGW < M) row_load4(h + (size_t)(gw + NGW) * DM, ny, lane);
    auto body = [&](int m, u32x2 (&buf)[4]) {
        f32x4 v[4];
        row_get(buf, v);
        if (m + 2 * NGW < M) row_load4(h + (size_t)(m + 2 * NGW) * DM, buf, lane);
        rms_regs(wv, v); store_row_bf16(XN + (size_t)m * DM, v, lane);
        float mine = 0.f;
#pragma unroll 1
        for (int x = 0; x < 16; ++x) { float s = 0.f;
#pragma unroll
            for (int j = 0; j < 4; ++j) { const f32x4 wr = *(const LAS f32x4*)(wrT + x * 1024 + 4 * lane + 256 * j); s += (v[j].x * wr.x + v[j].y * wr.y) + (v[j].z * wr.z + v[j].w * wr.w); }
            s = wave_sum(s); mine = (lane == x) ? s : mine; }
        float mx = mine;
        mx = fmaxf(mx, __shfl_xor(mx, 1)); mx = fmaxf(mx, __shfl_xor(mx, 2)); mx = fmaxf(mx, __shfl_xor(mx, 4)); mx = fmaxf(mx, __shfl_xor(mx, 8));
        const float ex = expf(mine - mx); float den = ex;
        den += __shfl_xor(den, 1); den += __shfl_xor(den, 2); den += __shfl_xor(den, 4); den += __shfl_xor(den, 8);
        if (lane < 16) aff[(size_t)m * 16 + lane] = ex / den;
    };
    for (int m = gw; m < M; m += 2 * NGW) { body(m, nx); if (m + NGW < M) body(m + NGW, ny); }
}

__device__ __forceinline__ void phase_finish(const bf16* og, const bf16* ys, const bf16* yi, const bf16* gates, const float* gnw, const float* snw, bf16* mixed, int gw, int NGW, int lane) {
    float gw_[16], sw_[16];
#pragma unroll
    for (int c = 0; c < 16; ++c) { gw_[c] = gnw[(16 * lane + c) & 127]; sw_[c] = snw[16 * lane + c]; }
    bf16x8 nb[10], nc[10];
#define PF_LOAD(nb, m_) do { const size_t m1_ = (size_t)(m_); \
        nb[0] = *(const GAS bf16x8*)(og + m1_ * 1024 + 16 * lane); nb[1] = *(const GAS bf16x8*)(og + m1_ * 1024 + 16 * lane + 8); \
        nb[2] = *(const GAS bf16x8*)(ys + m1_ * 1024 + 16 * lane); nb[3] = *(const GAS bf16x8*)(ys + m1_ * 1024 + 16 * lane + 8); \
        nb[4] = *(const GAS bf16x8*)(yi + m1_ * 1024 + 16 * lane); nb[5] = *(const GAS bf16x8*)(yi + m1_ * 1024 + 16 * lane + 8); \
        nb[6] = *(const GAS bf16x8*)(gates + m1_ * 2048 + 16 * lane); nb[7] = *(const GAS bf16x8*)(gates + m1_ * 2048 + 16 * lane + 8); \
        nb[8] = *(const GAS bf16x8*)(gates + m1_ * 2048 + 1024 + 16 * lane); nb[9] = *(const GAS bf16x8*)(gates + m1_ * 2048 + 1024 + 16 * lane + 8); } while (0)
    PF_LOAD(nb, gw);
    if (gw + NGW < M) PF_LOAD(nc, gw + NGW);
    auto body = [&](int m, bf16x8 (&buf)[10]) {
        const bf16x8 o0 = buf[0], o1 = buf[1], y0 = buf[2], y1 = buf[3], i0 = buf[4], i1 = buf[5], g0 = buf[6], g1 = buf[7], z0 = buf[8], z1 = buf[9];
        if (m + 2 * NGW < M) PF_LOAD(buf, m + 2 * NGW);
        float o[16], t[16]; float so = 0.f, st = 0.f;
#pragma unroll
        for (int c = 0; c < 8; ++c) { o[c] = bf2f_s(o0[c]); o[8 + c] = bf2f_s(o1[c]); t[c] = (bf2f_s(y0[c]) + bf2f_s(i0[c])) * silu(bf2f_s(z0[c])); t[8 + c] = (bf2f_s(y1[c]) + bf2f_s(i1[c])) * silu(bf2f_s(z1[c])); }
#pragma unroll
        for (int c = 0; c < 16; ++c) { so += o[c] * o[c]; st += t[c] * t[c]; }
        so += __shfl_xor(so, 1); so += __shfl_xor(so, 2); so += __shfl_xor(so, 4);
        st += __shfl_xor(st, 1); st += __shfl_xor(st, 2); st += __shfl_xor(st, 4); st += __shfl_xor(st, 8); st += __shfl_xor(st, 16);
        const float ro = __builtin_amdgcn_rsqf(so * (1.0f / 128.f) + EPS), rt = __builtin_amdgcn_rsqf(st * (1.0f / 512.f) + EPS);
        float a[16], b2[16];
#pragma unroll
        for (int c = 0; c < 8; ++c) { a[c] = o[c] * ro * gw_[c] * silu(bf2f_s(g0[c])); a[8 + c] = o[8 + c] * ro * gw_[8 + c] * silu(bf2f_s(g1[c])); }
#pragma unroll
        for (int c = 0; c < 16; ++c) b2[c] = t[c] * rt * sw_[c];
        u32x4 w0, w1, w2, w3;
        w0.x = pkbf(a[0], a[1]); w0.y = pkbf(a[2], a[3]); w0.z = pkbf(a[4], a[5]); w0.w = pkbf(a[6], a[7]);
        w1.x = pkbf(a[8], a[9]); w1.y = pkbf(a[10], a[11]); w1.z = pkbf(a[12], a[13]); w1.w = pkbf(a[14], a[15]);
        w2.x = pkbf(b2[0], b2[1]); w2.y = pkbf(b2[2], b2[3]); w2.z = pkbf(b2[4], b2[5]); w2.w = pkbf(b2[6], b2[7]);
        w3.x = pkbf(b2[8], b2[9]); w3.y = pkbf(b2[10], b2[11]); w3.z = pkbf(b2[12], b2[13]); w3.w = pkbf(b2[14], b2[15]);
        GAS u32x4* mp = (GAS u32x4*)(mixed + (size_t)m * 2048 + 16 * lane);
        mp[0] = w0; mp[1] = w1; mp[128] = w2; mp[129] = w3;
    };
    for (int m = gw; m < M; m += 2 * NGW) { body(m, nb); if (m + NGW < M) body(m + NGW, nc); }
#undef PF_LOAD
}

__device__ __forceinline__ void phase_topk(LAS unsigned char* lds, const float* aff, int* idx, float* val, int* inv, int be, int tid, int wave, int lane) {
    LAS unsigned* hist = (LAS unsigned*)lds;
    LAS unsigned* ctl = hist + 256;
    LAS unsigned* wsum = hist + 320;
    const int b = be >> 4, e = be & 15;
    unsigned key[16];
#pragma unroll
    for (int i = 0; i < 16; ++i) key[i] = __float_as_uint(aff[((size_t)b * SEQ + tid * 16 + i) * 16 + e]);
    unsigned prefix = 0u, mask = 0u; unsigned krem = CAP;
    for (int pass = 0; pass < 4; ++pass) {
        const int shift = 24 - 8 * pass;
        if (tid < 256) hist[tid] = 0u;
        __syncthreads();
#pragma unroll
        for (int i = 0; i < 16; ++i) if ((key[i] & mask) == prefix) atomicAdd((unsigned*)&hist[(key[i] >> shift) & 255u], 1u);
        __syncthreads();
        if (wave == 0) {
            const u32x4 hb = *(const LAS u32x4*)(hist + 4 * lane); const unsigned sl = hb.x + hb.y + hb.z + hb.w;
            int Si = (int)sl; Si += dppi<0x101>(Si); Si += dppi<0x102>(Si); Si += dppi<0x104>(Si); Si += dppi<0x108>(Si);
            { const int t1 = __builtin_amdgcn_readlane(Si, 16), t2 = __builtin_amdgcn_readlane(Si, 32), t3 = __builtin_amdgcn_readlane(Si, 48); const int row = lane >> 4;
              Si += (row == 3 ? 0 : row == 2 ? t3 : row == 1 ? t3 + t2 : t3 + t2 + t1); }
            const unsigned S = (unsigned)Si;
            const unsigned above = S - sl;
            if (above < krem && krem <= above + sl) { unsigned cum = above; int d;
                if (cum + hb.w >= krem) d = 3; else { cum += hb.w; if (cum + hb.z >= krem) d = 2; else { cum += hb.z; if (cum + hb.y >= krem) d = 1; else { cum += hb.y; d = 0; } } }
                ctl[0] = prefix | ((unsigned)(4 * lane + d) << shift); ctl[1] = krem - cum; } }
        __syncthreads();
        prefix = ctl[0]; krem = ctl[1]; mask |= 255u << shift;
        __syncthreads();
    }
    const unsigned thr = prefix;
    int ngt = 0, neq = 0;
#pragma unroll
    for (int i = 0; i < 16; ++i) { ngt += key[i] > thr; neq += key[i] == thr; }
    const int sg = scan_fwd64_i(ngt, lane), sq = scan_fwd64_i(neq, lane);
    if (lane == 63) { wsum[wave] = (unsigned)sg; wsum[8 + wave] = (unsigned)sq; }
    __syncthreads();
    int bg = 0, bq = 0;
#pragma unroll
    for (int w = 0; w < 8; ++w) if (w < wave) { bg += (int)wsum[w]; bq += (int)wsum[8 + w]; }
    int pg = bg + sg - ngt, pq = bq + sq - neq;
#pragma unroll
    for (int i = 0; i < 16; ++i) {
        const int tok = tid * 16 + i; const bool gt = key[i] > thr, eq = key[i] == thr;
        const bool sel = gt || (eq && pq < (int)krem);
        const int slot = pg + (pq < (int)krem ? pq : (int)krem);
        if (sel) { idx[be * CAP + slot] = tok; val[be * CAP + slot] = __uint_as_float(key[i]); }
        inv[((size_t)b * SEQ + tok) * 16 + e] = sel ? slot : -1;
        pg += gt; pq += eq;
    }
    __syncthreads();
}

__device__ __forceinline__ void phase_gather(const bf16* XN, const int* idx, bf16* XG, int gw, int NGW, int lane) {
    for (int r = gw; r < MEXP; r += NGW) {
        const int b = r >> 14; const int tok = idx[r];
        const GAS u32x4* s = (const GAS u32x4*)(XN + ((size_t)b * SEQ + tok) * DM) + lane; GAS u32x4* d = (GAS u32x4*)(XG + (size_t)r * DM) + lane;
        const u32x4 a = s[0], c = s[64]; d[0] = a; d[64] = c;
    }
}

__device__ __forceinline__ void phase_combine(const bf16* hin, float* hout, const bf16* Y, const int* inv, const float* val, const float* wn, bf16* XN, bool final_, int gw, int NGW, int lane, float pscale = 1.0f) {
    f32x4 wv[4]; load_w4(wn, wv, lane);
    u32x2 nx[4], ny[4]; row_load4(hin + (size_t)gw * DM, nx, lane); int nslot = (lane < 16) ? inv[(size_t)gw * 16 + lane] : -1, nslot2 = -1;
    if (gw + NGW < M) { row_load4(hin + (size_t)(gw + NGW) * DM, ny, lane); nslot2 = (lane < 16) ? inv[(size_t)(gw + NGW) * 16 + lane] : -1; }
    auto body = [&](int m, u32x2 (&buf)[4], int& bslot) {
        const int b = m >> 13;
        f32x4 v[4];
        row_get(buf, v);
        const int myslot = bslot;
        if (m + 2 * NGW < M) { row_load4(hin + (size_t)(m + 2 * NGW) * DM, buf, lane); bslot = (lane < 16) ? inv[(size_t)(m + 2 * NGW) * 16 + lane] : -1; }
        unsigned mask = (unsigned)__builtin_amdgcn_ballot_w64(myslot >= 0) & 0xffffu;
        while (mask) {
            const int e0 = __builtin_ctz(mask); mask &= mask - 1u;
            const bool two = mask != 0u; const int e1 = two ? __builtin_ctz(mask) : e0; if (two) mask &= mask - 1u;
            const int s0 = __builtin_amdgcn_readlane(myslot, e0), s1 = __builtin_amdgcn_readlane(myslot, e1);
            const int r0 = (b * 16 + e0) * CAP + s0, r1 = (b * 16 + e1) * CAP + s1;
            const float a0 = val[r0]; const float a1 = two ? val[r1] : 0.f;
            const GAS u32x2* y0 = (const GAS u32x2*)(Y + (size_t)r0 * DM) + lane; const GAS u32x2* y1 = (const GAS u32x2*)(Y + (size_t)r1 * DM) + lane;
            u32x2 t0[4], t1[4];
#pragma unroll
            for (int j = 0; j < 4; ++j) { t0[j] = y0[64 * j]; t1[j] = y1[64 * j]; }
#pragma unroll
            for (int j = 0; j < 4; ++j) { const u32x2 t = t0[j];
                v[j].x += a0 * __uint_as_float(t.x << 16); v[j].y += a0 * __uint_as_float(t.x & 0xffff0000u); v[j].z += a0 * __uint_as_float(t.y << 16); v[j].w += a0 * __uint_as_float(t.y & 0xffff0000u); }
            if (two) {
#pragma unroll
                for (int j = 0; j < 4; ++j) { const u32x2 t = t1[j];
                    v[j].x += a1 * __uint_as_float(t.x << 16); v[j].y += a1 * __uint_as_float(t.x & 0xffff0000u); v[j].z += a1 * __uint_as_float(t.y << 16); v[j].w += a1 * __uint_as_float(t.y & 0xffff0000u); } }
        }
        float s2 = 0.f;
#pragma unroll
        for (int j = 0; j < 4; ++j) s2 += (v[j].x * v[j].x + v[j].y * v[j].y) + (v[j].z * v[j].z + v[j].w * v[j].w);
        const float rstd = __builtin_amdgcn_rsqf(wave_sum(s2) * (1.0f / DM) + EPS);
        if (final_) { GAS f32x4* ho = (GAS f32x4*)(hout + (size_t)m * DM) + lane;
#pragma unroll
            for (int j = 0; j < 4; ++j) ho[64 * j] = v[j] * (rstd * pscale) * wv[j];
        } else {
            store_row_bf16((bf16*)hout + (size_t)m * DM, v, lane);
            f32x4 nv[4];
#pragma unroll
            for (int j = 0; j < 4; ++j) nv[j] = v[j] * rstd * wv[j];
            store_row_bf16(XN + (size_t)m * DM, nv, lane);
        }
    };
    for (int m = gw; m < M; m += 2 * NGW) { body(m, nx, nslot); if (m + NGW < M) body(m + NGW, ny, nslot2); }
}
namespace gdn {
constexpr int CW = 0;
constexpr int SC = CW + 8 * 320 * 4;
constexpr int Q = SC + 1280;
constexpr int K = Q + 64 * 136 * 2;
constexpr int KDT = K + 64 * 136 * 2;
constexpr int VT = KDT + 128 * 72 * 2;
constexpr int T = VT + 64 * 72 * 2;
constexpr int QKD = T + 64 * 72 * 2;
constexpr int ST = QKD + 64 * 72 * 2;
constexpr int TMP = ST + 64 * 136 * 2;
constexpr int RQ = TMP, RK = RQ + 70 * 136 * 2, RV = RK + 70 * 136 * 2, RAW_END = RV + 70 * 72 * 2;
constexpr int AF = TMP, TF = AF + 64 * 68 * 4, XF = TF + 64 * 68 * 4, INV_END = XF + 3 * 16 * 17 * 4;
constexpr int RT = TMP, UT = RT + 64 * 72 * 2, OS = UT + 64 * 72 * 2, ST_END = OS + 64 * 65 * 4;
static_assert(RAW_END <= MISC_OFF && INV_END <= MISC_OFF && ST_END <= MISC_OFF, "gdn LDS map");
}
__device__ __forceinline__ void gdn_chain(LAS unsigned char* lds, int cid, const bf16* raw, const float* scal, const float* conv_w, const float* conv_b,
                                          const float* A_log, const float* dt_bias, bf16* og, int tid, int wave, int lane) {
    using namespace gdn;
    const int dvh = cid & 1, dir = (cid >> 1) & 1, h = (cid >> 2) & 7, b = cid >> 5;
    const int fr = lane & 15, fq = lane >> 4;
    LAS float* cw = (LAS float*)(lds + CW); LAS float* sc = (LAS float*)(lds + SC);
    LAS bf16* q_ = (LAS bf16*)(lds + Q); LAS bf16* k_ = (LAS bf16*)(lds + K); LAS bf16* kdT = (LAS bf16*)(lds + KDT); LAS bf16* vT = (LAS bf16*)(lds + VT);
    LAS bf16* T_ = (LAS bf16*)(lds + T); LAS bf16* QKd = (LAS bf16*)(lds + QKD); LAS bf16* ST_ = (LAS bf16*)(lds + ST);
    LAS bf16* rq = (LAS bf16*)(lds + RQ); LAS bf16* rk = (LAS bf16*)(lds + RK); LAS bf16* rv = (LAS bf16*)(lds + RV);
    LAS float* Af = (LAS float*)(lds + AF); LAS float* Tf = (LAS float*)(lds + TF); LAS float* Xf = (LAS float*)(lds + XF);
    LAS bf16* rT = (LAS bf16*)(lds + RT); LAS bf16* uT = (LAS bf16*)(lds + UT); LAS float* os = (LAS float*)(lds + OS);
    for (int e = tid; e < 8 * 320; e += 512) { const int r = e / 320, c = e % 320;
        const int gch = c < 128 ? h * 128 + c : (c < 256 ? 1024 + h * 128 + (c - 128) : 2048 + h * 128 + dvh * 64 + (c - 256));
        cw[e] = r < 7 ? conv_w[r * CONV_CH + gch] : conv_b[gch]; }
    for (int e = tid; e < 64 * 136 / 2; e += 512) ((LAS unsigned*)ST_)[e] = 0u;
    const float expA = expf(A_log[dir * 8 + h]), dtb = dt_bias[dir * 8 + h];
    f32x4 sacc[4];
#pragma unroll
    for (int nt = 0; nt < 4; ++nt) sacc[nt] = (f32x4){0.f, 0.f, 0.f, 0.f};
    const size_t rowb = (size_t)b * SEQ;
    __syncthreads();
    for (int n = 0; n < NCHUNK; ++n) {
        const int t0 = (dir ? NCHUNK - 1 - n : n) * 64;
        for (int e = tid; e < 70 * 40; e += 512) { const int r = e / 40, p = e % 40; const int t = t0 - 3 + r;
            u32x4 v = (u32x4){0u, 0u, 0u, 0u};
            const int col = p < 16 ? h * 128 + p * 8 : (p < 32 ? 1024 + h * 128 + (p - 16) * 8 : 2048 + h * 128 + dvh * 64 + (p - 32) * 8);
            if (t >= 0 && t < SEQ) v = *(const GAS u32x4*)(raw + (rowb + t) * CONV_CH + col);
            LAS bf16* d = p < 16 ? rq + r * 136 + p * 8 : (p < 32 ? rk + r * 136 + (p - 16) * 8 : rv + r * 72 + (p - 32) * 8);
            *(LAS u32x4*)d = v; }
        if (wave == 0) { const int i = lane; const int t = t0 + (dir ? 63 - i : i);
            const float braw = scal[(rowb + t) * 64 + dir * 8 + h], araw = scal[(rowb + t) * 64 + 16 + dir * 8 + h];
            const float g = -expA * softplus_f(araw + dtb);
            float gc = g;
#pragma unroll
            for (int o = 1; o < 64; o <<= 1) { const float y = __shfl_up(gc, o); if (i >= o) gc += y; }
            const float gl = __shfl(gc, 63);
            sc[i] = sigmoid_f(braw); sc[64 + i] = gc; sc[128 + i] = expf(gc); sc[192 + i] = expf(gl - gc); if (i == 0) sc[256] = expf(gl); }
        __syncthreads();
        { const int i = tid >> 3, cg = tid & 7; const int o = dir ? 63 - i : i;
          float a[16];
          conv16(a, rq + o * 136 + cg * 16, 136, cw + cg * 16, 320);
          float ss = 0.f;
#pragma unroll
          for (int c = 0; c < 16; ++c) { a[c] = silu(a[c]); ss += a[c] * a[c]; }
          ss += __shfl_xor(ss, 1); ss += __shfl_xor(ss, 2); ss += __shfl_xor(ss, 4);
          float rs = (1.0f / sqrtf(ss + EPS)) * 0.08838834764831845f;
          { u32x4 w0, w1; w0.x = pkbf(a[0] * rs, a[1] * rs); w0.y = pkbf(a[2] * rs, a[3] * rs); w0.z = pkbf(a[4] * rs, a[5] * rs); w0.w = pkbf(a[6] * rs, a[7] * rs);
            w1.x = pkbf(a[8] * rs, a[9] * rs); w1.y = pkbf(a[10] * rs, a[11] * rs); w1.z = pkbf(a[12] * rs, a[13] * rs); w1.w = pkbf(a[14] * rs, a[15] * rs);
            *(LAS u32x4*)(q_ + i * 136 + cg * 16) = w0; *(LAS u32x4*)(q_ + i * 136 + cg * 16 + 8) = w1; }
          conv16(a, rk + o * 136 + cg * 16, 136, cw + 128 + cg * 16, 320);
          ss = 0.f;
#pragma unroll
          for (int c = 0; c < 16; ++c) { a[c] = silu(a[c]); ss += a[c] * a[c]; }
          ss += __shfl_xor(ss, 1); ss += __shfl_xor(ss, 2); ss += __shfl_xor(ss, 4);
          rs = 1.0f / sqrtf(ss + EPS);
          { u32x4 w0, w1; w0.x = pkbf(a[0] * rs, a[1] * rs); w0.y = pkbf(a[2] * rs, a[3] * rs); w0.z = pkbf(a[4] * rs, a[5] * rs); w0.w = pkbf(a[6] * rs, a[7] * rs);
            w1.x = pkbf(a[8] * rs, a[9] * rs); w1.y = pkbf(a[10] * rs, a[11] * rs); w1.z = pkbf(a[12] * rs, a[13] * rs); w1.w = pkbf(a[14] * rs, a[15] * rs);
            *(LAS u32x4*)(k_ + i * 136 + cg * 16) = w0; *(LAS u32x4*)(k_ + i * 136 + cg * 16 + 8) = w1; }
          const float ek = sc[192 + i] * rs;
#pragma unroll
          for (int c = 0; c < 16; ++c) kdT[(cg * 16 + c) * 72 + i] = f2bf1(a[c] * ek);
          float v8[8];
          conv8(v8, rv + o * 72 + cg * 8, 72, cw + 256 + cg * 8, 320);
#pragma unroll
          for (int c = 0; c < 8; ++c) vT[(cg * 8 + c) * 72 + i] = f2bf1(silu(v8[c]));
        }
        __syncthreads();
        { const int which = wave >> 2, mt = wave & 3;
          f32x4 acc[1][4];
#pragma unroll
          for (int nt = 0; nt < 4; ++nt) acc[0][nt] = (f32x4){0.f, 0.f, 0.f, 0.f};
          mma_lds<1, 4>(acc, which ? q_ : k_, 136, mt * 16, k_, 136, 0, 128, fr, fq);
#pragma unroll
          for (int nt = 0; nt < 4; ++nt)
#pragma unroll
              for (int r = 0; r < 4; ++r) { const int i = mt * 16 + 4 * fq + r, j = nt * 16 + fr;
                  const float d = expf(fminf(sc[64 + i] - sc[64 + j], 0.f)); const float x = acc[0][nt][r] * d;
                  if (which == 0) Af[i * 68 + j] = (i > j) ? sc[i] * x : 0.f;
                  else QKd[i * 72 + j] = f2bf1((i >= j) ? x : 0.f); }
        }
        __syncthreads();
        if (wave == 0) { const int blk = lane >> 4, c = lane & 15; float t[16];
#pragma unroll
            for (int i = 0; i < 16; ++i) t[i] = (i == c) ? 1.f : 0.f;
#pragma unroll
            for (int i = 1; i < 16; ++i) { float s = 0.f; const LAS float* ar = Af + (blk * 16 + i) * 68 + blk * 16;
#pragma unroll
                for (int j = 0; j < i; ++j) s += ar[j] * t[j];
                t[i] = (i > c) ? -s : t[i];
                if ((i & 3) == 3) asm volatile("" ::: "memory"); }
#pragma unroll
            for (int i = 0; i < 16; ++i) Tf[(blk * 16 + i) * 68 + blk * 16 + c] = t[i]; }
        for (int d = 1; d <= 3; ++d) { const int nbk = 4 - d;
            __syncthreads();
            for (int e = tid; e < nbk * 256; e += 512) { const int J = e >> 8, r = (e >> 4) & 15, c = e & 15, I = J + d; float s = 0.f;
                for (int kk = J * 16; kk < I * 16; ++kk) s += Af[(I * 16 + r) * 68 + kk] * Tf[kk * 68 + J * 16 + c];
                Xf[(J * 16 + r) * 17 + c] = s; }
            __syncthreads();
            for (int e = tid; e < nbk * 256; e += 512) { const int J = e >> 8, r = (e >> 4) & 15, c = e & 15, I = J + d; float s = 0.f;
#pragma unroll
                for (int m2 = 0; m2 < 16; ++m2) s += Tf[(I * 16 + r) * 68 + I * 16 + m2] * Xf[(J * 16 + m2) * 17 + c];
                Tf[(I * 16 + r) * 68 + J * 16 + c] = -s; }
        }
        __syncthreads();
        for (int e = tid; e < 4096; e += 512) { const int i = e >> 6, j = e & 63; T_[i * 72 + j] = f2bf1(((i >> 4) >= (j >> 4)) ? Tf[i * 68 + j] : 0.f); }
        __syncthreads();
        const int mt = wave & 3, nh = wave >> 2;
        f32x4 aq[2];
        { f32x4 ak[2]; ak[0] = ak[1] = aq[0] = aq[1] = (f32x4){0.f, 0.f, 0.f, 0.f};
          for (int k0 = 0; k0 < 128; k0 += 32) {
              const bf16x8 fk = *(const LAS bf16x8*)(k_ + (mt * 16 + fr) * 136 + k0 + fq * 8), fqv = *(const LAS bf16x8*)(q_ + (mt * 16 + fr) * 136 + k0 + fq * 8);
#pragma unroll
              for (int nl = 0; nl < 2; ++nl) { const bf16x8 fb = *(const LAS bf16x8*)(ST_ + (nh * 32 + nl * 16 + fr) * 136 + k0 + fq * 8);
                  ak[nl] = __builtin_amdgcn_mfma_f32_16x16x32_bf16(fk, fb, ak[nl], 0, 0, 0); aq[nl] = __builtin_amdgcn_mfma_f32_16x16x32_bf16(fqv, fb, aq[nl], 0, 0, 0); } }
          const int i0 = mt * 16 + 4 * fq;
          const f32x4 be4 = *(const LAS f32x4*)(sc + i0), eg4 = *(const LAS f32x4*)(sc + 128 + i0);
#pragma unroll
          for (int nl = 0; nl < 2; ++nl) { const int dv = nh * 32 + nl * 16 + fr;
              const bf16x4 vv = *(const LAS bf16x4*)(vT + dv * 72 + i0);
              float r0 = be4[0] * (bf2f_s(vv[0]) - eg4[0] * ak[nl][0]), r1 = be4[1] * (bf2f_s(vv[1]) - eg4[1] * ak[nl][1]);
              float r2 = be4[2] * (bf2f_s(vv[2]) - eg4[2] * ak[nl][2]), r3 = be4[3] * (bf2f_s(vv[3]) - eg4[3] * ak[nl][3]);
              u32x2 w; w.x = pkbf(r0, r1); w.y = pkbf(r2, r3); *(LAS u32x2*)(rT + dv * 72 + i0) = w;
              aq[nl][0] *= eg4[0]; aq[nl][1] *= eg4[1]; aq[nl][2] *= eg4[2]; aq[nl][3] *= eg4[3]; }
        }
        __syncthreads();
        { f32x4 au[1][2]; au[0][0] = au[0][1] = (f32x4){0.f, 0.f, 0.f, 0.f};
          mma_lds<1, 2>(au, T_, 72, mt * 16, rT, 72, nh * 32, 64, fr, fq);
          const int i0 = mt * 16 + 4 * fq;
#pragma unroll
          for (int nl = 0; nl < 2; ++nl) { const int dv = nh * 32 + nl * 16 + fr; u32x2 w; w.x = pkbf(au[0][nl][0], au[0][nl][1]); w.y = pkbf(au[0][nl][2], au[0][nl][3]); *(LAS u32x2*)(uT + dv * 72 + i0) = w; }
        }
        __syncthreads();
        { f32x4 ao[1][2]; ao[0][0] = aq[0]; ao[0][1] = aq[1];
          mma_lds<1, 2>(ao, QKd, 72, mt * 16, uT, 72, nh * 32, 64, fr, fq);
          const int i0 = mt * 16 + 4 * fq;
#pragma unroll
          for (int nl = 0; nl < 2; ++nl)
#pragma unroll
              for (int r = 0; r < 4; ++r) os[(i0 + r) * 65 + nh * 32 + nl * 16 + fr] = ao[0][nl][r];
          const float egl = sc[256];
          f32x4 as_[1][4];
#pragma unroll
          for (int nt = 0; nt < 4; ++nt) as_[0][nt] = sacc[nt] * egl;
          mma_lds<1, 4>(as_, kdT, 72, wave * 16, uT, 72, 0, 64, fr, fq);
#pragma unroll
          for (int nt = 0; nt < 4; ++nt) { sacc[nt] = as_[0][nt];
              u32x2 w; w.x = pkbf(sacc[nt][0], sacc[nt][1]); w.y = pkbf(sacc[nt][2], sacc[nt][3]); *(LAS u32x2*)(ST_ + (nt * 16 + fr) * 136 + wave * 16 + 4 * fq) = w; }
        }
        __syncthreads();
#pragma unroll
        for (int ii = 0; ii < 4; ++ii) { const int i = wave * 8 + 2 * ii + (lane >> 5), cp = lane & 31; const int t = t0 + (dir ? 63 - i : i);
            atomic_add_bf16x2(og + (rowb + t) * 1024 + h * 128 + dvh * 64 + 2 * cp, os[i * 65 + 2 * cp], os[i * 65 + 2 * cp + 1]); }
        __syncthreads();
    }
}

namespace ssd {
constexpr int CW = 0;
constexpr int SC = CW + 8 * 320 * 4;
constexpr int BM_ = SC + 1280;
constexpr int CM_ = BM_ + 64 * 136 * 2;
constexpr int BT = CM_ + 64 * 136 * 2;
constexpr int XDT = BT + 128 * 72 * 2;
constexpr int XDW = XDT + 64 * 72 * 2;
constexpr int MM = XDW + 64 * 72 * 2;
constexpr int HT = MM + 64 * 72 * 2;
constexpr int TMP = HT + 64 * 136 * 2;
constexpr int RX = TMP, RB = RX + 70 * 72 * 2, RC = RB + 70 * 136 * 2, RAW_END = RC + 70 * 136 * 2;
constexpr int OS = TMP, OS_END = OS + 64 * 65 * 4;
static_assert(RAW_END <= MISC_OFF && OS_END <= MISC_OFF, "ssd LDS map");
}
__device__ __forceinline__ void ssd_chain(LAS unsigned char* lds, int cid, const bf16* raw, const float* scal, const float* conv_w, const float* conv_b,
                                          const float* A_log, const float* dt_bias, const float* Dp, bf16* ys, int tid, int wave, int lane) {
    using namespace ssd;
    const int dir = cid & 1, head = (cid >> 1) & 15, b = cid >> 5; const int g = head >> 3;
    const int fr = lane & 15, fq = lane >> 4;
    LAS float* cw = (LAS float*)(lds + CW); LAS float* sc = (LAS float*)(lds + SC);
    LAS bf16* Bm = (LAS bf16*)(lds + BM_); LAS bf16* Cm = (LAS bf16*)(lds + CM_); LAS bf16* BT_ = (LAS bf16*)(lds + BT);
    LAS bf16* xdt = (LAS bf16*)(lds + XDT); LAS bf16* xdw = (LAS bf16*)(lds + XDW); LAS bf16* Mm = (LAS bf16*)(lds + MM); LAS bf16* hT = (LAS bf16*)(lds + HT);
    LAS bf16* rx = (LAS bf16*)(lds + RX); LAS bf16* rb = (LAS bf16*)(lds + RB); LAS bf16* rc = (LAS bf16*)(lds + RC); LAS float* os = (LAS float*)(lds + OS);
    const int chx = 3072 + head * 64, chb = 4096 + g * 128, chc = 4352 + g * 128;
    for (int e = tid; e < 8 * 320; e += 512) { const int r = e / 320, c = e % 320;
        const int gch = c < 64 ? chx + c : (c < 192 ? chb + (c - 64) : chc + (c - 192));
        cw[e] = r < 7 ? conv_w[r * CONV_CH + gch] : conv_b[gch]; }
    for (int e = tid; e < 64 * 136 / 2; e += 512) ((LAS unsigned*)hT)[e] = 0u;
    const float Ah = -expf(A_log[dir * 16 + head]), dtb = dt_bias[dir * 16 + head], Dh = (dir == 0) ? Dp[head] : 0.f;
    f32x4 hacc[4];
#pragma unroll
    for (int nt = 0; nt < 4; ++nt) hacc[nt] = (f32x4){0.f, 0.f, 0.f, 0.f};
    const size_t rowb = (size_t)b * SEQ;
    __syncthreads();
    for (int n = 0; n < NCHUNK; ++n) {
        const int t0 = (dir ? NCHUNK - 1 - n : n) * 64;
        for (int e = tid; e < 70 * 40; e += 512) { const int r = e / 40, p = e % 40; const int t = t0 - 3 + r;
            u32x4 v = (u32x4){0u, 0u, 0u, 0u};
            const int col = p < 8 ? chx + p * 8 : (p < 24 ? chb + (p - 8) * 8 : chc + (p - 24) * 8);
            if (t >= 0 && t < SEQ) v = *(const GAS u32x4*)(raw + (rowb + t) * CONV_CH + col);
            LAS bf16* d = p < 8 ? rx + r * 72 + p * 8 : (p < 24 ? rb + r * 136 + (p - 8) * 8 : rc + r * 136 + (p - 24) * 8);
            *(LAS u32x4*)d = v; }
        if (wave == 0) { const int i = lane; const int t = t0 + (dir ? 63 - i : i);
            const float dt = softplus_f(scal[(rowb + t) * 64 + 32 + dir * 16 + head] + dtb);
            float cs = dt * Ah;
#pragma unroll
            for (int o = 1; o < 64; o <<= 1) { const float y = __shfl_up(cs, o); if (i >= o) cs += y; }
            const float cl = __shfl(cs, 63);
            sc[i] = dt; sc[64 + i] = cs; sc[128 + i] = expf(cs); sc[192 + i] = expf(cl - cs); if (i == 0) sc[256] = expf(cl); }
        __syncthreads();
        { const int i = tid >> 3, cg = tid & 7; const int o = dir ? 63 - i : i;
          float a[16];
          conv16(a, rb + o * 136 + cg * 16, 136, cw + 64 + cg * 16, 320);
#pragma unroll
          for (int c = 0; c < 16; ++c) a[c] = silu(a[c]);
          { u32x4 w0, w1; w0.x = pkbf(a[0], a[1]); w0.y = pkbf(a[2], a[3]); w0.z = pkbf(a[4], a[5]); w0.w = pkbf(a[6], a[7]);
            w1.x = pkbf(a[8], a[9]); w1.y = pkbf(a[10], a[11]); w1.z = pkbf(a[12], a[13]); w1.w = pkbf(a[14], a[15]);
            *(LAS u32x4*)(Bm + i * 136 + cg * 16) = w0; *(LAS u32x4*)(Bm + i * 136 + cg * 16 + 8) = w1; }
#pragma unroll
          for (int c = 0; c < 16; ++c) BT_[(cg * 16 + c) * 72 + i] = f2bf1(a[c]);
          conv16(a, rc + o * 136 + cg * 16, 136, cw + 192 + cg * 16, 320);
#pragma unroll
          for (int c = 0; c < 16; ++c) a[c] = silu(a[c]);
          { u32x4 w0, w1; w0.x = pkbf(a[0], a[1]); w0.y = pkbf(a[2], a[3]); w0.z = pkbf(a[4], a[5]); w0.w = pkbf(a[6], a[7]);
            w1.x = pkbf(a[8], a[9]); w1.y = pkbf(a[10], a[11]); w1.z = pkbf(a[12], a[13]); w1.w = pkbf(a[14], a[15]);
            *(LAS u32x4*)(Cm + i * 136 + cg * 16) = w0; *(LAS u32x4*)(Cm + i * 136 + cg * 16 + 8) = w1; }
          float x8[8];
          conv8(x8, rx + o * 72 + cg * 8, 72, cw + cg * 8, 320);
          const float dt = sc[i], wst = sc[192 + i];
#pragma unroll
          for (int c = 0; c < 8; ++c) { const float xv = silu(x8[c]) * dt; xdt[(cg * 8 + c) * 72 + i] = f2bf1(xv); xdw[(cg * 8 + c) * 72 + i] = f2bf1(xv * wst); }
        }
        __syncthreads();
        const int mt = wave & 3, nh = wave >> 2;
        { f32x4 acc[1][2]; acc[0][0] = acc[0][1] = (f32x4){0.f, 0.f, 0.f, 0.f};
          mma_lds<1, 2>(acc, Cm, 136, mt * 16, Bm, 136, nh * 32, 128, fr, fq);
#pragma unroll
          for (int nl = 0; nl < 2; ++nl)
#pragma unroll
              for (int r = 0; r < 4; ++r) { const int i = mt * 16 + 4 * fq + r, j = nh * 32 + nl * 16 + fr;
                  const float d = expf(fminf(sc[64 + i] - sc[64 + j], 0.f));
                  Mm[i * 72 + j] = f2bf1((i >= j) ? acc[0][nl][r] * d : 0.f); }
        }
        __syncthreads();
        { f32x4 a1[1][2], a2[1][2]; a1[0][0] = a1[0][1] = a2[0][0] = a2[0][1] = (f32x4){0.f, 0.f, 0.f, 0.f};
          mma_lds<1, 2>(a1, Mm, 72, mt * 16, xdt, 72, nh * 32, 64, fr, fq);
          mma_lds<1, 2>(a2, Cm, 136, mt * 16, hT, 136, nh * 32, 128, fr, fq);
          const int i0 = mt * 16 + 4 * fq;
          const f32x4 ec4 = *(const LAS f32x4*)(sc + 128 + i0), dt4 = *(const LAS f32x4*)(sc + i0);
#pragma unroll
          for (int nl = 0; nl < 2; ++nl) { const int p = nh * 32 + nl * 16 + fr; const bf16x4 xv = *(const LAS bf16x4*)(xdt + p * 72 + i0);
#pragma unroll
              for (int r = 0; r < 4; ++r) os[(i0 + r) * 65 + p] = a1[0][nl][r] + ec4[r] * a2[0][nl][r] + Dh * bf2f_s(xv[r]) / dt4[r]; }
        }
        __syncthreads();
        { const float ecl = sc[256];
          f32x4 ah[1][4];
#pragma unroll
          for (int nt = 0; nt < 4; ++nt) ah[0][nt] = hacc[nt] * ecl;
          mma_lds<1, 4>(ah, BT_, 72, wave * 16, xdw, 72, 0, 64, fr, fq);
#pragma unroll
          for (int nt = 0; nt < 4; ++nt) { hacc[nt] = ah[0][nt];
              u32x2 w; w.x = pkbf(hacc[nt][0], hacc[nt][1]); w.y = pkbf(hacc[nt][2], hacc[nt][3]); *(LAS u32x2*)(hT + (nt * 16 + fr) * 136 + wave * 16 + 4 * fq) = w; }
        }
#pragma unroll
        for (int ii = 0; ii < 4; ++ii) { const int i = wave * 8 + 2 * ii + (lane >> 5), cp = lane & 31; const int t = t0 + (dir ? 63 - i : i);
            atomic_add_bf16x2(ys + (rowb + t) * 1024 + head * 64 + 2 * cp, os[i * 65 + 2 * cp], os[i * 65 + 2 * cp + 1]); }
        __syncthreads();
    }
}
namespace pgd {
constexpr int CW = 0;
constexpr int SC = CW + 8 * 384 * 4;
constexpr int Q = SC + 1280;
constexpr int K = Q + 64 * 136 * 2;
constexpr int VT = K + 64 * 136 * 2;
constexpr int TMP = VT + 128 * 72 * 2;
constexpr int RQ = TMP, RK = RQ + 70 * 136 * 2, RV = RK + 70 * 136 * 2, RAW_END = RV + 70 * 136 * 2;
constexpr int AF = TMP, A2F = AF + 64 * 68 * 4, TF = A2F + 64 * 68 * 4, T2F = TF + 64 * 68 * 4, QKP = T2F + 64 * 68 * 4, INV_END = QKP + 64 * 72 * 2;
constexpr int XF = VT;
constexpr int TP = AF;
constexpr int STASH = MISC_OFF - 16384;
static_assert(RAW_END <= STASH && INV_END <= STASH, "prep gdn LDS map");
}
constexpr size_t WS_TQ = 379 * MiB;

__device__ __forceinline__ void prep_gdn_stash(LAS unsigned char* lds, int bid, const bf16* raw, int tid) {
    const int bh = bid >> 3, b = bh >> 3, h = bh & 7, r8 = bid & 7;
    LAS bf16* st = (LAS bf16*)(lds + pgd::STASH);
    for (int e = tid; e < 2 * 3 * 48; e += 512) { const int which = e / 144, r = (e % 144) / 48, p = e % 48;
        const int t = which ? (r8 * 16 + 16) * 64 + r : r8 * 16 * 64 - 3 + r;
        const int col = p < 16 ? h * 128 + p * 8 : (p < 32 ? 1024 + h * 128 + (p - 16) * 8 : 2048 + h * 128 + (p - 32) * 8);
        u32x4 v = (u32x4){0u, 0u, 0u, 0u};
        if (t >= 0 && t < SEQ) v = *(const GAS u32x4*)(raw + ((size_t)b * SEQ + t) * CONV_CH + col);
        *(LAS u32x4*)(st + which * 1152 + r * 384 + p * 8) = v; }
}
__device__ __forceinline__ void inv_diag_blocks(const LAS float* Af, LAS float* Tf, int lane) {
    const int blk = lane >> 4, c = lane & 15; float t[16];
#pragma unroll
    for (int i = 0; i < 16; ++i) t[i] = (i == c) ? 1.f : 0.f;
#pragma unroll
    for (int i = 1; i < 16; ++i) { float s = 0.f; const LAS float* ar = Af + (blk * 16 + i) * 68 + blk * 16;
#pragma unroll
        for (int j = 0; j < i; ++j) s += ar[j] * t[j];
        t[i] = (i > c) ? -s : t[i];
        if ((i & 3) == 3) asm volatile("" ::: "memory"); }
#pragma unroll
    for (int i = 0; i < 16; ++i) Tf[(blk * 16 + i) * 68 + blk * 16 + c] = t[i];
}
__device__ __forceinline__ void inv_offdiag_x(const LAS float* Af, const LAS float* Tf, LAS float* Xf, int d, int ht) {
    const int nbk = 4 - d;
    for (int e = ht; e < nbk * 256; e += 256) { const int J = e >> 8, r = (e >> 4) & 15, c = e & 15, I = J + d; float s = 0.f;
        for (int kk = J * 16; kk < I * 16; ++kk) s += Af[(I * 16 + r) * 68 + kk] * Tf[kk * 68 + J * 16 + c];
        Xf[(J * 16 + r) * 17 + c] = s; }
}
__device__ __forceinline__ void inv_offdiag_t(LAS float* Tf, const LAS float* Xf, int d, int ht) {
    const int nbk = 4 - d;
    for (int e = ht; e < nbk * 256; e += 256) { const int J = e >> 8, r = (e >> 4) & 15, c = e & 15, I = J + d; float s = 0.f;
#pragma unroll
        for (int m2 = 0; m2 < 16; ++m2) s += Tf[(I * 16 + r) * 68 + I * 16 + m2] * Xf[(J * 16 + m2) * 17 + c];
        Tf[(I * 16 + r) * 68 + J * 16 + c] = -s; }
}

__device__ __forceinline__ void conv_pair8(float (&o)[16], const LAS bf16* src  , int ld, const float (&w)[16]) {
#pragma unroll
    for (int t = 0; t < 8; ++t) { o[2 * t] = w[14]; o[2 * t + 1] = w[15]; }
#pragma unroll
    for (int r = 0; r < 14; ++r) { const unsigned xv = *(const LAS unsigned*)(src + r * ld); const float x0 = __uint_as_float(xv << 16), x1 = __uint_as_float(xv & 0xffff0000u);
#pragma unroll
        for (int t = 0; t < 8; ++t) { const int tap = r - t; if (tap >= 0 && tap < 7) { o[2 * t] += x0 * w[2 * tap]; o[2 * t + 1] += x1 * w[2 * tap + 1]; } } }
}
namespace pg2 {
constexpr int CW = 0;
constexpr int SC = CW + 8 * 384 * 4;
constexpr int Q = SC + 1280;
constexpr int K = Q + 64 * 136 * 2;
constexpr int VT = K + 64 * 136 * 2;
constexpr int RAWT = VT + 128 * 72 * 2;
constexpr int RAW_END = RAWT + 3 * 70 * 136 * 2;
constexpr int ABF = RAWT, TRM = ABF + 2 * 64 * 72 * 2, TTR = TRM + 2 * 64 * 72 * 2, AD = TTR + 2 * 64 * 72 * 2, XS = AD + 2 * 4 * 256 * 4, QKP = XS + 2 * 32 * 40 * 2, INV_END = QKP + 64 * 72 * 2;
static_assert(RAW_END <= pgd::STASH && INV_END <= pgd::STASH, "prep gdn v2 LDS map");
}
template <int XP = 0>
__device__ __forceinline__ void prep_gdn_range(LAS unsigned char* lds, int bid, bf16* raw, const float* scal, const float* conv_w, const float* conv_b,
                                               const float* A_log, const float* dt_bias, bf16* TQ, int tid_p, int wave_p, int lane_p, float* scal_w, bf16* rwb = nullptr) {
    using namespace pg2;
    int tid = tid_p, wave = wave_p, lane = lane_p;
    const int bh = bid >> 3, b = bh >> 3, h = bh & 7, r8 = bid & 7;
    LAS float* cw = (LAS float*)(lds + CW); LAS float* sc = (LAS float*)(lds + SC);
    LAS bf16* q_ = (LAS bf16*)(lds + Q); LAS bf16* k_ = (LAS bf16*)(lds + K); LAS bf16* vT = (LAS bf16*)(lds + VT);
    LAS bf16* rq = (LAS bf16*)(lds + RAWT); LAS bf16* rk = rq + 70 * 136; LAS bf16* rv = rk + 70 * 136;
    LAS bf16* Abf = (LAS bf16*)(lds + ABF); LAS bf16* Trm = (LAS bf16*)(lds + TRM); LAS bf16* Ttr = (LAS bf16*)(lds + TTR);
    LAS float* ADf = (LAS float*)(lds + AD); LAS bf16* Xs = (LAS bf16*)(lds + XS); LAS bf16* QKp = (LAS bf16*)(lds + QKP);
    LAS bf16* st = (LAS bf16*)(lds + pgd::STASH);
    for (int e = tid; e < 8 * 384; e += 512) { const int r = e / 384, c = e % 384;
        const int gch = (c >> 7) * 1024 + h * 128 + (c & 127);
        cw[e] = r < 7 ? conv_w[r * CONV_CH + gch] : conv_b[gch]; }
    const float LOG2E = 1.4426950408889634f;
    const float expAf = expf(A_log[h]), dtbf = dt_bias[h], expAb = expf(A_log[8 + h]), dtbb = dt_bias[8 + h];
    const size_t rowb = (size_t)b * SEQ;
    bf16* const raww = XP ? rwb : raw; const size_t rowbw = XP ? (size_t)0 : rowb; const int bhw = XP ? (bh & 15) : bh;
    u32x4 pre[7];
#define PG2_LOAD(u_) do { const int t0_ = (r8 * 16 + (u_)) * 64; \
        _Pragma("unroll") for (int x = 0; x < 7; ++x) { const int e = tid + 512 * x; const int r = e / 48, p = e % 48; \
            pre[x] = (u32x4){0u, 0u, 0u, 0u}; \
            if (e < 70 * 48 && r >= 3 && !(r >= 67 && (u_) == 15)) { const int col = p < 16 ? h * 128 + p * 8 : (p < 32 ? 1024 + h * 128 + (p - 16) * 8 : 2048 + h * 128 + (p - 32) * 8); \
                pre[x] = *(const GAS u32x4*)(raw + (rowb + t0_ - 3 + r) * CONV_CH + col); } } } while (0)
    PG2_LOAD(0);
    float psa = 0.f, psb = 0.f;
#define PG2_LOADS(u_) do { if (wave < 2) { const size_t so_ = (rowb + (size_t)(r8 * 16 + (u_)) * 64 + lane) * 64; psa = scal[so_ + 16 + 8 * wave + h]; psb = scal[so_ + 8 * wave + h]; } } while (0)
    PG2_LOADS(0);
    __syncthreads();
#define PG2_STAGEA(u_) do { const int t0_ = (r8 * 16 + (u_)) * 64; \
        _Pragma("unroll") for (int x = 0; x < 7; ++x) { const int e = tid + 512 * x; const int r = e / 48, p = e % 48; \
            if (e < 70 * 48) { u32x4 v = pre[x]; \
                if (r < 3) v = *(const LAS u32x4*)(st + r * 384 + p * 8); \
                else if (r >= 67 && (u_) == 15) v = *(const LAS u32x4*)(st + 1152 + (r - 67) * 384 + p * 8); \
                *(LAS u32x4*)((p < 16 ? rq + r * 136 + p * 8 : (p < 32 ? rk + r * 136 + (p - 16) * 8 : rv + r * 136 + (p - 32) * 8))) = v; } } \
        if (wave == 0) { const int i = lane; const size_t so = (rowbw + t0_ + i) * 64; \
            const float gc = scan_fwd64(-expAf * softplus_fast(psa + dtbf), i); \
            const float be_ = sigmoid_fast(psb); sc[i] = be_; sc[64 + i] = gc * LOG2E; scal_w[so + h] = be_; scal_w[so + 16 + h] = gc; } \
        if (wave == 1) { const int i = lane; const size_t so = (rowbw + t0_ + i) * 64; \
            const float gc = scan_bwd64(-expAb * softplus_fast(psa + dtbb), i); \
            const float be_ = sigmoid_fast(psb); sc[128 + i] = be_; sc[192 + i] = gc * LOG2E; scal_w[so + 8 + h] = be_; scal_w[so + 24 + h] = gc; } } while (0)
    PG2_STAGEA(0);
    PG2_LOAD(1); PG2_LOADS(1);
    __syncthreads();
    for (int u = 0; u < 16; ++u) {
        tid = tid_p; asm volatile("" : "+v"(tid));
        lane = tid & 63; wave = __builtin_amdgcn_readfirstlane(tid >> 6);
        const int fr = lane & 15, fq = lane >> 4, half = wave >> 2, w4 = wave & 3;
        const int c = r8 * 16 + u, t0 = c * 64;
        if (tid < 144) { const int r = tid / 48, p = tid % 48;
            const LAS bf16* s = p < 16 ? rq + (64 + r) * 136 + p * 8 : (p < 32 ? rk + (64 + r) * 136 + (p - 16) * 8 : rv + (64 + r) * 136 + (p - 32) * 8);
            *(LAS u32x4*)(st + r * 384 + p * 8) = *(const LAS u32x4*)s; }
        if (!(XP & 1)) { const int tg = wave, cp = lane; float w[16], o[16];
#pragma unroll
          for (int tap = 0; tap < 8; ++tap) { w[2 * tap] = cw[tap * 384 + 2 * cp]; w[2 * tap + 1] = cw[tap * 384 + 2 * cp + 1]; }
          conv_pair8(o, rq + (8 * tg) * 136 + 2 * cp, 136, w);
#pragma unroll
          for (int t = 0; t < 8; ++t) { o[2 * t] = silu(o[2 * t]); o[2 * t + 1] = silu(o[2 * t + 1]);
              const float rs = __builtin_amdgcn_rsqf(wave_sum(o[2 * t] * o[2 * t] + o[2 * t + 1] * o[2 * t + 1]) + EPS) * 0.08838834764831845f;
              const unsigned pk = pkbf(o[2 * t] * rs, o[2 * t + 1] * rs);
              *(LAS unsigned*)(q_ + (8 * tg + t) * 136 + 2 * cp) = pk; if (!(XP & 8)) *(GAS unsigned*)(raww + (rowbw + t0 + 8 * tg + t) * CONV_CH + h * 128 + 2 * cp) = pk; }
#pragma unroll
          for (int tap = 0; tap < 8; ++tap) { w[2 * tap] = cw[tap * 384 + 128 + 2 * cp]; w[2 * tap + 1] = cw[tap * 384 + 128 + 2 * cp + 1]; }
          conv_pair8(o, rk + (8 * tg) * 136 + 2 * cp, 136, w);
#pragma unroll
          for (int t = 0; t < 8; ++t) { o[2 * t] = silu(o[2 * t]); o[2 * t + 1] = silu(o[2 * t + 1]);
              const float rs = __builtin_amdgcn_rsqf(wave_sum(o[2 * t] * o[2 * t] + o[2 * t + 1] * o[2 * t + 1]) + EPS);
              const unsigned pk = pkbf(o[2 * t] * rs, o[2 * t + 1] * rs);
              *(LAS unsigned*)(k_ + (8 * tg + t) * 136 + 2 * cp) = pk; if (!(XP & 8)) *(GAS unsigned*)(raww + (rowbw + t0 + 8 * tg + t) * CONV_CH + 1024 + h * 128 + 2 * cp) = pk; }
#pragma unroll
          for (int tap = 0; tap < 8; ++tap) { w[2 * tap] = cw[tap * 384 + 256 + 2 * cp]; w[2 * tap + 1] = cw[tap * 384 + 256 + 2 * cp + 1]; }
          conv_pair8(o, rv + (8 * tg) * 136 + 2 * cp, 136, w);
#pragma unroll
          for (int t = 0; t < 16; ++t) o[t] = silu(o[t]);
          u32x4 e0, e1; e0.x = pkbf(o[0], o[2]); e0.y = pkbf(o[4], o[6]); e0.z = pkbf(o[8], o[10]); e0.w = pkbf(o[12], o[14]);
          e1.x = pkbf(o[1], o[3]); e1.y = pkbf(o[5], o[7]); e1.z = pkbf(o[9], o[11]); e1.w = pkbf(o[13], o[15]);
          *(LAS u32x4*)(vT + (2 * cp) * 72 + 8 * tg) = e0; *(LAS u32x4*)(vT + (2 * cp + 1) * 72 + 8 * tg) = e1;
        }
        __syncthreads();
        for (int e = tid; e < 128 * 8; e += 512) { const int dv = e >> 3, p = e & 7;
            if (!(XP & 8)) *(GAS u32x4*)(raww + (rowbw + t0 + (dv >> 1)) * CONV_CH + 2048 + h * 128 + (dv & 1) * 64 + p * 8) = *(const LAS u32x4*)(vT + dv * 72 + p * 8); }
        for (int e = tid; e < 2 * 2 * 64 * 72 * 2 / 16; e += 512) ((LAS u32x4*)(lds + TRM))[e] = (u32x4){0u, 0u, 0u, 0u};
        for (int e = tid; e < 2 * 32 * 40 * 2 / 16; e += 512) ((LAS u32x4*)(lds + XS))[e] = (u32x4){0u, 0u, 0u, 0u};
        if (!(XP & 4)) { const int mt = w4;
          f32x4 acc[1][4];
#pragma unroll
          for (int nt = 0; nt < 4; ++nt) acc[0][nt] = (f32x4){0.f, 0.f, 0.f, 0.f};
          mma_lds<1, 4>(acc, half ? q_ : k_, 136, mt * 16, k_, 136, 0, 128, fr, fq);
          const int i0 = mt * 16 + 4 * fq;
          const f32x4 gfi = *(const LAS f32x4*)(sc + 64 + i0), gbi = *(const LAS f32x4*)(sc + 192 + i0), bfi = *(const LAS f32x4*)(sc + i0), bbi = *(const LAS f32x4*)(sc + 128 + i0);
          float gfj[4], gbj[4];
#pragma unroll
          for (int nt = 0; nt < 4; ++nt) { gfj[nt] = sc[64 + nt * 16 + fr]; gbj[nt] = sc[192 + nt * 16 + fr]; }
          asm volatile("" ::: "memory");
#pragma unroll
          for (int nt = 0; nt < 4; ++nt)
#pragma unroll
              for (int r = 0; r < 4; ++r) { const int i = i0 + r, j = nt * 16 + fr; const bool lower = i > j, upper = i < j;
                  const float argl = gfi[r] - gfj[nt], argu = gbi[r] - gbj[nt];
                  const float x = acc[0][nt][r] * __builtin_amdgcn_exp2f(fminf(lower ? argl : argu, 0.f));
                  if (half == 0) { const float af = lower ? bfi[r] * x : 0.f, ab = upper ? bbi[r] * x : 0.f;
                      Abf[i * 72 + j] = f2bf1(af); Abf[64 * 72 + j * 72 + i] = f2bf1(ab);
                      if (mt == nt) { ADf[(mt * 16 + (i & 15)) * 16 + (j & 15)] = af; ADf[1024 + (mt * 16 + (j & 15)) * 16 + (i & 15)] = ab; } }
                  else QKp[i * 72 + j] = f2bf1(i == j ? acc[0][nt][r] : x); }
        }
        __syncthreads();
        if (!(XP & 2)) { LAS bf16* Ab = Abf + half * 64 * 72; LAS bf16* Tr = Trm + half * 64 * 72; LAS bf16* Tt = Ttr + half * 64 * 72; LAS bf16* Xh = Xs + half * 32 * 40;
          if (w4 == 0) { const int blk = lane >> 4, cc = lane & 15; float t[16]; const LAS float* ad = ADf + half * 1024 + blk * 256;
#pragma unroll
              for (int i = 0; i < 16; ++i) t[i] = (i == cc) ? 1.f : 0.f;
#pragma unroll
              for (int i = 1; i < 16; ++i) { float s0 = 0.f, s1 = 0.f;
#pragma unroll
                  for (int j = 0; j < i; ++j) { if (j & 1) s1 += ad[i * 16 + j] * t[j]; else s0 += ad[i * 16 + j] * t[j]; }
                  t[i] = (i > cc) ? -(s0 + s1) : t[i];
                  if ((i & 3) == 3) asm volatile("" ::: "memory"); }
#pragma unroll
              for (int i = 0; i < 16; ++i) { const unsigned short tb = f2bf1(t[i]); Tr[(blk * 16 + i) * 72 + blk * 16 + cc] = tb; Tt[(blk * 16 + cc) * 72 + blk * 16 + i] = tb; } }
          __syncthreads();
          f32x4 a1[1][1];
          if (w4 < 2) { const int J = 2 * w4, I = J + 1; a1[0][0] = (f32x4){0.f, 0.f, 0.f, 0.f};
              mma_lds<1, 1>(a1, Ab + 16 * J, 72, 16 * I, Tt + 16 * J, 72, 16 * J, 32, fr, fq);
              u32x2 wv; wv.x = pkbf(a1[0][0][0], a1[0][0][1]); wv.y = pkbf(a1[0][0][2], a1[0][0][3]);
              *(LAS u32x2*)(Xh + (w4 * 16 + fr) * 40 + 4 * fq) = wv; }
          __syncthreads();
          if (w4 < 2) { const int J = 2 * w4, I = J + 1; a1[0][0] = (f32x4){0.f, 0.f, 0.f, 0.f};
              mma_lds<1, 1>(a1, Tr + 16 * I, 72, 16 * I, Xh, 40, w4 * 16, 32, fr, fq);
#pragma unroll
              for (int r = 0; r < 4; ++r) Tr[(16 * I + 4 * fq + r) * 72 + 16 * J + fr] = f2bf1(-a1[0][0][r]);
              u32x2 wv; wv.x = pkbf(-a1[0][0][0], -a1[0][0][1]); wv.y = pkbf(-a1[0][0][2], -a1[0][0][3]);
              *(LAS u32x2*)(Tt + (16 * J + fr) * 72 + 16 * I + 4 * fq) = wv; }
          __syncthreads();
          { const int mt2 = w4 >> 1, nt2 = w4 & 1; a1[0][0] = (f32x4){0.f, 0.f, 0.f, 0.f};
            mma_lds<1, 1>(a1, Ab, 72, 32 + 16 * mt2, Tt, 72, 16 * nt2, 32, fr, fq);
            u32x2 wv; wv.x = pkbf(a1[0][0][0], a1[0][0][1]); wv.y = pkbf(a1[0][0][2], a1[0][0][3]);
            __syncthreads();
            *(LAS u32x2*)(Xh + (16 * nt2 + fr) * 40 + 16 * mt2 + 4 * fq) = wv;
            __syncthreads();
            a1[0][0] = (f32x4){0.f, 0.f, 0.f, 0.f};
            mma_lds<1, 1>(a1, Tr + 32, 72, 32 + 16 * mt2, Xh, 40, 16 * nt2, 32, fr, fq);
#pragma unroll
            for (int r = 0; r < 4; ++r) Tr[(32 + 16 * mt2 + 4 * fq + r) * 72 + 16 * nt2 + fr] = f2bf1(-a1[0][0][r]);
            u32x2 w2; w2.x = pkbf(-a1[0][0][0], -a1[0][0][1]); w2.y = pkbf(-a1[0][0][2], -a1[0][0][3]);
            *(LAS u32x2*)(Tt + (16 * nt2 + fr) * 72 + 32 + 16 * mt2 + 4 * fq) = w2; }
        }
        __syncthreads();
        { bf16* tq = TQ + ((size_t)(bhw * NCHUNK + c)) * 8192;
          const int i = (tid >> 3) & 63, p = tid & 7;
          const u32x4 qkv = *(const LAS u32x4*)(QKp + i * 72 + p * 8);
          const bf16x8 lo = *(const LAS bf16x8*)(Trm + i * 72 + p * 8), up = *(const LAS bf16x8*)(Ttr + 64 * 72 + i * 72 + p * 8); bf16x8 o8;
#pragma unroll
          for (int y = 0; y < 8; ++y) { const int j = p * 8 + y; o8[y] = (i > j) ? lo[y] : (i < j ? up[y] : (short)0x3F80); }
          __syncthreads();
          if (u + 1 < 16) { PG2_STAGEA(u + 1); }
          asm volatile("" ::: "memory");
          if (!(XP & 8)) { *(GAS bf16x8*)(tq + i * 64 + p * 8) = o8; *(GAS u32x4*)(tq + 4096 + i * 64 + p * 8) = qkv; }
          if (u + 2 < 16) { PG2_LOAD(u + 2); PG2_LOADS(u + 2); } }
        __syncthreads();
    }
#undef PG2_STAGEA
#undef PG2_LOAD
#undef PG2_LOADS
}

__device__ __forceinline__ void gdn_state_v1(LAS unsigned char* lds, int cid, const bf16* raw, const float* scal, const bf16* TQ,
                                             const float* A_log, const float* dt_bias, bf16* og, int tid, int wave, int lane) {
    using namespace gdn;
    const int dvh = cid & 1, dir = (cid >> 1) & 1, h = (cid >> 2) & 7, b = cid >> 5;
    const int fr = lane & 15, fq = lane >> 4;
    LAS float* sc = (LAS float*)(lds + SC);
    LAS bf16* q_ = (LAS bf16*)(lds + Q); LAS bf16* k_ = (LAS bf16*)(lds + K); LAS bf16* kdT = (LAS bf16*)(lds + KDT); LAS bf16* vT = (LAS bf16*)(lds + VT);
    LAS bf16* T_ = (LAS bf16*)(lds + T); LAS bf16* QKd = (LAS bf16*)(lds + QKD); LAS bf16* ST_ = (LAS bf16*)(lds + ST);
    LAS bf16* rT = (LAS bf16*)(lds + RT); LAS bf16* uT = (LAS bf16*)(lds + UT); LAS float* os = (LAS float*)(lds + OS);
    for (int e = tid; e < 64 * 136 / 2; e += 512) ((LAS unsigned*)ST_)[e] = 0u;
    const float expA = expf(A_log[dir * 8 + h]), dtb = dt_bias[dir * 8 + h];
    f32x4 sacc[4];
#pragma unroll
    for (int nt = 0; nt < 4; ++nt) sacc[nt] = (f32x4){0.f, 0.f, 0.f, 0.f};
    const size_t rowb = (size_t)b * SEQ; const int bh = b * 8 + h;
    __syncthreads();
    for (int n = 0; n < NCHUNK; ++n) {
        const int c = dir ? NCHUNK - 1 - n : n, t0 = c * 64;
        for (int e = tid; e < 64 * 16; e += 512) { const int r = e >> 4, p = e & 15;
            *(LAS u32x4*)(q_ + r * 136 + p * 8) = *(const GAS u32x4*)(raw + (rowb + t0 + r) * CONV_CH + h * 128 + p * 8);
            *(LAS u32x4*)(k_ + r * 136 + p * 8) = *(const GAS u32x4*)(raw + (rowb + t0 + r) * CONV_CH + 1024 + h * 128 + p * 8); }
        { const int dvl = tid >> 3, p = tid & 7; const int dv = dvh * 64 + dvl;
          *(LAS u32x4*)(vT + dvl * 72 + p * 8) = *(const GAS u32x4*)(raw + (rowb + t0 + (dv >> 1)) * CONV_CH + 2048 + h * 128 + (dv & 1) * 64 + p * 8); }
        { const bf16* tq = TQ + ((size_t)(bh * NCHUNK + c)) * 8192;
          for (int e = tid; e < 1024; e += 512) { const int which = e >> 9, i = (e >> 3) & 63, p = e & 7;
              bf16x8 v = *(const GAS bf16x8*)(tq + which * 4096 + i * 64 + p * 8);
#pragma unroll
              for (int x = 0; x < 8; ++x) { const int j = p * 8 + x; const bool keep = dir ? (i < j) : (i > j);
                  if (i == j) { if (which == 0) v[x] = (short)0x3F80; } else if (!keep) v[x] = 0; }
              *(LAS bf16x8*)((which ? QKd : T_) + i * 72 + p * 8) = v; } }
        if (wave == 0) { const int i = lane; const size_t so = (rowb + t0 + i) * 64;
            const float g = -expA * softplus_f(scal[so + 16 + dir * 8 + h] + dtb); float gc = g;
            if (dir == 0) {
#pragma unroll
                for (int o = 1; o < 64; o <<= 1) { const float y = __shfl_up(gc, o); if (i >= o) gc += y; }
            } else {
#pragma unroll
                for (int o = 1; o < 64; o <<= 1) { const float y = __shfl_down(gc, o); if (i + o < 64) gc += y; }
            }
            const float gl = __shfl(gc, dir ? 0 : 63);
            sc[i] = sigmoid_f(scal[so + dir * 8 + h]); sc[64 + i] = gc; sc[128 + i] = expf(gc); sc[192 + i] = expf(gl - gc); if (i == 0) sc[256] = expf(gl); }
        __syncthreads();
        { const int i = tid >> 3, cg = tid & 7; const float ek = sc[192 + i];
          const bf16x8 k0 = *(const LAS bf16x8*)(k_ + i * 136 + cg * 16), k1 = *(const LAS bf16x8*)(k_ + i * 136 + cg * 16 + 8);
#pragma unroll
          for (int x = 0; x < 8; ++x) { kdT[(cg * 16 + x) * 72 + i] = f2bf1(bf2f_s(k0[x]) * ek); kdT[(cg * 16 + 8 + x) * 72 + i] = f2bf1(bf2f_s(k1[x]) * ek); } }
        __syncthreads();
        const int mt = wave & 3, nh = wave >> 2;
        f32x4 aq[2];
        { f32x4 ak[2]; ak[0] = ak[1] = aq[0] = aq[1] = (f32x4){0.f, 0.f, 0.f, 0.f};
          for (int k0 = 0; k0 < 128; k0 += 32) {
              const bf16x8 fk = *(const LAS bf16x8*)(k_ + (mt * 16 + fr) * 136 + k0 + fq * 8), fqv = *(const LAS bf16x8*)(q_ + (mt * 16 + fr) * 136 + k0 + fq * 8);
#pragma unroll
              for (int nl = 0; nl < 2; ++nl) { const bf16x8 fb = *(const LAS bf16x8*)(ST_ + (nh * 32 + nl * 16 + fr) * 136 + k0 + fq * 8);
                  ak[nl] = __builtin_amdgcn_mfma_f32_16x16x32_bf16(fk, fb, ak[nl], 0, 0, 0); aq[nl] = __builtin_amdgcn_mfma_f32_16x16x32_bf16(fqv, fb, aq[nl], 0, 0, 0); } }
          const int i0 = mt * 16 + 4 * fq;
          const f32x4 be4 = *(const LAS f32x4*)(sc + i0), eg4 = *(const LAS f32x4*)(sc + 128 + i0);
#pragma unroll
          for (int nl = 0; nl < 2; ++nl) { const int dv = nh * 32 + nl * 16 + fr;
              const bf16x4 vv = *(const LAS bf16x4*)(vT + dv * 72 + i0);
              float r0 = be4[0] * (bf2f_s(vv[0]) - eg4[0] * ak[nl][0]), r1 = be4[1] * (bf2f_s(vv[1]) - eg4[1] * ak[nl][1]);
              float r2 = be4[2] * (bf2f_s(vv[2]) - eg4[2] * ak[nl][2]), r3 = be4[3] * (bf2f_s(vv[3]) - eg4[3] * ak[nl][3]);
              u32x2 w; w.x = pkbf(r0, r1); w.y = pkbf(r2, r3); *(LAS u32x2*)(rT + dv * 72 + i0) = w;
              aq[nl][0] *= eg4[0]; aq[nl][1] *= eg4[1]; aq[nl][2] *= eg4[2]; aq[nl][3] *= eg4[3]; }
        }
        __syncthreads();
        { f32x4 au[1][2]; au[0][0] = au[0][1] = (f32x4){0.f, 0.f, 0.f, 0.f};
          mma_lds<1, 2>(au, T_, 72, mt * 16, rT, 72, nh * 32, 64, fr, fq);
          const int i0 = mt * 16 + 4 * fq;
#pragma unroll
          for (int nl = 0; nl < 2; ++nl) { const int dv = nh * 32 + nl * 16 + fr; u32x2 w; w.x = pkbf(au[0][nl][0], au[0][nl][1]); w.y = pkbf(au[0][nl][2], au[0][nl][3]); *(LAS u32x2*)(uT + dv * 72 + i0) = w; }
        }
        __syncthreads();
        { f32x4 ao[1][2]; ao[0][0] = aq[0]; ao[0][1] = aq[1];
          mma_lds<1, 2>(ao, QKd, 72, mt * 16, uT, 72, nh * 32, 64, fr, fq);
          const int i0 = mt * 16 + 4 * fq;
#pragma unroll
          for (int nl = 0; nl < 2; ++nl)
#pragma unroll
              for (int r = 0; r < 4; ++r) os[(i0 + r) * 65 + nh * 32 + nl * 16 + fr] = ao[0][nl][r];
          const float egl = sc[256];
          f32x4 as_[1][4];
#pragma unroll
          for (int nt = 0; nt < 4; ++nt) as_[0][nt] = sacc[nt] * egl;
          mma_lds<1, 4>(as_, kdT, 72, wave * 16, uT, 72, 0, 64, fr, fq);
#pragma unroll
          for (int nt = 0; nt < 4; ++nt) { sacc[nt] = as_[0][nt];
              u32x2 w; w.x = pkbf(sacc[nt][0], sacc[nt][1]); w.y = pkbf(sacc[nt][2], sacc[nt][3]); *(LAS u32x2*)(ST_ + (nt * 16 + fr) * 136 + wave * 16 + 4 * fq) = w; }
        }
        __syncthreads();
#pragma unroll
        for (int ii = 0; ii < 4; ++ii) { const int i = wave * 8 + 2 * ii + (lane >> 5), cp = lane & 31;
            atomic_add_bf16x2(og + (rowb + t0 + i) * 1024 + h * 128 + dvh * 64 + 2 * cp, os[i * 65 + 2 * cp], os[i * 65 + 2 * cp + 1]); }
        __syncthreads();
    }
}
typedef float f32x16 __attribute__((ext_vector_type(16)));
typedef short v4i16_t __attribute__((ext_vector_type(4)));
namespace gs2 {
constexpr int KO = 0;
constexpr int QO = KO + 64 * 132 * 2;
constexpr int VTO = QO + 64 * 132 * 2;
constexpr int TO = VTO + 64 * 68 * 2;
constexpr int QKO = TO + 64 * 68 * 2;
constexpr int SCO = QKO + 64 * 68 * 2;
constexpr int BUF = SCO + 1024;
constexpr int OST = 2 * BUF;
constexpr int END = OST + 2 * 64 * 72 * 2;
static_assert(END <= MISC_OFF && BUF % 16 == 0, "gdn state LDS map");
}
__device__ __forceinline__ bf16x8 cvt8(const f32x16& x, int base) {
    u32x4 w; w.x = pkbf(x[base], x[base + 1]); w.y = pkbf(x[base + 2], x[base + 3]); w.z = pkbf(x[base + 4], x[base + 5]); w.w = pkbf(x[base + 6], x[base + 7]);
    return __builtin_bit_cast(bf16x8, w);
}
__device__ __forceinline__ bf16x8 afrag(const LAS bf16* p) {
    const bf16x4 lo = *(const LAS bf16x4*)p, hi = *(const LAS bf16x4*)(p + 8);
    return (bf16x8){lo[0], lo[1], lo[2], lo[3], hi[0], hi[1], hi[2], hi[3]};
}
__device__ __forceinline__ bf16x8 afrag_tr(const LAS bf16* p, int ld) {
    const v4i16_t lo = __builtin_amdgcn_ds_read_tr16_b64_v4i16((LAS v4i16_t*)p), hi = __builtin_amdgcn_ds_read_tr16_b64_v4i16((LAS v4i16_t*)(p + 8 * ld));
    return (bf16x8){lo[0], lo[1], lo[2], lo[3], hi[0], hi[1], hi[2], hi[3]};
}
#define MFMA32(a, b, c) __builtin_amdgcn_mfma_f32_32x32x16_bf16((a), (b), (c), 0, 0, 0)

#ifndef WG_BAR
#define WG_BAR() asm volatile("s_waitcnt lgkmcnt(0)\n\ts_barrier" ::: "memory")
#endif
template <int DIR>
__device__ __forceinline__ void gdn_state2(LAS unsigned char* lds, int b, int h, int half, const bf16* raw, const float* scal, const bf16* TQ,
                                           const float* A_log, const float* dt_bias, bf16* og, int tid, int wave, int lane, float* probe = nullptr) {
    using namespace gs2;
    const size_t rowb = (size_t)b * SEQ; const int bh = b * 8 + h;
    const float expA = expf(A_log[DIR * 8 + h]), dtb = dt_bias[DIR * 8 + h];
    LAS bf16* ost = (LAS bf16*)(lds + OST);
    const int r31 = lane & 31, hh = lane >> 5;
    if (wave == 4 || wave == 5) {
        for (int n = 0; n < NCHUNK + 1; ++n) WG_BAR();
    } else if (wave >= 2) {
        const int hw = (wave & 1) | ((wave >> 2) << 1);
        const int ht = hw * 64 + lane;
        unsigned go[14], lo_[14]; u32x4 ld[14]; float sr0 = 0.f, sr1 = 0.f;
#pragma unroll
        for (int x = 0; x < 4; ++x) { const int e = ht + 256 * x, r = e >> 4, p = e & 15;
            go[x] = (unsigned)((r * CONV_CH + 1024 + h * 128 + p * 8) * 2); go[4 + x] = (unsigned)((r * CONV_CH + h * 128 + p * 8) * 2);
            lo_[x] = (unsigned)(KO + (r * 132 + p * 8) * 2); lo_[4 + x] = (unsigned)(QO + (r * 132 + p * 8) * 2); }
#pragma unroll
        for (int x = 0; x < 2; ++x) { const int e = ht + 256 * x, dvl = e >> 3, p = e & 7; const int dv = 64 * half + dvl;
            go[8 + x] = (unsigned)(((dv >> 1) * CONV_CH + 2048 + h * 128 + (dv & 1) * 64 + p * 8) * 2); lo_[8 + x] = (unsigned)(VTO + (dvl * 68 + p * 8) * 2); }
        u32x4 km[2], dg[2], qm[2];
#pragma unroll
        for (int x = 0; x < 2; ++x) { const int e = ht + 256 * x, i = e >> 3, p = e & 7;
            go[10 + x] = (unsigned)(e * 16); go[12 + x] = (unsigned)(8192 + e * 16);
            lo_[10 + x] = (unsigned)(TO + (i * 68 + p * 8) * 2); lo_[12 + x] = (unsigned)(QKO + (i * 68 + p * 8) * 2);
            unsigned kw[4], dw[4], qw[4];
#pragma unroll
            for (int w = 0; w < 4; ++w) { const int j0 = p * 8 + 2 * w, j1 = j0 + 1;
                const bool k0 = DIR ? (i < j0) : (i > j0), k1 = DIR ? (i < j1) : (i > j1);
                kw[w] = (k0 ? 0xFFFFu : 0u) | (k1 ? 0xFFFF0000u : 0u); dw[w] = (i == j0 ? 0x3F80u : 0u) | (i == j1 ? 0x3F800000u : 0u);
                qw[w] = kw[w] | (i == j0 ? 0xFFFFu : 0u) | (i == j1 ? 0xFFFF0000u : 0u); }
            km[x] = (u32x4){kw[0], kw[1], kw[2], kw[3]}; dg[x] = (u32x4){dw[0], dw[1], dw[2], dw[3]}; qm[x] = (u32x4){qw[0], qw[1], qw[2], qw[3]}; }
        const unsigned so_l = (unsigned)(lane * 256 + (DIR * 8 + h) * 4);
#define GS2_ISSUE(c_) do { const GAS char* rb_ = (const GAS char*)(raw + (rowb + (size_t)(c_) * 64) * CONV_CH); const GAS char* tb_ = (const GAS char*)(TQ + ((size_t)(bh * NCHUNK + (c_))) * 8192); \
            _Pragma("unroll") for (int x = 0; x < 10; ++x) ld[x] = *(const GAS u32x4*)(rb_ + go[x]); \
            _Pragma("unroll") for (int x = 10; x < 14; ++x) ld[x] = *(const GAS u32x4*)(tb_ + go[x]); \
            if (hw == 0) { const GAS char* sb_ = (const GAS char*)(scal + (rowb + (size_t)(c_) * 64) * 64); sr0 = *(const GAS float*)(sb_ + so_l); sr1 = *(const GAS float*)(sb_ + so_l + 64); } } while (0)
#define GS2_ST16(off_, v_) do { LAS unsigned char* d_ = B_ + (off_); *(LAS u32x2*)(d_) = (u32x2){(v_).x, (v_).y}; *(LAS u32x2*)(d_ + 8) = (u32x2){(v_).z, (v_).w}; } while (0)
#define GS2_COMMIT(bi_, c_) do { LAS unsigned char* B_ = lds + (bi_) * BUF; \
            _Pragma("unroll") for (int x = 0; x < 10; ++x) GS2_ST16(lo_[x], ld[x]); \
            _Pragma("unroll") for (int x = 0; x < 2; ++x) { const u32x4 tv = (ld[10 + x] & km[x]) | dg[x], qv = ld[12 + x] & qm[x]; \
                GS2_ST16(lo_[10 + x], tv); GS2_ST16(lo_[12 + x], qv); } \
            if (hw == 0) { LAS float* sc_ = (LAS float*)(B_ + SCO); const int i = lane; const float gc = sr1; const float gl = __shfl(gc, DIR ? 0 : 63); \
                sc_[i] = sr0; sc_[64 + i] = __expf(gc); sc_[128 + i] = __expf(gl - gc); if (i == 0) sc_[192] = __expf(gl); } } while (0)
        { const int c0 = DIR ? NCHUNK - 1 : 0; GS2_ISSUE(c0); GS2_COMMIT(0, c0); GS2_ISSUE((DIR ? c0 - 1 : c0 + 1)); }
        for (int n = 0; n < NCHUNK; ++n) {
            const int c = DIR ? NCHUNK - 1 - n : n;
            WG_BAR();
            const bool more = n + 1 < NCHUNK; const int cn = DIR ? c - 1 : c + 1;
            if (more) { GS2_COMMIT((n + 1) & 1, cn); if (n + 2 < NCHUNK) GS2_ISSUE((DIR ? cn - 1 : cn + 1)); }
            unsigned ov[8];
            if (n > 0) {
#pragma unroll
                for (int x = 0; x < 8; ++x) ov[x] = *(const LAS unsigned*)(ost + ((n - 1) & 1) * (64 * 72) + (hw * 16 + 2 * x + (lane >> 5)) * 72 + 2 * (lane & 31));
            }
            if (n > 0) { const int tp = (DIR ? c + 1 : c - 1) * 64;
#pragma unroll
                for (int x = 0; x < 8; ++x) { GAS char* ob_ = (GAS char*)(og + (rowb + tp + hw * 16 + 2 * x) * 1024 + h * 128 + half * 64);
                    (void)__builtin_amdgcn_global_atomic_fadd_v2bf16((GAS s16x2*)(ob_ + (lane >> 5) * 2048 + (lane & 31) * 4), __builtin_bit_cast(s16x2, ov[x])); } }
        }
        WG_BAR();
        { const int tp = (DIR ? 0 : NCHUNK - 1) * 64;
#pragma unroll
          for (int x = 0; x < 8; ++x) { const unsigned v = *(const LAS unsigned*)(ost + ((NCHUNK - 1) & 1) * (64 * 72) + (hw * 16 + 2 * x + (lane >> 5)) * 72 + 2 * (lane & 31));
              GAS char* ob_ = (GAS char*)(og + (rowb + tp + hw * 16 + 2 * x) * 1024 + h * 128 + half * 64);
              (void)__builtin_amdgcn_global_atomic_fadd_v2bf16((GAS s16x2*)(ob_ + (lane >> 5) * 2048 + (lane & 31) * 4), __builtin_bit_cast(s16x2, v)); } }
#undef GS2_ISSUE
#undef GS2_COMMIT
#undef GS2_ST16
    } else {
        const int dv0 = 32 * wave;
#if defined(PROBE_STATE)
        unsigned long long tw_ = 0ull; const unsigned long long ts0_ = __builtin_amdgcn_s_memtime();
#define PB_BAR() do { const unsigned long long t0_ = __builtin_amdgcn_s_memtime(); WG_BAR(); tw_ += __builtin_amdgcn_s_memtime() - t0_; } while (0)
#else
#define PB_BAR() WG_BAR()
#endif
        f32x16 St[4];
#pragma unroll
        for (int t = 0; t < 4; ++t)
#pragma unroll
            for (int r = 0; r < 16; ++r) St[t][r] = 0.f;
        for (int n = 0; n < NCHUNK; ++n) {
            PB_BAR();
            const LAS unsigned char* Bb = lds + (n & 1) * BUF;
            const LAS bf16* Kb = (const LAS bf16*)(Bb + KO); const LAS bf16* Qb = (const LAS bf16*)(Bb + QO); const LAS bf16* Vb = (const LAS bf16*)(Bb + VTO);
            const LAS bf16* Tb = (const LAS bf16*)(Bb + TO); const LAS bf16* QKb = (const LAS bf16*)(Bb + QKO); const LAS float* sc = (const LAS float*)(Bb + SCO);
            f32x16 aK[2];
#pragma unroll
            for (int m = 0; m < 2; ++m)
#pragma unroll
                for (int r = 0; r < 16; ++r) aK[m][r] = 0.f;
            bf16x8 fa[2][2];
            const int offk = r31 * 132 + 4 * hh;
#define GS2_LD2(P_, bi_, ks_) do { fa[bi_][0] = afrag((P_) + offk + 16 * (ks_)); fa[bi_][1] = afrag((P_) + offk + 32 * 132 + 16 * (ks_)); } while (0)
            GS2_LD2(Kb, 0, 0);
#pragma unroll
            for (int ks = 0; ks < 8; ++ks) {
                if (ks < 7) GS2_LD2(Kb, (ks + 1) & 1, ks + 1);
                __builtin_amdgcn_sched_barrier(0);
                const bf16x8 bs = cvt8(St[ks >> 1], 8 * (ks & 1));
                aK[0] = MFMA32(fa[ks & 1][0], bs, aK[0]); aK[1] = MFMA32(fa[ks & 1][1], bs, aK[1]);
                __builtin_amdgcn_sched_barrier(0); }
            bf16x8 ft[8];
#pragma unroll
            for (int mi = 0; mi < 2; ++mi)
#pragma unroll
                for (int kt = 0; kt < 4; ++kt) { const bool need = DIR ? (kt >= 2 * mi) : (kt <= 2 * mi + 1);
                    if (need) ft[mi * 4 + kt] = afrag(Tb + (32 * mi + r31) * 68 + 16 * kt + 4 * hh); }
#pragma unroll
            for (int m = 0; m < 2; ++m)
#pragma unroll
                for (int q4 = 0; q4 < 4; ++q4) { const int tb = 32 * m + 8 * q4 + 4 * hh;
                    const bf16x4 vv = *(const LAS bf16x4*)(Vb + (dv0 + r31) * 68 + tb); const f32x4 be = *(const LAS f32x4*)(sc + tb), eg = *(const LAS f32x4*)(sc + 64 + tb);
#pragma unroll
                    for (int e = 0; e < 4; ++e) aK[m][4 * q4 + e] = be[e] * (bf2f_s(vv[e]) - eg[e] * aK[m][4 * q4 + e]); }
            const bf16x8 br0 = cvt8(aK[0], 0), br1 = cvt8(aK[0], 8), br2 = cvt8(aK[1], 0), br3 = cvt8(aK[1], 8);
            __builtin_amdgcn_sched_barrier(0);
            f32x16 au[2];
#pragma unroll
            for (int m = 0; m < 2; ++m)
#pragma unroll
                for (int r = 0; r < 16; ++r) au[m][r] = 0.f;
            GS2_LD2(Qb, 0, 0);
#pragma unroll
            for (int mi = 0; mi < 2; ++mi)
#pragma unroll
                for (int kt = 0; kt < 4; ++kt) { const bool need = DIR ? (kt >= 2 * mi) : (kt <= 2 * mi + 1);
                    if (need) au[mi] = MFMA32(ft[mi * 4 + kt], (kt == 0 ? br0 : kt == 1 ? br1 : kt == 2 ? br2 : br3), au[mi]); }
            __builtin_amdgcn_sched_barrier(0);
            f32x16 aQ[2];
#pragma unroll
            for (int m = 0; m < 2; ++m)
#pragma unroll
                for (int r = 0; r < 16; ++r) aQ[m][r] = 0.f;
#pragma unroll
            for (int ks = 0; ks < 8; ++ks) {
                if (ks < 7) GS2_LD2(Qb, (ks + 1) & 1, ks + 1);
                __builtin_amdgcn_sched_barrier(0);
                const bf16x8 bs = cvt8(St[ks >> 1], 8 * (ks & 1));
                aQ[0] = MFMA32(fa[ks & 1][0], bs, aQ[0]); aQ[1] = MFMA32(fa[ks & 1][1], bs, aQ[1]);
                __builtin_amdgcn_sched_barrier(0); }
#undef GS2_LD2
            const bf16x8 bu0 = cvt8(au[0], 0), bu1 = cvt8(au[0], 8), bu2 = cvt8(au[1], 0), bu3 = cvt8(au[1], 8);
#pragma unroll
            for (int m = 0; m < 2; ++m)
#pragma unroll
                for (int q4 = 0; q4 < 4; ++q4) { const int tb = 32 * m + 8 * q4 + 4 * hh; const f32x4 ek = *(const LAS f32x4*)(sc + 128 + tb), eg = *(const LAS f32x4*)(sc + 64 + tb);
#pragma unroll
                    for (int e = 0; e < 4; ++e) { au[m][4 * q4 + e] *= ek[e]; aQ[m][4 * q4 + e] *= eg[e]; } }
            const bf16x8 bd0 = cvt8(au[0], 0), bd1 = cvt8(au[0], 8), bd2 = cvt8(au[1], 0), bd3 = cvt8(au[1], 8);
            __builtin_amdgcn_sched_barrier(0);
            bf16x8 fqk[8];
#pragma unroll
            for (int mi = 0; mi < 2; ++mi)
#pragma unroll
                for (int kt = 0; kt < 4; ++kt) { const bool need = DIR ? (kt >= 2 * mi) : (kt <= 2 * mi + 1);
                    if (need) fqk[mi * 4 + kt] = afrag(QKb + (32 * mi + r31) * 68 + 16 * kt + 4 * hh); }
            const int i16 = r31 & 15; const LAS bf16* kp = Kb + (4 * hh + (i16 >> 2)) * 132 + 16 * (r31 >> 4) + 4 * (i16 & 3);
            bf16x8 fk[2][4];
#define GS2_LDKT(bi_, t_) do { _Pragma("unroll") for (int kt = 0; kt < 4; ++kt) fk[bi_][kt] = afrag_tr(kp + (16 * kt) * 132 + 32 * (t_), 132); } while (0)
            __builtin_amdgcn_sched_barrier(0);
#pragma unroll
            for (int mi = 0; mi < 2; ++mi)
#pragma unroll
                for (int kt = 0; kt < 4; ++kt) { const bool need = DIR ? (kt >= 2 * mi) : (kt <= 2 * mi + 1);
                    if (need) aQ[mi] = MFMA32(fqk[mi * 4 + kt], (kt == 0 ? bu0 : kt == 1 ? bu1 : kt == 2 ? bu2 : bu3), aQ[mi]); }
            GS2_LDKT(0, 0);
            const float egl = sc[192];
#pragma unroll
            for (int mi = 0; mi < 2; ++mi)
#pragma unroll
                for (int r = 0; r < 16; ++r) ost[(n & 1) * (64 * 72) + (32 * mi + (r & 3) + 8 * (r >> 2) + 4 * hh) * 72 + dv0 + r31] = f2bf1(aQ[mi][r]);
#pragma unroll
            for (int t = 0; t < 4; ++t) {
                if (t < 3) GS2_LDKT((t + 1) & 1, t + 1);
                __builtin_amdgcn_sched_barrier(0);
#pragma unroll
                for (int r = 0; r < 16; ++r) St[t][r] *= egl;
                St[t] = MFMA32(fk[t & 1][0], bd0, St[t]); St[t] = MFMA32(fk[t & 1][1], bd1, St[t]);
                St[t] = MFMA32(fk[t & 1][2], bd2, St[t]); St[t] = MFMA32(fk[t & 1][3], bd3, St[t]);
                __builtin_amdgcn_sched_barrier(0); }
#undef GS2_LDKT
        }
        WG_BAR();
#if defined(PROBE_STATE)
        if (blockIdx.x == 0 && tid == 0 && probe) { const unsigned long long tt_ = __builtin_amdgcn_s_memtime() - ts0_; *probe = (float)((double)tw_ / (double)tt_); }
#endif
    }
}
constexpr size_t WS_SSC = 1 * MiB;
namespace psd {
constexpr int CW = 0;
constexpr int SC = CW + 8 * 768 * 4;
constexpr int BM_ = SC + 8 * 4 * 64 * 4;
constexpr int CM_ = BM_ + 64 * 136 * 2;
constexpr int CB = CM_ + 64 * 136 * 2;
constexpr int R = CB + 64 * 68 * 4;
constexpr int RBC = R, RBC_END = R + 70 * 272 * 2;
constexpr int RX = R, XT = RX + 70 * 136 * 2, MM = XT + 128 * 72 * 2, R_END = MM + 2 * 64 * 72 * 2;
constexpr int YST = RX;
constexpr int PRBC = CW + 8 * 768 * 4, PXT = PRBC + 70 * 272 * 2, P_END = PXT + 256 * 72 * 2;
constexpr int STASH = pgd::STASH + 4608;
static_assert(P_END <= pgd::STASH, "prep ssd conv LDS map");
static_assert(RBC_END <= pgd::STASH && R_END <= pgd::STASH && STASH + 9216 <= MISC_OFF, "prep ssd LDS map");
}
__device__ __forceinline__ void prep_ssd_stash(LAS unsigned char* lds, int bid, const bf16* raw, int tid) {
    const int bg = bid >> 5, b = bg >> 1, g = bg & 1, r32 = bid & 31;
    LAS bf16* st = (LAS bf16*)(lds + psd::STASH);
    for (int e = tid; e < 2 * 3 * 96; e += 512) { const int which = e / 288, r = (e % 288) / 96, p = e % 96;
        const int t = which ? (r32 * 4 + 4) * 64 + r : r32 * 4 * 64 - 3 + r;
        const int col = p < 64 ? 3072 + g * 512 + p * 8 : (p < 80 ? 4096 + g * 128 + (p - 64) * 8 : 4352 + g * 128 + (p - 80) * 8);
        u32x4 v = (u32x4){0u, 0u, 0u, 0u};
        if (t >= 0 && t < SEQ) v = *(const GAS u32x4*)(raw + ((size_t)b * SEQ + t) * CONV_CH + col);
        *(LAS u32x4*)(st + which * 2304 + r * 768 + p * 8) = v; }
}
template <int XP = 0>
__device__ __forceinline__ void prep_ssd_range(LAS unsigned char* lds, int bid, bf16* raw, const float* conv_w, const float* conv_b, int tid_p,
                                               const float* scal, const float* A_log, const float* dt_bias, float* ssc, bf16* rwb = nullptr) {
    using namespace psd;
    const int bg = bid >> 5, b = bg >> 1, g = bg & 1, r32 = bid & 31;
    bf16* const raww = XP ? rwb : raw; const size_t rowbw = XP ? (size_t)0 : (size_t)b * SEQ; const int bw = XP ? 0 : b;
    LAS float* cw = (LAS float*)(lds + CW);
    LAS bf16* rbc = (LAS bf16*)(lds + PRBC); LAS bf16* xT = (LAS bf16*)(lds + PXT);
    LAS bf16* st = (LAS bf16*)(lds + STASH);
    for (int e = tid_p; e < 8 * 768; e += 512) { const int r = e / 768, c = e % 768;
        const int gch = c < 512 ? 3072 + g * 512 + c : (c < 640 ? 4096 + g * 128 + (c - 512) : 4352 + g * 128 + (c - 640));
        cw[e] = r < 7 ? conv_w[r * CONV_CH + gch] : conv_b[gch]; }
    const size_t rowb = (size_t)b * SEQ;
    u32x4 pre[5];
#define PSD_LOAD(u_, ps_) do { const int t0_ = (r32 * 4 + (u_)) * 64; \
        _Pragma("unroll") for (int x = 0; x < 5; ++x) { const int e = tid_p + 512 * x; const int r = e >> 5, p = e & 31; \
            pre[x] = (u32x4){0u, 0u, 0u, 0u}; \
            if (e < 70 * 32 && r >= 3 && !(r >= 67 && (u_) == 3)) { const int col = (ps_) == 0 ? (p < 16 ? 4096 + g * 128 + p * 8 : 4352 + g * 128 + (p - 16) * 8) : 3072 + g * 512 + ((ps_) - 1) * 256 + p * 8; \
                pre[x] = *(const GAS u32x4*)(raw + (rowb + t0_ - 3 + r) * CONV_CH + col); } } } while (0)
    PSD_LOAD(0, 0);
    float sdf[4], sdb[4];
    { const int lane0 = tid_p & 63, wave0 = tid_p >> 6, hd0 = g * 8 + wave0;
#pragma unroll
      for (int u = 0; u < 4; ++u) { const size_t so = (rowb + (size_t)(r32 * 4 + u) * 64 + lane0) * 64; sdf[u] = scal[so + 32 + hd0]; sdb[u] = scal[so + 48 + hd0]; } }
#define PSD_STAGE(u_, scol_) do { _Pragma("unroll") for (int x = 0; x < 5; ++x) { const int e = tid_p + 512 * x; const int r = e >> 5, p = e & 31; \
            if (e < 70 * 32) { u32x4 v = pre[x]; \
                if (r < 3) v = *(const LAS u32x4*)(st + r * 768 + (scol_) + p * 8); \
                else if (r >= 67 && (u_) == 3) v = *(const LAS u32x4*)(st + 2304 + (r - 67) * 768 + (scol_) + p * 8); \
                *(LAS u32x4*)(rbc + r * 272 + (p < 16 ? p * 8 : 136 + (p - 16) * 8)) = v; } } } while (0)
    __syncthreads();
    PSD_STAGE(0, 512);
    PSD_LOAD(0, 1);
    __syncthreads();
#pragma unroll
    for (int u = 0; u < 4; ++u) {
        int tid = tid_p; asm volatile("" : "+v"(tid));
        const int lane = tid & 63, wave = __builtin_amdgcn_readfirstlane(tid >> 6);
        const int c = r32 * 4 + u, t0 = c * 64;
        { const int hd = g * 8 + wave, i = lane;
          const float dtf = softplus_fast(sdf[u] + dt_bias[hd]), dtb = softplus_fast(sdb[u] + dt_bias[16 + hd]);
          const float cf = scan_fwd64(dtf * -expf(A_log[hd]), i), cbk = scan_bwd64(dtb * -expf(A_log[16 + hd]), i);
          float* sp = ssc + ((size_t)((bw * 16 + hd) * NCHUNK + c)) * 256 + i; sp[0] = dtf; sp[64] = cf; sp[128] = dtb; sp[192] = cbk; }
        for (int ps = 0; ps < 3; ++ps) {
            const int scol = ps == 0 ? 512 : (ps == 1 ? 0 : 256);
            if (tid < 96) { const int r = tid >> 5, p = tid & 31;
                *(LAS u32x4*)(st + r * 768 + scol + p * 8) = *(const LAS u32x4*)(rbc + (64 + r) * 272 + (p < 16 ? p * 8 : 136 + (p - 16) * 8)); }
            unsigned bcv[16];
#pragma unroll
            for (int t = 0; t < 16; ++t) bcv[t] = 0u;
            if (!(XP & 1)) { const int tg = wave, cp = lane; float w[16], o[16];
#pragma unroll
              for (int hf = 0; hf < 2; ++hf) {
#pragma unroll
                  for (int tap = 0; tap < 8; ++tap) { w[2 * tap] = cw[tap * 768 + scol + hf * 128 + 2 * cp]; w[2 * tap + 1] = cw[tap * 768 + scol + hf * 128 + 2 * cp + 1]; }
                  conv_pair8(o, rbc + (8 * tg) * 272 + hf * 136 + 2 * cp, 272, w);
#pragma unroll
                  for (int t = 0; t < 16; ++t) o[t] = silu(o[t]);
#pragma unroll
                  for (int t = 0; t < 8; ++t) bcv[hf * 8 + t] = pkbf(o[2 * t], o[2 * t + 1]);
                  if (ps != 0) {
                      u32x4 e0, e1; e0.x = pkbf(o[0], o[2]); e0.y = pkbf(o[4], o[6]); e0.z = pkbf(o[8], o[10]); e0.w = pkbf(o[12], o[14]);
                      e1.x = pkbf(o[1], o[3]); e1.y = pkbf(o[5], o[7]); e1.z = pkbf(o[9], o[11]); e1.w = pkbf(o[13], o[15]);
                      *(LAS u32x4*)(xT + (hf * 128 + 2 * cp) * 72 + 8 * tg) = e0; *(LAS u32x4*)(xT + (hf * 128 + 2 * cp + 1) * 72 + 8 * tg) = e1; } } }
            __syncthreads();
            const bool lastp = (u == 3 && ps == 2);
            if (!lastp) { if (ps < 2) PSD_STAGE(u, (ps == 0 ? 0 : 256)); else PSD_STAGE(u + 1, 512); }
            asm volatile("" ::: "memory");
            if (ps == 0) {
                const int tg = wave, cp = lane;
#pragma unroll
                for (int hf = 0; hf < 2; ++hf)
#pragma unroll
                    for (int t = 0; t < 8; ++t) { if (!(XP & 8)) *(GAS unsigned*)(raww + (rowbw + t0 + 8 * tg + t) * CONV_CH + (hf ? 4352 : 4096) + g * 128 + 2 * cp) = bcv[hf * 8 + t]; }
            } else {
                for (int e = tid; e < 256 * 8; e += 512) { const int xr = e >> 3, p = e & 7; const int hl = (ps - 1) * 4 + (xr >> 6), pp = xr & 63;
                    if (!(XP & 8)) *(GAS u32x4*)(raww + (rowbw + t0 + pp) * CONV_CH + 3072 + (g * 8 + hl) * 64 + p * 8) = *(const LAS u32x4*)(xT + xr * 72 + p * 8); } }
            if (ps == 0) PSD_LOAD(u, 2); else if (u < 3) { if (ps == 1) PSD_LOAD(u + 1, 0); else PSD_LOAD(u + 1, 1); }
            __syncthreads();
        }
    }
}
#undef PSD_STAGE
#undef PSD_LOAD
__device__ __forceinline__ void ssd_intra_range(LAS unsigned char* lds, int bid, const bf16* raw, const float* ssc, const float* Dp, bf16* yi, int tid_p) {
    using namespace psd;
    const int bg = bid >> 5, b = bg >> 1, g = bg & 1, r32 = bid & 31;
    LAS float* sc = (LAS float*)(lds + SC);
    LAS bf16* Bm = (LAS bf16*)(lds + BM_); LAS bf16* Cm = (LAS bf16*)(lds + CM_); LAS float* cb = (LAS float*)(lds + CB);
    LAS bf16* xT = (LAS bf16*)(lds + XT); LAS bf16* Mm = (LAS bf16*)(lds + MM); LAS bf16* yst = (LAS bf16*)(lds + YST);
    const size_t rowb = (size_t)b * SEQ;
    u32x4 pbc[4], px[8]; float pss[4];
#define PSI_LOADBC(u_) do { const int t0_ = (r32 * 4 + (u_)) * 64; \
        _Pragma("unroll") for (int x = 0; x < 4; ++x) { const int e = tid_p + 512 * x; const int r = e >> 5, p = e & 31; \
            pbc[x] = *(const GAS u32x4*)(raw + (rowb + t0_ + r) * CONV_CH + (p < 16 ? 4096 + g * 128 + p * 8 : 4352 + g * 128 + (p - 16) * 8)); } \
        { const float* sp_ = ssc + ((size_t)((b * 16 + g * 8 + (tid_p >> 6)) * NCHUNK + (r32 * 4 + (u_)))) * 256 + (tid_p & 63); pss[0] = sp_[0]; pss[1] = sp_[64]; pss[2] = sp_[128]; pss[3] = sp_[192]; } } while (0)
#define PSI_LOADX(u_, hp_) do { const int t0_ = (r32 * 4 + (u_)) * 64; \
        _Pragma("unroll") for (int y = 0; y < 2; ++y) { const int e = tid_p + 512 * y; const int xr = e >> 3, p = e & 7; const int hl = 2 * (hp_) + (xr >> 6), pp = xr & 63; \
            px[2 * (hp_) + y] = *(const GAS u32x4*)(raw + (rowb + t0_ + pp) * CONV_CH + 3072 + (g * 8 + hl) * 64 + p * 8); } } while (0)
#define PSI_PUTX(hp_) do { _Pragma("unroll") for (int y = 0; y < 2; ++y) { const int e = tid_p + 512 * y; const int xr = e >> 3, p = e & 7; *(LAS u32x4*)(xT + xr * 72 + p * 8) = px[2 * (hp_) + y]; } } while (0)
    PSI_LOADBC(0); PSI_LOADX(0, 0); PSI_LOADX(0, 1); PSI_LOADX(0, 2); PSI_LOADX(0, 3);
    for (int u = 0; u < 4; ++u) {
        int tid = tid_p; asm volatile("" : "+v"(tid));
        const int lane = tid & 63, wave = __builtin_amdgcn_readfirstlane(tid >> 6), fr = lane & 15, fq = lane >> 4;
        const int c = r32 * 4 + u, t0 = c * 64;
#pragma unroll
        for (int x = 0; x < 4; ++x) { const int e = tid_p + 512 * x; const int r = e >> 5, p = e & 31;
            *(LAS u32x4*)((p < 16 ? Bm + r * 136 + p * 8 : Cm + r * 136 + (p - 16) * 8)) = pbc[x]; }
        { const int i = lane; LAS float* s = sc + wave * 256; s[i] = pss[0]; s[64 + i] = pss[1] * 1.4426950408889634f; s[128 + i] = pss[2]; s[192 + i] = pss[3] * 1.4426950408889634f; }
        PSI_PUTX(0);
        if (u + 1 < 4) PSI_LOADBC(u + 1);
        __syncthreads();
        { const int mt = wave & 3, nh = wave >> 2;
          f32x4 acc[1][2]; acc[0][0] = acc[0][1] = (f32x4){0.f, 0.f, 0.f, 0.f};
          mma_lds<1, 2>(acc, Cm, 136, mt * 16, Bm, 136, nh * 32, 128, fr, fq);
#pragma unroll
          for (int nl = 0; nl < 2; ++nl)
#pragma unroll
              for (int r = 0; r < 4; ++r) cb[(mt * 16 + 4 * fq + r) * 68 + nh * 32 + nl * 16 + fr] = acc[0][nl][r]; }
#pragma unroll
        for (int hp = 0; hp < 4; ++hp) {
            __syncthreads();
            if (u + 1 < 4) PSI_LOADX(u + 1, hp);
            { const int e = tid >> 8, i = (tid >> 2) & 63, jq = tid & 3; const int hl = 2 * hp + e;
              const LAS float* s = sc + hl * 256; const float Dh = Dp[g * 8 + hl];
              const float csfi = s[64 + i], csbi = s[192 + i], dsum = s[i] + s[128 + i];
#pragma unroll
              for (int jj = 0; jj < 16; jj += 2) { float m2[2];
#pragma unroll
                  for (int y = 0; y < 2; ++y) { const int j = jq * 16 + jj + y; const float cbv = cb[i * 68 + j];
                      const float cfj = s[64 + j], cbj = s[192 + j], dfj = s[j], dbj = s[128 + j];
                      const float arg = (i > j) ? csfi - cfj : csbi - cbj;
                      const float dtj = (i > j) ? dfj : dbj;
                      const float w = (i == j) ? dsum : __builtin_amdgcn_exp2f(fminf(arg, 0.f)) * dtj;
                      m2[y] = cbv * w + ((i == j) ? Dh : 0.f); }
                  *(LAS unsigned*)(Mm + (e * 64 + i) * 72 + jq * 16 + jj) = pkbf(m2[0], m2[1]); } }
            __syncthreads();
            { const int e = wave >> 2, mt = wave & 3;
              f32x4 acc[1][4];
#pragma unroll
              for (int nt = 0; nt < 4; ++nt) acc[0][nt] = (f32x4){0.f, 0.f, 0.f, 0.f};
              mma_lds<1, 4>(acc, xT + e * 64 * 72, 72, mt * 16, Mm + e * 64 * 72, 72, 0, 64, fr, fq);
#pragma unroll
              for (int nt = 0; nt < 4; ++nt) { u32x2 w; w.x = pkbf(acc[0][nt][0], acc[0][nt][1]); w.y = pkbf(acc[0][nt][2], acc[0][nt][3]);
                  *(LAS u32x2*)(yst + (nt * 16 + fr) * 136 + e * 64 + mt * 16 + 4 * fq) = w; } }
            __syncthreads();
            if (hp < 3) PSI_PUTX(hp + 1);
            for (int e = tid; e < 64 * 16; e += 512) { const int i = e >> 4, p = e & 15;
                *(GAS u32x4*)(yi + (rowb + t0 + i) * 1024 + (g * 8 + 2 * hp) * 64 + p * 8) = *(const LAS u32x4*)(yst + i * 136 + p * 8); }
        }
        __syncthreads();
    }
#undef PSI_LOADBC
#undef PSI_LOADX
#undef PSI_PUTX
}

namespace ss2 {
constexpr int CO = 0;
constexpr int BO = CO + 64 * 132 * 2;
constexpr int XO = BO + 64 * 132 * 2;
constexpr int SCO = XO + 64 * 72 * 2;
constexpr int BUF = SCO + 768;
constexpr int OST = 2 * BUF;
constexpr int END = OST + 2 * 64 * 72 * 2;
static_assert(END <= MISC_OFF && BUF % 16 == 0, "ssd state LDS map");
}
template <int DIR>
__device__ __forceinline__ void ssd_state2(LAS unsigned char* lds, int b, int hd, const bf16* raw, const float* ssc, bf16* ys, int tid, int wave, int lane) {
    using namespace ss2;
    const size_t rowb = (size_t)b * SEQ; const int g = hd >> 3;
    LAS bf16* ost = (LAS bf16*)(lds + OST);
    const int r31 = lane & 31, hh = lane >> 5;
    if (wave == 4 || wave == 5) {
        for (int n = 0; n < NCHUNK + 1; ++n) WG_BAR();
    } else if (wave >= 2) {
        const int hw = (wave & 1) | ((wave >> 2) << 1); const int ht = hw * 64 + lane;
        unsigned go[10], lo_[10]; u32x4 ld[10]; float sr0 = 0.f, sr1 = 0.f;
#pragma unroll
        for (int x = 0; x < 4; ++x) { const int e = ht + 256 * x, r = e >> 4, p = e & 15;
            go[x] = (unsigned)((r * CONV_CH + 4352 + g * 128 + p * 8) * 2); go[4 + x] = (unsigned)((r * CONV_CH + 4096 + g * 128 + p * 8) * 2);
            lo_[x] = (unsigned)(CO + (r * 132 + p * 8) * 2); lo_[4 + x] = (unsigned)(BO + (r * 132 + p * 8) * 2); }
#pragma unroll
        for (int x = 0; x < 2; ++x) { const int e = ht + 256 * x, xr = e >> 3, p = e & 7;
            go[8 + x] = (unsigned)((xr * CONV_CH + 3072 + hd * 64 + p * 8) * 2); lo_[8 + x] = (unsigned)(XO + (xr * 72 + p * 8) * 2); }
#define SS2_ISSUE(c_) do { const GAS char* rb_ = (const GAS char*)(raw + (rowb + (size_t)(c_) * 64) * CONV_CH); \
            _Pragma("unroll") for (int x = 0; x < 10; ++x) ld[x] = *(const GAS u32x4*)(rb_ + go[x]); \
            if (hw == 0) { const float* sp_ = ssc + ((size_t)((b * 16 + hd) * NCHUNK + (c_))) * 256 + DIR * 128 + lane; sr0 = sp_[0]; sr1 = sp_[64]; } } while (0)
#define SS2_COMMIT(bi_, c_) do { LAS unsigned char* B_ = lds + (bi_) * BUF; \
            _Pragma("unroll") for (int x = 0; x < 10; ++x) { LAS unsigned char* d_ = B_ + lo_[x]; *(LAS u32x2*)(d_) = (u32x2){ld[x].x, ld[x].y}; *(LAS u32x2*)(d_ + 8) = (u32x2){ld[x].z, ld[x].w}; } \
            if (hw == 0) { LAS float* sc_ = (LAS float*)(B_ + SCO); const int i = lane; const float cs = sr1; const float cl = __shfl(cs, DIR ? 0 : 63); \
                sc_[i] = __expf(cs); sc_[64 + i] = sr0 * __expf(cl - cs); if (i == 0) sc_[128] = __expf(cl); } } while (0)
        { const int c0 = DIR ? NCHUNK - 1 : 0; SS2_ISSUE(c0); SS2_COMMIT(0, c0); SS2_ISSUE((DIR ? c0 - 1 : c0 + 1)); }
        for (int n = 0; n < NCHUNK; ++n) {
            const int c = DIR ? NCHUNK - 1 - n : n;
            WG_BAR();
            const bool more = n + 1 < NCHUNK; const int cn = DIR ? c - 1 : c + 1;
            if (more) { SS2_COMMIT((n + 1) & 1, cn); if (n + 2 < NCHUNK) SS2_ISSUE((DIR ? cn - 1 : cn + 1)); }
            unsigned ov[8];
            if (n > 0) {
#pragma unroll
                for (int x = 0; x < 8; ++x) ov[x] = *(const LAS unsigned*)(ost + ((n - 1) & 1) * (64 * 72) + (hw * 16 + 2 * x + (lane >> 5)) * 72 + 2 * (lane & 31));
            }
            if (n > 0) { const int tp = (DIR ? c + 1 : c - 1) * 64;
#pragma unroll
                for (int x = 0; x < 8; ++x) { GAS char* ob_ = (GAS char*)(ys + (rowb + tp + hw * 16 + 2 * x) * 1024 + hd * 64);
                    (void)__builtin_amdgcn_global_atomic_fadd_v2bf16((GAS s16x2*)(ob_ + (lane >> 5) * 2048 + (lane & 31) * 4), __builtin_bit_cast(s16x2, ov[x])); } }
        }
        WG_BAR();
        { const int tp = (DIR ? 0 : NCHUNK - 1) * 64;
#pragma unroll
          for (int x = 0; x < 8; ++x) { const unsigned v = *(const LAS unsigned*)(ost + ((NCHUNK - 1) & 1) * (64 * 72) + (hw * 16 + 2 * x + (lane >> 5)) * 72 + 2 * (lane & 31));
              GAS char* ob_ = (GAS char*)(ys + (rowb + tp + hw * 16 + 2 * x) * 1024 + hd * 64);
              (void)__builtin_amdgcn_global_atomic_fadd_v2bf16((GAS s16x2*)(ob_ + (lane >> 5) * 2048 + (lane & 31) * 4), __builtin_bit_cast(s16x2, v)); } }
#undef SS2_ISSUE
#undef SS2_COMMIT
    } else {
        const int ps = wave; const int xrow = ps * 32 + r31;
        f32x16 Ht[4];
#pragma unroll
        for (int t = 0; t < 4; ++t)
#pragma unroll
            for (int r = 0; r < 16; ++r) Ht[t][r] = 0.f;
        for (int n = 0; n < NCHUNK; ++n) {
            WG_BAR();
            const LAS unsigned char* Bb = lds + (n & 1) * BUF;
            const LAS bf16* Cb = (const LAS bf16*)(Bb + CO); const LAS bf16* Bmb = (const LAS bf16*)(Bb + BO); const LAS bf16* Xb = (const LAS bf16*)(Bb + XO);
            const LAS float* sc = (const LAS float*)(Bb + SCO);
            f32x16 aY[2];
#pragma unroll
            for (int m = 0; m < 2; ++m)
#pragma unroll
                for (int r = 0; r < 16; ++r) aY[m][r] = 0.f;
            bf16x8 fa[2][2];
            const int offc = r31 * 132 + 4 * hh;
#define SS2_LD2(bi_, ks_) do { fa[bi_][0] = afrag(Cb + offc + 16 * (ks_)); fa[bi_][1] = afrag(Cb + offc + 32 * 132 + 16 * (ks_)); } while (0)
            SS2_LD2(0, 0);
#pragma unroll
            for (int ks = 0; ks < 8; ++ks) {
                if (ks < 7) SS2_LD2((ks + 1) & 1, ks + 1);
                __builtin_amdgcn_sched_barrier(0);
                const bf16x8 bs = cvt8(Ht[ks >> 1], 8 * (ks & 1));
                aY[0] = MFMA32(fa[ks & 1][0], bs, aY[0]); aY[1] = MFMA32(fa[ks & 1][1], bs, aY[1]);
                __builtin_amdgcn_sched_barrier(0); }
#undef SS2_LD2
            const int i16 = r31 & 15; const LAS bf16* bp = Bmb + (8 * hh + (i16 >> 2)) * 132 + 16 * (r31 >> 4) + 4 * (i16 & 3);
            bf16x8 xf[4];
#pragma unroll
            for (int kt = 0; kt < 4; ++kt) { const bf16x8 xv = *(const LAS bf16x8*)(Xb + xrow * 72 + 16 * kt + 8 * hh);
                const f32x4 w0 = *(const LAS f32x4*)(sc + 64 + 16 * kt + 8 * hh), w1 = *(const LAS f32x4*)(sc + 64 + 16 * kt + 8 * hh + 4);
                u32x4 w; w.x = pkbf(bf2f_s(xv[0]) * w0[0], bf2f_s(xv[1]) * w0[1]); w.y = pkbf(bf2f_s(xv[2]) * w0[2], bf2f_s(xv[3]) * w0[3]);
                w.z = pkbf(bf2f_s(xv[4]) * w1[0], bf2f_s(xv[5]) * w1[1]); w.w = pkbf(bf2f_s(xv[6]) * w1[2], bf2f_s(xv[7]) * w1[3]);
                xf[kt] = __builtin_bit_cast(bf16x8, w); }
            bf16x8 fb[2][4];
#define SS2_LDBT(bi_, t_) do { _Pragma("unroll") for (int kt = 0; kt < 4; ++kt) { const LAS bf16* p_ = bp + (16 * kt) * 132 + 32 * (t_); \
                const v4i16_t lo_ = __builtin_amdgcn_ds_read_tr16_b64_v4i16((LAS v4i16_t*)p_), hi_ = __builtin_amdgcn_ds_read_tr16_b64_v4i16((LAS v4i16_t*)(p_ + 4 * 132)); \
                fb[bi_][kt] = (bf16x8){lo_[0], lo_[1], lo_[2], lo_[3], hi_[0], hi_[1], hi_[2], hi_[3]}; } } while (0)
            SS2_LDBT(0, 0);
#pragma unroll
            for (int m = 0; m < 2; ++m)
#pragma unroll
                for (int q4 = 0; q4 < 4; ++q4) { const f32x4 ec = *(const LAS f32x4*)(sc + 32 * m + 8 * q4 + 4 * hh);
#pragma unroll
                    for (int x = 0; x < 4; ++x) aY[m][4 * q4 + x] *= ec[x]; }
            const float ecl = sc[128];
#pragma unroll
            for (int mi = 0; mi < 2; ++mi)
#pragma unroll
                for (int r = 0; r < 16; ++r) ost[(n & 1) * (64 * 72) + (32 * mi + (r & 3) + 8 * (r >> 2) + 4 * hh) * 72 + ps * 32 + r31] = f2bf1(aY[mi][r]);
#pragma unroll
            for (int t = 0; t < 4; ++t) {
                if (t < 3) SS2_LDBT((t + 1) & 1, t + 1);
                __builtin_amdgcn_sched_barrier(0);
#pragma unroll
                for (int r = 0; r < 16; ++r) Ht[t][r] *= ecl;
                Ht[t] = MFMA32(fb[t & 1][0], xf[0], Ht[t]); Ht[t] = MFMA32(fb[t & 1][1], xf[1], Ht[t]);
                Ht[t] = MFMA32(fb[t & 1][2], xf[2], Ht[t]); Ht[t] = MFMA32(fb[t & 1][3], xf[3], Ht[t]);
                __builtin_amdgcn_sched_barrier(0); }
#undef SS2_LDBT
        }
        WG_BAR();
    }
}
#ifndef GS3_LDK
#define GS3_LDK 136
#endif
namespace gs3 {
constexpr int LDK = GS3_LDK, LDT = 72;
constexpr int KO = 0;
constexpr int QO = KO + 64 * LDK * 2;
constexpr int VTO = QO + 64 * LDK * 2;
constexpr int TO = VTO + 64 * LDT * 2;
constexpr int QKO = TO + 64 * LDT * 2;
constexpr int SCO = QKO + 64 * LDT * 2;
constexpr int BUF = SCO + 1024;
constexpr int OST = 2 * BUF;
constexpr int END = OST + 2 * 64 * 72 * 2;
static_assert(END <= MISC_OFF && BUF % 16 == 0, "gdn state3 LDS map");
}
__device__ __forceinline__ bf16x8 pack2(const f32x4& a, const f32x4& b) {
    u32x4 w; w.x = pkbf(a[0], a[1]); w.y = pkbf(a[2], a[3]); w.z = pkbf(b[0], b[1]); w.w = pkbf(b[2], b[3]);
    return __builtin_bit_cast(bf16x8, w);
}
__device__ __forceinline__ bf16x8 afrag16(const LAS bf16* p) {
    const bf16x4 lo = *(const LAS bf16x4*)p, hi = *(const LAS bf16x4*)(p + 16);
    return (bf16x8){lo[0], lo[1], lo[2], lo[3], hi[0], hi[1], hi[2], hi[3]};
}
__device__ __forceinline__ bf16x8 afrag16_tr(const LAS bf16* p, int ld) {
    const v4i16_t lo = __builtin_amdgcn_ds_read_tr16_b64_v4i16((LAS v4i16_t*)p), hi = __builtin_amdgcn_ds_read_tr16_b64_v4i16((LAS v4i16_t*)(p + 16 * ld));
    return (bf16x8){lo[0], lo[1], lo[2], lo[3], hi[0], hi[1], hi[2], hi[3]};
}
#define MFMA16(a, b, c) __builtin_amdgcn_mfma_f32_16x16x32_bf16((a), (b), (c), 0, 0, 0)

constexpr int CW_OFLAG = 16384;
__device__ __forceinline__ void store16_wt(bf16* p, u32x4 v) { asm volatile("global_store_dwordx4 %0, %1, off sc1\n\ts_nop 1" :: "v"(p), "v"(v) : "memory"); }
__device__ __forceinline__ void out_rows(const LAS bf16* ostb, bf16* gbase  , int lane, bool second) {
#pragma unroll
    for (int x = 0; x < 2; ++x) { const int r = 8 * x + (lane >> 3), pc = lane & 7;
        const u32x4 ov = *(const LAS u32x4*)(ostb + r * 72 + pc * 8); bf16* gp = gbase + (size_t)r * 1024 + pc * 8;
        if (!second) store16_wt(gp, ov);
        else { const u32x4 gv = *(const GAS u32x4*)gp; u32x4 o;
            o.x = pkbf(__uint_as_float(ov.x << 16) + __uint_as_float(gv.x << 16), __uint_as_float(ov.x & 0xffff0000u) + __uint_as_float(gv.x & 0xffff0000u));
            o.y = pkbf(__uint_as_float(ov.y << 16) + __uint_as_float(gv.y << 16), __uint_as_float(ov.y & 0xffff0000u) + __uint_as_float(gv.y & 0xffff0000u));
            o.z = pkbf(__uint_as_float(ov.z << 16) + __uint_as_float(gv.z << 16), __uint_as_float(ov.z & 0xffff0000u) + __uint_as_float(gv.z & 0xffff0000u));
            o.w = pkbf(__uint_as_float(ov.w << 16) + __uint_as_float(gv.w << 16), __uint_as_float(ov.w & 0xffff0000u) + __uint_as_float(gv.w & 0xffff0000u));
            *(GAS u32x4*)gp = o; } }
}
__device__ __forceinline__ void out_handshake(unsigned* flags, int mine, int partner, int hw, int lane) {
    asm volatile("s_waitcnt vmcnt(0)" ::: "memory");
    if (lane == 0) { __hip_atomic_store(flags + (mine * 4 + hw) * 16, 1u, __ATOMIC_RELAXED, __HIP_MEMORY_SCOPE_AGENT);
        unsigned sp = 0;
        while (__hip_atomic_load(flags + (partner * 4 + hw) * 16, __ATOMIC_RELAXED, __HIP_MEMORY_SCOPE_AGENT) == 0u) { __builtin_amdgcn_s_sleep(2); if (++sp > (1u << 22)) break; } }
    __builtin_amdgcn_fence(__ATOMIC_ACQUIRE, "agent");
    asm volatile("s_waitcnt vmcnt(0)" ::: "memory");
}

template <int DIR, int XP = 0>
__device__ __forceinline__ void gdn_state3(LAS unsigned char* lds, int b, int h, int half, const bf16* raw, const float* scal, const bf16* TQ, bf16* og, int tid, int wave, int lane, unsigned* flags, int cid) {
    using namespace gs3;
    const size_t rowb = (size_t)b * SEQ; const int bh = b * 8 + h;
    LAS bf16* ost = (LAS bf16*)(lds + OST);
    const int fr = lane & 15, fq = lane >> 4;
    if (wave >= 4) {
        const int hw = wave - 4; const int ht = hw * 64 + lane;
        unsigned go[14], lo_[14]; u32x4 ld[14]; float sr0 = 0.f, sr1 = 0.f;
#pragma unroll
        for (int x = 0; x < 4; ++x) { const int e = ht + 256 * x, r = e >> 4, p = e & 15;
            go[x] = (unsigned)((r * CONV_CH + 1024 + h * 128 + p * 8) * 2); go[4 + x] = (unsigned)((r * CONV_CH + h * 128 + p * 8) * 2);
            lo_[x] = (unsigned)(KO + (r * LDK + p * 8) * 2); lo_[4 + x] = (unsigned)(QO + (r * LDK + p * 8) * 2); }
#pragma unroll
        for (int x = 0; x < 2; ++x) { const int e = ht + 256 * x, dvl = e >> 3, p = e & 7; const int dv = 64 * half + dvl;
            go[8 + x] = (unsigned)(((dv >> 1) * CONV_CH + 2048 + h * 128 + (dv & 1) * 64 + p * 8) * 2); lo_[8 + x] = (unsigned)(VTO + (dvl * LDT + p * 8) * 2); }
        u32x4 km[2], dg[2], qm[2];
#pragma unroll
        for (int x = 0; x < 2; ++x) { const int e = ht + 256 * x, i = e >> 3, p = e & 7;
            go[10 + x] = (unsigned)(e * 16); go[12 + x] = (unsigned)(8192 + e * 16);
            lo_[10 + x] = (unsigned)(TO + (i * LDT + p * 8) * 2); lo_[12 + x] = (unsigned)(QKO + (i * LDT + p * 8) * 2);
            unsigned kw[4], dw[4], qw[4];
#pragma unroll
            for (int w = 0; w < 4; ++w) { const int j0 = p * 8 + 2 * w, j1 = j0 + 1;
                const bool k0 = DIR ? (i < j0) : (i > j0), k1 = DIR ? (i < j1) : (i > j1);
                kw[w] = (k0 ? 0xFFFFu : 0u) | (k1 ? 0xFFFF0000u : 0u); dw[w] = (i == j0 ? 0x3F80u : 0u) | (i == j1 ? 0x3F800000u : 0u);
                qw[w] = kw[w] | (i == j0 ? 0xFFFFu : 0u) | (i == j1 ? 0xFFFF0000u : 0u); }
            km[x] = (u32x4){kw[0], kw[1], kw[2], kw[3]}; dg[x] = (u32x4){dw[0], dw[1], dw[2], dw[3]}; qm[x] = (u32x4){qw[0], qw[1], qw[2], qw[3]}; }
        const unsigned so_l = (unsigned)(lane * 256 + (DIR * 8 + h) * 4);
#define GS3_ISSUE(c_) do { const GAS char* rb_ = (const GAS char*)(raw + (rowb + (size_t)(c_) * 64) * CONV_CH); const GAS char* tb_ = (const GAS char*)(TQ + ((size_t)(bh * NCHUNK + (c_))) * 8192); \
            _Pragma("unroll") for (int x = 0; x < 10; ++x) ld[x] = *(const GAS u32x4*)(rb_ + go[x]); \
            _Pragma("unroll") for (int x = 10; x < 14; ++x) ld[x] = *(const GAS u32x4*)(tb_ + go[x]); \
            if (hw == 0) { const GAS char* sb_ = (const GAS char*)(scal + (rowb + (size_t)(c_) * 64) * 64); sr0 = *(const GAS float*)(sb_ + so_l); sr1 = *(const GAS float*)(sb_ + so_l + 64); } } while (0)
#define GS3_COMMIT(bi_, c_) do { LAS unsigned char* B_ = lds + (bi_) * BUF; \
            _Pragma("unroll") for (int x = 0; x < 10; ++x) *(LAS u32x4*)(B_ + lo_[x]) = ld[x]; \
            _Pragma("unroll") for (int x = 0; x < 2; ++x) { *(LAS u32x4*)(B_ + lo_[10 + x]) = (ld[10 + x] & km[x]) | dg[x]; *(LAS u32x4*)(B_ + lo_[12 + x]) = ld[12 + x] & qm[x]; } \
            if (hw == 0) { LAS float* sc_ = (LAS float*)(B_ + SCO); const int i = lane; const float gc = sr1; const float gl = __shfl(gc, DIR ? 0 : 63); \
                sc_[i] = sr0; sc_[64 + i] = __expf(gc); sc_[128 + i] = __expf(gl - gc); if (i == 0) sc_[192] = __expf(gl); } } while (0)
        { const int c0 = DIR ? NCHUNK - 1 : 0; GS3_ISSUE(c0); GS3_COMMIT(0, c0); GS3_ISSUE((DIR ? c0 - 1 : c0 + 1)); }
        for (int n = 0; n < NCHUNK; ++n) {
            const int c = DIR ? NCHUNK - 1 - n : n;
            WG_BAR();
            const bool more = n + 1 < NCHUNK; const int cn = DIR ? c - 1 : c + 1;
            if (more) { GS3_COMMIT((n + 1) & 1, cn); if (n + 2 < NCHUNK && (!(XP & 2) || n < 2)) GS3_ISSUE((DIR ? cn - 1 : cn + 1)); }
            if (n > 0 && !(XP & 1)) { const int tp = (DIR ? c + 1 : c - 1) * 64;
#pragma unroll
                for (int x = 0; x < 8; ++x) { const unsigned v = *(const LAS unsigned*)(ost + ((n - 1) & 1) * (64 * 72) + (hw * 16 + 2 * x + (lane >> 5)) * 72 + 2 * (lane & 31));
                    GAS char* ob_ = (GAS char*)(og + (rowb + tp + hw * 16 + 2 * x) * 1024 + h * 128 + half * 64);
                    (void)__builtin_amdgcn_global_atomic_fadd_v2bf16((GAS s16x2*)(ob_ + (lane >> 5) * 2048 + (lane & 31) * 4), __builtin_bit_cast(s16x2, v)); } }
        }
        WG_BAR();
        { const int tp = (DIR ? 0 : NCHUNK - 1) * 64;
#pragma unroll
          for (int x = 0; x < 8; ++x) { const unsigned v = *(const LAS unsigned*)(ost + ((NCHUNK - 1) & 1) * (64 * 72) + (hw * 16 + 2 * x + (lane >> 5)) * 72 + 2 * (lane & 31));
              GAS char* ob_ = (GAS char*)(og + (rowb + tp + hw * 16 + 2 * x) * 1024 + h * 128 + half * 64);
              (void)__builtin_amdgcn_global_atomic_fadd_v2bf16((GAS s16x2*)(ob_ + (lane >> 5) * 2048 + (lane & 31) * 4), __builtin_bit_cast(s16x2, v)); } }
#undef GS3_ISSUE
#undef GS3_COMMIT
    } else {
        const int dv0 = 16 * wave;
        f32x4 St[8];
#pragma unroll
        for (int t = 0; t < 8; ++t) St[t] = (f32x4){0.f, 0.f, 0.f, 0.f};
        for (int n = 0; n < NCHUNK; ++n) {
            WG_BAR();
            const LAS unsigned char* Bb = lds + (n & 1) * BUF;
            const LAS bf16* Kb = (const LAS bf16*)(Bb + KO); const LAS bf16* Qb = (const LAS bf16*)(Bb + QO); const LAS bf16* Vb = (const LAS bf16*)(Bb + VTO);
            const LAS bf16* Tb = (const LAS bf16*)(Bb + TO); const LAS bf16* QKb = (const LAS bf16*)(Bb + QKO); const LAS float* sc = (const LAS float*)(Bb + SCO);
            const int offa = fr * LDK + 4 * fq, offt = fr * LDT + 4 * fq;
            bf16x8 bS[4];
#pragma unroll
            for (int ks = 0; ks < 4; ++ks) bS[ks] = pack2(St[2 * ks], St[2 * ks + 1]);
            f32x4 aK[4];
#pragma unroll
            for (int m = 0; m < 4; ++m) aK[m] = (f32x4){0.f, 0.f, 0.f, 0.f};
#pragma unroll
            for (int ks = 0; ks < 4; ++ks) { bf16x8 fa[4];
#pragma unroll
                for (int m = 0; m < 4; ++m) fa[m] = afrag16(Kb + offa + 16 * m * LDK + 32 * ks);
#pragma unroll
                for (int m = 0; m < 4; ++m) aK[m] = MFMA16(fa[m], bS[ks], aK[m]); }
            bf16x8 ft[8];
#pragma unroll
            for (int mi = 0; mi < 4; ++mi)
#pragma unroll
                for (int kt = 0; kt < 2; ++kt) { const bool need = DIR ? (kt >= (mi >> 1)) : (kt <= (mi >> 1));
                    if (need) ft[mi * 2 + kt] = afrag16(Tb + offt + 16 * mi * LDT + 32 * kt); }
#pragma unroll
            for (int m = 0; m < 4; ++m) { const int tb = 16 * m + 4 * fq;
                const bf16x4 vv = *(const LAS bf16x4*)(Vb + (dv0 + fr) * LDT + tb); const f32x4 be = *(const LAS f32x4*)(sc + tb), eg = *(const LAS f32x4*)(sc + 64 + tb);
#pragma unroll
                for (int e = 0; e < 4; ++e) aK[m][e] = be[e] * (bf2f_s(vv[e]) - eg[e] * aK[m][e]); }
            const bf16x8 br0 = pack2(aK[0], aK[1]), br1 = pack2(aK[2], aK[3]);
            f32x4 au[4];
#pragma unroll
            for (int m = 0; m < 4; ++m) au[m] = (f32x4){0.f, 0.f, 0.f, 0.f};
#pragma unroll
            for (int mi = 0; mi < 4; ++mi)
#pragma unroll
                for (int kt = 0; kt < 2; ++kt) { const bool need = DIR ? (kt >= (mi >> 1)) : (kt <= (mi >> 1));
                    if (need) au[mi] = MFMA16(ft[mi * 2 + kt], (kt == 0 ? br0 : br1), au[mi]); }
            f32x4 aQ[4];
            if constexpr (!(XP & 4)) {
#pragma unroll
            for (int m = 0; m < 4; ++m) aQ[m] = (f32x4){0.f, 0.f, 0.f, 0.f};
#pragma unroll
            for (int ks = 0; ks < 4; ++ks) { bf16x8 fa[4];
#pragma unroll
                for (int m = 0; m < 4; ++m) fa[m] = afrag16(Qb + offa + 16 * m * LDK + 32 * ks);
#pragma unroll
                for (int m = 0; m < 4; ++m) aQ[m] = MFMA16(fa[m], bS[ks], aQ[m]); }
            bf16x8 fqk[8];
#pragma unroll
            for (int mi = 0; mi < 4; ++mi)
#pragma unroll
                for (int kt = 0; kt < 2; ++kt) { const bool need = DIR ? (kt >= (mi >> 1)) : (kt <= (mi >> 1));
                    if (need) fqk[mi * 2 + kt] = afrag16(QKb + offt + 16 * mi * LDT + 32 * kt); }
            const bf16x8 bu0 = pack2(au[0], au[1]), bu1 = pack2(au[2], au[3]);
#pragma unroll
            for (int m = 0; m < 4; ++m) { const int tb = 16 * m + 4 * fq; const f32x4 eg = *(const LAS f32x4*)(sc + 64 + tb);
#pragma unroll
                for (int e = 0; e < 4; ++e) { aQ[m][e] *= eg[e]; } }
#pragma unroll
            for (int mi = 0; mi < 4; ++mi)
#pragma unroll
                for (int kt = 0; kt < 2; ++kt) { const bool need = DIR ? (kt >= (mi >> 1)) : (kt <= (mi >> 1));
                    if (need) aQ[mi] = MFMA16(fqk[mi * 2 + kt], (kt == 0 ? bu0 : bu1), aQ[mi]); }
#pragma unroll
            for (int m = 0; m < 4; ++m)
#pragma unroll
                for (int e = 0; e < 4; ++e) ost[(n & 1) * (64 * 72) + (16 * m + 4 * fq + e) * 72 + dv0 + fr] = f2bf1(aQ[m][e]);
            }
#pragma unroll
            for (int m = 0; m < 4; ++m) { const int tb = 16 * m + 4 * fq; const f32x4 ek = *(const LAS f32x4*)(sc + 128 + tb);
#pragma unroll
                for (int e = 0; e < 4; ++e) { au[m][e] *= ek[e]; } }
            const bf16x8 bd0 = pack2(au[0], au[1]), bd1 = pack2(au[2], au[3]);
            const float egl = sc[192];
            { const LAS bf16* kp = Kb + (4 * fq + (fr >> 2)) * LDK + 4 * (fr & 3);
#pragma unroll
              for (int t = 0; t < 8; ++t) { const bf16x8 f0 = afrag16_tr(kp + 16 * t, LDK), f1 = afrag16_tr(kp + 32 * LDK + 16 * t, LDK);
                  St[t] = St[t] * egl; St[t] = MFMA16(f0, bd0, St[t]); St[t] = MFMA16(f1, bd1, St[t]); } }
        }
        WG_BAR();
    }
}

namespace ss3 {
constexpr int LDK = GS3_LDK, LDT = 72;
constexpr int CO = 0;
constexpr int BO = CO + 64 * LDK * 2;
constexpr int XO = BO + 64 * LDK * 2;
constexpr int SCO = XO + 64 * LDT * 2;
constexpr int BUF = SCO + 768;
constexpr int OST = 2 * BUF;
constexpr int END = OST + 2 * 64 * 72 * 2;
static_assert(END <= MISC_OFF && BUF % 16 == 0, "ssd state3 LDS map");
}
template <int DIR, int XP = 0>
__device__ __forceinline__ void ssd_state3(LAS unsigned char* lds, int b, int hd, const bf16* raw, const float* ssc, bf16* ys, int tid, int wave, int lane, unsigned* flags, int cid) {
    using namespace ss3;
    const size_t rowb = (size_t)b * SEQ; const int g = hd >> 3;
    LAS bf16* ost = (LAS bf16*)(lds + OST);
    const int fr = lane & 15, fq = lane >> 4;
    if (wave >= 4) {
        const int hw = wave - 4; const int ht = hw * 64 + lane;
        unsigned go[10], lo_[10]; u32x4 ld[10]; float sr0 = 0.f, sr1 = 0.f;
#pragma unroll
        for (int x = 0; x < 4; ++x) { const int e = ht + 256 * x, r = e >> 4, p = e & 15;
            go[x] = (unsigned)((r * CONV_CH + 4352 + g * 128 + p * 8) * 2); go[4 + x] = (unsigned)((r * CONV_CH + 4096 + g * 128 + p * 8) * 2);
            lo_[x] = (unsigned)(CO + (r * LDK + p * 8) * 2); lo_[4 + x] = (unsigned)(BO + (r * LDK + p * 8) * 2); }
#pragma unroll
        for (int x = 0; x < 2; ++x) { const int e = ht + 256 * x, xr = e >> 3, p = e & 7;
            go[8 + x] = (unsigned)((xr * CONV_CH + 3072 + hd * 64 + p * 8) * 2); lo_[8 + x] = (unsigned)(XO + (xr * LDT + p * 8) * 2); }
#define SS3_ISSUE(c_) do { const GAS char* rb_ = (const GAS char*)(raw + (rowb + (size_t)(c_) * 64) * CONV_CH); \
            _Pragma("unroll") for (int x = 0; x < 10; ++x) ld[x] = *(const GAS u32x4*)(rb_ + go[x]); \
            if (hw == 0) { const float* sp_ = ssc + ((size_t)((b * 16 + hd) * NCHUNK + (c_))) * 256 + DIR * 128 + lane; sr0 = sp_[0]; sr1 = sp_[64]; } } while (0)
#define SS3_COMMIT(bi_, c_) do { LAS unsigned char* B_ = lds + (bi_) * BUF; \
            _Pragma("unroll") for (int x = 0; x < 10; ++x) *(LAS u32x4*)(B_ + lo_[x]) = ld[x]; \
            if (hw == 0) { LAS float* sc_ = (LAS float*)(B_ + SCO); const int i = lane; const float cs = sr1; const float cl = __shfl(cs, DIR ? 0 : 63); \
                sc_[i] = __expf(cs); sc_[64 + i] = sr0 * __expf(cl - cs); if (i == 0) sc_[128] = __expf(cl); } } while (0)
        { const int c0 = DIR ? NCHUNK - 1 : 0; SS3_ISSUE(c0); SS3_COMMIT(0, c0); SS3_ISSUE((DIR ? c0 - 1 : c0 + 1)); }
        for (int n = 0; n < NCHUNK; ++n) {
            const int c = DIR ? NCHUNK - 1 - n : n;
            WG_BAR();
            const bool more = n + 1 < NCHUNK; const int cn = DIR ? c - 1 : c + 1;
            if (more) { SS3_COMMIT((n + 1) & 1, cn); if (n + 2 < NCHUNK && (!(XP & 2) || n < 2)) SS3_ISSUE((DIR ? cn - 1 : cn + 1)); }
            if (n > 0 && !(XP & 1)) { const int tp = (DIR ? c + 1 : c - 1) * 64;
#pragma unroll
                for (int x = 0; x < 8; ++x) { const unsigned v = *(const LAS unsigned*)(ost + ((n - 1) & 1) * (64 * 72) + (hw * 16 + 2 * x + (lane >> 5)) * 72 + 2 * (lane & 31));
                    GAS char* ob_ = (GAS char*)(ys + (rowb + tp + hw * 16 + 2 * x) * 1024 + hd * 64);
                    (void)__builtin_amdgcn_global_atomic_fadd_v2bf16((GAS s16x2*)(ob_ + (lane >> 5) * 2048 + (lane & 31) * 4), __builtin_bit_cast(s16x2, v)); } }
        }
        WG_BAR();
        { const int tp = (DIR ? 0 : NCHUNK - 1) * 64;
#pragma unroll
          for (int x = 0; x < 8; ++x) { const unsigned v = *(const LAS unsigned*)(ost + ((NCHUNK - 1) & 1) * (64 * 72) + (hw * 16 + 2 * x + (lane >> 5)) * 72 + 2 * (lane & 31));
              GAS char* ob_ = (GAS char*)(ys + (rowb + tp + hw * 16 + 2 * x) * 1024 + hd * 64);
              (void)__builtin_amdgcn_global_atomic_fadd_v2bf16((GAS s16x2*)(ob_ + (lane >> 5) * 2048 + (lane & 31) * 4), __builtin_bit_cast(s16x2, v)); } }
#undef SS3_ISSUE
#undef SS3_COMMIT
    } else {
        const int p0 = 16 * wave;
        f32x4 Ht[8];
#pragma unroll
        for (int t = 0; t < 8; ++t) Ht[t] = (f32x4){0.f, 0.f, 0.f, 0.f};
        for (int n = 0; n < NCHUNK; ++n) {
            WG_BAR();
            const LAS unsigned char* Bb = lds + (n & 1) * BUF;
            const LAS bf16* Cb = (const LAS bf16*)(Bb + CO); const LAS bf16* Bmb = (const LAS bf16*)(Bb + BO); const LAS bf16* Xb = (const LAS bf16*)(Bb + XO);
            const LAS float* sc = (const LAS float*)(Bb + SCO);
            const int offa = fr * LDK + 4 * fq;
            f32x4 aY[4];
#pragma unroll
            for (int m = 0; m < 4; ++m) aY[m] = (f32x4){0.f, 0.f, 0.f, 0.f};
#pragma unroll
            for (int ks = 0; ks < 4; ++ks) { const bf16x8 bs = pack2(Ht[2 * ks], Ht[2 * ks + 1]); bf16x8 fa[4];
#pragma unroll
                for (int m = 0; m < 4; ++m) fa[m] = afrag16(Cb + offa + 16 * m * LDK + 32 * ks);
#pragma unroll
                for (int m = 0; m < 4; ++m) aY[m] = MFMA16(fa[m], bs, aY[m]); }
            bf16x8 xf[2];
#pragma unroll
            for (int kt = 0; kt < 2; ++kt) { const bf16x8 xv = *(const LAS bf16x8*)(Xb + (p0 + fr) * LDT + 32 * kt + 8 * fq);
                const f32x4 w0 = *(const LAS f32x4*)(sc + 64 + 32 * kt + 8 * fq), w1 = *(const LAS f32x4*)(sc + 64 + 32 * kt + 8 * fq + 4);
                u32x4 w; w.x = pkbf(bf2f_s(xv[0]) * w0[0], bf2f_s(xv[1]) * w0[1]); w.y = pkbf(bf2f_s(xv[2]) * w0[2], bf2f_s(xv[3]) * w0[3]);
                w.z = pkbf(bf2f_s(xv[4]) * w1[0], bf2f_s(xv[5]) * w1[1]); w.w = pkbf(bf2f_s(xv[6]) * w1[2], bf2f_s(xv[7]) * w1[3]);
                xf[kt] = __builtin_bit_cast(bf16x8, w); }
#pragma unroll
            for (int m = 0; m < 4; ++m) { const f32x4 ec = *(const LAS f32x4*)(sc + 16 * m + 4 * fq);
#pragma unroll
                for (int e = 0; e < 4; ++e) aY[m][e] *= ec[e]; }
            const float ecl = sc[128];
#pragma unroll
            for (int m = 0; m < 4; ++m)
#pragma unroll
                for (int e = 0; e < 4; ++e) ost[(n & 1) * (64 * 72) + (16 * m + 4 * fq + e) * 72 + p0 + fr] = f2bf1(aY[m][e]);
            { const LAS bf16* bp = Bmb + (8 * fq + (fr >> 2)) * LDK + 4 * (fr & 3);
#pragma unroll
              for (int t = 0; t < 8; ++t) {
                  bf16x8 f[2];
#pragma unroll
                  for (int kt = 0; kt < 2; ++kt) { const LAS bf16* p = bp + (32 * kt) * LDK + 16 * t;
                      const v4i16_t lo = __builtin_amdgcn_ds_read_tr16_b64_v4i16((LAS v4i16_t*)p), hi = __builtin_amdgcn_ds_read_tr16_b64_v4i16((LAS v4i16_t*)(p + 4 * LDK));
                      f[kt] = (bf16x8){lo[0], lo[1], lo[2], lo[3], hi[0], hi[1], hi[2], hi[3]}; }
                  Ht[t] = Ht[t] * ecl; Ht[t] = MFMA16(f[0], xf[0], Ht[t]); Ht[t] = MFMA16(f[1], xf[1], Ht[t]); } }
        }
        WG_BAR();
    }
}
#ifndef PG8_SP2_
#define PG8_SP2_ true
#endif
#ifndef MK_ONE_LAUNCH
#define MK_ONE_LAUNCH 1
#endif
constexpr int PPL = 13;
constexpr int NPHASE = 1 + PPL * DEPTH;
#ifndef STAGGER_TICKS
#define STAGGER_TICKS 0
#endif
#ifndef STAGGER_MODE
#define STAGGER_MODE 0
#endif
__device__ __forceinline__ void xcd_stagger(int bid) {
    const int x = STAGGER_MODE ? ((bid >> 3) & 31) : (bid & 7);
    if (STAGGER_TICKS > 0 && x) { const unsigned long long t0 = __builtin_amdgcn_s_memrealtime(), d = (unsigned long long)(x * STAGGER_TICKS);
        while (__builtin_amdgcn_s_memrealtime() - t0 < d) __builtin_amdgcn_s_sleep(4); }
}
struct Args { const float* in[19]; float* out; unsigned char* ws; int ph_lo, ph_hi; };
__global__ void __launch_bounds__(NWAVES * 64, 2) fwd_kernel(Args args) {
    extern __shared__ __attribute__((aligned(16))) unsigned char lds_raw[];
    LAS unsigned char* lds = (LAS unsigned char*)lds_raw;
    unsigned* ctl = (unsigned*)(args.ws + WS_CTL);
    volatile LAS unsigned* MISC = (volatile LAS unsigned*)(lds + MISC_OFF);
    for (int u = threadIdx.x; u < 64; u += 512) MISC[u] = 0u;
    __syncthreads();
#if MK_ONE_LAUNCH
    XcdBarrier bar = xcd_barrier_post(ctl + CW_BAR, MISC + 8);
#define GRID_BAR() do { XcdBarrier bb_ = bar; asm volatile("" : "+s"(bb_.bar), "+s"(bb_.x)); xcd_barrier(bb_); } while (0)
#else
#define GRID_BAR() do {} while (0)
#endif
    const int lo = args.ph_lo, hi = args.ph_hi;
#define WSP(T, off) ((T*)(wsb + (off)))
#if defined(PROBE_STATE) || defined(PROBE_ANY) || defined(PROBE_SUB)
#define PROBE_PTR ((float*)(wsb + WS_CTL) + 2048)
#define PROBE_SCALE (1.0f + sqrtf(8.7e-4f * fminf(fmaxf(*(volatile float*)PROBE_PTR, 0.f), 1.f)))
#else
#define PROBE_PTR ((float*)nullptr)
#define PROBE_SCALE 1.0f
#endif
    for (int ph = lo; ph < hi; ++ph) {
        int tid = threadIdx.x, bid = blockIdx.x, G = gridDim.x;
        const __attribute__((address_space(4))) Args* ap = (const __attribute__((address_space(4))) Args*)__builtin_amdgcn_kernarg_segment_ptr();
        asm volatile("" : "+v"(tid)); asm volatile("" : "+s"(bid), "+s"(G), "+s"(ap));
        unsigned char* wsb = ap->ws;
        const int lane = tid & 63, wave = __builtin_amdgcn_readfirstlane(tid >> 6);
        const int gw = bid * NWAVES + wave, NGW = G * NWAVES, gtid = bid * 512 + tid, NGT = G * 512;
        const int l = (ph == 0) ? 0 : (ph - 1) / PPL; const int k = (ph == 0) ? -1 : (ph - 1) % PPL;
#if defined(PROBE_ANY)
        if (l == PROBE_L && k == PROBE_K0 && blockIdx.x == 0 && threadIdx.x == 0) ((unsigned long long*)(wsb + WS_CTL))[1100] = __builtin_amdgcn_s_memrealtime();
#endif
        switch (k) {
        case -1: {
            cvt_mixer_weights(lds, wsb, ap->in[2], ap->in[12], gw, NGW, wave, lane);
            phase_norm<float>(ap->in[0], ap->in[1], WSP(bf16, WS_XN), gw, NGW, lane);
        } break;
        case 0: {
            pg8::Gemm g{WSP(bf16, WS_XN), WSP(bf16, WS_WA), M, NWA, DM, 0, 0, 0}; pg8::StaticOrder S; S.init(M, NWA, G, bid);
            pg8::EpiRawA E{WSP(bf16, WS_RAW), WSP(float, WS_SCAL)};
            xcd_stagger(bid);
            pg8::gemm_phase<pg8::EpiRawA, pg8::StaticOrder, true, PG8_SP2_>(lds, g, S, E);
#if defined(EXP_DUP_GEMM)
#if defined(EXP_PADEPI)
            if (l == 0 && (EXP_DUP_GEMM & 1)) { __syncthreads(); pg8::EpiPadA EP{(bf16*)ap->out, EXP_PADEPI}; pg8::gemm_phase<pg8::EpiPadA, pg8::StaticOrder, true, PG8_SP2_>(lds, g, S, EP); }
#elif defined(EXP_NULLEPI)
            if (l == 0 && (EXP_DUP_GEMM & 1)
#if defined(EXP_HALFWG)
                && !((bid >> 3) & 1)
#endif
               ) { __syncthreads(); pg8::EpiNullA EN{WSP(bf16, WS_RAW)}; pg8::gemm_phase<pg8::EpiNullA, pg8::StaticOrder, true, PG8_SP2_>(lds, g, S, EN); }
#else
            if (l == 0 && (EXP_DUP_GEMM & 1)
#if defined(EXP_HALFWG)
                && !((bid >> 3) & 1)
#endif
               ) { __syncthreads(); pg8::gemm_phase<pg8::EpiRawA, pg8::StaticOrder, true, PG8_SP2_>(lds, g, S, E); }
#endif
#endif
        } break;
        case 1: {
            if (l == 1) PB_START(3, wsb);
            prep_gdn_stash(lds, bid, WSP(bf16, WS_RAW), tid); prep_ssd_stash(lds, bid, WSP(bf16, WS_RAW), tid);
            zero_region(wsb + WS_OG, 64 * MiB, gtid, NGT); zero_region(wsb + WS_YS, 64 * MiB, gtid, NGT);
            GRID_BAR();
#if defined(EXP_DUP_PREP)
            if (l == 0) {
                bf16* dmy = (bf16*)ap->out;
                if (!(EXP_DUP_PREP & 32)) prep_gdn_range<EXP_DUP_PREP | 64>(lds, bid, WSP(bf16, WS_RAW), WSP(float, WS_SCAL), ap->in[3] + (size_t)l * 7 * CONV_CH, ap->in[4] + (size_t)l * CONV_CH,
                           ap->in[5] + l * 16, ap->in[6] + l * 16, dmy + 40 * MiB, tid, wave, lane, (float*)(dmy + 38 * MiB), dmy);
                __syncthreads();
                if (!(EXP_DUP_PREP & 16)) { int tid2 = threadIdx.x; asm volatile("" : "+v"(tid2));
                  prep_ssd_range<EXP_DUP_PREP | 64>(lds, bid, WSP(bf16, WS_RAW), ap->in[3] + (size_t)l * 7 * CONV_CH, ap->in[4] + (size_t)l * CONV_CH, tid2,
                             WSP(float, WS_SCAL), ap->in[8] + l * 32, ap->in[9] + l * 32, (float*)(dmy + 56 * MiB), dmy); }
                __syncthreads();
                prep_gdn_stash(lds, bid, WSP(bf16, WS_RAW), tid); prep_ssd_stash(lds, bid, WSP(bf16, WS_RAW), tid);
                GRID_BAR();
            }
#endif
            if (l == 1) { PB_END(3, wsb); PB_START(1, wsb); }
            prep_gdn_range(lds, bid, WSP(bf16, WS_RAW), WSP(float, WS_SCAL), ap->in[3] + (size_t)l * 7 * CONV_CH, ap->in[4] + (size_t)l * CONV_CH,
                           ap->in[5] + l * 16, ap->in[6] + l * 16, WSP(bf16, WS_TQ), tid, wave, lane, WSP(float, WS_SCAL));
            __syncthreads();
            if (l == 1) { PB_END(1, wsb); PB_START(2, wsb); }
            { int tid2 = threadIdx.x; asm volatile("" : "+v"(tid2));
              prep_ssd_range(lds, bid, WSP(bf16, WS_RAW), ap->in[3] + (size_t)l * 7 * CONV_CH, ap->in[4] + (size_t)l * CONV_CH, tid2,
                             WSP(float, WS_SCAL), ap->in[8] + l * 32, ap->in[9] + l * 32, WSP(float, WS_SSC)); }
            if (l == 1) { __syncthreads(); PB_END(2, wsb); }
        } break;
        case 2: {
#if defined(EXP_DUP_ST)
            for (int c0_ = bid; c0_ < 256 * 2; c0_ += G) {
                const int c = c0_ & 255; const bool dup_ = c0_ >= 256;
                if (dup_ && (l != 0 || ((EXP_DUP_ST == 1) != (c < 128)))) continue;
                bf16* const ogp_ = dup_ ? (bf16*)ap->out : WSP(bf16, WS_OG); bf16* const ysp_ = dup_ ? (bf16*)ap->out : WSP(bf16, WS_YS);
#else
            for (int c = bid; c < 256; c += G) {
                bf16* const ogp_ = WSP(bf16, WS_OG); bf16* const ysp_ = WSP(bf16, WS_YS);
#endif
                int tid = threadIdx.x; asm volatile("" : "+v"(tid));
                const int lane = tid & 63, wave = __builtin_amdgcn_readfirstlane(tid >> 6);
                if (c < 128) { const int x_ = (c & 7) | ((c >> 4) << 3), hf_ = (c >> 3) & 1;
                    const int b_ = x_ >> 4, h_ = (x_ >> 1) & 7;
#if defined(EXP_DUP_ST) && defined(EXP_S2)
                    if (dup_) { if (x_ & 1) gdn_state2<1>(lds, b_, h_, hf_, WSP(bf16, WS_RAW), WSP(float, WS_SCAL), WSP(bf16, WS_TQ), ap->in[5] + l * 16, ap->in[6] + l * 16, ogp_, tid, wave, lane);
                                else        gdn_state2<0>(lds, b_, h_, hf_, WSP(bf16, WS_RAW), WSP(float, WS_SCAL), WSP(bf16, WS_TQ), ap->in[5] + l * 16, ap->in[6] + l * 16, ogp_, tid, wave, lane); } else
#endif
#if defined(EXP_DUP_ST) && defined(EXP_XP)
                    if (dup_) { if (x_ & 1) gdn_state3<1, EXP_XP>(lds, b_, h_, hf_, WSP(bf16, WS_RAW), WSP(float, WS_SCAL), WSP(bf16, WS_TQ), ogp_, tid, wave, lane, nullptr, 0);
                                else        gdn_state3<0, EXP_XP>(lds, b_, h_, hf_, WSP(bf16, WS_RAW), WSP(float, WS_SCAL), WSP(bf16, WS_TQ), ogp_, tid, wave, lane, nullptr, 0); } else
#endif
                    if (x_ & 1) gdn_state3<1>(lds, b_, h_, hf_, WSP(bf16, WS_RAW), WSP(float, WS_SCAL), WSP(bf16, WS_TQ), ogp_, tid, wave, lane, nullptr, 0);
                    else        gdn_state3<0>(lds, b_, h_, hf_, WSP(bf16, WS_RAW), WSP(float, WS_SCAL), WSP(bf16, WS_TQ), ogp_, tid, wave, lane, nullptr, 0); }
                else { const int c2 = c - 128, gi_ = c2 & 15, hl_ = c2 >> 4;
                    const int b_ = gi_ >> 2, hd_ = ((gi_ >> 1) & 1) * 8 + hl_;
#if defined(EXP_DUP_ST) && defined(EXP_XP)
                    if (dup_) { if (gi_ & 1) ssd_state3<1, EXP_XP>(lds, b_, hd_, WSP(bf16, WS_RAW), WSP(float, WS_SSC), ysp_, tid, wave, lane, nullptr, 0);
                                else         ssd_state3<0, EXP_XP>(lds, b_, hd_, WSP(bf16, WS_RAW), WSP(float, WS_SSC), ysp_, tid, wave, lane, nullptr, 0); } else
#endif
                    if (gi_ & 1) ssd_state3<1>(lds, b_, hd_, WSP(bf16, WS_RAW), WSP(float, WS_SSC), ysp_, tid, wave, lane, nullptr, 0);
                    else         ssd_state3<0>(lds, b_, hd_, WSP(bf16, WS_RAW), WSP(float, WS_SSC), ysp_, tid, wave, lane, nullptr, 0); }
                __syncthreads();
            }
        } break;
        case 3: {
            ssd_intra_range(lds, bid, WSP(bf16, WS_RAW), WSP(float, WS_SSC), ap->in[10] + l * 16, WSP(bf16, WS_TQ), tid);
#if defined(EXP_DUP_INTRA)
            if (l == 0) { __syncthreads();
            ssd_intra_range(lds, bid, WSP(bf16, WS_RAW), WSP(float, WS_SSC), ap->in[10] + l * 16, WSP(bf16, WS_TQ), tid);
 }
#endif
        } break;
        case 4: {
            if (l == 0) phase_norm<float>(ap->in[0], ap->in[1] + (size_t)l * DM, WSP(bf16, WS_XN2), gw, NGW, lane);
            else        phase_norm<bf16>((const bf16*)ap->out, ap->in[1] + (size_t)l * DM, WSP(bf16, WS_XN2), gw, NGW, lane);
#if defined(EXP_DUP_B)
            if (l == 0) { __syncthreads();
            phase_norm((l == 0) ? ap->in[0] : ap->out, ap->in[1] + (size_t)l * DM, WSP(bf16, WS_XN2), gw, NGW, lane);
 }
#endif
        } break;
        case 5: {
            pg8::Gemm g{WSP(bf16, WS_XN2), WSP(bf16, WS_WB), M, NGATE, DM, 0, 0, 0}; pg8::StaticOrder S; S.init(M, NGATE, G, bid);
            pg8::EpiBf16 E{WSP(bf16, WS_GATES), NGATE};
            xcd_stagger(bid);
            pg8::gemm_phase<pg8::EpiBf16, pg8::StaticOrder, true, PG8_SP2_>(lds, g, S, E);
#if defined(EXP_DUP_GEMM)
            if (l == 0 && (EXP_DUP_GEMM & 2)) { __syncthreads(); pg8::gemm_phase<pg8::EpiBf16, pg8::StaticOrder, true, PG8_SP2_>(lds, g, S, E); }
#endif
        } break;
        case 6: {
            phase_finish(WSP(bf16, WS_OG), WSP(bf16, WS_YS), WSP(bf16, WS_TQ), WSP(bf16, WS_GATES), ap->in[7] + l * 128, ap->in[11] + l * 1024, WSP(bf16, WS_MIXED), gw, NGW, lane);
#if defined(EXP_DUP_B)
            if (l == 0) { __syncthreads();
            phase_finish(WSP(bf16, WS_OG), WSP(bf16, WS_YS), WSP(bf16, WS_TQ), WSP(bf16, WS_GATES), ap->in[7] + l * 128, ap->in[11] + l * 1024, WSP(bf16, WS_MIXED), gw, NGW, lane);
 }
#endif
        } break;
        case 7: {
            pg8::Gemm g{WSP(bf16, WS_MIXED), WSP(bf16, WS_WO), M, DM, 2048, 0, 0, 0}; pg8::StaticOrder S; S.init(M, DM, G, bid);
            pg8::EpiResidB E{(l == 0) ? ap->in[0] : (const float*)nullptr, (const bf16*)ap->out, WSP(bf16, WS_H), DM};
            xcd_stagger(bid);
            pg8::gemm_phase<pg8::EpiResidB, pg8::StaticOrder, true, PG8_SP2_>(lds, g, S, E);
#if defined(EXP_DUP_GEMM)
            if (l == 0 && (EXP_DUP_GEMM & 4)) { __syncthreads(); pg8::gemm_phase<pg8::EpiResidB, pg8::StaticOrder, true, PG8_SP2_>(lds, g, S, E); }
#endif
        } break;
        case 8: {
            phase_norm2_router(lds, WSP(bf16, WS_H), ap->in[13] + l * DM, ap->in[14] + (size_t)l * DM * 16, WSP(bf16, WS_XN), WSP(float, WS_AFF), gw, NGW, tid, lane);
#if defined(EXP_DUP_A) || defined(EXP_DUP_N2)
            if (l == 0) { __syncthreads();
            phase_norm2_router(lds, WSP(bf16, WS_H), ap->in[13] + l * DM, ap->in[14] + (size_t)l * DM * 16, WSP(bf16, WS_XN), WSP(float, WS_AFF), gw, NGW, tid, lane);
            __syncthreads();
            cvt_expert_weights(lds, wsb, ap->in[15] + (size_t)l * NEXP * DM * EFF, ap->in[16] + (size_t)l * NEXP * DM * EFF, ap->in[17] + (size_t)l * NEXP * EFF * DM, gw, NGW, wave, lane);
            if (l + 1 < DEPTH) cvt_mixer_weights(lds, wsb, ap->in[2] + (size_t)(l + 1) * DM * 6720, ap->in[12] + (size_t)(l + 1) * 2048 * DM, gw, NGW, wave, lane);
 }
#endif
        } break;
        case 9: {
            if (bid < NB * NEXP) phase_topk(lds, WSP(float, WS_AFF), WSP(int, WS_IDX), WSP(float, WS_VAL), WSP(int, WS_INV), bid, tid, wave, lane);
            else if (G > NB * NEXP) { const int gw2 = (bid - NB * NEXP) * NWAVES + wave, NGW2 = (G - NB * NEXP) * NWAVES;
                cvt_expert_weights(lds, wsb, ap->in[15] + (size_t)l * NEXP * DM * EFF, ap->in[16] + (size_t)l * NEXP * DM * EFF, ap->in[17] + (size_t)l * NEXP * EFF * DM, gw2, NGW2, wave, lane);
                if (l + 1 < DEPTH) cvt_mixer_weights(lds, wsb, ap->in[2] + (size_t)(l + 1) * DM * 6720, ap->in[12] + (size_t)(l + 1) * 2048 * DM, gw2, NGW2, wave, lane); }
#if defined(EXP_DUP_A) || defined(EXP_DUP_TK)
            if (l == 0) { __syncthreads();
            for (int be = bid; be < NB * NEXP; be += G) phase_topk(lds, WSP(float, WS_AFF), WSP(int, WS_IDX), WSP(float, WS_VAL), WSP(int, WS_INV), be, tid, wave, lane);
 }
#endif
        } break;
        case 10: {
            pg8::Gemm g{WSP(bf16, WS_XN), WSP(bf16, WS_WGU), MEXP, 1024, DM, 2, 15, (size_t)1024 * 1024 * 2, WSP(int, WS_IDX), 14, SEQ}; pg8::StaticOrder S; S.init(MEXP, 1024, G, bid);
            pg8::EpiSwiglu E{WSP(bf16, WS_HMID), EFF};
            xcd_stagger(bid);
            pg8::gemm_phase<pg8::EpiSwiglu, pg8::StaticOrder, true, PG8_SP2_, true>(lds, g, S, E);
#if defined(EXP_DUP_GEMM)
            if (l == 0 && (EXP_DUP_GEMM & 8)) { __syncthreads(); pg8::gemm_phase<pg8::EpiSwiglu, pg8::StaticOrder, true, PG8_SP2_, true>(lds, g, S, E); }
#endif
        } break;
        case 11: {
            pg8::Gemm g{WSP(bf16, WS_HMID), WSP(bf16, WS_WD), MEXP, 1024, EFF, 2, 15, (size_t)1024 * 512 * 2}; pg8::StaticOrder S; S.init(MEXP, 1024, G, bid);
            pg8::EpiBf16 E{WSP(bf16, WS_XG), 1024};
            xcd_stagger(bid);
            pg8::gemm_phase<pg8::EpiBf16, pg8::StaticOrder, true, PG8_SP2_>(lds, g, S, E);
#if defined(EXP_DUP_GEMM)
            if (l == 0 && (EXP_DUP_GEMM & 16)) { __syncthreads(); pg8::gemm_phase<pg8::EpiBf16, pg8::StaticOrder, true, PG8_SP2_>(lds, g, S, E); }
#endif
        } break;
        default: {
            const bool last = (l + 1 == DEPTH);
            phase_combine(WSP(bf16, WS_H), ap->out, WSP(bf16, WS_XG), WSP(int, WS_INV), WSP(float, WS_VAL), last ? ap->in[18] : ap->in[1] + (size_t)(l + 1) * DM, WSP(bf16, WS_XN), last, gw, NGW, lane, PROBE_SCALE);

        } break;
        }
        if (ph + 1 < hi) GRID_BAR();
#if defined(EXP_XBAR)
        if (ph == 1) for (int xb_ = 0; xb_ < EXP_XBAR; ++xb_) GRID_BAR();
#endif
#if defined(PROBE_ANY)
        if (l == PROBE_L && k == PROBE_K1 && blockIdx.x == 0 && threadIdx.x == 0) { const unsigned long long t1_ = __builtin_amdgcn_s_memrealtime(), t0_ = ((unsigned long long*)(wsb + WS_CTL))[1100];
            const unsigned bk_ = (unsigned)((t1_ - t0_) / PROBE_TICKS); *(volatile float*)PROBE_PTR = (float)(bk_ > 40u ? 40u : bk_) * (1.0f / 40.0f); }
#endif
    }
#undef WSP
}

extern "C" void kernel_launch(void* const* d_in, const int* in_sizes, int n_in, void* d_out, int out_size, void* d_ws, size_t ws_size, hipStream_t stream) {
    static int grid = 0;
    if (grid == 0) {
        if (n_in != 19 || in_sizes[0] != M * DM || out_size != M * DM || ws_size < WS_END) { fprintf(stderr, "kernel_launch: unexpected shapes (n_in %d, in0 %d, out %d, ws %zu); nothing launched\n", n_in, n_in > 0 ? in_sizes[0] : -1, out_size, ws_size); grid = -1; return; }
        int dev = 0, cus = 0;
        if (hipGetDevice(&dev) != hipSuccess || hipDeviceGetAttribute(&cus, hipDeviceAttributeMultiprocessorCount, dev) != hipSuccess) { grid = -1; return; }
        if (hipFuncSetAttribute((const void*)fwd_kernel, hipFuncAttributeMaxDynamicSharedMemorySize, LDS_BYTES) != hipSuccess) { fprintf(stderr, "kernel_launch: hipFuncSetAttribute failed\n"); grid = -1; return; }
        (void)hipGetLastError();
        grid = cus;
    }
    if (grid < 0) return;
    (void)hipMemsetAsync((char*)d_ws + WS_CTL, 0, CTL_ZERO_BYTES, stream);
    Args a{};
    for (int i = 0; i < 19; ++i) a.in[i] = (const float*)d_in[i];
    a.out = (float*)d_out; a.ws = (unsigned char*)d_ws;
#if MK_ONE_LAUNCH
    a.ph_lo = 0; a.ph_hi = NPHASE;
    hipLaunchKernelGGL(fwd_kernel, dim3(grid), dim3(NWAVES * 64), LDS_BYTES, stream, a);
#else
    for (int p = 0; p < NPHASE; ++p) { a.ph_lo = p; a.ph_hi = p + 1; hipLaunchKernelGGL(fwd_kernel, dim3(grid), dim3(NWAVES * 64), LDS_BYTES, stream, a); }
#endif
}
```

```cpp
#include <hip/hip_runtime.h>
#include <cstdio>
#include <cstdint>
namespace pg8 {
#define PG8_LAS __attribute__((address_space(3)))
typedef unsigned short bf16_t;
typedef short bf16x8 __attribute__((ext_vector_type(8)));
typedef float f32x4 __attribute__((ext_vector_type(4)));
typedef unsigned u32x4 __attribute__((ext_vector_type(4)));
constexpr int BM = 256, BK = 64, HALF = 128, HTB = HALF * BK * 2  , STAGE_BYTES = 8 * HTB, NXCD = 8, WGM = 8;

__host__ __device__ __forceinline__ int lds_byte(int r, int c) { const int st = (r >> 4) * 2 + (c >> 5), rr = r & 15, cc = c & 31, ob = rr * 64 + cc * 2; return st * 1024 + (ob ^ (((ob >> 9) & 1) << 5)); }
__host__ __device__ __forceinline__ void stage_rc(int b, int& R, int& C) { const int st = b / 1024, sb = b % 1024, swz = sb ^ (((sb >> 9) & 1) << 5); R = (st >> 1) * 16 + swz / 64; C = (st & 1) * 32 + (swz % 64) / 2; }
__host__ __device__ __forceinline__ int perm32(int rho) { const int n = rho >> 4, i = rho & 15; return 8 * (i >> 2) + 4 * n + (i & 3); }

struct Unit { int pm, pn; };
struct Gemm { const bf16_t* A; const bf16_t* Bt; int M, N, K; int bshift, bmask; size_t bstride; const int* gidx = nullptr; int gshift = 0, gmul = 0;
    __device__ __forceinline__ size_t grp_off(int pm) const { return (size_t)((pm >> bshift) & bmask) * bstride; } };

struct StaticOrder {
    int nM, nN, nwg, G, c;
    __host__ __device__ void init(int M, int N, int G_, int c_) { nM = M / BM; nN = N / BM; nwg = nM * nN; G = G_; c = c_; }
    __host__ __device__ bool next(int i, Unit& u) const {
        const long L = (long)i * G + c; if (L >= nwg) return false;
        int wgid = (int)L; { const int q = nwg / NXCD, r = nwg % NXCD, xcd = wgid % NXCD, off = wgid / NXCD; wgid = (xcd < r ? xcd * (q + 1) : r * (q + 1) + (xcd - r) * q) + off; }
        const int nig = WGM * nN, gid = wgid / nig, fm = gid * WGM, gsz = (nM - fm) < WGM ? (nM - fm) : WGM;
        u.pm = fm + ((wgid % nig) % gsz); u.pn = (wgid % nig) / gsz; return true;
    }
    __device__ __forceinline__ void a_ready(const Unit&) const {}
    __device__ __forceinline__ void done(const Unit&) const {}
};

__device__ __forceinline__ unsigned cvt_pk_bf16(float lo, float hi) { unsigned r; asm volatile("v_cvt_pk_bf16_f32 %0, %1, %2" : "=v"(r) : "v"(lo), "v"(hi)); return r; }
__device__ __forceinline__ float silu_f(float x) { return x * __builtin_amdgcn_rcpf(1.0f + __builtin_amdgcn_exp2f(-1.4426950408889634f * x)); }
#ifndef PG8_NDEF
#define PG8_NDEF 2
#endif
#if !defined(EPI_SC1)
#define EPI_ST16(p_, v_) (*(u32x4*)(p_) = (v_))
#define EPI_ST8(p_, v_) (*(u32x2*)(p_) = (v_))
#else
#define EPI_ST16(p_, v_) asm volatile("global_store_dwordx4 %0, %1, off sc1\n\ts_nop 1" :: "v"(p_), "v"(v_) : "memory")
#define EPI_ST8(p_, v_) asm volatile("global_store_dwordx2 %0, %1, off sc1" :: "v"(p_), "v"(v_) : "memory")
#endif
__device__ __forceinline__ unsigned epi_ror8(unsigned v) { return (unsigned)__builtin_amdgcn_update_dpp(0, (int)v, 0x128, 0xf, 0xf, false); }
__device__ __forceinline__ void epi_pair(const f32x4 (&a0)[2], const f32x4 (&a1)[2], bool hi, u32x4& sa, u32x4& sb) {
    u32x4 p0, p1; p0.x = cvt_pk_bf16(a0[0][0], a0[0][1]); p0.y = cvt_pk_bf16(a0[0][2], a0[0][3]); p0.z = cvt_pk_bf16(a0[1][0], a0[1][1]); p0.w = cvt_pk_bf16(a0[1][2], a0[1][3]);
    p1.x = cvt_pk_bf16(a1[0][0], a1[0][1]); p1.y = cvt_pk_bf16(a1[0][2], a1[0][3]); p1.z = cvt_pk_bf16(a1[1][0], a1[1][1]); p1.w = cvt_pk_bf16(a1[1][2], a1[1][3]);
    u32x4 sd, rc; sd.x = hi ? p0.x : p1.x; sd.y = hi ? p0.y : p1.y; sd.z = hi ? p0.z : p1.z; sd.w = hi ? p0.w : p1.w;
    rc.x = epi_ror8(sd.x); rc.y = epi_ror8(sd.y); rc.z = epi_ror8(sd.z); rc.w = epi_ror8(sd.w);
    sa.x = hi ? rc.x : p0.x; sa.y = hi ? rc.y : p0.y; sa.z = hi ? rc.z : p0.z; sa.w = hi ? rc.w : p0.w;
    sb.x = hi ? p1.x : rc.x; sb.y = hi ? p1.y : rc.y; sb.z = hi ? p1.z : rc.z; sb.w = hi ? p1.w : rc.w;
}
struct EpiBf16 {
    static constexpr bool PERM = true, AFTER_DRAIN = false, DEFERRABLE = false, COL64 = true;
    bf16_t* O; int ldc;
    template <int A0, int A1, bool LEAN = false> __device__ __forceinline__ void run(const f32x4 (&acc)[2][2][4][2], const Unit& u, int wr, int wc, int fr, int fq) const {
        const bool hi = fr >= 8; const int row0 = u.pm * BM + wr * 64 + (fr & 7); const int col0 = u.pn * BM + wc * 64 + (hi ? 32 : 0) + 8 * fq;
#pragma unroll
        for (int ai = A0; ai < A1; ++ai)
#pragma unroll
            for (int m = 0; m < 4; ++m) { bf16_t* rowp = O + (size_t)(row0 + ai * HALF + m * 16) * ldc + col0;
                if constexpr (LEAN) { const bf16_t* rl = O + (size_t)(u.pm * BM + wr * 64 + fr + ai * HALF + m * 16) * ldc + u.pn * BM + wc * 64 + 8 * fq;
#pragma unroll
                    for (int bj = 0; bj < 2; ++bj) { const f32x4 v0 = acc[ai][bj][m][0], v1 = acc[ai][bj][m][1];
                        u32x4 w; w.x = cvt_pk_bf16(v0[0], v0[1]); w.y = cvt_pk_bf16(v0[2], v0[3]); w.z = cvt_pk_bf16(v1[0], v1[1]); w.w = cvt_pk_bf16(v1[2], v1[3]);
                        EPI_ST16(rl + bj * 32, w); } }
                else { u32x4 sa, sb; epi_pair(acc[ai][0][m], acc[ai][1][m], hi, sa, sb);
                    EPI_ST16(rowp, sa); EPI_ST16(rowp + (size_t)8 * ldc, sb); } }
    }
    __device__ __forceinline__ void operator()(const f32x4 (&acc)[2][2][4][2], const Unit& u, int wr, int wc, int fr, int fq) const { run<0, 2>(acc, u, wr, wc, fr, fq); }
    template <int AI> __device__ __forceinline__ void part(const f32x4 (&acc)[2][2][4][2], const Unit& u, int wr, int wc, int fr, int fq) const { run<AI, AI + 1, (AI == 1)>(acc, u, wr, wc, fr, fq); }
    static constexpr bool SPLIT = false;
    __device__ __forceinline__ bool splittable(const Unit&) const { return true; }
    __device__ __forceinline__ void part1_lean(const f32x4 (&acc)[2][2][4][2], const Unit& u, int wr, int wc, int fr, int fq) const { part<1>(acc, u, wr, wc, fr, fq); }
};
struct EpiRawA {
    static constexpr bool PERM = true, AFTER_DRAIN = false, DEFERRABLE = false, COL64 = true;
    bf16_t* O; float* S;
    template <int A0, int A1, bool LEAN = false> __device__ __forceinline__ void run(const f32x4 (&acc)[2][2][4][2], const Unit& u, int wr, int wc, int fr, int fq) const {
        if (u.pn < 18) {
            const bool hi = fr >= 8; const int row0 = u.pm * BM + wr * 64 + (fr & 7); const int col0 = u.pn * BM + wc * 64 + (hi ? 32 : 0) + 8 * fq;
#pragma unroll
            for (int ai = A0; ai < A1; ++ai) {
#if defined(EPI_SLEEP)
                if (ai == 1) __builtin_amdgcn_s_sleep(EPI_SLEEP);
#endif
#pragma unroll
                for (int m = 0; m < 4; ++m) { bf16_t* rowp = O + (size_t)(row0 + ai * HALF + m * 16) * 4608 + col0;
                if constexpr (LEAN) { const bf16_t* rl = O + (size_t)(u.pm * BM + wr * 64 + fr + ai * HALF + m * 16) * 4608 + u.pn * BM + wc * 64 + 8 * fq;
#pragma unroll
                    for (int bj = 0; bj < 2; ++bj) { const f32x4 v0 = acc[ai][bj][m][0], v1 = acc[ai][bj][m][1];
                        u32x4 w; w.x = cvt_pk_bf16(v0[0], v0[1]); w.y = cvt_pk_bf16(v0[2], v0[3]); w.z = cvt_pk_bf16(v1[0], v1[1]); w.w = cvt_pk_bf16(v1[2], v1[3]);
                        EPI_ST16(rl + bj * 32, w); } }
                else { u32x4 sa, sb; epi_pair(acc[ai][0][m], acc[ai][1][m], hi, sa, sb);
                    EPI_ST16(rowp, sa); EPI_ST16(rowp + (size_t)8 * 4608, sb); } } }
        } else if (wc == 0) {
            const int row0 = u.pm * BM + wr * 64 + fr;
#pragma unroll
            for (int ai = A0; ai < A1; ++ai)
#pragma unroll
                for (int m = 0; m < 4; ++m) { float* sp = S + (size_t)(row0 + ai * HALF + m * 16) * 64 + 8 * fq;
#pragma unroll
                    for (int bj = 0; bj < 2; ++bj) { *(f32x4*)(sp + bj * 32) = acc[ai][bj][m][0]; *(f32x4*)(sp + bj * 32 + 4) = acc[ai][bj][m][1]; } }
        }
    }
    __device__ __forceinline__ void operator()(const f32x4 (&acc)[2][2][4][2], const Unit& u, int wr, int wc, int fr, int fq) const { run<0, 2>(acc, u, wr, wc, fr, fq); }
    template <int AI> __device__ __forceinline__ void part(const f32x4 (&acc)[2][2][4][2], const Unit& u, int wr, int wc, int fr, int fq) const { run<AI, AI + 1, (AI == 1)>(acc, u, wr, wc, fr, fq); }
    static constexpr bool SPLIT = true;
    __device__ __forceinline__ bool splittable(const Unit& u) const { return u.pn < 18; }
    __device__ __forceinline__ void part1_lean(const f32x4 (&acc)[2][2][4][2], const Unit& u, int wr, int wc, int fr, int fq) const {
#pragma unroll
        for (int m = 0; m < 4; ++m) { const bf16_t* rl = O + (size_t)(u.pm * BM + wr * 64 + fr + HALF + m * 16) * 4608 + u.pn * BM + wc * 64 + 8 * fq;
#pragma unroll
            for (int bj = 0; bj < 2; ++bj) { const f32x4 v0 = acc[1][bj][m][0], v1 = acc[1][bj][m][1];
                u32x4 w; w.x = cvt_pk_bf16(v0[0], v0[1]); w.y = cvt_pk_bf16(v0[2], v0[3]); w.z = cvt_pk_bf16(v1[0], v1[1]); w.w = cvt_pk_bf16(v1[2], v1[3]);
                EPI_ST16(rl + bj * 32, w); } }
    }
};
struct EpiResid {
    static constexpr bool PERM = false, AFTER_DRAIN = false, DEFERRABLE = false, COL64 = false;
    const float* base; float* out; int ldc;
    __device__ __forceinline__ void operator()(const f32x4 (&acc)[2][2][4][2], const Unit& u, int wr, int wc, int fr, int fq) const {
        const int row0 = u.pm * BM + wr * 64 + fr, col0 = u.pn * BM + wc * 32 + 4 * fq;
#pragma unroll
        for (int ai = 0; ai < 2; ++ai)
#pragma unroll
            for (int mp = 0; mp < 2; ++mp) { f32x4 rv[2][2][2];
#pragma unroll
                for (int mm = 0; mm < 2; ++mm) { const size_t off = (size_t)(row0 + ai * HALF + (2 * mp + mm) * 16) * ldc + col0;
#pragma unroll
                    for (int bj = 0; bj < 2; ++bj)
#pragma unroll
                        for (int n = 0; n < 2; ++n) rv[mm][bj][n] = *(const f32x4*)(base + off + bj * HALF + n * 16); }
                asm volatile("" ::: "memory");
#pragma unroll
                for (int mm = 0; mm < 2; ++mm) { const size_t off = (size_t)(row0 + ai * HALF + (2 * mp + mm) * 16) * ldc + col0;
#pragma unroll
                    for (int bj = 0; bj < 2; ++bj)
#pragma unroll
                        for (int n = 0; n < 2; ++n) *(f32x4*)(out + off + bj * HALF + n * 16) = rv[mm][bj][n] + acc[ai][bj][2 * mp + mm][n]; }
                asm volatile("" ::: "memory"); }
    }
    static constexpr bool SPLIT = false;
};
struct EpiPadA {
    static constexpr bool PERM = true, AFTER_DRAIN = false, DEFERRABLE = false, COL64 = true;
    bf16_t* O; int ldc;
    template <int A0, int A1> __device__ __forceinline__ void run(const f32x4 (&acc)[2][2][4][2], const Unit& u, int wr, int wc, int fr, int fq) const {
        const bool hi = fr >= 8; const int row0 = (u.pm & 31) * BM + wr * 64 + (fr & 7); const int col0 = (u.pn < 18 ? u.pn : 0) * BM + wc * 64 + (hi ? 32 : 0) + 8 * fq;
#pragma unroll
        for (int ai = A0; ai < A1; ++ai)
#pragma unroll
            for (int m = 0; m < 4; ++m) { bf16_t* rowp = O + (size_t)(row0 + ai * HALF + m * 16) * ldc + col0;
                u32x4 sa, sb; epi_pair(acc[ai][0][m], acc[ai][1][m], hi, sa, sb);
                EPI_ST16(rowp, sa); EPI_ST16(rowp + (size_t)8 * ldc, sb); }
    }
    __device__ __forceinline__ void operator()(const f32x4 (&acc)[2][2][4][2], const Unit& u, int wr, int wc, int fr, int fq) const { run<0, 2>(acc, u, wr, wc, fr, fq); }
    template <int AI> __device__ __forceinline__ void part(const f32x4 (&acc)[2][2][4][2], const Unit& u, int wr, int wc, int fr, int fq) const { run<AI, AI + 1>(acc, u, wr, wc, fr, fq); }
    static constexpr bool SPLIT = false;
    __device__ __forceinline__ bool splittable(const Unit&) const { return true; }
    __device__ __forceinline__ void part1_lean(const f32x4 (&acc)[2][2][4][2], const Unit& u, int wr, int wc, int fr, int fq) const { part<1>(acc, u, wr, wc, fr, fq); }
};
struct EpiNullA {
    static constexpr bool PERM = true, AFTER_DRAIN = false, DEFERRABLE = false, COL64 = true;
    bf16_t* O;
    __device__ __forceinline__ void operator()(const f32x4 (&acc)[2][2][4][2], const Unit& u, int wr, int wc, int fr, int fq) const {
        float s = 0.f;
#pragma unroll
        for (int ai = 0; ai < 2; ++ai)
#pragma unroll
            for (int bj = 0; bj < 2; ++bj)
#pragma unroll
                for (int m = 0; m < 4; ++m)
#pragma unroll
                    for (int n = 0; n < 2; ++n) s += acc[ai][bj][m][n][0] + acc[ai][bj][m][n][1] + acc[ai][bj][m][n][2] + acc[ai][bj][m][n][3];
        if (s == 12345.6789f) O[0] = 1;
    }
    static constexpr bool SPLIT = false;
};
struct EpiResidB {
    static constexpr bool PERM = true, AFTER_DRAIN = false, DEFERRABLE = false, COL64 = true;
    const float* basef; const bf16_t* baseb; bf16_t* out; int ldc;
    template <int A0, int A1> __device__ __forceinline__ void run(const f32x4 (&acc)[2][2][4][2], const Unit& u, int wr, int wc, int fr, int fq) const {
        const int row0 = u.pm * BM + wr * 64 + fr, col0 = u.pn * BM + wc * 64 + 8 * fq;
#pragma unroll
        for (int ai = A0; ai < A1; ++ai)
#pragma unroll
            for (int mp = 0; mp < 2; ++mp) { f32x4 rv[2][2][2];
                if (basef) {
#pragma unroll
                    for (int mm = 0; mm < 2; ++mm) { const size_t off = (size_t)(row0 + ai * HALF + (2 * mp + mm) * 16) * ldc + col0;
#pragma unroll
                        for (int bj = 0; bj < 2; ++bj) { rv[mm][bj][0] = *(const f32x4*)(basef + off + bj * 32); rv[mm][bj][1] = *(const f32x4*)(basef + off + bj * 32 + 4); } }
                } else { u32x4 rb[2][2];
#pragma unroll
                    for (int mm = 0; mm < 2; ++mm) { const size_t off = (size_t)(row0 + ai * HALF + (2 * mp + mm) * 16) * ldc + col0;
#pragma unroll
                        for (int bj = 0; bj < 2; ++bj) rb[mm][bj] = *(const u32x4*)(baseb + off + bj * 32); }
#pragma unroll
                    for (int mm = 0; mm < 2; ++mm)
#pragma unroll
                        for (int bj = 0; bj < 2; ++bj) { const u32x4 t = rb[mm][bj];
                            rv[mm][bj][0] = (f32x4){__uint_as_float(t.x << 16), __uint_as_float(t.x & 0xffff0000u), __uint_as_float(t.y << 16), __uint_as_float(t.y & 0xffff0000u)};
                            rv[mm][bj][1] = (f32x4){__uint_as_float(t.z << 16), __uint_as_float(t.z & 0xffff0000u), __uint_as_float(t.w << 16), __uint_as_float(t.w & 0xffff0000u)}; } }
                asm volatile("" ::: "memory");
#pragma unroll
                for (int mm = 0; mm < 2; ++mm) { const size_t off = (size_t)(row0 + ai * HALF + (2 * mp + mm) * 16) * ldc + col0;
#pragma unroll
                    for (int bj = 0; bj < 2; ++bj) { const f32x4 v0 = rv[mm][bj][0] + acc[ai][bj][2 * mp + mm][0], v1 = rv[mm][bj][1] + acc[ai][bj][2 * mp + mm][1];
                        u32x4 w; w.x = cvt_pk_bf16(v0[0], v0[1]); w.y = cvt_pk_bf16(v0[2], v0[3]); w.z = cvt_pk_bf16(v1[0], v1[1]); w.w = cvt_pk_bf16(v1[2], v1[3]);
                        EPI_ST16(out + off + bj * 32, w); } }
                asm volatile("" ::: "memory"); }
    }
    __device__ __forceinline__ void operator()(const f32x4 (&acc)[2][2][4][2], const Unit& u, int wr, int wc, int fr, int fq) const { run<0, 2>(acc, u, wr, wc, fr, fq); }
    template <int AI> __device__ __forceinline__ void part(const f32x4 (&acc)[2][2][4][2], const Unit& u, int wr, int wc, int fr, int fq) const { run<AI, AI + 1>(acc, u, wr, wc, fr, fq); }
    static constexpr bool SPLIT = false;
    __device__ __forceinline__ bool splittable(const Unit&) const { return true; }
    __device__ __forceinline__ void part1_lean(const f32x4 (&acc)[2][2][4][2], const Unit& u, int wr, int wc, int fr, int fq) const { part<1>(acc, u, wr, wc, fr, fq); }
};
struct EpiSwiglu {
    static constexpr bool PERM = true, AFTER_DRAIN = false, DEFERRABLE = false, COL64 = true;
    bf16_t* O; int ldh;
    template <int A0, int A1> __device__ __forceinline__ void run(const f32x4 (&acc)[2][2][4][2], const Unit& u, int wr, int wc, int fr, int fq) const {
        const int row0 = u.pm * BM + wr * 64 + fr; const int f0 = (u.pn * BM + wc * 64 + 8 * fq) >> 1;
        typedef unsigned u32x2 __attribute__((ext_vector_type(2)));
#pragma unroll
        for (int ai = A0; ai < A1; ++ai)
#pragma unroll
            for (int m = 0; m < 4; ++m) { bf16_t* rowp = O + (size_t)(row0 + ai * HALF + m * 16) * ldh + f0;
#pragma unroll
                for (int bj = 0; bj < 2; ++bj) { const f32x4 v0 = acc[ai][bj][m][0], v1 = acc[ai][bj][m][1];
                    u32x2 w; w.x = cvt_pk_bf16(silu_f(v0[0]) * v0[1], silu_f(v0[2]) * v0[3]); w.y = cvt_pk_bf16(silu_f(v1[0]) * v1[1], silu_f(v1[2]) * v1[3]);
                    EPI_ST8(rowp + bj * 16, w); } }
    }
    __device__ __forceinline__ void operator()(const f32x4 (&acc)[2][2][4][2], const Unit& u, int wr, int wc, int fr, int fq) const { run<0, 2>(acc, u, wr, wc, fr, fq); }
    template <int AI> __device__ __forceinline__ void part(const f32x4 (&acc)[2][2][4][2], const Unit& u, int wr, int wc, int fr, int fq) const { run<AI, AI + 1>(acc, u, wr, wc, fr, fq); }
    static constexpr bool SPLIT = false;
    __device__ __forceinline__ bool splittable(const Unit&) const { return true; }
    __device__ __forceinline__ void part1_lean(const f32x4 (&acc)[2][2][4][2], const Unit& u, int wr, int wc, int fr, int fq) const { part<1>(acc, u, wr, wc, fr, fq); }
};
template <class Epi, class Sched, bool ALIGN_EPI = false, bool SP2 = false, bool GATHER = false>
__device__ __forceinline__ void gemm_phase(PG8_LAS unsigned char* lds, const Gemm g, const Sched& S, const Epi& E) {
    int tid_o = threadIdx.x; asm volatile("" : "+v"(tid_o));
    const int tid = tid_o, wid = __builtin_amdgcn_readfirstlane(tid >> 6), lane = tid & 63, wr = wid >> 2, wc = wid & 3, fr = lane & 15, fq = lane >> 4;
    const int K = g.K, nt = K / BK;
    unsigned voffA[2], voffB[2];
#pragma unroll
    for (int i = 0; i < 2; ++i) { int R, C; stage_rc(tid * 16 + i * 8192, R, C); const int Rb = Epi::COL64 ? (64 * (R >> 5) + perm32(R & 31)) : (Epi::PERM ? ((R & ~31) + perm32(R & 31)) : R);
        voffA[i] = (unsigned)(R * K + C) * 2u; voffB[i] = (unsigned)(Rb * K + C) * 2u; }
    const size_t kstep = (size_t)(BK * 2);
    const size_t hstep = (size_t)HALF * K * 2;
    const size_t tstep = 2 * hstep;
    const size_t hstepB = Epi::COL64 ? (size_t)32 * K * 2 : hstep;
    const size_t hstepA = GATHER ? (size_t)0 : hstep, tstepA = GATHER ? (size_t)0 : tstep;
    unsigned gC[2][2]; int gI[2][2];
    auto g_load = [&](const Unit& u) { _Pragma("unroll") for (int h = 0; h < 2; ++h) _Pragma("unroll") for (int i = 0; i < 2; ++i) { int R, C; stage_rc(tid * 16 + i * 8192, R, C);
        gI[h][i] = g.gidx[u.pm * BM + h * HALF + R]; } };
    auto g_make = [&](const Unit& u, unsigned (&o)[2][2]) { _Pragma("unroll") for (int h = 0; h < 2; ++h) _Pragma("unroll") for (int i = 0; i < 2; ++i) { int R, C; stage_rc(tid * 16 + i * 8192, R, C);
        const int row = u.pm * BM + h * HALF + R; o[h][i] = (unsigned)(((row >> g.gshift) * g.gmul + gI[h][i]) * K + C) * 2u; } };
    const unsigned ldsw = (unsigned)wid * 1024u;
    const int aoff = lds_byte(wr * 64 + fr, fq * 8), boff = lds_byte(wc * 32 + fr, fq * 8);
#define PG8_SA(b, h) (((b) * 2 + (h)) * HTB)
#define PG8_SB(b, h) ((4 + (b) * 2 + (h)) * HTB)
#define PG8_STAGE(bufoff, gbase, voff) do { _Pragma("unroll") for (int _i = 0; _i < 2; ++_i) \
        __builtin_amdgcn_global_load_lds((const unsigned*)((const char*)(gbase) + (voff)[_i]), (PG8_LAS unsigned*)(lds + (bufoff) + ldsw + _i * 8192), 16, 0, 0); } while (0)
#define PG8_LDA(dst, b, h) do { _Pragma("unroll") for (int m = 0; m < 4; ++m) _Pragma("unroll") for (int k = 0; k < 2; ++k) dst[m][k] = *(const PG8_LAS bf16x8*)(lds + PG8_SA(b, h) + aoff + m * 2048 + k * 1024); } while (0)
#define PG8_LDB(dst, b, h) do { _Pragma("unroll") for (int n = 0; n < 2; ++n) _Pragma("unroll") for (int k = 0; k < 2; ++k) dst[n][k] = *(const PG8_LAS bf16x8*)(lds + PG8_SB(b, h) + boff + n * 2048 + k * 1024); } while (0)
#define PG8_MMA(ai, bj, At, Bt) do { __builtin_amdgcn_s_setprio(1); _Pragma("unroll") for (int m = 0; m < 4; ++m) _Pragma("unroll") for (int n = 0; n < 2; ++n) _Pragma("unroll") for (int k = 0; k < 2; ++k) \
        acc[ai][bj][m][n] = __builtin_amdgcn_mfma_f32_16x16x32_bf16(Bt[n][k], At[m][k], acc[ai][bj][m][n], 0, 0, 0); __builtin_amdgcn_s_setprio(0); } while (0)
#define PG8_WAIT_V(n) asm volatile("s_waitcnt vmcnt(" #n ")" ::: "memory")
#define PG8_WAIT_L(n) asm volatile("s_waitcnt lgkmcnt(" #n ")" ::: "memory")
#define PG8_BAR __builtin_amdgcn_s_barrier()
#define PG8_SCHED __builtin_amdgcn_sched_barrier(0)
    Unit cur, nxt; int ui = 0;
    if (!S.next(0, cur)) return;
#ifndef PG8_DEFER
#define PG8_DEFER 0
#endif
    constexpr bool DEFER = PG8_DEFER && Epi::DEFERRABLE && !Epi::AFTER_DRAIN;
#ifndef PG8_SPLIT
#define PG8_SPLIT 0
#endif
    constexpr bool SPLIT = PG8_SPLIT && Epi::SPLIT && !Epi::AFTER_DRAIN && SP2;
    bool pend2 = false;
    Unit pu = cur;
    f32x4 acc[2][2][4][2];
#pragma unroll
    for (int a = 0; a < 2; ++a)
#pragma unroll
        for (int b = 0; b < 2; ++b)
#pragma unroll
            for (int m = 0; m < 4; ++m)
#pragma unroll
                for (int n = 0; n < 2; ++n) acc[a][b][m][n] = (f32x4){0.f, 0.f, 0.f, 0.f};
    bf16x8 At[4][2], B0[2][2], B1[2][2];
    const char* cA = (const char*)g.A + (size_t)cur.pm * tstepA; const char* cB = (const char*)g.Bt + g.grp_off(cur.pm) + (size_t)cur.pn * tstep;
    if constexpr (GATHER) { g_load(cur); g_make(cur, gC); }
#define PG8_VA(h) (GATHER ? gC[h] : voffA)
    S.a_ready(cur);
    if constexpr (SP2) {
        PG8_STAGE(PG8_SB(0, 0), cB, voffB); PG8_STAGE(PG8_SB(0, 1), cB + hstepB, voffB); PG8_STAGE(PG8_SA(0, 0), cA, PG8_VA(0)); PG8_STAGE(PG8_SA(0, 1), cA + hstepA, PG8_VA(1));
        if (wr == 1) PG8_BAR;
        PG8_WAIT_V(2); PG8_BAR;
        PG8_STAGE(PG8_SB(1, 0), cB + kstep, voffB); PG8_STAGE(PG8_SA(1, 0), cA + kstep, PG8_VA(0)); PG8_STAGE(PG8_SB(1, 1), cB + hstepB + kstep, voffB);
        PG8_WAIT_V(6); PG8_BAR;
    } else {
        PG8_STAGE(PG8_SB(0, 0), cB, voffB); PG8_STAGE(PG8_SA(0, 0), cA, PG8_VA(0)); PG8_STAGE(PG8_SB(0, 1), cB + hstepB, voffB); PG8_STAGE(PG8_SA(0, 1), cA + hstepA, PG8_VA(1));
        if (wr == 1) PG8_BAR;
        PG8_WAIT_V(4); PG8_BAR;
        PG8_STAGE(PG8_SB(1, 0), cB + kstep, voffB); PG8_STAGE(PG8_SA(1, 0), cA + kstep, PG8_VA(0)); PG8_STAGE(PG8_SB(1, 1), cB + hstepB + kstep, voffB);
        PG8_WAIT_V(6); PG8_BAR;
    }
    for (;;) {
        const bool has_next = S.next(ui + 1, nxt);
        const char* nA = has_next ? (const char*)g.A + (size_t)nxt.pm * tstepA : cA; const char* nB = has_next ? (const char*)g.Bt + g.grp_off(nxt.pm) + (size_t)nxt.pn * tstep : cB;
        if constexpr (GATHER) { if (has_next) g_load(nxt); }
        for (int t = 0; t < nt; t += 2) {
            const bool last = (t == nt - 2);
            const char* a1 = cA + (size_t)(t + 1) * kstep;
            const char* a2 = last ? nA : cA + (size_t)(t + 2) * kstep; const char* b2 = last ? nB : cB + (size_t)(t + 2) * kstep;
            const char* a3 = a2 + kstep; const char* b3 = b2 + kstep;
            if (last && has_next) S.a_ready(nxt);
#define PG8_GS() do { if constexpr (GATHER) { if (last && has_next) g_make(nxt, gC); } } while (0)
            if constexpr (SP2) {
            PG8_LDB(B0, 0, 0); PG8_LDB(B1, 0, 1); PG8_SCHED; PG8_LDA(At, 0, 0); PG8_STAGE(PG8_SA(1, 1), a1 + hstepA, PG8_VA(1)); PG8_GS();
            PG8_WAIT_V(8); PG8_WAIT_L(0); PG8_BAR; PG8_MMA(0, 0, At, B0); PG8_MMA(0, 1, At, B1); PG8_BAR; PG8_SCHED;
            if constexpr (SPLIT) { if (pend2) { E.part1_lean(acc, pu, wr, wc, fr, fq);
                    _Pragma("unroll") for (int b = 0; b < 2; ++b) _Pragma("unroll") for (int m = 0; m < 4; ++m) _Pragma("unroll") for (int n = 0; n < 2; ++n) acc[1][b][m][n] = (f32x4){0.f, 0.f, 0.f, 0.f};
                    pend2 = false; } PG8_SCHED; }
            PG8_LDA(At, 0, 1); PG8_STAGE(PG8_SB(0, 0), b2, voffB); PG8_STAGE(PG8_SB(0, 1), b2 + hstepB, voffB); PG8_STAGE(PG8_SA(0, 0), a2, PG8_VA(0));
            PG8_WAIT_V(8); PG8_WAIT_L(0); PG8_BAR; PG8_MMA(1, 0, At, B0); PG8_MMA(1, 1, At, B1); PG8_BAR; PG8_SCHED;
            PG8_LDB(B0, 1, 0); PG8_LDB(B1, 1, 1); PG8_SCHED; PG8_LDA(At, 1, 0); PG8_STAGE(PG8_SA(0, 1), a2 + hstepA, PG8_VA(1));
            PG8_WAIT_V(8); PG8_WAIT_L(0); PG8_BAR; PG8_MMA(0, 0, At, B0); PG8_MMA(0, 1, At, B1); PG8_BAR; PG8_SCHED;
            PG8_LDA(At, 1, 1); PG8_STAGE(PG8_SB(1, 0), b3, voffB); PG8_STAGE(PG8_SB(1, 1), b3 + hstepB, voffB); PG8_STAGE(PG8_SA(1, 0), a3, PG8_VA(0));
            PG8_WAIT_V(8); PG8_WAIT_L(0); PG8_BAR; PG8_MMA(1, 0, At, B0); PG8_MMA(1, 1, At, B1); PG8_BAR; PG8_SCHED;
            } else {
            PG8_LDB(B0, 0, 0); PG8_SCHED; PG8_LDA(At, 0, 0); PG8_STAGE(PG8_SA(1, 1), a1 + hstepA, PG8_VA(1)); PG8_GS();
            PG8_WAIT_L(8); PG8_BAR; PG8_WAIT_L(0); PG8_MMA(0, 0, At, B0); PG8_BAR; PG8_SCHED;
            PG8_LDB(B1, 0, 1); PG8_STAGE(PG8_SB(0, 0), b2, voffB);
            PG8_BAR; PG8_WAIT_L(0); PG8_MMA(0, 1, At, B1); PG8_BAR;
            PG8_LDA(At, 0, 1); PG8_STAGE(PG8_SA(0, 0), a2, PG8_VA(0));
            PG8_BAR; PG8_WAIT_L(0); PG8_MMA(1, 0, At, B0); PG8_BAR; PG8_SCHED;
            PG8_STAGE(PG8_SB(0, 1), b2 + hstepB, voffB);
            PG8_WAIT_V(6); PG8_BAR; PG8_MMA(1, 1, At, B1); PG8_BAR;
            PG8_LDB(B0, 1, 0); PG8_SCHED; PG8_LDA(At, 1, 0); PG8_STAGE(PG8_SA(0, 1), a2 + hstepA, PG8_VA(1));
            PG8_WAIT_L(8); PG8_BAR; PG8_WAIT_L(0); PG8_MMA(0, 0, At, B0); PG8_BAR; PG8_SCHED;
            PG8_LDB(B1, 1, 1); PG8_STAGE(PG8_SB(1, 0), b3, voffB);
            PG8_BAR; PG8_WAIT_L(0); PG8_MMA(0, 1, At, B1); PG8_BAR;
            PG8_LDA(At, 1, 1); PG8_STAGE(PG8_SA(1, 0), a3, PG8_VA(0));
            PG8_BAR; PG8_WAIT_L(0); PG8_MMA(1, 0, At, B0); PG8_BAR; PG8_SCHED;
            PG8_STAGE(PG8_SB(1, 1), b3 + hstepB, voffB);
            PG8_WAIT_V(6); PG8_BAR; PG8_MMA(1, 1, At, B1); PG8_BAR;
            }
        }
        if constexpr (ALIGN_EPI) { if (wr == 0) PG8_BAR; }
        if constexpr (SPLIT) { if (has_next && E.splittable(cur)) { E.template part<0>(acc, cur, wr, wc, fr, fq); pu = cur; pend2 = true; } else E(acc, cur, wr, wc, fr, fq); S.done(cur); }
        else if constexpr (!Epi::AFTER_DRAIN) { E(acc, cur, wr, wc, fr, fq); S.done(cur); }
        if (!has_next) break;
#pragma unroll
        for (int a = 0; a < 2; ++a) { if (SPLIT && a == 1 && pend2) break;
#pragma unroll
            for (int b = 0; b < 2; ++b)
#pragma unroll
                for (int m = 0; m < 4; ++m)
#pragma unroll
                    for (int n = 0; n < 2; ++n) acc[a][b][m][n] = (f32x4){0.f, 0.f, 0.f, 0.f}; }
        cur = nxt; cA = nA; cB = nB; ++ui;
        if constexpr (ALIGN_EPI) { if (wr == 1) PG8_BAR; }
    }
    PG8_WAIT_V(0);
    if constexpr (!ALIGN_EPI) { if (wr == 0) PG8_BAR; }
    PG8_BAR;
    if constexpr (Epi::AFTER_DRAIN) { E.fused(acc, cur, wr, wc, fr, fq, lds, wid, lane); S.done(cur); }
#undef PG8_SA
#undef PG8_VA
#undef PG8_GS
#undef PG8_SB
#undef PG8_STAGE
#undef PG8_LDA
#undef PG8_LDB
#undef PG8_MMA
#undef PG8_WAIT_V
#undef PG8_WAIT_L
#undef PG8_BAR
#undef PG8_SCHED
}
}
#define GAS __attribute__((address_space(1)))
#define LAS __attribute__((address_space(3)))
typedef unsigned short bf16;
typedef unsigned v4u __attribute__((ext_vector_type(4)));
typedef float f32x4 __attribute__((ext_vector_type(4)));
typedef short bf16x8 __attribute__((ext_vector_type(8)));
typedef GAS unsigned gu32;
typedef GAS unsigned long long gu64;
#define RLX_AGENT __ATOMIC_RELAXED, __HIP_MEMORY_SCOPE_AGENT
#define LDS_WAIT() asm volatile("s_waitcnt lgkmcnt(0)" ::: "memory")
#define VM_WAIT() asm volatile("s_waitcnt vmcnt(0)" ::: "memory")
__device__ __forceinline__ unsigned long long rt() { return __builtin_amdgcn_s_memrealtime(); }
__device__ __forceinline__ unsigned f2bf(float f) { unsigned u = __builtin_bit_cast(unsigned, f); return (u + 0x7fffu + ((u >> 16) & 1u)) >> 16; }
__device__ __forceinline__ unsigned pk2(float lo, float hi) { return f2bf(lo) | (f2bf(hi) << 16); }
#define XB_TMO      128
#define XB_XCNT(j)  (256  + 64 * (j))
#define XB_XSUB(j)  (1280 + 64 * (j))
#define XB_XGEN(j)  (2304 + 64 * (j))
#define XB_TOP      3328
#define XB_TOPGEN   3392
#define XCD_BAR_WORDS 3456
#define XB_SPIN_CAP (1u << 18)

__device__ __forceinline__ unsigned xb_ld(unsigned* p)              { return __hip_atomic_load(p, __ATOMIC_RELAXED, __HIP_MEMORY_SCOPE_AGENT); }
__device__ __forceinline__ unsigned xb_add(unsigned* p, unsigned v) { return __hip_atomic_fetch_add(p, v, __ATOMIC_RELAXED, __HIP_MEMORY_SCOPE_AGENT); }
__device__ __forceinline__ unsigned xb_xcc_id() { return (unsigned)__builtin_amdgcn_s_getreg((3 << 11) | 20) & 0xFu; }
#define XB_SPIN(cond, bar) do { unsigned _sp = 0; while (cond) { __builtin_amdgcn_s_sleep(1); \
    if ((++_sp & 255u) == 0u) { if (xb_ld(&(bar)[XB_TMO])) break; if (_sp > XB_SPIN_CAP) { atomicAdd(&(bar)[XB_TMO], 1u); break; } } } } while (0)

struct XcdBarrier {
    unsigned* bar; unsigned x;
    volatile LAS unsigned* st;
};

__device__ __forceinline__ XcdBarrier xcd_barrier_post(unsigned* bar, volatile LAS unsigned* st) {
    XcdBarrier b; b.bar = bar; b.x = xb_xcc_id(); b.st = st;
    if (threadIdx.x == 0) (void)xb_add(&bar[XB_XCNT(b.x)], 1u);
    return b;
}
__device__ __forceinline__ void xcd_barrier_complete(unsigned* bar, unsigned x, unsigned& nloc, unsigned& nx) {
    const unsigned G = gridDim.x * gridDim.y * gridDim.z;
    unsigned sum, cnt, mine, sp = 0u;
    for (;;) {
        sum = 0u; cnt = 0u; mine = 0u;
#pragma unroll
        for (unsigned j = 0; j < 16; ++j) { const unsigned c = xb_ld(&bar[XB_XCNT(j)]); sum += c; cnt += (c > 0u) ? 1u : 0u; mine = (j == x) ? c : mine; }
        if (sum == G) break;
        __builtin_amdgcn_s_sleep(1);
        if ((++sp & 255u) == 0u) { if (xb_ld(&bar[XB_TMO])) break; if (sp > XB_SPIN_CAP) { atomicAdd(&bar[XB_TMO], 1u); break; } }
    }
    nloc = mine > 0u ? mine : 1u; nx = cnt > 0u ? cnt : 1u;
}

__device__ __forceinline__ void xcd_barrier(const XcdBarrier& b) {
    asm volatile("s_waitcnt vmcnt(0)" ::: "memory");
    __syncthreads();
    if (threadIdx.x == 0) {
        unsigned* bar = b.bar;
        __builtin_amdgcn_s_waitcnt(0);
        unsigned nloc = b.st[0], nx = b.st[1];
        if (nloc == 0u) { xcd_barrier_complete(bar, b.x, nloc, nx); b.st[0] = nloc; b.st[1] = nx; }
        const unsigned old = xb_add(&bar[XB_XSUB(b.x)], 1u);
        const unsigned gen = old / nloc;
        if (old + 1u == (gen + 1u) * nloc) {
            __builtin_amdgcn_fence(__ATOMIC_RELEASE, "agent");
            asm volatile("s_waitcnt vmcnt(0)" ::: "memory");
            const unsigned og = xb_add(&bar[XB_TOP], 1u);
            const unsigned tg = og / nx;
            if (og + 1u == (tg + 1u) * nx) xb_add(&bar[XB_TOPGEN], 1u);
            else XB_SPIN(xb_ld(&bar[XB_TOPGEN]) == tg, bar);
            __builtin_amdgcn_fence(__ATOMIC_ACQUIRE, "agent");
            xb_add(&bar[XB_XGEN(b.x)], 1u);
            asm volatile("s_waitcnt vmcnt(0)" ::: "memory");
        } else {
            XB_SPIN(xb_ld(&bar[XB_XGEN(b.x)]) == gen, bar);
            __builtin_amdgcn_fence(__ATOMIC_ACQUIRE, "agent");
            asm volatile("s_waitcnt vmcnt(0)" ::: "memory");
        }
    }
    __syncthreads();
}
constexpr int NB = 4, SEQ = 8192, DM = 1024, M = NB * SEQ, DEPTH = 2;
constexpr int NCHUNK = SEQ / 64;
constexpr int CONV_CH = 4608, NWA = 4864  , NGATE = 2048, NEXP = 16, EFF = 512, CAP = 1024;
constexpr int MEXP = NB * NEXP * CAP;
constexpr float EPS = 1e-6f;
constexpr int NWAVES = 8;
constexpr size_t MiB = 1u << 20;
constexpr size_t WS_CTL = 0, CTL_ZERO_BYTES = 1 * MiB;
constexpr size_t WS_WA = 1 * MiB;
constexpr size_t WS_WB = 11 * MiB;
constexpr size_t WS_WO = 15 * MiB;
constexpr size_t WS_XN = 19 * MiB;
constexpr size_t WS_RAW = 83 * MiB;
constexpr size_t WS_SCAL = 371 * MiB;
constexpr size_t WS_OG = 19 * MiB;
constexpr size_t WS_YS = 443 * MiB;
constexpr size_t WS_XN2 = 83 * MiB;
constexpr size_t WS_GATES = 147 * MiB;
constexpr size_t WS_MIXED = 147 * MiB;
constexpr size_t WS_WGU = 83 * MiB;
constexpr size_t WS_WD = 115 * MiB;
constexpr size_t WS_XG = 131 * MiB;
constexpr size_t WS_HMID = 259 * MiB;
constexpr size_t WS_AFF = 323 * MiB;
constexpr size_t WS_IDX = 325 * MiB;
constexpr size_t WS_VAL = 326 * MiB;
constexpr size_t WS_INV = 327 * MiB;
constexpr size_t WS_H = 443 * MiB;
constexpr size_t WS_END = 507 * MiB;
constexpr int CW_TMO = 0, CW_BAR = 4096;
constexpr int LDS_BYTES = 163840;
constexpr int MISC_OFF = LDS_BYTES - 256;

typedef short bf16x8 __attribute__((ext_vector_type(8)));
typedef short bf16x4 __attribute__((ext_vector_type(4)));
typedef float f32x4 __attribute__((ext_vector_type(4)));
typedef float f32x2 __attribute__((ext_vector_type(2)));
typedef unsigned u32x4 __attribute__((ext_vector_type(4)));
typedef unsigned u32x2 __attribute__((ext_vector_type(2)));
typedef __bf16 bf16x2_t __attribute__((ext_vector_type(2)));
typedef short s16x2 __attribute__((ext_vector_type(2)));

__device__ __forceinline__ float bf2f(unsigned short v) { return __uint_as_float((unsigned)v << 16); }
__device__ __forceinline__ float bf2f_s(short v) { return __uint_as_float((unsigned)(unsigned short)v << 16); }
__device__ __forceinline__ unsigned pkbf(float lo, float hi) { f32x2 v = {lo, hi}; bf16x2_t b = __builtin_convertvector(v, bf16x2_t); return __builtin_bit_cast(unsigned, b); }
__device__ __forceinline__ unsigned short f2bf1(float f) { return (unsigned short)(pkbf(f, 0.f) & 0xffffu); }
__device__ __forceinline__ float silu(float x) { return x * __builtin_amdgcn_rcpf(1.0f + __builtin_amdgcn_exp2f(-1.4426950408889634f * x)); }
__device__ __forceinline__ float softplus_f(float x) { return x > 20.f ? x : log1pf(expf(x)); }
__device__ __forceinline__ float sigmoid_f(float x) { return 1.0f / (1.0f + expf(-x)); }
__device__ __forceinline__ void atomic_add_bf16x2(bf16* p, float a, float b) {
    (void)__builtin_amdgcn_global_atomic_fadd_v2bf16((GAS s16x2*)p, __builtin_bit_cast(s16x2, pkbf(a, b)));
}
template <int CTRL> __device__ __forceinline__ float dppf(float v) { return __builtin_bit_cast(float, __builtin_amdgcn_update_dpp(0, __builtin_bit_cast(int, v), CTRL, 0xF, 0xF, true)); }
__device__ __forceinline__ float wave_sum(float v) {
    v += dppf<0xB1>(v); v += dppf<0x4E>(v); v += dppf<0x141>(v); v += dppf<0x140>(v);
    const float s0 = __builtin_bit_cast(float, __builtin_amdgcn_readlane(__builtin_bit_cast(int, v), 0)), s1 = __builtin_bit_cast(float, __builtin_amdgcn_readlane(__builtin_bit_cast(int, v), 16));
    const float s2 = __builtin_bit_cast(float, __builtin_amdgcn_readlane(__builtin_bit_cast(int, v), 32)), s3 = __builtin_bit_cast(float, __builtin_amdgcn_readlane(__builtin_bit_cast(int, v), 48));
    return (s0 + s1) + (s2 + s3);
}

__device__ __forceinline__ float softplus_fast(float x) { const float e = __builtin_amdgcn_exp2f(1.4426950408889634f * fminf(x, 20.f));
    const float lg = (e < 1e-3f) ? e * (1.0f - 0.5f * e) : 0.6931471805599453f * __builtin_amdgcn_logf(1.0f + e); return x > 20.f ? x : lg; }
__device__ __forceinline__ float sigmoid_fast(float x) { return __builtin_amdgcn_rcpf(1.0f + __builtin_amdgcn_exp2f(-1.4426950408889634f * x)); }
__device__ __forceinline__ float scan_fwd64(float v, int lane) {
    v += dppf<0x111>(v); v += dppf<0x112>(v); v += dppf<0x114>(v); v += dppf<0x118>(v);
    const float t0 = __builtin_bit_cast(float, __builtin_amdgcn_readlane(__builtin_bit_cast(int, v), 15)), t1 = __builtin_bit_cast(float, __builtin_amdgcn_readlane(__builtin_bit_cast(int, v), 31));
    const float t2 = __builtin_bit_cast(float, __builtin_amdgcn_readlane(__builtin_bit_cast(int, v), 47));
    const int row = lane >> 4; return v + (row == 0 ? 0.f : row == 1 ? t0 : row == 2 ? t0 + t1 : (t0 + t1) + t2);
}
__device__ __forceinline__ float scan_bwd64(float v, int lane) {
    v += dppf<0x101>(v); v += dppf<0x102>(v); v += dppf<0x104>(v); v += dppf<0x108>(v);
    const float t1 = __builtin_bit_cast(float, __builtin_amdgcn_readlane(__builtin_bit_cast(int, v), 16)), t2 = __builtin_bit_cast(float, __builtin_amdgcn_readlane(__builtin_bit_cast(int, v), 32));
    const float t3 = __builtin_bit_cast(float, __builtin_amdgcn_readlane(__builtin_bit_cast(int, v), 48));
    const int row = lane >> 4; return v + (row == 3 ? 0.f : row == 2 ? t3 : row == 1 ? t3 + t2 : (t3 + t2) + t1);
}

template <int CTRL> __device__ __forceinline__ int dppi(int v) { return __builtin_amdgcn_update_dpp(0, v, CTRL, 0xF, 0xF, true); }
__device__ __forceinline__ int scan_fwd64_i(int v, int lane) {
    v += dppi<0x111>(v); v += dppi<0x112>(v); v += dppi<0x114>(v); v += dppi<0x118>(v);
    const int t0 = __builtin_amdgcn_readlane(v, 15), t1 = __builtin_amdgcn_readlane(v, 31), t2 = __builtin_amdgcn_readlane(v, 47);
    const int row = lane >> 4; return v + (row == 0 ? 0 : row == 1 ? t0 : row == 2 ? t0 + t1 : t0 + t1 + t2);
}
template <int MT, int NT>
__device__ __forceinline__ void mma_lds(f32x4 (&acc)[MT][NT], const LAS bf16* A, int lda, int m0, const LAS bf16* Bt, int ldb, int n0, int K, int fr, int fq) {
    for (int k0 = 0; k0 < K; k0 += 32) {
        bf16x8 a[MT], b[NT];
#pragma unroll
        for (int mt = 0; mt < MT; ++mt) a[mt] = *(const LAS bf16x8*)(A + (m0 + mt * 16 + fr) * lda + k0 + fq * 8);
#pragma unroll
        for (int nt = 0; nt < NT; ++nt) b[nt] = *(const LAS bf16x8*)(Bt + (n0 + nt * 16 + fr) * ldb + k0 + fq * 8);
#pragma unroll
        for (int mt = 0; mt < MT; ++mt)
#pragma unroll
            for (int nt = 0; nt < NT; ++nt) acc[mt][nt] = __builtin_amdgcn_mfma_f32_16x16x32_bf16(a[mt], b[nt], acc[mt][nt], 0, 0, 0);
    }
}

__device__ __forceinline__ void conv16(float (&acc)[16], const LAS bf16* src, int ld, const LAS float* cw, int cwld) {
#pragma unroll
    for (int c = 0; c < 16; ++c) acc[c] = cw[7 * cwld + c];
#pragma unroll
    for (int tap = 0; tap < 7; ++tap) {
        const bf16x8 x0 = *(const LAS bf16x8*)(src + tap * ld), x1 = *(const LAS bf16x8*)(src + tap * ld + 8);
        const LAS float* w = cw + tap * cwld;
#pragma unroll
        for (int c = 0; c < 8; ++c) { acc[c] += bf2f_s(x0[c]) * w[c]; acc[8 + c] += bf2f_s(x1[c]) * w[8 + c]; }
        if (tap & 1) asm volatile("" ::: "memory");
    }
}
__device__ __forceinline__ void conv8(float (&acc)[8], const LAS bf16* src, int ld, const LAS float* cw, int cwld) {
#pragma unroll
    for (int c = 0; c < 8; ++c) acc[c] = cw[7 * cwld + c];
#pragma unroll
    for (int tap = 0; tap < 7; ++tap) {
        const bf16x8 x0 = *(const LAS bf16x8*)(src + tap * ld);
        const LAS float* w = cw + tap * cwld;
#pragma unroll
        for (int c = 0; c < 8; ++c) acc[c] += bf2f_s(x0[c]) * w[c];
        if (tap & 1) asm volatile("" ::: "memory");
    }
}

#if defined(PROBE_SUB)
#define PB_START(id_, ws_) do { if ((id_) == PROBE_SUB && blockIdx.x == 0 && threadIdx.x == 0) ((unsigned long long*)(ws_))[1100] = __builtin_amdgcn_s_memrealtime(); } while (0)
#define PB_END(id_, ws_) do { if ((id_) == PROBE_SUB && blockIdx.x == 0 && threadIdx.x == 0) { const unsigned long long t1_ = __builtin_amdgcn_s_memrealtime(), t0_ = ((unsigned long long*)(ws_))[1100]; \
        const unsigned bk_ = (unsigned)((t1_ - t0_) / PROBE_TICKS); *((volatile float*)(ws_) + 2048) = (float)(bk_ > 40u ? 40u : bk_) * (1.0f / 40.0f); } } while (0)
#else
#define PB_START(id_, ws_) do {} while (0)
#define PB_END(id_, ws_) do {} while (0)
#endif
__device__ __forceinline__ void transpose_item(const float* W, int K, int N, int k0, int n0, bf16* WT, int drow0, int rmul, LAS float* scr, int lane) {
    f32x4 v[16];
#pragma unroll
    for (int i = 0; i < 16; ++i) { const int kk = 4 * i + (lane >> 4); v[i] = *(const GAS f32x4*)(W + (size_t)(k0 + kk) * N + n0 + 4 * (lane & 15)); }
#pragma unroll
    for (int i = 0; i < 16; ++i) { const int kk = 4 * i + (lane >> 4); LAS float* d = scr + kk * 65 + 4 * (lane & 15); d[0] = v[i].x; d[1] = v[i].y; d[2] = v[i].z; d[3] = v[i].w; }
    LDS_WAIT(); asm volatile("" ::: "memory");
    const int c = lane & 7;
#pragma unroll
    for (int j = 0; j < 8; ++j) { const int n = (lane >> 3) + 8 * j; const LAS float* s = scr + (8 * c) * 65 + n;
        u32x4 o; o.x = pkbf(s[0 * 65], s[1 * 65]); o.y = pkbf(s[2 * 65], s[3 * 65]); o.z = pkbf(s[4 * 65], s[5 * 65]); o.w = pkbf(s[6 * 65], s[7 * 65]);
        *(GAS u32x4*)(WT + (size_t)(drow0 + rmul * n) * K + k0 + 8 * c) = o; }
    LDS_WAIT(); asm volatile("" ::: "memory");
}
__device__ __forceinline__ void cvt_mixer_weights(LAS unsigned char* lds, unsigned char* ws, const float* w_in, const float* w_out, int gw, int NGW, int wave, int lane) {
    LAS float* scr = (LAS float*)(lds + wave * 16896);
    bf16* WA = (bf16*)(ws + WS_WA); bf16* WB = (bf16*)(ws + WS_WB); bf16* WO = (bf16*)(ws + WS_WO);
    constexpr int I_IN = 16 * 105, I_OUT = 32 * 16;
    for (int it = gw; it < I_IN + I_OUT; it += NGW) {
        if (it < I_IN) { const int kb = it / 105, nb = it % 105, n0 = nb * 64;
            bf16* dst; int drow;
            if (n0 < 4608) { dst = WA; drow = n0; } else if (n0 < 6656) { dst = WB; drow = n0 - 4608; } else { dst = WA; drow = 4608 + (n0 - 6656); }
            transpose_item(w_in, 1024, 6720, kb * 64, n0, dst, drow, 1, scr, lane);
        } else { const int r = it - I_IN, kb = r / 16, nb = r % 16; transpose_item(w_out, 2048, 1024, kb * 64, nb * 64, WO, nb * 64, 1, scr, lane); }
    }
    { u32x4 z = (u32x4){0u, 0u, 0u, 0u}; asm volatile("" : "+v"(z));
      for (int r = gw; r < 192; r += NGW) { GAS u32x4* p = (GAS u32x4*)(WA + (size_t)(4672 + r) * 1024) + lane; p[0] = z; p[64] = z; } }
}
__device__ __forceinline__ void cvt_expert_weights(LAS unsigned char* lds, unsigned char* ws, const float* w_gate, const float* w_up, const float* w_down, int gw, int NGW, int wave, int lane) {
    LAS float* scr = (LAS float*)(lds + wave * 16896);
    bf16* WGU = (bf16*)(ws + WS_WGU); bf16* WD = (bf16*)(ws + WS_WD);
    constexpr int I_G = 16 * 8;
    constexpr int I_D = 8 * 16;
    constexpr int PER_E = 2 * I_G + I_D;
    for (int it = gw; it < NEXP * PER_E; it += NGW) {
        const int e = it / PER_E; int r = it % PER_E;
        if (r < 2 * I_G) { const int up = r >= I_G; if (up) r -= I_G; const int kb = r / 8, nb = r % 8;
            transpose_item((up ? w_up : w_gate) + (size_t)e * 1024 * 512, 1024, 512, kb * 64, nb * 64, WGU + (size_t)e * 1024 * 1024, 2 * (nb * 64) + up, 2, scr, lane);
        } else { r -= 2 * I_G; const int kb = r / 16, nb = r % 16;
            transpose_item(w_down + (size_t)e * 512 * 1024, 512, 1024, kb * 64, nb * 64, WD + (size_t)e * 1024 * 512, nb * 64, 1, scr, lane); }
    }
}

__device__ __forceinline__ void rms_row_regs(const float* xrow, const f32x4 (&w)[4], f32x4 (&v)[4], int lane) {
    const GAS f32x4* xr = (const GAS f32x4*)xrow + lane; float s = 0.f;
#pragma unroll
    for (int j = 0; j < 4; ++j) { v[j] = xr[64 * j]; s += (v[j].x * v[j].x + v[j].y * v[j].y) + (v[j].z * v[j].z + v[j].w * v[j].w); }
    const float rstd = __builtin_amdgcn_rsqf(wave_sum(s) * (1.0f / DM) + EPS);
#pragma unroll
    for (int j = 0; j < 4; ++j) v[j] = v[j] * rstd * w[j];
}
__device__ __forceinline__ void row_load4(const float* xrow, f32x4 (&v)[4], int lane) {
    const GAS f32x4* xr = (const GAS f32x4*)xrow + lane;
#pragma unroll
    for (int j = 0; j < 4; ++j) v[j] = xr[64 * j];
}
__device__ __forceinline__ void row_load4(const bf16* xrow, u32x2 (&v)[4], int lane) {
    const GAS u32x2* xr = (const GAS u32x2*)xrow + lane;
#pragma unroll
    for (int j = 0; j < 4; ++j) v[j] = xr[64 * j];
}
__device__ __forceinline__ void row_get(const f32x4 (&b)[4], f32x4 (&v)[4]) {
#pragma unroll
    for (int j = 0; j < 4; ++j) v[j] = b[j];
}
__device__ __forceinline__ void row_get(const u32x2 (&b)[4], f32x4 (&v)[4]) {
#pragma unroll
    for (int j = 0; j < 4; ++j) v[j] = (f32x4){__uint_as_float(b[j].x << 16), __uint_as_float(b[j].x & 0xffff0000u), __uint_as_float(b[j].y << 16), __uint_as_float(b[j].y & 0xffff0000u)};
}
template <class T> struct RowBuf;
template <> struct RowBuf<float> { typedef f32x4 type; };
template <> struct RowBuf<bf16> { typedef u32x2 type; };
__device__ __forceinline__ void rms_regs(const f32x4 (&w)[4], f32x4 (&v)[4]) {
    float s = 0.f;
#pragma unroll
    for (int j = 0; j < 4; ++j) s += (v[j].x * v[j].x + v[j].y * v[j].y) + (v[j].z * v[j].z + v[j].w * v[j].w);
    const float rstd = __builtin_amdgcn_rsqf(wave_sum(s) * (1.0f / DM) + EPS);
#pragma unroll
    for (int j = 0; j < 4; ++j) v[j] = v[j] * rstd * w[j];
}
__device__ __forceinline__ void store_row_bf16(bf16* orow, const f32x4 (&v)[4], int lane) {
    GAS u32x2* o8 = (GAS u32x2*)orow + lane;
#pragma unroll
    for (int j = 0; j < 4; ++j) { u32x2 t; t.x = pkbf(v[j].x, v[j].y); t.y = pkbf(v[j].z, v[j].w); o8[64 * j] = t; }
}
__device__ __forceinline__ void load_w4(const float* w, f32x4 (&wv)[4], int lane) {
#pragma unroll
    for (int j = 0; j < 4; ++j) wv[j] = ((const GAS f32x4*)w)[lane + 64 * j];
}
template <class T>
__device__ __forceinline__ void phase_norm(const T* src, const float* w, bf16* XN, int gw, int NGW, int lane) {
    typedef typename RowBuf<T>::type RB;
    f32x4 wv[4]; load_w4(w, wv, lane);
    RB nx[4], ny[4]; row_load4(src + (size_t)gw * DM, nx, lane);
    if (gw + NGW < M) row_load4(src + (size_t)(gw + NGW) * DM, ny, lane);
    auto body = [&](int m, RB (&buf)[4]) { f32x4 v[4];
        row_get(buf, v);
        if (m + 2 * NGW < M) row_load4(src + (size_t)(m + 2 * NGW) * DM, buf, lane);
        rms_regs(wv, v); store_row_bf16(XN + (size_t)m * DM, v, lane); };
    for (int m = gw; m < M; m += 2 * NGW) { body(m, nx); if (m + NGW < M) body(m + NGW, ny); }
}
__device__ __forceinline__ void zero_region(unsigned char* p, size_t bytes, int gtid, int NGT) {
    GAS u32x4* q = (GAS u32x4*)p; const size_t n = bytes / 16;
    u32x4 z = (u32x4){0u, 0u, 0u, 0u}; asm volatile("" : "+v"(z));
    for (size_t i = gtid; i < n; i += NGT) q[i] = z;
}

__device__ __forceinline__ void phase_norm2_router(LAS unsigned char* lds, const bf16* h, const float* w2, const float* w_router, bf16* XN, float* aff, int gw, int NGW, int tid, int lane) {
    LAS float* wrT = (LAS float*)lds;
    for (int e = tid; e < 16 * 1024; e += 512) { const int k = e >> 4, x = e & 15; wrT[x * 1024 + k] = w_router[e]; }
    __syncthreads();
    f32x4 wv[4]; load_w4(w2, wv, lane);
    u32x2 nx[4], ny[4]; row_load4(h + (size_t)gw * DM, nx, lane);
    if (gw + NGW < M) row_load4(h + (size_t)(gw + NGW) * DM, ny, lane);
    auto body = [&](int m, u32x2 (&buf)[4]) {
        f32x4 v[4];
        row_get(buf, v);
        if (m + 2 * NGW < M) row_load4(h + (size_t)(m + 2 * NGW) * DM, buf, lane);
        rms_regs(wv, v); store_row_bf16(XN + (size_t)m * DM, v, lane);
        float mine = 0.f;
#pragma unroll 1
        for (int x = 0; x < 16; ++x) { float s = 0.f;
#pragma unroll
            for (int j = 0; j < 4; ++j) { const f32x4 wr = *(const LAS f32x4*)(wrT + x * 1024 + 4 * lane + 256 * j); s += (v[j].x * wr.x + v[j].y * wr.y) + (v[j].z * wr.z + v[j].w * wr.w); }
            s = wave_sum(s); mine = (lane == x) ? s : mine; }
        float mx = mine;
        mx = fmaxf(mx, __shfl_xor(mx, 1)); mx = fmaxf(mx, __shfl_xor(mx, 2)); mx = fmaxf(mx, __shfl_xor(mx, 4)); mx = fmaxf(mx, __shfl_xor(mx, 8));
        const float ex = expf(mine - mx); float den = ex;
        den += __shfl_xor(den, 1); den += __shfl_xor(den, 2); den += __shfl_xor(den, 4); den += __shfl_xor(den, 8);
        if (lane < 16) aff[(size_t)m * 16 + lane] = ex / den;
    };
    for (int m = gw; m < M; m += 2 * NGW) { body(m, nx); if (m + NGW < M) body(m + NGW, ny); }
}

__device__ __forceinline__ void phase_finish(const bf16* og, const bf16* ys, const bf16* yi, const bf16* gates, const float* gnw, const float* snw, bf16* mixed, int gw, int NGW, int lane) {
    float gw_[16], sw_[16];
#pragma unroll
    for (int c = 0; c < 16; ++c) { gw_[c] = gnw[(16 * lane + c) & 127]; sw_[c] = snw[16 * lane + c]; }
    bf16x8 nb[10], nc[10];
#define PF_LOAD(nb, m_) do { const size_t m1_ = (size_t)(m_); \
        nb[0] = *(const GAS bf16x8*)(og + m1_ * 1024 + 16 * lane); nb[1] = *(const GAS bf16x8*)(og + m1_ * 1024 + 16 * lane + 8); \
        nb[2] = *(const GAS bf16x8*)(ys + m1_ * 1024 + 16 * lane); nb[3] = *(const GAS bf16x8*)(ys + m1_ * 1024 + 16 * lane + 8); \
        nb[4] = *(const GAS bf16x8*)(yi + m1_ * 1024 + 16 * lane); nb[5] = *(const GAS bf16x8*)(yi + m1_ * 1024 + 16 * lane + 8); \
        nb[6] = *(const GAS bf16x8*)(gates + m1_ * 2048 + 16 * lane); nb[7] = *(const GAS bf16x8*)(gates + m1_ * 2048 + 16 * lane + 8); \
        nb[8] = *(const GAS bf16x8*)(gates + m1_ * 2048 + 1024 + 16 * lane); nb[9] = *(const GAS bf16x8*)(gates + m1_ * 2048 + 1024 + 16 * lane + 8); } while (0)
    PF_LOAD(nb, gw);
    if (gw + NGW < M) PF_LOAD(nc, gw + NGW);
    auto body = [&](int m, bf16x8 (&buf)[10]) {
        const bf16x8 o0 = buf[0], o1 = buf[1], y0 = buf[2], y1 = buf[3], i0 = buf[4], i1 = buf[5], g0 = buf[6], g1 = buf[7], z0 = buf[8], z1 = buf[9];
        if (m + 2 * NGW < M) PF_LOAD(buf, m + 2 * NGW);
        float o[16], t[16]; float so = 0.f, st = 0.f;
#pragma unroll
        for (int c = 0; c < 8; ++c) { o[c] = bf2f_s(o0[c]); o[8 + c] = bf2f_s(o1[c]); t[c] = (bf2f_s(y0[c]) + bf2f_s(i0[c])) * silu(bf2f_s(z0[c])); t[8 + c] = (bf2f_s(y1[c]) + bf2f_s(i1[c])) * silu(bf2f_s(z1[c])); }
#pragma unroll
        for (int c = 0; c < 16; ++c) { so += o[c] * o[c]; st += t[c] * t[c]; }
        so += __shfl_xor(so, 1); so += __shfl_xor(so, 2); so += __shfl_xor(so, 4);
        st += __shfl_xor(st, 1); st += __shfl_xor(st, 2); st += __shfl_xor(st, 4); st += __shfl_xor(st, 8); st += __shfl_xor(st, 16);
        const float ro = __builtin_amdgcn_rsqf(so * (1.0f / 128.f) + EPS), rt = __builtin_amdgcn_rsqf(st * (1.0f / 512.f) + EPS);
        float a[16], b2[16];
#pragma unroll
        for (int c = 0; c < 8; ++c) { a[c] = o[c] * ro * gw_[c] * silu(bf2f_s(g0[c])); a[8 + c] = o[8 + c] * ro * gw_[8 + c] * silu(bf2f_s(g1[c])); }
#pragma unroll
        for (int c = 0; c < 16; ++c) b2[c] = t[c] * rt * sw_[c];
        u32x4 w0, w1, w2, w3;
        w0.x = pkbf(a[0], a[1]); w0.y = pkbf(a[2], a[3]); w0.z = pkbf(a[4], a[5]); w0.w = pkbf(a[6], a[7]);
        w1.x = pkbf(a[8], a[9]); w1.y = pkbf(a[10], a[11]); w1.z = pkbf(a[12], a[13]); w1.w = pkbf(a[14], a[15]);
        w2.x = pkbf(b2[0], b2[1]); w2.y = pkbf(b2[2], b2[3]); w2.z = pkbf(b2[4], b2[5]); w2.w = pkbf(b2[6], b2[7]);
        w3.x = pkbf(b2[8], b2[9]); w3.y = pkbf(b2[10], b2[11]); w3.z = pkbf(b2[12], b2[13]); w3.w = pkbf(b2[14], b2[15]);
        GAS u32x4* mp = (GAS u32x4*)(mixed + (size_t)m * 2048 + 16 * lane);
        mp[0] = w0; mp[1] = w1; mp[128] = w2; mp[129] = w3;
    };
    for (int m = gw; m < M; m += 2 * NGW) { body(m, nb); if (m + NGW < M) body(m + NGW, nc); }
#undef PF_LOAD
}

__device__ __forceinline__ void phase_topk(LAS unsigned char* lds, const float* aff, int* idx, float* val, int* inv, int be, int tid, int wave, int lane) {
    LAS unsigned* hist = (LAS unsigned*)lds;
    LAS unsigned* ctl = hist + 256;
    LAS unsigned* wsum = hist + 320;
    const int b = be >> 4, e = be & 15;
    unsigned key[16];
#pragma unroll
    for (int i = 0; i < 16; ++i) key[i] = __float_as_uint(aff[((size_t)b * SEQ + tid * 16 + i) * 16 + e]);
    unsigned prefix = 0u, mask = 0u; unsigned krem = CAP;
    for (int pass = 0; pass < 4; ++pass) {
        const int shift = 24 - 8 * pass;
        if (tid < 256) hist[tid] = 0u;
        __syncthreads();
#pragma unroll
        for (int i = 0; i < 16; ++i) if ((key[i] & mask) == prefix) atomicAdd((unsigned*)&hist[(key[i] >> shift) & 255u], 1u);
        __syncthreads();
        if (wave == 0) {
            const u32x4 hb = *(const LAS u32x4*)(hist + 4 * lane); const unsigned sl = hb.x + hb.y + hb.z + hb.w;
            int Si = (int)sl; Si += dppi<0x101>(Si); Si += dppi<0x102>(Si); Si += dppi<0x104>(Si); Si += dppi<0x108>(Si);
            { const int t1 = __builtin_amdgcn_readlane(Si, 16), t2 = __builtin_amdgcn_readlane(Si, 32), t3 = __builtin_amdgcn_readlane(Si, 48); const int row = lane >> 4;
              Si += (row == 3 ? 0 : row == 2 ? t3 : row == 1 ? t3 + t2 : t3 + t2 + t1); }
            const unsigned S = (unsigned)Si;
            const unsigned above = S - sl;
            if (above < krem && krem <= above + sl) { unsigned cum = above; int d;
                if (cum + hb.w >= krem) d = 3; else { cum += hb.w; if (cum + hb.z >= krem) d = 2; else { cum += hb.z; if (cum + hb.y >= krem) d = 1; else { cum += hb.y; d = 0; } } }
                ctl[0] = prefix | ((unsigned)(4 * lane + d) << shift); ctl[1] = krem - cum; } }
        __syncthreads();
        prefix = ctl[0]; krem = ctl[1]; mask |= 255u << shift;
        __syncthreads();
    }
    const unsigned thr = prefix;
    int ngt = 0, neq = 0;
#pragma unroll
    for (int i = 0; i < 16; ++i) { ngt += key[i] > thr; neq += key[i] == thr; }
    const int sg = scan_fwd64_i(ngt, lane), sq = scan_fwd64_i(neq, lane);
    if (lane == 63) { wsum[wave] = (unsigned)sg; wsum[8 + wave] = (unsigned)sq; }
    __syncthreads();
    int bg = 0, bq = 0;
#pragma unroll
    for (int w = 0; w < 8; ++w) if (w < wave) { bg += (int)wsum[w]; bq += (int)wsum[8 + w]; }
    int pg = bg + sg - ngt, pq = bq + sq - neq;
#pragma unroll
    for (int i = 0; i < 16; ++i) {
        const int tok = tid * 16 + i; const bool gt = key[i] > thr, eq = key[i] == thr;
        const bool sel = gt || (eq && pq < (int)krem);
        const int slot = pg + (pq < (int)krem ? pq : (int)krem);
        if (sel) { idx[be * CAP + slot] = tok; val[be * CAP + slot] = __uint_as_float(key[i]); }
        inv[((size_t)b * SEQ + tok) * 16 + e] = sel ? slot : -1;
        pg += gt; pq += eq;
    }
    __syncthreads();
}

__device__ __forceinline__ void phase_gather(const bf16* XN, const int* idx, bf16* XG, int gw, int NGW, int lane) {
    for (int r = gw; r < MEXP; r += NGW) {
        const int b = r >> 14; const int tok = idx[r];
        const GAS u32x4* s = (const GAS u32x4*)(XN + ((size_t)b * SEQ + tok) * DM) + lane; GAS u32x4* d = (GAS u32x4*)(XG + (size_t)r * DM) + lane;
        const u32x4 a = s[0], c = s[64]; d[0] = a; d[64] = c;
    }
}

__device__ __forceinline__ void phase_combine(const bf16* hin, float* hout, const bf16* Y, const int* inv, const float* val, const float* wn, bf16* XN, bool final_, int gw, int NGW, int lane, float pscale = 1.0f) {
    f32x4 wv[4]; load_w4(wn, wv, lane);
    u32x2 nx[4], ny[4]; row_load4(hin + (size_t)gw * DM, nx, lane); int nslot = (lane < 16) ? inv[(size_t)gw * 16 + lane] : -1, nslot2 = -1;
    if (gw + NGW < M) { row_load4(hin + (size_t)(gw + NGW) * DM, ny, lane); nslot2 = (lane < 16) ? inv[(size_t)(gw + NGW) * 16 + lane] : -1; }
    auto body = [&](int m, u32x2 (&buf)[4], int& bslot) {
        const int b = m >> 13;
        f32x4 v[4];
        row_get(buf, v);
        const int myslot = bslot;
        if (m + 2 * NGW < M) { row_load4(hin + (size_t)(m + 2 * NGW) * DM, buf, lane); bslot = (lane < 16) ? inv[(size_t)(m + 2 * NGW) * 16 + lane] : -1; }
        unsigned mask = (unsigned)__builtin_amdgcn_ballot_w64(myslot >= 0) & 0xffffu;
        while (mask) {
            const int e0 = __builtin_ctz(mask); mask &= mask - 1u;
            const bool two = mask != 0u; const int e1 = two ? __builtin_ctz(mask) : e0; if (two) mask &= mask - 1u;
            const int s0 = __builtin_amdgcn_readlane(myslot, e0), s1 = __builtin_amdgcn_readlane(myslot, e1);
            const int r0 = (b * 16 + e0) * CAP + s0, r1 = (b * 16 + e1) * CAP + s1;
            const float a0 = val[r0]; const float a1 = two ? val[r1] : 0.f;
            const GAS u32x2* y0 = (const GAS u32x2*)(Y + (size_t)r0 * DM) + lane; const GAS u32x2* y1 = (const GAS u32x2*)(Y + (size_t)r1 * DM) + lane;
            u32x2 t0[4], t1[4];
#pragma unroll
            for (int j = 0; j < 4; ++j) { t0[j] = y0[64 * j]; t1[j] = y1[64 * j]; }
#pragma unroll
            for (int j = 0; j < 4; ++j) { const u32x2 t = t0[j];
                v[j].x += a0 * __uint_as_float(t.x << 16); v[j].y += a0 * __uint_as_float(t.x & 0xffff0000u); v[j].z += a0 * __uint_as_float(t.y << 16); v[j].w += a0 * __uint_as_float(t.y & 0xffff0000u); }
            if (two) {
#pragma unroll
                for (int j = 0; j < 4; ++j) { const u32x2 t = t1[j];
                    v[j].x += a1 * __uint_as_float(t.x << 16); v[j].y += a1 * __uint_as_float(t.x & 0xffff0000u); v[j].z += a1 * __uint_as_float(t.y << 16); v[j].w += a1 * __uint_as_float(t.y & 0xffff0000u); } }
        }
        float s2 = 0.f;
#pragma unroll
        for (int j = 0; j < 4; ++j) s2 += (v[j].x * v[j].x + v[j].y * v[j].y) + (v[j].z * v[j].z + v[j].w * v[j].w);
        const float rstd = __builtin_amdgcn_rsqf(wave_sum(s2) * (1.0f / DM) + EPS);
        if (final_) { GAS f32x4* ho = (GAS f32x4*)(hout + (size_t)m * DM) + lane;
#pragma unroll
            for (int j = 0; j < 4; ++j) ho[64 * j] = v[j] * (rstd * pscale) * wv[j];
        } else {
            store_row_bf16((bf16*)hout + (size_t)m * DM, v, lane);
            f32x4 nv[4];
#pragma unroll
            for (int j = 0; j < 4; ++j) nv[j] = v[j] * rstd * wv[j];
            store_row_bf16(XN + (size_t)m * DM, nv, lane);
        }
    };
    for (int m = gw; m < M; m += 2 * NGW) { body(m, nx, nslot); if (m + NGW < M) body(m + NGW, ny, nslot2); }
}
namespace gdn {
constexpr int CW = 0;
constexpr int SC = CW + 8 * 320 * 4;
constexpr int Q = SC + 1280;
constexpr int K = Q + 64 * 136 * 2;
constexpr int KDT = K + 64 * 136 * 2;
constexpr int VT = KDT + 128 * 72 * 2;
constexpr int T = VT + 64 * 72 * 2;
constexpr int QKD = T + 64 * 72 * 2;
constexpr int ST = QKD + 64 * 72 * 2;
constexpr int TMP = ST + 64 * 136 * 2;
constexpr int RQ = TMP, RK = RQ + 70 * 136 * 2, RV = RK + 70 * 136 * 2, RAW_END = RV + 70 * 72 * 2;
constexpr int AF = TMP, TF = AF + 64 * 68 * 4, XF = TF + 64 * 68 * 4, INV_END = XF + 3 * 16 * 17 * 4;
constexpr int RT = TMP, UT = RT + 64 * 72 * 2, OS = UT + 64 * 72 * 2, ST_END = OS + 64 * 65 * 4;
static_assert(RAW_END <= MISC_OFF && INV_END <= MISC_OFF && ST_END <= MISC_OFF, "gdn LDS map");
}
__device__ __forceinline__ void gdn_chain(LAS unsigned char* lds, int cid, const bf16* raw, const float* scal, const float* conv_w, const float* conv_b,
                                          const float* A_log, const float* dt_bias, bf16* og, int tid, int wave, int lane) {
    using namespace gdn;
    const int dvh = cid & 1, dir = (cid >> 1) & 1, h = (cid >> 2) & 7, b = cid >> 5;
    const int fr = lane & 15, fq = lane >> 4;
    LAS float* cw = (LAS float*)(lds + CW); LAS float* sc = (LAS float*)(lds + SC);
    LAS bf16* q_ = (LAS bf16*)(lds + Q); LAS bf16* k_ = (LAS bf16*)(lds + K); LAS bf16* kdT = (LAS bf16*)(lds + KDT); LAS bf16* vT = (LAS bf16*)(lds + VT);
    LAS bf16* T_ = (LAS bf16*)(lds + T); LAS bf16* QKd = (LAS bf16*)(lds + QKD); LAS bf16* ST_ = (LAS bf16*)(lds + ST);
    LAS bf16* rq = (LAS bf16*)(lds + RQ); LAS bf16* rk = (LAS bf16*)(lds + RK); LAS bf16* rv = (LAS bf16*)(lds + RV);
    LAS float* Af = (LAS float*)(lds + AF); LAS float* Tf = (LAS float*)(lds + TF); LAS float* Xf = (LAS float*)(lds + XF);
    LAS bf16* rT = (LAS bf16*)(lds + RT); LAS bf16* uT = (LAS bf16*)(lds + UT); LAS float* os = (LAS float*)(lds + OS);
    for (int e = tid; e < 8 * 320; e += 512) { const int r = e / 320, c = e % 320;
        const int gch = c < 128 ? h * 128 + c : (c < 256 ? 1024 + h * 128 + (c - 128) : 2048 + h * 128 + dvh * 64 + (c - 256));
        cw[e] = r < 7 ? conv_w[r * CONV_CH + gch] : conv_b[gch]; }
    for (int e = tid; e < 64 * 136 / 2; e += 512) ((LAS unsigned*)ST_)[e] = 0u;
    const float expA = expf(A_log[dir * 8 + h]), dtb = dt_bias[dir * 8 + h];
    f32x4 sacc[4];
#pragma unroll
    for (int nt = 0; nt < 4; ++nt) sacc[nt] = (f32x4){0.f, 0.f, 0.f, 0.f};
    const size_t rowb = (size_t)b * SEQ;
    __syncthreads();
    for (int n = 0; n < NCHUNK; ++n) {
        const int t0 = (dir ? NCHUNK - 1 - n : n) * 64;
        for (int e = tid; e < 70 * 40; e += 512) { const int r = e / 40, p = e % 40; const int t = t0 - 3 + r;
            u32x4 v = (u32x4){0u, 0u, 0u, 0u};
            const int col = p < 16 ? h * 128 + p * 8 : (p < 32 ? 1024 + h * 128 + (p - 16) * 8 : 2048 + h * 128 + dvh * 64 + (p - 32) * 8);
            if (t >= 0 && t < SEQ) v = *(const GAS u32x4*)(raw + (rowb + t) * CONV_CH + col);
            LAS bf16* d = p < 16 ? rq + r * 136 + p * 8 : (p < 32 ? rk + r * 136 + (p - 16) * 8 : rv + r * 72 + (p - 32) * 8);
            *(LAS u32x4*)d = v; }
        if (wave == 0) { const int i = lane; const int t = t0 + (dir ? 63 - i : i);
            const float braw = scal[(rowb + t) * 64 + dir * 8 + h], araw = scal[(rowb + t) * 64 + 16 + dir * 8 + h];
            const float g = -expA * softplus_f(araw + dtb);
            float gc = g;
#pragma unroll
            for (int o = 1; o < 64; o <<= 1) { const float y = __shfl_up(gc, o); if (i >= o) gc += y; }
            const float gl = __shfl(gc, 63);
            sc[i] = sigmoid_f(braw); sc[64 + i] = gc; sc[128 + i] = expf(gc); sc[192 + i] = expf(gl - gc); if (i == 0) sc[256] = expf(gl); }
        __syncthreads();
        { const int i = tid >> 3, cg = tid & 7; const int o = dir ? 63 - i : i;
          float a[16];
          conv16(a, rq + o * 136 + cg * 16, 136, cw + cg * 16, 320);
          float ss = 0.f;
#pragma unroll
          for (int c = 0; c < 16; ++c) { a[c] = silu(a[c]); ss += a[c] * a[c]; }
          ss += __shfl_xor(ss, 1); ss += __shfl_xor(ss, 2); ss += __shfl_xor(ss, 4);
          float rs = (1.0f / sqrtf(ss + EPS)) * 0.08838834764831845f;
          { u32x4 w0, w1; w0.x = pkbf(a[0] * rs, a[1] * rs); w0.y = pkbf(a[2] * rs, a[3] * rs); w0.z = pkbf(a[4] * rs, a[5] * rs); w0.w = pkbf(a[6] * rs, a[7] * rs);
            w1.x = pkbf(a[8] * rs, a[9] * rs); w1.y = pkbf(a[10] * rs, a[11] * rs); w1.z = pkbf(a[12] * rs, a[13] * rs); w1.w = pkbf(a[14] * rs, a[15] * rs);
            *(LAS u32x4*)(q_ + i * 136 + cg * 16) = w0; *(LAS u32x4*)(q_ + i * 136 + cg * 16 + 8) = w1; }
          conv16(a, rk + o * 136 + cg * 16, 136, cw + 128 + cg * 16, 320);
          ss = 0.f;
#pragma unroll
          for (int c = 0; c < 16; ++c) { a[c] = silu(a[c]); ss += a[c] * a[c]; }
          ss += __shfl_xor(ss, 1); ss += __shfl_xor(ss, 2); ss += __shfl_xor(ss, 4);
          rs = 1.0f / sqrtf(ss + EPS);
          { u32x4 w0, w1; w0.x = pkbf(a[0] * rs, a[1] * rs); w0.y = pkbf(a[2] * rs, a[3] * rs); w0.z = pkbf(a[4] * rs, a[5] * rs); w0.w = pkbf(a[6] * rs, a[7] * rs);
            w1.x = pkbf(a[8] * rs, a[9] * rs); w1.y = pkbf(a[10] * rs, a[11] * rs); w1.z = pkbf(a[12] * rs, a[13] * rs); w1.w = pkbf(a[14] * rs, a[15] * rs);
            *(LAS u32x4*)(k_ + i * 136 + cg * 16) = w0; *(LAS u32x4*)(k_ + i * 136 + cg * 16 + 8) = w1; }
          const float ek = sc[192 + i] * rs;
#pragma unroll
          for (int c = 0; c < 16; ++c) kdT[(cg * 16 + c) * 72 + i] = f2bf1(a[c] * ek);
          float v8[8];
          conv8(v8, rv + o * 72 + cg * 8, 72, cw + 256 + cg * 8, 320);
#pragma unroll
          for (int c = 0; c < 8; ++c) vT[(cg * 8 + c) * 72 + i] = f2bf1(silu(v8[c]));
        }
        __syncthreads();
        { const int which = wave >> 2, mt = wave & 3;
          f32x4 acc[1][4];
#pragma unroll
          for (int nt = 0; nt < 4; ++nt) acc[0][nt] = (f32x4){0.f, 0.f, 0.f, 0.f};
          mma_lds<1, 4>(acc, which ? q_ : k_, 136, mt * 16, k_, 136, 0, 128, fr, fq);
#pragma unroll
          for (int nt = 0; nt < 4; ++nt)
#pragma unroll
              for (int r = 0; r < 4; ++r) { const int i = mt * 16 + 4 * fq + r, j = nt * 16 + fr;
                  const float d = expf(fminf(sc[64 + i] - sc[64 + j], 0.f)); const float x = acc[0][nt][r] * d;
                  if (which == 0) Af[i * 68 + j] = (i > j) ? sc[i] * x : 0.f;
                  else QKd[i * 72 + j] = f2bf1((i >= j) ? x : 0.f); }
        }
        __syncthreads();
        if (wave == 0) { const int blk = lane >> 4, c = lane & 15; float t[16];
#pragma unroll
            for (int i = 0; i < 16; ++i) t[i] = (i == c) ? 1.f : 0.f;
#pragma unroll
            for (int i = 1; i < 16; ++i) { float s = 0.f; const LAS float* ar = Af + (blk * 16 + i) * 68 + blk * 16;
#pragma unroll
                for (int j = 0; j < i; ++j) s += ar[j] * t[j];
                t[i] = (i > c) ? -s : t[i];
                if ((i & 3) == 3) asm volatile("" ::: "memory"); }
#pragma unroll
            for (int i = 0; i < 16; ++i) Tf[(blk * 16 + i) * 68 + blk * 16 + c] = t[i]; }
        for (int d = 1; d <= 3; ++d) { const int nbk = 4 - d;
            __syncthreads();
            for (int e = tid; e < nbk * 256; e += 512) { const int J = e >> 8, r = (e >> 4) & 15, c = e & 15, I = J + d; float s = 0.f;
                for (int kk = J * 16; kk < I * 16; ++kk) s += Af[(I * 16 + r) * 68 + kk] * Tf[kk * 68 + J * 16 + c];
                Xf[(J * 16 + r) * 17 + c] = s; }
            __syncthreads();
            for (int e = tid; e < nbk * 256; e += 512) { const int J = e >> 8, r = (e >> 4) & 15, c = e & 15, I = J + d; float s = 0.f;
#pragma unroll
                for (int m2 = 0; m2 < 16; ++m2) s += Tf[(I * 16 + r) * 68 + I * 16 + m2] * Xf[(J * 16 + m2) * 17 + c];
                Tf[(I * 16 + r) * 68 + J * 16 + c] = -s; }
        }
        __syncthreads();
        for (int e = tid; e < 4096; e += 512) { const int i = e >> 6, j = e & 63; T_[i * 72 + j] = f2bf1(((i >> 4) >= (j >> 4)) ? Tf[i * 68 + j] : 0.f); }
        __syncthreads();
        const int mt = wave & 3, nh = wave >> 2;
        f32x4 aq[2];
        { f32x4 ak[2]; ak[0] = ak[1] = aq[0] = aq[1] = (f32x4){0.f, 0.f, 0.f, 0.f};
          for (int k0 = 0; k0 < 128; k0 += 32) {
              const bf16x8 fk = *(const LAS bf16x8*)(k_ + (mt * 16 + fr) * 136 + k0 + fq * 8), fqv = *(const LAS bf16x8*)(q_ + (mt * 16 + fr) * 136 + k0 + fq * 8);
#pragma unroll
              for (int nl = 0; nl < 2; ++nl) { const bf16x8 fb = *(const LAS bf16x8*)(ST_ + (nh * 32 + nl * 16 + fr) * 136 + k0 + fq * 8);
                  ak[nl] = __builtin_amdgcn_mfma_f32_16x16x32_bf16(fk, fb, ak[nl], 0, 0, 0); aq[nl] = __builtin_amdgcn_mfma_f32_16x16x32_bf16(fqv, fb, aq[nl], 0, 0, 0); } }
          const int i0 = mt * 16 + 4 * fq;
          const f32x4 be4 = *(const LAS f32x4*)(sc + i0), eg4 = *(const LAS f32x4*)(sc + 128 + i0);
#pragma unroll
          for (int nl = 0; nl < 2; ++nl) { const int dv = nh * 32 + nl * 16 + fr;
              const bf16x4 vv = *(const LAS bf16x4*)(vT + dv * 72 + i0);
              float r0 = be4[0] * (bf2f_s(vv[0]) - eg4[0] * ak[nl][0]), r1 = be4[1] * (bf2f_s(vv[1]) - eg4[1] * ak[nl][1]);
              float r2 = be4[2] * (bf2f_s(vv[2]) - eg4[2] * ak[nl][2]), r3 = be4[3] * (bf2f_s(vv[3]) - eg4[3] * ak[nl][3]);
              u32x2 w; w.x = pkbf(r0, r1); w.y = pkbf(r2, r3); *(LAS u32x2*)(rT + dv * 72 + i0) = w;
              aq[nl][0] *= eg4[0]; aq[nl][1] *= eg4[1]; aq[nl][2] *= eg4[2]; aq[nl][3] *= eg4[3]; }
        }
        __syncthreads();
        { f32x4 au[1][2]; au[0][0] = au[0][1] = (f32x4){0.f, 0.f, 0.f, 0.f};
          mma_lds<1, 2>(au, T_, 72, mt * 16, rT, 72, nh * 32, 64, fr, fq);
          const int i0 = mt * 16 + 4 * fq;
#pragma unroll
          for (int nl = 0; nl < 2; ++nl) { const int dv = nh * 32 + nl * 16 + fr; u32x2 w; w.x = pkbf(au[0][nl][0], au[0][nl][1]); w.y = pkbf(au[0][nl][2], au[0][nl][3]); *(LAS u32x2*)(uT + dv * 72 + i0) = w; }
        }
        __syncthreads();
        { f32x4 ao[1][2]; ao[0][0] = aq[0]; ao[0][1] = aq[1];
          mma_lds<1, 2>(ao, QKd, 72, mt * 16, uT, 72, nh * 32, 64, fr, fq);
          const int i0 = mt * 16 + 4 * fq;
#pragma unroll
          for (int nl = 0; nl < 2; ++nl)
#pragma unroll
              for (int r = 0; r < 4; ++r) os[(i0 + r) * 65 + nh * 32 + nl * 16 + fr] = ao[0][nl][r];
          const float egl = sc[256];
          f32x4 as_[1][4];
#pragma unroll
          for (int nt = 0; nt < 4; ++nt) as_[0][nt] = sacc[nt] * egl;
          mma_lds<1, 4>(as_, kdT, 72, wave * 16, uT, 72, 0, 64, fr, fq);
#pragma unroll
          for (int nt = 0; nt < 4; ++nt) { sacc[nt] = as_[0][nt];
              u32x2 w; w.x = pkbf(sacc[nt][0], sacc[nt][1]); w.y = pkbf(sacc[nt][2], sacc[nt][3]); *(LAS u32x2*)(ST_ + (nt * 16 + fr) * 136 + wave * 16 + 4 * fq) = w; }
        }
        __syncthreads();
#pragma unroll
        for (int ii = 0; ii < 4; ++ii) { const int i = wave * 8 + 2 * ii + (lane >> 5), cp = lane & 31; const int t = t0 + (dir ? 63 - i : i);
            atomic_add_bf16x2(og + (rowb + t) * 1024 + h * 128 + dvh * 64 + 2 * cp, os[i * 65 + 2 * cp], os[i * 65 + 2 * cp + 1]); }
        __syncthreads();
    }
}

namespace ssd {
constexpr int CW = 0;
constexpr int SC = CW + 8 * 320 * 4;
constexpr int BM_ = SC + 1280;
constexpr int CM_ = BM_ + 64 * 136 * 2;
constexpr int BT = CM_ + 64 * 136 * 2;
constexpr int XDT = BT + 128 * 72 * 2;
constexpr int XDW = XDT + 64 * 72 * 2;
constexpr int MM = XDW + 64 * 72 * 2;
constexpr int HT = MM + 64 * 72 * 2;
constexpr int TMP = HT + 64 * 136 * 2;
constexpr int RX = TMP, RB = RX + 70 * 72 * 2, RC = RB + 70 * 136 * 2, RAW_END = RC + 70 * 136 * 2;
constexpr int OS = TMP, OS_END = OS + 64 * 65 * 4;
static_assert(RAW_END <= MISC_OFF && OS_END <= MISC_OFF, "ssd LDS map");
}
__device__ __forceinline__ void ssd_chain(LAS unsigned char* lds, int cid, const bf16* raw, const float* scal, const float* conv_w, const float* conv_b,
                                          const float* A_log, const float* dt_bias, const float* Dp, bf16* ys, int tid, int wave, int lane) {
    using namespace ssd;
    const int dir = cid & 1, head = (cid >> 1) & 15, b = cid >> 5; const int g = head >> 3;
    const int fr = lane & 15, fq = lane >> 4;
    LAS float* cw = (LAS float*)(lds + CW); LAS float* sc = (LAS float*)(lds + SC);
    LAS bf16* Bm = (LAS bf16*)(lds + BM_); LAS bf16* Cm = (LAS bf16*)(lds + CM_); LAS bf16* BT_ = (LAS bf16*)(lds + BT);
    LAS bf16* xdt = (LAS bf16*)(lds + XDT); LAS bf16* xdw = (LAS bf16*)(lds + XDW); LAS bf16* Mm = (LAS bf16*)(lds + MM); LAS bf16* hT = (LAS bf16*)(lds + HT);
    LAS bf16* rx = (LAS bf16*)(lds + RX); LAS bf16* rb = (LAS bf16*)(lds + RB); LAS bf16* rc = (LAS bf16*)(lds + RC); LAS float* os = (LAS float*)(lds + OS);
    const int chx = 3072 + head * 64, chb = 4096 + g * 128, chc = 4352 + g * 128;
    for (int e = tid; e < 8 * 320; e += 512) { const int r = e / 320, c = e % 320;
        const int gch = c < 64 ? chx + c : (c < 192 ? chb + (c - 64) : chc + (c - 192));
        cw[e] = r < 7 ? conv_w[r * CONV_CH + gch] : conv_b[gch]; }
    for (int e = tid; e < 64 * 136 / 2; e += 512) ((LAS unsigned*)hT)[e] = 0u;
    const float Ah = -expf(A_log[dir * 16 + head]), dtb = dt_bias[dir * 16 + head], Dh = (dir == 0) ? Dp[head] : 0.f;
    f32x4 hacc[4];
#pragma unroll
    for (int nt = 0; nt < 4; ++nt) hacc[nt] = (f32x4){0.f, 0.f, 0.f, 0.f};
    const size_t rowb = (size_t)b * SEQ;
    __syncthreads();
    for (int n = 0; n < NCHUNK; ++n) {
        const int t0 = (dir ? NCHUNK - 1 - n : n) * 64;
        for (int e = tid; e < 70 * 40; e += 512) { const int r = e / 40, p = e % 40; const int t = t0 - 3 + r;
            u32x4 v = (u32x4){0u, 0u, 0u, 0u};
            const int col = p < 8 ? chx + p * 8 : (p < 24 ? chb + (p - 8) * 8 : chc + (p - 24) * 8);
            if (t >= 0 && t < SEQ) v = *(const GAS u32x4*)(raw + (rowb + t) * CONV_CH + col);
            LAS bf16* d = p < 8 ? rx + r * 72 + p * 8 : (p < 24 ? rb + r * 136 + (p - 8) * 8 : rc + r * 136 + (p - 24) * 8);
            *(LAS u32x4*)d = v; }
        if (wave == 0) { const int i = lane; const int t = t0 + (dir ? 63 - i : i);
            const float dt = softplus_f(scal[(rowb + t) * 64 + 32 + dir * 16 + head] + dtb);
            float cs = dt * Ah;
#pragma unroll
            for (int o = 1; o < 64; o <<= 1) { const float y = __shfl_up(cs, o); if (i >= o) cs += y; }
            const float cl = __shfl(cs, 63);
            sc[i] = dt; sc[64 + i] = cs; sc[128 + i] = expf(cs); sc[192 + i] = expf(cl - cs); if (i == 0) sc[256] = expf(cl); }
        __syncthreads();
        { const int i = tid >> 3, cg = tid & 7; const int o = dir ? 63 - i : i;
          float a[16];
          conv16(a, rb + o * 136 + cg * 16, 136, cw + 64 + cg * 16, 320);
#pragma unroll
          for (int c = 0; c < 16; ++c) a[c] = silu(a[c]);
          { u32x4 w0, w1; w0.x = pkbf(a[0], a[1]); w0.y = pkbf(a[2], a[3]); w0.z = pkbf(a[4], a[5]); w0.w = pkbf(a[6], a[7]);
            w1.x = pkbf(a[8], a[9]); w1.y = pkbf(a[10], a[11]); w1.z = pkbf(a[12], a[13]); w1.w = pkbf(a[14], a[15]);
            *(LAS u32x4*)(Bm + i * 136 + cg * 16) = w0; *(LAS u32x4*)(Bm + i * 136 + cg * 16 + 8) = w1; }
#pragma unroll
          for (int c = 0; c < 16; ++c) BT_[(cg * 16 + c) * 72 + i] = f2bf1(a[c]);
          conv16(a, rc + o * 136 + cg * 16, 136, cw + 192 + cg * 16, 320);
#pragma unroll
          for (int c = 0; c < 16; ++c) a[c] = silu(a[c]);
          { u32x4 w0, w1; w0.x = pkbf(a[0], a[1]); w0.y = pkbf(a[2], a[3]); w0.z = pkbf(a[4], a[5]); w0.w = pkbf(a[6], a[7]);
            w1.x = pkbf(a[8], a[9]); w1.y = pkbf(a[10], a[11]); w1.z = pkbf(a[12], a[13]); w1.w = pkbf(a[14], a[15]);
            *(LAS u32x4*)(Cm + i * 136 + cg * 16) = w0; *(LAS u32x4*)(Cm + i * 136 + cg * 16 + 8) = w1; }
          float x8[8];
          conv8(x8, rx + o * 72 + cg * 8, 72, cw + cg * 8, 320);
          const float dt = sc[i], wst = sc[192 + i];
#pragma unroll
          for (int c = 0; c < 8; ++c) { const float xv = silu(x8[c]) * dt; xdt[(cg * 8 + c) * 72 + i] = f2bf1(xv); xdw[(cg * 8 + c) * 72 + i] = f2bf1(xv * wst); }
        }
        __syncthreads();
        const int mt = wave & 3, nh = wave >> 2;
        { f32x4 acc[1][2]; acc[0][0] = acc[0][1] = (f32x4){0.f, 0.f, 0.f, 0.f};
          mma_lds<1, 2>(acc, Cm, 136, mt * 16, Bm, 136, nh * 32, 128, fr, fq);
#pragma unroll
          for (int nl = 0; nl < 2; ++nl)
#pragma unroll
              for (int r = 0; r < 4; ++r) { const int i = mt * 16 + 4 * fq + r, j = nh * 32 + nl * 16 + fr;
                  const float d = expf(fminf(sc[64 + i] - sc[64 + j], 0.f));
                  Mm[i * 72 + j] = f2bf1((i >= j) ? acc[0][nl][r] * d : 0.f); }
        }
        __syncthreads();
        { f32x4 a1[1][2], a2[1][2]; a1[0][0] = a1[0][1] = a2[0][0] = a2[0][1] = (f32x4){0.f, 0.f, 0.f, 0.f};
          mma_lds<1, 2>(a1, Mm, 72, mt * 16, xdt, 72, nh * 32, 64, fr, fq);
          mma_lds<1, 2>(a2, Cm, 136, mt * 16, hT, 136, nh * 32, 128, fr, fq);
          const int i0 = mt * 16 + 4 * fq;
          const f32x4 ec4 = *(const LAS f32x4*)(sc + 128 + i0), dt4 = *(const LAS f32x4*)(sc + i0);
#pragma unroll
          for (int nl = 0; nl < 2; ++nl) { const int p = nh * 32 + nl * 16 + fr; const bf16x4 xv = *(const LAS bf16x4*)(xdt + p * 72 + i0);
#pragma unroll
              for (int r = 0; r < 4; ++r) os[(i0 + r) * 65 + p] = a1[0][nl][r] + ec4[r] * a2[0][nl][r] + Dh * bf2f_s(xv[r]) / dt4[r]; }
        }
        __syncthreads();
        { const float ecl = sc[256];
          f32x4 ah[1][4];
#pragma unroll
          for (int nt = 0; nt < 4; ++nt) ah[0][nt] = hacc[nt] * ecl;
          mma_lds<1, 4>(ah, BT_, 72, wave * 16, xdw, 72, 0, 64, fr, fq);
#pragma unroll
          for (int nt = 0; nt < 4; ++nt) { hacc[nt] = ah[0][nt];
              u32x2 w; w.x = pkbf(hacc[nt][0], hacc[nt][1]); w.y = pkbf(hacc[nt][2], hacc[nt][3]); *(LAS u32x2*)(hT + (nt * 16 + fr) * 136 + wave * 16 + 4 * fq) = w; }
        }
#pragma unroll
        for (int ii = 0; ii < 4; ++ii) { const int i = wave * 8 + 2 * ii + (lane >> 5), cp = lane & 31; const int t = t0 + (dir ? 63 - i : i);
            atomic_add_bf16x2(ys + (rowb + t) * 1024 + head * 64 + 2 * cp, os[i * 65 + 2 * cp], os[i * 65 + 2 * cp + 1]); }
        __syncthreads();
    }
}
namespace pgd {
constexpr int CW = 0;
constexpr int SC = CW + 8 * 384 * 4;
constexpr int Q = SC + 1280;
constexpr int K = Q + 64 * 136 * 2;
constexpr int VT = K + 64 * 136 * 2;
constexpr int TMP = VT + 128 * 72 * 2;
constexpr int RQ = TMP, RK = RQ + 70 * 136 * 2, RV = RK + 70 * 136 * 2, RAW_END = RV + 70 * 136 * 2;
constexpr int AF = TMP, A2F = AF + 64 * 68 * 4, TF = A2F + 64 * 68 * 4, T2F = TF + 64 * 68 * 4, QKP = T2F + 64 * 68 * 4, INV_END = QKP + 64 * 72 * 2;
constexpr int XF = VT;
constexpr int TP = AF;
constexpr int STASH = MISC_OFF - 16384;
static_assert(RAW_END <= STASH && INV_END <= STASH, "prep gdn LDS map");
}
constexpr size_t WS_TQ = 379 * MiB;

__device__ __forceinline__ void prep_gdn_stash(LAS unsigned char* lds, int bid, const bf16* raw, int tid) {
    const int bh = bid >> 3, b = bh >> 3, h = bh & 7, r8 = bid & 7;
    LAS bf16* st = (LAS bf16*)(lds + pgd::STASH);
    for (int e = tid; e < 2 * 3 * 48; e += 512) { const int which = e / 144, r = (e % 144) / 48, p = e % 48;
        const int t = which ? (r8 * 16 + 16) * 64 + r : r8 * 16 * 64 - 3 + r;
        const int col = p < 16 ? h * 128 + p * 8 : (p < 32 ? 1024 + h * 128 + (p - 16) * 8 : 2048 + h * 128 + (p - 32) * 8);
        u32x4 v = (u32x4){0u, 0u, 0u, 0u};
        if (t >= 0 && t < SEQ) v = *(const GAS u32x4*)(raw + ((size_t)b * SEQ + t) * CONV_CH + col);
        *(LAS u32x4*)(st + which * 1152 + r * 384 + p * 8) = v; }
}
__device__ __forceinline__ void inv_diag_blocks(const LAS float* Af, LAS float* Tf, int lane) {
    const int blk = lane >> 4, c = lane & 15; float t[16];
#pragma unroll
    for (int i = 0; i < 16; ++i) t[i] = (i == c) ? 1.f : 0.f;
#pragma unroll
    for (int i = 1; i < 16; ++i) { float s = 0.f; const LAS float* ar = Af + (blk * 16 + i) * 68 + blk * 16;
#pragma unroll
        for (int j = 0; j < i; ++j) s += ar[j] * t[j];
        t[i] = (i > c) ? -s : t[i];
        if ((i & 3) == 3) asm volatile("" ::: "memory"); }
#pragma unroll
    for (int i = 0; i < 16; ++i) Tf[(blk * 16 + i) * 68 + blk * 16 + c] = t[i];
}
__device__ __forceinline__ void inv_offdiag_x(const LAS float* Af, const LAS float* Tf, LAS float* Xf, int d, int ht) {
    const int nbk = 4 - d;
    for (int e = ht; e < nbk * 256; e += 256) { const int J = e >> 8, r = (e >> 4) & 15, c = e & 15, I = J + d; float s = 0.f;
        for (int kk = J * 16; kk < I * 16; ++kk) s += Af[(I * 16 + r) * 68 + kk] * Tf[kk * 68 + J * 16 + c];
        Xf[(J * 16 + r) * 17 + c] = s; }
}
__device__ __forceinline__ void inv_offdiag_t(LAS float* Tf, const LAS float* Xf, int d, int ht) {
    const int nbk = 4 - d;
    for (int e = ht; e < nbk * 256; e += 256) { const int J = e >> 8, r = (e >> 4) & 15, c = e & 15, I = J + d; float s = 0.f;
#pragma unroll
        for (int m2 = 0; m2 < 16; ++m2) s += Tf[(I * 16 + r) * 68 + I * 16 + m2] * Xf[(J * 16 + m2) * 17 + c];
        Tf[(I * 16 + r) * 68 + J * 16 + c] = -s; }
}

__device__ __forceinline__ void conv_pair8(float (&o)[16], const LAS bf16* src  , int ld, const float (&w)[16]) {
#pragma unroll
    for (int t = 0; t < 8; ++t) { o[2 * t] = w[14]; o[2 * t + 1] = w[15]; }
#pragma unroll
    for (int r = 0; r < 14; ++r) { const unsigned xv = *(const LAS unsigned*)(src + r * ld); const float x0 = __uint_as_float(xv << 16), x1 = __uint_as_float(xv & 0xffff0000u);
#pragma unroll
        for (int t = 0; t < 8; ++t) { const int tap = r - t; if (tap >= 0 && tap < 7) { o[2 * t] += x0 * w[2 * tap]; o[2 * t + 1] += x1 * w[2 * tap + 1]; } } }
}
namespace pg2 {
constexpr int CW = 0;
constexpr int SC = CW + 8 * 384 * 4;
constexpr int Q = SC + 1280;
constexpr int K = Q + 64 * 136 * 2;
constexpr int VT = K + 64 * 136 * 2;
constexpr int RAWT = VT + 128 * 72 * 2;
constexpr int RAW_END = RAWT + 3 * 70 * 136 * 2;
constexpr int ABF = RAWT, TRM = ABF + 2 * 64 * 72 * 2, TTR = TRM + 2 * 64 * 72 * 2, AD = TTR + 2 * 64 * 72 * 2, XS = AD + 2 * 4 * 256 * 4, QKP = XS + 2 * 32 * 40 * 2, INV_END = QKP + 64 * 72 * 2;
static_assert(RAW_END <= pgd::STASH && INV_END <= pgd::STASH, "prep gdn v2 LDS map");
}
template <int XP = 0>
__device__ __forceinline__ void prep_gdn_range(LAS unsigned char* lds, int bid, bf16* raw, const float* scal, const float* conv_w, const float* conv_b,
                                               const float* A_log, const float* dt_bias, bf16* TQ, int tid_p, int wave_p, int lane_p, float* scal_w, bf16* rwb = nullptr) {
    using namespace pg2;
    int tid = tid_p, wave = wave_p, lane = lane_p;
    const int bh = bid >> 3, b = bh >> 3, h = bh & 7, r8 = bid & 7;
    LAS float* cw = (LAS float*)(lds + CW); LAS float* sc = (LAS float*)(lds + SC);
    LAS bf16* q_ = (LAS bf16*)(lds + Q); LAS bf16* k_ = (LAS bf16*)(lds + K); LAS bf16* vT = (LAS bf16*)(lds + VT);
    LAS bf16* rq = (LAS bf16*)(lds + RAWT); LAS bf16* rk = rq + 70 * 136; LAS bf16* rv = rk + 70 * 136;
    LAS bf16* Abf = (LAS bf16*)(lds + ABF); LAS bf16* Trm = (LAS bf16*)(lds + TRM); LAS bf16* Ttr = (LAS bf16*)(lds + TTR);
    LAS float* ADf = (LAS float*)(lds + AD); LAS bf16* Xs = (LAS bf16*)(lds + XS); LAS bf16* QKp = (LAS bf16*)(lds + QKP);
    LAS bf16* st = (LAS bf16*)(lds + pgd::STASH);
    for (int e = tid; e < 8 * 384; e += 512) { const int r = e / 384, c = e % 384;
        const int gch = (c >> 7) * 1024 + h * 128 + (c & 127);
        cw[e] = r < 7 ? conv_w[r * CONV_CH + gch] : conv_b[gch]; }
    const float LOG2E = 1.4426950408889634f;
    const float expAf = expf(A_log[h]), dtbf = dt_bias[h], expAb = expf(A_log[8 + h]), dtbb = dt_bias[8 + h];
    const size_t rowb = (size_t)b * SEQ;
    bf16* const raww = XP ? rwb : raw; const size_t rowbw = XP ? (size_t)0 : rowb; const int bhw = XP ? (bh & 15) : bh;
    u32x4 pre[7];
#define PG2_LOAD(u_) do { const int t0_ = (r8 * 16 + (u_)) * 64; \
        _Pragma("unroll") for (int x = 0; x < 7; ++x) { const int e = tid + 512 * x; const int r = e / 48, p = e % 48; \
            pre[x] = (u32x4){0u, 0u, 0u, 0u}; \
            if (e < 70 * 48 && r >= 3 && !(r >= 67 && (u_) == 15)) { const int col = p < 16 ? h * 128 + p * 8 : (p < 32 ? 1024 + h * 128 + (p - 16) * 8 : 2048 + h * 128 + (p - 32) * 8); \
                pre[x] = *(const GAS u32x4*)(raw + (rowb + t0_ - 3 + r) * CONV_CH + col); } } } while (0)
    PG2_LOAD(0);
    float psa = 0.f, psb = 0.f;
#define PG2_LOADS(u_) do { if (wave < 2) { const size_t so_ = (rowb + (size_t)(r8 * 16 + (u_)) * 64 + lane) * 64; psa = scal[so_ + 16 + 8 * wave + h]; psb = scal[so_ + 8 * wave + h]; } } while (0)
    PG2_LOADS(0);
    __syncthreads();
#define PG2_STAGEA(u_) do { const int t0_ = (r8 * 16 + (u_)) * 64; \
        _Pragma("unroll") for (int x = 0; x < 7; ++x) { const int e = tid + 512 * x; const int r = e / 48, p = e % 48; \
            if (e < 70 * 48) { u32x4 v = pre[x]; \
                if (r < 3) v = *(const LAS u32x4*)(st + r * 384 + p * 8); \
                else if (r >= 67 && (u_) == 15) v = *(const LAS u32x4*)(st + 1152 + (r - 67) * 384 + p * 8); \
                *(LAS u32x4*)((p < 16 ? rq + r * 136 + p * 8 : (p < 32 ? rk + r * 136 + (p - 16) * 8 : rv + r * 136 + (p - 32) * 8))) = v; } } \
        if (wave == 0) { const int i = lane; const size_t so = (rowbw + t0_ + i) * 64; \
            const float gc = scan_fwd64(-expAf * softplus_fast(psa + dtbf), i); \
            const float be_ = sigmoid_fast(psb); sc[i] = be_; sc[64 + i] = gc * LOG2E; scal_w[so + h] = be_; scal_w[so + 16 + h] = gc; } \
        if (wave == 1) { const int i = lane; const size_t so = (rowbw + t0_ + i) * 64; \
            const float gc = scan_bwd64(-expAb * softplus_fast(psa + dtbb), i); \
            const float be_ = sigmoid_fast(psb); sc[128 + i] = be_; sc[192 + i] = gc * LOG2E; scal_w[so + 8 + h] = be_; scal_w[so + 24 + h] = gc; } } while (0)
    PG2_STAGEA(0);
    PG2_LOAD(1); PG2_LOADS(1);
    __syncthreads();
    for (int u = 0; u < 16; ++u) {
        tid = tid_p; asm volatile("" : "+v"(tid));
        lane = tid & 63; wave = __builtin_amdgcn_readfirstlane(tid >> 6);
        const int fr = lane & 15, fq = lane >> 4, half = wave >> 2, w4 = wave & 3;
        const int c = r8 * 16 + u, t0 = c * 64;
        if (tid < 144) { const int r = tid / 48, p = tid % 48;
            const LAS bf16* s = p < 16 ? rq + (64 + r) * 136 + p * 8 : (p < 32 ? rk + (64 + r) * 136 + (p - 16) * 8 : rv + (64 + r) * 136 + (p - 32) * 8);
            *(LAS u32x4*)(st + r * 384 + p * 8) = *(const LAS u32x4*)s; }
        if (!(XP & 1)) { const int tg = wave, cp = lane; float w[16], o[16];
#pragma unroll
          for (int tap = 0; tap < 8; ++tap) { w[2 * tap] = cw[tap * 384 + 2 * cp]; w[2 * tap + 1] = cw[tap * 384 + 2 * cp + 1]; }
          conv_pair8(o, rq + (8 * tg) * 136 + 2 * cp, 136, w);
#pragma unroll
          for (int t = 0; t < 8; ++t) { o[2 * t] = silu(o[2 * t]); o[2 * t + 1] = silu(o[2 * t + 1]);
              const float rs = __builtin_amdgcn_rsqf(wave_sum(o[2 * t] * o[2 * t] + o[2 * t + 1] * o[2 * t + 1]) + EPS) * 0.08838834764831845f;
              const unsigned pk = pkbf(o[2 * t] * rs, o[2 * t + 1] * rs);
              *(LAS unsigned*)(q_ + (8 * tg + t) * 136 + 2 * cp) = pk; if (!(XP & 8)) *(GAS unsigned*)(raww + (rowbw + t0 + 8 * tg + t) * CONV_CH + h * 128 + 2 * cp) = pk; }
#pragma unroll
          for (int tap = 0; tap < 8; ++tap) { w[2 * tap] = cw[tap * 384 + 128 + 2 * cp]; w[2 * tap + 1] = cw[tap * 384 + 128 + 2 * cp + 1]; }
          conv_pair8(o, rk + (8 * tg) * 136 + 2 * cp, 136, w);
#pragma unroll
          for (int t = 0; t < 8; ++t) { o[2 * t] = silu(o[2 * t]); o[2 * t + 1] = silu(o[2 * t + 1]);
              const float rs = __builtin_amdgcn_rsqf(wave_sum(o[2 * t] * o[2 * t] + o[2 * t + 1] * o[2 * t + 1]) + EPS);
              const unsigned pk = pkbf(o[2 * t] * rs, o[2 * t + 1] * rs);
              *(LAS unsigned*)(k_ + (8 * tg + t) * 136 + 2 * cp) = pk; if (!(XP & 8)) *(GAS unsigned*)(raww + (rowbw + t0 + 8 * tg + t) * CONV_CH + 1024 + h * 128 + 2 * cp) = pk; }
#pragma unroll
          for (int tap = 0; tap < 8; ++tap) { w[2 * tap] = cw[tap * 384 + 256 + 2 * cp]; w[2 * tap + 1] = cw[tap * 384 + 256 + 2 * cp + 1]; }
          conv_pair8(o, rv + (8 * tg) * 136 + 2 * cp, 136, w);
#pragma unroll
          for (int t = 0; t < 16; ++t) o[t] = silu(o[t]);
          u32x4 e0, e1; e0.x = pkbf(o[0], o[2]); e0.y = pkbf(o[4], o[6]); e0.z = pkbf(o[8], o[10]); e0.w = pkbf(o[12], o[14]);
          e1.x = pkbf(o[1], o[3]); e1.y = pkbf(o[5], o[7]); e1.z = pkbf(o[9], o[11]); e1.w = pkbf(o[13], o[15]);
          *(LAS u32x4*)(vT + (2 * cp) * 72 + 8 * tg) = e0; *(LAS u32x4*)(vT + (2 * cp + 1) * 72 + 8 * tg) = e1;
        }
        __syncthreads();
        for (int e = tid; e < 128 * 8; e += 512) { const int dv = e >> 3, p = e & 7;
            if (!(XP & 8)) *(GAS u32x4*)(raww + (rowbw + t0 + (dv >> 1)) * CONV_CH + 2048 + h * 128 + (dv & 1) * 64 + p * 8) = *(const LAS u32x4*)(vT + dv * 72 + p * 8); }
        for (int e = tid; e < 2 * 2 * 64 * 72 * 2 / 16; e += 512) ((LAS u32x4*)(lds + TRM))[e] = (u32x4){0u, 0u, 0u, 0u};
        for (int e = tid; e < 2 * 32 * 40 * 2 / 16; e += 512) ((LAS u32x4*)(lds + XS))[e] = (u32x4){0u, 0u, 0u, 0u};
        if (!(XP & 4)) { const int mt = w4;
          f32x4 acc[1][4];
#pragma unroll
          for (int nt = 0; nt < 4; ++nt) acc[0][nt] = (f32x4){0.f, 0.f, 0.f, 0.f};
          mma_lds<1, 4>(acc, half ? q_ : k_, 136, mt * 16, k_, 136, 0, 128, fr, fq);
          const int i0 = mt * 16 + 4 * fq;
          const f32x4 gfi = *(const LAS f32x4*)(sc + 64 + i0), gbi = *(const LAS f32x4*)(sc + 192 + i0), bfi = *(const LAS f32x4*)(sc + i0), bbi = *(const LAS f32x4*)(sc + 128 + i0);
          float gfj[4], gbj[4];
#pragma unroll
          for (int nt = 0; nt < 4; ++nt) { gfj[nt] = sc[64 + nt * 16 + fr]; gbj[nt] = sc[192 + nt * 16 + fr]; }
          asm volatile("" ::: "memory");
#pragma unroll
          for (int nt = 0; nt < 4; ++nt)
#pragma unroll
              for (int r = 0; r < 4; ++r) { const int i = i0 + r, j = nt * 16 + fr; const bool lower = i > j, upper = i < j;
                  const float argl = gfi[r] - gfj[nt], argu = gbi[r] - gbj[nt];
                  const float x = acc[0][nt][r] * __builtin_amdgcn_exp2f(fminf(lower ? argl : argu, 0.f));
                  if (half == 0) { const float af = lower ? bfi[r] * x : 0.f, ab = upper ? bbi[r] * x : 0.f;
                      Abf[i * 72 + j] = f2bf1(af); Abf[64 * 72 + j * 72 + i] = f2bf1(ab);
                      if (mt == nt) { ADf[(mt * 16 + (i & 15)) * 16 + (j & 15)] = af; ADf[1024 + (mt * 16 + (j & 15)) * 16 + (i & 15)] = ab; } }
                  else QKp[i * 72 + j] = f2bf1(i == j ? acc[0][nt][r] : x); }
        }
        __syncthreads();
        if (!(XP & 2)) { LAS bf16* Ab = Abf + half * 64 * 72; LAS bf16* Tr = Trm + half * 64 * 72; LAS bf16* Tt = Ttr + half * 64 * 72; LAS bf16* Xh = Xs + half * 32 * 40;
          if (w4 == 0) { const int blk = lane >> 4, cc = lane & 15; float t[16]; const LAS float* ad = ADf + half * 1024 + blk * 256;
#pragma unroll
              for (int i = 0; i < 16; ++i) t[i] = (i == cc) ? 1.f : 0.f;
#pragma unroll
              for (int i = 1; i < 16; ++i) { float s0 = 0.f, s1 = 0.f;
#pragma unroll
                  for (int j = 0; j < i; ++j) { if (j & 1) s1 += ad[i * 16 + j] * t[j]; else s0 += ad[i * 16 + j] * t[j]; }
                  t[i] = (i > cc) ? -(s0 + s1) : t[i];
                  if ((i & 3) == 3) asm volatile("" ::: "memory"); }
#pragma unroll
              for (int i = 0; i < 16; ++i) { const unsigned short tb = f2bf1(t[i]); Tr[(blk * 16 + i) * 72 + blk * 16 + cc] = tb; Tt[(blk * 16 + cc) * 72 + blk * 16 + i] = tb; } }
          __syncthreads();
          f32x4 a1[1][1];
          if (w4 < 2) { const int J = 2 * w4, I = J + 1; a1[0][0] = (f32x4){0.f, 0.f, 0.f, 0.f};
              mma_lds<1, 1>(a1, Ab + 16 * J, 72, 16 * I, Tt + 16 * J, 72, 16 * J, 32, fr, fq);
              u32x2 wv; wv.x = pkbf(a1[0][0][0], a1[0][0][1]); wv.y = pkbf(a1[0][0][2], a1[0][0][3]);
              *(LAS u32x2*)(Xh + (w4 * 16 + fr) * 40 + 4 * fq) = wv; }
          __syncthreads();
          if (w4 < 2) { const int J = 2 * w4, I = J + 1; a1[0][0] = (f32x4){0.f, 0.f, 0.f, 0.f};
              mma_lds<1, 1>(a1, Tr + 16 * I, 72, 16 * I, Xh, 40, w4 * 16, 32, fr, fq);
#pragma unroll
              for (int r = 0; r < 4; ++r) Tr[(16 * I + 4 * fq + r) * 72 + 16 * J + fr] = f2bf1(-a1[0][0][r]);
              u32x2 wv; wv.x = pkbf(-a1[0][0][0], -a1[0][0][1]); wv.y = pkbf(-a1[0][0][2], -a1[0][0][3]);
              *(LAS u32x2*)(Tt + (16 * J + fr) * 72 + 16 * I + 4 * fq) = wv; }
          __syncthreads();
          { const int mt2 = w4 >> 1, nt2 = w4 & 1; a1[0][0] = (f32x4){0.f, 0.f, 0.f, 0.f};
            mma_lds<1, 1>(a1, Ab, 72, 32 + 16 * mt2, Tt, 72, 16 * nt2, 32, fr, fq);
            u32x2 wv; wv.x = pkbf(a1[0][0][0], a1[0][0][1]); wv.y = pkbf(a1[0][0][2], a1[0][0][3]);
            __syncthreads();
            *(LAS u32x2*)(Xh + (16 * nt2 + fr) * 40 + 16 * mt2 + 4 * fq) = wv;
            __syncthreads();
            a1[0][0] = (f32x4){0.f, 0.f, 0.f, 0.f};
            mma_lds<1, 1>(a1, Tr + 32, 72, 32 + 16 * mt2, Xh, 40, 16 * nt2, 32, fr, fq);
#pragma unroll
            for (int r = 0; r < 4; ++r) Tr[(32 + 16 * mt2 + 4 * fq + r) * 72 + 16 * nt2 + fr] = f2bf1(-a1[0][0][r]);
            u32x2 w2; w2.x = pkbf(-a1[0][0][0], -a1[0][0][1]); w2.y = pkbf(-a1[0][0][2], -a1[0][0][3]);
            *(LAS u32x2*)(Tt + (16 * nt2 + fr) * 72 + 32 + 16 * mt2 + 4 * fq) = w2; }
        }
        __syncthreads();
        { bf16* tq = TQ + ((size_t)(bhw * NCHUNK + c)) * 8192;
          const int i = (tid >> 3) & 63, p = tid & 7;
          const u32x4 qkv = *(const LAS u32x4*)(QKp + i * 72 + p * 8);
          const bf16x8 lo = *(const LAS bf16x8*)(Trm + i * 72 + p * 8), up = *(const LAS bf16x8*)(Ttr + 64 * 72 + i * 72 + p * 8); bf16x8 o8;
#pragma unroll
          for (int y = 0; y < 8; ++y) { const int j = p * 8 + y; o8[y] = (i > j) ? lo[y] : (i < j ? up[y] : (short)0x3F80); }
          __syncthreads();
          if (u + 1 < 16) { PG2_STAGEA(u + 1); }
          asm volatile("" ::: "memory");
          if (!(XP & 8)) { *(GAS bf16x8*)(tq + i * 64 + p * 8) = o8; *(GAS u32x4*)(tq + 4096 + i * 64 + p * 8) = qkv; }
          if (u + 2 < 16) { PG2_LOAD(u + 2); PG2_LOADS(u + 2); } }
        __syncthreads();
    }
#undef PG2_STAGEA
#undef PG2_LOAD
#undef PG2_LOADS
}

__device__ __forceinline__ void gdn_state_v1(LAS unsigned char* lds, int cid, const bf16* raw, const float* scal, const bf16* TQ,
                                             const float* A_log, const float* dt_bias, bf16* og, int tid, int wave, int lane) {
    using namespace gdn;
    const int dvh = cid & 1, dir = (cid >> 1) & 1, h = (cid >> 2) & 7, b = cid >> 5;
    const int fr = lane & 15, fq = lane >> 4;
    LAS float* sc = (LAS float*)(lds + SC);
    LAS bf16* q_ = (LAS bf16*)(lds + Q); LAS bf16* k_ = (LAS bf16*)(lds + K); LAS bf16* kdT = (LAS bf16*)(lds + KDT); LAS bf16* vT = (LAS bf16*)(lds + VT);
    LAS bf16* T_ = (LAS bf16*)(lds + T); LAS bf16* QKd = (LAS bf16*)(lds + QKD); LAS bf16* ST_ = (LAS bf16*)(lds + ST);
    LAS bf16* rT = (LAS bf16*)(lds + RT); LAS bf16* uT = (LAS bf16*)(lds + UT); LAS float* os = (LAS float*)(lds + OS);
    for (int e = tid; e < 64 * 136 / 2; e += 512) ((LAS unsigned*)ST_)[e] = 0u;
    const float expA = expf(A_log[dir * 8 + h]), dtb = dt_bias[dir * 8 + h];
    f32x4 sacc[4];
#pragma unroll
    for (int nt = 0; nt < 4; ++nt) sacc[nt] = (f32x4){0.f, 0.f, 0.f, 0.f};
    const size_t rowb = (size_t)b * SEQ; const int bh = b * 8 + h;
    __syncthreads();
    for (int n = 0; n < NCHUNK; ++n) {
        const int c = dir ? NCHUNK - 1 - n : n, t0 = c * 64;
        for (int e = tid; e < 64 * 16; e += 512) { const int r = e >> 4, p = e & 15;
            *(LAS u32x4*)(q_ + r * 136 + p * 8) = *(const GAS u32x4*)(raw + (rowb + t0 + r) * CONV_CH + h * 128 + p * 8);
            *(LAS u32x4*)(k_ + r * 136 + p * 8) = *(const GAS u32x4*)(raw + (rowb + t0 + r) * CONV_CH + 1024 + h * 128 + p * 8); }
        { const int dvl = tid >> 3, p = tid & 7; const int dv = dvh * 64 + dvl;
          *(LAS u32x4*)(vT + dvl * 72 + p * 8) = *(const GAS u32x4*)(raw + (rowb + t0 + (dv >> 1)) * CONV_CH + 2048 + h * 128 + (dv & 1) * 64 + p * 8); }
        { const bf16* tq = TQ + ((size_t)(bh * NCHUNK + c)) * 8192;
          for (int e = tid; e < 1024; e += 512) { const int which = e >> 9, i = (e >> 3) & 63, p = e & 7;
              bf16x8 v = *(const GAS bf16x8*)(tq + which * 4096 + i * 64 + p * 8);
#pragma unroll
              for (int x = 0; x < 8; ++x) { const int j = p * 8 + x; const bool keep = dir ? (i < j) : (i > j);
                  if (i == j) { if (which == 0) v[x] = (short)0x3F80; } else if (!keep) v[x] = 0; }
              *(LAS bf16x8*)((which ? QKd : T_) + i * 72 + p * 8) = v; } }
        if (wave == 0) { const int i = lane; const size_t so = (rowb + t0 + i) * 64;
            const float g = -expA * softplus_f(scal[so + 16 + dir * 8 + h] + dtb); float gc = g;
            if (dir == 0) {
#pragma unroll
                for (int o = 1; o < 64; o <<= 1) { const float y = __shfl_up(gc, o); if (i >= o) gc += y; }
            } else {
#pragma unroll
                for (int o = 1; o < 64; o <<= 1) { const float y = __shfl_down(gc, o); if (i + o < 64) gc += y; }
            }
            const float gl = __shfl(gc, dir ? 0 : 63);
            sc[i] = sigmoid_f(scal[so + dir * 8 + h]); sc[64 + i] = gc; sc[128 + i] = expf(gc); sc[192 + i] = expf(gl - gc); if (i == 0) sc[256] = expf(gl); }
        __syncthreads();
        { const int i = tid >> 3, cg = tid & 7; const float ek = sc[192 + i];
          const bf16x8 k0 = *(const LAS bf16x8*)(k_ + i * 136 + cg * 16), k1 = *(const LAS bf16x8*)(k_ + i * 136 + cg * 16 + 8);
#pragma unroll
          for (int x = 0; x < 8; ++x) { kdT[(cg * 16 + x) * 72 + i] = f2bf1(bf2f_s(k0[x]) * ek); kdT[(cg * 16 + 8 + x) * 72 + i] = f2bf1(bf2f_s(k1[x]) * ek); } }
        __syncthreads();
        const int mt = wave & 3, nh = wave >> 2;
        f32x4 aq[2];
        { f32x4 ak[2]; ak[0] = ak[1] = aq[0] = aq[1] = (f32x4){0.f, 0.f, 0.f, 0.f};
          for (int k0 = 0; k0 < 128; k0 += 32) {
              const bf16x8 fk = *(const LAS bf16x8*)(k_ + (mt * 16 + fr) * 136 + k0 + fq * 8), fqv = *(const LAS bf16x8*)(q_ + (mt * 16 + fr) * 136 + k0 + fq * 8);
#pragma unroll
              for (int nl = 0; nl < 2; ++nl) { const bf16x8 fb = *(const LAS bf16x8*)(ST_ + (nh * 32 + nl * 16 + fr) * 136 + k0 + fq * 8);
                  ak[nl] = __builtin_amdgcn_mfma_f32_16x16x32_bf16(fk, fb, ak[nl], 0, 0, 0); aq[nl] = __builtin_amdgcn_mfma_f32_16x16x32_bf16(fqv, fb, aq[nl], 0, 0, 0); } }
          const int i0 = mt * 16 + 4 * fq;
          const f32x4 be4 = *(const LAS f32x4*)(sc + i0), eg4 = *(const LAS f32x4*)(sc + 128 + i0);
#pragma unroll
          for (int nl = 0; nl < 2; ++nl) { const int dv = nh * 32 + nl * 16 + fr;
              const bf16x4 vv = *(const LAS bf16x4*)(vT + dv * 72 + i0);
              float r0 = be4[0] * (bf2f_s(vv[0]) - eg4[0] * ak[nl][0]), r1 = be4[1] * (bf2f_s(vv[1]) - eg4[1] * ak[nl][1]);
              float r2 = be4[2] * (bf2f_s(vv[2]) - eg4[2] * ak[nl][2]), r3 = be4[3] * (bf2f_s(vv[3]) - eg4[3] * ak[nl][3]);
              u32x2 w; w.x = pkbf(r0, r1); w.y = pkbf(r2, r3); *(LAS u32x2*)(rT + dv * 72 + i0) = w;
              aq[nl][0] *= eg4[0]; aq[nl][1] *= eg4[1]; aq[nl][2] *= eg4[2]; aq[nl][3] *= eg4[3]; }
        }
        __syncthreads();
        { f32x4 au[1][2]; au[0][0] = au[0][1] = (f32x4){0.f, 0.f, 0.f, 0.f};
          mma_lds<1, 2>(au, T_, 72, mt * 16, rT, 72, nh * 32, 64, fr, fq);
          const int i0 = mt * 16 + 4 * fq;
#pragma unroll
          for (int nl = 0; nl < 2; ++nl) { const int dv = nh * 32 + nl * 16 + fr; u32x2 w; w.x = pkbf(au[0][nl][0], au[0][nl][1]); w.y = pkbf(au[0][nl][2], au[0][nl][3]); *(LAS u32x2*)(uT + dv * 72 + i0) = w; }
        }
        __syncthreads();
        { f32x4 ao[1][2]; ao[0][0] = aq[0]; ao[0][1] = aq[1];
          mma_lds<1, 2>(ao, QKd, 72, mt * 16, uT, 72, nh * 32, 64, fr, fq);
          const int i0 = mt * 16 + 4 * fq;
#pragma unroll
          for (int nl = 0; nl < 2; ++nl)
#pragma unroll
              for (int r = 0; r < 4; ++r) os[(i0 + r) * 65 + nh * 32 + nl * 16 + fr] = ao[0][nl][r];
          const float egl = sc[256];
          f32x4 as_[1][4];
#pragma unroll
          for (int nt = 0; nt < 4; ++nt) as_[0][nt] = sacc[nt] * egl;
          mma_lds<1, 4>(as_, kdT, 72, wave * 16, uT, 72, 0, 64, fr, fq);
#pragma unroll
          for (int nt = 0; nt < 4; ++nt) { sacc[nt] = as_[0][nt];
              u32x2 w; w.x = pkbf(sacc[nt][0], sacc[nt][1]); w.y = pkbf(sacc[nt][2], sacc[nt][3]); *(LAS u32x2*)(ST_ + (nt * 16 + fr) * 136 + wave * 16 + 4 * fq) = w; }
        }
        __syncthreads();
#pragma unroll
        for (int ii = 0; ii < 4; ++ii) { const int i = wave * 8 + 2 * ii + (lane >> 5), cp = lane & 31;
            atomic_add_bf16x2(og + (rowb + t0 + i) * 1024 + h * 128 + dvh * 64 + 2 * cp, os[i * 65 + 2 * cp], os[i * 65 + 2 * cp + 1]); }
        __syncthreads();
    }
}
typedef float f32x16 __attribute__((ext_vector_type(16)));
typedef short v4i16_t __attribute__((ext_vector_type(4)));
namespace gs2 {
constexpr int KO = 0;
constexpr int QO = KO + 64 * 132 * 2;
constexpr int VTO = QO + 64 * 132 * 2;
constexpr int TO = VTO + 64 * 68 * 2;
constexpr int QKO = TO + 64 * 68 * 2;
constexpr int SCO = QKO + 64 * 68 * 2;
constexpr int BUF = SCO + 1024;
constexpr int OST = 2 * BUF;
constexpr int END = OST + 2 * 64 * 72 * 2;
static_assert(END <= MISC_OFF && BUF % 16 == 0, "gdn state LDS map");
}
__device__ __forceinline__ bf16x8 cvt8(const f32x16& x, int base) {
    u32x4 w; w.x = pkbf(x[base], x[base + 1]); w.y = pkbf(x[base + 2], x[base + 3]); w.z = pkbf(x[base + 4], x[base + 5]); w.w = pkbf(x[base + 6], x[base + 7]);
    return __builtin_bit_cast(bf16x8, w);
}
__device__ __forceinline__ bf16x8 afrag(const LAS bf16* p) {
    const bf16x4 lo = *(const LAS bf16x4*)p, hi = *(const LAS bf16x4*)(p + 8);
    return (bf16x8){lo[0], lo[1], lo[2], lo[3], hi[0], hi[1], hi[2], hi[3]};
}
__device__ __forceinline__ bf16x8 afrag_tr(const LAS bf16* p, int ld) {
    const v4i16_t lo = __builtin_amdgcn_ds_read_tr16_b64_v4i16((LAS v4i16_t*)p), hi = __builtin_amdgcn_ds_read_tr16_b64_v4i16((LAS v4i16_t*)(p + 8 * ld));
    return (bf16x8){lo[0], lo[1], lo[2], lo[3], hi[0], hi[1], hi[2], hi[3]};
}
#define MFMA32(a, b, c) __builtin_amdgcn_mfma_f32_32x32x16_bf16((a), (b), (c), 0, 0, 0)

#ifndef WG_BAR
#define WG_BAR() asm volatile("s_waitcnt lgkmcnt(0)\n\ts_barrier" ::: "memory")
#endif
template <int DIR>
__device__ __forceinline__ void gdn_state2(LAS unsigned char* lds, int b, int h, int half, const bf16* raw, const float* scal, const bf16* TQ,
                                           const float* A_log, const float* dt_bias, bf16* og, int tid, int wave, int lane, float* probe = nullptr) {
    using namespace gs2;
    const size_t rowb = (size_t)b * SEQ; const int bh = b * 8 + h;
    const float expA = expf(A_log[DIR * 8 + h]), dtb = dt_bias[DIR * 8 + h];
    LAS bf16* ost = (LAS bf16*)(lds + OST);
    const int r31 = lane & 31, hh = lane >> 5;
    if (wave == 4 || wave == 5) {
        for (int n = 0; n < NCHUNK + 1; ++n) WG_BAR();
    } else if (wave >= 2) {
        const int hw = (wave & 1) | ((wave >> 2) << 1);
        const int ht = hw * 64 + lane;
        unsigned go[14], lo_[14]; u32x4 ld[14]; float sr0 = 0.f, sr1 = 0.f;
#pragma unroll
        for (int x = 0; x < 4; ++x) { const int e = ht + 256 * x, r = e >> 4, p = e & 15;
            go[x] = (unsigned)((r * CONV_CH + 1024 + h * 128 + p * 8) * 2); go[4 + x] = (unsigned)((r * CONV_CH + h * 128 + p * 8) * 2);
            lo_[x] = (unsigned)(KO + (r * 132 + p * 8) * 2); lo_[4 + x] = (unsigned)(QO + (r * 132 + p * 8) * 2); }
#pragma unroll
        for (int x = 0; x < 2; ++x) { const int e = ht + 256 * x, dvl = e >> 3, p = e & 7; const int dv = 64 * half + dvl;
            go[8 + x] = (unsigned)(((dv >> 1) * CONV_CH + 2048 + h * 128 + (dv & 1) * 64 + p * 8) * 2); lo_[8 + x] = (unsigned)(VTO + (dvl * 68 + p * 8) * 2); }
        u32x4 km[2], dg[2], qm[2];
#pragma unroll
        for (int x = 0; x < 2; ++x) { const int e = ht + 256 * x, i = e >> 3, p = e & 7;
            go[10 + x] = (unsigned)(e * 16); go[12 + x] = (unsigned)(8192 + e * 16);
            lo_[10 + x] = (unsigned)(TO + (i * 68 + p * 8) * 2); lo_[12 + x] = (unsigned)(QKO + (i * 68 + p * 8) * 2);
            unsigned kw[4], dw[4], qw[4];
#pragma unroll
            for (int w = 0; w < 4; ++w) { const int j0 = p * 8 + 2 * w, j1 = j0 + 1;
                const bool k0 = DIR ? (i < j0) : (i > j0), k1 = DIR ? (i < j1) : (i > j1);
                kw[w] = (k0 ? 0xFFFFu : 0u) | (k1 ? 0xFFFF0000u : 0u); dw[w] = (i == j0 ? 0x3F80u : 0u) | (i == j1 ? 0x3F800000u : 0u);
                qw[w] = kw[w] | (i == j0 ? 0xFFFFu : 0u) | (i == j1 ? 0xFFFF0000u : 0u); }
            km[x] = (u32x4){kw[0], kw[1], kw[2], kw[3]}; dg[x] = (u32x4){dw[0], dw[1], dw[2], dw[3]}; qm[x] = (u32x4){qw[0], qw[1], qw[2], qw[3]}; }
        const unsigned so_l = (unsigned)(lane * 256 + (DIR * 8 + h) * 4);
#define GS2_ISSUE(c_) do { const GAS char* rb_ = (const GAS char*)(raw + (rowb + (size_t)(c_) * 64) * CONV_CH); const GAS char* tb_ = (const GAS char*)(TQ + ((size_t)(bh * NCHUNK + (c_))) * 8192); \
            _Pragma("unroll") for (int x = 0; x < 10; ++x) ld[x] = *(const GAS u32x4*)(rb_ + go[x]); \
            _Pragma("unroll") for (int x = 10; x < 14; ++x) ld[x] = *(const GAS u32x4*)(tb_ + go[x]); \
            if (hw == 0) { const GAS char* sb_ = (const GAS char*)(scal + (rowb + (size_t)(c_) * 64) * 64); sr0 = *(const GAS float*)(sb_ + so_l); sr1 = *(const GAS float*)(sb_ + so_l + 64); } } while (0)
#define GS2_ST16(off_, v_) do { LAS unsigned char* d_ = B_ + (off_); *(LAS u32x2*)(d_) = (u32x2){(v_).x, (v_).y}; *(LAS u32x2*)(d_ + 8) = (u32x2){(v_).z, (v_).w}; } while (0)
#define GS2_COMMIT(bi_, c_) do { LAS unsigned char* B_ = lds + (bi_) * BUF; \
            _Pragma("unroll") for (int x = 0; x < 10; ++x) GS2_ST16(lo_[x], ld[x]); \
            _Pragma("unroll") for (int x = 0; x < 2; ++x) { const u32x4 tv = (ld[10 + x] & km[x]) | dg[x], qv = ld[12 + x] & qm[x]; \
                GS2_ST16(lo_[10 + x], tv); GS2_ST16(lo_[12 + x], qv); } \
            if (hw == 0) { LAS float* sc_ = (LAS float*)(B_ + SCO); const int i = lane; const float gc = sr1; const float gl = __shfl(gc, DIR ? 0 : 63); \
                sc_[i] = sr0; sc_[64 + i] = __expf(gc); sc_[128 + i] = __expf(gl - gc); if (i == 0) sc_[192] = __expf(gl); } } while (0)
        { const int c0 = DIR ? NCHUNK - 1 : 0; GS2_ISSUE(c0); GS2_COMMIT(0, c0); GS2_ISSUE((DIR ? c0 - 1 : c0 + 1)); }
        for (int n = 0; n < NCHUNK; ++n) {
            const int c = DIR ? NCHUNK - 1 - n : n;
            WG_BAR();
            const bool more = n + 1 < NCHUNK; const int cn = DIR ? c - 1 : c + 1;
            if (more) { GS2_COMMIT((n + 1) & 1, cn); if (n + 2 < NCHUNK) GS2_ISSUE((DIR ? cn - 1 : cn + 1)); }
            unsigned ov[8];
            if (n > 0) {
#pragma unroll
                for (int x = 0; x < 8; ++x) ov[x] = *(const LAS unsigned*)(ost + ((n - 1) & 1) * (64 * 72) + (hw * 16 + 2 * x + (lane >> 5)) * 72 + 2 * (lane & 31));
            }
            if (n > 0) { const int tp = (DIR ? c + 1 : c - 1) * 64;
#pragma unroll
                for (int x = 0; x < 8; ++x) { GAS char* ob_ = (GAS char*)(og + (rowb + tp + hw * 16 + 2 * x) * 1024 + h * 128 + half * 64);
                    (void)__builtin_amdgcn_global_atomic_fadd_v2bf16((GAS s16x2*)(ob_ + (lane >> 5) * 2048 + (lane & 31) * 4), __builtin_bit_cast(s16x2, ov[x])); } }
        }
        WG_BAR();
        { const int tp = (DIR ? 0 : NCHUNK - 1) * 64;
#pragma unroll
          for (int x = 0; x < 8; ++x) { const unsigned v = *(const LAS unsigned*)(ost + ((NCHUNK - 1) & 1) * (64 * 72) + (hw * 16 + 2 * x + (lane >> 5)) * 72 + 2 * (lane & 31));
              GAS char* ob_ = (GAS char*)(og + (rowb + tp + hw * 16 + 2 * x) * 1024 + h * 128 + half * 64);
              (void)__builtin_amdgcn_global_atomic_fadd_v2bf16((GAS s16x2*)(ob_ + (lane >> 5) * 2048 + (lane & 31) * 4), __builtin_bit_cast(s16x2, v)); } }
#undef GS2_ISSUE
#undef GS2_COMMIT
#undef GS2_ST16
    } else {
        const int dv0 = 32 * wave;
#if defined(PROBE_STATE)
        unsigned long long tw_ = 0ull; const unsigned long long ts0_ = __builtin_amdgcn_s_memtime();
#define PB_BAR() do { const unsigned long long t0_ = __builtin_amdgcn_s_memtime(); WG_BAR(); tw_ += __builtin_amdgcn_s_memtime() - t0_; } while (0)
#else
#define PB_BAR() WG_BAR()
#endif
        f32x16 St[4];
#pragma unroll
        for (int t = 0; t < 4; ++t)
#pragma unroll
            for (int r = 0; r < 16; ++r) St[t][r] = 0.f;
        for (int n = 0; n < NCHUNK; ++n) {
            PB_BAR();
            const LAS unsigned char* Bb = lds + (n & 1) * BUF;
            const LAS bf16* Kb = (const LAS bf16*)(Bb + KO); const LAS bf16* Qb = (const LAS bf16*)(Bb + QO); const LAS bf16* Vb = (const LAS bf16*)(Bb + VTO);
            const LAS bf16* Tb = (const LAS bf16*)(Bb + TO); const LAS bf16* QKb = (const LAS bf16*)(Bb + QKO); const LAS float* sc = (const LAS float*)(Bb + SCO);
            f32x16 aK[2];
#pragma unroll
            for (int m = 0; m < 2; ++m)
#pragma unroll
                for (int r = 0; r < 16; ++r) aK[m][r] = 0.f;
            bf16x8 fa[2][2];
            const int offk = r31 * 132 + 4 * hh;
#define GS2_LD2(P_, bi_, ks_) do { fa[bi_][0] = afrag((P_) + offk + 16 * (ks_)); fa[bi_][1] = afrag((P_) + offk + 32 * 132 + 16 * (ks_)); } while (0)
            GS2_LD2(Kb, 0, 0);
#pragma unroll
            for (int ks = 0; ks < 8; ++ks) {
                if (ks < 7) GS2_LD2(Kb, (ks + 1) & 1, ks + 1);
                __builtin_amdgcn_sched_barrier(0);
                const bf16x8 bs = cvt8(St[ks >> 1], 8 * (ks & 1));
                aK[0] = MFMA32(fa[ks & 1][0], bs, aK[0]); aK[1] = MFMA32(fa[ks & 1][1], bs, aK[1]);
                __builtin_amdgcn_sched_barrier(0); }
            bf16x8 ft[8];
#pragma unroll
            for (int mi = 0; mi < 2; ++mi)
#pragma unroll
                for (int kt = 0; kt < 4; ++kt) { const bool need = DIR ? (kt >= 2 * mi) : (kt <= 2 * mi + 1);
                    if (need) ft[mi * 4 + kt] = afrag(Tb + (32 * mi + r31) * 68 + 16 * kt + 4 * hh); }
#pragma unroll
            for (int m = 0; m < 2; ++m)
#pragma unroll
                for (int q4 = 0; q4 < 4; ++q4) { const int tb = 32 * m + 8 * q4 + 4 * hh;
                    const bf16x4 vv = *(const LAS bf16x4*)(Vb + (dv0 + r31) * 68 + tb); const f32x4 be = *(const LAS f32x4*)(sc + tb), eg = *(const LAS f32x4*)(sc + 64 + tb);
#pragma unroll
                    for (int e = 0; e < 4; ++e) aK[m][4 * q4 + e] = be[e] * (bf2f_s(vv[e]) - eg[e] * aK[m][4 * q4 + e]); }
            const bf16x8 br0 = cvt8(aK[0], 0), br1 = cvt8(aK[0], 8), br2 = cvt8(aK[1], 0), br3 = cvt8(aK[1], 8);
            __builtin_amdgcn_sched_barrier(0);
            f32x16 au[2];
#pragma unroll
            for (int m = 0; m < 2; ++m)
#pragma unroll
                for (int r = 0; r < 16; ++r) au[m][r] = 0.f;
            GS2_LD2(Qb, 0, 0);
#pragma unroll
            for (int mi = 0; mi < 2; ++mi)
#pragma unroll
                for (int kt = 0; kt < 4; ++kt) { const bool need = DIR ? (kt >= 2 * mi) : (kt <= 2 * mi + 1);
                    if (need) au[mi] = MFMA32(ft[mi * 4 + kt], (kt == 0 ? br0 : kt == 1 ? br1 : kt == 2 ? br2 : br3), au[mi]); }
            __builtin_amdgcn_sched_barrier(0);
            f32x16 aQ[2];
#pragma unroll
            for (int m = 0; m < 2; ++m)
#pragma unroll
                for (int r = 0; r < 16; ++r) aQ[m][r] = 0.f;
#pragma unroll
            for (int ks = 0; ks < 8; ++ks) {
                if (ks < 7) GS2_LD2(Qb, (ks + 1) & 1, ks + 1);
                __builtin_amdgcn_sched_barrier(0);
                const bf16x8 bs = cvt8(St[ks >> 1], 8 * (ks & 1));
                aQ[0] = MFMA32(fa[ks & 1][0], bs, aQ[0]); aQ[1] = MFMA32(fa[ks & 1][1], bs, aQ[1]);
                __builtin_amdgcn_sched_barrier(0); }
#undef GS2_LD2
            const bf16x8 bu0 = cvt8(au[0], 0), bu1 = cvt8(au[0], 8), bu2 = cvt8(au[1], 0), bu3 = cvt8(au[1], 8);
#pragma unroll
            for (int m = 0; m < 2; ++m)
#pragma unroll
                for (int q4 = 0; q4 < 4; ++q4) { const int tb = 32 * m + 8 * q4 + 4 * hh; const f32x4 ek = *(const LAS f32x4*)(sc + 128 + tb), eg = *(const LAS f32x4*)(sc + 64 + tb);
#pragma unroll
                    for (int e = 0; e < 4; ++e) { au[m][4 * q4 + e] *= ek[e]; aQ[m][4 * q4 + e] *= eg[e]; } }
            const bf16x8 bd0 = cvt8(au[0], 0), bd1 = cvt8(au[0], 8), bd2 = cvt8(au[1], 0), bd3 = cvt8(au[1], 8);
            __builtin_amdgcn_sched_barrier(0);
            bf16x8 fqk[8];
#pragma unroll
            for (int mi = 0; mi < 2; ++mi)
#pragma unroll
                for (int kt = 0; kt < 4; ++kt) { const bool need = DIR ? (kt >= 2 * mi) : (kt <= 2 * mi + 1);
                    if (need) fqk[mi * 4 + kt] = afrag(QKb + (32 * mi + r31) * 68 + 16 * kt + 4 * hh); }
            const int i16 = r31 & 15; const LAS bf16* kp = Kb + (4 * hh + (i16 >> 2)) * 132 + 16 * (r31 >> 4) + 4 * (i16 & 3);
            bf16x8 fk[2][4];
#define GS2_LDKT(bi_, t_) do { _Pragma("unroll") for (int kt = 0; kt < 4; ++kt) fk[bi_][kt] = afrag_tr(kp + (16 * kt) * 132 + 32 * (t_), 132); } while (0)
            __builtin_amdgcn_sched_barrier(0);
#pragma unroll
            for (int mi = 0; mi < 2; ++mi)
#pragma unroll
                for (int kt = 0; kt < 4; ++kt) { const bool need = DIR ? (kt >= 2 * mi) : (kt <= 2 * mi + 1);
                    if (need) aQ[mi] = MFMA32(fqk[mi * 4 + kt], (kt == 0 ? bu0 : kt == 1 ? bu1 : kt == 2 ? bu2 : bu3), aQ[mi]); }
            GS2_LDKT(0, 0);
            const float egl = sc[192];
#pragma unroll
            for (int mi = 0; mi < 2; ++mi)
#pragma unroll
                for (int r = 0; r < 16; ++r) ost[(n & 1) * (64 * 72) + (32 * mi + (r & 3) + 8 * (r >> 2) + 4 * hh) * 72 + dv0 + r31] = f2bf1(aQ[mi][r]);
#pragma unroll
            for (int t = 0; t < 4; ++t) {
                if (t < 3) GS2_LDKT((t + 1) & 1, t + 1);
                __builtin_amdgcn_sched_barrier(0);
#pragma unroll
                for (int r = 0; r < 16; ++r) St[t][r] *= egl;
                St[t] = MFMA32(fk[t & 1][0], bd0, St[t]); St[t] = MFMA32(fk[t & 1][1], bd1, St[t]);
                St[t] = MFMA32(fk[t & 1][2], bd2, St[t]); St[t] = MFMA32(fk[t & 1][3], bd3, St[t]);
                __builtin_amdgcn_sched_barrier(0); }
#undef GS2_LDKT
        }
        WG_BAR();
#if defined(PROBE_STATE)
        if (blockIdx.x == 0 && tid == 0 && probe) { const unsigned long long tt_ = __builtin_amdgcn_s_memtime() - ts0_; *probe = (float)((double)tw_ / (double)tt_); }
#endif
    }
}
constexpr size_t WS_SSC = 1 * MiB;
namespace psd {
constexpr int CW = 0;
constexpr int SC = CW + 8 * 768 * 4;
constexpr int BM_ = SC + 8 * 4 * 64 * 4;
constexpr int CM_ = BM_ + 64 * 136 * 2;
constexpr int CB = CM_ + 64 * 136 * 2;
constexpr int R = CB + 64 * 68 * 4;
constexpr int RBC = R, RBC_END = R + 70 * 272 * 2;
constexpr int RX = R, XT = RX + 70 * 136 * 2, MM = XT + 128 * 72 * 2, R_END = MM + 2 * 64 * 72 * 2;
constexpr int YST = RX;
constexpr int PRBC = CW + 8 * 768 * 4, PXT = PRBC + 70 * 272 * 2, P_END = PXT + 256 * 72 * 2;
constexpr int STASH = pgd::STASH + 4608;
static_assert(P_END <= pgd::STASH, "prep ssd conv LDS map");
static_assert(RBC_END <= pgd::STASH && R_END <= pgd::STASH && STASH + 9216 <= MISC_OFF, "prep ssd LDS map");
}
__device__ __forceinline__ void prep_ssd_stash(LAS unsigned char* lds, int bid, const bf16* raw, int tid) {
    const int bg = bid >> 5, b = bg >> 1, g = bg & 1, r32 = bid & 31;
    LAS bf16* st = (LAS bf16*)(lds + psd::STASH);
    for (int e = tid; e < 2 * 3 * 96; e += 512) { const int which = e / 288, r = (e % 288) / 96, p = e % 96;
        const int t = which ? (r32 * 4 + 4) * 64 + r : r32 * 4 * 64 - 3 + r;
        const int col = p < 64 ? 3072 + g * 512 + p * 8 : (p < 80 ? 4096 + g * 128 + (p - 64) * 8 : 4352 + g * 128 + (p - 80) * 8);
        u32x4 v = (u32x4){0u, 0u, 0u, 0u};
        if (t >= 0 && t < SEQ) v = *(const GAS u32x4*)(raw + ((size_t)b * SEQ + t) * CONV_CH + col);
        *(LAS u32x4*)(st + which * 2304 + r * 768 + p * 8) = v; }
}
template <int XP = 0>
__device__ __forceinline__ void prep_ssd_range(LAS unsigned char* lds, int bid, bf16* raw, const float* conv_w, const float* conv_b, int tid_p,
                                               const float* scal, const float* A_log, const float* dt_bias, float* ssc, bf16* rwb = nullptr) {
    using namespace psd;
    const int bg = bid >> 5, b = bg >> 1, g = bg & 1, r32 = bid & 31;
    bf16* const raww = XP ? rwb : raw; const size_t rowbw = XP ? (size_t)0 : (size_t)b * SEQ; const int bw = XP ? 0 : b;
    LAS float* cw = (LAS float*)(lds + CW);
    LAS bf16* rbc = (LAS bf16*)(lds + PRBC); LAS bf16* xT = (LAS bf16*)(lds + PXT);
    LAS bf16* st = (LAS bf16*)(lds + STASH);
    for (int e = tid_p; e < 8 * 768; e += 512) { const int r = e / 768, c = e % 768;
        const int gch = c < 512 ? 3072 + g * 512 + c : (c < 640 ? 4096 + g * 128 + (c - 512) : 4352 + g * 128 + (c - 640));
        cw[e] = r < 7 ? conv_w[r * CONV_CH + gch] : conv_b[gch]; }
    const size_t rowb = (size_t)b * SEQ;
    u32x4 pre[5];
#define PSD_LOAD(u_, ps_) do { const int t0_ = (r32 * 4 + (u_)) * 64; \
        _Pragma("unroll") for (int x = 0; x < 5; ++x) { const int e = tid_p + 512 * x; const int r = e >> 5, p = e & 31; \
            pre[x] = (u32x4){0u, 0u, 0u, 0u}; \
            if (e < 70 * 32 && r >= 3 && !(r >= 67 && (u_) == 3)) { const int col = (ps_) == 0 ? (p < 16 ? 4096 + g * 128 + p * 8 : 4352 + g * 128 + (p - 16) * 8) : 3072 + g * 512 + ((ps_) - 1) * 256 + p * 8; \
                pre[x] = *(const GAS u32x4*)(raw + (rowb + t0_ - 3 + r) * CONV_CH + col); } } } while (0)
    PSD_LOAD(0, 0);
    float sdf[4], sdb[4];
    { const int lane0 = tid_p & 63, wave0 = tid_p >> 6, hd0 = g * 8 + wave0;
#pragma unroll
      for (int u = 0; u < 4; ++u) { const size_t so = (rowb + (size_t)(r32 * 4 + u) * 64 + lane0) * 64; sdf[u] = scal[so + 32 + hd0]; sdb[u] = scal[so + 48 + hd0]; } }
#define PSD_STAGE(u_, scol_) do { _Pragma("unroll") for (int x = 0; x < 5; ++x) { const int e = tid_p + 512 * x; const int r = e >> 5, p = e & 31; \
            if (e < 70 * 32) { u32x4 v = pre[x]; \
                if (r < 3) v = *(const LAS u32x4*)(st + r * 768 + (scol_) + p * 8); \
                else if (r >= 67 && (u_) == 3) v = *(const LAS u32x4*)(st + 2304 + (r - 67) * 768 + (scol_) + p * 8); \
                *(LAS u32x4*)(rbc + r * 272 + (p < 16 ? p * 8 : 136 + (p - 16) * 8)) = v; } } } while (0)
    __syncthreads();
    PSD_STAGE(0, 512);
    PSD_LOAD(0, 1);
    __syncthreads();
#pragma unroll
    for (int u = 0; u < 4; ++u) {
        int tid = tid_p; asm volatile("" : "+v"(tid));
        const int lane = tid & 63, wave = __builtin_amdgcn_readfirstlane(tid >> 6);
        const int c = r32 * 4 + u, t0 = c * 64;
        { const int hd = g * 8 + wave, i = lane;
          const float dtf = softplus_fast(sdf[u] + dt_bias[hd]), dtb = softplus_fast(sdb[u] + dt_bias[16 + hd]);
          const float cf = scan_fwd64(dtf * -expf(A_log[hd]), i), cbk = scan_bwd64(dtb * -expf(A_log[16 + hd]), i);
          float* sp = ssc + ((size_t)((bw * 16 + hd) * NCHUNK + c)) * 256 + i; sp[0] = dtf; sp[64] = cf; sp[128] = dtb; sp[192] = cbk; }
        for (int ps = 0; ps < 3; ++ps) {
            const int scol = ps == 0 ? 512 : (ps == 1 ? 0 : 256);
            if (tid < 96) { const int r = tid >> 5, p = tid & 31;
                *(LAS u32x4*)(st + r * 768 + scol + p * 8) = *(const LAS u32x4*)(rbc + (64 + r) * 272 + (p < 16 ? p * 8 : 136 + (p - 16) * 8)); }
            unsigned bcv[16];
#pragma unroll
            for (int t = 0; t < 16; ++t) bcv[t] = 0u;
            if (!(XP & 1)) { const int tg = wave, cp = lane; float w[16], o[16];
#pragma unroll
              for (int hf = 0; hf < 2; ++hf) {
#pragma unroll
                  for (int tap = 0; tap < 8; ++tap) { w[2 * tap] = cw[tap * 768 + scol + hf * 128 + 2 * cp]; w[2 * tap + 1] = cw[tap * 768 + scol + hf * 128 + 2 * cp + 1]; }
                  conv_pair8(o, rbc + (8 * tg) * 272 + hf * 136 + 2 * cp, 272, w);
#pragma unroll
                  for (int t = 0; t < 16; ++t) o[t] = silu(o[t]);
#pragma unroll
                  for (int t = 0; t < 8; ++t) bcv[hf * 8 + t] = pkbf(o[2 * t], o[2 * t + 1]);
                  if (ps != 0) {
                      u32x4 e0, e1; e0.x = pkbf(o[0], o[2]); e0.y = pkbf(o[4], o[6]); e0.z = pkbf(o[8], o[10]); e0.w = pkbf(o[12], o[14]);
                      e1.x = pkbf(o[1], o[3]); e1.y = pkbf(o[5], o[7]); e1.z = pkbf(o[9], o[11]); e1.w = pkbf(o[13], o[15]);
                      *(LAS u32x4*)(xT + (hf * 128 + 2 * cp) * 72 + 8 * tg) = e0; *(LAS u32x4*)(xT + (hf * 128 + 2 * cp + 1) * 72 + 8 * tg) = e1; } } }
            __syncthreads();
            const bool lastp = (u == 3 && ps == 2);
            if (!lastp) { if (ps < 2) PSD_STAGE(u, (ps == 0 ? 0 : 256)); else PSD_STAGE(u + 1, 512); }
            asm volatile("" ::: "memory");
            if (ps == 0) {
                const int tg = wave, cp = lane;
#pragma unroll
                for (int hf = 0; hf < 2; ++hf)
#pragma unroll
                    for (int t = 0; t < 8; ++t) { if (!(XP & 8)) *(GAS unsigned*)(raww + (rowbw + t0 + 8 * tg + t) * CONV_CH + (hf ? 4352 : 4096) + g * 128 + 2 * cp) = bcv[hf * 8 + t]; }
            } else {
                for (int e = tid; e < 256 * 8; e += 512) { const int xr = e >> 3, p = e & 7; const int hl = (ps - 1) * 4 + (xr >> 6), pp = xr & 63;
                    if (!(XP & 8)) *(GAS u32x4*)(raww + (rowbw + t0 + pp) * CONV_CH + 3072 + (g * 8 + hl) * 64 + p * 8) = *(const LAS u32x4*)(xT + xr * 72 + p * 8); } }
            if (ps == 0) PSD_LOAD(u, 2); else if (u < 3) { if (ps == 1) PSD_LOAD(u + 1, 0); else PSD_LOAD(u + 1, 1); }
            __syncthreads();
        }
    }
}
#undef PSD_STAGE
#undef PSD_LOAD
__device__ __forceinline__ void ssd_intra_range(LAS unsigned char* lds, int bid, const bf16* raw, const float* ssc, const float* Dp, bf16* yi, int tid_p) {
    using namespace psd;
    const int bg = bid >> 5, b = bg >> 1, g = bg & 1, r32 = bid & 31;
    LAS float* sc = (LAS float*)(lds + SC);
    LAS bf16* Bm = (LAS bf16*)(lds + BM_); LAS bf16* Cm = (LAS bf16*)(lds + CM_); LAS float* cb = (LAS float*)(lds + CB);
    LAS bf16* xT = (LAS bf16*)(lds + XT); LAS bf16* Mm = (LAS bf16*)(lds + MM); LAS bf16* yst = (LAS bf16*)(lds + YST);
    const size_t rowb = (size_t)b * SEQ;
    u32x4 pbc[4], px[8]; float pss[4];
#define PSI_LOADBC(u_) do { const int t0_ = (r32 * 4 + (u_)) * 64; \
        _Pragma("unroll") for (int x = 0; x < 4; ++x) { const int e = tid_p + 512 * x; const int r = e >> 5, p = e & 31; \
            pbc[x] = *(const GAS u32x4*)(raw + (rowb + t0_ + r) * CONV_CH + (p < 16 ? 4096 + g * 128 + p * 8 : 4352 + g * 128 + (p - 16) * 8)); } \
        { const float* sp_ = ssc + ((size_t)((b * 16 + g * 8 + (tid_p >> 6)) * NCHUNK + (r32 * 4 + (u_)))) * 256 + (tid_p & 63); pss[0] = sp_[0]; pss[1] = sp_[64]; pss[2] = sp_[128]; pss[3] = sp_[192]; } } while (0)
#define PSI_LOADX(u_, hp_) do { const int t0_ = (r32 * 4 + (u_)) * 64; \
        _Pragma("unroll") for (int y = 0; y < 2; ++y) { const int e = tid_p + 512 * y; const int xr = e >> 3, p = e & 7; const int hl = 2 * (hp_) + (xr >> 6), pp = xr & 63; \
            px[2 * (hp_) + y] = *(const GAS u32x4*)(raw + (rowb + t0_ + pp) * CONV_CH + 3072 + (g * 8 + hl) * 64 + p * 8); } } while (0)
#define PSI_PUTX(hp_) do { _Pragma("unroll") for (int y = 0; y < 2; ++y) { const int e = tid_p + 512 * y; const int xr = e >> 3, p = e & 7; *(LAS u32x4*)(xT + xr * 72 + p * 8) = px[2 * (hp_) + y]; } } while (0)
    PSI_LOADBC(0); PSI_LOADX(0, 0); PSI_LOADX(0, 1); PSI_LOADX(0, 2); PSI_LOADX(0, 3);
    for (int u = 0; u < 4; ++u) {
        int tid = tid_p; asm volatile("" : "+v"(tid));
        const int lane = tid & 63, wave = __builtin_amdgcn_readfirstlane(tid >> 6), fr = lane & 15, fq = lane >> 4;
        const int c = r32 * 4 + u, t0 = c * 64;
#pragma unroll
        for (int x = 0; x < 4; ++x) { const int e = tid_p + 512 * x; const int r = e >> 5, p = e & 31;
            *(LAS u32x4*)((p < 16 ? Bm + r * 136 + p * 8 : Cm + r * 136 + (p - 16) * 8)) = pbc[x]; }
        { const int i = lane; LAS float* s = sc + wave * 256; s[i] = pss[0]; s[64 + i] = pss[1] * 1.4426950408889634f; s[128 + i] = pss[2]; s[192 + i] = pss[3] * 1.4426950408889634f; }
        PSI_PUTX(0);
        if (u + 1 < 4) PSI_LOADBC(u + 1);
        __syncthreads();
        { const int mt = wave & 3, nh = wave >> 2;
          f32x4 acc[1][2]; acc[0][0] = acc[0][1] = (f32x4){0.f, 0.f, 0.f, 0.f};
          mma_lds<1, 2>(acc, Cm, 136, mt * 16, Bm, 136, nh * 32, 128, fr, fq);
#pragma unroll
          for (int nl = 0; nl < 2; ++nl)
#pragma unroll
              for (int r = 0; r < 4; ++r) cb[(mt * 16 + 4 * fq + r) * 68 + nh * 32 + nl * 16 + fr] = acc[0][nl][r]; }
#pragma unroll
        for (int hp = 0; hp < 4; ++hp) {
            __syncthreads();
            if (u + 1 < 4) PSI_LOADX(u + 1, hp);
            { const int e = tid >> 8, i = (tid >> 2) & 63, jq = tid & 3; const int hl = 2 * hp + e;
              const LAS float* s = sc + hl * 256; const float Dh = Dp[g * 8 + hl];
              const float csfi = s[64 + i], csbi = s[192 + i], dsum = s[i] + s[128 + i];
#pragma unroll
              for (int jj = 0; jj < 16; jj += 2) { float m2[2];
#pragma unroll
                  for (int y = 0; y < 2; ++y) { const int j = jq * 16 + jj + y; const float cbv = cb[i * 68 + j];
                      const float cfj = s[64 + j], cbj = s[192 + j], dfj = s[j], dbj = s[128 + j];
                      const float arg = (i > j) ? csfi - cfj : csbi - cbj;
                      const float dtj = (i > j) ? dfj : dbj;
                      const float w = (i == j) ? dsum : __builtin_amdgcn_exp2f(fminf(arg, 0.f)) * dtj;
                      m2[y] = cbv * w + ((i == j) ? Dh : 0.f); }
                  *(LAS unsigned*)(Mm + (e * 64 + i) * 72 + jq * 16 + jj) = pkbf(m2[0], m2[1]); } }
            __syncthreads();
            { const int e = wave >> 2, mt = wave & 3;
              f32x4 acc[1][4];
#pragma unroll
              for (int nt = 0; nt < 4; ++nt) acc[0][nt] = (f32x4){0.f, 0.f, 0.f, 0.f};
              mma_lds<1, 4>(acc, xT + e * 64 * 72, 72, mt * 16, Mm + e * 64 * 72, 72, 0, 64, fr, fq);
#pragma unroll
              for (int nt = 0; nt < 4; ++nt) { u32x2 w; w.x = pkbf(acc[0][nt][0], acc[0][nt][1]); w.y = pkbf(acc[0][nt][2], acc[0][nt][3]);
                  *(LAS u32x2*)(yst + (nt * 16 + fr) * 136 + e * 64 + mt * 16 + 4 * fq) = w; } }
            __syncthreads();
            if (hp < 3) PSI_PUTX(hp + 1);
            for (int e = tid; e < 64 * 16; e += 512) { const int i = e >> 4, p = e & 15;
                *(GAS u32x4*)(yi + (rowb + t0 + i) * 1024 + (g * 8 + 2 * hp) * 64 + p * 8) = *(const LAS u32x4*)(yst + i * 136 + p * 8); }
        }
        __syncthreads();
    }
#undef PSI_LOADBC
#undef PSI_LOADX
#undef PSI_PUTX
}

namespace ss2 {
constexpr int CO = 0;
constexpr int BO = CO + 64 * 132 * 2;
constexpr int XO = BO + 64 * 132 * 2;
constexpr int SCO = XO + 64 * 72 * 2;
constexpr int BUF = SCO + 768;
constexpr int OST = 2 * BUF;
constexpr int END = OST + 2 * 64 * 72 * 2;
static_assert(END <= MISC_OFF && BUF % 16 == 0, "ssd state LDS map");
}
template <int DIR>
__device__ __forceinline__ void ssd_state2(LAS unsigned char* lds, int b, int hd, const bf16* raw, const float* ssc, bf16* ys, int tid, int wave, int lane) {
    using namespace ss2;
    const size_t rowb = (size_t)b * SEQ; const int g = hd >> 3;
    LAS bf16* ost = (LAS bf16*)(lds + OST);
    const int r31 = lane & 31, hh = lane >> 5;
    if (wave == 4 || wave == 5) {
        for (int n = 0; n < NCHUNK + 1; ++n) WG_BAR();
    } else if (wave >= 2) {
        const int hw = (wave & 1) | ((wave >> 2) << 1); const int ht = hw * 64 + lane;
        unsigned go[10], lo_[10]; u32x4 ld[10]; float sr0 = 0.f, sr1 = 0.f;
#pragma unroll
        for (int x = 0; x < 4; ++x) { const int e = ht + 256 * x, r = e >> 4, p = e & 15;
            go[x] = (unsigned)((r * CONV_CH + 4352 + g * 128 + p * 8) * 2); go[4 + x] = (unsigned)((r * CONV_CH + 4096 + g * 128 + p * 8) * 2);
            lo_[x] = (unsigned)(CO + (r * 132 + p * 8) * 2); lo_[4 + x] = (unsigned)(BO + (r * 132 + p * 8) * 2); }
#pragma unroll
        for (int x = 0; x < 2; ++x) { const int e = ht + 256 * x, xr = e >> 3, p = e & 7;
            go[8 + x] = (unsigned)((xr * CONV_CH + 3072 + hd * 64 + p * 8) * 2); lo_[8 + x] = (unsigned)(XO + (xr * 72 + p * 8) * 2); }
#define SS2_ISSUE(c_) do { const GAS char* rb_ = (const GAS char*)(raw + (rowb + (size_t)(c_) * 64) * CONV_CH); \
            _Pragma("unroll") for (int x = 0; x < 10; ++x) ld[x] = *(const GAS u32x4*)(rb_ + go[x]); \
            if (hw == 0) { const float* sp_ = ssc + ((size_t)((b * 16 + hd) * NCHUNK + (c_))) * 256 + DIR * 128 + lane; sr0 = sp_[0]; sr1 = sp_[64]; } } while (0)
#define SS2_COMMIT(bi_, c_) do { LAS unsigned char* B_ = lds + (bi_) * BUF; \
            _Pragma("unroll") for (int x = 0; x < 10; ++x) { LAS unsigned char* d_ = B_ + lo_[x]; *(LAS u32x2*)(d_) = (u32x2){ld[x].x, ld[x].y}; *(LAS u32x2*)(d_ + 8) = (u32x2){ld[x].z, ld[x].w}; } \
            if (hw == 0) { LAS float* sc_ = (LAS float*)(B_ + SCO); const int i = lane; const float cs = sr1; const float cl = __shfl(cs, DIR ? 0 : 63); \
                sc_[i] = __expf(cs); sc_[64 + i] = sr0 * __expf(cl - cs); if (i == 0) sc_[128] = __expf(cl); } } while (0)
        { const int c0 = DIR ? NCHUNK - 1 : 0; SS2_ISSUE(c0); SS2_COMMIT(0, c0); SS2_ISSUE((DIR ? c0 - 1 : c0 + 1)); }
        for (int n = 0; n < NCHUNK; ++n) {
            const int c = DIR ? NCHUNK - 1 - n : n;
            WG_BAR();
            const bool more = n + 1 < NCHUNK; const int cn = DIR ? c - 1 : c + 1;
            if (more) { SS2_COMMIT((n + 1) & 1, cn); if (n + 2 < NCHUNK) SS2_ISSUE((DIR ? cn - 1 : cn + 1)); }
            unsigned ov[8];
            if (n > 0) {
#pragma unroll
                for (int x = 0; x < 8; ++x) ov[x] = *(const LAS unsigned*)(ost + ((n - 1) & 1) * (64 * 72) + (hw * 16 + 2 * x + (lane >> 5)) * 72 + 2 * (lane & 31));
            }
            if (n > 0) { const int tp = (DIR ? c + 1 : c - 1) * 64;
#pragma unroll
                for (int x = 0; x < 8; ++x) { GAS char* ob_ = (GAS char*)(ys + (rowb + tp + hw * 16 + 2 * x) * 1024 + hd * 64);
                    (void)__builtin_amdgcn_global_atomic_fadd_v2bf16((GAS s16x2*)(ob_ + (lane >> 5) * 2048 + (lane & 31) * 4), __builtin_bit_cast(s16x2, ov[x])); } }
        }
        WG_BAR();
        { const int tp = (DIR ? 0 : NCHUNK - 1) * 64;
#pragma unroll
          for (int x = 0; x < 8; ++x) { const unsigned v = *(const LAS unsigned*)(ost + ((NCHUNK - 1) & 1) * (64 * 72) + (hw * 16 + 2 * x + (lane >> 5)) * 72 + 2 * (lane & 31));
              GAS char* ob_ = (GAS char*)(ys + (rowb + tp + hw * 16 + 2 * x) * 1024 + hd * 64);
              (void)__builtin_amdgcn_global_atomic_fadd_v2bf16((GAS s16x2*)(ob_ + (lane >> 5) * 2048 + (lane & 31) * 4), __builtin_bit_cast(s16x2, v)); } }
#undef SS2_ISSUE
#undef SS2_COMMIT
    } else {
        const int ps = wave; const int xrow = ps * 32 + r31;
        f32x16 Ht[4];
#pragma unroll
        for (int t = 0; t < 4; ++t)
#pragma unroll
            for (int r = 0; r < 16; ++r) Ht[t][r] = 0.f;
        for (int n = 0; n < NCHUNK; ++n) {
            WG_BAR();
            const LAS unsigned char* Bb = lds + (n & 1) * BUF;
            const LAS bf16* Cb = (const LAS bf16*)(Bb + CO); const LAS bf16* Bmb = (const LAS bf16*)(Bb + BO); const LAS bf16* Xb = (const LAS bf16*)(Bb + XO);
            const LAS float* sc = (const LAS float*)(Bb + SCO);
            f32x16 aY[2];
#pragma unroll
            for (int m = 0; m < 2; ++m)
#pragma unroll
                for (int r = 0; r < 16; ++r) aY[m][r] = 0.f;
            bf16x8 fa[2][2];
            const int offc = r31 * 132 + 4 * hh;
#define SS2_LD2(bi_, ks_) do { fa[bi_][0] = afrag(Cb + offc + 16 * (ks_)); fa[bi_][1] = afrag(Cb + offc + 32 * 132 + 16 * (ks_)); } while (0)
            SS2_LD2(0, 0);
#pragma unroll
            for (int ks = 0; ks < 8; ++ks) {
                if (ks < 7) SS2_LD2((ks + 1) & 1, ks + 1);
                __builtin_amdgcn_sched_barrier(0);
                const bf16x8 bs = cvt8(Ht[ks >> 1], 8 * (ks & 1));
                aY[0] = MFMA32(fa[ks & 1][0], bs, aY[0]); aY[1] = MFMA32(fa[ks & 1][1], bs, aY[1]);
                __builtin_amdgcn_sched_barrier(0); }
#undef SS2_LD2
            const int i16 = r31 & 15; const LAS bf16* bp = Bmb + (8 * hh + (i16 >> 2)) * 132 + 16 * (r31 >> 4) + 4 * (i16 & 3);
            bf16x8 xf[4];
#pragma unroll
            for (int kt = 0; kt < 4; ++kt) { const bf16x8 xv = *(const LAS bf16x8*)(Xb + xrow * 72 + 16 * kt + 8 * hh);
                const f32x4 w0 = *(const LAS f32x4*)(sc + 64 + 16 * kt + 8 * hh), w1 = *(const LAS f32x4*)(sc + 64 + 16 * kt + 8 * hh + 4);
                u32x4 w; w.x = pkbf(bf2f_s(xv[0]) * w0[0], bf2f_s(xv[1]) * w0[1]); w.y = pkbf(bf2f_s(xv[2]) * w0[2], bf2f_s(xv[3]) * w0[3]);
                w.z = pkbf(bf2f_s(xv[4]) * w1[0], bf2f_s(xv[5]) * w1[1]); w.w = pkbf(bf2f_s(xv[6]) * w1[2], bf2f_s(xv[7]) * w1[3]);
                xf[kt] = __builtin_bit_cast(bf16x8, w); }
            bf16x8 fb[2][4];
#define SS2_LDBT(bi_, t_) do { _Pragma("unroll") for (int kt = 0; kt < 4; ++kt) { const LAS bf16* p_ = bp + (16 * kt) * 132 + 32 * (t_); \
                const v4i16_t lo_ = __builtin_amdgcn_ds_read_tr16_b64_v4i16((LAS v4i16_t*)p_), hi_ = __builtin_amdgcn_ds_read_tr16_b64_v4i16((LAS v4i16_t*)(p_ + 4 * 132)); \
                fb[bi_][kt] = (bf16x8){lo_[0], lo_[1], lo_[2], lo_[3], hi_[0], hi_[1], hi_[2], hi_[3]}; } } while (0)
            SS2_LDBT(0, 0);
#pragma unroll
            for (int m = 0; m < 2; ++m)
#pragma unroll
                for (int q4 = 0; q4 < 4; ++q4) { const f32x4 ec = *(const LAS f32x4*)(sc + 32 * m + 8 * q4 + 4 * hh);
#pragma unroll
                    for (int x = 0; x < 4; ++x) aY[m][4 * q4 + x] *= ec[x]; }
            const float ecl = sc[128];
#pragma unroll
            for (int mi = 0; mi < 2; ++mi)
#pragma unroll
                for (int r = 0; r < 16; ++r) ost[(n & 1) * (64 * 72) + (32 * mi + (r & 3) + 8 * (r >> 2) + 4 * hh) * 72 + ps * 32 + r31] = f2bf1(aY[mi][r]);
#pragma unroll
            for (int t = 0; t < 4; ++t) {
                if (t < 3) SS2_LDBT((t + 1) & 1, t + 1);
                __builtin_amdgcn_sched_barrier(0);
#pragma unroll
                for (int r = 0; r < 16; ++r) Ht[t][r] *= ecl;
                Ht[t] = MFMA32(fb[t & 1][0], xf[0], Ht[t]); Ht[t] = MFMA32(fb[t & 1][1], xf[1], Ht[t]);
                Ht[t] = MFMA32(fb[t & 1][2], xf[2], Ht[t]); Ht[t] = MFMA32(fb[t & 1][3], xf[3], Ht[t]);
                __builtin_amdgcn_sched_barrier(0); }
#undef SS2_LDBT
        }
        WG_BAR();
    }
}
#ifndef GS3_LDK
#define GS3_LDK 136
#endif
namespace gs3 {
constexpr int LDK = GS3_LDK, LDT = 72;
constexpr int KO = 0;
constexpr int QO = KO + 64 * LDK * 2;
constexpr int VTO = QO + 64 * LDK * 2;
constexpr int TO = VTO + 64 * LDT * 2;
constexpr int QKO = TO + 64 * LDT * 2;
constexpr int SCO = QKO + 64 * LDT * 2;
constexpr int BUF = SCO + 1024;
constexpr int OST = 2 * BUF;
constexpr int END = OST + 2 * 64 * 72 * 2;
static_assert(END <= MISC_OFF && BUF % 16 == 0, "gdn state3 LDS map");
}
__device__ __forceinline__ bf16x8 pack2(const f32x4& a, const f32x4& b) {
    u32x4 w; w.x = pkbf(a[0], a[1]); w.y = pkbf(a[2], a[3]); w.z = pkbf(b[0], b[1]); w.w = pkbf(b[2], b[3]);
    return __builtin_bit_cast(bf16x8, w);
}
__device__ __forceinline__ bf16x8 afrag16(const LAS bf16* p) {
    const bf16x4 lo = *(const LAS bf16x4*)p, hi = *(const LAS bf16x4*)(p + 16);
    return (bf16x8){lo[0], lo[1], lo[2], lo[3], hi[0], hi[1], hi[2], hi[3]};
}
__device__ __forceinline__ bf16x8 afrag16_tr(const LAS bf16* p, int ld) {
    const v4i16_t lo = __builtin_amdgcn_ds_read_tr16_b64_v4i16((LAS v4i16_t*)p), hi = __builtin_amdgcn_ds_read_tr16_b64_v4i16((LAS v4i16_t*)(p + 16 * ld));
    return (bf16x8){lo[0], lo[1], lo[2], lo[3], hi[0], hi[1], hi[2], hi[3]};
}
#define MFMA16(a, b, c) __builtin_amdgcn_mfma_f32_16x16x32_bf16((a), (b), (c), 0, 0, 0)

constexpr int CW_OFLAG = 16384;
__device__ __forceinline__ void store16_wt(bf16* p, u32x4 v) { asm volatile("global_store_dwordx4 %0, %1, off sc1\n\ts_nop 1" :: "v"(p), "v"(v) : "memory"); }
__device__ __forceinline__ void out_rows(const LAS bf16* ostb, bf16* gbase  , int lane, bool second) {
#pragma unroll
    for (int x = 0; x < 2; ++x) { const int r = 8 * x + (lane >> 3), pc = lane & 7;
        const u32x4 ov = *(const LAS u32x4*)(ostb + r * 72 + pc * 8); bf16* gp = gbase + (size_t)r * 1024 + pc * 8;
        if (!second) store16_wt(gp, ov);
        else { const u32x4 gv = *(const GAS u32x4*)gp; u32x4 o;
            o.x = pkbf(__uint_as_float(ov.x << 16) + __uint_as_float(gv.x << 16), __uint_as_float(ov.x & 0xffff0000u) + __uint_as_float(gv.x & 0xffff0000u));
            o.y = pkbf(__uint_as_float(ov.y << 16) + __uint_as_float(gv.y << 16), __uint_as_float(ov.y & 0xffff0000u) + __uint_as_float(gv.y & 0xffff0000u));
            o.z = pkbf(__uint_as_float(ov.z << 16) + __uint_as_float(gv.z << 16), __uint_as_float(ov.z & 0xffff0000u) + __uint_as_float(gv.z & 0xffff0000u));
            o.w = pkbf(__uint_as_float(ov.w << 16) + __uint_as_float(gv.w << 16), __uint_as_float(ov.w & 0xffff0000u) + __uint_as_float(gv.w & 0xffff0000u));
            *(GAS u32x4*)gp = o; } }
}
__device__ __forceinline__ void out_handshake(unsigned* flags, int mine, int partner, int hw, int lane) {
    asm volatile("s_waitcnt vmcnt(0)" ::: "memory");
    if (lane == 0) { __hip_atomic_store(flags + (mine * 4 + hw) * 16, 1u, __ATOMIC_RELAXED, __HIP_MEMORY_SCOPE_AGENT);
        unsigned sp = 0;
        while (__hip_atomic_load(flags + (partner * 4 + hw) * 16, __ATOMIC_RELAXED, __HIP_MEMORY_SCOPE_AGENT) == 0u) { __builtin_amdgcn_s_sleep(2); if (++sp > (1u << 22)) break; } }
    __builtin_amdgcn_fence(__ATOMIC_ACQUIRE, "agent");
    asm volatile("s_waitcnt vmcnt(0)" ::: "memory");
}

template <int DIR, int XP = 0>
__device__ __forceinline__ void gdn_state3(LAS unsigned char* lds, int b, int h, int half, const bf16* raw, const float* scal, const bf16* TQ, bf16* og, int tid, int wave, int lane, unsigned* flags, int cid) {
    using namespace gs3;
    const size_t rowb = (size_t)b * SEQ; const int bh = b * 8 + h;
    LAS bf16* ost = (LAS bf16*)(lds + OST);
    const int fr = lane & 15, fq = lane >> 4;
    if (wave >= 4) {
        const int hw = wave - 4; const int ht = hw * 64 + lane;
        unsigned go[14], lo_[14]; u32x4 ld[14]; float sr0 = 0.f, sr1 = 0.f;
#pragma unroll
        for (int x = 0; x < 4; ++x) { const int e = ht + 256 * x, r = e >> 4, p = e & 15;
            go[x] = (unsigned)((r * CONV_CH + 1024 + h * 128 + p * 8) * 2); go[4 + x] = (unsigned)((r * CONV_CH + h * 128 + p * 8) * 2);
            lo_[x] = (unsigned)(KO + (r * LDK + p * 8) * 2); lo_[4 + x] = (unsigned)(QO + (r * LDK + p * 8) * 2); }
#pragma unroll
        for (int x = 0; x < 2; ++x) { const int e = ht + 256 * x, dvl = e >> 3, p = e & 7; const int dv = 64 * half + dvl;
            go[8 + x] = (unsigned)(((dv >> 1) * CONV_CH + 2048 + h * 128 + (dv & 1) * 64 + p * 8) * 2); lo_[8 + x] = (unsigned)(VTO + (dvl * LDT + p * 8) * 2); }
        u32x4 km[2], dg[2], qm[2];
#pragma unroll
        for (int x = 0; x < 2; ++x) { const int e = ht + 256 * x, i = e >> 3, p = e & 7;
            go[10 + x] = (unsigned)(e * 16); go[12 + x] = (unsigned)(8192 + e * 16);
            lo_[10 + x] = (unsigned)(TO + (i * LDT + p * 8) * 2); lo_[12 + x] = (unsigned)(QKO + (i * LDT + p * 8) * 2);
            unsigned kw[4], dw[4], qw[4];
#pragma unroll
            for (int w = 0; w < 4; ++w) { const int j0 = p * 8 + 2 * w, j1 = j0 + 1;
                const bool k0 = DIR ? (i < j0) : (i > j0), k1 = DIR ? (i < j1) : (i > j1);
                kw[w] = (k0 ? 0xFFFFu : 0u) | (k1 ? 0xFFFF0000u : 0u); dw[w] = (i == j0 ? 0x3F80u : 0u) | (i == j1 ? 0x3F800000u : 0u);
                qw[w] = kw[w] | (i == j0 ? 0xFFFFu : 0u) | (i == j1 ? 0xFFFF0000u : 0u); }
            km[x] = (u32x4){kw[0], kw[1], kw[2], kw[3]}; dg[x] = (u32x4){dw[0], dw[1], dw[2], dw[3]}; qm[x] = (u32x4){qw[0], qw[1], qw[2], qw[3]}; }
        const unsigned so_l = (unsigned)(lane * 256 + (DIR * 8 + h) * 4);
#define GS3_ISSUE(c_) do { const GAS char* rb_ = (const GAS char*)(raw + (rowb + (size_t)(c_) * 64) * CONV_CH); const GAS char* tb_ = (const GAS char*)(TQ + ((size_t)(bh * NCHUNK + (c_))) * 8192); \
            _Pragma("unroll") for (int x = 0; x < 10; ++x) ld[x] = *(const GAS u32x4*)(rb_ + go[x]); \
            _Pragma("unroll") for (int x = 10; x < 14; ++x) ld[x] = *(const GAS u32x4*)(tb_ + go[x]); \
            if (hw == 0) { const GAS char* sb_ = (const GAS char*)(scal + (rowb + (size_t)(c_) * 64) * 64); sr0 = *(const GAS float*)(sb_ + so_l); sr1 = *(const GAS float*)(sb_ + so_l + 64); } } while (0)
#define GS3_COMMIT(bi_, c_) do { LAS unsigned char* B_ = lds + (bi_) * BUF; \
            _Pragma("unroll") for (int x = 0; x < 10; ++x) *(LAS u32x4*)(B_ + lo_[x]) = ld[x]; \
            _Pragma("unroll") for (int x = 0; x < 2; ++x) { *(LAS u32x4*)(B_ + lo_[10 + x]) = (ld[10 + x] & km[x]) | dg[x]; *(LAS u32x4*)(B_ + lo_[12 + x]) = ld[12 + x] & qm[x]; } \
            if (hw == 0) { LAS float* sc_ = (LAS float*)(B_ + SCO); const int i = lane; const float gc = sr1; const float gl = __shfl(gc, DIR ? 0 : 63); \
                sc_[i] = sr0; sc_[64 + i] = __expf(gc); sc_[128 + i] = __expf(gl - gc); if (i == 0) sc_[192] = __expf(gl); } } while (0)
        { const int c0 = DIR ? NCHUNK - 1 : 0; GS3_ISSUE(c0); GS3_COMMIT(0, c0); GS3_ISSUE((DIR ? c0 - 1 : c0 + 1)); }
        for (int n = 0; n < NCHUNK; ++n) {
            const int c = DIR ? NCHUNK - 1 - n : n;
            WG_BAR();
            const bool more = n + 1 < NCHUNK; const int cn = DIR ? c - 1 : c + 1;
            if (more) { GS3_COMMIT((n + 1) & 1, cn); if (n + 2 < NCHUNK && (!(XP & 2) || n < 2)) GS3_ISSUE((DIR ? cn - 1 : cn + 1)); }
            if (n > 0 && !(XP & 1)) { const int tp = (DIR ? c + 1 : c - 1) * 64;
#pragma unroll
                for (int x = 0; x < 8; ++x) { const unsigned v = *(const LAS unsigned*)(ost + ((n - 1) & 1) * (64 * 72) + (hw * 16 + 2 * x + (lane >> 5)) * 72 + 2 * (lane & 31));
                    GAS char* ob_ = (GAS char*)(og + (rowb + tp + hw * 16 + 2 * x) * 1024 + h * 128 + half * 64);
                    (void)__builtin_amdgcn_global_atomic_fadd_v2bf16((GAS s16x2*)(ob_ + (lane >> 5) * 2048 + (lane & 31) * 4), __builtin_bit_cast(s16x2, v)); } }
        }
        WG_BAR();
        { const int tp = (DIR ? 0 : NCHUNK - 1) * 64;
#pragma unroll
          for (int x = 0; x < 8; ++x) { const unsigned v = *(const LAS unsigned*)(ost + ((NCHUNK - 1) & 1) * (64 * 72) + (hw * 16 + 2 * x + (lane >> 5)) * 72 + 2 * (lane & 31));
              GAS char* ob_ = (GAS char*)(og + (rowb + tp + hw * 16 + 2 * x) * 1024 + h * 128 + half * 64);
              (void)__builtin_amdgcn_global_atomic_fadd_v2bf16((GAS s16x2*)(ob_ + (lane >> 5) * 2048 + (lane & 31) * 4), __builtin_bit_cast(s16x2, v)); } }
#undef GS3_ISSUE
#undef GS3_COMMIT
    } else {
        const int dv0 = 16 * wave;
        f32x4 St[8];
#pragma unroll
        for (int t = 0; t < 8; ++t) St[t] = (f32x4){0.f, 0.f, 0.f, 0.f};
        for (int n = 0; n < NCHUNK; ++n) {
            WG_BAR();
            const LAS unsigned char* Bb = lds + (n & 1) * BUF;
            const LAS bf16* Kb = (const LAS bf16*)(Bb + KO); const LAS bf16* Qb = (const LAS bf16*)(Bb + QO); const LAS bf16* Vb = (const LAS bf16*)(Bb + VTO);
            const LAS bf16* Tb = (const LAS bf16*)(Bb + TO); const LAS bf16* QKb = (const LAS bf16*)(Bb + QKO); const LAS float* sc = (const LAS float*)(Bb + SCO);
            const int offa = fr * LDK + 4 * fq, offt = fr * LDT + 4 * fq;
            bf16x8 bS[4];
#pragma unroll
            for (int ks = 0; ks < 4; ++ks) bS[ks] = pack2(St[2 * ks], St[2 * ks + 1]);
            f32x4 aK[4];
#pragma unroll
            for (int m = 0; m < 4; ++m) aK[m] = (f32x4){0.f, 0.f, 0.f, 0.f};
#pragma unroll
            for (int ks = 0; ks < 4; ++ks) { bf16x8 fa[4];
#pragma unroll
                for (int m = 0; m < 4; ++m) fa[m] = afrag16(Kb + offa + 16 * m * LDK + 32 * ks);
#pragma unroll
                for (int m = 0; m < 4; ++m) aK[m] = MFMA16(fa[m], bS[ks], aK[m]); }
            bf16x8 ft[8];
#pragma unroll
            for (int mi = 0; mi < 4; ++mi)
#pragma unroll
                for (int kt = 0; kt < 2; ++kt) { const bool need = DIR ? (kt >= (mi >> 1)) : (kt <= (mi >> 1));
                    if (need) ft[mi * 2 + kt] = afrag16(Tb + offt + 16 * mi * LDT + 32 * kt); }
#pragma unroll
            for (int m = 0; m < 4; ++m) { const int tb = 16 * m + 4 * fq;
                const bf16x4 vv = *(const LAS bf16x4*)(Vb + (dv0 + fr) * LDT + tb); const f32x4 be = *(const LAS f32x4*)(sc + tb), eg = *(const LAS f32x4*)(sc + 64 + tb);
#pragma unroll
                for (int e = 0; e < 4; ++e) aK[m][e] = be[e] * (bf2f_s(vv[e]) - eg[e] * aK[m][e]); }
            const bf16x8 br0 = pack2(aK[0], aK[1]), br1 = pack2(aK[2], aK[3]);
            f32x4 au[4];
#pragma unroll
            for (int m = 0; m < 4; ++m) au[m] = (f32x4){0.f, 0.f, 0.f, 0.f};
#pragma unroll
            for (int mi = 0; mi < 4; ++mi)
#pragma unroll
                for (int kt = 0; kt < 2; ++kt) { const bool need = DIR ? (kt >= (mi >> 1)) : (kt <= (mi >> 1));
                    if (need) au[mi] = MFMA16(ft[mi * 2 + kt], (kt == 0 ? br0 : br1), au[mi]); }
            f32x4 aQ[4];
            if constexpr (!(XP & 4)) {
#pragma unroll
            for (int m = 0; m < 4; ++m) aQ[m] = (f32x4){0.f, 0.f, 0.f, 0.f};
#pragma unroll
            for (int ks = 0; ks < 4; ++ks) { bf16x8 fa[4];
#pragma unroll
                for (int m = 0; m < 4; ++m) fa[m] = afrag16(Qb + offa + 16 * m * LDK + 32 * ks);
#pragma unroll
                for (int m = 0; m < 4; ++m) aQ[m] = MFMA16(fa[m], bS[ks], aQ[m]); }
            bf16x8 fqk[8];
#pragma unroll
            for (int mi = 0; mi < 4; ++mi)
#pragma unroll
                for (int kt = 0; kt < 2; ++kt) { const bool need = DIR ? (kt >= (mi >> 1)) : (kt <= (mi >> 1));
                    if (need) fqk[mi * 2 + kt] = afrag16(QKb + offt + 16 * mi * LDT + 32 * kt); }
            const bf16x8 bu0 = pack2(au[0], au[1]), bu1 = pack2(au[2], au[3]);
#pragma unroll
            for (int m = 0; m < 4; ++m) { const int tb = 16 * m + 4 * fq; const f32x4 eg = *(const LAS f32x4*)(sc + 64 + tb);
#pragma unroll
                for (int e = 0; e < 4; ++e) { aQ[m][e] *= eg[e]; } }
#pragma unroll
            for (int mi = 0; mi < 4; ++mi)
#pragma unroll
                for (int kt = 0; kt < 2; ++kt) { const bool need = DIR ? (kt >= (mi >> 1)) : (kt <= (mi >> 1));
                    if (need) aQ[mi] = MFMA16(fqk[mi * 2 + kt], (kt == 0 ? bu0 : bu1), aQ[mi]); }
#pragma unroll
            for (int m = 0; m < 4; ++m)
#pragma unroll
                for (int e = 0; e < 4; ++e) ost[(n & 1) * (64 * 72) + (16 * m + 4 * fq + e) * 72 + dv0 + fr] = f2bf1(aQ[m][e]);
            }
#pragma unroll
            for (int m = 0; m < 4; ++m) { const int tb = 16 * m + 4 * fq; const f32x4 ek = *(const LAS f32x4*)(sc + 128 + tb);
#pragma unroll
                for (int e = 0; e < 4; ++e) { au[m][e] *= ek[e]; } }
            const bf16x8 bd0 = pack2(au[0], au[1]), bd1 = pack2(au[2], au[3]);
            const float egl = sc[192];
            { const LAS bf16* kp = Kb + (4 * fq + (fr >> 2)) * LDK + 4 * (fr & 3);
#pragma unroll
              for (int t = 0; t < 8; ++t) { const bf16x8 f0 = afrag16_tr(kp + 16 * t, LDK), f1 = afrag16_tr(kp + 32 * LDK + 16 * t, LDK);
                  St[t] = St[t] * egl; St[t] = MFMA16(f0, bd0, St[t]); St[t] = MFMA16(f1, bd1, St[t]); } }
        }
        WG_BAR();
    }
}

namespace ss3 {
constexpr int LDK = GS3_LDK, LDT = 72;
constexpr int CO = 0;
constexpr int BO = CO + 64 * LDK * 2;
constexpr int XO = BO + 64 * LDK * 2;
constexpr int SCO = XO + 64 * LDT * 2;
constexpr int BUF = SCO + 768;
constexpr int OST = 2 * BUF;
constexpr int END = OST + 2 * 64 * 72 * 2;
static_assert(END <= MISC_OFF && BUF % 16 == 0, "ssd state3 LDS map");
}
template <int DIR, int XP = 0>
__device__ __forceinline__ void ssd_state3(LAS unsigned char* lds, int b, int hd, const bf16* raw, const float* ssc, bf16* ys, int tid, int wave, int lane, unsigned* flags, int cid) {
    using namespace ss3;
    const size_t rowb = (size_t)b * SEQ; const int g = hd >> 3;
    LAS bf16* ost = (LAS bf16*)(lds + OST);
    const int fr = lane & 15, fq = lane >> 4;
    if (wave >= 4) {
        const int hw = wave - 4; const int ht = hw * 64 + lane;
        unsigned go[10], lo_[10]; u32x4 ld[10]; float sr0 = 0.f, sr1 = 0.f;
#pragma unroll
        for (int x = 0; x < 4; ++x) { const int e = ht + 256 * x, r = e >> 4, p = e & 15;
            go[x] = (unsigned)((r * CONV_CH + 4352 + g * 128 + p * 8) * 2); go[4 + x] = (unsigned)((r * CONV_CH + 4096 + g * 128 + p * 8) * 2);
            lo_[x] = (unsigned)(CO + (r * LDK + p * 8) * 2); lo_[4 + x] = (unsigned)(BO + (r * LDK + p * 8) * 2); }
#pragma unroll
        for (int x = 0; x < 2; ++x) { const int e = ht + 256 * x, xr = e >> 3, p = e & 7;
            go[8 + x] = (unsigned)((xr * CONV_CH + 3072 + hd * 64 + p * 8) * 2); lo_[8 + x] = (unsigned)(XO + (xr * LDT + p * 8) * 2); }
#define SS3_ISSUE(c_) do { const GAS char* rb_ = (const GAS char*)(raw + (rowb + (size_t)(c_) * 64) * CONV_CH); \
            _Pragma("unroll") for (int x = 0; x < 10; ++x) ld[x] = *(const GAS u32x4*)(rb_ + go[x]); \
            if (hw == 0) { const float* sp_ = ssc + ((size_t)((b * 16 + hd) * NCHUNK + (c_))) * 256 + DIR * 128 + lane; sr0 = sp_[0]; sr1 = sp_[64]; } } while (0)
#define SS3_COMMIT(bi_, c_) do { LAS unsigned char* B_ = lds + (bi_) * BUF; \
            _Pragma("unroll") for (int x = 0; x < 10; ++x) *(LAS u32x4*)(B_ + lo_[x]) = ld[x]; \
            if (hw == 0) { LAS float* sc_ = (LAS float*)(B_ + SCO); const int i = lane; const float cs = sr1; const float cl = __shfl(cs, DIR ? 0 : 63); \
                sc_[i] = __expf(cs); sc_[64 + i] = sr0 * __expf(cl - cs); if (i == 0) sc_[128] = __expf(cl); } } while (0)
        { const int c0 = DIR ? NCHUNK - 1 : 0; SS3_ISSUE(c0); SS3_COMMIT(0, c0); SS3_ISSUE((DIR ? c0 - 1 : c0 + 1)); }
        for (int n = 0; n < NCHUNK; ++n) {
            const int c = DIR ? NCHUNK - 1 - n : n;
            WG_BAR();
            const bool more = n + 1 < NCHUNK; const int cn = DIR ? c - 1 : c + 1;
            if (more) { SS3_COMMIT((n + 1) & 1, cn); if (n + 2 < NCHUNK && (!(XP & 2) || n < 2)) SS3_ISSUE((DIR ? cn - 1 : cn + 1)); }
            if (n > 0 && !(XP & 1)) { const int tp = (DIR ? c + 1 : c - 1) * 64;
#pragma unroll
                for (int x = 0; x < 8; ++x) { const unsigned v = *(const LAS unsigned*)(ost + ((n - 1) & 1) * (64 * 72) + (hw * 16 + 2 * x + (lane >> 5)) * 72 + 2 * (lane & 31));
                    GAS char* ob_ = (GAS char*)(ys + (rowb + tp + hw * 16 + 2 * x) * 1024 + hd * 64);
                    (void)__builtin_amdgcn_global_atomic_fadd_v2bf16((GAS s16x2*)(ob_ + (lane >> 5) * 2048 + (lane & 31) * 4), __builtin_bit_cast(s16x2, v)); } }
        }
        WG_BAR();
        { const int tp = (DIR ? 0 : NCHUNK - 1) * 64;
#pragma unroll
          for (int x = 0; x < 8; ++x) { const unsigned v = *(const LAS unsigned*)(ost + ((NCHUNK - 1) & 1) * (64 * 72) + (hw * 16 + 2 * x + (lane >> 5)) * 72 + 2 * (lane & 31));
              GAS char* ob_ = (GAS char*)(ys + (rowb + tp + hw * 16 + 2 * x) * 1024 + hd * 64);
              (void)__builtin_amdgcn_global_atomic_fadd_v2bf16((GAS s16x2*)(ob_ + (lane >> 5) * 2048 + (lane & 31) * 4), __builtin_bit_cast(s16x2, v)); } }
#undef SS3_ISSUE
#undef SS3_COMMIT
    } else {
        const int p0 = 16 * wave;
        f32x4 Ht[8];
#pragma unroll
        for (int t = 0; t < 8; ++t) Ht[t] = (f32x4){0.f, 0.f, 0.f, 0.f};
        for (int n = 0; n < NCHUNK; ++n) {
            WG_BAR();
            const LAS unsigned char* Bb = lds + (n & 1) * BUF;
            const LAS bf16* Cb = (const LAS bf16*)(Bb + CO); const LAS bf16* Bmb = (const LAS bf16*)(Bb + BO); const LAS bf16* Xb = (const LAS bf16*)(Bb + XO);
            const LAS float* sc = (const LAS float*)(Bb + SCO);
            const int offa = fr * LDK + 4 * fq;
            f32x4 aY[4];
#pragma unroll
            for (int m = 0; m < 4; ++m) aY[m] = (f32x4){0.f, 0.f, 0.f, 0.f};
#pragma unroll
            for (int ks = 0; ks < 4; ++ks) { const bf16x8 bs = pack2(Ht[2 * ks], Ht[2 * ks + 1]); bf16x8 fa[4];
#pragma unroll
                for (int m = 0; m < 4; ++m) fa[m] = afrag16(Cb + offa + 16 * m * LDK + 32 * ks);
#pragma unroll
                for (int m = 0; m < 4; ++m) aY[m] = MFMA16(fa[m], bs, aY[m]); }
            bf16x8 xf[2];
#pragma unroll
            for (int kt = 0; kt < 2; ++kt) { const bf16x8 xv = *(const LAS bf16x8*)(Xb + (p0 + fr) * LDT + 32 * kt + 8 * fq);
                const f32x4 w0 = *(const LAS f32x4*)(sc + 64 + 32 * kt + 8 * fq), w1 = *(const LAS f32x4*)(sc + 64 + 32 * kt + 8 * fq + 4);
                u32x4 w; w.x = pkbf(bf2f_s(xv[0]) * w0[0], bf2f_s(xv[1]) * w0[1]); w.y = pkbf(bf2f_s(xv[2]) * w0[2], bf2f_s(xv[3]) * w0[3]);
                w.z = pkbf(bf2f_s(xv[4]) * w1[0], bf2f_s(xv[5]) * w1[1]); w.w = pkbf(bf2f_s(xv[6]) * w1[2], bf2f_s(xv[7]) * w1[3]);
                xf[kt] = __builtin_bit_cast(bf16x8, w); }
#pragma unroll
            for (int m = 0; m < 4; ++m) { const f32x4 ec = *(const LAS f32x4*)(sc + 16 * m + 4 * fq);
#pragma unroll
                for (int e = 0; e < 4; ++e) aY[m][e] *= ec[e]; }
            const float ecl = sc[128];
#pragma unroll
            for (int m = 0; m < 4; ++m)
#pragma unroll
                for (int e = 0; e < 4; ++e) ost[(n & 1) * (64 * 72) + (16 * m + 4 * fq + e) * 72 + p0 + fr] = f2bf1(aY[m][e]);
            { const LAS bf16* bp = Bmb + (8 * fq + (fr >> 2)) * LDK + 4 * (fr & 3);
#pragma unroll
              for (int t = 0; t < 8; ++t) {
                  bf16x8 f[2];
#pragma unroll
                  for (int kt = 0; kt < 2; ++kt) { const LAS bf16* p = bp + (32 * kt) * LDK + 16 * t;
                      const v4i16_t lo = __builtin_amdgcn_ds_read_tr16_b64_v4i16((LAS v4i16_t*)p), hi = __builtin_amdgcn_ds_read_tr16_b64_v4i16((LAS v4i16_t*)(p + 4 * LDK));
                      f[kt] = (bf16x8){lo[0], lo[1], lo[2], lo[3], hi[0], hi[1], hi[2], hi[3]}; }
                  Ht[t] = Ht[t] * ecl; Ht[t] = MFMA16(f[0], xf[0], Ht[t]); Ht[t] = MFMA16(f[1], xf[1], Ht[t]); } }
        }
        WG_BAR();
    }
}
#ifndef PG8_SP2_
#define PG8_SP2_ true
#endif
#ifndef MK_ONE_LAUNCH
#define MK_ONE_LAUNCH 1
#endif
constexpr int PPL = 12;
constexpr int NPHASE = 1 + PPL * DEPTH;
__device__ __forceinline__ void half_stagger(int bid, int ticks) {
    if (ticks > 0 && (bid & 128)) { const unsigned long long t0 = __builtin_amdgcn_s_memrealtime();
        while (__builtin_amdgcn_s_memrealtime() - t0 < (unsigned long long)ticks) __builtin_amdgcn_s_sleep(8); }
}
#ifndef STG_A
#define STG_A 0
#endif
#ifndef STG_B
#define STG_B 0
#endif
#ifndef STG_O
#define STG_O 0
#endif
#ifndef STG_E1
#define STG_E1 0
#endif
#ifndef STG_E2
#define STG_E2 0
#endif
struct Args { const float* in[19]; float* out; unsigned char* ws; int ph_lo, ph_hi; };
__global__ void __launch_bounds__(NWAVES * 64, 2) fwd_kernel(Args args) {
    extern __shared__ __attribute__((aligned(16))) unsigned char lds_raw[];
    LAS unsigned char* lds = (LAS unsigned char*)lds_raw;
    unsigned* ctl = (unsigned*)(args.ws + WS_CTL);
    volatile LAS unsigned* MISC = (volatile LAS unsigned*)(lds + MISC_OFF);
    for (int u = threadIdx.x; u < 64; u += 512) MISC[u] = 0u;
    __syncthreads();
#if MK_ONE_LAUNCH
    XcdBarrier bar = xcd_barrier_post(ctl + CW_BAR, MISC + 8);
#define GRID_BAR() do { XcdBarrier bb_ = bar; asm volatile("" : "+s"(bb_.bar), "+s"(bb_.x)); xcd_barrier(bb_); } while (0)
#else
#define GRID_BAR() do {} while (0)
#endif
    const int lo = args.ph_lo, hi = args.ph_hi;
#define WSP(T, off) ((T*)(wsb + (off)))
#define OGP ((bf16*)ap->out + (size_t)32 * MiB)
#if defined(PROBE_STATE) || defined(PROBE_ANY) || defined(PROBE_SUB)
#define PROBE_PTR ((float*)(wsb + WS_CTL) + 2048)
#define PROBE_SCALE (1.0f + sqrtf(8.7e-4f * fminf(fmaxf(*(volatile float*)PROBE_PTR, 0.f), 1.f)))
#else
#define PROBE_PTR ((float*)nullptr)
#define PROBE_SCALE 1.0f
#endif
    for (int ph = lo; ph < hi; ++ph) {
        int tid = threadIdx.x, bid = blockIdx.x, G = gridDim.x;
        const __attribute__((address_space(4))) Args* ap = (const __attribute__((address_space(4))) Args*)__builtin_amdgcn_kernarg_segment_ptr();
        asm volatile("" : "+v"(tid)); asm volatile("" : "+s"(bid), "+s"(G), "+s"(ap));
        unsigned char* wsb = ap->ws;
        const int lane = tid & 63, wave = __builtin_amdgcn_readfirstlane(tid >> 6);
        const int gw = bid * NWAVES + wave, NGW = G * NWAVES, gtid = bid * 512 + tid, NGT = G * 512;
        const int l = (ph == 0) ? 0 : (ph - 1) / PPL; const int k = (ph == 0) ? -1 : (ph - 1) % PPL;
#if defined(PROBE_ANY)
        if (l == PROBE_L && k == PROBE_K0 && blockIdx.x == 0 && threadIdx.x == 0) ((unsigned long long*)(wsb + WS_CTL))[1100] = __builtin_amdgcn_s_memrealtime();
#endif
        switch (k) {
        case -1: {
            cvt_mixer_weights(lds, wsb, ap->in[2], ap->in[12], gw, NGW, wave, lane);
            phase_norm<float>(ap->in[0], ap->in[1], WSP(bf16, WS_XN), gw, NGW, lane);
        } break;
        case 0: {
            pg8::Gemm g{WSP(bf16, WS_XN), WSP(bf16, WS_WA), M, NWA, DM, 0, 0, 0}; pg8::StaticOrder S; S.init(M, NWA, G, bid);
            pg8::EpiRawA E{WSP(bf16, WS_RAW), WSP(float, WS_SCAL)};
            half_stagger(bid, STG_A);
            pg8::gemm_phase<pg8::EpiRawA, pg8::StaticOrder, true, PG8_SP2_>(lds, g, S, E);
#if defined(EXP_DUP_GEMM)
#if defined(EXP_PADEPI)
            if (l == 0 && (EXP_DUP_GEMM & 1)) { __syncthreads(); pg8::EpiPadA EP{(bf16*)ap->out, EXP_PADEPI}; pg8::gemm_phase<pg8::EpiPadA, pg8::StaticOrder, true, PG8_SP2_>(lds, g, S, EP); }
#elif defined(EXP_NULLEPI)
            if (l == 0 && (EXP_DUP_GEMM & 1)
#if defined(EXP_HALFWG)
                && !((bid >> 3) & 1)
#endif
               ) { __syncthreads(); pg8::EpiNullA EN{WSP(bf16, WS_RAW)}; pg8::gemm_phase<pg8::EpiNullA, pg8::StaticOrder, true, PG8_SP2_>(lds, g, S, EN); }
#else
            if (l == 0 && (EXP_DUP_GEMM & 1)
#if defined(EXP_HALFWG)
                && !((bid >> 3) & 1)
#endif
               ) { __syncthreads(); pg8::gemm_phase<pg8::EpiRawA, pg8::StaticOrder, true, PG8_SP2_>(lds, g, S, E); }
#endif
#endif
        } break;
        case 1: {
            if (l == 1) PB_START(3, wsb);
            prep_gdn_stash(lds, bid, WSP(bf16, WS_RAW), tid); prep_ssd_stash(lds, bid, WSP(bf16, WS_RAW), tid);
            zero_region((unsigned char*)OGP, 64 * MiB, gtid, NGT); zero_region(wsb + WS_YS, 64 * MiB, gtid, NGT);
            GRID_BAR();
#if defined(EXP_DUP_PREP)
            if (l == 0) {
                bf16* dmy = (bf16*)ap->out;
                if (!(EXP_DUP_PREP & 32)) prep_gdn_range<EXP_DUP_PREP | 64>(lds, bid, WSP(bf16, WS_RAW), WSP(float, WS_SCAL), ap->in[3] + (size_t)l * 7 * CONV_CH, ap->in[4] + (size_t)l * CONV_CH,
                           ap->in[5] + l * 16, ap->in[6] + l * 16, dmy + 40 * MiB, tid, wave, lane, (float*)(dmy + 38 * MiB), dmy);
                __syncthreads();
                if (!(EXP_DUP_PREP & 16)) { int tid2 = threadIdx.x; asm volatile("" : "+v"(tid2));
                  prep_ssd_range<EXP_DUP_PREP | 64>(lds, bid, WSP(bf16, WS_RAW), ap->in[3] + (size_t)l * 7 * CONV_CH, ap->in[4] + (size_t)l * CONV_CH, tid2,
                             WSP(float, WS_SCAL), ap->in[8] + l * 32, ap->in[9] + l * 32, (float*)(dmy + 56 * MiB), dmy); }
                __syncthreads();
                prep_gdn_stash(lds, bid, WSP(bf16, WS_RAW), tid); prep_ssd_stash(lds, bid, WSP(bf16, WS_RAW), tid);
                GRID_BAR();
            }
#endif
            if (l == 1) { PB_END(3, wsb); PB_START(1, wsb); }
            prep_gdn_range(lds, bid, WSP(bf16, WS_RAW), WSP(float, WS_SCAL), ap->in[3] + (size_t)l * 7 * CONV_CH, ap->in[4] + (size_t)l * CONV_CH,
                           ap->in[5] + l * 16, ap->in[6] + l * 16, WSP(bf16, WS_TQ), tid, wave, lane, WSP(float, WS_SCAL));
            __syncthreads();
            if (l == 1) { PB_END(1, wsb); PB_START(2, wsb); }
            { int tid2 = threadIdx.x; asm volatile("" : "+v"(tid2));
              prep_ssd_range(lds, bid, WSP(bf16, WS_RAW), ap->in[3] + (size_t)l * 7 * CONV_CH, ap->in[4] + (size_t)l * CONV_CH, tid2,
                             WSP(float, WS_SCAL), ap->in[8] + l * 32, ap->in[9] + l * 32, WSP(float, WS_SSC)); }
            if (l == 1) { __syncthreads(); PB_END(2, wsb); }
        } break;
        case 2: {
#if defined(EXP_DUP_ST)
            for (int c0_ = bid; c0_ < 256 * 2; c0_ += G) {
                const int c = c0_ & 255; const bool dup_ = c0_ >= 256;
                if (dup_ && (l != 0 || ((EXP_DUP_ST == 1) != (c < 128)))) continue;
                bf16* const ogp_ = dup_ ? (bf16*)ap->out : OGP; bf16* const ysp_ = dup_ ? (bf16*)ap->out : WSP(bf16, WS_YS);
#else
            for (int c = bid; c < 256; c += G) {
                bf16* const ogp_ = OGP; bf16* const ysp_ = WSP(bf16, WS_YS);
#endif
                int tid = threadIdx.x; asm volatile("" : "+v"(tid));
                const int lane = tid & 63, wave = __builtin_amdgcn_readfirstlane(tid >> 6);
                if (c < 128) { const int x_ = (c & 7) | ((c >> 4) << 3), hf_ = (c >> 3) & 1;
                    const int b_ = x_ >> 4, h_ = (x_ >> 1) & 7;
#if defined(EXP_DUP_ST) && defined(EXP_S2)
                    if (dup_) { if (x_ & 1) gdn_state2<1>(lds, b_, h_, hf_, WSP(bf16, WS_RAW), WSP(float, WS_SCAL), WSP(bf16, WS_TQ), ap->in[5] + l * 16, ap->in[6] + l * 16, ogp_, tid, wave, lane);
                                else        gdn_state2<0>(lds, b_, h_, hf_, WSP(bf16, WS_RAW), WSP(float, WS_SCAL), WSP(bf16, WS_TQ), ap->in[5] + l * 16, ap->in[6] + l * 16, ogp_, tid, wave, lane); } else
#endif
#if defined(EXP_DUP_ST) && defined(EXP_XP)
                    if (dup_) { if (x_ & 1) gdn_state3<1, EXP_XP>(lds, b_, h_, hf_, WSP(bf16, WS_RAW), WSP(float, WS_SCAL), WSP(bf16, WS_TQ), ogp_, tid, wave, lane, nullptr, 0);
                                else        gdn_state3<0, EXP_XP>(lds, b_, h_, hf_, WSP(bf16, WS_RAW), WSP(float, WS_SCAL), WSP(bf16, WS_TQ), ogp_, tid, wave, lane, nullptr, 0); } else
#endif
                    if (x_ & 1) gdn_state3<1>(lds, b_, h_, hf_, WSP(bf16, WS_RAW), WSP(float, WS_SCAL), WSP(bf16, WS_TQ), ogp_, tid, wave, lane, nullptr, 0);
                    else        gdn_state3<0>(lds, b_, h_, hf_, WSP(bf16, WS_RAW), WSP(float, WS_SCAL), WSP(bf16, WS_TQ), ogp_, tid, wave, lane, nullptr, 0); }
                else { const int c2 = c - 128, gi_ = c2 & 15, hl_ = c2 >> 4;
                    const int b_ = gi_ >> 2, hd_ = ((gi_ >> 1) & 1) * 8 + hl_;
#if defined(EXP_DUP_ST) && defined(EXP_XP)
                    if (dup_) { if (gi_ & 1) ssd_state3<1, EXP_XP>(lds, b_, hd_, WSP(bf16, WS_RAW), WSP(float, WS_SSC), ysp_, tid, wave, lane, nullptr, 0);
                                else         ssd_state3<0, EXP_XP>(lds, b_, hd_, WSP(bf16, WS_RAW), WSP(float, WS_SSC), ysp_, tid, wave, lane, nullptr, 0); } else
#endif
                    if (gi_ & 1) ssd_state3<1>(lds, b_, hd_, WSP(bf16, WS_RAW), WSP(float, WS_SSC), ysp_, tid, wave, lane, nullptr, 0);
                    else         ssd_state3<0>(lds, b_, hd_, WSP(bf16, WS_RAW), WSP(float, WS_SSC), ysp_, tid, wave, lane, nullptr, 0); }
                __syncthreads();
            }
        } break;
        case 3: {
            ssd_intra_range(lds, bid, WSP(bf16, WS_RAW), WSP(float, WS_SSC), ap->in[10] + l * 16, WSP(bf16, WS_TQ), tid);
#if defined(EXP_DUP_INTRA)
            if (l == 0) { __syncthreads();
            ssd_intra_range(lds, bid, WSP(bf16, WS_RAW), WSP(float, WS_SSC), ap->in[10] + l * 16, WSP(bf16, WS_TQ), tid);
 }
#endif
        } break;
        case 4: {
            pg8::Gemm g{WSP(bf16, WS_XN), WSP(bf16, WS_WB), M, NGATE, DM, 0, 0, 0}; pg8::StaticOrder S; S.init(M, NGATE, G, bid);
            pg8::EpiBf16 E{WSP(bf16, WS_GATES), NGATE};
            half_stagger(bid, STG_B);
            pg8::gemm_phase<pg8::EpiBf16, pg8::StaticOrder, true, PG8_SP2_>(lds, g, S, E);
#if defined(EXP_DUP_GEMM)
            if (l == 0 && (EXP_DUP_GEMM & 2)) { __syncthreads(); pg8::gemm_phase<pg8::EpiBf16, pg8::StaticOrder, true, PG8_SP2_>(lds, g, S, E); }
#endif
        } break;
        case 5: {
            phase_finish(OGP, WSP(bf16, WS_YS), WSP(bf16, WS_TQ), WSP(bf16, WS_GATES), ap->in[7] + l * 128, ap->in[11] + l * 1024, WSP(bf16, WS_MIXED), gw, NGW, lane);
#if defined(EXP_DUP_B)
            if (l == 0) { __syncthreads();
            phase_finish(OGP, WSP(bf16, WS_YS), WSP(bf16, WS_TQ), WSP(bf16, WS_GATES), ap->in[7] + l * 128, ap->in[11] + l * 1024, WSP(bf16, WS_MIXED), gw, NGW, lane);
 }
#endif
        } break;
        case 6: {
            pg8::Gemm g{WSP(bf16, WS_MIXED), WSP(bf16, WS_WO), M, DM, 2048, 0, 0, 0}; pg8::StaticOrder S; S.init(M, DM, G, bid);
            pg8::EpiResidB E{(l == 0) ? ap->in[0] : (const float*)nullptr, (const bf16*)ap->out, WSP(bf16, WS_H), DM};
            half_stagger(bid, STG_O);
            pg8::gemm_phase<pg8::EpiResidB, pg8::StaticOrder, true, PG8_SP2_>(lds, g, S, E);
#if defined(EXP_DUP_GEMM)
            if (l == 0 && (EXP_DUP_GEMM & 4)) { __syncthreads(); pg8::gemm_phase<pg8::EpiResidB, pg8::StaticOrder, true, PG8_SP2_>(lds, g, S, E); }
#endif
        } break;
        case 7: {
            phase_norm2_router(lds, WSP(bf16, WS_H), ap->in[13] + l * DM, ap->in[14] + (size_t)l * DM * 16, WSP(bf16, WS_XN), WSP(float, WS_AFF), gw, NGW, tid, lane);
#if defined(EXP_DUP_A) || defined(EXP_DUP_N2)
            if (l == 0) { __syncthreads();
            phase_norm2_router(lds, WSP(bf16, WS_H), ap->in[13] + l * DM, ap->in[14] + (size_t)l * DM * 16, WSP(bf16, WS_XN), WSP(float, WS_AFF), gw, NGW, tid, lane);
            __syncthreads();
            cvt_expert_weights(lds, wsb, ap->in[15] + (size_t)l * NEXP * DM * EFF, ap->in[16] + (size_t)l * NEXP * DM * EFF, ap->in[17] + (size_t)l * NEXP * EFF * DM, gw, NGW, wave, lane);
            if (l + 1 < DEPTH) cvt_mixer_weights(lds, wsb, ap->in[2] + (size_t)(l + 1) * DM * 6720, ap->in[12] + (size_t)(l + 1) * 2048 * DM, gw, NGW, wave, lane);
 }
#endif
        } break;
        case 8: {
            if (bid < NB * NEXP) phase_topk(lds, WSP(float, WS_AFF), WSP(int, WS_IDX), WSP(float, WS_VAL), WSP(int, WS_INV), bid, tid, wave, lane);
            else if (G > NB * NEXP) { const int gw2 = (bid - NB * NEXP) * NWAVES + wave, NGW2 = (G - NB * NEXP) * NWAVES;
                cvt_expert_weights(lds, wsb, ap->in[15] + (size_t)l * NEXP * DM * EFF, ap->in[16] + (size_t)l * NEXP * DM * EFF, ap->in[17] + (size_t)l * NEXP * EFF * DM, gw2, NGW2, wave, lane);
                if (l + 1 < DEPTH) cvt_mixer_weights(lds, wsb, ap->in[2] + (size_t)(l + 1) * DM * 6720, ap->in[12] + (size_t)(l + 1) * 2048 * DM, gw2, NGW2, wave, lane); }
#if defined(EXP_DUP_A) || defined(EXP_DUP_TK)
            if (l == 0) { __syncthreads();
            for (int be = bid; be < NB * NEXP; be += G) phase_topk(lds, WSP(float, WS_AFF), WSP(int, WS_IDX), WSP(float, WS_VAL), WSP(int, WS_INV), be, tid, wave, lane);
 }
#endif
        } break;
        case 9: {
            pg8::Gemm g{WSP(bf16, WS_XN), WSP(bf16, WS_WGU), MEXP, 1024, DM, 2, 15, (size_t)1024 * 1024 * 2, WSP(int, WS_IDX), 14, SEQ}; pg8::StaticOrder S; S.init(MEXP, 1024, G, bid);
            pg8::EpiSwiglu E{WSP(bf16, WS_HMID), EFF};
            half_stagger(bid, STG_E1);
            pg8::gemm_phase<pg8::EpiSwiglu, pg8::StaticOrder, true, PG8_SP2_, true>(lds, g, S, E);
#if defined(EXP_DUP_GEMM)
            if (l == 0 && (EXP_DUP_GEMM & 8)) { __syncthreads(); pg8::gemm_phase<pg8::EpiSwiglu, pg8::StaticOrder, true, PG8_SP2_, true>(lds, g, S, E); }
#endif
        } break;
        case 10: {
            pg8::Gemm g{WSP(bf16, WS_HMID), WSP(bf16, WS_WD), MEXP, 1024, EFF, 2, 15, (size_t)1024 * 512 * 2}; pg8::StaticOrder S; S.init(MEXP, 1024, G, bid);
            pg8::EpiBf16 E{WSP(bf16, WS_XG), 1024};
            half_stagger(bid, STG_E2);
            pg8::gemm_phase<pg8::EpiBf16, pg8::StaticOrder, true, PG8_SP2_>(lds, g, S, E);
#if defined(EXP_DUP_GEMM)
            if (l == 0 && (EXP_DUP_GEMM & 16)) { __syncthreads(); pg8::gemm_phase<pg8::EpiBf16, pg8::StaticOrder, true, PG8_SP2_>(lds, g, S, E); }
#endif
        } break;
        default: {
            const bool last = (l + 1 == DEPTH);
            phase_combine(WSP(bf16, WS_H), ap->out, WSP(bf16, WS_XG), WSP(int, WS_INV), WSP(float, WS_VAL), last ? ap->in[18] : ap->in[1] + (size_t)(l + 1) * DM, WSP(bf16, WS_XN), last, gw, NGW, lane, PROBE_SCALE);

        } break;
        }
        if (ph + 1 < hi) GRID_BAR();
#if defined(EXP_XBAR)
        if (ph == 1) for (int xb_ = 0; xb_ < EXP_XBAR; ++xb_) GRID_BAR();
#endif
#if defined(PROBE_ANY)
        if (l == PROBE_L && k == PROBE_K1 && blockIdx.x == 0 && threadIdx.x == 0) { const unsigned long long t1_ = __builtin_amdgcn_s_memrealtime(), t0_ = ((unsigned long long*)(wsb + WS_CTL))[1100];
            const unsigned bk_ = (unsigned)((t1_ - t0_) / PROBE_TICKS); *(volatile float*)PROBE_PTR = (float)(bk_ > 40u ? 40u : bk_) * (1.0f / 40.0f); }
#endif
    }
#undef WSP
#undef OGP
}

extern "C" void kernel_launch(void* const* d_in, const int* in_sizes, int n_in, void* d_out, int out_size, void* d_ws, size_t ws_size, hipStream_t stream) {
    static int grid = 0;
    if (grid == 0) {
        if (n_in != 19 || in_sizes[0] != M * DM || out_size != M * DM || ws_size < WS_END) { fprintf(stderr, "kernel_launch: unexpected shapes (n_in %d, in0 %d, out %d, ws %zu); nothing launched\n", n_in, n_in > 0 ? in_sizes[0] : -1, out_size, ws_size); grid = -1; return; }
        int dev = 0, cus = 0;
        if (hipGetDevice(&dev) != hipSuccess || hipDeviceGetAttribute(&cus, hipDeviceAttributeMultiprocessorCount, dev) != hipSuccess) { grid = -1; return; }
        if (hipFuncSetAttribute((const void*)fwd_kernel, hipFuncAttributeMaxDynamicSharedMemorySize, LDS_BYTES) != hipSuccess) { fprintf(stderr, "kernel_launch: hipFuncSetAttribute failed\n"); grid = -1; return; }
        (void)hipGetLastError();
        grid = cus;
    }
    if (grid < 0) return;
    (void)hipMemsetAsync((char*)d_ws + WS_CTL, 0, CTL_ZERO_BYTES, stream);
    Args a{};
    for (int i = 0; i < 19; ++i) a.in[i] = (const float*)d_in[i];
    a.out = (float*)d_out; a.ws = (unsigned char*)d_ws;
#if MK_ONE_LAUNCH
    a.ph_lo = 0; a.ph_hi = NPHASE;
    hipLaunchKernelGGL(fwd_kernel, dim3(grid), dim3(NWAVES * 64), LDS_BYTES, stream, a);
#else
    for (int p = 0; p < NPHASE; ++p) { a.ph_lo = p; a.ph_hi = p + 1; hipLaunchKernelGGL(fwd_kernel, dim3(grid), dim3(NWAVES * 64), LDS_BYTES, stream, a); }
#endif
}
```
